# Optimizing an MI355X kernel written in HIP

```python
import math
import jax, jax.numpy as jnp
from jax import lax
import numpy as np

D_MODEL = 2048
BATCH = 2
SEQ = 8192
DEPTH = 2

N_MIXERS = 2
N_HEADS = 16
HEAD_DIM = D_MODEL // N_HEADS
NSA_KV_GROUPS = 4
NSA_HPG = N_HEADS // NSA_KV_GROUPS
CMP_LEN = 32
CMP_STRIDE = 16
SEL_LEN = 64
SEL_TOP = 16
WINDOW = 512
N_BRANCH = 3
NSA_Q_BLOCK = 64
SEL_FORCE = 1e4
MLA_KV_RANK = 256
IDX_HEADS = 8
IDX_DIM = 64
IDX_TOPK = 256
DSA_Q_BLOCK = 128
REL_BUCKETS = 32
REL_MAX_DIST = 128
D_FF = 5632
N_EXPERTS = 8
MOE_TOP_K = 2
D_FF_EXPERT = 7168
MOE_ROW_BLOCK = 512
ALPHA = (2 * DEPTH) ** 0.25
BETA = (8 * DEPTH) ** -0.25
LN_EPS = 1e-5
RMS_EPS = 1e-6
NEG_INF = -1e30
NSA_SIZES = (N_HEADS * HEAD_DIM,) + (NSA_KV_GROUPS * HEAD_DIM,) * 6 + (N_BRANCH * N_HEADS,)
DSA_SIZES = (N_HEADS * HEAD_DIM, MLA_KV_RANK, IDX_HEADS * IDX_DIM, IDX_DIM, IDX_HEADS)

kernel_name = "nsa_dsa_interleaved_deepnorm_moe"


def split_cols(y, sizes):
    return jnp.split(y, np.cumsum(sizes)[:-1].tolist(), axis=-1)


def layer_norm(x, g, b):
    xf = x.astype(jnp.float32)
    mu = xf.mean(-1, keepdims=True)
    var = jnp.square(xf - mu).mean(-1, keepdims=True)
    return ((xf - mu) * lax.rsqrt(var + LN_EPS) * g + b).astype(x.dtype)


def rms_norm(x, g):
    xf = x.astype(jnp.float32)
    return (xf * lax.rsqrt(jnp.mean(xf * xf, -1, keepdims=True) + RMS_EPS) * g).astype(x.dtype)


def masked_softmax(s, mask):
    s = jnp.where(mask, s.astype(jnp.float32), NEG_INF)
    return jax.nn.softmax(s, axis=-1) * mask


def rel_bucket(dist):
    n = jnp.maximum(dist, 0)
    exact = REL_BUCKETS // 2
    nf = jnp.maximum(n, exact).astype(jnp.float32)
    large = exact + (jnp.log(nf / exact) / math.log(REL_MAX_DIST / exact)
                     * (REL_BUCKETS - exact)).astype(jnp.int32)
    return jnp.where(n < exact, n, jnp.minimum(large, REL_BUCKETS - 1))


def head_bias(rel_bias, dist):
    tq, n = dist.shape
    bias = rel_bias[rel_bucket(dist)].transpose(2, 0, 1)
    return bias.reshape(NSA_KV_GROUPS, NSA_HPG, tq, n).astype(jnp.float32)


def compress_blocks(kv, cidx, pe, w1, w2):
    blk = kv[:, cidx] + pe[:, None, :]
    hid = jax.nn.gelu(jnp.einsum('bnlgd,lde->bnge', blk, w1))
    return jnp.einsum('bnge,ef->bngf', hid, w2)


def cmp_sel_overlap(n_cmp, n_sel):
    i = np.arange(n_cmp)[:, None]
    j = np.arange(n_sel)[None, :]
    lo = np.maximum(i * CMP_STRIDE, j * SEL_LEN)
    hi = np.minimum(i * CMP_STRIDE + CMP_LEN, (j + 1) * SEL_LEN)
    return (np.maximum(hi - lo, 0) / CMP_LEN).astype(np.float32)


def nsa_mixer(x, w_in, pe_k, w1_k, w2_k, pe_v, w1_v, w2_v, w_out, rel_bias):
    b, s_len, _ = x.shape
    G, J, Dh = NSA_KV_GROUPS, NSA_HPG, HEAD_DIM
    q, kc, vc, ksl, vsl, kw, vw, gl = split_cols(x @ w_in, NSA_SIZES)
    q = q.reshape(b, s_len, N_HEADS, Dh) * (Dh ** -0.5)
    gates = jax.nn.sigmoid(gl.astype(jnp.float32)).astype(x.dtype).reshape(b, s_len, G, J, N_BRANCH)
    kv = lambda t: t.reshape(b, s_len, G, Dh)
    n_cmp = (s_len - CMP_LEN) // CMP_STRIDE + 1
    cidx = np.arange(n_cmp)[:, None] * CMP_STRIDE + np.arange(CMP_LEN)[None, :]
    k_cmp = compress_blocks(kv(kc), cidx, pe_k, w1_k, w2_k)
    v_cmp = compress_blocks(kv(vc), cidx, pe_v, w1_v, w2_v)
    cmp_end = jnp.asarray(np.arange(n_cmp) * CMP_STRIDE + CMP_LEN - 1, jnp.int32)
    n_sel = s_len // SEL_LEN
    n_top = min(SEL_TOP, n_sel)
    overlap = jnp.asarray(cmp_sel_overlap(n_cmp, n_sel))
    k_blk = kv(ksl).reshape(b, n_sel, SEL_LEN, G, Dh).transpose(0, 3, 1, 2, 4)
    v_blk = kv(vsl).reshape(b, n_sel, SEL_LEN, G, Dh).transpose(0, 3, 1, 2, 4)
    pad = ((0, 0), (WINDOW, 0), (0, 0), (0, 0))
    k_win = jnp.pad(kv(kw), pad)
    v_win = jnp.pad(kv(vw), pad)
    bI = jnp.arange(b)[:, None, None, None]
    gI = jnp.arange(G)[None, :, None, None]
    table_g = rel_bias.reshape(REL_BUCKETS, G, J)
    sel_off = jnp.arange(SEL_LEN)
    j_sel = jnp.arange(n_sel)

    def one_block(args):
        qb, q_b, g_b = args
        t = qb * NSA_Q_BLOCK + jnp.arange(NSA_Q_BLOCK)
        qg = q_b.reshape(b, NSA_Q_BLOCK, G, J, Dh)
        d_c = t[:, None] - cmp_end[None, :]
        s_c = jnp.einsum('bqgjd,bngd->bgjqn', qg, k_cmp).astype(jnp.float32) + head_bias(rel_bias, d_c)
        p_c = masked_softmax(s_c, d_c >= 0)
        o_c = jnp.einsum('bgjqn,bngd->bqgjd', p_c.astype(x.dtype), v_cmp)
        score = jnp.einsum('bgjqn,nm->bgqm', p_c, overlap)
        cur = (t // SEL_LEN)[:, None]
        forced = (j_sel == 0) | (j_sel == cur) | (j_sel == cur - 1)
        visible = j_sel * SEL_LEN <= t[:, None]
        score = jnp.where(forced, SEL_FORCE, jnp.where(visible, score, -1.0))
        _, sel = lax.top_k(score, n_top)
        k_s = k_blk[bI, gI, sel].reshape(b, G, NSA_Q_BLOCK, n_top * SEL_LEN, Dh)
        v_s = v_blk[bI, gI, sel].reshape(b, G, NSA_Q_BLOCK, n_top * SEL_LEN, Dh)
        pos = (sel[..., None] * SEL_LEN + sel_off).reshape(b, G, NSA_Q_BLOCK, n_top * SEL_LEN)
        d_s = t[None, None, :, None] - pos
        bias_s = table_g[rel_bucket(d_s), gI].transpose(0, 1, 4, 2, 3).astype(jnp.float32)
        s_s = jnp.einsum('bqgjd,bgqkd->bgjqk', qg, k_s).astype(jnp.float32) + bias_s
        p_s = masked_softmax(s_s, (d_s >= 0)[:, :, None])
        o_s = jnp.einsum('bgjqk,bgqkd->bqgjd', p_s.astype(x.dtype), v_s)
        start = qb * NSA_Q_BLOCK
        k_w = lax.dynamic_slice_in_dim(k_win, start, WINDOW + NSA_Q_BLOCK, axis=1)
        v_w = lax.dynamic_slice_in_dim(v_win, start, WINDOW + NSA_Q_BLOCK, axis=1)
        spos = start - WINDOW + jnp.arange(WINDOW + NSA_Q_BLOCK)
        d_w = t[:, None] - spos[None, :]
        m_w = (d_w >= 0) & (d_w < WINDOW) & (spos >= 0)[None, :]
        s_w = jnp.einsum('bqgjd,bkgd->bgjqk', qg, k_w).astype(jnp.float32) + head_bias(rel_bias, d_w)
        p_w = masked_softmax(s_w, m_w)
        o_w = jnp.einsum('bgjqk,bkgd->bqgjd', p_w.astype(x.dtype), v_w)
        return g_b[..., 0:1] * o_c + g_b[..., 1:2] * o_s + g_b[..., 2:3] * o_w

    nqb = s_len // NSA_Q_BLOCK
    q_blocks = q.reshape(b, nqb, NSA_Q_BLOCK, N_HEADS, Dh).swapaxes(0, 1)
    g_blocks = gates.reshape(b, nqb, NSA_Q_BLOCK, G, J, N_BRANCH).swapaxes(0, 1)
    o = lax.map(one_block, (jnp.arange(nqb), q_blocks, g_blocks))
    o = o.swapaxes(0, 1).reshape(b, s_len, N_HEADS * Dh)
    return o @ w_out


def dsa_mixer(x, w_in, kv_norm_g, w_uk, w_uv, w_out, rel_bias):
    b, s_len, _ = x.shape
    q, c, qi, ki, wi = split_cols(x @ w_in, DSA_SIZES)
    q = q.reshape(b, s_len, N_HEADS, HEAD_DIM)
    c = rms_norm(c, kv_norm_g)
    qi = qi.reshape(b, s_len, IDX_HEADS, IDX_DIM) * (IDX_DIM ** -0.5)
    wi = wi * (IDX_HEADS ** -0.5)
    q_lat = jnp.einsum('bshd,hdc->bshc', q, w_uk) * (HEAD_DIM ** -0.5)
    k_sel = min(IDX_TOPK, s_len // 4)
    nqb = s_len // DSA_Q_BLOCK
    keys = jnp.arange(s_len)
    bI = jnp.arange(b)[:, None, None]

    def one_block(args):
        qb, qi_b, wi_b, ql_b = args
        t = qb * DSA_Q_BLOCK + jnp.arange(DSA_Q_BLOCK)
        dots = jnp.einsum('bqhe,bke->bqhk', qi_b, ki).astype(jnp.float32)
        score = jnp.einsum('bqh,bqhk->bqk', wi_b.astype(jnp.float32), jax.nn.relu(dots))
        score = jnp.where(keys[None, :] <= t[:, None], score, NEG_INF)
        _, idx = lax.top_k(score, k_sel)
        c_s = c[bI, idx]
        d = t[None, :, None] - idx
        bias = rel_bias[rel_bucket(d)].transpose(0, 3, 1, 2).astype(jnp.float32)
        s = jnp.einsum('bqhc,bqkc->bhqk', ql_b, c_s).astype(jnp.float32) + bias
        p = masked_softmax(s, (d >= 0)[:, None])
        o_lat = jnp.einsum('bhqk,bqkc->bqhc', p.astype(x.dtype), c_s)
        return jnp.einsum('bqhc,hcd->bqhd', o_lat, w_uv)

    blk = lambda t: t.reshape((b, nqb, DSA_Q_BLOCK) + t.shape[2:]).swapaxes(0, 1)
    o = lax.map(one_block, (jnp.arange(nqb), blk(qi), blk(wi), blk(q_lat)))
    o = o.swapaxes(0, 1).reshape(b, s_len, N_HEADS * HEAD_DIM)
    return o @ w_out


def swiglu(x, w_gate, w_up, w_down):
    return (jax.nn.silu(x @ w_gate) * (x @ w_up)) @ w_down


def moe_swiglu(x, w_router, b_router, w_gate, w_up, w_down):
    b, s_len, d = x.shape
    xt = x.reshape(-1, d)
    n_tok = xt.shape[0]
    logits = xt.astype(jnp.float32) @ w_router.astype(jnp.float32) + b_router.astype(jnp.float32)
    top_logit, top_e = lax.top_k(logits, MOE_TOP_K)
    top_w = jax.nn.softmax(top_logit, axis=-1)
    n_assign = n_tok * MOE_TOP_K
    e_flat = top_e.reshape(-1)
    order = jnp.argsort(e_flat)
    e_sorted = e_flat[order]
    tok_sorted = (order // MOE_TOP_K).astype(jnp.int32)
    w_sorted = top_w.reshape(-1)[order].astype(x.dtype)
    counts = jnp.bincount(e_flat, length=N_EXPERTS)
    starts = jnp.cumsum(counts) - counts
    padded = (counts + MOE_ROW_BLOCK - 1) // MOE_ROW_BLOCK * MOE_ROW_BLOCK
    pad_ends = jnp.cumsum(padded)
    pad_starts = pad_ends - padded
    dest = pad_starts[e_sorted] + jnp.arange(n_assign) - starts[e_sorted]
    n_blocks = -(-n_assign // MOE_ROW_BLOCK) + N_EXPERTS
    n_rows = n_blocks * MOE_ROW_BLOCK
    row_tok = jnp.zeros((n_rows,), jnp.int32).at[dest].set(tok_sorted)
    row_w = jnp.zeros((n_rows,), x.dtype).at[dest].set(w_sorted)
    block_e = jnp.minimum(jnp.searchsorted(pad_ends, jnp.arange(n_blocks) * MOE_ROW_BLOCK, side='right'),
                          N_EXPERTS - 1)

    def expert_block(args):
        tok, w, e = args
        xb = xt[tok]
        h = jax.nn.silu(xb @ w_gate[e]) * (xb @ w_up[e])
        return (h @ w_down[e]) * w[:, None]

    y_rows = lax.map(expert_block, (row_tok.reshape(n_blocks, MOE_ROW_BLOCK),
                                    row_w.reshape(n_blocks, MOE_ROW_BLOCK), block_e))
    y = jnp.zeros_like(xt).at[row_tok].add(y_rows.reshape(n_rows, d))
    return y.reshape(b, s_len, d)


def setup_inputs(seed: int = 0) -> dict:
    key = jax.random.key(seed)
    ks = iter(jax.random.split(key, 32))
    nrm = lambda shape, scale: jax.random.normal(next(ks), shape, jnp.float32) * scale
    D, Dh, E = D_MODEL, HEAD_DIM, N_EXPERTS
    return {
        "x": nrm((BATCH, SEQ, D), 1.0),
        "rel_bias": nrm((REL_BUCKETS, N_HEADS), 0.3),
        "nsa_w_in": nrm((D, sum(NSA_SIZES)), D ** -0.5),
        "nsa_cmp_pe_k": nrm((CMP_LEN, Dh), 0.1),
        "nsa_cmp_w1_k": nrm((CMP_LEN, Dh, Dh), (CMP_LEN * Dh) ** -0.5),
        "nsa_cmp_w2_k": nrm((Dh, Dh), Dh ** -0.5),
        "nsa_cmp_pe_v": nrm((CMP_LEN, Dh), 0.1),
        "nsa_cmp_w1_v": nrm((CMP_LEN, Dh, Dh), (CMP_LEN * Dh) ** -0.5),
        "nsa_cmp_w2_v": nrm((Dh, Dh), Dh ** -0.5),
        "nsa_w_out": nrm((N_HEADS * Dh, D), BETA * (N_HEADS * Dh) ** -0.5),
        "dsa_w_in": nrm((D, sum(DSA_SIZES)), D ** -0.5),
        "dsa_kv_norm_g": 1.0 + nrm((MLA_KV_RANK,), 0.02),
        "dsa_w_uk": nrm((N_HEADS, Dh, MLA_KV_RANK), Dh ** -0.5),
        "dsa_w_uv": nrm((N_HEADS, MLA_KV_RANK, Dh), MLA_KV_RANK ** -0.5),
        "dsa_w_out": nrm((N_HEADS * Dh, D), BETA * (N_HEADS * Dh) ** -0.5),
        "ffn_w_gate": nrm((D, D_FF), D ** -0.5),
        "ffn_w_up": nrm((D, D_FF), D ** -0.5),
        "ffn_w_down": nrm((D_FF, D), BETA * D_FF ** -0.5),
        "moe_w_router": nrm((D, E), D ** -0.5),
        "moe_b_router": nrm((E,), 0.01),
        "moe_w_gate": nrm((E, D, D_FF_EXPERT), D ** -0.5),
        "moe_w_up": nrm((E, D, D_FF_EXPERT), D ** -0.5),
        "moe_w_down": nrm((E, D_FF_EXPERT, D), BETA * D_FF_EXPERT ** -0.5),
        "ln_mix_g": 1.0 + nrm((DEPTH, D), 0.02),
        "ln_mix_b": nrm((DEPTH, D), 0.02),
        "ln_ffn_g": 1.0 + nrm((DEPTH, D), 0.02),
        "ln_ffn_b": nrm((DEPTH, D), 0.02),
    }


def reference(x, rel_bias,
              nsa_w_in, nsa_cmp_pe_k, nsa_cmp_w1_k, nsa_cmp_w2_k,
              nsa_cmp_pe_v, nsa_cmp_w1_v, nsa_cmp_w2_v, nsa_w_out,
              dsa_w_in, dsa_kv_norm_g, dsa_w_uk, dsa_w_uv, dsa_w_out,
              ffn_w_gate, ffn_w_up, ffn_w_down,
              moe_w_router, moe_b_router, moe_w_gate, moe_w_up, moe_w_down,
              ln_mix_g, ln_mix_b, ln_ffn_g, ln_ffn_b):
    for i in range(DEPTH):
        if i % N_MIXERS == 0:
            h = nsa_mixer(x, nsa_w_in, nsa_cmp_pe_k, nsa_cmp_w1_k, nsa_cmp_w2_k,
                          nsa_cmp_pe_v, nsa_cmp_w1_v, nsa_cmp_w2_v, nsa_w_out, rel_bias)
        else:
            h = dsa_mixer(x, dsa_w_in, dsa_kv_norm_g, dsa_w_uk, dsa_w_uv, dsa_w_out, rel_bias)
        x = layer_norm(ALPHA * x + h, ln_mix_g[i], ln_mix_b[i])
        if i % 2 == 0:
            f = swiglu(x, ffn_w_gate, ffn_w_up, ffn_w_down)
        else:
            f = moe_swiglu(x, moe_w_router, moe_b_router, moe_w_gate, moe_w_up, moe_w_down)
        x = layer_norm(ALPHA * x + f, ln_ffn_g[i], ln_ffn_b[i])
    return x
```

```cpp
#include <hip/hip_runtime.h>
#include <cstdio>
#include <cstdint>
namespace pg8 {
#define PG8_LAS __attribute__((address_space(3)))
typedef unsigned short bf16_t;
typedef short bf16x8 __attribute__((ext_vector_type(8)));
typedef float f32x4 __attribute__((ext_vector_type(4)));
typedef unsigned u32x4 __attribute__((ext_vector_type(4)));
constexpr int BM = 256, BK = 64, HALF = 128, HTB = HALF * BK * 2  , STAGE_BYTES = 8 * HTB, NXCD = 8, WGM = 8;

__host__ __device__ __forceinline__ int lds_byte(int r, int c) { const int st = (r >> 4) * 2 + (c >> 5), rr = r & 15, cc = c & 31, ob = rr * 64 + cc * 2; return st * 1024 + (ob ^ (((ob >> 9) & 1) << 5)); }
__host__ __device__ __forceinline__ void stage_rc(int b, int& R, int& C) { const int st = b / 1024, sb = b % 1024, swz = sb ^ (((sb >> 9) & 1) << 5); R = (st >> 1) * 16 + swz / 64; C = (st & 1) * 32 + (swz % 64) / 2; }
__host__ __device__ __forceinline__ int perm32(int rho) { const int n = rho >> 4, i = rho & 15; return 8 * (i >> 2) + 4 * n + (i & 3); }

struct Unit { int pm, pn; };
struct Gemm { const bf16_t* A; const bf16_t* Bt; int M, N, K; };

struct StaticOrder {
    int nM, nN, nwg, G, c;
    __host__ __device__ void init(int M, int N, int G_, int c_) { nM = M / BM; nN = N / BM; nwg = nM * nN; G = G_; c = c_; }
    __host__ __device__ bool next(int i, Unit& u) const {
        const long L = (long)i * G + c; if (L >= nwg) return false;
        int wgid = (int)L; { const int q = nwg / NXCD, r = nwg % NXCD, xcd = wgid % NXCD, off = wgid / NXCD; wgid = (xcd < r ? xcd * (q + 1) : r * (q + 1) + (xcd - r) * q) + off; }
        const int nig = WGM * nN, gid = wgid / nig, fm = gid * WGM, gsz = (nM - fm) < WGM ? (nM - fm) : WGM;
        u.pm = fm + ((wgid % nig) % gsz); u.pn = (wgid % nig) / gsz; return true;
    }
    __device__ __forceinline__ void a_ready(const Unit&) const {}
    __device__ __forceinline__ void done(const Unit&) const {}
    __device__ __forceinline__ const char* a_ptr(const Gemm& g, const Unit& u) const { return (const char*)g.A + (size_t)u.pm * ((size_t)BM * g.K * 2); }
    __device__ __forceinline__ const char* b_ptr(const Gemm& g, const Unit& u) const { return (const char*)g.Bt + (size_t)u.pn * ((size_t)BM * g.K * 2); }
};


__device__ __forceinline__ unsigned cvt_pk_bf16(float lo, float hi) { unsigned r; asm volatile("v_cvt_pk_bf16_f32 %0, %1, %2" : "=v"(r) : "v"(lo), "v"(hi)); return r; }
__device__ __forceinline__ u32x4 pack8(const f32x4 v0, const f32x4 v1) { u32x4 w; w.x = cvt_pk_bf16(v0[0], v0[1]); w.y = cvt_pk_bf16(v0[2], v0[3]); w.z = cvt_pk_bf16(v1[0], v1[1]); w.w = cvt_pk_bf16(v1[2], v1[3]); return w; }

struct EpiNsaIn {
    static constexpr bool PERM = true, AFTER_DRAIN = false;
    bf16_t* P0; float* GL; float qscale;
    __device__ __forceinline__ void operator()(const f32x4 (&acc)[2][2][4][2], const Unit& u, int wr, int wc, int fr, int fq) const {
        const int row0 = u.pm * BM + wr * 64 + fr;
        if (u.pn < 20) {
            const float s = u.pn < 8 ? qscale : 1.0f;
            const int col0 = u.pn * BM + wc * 32 + 8 * fq;
#pragma unroll
            for (int ai = 0; ai < 2; ++ai)
#pragma unroll
                for (int m = 0; m < 4; ++m) { bf16_t* rowp = P0 + (size_t)(row0 + ai * HALF + m * 16) * 5120 + col0;
#pragma unroll
                    for (int bj = 0; bj < 2; ++bj) *(u32x4*)(rowp + bj * HALF) = pack8(acc[ai][bj][m][0] * s, acc[ai][bj][m][1] * s); }
        } else {
            const int c = wc * 32 + 8 * fq;
            if (c < 48) {
#pragma unroll
                for (int ai = 0; ai < 2; ++ai)
#pragma unroll
                    for (int m = 0; m < 4; ++m) { float* gp = GL + (size_t)(row0 + ai * HALF + m * 16) * 48 + c;
                        *(f32x4*)gp = acc[ai][0][m][0]; *(f32x4*)(gp + 4) = acc[ai][0][m][1]; }
            }
        }
    }
};
struct EpiDsaIn {
    static constexpr bool PERM = true, AFTER_DRAIN = false;
    bf16_t* Q; float* CRAW; bf16_t* QI; float* KIWI; float qiscale;
    __device__ __forceinline__ void operator()(const f32x4 (&acc)[2][2][4][2], const Unit& u, int wr, int wc, int fr, int fq) const {
        const int row0 = u.pm * BM + wr * 64 + fr; const int c = wc * 32 + 8 * fq;
        if (u.pn < 8) {
#pragma unroll
            for (int ai = 0; ai < 2; ++ai)
#pragma unroll
                for (int m = 0; m < 4; ++m) { bf16_t* rowp = Q + (size_t)(row0 + ai * HALF + m * 16) * 2048 + u.pn * BM + c;
#pragma unroll
                    for (int bj = 0; bj < 2; ++bj) *(u32x4*)(rowp + bj * HALF) = pack8(acc[ai][bj][m][0], acc[ai][bj][m][1]); }
        } else if (u.pn == 8) {
#pragma unroll
            for (int ai = 0; ai < 2; ++ai)
#pragma unroll
                for (int m = 0; m < 4; ++m) { float* rowp = CRAW + (size_t)(row0 + ai * HALF + m * 16) * 256 + c;
#pragma unroll
                    for (int bj = 0; bj < 2; ++bj) { *(f32x4*)(rowp + bj * HALF) = acc[ai][bj][m][0]; *(f32x4*)(rowp + bj * HALF + 4) = acc[ai][bj][m][1]; } }
        } else if (u.pn < 11) {
#pragma unroll
            for (int ai = 0; ai < 2; ++ai)
#pragma unroll
                for (int m = 0; m < 4; ++m) { bf16_t* rowp = QI + (size_t)(row0 + ai * HALF + m * 16) * 512 + (u.pn - 9) * BM + c;
#pragma unroll
                    for (int bj = 0; bj < 2; ++bj) *(u32x4*)(rowp + bj * HALF) = pack8(acc[ai][bj][m][0] * qiscale, acc[ai][bj][m][1] * qiscale); }
        } else {
#pragma unroll
            for (int ai = 0; ai < 2; ++ai)
#pragma unroll
                for (int m = 0; m < 4; ++m) { float* rowp = KIWI + (size_t)(row0 + ai * HALF + m * 16) * 128 + c;
                    *(f32x4*)rowp = acc[ai][0][m][0]; *(f32x4*)(rowp + 4) = acc[ai][0][m][1]; }
        }
    }
};
struct EpiResF32 {
    static constexpr bool PERM = false, AFTER_DRAIN = false;
    const float* R; float* Z; float alpha; int ldc;
    __device__ __forceinline__ void operator()(const f32x4 (&acc)[2][2][4][2], const Unit& u, int wr, int wc, int fr, int fq) const {
        const int row0 = u.pm * BM + wr * 64 + fr, col0 = u.pn * BM + wc * 32 + 4 * fq;
#pragma unroll
        for (int ai = 0; ai < 2; ++ai)
#pragma unroll
            for (int m = 0; m < 4; ++m) { const size_t off = (size_t)(row0 + ai * HALF + m * 16) * ldc + col0;
#pragma unroll
                for (int bj = 0; bj < 2; ++bj)
#pragma unroll
                    for (int n = 0; n < 2; ++n) { const f32x4 r = *(const f32x4*)(R + off + bj * HALF + n * 16); *(f32x4*)(Z + off + bj * HALF + n * 16) = r * alpha + acc[ai][bj][m][n]; } }
    }
};
struct EpiF32 {
    static constexpr bool PERM = false, AFTER_DRAIN = false;
    float* C; int ldc;
    __device__ __forceinline__ void operator()(const f32x4 (&acc)[2][2][4][2], const Unit& u, int wr, int wc, int fr, int fq) const {
        const int row0 = u.pm * BM + wr * 64 + fr, col0 = u.pn * BM + wc * 32 + 4 * fq;
#pragma unroll
        for (int ai = 0; ai < 2; ++ai)
#pragma unroll
            for (int m = 0; m < 4; ++m) { float* rowp = C + (size_t)(row0 + ai * HALF + m * 16) * ldc + col0;
#pragma unroll
                for (int bj = 0; bj < 2; ++bj)
#pragma unroll
                    for (int n = 0; n < 2; ++n) *(f32x4*)(rowp + bj * HALF + n * 16) = acc[ai][bj][m][n]; }
    }
};
__device__ __forceinline__ float silu_mul(float g, float u) { return g * __builtin_amdgcn_rcpf(1.0f + __expf(-g)) * u; }
struct EpiSwiGLU {
    static constexpr bool PERM = true, AFTER_DRAIN = false;
    bf16_t* H; int ldh;
    __device__ __forceinline__ void operator()(const f32x4 (&acc)[2][2][4][2], const Unit& u, int wr, int wc, int fr, int fq) const {
        const int row0 = u.pm * BM + wr * 64 + fr, col0 = u.pn * HALF + wc * 32 + 8 * fq;
#pragma unroll
        for (int ai = 0; ai < 2; ++ai)
#pragma unroll
            for (int m = 0; m < 4; ++m) { bf16_t* rowp = H + (size_t)(row0 + ai * HALF + m * 16) * ldh + col0;
                f32x4 v0, v1;
#pragma unroll
                for (int j = 0; j < 4; ++j) { v0[j] = silu_mul(acc[ai][0][m][0][j], acc[ai][1][m][0][j]); v1[j] = silu_mul(acc[ai][0][m][1][j], acc[ai][1][m][1][j]); }
                *(u32x4*)rowp = pack8(v0, v1); }
    }
};
struct MoeOrder : StaticOrder {
    int tend[8]; int nexp_rows;
    __device__ __forceinline__ int expert(int pm) const { int e = 0;
#pragma unroll
        for (int i = 0; i < 7; ++i) e += (pm >= tend[i]) ? 1 : 0; return e; }
    __device__ __forceinline__ const char* b_ptr(const Gemm& g, const Unit& u) const { return (const char*)g.Bt + ((size_t)expert(u.pm) * nexp_rows + (size_t)u.pn * BM) * ((size_t)g.K * 2); }
};
template <class Epi, class Sched, bool ALIGN_EPI = false, bool SP2 = false>
__device__ __forceinline__ void gemm_phase(PG8_LAS unsigned char* lds, const Gemm g, const Sched& S, const Epi& E) {
    int tid = threadIdx.x; asm volatile("" : "+v"(tid));
    const int wid = __builtin_amdgcn_readfirstlane(tid >> 6), lane = tid & 63, wr = wid >> 2, wc = wid & 3, fr = lane & 15, fq = lane >> 4;
    const int K = g.K, nt = K / BK;
    unsigned voffA[2], voffB[2];
#pragma unroll
    for (int i = 0; i < 2; ++i) { int R, C; stage_rc(tid * 16 + i * 8192, R, C); const int Rb = Epi::PERM ? ((R & ~31) + perm32(R & 31)) : R;
        voffA[i] = (unsigned)(R * K + C) * 2u; voffB[i] = (unsigned)(Rb * K + C) * 2u; }
    const size_t kstep = (size_t)(BK * 2);
    const size_t hstep = (size_t)HALF * K * 2;
    const size_t tstep = 2 * hstep;
    const unsigned ldsw = (unsigned)wid * 1024u;
    const int aoff = lds_byte(wr * 64 + fr, fq * 8), boff = lds_byte(wc * 32 + fr, fq * 8);
#define PG8_SA(b, h) (((b) * 2 + (h)) * HTB)
#define PG8_SB(b, h) ((4 + (b) * 2 + (h)) * HTB)
#define PG8_STAGE(bufoff, gbase, voff) do { _Pragma("unroll") for (int _i = 0; _i < 2; ++_i) \
        __builtin_amdgcn_global_load_lds((const unsigned*)((const char*)(gbase) + (voff)[_i]), (PG8_LAS unsigned*)(lds + (bufoff) + ldsw + _i * 8192), 16, 0, 0); } while (0)
#define PG8_LDA(dst, b, h) do { _Pragma("unroll") for (int m = 0; m < 4; ++m) _Pragma("unroll") for (int k = 0; k < 2; ++k) dst[m][k] = *(const PG8_LAS bf16x8*)(lds + PG8_SA(b, h) + aoff + m * 2048 + k * 1024); } while (0)
#define PG8_LDB(dst, b, h) do { _Pragma("unroll") for (int n = 0; n < 2; ++n) _Pragma("unroll") for (int k = 0; k < 2; ++k) dst[n][k] = *(const PG8_LAS bf16x8*)(lds + PG8_SB(b, h) + boff + n * 2048 + k * 1024); } while (0)
#define PG8_MMA(ai, bj, At, Bt) do { __builtin_amdgcn_s_setprio(1); _Pragma("unroll") for (int m = 0; m < 4; ++m) _Pragma("unroll") for (int n = 0; n < 2; ++n) _Pragma("unroll") for (int k = 0; k < 2; ++k) \
        acc[ai][bj][m][n] = __builtin_amdgcn_mfma_f32_16x16x32_bf16(Bt[n][k], At[m][k], acc[ai][bj][m][n], 0, 0, 0); __builtin_amdgcn_s_setprio(0); } while (0)
#define PG8_WAIT_V(n) asm volatile("s_waitcnt vmcnt(" #n ")" ::: "memory")
#define PG8_WAIT_L(n) asm volatile("s_waitcnt lgkmcnt(" #n ")" ::: "memory")
#define PG8_BAR __builtin_amdgcn_s_barrier()
#define PG8_SCHED __builtin_amdgcn_sched_barrier(0)
    Unit cur, nxt; int ui = 0;
    if (!S.next(0, cur)) return;
    f32x4 acc[2][2][4][2];
#pragma unroll
    for (int a = 0; a < 2; ++a)
#pragma unroll
        for (int b = 0; b < 2; ++b)
#pragma unroll
            for (int m = 0; m < 4; ++m)
#pragma unroll
                for (int n = 0; n < 2; ++n) acc[a][b][m][n] = (f32x4){0.f, 0.f, 0.f, 0.f};
    bf16x8 At[4][2], B0[2][2], B1[2][2];
    const char* cA = S.a_ptr(g, cur); const char* cB = S.b_ptr(g, cur);
    S.a_ready(cur);
    if constexpr (SP2) {
        PG8_STAGE(PG8_SB(0, 0), cB, voffB); PG8_STAGE(PG8_SB(0, 1), cB + hstep, voffB); PG8_STAGE(PG8_SA(0, 0), cA, voffA); PG8_STAGE(PG8_SA(0, 1), cA + hstep, voffA);
        if (wr == 1) PG8_BAR;
        PG8_WAIT_V(2); PG8_BAR;
        PG8_STAGE(PG8_SB(1, 0), cB + kstep, voffB); PG8_STAGE(PG8_SA(1, 0), cA + kstep, voffA); PG8_STAGE(PG8_SB(1, 1), cB + hstep + kstep, voffB);
        PG8_WAIT_V(6); PG8_BAR;
    } else {
        PG8_STAGE(PG8_SB(0, 0), cB, voffB); PG8_STAGE(PG8_SA(0, 0), cA, voffA); PG8_STAGE(PG8_SB(0, 1), cB + hstep, voffB); PG8_STAGE(PG8_SA(0, 1), cA + hstep, voffA);
        if (wr == 1) PG8_BAR;
        PG8_WAIT_V(4); PG8_BAR;
        PG8_STAGE(PG8_SB(1, 0), cB + kstep, voffB); PG8_STAGE(PG8_SA(1, 0), cA + kstep, voffA); PG8_STAGE(PG8_SB(1, 1), cB + hstep + kstep, voffB);
        PG8_WAIT_V(6); PG8_BAR;
    }
    for (;;) {
        const bool has_next = S.next(ui + 1, nxt);
        const char* nA = has_next ? S.a_ptr(g, nxt) : cA; const char* nB = has_next ? S.b_ptr(g, nxt) : cB;
        for (int t = 0; t < nt; t += 2) {
            const bool last = (t == nt - 2);
            const char* a1 = cA + (size_t)(t + 1) * kstep;
            const char* a2 = last ? nA : cA + (size_t)(t + 2) * kstep; const char* b2 = last ? nB : cB + (size_t)(t + 2) * kstep;
            const char* a3 = a2 + kstep; const char* b3 = b2 + kstep;
            if (last && has_next) S.a_ready(nxt);
            if constexpr (SP2) {
            PG8_LDB(B0, 0, 0); PG8_LDB(B1, 0, 1); PG8_SCHED; PG8_LDA(At, 0, 0); PG8_STAGE(PG8_SA(1, 1), a1 + hstep, voffA);
            PG8_WAIT_V(8); PG8_WAIT_L(0); PG8_BAR; PG8_MMA(0, 0, At, B0); PG8_MMA(0, 1, At, B1); PG8_BAR; PG8_SCHED;
            PG8_LDA(At, 0, 1); PG8_STAGE(PG8_SB(0, 0), b2, voffB); PG8_STAGE(PG8_SB(0, 1), b2 + hstep, voffB); PG8_STAGE(PG8_SA(0, 0), a2, voffA);
            PG8_WAIT_V(8); PG8_WAIT_L(0); PG8_BAR; PG8_MMA(1, 0, At, B0); PG8_MMA(1, 1, At, B1); PG8_BAR; PG8_SCHED;
            PG8_LDB(B0, 1, 0); PG8_LDB(B1, 1, 1); PG8_SCHED; PG8_LDA(At, 1, 0); PG8_STAGE(PG8_SA(0, 1), a2 + hstep, voffA);
            PG8_WAIT_V(8); PG8_WAIT_L(0); PG8_BAR; PG8_MMA(0, 0, At, B0); PG8_MMA(0, 1, At, B1); PG8_BAR; PG8_SCHED;
            PG8_LDA(At, 1, 1); PG8_STAGE(PG8_SB(1, 0), b3, voffB); PG8_STAGE(PG8_SB(1, 1), b3 + hstep, voffB); PG8_STAGE(PG8_SA(1, 0), a3, voffA);
            PG8_WAIT_V(8); PG8_WAIT_L(0); PG8_BAR; PG8_MMA(1, 0, At, B0); PG8_MMA(1, 1, At, B1); PG8_BAR; PG8_SCHED;
            } else {
            PG8_LDB(B0, 0, 0); PG8_SCHED; PG8_LDA(At, 0, 0); PG8_STAGE(PG8_SA(1, 1), a1 + hstep, voffA);
            PG8_WAIT_L(8); PG8_BAR; PG8_WAIT_L(0); PG8_MMA(0, 0, At, B0); PG8_BAR; PG8_SCHED;
            PG8_LDB(B1, 0, 1); PG8_STAGE(PG8_SB(0, 0), b2, voffB);
            PG8_BAR; PG8_WAIT_L(0); PG8_MMA(0, 1, At, B1); PG8_BAR;
            PG8_LDA(At, 0, 1); PG8_STAGE(PG8_SA(0, 0), a2, voffA);
            PG8_BAR; PG8_WAIT_L(0); PG8_MMA(1, 0, At, B0); PG8_BAR; PG8_SCHED;
            PG8_STAGE(PG8_SB(0, 1), b2 + hstep, voffB);
            PG8_WAIT_V(6); PG8_BAR; PG8_MMA(1, 1, At, B1); PG8_BAR;
            PG8_LDB(B0, 1, 0); PG8_SCHED; PG8_LDA(At, 1, 0); PG8_STAGE(PG8_SA(0, 1), a2 + hstep, voffA);
            PG8_WAIT_L(8); PG8_BAR; PG8_WAIT_L(0); PG8_MMA(0, 0, At, B0); PG8_BAR; PG8_SCHED;
            PG8_LDB(B1, 1, 1); PG8_STAGE(PG8_SB(1, 0), b3, voffB);
            PG8_BAR; PG8_WAIT_L(0); PG8_MMA(0, 1, At, B1); PG8_BAR;
            PG8_LDA(At, 1, 1); PG8_STAGE(PG8_SA(1, 0), a3, voffA);
            PG8_BAR; PG8_WAIT_L(0); PG8_MMA(1, 0, At, B0); PG8_BAR; PG8_SCHED;
            PG8_STAGE(PG8_SB(1, 1), b3 + hstep, voffB);
            PG8_WAIT_V(6); PG8_BAR; PG8_MMA(1, 1, At, B1); PG8_BAR;
            }
        }
        if constexpr (ALIGN_EPI) { if (wr == 0) PG8_BAR; }
        if constexpr (!Epi::AFTER_DRAIN) { E(acc, cur, wr, wc, fr, fq); S.done(cur); }
        if (!has_next) break;
#pragma unroll
        for (int a = 0; a < 2; ++a)
#pragma unroll
            for (int b = 0; b < 2; ++b)
#pragma unroll
                for (int m = 0; m < 4; ++m)
#pragma unroll
                    for (int n = 0; n < 2; ++n) acc[a][b][m][n] = (f32x4){0.f, 0.f, 0.f, 0.f};
        cur = nxt; cA = nA; cB = nB; ++ui;
        if constexpr (ALIGN_EPI) { if (wr == 1) PG8_BAR; }
    }
    PG8_WAIT_V(0);
    if constexpr (!ALIGN_EPI) { if (wr == 0) PG8_BAR; }
    PG8_BAR;
    if constexpr (Epi::AFTER_DRAIN) { E.fused(acc, cur, wr, wc, fr, fq, lds, wid, lane); S.done(cur); }
#undef PG8_SA
#undef PG8_SB
#undef PG8_STAGE
#undef PG8_LDA
#undef PG8_LDB
#undef PG8_MMA
#undef PG8_WAIT_V
#undef PG8_WAIT_L
#undef PG8_BAR
#undef PG8_SCHED
}
}
#define GAS __attribute__((address_space(1)))
#define LAS __attribute__((address_space(3)))
typedef unsigned short bf16;
typedef unsigned v4u __attribute__((ext_vector_type(4)));
typedef float f32x4 __attribute__((ext_vector_type(4)));
typedef short bf16x8 __attribute__((ext_vector_type(8)));
typedef GAS unsigned gu32;
typedef GAS unsigned long long gu64;
#define RLX_AGENT __ATOMIC_RELAXED, __HIP_MEMORY_SCOPE_AGENT
#define LDS_WAIT() asm volatile("s_waitcnt lgkmcnt(0)" ::: "memory")
#define VM_WAIT() asm volatile("s_waitcnt vmcnt(0)" ::: "memory")
__device__ __forceinline__ unsigned long long rt() { return __builtin_amdgcn_s_memrealtime(); }
__device__ __forceinline__ unsigned f2bf(float f) { unsigned u = __builtin_bit_cast(unsigned, f); return (u + 0x7fffu + ((u >> 16) & 1u)) >> 16; }
__device__ __forceinline__ unsigned pk2(float lo, float hi) { return f2bf(lo) | (f2bf(hi) << 16); }

#define XB_TMO      128
#define XB_XCNT(j)  (256  + 64 * (j))
#define XB_XSUB(j)  (1280 + 64 * (j))
#define XB_XGEN(j)  (2304 + 64 * (j))
#define XB_TOP      3328
#define XB_TOPGEN   3392
#define XCD_BAR_WORDS 3456
#define XB_SPIN_CAP (1u << 18)

__device__ __forceinline__ unsigned xb_ld(unsigned* p)              { return __hip_atomic_load(p, __ATOMIC_RELAXED, __HIP_MEMORY_SCOPE_AGENT); }
__device__ __forceinline__ unsigned xb_add(unsigned* p, unsigned v) { return __hip_atomic_fetch_add(p, v, __ATOMIC_RELAXED, __HIP_MEMORY_SCOPE_AGENT); }
__device__ __forceinline__ unsigned xb_xcc_id() { return (unsigned)__builtin_amdgcn_s_getreg((3 << 11) | 20) & 0xFu; }
#define XB_SPIN(cond, bar) do { unsigned _sp = 0; while (cond) { __builtin_amdgcn_s_sleep(1); \
    if ((++_sp & 255u) == 0u) { if (xb_ld(&(bar)[XB_TMO])) break; if (_sp > XB_SPIN_CAP) { atomicAdd(&(bar)[XB_TMO], 1u); break; } } } } while (0)

struct XcdBarrier {
    unsigned* bar; unsigned x;
    volatile LAS unsigned* st;
};

__device__ __forceinline__ XcdBarrier xcd_barrier_post(unsigned* bar, volatile LAS unsigned* st) {
    XcdBarrier b; b.bar = bar; b.x = xb_xcc_id(); b.st = st;
    if (threadIdx.x == 0) (void)xb_add(&bar[XB_XCNT(b.x)], 1u);
    return b;
}
__device__ __forceinline__ void xcd_barrier_complete(unsigned* bar, unsigned x, unsigned& nloc, unsigned& nx) {
    const unsigned G = gridDim.x * gridDim.y * gridDim.z;
    unsigned sum, cnt, mine, sp = 0u;
    for (;;) {
        sum = 0u; cnt = 0u; mine = 0u;
#pragma unroll
        for (unsigned j = 0; j < 16; ++j) { const unsigned c = xb_ld(&bar[XB_XCNT(j)]); sum += c; cnt += (c > 0u) ? 1u : 0u; mine = (j == x) ? c : mine; }
        if (sum == G) break;
        __builtin_amdgcn_s_sleep(1);
        if ((++sp & 255u) == 0u) { if (xb_ld(&bar[XB_TMO])) break; if (sp > XB_SPIN_CAP) { atomicAdd(&bar[XB_TMO], 1u); break; } }
    }
    nloc = mine > 0u ? mine : 1u; nx = cnt > 0u ? cnt : 1u;
}

__device__ __forceinline__ void xcd_barrier(const XcdBarrier& b) {
    asm volatile("s_waitcnt vmcnt(0)" ::: "memory");
    __syncthreads();
    if (threadIdx.x == 0) {
        unsigned* bar = b.bar;
        __builtin_amdgcn_s_waitcnt(0);
        unsigned nloc = b.st[0], nx = b.st[1];
        if (nloc == 0u) { xcd_barrier_complete(bar, b.x, nloc, nx); b.st[0] = nloc; b.st[1] = nx; }
        const unsigned old = xb_add(&bar[XB_XSUB(b.x)], 1u);
        const unsigned gen = old / nloc;
        if (old + 1u == (gen + 1u) * nloc) {
            __builtin_amdgcn_fence(__ATOMIC_RELEASE, "agent");
            asm volatile("s_waitcnt vmcnt(0)" ::: "memory");
            const unsigned og = xb_add(&bar[XB_TOP], 1u);
            const unsigned tg = og / nx;
            if (og + 1u == (tg + 1u) * nx) xb_add(&bar[XB_TOPGEN], 1u);
            else XB_SPIN(xb_ld(&bar[XB_TOPGEN]) == tg, bar);
            __builtin_amdgcn_fence(__ATOMIC_ACQUIRE, "agent");
            xb_add(&bar[XB_XGEN(b.x)], 1u);
            asm volatile("s_waitcnt vmcnt(0)" ::: "memory");
        } else {
            XB_SPIN(xb_ld(&bar[XB_XGEN(b.x)]) == gen, bar);
            __builtin_amdgcn_fence(__ATOMIC_ACQUIRE, "agent");
            asm volatile("s_waitcnt vmcnt(0)" ::: "memory");
        }
    }
    __syncthreads();
}

constexpr int NWAVES = 8;
#ifndef MK_PER_PHASE
#define MK_PER_PHASE 0
#endif
constexpr int NPHASE = 19;

constexpr int BATCH = 2, SEQ = 8192, DM = 2048, NTOK = BATCH * SEQ, NH = 16, DH = 128;
constexpr int NSA_N = 5168, NSA_NPAD = 5376, P0LD = 5120;
constexpr int NCMP = 511, NSELB = 128;
constexpr int COL_KC = 2048, COL_VC = 2560, COL_KS = 3072, COL_VS = 3584, COL_KW = 4096, COL_VW = 4608;
constexpr int DSA_N = 2888, DSA_NPAD = 3072, KVR = 256, TOPK = 256;
constexpr int DFF = 5632, NEXP = 8, DFFE = 7168, MOE_ROWS = 34816;
constexpr float ALPHA = 1.41421356237309515f, LN_EPS = 1e-5f, RMS_EPS = 1e-6f;

constexpr size_t MiB = (size_t)1 << 20;
constexpr size_t WS_CTL = 0, CTL_ZERO_BYTES = 1 * MiB;
constexpr size_t WS_W_NSA_IN = 2 * MiB, WS_W_NSA_OUT = 23 * MiB, WS_W_FFN_GU = 31 * MiB, WS_W_FFN_DN = 75 * MiB, WS_W_DSA_IN = 97 * MiB, WS_W_DSA_OUT = 109 * MiB;
constexpr size_t WS_W_CMPK = 117 * MiB, WS_W_CMPV = 118 * MiB, WS_W_UK = 119 * MiB, WS_W_UV = 120 * MiB, WS_CBIAS = 121 * MiB;
constexpr size_t WS_KCMP = 122 * MiB, WS_VCMP = 124 * MiB, WS_GL = 126 * MiB, WS_ROUTE = 129 * MiB;
constexpr size_t WS_CRAW = 130 * MiB, WS_KIWI = 146 * MiB, WS_IDX = 154 * MiB, WS_CN = 170 * MiB;
constexpr size_t WS_W_MOE_GU = 192 * MiB, WS_W_MOE_DN = 640 * MiB;
constexpr size_t WS_XB = 864 * MiB, WS_XF = 928 * MiB, WS_Z = 1056 * MiB;
constexpr size_t WS_P0 = 1184 * MiB, WS_OATT0 = 1344 * MiB, WS_HFF = 1408 * MiB;
constexpr size_t WS_Q = 1184 * MiB, WS_QI = 1248 * MiB, WS_QLAT = 1264 * MiB, WS_OLAT = 1392 * MiB, WS_OATT1 = 1520 * MiB;
constexpr size_t WS_XG = 1056 * MiB, WS_HM = 1192 * MiB, WS_Y = 192 * MiB;
constexpr size_t WS_END = 1668 * MiB;
static_assert(WS_HM + (size_t)MOE_ROWS * DFFE * 2 <= WS_END, "hm fits");
static_assert(WS_XG + (size_t)MOE_ROWS * DM * 2 <= WS_HM, "xg fits");
static_assert(WS_Y + (size_t)MOE_ROWS * DM * 4 <= WS_W_MOE_DN, "y overlays the dead gate/up weights only");
static_assert(WS_HFF + (size_t)NTOK * DFF * 2 <= WS_END, "hff fits");
constexpr int CW_TMO = 0, CW_CODE = 1;
constexpr int CW_BAR = 4096;
constexpr int CW_MOECNT = 16384;

constexpr int RING_OFF = 0, RING_BYTES = 131072;
constexpr int LDSCTL_OFF = RING_BYTES, MISC_OFF = LDSCTL_OFF + 320;
constexpr int LDS_BYTES = 147456;

struct Frame {
    LAS unsigned char* lds;
    volatile LAS unsigned* MISC;
    gu32* ctl;
    int tid, lane, wave, vcu, G;
};

__device__ __forceinline__ void relaunder(Frame& F) { int t = F.tid; asm volatile("" : "+v"(t)); F.tid = t; F.lane = t & 63; }
__device__ __forceinline__ float bf2f(unsigned short h) { return __uint_as_float(((unsigned)h) << 16); }
__device__ __forceinline__ float bflo(unsigned w) { return __uint_as_float(w << 16); }
__device__ __forceinline__ float bfhi(unsigned w) { return __uint_as_float(w & 0xffff0000u); }
__device__ __forceinline__ float wave_sum(float v) {
#pragma unroll
    for (int o = 1; o < 64; o <<= 1) v += __shfl_xor(v, o);
    return v;
}
__device__ __forceinline__ float wave_max(float v) {
#pragma unroll
    for (int o = 1; o < 64; o <<= 1) v = fmaxf(v, __shfl_xor(v, o));
    return v;
}
#define WSYNC() do { __builtin_amdgcn_wave_barrier(); asm volatile("s_waitcnt lgkmcnt(0)" ::: "memory"); __builtin_amdgcn_wave_barrier(); } while (0)

__device__ __forceinline__ int rel_bucket(int n) {
    if (n < 16) return n;
    if (n >= 113) return 31;
    int b = 16;
    b += (n >= 19); b += (n >= 21); b += (n >= 24); b += (n >= 27); b += (n >= 31); b += (n >= 35); b += (n >= 40); b += (n >= 46);
    b += (n >= 52); b += (n >= 59); b += (n >= 67); b += (n >= 77); b += (n >= 87); b += (n >= 99);
    return b;
}

__device__ __forceinline__ void tr_item(const float* W, int N, int ldw, bf16* WT, int Kdst, int k0, int n0, int drow, LAS float* scr, int lane) {
#pragma unroll 8
    for (int i = 0; i < 32; ++i) { const int kk = 2 * i + (lane >> 5); const int n = n0 + (lane & 31); scr[kk * 33 + (lane & 31)] = (n < N) ? W[(size_t)(k0 + kk) * ldw + n] : 0.f; }
    LDS_WAIT(); asm volatile("" ::: "memory");
    const int c = lane & 7;
#pragma unroll
    for (int j = 0; j < 4; ++j) { const int n = (lane >> 3) + 8 * j; const LAS float* s = scr + (8 * c) * 33 + n;
        v4u o; o.x = pk2(s[0 * 33], s[1 * 33]); o.y = pk2(s[2 * 33], s[3 * 33]); o.z = pk2(s[4 * 33], s[5 * 33]); o.w = pk2(s[6 * 33], s[7 * 33]);
        *(v4u*)(WT + (size_t)(drow + n) * Kdst + k0 + 8 * c) = o; }
    LDS_WAIT(); asm volatile("" ::: "memory");
}
__device__ __forceinline__ void tr_mat(const float* W, int K, int N, int Npad, bf16* WT, int mode, int item, LAS float* scr, int lane) {
    const int nblk = Npad / 32, kb = item / nblk, nb = item - kb * nblk, n0 = 32 * nb;
    const int drow = (mode == 0) ? n0 : ((n0 >> 7) * 256 + (mode - 1) * 128 + (n0 & 127));
    tr_item(W, N, N, WT, K, 64 * kb, n0, drow, scr, lane);
}

struct Args { const float* in[27]; float* out; unsigned char* ws; int ph_lo, ph_hi; };

__device__ __forceinline__ void p0_prologue(Frame& F, const Args& A) {
    LAS float* scr = (LAS float*)(F.lds + RING_OFF + F.wave * 16384);
    unsigned char* ws = A.ws;
    const int gw = F.vcu * NWAVES + F.wave, NGW = F.G * NWAVES, lane = F.lane;
    constexpr int I_NSA_IN = (DM / 64) * (NSA_NPAD / 32), I_SQ = (DM / 64) * (DM / 32), I_FFN = (DM / 64) * (DFF / 32), I_FFD = (DFF / 64) * (DM / 32), I_DSA_IN = (DM / 64) * (DSA_NPAD / 32);
    constexpr int I_CMP = (4096 / 64) * (128 / 32), I_UK1 = (128 / 64) * (256 / 32), I_UV1 = (256 / 64) * (128 / 32);
    constexpr int I_MG1 = (DM / 64) * (DFFE / 32), I_MD1 = (DFFE / 64) * (DM / 32);
    constexpr int NITEMS = I_NSA_IN + 2 * I_SQ + 2 * I_FFN + I_FFD + I_DSA_IN + 2 * I_CMP + 16 * I_UK1 + 16 * I_UV1 + 16 * I_MG1 + 8 * I_MD1;
    for (int it = gw; it < NITEMS; it += NGW) {
        int r = it;
        if (r < I_NSA_IN) { tr_mat(A.in[2], DM, NSA_N, NSA_NPAD, (bf16*)(ws + WS_W_NSA_IN), 0, r, scr, lane); continue; } r -= I_NSA_IN;
        if (r < I_SQ) { tr_mat(A.in[9], DM, DM, DM, (bf16*)(ws + WS_W_NSA_OUT), 0, r, scr, lane); continue; } r -= I_SQ;
        if (r < I_SQ) { tr_mat(A.in[14], DM, DM, DM, (bf16*)(ws + WS_W_DSA_OUT), 0, r, scr, lane); continue; } r -= I_SQ;
        if (r < I_FFN) { tr_mat(A.in[15], DM, DFF, DFF, (bf16*)(ws + WS_W_FFN_GU), 1, r, scr, lane); continue; } r -= I_FFN;
        if (r < I_FFN) { tr_mat(A.in[16], DM, DFF, DFF, (bf16*)(ws + WS_W_FFN_GU), 2, r, scr, lane); continue; } r -= I_FFN;
        if (r < I_FFD) { tr_mat(A.in[17], DFF, DM, DM, (bf16*)(ws + WS_W_FFN_DN), 0, r, scr, lane); continue; } r -= I_FFD;
        if (r < I_DSA_IN) { tr_mat(A.in[10], DM, DSA_N, DSA_NPAD, (bf16*)(ws + WS_W_DSA_IN), 0, r, scr, lane); continue; } r -= I_DSA_IN;
        if (r < I_CMP) { tr_mat(A.in[4], 4096, 128, 128, (bf16*)(ws + WS_W_CMPK), 0, r, scr, lane); continue; } r -= I_CMP;
        if (r < I_CMP) { tr_mat(A.in[7], 4096, 128, 128, (bf16*)(ws + WS_W_CMPV), 0, r, scr, lane); continue; } r -= I_CMP;
        if (r < 16 * I_UK1) { const int h = r / I_UK1; tr_mat(A.in[12] + (size_t)h * 128 * 256, 128, 256, 256, (bf16*)(ws + WS_W_UK) + (size_t)h * 256 * 128, 0, r - h * I_UK1, scr, lane); continue; } r -= 16 * I_UK1;
        if (r < 16 * I_UV1) { const int h = r / I_UV1; tr_mat(A.in[13] + (size_t)h * 256 * 128, 256, 128, 128, (bf16*)(ws + WS_W_UV) + (size_t)h * 128 * 256, 0, r - h * I_UV1, scr, lane); continue; } r -= 16 * I_UV1;
        if (r < 8 * I_MG1) { const int e = r / I_MG1; tr_mat(A.in[20] + (size_t)e * DM * DFFE, DM, DFFE, DFFE, (bf16*)(ws + WS_W_MOE_GU) + (size_t)e * 2 * DFFE * DM, 1, r - e * I_MG1, scr, lane); continue; } r -= 8 * I_MG1;
        if (r < 8 * I_MG1) { const int e = r / I_MG1; tr_mat(A.in[21] + (size_t)e * DM * DFFE, DM, DFFE, DFFE, (bf16*)(ws + WS_W_MOE_GU) + (size_t)e * 2 * DFFE * DM, 2, r - e * I_MG1, scr, lane); continue; } r -= 8 * I_MG1;
        { const int e = r / I_MD1; tr_mat(A.in[22] + (size_t)e * DFFE * DM, DFFE, DM, DM, (bf16*)(ws + WS_W_MOE_DN) + (size_t)e * DM * DFFE, 0, r - e * I_MD1, scr, lane); }
    }
    { const float* x = A.in[0]; bf16* xb = (bf16*)(ws + WS_XB); const size_t n8 = (size_t)NTOK * DM / 8;
      for (size_t i = (size_t)F.vcu * 512 + F.tid; i < n8; i += (size_t)F.G * 512) { const f32x4 a = *(const f32x4*)(x + i * 8), b = *(const f32x4*)(x + i * 8 + 4);
          v4u o; o.x = pk2(a[0], a[1]); o.y = pk2(a[2], a[3]); o.z = pk2(b[0], b[1]); o.w = pk2(b[2], b[3]); *(v4u*)(xb + i * 8) = o; } }
    for (int it = gw; it < 64; it += NGW) { const int kv = it >> 5, ch = it & 31; const float* pe = A.in[kv ? 6 : 3]; const float* w1 = A.in[kv ? 7 : 4];
        float s0 = 0.f, s1 = 0.f;
        for (int k = ch * 128; k < ch * 128 + 128; ++k) { const float p = pe[k]; s0 += p * w1[(size_t)k * 128 + lane]; s1 += p * w1[(size_t)k * 128 + 64 + lane]; }
        float* cb = (float*)(ws + WS_CBIAS) + (size_t)(kv * 32 + ch) * 128; cb[lane] = s0; cb[64 + lane] = s1; }
}

typedef short s8v __attribute__((ext_vector_type(8)));
__device__ __forceinline__ s8v ld_frag(const bf16* p) { return *(const s8v*)p; }

__device__ __forceinline__ float gelu_tanh(float x) { const float u = 0.7978845608028654f * (x + 0.044715f * x * x * x); return 0.5f * x * (1.0f + tanhf(u)); }
__device__ __forceinline__ void p2_compress(Frame& F, const Args& A) {
    unsigned char* ws = A.ws; const int lane = F.lane;
    const bf16* P0 = (const bf16*)(ws + WS_P0);
    LAS float* hid = (LAS float*)(F.lds + RING_OFF + F.wave * 16384);
    const int gw = F.vcu * NWAVES + F.wave, NGW = F.G * NWAVES;
    const int r16 = lane & 15, kq = lane >> 4;
    for (int it = gw; it < 256; it += NGW) {
        const int kv = it >> 7, tile = it & 127;
        const bf16* W1T = (const bf16*)(ws + (kv ? WS_W_CMPV : WS_W_CMPK));
        const float* w2 = A.in[kv ? 8 : 5];
        const float* cbp = (const float*)(ws + WS_CBIAS) + (size_t)kv * 32 * 128;
        float* outp = (float*)(ws + (kv ? WS_VCMP : WS_KCMP));
        const int colbase = kv ? COL_VC : COL_KC;
        f32x4 acc[2][8];
#pragma unroll
        for (int m = 0; m < 2; ++m)
#pragma unroll
            for (int n = 0; n < 8; ++n) acc[m][n] = (f32x4){0.f, 0.f, 0.f, 0.f};
        const bf16* arow[2];
#pragma unroll
        for (int m = 0; m < 2; ++m) { int R = tile * 32 + m * 16 + r16; if (R > 4087) R = 4087; const int g = R & 3, bn = R >> 2, b = bn / NCMP, n = bn - b * NCMP;
            arow[m] = P0 + (size_t)(b * SEQ + 16 * n) * P0LD + colbase + g * 128 + kq * 8; }
        for (int ks = 0; ks < 128; ++ks) {
            const int l = ks >> 2, d0 = (ks & 3) * 32;
            s8v af[2], bfr[8];
#pragma unroll
            for (int m = 0; m < 2; ++m) af[m] = ld_frag(arow[m] + (size_t)l * P0LD + d0);
#pragma unroll
            for (int n = 0; n < 8; ++n) bfr[n] = ld_frag(W1T + (size_t)(n * 16 + r16) * 4096 + ks * 32 + kq * 8);
#pragma unroll
            for (int m = 0; m < 2; ++m)
#pragma unroll
                for (int n = 0; n < 8; ++n) acc[m][n] = __builtin_amdgcn_mfma_f32_16x16x32_bf16(af[m], bfr[n], acc[m][n], 0, 0, 0);
        }
#pragma unroll
        for (int n = 0; n < 8; ++n) { const int e = n * 16 + r16; float cb = 0.f; for (int ch = 0; ch < 32; ++ch) cb += cbp[ch * 128 + e];
#pragma unroll
            for (int m = 0; m < 2; ++m)
#pragma unroll
                for (int j = 0; j < 4; ++j) hid[(m * 16 + kq * 4 + j) * 128 + e] = gelu_tanh(acc[m][n][j] + cb); }
        WSYNC();
        for (int rr = 0; rr < 32; ++rr) { const int R = tile * 32 + rr; if (R > 4087) break;
            float s0 = 0.f, s1 = 0.f;
#pragma unroll 8
            for (int e = 0; e < 128; ++e) { const float hv = hid[rr * 128 + e]; s0 += hv * w2[e * 128 + lane]; s1 += hv * w2[e * 128 + 64 + lane]; }
            outp[(size_t)R * 128 + lane] = s0; outp[(size_t)R * 128 + 64 + lane] = s1; }
        WSYNC();
    }
}

__device__ __forceinline__ void dot2_bf(const bf16* kr, const LAS float* q, float& s0, float& s1) {
    s0 = 0.f; s1 = 0.f;
#pragma unroll 2
    for (int c = 0; c < 16; ++c) { const v4u kv = *(const v4u*)(kr + c * 8);
        const float k0 = bflo(kv.x), k1 = bfhi(kv.x), k2 = bflo(kv.y), k3 = bfhi(kv.y), k4 = bflo(kv.z), k5 = bfhi(kv.z), k6 = bflo(kv.w), k7 = bfhi(kv.w);
        { const f32x4 a = *(const LAS f32x4*)(q + c * 8), b = *(const LAS f32x4*)(q + c * 8 + 4); s0 += k0 * a[0] + k1 * a[1] + k2 * a[2] + k3 * a[3] + k4 * b[0] + k5 * b[1] + k6 * b[2] + k7 * b[3]; }
        { const f32x4 a = *(const LAS f32x4*)(q + 128 + c * 8), b = *(const LAS f32x4*)(q + 128 + c * 8 + 4); s1 += k0 * a[0] + k1 * a[1] + k2 * a[2] + k3 * a[3] + k4 * b[0] + k5 * b[1] + k6 * b[2] + k7 * b[3]; } }
}
__device__ __forceinline__ void dot2_f32(const float* kr, const LAS float* q, float& s0, float& s1) {
    s0 = 0.f; s1 = 0.f;
#pragma unroll 2
    for (int c = 0; c < 32; ++c) { const f32x4 kv = *(const f32x4*)(kr + c * 4);
        { const f32x4 a = *(const LAS f32x4*)(q + c * 4); s0 += kv[0] * a[0] + kv[1] * a[1] + kv[2] * a[2] + kv[3] * a[3]; }
        { const f32x4 a = *(const LAS f32x4*)(q + 128 + c * 4); s1 += kv[0] * a[0] + kv[1] * a[1] + kv[2] * a[2] + kv[3] * a[3]; } }
}
__device__ __forceinline__ void softmax_slots(LAS float* s, int nslots, int lane) {
    float mx = -1e30f;
    for (int i = 0; i < nslots; ++i) mx = fmaxf(mx, s[i * 64 + lane]);
    mx = wave_max(mx); float sum = 0.f;
    for (int i = 0; i < nslots; ++i) { const float e = __expf(s[i * 64 + lane] - mx); s[i * 64 + lane] = e; sum += e; }
    sum = wave_sum(sum); const float inv = 1.0f / sum;
    for (int i = 0; i < nslots; ++i) s[i * 64 + lane] *= inv;
}
__device__ __forceinline__ void p3_nsa_attn(Frame& F, const Args& A) {
    unsigned char* ws = A.ws; const int lane = F.lane;
    const bf16* P0 = (const bf16*)(ws + WS_P0);
    const float* KC = (const float*)(ws + WS_KCMP); const float* VC = (const float*)(ws + WS_VCMP); const float* GL = (const float*)(ws + WS_GL);
    bf16* O = (bf16*)(ws + WS_OATT0);
    LAS float* lut = (LAS float*)(F.lds + RING_OFF + 8 * 12288);
    for (int i = F.tid; i < 129 * 16; i += 512) { const int n = i >> 4, h = i & 15; lut[i] = A.in[1][rel_bucket(n) * 16 + h]; }
    __syncthreads();
    LAS float* wl = (LAS float*)(F.lds + RING_OFF + F.wave * 12288);
    LAS float* qs = wl; LAS float* sb = wl + 512; LAS float* ps = wl + 2560; LAS int* selb = (LAS int*)(wl + 3072 - 16);
    const int gw = F.vcu * NWAVES + F.wave, NGW = F.G * NWAVES;
    for (int it = gw; it < NTOK * 4; it += NGW) {
        const int g = it & 3, tok = it >> 2, b = tok >> 13, t = tok & (SEQ - 1), qb = t >> 6;
        const bf16* prow = P0 + (size_t)tok * P0LD;
        for (int i = lane; i < 512; i += 64) { qs[i] = bf2f(prow[g * 512 + i]); ps[i] = 0.f; }
        WSYNC();
        const size_t kvbase = (size_t)b * SEQ * P0LD + g * 128;
        const int nvalid = (t >= 31) ? min((t - 31) / 16 + 1, NCMP) : 0;
        const int ncs = (nvalid + 63) >> 6;
        float oacc[4][2];
#pragma unroll
        for (int j = 0; j < 4; ++j) { oacc[j][0] = 0.f; oacc[j][1] = 0.f; }
        if (nvalid > 0) {
#pragma unroll
            for (int hp = 0; hp < 2; ++hp) {
                const LAS float* q2 = qs + hp * 256;
                for (int i = 0; i < ncs; ++i) { const int n = lane + 64 * i; float s0 = -1e30f, s1 = -1e30f;
                    if (n < nvalid) { dot2_f32(KC + ((size_t)(b * NCMP + n) * 4 + g) * 128, q2, s0, s1); const int dist = min(t - 16 * n - 31, 128); s0 += lut[dist * 16 + g * 4 + hp * 2]; s1 += lut[dist * 16 + g * 4 + hp * 2 + 1]; }
                    sb[i * 64 + lane] = s0; sb[1024 + i * 64 + lane] = s1; }
#pragma unroll
                for (int jj = 0; jj < 2; ++jj) { LAS float* sj = sb + jj * 1024; const int j = hp * 2 + jj;
                    softmax_slots(sj, ncs, lane);
                    for (int i = 0; i < ncs; ++i) ps[i * 64 + lane] += sj[i * 64 + lane];
                    WSYNC();
                    float o0 = 0.f, o1 = 0.f;
#pragma unroll 4
                    for (int n = 0; n < nvalid; ++n) { const float p = sj[n]; const float2 v = *(const float2*)(VC + ((size_t)(b * NCMP + n) * 4 + g) * 128 + 2 * lane); o0 += p * v.x; o1 += p * v.y; }
                    const float x = GL[(size_t)tok * 48 + (g * 4 + j) * 3 + 0]; const float gt = 1.0f / (1.0f + __expf(-x));
                    oacc[j][0] += gt * o0; oacc[j][1] += gt * o1; }
                WSYNC();
            }
        }
        WSYNC();
        float v01[2];
#pragma unroll
        for (int s = 0; s < 2; ++s) { const int m = lane + 64 * s;
            const float scv = ps[4 * m] + ps[4 * m + 1] + ps[4 * m + 2] + 0.5f * (ps[4 * m + 3] + (m > 0 ? ps[4 * m - 1] : 0.f));
            const bool forced = (m == 0) || (m == qb) || (m == qb - 1);
            v01[s] = forced ? 1e4f : (m <= qb ? scv : -1.0f); }
        WSYNC();
        for (int i = 0; i < 16; ++i) {
            float bv = v01[0]; int bi = lane; if (v01[1] > v01[0]) { bv = v01[1]; bi = lane + 64; }
#pragma unroll
            for (int o = 1; o < 64; o <<= 1) { const float ov = __shfl_xor(bv, o); const int oi = __shfl_xor(bi, o); if (ov > bv || (ov == bv && oi < bi)) { bv = ov; bi = oi; } }
            if (lane == 0) selb[i] = bi;
            if (bi == lane) v01[0] = -3e38f;
            if (bi == lane + 64) v01[1] = -3e38f;
        }
        WSYNC();
#pragma unroll
        for (int hp = 0; hp < 2; ++hp) {
            const LAS float* q2 = qs + hp * 256;
            for (int i = 0; i < 16; ++i) { const int m = __builtin_amdgcn_readfirstlane(selb[i]); const int key = m * 64 + lane; float s0 = -1e30f, s1 = -1e30f;
                if (m <= qb && key <= t) { dot2_bf(P0 + kvbase + (size_t)key * P0LD + COL_KS, q2, s0, s1); const int dist = min(t - key, 128); s0 += lut[dist * 16 + g * 4 + hp * 2]; s1 += lut[dist * 16 + g * 4 + hp * 2 + 1]; }
                sb[i * 64 + lane] = s0; sb[1024 + i * 64 + lane] = s1; }
#pragma unroll
            for (int jj = 0; jj < 2; ++jj) { LAS float* sj = sb + jj * 1024; const int j = hp * 2 + jj;
                softmax_slots(sj, 16, lane);
                WSYNC();
                float o0 = 0.f, o1 = 0.f;
                for (int i = 0; i < 16; ++i) { const int m = __builtin_amdgcn_readfirstlane(selb[i]);
                    if (m <= qb) { const int k0 = m * 64; const int kmax = min(63, t - k0);
#pragma unroll 4
                        for (int k = 0; k <= kmax; ++k) { const float p = sj[i * 64 + k]; const unsigned v = *(const unsigned*)(P0 + kvbase + (size_t)(k0 + k) * P0LD + COL_VS + 2 * lane); o0 += p * bflo(v); o1 += p * bfhi(v); } } }
                const float x = GL[(size_t)tok * 48 + (g * 4 + j) * 3 + 1]; const float gt = 1.0f / (1.0f + __expf(-x));
                oacc[j][0] += gt * o0; oacc[j][1] += gt * o1; }
            WSYNC();
        }
#pragma unroll
        for (int hp = 0; hp < 2; ++hp) {
            const LAS float* q2 = qs + hp * 256;
            for (int i = 0; i < 8; ++i) { const int key = t - 511 + lane + 64 * i; float s0 = -1e30f, s1 = -1e30f;
                if (key >= 0) { dot2_bf(P0 + kvbase + (size_t)key * P0LD + COL_KW, q2, s0, s1); const int dist = min(t - key, 128); s0 += lut[dist * 16 + g * 4 + hp * 2]; s1 += lut[dist * 16 + g * 4 + hp * 2 + 1]; }
                sb[i * 64 + lane] = s0; sb[1024 + i * 64 + lane] = s1; }
#pragma unroll
            for (int jj = 0; jj < 2; ++jj) { LAS float* sj = sb + jj * 1024; const int j = hp * 2 + jj;
                softmax_slots(sj, 8, lane);
                WSYNC();
                float o0 = 0.f, o1 = 0.f; const int kfirst = max(0, t - 511);
#pragma unroll 4
                for (int key = kfirst; key <= t; ++key) { const float p = sj[key - (t - 511)]; const unsigned v = *(const unsigned*)(P0 + kvbase + (size_t)key * P0LD + COL_VW + 2 * lane); o0 += p * bflo(v); o1 += p * bfhi(v); }
                const float x = GL[(size_t)tok * 48 + (g * 4 + j) * 3 + 2]; const float gt = 1.0f / (1.0f + __expf(-x));
                oacc[j][0] += gt * o0; oacc[j][1] += gt * o1; }
            WSYNC();
        }
#pragma unroll
        for (int j = 0; j < 4; ++j) *(unsigned*)(O + (size_t)tok * DM + (g * 4 + j) * 128 + 2 * lane) = pk2(oacc[j][0], oacc[j][1]);
        WSYNC();
    }
    __syncthreads();
}

template <bool ROUTE>
__device__ __forceinline__ void ln_phase(Frame& F, const Args& A, const float* Z, const float* gam, const float* bet, float* XF, bf16* XB) {
    const int gw = F.vcu * NWAVES + F.wave, NGW = F.G * NWAVES, lane = F.lane;
    LAS float* wrl = (LAS float*)(F.lds + RING_OFF);
    if (ROUTE) { for (int i = F.tid; i < DM * 8 / 4; i += 512) *(LAS f32x4*)(wrl + i * 4) = *(const f32x4*)(A.in[18] + i * 4); __syncthreads(); }
    for (int row = gw; row < NTOK; row += NGW) {
        const f32x4* zr = (const f32x4*)(Z + (size_t)row * DM) + lane;
        f32x4 v[8]; float s = 0.f;
#pragma unroll
        for (int j = 0; j < 8; ++j) { v[j] = zr[64 * j]; s += (v[j][0] + v[j][1]) + (v[j][2] + v[j][3]); }
        const float mean = wave_sum(s) * (1.f / DM); float s2 = 0.f;
#pragma unroll
        for (int j = 0; j < 8; ++j) { v[j] = v[j] - mean; s2 += (v[j][0] * v[j][0] + v[j][1] * v[j][1]) + (v[j][2] * v[j][2] + v[j][3] * v[j][3]); }
        const float rstd = 1.f / sqrtf(wave_sum(s2) * (1.f / DM) + LN_EPS);
        float lg[8];
#pragma unroll
        for (int e = 0; e < 8; ++e) lg[e] = 0.f;
#pragma unroll
        for (int j = 0; j < 8; ++j) { const int c = 4 * lane + 256 * j; const f32x4 gg = *(const f32x4*)(gam + c), bb = *(const f32x4*)(bet + c);
            const f32x4 x = v[j] * rstd * gg + bb;
            *(f32x4*)(XF + (size_t)row * DM + c) = x;
            uint2 o; o.x = pk2(x[0], x[1]); o.y = pk2(x[2], x[3]); *(uint2*)(XB + (size_t)row * DM + c) = o;
            asm volatile("" ::: "memory");
            if (ROUTE) { const LAS float* wr = wrl + c * 8;
#pragma unroll
                for (int q = 0; q < 4; ++q) { const f32x4 w0 = *(const LAS f32x4*)(wr + q * 8), w1 = *(const LAS f32x4*)(wr + q * 8 + 4);
                    lg[0] += x[q] * w0[0]; lg[1] += x[q] * w0[1]; lg[2] += x[q] * w0[2]; lg[3] += x[q] * w0[3]; lg[4] += x[q] * w1[0]; lg[5] += x[q] * w1[1]; lg[6] += x[q] * w1[2]; lg[7] += x[q] * w1[3]; }  asm volatile("" ::: "memory"); }
        }
        if (ROUTE) {
#pragma unroll
            for (int e = 0; e < 8; ++e) lg[e] = wave_sum(lg[e]) + A.in[19][e];
            int e0 = 0; float l0 = lg[0];
#pragma unroll
            for (int e = 1; e < 8; ++e) if (lg[e] > l0) { l0 = lg[e]; e0 = e; }
            int e1 = -1; float l1 = -3e38f;
#pragma unroll
            for (int e = 0; e < 8; ++e) if (e != e0 && lg[e] > l1) { l1 = lg[e]; e1 = e; }
            const float w0 = 1.0f / (1.0f + __expf(l1 - l0)), w1 = 1.0f - w0;
            if (lane == 0) {
                const unsigned p0 = __hip_atomic_fetch_add((unsigned*)(F.ctl + CW_MOECNT + 64 * e0), 1u, __ATOMIC_RELAXED, __HIP_MEMORY_SCOPE_AGENT);
                const unsigned p1 = __hip_atomic_fetch_add((unsigned*)(F.ctl + CW_MOECNT + 64 * e1), 1u, __ATOMIC_RELAXED, __HIP_MEMORY_SCOPE_AGENT);
                int* re = (int*)(A.ws + WS_ROUTE); int* rp = re + 2 * NTOK; float* rw = (float*)(rp + 2 * NTOK);
                re[2 * row] = e0; re[2 * row + 1] = e1; rp[2 * row] = (int)p0; rp[2 * row + 1] = (int)p1; rw[2 * row] = w0; rw[2 * row + 1] = w1;
            }
        }
    }
}

__device__ __forceinline__ void ln_route_phase(Frame& F, const Args& A, const float* Z, const float* gam, const float* bet, float* XF, bf16* XB) {
    const int gw = F.vcu * NWAVES + F.wave, NGW = F.G * NWAVES, lane = F.lane;
    LAS float* wrl = (LAS float*)(F.lds + RING_OFF);
    LAS float* rowb = (LAS float*)(F.lds + RING_OFF + 65536 + F.wave * 8192);
    for (int i = F.tid; i < DM * 8 / 4; i += 512) *(LAS f32x4*)(wrl + i * 4) = *(const f32x4*)(A.in[18] + i * 4);
    __syncthreads();
    for (int row = gw; row < NTOK; row += NGW) {
        float s = 0.f, s2 = 0.f;
#pragma unroll 1
        for (int j = 0; j < 8; ++j) { const f32x4 v = *(const f32x4*)(Z + (size_t)row * DM + 4 * lane + 256 * j); *(LAS f32x4*)(rowb + 4 * lane + 256 * j) = v;
            s += (v[0] + v[1]) + (v[2] + v[3]); }
        const float mean = wave_sum(s) * (1.f / DM);
#pragma unroll 1
        for (int j = 0; j < 8; ++j) { const f32x4 v = *(const LAS f32x4*)(rowb + 4 * lane + 256 * j) - mean; s2 += (v[0] * v[0] + v[1] * v[1]) + (v[2] * v[2] + v[3] * v[3]); }
        const float rstd = 1.f / sqrtf(wave_sum(s2) * (1.f / DM) + LN_EPS);
        float lg[8];
#pragma unroll
        for (int e = 0; e < 8; ++e) lg[e] = 0.f;
#pragma unroll 1
        for (int j = 0; j < 8; ++j) { const int c = 4 * lane + 256 * j; const f32x4 gg = *(const f32x4*)(gam + c), bb = *(const f32x4*)(bet + c);
            const f32x4 x = (*(const LAS f32x4*)(rowb + c) - mean) * rstd * gg + bb;
            *(f32x4*)(XF + (size_t)row * DM + c) = x;
            uint2 o; o.x = pk2(x[0], x[1]); o.y = pk2(x[2], x[3]); *(uint2*)(XB + (size_t)row * DM + c) = o;
            const LAS float* wr = wrl + c * 8;
#pragma unroll
            for (int q = 0; q < 4; ++q) { const f32x4 w0 = *(const LAS f32x4*)(wr + q * 8), w1 = *(const LAS f32x4*)(wr + q * 8 + 4);
                lg[0] += x[q] * w0[0]; lg[1] += x[q] * w0[1]; lg[2] += x[q] * w0[2]; lg[3] += x[q] * w0[3]; lg[4] += x[q] * w1[0]; lg[5] += x[q] * w1[1]; lg[6] += x[q] * w1[2]; lg[7] += x[q] * w1[3]; } }
#pragma unroll
        for (int e = 0; e < 8; ++e) lg[e] = wave_sum(lg[e]) + A.in[19][e];
        int e0 = 0; float l0 = lg[0];
#pragma unroll
        for (int e = 1; e < 8; ++e) if (lg[e] > l0) { l0 = lg[e]; e0 = e; }
        int e1 = -1; float l1 = -3e38f;
#pragma unroll
        for (int e = 0; e < 8; ++e) if (e != e0 && lg[e] > l1) { l1 = lg[e]; e1 = e; }
        const float w0 = 1.0f / (1.0f + __expf(l1 - l0)), w1 = 1.0f - w0;
        if (lane == 0) {
            const unsigned p0 = __hip_atomic_fetch_add((unsigned*)(F.ctl + CW_MOECNT + 64 * e0), 1u, __ATOMIC_RELAXED, __HIP_MEMORY_SCOPE_AGENT);
            const unsigned p1 = __hip_atomic_fetch_add((unsigned*)(F.ctl + CW_MOECNT + 64 * e1), 1u, __ATOMIC_RELAXED, __HIP_MEMORY_SCOPE_AGENT);
            int* re = (int*)(A.ws + WS_ROUTE); int* rp = re + 2 * NTOK; float* rw = (float*)(rp + 2 * NTOK);
            re[2 * row] = e0; re[2 * row + 1] = e1; rp[2 * row] = (int)p0; rp[2 * row + 1] = (int)p1; rw[2 * row] = w0; rw[2 * row + 1] = w1;
        }
        WSYNC();
    }
    __syncthreads();
}

__device__ __forceinline__ void p10_dsa_prep(Frame& F, const Args& A) {
    unsigned char* ws = A.ws; const int lane = F.lane;
    const int gw = F.vcu * NWAVES + F.wave, NGW = F.G * NWAVES;
    { const float* CR = (const float*)(ws + WS_CRAW); bf16* CN = (bf16*)(ws + WS_CN); const f32x4 gg = *(const f32x4*)(A.in[11] + 4 * lane);
      for (int row = gw; row < NTOK; row += NGW) { const f32x4 v = *(const f32x4*)(CR + (size_t)row * KVR + 4 * lane);
          const float ss = wave_sum(v[0] * v[0] + v[1] * v[1] + v[2] * v[2] + v[3] * v[3]); const float r = 1.f / sqrtf(ss * (1.f / KVR) + RMS_EPS);
          uint2 o; o.x = pk2(v[0] * r * gg[0], v[1] * r * gg[1]); o.y = pk2(v[2] * r * gg[2], v[3] * r * gg[3]); *(uint2*)(CN + (size_t)row * KVR + 4 * lane) = o; } }
    const bf16* Q = (const bf16*)(ws + WS_Q); const bf16* UKT = (const bf16*)(ws + WS_W_UK); bf16* QL = (bf16*)(ws + WS_QLAT);
    const int r16 = lane & 15, kq = lane >> 4; const float sc = 0.08838834764831845f;
    for (int it = gw; it < 512 * 16 * 4; it += NGW) {
        const int nc = it & 3, h = (it >> 2) & 15, mt = it >> 6;
        f32x4 acc[2][4];
#pragma unroll
        for (int m = 0; m < 2; ++m)
#pragma unroll
            for (int n = 0; n < 4; ++n) acc[m][n] = (f32x4){0.f, 0.f, 0.f, 0.f};
#pragma unroll
        for (int ks = 0; ks < 4; ++ks) { s8v af[2], bfr[4];
#pragma unroll
            for (int m = 0; m < 2; ++m) af[m] = ld_frag(Q + (size_t)(mt * 32 + m * 16 + r16) * DM + h * 128 + ks * 32 + kq * 8);
#pragma unroll
            for (int n = 0; n < 4; ++n) bfr[n] = ld_frag(UKT + ((size_t)h * 256 + nc * 64 + n * 16 + r16) * 128 + ks * 32 + kq * 8);
#pragma unroll
            for (int m = 0; m < 2; ++m)
#pragma unroll
                for (int n = 0; n < 4; ++n) acc[m][n] = __builtin_amdgcn_mfma_f32_16x16x32_bf16(af[m], bfr[n], acc[m][n], 0, 0, 0); }
#pragma unroll
        for (int m = 0; m < 2; ++m)
#pragma unroll
            for (int n = 0; n < 4; ++n)
#pragma unroll
                for (int j = 0; j < 4; ++j) QL[(size_t)(mt * 32 + m * 16 + kq * 4 + j) * 4096 + h * 256 + nc * 64 + n * 16 + r16] = (bf16)f2bf(acc[m][n][j] * sc);
    }
}
__device__ __forceinline__ void p12_dsa_uv(Frame& F, const Args& A) {
    unsigned char* ws = A.ws; const int lane = F.lane;
    const int gw = F.vcu * NWAVES + F.wave, NGW = F.G * NWAVES;
    const bf16* OL = (const bf16*)(ws + WS_OLAT); const bf16* UVT = (const bf16*)(ws + WS_W_UV); bf16* O = (bf16*)(ws + WS_OATT1);
    const int r16 = lane & 15, kq = lane >> 4;
    for (int it = gw; it < 512 * 16 * 2; it += NGW) {
        const int nc = it & 1, h = (it >> 1) & 15, mt = it >> 5;
        f32x4 acc[2][4];
#pragma unroll
        for (int m = 0; m < 2; ++m)
#pragma unroll
            for (int n = 0; n < 4; ++n) acc[m][n] = (f32x4){0.f, 0.f, 0.f, 0.f};
#pragma unroll
        for (int ks = 0; ks < 8; ++ks) { s8v af[2], bfr[4];
#pragma unroll
            for (int m = 0; m < 2; ++m) af[m] = ld_frag(OL + (size_t)(mt * 32 + m * 16 + r16) * 4096 + h * 256 + ks * 32 + kq * 8);
#pragma unroll
            for (int n = 0; n < 4; ++n) bfr[n] = ld_frag(UVT + ((size_t)h * 128 + nc * 64 + n * 16 + r16) * 256 + ks * 32 + kq * 8);
#pragma unroll
            for (int m = 0; m < 2; ++m)
#pragma unroll
                for (int n = 0; n < 4; ++n) acc[m][n] = __builtin_amdgcn_mfma_f32_16x16x32_bf16(af[m], bfr[n], acc[m][n], 0, 0, 0); }
#pragma unroll
        for (int m = 0; m < 2; ++m)
#pragma unroll
            for (int n = 0; n < 4; ++n)
#pragma unroll
                for (int j = 0; j < 4; ++j) O[(size_t)(mt * 32 + m * 16 + kq * 4 + j) * DM + h * 128 + nc * 64 + n * 16 + r16] = (bf16)f2bf(acc[m][n][j]);
    }
}

__device__ __forceinline__ unsigned f2key(float f) { const unsigned u = __float_as_uint(f); return (u & 0x80000000u) ? ~u : (u | 0x80000000u); }
__device__ __forceinline__ void p11_dsa_attn(Frame& F, const Args& A) {
    unsigned char* ws = A.ws; const int tid = F.tid, lane = F.lane, wave = F.wave;
    const float* KIWI = (const float*)(ws + WS_KIWI); const bf16* QI = (const bf16*)(ws + WS_QI); const bf16* CN = (const bf16*)(ws + WS_CN);
    const bf16* QL = (const bf16*)(ws + WS_QLAT); bf16* OL = (bf16*)(ws + WS_OLAT);
    LAS float* sc = (LAS float*)(F.lds + RING_OFF);
    LAS float* qif = (LAS float*)(F.lds + RING_OFF + 32768);
    LAS float* wif = qif + 512;
    LAS unsigned* hist = (LAS unsigned*)(wif + 8);
    LAS unsigned* misc = hist + 256;
    LAS int* idxl = (LAS int*)(misc + 8);
    LAS int* tiel = idxl + 256;
    LAS float* ql = (LAS float*)(tiel + 512);
    LAS float* pS = ql + 4096;
    LAS float* lut = pS + 4096;
    for (int i = tid; i < 129 * 16; i += 512) { const int n = i >> 4, h = i & 15; lut[i] = A.in[1][rel_bucket(n) * 16 + h]; }
    __syncthreads();
    for (int tok = F.vcu; tok < NTOK; tok += F.G) {
        const int b = tok >> 13, t = tok & (SEQ - 1), nkeys = t + 1;
        qif[tid] = bf2f(QI[(size_t)tok * 512 + tid]);
        if (tid < 8) wif[tid] = KIWI[(size_t)tok * 128 + 64 + tid] * 0.35355339059327373f;
        for (int i = tid; i < 4096; i += 512) ql[i] = bf2f(QL[(size_t)tok * 4096 + i]);
        __syncthreads();
        for (int k = tid; k < nkeys; k += 512) {
            const float* kr = KIWI + (size_t)(b * SEQ + k) * 128; float d[8];
#pragma unroll
            for (int h = 0; h < 8; ++h) d[h] = 0.f;
#pragma unroll 4
            for (int c = 0; c < 16; ++c) { const f32x4 kv = *(const f32x4*)(kr + c * 4);
#pragma unroll
                for (int h = 0; h < 8; ++h) { const f32x4 q = *(const LAS f32x4*)(qif + h * 64 + c * 4); d[h] += kv[0] * q[0] + kv[1] * q[1] + kv[2] * q[2] + kv[3] * q[3]; } }
            float s = 0.f;
#pragma unroll
            for (int h = 0; h < 8; ++h) s += wif[h] * fmaxf(d[h], 0.f);
            sc[k] = s + 0.0f;
        }
        if (tid == 0) { misc[0] = 0u; misc[1] = TOPK; misc[2] = 0u; misc[3] = 0u; }
        __syncthreads();
        int cnt;
        if (nkeys <= TOPK) { if (tid < nkeys) idxl[tid] = tid; cnt = nkeys; }
        else {
            unsigned prefix = 0u, pmask = 0u;
            for (int pass = 0; pass < 4; ++pass) {
                const int shift = 24 - 8 * pass;
                if (tid < 256) hist[tid] = 0u;
                __syncthreads();
                for (int k = tid; k < nkeys; k += 512) { const unsigned u = f2key(sc[k]); if ((u & pmask) == prefix) __hip_atomic_fetch_add(&hist[(u >> shift) & 255u], 1u, __ATOMIC_RELAXED, __HIP_MEMORY_SCOPE_WORKGROUP); }
                __syncthreads();
                if (tid == 0) { unsigned need = misc[1], cum = 0u; int bsel = 0;
                    for (int bb = 255; bb >= 0; --bb) { const unsigned hcnt = hist[bb]; if (cum + hcnt >= need) { bsel = bb; break; } cum += hcnt; }
                    misc[1] = need - cum; misc[0] = prefix | ((unsigned)bsel << shift); }
                __syncthreads();
                prefix = misc[0]; pmask |= (255u << shift);
                __syncthreads();
            }
            const unsigned T = prefix; const unsigned needtie = misc[1];
            for (int k = tid; k < nkeys; k += 512) { const unsigned u = f2key(sc[k]);
                if (u > T) { const unsigned p = __hip_atomic_fetch_add(&misc[2], 1u, __ATOMIC_RELAXED, __HIP_MEMORY_SCOPE_WORKGROUP); idxl[p] = k; }
                else if (u == T) { const unsigned p = __hip_atomic_fetch_add(&misc[3], 1u, __ATOMIC_RELAXED, __HIP_MEMORY_SCOPE_WORKGROUP); if (p < 512u) tiel[p] = k; } }
            __syncthreads();
            if (tid == 0) { unsigned base = misc[2]; int nt = (int)min(misc[3], 512u); int last = -1;
                for (unsigned q = 0; q < needtie; ++q) { int best = 0x7fffffff; for (int i = 0; i < nt; ++i) { const int v = tiel[i]; if (v > last && v < best) best = v; } idxl[base + q] = best; last = best; } }
            __syncthreads();
            cnt = TOPK;
        }
        __syncthreads();
        { const int i = tid & 255, hg = tid >> 8;
          if (i < cnt) { const int key = idxl[i]; const bf16* cr = CN + (size_t)(b * SEQ + key) * KVR; float acc[8];
#pragma unroll
              for (int hh = 0; hh < 8; ++hh) acc[hh] = 0.f;
#pragma unroll 2
              for (int c = 0; c < 32; ++c) { const v4u kv = *(const v4u*)(cr + c * 8);
                  const float k0 = bflo(kv.x), k1 = bfhi(kv.x), k2 = bflo(kv.y), k3 = bfhi(kv.y), k4 = bflo(kv.z), k5 = bfhi(kv.z), k6 = bflo(kv.w), k7 = bfhi(kv.w);
#pragma unroll
                  for (int hh = 0; hh < 8; ++hh) { const LAS float* qp = ql + (hg * 8 + hh) * 256 + c * 8; const f32x4 a = *(const LAS f32x4*)qp, bq = *(const LAS f32x4*)(qp + 4);
                      acc[hh] += k0 * a[0] + k1 * a[1] + k2 * a[2] + k3 * a[3] + k4 * bq[0] + k5 * bq[1] + k6 * bq[2] + k7 * bq[3]; } }
              const int dist = min(t - key, 128);
#pragma unroll
              for (int hh = 0; hh < 8; ++hh) pS[(hg * 8 + hh) * 256 + i] = acc[hh] + lut[dist * 16 + hg * 8 + hh];
          } else {
#pragma unroll
              for (int hh = 0; hh < 8; ++hh) pS[(hg * 8 + hh) * 256 + i] = -1e30f; } }
        __syncthreads();
#pragma unroll
        for (int hh = 0; hh < 2; ++hh) { LAS float* pr = pS + (wave * 2 + hh) * 256; float v[4]; float mx = -1e30f;
#pragma unroll
            for (int q = 0; q < 4; ++q) { v[q] = pr[lane + 64 * q]; mx = fmaxf(mx, v[q]); }
            mx = wave_max(mx); float sum = 0.f;
#pragma unroll
            for (int q = 0; q < 4; ++q) { v[q] = (lane + 64 * q < cnt) ? __expf(v[q] - mx) : 0.f; sum += v[q]; }
            sum = wave_sum(sum); const float inv = 1.0f / sum;
#pragma unroll
            for (int q = 0; q < 4; ++q) pr[lane + 64 * q] = v[q] * inv; }
        __syncthreads();
        { const int c = tid & 255, hg = tid >> 8; float acc[8];
#pragma unroll
          for (int hh = 0; hh < 8; ++hh) acc[hh] = 0.f;
#pragma unroll 4
          for (int i = 0; i < cnt; ++i) { const float cv = bf2f(CN[(size_t)(b * SEQ + idxl[i]) * KVR + c]);
#pragma unroll
              for (int hh = 0; hh < 8; ++hh) acc[hh] += pS[(hg * 8 + hh) * 256 + i] * cv; }
#pragma unroll
          for (int hh = 0; hh < 8; ++hh) OL[(size_t)tok * 4096 + (hg * 8 + hh) * 256 + c] = (bf16)f2bf(acc[hh]); }
        __syncthreads();
    }
}

struct MoeTiles { int tend[8]; int pstart[8]; int MT; };
__device__ __forceinline__ void moe_tiles(Frame& F, MoeTiles& T) {
    int acc = 0;
#pragma unroll
    for (int e = 0; e < 8; ++e) { const int c = (int)__builtin_amdgcn_readfirstlane(__hip_atomic_load((unsigned*)(F.ctl + CW_MOECNT + 64 * e), __ATOMIC_RELAXED, __HIP_MEMORY_SCOPE_AGENT));
        T.pstart[e] = acc * 256; acc += (c + 255) >> 8; T.tend[e] = acc; }
    T.MT = acc;
}
__device__ __forceinline__ void p15_gather(Frame& F, const Args& A) {
    MoeTiles T; moe_tiles(F, T);
    const int gw = F.vcu * NWAVES + F.wave, NGW = F.G * NWAVES, lane = F.lane;
    const bf16* XB = (const bf16*)(A.ws + WS_XB); bf16* XG = (bf16*)(A.ws + WS_XG);
    const int* re = (const int*)(A.ws + WS_ROUTE); const int* rp = re + 2 * NTOK;
    for (int tok = gw; tok < NTOK; tok += NGW) {
        const v4u* src = (const v4u*)(XB + (size_t)tok * DM) + lane; v4u v[4];
#pragma unroll
        for (int j = 0; j < 4; ++j) v[j] = src[64 * j];
#pragma unroll
        for (int s = 0; s < 2; ++s) { const int e = re[2 * tok + s], p = rp[2 * tok + s]; int ps = 0;
#pragma unroll
            for (int q = 0; q < 8; ++q) ps = (q == e) ? T.pstart[q] : ps;
            v4u* dst = (v4u*)(XG + (size_t)(ps + p) * DM) + lane;
#pragma unroll
            for (int j = 0; j < 4; ++j) dst[64 * j] = v[j]; }
    }
}
__device__ __forceinline__ void p18_final(Frame& F, const Args& A) {
    MoeTiles T; moe_tiles(F, T);
    const int gw = F.vcu * NWAVES + F.wave, NGW = F.G * NWAVES, lane = F.lane;
    const float* XF = (const float*)(A.ws + WS_XF); const float* Y = (const float*)(A.ws + WS_Y);
    const int* re = (const int*)(A.ws + WS_ROUTE); const int* rp = re + 2 * NTOK; const float* rw = (const float*)(rp + 2 * NTOK);
    const float* gam = A.in[25] + DM; const float* bet = A.in[26] + DM;
    for (int tok = gw; tok < NTOK; tok += NGW) {
        int rows[2]; float w[2];
#pragma unroll
        for (int s = 0; s < 2; ++s) { const int e = re[2 * tok + s]; int ps = 0;
#pragma unroll
            for (int q = 0; q < 8; ++q) ps = (q == e) ? T.pstart[q] : ps;
            rows[s] = ps + rp[2 * tok + s]; w[s] = rw[2 * tok + s]; }
        const f32x4* xr = (const f32x4*)(XF + (size_t)tok * DM) + lane; const f32x4* y0 = (const f32x4*)(Y + (size_t)rows[0] * DM) + lane; const f32x4* y1 = (const f32x4*)(Y + (size_t)rows[1] * DM) + lane;
        f32x4 v[8]; float s = 0.f;
#pragma unroll
        for (int j = 0; j < 8; ++j) { v[j] = xr[64 * j] * ALPHA + y0[64 * j] * w[0] + y1[64 * j] * w[1]; s += (v[j][0] + v[j][1]) + (v[j][2] + v[j][3]); }
        const float mean = wave_sum(s) * (1.f / DM); float s2 = 0.f;
#pragma unroll
        for (int j = 0; j < 8; ++j) { v[j] = v[j] - mean; s2 += (v[j][0] * v[j][0] + v[j][1] * v[j][1]) + (v[j][2] * v[j][2] + v[j][3] * v[j][3]); }
        const float rstd = 1.f / sqrtf(wave_sum(s2) * (1.f / DM) + LN_EPS);
#pragma unroll
        for (int j = 0; j < 8; ++j) { const int c = 4 * lane + 256 * j; const f32x4 gg = *(const f32x4*)(gam + c), bb = *(const f32x4*)(bet + c);
            *(f32x4*)(A.out + (size_t)tok * DM + c) = v[j] * rstd * gg + bb; }
    }
}

__global__ void __launch_bounds__(NWAVES * 64, 2) mega_fwd(Args args) {
    extern __shared__ __attribute__((aligned(16))) unsigned char lds[];
    Frame F;
    F.lds = (LAS unsigned char*)lds;
    F.MISC = (volatile LAS unsigned*)(F.lds + MISC_OFF);
    F.tid = threadIdx.x; F.lane = F.tid & 63; F.wave = __builtin_amdgcn_readfirstlane(F.tid >> 6);
    F.G = gridDim.x; { const int bx = blockIdx.x; F.vcu = (F.G % 8 == 0) ? (bx % 8) * (F.G / 8) + bx / 8 : bx; }
    unsigned char* ws = args.ws;
    F.ctl = (gu32*)(ws + WS_CTL);
    for (int u = F.tid; u < (LDS_BYTES - LDSCTL_OFF) / 4; u += NWAVES * 64) ((LAS unsigned*)(F.lds + LDSCTL_OFF))[u] = 0u;
    __syncthreads();
    XcdBarrier bar; bar.bar = (unsigned*)(F.ctl + CW_BAR); bar.x = 0; bar.st = nullptr;
#if !MK_PER_PHASE
    bar = xcd_barrier_post((unsigned*)(F.ctl + CW_BAR), F.MISC + 8);
#define GRID_BAR() xcd_barrier(bar)
#else
#define GRID_BAR() do { } while (0)
#endif
    const int lo = args.ph_lo, hi = args.ph_hi;
#ifndef PH_MASK
#define PH_MASK 0x7ffff
#endif
#define IN(k) (((PH_MASK >> (k)) & 1) && lo <= (k) && (k) < hi)
#define BOTH(k) (IN(k) && IN((k) + 1))
    bf16* XB = (bf16*)(ws + WS_XB); float* XF = (float*)(ws + WS_XF); float* Z = (float*)(ws + WS_Z);

    if (IN(0)) { relaunder(F); p0_prologue(F, args); if (BOTH(0)) GRID_BAR(); }
    if (IN(1)) { relaunder(F);
        pg8::Gemm g{XB, (const bf16*)(ws + WS_W_NSA_IN), NTOK, NSA_NPAD, DM}; pg8::StaticOrder S; S.init(NTOK, NSA_NPAD, F.G, (int)blockIdx.x);
        pg8::EpiNsaIn E{(bf16*)(ws + WS_P0), (float*)(ws + WS_GL), 0.08838834764831845f};
        pg8::gemm_phase<pg8::EpiNsaIn, pg8::StaticOrder, true, true>(F.lds + RING_OFF, g, S, E);
        if (BOTH(1)) GRID_BAR();
    }
    if (IN(2)) { relaunder(F); p2_compress(F, args); if (BOTH(2)) GRID_BAR(); }
    if (IN(3)) { relaunder(F); p3_nsa_attn(F, args); if (BOTH(3)) GRID_BAR(); }
    if (IN(4)) { relaunder(F);
        pg8::Gemm g{(const bf16*)(ws + WS_OATT0), (const bf16*)(ws + WS_W_NSA_OUT), NTOK, DM, DM}; pg8::StaticOrder S; S.init(NTOK, DM, F.G, (int)blockIdx.x);
        pg8::EpiResF32 E{args.in[0], Z, ALPHA, DM};
        pg8::gemm_phase<pg8::EpiResF32, pg8::StaticOrder, true, true>(F.lds + RING_OFF, g, S, E);
        if (BOTH(4)) GRID_BAR();
    }
    if (IN(5)) { relaunder(F); ln_phase<false>(F, args, Z, args.in[23], args.in[24], XF, XB); if (BOTH(5)) GRID_BAR(); }
    if (IN(6)) { relaunder(F);
        pg8::Gemm g{XB, (const bf16*)(ws + WS_W_FFN_GU), NTOK, 2 * DFF, DM}; pg8::StaticOrder S; S.init(NTOK, 2 * DFF, F.G, (int)blockIdx.x);
        pg8::EpiSwiGLU E{(bf16*)(ws + WS_HFF), DFF};
        pg8::gemm_phase<pg8::EpiSwiGLU, pg8::StaticOrder, true, true>(F.lds + RING_OFF, g, S, E);
        if (BOTH(6)) GRID_BAR();
    }
    if (IN(7)) { relaunder(F);
        pg8::Gemm g{(const bf16*)(ws + WS_HFF), (const bf16*)(ws + WS_W_FFN_DN), NTOK, DM, DFF}; pg8::StaticOrder S; S.init(NTOK, DM, F.G, (int)blockIdx.x);
        pg8::EpiResF32 E{XF, Z, ALPHA, DM};
        pg8::gemm_phase<pg8::EpiResF32, pg8::StaticOrder, true, true>(F.lds + RING_OFF, g, S, E);
        if (BOTH(7)) GRID_BAR();
    }
    if (IN(8)) { relaunder(F); ln_phase<false>(F, args, Z, args.in[25], args.in[26], XF, XB); if (BOTH(8)) GRID_BAR(); }
    if (IN(9)) { relaunder(F);
        pg8::Gemm g{XB, (const bf16*)(ws + WS_W_DSA_IN), NTOK, DSA_NPAD, DM}; pg8::StaticOrder S; S.init(NTOK, DSA_NPAD, F.G, (int)blockIdx.x);
        pg8::EpiDsaIn E{(bf16*)(ws + WS_Q), (float*)(ws + WS_CRAW), (bf16*)(ws + WS_QI), (float*)(ws + WS_KIWI), 0.125f};
        pg8::gemm_phase<pg8::EpiDsaIn, pg8::StaticOrder, true, true>(F.lds + RING_OFF, g, S, E);
        if (BOTH(9)) GRID_BAR();
    }
    if (IN(10)) { relaunder(F); p10_dsa_prep(F, args); if (BOTH(10)) GRID_BAR(); }
    if (IN(11)) { relaunder(F); p11_dsa_attn(F, args); if (BOTH(11)) GRID_BAR(); }
    if (IN(12)) { relaunder(F); p12_dsa_uv(F, args); if (BOTH(12)) GRID_BAR(); }
    if (IN(13)) { relaunder(F);
        pg8::Gemm g{(const bf16*)(ws + WS_OATT1), (const bf16*)(ws + WS_W_DSA_OUT), NTOK, DM, DM}; pg8::StaticOrder S; S.init(NTOK, DM, F.G, (int)blockIdx.x);
        pg8::EpiResF32 E{XF, Z, ALPHA, DM};
        pg8::gemm_phase<pg8::EpiResF32, pg8::StaticOrder, true, true>(F.lds + RING_OFF, g, S, E);
        if (BOTH(13)) GRID_BAR();
    }
    if (IN(14)) { relaunder(F); ln_route_phase(F, args, Z, args.in[23] + DM, args.in[24] + DM, XF, XB); if (BOTH(14)) GRID_BAR(); }
    if (IN(15)) { relaunder(F); p15_gather(F, args); if (BOTH(15)) GRID_BAR(); }
    if (IN(16)) { relaunder(F);
        MoeTiles T; moe_tiles(F, T);
        pg8::Gemm g{(const bf16*)(ws + WS_XG), (const bf16*)(ws + WS_W_MOE_GU), T.MT * 256, 2 * DFFE, DM}; pg8::MoeOrder S; S.init(T.MT * 256, 2 * DFFE, F.G, (int)blockIdx.x); S.nexp_rows = 2 * DFFE;
#pragma unroll
        for (int e = 0; e < 8; ++e) S.tend[e] = T.tend[e];
        pg8::EpiSwiGLU E{(bf16*)(ws + WS_HM), DFFE};
        pg8::gemm_phase<pg8::EpiSwiGLU, pg8::MoeOrder, true, true>(F.lds + RING_OFF, g, S, E);
        if (BOTH(16)) GRID_BAR();
    }
    if (IN(17)) { relaunder(F);
        MoeTiles T; moe_tiles(F, T);
        pg8::Gemm g{(const bf16*)(ws + WS_HM), (const bf16*)(ws + WS_W_MOE_DN), T.MT * 256, DM, DFFE}; pg8::MoeOrder S; S.init(T.MT * 256, DM, F.G, (int)blockIdx.x); S.nexp_rows = DM;
#pragma unroll
        for (int e = 0; e < 8; ++e) S.tend[e] = T.tend[e];
        pg8::EpiF32 E{(float*)(ws + WS_Y), DM};
        pg8::gemm_phase<pg8::EpiF32, pg8::MoeOrder, true, true>(F.lds + RING_OFF, g, S, E);
        if (BOTH(17)) GRID_BAR();
    }
    if (IN(18)) { relaunder(F); p18_final(F, args); }
#undef IN
#undef BOTH
}

extern "C" void kernel_launch(void* const* d_in, const int* in_sizes, int n_in, void* d_out, int out_size, void* d_ws, size_t ws_size, hipStream_t stream) {
    static int grid = 0;
    if (grid == 0) {
        if (n_in != 27 || out_size != NTOK * DM || ws_size < WS_END) { fprintf(stderr, "kernel_launch: unexpected shapes (n_in %d, out %d, ws %zu); nothing launched\n", n_in, out_size, ws_size); grid = -1; return; }
        int dev = 0, cus = 0, per_cu = 0;
        if (hipGetDevice(&dev) != hipSuccess || hipDeviceGetAttribute(&cus, hipDeviceAttributeMultiprocessorCount, dev) != hipSuccess) { grid = -1; return; }
        if (hipFuncSetAttribute((const void*)mega_fwd, hipFuncAttributeMaxDynamicSharedMemorySize, LDS_BYTES) != hipSuccess) { fprintf(stderr, "kernel_launch: hipFuncSetAttribute failed\n"); grid = -1; return; }
        if (hipOccupancyMaxActiveBlocksPerMultiprocessor(&per_cu, (const void*)mega_fwd, NWAVES * 64, LDS_BYTES) != hipSuccess || per_cu < 1) { fprintf(stderr, "kernel_launch: occupancy query says %d\n", per_cu); }
        (void)hipGetLastError();
        grid = cus;
    }
    if (grid < 0) return;
    if (hipMemsetAsync((char*)d_ws + WS_CTL, 0, CTL_ZERO_BYTES, stream) != hipSuccess) return;
    Args a{};
    for (int i = 0; i < 27; ++i) a.in[i] = (const float*)d_in[i];
    a.out = (float*)d_out; a.ws = (unsigned char*)d_ws;
#if MK_PER_PHASE
    for (int p = 0; p < NPHASE; ++p) { a.ph_lo = p; a.ph_hi = p + 1; hipLaunchKernelGGL(mega_fwd, dim3(grid), dim3(NWAVES * 64), LDS_BYTES, stream, a); }
#else
    a.ph_lo = 0; a.ph_hi = NPHASE;
    hipLaunchKernelGGL(mega_fwd, dim3(grid), dim3(NWAVES * 64), LDS_BYTES, stream, a);
#endif
}
```

```cpp
#include <hip/hip_runtime.h>
#include <cstdio>
#include <cstdint>
namespace pg8 {
#define PG8_LAS __attribute__((address_space(3)))
typedef unsigned short bf16_t;
typedef short bf16x8 __attribute__((ext_vector_type(8)));
typedef float f32x4 __attribute__((ext_vector_type(4)));
typedef unsigned u32x4 __attribute__((ext_vector_type(4)));
constexpr int BM = 256, BK = 64, HALF = 128, HTB = HALF * BK * 2  , STAGE_BYTES = 8 * HTB, NXCD = 8, WGM = 8;

__host__ __device__ __forceinline__ int lds_byte(int r, int c) { const int st = (r >> 4) * 2 + (c >> 5), rr = r & 15, cc = c & 31, ob = rr * 64 + cc * 2; return st * 1024 + (ob ^ (((ob >> 9) & 1) << 5)); }
__host__ __device__ __forceinline__ void stage_rc(int b, int& R, int& C) { const int st = b / 1024, sb = b % 1024, swz = sb ^ (((sb >> 9) & 1) << 5); R = (st >> 1) * 16 + swz / 64; C = (st & 1) * 32 + (swz % 64) / 2; }
__host__ __device__ __forceinline__ int perm32(int rho) { const int n = rho >> 4, i = rho & 15; return 8 * (i >> 2) + 4 * n + (i & 3); }

struct Unit { int pm, pn; };
struct Gemm { const bf16_t* A; const bf16_t* Bt; int M, N, K; };

struct StaticOrder {
    int nM, nN, nwg, G, c;
    __host__ __device__ void init(int M, int N, int G_, int c_) { nM = M / BM; nN = N / BM; nwg = nM * nN; G = G_; c = c_; }
    __host__ __device__ bool next(int i, Unit& u) const {
        const long L = (long)i * G + c; if (L >= nwg) return false;
        int wgid = (int)L; { const int q = nwg / NXCD, r = nwg % NXCD, xcd = wgid % NXCD, off = wgid / NXCD; wgid = (xcd < r ? xcd * (q + 1) : r * (q + 1) + (xcd - r) * q) + off; }
        const int nig = WGM * nN, gid = wgid / nig, fm = gid * WGM, gsz = (nM - fm) < WGM ? (nM - fm) : WGM;
        u.pm = fm + ((wgid % nig) % gsz); u.pn = (wgid % nig) / gsz; return true;
    }
    __device__ __forceinline__ void a_ready(const Unit&) const {}
    __device__ __forceinline__ void done(const Unit&) const {}
    __device__ __forceinline__ const char* a_ptr(const Gemm& g, const Unit& u) const { return (const char*)g.A + (size_t)u.pm * ((size_t)BM * g.K * 2); }
    __device__ __forceinline__ const char* b_ptr(const Gemm& g, const Unit& u) const { return (const char*)g.Bt + (size_t)u.pn * ((size_t)BM * g.K * 2); }
};


__device__ __forceinline__ unsigned cvt_pk_bf16(float lo, float hi) { unsigned r; asm volatile("v_cvt_pk_bf16_f32 %0, %1, %2" : "=v"(r) : "v"(lo), "v"(hi)); return r; }
__device__ __forceinline__ u32x4 pack8(const f32x4 v0, const f32x4 v1) { u32x4 w; w.x = cvt_pk_bf16(v0[0], v0[1]); w.y = cvt_pk_bf16(v0[2], v0[3]); w.z = cvt_pk_bf16(v1[0], v1[1]); w.w = cvt_pk_bf16(v1[2], v1[3]); return w; }

struct EpiNsaIn {
    static constexpr bool PERM = true, AFTER_DRAIN = false;
    bf16_t* P0; float* GL; float qscale;
    __device__ __forceinline__ void operator()(const f32x4 (&acc)[2][2][4][2], const Unit& u, int wr, int wc, int fr, int fq) const {
        const int row0 = u.pm * BM + wr * 64 + fr;
        if (u.pn < 20) {
            const float s = u.pn < 8 ? qscale : 1.0f;
            const int col0 = u.pn * BM + wc * 32 + 8 * fq;
#pragma unroll
            for (int ai = 0; ai < 2; ++ai)
#pragma unroll
                for (int m = 0; m < 4; ++m) { bf16_t* rowp = P0 + (size_t)(row0 + ai * HALF + m * 16) * 5120 + col0;
#pragma unroll
                    for (int bj = 0; bj < 2; ++bj) *(u32x4*)(rowp + bj * HALF) = pack8(acc[ai][bj][m][0] * s, acc[ai][bj][m][1] * s); }
        } else {
            const int c = wc * 32 + 8 * fq;
            if (c < 48) {
#pragma unroll
                for (int ai = 0; ai < 2; ++ai)
#pragma unroll
                    for (int m = 0; m < 4; ++m) { float* gp = GL + (size_t)(row0 + ai * HALF + m * 16) * 48 + c;
                        *(f32x4*)gp = acc[ai][0][m][0]; *(f32x4*)(gp + 4) = acc[ai][0][m][1]; }
            }
        }
    }
};
struct EpiDsaIn {
    static constexpr bool PERM = true, AFTER_DRAIN = false;
    bf16_t* Q; float* CRAW; bf16_t* QI; float* KIWI; float qiscale;
    __device__ __forceinline__ void operator()(const f32x4 (&acc)[2][2][4][2], const Unit& u, int wr, int wc, int fr, int fq) const {
        const int row0 = u.pm * BM + wr * 64 + fr; const int c = wc * 32 + 8 * fq;
        if (u.pn < 8) {
#pragma unroll
            for (int ai = 0; ai < 2; ++ai)
#pragma unroll
                for (int m = 0; m < 4; ++m) { bf16_t* rowp = Q + (size_t)(row0 + ai * HALF + m * 16) * 2048 + u.pn * BM + c;
#pragma unroll
                    for (int bj = 0; bj < 2; ++bj) *(u32x4*)(rowp + bj * HALF) = pack8(acc[ai][bj][m][0], acc[ai][bj][m][1]); }
        } else if (u.pn == 8) {
#pragma unroll
            for (int ai = 0; ai < 2; ++ai)
#pragma unroll
                for (int m = 0; m < 4; ++m) { float* rowp = CRAW + (size_t)(row0 + ai * HALF + m * 16) * 256 + c;
#pragma unroll
                    for (int bj = 0; bj < 2; ++bj) { *(f32x4*)(rowp + bj * HALF) = acc[ai][bj][m][0]; *(f32x4*)(rowp + bj * HALF + 4) = acc[ai][bj][m][1]; } }
        } else if (u.pn < 11) {
#pragma unroll
            for (int ai = 0; ai < 2; ++ai)
#pragma unroll
                for (int m = 0; m < 4; ++m) { bf16_t* rowp = QI + (size_t)(row0 + ai * HALF + m * 16) * 512 + (u.pn - 9) * BM + c;
#pragma unroll
                    for (int bj = 0; bj < 2; ++bj) *(u32x4*)(rowp + bj * HALF) = pack8(acc[ai][bj][m][0] * qiscale, acc[ai][bj][m][1] * qiscale); }
        } else {
#pragma unroll
            for (int ai = 0; ai < 2; ++ai)
#pragma unroll
                for (int m = 0; m < 4; ++m) { float* rowp = KIWI + (size_t)(row0 + ai * HALF + m * 16) * 128 + c;
                    *(f32x4*)rowp = acc[ai][0][m][0]; *(f32x4*)(rowp + 4) = acc[ai][0][m][1]; }
        }
    }
};
struct EpiResF32 {
    static constexpr bool PERM = false, AFTER_DRAIN = false;
    const float* R; float* Z; float alpha; int ldc;
    __device__ __forceinline__ void operator()(const f32x4 (&acc)[2][2][4][2], const Unit& u, int wr, int wc, int fr, int fq) const {
        const int row0 = u.pm * BM + wr * 64 + fr, col0 = u.pn * BM + wc * 32 + 4 * fq;
#pragma unroll
        for (int ai = 0; ai < 2; ++ai)
#pragma unroll
            for (int m = 0; m < 4; ++m) { const size_t off = (size_t)(row0 + ai * HALF + m * 16) * ldc + col0;
#pragma unroll
                for (int bj = 0; bj < 2; ++bj)
#pragma unroll
                    for (int n = 0; n < 2; ++n) { const f32x4 r = *(const f32x4*)(R + off + bj * HALF + n * 16); *(f32x4*)(Z + off + bj * HALF + n * 16) = r * alpha + acc[ai][bj][m][n]; } }
    }
};
struct EpiF32 {
    static constexpr bool PERM = false, AFTER_DRAIN = false;
    float* C; int ldc;
    __device__ __forceinline__ void operator()(const f32x4 (&acc)[2][2][4][2], const Unit& u, int wr, int wc, int fr, int fq) const {
        const int row0 = u.pm * BM + wr * 64 + fr, col0 = u.pn * BM + wc * 32 + 4 * fq;
#pragma unroll
        for (int ai = 0; ai < 2; ++ai)
#pragma unroll
            for (int m = 0; m < 4; ++m) { float* rowp = C + (size_t)(row0 + ai * HALF + m * 16) * ldc + col0;
#pragma unroll
                for (int bj = 0; bj < 2; ++bj)
#pragma unroll
                    for (int n = 0; n < 2; ++n) *(f32x4*)(rowp + bj * HALF + n * 16) = acc[ai][bj][m][n]; }
    }
};
__device__ __forceinline__ float silu_mul(float g, float u) { return g * __builtin_amdgcn_rcpf(1.0f + __expf(-g)) * u; }
struct EpiSwiGLU {
    static constexpr bool PERM = true, AFTER_DRAIN = false;
    bf16_t* H; int ldh;
    __device__ __forceinline__ void operator()(const f32x4 (&acc)[2][2][4][2], const Unit& u, int wr, int wc, int fr, int fq) const {
        const int row0 = u.pm * BM + wr * 64 + fr, col0 = u.pn * HALF + wc * 32 + 8 * fq;
#pragma unroll
        for (int ai = 0; ai < 2; ++ai)
#pragma unroll
            for (int m = 0; m < 4; ++m) { bf16_t* rowp = H + (size_t)(row0 + ai * HALF + m * 16) * ldh + col0;
                f32x4 v0, v1;
#pragma unroll
                for (int j = 0; j < 4; ++j) { v0[j] = silu_mul(acc[ai][0][m][0][j], acc[ai][1][m][0][j]); v1[j] = silu_mul(acc[ai][0][m][1][j], acc[ai][1][m][1][j]); }
                *(u32x4*)rowp = pack8(v0, v1); }
    }
};
struct MoeOrder : StaticOrder {
    int tend[8]; int nexp_rows;
    __device__ __forceinline__ int expert(int pm) const { int e = 0;
#pragma unroll
        for (int i = 0; i < 7; ++i) e += (pm >= tend[i]) ? 1 : 0; return e; }
    __device__ __forceinline__ const char* b_ptr(const Gemm& g, const Unit& u) const { return (const char*)g.Bt + ((size_t)expert(u.pm) * nexp_rows + (size_t)u.pn * BM) * ((size_t)g.K * 2); }
};
template <class Epi, class Sched, bool ALIGN_EPI = false, bool SP2 = false>
__device__ __forceinline__ void gemm_phase(PG8_LAS unsigned char* lds, const Gemm g, const Sched& S, const Epi& E) {
    int tid = threadIdx.x; asm volatile("" : "+v"(tid));
    const int wid = __builtin_amdgcn_readfirstlane(tid >> 6), lane = tid & 63, wr = wid >> 2, wc = wid & 3, fr = lane & 15, fq = lane >> 4;
    const int K = g.K, nt = K / BK;
    unsigned voffA[2], voffB[2];
#pragma unroll
    for (int i = 0; i < 2; ++i) { int R, C; stage_rc(tid * 16 + i * 8192, R, C); const int Rb = Epi::PERM ? ((R & ~31) + perm32(R & 31)) : R;
        voffA[i] = (unsigned)(R * K + C) * 2u; voffB[i] = (unsigned)(Rb * K + C) * 2u; }
    const size_t kstep = (size_t)(BK * 2);
    const size_t hstep = (size_t)HALF * K * 2;
    const size_t tstep = 2 * hstep;
    const unsigned ldsw = (unsigned)wid * 1024u;
    const int aoff = lds_byte(wr * 64 + fr, fq * 8), boff = lds_byte(wc * 32 + fr, fq * 8);
#define PG8_SA(b, h) (((b) * 2 + (h)) * HTB)
#define PG8_SB(b, h) ((4 + (b) * 2 + (h)) * HTB)
#define PG8_STAGE(bufoff, gbase, voff) do { _Pragma("unroll") for (int _i = 0; _i < 2; ++_i) \
        __builtin_amdgcn_global_load_lds((const unsigned*)((const char*)(gbase) + (voff)[_i]), (PG8_LAS unsigned*)(lds + (bufoff) + ldsw + _i * 8192), 16, 0, 0); } while (0)
#define PG8_LDA(dst, b, h) do { _Pragma("unroll") for (int m = 0; m < 4; ++m) _Pragma("unroll") for (int k = 0; k < 2; ++k) dst[m][k] = *(const PG8_LAS bf16x8*)(lds + PG8_SA(b, h) + aoff + m * 2048 + k * 1024); } while (0)
#define PG8_LDB(dst, b, h) do { _Pragma("unroll") for (int n = 0; n < 2; ++n) _Pragma("unroll") for (int k = 0; k < 2; ++k) dst[n][k] = *(const PG8_LAS bf16x8*)(lds + PG8_SB(b, h) + boff + n * 2048 + k * 1024); } while (0)
#define PG8_MMA(ai, bj, At, Bt) do { __builtin_amdgcn_s_setprio(1); _Pragma("unroll") for (int m = 0; m < 4; ++m) _Pragma("unroll") for (int n = 0; n < 2; ++n) _Pragma("unroll") for (int k = 0; k < 2; ++k) \
        acc[ai][bj][m][n] = __builtin_amdgcn_mfma_f32_16x16x32_bf16(Bt[n][k], At[m][k], acc[ai][bj][m][n], 0, 0, 0); __builtin_amdgcn_s_setprio(0); } while (0)
#define PG8_WAIT_V(n) asm volatile("s_waitcnt vmcnt(" #n ")" ::: "memory")
#define PG8_WAIT_L(n) asm volatile("s_waitcnt lgkmcnt(" #n ")" ::: "memory")
#define PG8_BAR __builtin_amdgcn_s_barrier()
#define PG8_SCHED __builtin_amdgcn_sched_barrier(0)
    Unit cur, nxt; int ui = 0;
    if (!S.next(0, cur)) return;
    f32x4 acc[2][2][4][2];
#pragma unroll
    for (int a = 0; a < 2; ++a)
#pragma unroll
        for (int b = 0; b < 2; ++b)
#pragma unroll
            for (int m = 0; m < 4; ++m)
#pragma unroll
                for (int n = 0; n < 2; ++n) acc[a][b][m][n] = (f32x4){0.f, 0.f, 0.f, 0.f};
    bf16x8 At[4][2], B0[2][2], B1[2][2];
    const char* cA = S.a_ptr(g, cur); const char* cB = S.b_ptr(g, cur);
    S.a_ready(cur);
    if constexpr (SP2) {
        PG8_STAGE(PG8_SB(0, 0), cB, voffB); PG8_STAGE(PG8_SB(0, 1), cB + hstep, voffB); PG8_STAGE(PG8_SA(0, 0), cA, voffA); PG8_STAGE(PG8_SA(0, 1), cA + hstep, voffA);
        if (wr == 1) PG8_BAR;
        PG8_WAIT_V(2); PG8_BAR;
        PG8_STAGE(PG8_SB(1, 0), cB + kstep, voffB); PG8_STAGE(PG8_SA(1, 0), cA + kstep, voffA); PG8_STAGE(PG8_SB(1, 1), cB + hstep + kstep, voffB);
        PG8_WAIT_V(6); PG8_BAR;
    } else {
        PG8_STAGE(PG8_SB(0, 0), cB, voffB); PG8_STAGE(PG8_SA(0, 0), cA, voffA); PG8_STAGE(PG8_SB(0, 1), cB + hstep, voffB); PG8_STAGE(PG8_SA(0, 1), cA + hstep, voffA);
        if (wr == 1) PG8_BAR;
        PG8_WAIT_V(4); PG8_BAR;
        PG8_STAGE(PG8_SB(1, 0), cB + kstep, voffB); PG8_STAGE(PG8_SA(1, 0), cA + kstep, voffA); PG8_STAGE(PG8_SB(1, 1), cB + hstep + kstep, voffB);
        PG8_WAIT_V(6); PG8_BAR;
    }
    for (;;) {
        const bool has_next = S.next(ui + 1, nxt);
        const char* nA = has_next ? S.a_ptr(g, nxt) : cA; const char* nB = has_next ? S.b_ptr(g, nxt) : cB;
        for (int t = 0; t < nt; t += 2) {
            const bool last = (t == nt - 2);
            const char* a1 = cA + (size_t)(t + 1) * kstep;
            const char* a2 = last ? nA : cA + (size_t)(t + 2) * kstep; const char* b2 = last ? nB : cB + (size_t)(t + 2) * kstep;
            const char* a3 = a2 + kstep; const char* b3 = b2 + kstep;
            if (last && has_next) S.a_ready(nxt);
            if constexpr (SP2) {
            PG8_LDB(B0, 0, 0); PG8_LDB(B1, 0, 1); PG8_SCHED; PG8_LDA(At, 0, 0); PG8_STAGE(PG8_SA(1, 1), a1 + hstep, voffA);
            PG8_WAIT_V(8); PG8_WAIT_L(0); PG8_BAR; PG8_MMA(0, 0, At, B0); PG8_MMA(0, 1, At, B1); PG8_BAR; PG8_SCHED;
            PG8_LDA(At, 0, 1); PG8_STAGE(PG8_SB(0, 0), b2, voffB); PG8_STAGE(PG8_SB(0, 1), b2 + hstep, voffB); PG8_STAGE(PG8_SA(0, 0), a2, voffA);
            PG8_WAIT_V(8); PG8_WAIT_L(0); PG8_BAR; PG8_MMA(1, 0, At, B0); PG8_MMA(1, 1, At, B1); PG8_BAR; PG8_SCHED;
            PG8_LDB(B0, 1, 0); PG8_LDB(B1, 1, 1); PG8_SCHED; PG8_LDA(At, 1, 0); PG8_STAGE(PG8_SA(0, 1), a2 + hstep, voffA);
            PG8_WAIT_V(8); PG8_WAIT_L(0); PG8_BAR; PG8_MMA(0, 0, At, B0); PG8_MMA(0, 1, At, B1); PG8_BAR; PG8_SCHED;
            PG8_LDA(At, 1, 1); PG8_STAGE(PG8_SB(1, 0), b3, voffB); PG8_STAGE(PG8_SB(1, 1), b3 + hstep, voffB); PG8_STAGE(PG8_SA(1, 0), a3, voffA);
            PG8_WAIT_V(8); PG8_WAIT_L(0); PG8_BAR; PG8_MMA(1, 0, At, B0); PG8_MMA(1, 1, At, B1); PG8_BAR; PG8_SCHED;
            } else {
            PG8_LDB(B0, 0, 0); PG8_SCHED; PG8_LDA(At, 0, 0); PG8_STAGE(PG8_SA(1, 1), a1 + hstep, voffA);
            PG8_WAIT_L(8); PG8_BAR; PG8_WAIT_L(0); PG8_MMA(0, 0, At, B0); PG8_BAR; PG8_SCHED;
            PG8_LDB(B1, 0, 1); PG8_STAGE(PG8_SB(0, 0), b2, voffB);
            PG8_BAR; PG8_WAIT_L(0); PG8_MMA(0, 1, At, B1); PG8_BAR;
            PG8_LDA(At, 0, 1); PG8_STAGE(PG8_SA(0, 0), a2, voffA);
            PG8_BAR; PG8_WAIT_L(0); PG8_MMA(1, 0, At, B0); PG8_BAR; PG8_SCHED;
            PG8_STAGE(PG8_SB(0, 1), b2 + hstep, voffB);
            PG8_WAIT_V(6); PG8_BAR; PG8_MMA(1, 1, At, B1); PG8_BAR;
            PG8_LDB(B0, 1, 0); PG8_SCHED; PG8_LDA(At, 1, 0); PG8_STAGE(PG8_SA(0, 1), a2 + hstep, voffA);
            PG8_WAIT_L(8); PG8_BAR; PG8_WAIT_L(0); PG8_MMA(0, 0, At, B0); PG8_BAR; PG8_SCHED;
            PG8_LDB(B1, 1, 1); PG8_STAGE(PG8_SB(1, 0), b3, voffB);
            PG8_BAR; PG8_WAIT_L(0); PG8_MMA(0, 1, At, B1); PG8_BAR;
            PG8_LDA(At, 1, 1); PG8_STAGE(PG8_SA(1, 0), a3, voffA);
            PG8_BAR; PG8_WAIT_L(0); PG8_MMA(1, 0, At, B0); PG8_BAR; PG8_SCHED;
            PG8_STAGE(PG8_SB(1, 1), b3 + hstep, voffB);
            PG8_WAIT_V(6); PG8_BAR; PG8_MMA(1, 1, At, B1); PG8_BAR;
            }
        }
        if constexpr (ALIGN_EPI) { if (wr == 0) PG8_BAR; }
        if constexpr (!Epi::AFTER_DRAIN) { E(acc, cur, wr, wc, fr, fq); S.done(cur); }
        if (!has_next) break;
#pragma unroll
        for (int a = 0; a < 2; ++a)
#pragma unroll
            for (int b = 0; b < 2; ++b)
#pragma unroll
                for (int m = 0; m < 4; ++m)
#pragma unroll
                    for (int n = 0; n < 2; ++n) acc[a][b][m][n] = (f32x4){0.f, 0.f, 0.f, 0.f};
        cur = nxt; cA = nA; cB = nB; ++ui;
        if constexpr (ALIGN_EPI) { if (wr == 1) PG8_BAR; }
    }
    PG8_WAIT_V(0);
    if constexpr (!ALIGN_EPI) { if (wr == 0) PG8_BAR; }
    PG8_BAR;
    if constexpr (Epi::AFTER_DRAIN) { E.fused(acc, cur, wr, wc, fr, fq, lds, wid, lane); S.done(cur); }
#undef PG8_SA
#undef PG8_SB
#undef PG8_STAGE
#undef PG8_LDA
#undef PG8_LDB
#undef PG8_MMA
#undef PG8_WAIT_V
#undef PG8_WAIT_L
#undef PG8_BAR
#undef PG8_SCHED
}
}
#define GAS __attribute__((address_space(1)))
#define LAS __attribute__((address_space(3)))
typedef unsigned short bf16;
typedef unsigned v4u __attribute__((ext_vector_type(4)));
typedef float f32x4 __attribute__((ext_vector_type(4)));
typedef short bf16x8 __attribute__((ext_vector_type(8)));
typedef GAS unsigned gu32;
typedef GAS unsigned long long gu64;
#define RLX_AGENT __ATOMIC_RELAXED, __HIP_MEMORY_SCOPE_AGENT
#define LDS_WAIT() asm volatile("s_waitcnt lgkmcnt(0)" ::: "memory")
#define VM_WAIT() asm volatile("s_waitcnt vmcnt(0)" ::: "memory")
__device__ __forceinline__ unsigned long long rt() { return __builtin_amdgcn_s_memrealtime(); }
__device__ __forceinline__ unsigned f2bf(float f) { unsigned u = __builtin_bit_cast(unsigned, f); return (u + 0x7fffu + ((u >> 16) & 1u)) >> 16; }
__device__ __forceinline__ unsigned pk2(float lo, float hi) { return f2bf(lo) | (f2bf(hi) << 16); }

#define XB_TMO      128
#define XB_XCNT(j)  (256  + 64 * (j))
#define XB_XSUB(j)  (1280 + 64 * (j))
#define XB_XGEN(j)  (2304 + 64 * (j))
#define XB_TOP      3328
#define XB_TOPGEN   3392
#define XCD_BAR_WORDS 3456
#define XB_SPIN_CAP (1u << 18)

__device__ __forceinline__ unsigned xb_ld(unsigned* p)              { return __hip_atomic_load(p, __ATOMIC_RELAXED, __HIP_MEMORY_SCOPE_AGENT); }
__device__ __forceinline__ unsigned xb_add(unsigned* p, unsigned v) { return __hip_atomic_fetch_add(p, v, __ATOMIC_RELAXED, __HIP_MEMORY_SCOPE_AGENT); }
__device__ __forceinline__ unsigned xb_xcc_id() { return (unsigned)__builtin_amdgcn_s_getreg((3 << 11) | 20) & 0xFu; }
#define XB_SPIN(cond, bar) do { unsigned _sp = 0; while (cond) { __builtin_amdgcn_s_sleep(1); \
    if ((++_sp & 255u) == 0u) { if (xb_ld(&(bar)[XB_TMO])) break; if (_sp > XB_SPIN_CAP) { atomicAdd(&(bar)[XB_TMO], 1u); break; } } } } while (0)

struct XcdBarrier {
    unsigned* bar; unsigned x;
    volatile LAS unsigned* st;
};

__device__ __forceinline__ XcdBarrier xcd_barrier_post(unsigned* bar, volatile LAS unsigned* st) {
    XcdBarrier b; b.bar = bar; b.x = xb_xcc_id(); b.st = st;
    if (threadIdx.x == 0) (void)xb_add(&bar[XB_XCNT(b.x)], 1u);
    return b;
}
__device__ __forceinline__ void xcd_barrier_complete(unsigned* bar, unsigned x, unsigned& nloc, unsigned& nx) {
    const unsigned G = gridDim.x * gridDim.y * gridDim.z;
    unsigned sum, cnt, mine, sp = 0u;
    for (;;) {
        sum = 0u; cnt = 0u; mine = 0u;
#pragma unroll
        for (unsigned j = 0; j < 16; ++j) { const unsigned c = xb_ld(&bar[XB_XCNT(j)]); sum += c; cnt += (c > 0u) ? 1u : 0u; mine = (j == x) ? c : mine; }
        if (sum == G) break;
        __builtin_amdgcn_s_sleep(1);
        if ((++sp & 255u) == 0u) { if (xb_ld(&bar[XB_TMO])) break; if (sp > XB_SPIN_CAP) { atomicAdd(&bar[XB_TMO], 1u); break; } }
    }
    nloc = mine > 0u ? mine : 1u; nx = cnt > 0u ? cnt : 1u;
}

__device__ __forceinline__ void xcd_barrier(const XcdBarrier& b) {
    asm volatile("s_waitcnt vmcnt(0)" ::: "memory");
    __syncthreads();
    if (threadIdx.x == 0) {
        unsigned* bar = b.bar;
        __builtin_amdgcn_s_waitcnt(0);
        unsigned nloc = b.st[0], nx = b.st[1];
        if (nloc == 0u) { xcd_barrier_complete(bar, b.x, nloc, nx); b.st[0] = nloc; b.st[1] = nx; }
        const unsigned old = xb_add(&bar[XB_XSUB(b.x)], 1u);
        const unsigned gen = old / nloc;
        if (old + 1u == (gen + 1u) * nloc) {
            __builtin_amdgcn_fence(__ATOMIC_RELEASE, "agent");
            asm volatile("s_waitcnt vmcnt(0)" ::: "memory");
            const unsigned og = xb_add(&bar[XB_TOP], 1u);
            const unsigned tg = og / nx;
            if (og + 1u == (tg + 1u) * nx) xb_add(&bar[XB_TOPGEN], 1u);
            else XB_SPIN(xb_ld(&bar[XB_TOPGEN]) == tg, bar);
            __builtin_amdgcn_fence(__ATOMIC_ACQUIRE, "agent");
            xb_add(&bar[XB_XGEN(b.x)], 1u);
            asm volatile("s_waitcnt vmcnt(0)" ::: "memory");
        } else {
            XB_SPIN(xb_ld(&bar[XB_XGEN(b.x)]) == gen, bar);
            __builtin_amdgcn_fence(__ATOMIC_ACQUIRE, "agent");
            asm volatile("s_waitcnt vmcnt(0)" ::: "memory");
        }
    }
    __syncthreads();
}

constexpr int NWAVES = 8;
#ifndef MK_PER_PHASE
#define MK_PER_PHASE 0
#endif
constexpr int NPHASE = 21;

constexpr int BATCH = 2, SEQ = 8192, DM = 2048, NTOK = BATCH * SEQ, NH = 16, DH = 128;
constexpr int NSA_N = 5168, NSA_NPAD = 5376, P0LD = 5120;
constexpr int NCMP = 511, NSELB = 128;
constexpr int COL_KC = 2048, COL_VC = 2560, COL_KS = 3072, COL_VS = 3584, COL_KW = 4096, COL_VW = 4608;
constexpr int DSA_N = 2888, DSA_NPAD = 3072, KVR = 256, TOPK = 256;
constexpr int DFF = 5632, NEXP = 8, DFFE = 7168, MOE_ROWS = 34816;
constexpr float ALPHA = 1.41421356237309515f, LN_EPS = 1e-5f, RMS_EPS = 1e-6f;

constexpr size_t MiB = (size_t)1 << 20;
constexpr size_t WS_CTL = 0, CTL_ZERO_BYTES = 1 * MiB;
constexpr size_t WS_W_NSA_IN = 2 * MiB, WS_W_NSA_OUT = 23 * MiB, WS_W_FFN_GU = 31 * MiB, WS_W_FFN_DN = 75 * MiB, WS_W_DSA_IN = 97 * MiB, WS_W_DSA_OUT = 109 * MiB;
constexpr size_t WS_W_CMPK = 117 * MiB, WS_W_CMPV = 118 * MiB, WS_W_UK = 119 * MiB, WS_W_UV = 120 * MiB, WS_CBIAS = 121 * MiB;
constexpr size_t WS_KCMP = 122 * MiB, WS_VCMP = 124 * MiB, WS_GL = 126 * MiB, WS_ROUTE = 129 * MiB;
constexpr size_t WS_SELM = 178 * MiB;
constexpr size_t WS_CRAW = 130 * MiB, WS_KIWI = 146 * MiB, WS_IDX = 154 * MiB, WS_CN = 170 * MiB;
constexpr size_t WS_W_MOE_GU = 192 * MiB, WS_W_MOE_DN = 640 * MiB;
constexpr size_t WS_XB = 864 * MiB, WS_XF = 928 * MiB, WS_Z = 1056 * MiB;
constexpr size_t WS_P0 = 1184 * MiB, WS_OATT0 = 1344 * MiB, WS_HFF = 1408 * MiB;
constexpr size_t WS_Q = 1184 * MiB, WS_QI = 1248 * MiB, WS_QLAT = 1264 * MiB, WS_OLAT = 1392 * MiB, WS_OATT1 = 1520 * MiB;
constexpr size_t WS_XG = 1056 * MiB, WS_HM = 1192 * MiB, WS_Y = 192 * MiB;
constexpr size_t WS_END = 1668 * MiB;
static_assert(WS_HM + (size_t)MOE_ROWS * DFFE * 2 <= WS_END, "hm fits");
static_assert(WS_XG + (size_t)MOE_ROWS * DM * 2 <= WS_HM, "xg fits");
static_assert(WS_Y + (size_t)MOE_ROWS * DM * 4 <= WS_W_MOE_DN, "y overlays the dead gate/up weights only");
static_assert(WS_HFF + (size_t)NTOK * DFF * 2 <= WS_END, "hff fits");
constexpr int CW_TMO = 0, CW_CODE = 1;
constexpr int CW_BAR = 4096;
constexpr int CW_MOECNT = 16384;

constexpr int RING_OFF = 0, RING_BYTES = 131072;
constexpr int LDSCTL_OFF = RING_BYTES, MISC_OFF = LDSCTL_OFF + 320;
constexpr int LDS_BYTES = 147456;

struct Frame {
    LAS unsigned char* lds;
    volatile LAS unsigned* MISC;
    gu32* ctl;
    int tid, lane, wave, vcu, G;
};

__device__ __forceinline__ void relaunder(Frame& F) { int t = F.tid; asm volatile("" : "+v"(t)); F.tid = t; F.lane = t & 63; }
__device__ __forceinline__ float bf2f(unsigned short h) { return __uint_as_float(((unsigned)h) << 16); }
__device__ __forceinline__ float bflo(unsigned w) { return __uint_as_float(w << 16); }
__device__ __forceinline__ float bfhi(unsigned w) { return __uint_as_float(w & 0xffff0000u); }
__device__ __forceinline__ float wave_sum(float v) {
#pragma unroll
    for (int o = 1; o < 64; o <<= 1) v += __shfl_xor(v, o);
    return v;
}
__device__ __forceinline__ float wave_max(float v) {
#pragma unroll
    for (int o = 1; o < 64; o <<= 1) v = fmaxf(v, __shfl_xor(v, o));
    return v;
}
#define WSYNC() do { __builtin_amdgcn_wave_barrier(); asm volatile("s_waitcnt lgkmcnt(0)" ::: "memory"); __builtin_amdgcn_wave_barrier(); } while (0)

__device__ __forceinline__ int rel_bucket(int n) {
    if (n < 16) return n;
    if (n >= 113) return 31;
    int b = 16;
    b += (n >= 19); b += (n >= 21); b += (n >= 24); b += (n >= 27); b += (n >= 31); b += (n >= 35); b += (n >= 40); b += (n >= 46);
    b += (n >= 52); b += (n >= 59); b += (n >= 67); b += (n >= 77); b += (n >= 87); b += (n >= 99);
    return b;
}

__device__ __forceinline__ void tr_item(const float* W, int N, int ldw, bf16* WT, int Kdst, int k0, int n0, int drow, LAS float* scr, int lane) {
#pragma unroll 8
    for (int i = 0; i < 32; ++i) { const int kk = 2 * i + (lane >> 5); const int n = n0 + (lane & 31); scr[kk * 33 + (lane & 31)] = (n < N) ? W[(size_t)(k0 + kk) * ldw + n] : 0.f; }
    LDS_WAIT(); asm volatile("" ::: "memory");
    const int c = lane & 7;
#pragma unroll
    for (int j = 0; j < 4; ++j) { const int n = (lane >> 3) + 8 * j; const LAS float* s = scr + (8 * c) * 33 + n;
        v4u o; o.x = pk2(s[0 * 33], s[1 * 33]); o.y = pk2(s[2 * 33], s[3 * 33]); o.z = pk2(s[4 * 33], s[5 * 33]); o.w = pk2(s[6 * 33], s[7 * 33]);
        *(v4u*)(WT + (size_t)(drow + n) * Kdst + k0 + 8 * c) = o; }
    LDS_WAIT(); asm volatile("" ::: "memory");
}
__device__ __forceinline__ void tr_mat(const float* W, int K, int N, int Npad, bf16* WT, int mode, int item, LAS float* scr, int lane) {
    const int nblk = Npad / 32, kb = item / nblk, nb = item - kb * nblk, n0 = 32 * nb;
    const int drow = (mode == 0) ? n0 : ((n0 >> 7) * 256 + (mode - 1) * 128 + (n0 & 127));
    tr_item(W, N, N, WT, K, 64 * kb, n0, drow, scr, lane);
}

struct Args { const float* in[27]; float* out; unsigned char* ws; int ph_lo, ph_hi; };

__device__ __forceinline__ void p0_prologue(Frame& F, const Args& A) {
    LAS float* scr = (LAS float*)(F.lds + RING_OFF + F.wave * 16384);
    unsigned char* ws = A.ws;
    const int gw = F.vcu * NWAVES + F.wave, NGW = F.G * NWAVES, lane = F.lane;
    constexpr int I_NSA_IN = (DM / 64) * (NSA_NPAD / 32), I_SQ = (DM / 64) * (DM / 32), I_FFN = (DM / 64) * (DFF / 32), I_FFD = (DFF / 64) * (DM / 32), I_DSA_IN = (DM / 64) * (DSA_NPAD / 32);
    constexpr int I_CMP = (4096 / 64) * (128 / 32), I_UK1 = (128 / 64) * (256 / 32), I_UV1 = (256 / 64) * (128 / 32);
    constexpr int I_MG1 = (DM / 64) * (DFFE / 32), I_MD1 = (DFFE / 64) * (DM / 32);
    constexpr int NITEMS = I_NSA_IN + 2 * I_SQ + 2 * I_FFN + I_FFD + I_DSA_IN + 2 * I_CMP + 16 * I_UK1 + 16 * I_UV1 + 16 * I_MG1 + 8 * I_MD1;
    for (int it = gw; it < NITEMS; it += NGW) {
        int r = it;
        if (r < I_NSA_IN) { tr_mat(A.in[2], DM, NSA_N, NSA_NPAD, (bf16*)(ws + WS_W_NSA_IN), 0, r, scr, lane); continue; } r -= I_NSA_IN;
        if (r < I_SQ) { tr_mat(A.in[9], DM, DM, DM, (bf16*)(ws + WS_W_NSA_OUT), 0, r, scr, lane); continue; } r -= I_SQ;
        if (r < I_SQ) { tr_mat(A.in[14], DM, DM, DM, (bf16*)(ws + WS_W_DSA_OUT), 0, r, scr, lane); continue; } r -= I_SQ;
        if (r < I_FFN) { tr_mat(A.in[15], DM, DFF, DFF, (bf16*)(ws + WS_W_FFN_GU), 1, r, scr, lane); continue; } r -= I_FFN;
        if (r < I_FFN) { tr_mat(A.in[16], DM, DFF, DFF, (bf16*)(ws + WS_W_FFN_GU), 2, r, scr, lane); continue; } r -= I_FFN;
        if (r < I_FFD) { tr_mat(A.in[17], DFF, DM, DM, (bf16*)(ws + WS_W_FFN_DN), 0, r, scr, lane); continue; } r -= I_FFD;
        if (r < I_DSA_IN) { tr_mat(A.in[10], DM, DSA_N, DSA_NPAD, (bf16*)(ws + WS_W_DSA_IN), 0, r, scr, lane); continue; } r -= I_DSA_IN;
        if (r < I_CMP) { tr_mat(A.in[4], 4096, 128, 128, (bf16*)(ws + WS_W_CMPK), 0, r, scr, lane); continue; } r -= I_CMP;
        if (r < I_CMP) { tr_mat(A.in[7], 4096, 128, 128, (bf16*)(ws + WS_W_CMPV), 0, r, scr, lane); continue; } r -= I_CMP;
        if (r < 16 * I_UK1) { const int h = r / I_UK1; tr_mat(A.in[12] + (size_t)h * 128 * 256, 128, 256, 256, (bf16*)(ws + WS_W_UK) + (size_t)h * 256 * 128, 0, r - h * I_UK1, scr, lane); continue; } r -= 16 * I_UK1;
        if (r < 16 * I_UV1) { const int h = r / I_UV1; tr_mat(A.in[13] + (size_t)h * 256 * 128, 256, 128, 128, (bf16*)(ws + WS_W_UV) + (size_t)h * 128 * 256, 0, r - h * I_UV1, scr, lane); continue; } r -= 16 * I_UV1;
        if (r < 8 * I_MG1) { const int e = r / I_MG1; tr_mat(A.in[20] + (size_t)e * DM * DFFE, DM, DFFE, DFFE, (bf16*)(ws + WS_W_MOE_GU) + (size_t)e * 2 * DFFE * DM, 1, r - e * I_MG1, scr, lane); continue; } r -= 8 * I_MG1;
        if (r < 8 * I_MG1) { const int e = r / I_MG1; tr_mat(A.in[21] + (size_t)e * DM * DFFE, DM, DFFE, DFFE, (bf16*)(ws + WS_W_MOE_GU) + (size_t)e * 2 * DFFE * DM, 2, r - e * I_MG1, scr, lane); continue; } r -= 8 * I_MG1;
        { const int e = r / I_MD1; tr_mat(A.in[22] + (size_t)e * DFFE * DM, DFFE, DM, DM, (bf16*)(ws + WS_W_MOE_DN) + (size_t)e * DM * DFFE, 0, r - e * I_MD1, scr, lane); }
    }
    { const float* x = A.in[0]; bf16* xb = (bf16*)(ws + WS_XB); const size_t n8 = (size_t)NTOK * DM / 8;
      for (size_t i = (size_t)F.vcu * 512 + F.tid; i < n8; i += (size_t)F.G * 512) { const f32x4 a = *(const f32x4*)(x + i * 8), b = *(const f32x4*)(x + i * 8 + 4);
          v4u o; o.x = pk2(a[0], a[1]); o.y = pk2(a[2], a[3]); o.z = pk2(b[0], b[1]); o.w = pk2(b[2], b[3]); *(v4u*)(xb + i * 8) = o; } }
    for (int it = gw; it < 64; it += NGW) { const int kv = it >> 5, ch = it & 31; const float* pe = A.in[kv ? 6 : 3]; const float* w1 = A.in[kv ? 7 : 4];
        float s0 = 0.f, s1 = 0.f;
        for (int k = ch * 128; k < ch * 128 + 128; ++k) { const float p = pe[k]; s0 += p * w1[(size_t)k * 128 + lane]; s1 += p * w1[(size_t)k * 128 + 64 + lane]; }
        float* cb = (float*)(ws + WS_CBIAS) + (size_t)(kv * 32 + ch) * 128; cb[lane] = s0; cb[64 + lane] = s1; }
}

typedef short s8v __attribute__((ext_vector_type(8)));
__device__ __forceinline__ s8v ld_frag(const bf16* p) { return *(const s8v*)p; }

__device__ __forceinline__ float gelu_tanh(float x) { const float u = 0.7978845608028654f * (x + 0.044715f * x * x * x); return 0.5f * x * (1.0f + tanhf(u)); }
__device__ __forceinline__ void p2_compress(Frame& F, const Args& A) {
    unsigned char* ws = A.ws; const int lane = F.lane;
    const bf16* P0 = (const bf16*)(ws + WS_P0);
    LAS float* hid = (LAS float*)(F.lds + RING_OFF + F.wave * 16384);
    const int gw = F.vcu * NWAVES + F.wave, NGW = F.G * NWAVES;
    const int r16 = lane & 15, kq = lane >> 4;
    if (gw < 16) { bf16* zp = (bf16*)(ws + ((gw & 1) ? WS_VCMP : WS_KCMP)) + ((size_t)(gw >> 1) * 512 + 511) * 128; zp[lane] = 0; zp[64 + lane] = 0; }
    for (int it = gw; it < 256; it += NGW) {
        const int kv = it >> 7, tile = it & 127;
        const bf16* W1T = (const bf16*)(ws + (kv ? WS_W_CMPV : WS_W_CMPK));
        const float* w2 = A.in[kv ? 8 : 5];
        const float* cbp = (const float*)(ws + WS_CBIAS) + (size_t)kv * 32 * 128;
        bf16* outp = (bf16*)(ws + (kv ? WS_VCMP : WS_KCMP));
        const int colbase = kv ? COL_VC : COL_KC;
        f32x4 acc[2][8];
#pragma unroll
        for (int m = 0; m < 2; ++m)
#pragma unroll
            for (int n = 0; n < 8; ++n) acc[m][n] = (f32x4){0.f, 0.f, 0.f, 0.f};
        const bf16* arow[2];
#pragma unroll
        for (int m = 0; m < 2; ++m) { int R = tile * 32 + m * 16 + r16; if (R > 4087) R = 4087; const int g = R & 3, bn = R >> 2, b = bn / NCMP, n = bn - b * NCMP;
            arow[m] = P0 + (size_t)(b * SEQ + 16 * n) * P0LD + colbase + g * 128 + kq * 8; }
        for (int ks = 0; ks < 128; ++ks) {
            const int l = ks >> 2, d0 = (ks & 3) * 32;
            s8v af[2], bfr[8];
#pragma unroll
            for (int m = 0; m < 2; ++m) af[m] = ld_frag(arow[m] + (size_t)l * P0LD + d0);
#pragma unroll
            for (int n = 0; n < 8; ++n) bfr[n] = ld_frag(W1T + (size_t)(n * 16 + r16) * 4096 + ks * 32 + kq * 8);
#pragma unroll
            for (int m = 0; m < 2; ++m)
#pragma unroll
                for (int n = 0; n < 8; ++n) acc[m][n] = __builtin_amdgcn_mfma_f32_16x16x32_bf16(af[m], bfr[n], acc[m][n], 0, 0, 0);
        }
#pragma unroll
        for (int n = 0; n < 8; ++n) { const int e = n * 16 + r16; float cb = 0.f; for (int ch = 0; ch < 32; ++ch) cb += cbp[ch * 128 + e];
#pragma unroll
            for (int m = 0; m < 2; ++m)
#pragma unroll
                for (int j = 0; j < 4; ++j) hid[(m * 16 + kq * 4 + j) * 128 + e] = gelu_tanh(acc[m][n][j] + cb); }
        WSYNC();
        for (int rr = 0; rr < 32; ++rr) { const int R = tile * 32 + rr; if (R > 4087) break;
            float s0 = 0.f, s1 = 0.f;
#pragma unroll 8
            for (int e = 0; e < 128; ++e) { const float hv = hid[rr * 128 + e]; s0 += hv * w2[e * 128 + lane]; s1 += hv * w2[e * 128 + 64 + lane]; }
            { const int g = R & 3, bn = R >> 2, b = bn / NCMP, n = bn - b * NCMP; bf16* op = outp + ((size_t)(b * 4 + g) * 512 + n) * 128; op[lane] = (bf16)f2bf(s0); op[64 + lane] = (bf16)f2bf(s1); } }
        WSYNC();
    }
}


namespace fa {
typedef float f32x16 __attribute__((ext_vector_type(16)));
typedef short s16x4 __attribute__((ext_vector_type(4)));
typedef unsigned u32x4v __attribute__((ext_vector_type(4)));
constexpr int SHM_K = 16384, SHM_V = 16384;
constexpr int OFF_V = 0, OFF_K = 2 * SHM_V, OFF_WS = 2 * SHM_V + 2 * SHM_K, OFF_LUT = OFF_WS + 8 * 256, OFF_MASK = OFF_LUT + 144 * 16 * 4, OFF_TAB = OFF_MASK + 1024;
constexpr int TABLD = 130;
constexpr float C2 = 1.4426950408889634f, THR = 8.f;
#define FA_KSWZ(row, colB) ((row) * 256 + ((colB) ^ (((row) & 7) << 4)))
#define FA_SBAR() __builtin_amdgcn_sched_barrier(0)
__device__ __forceinline__ int v_st(int k, int c) { const int kk = (k & ~0xC) | ((k & 4) << 1) | ((k & 8) >> 1); return ((kk >> 3) * 4 + (c >> 5)) * 512 + ((kk & 7) * 32 + (c & 31)) * 2; }
__device__ __forceinline__ int v_rd_base(int lane) { return ((lane & 3) << 3) | (((lane >> 2) & 3) << 6) | (((lane >> 4) & 1) << 5) | (((lane >> 5) & 1) << 8); }
constexpr int v_rd_off(int d0, int ks, int half) { return d0 * 512 + ks * 4096 + half * 2048; }
__device__ __forceinline__ int crow(int r, int hi) { return (r & 3) + 8 * (r >> 2) + 4 * hi; }
__device__ __forceinline__ unsigned cvtpk(float lo, float hi) { unsigned r; asm volatile("v_cvt_pk_bf16_f32 %0, %1, %2" : "=v"(r) : "v"(lo), "v"(hi)); return r; }

__device__ __forceinline__ void qkt(f32x16& p0, f32x16& p1, const LAS char* Kb, int r32, int hi, const bf16x8 (&qr)[8], float init) {
#pragma unroll
    for (int r = 0; r < 16; ++r) { p0[r] = init; p1[r] = init; }
    const LAS char* kb[4];
#pragma unroll
    for (int dd = 0; dd < 4; ++dd) kb[dd] = Kb + FA_KSWZ(r32, (dd * 16 + hi * 8) * 2);
#pragma unroll
    for (int d0 = 0; d0 < 8; ++d0) { const LAS char* a = kb[d0 & 3] + (d0 >> 2) * 128;
        const bf16x8 b0 = *(const LAS bf16x8*)a;
        const bf16x8 b1 = *(const LAS bf16x8*)(a + 32 * 256);
        p0 = __builtin_amdgcn_mfma_f32_32x32x16_bf16(b0, qr[d0], p0, 0, 0, 0);
        p1 = __builtin_amdgcn_mfma_f32_32x32x16_bf16(b1, qr[d0], p1, 0, 0, 0); }
}
__device__ __forceinline__ void pv_tile(f32x16 (&o)[4], int vb0, bf16x8 pa0, bf16x8 pa1, bf16x8 pa2, bf16x8 pa3) {
#define FA_TRRD(dst, off) asm volatile("ds_read_b64_tr_b16 %0, %1 offset:%2" : "=&v"(dst) : "v"(vb0), "i"(off) : "memory")
#define FA_PV_D0(d0) do { s16x4 l0, l1, l2, l3, h0, h1, h2, h3; constexpr int b_ = v_rd_off(d0, 0, 0); \
        FA_TRRD(l0, b_); FA_TRRD(h0, b_ + 2048); FA_TRRD(l1, b_ + 4096); FA_TRRD(h1, b_ + 6144); FA_TRRD(l2, b_ + 8192); FA_TRRD(h2, b_ + 10240); FA_TRRD(l3, b_ + 12288); FA_TRRD(h3, b_ + 14336); \
        asm volatile("s_waitcnt lgkmcnt(0)" ::: "memory"); FA_SBAR(); \
        o[d0] = __builtin_amdgcn_mfma_f32_32x32x16_bf16(pa0, (bf16x8){l0[0], l0[1], l0[2], l0[3], h0[0], h0[1], h0[2], h0[3]}, o[d0], 0, 0, 0); \
        o[d0] = __builtin_amdgcn_mfma_f32_32x32x16_bf16(pa1, (bf16x8){l1[0], l1[1], l1[2], l1[3], h1[0], h1[1], h1[2], h1[3]}, o[d0], 0, 0, 0); \
        o[d0] = __builtin_amdgcn_mfma_f32_32x32x16_bf16(pa2, (bf16x8){l2[0], l2[1], l2[2], l2[3], h2[0], h2[1], h2[2], h2[3]}, o[d0], 0, 0, 0); \
        o[d0] = __builtin_amdgcn_mfma_f32_32x32x16_bf16(pa3, (bf16x8){l3[0], l3[1], l3[2], l3[3], h3[0], h3[1], h3[2], h3[3]}, o[d0], 0, 0, 0); } while (0)
    FA_PV_D0(0); FA_PV_D0(1); FA_PV_D0(2); FA_PV_D0(3);
#undef FA_PV_D0
#undef FA_TRRD
}
__device__ __forceinline__ void partialSM(f32x16& p0, f32x16& p1, float& m_reg, float& alpha) {
    float pmax = p0[0];
#pragma unroll
    for (int r = 1; r < 16; ++r) pmax = fmaxf(pmax, p0[r]);
#pragma unroll
    for (int r = 0; r < 16; ++r) pmax = fmaxf(pmax, p1[r]);
    { auto rr = __builtin_amdgcn_permlane32_swap(__float_as_uint(pmax), __float_as_uint(pmax), false, false); pmax = fmaxf(__uint_as_float(rr[0]), __uint_as_float(rr[1])); }
    float mn;
    if (__all(pmax - m_reg <= THR)) { mn = m_reg; alpha = 1.f; }
    else { mn = fmaxf(m_reg, pmax); alpha = __builtin_amdgcn_exp2f((m_reg - mn) * C2); m_reg = mn; }
    const float mnL = -mn * C2;
#pragma unroll
    for (int r = 0; r < 16; ++r) { p0[r] = __builtin_amdgcn_exp2f(fmaf(p0[r], C2, mnL)); p1[r] = __builtin_amdgcn_exp2f(fmaf(p1[r], C2, mnL)); }
}
__device__ __forceinline__ float finishSM(const f32x16& p0, const f32x16& p1, bf16x8& pa0, bf16x8& pa1, bf16x8& pa2, bf16x8& pa3) {
    float ps = 0.f;
#pragma unroll
    for (int r = 0; r < 16; ++r) ps += p0[r];
#pragma unroll
    for (int r = 0; r < 16; ++r) ps += p1[r];
    { auto rr = __builtin_amdgcn_permlane32_swap(__float_as_uint(ps), __float_as_uint(ps), false, false); ps = __uint_as_float(rr[0]) + __uint_as_float(rr[1]); }
#define FA_PK4(P, B_, OUT) do { unsigned a0 = cvtpk(P[B_ + 0], P[B_ + 1]), a1 = cvtpk(P[B_ + 2], P[B_ + 3]); unsigned b0 = cvtpk(P[B_ + 4], P[B_ + 5]), b1 = cvtpk(P[B_ + 6], P[B_ + 7]); \
        auto r0 = __builtin_amdgcn_permlane32_swap(a0, b0, false, false); auto r1 = __builtin_amdgcn_permlane32_swap(a1, b1, false, false); \
        u32x4v w = {r0[0], r1[0], r0[1], r1[1]}; OUT = *reinterpret_cast<bf16x8*>(&w); } while (0)
    FA_PK4(p0, 0, pa0); FA_PK4(p0, 8, pa1); FA_PK4(p1, 0, pa2); FA_PK4(p1, 8, pa3);
#undef FA_PK4
    return ps;
}
__device__ __forceinline__ void rescale(f32x16 (&o)[4], float alpha, LAS float* al_l, int r32, int hi) {
    if (__any(alpha < 1.f)) { if (hi == 0) al_l[r32] = alpha; asm volatile("s_waitcnt lgkmcnt(0)" ::: "memory");
#pragma unroll
        for (int r = 0; r < 16; ++r) { const float a = al_l[crow(r, hi)];
#pragma unroll
            for (int d = 0; d < 4; ++d) o[d][r] *= a; }
        asm volatile("s_waitcnt lgkmcnt(0)" ::: "memory"); }
}
__device__ __forceinline__ void mask_tile(f32x16& p0, f32x16& p1, int dq, unsigned W) {
    const float NEG = -__builtin_inff();
#pragma unroll
    for (int r = 0; r < 16; ++r) { const int c = (r & 3) + 8 * (r >> 2);
        if ((unsigned)(dq - c) >= W) p0[r] = NEG;
        if ((unsigned)(dq - c - 32) >= W) p1[r] = NEG; }
}
__device__ __forceinline__ void mask_all(f32x16& p0, f32x16& p1, bool keep) {
    const float NEG = -__builtin_inff();
#pragma unroll
    for (int r = 0; r < 16; ++r) { p0[r] = keep ? p0[r] : NEG; p1[r] = keep ? p1[r] : NEG; }
}
__device__ __forceinline__ void bias_near(f32x16& p0, f32x16& p1, int dq, int step, const LAS float* lutcol) {
#pragma unroll
    for (int r = 0; r < 16; ++r) { const int c = (r & 3) + 8 * (r >> 2);
        const int d0 = min(max((dq - c) * step, 0), 128), d1 = min(max((dq - c - 32) * step, 0), 128);
        p0[r] += lutcol[d0 * 16]; p1[r] += lutcol[d1 * 16]; }
}
struct Stage { bf16x8 k0, k1, v0, v1; };
__device__ __forceinline__ void stage_load(Stage& S, const bf16* Kp, const bf16* Vp, size_t ld, int row0, int maxrow, int sr, int sc) {
    const int ra = min(row0 + sr, maxrow), rb = min(row0 + 32 + sr, maxrow);
    S.k0 = *(const bf16x8*)(Kp + (size_t)ra * ld + sc); S.k1 = *(const bf16x8*)(Kp + (size_t)rb * ld + sc);
    S.v0 = *(const bf16x8*)(Vp + (size_t)ra * ld + sc); S.v1 = *(const bf16x8*)(Vp + (size_t)rb * ld + sc);
}
__device__ __forceinline__ void stage_write(const Stage& S, LAS char* Kb, LAS char* Vb, int kws, int vst0, int vst1) {
    *(LAS bf16x8*)(Kb + kws) = S.k0; *(LAS bf16x8*)(Kb + kws + 32 * 256) = S.k1;
    *(LAS bf16x8*)(Vb + vst0) = S.v0; *(LAS bf16x8*)(Vb + vst1) = S.v1;
}
}

struct NsaLane { int wid, lane, r32, hi, ql, j, sr, sc, kws, vst0, vst1, vrd; };
__device__ __forceinline__ NsaLane nsa_lane(const Frame& F) {
    NsaLane L; L.wid = F.wave; L.lane = F.lane; L.r32 = F.lane & 31; L.hi = F.lane >> 5; L.ql = L.r32 >> 2; L.j = L.r32 & 3;
    L.sr = F.tid >> 4; L.sc = (F.tid & 15) * 8; L.kws = FA_KSWZ(L.sr, L.sc * 2); L.vst0 = fa::v_st(L.sr, L.sc); L.vst1 = fa::v_st(32 + L.sr, L.sc); L.vrd = fa::v_rd_base(F.lane);
    return L;
}
__device__ __forceinline__ void nsa_load_q(bf16x8 (&qr)[8], const bf16* P0, int tok0, int g, const NsaLane& L) {
    const bf16* qp = P0 + (size_t)(tok0 + L.wid * 8 + L.ql) * P0LD + (g * 4 + L.j) * 128 + L.hi * 8;
#pragma unroll
    for (int d0 = 0; d0 < 8; ++d0) qr[d0] = *(const bf16x8*)(qp + d0 * 16);
}
__device__ __forceinline__ void nsa_lut(Frame& F, const Args& A) {
    LAS float* lut = (LAS float*)(F.lds + RING_OFF + fa::OFF_LUT);
    for (int i = F.tid; i < 144 * 16; i += 512) { const int n = i >> 4, h = i & 15; lut[i] = A.in[1][rel_bucket(n) * 16 + h]; }
    __syncthreads();
}
template <int MODE>
__device__ __forceinline__ void nsa_store(const fa::f32x16 (&o)[4], float l_reg, LAS float* li_l, const float* GL, float* OACC, bf16* OATT, int tok0, int g, int br, const NsaLane& L) {
    if (L.hi == 0) li_l[L.r32] = l_reg;
    asm volatile("s_waitcnt lgkmcnt(0)" ::: "memory");
#pragma unroll
    for (int r = 0; r < 16; ++r) { const int row = fa::crow(r, L.hi), tok = tok0 + L.wid * 8 + (row >> 2), h = g * 4 + (row & 3);
        const float l = li_l[row]; const float gl = GL[(size_t)tok * 48 + h * 3 + br];
        const float sc = (l > 0.f) ? __builtin_amdgcn_rcpf(l) / (1.0f + __expf(-gl)) : 0.f;
        float* ap = OACC + (size_t)tok * DM + h * 128 + L.r32;
#pragma unroll
        for (int d0 = 0; d0 < 4; ++d0) { float v = o[d0][r] * sc;
            if (MODE == 0) ap[d0 * 32] = v;
            else if (MODE == 1) ap[d0 * 32] += v;
            else { v += ap[d0 * 32]; const float vn = __shfl_xor(v, 1); if ((L.r32 & 1) == 0) *(unsigned*)(OATT + (size_t)tok * DM + h * 128 + d0 * 32 + L.r32) = fa::cvtpk(v, vn); } } }
    asm volatile("s_waitcnt lgkmcnt(0)" ::: "memory");
}

__device__ __forceinline__ void p3a_nsa_cmp(Frame& F, const Args& A) {
    unsigned char* ws = A.ws; const NsaLane L = nsa_lane(F);
    const bf16* P0 = (const bf16*)(ws + WS_P0); const bf16* KCB = (const bf16*)(ws + WS_KCMP); const bf16* VCB = (const bf16*)(ws + WS_VCMP);
    const float* GL = (const float*)(ws + WS_GL); float* OACC = (float*)(ws + WS_Z); unsigned* SELM = (unsigned*)(ws + WS_SELM);
    nsa_lut(F, A);
    LAS char* lds = (LAS char*)(F.lds + RING_OFF);
    LAS float* wsf = (LAS float*)(lds + fa::OFF_WS) + L.wid * 64; LAS float* li_l = wsf; LAS float* al_l = wsf + 32;
    const LAS float* lut = (const LAS float*)(lds + fa::OFF_LUT);
    LAS float* tab = (LAS float*)(lds + fa::OFF_TAB);
    for (int ui = 0; ui < 2 * ((512 - F.vcu + F.G - 1) / F.G); ++ui) {
        const int p = F.vcu + (ui >> 1) * F.G, bg = p >> 6, y = p & 63, qb = (ui & 1) ? 127 - y : y, b = bg >> 2, g = bg & 3;
        const int tok0 = b * SEQ + qb * 64;
        bf16x8 qr[8]; nsa_load_q(qr, P0, tok0, g, L);
        const int trow = qb * 64 + L.wid * 8 + L.ql;
        const int h = g * 4 + L.j; const LAS float* lutcol = lut + h; const float bias_far = lutcol[128 * 16];
        const int nmaxrow = (trow >= 31) ? (trow - 31) >> 4 : -1;
        const int NT = (4 * qb + 3 + 63) >> 6;
        const bf16* Kg = KCB + (size_t)(b * 4 + g) * 512 * 128; const bf16* Vg = VCB + (size_t)(b * 4 + g) * 512 * 128;
        for (int i = F.tid; i < 64 * fa::TABLD; i += 512) tab[i] = 0.f;
        float m_reg = -1e30f, l_reg = 0.f;
        fa::Stage S;
        const int rem16 = (trow >= 31) ? ((trow - 31) & 15) : 0;
        fa::stage_load(S, Kg, Vg, 128, 0, 511, L.sr, L.sc); asm volatile("s_waitcnt vmcnt(0)" ::: "memory");
        fa::stage_write(S, lds + fa::OFF_K, lds + fa::OFF_V, L.kws, L.vst0, L.vst1);
        __syncthreads();
#pragma unroll 1
        for (int t = 0; t < NT; ++t) {
            const int buf = t & 1;
            if (t + 1 < NT) fa::stage_load(S, Kg, Vg, 128, (t + 1) * 64, 511, L.sr, L.sc);
            fa::f32x16 p0, p1;
            const bool farT = (qb * 64 + L.wid * 8) - 31 - 16 * (t * 64 + 63) >= 128;
            fa::qkt(p0, p1, lds + fa::OFF_K + buf * fa::SHM_K, L.r32, L.hi, qr, farT ? bias_far : 0.f);
            const int dq = nmaxrow - t * 64 - 4 * L.hi;
            if (!farT) fa::bias_near(p0, p1, dq, 16, lutcol + rem16 * 16);
            fa::mask_tile(p0, p1, dq, 0x40000000u);
            float alpha; fa::partialSM(p0, p1, m_reg, alpha);
            float ps = 0.f;
#pragma unroll
            for (int r = 0; r < 16; ++r) ps += p0[r] + p1[r];
            { auto rr = __builtin_amdgcn_permlane32_swap(__float_as_uint(ps), __float_as_uint(ps), false, false); ps = __uint_as_float(rr[0]) + __uint_as_float(rr[1]); }
            l_reg = l_reg * alpha + ps;
            if (t + 1 < NT) { asm volatile("s_waitcnt vmcnt(0)" ::: "memory"); fa::stage_write(S, lds + fa::OFF_K + (buf ^ 1) * fa::SHM_K, lds + fa::OFF_V + (buf ^ 1) * fa::SHM_V, L.kws, L.vst0, L.vst1); }
            __syncthreads();
        }
        fa::f32x16 o[4];
#pragma unroll
        for (int d = 0; d < 4; ++d)
#pragma unroll
            for (int r = 0; r < 16; ++r) o[d][r] = 0.f;
        fa::stage_load(S, Kg, Vg, 128, 0, 511, L.sr, L.sc); asm volatile("s_waitcnt vmcnt(0)" ::: "memory");
        fa::stage_write(S, lds + fa::OFF_K, lds + fa::OFF_V, L.kws, L.vst0, L.vst1);
        __syncthreads();
        const float inv_l = (l_reg > 0.f) ? 1.0f / l_reg : 0.f; const float mnL = -m_reg * fa::C2;
#pragma unroll 1
        for (int t = 0; t < NT; ++t) {
            const int buf = t & 1;
            if (t + 1 < NT) fa::stage_load(S, Kg, Vg, 128, (t + 1) * 64, 511, L.sr, L.sc);
            fa::f32x16 p0, p1;
            const bool farT = (qb * 64 + L.wid * 8) - 31 - 16 * (t * 64 + 63) >= 128;
            fa::qkt(p0, p1, lds + fa::OFF_K + buf * fa::SHM_K, L.r32, L.hi, qr, farT ? bias_far : 0.f);
            const int dq = nmaxrow - t * 64 - 4 * L.hi;
            if (!farT) fa::bias_near(p0, p1, dq, 16, lutcol + rem16 * 16);
            fa::mask_tile(p0, p1, dq, 0x40000000u);
#pragma unroll
            for (int r = 0; r < 16; ++r) { p0[r] = __builtin_amdgcn_exp2f(fmaf(p0[r], fa::C2, mnL)) * inv_l; p1[r] = __builtin_amdgcn_exp2f(fmaf(p1[r], fa::C2, mnL)) * inv_l; }
            LAS float* tb = tab + (L.wid * 8 + L.ql) * fa::TABLD + t * 16 + L.hi;
#pragma unroll
            for (int half = 0; half < 2; ++half)
#pragma unroll
                for (int gq = 0; gq < 4; ++gq) { const fa::f32x16& pp = half ? p1 : p0;
                    float s4 = pp[4 * gq] + pp[4 * gq + 1] + pp[4 * gq + 2] + 0.5f * pp[4 * gq + 3], cr = 0.5f * pp[4 * gq + 3];
                    s4 += __shfl_xor(s4, 1); s4 += __shfl_xor(s4, 2); cr += __shfl_xor(cr, 1); cr += __shfl_xor(cr, 2);
                    if (L.j == 0) { __hip_atomic_fetch_add(tb + half * 8 + 2 * gq, s4, __ATOMIC_RELAXED, __HIP_MEMORY_SCOPE_WORKGROUP); __hip_atomic_fetch_add(tb + half * 8 + 2 * gq + 1, cr, __ATOMIC_RELAXED, __HIP_MEMORY_SCOPE_WORKGROUP); } }
            bf16x8 a0, a1, a2, a3; (void)fa::finishSM(p0, p1, a0, a1, a2, a3);
            fa::pv_tile(o, (int)(uintptr_t)(lds + fa::OFF_V + buf * fa::SHM_V) + L.vrd, a0, a1, a2, a3);
            if (t + 1 < NT) { asm volatile("s_waitcnt vmcnt(0)" ::: "memory"); fa::stage_write(S, lds + fa::OFF_K + (buf ^ 1) * fa::SHM_K, lds + fa::OFF_V + (buf ^ 1) * fa::SHM_V, L.kws, L.vst0, L.vst1); }
            __syncthreads();
        }
        nsa_store<0>(o, (l_reg > 0.f) ? 1.0f : 0.f, li_l, GL, OACC, nullptr, tok0, g, 0, L);
        __syncthreads();
        for (int qi = 0; qi < 8; ++qi) { const int ql = L.wid * 8 + qi;
            bool s0 = false, s1 = false;
            if (qb < 16) { s0 = (L.lane <= qb); }
            else {
                float v0 = (L.lane >= 1 && L.lane <= qb - 2) ? tab[ql * fa::TABLD + L.lane] : -1.0f, v1 = (L.lane + 64 <= qb - 2) ? tab[ql * fa::TABLD + L.lane + 64] : -1.0f;
                s0 = (L.lane == 0) || (L.lane == qb) || (L.lane == qb - 1); s1 = (L.lane + 64 == qb) || (L.lane + 64 == qb - 1);
                if (s0) v0 = -3e38f; if (s1) v1 = -3e38f;
#pragma unroll 1
                for (int k = 0; k < 13; ++k) { float bv = v0; int bi = L.lane; if (v1 > v0) { bv = v1; bi = L.lane + 64; }
#pragma unroll
                    for (int of = 1; of < 64; of <<= 1) { const float ov = __shfl_xor(bv, of); const int oi = __shfl_xor(bi, of); if (ov > bv || (ov == bv && oi < bi)) { bv = ov; bi = oi; } }
                    if (bi == L.lane) { v0 = -3e38f; s0 = true; } if (bi == L.lane + 64) { v1 = -3e38f; s1 = true; } }
            }
            const unsigned long long b0 = __ballot(s0), b1 = __ballot(s1);
            if (L.lane == 0) { uint4 mv; mv.x = (unsigned)b0; mv.y = (unsigned)(b0 >> 32); mv.z = (unsigned)b1; mv.w = (unsigned)(b1 >> 32); *(uint4*)(SELM + ((size_t)(tok0 + ql) * 4 + g) * 4) = mv; }
        }
        __syncthreads();
    }
}
__device__ __forceinline__ void p3b_nsa_sel(Frame& F, const Args& A) {
    unsigned char* ws = A.ws; const NsaLane L = nsa_lane(F);
    const bf16* P0 = (const bf16*)(ws + WS_P0); const float* GL = (const float*)(ws + WS_GL); float* OACC = (float*)(ws + WS_Z); const unsigned* SELM = (const unsigned*)(ws + WS_SELM);
    nsa_lut(F, A);
    LAS char* lds = (LAS char*)(F.lds + RING_OFF);
    LAS float* wsf = (LAS float*)(lds + fa::OFF_WS) + L.wid * 64; LAS float* li_l = wsf; LAS float* al_l = wsf + 32;
    const LAS float* lut = (const LAS float*)(lds + fa::OFF_LUT);
    for (int ui = 0; ui < 2 * ((512 - F.vcu + F.G - 1) / F.G); ++ui) {
        const int p = F.vcu + (ui >> 1) * F.G, bg = p >> 6, y = p & 63, qb = (ui & 1) ? 127 - y : y, b = bg >> 2, g = bg & 3;
        const int tok0 = b * SEQ + qb * 64;
        bf16x8 qr[8]; nsa_load_q(qr, P0, tok0, g, L);
        const int trow = qb * 64 + L.wid * 8 + L.ql;
        const int h = g * 4 + L.j; const LAS float* lutcol = lut + h; const float bias_far = lutcol[128 * 16];
        const uint4 mv = *(const uint4*)(SELM + ((size_t)(tok0 + L.wid * 8 + L.ql) * 4 + g) * 4);
        const bf16* Kg = P0 + (size_t)b * SEQ * P0LD + COL_KS + g * 128; const bf16* Vg = P0 + (size_t)b * SEQ * P0LD + COL_VS + g * 128;
        const int NT = qb + 1;
        float m_reg = -1e30f, l_reg = 0.f; fa::f32x16 o[4];
#pragma unroll
        for (int d = 0; d < 4; ++d)
#pragma unroll
            for (int r = 0; r < 16; ++r) o[d][r] = 0.f;
        fa::Stage S;
        fa::stage_load(S, Kg, Vg, P0LD, 0, SEQ - 1, L.sr, L.sc); asm volatile("s_waitcnt vmcnt(0)" ::: "memory");
        fa::stage_write(S, lds + fa::OFF_K, lds + fa::OFF_V, L.kws, L.vst0, L.vst1);
        __syncthreads();
#pragma unroll 1
        for (int t = 0; t < NT; ++t) {
            const int buf = t & 1;
            if (t + 1 < NT) fa::stage_load(S, Kg, Vg, P0LD, (t + 1) * 64, SEQ - 1, L.sr, L.sc);
            fa::f32x16 p0, p1;
            const bool farT = (qb * 64 + L.wid * 8) - (t * 64 + 63) >= 128;
            fa::qkt(p0, p1, lds + fa::OFF_K + buf * fa::SHM_K, L.r32, L.hi, qr, farT ? bias_far : 0.f);
            const int dq = trow - t * 64 - 4 * L.hi;
            if (!farT) fa::bias_near(p0, p1, dq, 1, lutcol);
            const unsigned word = (t < 32) ? mv.x : (t < 64) ? mv.y : (t < 96) ? mv.z : mv.w;
            fa::mask_all(p0, p1, ((word >> (t & 31)) & 1u) != 0u);
            if (t == qb) fa::mask_tile(p0, p1, dq, 0x40000000u);
            float alpha; fa::partialSM(p0, p1, m_reg, alpha);
            fa::rescale(o, alpha, al_l, L.r32, L.hi);
            bf16x8 a0, a1, a2, a3; const float ps = fa::finishSM(p0, p1, a0, a1, a2, a3); l_reg = l_reg * alpha + ps;
            fa::pv_tile(o, (int)(uintptr_t)(lds + fa::OFF_V + buf * fa::SHM_V) + L.vrd, a0, a1, a2, a3);
            if (t + 1 < NT) { asm volatile("s_waitcnt vmcnt(0)" ::: "memory"); fa::stage_write(S, lds + fa::OFF_K + (buf ^ 1) * fa::SHM_K, lds + fa::OFF_V + (buf ^ 1) * fa::SHM_V, L.kws, L.vst0, L.vst1); }
            __syncthreads();
        }
        nsa_store<1>(o, l_reg, li_l, GL, OACC, nullptr, tok0, g, 1, L);
        __syncthreads();
    }
}
__device__ __forceinline__ void p3c_nsa_win(Frame& F, const Args& A) {
    unsigned char* ws = A.ws; const NsaLane L = nsa_lane(F);
    const bf16* P0 = (const bf16*)(ws + WS_P0); const float* GL = (const float*)(ws + WS_GL); float* OACC = (float*)(ws + WS_Z); bf16* OATT = (bf16*)(ws + WS_OATT0);
    nsa_lut(F, A);
    LAS char* lds = (LAS char*)(F.lds + RING_OFF);
    LAS float* wsf = (LAS float*)(lds + fa::OFF_WS) + L.wid * 64; LAS float* li_l = wsf; LAS float* al_l = wsf + 32;
    const LAS float* lut = (const LAS float*)(lds + fa::OFF_LUT);
    for (int u = F.vcu; u < 1024; u += F.G) {
        const int bg = u >> 7, qb = u & 127, b = bg >> 2, g = bg & 3;
        const int tok0 = b * SEQ + qb * 64;
        bf16x8 qr[8]; nsa_load_q(qr, P0, tok0, g, L);
        const int trow = qb * 64 + L.wid * 8 + L.ql;
        const int h = g * 4 + L.j; const LAS float* lutcol = lut + h; const float bias_far = lutcol[128 * 16];
        const bf16* Kg = P0 + (size_t)b * SEQ * P0LD + COL_KW + g * 128; const bf16* Vg = P0 + (size_t)b * SEQ * P0LD + COL_VW + g * 128;
        const int t0 = max(0, qb - 8), NT = qb - t0 + 1;
        float m_reg = -1e30f, l_reg = 0.f; fa::f32x16 o[4];
#pragma unroll
        for (int d = 0; d < 4; ++d)
#pragma unroll
            for (int r = 0; r < 16; ++r) o[d][r] = 0.f;
        fa::Stage S;
        fa::stage_load(S, Kg, Vg, P0LD, t0 * 64, SEQ - 1, L.sr, L.sc); asm volatile("s_waitcnt vmcnt(0)" ::: "memory");
        fa::stage_write(S, lds + fa::OFF_K, lds + fa::OFF_V, L.kws, L.vst0, L.vst1);
        __syncthreads();
#pragma unroll 1
        for (int tt = 0; tt < NT; ++tt) {
            const int buf = tt & 1, t = t0 + tt;
            if (tt + 1 < NT) fa::stage_load(S, Kg, Vg, P0LD, (t + 1) * 64, SEQ - 1, L.sr, L.sc);
            fa::f32x16 p0, p1;
            const bool farT = (qb * 64 + L.wid * 8) - (t * 64 + 63) >= 128;
            fa::qkt(p0, p1, lds + fa::OFF_K + buf * fa::SHM_K, L.r32, L.hi, qr, farT ? bias_far : 0.f);
            const int dq = trow - t * 64 - 4 * L.hi;
            if (!farT) fa::bias_near(p0, p1, dq, 1, lutcol);
            if (t == qb || t == t0) fa::mask_tile(p0, p1, dq, 512u);
            float alpha; fa::partialSM(p0, p1, m_reg, alpha);
            fa::rescale(o, alpha, al_l, L.r32, L.hi);
            bf16x8 a0, a1, a2, a3; const float ps = fa::finishSM(p0, p1, a0, a1, a2, a3); l_reg = l_reg * alpha + ps;
            fa::pv_tile(o, (int)(uintptr_t)(lds + fa::OFF_V + buf * fa::SHM_V) + L.vrd, a0, a1, a2, a3);
            if (tt + 1 < NT) { asm volatile("s_waitcnt vmcnt(0)" ::: "memory"); fa::stage_write(S, lds + fa::OFF_K + (buf ^ 1) * fa::SHM_K, lds + fa::OFF_V + (buf ^ 1) * fa::SHM_V, L.kws, L.vst0, L.vst1); }
            __syncthreads();
        }
        nsa_store<2>(o, l_reg, li_l, GL, OACC, OATT, tok0, g, 2, L);
        __syncthreads();
    }
}

template <bool ROUTE>
__device__ __forceinline__ void ln_phase(Frame& F, const Args& A, const float* Z, const float* gam, const float* bet, float* XF, bf16* XB) {
    const int gw = F.vcu * NWAVES + F.wave, NGW = F.G * NWAVES, lane = F.lane;
    LAS float* wrl = (LAS float*)(F.lds + RING_OFF);
    if (ROUTE) { for (int i = F.tid; i < DM * 8 / 4; i += 512) *(LAS f32x4*)(wrl + i * 4) = *(const f32x4*)(A.in[18] + i * 4); __syncthreads(); }
    for (int row = gw; row < NTOK; row += NGW) {
        const f32x4* zr = (const f32x4*)(Z + (size_t)row * DM) + lane;
        f32x4 v[8]; float s = 0.f;
#pragma unroll
        for (int j = 0; j < 8; ++j) { v[j] = zr[64 * j]; s += (v[j][0] + v[j][1]) + (v[j][2] + v[j][3]); }
        const float mean = wave_sum(s) * (1.f / DM); float s2 = 0.f;
#pragma unroll
        for (int j = 0; j < 8; ++j) { v[j] = v[j] - mean; s2 += (v[j][0] * v[j][0] + v[j][1] * v[j][1]) + (v[j][2] * v[j][2] + v[j][3] * v[j][3]); }
        const float rstd = 1.f / sqrtf(wave_sum(s2) * (1.f / DM) + LN_EPS);
        float lg[8];
#pragma unroll
        for (int e = 0; e < 8; ++e) lg[e] = 0.f;
#pragma unroll
        for (int j = 0; j < 8; ++j) { const int c = 4 * lane + 256 * j; const f32x4 gg = *(const f32x4*)(gam + c), bb = *(const f32x4*)(bet + c);
            const f32x4 x = v[j] * rstd * gg + bb;
            *(f32x4*)(XF + (size_t)row * DM + c) = x;
            uint2 o; o.x = pk2(x[0], x[1]); o.y = pk2(x[2], x[3]); *(uint2*)(XB + (size_t)row * DM + c) = o;
            asm volatile("" ::: "memory");
            if (ROUTE) { const LAS float* wr = wrl + c * 8;
#pragma unroll
                for (int q = 0; q < 4; ++q) { const f32x4 w0 = *(const LAS f32x4*)(wr + q * 8), w1 = *(const LAS f32x4*)(wr + q * 8 + 4);
                    lg[0] += x[q] * w0[0]; lg[1] += x[q] * w0[1]; lg[2] += x[q] * w0[2]; lg[3] += x[q] * w0[3]; lg[4] += x[q] * w1[0]; lg[5] += x[q] * w1[1]; lg[6] += x[q] * w1[2]; lg[7] += x[q] * w1[3]; }  asm volatile("" ::: "memory"); }
        }
        if (ROUTE) {
#pragma unroll
            for (int e = 0; e < 8; ++e) lg[e] = wave_sum(lg[e]) + A.in[19][e];
            int e0 = 0; float l0 = lg[0];
#pragma unroll
            for (int e = 1; e < 8; ++e) if (lg[e] > l0) { l0 = lg[e]; e0 = e; }
            int e1 = -1; float l1 = -3e38f;
#pragma unroll
            for (int e = 0; e < 8; ++e) if (e != e0 && lg[e] > l1) { l1 = lg[e]; e1 = e; }
            const float w0 = 1.0f / (1.0f + __expf(l1 - l0)), w1 = 1.0f - w0;
            if (lane == 0) {
                const unsigned p0 = __hip_atomic_fetch_add((unsigned*)(F.ctl + CW_MOECNT + 64 * e0), 1u, __ATOMIC_RELAXED, __HIP_MEMORY_SCOPE_AGENT);
                const unsigned p1 = __hip_atomic_fetch_add((unsigned*)(F.ctl + CW_MOECNT + 64 * e1), 1u, __ATOMIC_RELAXED, __HIP_MEMORY_SCOPE_AGENT);
                int* re = (int*)(A.ws + WS_ROUTE); int* rp = re + 2 * NTOK; float* rw = (float*)(rp + 2 * NTOK);
                re[2 * row] = e0; re[2 * row + 1] = e1; rp[2 * row] = (int)p0; rp[2 * row + 1] = (int)p1; rw[2 * row] = w0; rw[2 * row + 1] = w1;
            }
        }
    }
}

__device__ __forceinline__ void ln_route_phase(Frame& F, const Args& A, const float* Z, const float* gam, const float* bet, float* XF, bf16* XB) {
    const int gw = F.vcu * NWAVES + F.wave, NGW = F.G * NWAVES, lane = F.lane;
    LAS float* wrl = (LAS float*)(F.lds + RING_OFF);
    LAS float* rowb = (LAS float*)(F.lds + RING_OFF + 65536 + F.wave * 8192);
    for (int i = F.tid; i < DM * 8 / 4; i += 512) *(LAS f32x4*)(wrl + i * 4) = *(const f32x4*)(A.in[18] + i * 4);
    __syncthreads();
    for (int row = gw; row < NTOK; row += NGW) {
        float s = 0.f, s2 = 0.f;
#pragma unroll 1
        for (int j = 0; j < 8; ++j) { const f32x4 v = *(const f32x4*)(Z + (size_t)row * DM + 4 * lane + 256 * j); *(LAS f32x4*)(rowb + 4 * lane + 256 * j) = v;
            s += (v[0] + v[1]) + (v[2] + v[3]); }
        const float mean = wave_sum(s) * (1.f / DM);
#pragma unroll 1
        for (int j = 0; j < 8; ++j) { const f32x4 v = *(const LAS f32x4*)(rowb + 4 * lane + 256 * j) - mean; s2 += (v[0] * v[0] + v[1] * v[1]) + (v[2] * v[2] + v[3] * v[3]); }
        const float rstd = 1.f / sqrtf(wave_sum(s2) * (1.f / DM) + LN_EPS);
        float lg[8];
#pragma unroll
        for (int e = 0; e < 8; ++e) lg[e] = 0.f;
#pragma unroll 1
        for (int j = 0; j < 8; ++j) { const int c = 4 * lane + 256 * j; const f32x4 gg = *(const f32x4*)(gam + c), bb = *(const f32x4*)(bet + c);
            const f32x4 x = (*(const LAS f32x4*)(rowb + c) - mean) * rstd * gg + bb;
            *(f32x4*)(XF + (size_t)row * DM + c) = x;
            uint2 o; o.x = pk2(x[0], x[1]); o.y = pk2(x[2], x[3]); *(uint2*)(XB + (size_t)row * DM + c) = o;
            const LAS float* wr = wrl + c * 8;
#pragma unroll
            for (int q = 0; q < 4; ++q) { const f32x4 w0 = *(const LAS f32x4*)(wr + q * 8), w1 = *(const LAS f32x4*)(wr + q * 8 + 4);
                lg[0] += x[q] * w0[0]; lg[1] += x[q] * w0[1]; lg[2] += x[q] * w0[2]; lg[3] += x[q] * w0[3]; lg[4] += x[q] * w1[0]; lg[5] += x[q] * w1[1]; lg[6] += x[q] * w1[2]; lg[7] += x[q] * w1[3]; } }
#pragma unroll
        for (int e = 0; e < 8; ++e) lg[e] = wave_sum(lg[e]) + A.in[19][e];
        int e0 = 0; float l0 = lg[0];
#pragma unroll
        for (int e = 1; e < 8; ++e) if (lg[e] > l0) { l0 = lg[e]; e0 = e; }
        int e1 = -1; float l1 = -3e38f;
#pragma unroll
        for (int e = 0; e < 8; ++e) if (e != e0 && lg[e] > l1) { l1 = lg[e]; e1 = e; }
        const float w0 = 1.0f / (1.0f + __expf(l1 - l0)), w1 = 1.0f - w0;
        if (lane == 0) {
            const unsigned p0 = __hip_atomic_fetch_add((unsigned*)(F.ctl + CW_MOECNT + 64 * e0), 1u, __ATOMIC_RELAXED, __HIP_MEMORY_SCOPE_AGENT);
            const unsigned p1 = __hip_atomic_fetch_add((unsigned*)(F.ctl + CW_MOECNT + 64 * e1), 1u, __ATOMIC_RELAXED, __HIP_MEMORY_SCOPE_AGENT);
            int* re = (int*)(A.ws + WS_ROUTE); int* rp = re + 2 * NTOK; float* rw = (float*)(rp + 2 * NTOK);
            re[2 * row] = e0; re[2 * row + 1] = e1; rp[2 * row] = (int)p0; rp[2 * row + 1] = (int)p1; rw[2 * row] = w0; rw[2 * row + 1] = w1;
        }
        WSYNC();
    }
    __syncthreads();
}

__device__ __forceinline__ void p10_dsa_prep(Frame& F, const Args& A) {
    unsigned char* ws = A.ws; const int lane = F.lane;
    const int gw = F.vcu * NWAVES + F.wave, NGW = F.G * NWAVES;
    { const float* CR = (const float*)(ws + WS_CRAW); bf16* CN = (bf16*)(ws + WS_CN); const f32x4 gg = *(const f32x4*)(A.in[11] + 4 * lane);
      for (int row = gw; row < NTOK; row += NGW) { const f32x4 v = *(const f32x4*)(CR + (size_t)row * KVR + 4 * lane);
          const float ss = wave_sum(v[0] * v[0] + v[1] * v[1] + v[2] * v[2] + v[3] * v[3]); const float r = 1.f / sqrtf(ss * (1.f / KVR) + RMS_EPS);
          uint2 o; o.x = pk2(v[0] * r * gg[0], v[1] * r * gg[1]); o.y = pk2(v[2] * r * gg[2], v[3] * r * gg[3]); *(uint2*)(CN + (size_t)row * KVR + 4 * lane) = o; } }
    const bf16* Q = (const bf16*)(ws + WS_Q); const bf16* UKT = (const bf16*)(ws + WS_W_UK); bf16* QL = (bf16*)(ws + WS_QLAT);
    const int r16 = lane & 15, kq = lane >> 4; const float sc = 0.08838834764831845f;
    for (int it = gw; it < 512 * 16 * 4; it += NGW) {
        const int nc = it & 3, h = (it >> 2) & 15, mt = it >> 6;
        f32x4 acc[2][4];
#pragma unroll
        for (int m = 0; m < 2; ++m)
#pragma unroll
            for (int n = 0; n < 4; ++n) acc[m][n] = (f32x4){0.f, 0.f, 0.f, 0.f};
#pragma unroll
        for (int ks = 0; ks < 4; ++ks) { s8v af[2], bfr[4];
#pragma unroll
            for (int m = 0; m < 2; ++m) af[m] = ld_frag(Q + (size_t)(mt * 32 + m * 16 + r16) * DM + h * 128 + ks * 32 + kq * 8);
#pragma unroll
            for (int n = 0; n < 4; ++n) bfr[n] = ld_frag(UKT + ((size_t)h * 256 + nc * 64 + n * 16 + r16) * 128 + ks * 32 + kq * 8);
#pragma unroll
            for (int m = 0; m < 2; ++m)
#pragma unroll
                for (int n = 0; n < 4; ++n) acc[m][n] = __builtin_amdgcn_mfma_f32_16x16x32_bf16(af[m], bfr[n], acc[m][n], 0, 0, 0); }
#pragma unroll
        for (int m = 0; m < 2; ++m)
#pragma unroll
            for (int n = 0; n < 4; ++n)
#pragma unroll
                for (int j = 0; j < 4; ++j) QL[(size_t)(mt * 32 + m * 16 + kq * 4 + j) * 4096 + h * 256 + nc * 64 + n * 16 + r16] = (bf16)f2bf(acc[m][n][j] * sc);
    }
}
__device__ __forceinline__ void p12_dsa_uv(Frame& F, const Args& A) {
    unsigned char* ws = A.ws; const int lane = F.lane;
    const int gw = F.vcu * NWAVES + F.wave, NGW = F.G * NWAVES;
    const bf16* OL = (const bf16*)(ws + WS_OLAT); const bf16* UVT = (const bf16*)(ws + WS_W_UV); bf16* O = (bf16*)(ws + WS_OATT1);
    const int r16 = lane & 15, kq = lane >> 4;
    for (int it = gw; it < 512 * 16 * 2; it += NGW) {
        const int nc = it & 1, h = (it >> 1) & 15, mt = it >> 5;
        f32x4 acc[2][4];
#pragma unroll
        for (int m = 0; m < 2; ++m)
#pragma unroll
            for (int n = 0; n < 4; ++n) acc[m][n] = (f32x4){0.f, 0.f, 0.f, 0.f};
#pragma unroll
        for (int ks = 0; ks < 8; ++ks) { s8v af[2], bfr[4];
#pragma unroll
            for (int m = 0; m < 2; ++m) af[m] = ld_frag(OL + (size_t)(mt * 32 + m * 16 + r16) * 4096 + h * 256 + ks * 32 + kq * 8);
#pragma unroll
            for (int n = 0; n < 4; ++n) bfr[n] = ld_frag(UVT + ((size_t)h * 128 + nc * 64 + n * 16 + r16) * 256 + ks * 32 + kq * 8);
#pragma unroll
            for (int m = 0; m < 2; ++m)
#pragma unroll
                for (int n = 0; n < 4; ++n) acc[m][n] = __builtin_amdgcn_mfma_f32_16x16x32_bf16(af[m], bfr[n], acc[m][n], 0, 0, 0); }
#pragma unroll
        for (int m = 0; m < 2; ++m)
#pragma unroll
            for (int n = 0; n < 4; ++n)
#pragma unroll
                for (int j = 0; j < 4; ++j) O[(size_t)(mt * 32 + m * 16 + kq * 4 + j) * DM + h * 128 + nc * 64 + n * 16 + r16] = (bf16)f2bf(acc[m][n][j]);
    }
}

__device__ __forceinline__ unsigned f2key(float f) { const unsigned u = __float_as_uint(f); return (u & 0x80000000u) ? ~u : (u | 0x80000000u); }
__device__ __forceinline__ void p11_dsa_attn(Frame& F, const Args& A) {
    unsigned char* ws = A.ws; const int tid = F.tid, lane = F.lane, wave = F.wave;
    const float* KIWI = (const float*)(ws + WS_KIWI); const bf16* QI = (const bf16*)(ws + WS_QI); const bf16* CN = (const bf16*)(ws + WS_CN);
    const bf16* QL = (const bf16*)(ws + WS_QLAT); bf16* OL = (bf16*)(ws + WS_OLAT);
    LAS float* sc = (LAS float*)(F.lds + RING_OFF);
    LAS float* qif = (LAS float*)(F.lds + RING_OFF + 32768);
    LAS float* wif = qif + 512;
    LAS unsigned* hist = (LAS unsigned*)(wif + 8);
    LAS unsigned* misc = hist + 256;
    LAS int* idxl = (LAS int*)(misc + 8);
    LAS int* tiel = idxl + 256;
    LAS float* ql = (LAS float*)(tiel + 512);
    LAS float* pS = ql + 4096;
    LAS float* lut = pS + 4096;
    for (int i = tid; i < 129 * 16; i += 512) { const int n = i >> 4, h = i & 15; lut[i] = A.in[1][rel_bucket(n) * 16 + h]; }
    __syncthreads();
    for (int tok = F.vcu; tok < NTOK; tok += F.G) {
        const int b = tok >> 13, t = tok & (SEQ - 1), nkeys = t + 1;
        qif[tid] = bf2f(QI[(size_t)tok * 512 + tid]);
        if (tid < 8) wif[tid] = KIWI[(size_t)tok * 128 + 64 + tid] * 0.35355339059327373f;
        for (int i = tid; i < 4096; i += 512) ql[i] = bf2f(QL[(size_t)tok * 4096 + i]);
        __syncthreads();
        for (int k = tid; k < nkeys; k += 512) {
            const float* kr = KIWI + (size_t)(b * SEQ + k) * 128; float d[8];
#pragma unroll
            for (int h = 0; h < 8; ++h) d[h] = 0.f;
#pragma unroll 4
            for (int c = 0; c < 16; ++c) { const f32x4 kv = *(const f32x4*)(kr + c * 4);
#pragma unroll
                for (int h = 0; h < 8; ++h) { const f32x4 q = *(const LAS f32x4*)(qif + h * 64 + c * 4); d[h] += kv[0] * q[0] + kv[1] * q[1] + kv[2] * q[2] + kv[3] * q[3]; } }
            float s = 0.f;
#pragma unroll
            for (int h = 0; h < 8; ++h) s += wif[h] * fmaxf(d[h], 0.f);
            sc[k] = s + 0.0f;
        }
        if (tid == 0) { misc[0] = 0u; misc[1] = TOPK; misc[2] = 0u; misc[3] = 0u; }
        __syncthreads();
        int cnt;
        if (nkeys <= TOPK) { if (tid < nkeys) idxl[tid] = tid; cnt = nkeys; }
        else {
            unsigned prefix = 0u, pmask = 0u;
            for (int pass = 0; pass < 4; ++pass) {
                const int shift = 24 - 8 * pass;
                if (tid < 256) hist[tid] = 0u;
                __syncthreads();
                for (int k = tid; k < nkeys; k += 512) { const unsigned u = f2key(sc[k]); if ((u & pmask) == prefix) __hip_atomic_fetch_add(&hist[(u >> shift) & 255u], 1u, __ATOMIC_RELAXED, __HIP_MEMORY_SCOPE_WORKGROUP); }
                __syncthreads();
                if (tid == 0) { unsigned need = misc[1], cum = 0u; int bsel = 0;
                    for (int bb = 255; bb >= 0; --bb) { const unsigned hcnt = hist[bb]; if (cum + hcnt >= need) { bsel = bb; break; } cum += hcnt; }
                    misc[1] = need - cum; misc[0] = prefix | ((unsigned)bsel << shift); }
                __syncthreads();
                prefix = misc[0]; pmask |= (255u << shift);
                __syncthreads();
            }
            const unsigned T = prefix; const unsigned needtie = misc[1];
            for (int k = tid; k < nkeys; k += 512) { const unsigned u = f2key(sc[k]);
                if (u > T) { const unsigned p = __hip_atomic_fetch_add(&misc[2], 1u, __ATOMIC_RELAXED, __HIP_MEMORY_SCOPE_WORKGROUP); idxl[p] = k; }
                else if (u == T) { const unsigned p = __hip_atomic_fetch_add(&misc[3], 1u, __ATOMIC_RELAXED, __HIP_MEMORY_SCOPE_WORKGROUP); if (p < 512u) tiel[p] = k; } }
            __syncthreads();
            if (tid == 0) { unsigned base = misc[2]; int nt = (int)min(misc[3], 512u); int last = -1;
                for (unsigned q = 0; q < needtie; ++q) { int best = 0x7fffffff; for (int i = 0; i < nt; ++i) { const int v = tiel[i]; if (v > last && v < best) best = v; } idxl[base + q] = best; last = best; } }
            __syncthreads();
            cnt = TOPK;
        }
        __syncthreads();
        { const int i = tid & 255, hg = tid >> 8;
          if (i < cnt) { const int key = idxl[i]; const bf16* cr = CN + (size_t)(b * SEQ + key) * KVR; float acc[8];
#pragma unroll
              for (int hh = 0; hh < 8; ++hh) acc[hh] = 0.f;
#pragma unroll 2
              for (int c = 0; c < 32; ++c) { const v4u kv = *(const v4u*)(cr + c * 8);
                  const float k0 = bflo(kv.x), k1 = bfhi(kv.x), k2 = bflo(kv.y), k3 = bfhi(kv.y), k4 = bflo(kv.z), k5 = bfhi(kv.z), k6 = bflo(kv.w), k7 = bfhi(kv.w);
#pragma unroll
                  for (int hh = 0; hh < 8; ++hh) { const LAS float* qp = ql + (hg * 8 + hh) * 256 + c * 8; const f32x4 a = *(const LAS f32x4*)qp, bq = *(const LAS f32x4*)(qp + 4);
                      acc[hh] += k0 * a[0] + k1 * a[1] + k2 * a[2] + k3 * a[3] + k4 * bq[0] + k5 * bq[1] + k6 * bq[2] + k7 * bq[3]; } }
              const int dist = min(t - key, 128);
#pragma unroll
              for (int hh = 0; hh < 8; ++hh) pS[(hg * 8 + hh) * 256 + i] = acc[hh] + lut[dist * 16 + hg * 8 + hh];
          } else {
#pragma unroll
              for (int hh = 0; hh < 8; ++hh) pS[(hg * 8 + hh) * 256 + i] = -1e30f; } }
        __syncthreads();
#pragma unroll
        for (int hh = 0; hh < 2; ++hh) { LAS float* pr = pS + (wave * 2 + hh) * 256; float v[4]; float mx = -1e30f;
#pragma unroll
            for (int q = 0; q < 4; ++q) { v[q] = pr[lane + 64 * q]; mx = fmaxf(mx, v[q]); }
            mx = wave_max(mx); float sum = 0.f;
#pragma unroll
            for (int q = 0; q < 4; ++q) { v[q] = (lane + 64 * q < cnt) ? __expf(v[q] - mx) : 0.f; sum += v[q]; }
            sum = wave_sum(sum); const float inv = 1.0f / sum;
#pragma unroll
            for (int q = 0; q < 4; ++q) pr[lane + 64 * q] = v[q] * inv; }
        __syncthreads();
        { const int c = tid & 255, hg = tid >> 8; float acc[8];
#pragma unroll
          for (int hh = 0; hh < 8; ++hh) acc[hh] = 0.f;
#pragma unroll 4
          for (int i = 0; i < cnt; ++i) { const float cv = bf2f(CN[(size_t)(b * SEQ + idxl[i]) * KVR + c]);
#pragma unroll
              for (int hh = 0; hh < 8; ++hh) acc[hh] += pS[(hg * 8 + hh) * 256 + i] * cv; }
#pragma unroll
          for (int hh = 0; hh < 8; ++hh) OL[(size_t)tok * 4096 + (hg * 8 + hh) * 256 + c] = (bf16)f2bf(acc[hh]); }
        __syncthreads();
    }
}

struct MoeTiles { int tend[8]; int pstart[8]; int MT; };
__device__ __forceinline__ void moe_tiles(Frame& F, MoeTiles& T) {
    int acc = 0;
#pragma unroll
    for (int e = 0; e < 8; ++e) { const int c = (int)__builtin_amdgcn_readfirstlane(__hip_atomic_load((unsigned*)(F.ctl + CW_MOECNT + 64 * e), __ATOMIC_RELAXED, __HIP_MEMORY_SCOPE_AGENT));
        T.pstart[e] = acc * 256; acc += (c + 255) >> 8; T.tend[e] = acc; }
    T.MT = acc;
}
__device__ __forceinline__ void p15_gather(Frame& F, const Args& A) {
    MoeTiles T; moe_tiles(F, T);
    const int gw = F.vcu * NWAVES + F.wave, NGW = F.G * NWAVES, lane = F.lane;
    const bf16* XB = (const bf16*)(A.ws + WS_XB); bf16* XG = (bf16*)(A.ws + WS_XG);
    const int* re = (const int*)(A.ws + WS_ROUTE); const int* rp = re + 2 * NTOK;
    for (int tok = gw; tok < NTOK; tok += NGW) {
        const v4u* src = (const v4u*)(XB + (size_t)tok * DM) + lane; v4u v[4];
#pragma unroll
        for (int j = 0; j < 4; ++j) v[j] = src[64 * j];
#pragma unroll
        for (int s = 0; s < 2; ++s) { const int e = re[2 * tok + s], p = rp[2 * tok + s]; int ps = 0;
#pragma unroll
            for (int q = 0; q < 8; ++q) ps = (q == e) ? T.pstart[q] : ps;
            v4u* dst = (v4u*)(XG + (size_t)(ps + p) * DM) + lane;
#pragma unroll
            for (int j = 0; j < 4; ++j) dst[64 * j] = v[j]; }
    }
}
__device__ __forceinline__ void p18_final(Frame& F, const Args& A) {
    MoeTiles T; moe_tiles(F, T);
    const int gw = F.vcu * NWAVES + F.wave, NGW = F.G * NWAVES, lane = F.lane;
    const float* XF = (const float*)(A.ws + WS_XF); const float* Y = (const float*)(A.ws + WS_Y);
    const int* re = (const int*)(A.ws + WS_ROUTE); const int* rp = re + 2 * NTOK; const float* rw = (const float*)(rp + 2 * NTOK);
    const float* gam = A.in[25] + DM; const float* bet = A.in[26] + DM;
    for (int tok = gw; tok < NTOK; tok += NGW) {
        int rows[2]; float w[2];
#pragma unroll
        for (int s = 0; s < 2; ++s) { const int e = re[2 * tok + s]; int ps = 0;
#pragma unroll
            for (int q = 0; q < 8; ++q) ps = (q == e) ? T.pstart[q] : ps;
            rows[s] = ps + rp[2 * tok + s]; w[s] = rw[2 * tok + s]; }
        const f32x4* xr = (const f32x4*)(XF + (size_t)tok * DM) + lane; const f32x4* y0 = (const f32x4*)(Y + (size_t)rows[0] * DM) + lane; const f32x4* y1 = (const f32x4*)(Y + (size_t)rows[1] * DM) + lane;
        f32x4 v[8]; float s = 0.f;
#pragma unroll
        for (int j = 0; j < 8; ++j) { v[j] = xr[64 * j] * ALPHA + y0[64 * j] * w[0] + y1[64 * j] * w[1]; s += (v[j][0] + v[j][1]) + (v[j][2] + v[j][3]); }
        const float mean = wave_sum(s) * (1.f / DM); float s2 = 0.f;
#pragma unroll
        for (int j = 0; j < 8; ++j) { v[j] = v[j] - mean; s2 += (v[j][0] * v[j][0] + v[j][1] * v[j][1]) + (v[j][2] * v[j][2] + v[j][3] * v[j][3]); }
        const float rstd = 1.f / sqrtf(wave_sum(s2) * (1.f / DM) + LN_EPS);
#pragma unroll
        for (int j = 0; j < 8; ++j) { const int c = 4 * lane + 256 * j; const f32x4 gg = *(const f32x4*)(gam + c), bb = *(const f32x4*)(bet + c);
            *(f32x4*)(A.out + (size_t)tok * DM + c) = v[j] * rstd * gg + bb; }
    }
}

__global__ void __launch_bounds__(NWAVES * 64, 2) mega_fwd(Args args) {
    extern __shared__ __attribute__((aligned(16))) unsigned char lds[];
    Frame F;
    F.lds = (LAS unsigned char*)lds;
    F.MISC = (volatile LAS unsigned*)(F.lds + MISC_OFF);
    F.tid = threadIdx.x; F.lane = F.tid & 63; F.wave = __builtin_amdgcn_readfirstlane(F.tid >> 6);
    F.G = gridDim.x; { const int bx = blockIdx.x; F.vcu = (F.G % 8 == 0) ? (bx % 8) * (F.G / 8) + bx / 8 : bx; }
    unsigned char* ws = args.ws;
    F.ctl = (gu32*)(ws + WS_CTL);
    for (int u = F.tid; u < (LDS_BYTES - LDSCTL_OFF) / 4; u += NWAVES * 64) ((LAS unsigned*)(F.lds + LDSCTL_OFF))[u] = 0u;
    __syncthreads();
    XcdBarrier bar; bar.bar = (unsigned*)(F.ctl + CW_BAR); bar.x = 0; bar.st = nullptr;
#if !MK_PER_PHASE
    bar = xcd_barrier_post((unsigned*)(F.ctl + CW_BAR), F.MISC + 8);
#define GRID_BAR() xcd_barrier(bar)
#else
#define GRID_BAR() do { } while (0)
#endif
    const int lo = args.ph_lo, hi = args.ph_hi;
#ifndef PH_MASK
#define PH_MASK 0x1fffff
#endif
#define IN(k) (((PH_MASK >> (k)) & 1) && lo <= (k) && (k) < hi)
#define BOTH(k) (IN(k) && IN((k) + 1))
    bf16* XB = (bf16*)(ws + WS_XB); float* XF = (float*)(ws + WS_XF); float* Z = (float*)(ws + WS_Z);

    if (IN(0)) { relaunder(F); p0_prologue(F, args); if (BOTH(0)) GRID_BAR(); }
    if (IN(1)) { relaunder(F);
        pg8::Gemm g{XB, (const bf16*)(ws + WS_W_NSA_IN), NTOK, NSA_NPAD, DM}; pg8::StaticOrder S; S.init(NTOK, NSA_NPAD, F.G, (int)blockIdx.x);
        pg8::EpiNsaIn E{(bf16*)(ws + WS_P0), (float*)(ws + WS_GL), 0.08838834764831845f};
        pg8::gemm_phase<pg8::EpiNsaIn, pg8::StaticOrder, true, true>(F.lds + RING_OFF, g, S, E);
        if (BOTH(1)) GRID_BAR();
    }
    if (IN(2)) { relaunder(F); p2_compress(F, args); if (BOTH(2)) GRID_BAR(); }
    if (IN(3)) { relaunder(F); p3a_nsa_cmp(F, args); if (BOTH(3)) GRID_BAR(); }
    if (IN(4)) { relaunder(F); p3b_nsa_sel(F, args); if (BOTH(4)) GRID_BAR(); }
    if (IN(5)) { relaunder(F); p3c_nsa_win(F, args); if (BOTH(5)) GRID_BAR(); }
    if (IN(6)) { relaunder(F);
        pg8::Gemm g{(const bf16*)(ws + WS_OATT0), (const bf16*)(ws + WS_W_NSA_OUT), NTOK, DM, DM}; pg8::StaticOrder S; S.init(NTOK, DM, F.G, (int)blockIdx.x);
        pg8::EpiResF32 E{args.in[0], Z, ALPHA, DM};
        pg8::gemm_phase<pg8::EpiResF32, pg8::StaticOrder, true, true>(F.lds + RING_OFF, g, S, E);
        if (BOTH(6)) GRID_BAR();
    }
    if (IN(7)) { relaunder(F); ln_phase<false>(F, args, Z, args.in[23], args.in[24], XF, XB); if (BOTH(7)) GRID_BAR(); }
    if (IN(8)) { relaunder(F);
        pg8::Gemm g{XB, (const bf16*)(ws + WS_W_FFN_GU), NTOK, 2 * DFF, DM}; pg8::StaticOrder S; S.init(NTOK, 2 * DFF, F.G, (int)blockIdx.x);
        pg8::EpiSwiGLU E{(bf16*)(ws + WS_HFF), DFF};
        pg8::gemm_phase<pg8::EpiSwiGLU, pg8::StaticOrder, true, true>(F.lds + RING_OFF, g, S, E);
        if (BOTH(8)) GRID_BAR();
    }
    if (IN(9)) { relaunder(F);
        pg8::Gemm g{(const bf16*)(ws + WS_HFF), (const bf16*)(ws + WS_W_FFN_DN), NTOK, DM, DFF}; pg8::StaticOrder S; S.init(NTOK, DM, F.G, (int)blockIdx.x);
        pg8::EpiResF32 E{XF, Z, ALPHA, DM};
        pg8::gemm_phase<pg8::EpiResF32, pg8::StaticOrder, true, true>(F.lds + RING_OFF, g, S, E);
        if (BOTH(9)) GRID_BAR();
    }
    if (IN(10)) { relaunder(F); ln_phase<false>(F, args, Z, args.in[25], args.in[26], XF, XB); if (BOTH(10)) GRID_BAR(); }
    if (IN(11)) { relaunder(F);
        pg8::Gemm g{XB, (const bf16*)(ws + WS_W_DSA_IN), NTOK, DSA_NPAD, DM}; pg8::StaticOrder S; S.init(NTOK, DSA_NPAD, F.G, (int)blockIdx.x);
        pg8::EpiDsaIn E{(bf16*)(ws + WS_Q), (float*)(ws + WS_CRAW), (bf16*)(ws + WS_QI), (float*)(ws + WS_KIWI), 0.125f};
        pg8::gemm_phase<pg8::EpiDsaIn, pg8::StaticOrder, true, true>(F.lds + RING_OFF, g, S, E);
        if (BOTH(11)) GRID_BAR();
    }
    if (IN(12)) { relaunder(F); p10_dsa_prep(F, args); if (BOTH(12)) GRID_BAR(); }
    if (IN(13)) { relaunder(F); p11_dsa_attn(F, args); if (BOTH(13)) GRID_BAR(); }
    if (IN(14)) { relaunder(F); p12_dsa_uv(F, args); if (BOTH(14)) GRID_BAR(); }
    if (IN(15)) { relaunder(F);
        pg8::Gemm g{(const bf16*)(ws + WS_OATT1), (const bf16*)(ws + WS_W_DSA_OUT), NTOK, DM, DM}; pg8::StaticOrder S; S.init(NTOK, DM, F.G, (int)blockIdx.x);
        pg8::EpiResF32 E{XF, Z, ALPHA, DM};
        pg8::gemm_phase<pg8::EpiResF32, pg8::StaticOrder, true, true>(F.lds + RING_OFF, g, S, E);
        if (BOTH(15)) GRID_BAR();
    }
    if (IN(16)) { relaunder(F); ln_route_phase(F, args, Z, args.in[23] + DM, args.in[24] + DM, XF, XB); if (BOTH(16)) GRID_BAR(); }
    if (IN(17)) { relaunder(F); p15_gather(F, args); if (BOTH(17)) GRID_BAR(); }
    if (IN(18)) { relaunder(F);
        MoeTiles T; moe_tiles(F, T);
        pg8::Gemm g{(const bf16*)(ws + WS_XG), (const bf16*)(ws + WS_W_MOE_GU), T.MT * 256, 2 * DFFE, DM}; pg8::MoeOrder S; S.init(T.MT * 256, 2 * DFFE, F.G, (int)blockIdx.x); S.nexp_rows = 2 * DFFE;
#pragma unroll
        for (int e = 0; e < 8; ++e) S.tend[e] = T.tend[e];
        pg8::EpiSwiGLU E{(bf16*)(ws + WS_HM), DFFE};
        pg8::gemm_phase<pg8::EpiSwiGLU, pg8::MoeOrder, true, true>(F.lds + RING_OFF, g, S, E);
        if (BOTH(18)) GRID_BAR();
    }
    if (IN(19)) { relaunder(F);
        MoeTiles T; moe_tiles(F, T);
        pg8::Gemm g{(const bf16*)(ws + WS_HM), (const bf16*)(ws + WS_W_MOE_DN), T.MT * 256, DM, DFFE}; pg8::MoeOrder S; S.init(T.MT * 256, DM, F.G, (int)blockIdx.x); S.nexp_rows = DM;
#pragma unroll
        for (int e = 0; e < 8; ++e) S.tend[e] = T.tend[e];
        pg8::EpiF32 E{(float*)(ws + WS_Y), DM};
        pg8::gemm_phase<pg8::EpiF32, pg8::MoeOrder, true, true>(F.lds + RING_OFF, g, S, E);
        if (BOTH(19)) GRID_BAR();
    }
    if (IN(20)) { relaunder(F); p18_final(F, args); }
#undef IN
#undef BOTH
}

extern "C" void kernel_launch(void* const* d_in, const int* in_sizes, int n_in, void* d_out, int out_size, void* d_ws, size_t ws_size, hipStream_t stream) {
    static int grid = 0;
    if (grid == 0) {
        if (n_in != 27 || out_size != NTOK * DM || ws_size < WS_END) { fprintf(stderr, "kernel_launch: unexpected shapes (n_in %d, out %d, ws %zu); nothing launched\n", n_in, out_size, ws_size); grid = -1; return; }
        int dev = 0, cus = 0, per_cu = 0;
        if (hipGetDevice(&dev) != hipSuccess || hipDeviceGetAttribute(&cus, hipDeviceAttributeMultiprocessorCount, dev) != hipSuccess) { grid = -1; return; }
        if (hipFuncSetAttribute((const void*)mega_fwd, hipFuncAttributeMaxDynamicSharedMemorySize, LDS_BYTES) != hipSuccess) { fprintf(stderr, "kernel_launch: hipFuncSetAttribute failed\n"); grid = -1; return; }
        if (hipOccupancyMaxActiveBlocksPerMultiprocessor(&per_cu, (const void*)mega_fwd, NWAVES * 64, LDS_BYTES) != hipSuccess || per_cu < 1) { fprintf(stderr, "kernel_launch: occupancy query says %d\n", per_cu); }
        (void)hipGetLastError();
        grid = cus;
    }
    if (grid < 0) return;
    if (hipMemsetAsync((char*)d_ws + WS_CTL, 0, CTL_ZERO_BYTES, stream) != hipSuccess) return;
    Args a{};
    for (int i = 0; i < 27; ++i) a.in[i] = (const float*)d_in[i];
    a.out = (float*)d_out; a.ws = (unsigned char*)d_ws;
#if MK_PER_PHASE
    for (int p = 0; p < NPHASE; ++p) { a.ph_lo = p; a.ph_hi = p + 1; hipLaunchKernelGGL(mega_fwd, dim3(grid), dim3(NWAVES * 64), LDS_BYTES, stream, a); }
#else
    a.ph_lo = 0; a.ph_hi = NPHASE;
    hipLaunchKernelGGL(mega_fwd, dim3(grid), dim3(NWAVES * 64), LDS_BYTES, stream, a);
#endif
}
```

```cpp
#include <hip/hip_runtime.h>
#include <cstdio>
#include <cstdint>
namespace pg8 {
#define PG8_LAS __attribute__((address_space(3)))
typedef unsigned short bf16_t;
typedef short bf16x8 __attribute__((ext_vector_type(8)));
typedef float f32x4 __attribute__((ext_vector_type(4)));
typedef unsigned u32x4 __attribute__((ext_vector_type(4)));
constexpr int BM = 256, BK = 64, HALF = 128, HTB = HALF * BK * 2  , STAGE_BYTES = 8 * HTB, NXCD = 8, WGM = 8;

__host__ __device__ __forceinline__ int lds_byte(int r, int c) { const int st = (r >> 4) * 2 + (c >> 5), rr = r & 15, cc = c & 31, ob = rr * 64 + cc * 2; return st * 1024 + (ob ^ (((ob >> 9) & 1) << 5)); }
__host__ __device__ __forceinline__ void stage_rc(int b, int& R, int& C) { const int st = b / 1024, sb = b % 1024, swz = sb ^ (((sb >> 9) & 1) << 5); R = (st >> 1) * 16 + swz / 64; C = (st & 1) * 32 + (swz % 64) / 2; }
__host__ __device__ __forceinline__ int perm32(int rho) { const int n = rho >> 4, i = rho & 15; return 8 * (i >> 2) + 4 * n + (i & 3); }

struct Unit { int pm, pn; };
struct Gemm { const bf16_t* A; const bf16_t* Bt; int M, N, K; };

struct StaticOrder {
    int nM, nN, nwg, G, c;
    __host__ __device__ void init(int M, int N, int G_, int c_) { nM = M / BM; nN = N / BM; nwg = nM * nN; G = G_; c = c_; }
    __host__ __device__ bool next(int i, Unit& u) const {
        const long L = (long)i * G + c; if (L >= nwg) return false;
        int wgid = (int)L; { const int q = nwg / NXCD, r = nwg % NXCD, xcd = wgid % NXCD, off = wgid / NXCD; wgid = (xcd < r ? xcd * (q + 1) : r * (q + 1) + (xcd - r) * q) + off; }
        const int nig = WGM * nN, gid = wgid / nig, fm = gid * WGM, gsz = (nM - fm) < WGM ? (nM - fm) : WGM;
        u.pm = fm + ((wgid % nig) % gsz); u.pn = (wgid % nig) / gsz; return true;
    }
    __device__ __forceinline__ void a_ready(const Unit&) const {}
    __device__ __forceinline__ void done(const Unit&) const {}
    __device__ __forceinline__ const char* a_ptr(const Gemm& g, const Unit& u) const { return (const char*)g.A + (size_t)u.pm * ((size_t)BM * g.K * 2); }
    __device__ __forceinline__ const char* b_ptr(const Gemm& g, const Unit& u) const { return (const char*)g.Bt + (size_t)u.pn * ((size_t)BM * g.K * 2); }
};


__device__ __forceinline__ unsigned cvt_pk_bf16(float lo, float hi) { unsigned r; asm volatile("v_cvt_pk_bf16_f32 %0, %1, %2" : "=v"(r) : "v"(lo), "v"(hi)); return r; }
__device__ __forceinline__ u32x4 pack8(const f32x4 v0, const f32x4 v1) { u32x4 w; w.x = cvt_pk_bf16(v0[0], v0[1]); w.y = cvt_pk_bf16(v0[2], v0[3]); w.z = cvt_pk_bf16(v1[0], v1[1]); w.w = cvt_pk_bf16(v1[2], v1[3]); return w; }

struct EpiNsaIn {
    static constexpr bool PERM = true, AFTER_DRAIN = false;
    bf16_t* P0; float* GL; float qscale;
    __device__ __forceinline__ void operator()(const f32x4 (&acc)[2][2][4][2], const Unit& u, int wr, int wc, int fr, int fq) const {
        const int row0 = u.pm * BM + wr * 64 + fr;
        if (u.pn < 20) {
            const float s = u.pn < 8 ? qscale : 1.0f;
            const int col0 = u.pn * BM + wc * 32 + 8 * fq;
#pragma unroll
            for (int ai = 0; ai < 2; ++ai)
#pragma unroll
                for (int m = 0; m < 4; ++m) { bf16_t* rowp = P0 + (size_t)(row0 + ai * HALF + m * 16) * 5120 + col0;
#pragma unroll
                    for (int bj = 0; bj < 2; ++bj) *(u32x4*)(rowp + bj * HALF) = pack8(acc[ai][bj][m][0] * s, acc[ai][bj][m][1] * s); }
        } else {
            const int c = wc * 32 + 8 * fq;
            if (c < 48) {
#pragma unroll
                for (int ai = 0; ai < 2; ++ai)
#pragma unroll
                    for (int m = 0; m < 4; ++m) { float* gp = GL + (size_t)(row0 + ai * HALF + m * 16) * 48 + c;
                        *(f32x4*)gp = acc[ai][0][m][0]; *(f32x4*)(gp + 4) = acc[ai][0][m][1]; }
            }
        }
    }
};
struct EpiDsaIn {
    static constexpr bool PERM = true, AFTER_DRAIN = false;
    bf16_t* Q; float* CRAW; bf16_t* QI; float* KIWI; float qiscale;
    __device__ __forceinline__ void operator()(const f32x4 (&acc)[2][2][4][2], const Unit& u, int wr, int wc, int fr, int fq) const {
        const int row0 = u.pm * BM + wr * 64 + fr; const int c = wc * 32 + 8 * fq;
        if (u.pn < 8) {
#pragma unroll
            for (int ai = 0; ai < 2; ++ai)
#pragma unroll
                for (int m = 0; m < 4; ++m) { bf16_t* rowp = Q + (size_t)(row0 + ai * HALF + m * 16) * 2048 + u.pn * BM + c;
#pragma unroll
                    for (int bj = 0; bj < 2; ++bj) *(u32x4*)(rowp + bj * HALF) = pack8(acc[ai][bj][m][0], acc[ai][bj][m][1]); }
        } else if (u.pn == 8) {
#pragma unroll
            for (int ai = 0; ai < 2; ++ai)
#pragma unroll
                for (int m = 0; m < 4; ++m) { float* rowp = CRAW + (size_t)(row0 + ai * HALF + m * 16) * 256 + c;
#pragma unroll
                    for (int bj = 0; bj < 2; ++bj) { *(f32x4*)(rowp + bj * HALF) = acc[ai][bj][m][0]; *(f32x4*)(rowp + bj * HALF + 4) = acc[ai][bj][m][1]; } }
        } else if (u.pn < 11) {
#pragma unroll
            for (int ai = 0; ai < 2; ++ai)
#pragma unroll
                for (int m = 0; m < 4; ++m) { bf16_t* rowp = QI + (size_t)(row0 + ai * HALF + m * 16) * 512 + (u.pn - 9) * BM + c;
#pragma unroll
                    for (int bj = 0; bj < 2; ++bj) *(u32x4*)(rowp + bj * HALF) = pack8(acc[ai][bj][m][0] * qiscale, acc[ai][bj][m][1] * qiscale); }
        } else {
#pragma unroll
            for (int ai = 0; ai < 2; ++ai)
#pragma unroll
                for (int m = 0; m < 4; ++m) { float* rowp = KIWI + (size_t)(row0 + ai * HALF + m * 16) * 128 + c;
                    *(f32x4*)rowp = acc[ai][0][m][0]; *(f32x4*)(rowp + 4) = acc[ai][0][m][1]; }
        }
    }
};
struct EpiResF32 {
    static constexpr bool PERM = false, AFTER_DRAIN = false;
    const float* R; float* Z; float alpha; int ldc;
    __device__ __forceinline__ void operator()(const f32x4 (&acc)[2][2][4][2], const Unit& u, int wr, int wc, int fr, int fq) const {
        const int row0 = u.pm * BM + wr * 64 + fr, col0 = u.pn * BM + wc * 32 + 4 * fq;
#pragma unroll
        for (int ai = 0; ai < 2; ++ai)
#pragma unroll
            for (int m = 0; m < 4; ++m) { const size_t off = (size_t)(row0 + ai * HALF + m * 16) * ldc + col0;
#pragma unroll
                for (int bj = 0; bj < 2; ++bj)
#pragma unroll
                    for (int n = 0; n < 2; ++n) { const f32x4 r = *(const f32x4*)(R + off + bj * HALF + n * 16); *(f32x4*)(Z + off + bj * HALF + n * 16) = r * alpha + acc[ai][bj][m][n]; } }
    }
};
struct EpiF32 {
    static constexpr bool PERM = false, AFTER_DRAIN = false;
    float* C; int ldc;
    __device__ __forceinline__ void operator()(const f32x4 (&acc)[2][2][4][2], const Unit& u, int wr, int wc, int fr, int fq) const {
        const int row0 = u.pm * BM + wr * 64 + fr, col0 = u.pn * BM + wc * 32 + 4 * fq;
#pragma unroll
        for (int ai = 0; ai < 2; ++ai)
#pragma unroll
            for (int m = 0; m < 4; ++m) { float* rowp = C + (size_t)(row0 + ai * HALF + m * 16) * ldc + col0;
#pragma unroll
                for (int bj = 0; bj < 2; ++bj)
#pragma unroll
                    for (int n = 0; n < 2; ++n) *(f32x4*)(rowp + bj * HALF + n * 16) = acc[ai][bj][m][n]; }
    }
};
__device__ __forceinline__ float silu_mul(float g, float u) { return g * __builtin_amdgcn_rcpf(1.0f + __expf(-g)) * u; }
struct EpiSwiGLU {
    static constexpr bool PERM = true, AFTER_DRAIN = false;
    bf16_t* H; int ldh;
    __device__ __forceinline__ void operator()(const f32x4 (&acc)[2][2][4][2], const Unit& u, int wr, int wc, int fr, int fq) const {
        const int row0 = u.pm * BM + wr * 64 + fr, col0 = u.pn * HALF + wc * 32 + 8 * fq;
#pragma unroll
        for (int ai = 0; ai < 2; ++ai)
#pragma unroll
            for (int m = 0; m < 4; ++m) { bf16_t* rowp = H + (size_t)(row0 + ai * HALF + m * 16) * ldh + col0;
                f32x4 v0, v1;
#pragma unroll
                for (int j = 0; j < 4; ++j) { v0[j] = silu_mul(acc[ai][0][m][0][j], acc[ai][1][m][0][j]); v1[j] = silu_mul(acc[ai][0][m][1][j], acc[ai][1][m][1][j]); }
                *(u32x4*)rowp = pack8(v0, v1); }
    }
};
struct MoeOrder : StaticOrder {
    int tend[8]; int nexp_rows;
    __device__ __forceinline__ int expert(int pm) const { int e = 0;
#pragma unroll
        for (int i = 0; i < 7; ++i) e += (pm >= tend[i]) ? 1 : 0; return e; }
    __device__ __forceinline__ const char* b_ptr(const Gemm& g, const Unit& u) const { return (const char*)g.Bt + ((size_t)expert(u.pm) * nexp_rows + (size_t)u.pn * BM) * ((size_t)g.K * 2); }
};
template <class Epi, class Sched, bool ALIGN_EPI = false, bool SP2 = false>
__device__ __forceinline__ void gemm_phase(PG8_LAS unsigned char* lds, const Gemm g, const Sched& S, const Epi& E) {
    int tid = threadIdx.x; asm volatile("" : "+v"(tid));
    const int wid = __builtin_amdgcn_readfirstlane(tid >> 6), lane = tid & 63, wr = wid >> 2, wc = wid & 3, fr = lane & 15, fq = lane >> 4;
    const int K = g.K, nt = K / BK;
    unsigned voffA[2], voffB[2];
#pragma unroll
    for (int i = 0; i < 2; ++i) { int R, C; stage_rc(tid * 16 + i * 8192, R, C); const int Rb = Epi::PERM ? ((R & ~31) + perm32(R & 31)) : R;
        voffA[i] = (unsigned)(R * K + C) * 2u; voffB[i] = (unsigned)(Rb * K + C) * 2u; }
    const size_t kstep = (size_t)(BK * 2);
    const size_t hstep = (size_t)HALF * K * 2;
    const size_t tstep = 2 * hstep;
    const unsigned ldsw = (unsigned)wid * 1024u;
    const int aoff = lds_byte(wr * 64 + fr, fq * 8), boff = lds_byte(wc * 32 + fr, fq * 8);
#define PG8_SA(b, h) (((b) * 2 + (h)) * HTB)
#define PG8_SB(b, h) ((4 + (b) * 2 + (h)) * HTB)
#define PG8_STAGE(bufoff, gbase, voff) do { _Pragma("unroll") for (int _i = 0; _i < 2; ++_i) \
        __builtin_amdgcn_global_load_lds((const unsigned*)((const char*)(gbase) + (voff)[_i]), (PG8_LAS unsigned*)(lds + (bufoff) + ldsw + _i * 8192), 16, 0, 0); } while (0)
#define PG8_LDA(dst, b, h) do { _Pragma("unroll") for (int m = 0; m < 4; ++m) _Pragma("unroll") for (int k = 0; k < 2; ++k) dst[m][k] = *(const PG8_LAS bf16x8*)(lds + PG8_SA(b, h) + aoff + m * 2048 + k * 1024); } while (0)
#define PG8_LDB(dst, b, h) do { _Pragma("unroll") for (int n = 0; n < 2; ++n) _Pragma("unroll") for (int k = 0; k < 2; ++k) dst[n][k] = *(const PG8_LAS bf16x8*)(lds + PG8_SB(b, h) + boff + n * 2048 + k * 1024); } while (0)
#define PG8_MMA(ai, bj, At, Bt) do { __builtin_amdgcn_s_setprio(1); _Pragma("unroll") for (int m = 0; m < 4; ++m) _Pragma("unroll") for (int n = 0; n < 2; ++n) _Pragma("unroll") for (int k = 0; k < 2; ++k) \
        acc[ai][bj][m][n] = __builtin_amdgcn_mfma_f32_16x16x32_bf16(Bt[n][k], At[m][k], acc[ai][bj][m][n], 0, 0, 0); __builtin_amdgcn_s_setprio(0); } while (0)
#define PG8_WAIT_V(n) asm volatile("s_waitcnt vmcnt(" #n ")" ::: "memory")
#define PG8_WAIT_L(n) asm volatile("s_waitcnt lgkmcnt(" #n ")" ::: "memory")
#define PG8_BAR __builtin_amdgcn_s_barrier()
#define PG8_SCHED __builtin_amdgcn_sched_barrier(0)
    Unit cur, nxt; int ui = 0;
    if (!S.next(0, cur)) return;
    f32x4 acc[2][2][4][2];
#pragma unroll
    for (int a = 0; a < 2; ++a)
#pragma unroll
        for (int b = 0; b < 2; ++b)
#pragma unroll
            for (int m = 0; m < 4; ++m)
#pragma unroll
                for (int n = 0; n < 2; ++n) acc[a][b][m][n] = (f32x4){0.f, 0.f, 0.f, 0.f};
    bf16x8 At[4][2], B0[2][2], B1[2][2];
    const char* cA = S.a_ptr(g, cur); const char* cB = S.b_ptr(g, cur);
    S.a_ready(cur);
    if constexpr (SP2) {
        PG8_STAGE(PG8_SB(0, 0), cB, voffB); PG8_STAGE(PG8_SB(0, 1), cB + hstep, voffB); PG8_STAGE(PG8_SA(0, 0), cA, voffA); PG8_STAGE(PG8_SA(0, 1), cA + hstep, voffA);
        if (wr == 1) PG8_BAR;
        PG8_WAIT_V(2); PG8_BAR;
        PG8_STAGE(PG8_SB(1, 0), cB + kstep, voffB); PG8_STAGE(PG8_SA(1, 0), cA + kstep, voffA); PG8_STAGE(PG8_SB(1, 1), cB + hstep + kstep, voffB);
        PG8_WAIT_V(6); PG8_BAR;
    } else {
        PG8_STAGE(PG8_SB(0, 0), cB, voffB); PG8_STAGE(PG8_SA(0, 0), cA, voffA); PG8_STAGE(PG8_SB(0, 1), cB + hstep, voffB); PG8_STAGE(PG8_SA(0, 1), cA + hstep, voffA);
        if (wr == 1) PG8_BAR;
        PG8_WAIT_V(4); PG8_BAR;
        PG8_STAGE(PG8_SB(1, 0), cB + kstep, voffB); PG8_STAGE(PG8_SA(1, 0), cA + kstep, voffA); PG8_STAGE(PG8_SB(1, 1), cB + hstep + kstep, voffB);
        PG8_WAIT_V(6); PG8_BAR;
    }
    for (;;) {
        const bool has_next = S.next(ui + 1, nxt);
        const char* nA = has_next ? S.a_ptr(g, nxt) : cA; const char* nB = has_next ? S.b_ptr(g, nxt) : cB;
        for (int t = 0; t < nt; t += 2) {
            const bool last = (t == nt - 2);
            const char* a1 = cA + (size_t)(t + 1) * kstep;
            const char* a2 = last ? nA : cA + (size_t)(t + 2) * kstep; const char* b2 = last ? nB : cB + (size_t)(t + 2) * kstep;
            const char* a3 = a2 + kstep; const char* b3 = b2 + kstep;
            if (last && has_next) S.a_ready(nxt);
            if constexpr (SP2) {
            PG8_LDB(B0, 0, 0); PG8_LDB(B1, 0, 1); PG8_SCHED; PG8_LDA(At, 0, 0); PG8_STAGE(PG8_SA(1, 1), a1 + hstep, voffA);
            PG8_WAIT_V(8); PG8_WAIT_L(0); PG8_BAR; PG8_MMA(0, 0, At, B0); PG8_MMA(0, 1, At, B1); PG8_BAR; PG8_SCHED;
            PG8_LDA(At, 0, 1); PG8_STAGE(PG8_SB(0, 0), b2, voffB); PG8_STAGE(PG8_SB(0, 1), b2 + hstep, voffB); PG8_STAGE(PG8_SA(0, 0), a2, voffA);
            PG8_WAIT_V(8); PG8_WAIT_L(0); PG8_BAR; PG8_MMA(1, 0, At, B0); PG8_MMA(1, 1, At, B1); PG8_BAR; PG8_SCHED;
            PG8_LDB(B0, 1, 0); PG8_LDB(B1, 1, 1); PG8_SCHED; PG8_LDA(At, 1, 0); PG8_STAGE(PG8_SA(0, 1), a2 + hstep, voffA);
            PG8_WAIT_V(8); PG8_WAIT_L(0); PG8_BAR; PG8_MMA(0, 0, At, B0); PG8_MMA(0, 1, At, B1); PG8_BAR; PG8_SCHED;
            PG8_LDA(At, 1, 1); PG8_STAGE(PG8_SB(1, 0), b3, voffB); PG8_STAGE(PG8_SB(1, 1), b3 + hstep, voffB); PG8_STAGE(PG8_SA(1, 0), a3, voffA);
            PG8_WAIT_V(8); PG8_WAIT_L(0); PG8_BAR; PG8_MMA(1, 0, At, B0); PG8_MMA(1, 1, At, B1); PG8_BAR; PG8_SCHED;
            } else {
            PG8_LDB(B0, 0, 0); PG8_SCHED; PG8_LDA(At, 0, 0); PG8_STAGE(PG8_SA(1, 1), a1 + hstep, voffA);
            PG8_WAIT_L(8); PG8_BAR; PG8_WAIT_L(0); PG8_MMA(0, 0, At, B0); PG8_BAR; PG8_SCHED;
            PG8_LDB(B1, 0, 1); PG8_STAGE(PG8_SB(0, 0), b2, voffB);
            PG8_BAR; PG8_WAIT_L(0); PG8_MMA(0, 1, At, B1); PG8_BAR;
            PG8_LDA(At, 0, 1); PG8_STAGE(PG8_SA(0, 0), a2, voffA);
            PG8_BAR; PG8_WAIT_L(0); PG8_MMA(1, 0, At, B0); PG8_BAR; PG8_SCHED;
            PG8_STAGE(PG8_SB(0, 1), b2 + hstep, voffB);
            PG8_WAIT_V(6); PG8_BAR; PG8_MMA(1, 1, At, B1); PG8_BAR;
            PG8_LDB(B0, 1, 0); PG8_SCHED; PG8_LDA(At, 1, 0); PG8_STAGE(PG8_SA(0, 1), a2 + hstep, voffA);
            PG8_WAIT_L(8); PG8_BAR; PG8_WAIT_L(0); PG8_MMA(0, 0, At, B0); PG8_BAR; PG8_SCHED;
            PG8_LDB(B1, 1, 1); PG8_STAGE(PG8_SB(1, 0), b3, voffB);
            PG8_BAR; PG8_WAIT_L(0); PG8_MMA(0, 1, At, B1); PG8_BAR;
            PG8_LDA(At, 1, 1); PG8_STAGE(PG8_SA(1, 0), a3, voffA);
            PG8_BAR; PG8_WAIT_L(0); PG8_MMA(1, 0, At, B0); PG8_BAR; PG8_SCHED;
            PG8_STAGE(PG8_SB(1, 1), b3 + hstep, voffB);
            PG8_WAIT_V(6); PG8_BAR; PG8_MMA(1, 1, At, B1); PG8_BAR;
            }
        }
        if constexpr (ALIGN_EPI) { if (wr == 0) PG8_BAR; }
        if constexpr (!Epi::AFTER_DRAIN) { E(acc, cur, wr, wc, fr, fq); S.done(cur); }
        if (!has_next) break;
#pragma unroll
        for (int a = 0; a < 2; ++a)
#pragma unroll
            for (int b = 0; b < 2; ++b)
#pragma unroll
                for (int m = 0; m < 4; ++m)
#pragma unroll
                    for (int n = 0; n < 2; ++n) acc[a][b][m][n] = (f32x4){0.f, 0.f, 0.f, 0.f};
        cur = nxt; cA = nA; cB = nB; ++ui;
        if constexpr (ALIGN_EPI) { if (wr == 1) PG8_BAR; }
    }
    PG8_WAIT_V(0);
    if constexpr (!ALIGN_EPI) { if (wr == 0) PG8_BAR; }
    PG8_BAR;
    if constexpr (Epi::AFTER_DRAIN) { E.fused(acc, cur, wr, wc, fr, fq, lds, wid, lane); S.done(cur); }
#undef PG8_SA
#undef PG8_SB
#undef PG8_STAGE
#undef PG8_LDA
#undef PG8_LDB
#undef PG8_MMA
#undef PG8_WAIT_V
#undef PG8_WAIT_L
#undef PG8_BAR
#undef PG8_SCHED
}
}
#define GAS __attribute__((address_space(1)))
#define LAS __attribute__((address_space(3)))
typedef unsigned short bf16;
typedef unsigned v4u __attribute__((ext_vector_type(4)));
typedef float f32x4 __attribute__((ext_vector_type(4)));
typedef short bf16x8 __attribute__((ext_vector_type(8)));
typedef GAS unsigned gu32;
typedef GAS unsigned long long gu64;
#define RLX_AGENT __ATOMIC_RELAXED, __HIP_MEMORY_SCOPE_AGENT
#define LDS_WAIT() asm volatile("s_waitcnt lgkmcnt(0)" ::: "memory")
#define VM_WAIT() asm volatile("s_waitcnt vmcnt(0)" ::: "memory")
__device__ __forceinline__ unsigned long long rt() { return __builtin_amdgcn_s_memrealtime(); }
__device__ __forceinline__ unsigned f2bf(float f) { unsigned u = __builtin_bit_cast(unsigned, f); return (u + 0x7fffu + ((u >> 16) & 1u)) >> 16; }
__device__ __forceinline__ unsigned pk2(float lo, float hi) { return f2bf(lo) | (f2bf(hi) << 16); }

#define XB_TMO      128
#define XB_XCNT(j)  (256  + 64 * (j))
#define XB_XSUB(j)  (1280 + 64 * (j))
#define XB_XGEN(j)  (2304 + 64 * (j))
#define XB_TOP      3328
#define XB_TOPGEN   3392
#define XCD_BAR_WORDS 3456
#define XB_SPIN_CAP (1u << 18)

__device__ __forceinline__ unsigned xb_ld(unsigned* p)              { return __hip_atomic_load(p, __ATOMIC_RELAXED, __HIP_MEMORY_SCOPE_AGENT); }
__device__ __forceinline__ unsigned xb_add(unsigned* p, unsigned v) { return __hip_atomic_fetch_add(p, v, __ATOMIC_RELAXED, __HIP_MEMORY_SCOPE_AGENT); }
__device__ __forceinline__ unsigned xb_xcc_id() { return (unsigned)__builtin_amdgcn_s_getreg((3 << 11) | 20) & 0xFu; }
#define XB_SPIN(cond, bar) do { unsigned _sp = 0; while (cond) { __builtin_amdgcn_s_sleep(1); \
    if ((++_sp & 255u) == 0u) { if (xb_ld(&(bar)[XB_TMO])) break; if (_sp > XB_SPIN_CAP) { atomicAdd(&(bar)[XB_TMO], 1u); break; } } } } while (0)

struct XcdBarrier {
    unsigned* bar; unsigned x;
    volatile LAS unsigned* st;
};

__device__ __forceinline__ XcdBarrier xcd_barrier_post(unsigned* bar, volatile LAS unsigned* st) {
    XcdBarrier b; b.bar = bar; b.x = xb_xcc_id(); b.st = st;
    if (threadIdx.x == 0) (void)xb_add(&bar[XB_XCNT(b.x)], 1u);
    return b;
}
__device__ __forceinline__ void xcd_barrier_complete(unsigned* bar, unsigned x, unsigned& nloc, unsigned& nx) {
    const unsigned G = gridDim.x * gridDim.y * gridDim.z;
    unsigned sum, cnt, mine, sp = 0u;
    for (;;) {
        sum = 0u; cnt = 0u; mine = 0u;
#pragma unroll
        for (unsigned j = 0; j < 16; ++j) { const unsigned c = xb_ld(&bar[XB_XCNT(j)]); sum += c; cnt += (c > 0u) ? 1u : 0u; mine = (j == x) ? c : mine; }
        if (sum == G) break;
        __builtin_amdgcn_s_sleep(1);
        if ((++sp & 255u) == 0u) { if (xb_ld(&bar[XB_TMO])) break; if (sp > XB_SPIN_CAP) { atomicAdd(&bar[XB_TMO], 1u); break; } }
    }
    nloc = mine > 0u ? mine : 1u; nx = cnt > 0u ? cnt : 1u;
}

__device__ __forceinline__ void xcd_barrier(const XcdBarrier& b) {
    asm volatile("s_waitcnt vmcnt(0)" ::: "memory");
    __syncthreads();
    if (threadIdx.x == 0) {
        unsigned* bar = b.bar;
        __builtin_amdgcn_s_waitcnt(0);
        unsigned nloc = b.st[0], nx = b.st[1];
        if (nloc == 0u) { xcd_barrier_complete(bar, b.x, nloc, nx); b.st[0] = nloc; b.st[1] = nx; }
        const unsigned old = xb_add(&bar[XB_XSUB(b.x)], 1u);
        const unsigned gen = old / nloc;
        if (old + 1u == (gen + 1u) * nloc) {
            __builtin_amdgcn_fence(__ATOMIC_RELEASE, "agent");
            asm volatile("s_waitcnt vmcnt(0)" ::: "memory");
            const unsigned og = xb_add(&bar[XB_TOP], 1u);
            const unsigned tg = og / nx;
            if (og + 1u == (tg + 1u) * nx) xb_add(&bar[XB_TOPGEN], 1u);
            else XB_SPIN(xb_ld(&bar[XB_TOPGEN]) == tg, bar);
            __builtin_amdgcn_fence(__ATOMIC_ACQUIRE, "agent");
            xb_add(&bar[XB_XGEN(b.x)], 1u);
            asm volatile("s_waitcnt vmcnt(0)" ::: "memory");
        } else {
            XB_SPIN(xb_ld(&bar[XB_XGEN(b.x)]) == gen, bar);
            __builtin_amdgcn_fence(__ATOMIC_ACQUIRE, "agent");
            asm volatile("s_waitcnt vmcnt(0)" ::: "memory");
        }
    }
    __syncthreads();
}

constexpr int NWAVES = 8;
#ifndef MK_PER_PHASE
#define MK_PER_PHASE 0
#endif
constexpr int NPHASE = 22;

constexpr int BATCH = 2, SEQ = 8192, DM = 2048, NTOK = BATCH * SEQ, NH = 16, DH = 128;
constexpr int NSA_N = 5168, NSA_NPAD = 5376, P0LD = 5120;
constexpr int NCMP = 511, NSELB = 128;
constexpr int COL_KC = 2048, COL_VC = 2560, COL_KS = 3072, COL_VS = 3584, COL_KW = 4096, COL_VW = 4608;
constexpr int DSA_N = 2888, DSA_NPAD = 3072, KVR = 256, TOPK = 256;
constexpr int DFF = 5632, NEXP = 8, DFFE = 7168, MOE_ROWS = 34816;
constexpr float ALPHA = 1.41421356237309515f, LN_EPS = 1e-5f, RMS_EPS = 1e-6f;

constexpr size_t MiB = (size_t)1 << 20;
constexpr size_t WS_CTL = 0, CTL_ZERO_BYTES = 1 * MiB;
constexpr size_t WS_W_NSA_IN = 2 * MiB, WS_W_NSA_OUT = 23 * MiB, WS_W_FFN_GU = 31 * MiB, WS_W_FFN_DN = 75 * MiB, WS_W_DSA_IN = 97 * MiB, WS_W_DSA_OUT = 109 * MiB;
constexpr size_t WS_W_CMPK = 117 * MiB, WS_W_CMPV = 118 * MiB, WS_W_UK = 119 * MiB, WS_W_UV = 120 * MiB, WS_CBIAS = 121 * MiB;
constexpr size_t WS_KCMP = 122 * MiB, WS_VCMP = 124 * MiB, WS_GL = 126 * MiB, WS_ROUTE = 129 * MiB;
constexpr size_t WS_KIB = 179 * MiB;
constexpr size_t WS_SELM = 178 * MiB;
constexpr size_t WS_CRAW = 130 * MiB, WS_KIWI = 146 * MiB, WS_IDX = 154 * MiB, WS_CN = 170 * MiB;
constexpr size_t WS_W_MOE_GU = 192 * MiB, WS_W_MOE_DN = 640 * MiB;
constexpr size_t WS_XB = 864 * MiB, WS_XF = 928 * MiB, WS_Z = 1056 * MiB;
constexpr size_t WS_P0 = 1184 * MiB, WS_OATT0 = 1344 * MiB, WS_HFF = 1408 * MiB;
constexpr size_t WS_Q = 1184 * MiB, WS_QI = 1248 * MiB, WS_QLAT = 1264 * MiB, WS_OLAT = 1392 * MiB, WS_OATT1 = 1520 * MiB;
constexpr size_t WS_XG = 1056 * MiB, WS_HM = 1192 * MiB, WS_Y = 192 * MiB;
constexpr size_t WS_END = 1668 * MiB;
static_assert(WS_HM + (size_t)MOE_ROWS * DFFE * 2 <= WS_END, "hm fits");
static_assert(WS_XG + (size_t)MOE_ROWS * DM * 2 <= WS_HM, "xg fits");
static_assert(WS_Y + (size_t)MOE_ROWS * DM * 4 <= WS_W_MOE_DN, "y overlays the dead gate/up weights only");
static_assert(WS_HFF + (size_t)NTOK * DFF * 2 <= WS_END, "hff fits");
constexpr int CW_TMO = 0, CW_CODE = 1;
constexpr int CW_BAR = 4096;
constexpr int CW_MOECNT = 16384;

constexpr int RING_OFF = 0, RING_BYTES = 131072;
constexpr int LDSCTL_OFF = RING_BYTES, MISC_OFF = LDSCTL_OFF + 320;
constexpr int LDS_BYTES = 163840;

struct Frame {
    LAS unsigned char* lds;
    volatile LAS unsigned* MISC;
    gu32* ctl;
    int tid, lane, wave, vcu, G;
};

__device__ __forceinline__ void relaunder(Frame& F) { int t = F.tid; asm volatile("" : "+v"(t)); F.tid = t; F.lane = t & 63; }
__device__ __forceinline__ float bf2f(unsigned short h) { return __uint_as_float(((unsigned)h) << 16); }
__device__ __forceinline__ float bflo(unsigned w) { return __uint_as_float(w << 16); }
__device__ __forceinline__ float bfhi(unsigned w) { return __uint_as_float(w & 0xffff0000u); }
__device__ __forceinline__ float wave_sum(float v) {
#pragma unroll
    for (int o = 1; o < 64; o <<= 1) v += __shfl_xor(v, o);
    return v;
}
__device__ __forceinline__ float wave_max(float v) {
#pragma unroll
    for (int o = 1; o < 64; o <<= 1) v = fmaxf(v, __shfl_xor(v, o));
    return v;
}
#define WSYNC() do { __builtin_amdgcn_wave_barrier(); asm volatile("s_waitcnt lgkmcnt(0)" ::: "memory"); __builtin_amdgcn_wave_barrier(); } while (0)

__device__ __forceinline__ int rel_bucket(int n) {
    if (n < 16) return n;
    if (n >= 113) return 31;
    int b = 16;
    b += (n >= 19); b += (n >= 21); b += (n >= 24); b += (n >= 27); b += (n >= 31); b += (n >= 35); b += (n >= 40); b += (n >= 46);
    b += (n >= 52); b += (n >= 59); b += (n >= 67); b += (n >= 77); b += (n >= 87); b += (n >= 99);
    return b;
}

__device__ __forceinline__ void tr_item(const float* W, int N, int ldw, bf16* WT, int Kdst, int k0, int n0, int drow, LAS float* scr, int lane) {
#pragma unroll 8
    for (int i = 0; i < 32; ++i) { const int kk = 2 * i + (lane >> 5); const int n = n0 + (lane & 31); scr[kk * 33 + (lane & 31)] = (n < N) ? W[(size_t)(k0 + kk) * ldw + n] : 0.f; }
    LDS_WAIT(); asm volatile("" ::: "memory");
    const int c = lane & 7;
#pragma unroll
    for (int j = 0; j < 4; ++j) { const int n = (lane >> 3) + 8 * j; const LAS float* s = scr + (8 * c) * 33 + n;
        v4u o; o.x = pk2(s[0 * 33], s[1 * 33]); o.y = pk2(s[2 * 33], s[3 * 33]); o.z = pk2(s[4 * 33], s[5 * 33]); o.w = pk2(s[6 * 33], s[7 * 33]);
        *(v4u*)(WT + (size_t)(drow + n) * Kdst + k0 + 8 * c) = o; }
    LDS_WAIT(); asm volatile("" ::: "memory");
}
__device__ __forceinline__ void tr_mat(const float* W, int K, int N, int Npad, bf16* WT, int mode, int item, LAS float* scr, int lane) {
    const int nblk = Npad / 32, kb = item / nblk, nb = item - kb * nblk, n0 = 32 * nb;
    const int drow = (mode == 0) ? n0 : ((n0 >> 7) * 256 + (mode - 1) * 128 + (n0 & 127));
    tr_item(W, N, N, WT, K, 64 * kb, n0, drow, scr, lane);
}

struct Args { const float* in[27]; float* out; unsigned char* ws; int ph_lo, ph_hi; };

__device__ __forceinline__ void p0_prologue(Frame& F, const Args& A) {
    LAS float* scr = (LAS float*)(F.lds + RING_OFF + F.wave * 16384);
    unsigned char* ws = A.ws;
    const int gw = F.vcu * NWAVES + F.wave, NGW = F.G * NWAVES, lane = F.lane;
    constexpr int I_NSA_IN = (DM / 64) * (NSA_NPAD / 32), I_SQ = (DM / 64) * (DM / 32), I_FFN = (DM / 64) * (DFF / 32), I_FFD = (DFF / 64) * (DM / 32), I_DSA_IN = (DM / 64) * (DSA_NPAD / 32);
    constexpr int I_CMP = (4096 / 64) * (128 / 32), I_UK1 = (128 / 64) * (256 / 32), I_UV1 = (256 / 64) * (128 / 32);
    constexpr int I_MG1 = (DM / 64) * (DFFE / 32), I_MD1 = (DFFE / 64) * (DM / 32);
    constexpr int NITEMS = I_NSA_IN + 2 * I_SQ + 2 * I_FFN + I_FFD + I_DSA_IN + 2 * I_CMP + 16 * I_UK1 + 16 * I_UV1 + 16 * I_MG1 + 8 * I_MD1;
    for (int it = gw; it < NITEMS; it += NGW) {
        int r = it;
        if (r < I_NSA_IN) { tr_mat(A.in[2], DM, NSA_N, NSA_NPAD, (bf16*)(ws + WS_W_NSA_IN), 0, r, scr, lane); continue; } r -= I_NSA_IN;
        if (r < I_SQ) { tr_mat(A.in[9], DM, DM, DM, (bf16*)(ws + WS_W_NSA_OUT), 0, r, scr, lane); continue; } r -= I_SQ;
        if (r < I_SQ) { tr_mat(A.in[14], DM, DM, DM, (bf16*)(ws + WS_W_DSA_OUT), 0, r, scr, lane); continue; } r -= I_SQ;
        if (r < I_FFN) { tr_mat(A.in[15], DM, DFF, DFF, (bf16*)(ws + WS_W_FFN_GU), 1, r, scr, lane); continue; } r -= I_FFN;
        if (r < I_FFN) { tr_mat(A.in[16], DM, DFF, DFF, (bf16*)(ws + WS_W_FFN_GU), 2, r, scr, lane); continue; } r -= I_FFN;
        if (r < I_FFD) { tr_mat(A.in[17], DFF, DM, DM, (bf16*)(ws + WS_W_FFN_DN), 0, r, scr, lane); continue; } r -= I_FFD;
        if (r < I_DSA_IN) { tr_mat(A.in[10], DM, DSA_N, DSA_NPAD, (bf16*)(ws + WS_W_DSA_IN), 0, r, scr, lane); continue; } r -= I_DSA_IN;
        if (r < I_CMP) { tr_mat(A.in[4], 4096, 128, 128, (bf16*)(ws + WS_W_CMPK), 0, r, scr, lane); continue; } r -= I_CMP;
        if (r < I_CMP) { tr_mat(A.in[7], 4096, 128, 128, (bf16*)(ws + WS_W_CMPV), 0, r, scr, lane); continue; } r -= I_CMP;
        if (r < 16 * I_UK1) { const int h = r / I_UK1; tr_mat(A.in[12] + (size_t)h * 128 * 256, 128, 256, 256, (bf16*)(ws + WS_W_UK) + (size_t)h * 256 * 128, 0, r - h * I_UK1, scr, lane); continue; } r -= 16 * I_UK1;
        if (r < 16 * I_UV1) { const int h = r / I_UV1; tr_mat(A.in[13] + (size_t)h * 256 * 128, 256, 128, 128, (bf16*)(ws + WS_W_UV) + (size_t)h * 128 * 256, 0, r - h * I_UV1, scr, lane); continue; } r -= 16 * I_UV1;
        if (r < 8 * I_MG1) { const int e = r / I_MG1; tr_mat(A.in[20] + (size_t)e * DM * DFFE, DM, DFFE, DFFE, (bf16*)(ws + WS_W_MOE_GU) + (size_t)e * 2 * DFFE * DM, 1, r - e * I_MG1, scr, lane); continue; } r -= 8 * I_MG1;
        if (r < 8 * I_MG1) { const int e = r / I_MG1; tr_mat(A.in[21] + (size_t)e * DM * DFFE, DM, DFFE, DFFE, (bf16*)(ws + WS_W_MOE_GU) + (size_t)e * 2 * DFFE * DM, 2, r - e * I_MG1, scr, lane); continue; } r -= 8 * I_MG1;
        { const int e = r / I_MD1; tr_mat(A.in[22] + (size_t)e * DFFE * DM, DFFE, DM, DM, (bf16*)(ws + WS_W_MOE_DN) + (size_t)e * DM * DFFE, 0, r - e * I_MD1, scr, lane); }
    }
    { const float* x = A.in[0]; bf16* xb = (bf16*)(ws + WS_XB); const size_t n8 = (size_t)NTOK * DM / 8;
      for (size_t i = (size_t)F.vcu * 512 + F.tid; i < n8; i += (size_t)F.G * 512) { const f32x4 a = *(const f32x4*)(x + i * 8), b = *(const f32x4*)(x + i * 8 + 4);
          v4u o; o.x = pk2(a[0], a[1]); o.y = pk2(a[2], a[3]); o.z = pk2(b[0], b[1]); o.w = pk2(b[2], b[3]); *(v4u*)(xb + i * 8) = o; } }
    for (int it = gw; it < 64; it += NGW) { const int kv = it >> 5, ch = it & 31; const float* pe = A.in[kv ? 6 : 3]; const float* w1 = A.in[kv ? 7 : 4];
        float s0 = 0.f, s1 = 0.f;
        for (int k = ch * 128; k < ch * 128 + 128; ++k) { const float p = pe[k]; s0 += p * w1[(size_t)k * 128 + lane]; s1 += p * w1[(size_t)k * 128 + 64 + lane]; }
        float* cb = (float*)(ws + WS_CBIAS) + (size_t)(kv * 32 + ch) * 128; cb[lane] = s0; cb[64 + lane] = s1; }
}

typedef short s8v __attribute__((ext_vector_type(8)));
__device__ __forceinline__ s8v ld_frag(const bf16* p) { return *(const s8v*)p; }

__device__ __forceinline__ float gelu_tanh(float x) { const float u = 0.7978845608028654f * (x + 0.044715f * x * x * x); return 0.5f * x * (1.0f + tanhf(u)); }
__device__ __forceinline__ void p2_compress(Frame& F, const Args& A) {
    unsigned char* ws = A.ws; const int lane = F.lane;
    const bf16* P0 = (const bf16*)(ws + WS_P0);
    LAS float* hid = (LAS float*)(F.lds + RING_OFF + F.wave * 16384);
    const int gw = F.vcu * NWAVES + F.wave, NGW = F.G * NWAVES;
    const int r16 = lane & 15, kq = lane >> 4;
    if (gw < 16) { bf16* zp = (bf16*)(ws + ((gw & 1) ? WS_VCMP : WS_KCMP)) + ((size_t)(gw >> 1) * 512 + 511) * 128; zp[lane] = 0; zp[64 + lane] = 0; }
    for (int it = gw; it < 256; it += NGW) {
        const int kv = it >> 7, tile = it & 127;
        const bf16* W1T = (const bf16*)(ws + (kv ? WS_W_CMPV : WS_W_CMPK));
        const float* w2 = A.in[kv ? 8 : 5];
        const float* cbp = (const float*)(ws + WS_CBIAS) + (size_t)kv * 32 * 128;
        bf16* outp = (bf16*)(ws + (kv ? WS_VCMP : WS_KCMP));
        const int colbase = kv ? COL_VC : COL_KC;
        f32x4 acc[2][8];
#pragma unroll
        for (int m = 0; m < 2; ++m)
#pragma unroll
            for (int n = 0; n < 8; ++n) acc[m][n] = (f32x4){0.f, 0.f, 0.f, 0.f};
        const bf16* arow[2];
#pragma unroll
        for (int m = 0; m < 2; ++m) { int R = tile * 32 + m * 16 + r16; if (R > 4087) R = 4087; const int g = R & 3, bn = R >> 2, b = bn / NCMP, n = bn - b * NCMP;
            arow[m] = P0 + (size_t)(b * SEQ + 16 * n) * P0LD + colbase + g * 128 + kq * 8; }
        for (int ks = 0; ks < 128; ++ks) {
            const int l = ks >> 2, d0 = (ks & 3) * 32;
            s8v af[2], bfr[8];
#pragma unroll
            for (int m = 0; m < 2; ++m) af[m] = ld_frag(arow[m] + (size_t)l * P0LD + d0);
#pragma unroll
            for (int n = 0; n < 8; ++n) bfr[n] = ld_frag(W1T + (size_t)(n * 16 + r16) * 4096 + ks * 32 + kq * 8);
#pragma unroll
            for (int m = 0; m < 2; ++m)
#pragma unroll
                for (int n = 0; n < 8; ++n) acc[m][n] = __builtin_amdgcn_mfma_f32_16x16x32_bf16(af[m], bfr[n], acc[m][n], 0, 0, 0);
        }
#pragma unroll
        for (int n = 0; n < 8; ++n) { const int e = n * 16 + r16; float cb = 0.f; for (int ch = 0; ch < 32; ++ch) cb += cbp[ch * 128 + e];
#pragma unroll
            for (int m = 0; m < 2; ++m)
#pragma unroll
                for (int j = 0; j < 4; ++j) hid[(m * 16 + kq * 4 + j) * 128 + e] = gelu_tanh(acc[m][n][j] + cb); }
        WSYNC();
        for (int rr = 0; rr < 32; ++rr) { const int R = tile * 32 + rr; if (R > 4087) break;
            float s0 = 0.f, s1 = 0.f;
#pragma unroll 8
            for (int e = 0; e < 128; ++e) { const float hv = hid[rr * 128 + e]; s0 += hv * w2[e * 128 + lane]; s1 += hv * w2[e * 128 + 64 + lane]; }
            { const int g = R & 3, bn = R >> 2, b = bn / NCMP, n = bn - b * NCMP; bf16* op = outp + ((size_t)(b * 4 + g) * 512 + n) * 128; op[lane] = (bf16)f2bf(s0); op[64 + lane] = (bf16)f2bf(s1); } }
        WSYNC();
    }
}


namespace fa {
typedef float f32x16 __attribute__((ext_vector_type(16)));
typedef short s16x4 __attribute__((ext_vector_type(4)));
typedef unsigned u32x4v __attribute__((ext_vector_type(4)));
constexpr int SHM_K = 16384, SHM_V = 16384;
constexpr int OFF_V = 0, OFF_K = 2 * SHM_V, OFF_WS = 2 * SHM_V + 2 * SHM_K, OFF_LUT = OFF_WS + 8 * 256, OFF_MASK = OFF_LUT + 144 * 16 * 4, OFF_TAB = OFF_MASK + 1024;
constexpr int TABLD = 130;
constexpr float C2 = 1.4426950408889634f, THR = 8.f;
#define FA_KSWZ(row, colB) ((row) * 256 + ((colB) ^ (((row) & 7) << 4)))
#define FA_SBAR() __builtin_amdgcn_sched_barrier(0)
__device__ __forceinline__ int v_st(int k, int c) { const int kk = (k & ~0xC) | ((k & 4) << 1) | ((k & 8) >> 1); return ((kk >> 3) * 4 + (c >> 5)) * 512 + ((kk & 7) * 32 + (c & 31)) * 2; }
__device__ __forceinline__ int v_rd_base(int lane) { return ((lane & 3) << 3) | (((lane >> 2) & 3) << 6) | (((lane >> 4) & 1) << 5) | (((lane >> 5) & 1) << 8); }
constexpr int v_rd_off(int d0, int ks, int half) { return d0 * 512 + ks * 4096 + half * 2048; }
__device__ __forceinline__ int crow(int r, int hi) { return (r & 3) + 8 * (r >> 2) + 4 * hi; }
__device__ __forceinline__ unsigned cvtpk(float lo, float hi) { unsigned r; asm volatile("v_cvt_pk_bf16_f32 %0, %1, %2" : "=v"(r) : "v"(lo), "v"(hi)); return r; }

__device__ __forceinline__ void qkt(f32x16& p0, f32x16& p1, const LAS char* Kb, int r32, int hi, const bf16x8 (&qr)[8], float init) {
#pragma unroll
    for (int r = 0; r < 16; ++r) { p0[r] = init; p1[r] = init; }
    const LAS char* kb[4];
#pragma unroll
    for (int dd = 0; dd < 4; ++dd) kb[dd] = Kb + FA_KSWZ(r32, (dd * 16 + hi * 8) * 2);
#pragma unroll
    for (int d0 = 0; d0 < 8; ++d0) { const LAS char* a = kb[d0 & 3] + (d0 >> 2) * 128;
        const bf16x8 b0 = *(const LAS bf16x8*)a;
        const bf16x8 b1 = *(const LAS bf16x8*)(a + 32 * 256);
        p0 = __builtin_amdgcn_mfma_f32_32x32x16_bf16(b0, qr[d0], p0, 0, 0, 0);
        p1 = __builtin_amdgcn_mfma_f32_32x32x16_bf16(b1, qr[d0], p1, 0, 0, 0); }
}
__device__ __forceinline__ void pv_tile(f32x16 (&o)[4], int vb0, bf16x8 pa0, bf16x8 pa1, bf16x8 pa2, bf16x8 pa3) {
#define FA_TRRD(dst, off) asm volatile("ds_read_b64_tr_b16 %0, %1 offset:%2" : "=&v"(dst) : "v"(vb0), "i"(off) : "memory")
#define FA_PV_D0(d0) do { s16x4 l0, l1, l2, l3, h0, h1, h2, h3; constexpr int b_ = v_rd_off(d0, 0, 0); \
        FA_TRRD(l0, b_); FA_TRRD(h0, b_ + 2048); FA_TRRD(l1, b_ + 4096); FA_TRRD(h1, b_ + 6144); FA_TRRD(l2, b_ + 8192); FA_TRRD(h2, b_ + 10240); FA_TRRD(l3, b_ + 12288); FA_TRRD(h3, b_ + 14336); \
        asm volatile("s_waitcnt lgkmcnt(0)" ::: "memory"); FA_SBAR(); \
        o[d0] = __builtin_amdgcn_mfma_f32_32x32x16_bf16(pa0, (bf16x8){l0[0], l0[1], l0[2], l0[3], h0[0], h0[1], h0[2], h0[3]}, o[d0], 0, 0, 0); \
        o[d0] = __builtin_amdgcn_mfma_f32_32x32x16_bf16(pa1, (bf16x8){l1[0], l1[1], l1[2], l1[3], h1[0], h1[1], h1[2], h1[3]}, o[d0], 0, 0, 0); \
        o[d0] = __builtin_amdgcn_mfma_f32_32x32x16_bf16(pa2, (bf16x8){l2[0], l2[1], l2[2], l2[3], h2[0], h2[1], h2[2], h2[3]}, o[d0], 0, 0, 0); \
        o[d0] = __builtin_amdgcn_mfma_f32_32x32x16_bf16(pa3, (bf16x8){l3[0], l3[1], l3[2], l3[3], h3[0], h3[1], h3[2], h3[3]}, o[d0], 0, 0, 0); } while (0)
    FA_PV_D0(0); FA_PV_D0(1); FA_PV_D0(2); FA_PV_D0(3);
#undef FA_PV_D0
#undef FA_TRRD
}
__device__ __forceinline__ void partialSM(f32x16& p0, f32x16& p1, float& m_reg, float& alpha) {
    float pmax = p0[0];
#pragma unroll
    for (int r = 1; r < 16; ++r) pmax = fmaxf(pmax, p0[r]);
#pragma unroll
    for (int r = 0; r < 16; ++r) pmax = fmaxf(pmax, p1[r]);
    { auto rr = __builtin_amdgcn_permlane32_swap(__float_as_uint(pmax), __float_as_uint(pmax), false, false); pmax = fmaxf(__uint_as_float(rr[0]), __uint_as_float(rr[1])); }
    float mn;
    if (__all(pmax - m_reg <= THR)) { mn = m_reg; alpha = 1.f; }
    else { mn = fmaxf(m_reg, pmax); alpha = __builtin_amdgcn_exp2f((m_reg - mn) * C2); m_reg = mn; }
    const float mnL = -mn * C2;
#pragma unroll
    for (int r = 0; r < 16; ++r) { p0[r] = __builtin_amdgcn_exp2f(fmaf(p0[r], C2, mnL)); p1[r] = __builtin_amdgcn_exp2f(fmaf(p1[r], C2, mnL)); }
}
__device__ __forceinline__ float finishSM(const f32x16& p0, const f32x16& p1, bf16x8& pa0, bf16x8& pa1, bf16x8& pa2, bf16x8& pa3) {
    float ps = 0.f;
#pragma unroll
    for (int r = 0; r < 16; ++r) ps += p0[r];
#pragma unroll
    for (int r = 0; r < 16; ++r) ps += p1[r];
    { auto rr = __builtin_amdgcn_permlane32_swap(__float_as_uint(ps), __float_as_uint(ps), false, false); ps = __uint_as_float(rr[0]) + __uint_as_float(rr[1]); }
#define FA_PK4(P, B_, OUT) do { unsigned a0 = cvtpk(P[B_ + 0], P[B_ + 1]), a1 = cvtpk(P[B_ + 2], P[B_ + 3]); unsigned b0 = cvtpk(P[B_ + 4], P[B_ + 5]), b1 = cvtpk(P[B_ + 6], P[B_ + 7]); \
        auto r0 = __builtin_amdgcn_permlane32_swap(a0, b0, false, false); auto r1 = __builtin_amdgcn_permlane32_swap(a1, b1, false, false); \
        u32x4v w = {r0[0], r1[0], r0[1], r1[1]}; OUT = *reinterpret_cast<bf16x8*>(&w); } while (0)
    FA_PK4(p0, 0, pa0); FA_PK4(p0, 8, pa1); FA_PK4(p1, 0, pa2); FA_PK4(p1, 8, pa3);
#undef FA_PK4
    return ps;
}
__device__ __forceinline__ void rescale(f32x16 (&o)[4], float alpha, LAS float* al_l, int r32, int hi) {
    if (__any(alpha < 1.f)) { if (hi == 0) al_l[r32] = alpha; asm volatile("s_waitcnt lgkmcnt(0)" ::: "memory");
#pragma unroll
        for (int r = 0; r < 16; ++r) { const float a = al_l[crow(r, hi)];
#pragma unroll
            for (int d = 0; d < 4; ++d) o[d][r] *= a; }
        asm volatile("s_waitcnt lgkmcnt(0)" ::: "memory"); }
}
__device__ __forceinline__ void mask_tile(f32x16& p0, f32x16& p1, int dq, unsigned W) {
    const float NEG = -__builtin_inff();
#pragma unroll
    for (int r = 0; r < 16; ++r) { const int c = (r & 3) + 8 * (r >> 2);
        if ((unsigned)(dq - c) >= W) p0[r] = NEG;
        if ((unsigned)(dq - c - 32) >= W) p1[r] = NEG; }
}
__device__ __forceinline__ void mask_all(f32x16& p0, f32x16& p1, bool keep) {
    const float NEG = -__builtin_inff();
#pragma unroll
    for (int r = 0; r < 16; ++r) { p0[r] = keep ? p0[r] : NEG; p1[r] = keep ? p1[r] : NEG; }
}
__device__ __forceinline__ void bias_near(f32x16& p0, f32x16& p1, int dq, int step, const LAS float* lutcol) {
#pragma unroll
    for (int r = 0; r < 16; ++r) { const int c = (r & 3) + 8 * (r >> 2);
        const int d0 = min(max((dq - c) * step, 0), 128), d1 = min(max((dq - c - 32) * step, 0), 128);
        p0[r] += lutcol[d0 * 16]; p1[r] += lutcol[d1 * 16]; }
}
struct Stage { bf16x8 k0, k1, v0, v1; };
__device__ __forceinline__ void stage_load(Stage& S, const bf16* Kp, const bf16* Vp, size_t ld, int row0, int maxrow, int sr, int sc) {
    const int ra = min(row0 + sr, maxrow), rb = min(row0 + 32 + sr, maxrow);
    S.k0 = *(const bf16x8*)(Kp + (size_t)ra * ld + sc); S.k1 = *(const bf16x8*)(Kp + (size_t)rb * ld + sc);
    S.v0 = *(const bf16x8*)(Vp + (size_t)ra * ld + sc); S.v1 = *(const bf16x8*)(Vp + (size_t)rb * ld + sc);
}
__device__ __forceinline__ void stage_write(const Stage& S, LAS char* Kb, LAS char* Vb, int kws, int vst0, int vst1) {
    *(LAS bf16x8*)(Kb + kws) = S.k0; *(LAS bf16x8*)(Kb + kws + 32 * 256) = S.k1;
    *(LAS bf16x8*)(Vb + vst0) = S.v0; *(LAS bf16x8*)(Vb + vst1) = S.v1;
}
}

struct NsaLane { int wid, lane, r32, hi, ql, j, sr, sc, kws, vst0, vst1, vrd; };
__device__ __forceinline__ NsaLane nsa_lane(const Frame& F) {
    NsaLane L; L.wid = F.wave; L.lane = F.lane; L.r32 = F.lane & 31; L.hi = F.lane >> 5; L.ql = L.r32 >> 2; L.j = L.r32 & 3;
    L.sr = F.tid >> 4; L.sc = (F.tid & 15) * 8; L.kws = FA_KSWZ(L.sr, L.sc * 2); L.vst0 = fa::v_st(L.sr, L.sc); L.vst1 = fa::v_st(32 + L.sr, L.sc); L.vrd = fa::v_rd_base(F.lane);
    return L;
}
__device__ __forceinline__ void nsa_load_q(bf16x8 (&qr)[8], const bf16* P0, int tok0, int g, const NsaLane& L) {
    const bf16* qp = P0 + (size_t)(tok0 + L.wid * 8 + L.ql) * P0LD + (g * 4 + L.j) * 128 + L.hi * 8;
#pragma unroll
    for (int d0 = 0; d0 < 8; ++d0) qr[d0] = *(const bf16x8*)(qp + d0 * 16);
}
__device__ __forceinline__ void nsa_lut(Frame& F, const Args& A) {
    LAS float* lut = (LAS float*)(F.lds + RING_OFF + fa::OFF_LUT);
    for (int i = F.tid; i < 144 * 16; i += 512) { const int n = i >> 4, h = i & 15; lut[i] = A.in[1][rel_bucket(n) * 16 + h]; }
    __syncthreads();
}
template <int MODE>
__device__ __forceinline__ void nsa_store(const fa::f32x16 (&o)[4], float l_reg, LAS float* li_l, const float* GL, float* OACC, bf16* OATT, int tok0, int g, int br, const NsaLane& L) {
    if (L.hi == 0) li_l[L.r32] = l_reg;
    asm volatile("s_waitcnt lgkmcnt(0)" ::: "memory");
#pragma unroll
    for (int r = 0; r < 16; ++r) { const int row = fa::crow(r, L.hi), tok = tok0 + L.wid * 8 + (row >> 2), h = g * 4 + (row & 3);
        const float l = li_l[row]; const float gl = GL[(size_t)tok * 48 + h * 3 + br];
        const float sc = (l > 0.f) ? __builtin_amdgcn_rcpf(l) / (1.0f + __expf(-gl)) : 0.f;
        float* ap = OACC + (size_t)tok * DM + h * 128 + L.r32;
#pragma unroll
        for (int d0 = 0; d0 < 4; ++d0) { float v = o[d0][r] * sc;
            if (MODE == 0) ap[d0 * 32] = v;
            else if (MODE == 1) ap[d0 * 32] += v;
            else { v += ap[d0 * 32]; const float vn = __shfl_xor(v, 1); if ((L.r32 & 1) == 0) *(unsigned*)(OATT + (size_t)tok * DM + h * 128 + d0 * 32 + L.r32) = fa::cvtpk(v, vn); } } }
    asm volatile("s_waitcnt lgkmcnt(0)" ::: "memory");
}

__device__ __forceinline__ void p3a_nsa_cmp(Frame& F, const Args& A) {
    unsigned char* ws = A.ws; const NsaLane L = nsa_lane(F);
    const bf16* P0 = (const bf16*)(ws + WS_P0); const bf16* KCB = (const bf16*)(ws + WS_KCMP); const bf16* VCB = (const bf16*)(ws + WS_VCMP);
    const float* GL = (const float*)(ws + WS_GL); float* OACC = (float*)(ws + WS_Z); unsigned* SELM = (unsigned*)(ws + WS_SELM);
    nsa_lut(F, A);
    LAS char* lds = (LAS char*)(F.lds + RING_OFF);
    LAS float* wsf = (LAS float*)(lds + fa::OFF_WS) + L.wid * 64; LAS float* li_l = wsf; LAS float* al_l = wsf + 32;
    const LAS float* lut = (const LAS float*)(lds + fa::OFF_LUT);
    LAS float* tab = (LAS float*)(lds + fa::OFF_TAB);
    for (int ui = 0; ui < 2 * ((512 - F.vcu + F.G - 1) / F.G); ++ui) {
        const int p = F.vcu + (ui >> 1) * F.G, bg = p >> 6, y = p & 63, qb = (ui & 1) ? 127 - y : y, b = bg >> 2, g = bg & 3;
        const int tok0 = b * SEQ + qb * 64;
        bf16x8 qr[8]; nsa_load_q(qr, P0, tok0, g, L);
        const int trow = qb * 64 + L.wid * 8 + L.ql;
        const int h = g * 4 + L.j; const LAS float* lutcol = lut + h; const float bias_far = lutcol[128 * 16];
        const int nmaxrow = (trow >= 31) ? (trow - 31) >> 4 : -1;
        const int NT = (4 * qb + 3 + 63) >> 6;
        const bf16* Kg = KCB + (size_t)(b * 4 + g) * 512 * 128; const bf16* Vg = VCB + (size_t)(b * 4 + g) * 512 * 128;
        for (int i = F.tid; i < 64 * fa::TABLD; i += 512) tab[i] = 0.f;
        float m_reg = -1e30f, l_reg = 0.f;
        fa::Stage S;
        const int rem16 = (trow >= 31) ? ((trow - 31) & 15) : 0;
        fa::stage_load(S, Kg, Vg, 128, 0, 511, L.sr, L.sc); asm volatile("s_waitcnt vmcnt(0)" ::: "memory");
        fa::stage_write(S, lds + fa::OFF_K, lds + fa::OFF_V, L.kws, L.vst0, L.vst1);
        __syncthreads();
#pragma unroll 1
        for (int t = 0; t < NT; ++t) {
            const int buf = t & 1;
            if (t + 1 < NT) fa::stage_load(S, Kg, Vg, 128, (t + 1) * 64, 511, L.sr, L.sc);
            fa::f32x16 p0, p1;
            const bool farT = (qb * 64 + L.wid * 8) - 31 - 16 * (t * 64 + 63) >= 128;
            fa::qkt(p0, p1, lds + fa::OFF_K + buf * fa::SHM_K, L.r32, L.hi, qr, farT ? bias_far : 0.f);
            const int dq = nmaxrow - t * 64 - 4 * L.hi;
            if (!farT) fa::bias_near(p0, p1, dq, 16, lutcol + rem16 * 16);
            fa::mask_tile(p0, p1, dq, 0x40000000u);
            float alpha; fa::partialSM(p0, p1, m_reg, alpha);
            float ps = 0.f;
#pragma unroll
            for (int r = 0; r < 16; ++r) ps += p0[r] + p1[r];
            { auto rr = __builtin_amdgcn_permlane32_swap(__float_as_uint(ps), __float_as_uint(ps), false, false); ps = __uint_as_float(rr[0]) + __uint_as_float(rr[1]); }
            l_reg = l_reg * alpha + ps;
            if (t + 1 < NT) { asm volatile("s_waitcnt vmcnt(0)" ::: "memory"); fa::stage_write(S, lds + fa::OFF_K + (buf ^ 1) * fa::SHM_K, lds + fa::OFF_V + (buf ^ 1) * fa::SHM_V, L.kws, L.vst0, L.vst1); }
            __syncthreads();
        }
        fa::f32x16 o[4];
#pragma unroll
        for (int d = 0; d < 4; ++d)
#pragma unroll
            for (int r = 0; r < 16; ++r) o[d][r] = 0.f;
        fa::stage_load(S, Kg, Vg, 128, 0, 511, L.sr, L.sc); asm volatile("s_waitcnt vmcnt(0)" ::: "memory");
        fa::stage_write(S, lds + fa::OFF_K, lds + fa::OFF_V, L.kws, L.vst0, L.vst1);
        __syncthreads();
        const float inv_l = (l_reg > 0.f) ? 1.0f / l_reg : 0.f; const float mnL = -m_reg * fa::C2;
#pragma unroll 1
        for (int t = 0; t < NT; ++t) {
            const int buf = t & 1;
            if (t + 1 < NT) fa::stage_load(S, Kg, Vg, 128, (t + 1) * 64, 511, L.sr, L.sc);
            fa::f32x16 p0, p1;
            const bool farT = (qb * 64 + L.wid * 8) - 31 - 16 * (t * 64 + 63) >= 128;
            fa::qkt(p0, p1, lds + fa::OFF_K + buf * fa::SHM_K, L.r32, L.hi, qr, farT ? bias_far : 0.f);
            const int dq = nmaxrow - t * 64 - 4 * L.hi;
            if (!farT) fa::bias_near(p0, p1, dq, 16, lutcol + rem16 * 16);
            fa::mask_tile(p0, p1, dq, 0x40000000u);
#pragma unroll
            for (int r = 0; r < 16; ++r) { p0[r] = __builtin_amdgcn_exp2f(fmaf(p0[r], fa::C2, mnL)) * inv_l; p1[r] = __builtin_amdgcn_exp2f(fmaf(p1[r], fa::C2, mnL)) * inv_l; }
            LAS float* tb = tab + (L.wid * 8 + L.ql) * fa::TABLD + t * 16 + L.hi;
#pragma unroll
            for (int half = 0; half < 2; ++half)
#pragma unroll
                for (int gq = 0; gq < 4; ++gq) { const fa::f32x16& pp = half ? p1 : p0;
                    float s4 = pp[4 * gq] + pp[4 * gq + 1] + pp[4 * gq + 2] + 0.5f * pp[4 * gq + 3], cr = 0.5f * pp[4 * gq + 3];
                    s4 += __shfl_xor(s4, 1); s4 += __shfl_xor(s4, 2); cr += __shfl_xor(cr, 1); cr += __shfl_xor(cr, 2);
                    if (L.j == 0) { __hip_atomic_fetch_add(tb + half * 8 + 2 * gq, s4, __ATOMIC_RELAXED, __HIP_MEMORY_SCOPE_WORKGROUP); __hip_atomic_fetch_add(tb + half * 8 + 2 * gq + 1, cr, __ATOMIC_RELAXED, __HIP_MEMORY_SCOPE_WORKGROUP); } }
            bf16x8 a0, a1, a2, a3; (void)fa::finishSM(p0, p1, a0, a1, a2, a3);
            fa::pv_tile(o, (int)(uintptr_t)(lds + fa::OFF_V + buf * fa::SHM_V) + L.vrd, a0, a1, a2, a3);
            if (t + 1 < NT) { asm volatile("s_waitcnt vmcnt(0)" ::: "memory"); fa::stage_write(S, lds + fa::OFF_K + (buf ^ 1) * fa::SHM_K, lds + fa::OFF_V + (buf ^ 1) * fa::SHM_V, L.kws, L.vst0, L.vst1); }
            __syncthreads();
        }
        nsa_store<0>(o, (l_reg > 0.f) ? 1.0f : 0.f, li_l, GL, OACC, nullptr, tok0, g, 0, L);
        __syncthreads();
        for (int qi = 0; qi < 8; ++qi) { const int ql = L.wid * 8 + qi;
            bool s0 = false, s1 = false;
            if (qb < 16) { s0 = (L.lane <= qb); }
            else {
                float v0 = (L.lane >= 1 && L.lane <= qb - 2) ? tab[ql * fa::TABLD + L.lane] : -1.0f, v1 = (L.lane + 64 <= qb - 2) ? tab[ql * fa::TABLD + L.lane + 64] : -1.0f;
                s0 = (L.lane == 0) || (L.lane == qb) || (L.lane == qb - 1); s1 = (L.lane + 64 == qb) || (L.lane + 64 == qb - 1);
                if (s0) v0 = -3e38f; if (s1) v1 = -3e38f;
#pragma unroll 1
                for (int k = 0; k < 13; ++k) { float bv = v0; int bi = L.lane; if (v1 > v0) { bv = v1; bi = L.lane + 64; }
#pragma unroll
                    for (int of = 1; of < 64; of <<= 1) { const float ov = __shfl_xor(bv, of); const int oi = __shfl_xor(bi, of); if (ov > bv || (ov == bv && oi < bi)) { bv = ov; bi = oi; } }
                    if (bi == L.lane) { v0 = -3e38f; s0 = true; } if (bi == L.lane + 64) { v1 = -3e38f; s1 = true; } }
            }
            const unsigned long long b0 = __ballot(s0), b1 = __ballot(s1);
            if (L.lane == 0) { uint4 mv; mv.x = (unsigned)b0; mv.y = (unsigned)(b0 >> 32); mv.z = (unsigned)b1; mv.w = (unsigned)(b1 >> 32); *(uint4*)(SELM + ((size_t)(tok0 + ql) * 4 + g) * 4) = mv; }
        }
        __syncthreads();
    }
}
__device__ __forceinline__ void p3b_nsa_sel(Frame& F, const Args& A) {
    unsigned char* ws = A.ws; const NsaLane L = nsa_lane(F);
    const bf16* P0 = (const bf16*)(ws + WS_P0); const float* GL = (const float*)(ws + WS_GL); float* OACC = (float*)(ws + WS_Z); const unsigned* SELM = (const unsigned*)(ws + WS_SELM);
    nsa_lut(F, A);
    LAS char* lds = (LAS char*)(F.lds + RING_OFF);
    LAS float* wsf = (LAS float*)(lds + fa::OFF_WS) + L.wid * 64; LAS float* li_l = wsf; LAS float* al_l = wsf + 32;
    const LAS float* lut = (const LAS float*)(lds + fa::OFF_LUT);
    for (int ui = 0; ui < 2 * ((512 - F.vcu + F.G - 1) / F.G); ++ui) {
        const int p = F.vcu + (ui >> 1) * F.G, bg = p >> 6, y = p & 63, qb = (ui & 1) ? 127 - y : y, b = bg >> 2, g = bg & 3;
        const int tok0 = b * SEQ + qb * 64;
        bf16x8 qr[8]; nsa_load_q(qr, P0, tok0, g, L);
        const int trow = qb * 64 + L.wid * 8 + L.ql;
        const int h = g * 4 + L.j; const LAS float* lutcol = lut + h; const float bias_far = lutcol[128 * 16];
        const uint4 mv = *(const uint4*)(SELM + ((size_t)(tok0 + L.wid * 8 + L.ql) * 4 + g) * 4);
        const bf16* Kg = P0 + (size_t)b * SEQ * P0LD + COL_KS + g * 128; const bf16* Vg = P0 + (size_t)b * SEQ * P0LD + COL_VS + g * 128;
        const int NT = qb + 1;
        float m_reg = -1e30f, l_reg = 0.f; fa::f32x16 o[4];
#pragma unroll
        for (int d = 0; d < 4; ++d)
#pragma unroll
            for (int r = 0; r < 16; ++r) o[d][r] = 0.f;
        fa::Stage S;
        fa::stage_load(S, Kg, Vg, P0LD, 0, SEQ - 1, L.sr, L.sc); asm volatile("s_waitcnt vmcnt(0)" ::: "memory");
        fa::stage_write(S, lds + fa::OFF_K, lds + fa::OFF_V, L.kws, L.vst0, L.vst1);
        __syncthreads();
#pragma unroll 1
        for (int t = 0; t < NT; ++t) {
            const int buf = t & 1;
            if (t + 1 < NT) fa::stage_load(S, Kg, Vg, P0LD, (t + 1) * 64, SEQ - 1, L.sr, L.sc);
            fa::f32x16 p0, p1;
            const bool farT = (qb * 64 + L.wid * 8) - (t * 64 + 63) >= 128;
            fa::qkt(p0, p1, lds + fa::OFF_K + buf * fa::SHM_K, L.r32, L.hi, qr, farT ? bias_far : 0.f);
            const int dq = trow - t * 64 - 4 * L.hi;
            if (!farT) fa::bias_near(p0, p1, dq, 1, lutcol);
            const unsigned word = (t < 32) ? mv.x : (t < 64) ? mv.y : (t < 96) ? mv.z : mv.w;
            fa::mask_all(p0, p1, ((word >> (t & 31)) & 1u) != 0u);
            if (t == qb) fa::mask_tile(p0, p1, dq, 0x40000000u);
            float alpha; fa::partialSM(p0, p1, m_reg, alpha);
            fa::rescale(o, alpha, al_l, L.r32, L.hi);
            bf16x8 a0, a1, a2, a3; const float ps = fa::finishSM(p0, p1, a0, a1, a2, a3); l_reg = l_reg * alpha + ps;
            fa::pv_tile(o, (int)(uintptr_t)(lds + fa::OFF_V + buf * fa::SHM_V) + L.vrd, a0, a1, a2, a3);
            if (t + 1 < NT) { asm volatile("s_waitcnt vmcnt(0)" ::: "memory"); fa::stage_write(S, lds + fa::OFF_K + (buf ^ 1) * fa::SHM_K, lds + fa::OFF_V + (buf ^ 1) * fa::SHM_V, L.kws, L.vst0, L.vst1); }
            __syncthreads();
        }
        nsa_store<1>(o, l_reg, li_l, GL, OACC, nullptr, tok0, g, 1, L);
        __syncthreads();
    }
}
__device__ __forceinline__ void p3c_nsa_win(Frame& F, const Args& A) {
    unsigned char* ws = A.ws; const NsaLane L = nsa_lane(F);
    const bf16* P0 = (const bf16*)(ws + WS_P0); const float* GL = (const float*)(ws + WS_GL); float* OACC = (float*)(ws + WS_Z); bf16* OATT = (bf16*)(ws + WS_OATT0);
    nsa_lut(F, A);
    LAS char* lds = (LAS char*)(F.lds + RING_OFF);
    LAS float* wsf = (LAS float*)(lds + fa::OFF_WS) + L.wid * 64; LAS float* li_l = wsf; LAS float* al_l = wsf + 32;
    const LAS float* lut = (const LAS float*)(lds + fa::OFF_LUT);
    for (int u = F.vcu; u < 1024; u += F.G) {
        const int bg = u >> 7, qb = u & 127, b = bg >> 2, g = bg & 3;
        const int tok0 = b * SEQ + qb * 64;
        bf16x8 qr[8]; nsa_load_q(qr, P0, tok0, g, L);
        const int trow = qb * 64 + L.wid * 8 + L.ql;
        const int h = g * 4 + L.j; const LAS float* lutcol = lut + h; const float bias_far = lutcol[128 * 16];
        const bf16* Kg = P0 + (size_t)b * SEQ * P0LD + COL_KW + g * 128; const bf16* Vg = P0 + (size_t)b * SEQ * P0LD + COL_VW + g * 128;
        const int t0 = max(0, qb - 8), NT = qb - t0 + 1;
        float m_reg = -1e30f, l_reg = 0.f; fa::f32x16 o[4];
#pragma unroll
        for (int d = 0; d < 4; ++d)
#pragma unroll
            for (int r = 0; r < 16; ++r) o[d][r] = 0.f;
        fa::Stage S;
        fa::stage_load(S, Kg, Vg, P0LD, t0 * 64, SEQ - 1, L.sr, L.sc); asm volatile("s_waitcnt vmcnt(0)" ::: "memory");
        fa::stage_write(S, lds + fa::OFF_K, lds + fa::OFF_V, L.kws, L.vst0, L.vst1);
        __syncthreads();
#pragma unroll 1
        for (int tt = 0; tt < NT; ++tt) {
            const int buf = tt & 1, t = t0 + tt;
            if (tt + 1 < NT) fa::stage_load(S, Kg, Vg, P0LD, (t + 1) * 64, SEQ - 1, L.sr, L.sc);
            fa::f32x16 p0, p1;
            const bool farT = (qb * 64 + L.wid * 8) - (t * 64 + 63) >= 128;
            fa::qkt(p0, p1, lds + fa::OFF_K + buf * fa::SHM_K, L.r32, L.hi, qr, farT ? bias_far : 0.f);
            const int dq = trow - t * 64 - 4 * L.hi;
            if (!farT) fa::bias_near(p0, p1, dq, 1, lutcol);
            if (t == qb || t == t0) fa::mask_tile(p0, p1, dq, 512u);
            float alpha; fa::partialSM(p0, p1, m_reg, alpha);
            fa::rescale(o, alpha, al_l, L.r32, L.hi);
            bf16x8 a0, a1, a2, a3; const float ps = fa::finishSM(p0, p1, a0, a1, a2, a3); l_reg = l_reg * alpha + ps;
            fa::pv_tile(o, (int)(uintptr_t)(lds + fa::OFF_V + buf * fa::SHM_V) + L.vrd, a0, a1, a2, a3);
            if (tt + 1 < NT) { asm volatile("s_waitcnt vmcnt(0)" ::: "memory"); fa::stage_write(S, lds + fa::OFF_K + (buf ^ 1) * fa::SHM_K, lds + fa::OFF_V + (buf ^ 1) * fa::SHM_V, L.kws, L.vst0, L.vst1); }
            __syncthreads();
        }
        nsa_store<2>(o, l_reg, li_l, GL, OACC, OATT, tok0, g, 2, L);
        __syncthreads();
    }
}

template <bool ROUTE>
__device__ __forceinline__ void ln_phase(Frame& F, const Args& A, const float* Z, const float* gam, const float* bet, float* XF, bf16* XB) {
    const int gw = F.vcu * NWAVES + F.wave, NGW = F.G * NWAVES, lane = F.lane;
    LAS float* wrl = (LAS float*)(F.lds + RING_OFF);
    if (ROUTE) { for (int i = F.tid; i < DM * 8 / 4; i += 512) *(LAS f32x4*)(wrl + i * 4) = *(const f32x4*)(A.in[18] + i * 4); __syncthreads(); }
    for (int row = gw; row < NTOK; row += NGW) {
        const f32x4* zr = (const f32x4*)(Z + (size_t)row * DM) + lane;
        f32x4 v[8]; float s = 0.f;
#pragma unroll
        for (int j = 0; j < 8; ++j) { v[j] = zr[64 * j]; s += (v[j][0] + v[j][1]) + (v[j][2] + v[j][3]); }
        const float mean = wave_sum(s) * (1.f / DM); float s2 = 0.f;
#pragma unroll
        for (int j = 0; j < 8; ++j) { v[j] = v[j] - mean; s2 += (v[j][0] * v[j][0] + v[j][1] * v[j][1]) + (v[j][2] * v[j][2] + v[j][3] * v[j][3]); }
        const float rstd = 1.f / sqrtf(wave_sum(s2) * (1.f / DM) + LN_EPS);
        float lg[8];
#pragma unroll
        for (int e = 0; e < 8; ++e) lg[e] = 0.f;
#pragma unroll
        for (int j = 0; j < 8; ++j) { const int c = 4 * lane + 256 * j; const f32x4 gg = *(const f32x4*)(gam + c), bb = *(const f32x4*)(bet + c);
            const f32x4 x = v[j] * rstd * gg + bb;
            *(f32x4*)(XF + (size_t)row * DM + c) = x;
            uint2 o; o.x = pk2(x[0], x[1]); o.y = pk2(x[2], x[3]); *(uint2*)(XB + (size_t)row * DM + c) = o;
            asm volatile("" ::: "memory");
            if (ROUTE) { const LAS float* wr = wrl + c * 8;
#pragma unroll
                for (int q = 0; q < 4; ++q) { const f32x4 w0 = *(const LAS f32x4*)(wr + q * 8), w1 = *(const LAS f32x4*)(wr + q * 8 + 4);
                    lg[0] += x[q] * w0[0]; lg[1] += x[q] * w0[1]; lg[2] += x[q] * w0[2]; lg[3] += x[q] * w0[3]; lg[4] += x[q] * w1[0]; lg[5] += x[q] * w1[1]; lg[6] += x[q] * w1[2]; lg[7] += x[q] * w1[3]; }  asm volatile("" ::: "memory"); }
        }
        if (ROUTE) {
#pragma unroll
            for (int e = 0; e < 8; ++e) lg[e] = wave_sum(lg[e]) + A.in[19][e];
            int e0 = 0; float l0 = lg[0];
#pragma unroll
            for (int e = 1; e < 8; ++e) if (lg[e] > l0) { l0 = lg[e]; e0 = e; }
            int e1 = -1; float l1 = -3e38f;
#pragma unroll
            for (int e = 0; e < 8; ++e) if (e != e0 && lg[e] > l1) { l1 = lg[e]; e1 = e; }
            const float w0 = 1.0f / (1.0f + __expf(l1 - l0)), w1 = 1.0f - w0;
            if (lane == 0) {
                const unsigned p0 = __hip_atomic_fetch_add((unsigned*)(F.ctl + CW_MOECNT + 64 * e0), 1u, __ATOMIC_RELAXED, __HIP_MEMORY_SCOPE_AGENT);
                const unsigned p1 = __hip_atomic_fetch_add((unsigned*)(F.ctl + CW_MOECNT + 64 * e1), 1u, __ATOMIC_RELAXED, __HIP_MEMORY_SCOPE_AGENT);
                int* re = (int*)(A.ws + WS_ROUTE); int* rp = re + 2 * NTOK; float* rw = (float*)(rp + 2 * NTOK);
                re[2 * row] = e0; re[2 * row + 1] = e1; rp[2 * row] = (int)p0; rp[2 * row + 1] = (int)p1; rw[2 * row] = w0; rw[2 * row + 1] = w1;
            }
        }
    }
}

__device__ __forceinline__ void ln_route_phase(Frame& F, const Args& A, const float* Z, const float* gam, const float* bet, float* XF, bf16* XB) {
    const int gw = F.vcu * NWAVES + F.wave, NGW = F.G * NWAVES, lane = F.lane;
    LAS float* wrl = (LAS float*)(F.lds + RING_OFF);
    LAS float* rowb = (LAS float*)(F.lds + RING_OFF + 65536 + F.wave * 8192);
    for (int i = F.tid; i < DM * 8 / 4; i += 512) *(LAS f32x4*)(wrl + i * 4) = *(const f32x4*)(A.in[18] + i * 4);
    __syncthreads();
    for (int row = gw; row < NTOK; row += NGW) {
        float s = 0.f, s2 = 0.f;
#pragma unroll 1
        for (int j = 0; j < 8; ++j) { const f32x4 v = *(const f32x4*)(Z + (size_t)row * DM + 4 * lane + 256 * j); *(LAS f32x4*)(rowb + 4 * lane + 256 * j) = v;
            s += (v[0] + v[1]) + (v[2] + v[3]); }
        const float mean = wave_sum(s) * (1.f / DM);
#pragma unroll 1
        for (int j = 0; j < 8; ++j) { const f32x4 v = *(const LAS f32x4*)(rowb + 4 * lane + 256 * j) - mean; s2 += (v[0] * v[0] + v[1] * v[1]) + (v[2] * v[2] + v[3] * v[3]); }
        const float rstd = 1.f / sqrtf(wave_sum(s2) * (1.f / DM) + LN_EPS);
        float lg[8];
#pragma unroll
        for (int e = 0; e < 8; ++e) lg[e] = 0.f;
#pragma unroll 1
        for (int j = 0; j < 8; ++j) { const int c = 4 * lane + 256 * j; const f32x4 gg = *(const f32x4*)(gam + c), bb = *(const f32x4*)(bet + c);
            const f32x4 x = (*(const LAS f32x4*)(rowb + c) - mean) * rstd * gg + bb;
            *(f32x4*)(XF + (size_t)row * DM + c) = x;
            uint2 o; o.x = pk2(x[0], x[1]); o.y = pk2(x[2], x[3]); *(uint2*)(XB + (size_t)row * DM + c) = o;
            const LAS float* wr = wrl + c * 8;
#pragma unroll
            for (int q = 0; q < 4; ++q) { const f32x4 w0 = *(const LAS f32x4*)(wr + q * 8), w1 = *(const LAS f32x4*)(wr + q * 8 + 4);
                lg[0] += x[q] * w0[0]; lg[1] += x[q] * w0[1]; lg[2] += x[q] * w0[2]; lg[3] += x[q] * w0[3]; lg[4] += x[q] * w1[0]; lg[5] += x[q] * w1[1]; lg[6] += x[q] * w1[2]; lg[7] += x[q] * w1[3]; } }
#pragma unroll
        for (int e = 0; e < 8; ++e) lg[e] = wave_sum(lg[e]) + A.in[19][e];
        int e0 = 0; float l0 = lg[0];
#pragma unroll
        for (int e = 1; e < 8; ++e) if (lg[e] > l0) { l0 = lg[e]; e0 = e; }
        int e1 = -1; float l1 = -3e38f;
#pragma unroll
        for (int e = 0; e < 8; ++e) if (e != e0 && lg[e] > l1) { l1 = lg[e]; e1 = e; }
        const float w0 = 1.0f / (1.0f + __expf(l1 - l0)), w1 = 1.0f - w0;
        if (lane == 0) {
            const unsigned p0 = __hip_atomic_fetch_add((unsigned*)(F.ctl + CW_MOECNT + 64 * e0), 1u, __ATOMIC_RELAXED, __HIP_MEMORY_SCOPE_AGENT);
            const unsigned p1 = __hip_atomic_fetch_add((unsigned*)(F.ctl + CW_MOECNT + 64 * e1), 1u, __ATOMIC_RELAXED, __HIP_MEMORY_SCOPE_AGENT);
            int* re = (int*)(A.ws + WS_ROUTE); int* rp = re + 2 * NTOK; float* rw = (float*)(rp + 2 * NTOK);
            re[2 * row] = e0; re[2 * row + 1] = e1; rp[2 * row] = (int)p0; rp[2 * row + 1] = (int)p1; rw[2 * row] = w0; rw[2 * row + 1] = w1;
        }
        WSYNC();
    }
    __syncthreads();
}

__device__ __forceinline__ void p10_dsa_prep(Frame& F, const Args& A) {
    unsigned char* ws = A.ws; const int lane = F.lane;
    const int gw = F.vcu * NWAVES + F.wave, NGW = F.G * NWAVES;
    { const float* CR = (const float*)(ws + WS_CRAW); bf16* CN = (bf16*)(ws + WS_CN); const f32x4 gg = *(const f32x4*)(A.in[11] + 4 * lane);
      for (int row = gw; row < NTOK; row += NGW) { const f32x4 v = *(const f32x4*)(CR + (size_t)row * KVR + 4 * lane);
          const float ss = wave_sum(v[0] * v[0] + v[1] * v[1] + v[2] * v[2] + v[3] * v[3]); const float r = 1.f / sqrtf(ss * (1.f / KVR) + RMS_EPS);
          uint2 o; o.x = pk2(v[0] * r * gg[0], v[1] * r * gg[1]); o.y = pk2(v[2] * r * gg[2], v[3] * r * gg[3]); *(uint2*)(CN + (size_t)row * KVR + 4 * lane) = o;
          if (lane < 16) { const f32x4 kv = *(const f32x4*)((const float*)(ws + WS_KIWI) + (size_t)row * 128 + 4 * lane); uint2 k2; k2.x = pk2(kv[0], kv[1]); k2.y = pk2(kv[2], kv[3]); *(uint2*)((bf16*)(ws + WS_KIB) + (size_t)row * 64 + 4 * lane) = k2; } } }
    const bf16* Q = (const bf16*)(ws + WS_Q); const bf16* UKT = (const bf16*)(ws + WS_W_UK); bf16* QL = (bf16*)(ws + WS_QLAT);
    const int r16 = lane & 15, kq = lane >> 4; const float sc = 0.08838834764831845f;
    for (int it = gw; it < 512 * 16 * 4; it += NGW) {
        const int nc = it & 3, h = (it >> 2) & 15, mt = it >> 6;
        f32x4 acc[2][4];
#pragma unroll
        for (int m = 0; m < 2; ++m)
#pragma unroll
            for (int n = 0; n < 4; ++n) acc[m][n] = (f32x4){0.f, 0.f, 0.f, 0.f};
#pragma unroll
        for (int ks = 0; ks < 4; ++ks) { s8v af[2], bfr[4];
#pragma unroll
            for (int m = 0; m < 2; ++m) af[m] = ld_frag(Q + (size_t)(mt * 32 + m * 16 + r16) * DM + h * 128 + ks * 32 + kq * 8);
#pragma unroll
            for (int n = 0; n < 4; ++n) bfr[n] = ld_frag(UKT + ((size_t)h * 256 + nc * 64 + n * 16 + r16) * 128 + ks * 32 + kq * 8);
#pragma unroll
            for (int m = 0; m < 2; ++m)
#pragma unroll
                for (int n = 0; n < 4; ++n) acc[m][n] = __builtin_amdgcn_mfma_f32_16x16x32_bf16(af[m], bfr[n], acc[m][n], 0, 0, 0); }
#pragma unroll
        for (int m = 0; m < 2; ++m)
#pragma unroll
            for (int n = 0; n < 4; ++n)
#pragma unroll
                for (int j = 0; j < 4; ++j) QL[(size_t)(mt * 32 + m * 16 + kq * 4 + j) * 4096 + h * 256 + nc * 64 + n * 16 + r16] = (bf16)f2bf(acc[m][n][j] * sc);
    }
}
__device__ __forceinline__ void p12_dsa_uv(Frame& F, const Args& A) {
    unsigned char* ws = A.ws; const int lane = F.lane;
    const int gw = F.vcu * NWAVES + F.wave, NGW = F.G * NWAVES;
    const bf16* OL = (const bf16*)(ws + WS_OLAT); const bf16* UVT = (const bf16*)(ws + WS_W_UV); bf16* O = (bf16*)(ws + WS_OATT1);
    const int r16 = lane & 15, kq = lane >> 4;
    for (int it = gw; it < 512 * 16 * 2; it += NGW) {
        const int nc = it & 1, h = (it >> 1) & 15, mt = it >> 5;
        f32x4 acc[2][4];
#pragma unroll
        for (int m = 0; m < 2; ++m)
#pragma unroll
            for (int n = 0; n < 4; ++n) acc[m][n] = (f32x4){0.f, 0.f, 0.f, 0.f};
#pragma unroll
        for (int ks = 0; ks < 8; ++ks) { s8v af[2], bfr[4];
#pragma unroll
            for (int m = 0; m < 2; ++m) af[m] = ld_frag(OL + (size_t)(mt * 32 + m * 16 + r16) * 4096 + h * 256 + ks * 32 + kq * 8);
#pragma unroll
            for (int n = 0; n < 4; ++n) bfr[n] = ld_frag(UVT + ((size_t)h * 128 + nc * 64 + n * 16 + r16) * 256 + ks * 32 + kq * 8);
#pragma unroll
            for (int m = 0; m < 2; ++m)
#pragma unroll
                for (int n = 0; n < 4; ++n) acc[m][n] = __builtin_amdgcn_mfma_f32_16x16x32_bf16(af[m], bfr[n], acc[m][n], 0, 0, 0); }
#pragma unroll
        for (int m = 0; m < 2; ++m)
#pragma unroll
            for (int n = 0; n < 4; ++n)
#pragma unroll
                for (int j = 0; j < 4; ++j) O[(size_t)(mt * 32 + m * 16 + kq * 4 + j) * DM + h * 128 + nc * 64 + n * 16 + r16] = (bf16)f2bf(acc[m][n][j]);
    }
}

__device__ __forceinline__ unsigned f2key(float f) { const unsigned u = __float_as_uint(f); return (u & 0x80000000u) ? ~u : (u | 0x80000000u); }

constexpr int DSA_SCR = 133120;
__device__ __forceinline__ unsigned dsa_off_b(unsigned row, unsigned ch) { return 256u * row + 16u * (ch ^ (((row & 3) << 2) | ((row >> 2) & 3))); }

__device__ __forceinline__ void p13a_dsa_index(Frame& F, const Args& A) {
    unsigned char* ws = A.ws; const int lane = F.lane, wid = F.wave, r32 = lane & 31, hi = lane >> 5;
    const bf16* QI = (const bf16*)(ws + WS_QI); const bf16* KIB = (const bf16*)(ws + WS_KIB); const float* KIWI = (const float*)(ws + WS_KIWI); int* IDX = (int*)(ws + WS_IDX);
    LAS float* sc = (LAS float*)(F.lds + RING_OFF);
    LAS unsigned* hist = (LAS unsigned*)(F.lds + DSA_SCR);
    LAS int* idxl = (LAS int*)(hist + 1024);
    LAS int* tiel = idxl + 1024;
    LAS unsigned* qm = (LAS unsigned*)(tiel + 256);
    const int q = wid >> 1, sub = wid & 1, th = sub * 64 + lane;
    for (int slot = F.vcu; slot < NTOK / 4; slot += F.G) {
        const int rowi = slot >> 8; int cc = slot & 255; if (rowi & 1) cc = 255 - cc;
        const int tok0 = (rowi * 256 + cc) * 4, b = tok0 >> 13, t0 = tok0 & (SEQ - 1), tmax = t0 + 3;
        bf16x8 qa[4];
#pragma unroll
        for (int s = 0; s < 4; ++s) qa[s] = *(const bf16x8*)(QI + (size_t)(tok0 + (r32 >> 3)) * 512 + (r32 & 7) * 64 + 16 * s + 8 * hi);
        float wv[16];
#pragma unroll
        for (int r = 0; r < 16; ++r) wv[r] = KIWI[(size_t)(tok0 + (r >> 2)) * 128 + 64 + (r & 3) + 4 * hi] * 0.35355339059327373f;
        const int ntiles = (tmax >> 5) + 1;
        for (int tile = wid; tile < ntiles; tile += 8) {
            const int key = tile * 32 + r32; const bf16* kp = KIB + (size_t)(b * SEQ + key) * 64 + 8 * hi;
            bf16x8 kb[4];
#pragma unroll
            for (int s = 0; s < 4; ++s) kb[s] = *(const bf16x8*)(kp + 16 * s);
            fa::f32x16 acc;
#pragma unroll
            for (int r = 0; r < 16; ++r) acc[r] = 0.f;
#pragma unroll
            for (int s = 0; s < 4; ++s) acc = __builtin_amdgcn_mfma_f32_32x32x16_bf16(qa[s], kb[s], acc, 0, 0, 0);
#pragma unroll
            for (int qq = 0; qq < 4; ++qq) { float part = 0.f;
#pragma unroll
                for (int r3 = 0; r3 < 4; ++r3) part += wv[4 * qq + r3] * fmaxf(acc[4 * qq + r3], 0.f);
                const float tot = part + __shfl_xor(part, 32);
                if ((qq >> 1) == hi) sc[qq * 8192 + key] = tot + 0.0f; }
        }
        __syncthreads();
        const int tok = tok0 + q, n = t0 + q + 1;
        if (tmax + 1 <= TOPK) {
            for (int i = th; i < TOPK; i += 128) IDX[(size_t)tok * TOPK + i] = (i < n) ? i : 0;
        } else {
            unsigned prefix = 0u, pmask = 0u, need = TOPK;
#pragma unroll 1
            for (int pass = 0; pass < 4; ++pass) {
                const int shift = 24 - 8 * pass;
                hist[q * 256 + th] = 0u; hist[q * 256 + 128 + th] = 0u;
                __syncthreads();
                for (int i = th; i < n; i += 128) { const unsigned u = f2key(sc[q * 8192 + i]); if ((u & pmask) == prefix) __hip_atomic_fetch_add(&hist[q * 256 + ((u >> shift) & 255u)], 1u, __ATOMIC_RELAXED, __HIP_MEMORY_SCOPE_WORKGROUP); }
                __syncthreads();
                if (sub == 0) {
                    const v4u c4 = *(const LAS v4u*)(hist + q * 256 + 4 * lane); const unsigned s4 = c4.x + c4.y + c4.z + c4.w; unsigned S = s4;
#pragma unroll
                    for (int o = 1; o < 64; o <<= 1) { const unsigned v = __shfl_down(S, o); if (lane + o < 64) S += v; }
                    const unsigned above = S - s4;
                    if (above < need && need <= S) { unsigned cum = above; int bin;
                        if (cum + c4.w >= need) bin = 3; else { cum += c4.w; if (cum + c4.z >= need) bin = 2; else { cum += c4.z; if (cum + c4.y >= need) bin = 1; else { cum += c4.y; bin = 0; } } }
                        qm[q * 8 + 0] = prefix | ((unsigned)(4 * lane + bin) << shift); qm[q * 8 + 1] = need - cum; }
                }
                __syncthreads();
                prefix = qm[q * 8 + 0]; need = qm[q * 8 + 1]; pmask |= (255u << shift);
            }
            if (th == 0) { qm[q * 8 + 2] = 0u; qm[q * 8 + 3] = 0u; }
            __syncthreads();
            const unsigned T = prefix;
            for (int i = th; i < n; i += 128) { const unsigned u = f2key(sc[q * 8192 + i]);
                if (u > T) { const unsigned p = __hip_atomic_fetch_add(&qm[q * 8 + 2], 1u, __ATOMIC_RELAXED, __HIP_MEMORY_SCOPE_WORKGROUP); if (p < (unsigned)TOPK) idxl[q * 256 + p] = i; }
                else if (u == T) { const unsigned p = __hip_atomic_fetch_add(&qm[q * 8 + 3], 1u, __ATOMIC_RELAXED, __HIP_MEMORY_SCOPE_WORKGROUP); if (p < 64u) tiel[q * 64 + p] = i; } }
            __syncthreads();
            if (sub == 0) { const int base = (int)qm[q * 8 + 2]; const int nt = (int)min(qm[q * 8 + 3], 64u);
                const int ti = (lane < nt) ? tiel[q * 64 + lane] : 0x7fffffff; int rank = 0;
                for (int j = 0; j < nt; ++j) { const int tj = __shfl(ti, j); rank += (tj < ti) ? 1 : 0; }
                if (lane < nt && rank < (int)need && base + rank < TOPK) idxl[q * 256 + base + rank] = ti; }
            __syncthreads();
            for (int i = th; i < TOPK; i += 128) IDX[(size_t)tok * TOPK + i] = idxl[q * 256 + i];
        }
        __syncthreads();
    }
}

__device__ __forceinline__ void p13b_dsa_attn(Frame& F, const Args& A) {
    unsigned char* ws = A.ws; const int lane = F.lane, wid = F.wave, c16 = lane & 15, g4 = lane >> 4;
    const bf16* CN = (const bf16*)(ws + WS_CN); const bf16* QL = (const bf16*)(ws + WS_QLAT); const int* IDX = (const int*)(ws + WS_IDX); bf16* OL = (bf16*)(ws + WS_OLAT);
    LAS float* lut = (LAS float*)(F.lds + DSA_SCR + 8192);
    for (int i = F.tid; i < 144 * 16; i += 512) { const int n = i >> 4, h = i & 15; lut[i] = A.in[1][rel_bucket(n) * 16 + h]; }
    __syncthreads();
    LAS char* img = (LAS char*)(F.lds + RING_OFF + wid * 16384);
    LAS int* idxw = (LAS int*)(F.lds + DSA_SCR + wid * 1024);
    const unsigned imgb = (unsigned)(uintptr_t)img;
    const int gw = F.vcu * NWAVES + wid, NGW = F.G * NWAVES;
    const unsigned prow0 = 8u * ((lane >> 2) & 3) + (lane & 3);
    for (int tok = gw; tok < NTOK; tok += NGW) {
        const int b = tok >> 13, t = tok & (SEQ - 1), cnt = min(TOPK, t + 1), ntile = (cnt + 31) >> 5;
        bf16x8 qb[8];
#pragma unroll
        for (int ks = 0; ks < 8; ++ks) qb[ks] = *(const bf16x8*)(QL + (size_t)tok * 4096 + c16 * 256 + ks * 32 + g4 * 8);
#pragma unroll
        for (int i = 0; i < 4; ++i) idxw[lane + 64 * i] = IDX[(size_t)tok * TOPK + lane + 64 * i];
        WSYNC();
        f32x4 o[16];
#pragma unroll
        for (int ct = 0; ct < 16; ++ct) o[ct] = (f32x4){0.f, 0.f, 0.f, 0.f};
        float m_run = -1e30f, l_run = 0.f;
        const LAS float* lutcol = lut + c16;
#pragma unroll 1
        for (int tile = 0; tile < ntile; ++tile) {
            { v4u st[16];
#pragma unroll
              for (int i = 0; i < 16; ++i) { const int nn = lane + 64 * i, row = nn >> 5, chg = nn & 31; const int key = idxw[tile * 32 + row];
                  st[i] = *(const v4u*)(CN + (size_t)(b * SEQ + key) * KVR + chg * 8); }
#pragma unroll
              for (int i = 0; i < 16; ++i) { const int nn = lane + 64 * i, row = nn >> 5, chg = nn & 31;
                  *(LAS v4u*)(img + (chg >> 4) * 8192 + dsa_off_b(row, chg & 15)) = st[i]; } }
            WSYNC();
            f32x4 sacc[2];
#pragma unroll
            for (int T = 0; T < 2; ++T) { sacc[T] = (f32x4){0.f, 0.f, 0.f, 0.f};
#pragma unroll
                for (int ks = 0; ks < 8; ++ks) { const bf16x8 a = *(const LAS bf16x8*)(img + (ks >> 2) * 8192 + dsa_off_b(prow0 + 4 * T, 4 * (ks & 3) + g4));
                    sacc[T] = __builtin_amdgcn_mfma_f32_16x16x32_bf16(a, qb[ks], sacc[T], 0, 0, 0); } }
            float pmax = -__builtin_inff();
#pragma unroll
            for (int T = 0; T < 2; ++T) { const int i0 = tile * 32 + 8 * g4 + 4 * T; const v4u kk = *(const LAS v4u*)(idxw + i0);
                const int kidx[4] = {(int)kk.x, (int)kk.y, (int)kk.z, (int)kk.w};
#pragma unroll
                for (int e = 0; e < 4; ++e) { const int dist = min(max(t - kidx[e], 0), 128); float s = sacc[T][e] + lutcol[dist * 16];
                    s = (i0 + e < cnt) ? s : -__builtin_inff(); sacc[T][e] = s; pmax = fmaxf(pmax, s); } }
            pmax = fmaxf(pmax, __shfl_xor(pmax, 16)); pmax = fmaxf(pmax, __shfl_xor(pmax, 32));
            const float mn = fmaxf(m_run, pmax), alpha = __builtin_amdgcn_exp2f((m_run - mn) * fa::C2); m_run = mn;
            float ps = 0.f;
#pragma unroll
            for (int T = 0; T < 2; ++T)
#pragma unroll
                for (int e = 0; e < 4; ++e) { const float pv = __builtin_amdgcn_exp2f((sacc[T][e] - mn) * fa::C2); sacc[T][e] = pv; ps += pv; }
            ps += __shfl_xor(ps, 16); ps += __shfl_xor(ps, 32);
            l_run = l_run * alpha + ps;
            if (__any(alpha < 1.f)) {
                float al[4];
#pragma unroll
                for (int e = 0; e < 4; ++e) al[e] = __shfl(alpha, 4 * g4 + e);
#pragma unroll
                for (int ct = 0; ct < 16; ++ct)
#pragma unroll
                    for (int e = 0; e < 4; ++e) o[ct][e] *= al[e];
            }
            fa::u32x4v pw; pw.x = fa::cvtpk(sacc[0][0], sacc[0][1]); pw.y = fa::cvtpk(sacc[0][2], sacc[0][3]); pw.z = fa::cvtpk(sacc[1][0], sacc[1][1]); pw.w = fa::cvtpk(sacc[1][2], sacc[1][3]);
            const bf16x8 pa = *reinterpret_cast<bf16x8*>(&pw);
            const unsigned qq = (lane & 15) >> 2, pp = lane & 3;
#pragma unroll
            for (int ct = 0; ct < 16; ++ct) { fa::s16x4 b0, b1;
                const unsigned a0 = imgb + (ct >> 3) * 8192 + dsa_off_b(8 * g4 + qq, 2 * (ct & 7) + (pp >> 1)) + 8 * (pp & 1);
                const unsigned a1 = imgb + (ct >> 3) * 8192 + dsa_off_b(8 * g4 + 4 + qq, 2 * (ct & 7) + (pp >> 1)) + 8 * (pp & 1);
                asm volatile("ds_read_b64_tr_b16 %0, %2\n\tds_read_b64_tr_b16 %1, %3\n\ts_waitcnt lgkmcnt(0)" : "=&v"(b0), "=&v"(b1) : "v"(a0), "v"(a1) : "memory");
                FA_SBAR();
                o[ct] = __builtin_amdgcn_mfma_f32_16x16x32_bf16(pa, (bf16x8){b0[0], b0[1], b0[2], b0[3], b1[0], b1[1], b1[2], b1[3]}, o[ct], 0, 0, 0); }
            WSYNC();
        }
        { const float il = (l_run > 0.f) ? 1.0f / l_run : 0.f; float ile[4];
#pragma unroll
          for (int e = 0; e < 4; ++e) ile[e] = __shfl(il, 4 * g4 + e);
#pragma unroll
          for (int ct = 0; ct < 16; ++ct)
#pragma unroll
              for (int e = 0; e < 4; ++e) { const float v = o[ct][e] * ile[e]; const float vn = __shfl_xor(v, 1);
                  if ((lane & 1) == 0) *(unsigned*)(OL + (size_t)tok * 4096 + (4 * g4 + e) * 256 + ct * 16 + c16) = fa::cvtpk(v, vn); } }
        WSYNC();
    }
    __syncthreads();
}

struct MoeTiles { int tend[8]; int pstart[8]; int MT; };
__device__ __forceinline__ void moe_tiles(Frame& F, MoeTiles& T) {
    int acc = 0;
#pragma unroll
    for (int e = 0; e < 8; ++e) { const int c = (int)__builtin_amdgcn_readfirstlane(__hip_atomic_load((unsigned*)(F.ctl + CW_MOECNT + 64 * e), __ATOMIC_RELAXED, __HIP_MEMORY_SCOPE_AGENT));
        T.pstart[e] = acc * 256; acc += (c + 255) >> 8; T.tend[e] = acc; }
    T.MT = acc;
}
__device__ __forceinline__ void p15_gather(Frame& F, const Args& A) {
    MoeTiles T; moe_tiles(F, T);
    const int gw = F.vcu * NWAVES + F.wave, NGW = F.G * NWAVES, lane = F.lane;
    const bf16* XB = (const bf16*)(A.ws + WS_XB); bf16* XG = (bf16*)(A.ws + WS_XG);
    const int* re = (const int*)(A.ws + WS_ROUTE); const int* rp = re + 2 * NTOK;
    for (int tok = gw; tok < NTOK; tok += NGW) {
        const v4u* src = (const v4u*)(XB + (size_t)tok * DM) + lane; v4u v[4];
#pragma unroll
        for (int j = 0; j < 4; ++j) v[j] = src[64 * j];
#pragma unroll
        for (int s = 0; s < 2; ++s) { const int e = re[2 * tok + s], p = rp[2 * tok + s]; int ps = 0;
#pragma unroll
            for (int q = 0; q < 8; ++q) ps = (q == e) ? T.pstart[q] : ps;
            v4u* dst = (v4u*)(XG + (size_t)(ps + p) * DM) + lane;
#pragma unroll
            for (int j = 0; j < 4; ++j) dst[64 * j] = v[j]; }
    }
}
__device__ __forceinline__ void p18_final(Frame& F, const Args& A) {
    MoeTiles T; moe_tiles(F, T);
    const int gw = F.vcu * NWAVES + F.wave, NGW = F.G * NWAVES, lane = F.lane;
    const float* XF = (const float*)(A.ws + WS_XF); const float* Y = (const float*)(A.ws + WS_Y);
    const int* re = (const int*)(A.ws + WS_ROUTE); const int* rp = re + 2 * NTOK; const float* rw = (const float*)(rp + 2 * NTOK);
    const float* gam = A.in[25] + DM; const float* bet = A.in[26] + DM;
    for (int tok = gw; tok < NTOK; tok += NGW) {
        int rows[2]; float w[2];
#pragma unroll
        for (int s = 0; s < 2; ++s) { const int e = re[2 * tok + s]; int ps = 0;
#pragma unroll
            for (int q = 0; q < 8; ++q) ps = (q == e) ? T.pstart[q] : ps;
            rows[s] = ps + rp[2 * tok + s]; w[s] = rw[2 * tok + s]; }
        const f32x4* xr = (const f32x4*)(XF + (size_t)tok * DM) + lane; const f32x4* y0 = (const f32x4*)(Y + (size_t)rows[0] * DM) + lane; const f32x4* y1 = (const f32x4*)(Y + (size_t)rows[1] * DM) + lane;
        f32x4 v[8]; float s = 0.f;
#pragma unroll
        for (int j = 0; j < 8; ++j) { v[j] = xr[64 * j] * ALPHA + y0[64 * j] * w[0] + y1[64 * j] * w[1]; s += (v[j][0] + v[j][1]) + (v[j][2] + v[j][3]); }
        const float mean = wave_sum(s) * (1.f / DM); float s2 = 0.f;
#pragma unroll
        for (int j = 0; j < 8; ++j) { v[j] = v[j] - mean; s2 += (v[j][0] * v[j][0] + v[j][1] * v[j][1]) + (v[j][2] * v[j][2] + v[j][3] * v[j][3]); }
        const float rstd = 1.f / sqrtf(wave_sum(s2) * (1.f / DM) + LN_EPS);
#pragma unroll
        for (int j = 0; j < 8; ++j) { const int c = 4 * lane + 256 * j; const f32x4 gg = *(const f32x4*)(gam + c), bb = *(const f32x4*)(bet + c);
            *(f32x4*)(A.out + (size_t)tok * DM + c) = v[j] * rstd * gg + bb; }
    }
}

__global__ void __launch_bounds__(NWAVES * 64, 2) mega_fwd(Args args) {
    extern __shared__ __attribute__((aligned(16))) unsigned char lds[];
    Frame F;
    F.lds = (LAS unsigned char*)lds;
    F.MISC = (volatile LAS unsigned*)(F.lds + MISC_OFF);
    F.tid = threadIdx.x; F.lane = F.tid & 63; F.wave = __builtin_amdgcn_readfirstlane(F.tid >> 6);
    F.G = gridDim.x; { const int bx = blockIdx.x; F.vcu = (F.G % 8 == 0) ? (bx % 8) * (F.G / 8) + bx / 8 : bx; }
    unsigned char* ws = args.ws;
    F.ctl = (gu32*)(ws + WS_CTL);
    for (int u = F.tid; u < (LDS_BYTES - LDSCTL_OFF) / 4; u += NWAVES * 64) ((LAS unsigned*)(F.lds + LDSCTL_OFF))[u] = 0u;
    __syncthreads();
    XcdBarrier bar; bar.bar = (unsigned*)(F.ctl + CW_BAR); bar.x = 0; bar.st = nullptr;
#if !MK_PER_PHASE
    bar = xcd_barrier_post((unsigned*)(F.ctl + CW_BAR), F.MISC + 8);
#define GRID_BAR() xcd_barrier(bar)
#else
#define GRID_BAR() do { } while (0)
#endif
    const int lo = args.ph_lo, hi = args.ph_hi;
#ifndef PH_MASK
#define PH_MASK 0x3fffff
#endif
#define IN(k) (((PH_MASK >> (k)) & 1) && lo <= (k) && (k) < hi)
#define BOTH(k) (IN(k) && IN((k) + 1))
    bf16* XB = (bf16*)(ws + WS_XB); float* XF = (float*)(ws + WS_XF); float* Z = (float*)(ws + WS_Z);

    if (IN(0)) { relaunder(F); p0_prologue(F, args); if (BOTH(0)) GRID_BAR(); }
    if (IN(1)) { relaunder(F);
        pg8::Gemm g{XB, (const bf16*)(ws + WS_W_NSA_IN), NTOK, NSA_NPAD, DM}; pg8::StaticOrder S; S.init(NTOK, NSA_NPAD, F.G, (int)blockIdx.x);
        pg8::EpiNsaIn E{(bf16*)(ws + WS_P0), (float*)(ws + WS_GL), 0.08838834764831845f};
        pg8::gemm_phase<pg8::EpiNsaIn, pg8::StaticOrder, true, true>(F.lds + RING_OFF, g, S, E);
        if (BOTH(1)) GRID_BAR();
    }
    if (IN(2)) { relaunder(F); p2_compress(F, args); if (BOTH(2)) GRID_BAR(); }
    if (IN(3)) { relaunder(F); p3a_nsa_cmp(F, args); if (BOTH(3)) GRID_BAR(); }
    if (IN(4)) { relaunder(F); p3b_nsa_sel(F, args); if (BOTH(4)) GRID_BAR(); }
    if (IN(5)) { relaunder(F); p3c_nsa_win(F, args); if (BOTH(5)) GRID_BAR(); }
    if (IN(6)) { relaunder(F);
        pg8::Gemm g{(const bf16*)(ws + WS_OATT0), (const bf16*)(ws + WS_W_NSA_OUT), NTOK, DM, DM}; pg8::StaticOrder S; S.init(NTOK, DM, F.G, (int)blockIdx.x);
        pg8::EpiResF32 E{args.in[0], Z, ALPHA, DM};
        pg8::gemm_phase<pg8::EpiResF32, pg8::StaticOrder, true, true>(F.lds + RING_OFF, g, S, E);
        if (BOTH(6)) GRID_BAR();
    }
    if (IN(7)) { relaunder(F); ln_phase<false>(F, args, Z, args.in[23], args.in[24], XF, XB); if (BOTH(7)) GRID_BAR(); }
    if (IN(8)) { relaunder(F);
        pg8::Gemm g{XB, (const bf16*)(ws + WS_W_FFN_GU), NTOK, 2 * DFF, DM}; pg8::StaticOrder S; S.init(NTOK, 2 * DFF, F.G, (int)blockIdx.x);
        pg8::EpiSwiGLU E{(bf16*)(ws + WS_HFF), DFF};
        pg8::gemm_phase<pg8::EpiSwiGLU, pg8::StaticOrder, true, true>(F.lds + RING_OFF, g, S, E);
        if (BOTH(8)) GRID_BAR();
    }
    if (IN(9)) { relaunder(F);
        pg8::Gemm g{(const bf16*)(ws + WS_HFF), (const bf16*)(ws + WS_W_FFN_DN), NTOK, DM, DFF}; pg8::StaticOrder S; S.init(NTOK, DM, F.G, (int)blockIdx.x);
        pg8::EpiResF32 E{XF, Z, ALPHA, DM};
        pg8::gemm_phase<pg8::EpiResF32, pg8::StaticOrder, true, true>(F.lds + RING_OFF, g, S, E);
        if (BOTH(9)) GRID_BAR();
    }
    if (IN(10)) { relaunder(F); ln_phase<false>(F, args, Z, args.in[25], args.in[26], XF, XB); if (BOTH(10)) GRID_BAR(); }
    if (IN(11)) { relaunder(F);
        pg8::Gemm g{XB, (const bf16*)(ws + WS_W_DSA_IN), NTOK, DSA_NPAD, DM}; pg8::StaticOrder S; S.init(NTOK, DSA_NPAD, F.G, (int)blockIdx.x);
        pg8::EpiDsaIn E{(bf16*)(ws + WS_Q), (float*)(ws + WS_CRAW), (bf16*)(ws + WS_QI), (float*)(ws + WS_KIWI), 0.125f};
        pg8::gemm_phase<pg8::EpiDsaIn, pg8::StaticOrder, true, true>(F.lds + RING_OFF, g, S, E);
        if (BOTH(11)) GRID_BAR();
    }
    if (IN(12)) { relaunder(F); p10_dsa_prep(F, args); if (BOTH(12)) GRID_BAR(); }
    if (IN(13)) { relaunder(F); p13a_dsa_index(F, args); if (BOTH(13)) GRID_BAR(); }
    if (IN(14)) { relaunder(F); p13b_dsa_attn(F, args); if (BOTH(14)) GRID_BAR(); }
    if (IN(15)) { relaunder(F); p12_dsa_uv(F, args); if (BOTH(15)) GRID_BAR(); }
    if (IN(16)) { relaunder(F);
        pg8::Gemm g{(const bf16*)(ws + WS_OATT1), (const bf16*)(ws + WS_W_DSA_OUT), NTOK, DM, DM}; pg8::StaticOrder S; S.init(NTOK, DM, F.G, (int)blockIdx.x);
        pg8::EpiResF32 E{XF, Z, ALPHA, DM};
        pg8::gemm_phase<pg8::EpiResF32, pg8::StaticOrder, true, true>(F.lds + RING_OFF, g, S, E);
        if (BOTH(16)) GRID_BAR();
    }
    if (IN(17)) { relaunder(F); ln_route_phase(F, args, Z, args.in[23] + DM, args.in[24] + DM, XF, XB); if (BOTH(17)) GRID_BAR(); }
    if (IN(18)) { relaunder(F); p15_gather(F, args); if (BOTH(18)) GRID_BAR(); }
    if (IN(19)) { relaunder(F);
        MoeTiles T; moe_tiles(F, T);
        pg8::Gemm g{(const bf16*)(ws + WS_XG), (const bf16*)(ws + WS_W_MOE_GU), T.MT * 256, 2 * DFFE, DM}; pg8::MoeOrder S; S.init(T.MT * 256, 2 * DFFE, F.G, (int)blockIdx.x); S.nexp_rows = 2 * DFFE;
#pragma unroll
        for (int e = 0; e < 8; ++e) S.tend[e] = T.tend[e];
        pg8::EpiSwiGLU E{(bf16*)(ws + WS_HM), DFFE};
        pg8::gemm_phase<pg8::EpiSwiGLU, pg8::MoeOrder, true, true>(F.lds + RING_OFF, g, S, E);
        if (BOTH(19)) GRID_BAR();
    }
    if (IN(20)) { relaunder(F);
        MoeTiles T; moe_tiles(F, T);
        pg8::Gemm g{(const bf16*)(ws + WS_HM), (const bf16*)(ws + WS_W_MOE_DN), T.MT * 256, DM, DFFE}; pg8::MoeOrder S; S.init(T.MT * 256, DM, F.G, (int)blockIdx.x); S.nexp_rows = DM;
#pragma unroll
        for (int e = 0; e < 8; ++e) S.tend[e] = T.tend[e];
        pg8::EpiF32 E{(float*)(ws + WS_Y), DM};
        pg8::gemm_phase<pg8::EpiF32, pg8::MoeOrder, true, true>(F.lds + RING_OFF, g, S, E);
        if (BOTH(20)) GRID_BAR();
    }
    if (IN(21)) { relaunder(F); p18_final(F, args); }
#undef IN
#undef BOTH
}

extern "C" void kernel_launch(void* const* d_in, const int* in_sizes, int n_in, void* d_out, int out_size, void* d_ws, size_t ws_size, hipStream_t stream) {
    static int grid = 0;
    if (grid == 0) {
        if (n_in != 27 || out_size != NTOK * DM || ws_size < WS_END) { fprintf(stderr, "kernel_launch: unexpected shapes (n_in %d, out %d, ws %zu); nothing launched\n", n_in, out_size, ws_size); grid = -1; return; }
        int dev = 0, cus = 0, per_cu = 0;
        if (hipGetDevice(&dev) != hipSuccess || hipDeviceGetAttribute(&cus, hipDeviceAttributeMultiprocessorCount, dev) != hipSuccess) { grid = -1; return; }
        if (hipFuncSetAttribute((const void*)mega_fwd, hipFuncAttributeMaxDynamicSharedMemorySize, LDS_BYTES) != hipSuccess) { fprintf(stderr, "kernel_launch: hipFuncSetAttribute failed\n"); grid = -1; return; }
        if (hipOccupancyMaxActiveBlocksPerMultiprocessor(&per_cu, (const void*)mega_fwd, NWAVES * 64, LDS_BYTES) != hipSuccess || per_cu < 1) { fprintf(stderr, "kernel_launch: occupancy query says %d\n", per_cu); }
        (void)hipGetLastError();
        grid = cus;
    }
    if (grid < 0) return;
    if (hipMemsetAsync((char*)d_ws + WS_CTL, 0, CTL_ZERO_BYTES, stream) != hipSuccess) return;
    Args a{};
    for (int i = 0; i < 27; ++i) a.in[i] = (const float*)d_in[i];
    a.out = (float*)d_out; a.ws = (unsigned char*)d_ws;
#if MK_PER_PHASE
    for (int p = 0; p < NPHASE; ++p) { a.ph_lo = p; a.ph_hi = p + 1; hipLaunchKernelGGL(mega_fwd, dim3(grid), dim3(NWAVES * 64), LDS_BYTES, stream, a); }
#else
    a.ph_lo = 0; a.ph_hi = NPHASE;
    hipLaunchKernelGGL(mega_fwd, dim3(grid), dim3(NWAVES * 64), LDS_BYTES, stream, a);
#endif
}
```

```cpp
#include <hip/hip_runtime.h>
#include <cstdio>
#include <cstdint>
namespace pg8 {
#define PG8_LAS __attribute__((address_space(3)))
typedef unsigned short bf16_t;
typedef short bf16x8 __attribute__((ext_vector_type(8)));
typedef float f32x4 __attribute__((ext_vector_type(4)));
typedef unsigned u32x4 __attribute__((ext_vector_type(4)));
constexpr int BM = 256, BK = 64, HALF = 128, HTB = HALF * BK * 2  , STAGE_BYTES = 8 * HTB, NXCD = 8, WGM = 8;

__host__ __device__ __forceinline__ int lds_byte(int r, int c) { const int st = (r >> 4) * 2 + (c >> 5), rr = r & 15, cc = c & 31, ob = rr * 64 + cc * 2; return st * 1024 + (ob ^ (((ob >> 9) & 1) << 5)); }
__host__ __device__ __forceinline__ void stage_rc(int b, int& R, int& C) { const int st = b / 1024, sb = b % 1024, swz = sb ^ (((sb >> 9) & 1) << 5); R = (st >> 1) * 16 + swz / 64; C = (st & 1) * 32 + (swz % 64) / 2; }
__host__ __device__ __forceinline__ int perm32(int rho) { const int n = rho >> 4, i = rho & 15; return 8 * (i >> 2) + 4 * n + (i & 3); }

struct Unit { int pm, pn; };
struct Gemm { const bf16_t* A; const bf16_t* Bt; int M, N, K; };

struct StaticOrder {
    int nM, nN, nwg, G, c;
    __host__ __device__ void init(int M, int N, int G_, int c_) { nM = M / BM; nN = N / BM; nwg = nM * nN; G = G_; c = c_; }
    __host__ __device__ bool next(int i, Unit& u) const {
        const long L = (long)i * G + c; if (L >= nwg) return false;
        int wgid = (int)L; { const int q = nwg / NXCD, r = nwg % NXCD, xcd = wgid % NXCD, off = wgid / NXCD; wgid = (xcd < r ? xcd * (q + 1) : r * (q + 1) + (xcd - r) * q) + off; }
        const int nig = WGM * nN, gid = wgid / nig, fm = gid * WGM, gsz = (nM - fm) < WGM ? (nM - fm) : WGM;
        u.pm = fm + ((wgid % nig) % gsz); u.pn = (wgid % nig) / gsz; return true;
    }
    __device__ __forceinline__ void a_ready(const Unit&) const {}
    __device__ __forceinline__ void done(const Unit&) const {}
    __device__ __forceinline__ const char* a_ptr(const Gemm& g, const Unit& u) const { return (const char*)g.A + (size_t)u.pm * ((size_t)BM * g.K * 2); }
    __device__ __forceinline__ const char* b_ptr(const Gemm& g, const Unit& u) const { return (const char*)g.Bt + (size_t)u.pn * ((size_t)BM * g.K * 2); }
};


__device__ __forceinline__ unsigned cvt_pk_bf16(float lo, float hi) { unsigned r; asm volatile("v_cvt_pk_bf16_f32 %0, %1, %2" : "=v"(r) : "v"(lo), "v"(hi)); return r; }
__device__ __forceinline__ u32x4 pack8(const f32x4 v0, const f32x4 v1) { u32x4 w; w.x = cvt_pk_bf16(v0[0], v0[1]); w.y = cvt_pk_bf16(v0[2], v0[3]); w.z = cvt_pk_bf16(v1[0], v1[1]); w.w = cvt_pk_bf16(v1[2], v1[3]); return w; }

struct EpiNsaIn {
    static constexpr bool PERM = true, AFTER_DRAIN = false;
    bf16_t* P0; float* GL; float qscale;
    __device__ __forceinline__ void operator()(const f32x4 (&acc)[2][2][4][2], const Unit& u, int wr, int wc, int fr, int fq) const {
        const int row0 = u.pm * BM + wr * 64 + fr;
        if (u.pn < 20) {
            const float s = u.pn < 8 ? qscale : 1.0f;
            const int col0 = u.pn * BM + wc * 32 + 8 * fq;
#pragma unroll
            for (int ai = 0; ai < 2; ++ai)
#pragma unroll
                for (int m = 0; m < 4; ++m) { bf16_t* rowp = P0 + (size_t)(row0 + ai * HALF + m * 16) * 5120 + col0;
#pragma unroll
                    for (int bj = 0; bj < 2; ++bj) *(u32x4*)(rowp + bj * HALF) = pack8(acc[ai][bj][m][0] * s, acc[ai][bj][m][1] * s); }
        } else {
            const int c = wc * 32 + 8 * fq;
            if (c < 48) {
#pragma unroll
                for (int ai = 0; ai < 2; ++ai)
#pragma unroll
                    for (int m = 0; m < 4; ++m) { float* gp = GL + (size_t)(row0 + ai * HALF + m * 16) * 48 + c;
                        *(f32x4*)gp = acc[ai][0][m][0]; *(f32x4*)(gp + 4) = acc[ai][0][m][1]; }
            }
        }
    }
};
struct EpiDsaIn {
    static constexpr bool PERM = true, AFTER_DRAIN = false;
    bf16_t* Q; float* CRAW; bf16_t* QI; float* KIWI; float qiscale;
    __device__ __forceinline__ void operator()(const f32x4 (&acc)[2][2][4][2], const Unit& u, int wr, int wc, int fr, int fq) const {
        const int row0 = u.pm * BM + wr * 64 + fr; const int c = wc * 32 + 8 * fq;
        if (u.pn < 8) {
#pragma unroll
            for (int ai = 0; ai < 2; ++ai)
#pragma unroll
                for (int m = 0; m < 4; ++m) { bf16_t* rowp = Q + (size_t)(row0 + ai * HALF + m * 16) * 2048 + u.pn * BM + c;
#pragma unroll
                    for (int bj = 0; bj < 2; ++bj) *(u32x4*)(rowp + bj * HALF) = pack8(acc[ai][bj][m][0], acc[ai][bj][m][1]); }
        } else if (u.pn == 8) {
#pragma unroll
            for (int ai = 0; ai < 2; ++ai)
#pragma unroll
                for (int m = 0; m < 4; ++m) { float* rowp = CRAW + (size_t)(row0 + ai * HALF + m * 16) * 256 + c;
#pragma unroll
                    for (int bj = 0; bj < 2; ++bj) { *(f32x4*)(rowp + bj * HALF) = acc[ai][bj][m][0]; *(f32x4*)(rowp + bj * HALF + 4) = acc[ai][bj][m][1]; } }
        } else if (u.pn < 11) {
#pragma unroll
            for (int ai = 0; ai < 2; ++ai)
#pragma unroll
                for (int m = 0; m < 4; ++m) { bf16_t* rowp = QI + (size_t)(row0 + ai * HALF + m * 16) * 512 + (u.pn - 9) * BM + c;
#pragma unroll
                    for (int bj = 0; bj < 2; ++bj) *(u32x4*)(rowp + bj * HALF) = pack8(acc[ai][bj][m][0] * qiscale, acc[ai][bj][m][1] * qiscale); }
        } else {
#pragma unroll
            for (int ai = 0; ai < 2; ++ai)
#pragma unroll
                for (int m = 0; m < 4; ++m) { float* rowp = KIWI + (size_t)(row0 + ai * HALF + m * 16) * 128 + c;
                    *(f32x4*)rowp = acc[ai][0][m][0]; *(f32x4*)(rowp + 4) = acc[ai][0][m][1]; }
        }
    }
};
struct EpiResF32 {
    static constexpr bool PERM = false, AFTER_DRAIN = false;
    const float* R; float* Z; float alpha; int ldc;
    __device__ __forceinline__ void operator()(const f32x4 (&acc)[2][2][4][2], const Unit& u, int wr, int wc, int fr, int fq) const {
        const int row0 = u.pm * BM + wr * 64 + fr, col0 = u.pn * BM + wc * 32 + 4 * fq;
#pragma unroll
        for (int ai = 0; ai < 2; ++ai)
#pragma unroll
            for (int m = 0; m < 4; ++m) { const size_t off = (size_t)(row0 + ai * HALF + m * 16) * ldc + col0;
#pragma unroll
                for (int bj = 0; bj < 2; ++bj)
#pragma unroll
                    for (int n = 0; n < 2; ++n) { const f32x4 r = *(const f32x4*)(R + off + bj * HALF + n * 16); *(f32x4*)(Z + off + bj * HALF + n * 16) = r * alpha + acc[ai][bj][m][n]; } }
    }
};
struct EpiF32 {
    static constexpr bool PERM = false, AFTER_DRAIN = false;
    float* C; int ldc;
    __device__ __forceinline__ void operator()(const f32x4 (&acc)[2][2][4][2], const Unit& u, int wr, int wc, int fr, int fq) const {
        const int row0 = u.pm * BM + wr * 64 + fr, col0 = u.pn * BM + wc * 32 + 4 * fq;
#pragma unroll
        for (int ai = 0; ai < 2; ++ai)
#pragma unroll
            for (int m = 0; m < 4; ++m) { float* rowp = C + (size_t)(row0 + ai * HALF + m * 16) * ldc + col0;
#pragma unroll
                for (int bj = 0; bj < 2; ++bj)
#pragma unroll
                    for (int n = 0; n < 2; ++n) *(f32x4*)(rowp + bj * HALF + n * 16) = acc[ai][bj][m][n]; }
    }
};
__device__ __forceinline__ float silu_mul(float g, float u) { return g * __builtin_amdgcn_rcpf(1.0f + __expf(-g)) * u; }
struct EpiSwiGLU {
    static constexpr bool PERM = true, AFTER_DRAIN = false;
    bf16_t* H; int ldh;
    __device__ __forceinline__ void operator()(const f32x4 (&acc)[2][2][4][2], const Unit& u, int wr, int wc, int fr, int fq) const {
        const int row0 = u.pm * BM + wr * 64 + fr, col0 = u.pn * HALF + wc * 32 + 8 * fq;
#pragma unroll
        for (int ai = 0; ai < 2; ++ai)
#pragma unroll
            for (int m = 0; m < 4; ++m) { bf16_t* rowp = H + (size_t)(row0 + ai * HALF + m * 16) * ldh + col0;
                f32x4 v0, v1;
#pragma unroll
                for (int j = 0; j < 4; ++j) { v0[j] = silu_mul(acc[ai][0][m][0][j], acc[ai][1][m][0][j]); v1[j] = silu_mul(acc[ai][0][m][1][j], acc[ai][1][m][1][j]); }
                *(u32x4*)rowp = pack8(v0, v1); }
    }
};
struct MoeOrder : StaticOrder {
    int tend[8]; int nexp_rows;
    __device__ __forceinline__ int expert(int pm) const { int e = 0;
#pragma unroll
        for (int i = 0; i < 7; ++i) e += (pm >= tend[i]) ? 1 : 0; return e; }
    __device__ __forceinline__ const char* b_ptr(const Gemm& g, const Unit& u) const { return (const char*)g.Bt + ((size_t)expert(u.pm) * nexp_rows + (size_t)u.pn * BM) * ((size_t)g.K * 2); }
};
template <class Epi, class Sched, bool ALIGN_EPI = false, bool SP2 = false>
__device__ __forceinline__ void gemm_phase(PG8_LAS unsigned char* lds, const Gemm g, const Sched& S, const Epi& E) {
    int tid = threadIdx.x; asm volatile("" : "+v"(tid));
    const int wid = __builtin_amdgcn_readfirstlane(tid >> 6), lane = tid & 63, wr = wid >> 2, wc = wid & 3, fr = lane & 15, fq = lane >> 4;
    const int K = g.K, nt = K / BK;
    unsigned voffA[2], voffB[2];
#pragma unroll
    for (int i = 0; i < 2; ++i) { int R, C; stage_rc(tid * 16 + i * 8192, R, C); const int Rb = Epi::PERM ? ((R & ~31) + perm32(R & 31)) : R;
        voffA[i] = (unsigned)(R * K + C) * 2u; voffB[i] = (unsigned)(Rb * K + C) * 2u; }
    const size_t kstep = (size_t)(BK * 2);
    const size_t hstep = (size_t)HALF * K * 2;
    const size_t tstep = 2 * hstep;
    const unsigned ldsw = (unsigned)wid * 1024u;
    const int aoff = lds_byte(wr * 64 + fr, fq * 8), boff = lds_byte(wc * 32 + fr, fq * 8);
#define PG8_SA(b, h) (((b) * 2 + (h)) * HTB)
#define PG8_SB(b, h) ((4 + (b) * 2 + (h)) * HTB)
#define PG8_STAGE(bufoff, gbase, voff) do { _Pragma("unroll") for (int _i = 0; _i < 2; ++_i) \
        __builtin_amdgcn_global_load_lds((const unsigned*)((const char*)(gbase) + (voff)[_i]), (PG8_LAS unsigned*)(lds + (bufoff) + ldsw + _i * 8192), 16, 0, 0); } while (0)
#define PG8_LDA(dst, b, h) do { _Pragma("unroll") for (int m = 0; m < 4; ++m) _Pragma("unroll") for (int k = 0; k < 2; ++k) dst[m][k] = *(const PG8_LAS bf16x8*)(lds + PG8_SA(b, h) + aoff + m * 2048 + k * 1024); } while (0)
#define PG8_LDB(dst, b, h) do { _Pragma("unroll") for (int n = 0; n < 2; ++n) _Pragma("unroll") for (int k = 0; k < 2; ++k) dst[n][k] = *(const PG8_LAS bf16x8*)(lds + PG8_SB(b, h) + boff + n * 2048 + k * 1024); } while (0)
#define PG8_MMA(ai, bj, At, Bt) do { __builtin_amdgcn_s_setprio(1); _Pragma("unroll") for (int m = 0; m < 4; ++m) _Pragma("unroll") for (int n = 0; n < 2; ++n) _Pragma("unroll") for (int k = 0; k < 2; ++k) \
        acc[ai][bj][m][n] = __builtin_amdgcn_mfma_f32_16x16x32_bf16(Bt[n][k], At[m][k], acc[ai][bj][m][n], 0, 0, 0); __builtin_amdgcn_s_setprio(0); } while (0)
#define PG8_WAIT_V(n) asm volatile("s_waitcnt vmcnt(" #n ")" ::: "memory")
#define PG8_WAIT_L(n) asm volatile("s_waitcnt lgkmcnt(" #n ")" ::: "memory")
#define PG8_BAR __builtin_amdgcn_s_barrier()
#define PG8_SCHED __builtin_amdgcn_sched_barrier(0)
    Unit cur, nxt; int ui = 0;
    if (!S.next(0, cur)) return;
    f32x4 acc[2][2][4][2];
#pragma unroll
    for (int a = 0; a < 2; ++a)
#pragma unroll
        for (int b = 0; b < 2; ++b)
#pragma unroll
            for (int m = 0; m < 4; ++m)
#pragma unroll
                for (int n = 0; n < 2; ++n) acc[a][b][m][n] = (f32x4){0.f, 0.f, 0.f, 0.f};
    bf16x8 At[4][2], B0[2][2], B1[2][2];
    const char* cA = S.a_ptr(g, cur); const char* cB = S.b_ptr(g, cur);
    S.a_ready(cur);
    if constexpr (SP2) {
        PG8_STAGE(PG8_SB(0, 0), cB, voffB); PG8_STAGE(PG8_SB(0, 1), cB + hstep, voffB); PG8_STAGE(PG8_SA(0, 0), cA, voffA); PG8_STAGE(PG8_SA(0, 1), cA + hstep, voffA);
        if (wr == 1) PG8_BAR;
        PG8_WAIT_V(2); PG8_BAR;
        PG8_STAGE(PG8_SB(1, 0), cB + kstep, voffB); PG8_STAGE(PG8_SA(1, 0), cA + kstep, voffA); PG8_STAGE(PG8_SB(1, 1), cB + hstep + kstep, voffB);
        PG8_WAIT_V(6); PG8_BAR;
    } else {
        PG8_STAGE(PG8_SB(0, 0), cB, voffB); PG8_STAGE(PG8_SA(0, 0), cA, voffA); PG8_STAGE(PG8_SB(0, 1), cB + hstep, voffB); PG8_STAGE(PG8_SA(0, 1), cA + hstep, voffA);
        if (wr == 1) PG8_BAR;
        PG8_WAIT_V(4); PG8_BAR;
        PG8_STAGE(PG8_SB(1, 0), cB + kstep, voffB); PG8_STAGE(PG8_SA(1, 0), cA + kstep, voffA); PG8_STAGE(PG8_SB(1, 1), cB + hstep + kstep, voffB);
        PG8_WAIT_V(6); PG8_BAR;
    }
    for (;;) {
        const bool has_next = S.next(ui + 1, nxt);
        const char* nA = has_next ? S.a_ptr(g, nxt) : cA; const char* nB = has_next ? S.b_ptr(g, nxt) : cB;
        for (int t = 0; t < nt; t += 2) {
            const bool last = (t == nt - 2);
            const char* a1 = cA + (size_t)(t + 1) * kstep;
            const char* a2 = last ? nA : cA + (size_t)(t + 2) * kstep; const char* b2 = last ? nB : cB + (size_t)(t + 2) * kstep;
            const char* a3 = a2 + kstep; const char* b3 = b2 + kstep;
            if (last && has_next) S.a_ready(nxt);
            if constexpr (SP2) {
            PG8_LDB(B0, 0, 0); PG8_LDB(B1, 0, 1); PG8_SCHED; PG8_LDA(At, 0, 0); PG8_STAGE(PG8_SA(1, 1), a1 + hstep, voffA);
            PG8_WAIT_V(8); PG8_WAIT_L(0); PG8_BAR; PG8_MMA(0, 0, At, B0); PG8_MMA(0, 1, At, B1); PG8_BAR; PG8_SCHED;
            PG8_LDA(At, 0, 1); PG8_STAGE(PG8_SB(0, 0), b2, voffB); PG8_STAGE(PG8_SB(0, 1), b2 + hstep, voffB); PG8_STAGE(PG8_SA(0, 0), a2, voffA);
            PG8_WAIT_V(8); PG8_WAIT_L(0); PG8_BAR; PG8_MMA(1, 0, At, B0); PG8_MMA(1, 1, At, B1); PG8_BAR; PG8_SCHED;
            PG8_LDB(B0, 1, 0); PG8_LDB(B1, 1, 1); PG8_SCHED; PG8_LDA(At, 1, 0); PG8_STAGE(PG8_SA(0, 1), a2 + hstep, voffA);
            PG8_WAIT_V(8); PG8_WAIT_L(0); PG8_BAR; PG8_MMA(0, 0, At, B0); PG8_MMA(0, 1, At, B1); PG8_BAR; PG8_SCHED;
            PG8_LDA(At, 1, 1); PG8_STAGE(PG8_SB(1, 0), b3, voffB); PG8_STAGE(PG8_SB(1, 1), b3 + hstep, voffB); PG8_STAGE(PG8_SA(1, 0), a3, voffA);
            PG8_WAIT_V(8); PG8_WAIT_L(0); PG8_BAR; PG8_MMA(1, 0, At, B0); PG8_MMA(1, 1, At, B1); PG8_BAR; PG8_SCHED;
            } else {
            PG8_LDB(B0, 0, 0); PG8_SCHED; PG8_LDA(At, 0, 0); PG8_STAGE(PG8_SA(1, 1), a1 + hstep, voffA);
            PG8_WAIT_L(8); PG8_BAR; PG8_WAIT_L(0); PG8_MMA(0, 0, At, B0); PG8_BAR; PG8_SCHED;
            PG8_LDB(B1, 0, 1); PG8_STAGE(PG8_SB(0, 0), b2, voffB);
            PG8_BAR; PG8_WAIT_L(0); PG8_MMA(0, 1, At, B1); PG8_BAR;
            PG8_LDA(At, 0, 1); PG8_STAGE(PG8_SA(0, 0), a2, voffA);
            PG8_BAR; PG8_WAIT_L(0); PG8_MMA(1, 0, At, B0); PG8_BAR; PG8_SCHED;
            PG8_STAGE(PG8_SB(0, 1), b2 + hstep, voffB);
            PG8_WAIT_V(6); PG8_BAR; PG8_MMA(1, 1, At, B1); PG8_BAR;
            PG8_LDB(B0, 1, 0); PG8_SCHED; PG8_LDA(At, 1, 0); PG8_STAGE(PG8_SA(0, 1), a2 + hstep, voffA);
            PG8_WAIT_L(8); PG8_BAR; PG8_WAIT_L(0); PG8_MMA(0, 0, At, B0); PG8_BAR; PG8_SCHED;
            PG8_LDB(B1, 1, 1); PG8_STAGE(PG8_SB(1, 0), b3, voffB);
            PG8_BAR; PG8_WAIT_L(0); PG8_MMA(0, 1, At, B1); PG8_BAR;
            PG8_LDA(At, 1, 1); PG8_STAGE(PG8_SA(1, 0), a3, voffA);
            PG8_BAR; PG8_WAIT_L(0); PG8_MMA(1, 0, At, B0); PG8_BAR; PG8_SCHED;
            PG8_STAGE(PG8_SB(1, 1), b3 + hstep, voffB);
            PG8_WAIT_V(6); PG8_BAR; PG8_MMA(1, 1, At, B1); PG8_BAR;
            }
        }
        if constexpr (ALIGN_EPI) { if (wr == 0) PG8_BAR; }
        if constexpr (!Epi::AFTER_DRAIN) { E(acc, cur, wr, wc, fr, fq); S.done(cur); }
        if (!has_next) break;
#pragma unroll
        for (int a = 0; a < 2; ++a)
#pragma unroll
            for (int b = 0; b < 2; ++b)
#pragma unroll
                for (int m = 0; m < 4; ++m)
#pragma unroll
                    for (int n = 0; n < 2; ++n) acc[a][b][m][n] = (f32x4){0.f, 0.f, 0.f, 0.f};
        cur = nxt; cA = nA; cB = nB; ++ui;
        if constexpr (ALIGN_EPI) { if (wr == 1) PG8_BAR; }
    }
    PG8_WAIT_V(0);
    if constexpr (!ALIGN_EPI) { if (wr == 0) PG8_BAR; }
    PG8_BAR;
    if constexpr (Epi::AFTER_DRAIN) { E.fused(acc, cur, wr, wc, fr, fq, lds, wid, lane); S.done(cur); }
#undef PG8_SA
#undef PG8_SB
#undef PG8_STAGE
#undef PG8_LDA
#undef PG8_LDB
#undef PG8_MMA
#undef PG8_WAIT_V
#undef PG8_WAIT_L
#undef PG8_BAR
#undef PG8_SCHED
}
}
#define GAS __attribute__((address_space(1)))
#define LAS __attribute__((address_space(3)))
typedef unsigned short bf16;
typedef unsigned v4u __attribute__((ext_vector_type(4)));
typedef float f32x4 __attribute__((ext_vector_type(4)));
typedef short bf16x8 __attribute__((ext_vector_type(8)));
typedef GAS unsigned gu32;
typedef GAS unsigned long long gu64;
#define RLX_AGENT __ATOMIC_RELAXED, __HIP_MEMORY_SCOPE_AGENT
#define LDS_WAIT() asm volatile("s_waitcnt lgkmcnt(0)" ::: "memory")
#define VM_WAIT() asm volatile("s_waitcnt vmcnt(0)" ::: "memory")
__device__ __forceinline__ unsigned long long rt() { return __builtin_amdgcn_s_memrealtime(); }
__device__ __forceinline__ unsigned f2bf(float f) { unsigned u = __builtin_bit_cast(unsigned, f); return (u + 0x7fffu + ((u >> 16) & 1u)) >> 16; }
__device__ __forceinline__ unsigned pk2(float lo, float hi) { return f2bf(lo) | (f2bf(hi) << 16); }

#define XB_TMO      128
#define XB_XCNT(j)  (256  + 64 * (j))
#define XB_XSUB(j)  (1280 + 64 * (j))
#define XB_XGEN(j)  (2304 + 64 * (j))
#define XB_TOP      3328
#define XB_TOPGEN   3392
#define XCD_BAR_WORDS 3456
#define XB_SPIN_CAP (1u << 18)

__device__ __forceinline__ unsigned xb_ld(unsigned* p)              { return __hip_atomic_load(p, __ATOMIC_RELAXED, __HIP_MEMORY_SCOPE_AGENT); }
__device__ __forceinline__ unsigned xb_add(unsigned* p, unsigned v) { return __hip_atomic_fetch_add(p, v, __ATOMIC_RELAXED, __HIP_MEMORY_SCOPE_AGENT); }
__device__ __forceinline__ unsigned xb_xcc_id() { return (unsigned)__builtin_amdgcn_s_getreg((3 << 11) | 20) & 0xFu; }
#define XB_SPIN(cond, bar) do { unsigned _sp = 0; while (cond) { __builtin_amdgcn_s_sleep(1); \
    if ((++_sp & 255u) == 0u) { if (xb_ld(&(bar)[XB_TMO])) break; if (_sp > XB_SPIN_CAP) { atomicAdd(&(bar)[XB_TMO], 1u); break; } } } } while (0)

struct XcdBarrier {
    unsigned* bar; unsigned x;
    volatile LAS unsigned* st;
};

__device__ __forceinline__ XcdBarrier xcd_barrier_post(unsigned* bar, volatile LAS unsigned* st) {
    XcdBarrier b; b.bar = bar; b.x = xb_xcc_id(); b.st = st;
    if (threadIdx.x == 0) (void)xb_add(&bar[XB_XCNT(b.x)], 1u);
    return b;
}
__device__ __forceinline__ void xcd_barrier_complete(unsigned* bar, unsigned x, unsigned& nloc, unsigned& nx) {
    const unsigned G = gridDim.x * gridDim.y * gridDim.z;
    unsigned sum, cnt, mine, sp = 0u;
    for (;;) {
        sum = 0u; cnt = 0u; mine = 0u;
#pragma unroll
        for (unsigned j = 0; j < 16; ++j) { const unsigned c = xb_ld(&bar[XB_XCNT(j)]); sum += c; cnt += (c > 0u) ? 1u : 0u; mine = (j == x) ? c : mine; }
        if (sum == G) break;
        __builtin_amdgcn_s_sleep(1);
        if ((++sp & 255u) == 0u) { if (xb_ld(&bar[XB_TMO])) break; if (sp > XB_SPIN_CAP) { atomicAdd(&bar[XB_TMO], 1u); break; } }
    }
    nloc = mine > 0u ? mine : 1u; nx = cnt > 0u ? cnt : 1u;
}

__device__ __forceinline__ void xcd_barrier(const XcdBarrier& b) {
    asm volatile("s_waitcnt vmcnt(0)" ::: "memory");
    __syncthreads();
    if (threadIdx.x == 0) {
        unsigned* bar = b.bar;
        __builtin_amdgcn_s_waitcnt(0);
        unsigned nloc = b.st[0], nx = b.st[1];
        if (nloc == 0u) { xcd_barrier_complete(bar, b.x, nloc, nx); b.st[0] = nloc; b.st[1] = nx; }
        const unsigned old = xb_add(&bar[XB_XSUB(b.x)], 1u);
        const unsigned gen = old / nloc;
        if (old + 1u == (gen + 1u) * nloc) {
            __builtin_amdgcn_fence(__ATOMIC_RELEASE, "agent");
            asm volatile("s_waitcnt vmcnt(0)" ::: "memory");
            const unsigned og = xb_add(&bar[XB_TOP], 1u);
            const unsigned tg = og / nx;
            if (og + 1u == (tg + 1u) * nx) xb_add(&bar[XB_TOPGEN], 1u);
            else XB_SPIN(xb_ld(&bar[XB_TOPGEN]) == tg, bar);
            __builtin_amdgcn_fence(__ATOMIC_ACQUIRE, "agent");
            xb_add(&bar[XB_XGEN(b.x)], 1u);
            asm volatile("s_waitcnt vmcnt(0)" ::: "memory");
        } else {
            XB_SPIN(xb_ld(&bar[XB_XGEN(b.x)]) == gen, bar);
            __builtin_amdgcn_fence(__ATOMIC_ACQUIRE, "agent");
            asm volatile("s_waitcnt vmcnt(0)" ::: "memory");
        }
    }
    __syncthreads();
}

constexpr int NWAVES = 8;
#ifndef MK_PER_PHASE
#define MK_PER_PHASE 0
#endif
constexpr int NPHASE = 22;

constexpr int BATCH = 2, SEQ = 8192, DM = 2048, NTOK = BATCH * SEQ, NH = 16, DH = 128;
constexpr int NSA_N = 5168, NSA_NPAD = 5376, P0LD = 5120;
constexpr int NCMP = 511, NSELB = 128;
constexpr int COL_KC = 2048, COL_VC = 2560, COL_KS = 3072, COL_VS = 3584, COL_KW = 4096, COL_VW = 4608;
constexpr int DSA_N = 2888, DSA_NPAD = 3072, KVR = 256, TOPK = 256;
constexpr int DFF = 5632, NEXP = 8, DFFE = 7168, MOE_ROWS = 34816;
constexpr float ALPHA = 1.41421356237309515f, LN_EPS = 1e-5f, RMS_EPS = 1e-6f;

constexpr size_t MiB = (size_t)1 << 20;
constexpr size_t WS_CTL = 0, CTL_ZERO_BYTES = 1 * MiB;
constexpr size_t WS_W_NSA_IN = 2 * MiB, WS_W_NSA_OUT = 23 * MiB, WS_W_FFN_GU = 31 * MiB, WS_W_FFN_DN = 75 * MiB, WS_W_DSA_IN = 97 * MiB, WS_W_DSA_OUT = 109 * MiB;
constexpr size_t WS_W_CMPK = 117 * MiB, WS_W_CMPV = 118 * MiB, WS_W_UK = 119 * MiB, WS_W_UV = 120 * MiB, WS_CBIAS = 121 * MiB;
constexpr size_t WS_KCMP = 122 * MiB, WS_VCMP = 124 * MiB, WS_GL = 126 * MiB, WS_ROUTE = 129 * MiB;
constexpr size_t WS_KIB = 179 * MiB;
constexpr size_t WS_SELM = 178 * MiB;
constexpr size_t WS_CRAW = 130 * MiB, WS_KIWI = 146 * MiB, WS_IDX = 154 * MiB, WS_CN = 170 * MiB;
constexpr size_t WS_W_MOE_GU = 192 * MiB, WS_W_MOE_DN = 640 * MiB;
constexpr size_t WS_XB = 864 * MiB, WS_XF = 928 * MiB, WS_Z = 1056 * MiB;
constexpr size_t WS_P0 = 1184 * MiB, WS_OATT0 = 1344 * MiB, WS_HFF = 1408 * MiB;
constexpr size_t WS_Q = 1184 * MiB, WS_QI = 1248 * MiB, WS_QLAT = 1264 * MiB, WS_OLAT = 1392 * MiB, WS_OATT1 = 1520 * MiB;
constexpr size_t WS_XG = 1056 * MiB, WS_HM = 1192 * MiB, WS_Y = 192 * MiB;
constexpr size_t WS_END = 1668 * MiB;
static_assert(WS_HM + (size_t)MOE_ROWS * DFFE * 2 <= WS_END, "hm fits");
static_assert(WS_XG + (size_t)MOE_ROWS * DM * 2 <= WS_HM, "xg fits");
static_assert(WS_Y + (size_t)MOE_ROWS * DM * 4 <= WS_W_MOE_DN, "y overlays the dead gate/up weights only");
static_assert(WS_HFF + (size_t)NTOK * DFF * 2 <= WS_END, "hff fits");
constexpr int CW_TMO = 0, CW_CODE = 1;
constexpr int CW_BAR = 4096;
constexpr int CW_MOECNT = 16384;

constexpr int RING_OFF = 0, RING_BYTES = 131072;
constexpr int LDSCTL_OFF = RING_BYTES, MISC_OFF = LDSCTL_OFF + 320;
constexpr int LDS_BYTES = 163840;
constexpr int DSA_SCR = 133120;

struct Frame {
    LAS unsigned char* lds;
    volatile LAS unsigned* MISC;
    gu32* ctl;
    int tid, lane, wave, vcu, G;
};

__device__ __forceinline__ void relaunder(Frame& F) { int t = F.tid; asm volatile("" : "+v"(t)); F.tid = t; F.lane = t & 63; }
__device__ __forceinline__ float bf2f(unsigned short h) { return __uint_as_float(((unsigned)h) << 16); }
__device__ __forceinline__ float bflo(unsigned w) { return __uint_as_float(w << 16); }
__device__ __forceinline__ float bfhi(unsigned w) { return __uint_as_float(w & 0xffff0000u); }
__device__ __forceinline__ float wave_sum(float v) {
#pragma unroll
    for (int o = 1; o < 64; o <<= 1) v += __shfl_xor(v, o);
    return v;
}
__device__ __forceinline__ float wave_max(float v) {
#pragma unroll
    for (int o = 1; o < 64; o <<= 1) v = fmaxf(v, __shfl_xor(v, o));
    return v;
}
#define WSYNC() do { __builtin_amdgcn_wave_barrier(); asm volatile("s_waitcnt lgkmcnt(0)" ::: "memory"); __builtin_amdgcn_wave_barrier(); } while (0)

__device__ __forceinline__ int rel_bucket(int n) {
    if (n < 16) return n;
    if (n >= 113) return 31;
    int b = 16;
    b += (n >= 19); b += (n >= 21); b += (n >= 24); b += (n >= 27); b += (n >= 31); b += (n >= 35); b += (n >= 40); b += (n >= 46);
    b += (n >= 52); b += (n >= 59); b += (n >= 67); b += (n >= 77); b += (n >= 87); b += (n >= 99);
    return b;
}

__device__ __forceinline__ void tr_item(const float* W, int N, int ldw, bf16* WT, int Kdst, int k0, int n0, int drow, LAS float* scr, int lane) {
    { const int kr = lane >> 3, c4 = lane & 7, n = n0 + 4 * c4; f32x4 v[8];
#pragma unroll
      for (int i = 0; i < 8; ++i) v[i] = (n < N) ? *(const f32x4*)(W + (size_t)(k0 + 8 * i + kr) * ldw + n) : (f32x4){0.f, 0.f, 0.f, 0.f};
#pragma unroll
      for (int i = 0; i < 8; ++i) { LAS float* d = scr + (8 * i + kr) * 33 + 4 * c4; d[0] = v[i][0]; d[1] = v[i][1]; d[2] = v[i][2]; d[3] = v[i][3]; } }
    LDS_WAIT(); asm volatile("" ::: "memory");
    const int c = lane & 7;
#pragma unroll
    for (int j = 0; j < 4; ++j) { const int n = (lane >> 3) + 8 * j; const LAS float* s = scr + (8 * c) * 33 + n;
        v4u o; o.x = pk2(s[0 * 33], s[1 * 33]); o.y = pk2(s[2 * 33], s[3 * 33]); o.z = pk2(s[4 * 33], s[5 * 33]); o.w = pk2(s[6 * 33], s[7 * 33]);
        *(v4u*)(WT + (size_t)(drow + n) * Kdst + k0 + 8 * c) = o; }
    LDS_WAIT(); asm volatile("" ::: "memory");
}
__device__ __forceinline__ void tr_mat(const float* W, int K, int N, int Npad, bf16* WT, int mode, int item, LAS float* scr, int lane) {
    const int nblk = Npad / 32, kb = item / nblk, nb = item - kb * nblk, n0 = 32 * nb;
    const int drow = (mode == 0) ? n0 : ((n0 >> 7) * 256 + (mode - 1) * 128 + (n0 & 127));
    tr_item(W, N, N, WT, K, 64 * kb, n0, drow, scr, lane);
}

struct Args { const float* in[27]; float* out; unsigned char* ws; int ph_lo, ph_hi; };

__device__ __forceinline__ void p0_prologue(Frame& F, const Args& A) {
    LAS float* scr = (LAS float*)(F.lds + RING_OFF + F.wave * 16384);
    unsigned char* ws = A.ws;
    const int gw = F.vcu * NWAVES + F.wave, NGW = F.G * NWAVES, lane = F.lane;
    constexpr int I_NSA_IN = (DM / 64) * (NSA_NPAD / 32), I_SQ = (DM / 64) * (DM / 32), I_FFN = (DM / 64) * (DFF / 32), I_FFD = (DFF / 64) * (DM / 32), I_DSA_IN = (DM / 64) * (DSA_NPAD / 32);
    constexpr int I_CMP = (4096 / 64) * (128 / 32), I_UK1 = (128 / 64) * (256 / 32), I_UV1 = (256 / 64) * (128 / 32);
    constexpr int I_MG1 = (DM / 64) * (DFFE / 32), I_MD1 = (DFFE / 64) * (DM / 32);
    constexpr int NITEMS = I_NSA_IN + 2 * I_SQ + 2 * I_FFN + I_FFD + I_DSA_IN + 2 * I_CMP + 16 * I_UK1 + 16 * I_UV1 + 16 * I_MG1 + 8 * I_MD1;
    for (int it = gw; it < NITEMS; it += NGW) {
        int r = it;
        if (r < I_NSA_IN) { tr_mat(A.in[2], DM, NSA_N, NSA_NPAD, (bf16*)(ws + WS_W_NSA_IN), 0, r, scr, lane); continue; } r -= I_NSA_IN;
        if (r < I_SQ) { tr_mat(A.in[9], DM, DM, DM, (bf16*)(ws + WS_W_NSA_OUT), 0, r, scr, lane); continue; } r -= I_SQ;
        if (r < I_SQ) { tr_mat(A.in[14], DM, DM, DM, (bf16*)(ws + WS_W_DSA_OUT), 0, r, scr, lane); continue; } r -= I_SQ;
        if (r < I_FFN) { tr_mat(A.in[15], DM, DFF, DFF, (bf16*)(ws + WS_W_FFN_GU), 1, r, scr, lane); continue; } r -= I_FFN;
        if (r < I_FFN) { tr_mat(A.in[16], DM, DFF, DFF, (bf16*)(ws + WS_W_FFN_GU), 2, r, scr, lane); continue; } r -= I_FFN;
        if (r < I_FFD) { tr_mat(A.in[17], DFF, DM, DM, (bf16*)(ws + WS_W_FFN_DN), 0, r, scr, lane); continue; } r -= I_FFD;
        if (r < I_DSA_IN) { tr_mat(A.in[10], DM, DSA_N, DSA_NPAD, (bf16*)(ws + WS_W_DSA_IN), 0, r, scr, lane); continue; } r -= I_DSA_IN;
        if (r < I_CMP) { tr_mat(A.in[4], 4096, 128, 128, (bf16*)(ws + WS_W_CMPK), 0, r, scr, lane); continue; } r -= I_CMP;
        if (r < I_CMP) { tr_mat(A.in[7], 4096, 128, 128, (bf16*)(ws + WS_W_CMPV), 0, r, scr, lane); continue; } r -= I_CMP;
        if (r < 16 * I_UK1) { const int h = r / I_UK1; tr_mat(A.in[12] + (size_t)h * 128 * 256, 128, 256, 256, (bf16*)(ws + WS_W_UK) + (size_t)h * 256 * 128, 0, r - h * I_UK1, scr, lane); continue; } r -= 16 * I_UK1;
        if (r < 16 * I_UV1) { const int h = r / I_UV1; tr_mat(A.in[13] + (size_t)h * 256 * 128, 256, 128, 128, (bf16*)(ws + WS_W_UV) + (size_t)h * 128 * 256, 0, r - h * I_UV1, scr, lane); continue; } r -= 16 * I_UV1;
        if (r < 8 * I_MG1) { const int e = r / I_MG1; tr_mat(A.in[20] + (size_t)e * DM * DFFE, DM, DFFE, DFFE, (bf16*)(ws + WS_W_MOE_GU) + (size_t)e * 2 * DFFE * DM, 1, r - e * I_MG1, scr, lane); continue; } r -= 8 * I_MG1;
        if (r < 8 * I_MG1) { const int e = r / I_MG1; tr_mat(A.in[21] + (size_t)e * DM * DFFE, DM, DFFE, DFFE, (bf16*)(ws + WS_W_MOE_GU) + (size_t)e * 2 * DFFE * DM, 2, r - e * I_MG1, scr, lane); continue; } r -= 8 * I_MG1;
        { const int e = r / I_MD1; tr_mat(A.in[22] + (size_t)e * DFFE * DM, DFFE, DM, DM, (bf16*)(ws + WS_W_MOE_DN) + (size_t)e * DM * DFFE, 0, r - e * I_MD1, scr, lane); }
    }
    { const float* x = A.in[0]; bf16* xb = (bf16*)(ws + WS_XB); const size_t n8 = (size_t)NTOK * DM / 8;
      for (size_t i = (size_t)F.vcu * 512 + F.tid; i < n8; i += (size_t)F.G * 512) { const f32x4 a = *(const f32x4*)(x + i * 8), b = *(const f32x4*)(x + i * 8 + 4);
          v4u o; o.x = pk2(a[0], a[1]); o.y = pk2(a[2], a[3]); o.z = pk2(b[0], b[1]); o.w = pk2(b[2], b[3]); *(v4u*)(xb + i * 8) = o; } }
    for (int it = gw; it < 64; it += NGW) { const int kv = it >> 5, ch = it & 31; const float* pe = A.in[kv ? 6 : 3]; const float* w1 = A.in[kv ? 7 : 4];
        float s0 = 0.f, s1 = 0.f;
        for (int k = ch * 128; k < ch * 128 + 128; ++k) { const float p = pe[k]; s0 += p * w1[(size_t)k * 128 + lane]; s1 += p * w1[(size_t)k * 128 + 64 + lane]; }
        float* cb = (float*)(ws + WS_CBIAS) + (size_t)(kv * 32 + ch) * 128; cb[lane] = s0; cb[64 + lane] = s1; }
}

typedef short s8v __attribute__((ext_vector_type(8)));
__device__ __forceinline__ s8v ld_frag(const bf16* p) { return *(const s8v*)p; }

__device__ __forceinline__ float gelu_tanh(float x) { const float u = 0.7978845608028654f * (x + 0.044715f * x * x * x); return 0.5f * x * (1.0f + tanhf(u)); }
__device__ __forceinline__ void p2_compress(Frame& F, const Args& A) {
    unsigned char* ws = A.ws; const int lane = F.lane, wid = F.wave, tid = F.tid;
    const bf16* P0 = (const bf16*)(ws + WS_P0);
    LAS float* part = (LAS float*)(F.lds + RING_OFF);
    LAS float* hid = (LAS float*)(F.lds + DSA_SCR);
    LAS float* cbl = hid + 4096;
    if (tid < 256) { const float* cbp = (const float*)(ws + WS_CBIAS) + (size_t)(tid >> 7) * 32 * 128 + (tid & 127); float cb = 0.f; for (int ch = 0; ch < 32; ++ch) cb += cbp[ch * 128]; cbl[tid] = cb; }
    if (F.vcu < 16 && wid == 0) { bf16* zp = (bf16*)(ws + ((F.vcu & 1) ? WS_VCMP : WS_KCMP)) + ((size_t)(F.vcu >> 1) * 512 + 511) * 128; zp[lane] = 0; zp[64 + lane] = 0; }
    __syncthreads();
    const int r16 = lane & 15, kq = lane >> 4;
    for (int it = F.vcu; it < 256; it += F.G) {
        const int kv = it >> 7, tile = it & 127;
        const bf16* W1T = (const bf16*)(ws + (kv ? WS_W_CMPV : WS_W_CMPK));
        const float* w2 = A.in[kv ? 8 : 5];
        bf16* outp = (bf16*)(ws + (kv ? WS_VCMP : WS_KCMP));
        const int colbase = kv ? COL_VC : COL_KC;
        f32x4 acc[2][8];
#pragma unroll
        for (int m = 0; m < 2; ++m)
#pragma unroll
            for (int n = 0; n < 8; ++n) acc[m][n] = (f32x4){0.f, 0.f, 0.f, 0.f};
        const bf16* arow[2];
#pragma unroll
        for (int m = 0; m < 2; ++m) { int R = tile * 32 + m * 16 + r16; if (R > 4087) R = 4087; const int g = R & 3, bn = R >> 2, b = bn / NCMP, n = bn - b * NCMP;
            arow[m] = P0 + (size_t)(b * SEQ + 16 * n) * P0LD + colbase + g * 128 + kq * 8; }
#pragma unroll 2
        for (int kk = 0; kk < 16; ++kk) {
            const int ks = wid * 16 + kk, l = ks >> 2, d0 = (ks & 3) * 32;
            s8v af[2], bfr[8];
#pragma unroll
            for (int m = 0; m < 2; ++m) af[m] = ld_frag(arow[m] + (size_t)l * P0LD + d0);
#pragma unroll
            for (int n = 0; n < 8; ++n) bfr[n] = ld_frag(W1T + (size_t)(n * 16 + r16) * 4096 + ks * 32 + kq * 8);
#pragma unroll
            for (int m = 0; m < 2; ++m)
#pragma unroll
                for (int n = 0; n < 8; ++n) acc[m][n] = __builtin_amdgcn_mfma_f32_16x16x32_bf16(af[m], bfr[n], acc[m][n], 0, 0, 0);
        }
#pragma unroll
        for (int m = 0; m < 2; ++m)
#pragma unroll
            for (int n = 0; n < 8; ++n)
#pragma unroll
                for (int j = 0; j < 4; ++j) part[wid * 4096 + (m * 16 + kq * 4 + j) * 128 + n * 16 + r16] = acc[m][n][j];
        __syncthreads();
        { const int row = tid >> 4, e0 = (tid & 15) * 8; f32x4 s0 = (f32x4){0.f, 0.f, 0.f, 0.f}, s1 = s0;
#pragma unroll
          for (int w = 0; w < 8; ++w) { s0 += *(const LAS f32x4*)(part + w * 4096 + row * 128 + e0); s1 += *(const LAS f32x4*)(part + w * 4096 + row * 128 + e0 + 4); }
#pragma unroll
          for (int j = 0; j < 4; ++j) { hid[row * 128 + e0 + j] = gelu_tanh(s0[j] + cbl[kv * 128 + e0 + j]); hid[row * 128 + e0 + 4 + j] = gelu_tanh(s1[j] + cbl[kv * 128 + e0 + 4 + j]); } }
        __syncthreads();
        { const int rr = tid >> 4, f0 = (tid & 15) * 8, R = tile * 32 + rr; f32x4 o0 = (f32x4){0.f, 0.f, 0.f, 0.f}, o1 = o0;
#pragma unroll 4
          for (int e = 0; e < 128; ++e) { const float hv = hid[rr * 128 + e]; o0 += *(const f32x4*)(w2 + e * 128 + f0) * hv; o1 += *(const f32x4*)(w2 + e * 128 + f0 + 4) * hv; }
          if (R <= 4087) { const int g = R & 3, bn = R >> 2, b = bn / NCMP, n = bn - b * NCMP;
              v4u o; o.x = pk2(o0[0], o0[1]); o.y = pk2(o0[2], o0[3]); o.z = pk2(o1[0], o1[1]); o.w = pk2(o1[2], o1[3]);
              *(v4u*)(outp + ((size_t)(b * 4 + g) * 512 + n) * 128 + f0) = o; } }
        __syncthreads();
    }
}

namespace fa {
typedef float f32x16 __attribute__((ext_vector_type(16)));
typedef short s16x4 __attribute__((ext_vector_type(4)));
typedef unsigned u32x4v __attribute__((ext_vector_type(4)));
constexpr int SHM_K = 16384, SHM_V = 16384;
constexpr int OFF_V = 0, OFF_K = 2 * SHM_V, OFF_WS = 2 * SHM_V + 2 * SHM_K, OFF_LUT = OFF_WS + 8 * 256, OFF_MASK = OFF_LUT + 144 * 16 * 4, OFF_TAB = OFF_MASK + 1024;
constexpr int TABLD = 130;
constexpr float C2 = 1.4426950408889634f, THR = 8.f;
#define FA_KSWZ(row, colB) ((row) * 256 + ((colB) ^ (((row) & 7) << 4)))
#define FA_SBAR() __builtin_amdgcn_sched_barrier(0)
__device__ __forceinline__ int v_st(int k, int c) { const int kk = (k & ~0xC) | ((k & 4) << 1) | ((k & 8) >> 1); return ((kk >> 3) * 4 + (c >> 5)) * 512 + ((kk & 7) * 32 + (c & 31)) * 2; }
__device__ __forceinline__ int v_rd_base(int lane) { return ((lane & 3) << 3) | (((lane >> 2) & 3) << 6) | (((lane >> 4) & 1) << 5) | (((lane >> 5) & 1) << 8); }
constexpr int v_rd_off(int d0, int ks, int half) { return d0 * 512 + ks * 4096 + half * 2048; }
__device__ __forceinline__ int crow(int r, int hi) { return (r & 3) + 8 * (r >> 2) + 4 * hi; }
__device__ __forceinline__ unsigned cvtpk(float lo, float hi) { unsigned r; asm volatile("v_cvt_pk_bf16_f32 %0, %1, %2" : "=v"(r) : "v"(lo), "v"(hi)); return r; }

__device__ __forceinline__ void qkt(f32x16& p0, f32x16& p1, const LAS char* Kb, int r32, int hi, const bf16x8 (&qr)[8], float init) {
#pragma unroll
    for (int r = 0; r < 16; ++r) { p0[r] = init; p1[r] = init; }
    const LAS char* kb[4];
#pragma unroll
    for (int dd = 0; dd < 4; ++dd) kb[dd] = Kb + FA_KSWZ(r32, (dd * 16 + hi * 8) * 2);
#pragma unroll
    for (int d0 = 0; d0 < 8; ++d0) { const LAS char* a = kb[d0 & 3] + (d0 >> 2) * 128;
        const bf16x8 b0 = *(const LAS bf16x8*)a;
        const bf16x8 b1 = *(const LAS bf16x8*)(a + 32 * 256);
        p0 = __builtin_amdgcn_mfma_f32_32x32x16_bf16(b0, qr[d0], p0, 0, 0, 0);
        p1 = __builtin_amdgcn_mfma_f32_32x32x16_bf16(b1, qr[d0], p1, 0, 0, 0); }
}
__device__ __forceinline__ void pv_tile(f32x16 (&o)[4], int vb0, bf16x8 pa0, bf16x8 pa1, bf16x8 pa2, bf16x8 pa3) {
#define FA_TRRD(dst, off) asm volatile("ds_read_b64_tr_b16 %0, %1 offset:%2" : "=&v"(dst) : "v"(vb0), "i"(off) : "memory")
#define FA_PV_D0(d0) do { s16x4 l0, l1, l2, l3, h0, h1, h2, h3; constexpr int b_ = v_rd_off(d0, 0, 0); \
        FA_TRRD(l0, b_); FA_TRRD(h0, b_ + 2048); FA_TRRD(l1, b_ + 4096); FA_TRRD(h1, b_ + 6144); FA_TRRD(l2, b_ + 8192); FA_TRRD(h2, b_ + 10240); FA_TRRD(l3, b_ + 12288); FA_TRRD(h3, b_ + 14336); \
        asm volatile("s_waitcnt lgkmcnt(0)" ::: "memory"); FA_SBAR(); \
        o[d0] = __builtin_amdgcn_mfma_f32_32x32x16_bf16(pa0, (bf16x8){l0[0], l0[1], l0[2], l0[3], h0[0], h0[1], h0[2], h0[3]}, o[d0], 0, 0, 0); \
        o[d0] = __builtin_amdgcn_mfma_f32_32x32x16_bf16(pa1, (bf16x8){l1[0], l1[1], l1[2], l1[3], h1[0], h1[1], h1[2], h1[3]}, o[d0], 0, 0, 0); \
        o[d0] = __builtin_amdgcn_mfma_f32_32x32x16_bf16(pa2, (bf16x8){l2[0], l2[1], l2[2], l2[3], h2[0], h2[1], h2[2], h2[3]}, o[d0], 0, 0, 0); \
        o[d0] = __builtin_amdgcn_mfma_f32_32x32x16_bf16(pa3, (bf16x8){l3[0], l3[1], l3[2], l3[3], h3[0], h3[1], h3[2], h3[3]}, o[d0], 0, 0, 0); } while (0)
    FA_PV_D0(0); FA_PV_D0(1); FA_PV_D0(2); FA_PV_D0(3);
#undef FA_PV_D0
#undef FA_TRRD
}
__device__ __forceinline__ void partialSM(f32x16& p0, f32x16& p1, float& m_reg, float& alpha) {
    float pmax = p0[0];
#pragma unroll
    for (int r = 1; r < 16; ++r) pmax = fmaxf(pmax, p0[r]);
#pragma unroll
    for (int r = 0; r < 16; ++r) pmax = fmaxf(pmax, p1[r]);
    { auto rr = __builtin_amdgcn_permlane32_swap(__float_as_uint(pmax), __float_as_uint(pmax), false, false); pmax = fmaxf(__uint_as_float(rr[0]), __uint_as_float(rr[1])); }
    float mn;
    if (__all(pmax - m_reg <= THR)) { mn = m_reg; alpha = 1.f; }
    else { mn = fmaxf(m_reg, pmax); alpha = __builtin_amdgcn_exp2f((m_reg - mn) * C2); m_reg = mn; }
    const float mnL = -mn * C2;
#pragma unroll
    for (int r = 0; r < 16; ++r) { p0[r] = __builtin_amdgcn_exp2f(fmaf(p0[r], C2, mnL)); p1[r] = __builtin_amdgcn_exp2f(fmaf(p1[r], C2, mnL)); }
}
__device__ __forceinline__ float finishSM(const f32x16& p0, const f32x16& p1, bf16x8& pa0, bf16x8& pa1, bf16x8& pa2, bf16x8& pa3) {
    float ps = 0.f;
#pragma unroll
    for (int r = 0; r < 16; ++r) ps += p0[r];
#pragma unroll
    for (int r = 0; r < 16; ++r) ps += p1[r];
    { auto rr = __builtin_amdgcn_permlane32_swap(__float_as_uint(ps), __float_as_uint(ps), false, false); ps = __uint_as_float(rr[0]) + __uint_as_float(rr[1]); }
#define FA_PK4(P, B_, OUT) do { unsigned a0 = cvtpk(P[B_ + 0], P[B_ + 1]), a1 = cvtpk(P[B_ + 2], P[B_ + 3]); unsigned b0 = cvtpk(P[B_ + 4], P[B_ + 5]), b1 = cvtpk(P[B_ + 6], P[B_ + 7]); \
        auto r0 = __builtin_amdgcn_permlane32_swap(a0, b0, false, false); auto r1 = __builtin_amdgcn_permlane32_swap(a1, b1, false, false); \
        u32x4v w = {r0[0], r1[0], r0[1], r1[1]}; OUT = *reinterpret_cast<bf16x8*>(&w); } while (0)
    FA_PK4(p0, 0, pa0); FA_PK4(p0, 8, pa1); FA_PK4(p1, 0, pa2); FA_PK4(p1, 8, pa3);
#undef FA_PK4
    return ps;
}
__device__ __forceinline__ void rescale(f32x16 (&o)[4], float alpha, LAS float* al_l, int r32, int hi) {
    if (__any(alpha < 1.f)) { if (hi == 0) al_l[r32] = alpha; asm volatile("s_waitcnt lgkmcnt(0)" ::: "memory");
#pragma unroll
        for (int r = 0; r < 16; ++r) { const float a = al_l[crow(r, hi)];
#pragma unroll
            for (int d = 0; d < 4; ++d) o[d][r] *= a; }
        asm volatile("s_waitcnt lgkmcnt(0)" ::: "memory"); }
}
__device__ __forceinline__ void mask_tile(f32x16& p0, f32x16& p1, int dq, unsigned W) {
    const float NEG = -__builtin_inff();
#pragma unroll
    for (int r = 0; r < 16; ++r) { const int c = (r & 3) + 8 * (r >> 2);
        if ((unsigned)(dq - c) >= W) p0[r] = NEG;
        if ((unsigned)(dq - c - 32) >= W) p1[r] = NEG; }
}
__device__ __forceinline__ void mask_all(f32x16& p0, f32x16& p1, bool keep) {
    const float NEG = -__builtin_inff();
#pragma unroll
    for (int r = 0; r < 16; ++r) { p0[r] = keep ? p0[r] : NEG; p1[r] = keep ? p1[r] : NEG; }
}
__device__ __forceinline__ void bias_near(f32x16& p0, f32x16& p1, int dq, int step, const LAS float* lutcol) {
#pragma unroll
    for (int r = 0; r < 16; ++r) { const int c = (r & 3) + 8 * (r >> 2);
        const int d0 = min(max((dq - c) * step, 0), 128), d1 = min(max((dq - c - 32) * step, 0), 128);
        p0[r] += lutcol[d0 * 16]; p1[r] += lutcol[d1 * 16]; }
}
struct Stage { bf16x8 k0, k1, v0, v1; };
__device__ __forceinline__ void stage_load(Stage& S, const bf16* Kp, const bf16* Vp, size_t ld, int row0, int maxrow, int sr, int sc) {
    const int ra = min(row0 + sr, maxrow), rb = min(row0 + 32 + sr, maxrow);
    S.k0 = *(const bf16x8*)(Kp + (size_t)ra * ld + sc); S.k1 = *(const bf16x8*)(Kp + (size_t)rb * ld + sc);
    S.v0 = *(const bf16x8*)(Vp + (size_t)ra * ld + sc); S.v1 = *(const bf16x8*)(Vp + (size_t)rb * ld + sc);
}
__device__ __forceinline__ void stage_write(const Stage& S, LAS char* Kb, LAS char* Vb, int kws, int vst0, int vst1) {
    *(LAS bf16x8*)(Kb + kws) = S.k0; *(LAS bf16x8*)(Kb + kws + 32 * 256) = S.k1;
    *(LAS bf16x8*)(Vb + vst0) = S.v0; *(LAS bf16x8*)(Vb + vst1) = S.v1;
}
}

struct NsaLane { int wid, lane, r32, hi, ql, j, sr, sc, kws, vst0, vst1, vrd; };
__device__ __forceinline__ NsaLane nsa_lane(const Frame& F) {
    NsaLane L; L.wid = F.wave; L.lane = F.lane; L.r32 = F.lane & 31; L.hi = F.lane >> 5; L.ql = L.r32 >> 2; L.j = L.r32 & 3;
    L.sr = F.tid >> 4; L.sc = (F.tid & 15) * 8; L.kws = FA_KSWZ(L.sr, L.sc * 2); L.vst0 = fa::v_st(L.sr, L.sc); L.vst1 = fa::v_st(32 + L.sr, L.sc); L.vrd = fa::v_rd_base(F.lane);
    return L;
}
__device__ __forceinline__ void nsa_load_q(bf16x8 (&qr)[8], const bf16* P0, int tok0, int g, const NsaLane& L) {
    const bf16* qp = P0 + (size_t)(tok0 + L.wid * 8 + L.ql) * P0LD + (g * 4 + L.j) * 128 + L.hi * 8;
#pragma unroll
    for (int d0 = 0; d0 < 8; ++d0) qr[d0] = *(const bf16x8*)(qp + d0 * 16);
}
__device__ __forceinline__ void nsa_lut(Frame& F, const Args& A) {
    LAS float* lut = (LAS float*)(F.lds + RING_OFF + fa::OFF_LUT);
    for (int i = F.tid; i < 144 * 16; i += 512) { const int n = i >> 4, h = i & 15; lut[i] = A.in[1][rel_bucket(n) * 16 + h]; }
    __syncthreads();
}
template <int MODE>
__device__ __forceinline__ void nsa_store(const fa::f32x16 (&o)[4], float l_reg, LAS float* li_l, const float* GL, float* OACC, bf16* OATT, int tok0, int g, int br, const NsaLane& L) {
    if (L.hi == 0) li_l[L.r32] = l_reg;
    asm volatile("s_waitcnt lgkmcnt(0)" ::: "memory");
#pragma unroll
    for (int r = 0; r < 16; ++r) { const int row = fa::crow(r, L.hi), tok = tok0 + L.wid * 8 + (row >> 2), h = g * 4 + (row & 3);
        const float l = li_l[row]; const float gl = GL[(size_t)tok * 48 + h * 3 + br];
        const float sc = (l > 0.f) ? __builtin_amdgcn_rcpf(l) / (1.0f + __expf(-gl)) : 0.f;
        float* ap = OACC + (size_t)tok * DM + h * 128 + L.r32;
#pragma unroll
        for (int d0 = 0; d0 < 4; ++d0) { float v = o[d0][r] * sc;
            if (MODE == 0) ap[d0 * 32] = v;
            else if (MODE == 1) ap[d0 * 32] += v;
            else { v += ap[d0 * 32]; const float vn = __shfl_xor(v, 1); if ((L.r32 & 1) == 0) *(unsigned*)(OATT + (size_t)tok * DM + h * 128 + d0 * 32 + L.r32) = fa::cvtpk(v, vn); } } }
    asm volatile("s_waitcnt lgkmcnt(0)" ::: "memory");
}

__device__ __forceinline__ void p3a_nsa_cmp(Frame& F, const Args& A) {
    unsigned char* ws = A.ws; const NsaLane L = nsa_lane(F);
    const bf16* P0 = (const bf16*)(ws + WS_P0); const bf16* KCB = (const bf16*)(ws + WS_KCMP); const bf16* VCB = (const bf16*)(ws + WS_VCMP);
    const float* GL = (const float*)(ws + WS_GL); float* OACC = (float*)(ws + WS_Z); unsigned* SELM = (unsigned*)(ws + WS_SELM);
    nsa_lut(F, A);
    LAS char* lds = (LAS char*)(F.lds + RING_OFF);
    LAS float* wsf = (LAS float*)(lds + fa::OFF_WS) + L.wid * 64; LAS float* li_l = wsf; LAS float* al_l = wsf + 32;
    const LAS float* lut = (const LAS float*)(lds + fa::OFF_LUT);
    LAS float* tab = (LAS float*)(lds + fa::OFF_TAB);
    for (int ui = 0; ui < 2 * ((512 - F.vcu + F.G - 1) / F.G); ++ui) {
        const int p = F.vcu + (ui >> 1) * F.G, bg = p >> 6, y = p & 63, qb = (ui & 1) ? 127 - y : y, b = bg >> 2, g = bg & 3;
        const int tok0 = b * SEQ + qb * 64;
        bf16x8 qr[8]; nsa_load_q(qr, P0, tok0, g, L);
        const int trow = qb * 64 + L.wid * 8 + L.ql;
        const int h = g * 4 + L.j; const LAS float* lutcol = lut + h; const float bias_far = lutcol[128 * 16];
        const int nmaxrow = (trow >= 31) ? (trow - 31) >> 4 : -1;
        const int NT = (4 * qb + 3 + 63) >> 6;
        const bf16* Kg = KCB + (size_t)(b * 4 + g) * 512 * 128; const bf16* Vg = VCB + (size_t)(b * 4 + g) * 512 * 128;
        for (int i = F.tid; i < 64 * fa::TABLD; i += 512) tab[i] = 0.f;
        float m_reg = -1e30f, l_reg = 0.f;
        fa::Stage S;
        const int rem16 = (trow >= 31) ? ((trow - 31) & 15) : 0;
        fa::stage_load(S, Kg, Vg, 128, 0, 511, L.sr, L.sc); asm volatile("s_waitcnt vmcnt(0)" ::: "memory");
        fa::stage_write(S, lds + fa::OFF_K, lds + fa::OFF_V, L.kws, L.vst0, L.vst1);
        __syncthreads();
#pragma unroll 1
        for (int t = 0; t < NT; ++t) {
            const int buf = t & 1;
            if (t + 1 < NT) fa::stage_load(S, Kg, Vg, 128, (t + 1) * 64, 511, L.sr, L.sc);
            fa::f32x16 p0, p1;
            const bool farT = (qb * 64 + L.wid * 8) - 31 - 16 * (t * 64 + 63) >= 128;
            fa::qkt(p0, p1, lds + fa::OFF_K + buf * fa::SHM_K, L.r32, L.hi, qr, farT ? bias_far : 0.f);
            const int dq = nmaxrow - t * 64 - 4 * L.hi;
            if (!farT) fa::bias_near(p0, p1, dq, 16, lutcol + rem16 * 16);
            fa::mask_tile(p0, p1, dq, 0x40000000u);
            float alpha; fa::partialSM(p0, p1, m_reg, alpha);
            float ps = 0.f;
#pragma unroll
            for (int r = 0; r < 16; ++r) ps += p0[r] + p1[r];
            { auto rr = __builtin_amdgcn_permlane32_swap(__float_as_uint(ps), __float_as_uint(ps), false, false); ps = __uint_as_float(rr[0]) + __uint_as_float(rr[1]); }
            l_reg = l_reg * alpha + ps;
            if (t + 1 < NT) { asm volatile("s_waitcnt vmcnt(0)" ::: "memory"); fa::stage_write(S, lds + fa::OFF_K + (buf ^ 1) * fa::SHM_K, lds + fa::OFF_V + (buf ^ 1) * fa::SHM_V, L.kws, L.vst0, L.vst1); }
            __syncthreads();
        }
        fa::f32x16 o[4];
#pragma unroll
        for (int d = 0; d < 4; ++d)
#pragma unroll
            for (int r = 0; r < 16; ++r) o[d][r] = 0.f;
        fa::stage_load(S, Kg, Vg, 128, 0, 511, L.sr, L.sc); asm volatile("s_waitcnt vmcnt(0)" ::: "memory");
        fa::stage_write(S, lds + fa::OFF_K, lds + fa::OFF_V, L.kws, L.vst0, L.vst1);
        __syncthreads();
        const float inv_l = (l_reg > 0.f) ? 1.0f / l_reg : 0.f; const float mnL = -m_reg * fa::C2;
#pragma unroll 1
        for (int t = 0; t < NT; ++t) {
            const int buf = t & 1;
            if (t + 1 < NT) fa::stage_load(S, Kg, Vg, 128, (t + 1) * 64, 511, L.sr, L.sc);
            fa::f32x16 p0, p1;
            const bool farT = (qb * 64 + L.wid * 8) - 31 - 16 * (t * 64 + 63) >= 128;
            fa::qkt(p0, p1, lds + fa::OFF_K + buf * fa::SHM_K, L.r32, L.hi, qr, farT ? bias_far : 0.f);
            const int dq = nmaxrow - t * 64 - 4 * L.hi;
            if (!farT) fa::bias_near(p0, p1, dq, 16, lutcol + rem16 * 16);
            fa::mask_tile(p0, p1, dq, 0x40000000u);
#pragma unroll
            for (int r = 0; r < 16; ++r) { p0[r] = __builtin_amdgcn_exp2f(fmaf(p0[r], fa::C2, mnL)) * inv_l; p1[r] = __builtin_amdgcn_exp2f(fmaf(p1[r], fa::C2, mnL)) * inv_l; }
            LAS float* tb = tab + (L.wid * 8 + L.ql) * fa::TABLD + t * 16 + L.hi;
#pragma unroll
            for (int half = 0; half < 2; ++half)
#pragma unroll
                for (int gq = 0; gq < 4; ++gq) { const fa::f32x16& pp = half ? p1 : p0;
                    float s4 = pp[4 * gq] + pp[4 * gq + 1] + pp[4 * gq + 2] + 0.5f * pp[4 * gq + 3], cr = 0.5f * pp[4 * gq + 3];
                    s4 += __shfl_xor(s4, 1); s4 += __shfl_xor(s4, 2); cr += __shfl_xor(cr, 1); cr += __shfl_xor(cr, 2);
                    if (L.j == 0) { __hip_atomic_fetch_add(tb + half * 8 + 2 * gq, s4, __ATOMIC_RELAXED, __HIP_MEMORY_SCOPE_WORKGROUP); __hip_atomic_fetch_add(tb + half * 8 + 2 * gq + 1, cr, __ATOMIC_RELAXED, __HIP_MEMORY_SCOPE_WORKGROUP); } }
            bf16x8 a0, a1, a2, a3; (void)fa::finishSM(p0, p1, a0, a1, a2, a3);
            fa::pv_tile(o, (int)(uintptr_t)(lds + fa::OFF_V + buf * fa::SHM_V) + L.vrd, a0, a1, a2, a3);
            if (t + 1 < NT) { asm volatile("s_waitcnt vmcnt(0)" ::: "memory"); fa::stage_write(S, lds + fa::OFF_K + (buf ^ 1) * fa::SHM_K, lds + fa::OFF_V + (buf ^ 1) * fa::SHM_V, L.kws, L.vst0, L.vst1); }
            __syncthreads();
        }
        nsa_store<0>(o, (l_reg > 0.f) ? 1.0f : 0.f, li_l, GL, OACC, nullptr, tok0, g, 0, L);
        __syncthreads();
        for (int qi = 0; qi < 8; ++qi) { const int ql = L.wid * 8 + qi;
            bool s0 = false, s1 = false;
            if (qb < 16) { s0 = (L.lane <= qb); }
            else {
                float v0 = (L.lane >= 1 && L.lane <= qb - 2) ? tab[ql * fa::TABLD + L.lane] : -1.0f, v1 = (L.lane + 64 <= qb - 2) ? tab[ql * fa::TABLD + L.lane + 64] : -1.0f;
                s0 = (L.lane == 0) || (L.lane == qb) || (L.lane == qb - 1); s1 = (L.lane + 64 == qb) || (L.lane + 64 == qb - 1);
                if (s0) v0 = -3e38f; if (s1) v1 = -3e38f;
#pragma unroll 1
                for (int k = 0; k < 13; ++k) { float bv = v0; int bi = L.lane; if (v1 > v0) { bv = v1; bi = L.lane + 64; }
#pragma unroll
                    for (int of = 1; of < 64; of <<= 1) { const float ov = __shfl_xor(bv, of); const int oi = __shfl_xor(bi, of); if (ov > bv || (ov == bv && oi < bi)) { bv = ov; bi = oi; } }
                    if (bi == L.lane) { v0 = -3e38f; s0 = true; } if (bi == L.lane + 64) { v1 = -3e38f; s1 = true; } }
            }
            const unsigned long long b0 = __ballot(s0), b1 = __ballot(s1);
            if (L.lane == 0) { uint4 mv; mv.x = (unsigned)b0; mv.y = (unsigned)(b0 >> 32); mv.z = (unsigned)b1; mv.w = (unsigned)(b1 >> 32); *(uint4*)(SELM + ((size_t)(tok0 + ql) * 4 + g) * 4) = mv; }
        }
        __syncthreads();
    }
}
__device__ __forceinline__ void p3b_nsa_sel(Frame& F, const Args& A) {
    unsigned char* ws = A.ws; const NsaLane L = nsa_lane(F);
    const bf16* P0 = (const bf16*)(ws + WS_P0); const float* GL = (const float*)(ws + WS_GL); float* OACC = (float*)(ws + WS_Z); const unsigned* SELM = (const unsigned*)(ws + WS_SELM);
    nsa_lut(F, A);
    LAS char* lds = (LAS char*)(F.lds + RING_OFF);
    LAS float* wsf = (LAS float*)(lds + fa::OFF_WS) + L.wid * 64; LAS float* li_l = wsf; LAS float* al_l = wsf + 32;
    const LAS float* lut = (const LAS float*)(lds + fa::OFF_LUT);
    for (int ui = 0; ui < 2 * ((512 - F.vcu + F.G - 1) / F.G); ++ui) {
        const int p = F.vcu + (ui >> 1) * F.G, bg = p >> 6, y = p & 63, qb = (ui & 1) ? 127 - y : y, b = bg >> 2, g = bg & 3;
        const int tok0 = b * SEQ + qb * 64;
        bf16x8 qr[8]; nsa_load_q(qr, P0, tok0, g, L);
        const int trow = qb * 64 + L.wid * 8 + L.ql;
        const int h = g * 4 + L.j; const LAS float* lutcol = lut + h; const float bias_far = lutcol[128 * 16];
        const uint4 mv = *(const uint4*)(SELM + ((size_t)(tok0 + L.wid * 8 + L.ql) * 4 + g) * 4);
        const bf16* Kg = P0 + (size_t)b * SEQ * P0LD + COL_KS + g * 128; const bf16* Vg = P0 + (size_t)b * SEQ * P0LD + COL_VS + g * 128;
        const int NT = qb + 1;
        float m_reg = -1e30f, l_reg = 0.f; fa::f32x16 o[4];
#pragma unroll
        for (int d = 0; d < 4; ++d)
#pragma unroll
            for (int r = 0; r < 16; ++r) o[d][r] = 0.f;
        fa::Stage S;
        fa::stage_load(S, Kg, Vg, P0LD, 0, SEQ - 1, L.sr, L.sc); asm volatile("s_waitcnt vmcnt(0)" ::: "memory");
        fa::stage_write(S, lds + fa::OFF_K, lds + fa::OFF_V, L.kws, L.vst0, L.vst1);
        __syncthreads();
#pragma unroll 1
        for (int t = 0; t < NT; ++t) {
            const int buf = t & 1;
            if (t + 1 < NT) fa::stage_load(S, Kg, Vg, P0LD, (t + 1) * 64, SEQ - 1, L.sr, L.sc);
            fa::f32x16 p0, p1;
            const bool farT = (qb * 64 + L.wid * 8) - (t * 64 + 63) >= 128;
            fa::qkt(p0, p1, lds + fa::OFF_K + buf * fa::SHM_K, L.r32, L.hi, qr, farT ? bias_far : 0.f);
            const int dq = trow - t * 64 - 4 * L.hi;
            if (!farT) fa::bias_near(p0, p1, dq, 1, lutcol);
            const unsigned word = (t < 32) ? mv.x : (t < 64) ? mv.y : (t < 96) ? mv.z : mv.w;
            fa::mask_all(p0, p1, ((word >> (t & 31)) & 1u) != 0u);
            if (t == qb) fa::mask_tile(p0, p1, dq, 0x40000000u);
            float alpha; fa::partialSM(p0, p1, m_reg, alpha);
            fa::rescale(o, alpha, al_l, L.r32, L.hi);
            bf16x8 a0, a1, a2, a3; const float ps = fa::finishSM(p0, p1, a0, a1, a2, a3); l_reg = l_reg * alpha + ps;
            fa::pv_tile(o, (int)(uintptr_t)(lds + fa::OFF_V + buf * fa::SHM_V) + L.vrd, a0, a1, a2, a3);
            if (t + 1 < NT) { asm volatile("s_waitcnt vmcnt(0)" ::: "memory"); fa::stage_write(S, lds + fa::OFF_K + (buf ^ 1) * fa::SHM_K, lds + fa::OFF_V + (buf ^ 1) * fa::SHM_V, L.kws, L.vst0, L.vst1); }
            __syncthreads();
        }
        nsa_store<1>(o, l_reg, li_l, GL, OACC, nullptr, tok0, g, 1, L);
        __syncthreads();
    }
}
__device__ __forceinline__ void p3c_nsa_win(Frame& F, const Args& A) {
    unsigned char* ws = A.ws; const NsaLane L = nsa_lane(F);
    const bf16* P0 = (const bf16*)(ws + WS_P0); const float* GL = (const float*)(ws + WS_GL); float* OACC = (float*)(ws + WS_Z); bf16* OATT = (bf16*)(ws + WS_OATT0);
    nsa_lut(F, A);
    LAS char* lds = (LAS char*)(F.lds + RING_OFF);
    LAS float* wsf = (LAS float*)(lds + fa::OFF_WS) + L.wid * 64; LAS float* li_l = wsf; LAS float* al_l = wsf + 32;
    const LAS float* lut = (const LAS float*)(lds + fa::OFF_LUT);
    for (int u = F.vcu; u < 1024; u += F.G) {
        const int bg = u >> 7, qb = u & 127, b = bg >> 2, g = bg & 3;
        const int tok0 = b * SEQ + qb * 64;
        bf16x8 qr[8]; nsa_load_q(qr, P0, tok0, g, L);
        const int trow = qb * 64 + L.wid * 8 + L.ql;
        const int h = g * 4 + L.j; const LAS float* lutcol = lut + h; const float bias_far = lutcol[128 * 16];
        const bf16* Kg = P0 + (size_t)b * SEQ * P0LD + COL_KW + g * 128; const bf16* Vg = P0 + (size_t)b * SEQ * P0LD + COL_VW + g * 128;
        const int t0 = max(0, qb - 8), NT = qb - t0 + 1;
        float m_reg = -1e30f, l_reg = 0.f; fa::f32x16 o[4];
#pragma unroll
        for (int d = 0; d < 4; ++d)
#pragma unroll
            for (int r = 0; r < 16; ++r) o[d][r] = 0.f;
        fa::Stage S;
        fa::stage_load(S, Kg, Vg, P0LD, t0 * 64, SEQ - 1, L.sr, L.sc); asm volatile("s_waitcnt vmcnt(0)" ::: "memory");
        fa::stage_write(S, lds + fa::OFF_K, lds + fa::OFF_V, L.kws, L.vst0, L.vst1);
        __syncthreads();
#pragma unroll 1
        for (int tt = 0; tt < NT; ++tt) {
            const int buf = tt & 1, t = t0 + tt;
            if (tt + 1 < NT) fa::stage_load(S, Kg, Vg, P0LD, (t + 1) * 64, SEQ - 1, L.sr, L.sc);
            fa::f32x16 p0, p1;
            const bool farT = (qb * 64 + L.wid * 8) - (t * 64 + 63) >= 128;
            fa::qkt(p0, p1, lds + fa::OFF_K + buf * fa::SHM_K, L.r32, L.hi, qr, farT ? bias_far : 0.f);
            const int dq = trow - t * 64 - 4 * L.hi;
            if (!farT) fa::bias_near(p0, p1, dq, 1, lutcol);
            if (t == qb || t == t0) fa::mask_tile(p0, p1, dq, 512u);
            float alpha; fa::partialSM(p0, p1, m_reg, alpha);
            fa::rescale(o, alpha, al_l, L.r32, L.hi);
            bf16x8 a0, a1, a2, a3; const float ps = fa::finishSM(p0, p1, a0, a1, a2, a3); l_reg = l_reg * alpha + ps;
            fa::pv_tile(o, (int)(uintptr_t)(lds + fa::OFF_V + buf * fa::SHM_V) + L.vrd, a0, a1, a2, a3);
            if (tt + 1 < NT) { asm volatile("s_waitcnt vmcnt(0)" ::: "memory"); fa::stage_write(S, lds + fa::OFF_K + (buf ^ 1) * fa::SHM_K, lds + fa::OFF_V + (buf ^ 1) * fa::SHM_V, L.kws, L.vst0, L.vst1); }
            __syncthreads();
        }
        nsa_store<2>(o, l_reg, li_l, GL, OACC, OATT, tok0, g, 2, L);
        __syncthreads();
    }
}

template <bool ROUTE>
__device__ __forceinline__ void ln_phase(Frame& F, const Args& A, const float* Z, const float* gam, const float* bet, float* XF, bf16* XB) {
    const int gw = F.vcu * NWAVES + F.wave, NGW = F.G * NWAVES, lane = F.lane;
    LAS float* wrl = (LAS float*)(F.lds + RING_OFF);
    if (ROUTE) { for (int i = F.tid; i < DM * 8 / 4; i += 512) *(LAS f32x4*)(wrl + i * 4) = *(const f32x4*)(A.in[18] + i * 4); __syncthreads(); }
    for (int row = gw; row < NTOK; row += NGW) {
        const f32x4* zr = (const f32x4*)(Z + (size_t)row * DM) + lane;
        f32x4 v[8]; float s = 0.f;
#pragma unroll
        for (int j = 0; j < 8; ++j) { v[j] = zr[64 * j]; s += (v[j][0] + v[j][1]) + (v[j][2] + v[j][3]); }
        const float mean = wave_sum(s) * (1.f / DM); float s2 = 0.f;
#pragma unroll
        for (int j = 0; j < 8; ++j) { v[j] = v[j] - mean; s2 += (v[j][0] * v[j][0] + v[j][1] * v[j][1]) + (v[j][2] * v[j][2] + v[j][3] * v[j][3]); }
        const float rstd = 1.f / sqrtf(wave_sum(s2) * (1.f / DM) + LN_EPS);
        float lg[8];
#pragma unroll
        for (int e = 0; e < 8; ++e) lg[e] = 0.f;
#pragma unroll
        for (int j = 0; j < 8; ++j) { const int c = 4 * lane + 256 * j; const f32x4 gg = *(const f32x4*)(gam + c), bb = *(const f32x4*)(bet + c);
            const f32x4 x = v[j] * rstd * gg + bb;
            *(f32x4*)(XF + (size_t)row * DM + c) = x;
            uint2 o; o.x = pk2(x[0], x[1]); o.y = pk2(x[2], x[3]); *(uint2*)(XB + (size_t)row * DM + c) = o;
            asm volatile("" ::: "memory");
            if (ROUTE) { const LAS float* wr = wrl + c * 8;
#pragma unroll
                for (int q = 0; q < 4; ++q) { const f32x4 w0 = *(const LAS f32x4*)(wr + q * 8), w1 = *(const LAS f32x4*)(wr + q * 8 + 4);
                    lg[0] += x[q] * w0[0]; lg[1] += x[q] * w0[1]; lg[2] += x[q] * w0[2]; lg[3] += x[q] * w0[3]; lg[4] += x[q] * w1[0]; lg[5] += x[q] * w1[1]; lg[6] += x[q] * w1[2]; lg[7] += x[q] * w1[3]; }  asm volatile("" ::: "memory"); }
        }
        if (ROUTE) {
#pragma unroll
            for (int e = 0; e < 8; ++e) lg[e] = wave_sum(lg[e]) + A.in[19][e];
            int e0 = 0; float l0 = lg[0];
#pragma unroll
            for (int e = 1; e < 8; ++e) if (lg[e] > l0) { l0 = lg[e]; e0 = e; }
            int e1 = -1; float l1 = -3e38f;
#pragma unroll
            for (int e = 0; e < 8; ++e) if (e != e0 && lg[e] > l1) { l1 = lg[e]; e1 = e; }
            const float w0 = 1.0f / (1.0f + __expf(l1 - l0)), w1 = 1.0f - w0;
            if (lane == 0) {
                const unsigned p0 = __hip_atomic_fetch_add((unsigned*)(F.ctl + CW_MOECNT + 64 * e0), 1u, __ATOMIC_RELAXED, __HIP_MEMORY_SCOPE_AGENT);
                const unsigned p1 = __hip_atomic_fetch_add((unsigned*)(F.ctl + CW_MOECNT + 64 * e1), 1u, __ATOMIC_RELAXED, __HIP_MEMORY_SCOPE_AGENT);
                int* re = (int*)(A.ws + WS_ROUTE); int* rp = re + 2 * NTOK; float* rw = (float*)(rp + 2 * NTOK);
                re[2 * row] = e0; re[2 * row + 1] = e1; rp[2 * row] = (int)p0; rp[2 * row + 1] = (int)p1; rw[2 * row] = w0; rw[2 * row + 1] = w1;
            }
        }
    }
}

__device__ __forceinline__ void ln_route_phase(Frame& F, const Args& A, const float* Z, const float* gam, const float* bet, float* XF, bf16* XB) {
    const int gw = F.vcu * NWAVES + F.wave, NGW = F.G * NWAVES, lane = F.lane;
    LAS float* wrl = (LAS float*)(F.lds + RING_OFF);
    LAS float* rowb = (LAS float*)(F.lds + RING_OFF + 65536 + F.wave * 8192);
    for (int i = F.tid; i < DM * 8 / 4; i += 512) *(LAS f32x4*)(wrl + i * 4) = *(const f32x4*)(A.in[18] + i * 4);
    __syncthreads();
    for (int row = gw; row < NTOK; row += NGW) {
        float s = 0.f, s2 = 0.f;
#pragma unroll 1
        for (int j = 0; j < 8; ++j) { const f32x4 v = *(const f32x4*)(Z + (size_t)row * DM + 4 * lane + 256 * j); *(LAS f32x4*)(rowb + 4 * lane + 256 * j) = v;
            s += (v[0] + v[1]) + (v[2] + v[3]); }
        const float mean = wave_sum(s) * (1.f / DM);
#pragma unroll 1
        for (int j = 0; j < 8; ++j) { const f32x4 v = *(const LAS f32x4*)(rowb + 4 * lane + 256 * j) - mean; s2 += (v[0] * v[0] + v[1] * v[1]) + (v[2] * v[2] + v[3] * v[3]); }
        const float rstd = 1.f / sqrtf(wave_sum(s2) * (1.f / DM) + LN_EPS);
        float lg[8];
#pragma unroll
        for (int e = 0; e < 8; ++e) lg[e] = 0.f;
#pragma unroll 1
        for (int j = 0; j < 8; ++j) { const int c = 4 * lane + 256 * j; const f32x4 gg = *(const f32x4*)(gam + c), bb = *(const f32x4*)(bet + c);
            const f32x4 x = (*(const LAS f32x4*)(rowb + c) - mean) * rstd * gg + bb;
            *(f32x4*)(XF + (size_t)row * DM + c) = x;
            uint2 o; o.x = pk2(x[0], x[1]); o.y = pk2(x[2], x[3]); *(uint2*)(XB + (size_t)row * DM + c) = o;
            const LAS float* wr = wrl + c * 8;
#pragma unroll
            for (int q = 0; q < 4; ++q) { const f32x4 w0 = *(const LAS f32x4*)(wr + q * 8), w1 = *(const LAS f32x4*)(wr + q * 8 + 4);
                lg[0] += x[q] * w0[0]; lg[1] += x[q] * w0[1]; lg[2] += x[q] * w0[2]; lg[3] += x[q] * w0[3]; lg[4] += x[q] * w1[0]; lg[5] += x[q] * w1[1]; lg[6] += x[q] * w1[2]; lg[7] += x[q] * w1[3]; } }
#pragma unroll
        for (int e = 0; e < 8; ++e) lg[e] = wave_sum(lg[e]) + A.in[19][e];
        int e0 = 0; float l0 = lg[0];
#pragma unroll
        for (int e = 1; e < 8; ++e) if (lg[e] > l0) { l0 = lg[e]; e0 = e; }
        int e1 = -1; float l1 = -3e38f;
#pragma unroll
        for (int e = 0; e < 8; ++e) if (e != e0 && lg[e] > l1) { l1 = lg[e]; e1 = e; }
        const float w0 = 1.0f / (1.0f + __expf(l1 - l0)), w1 = 1.0f - w0;
        if (lane == 0) {
            const unsigned p0 = __hip_atomic_fetch_add((unsigned*)(F.ctl + CW_MOECNT + 64 * e0), 1u, __ATOMIC_RELAXED, __HIP_MEMORY_SCOPE_AGENT);
            const unsigned p1 = __hip_atomic_fetch_add((unsigned*)(F.ctl + CW_MOECNT + 64 * e1), 1u, __ATOMIC_RELAXED, __HIP_MEMORY_SCOPE_AGENT);
            int* re = (int*)(A.ws + WS_ROUTE); int* rp = re + 2 * NTOK; float* rw = (float*)(rp + 2 * NTOK);
            re[2 * row] = e0; re[2 * row + 1] = e1; rp[2 * row] = (int)p0; rp[2 * row + 1] = (int)p1; rw[2 * row] = w0; rw[2 * row + 1] = w1;
        }
        WSYNC();
    }
    __syncthreads();
}

__device__ __forceinline__ void p10_dsa_prep(Frame& F, const Args& A) {
    unsigned char* ws = A.ws; const int lane = F.lane;
    const int gw = F.vcu * NWAVES + F.wave, NGW = F.G * NWAVES;
    { const float* CR = (const float*)(ws + WS_CRAW); bf16* CN = (bf16*)(ws + WS_CN); const f32x4 gg = *(const f32x4*)(A.in[11] + 4 * lane);
      for (int row = gw; row < NTOK; row += NGW) { const f32x4 v = *(const f32x4*)(CR + (size_t)row * KVR + 4 * lane);
          const float ss = wave_sum(v[0] * v[0] + v[1] * v[1] + v[2] * v[2] + v[3] * v[3]); const float r = 1.f / sqrtf(ss * (1.f / KVR) + RMS_EPS);
          uint2 o; o.x = pk2(v[0] * r * gg[0], v[1] * r * gg[1]); o.y = pk2(v[2] * r * gg[2], v[3] * r * gg[3]); *(uint2*)(CN + (size_t)row * KVR + 4 * lane) = o;
          if (lane < 16) { const f32x4 kv = *(const f32x4*)((const float*)(ws + WS_KIWI) + (size_t)row * 128 + 4 * lane); uint2 k2; k2.x = pk2(kv[0], kv[1]); k2.y = pk2(kv[2], kv[3]); *(uint2*)((bf16*)(ws + WS_KIB) + (size_t)row * 64 + 4 * lane) = k2; } } }
    const bf16* Q = (const bf16*)(ws + WS_Q); const bf16* UKT = (const bf16*)(ws + WS_W_UK); bf16* QL = (bf16*)(ws + WS_QLAT);
    const int r16 = lane & 15, kq = lane >> 4; const float sc = 0.08838834764831845f;
    for (int it = gw; it < 512 * 16 * 4; it += NGW) {
        const int nc = it & 3, h = (it >> 2) & 15, mt = it >> 6;
        f32x4 acc[2][4];
#pragma unroll
        for (int m = 0; m < 2; ++m)
#pragma unroll
            for (int n = 0; n < 4; ++n) acc[m][n] = (f32x4){0.f, 0.f, 0.f, 0.f};
#pragma unroll
        for (int ks = 0; ks < 4; ++ks) { s8v af[2], bfr[4];
#pragma unroll
            for (int m = 0; m < 2; ++m) af[m] = ld_frag(Q + (size_t)(mt * 32 + m * 16 + r16) * DM + h * 128 + ks * 32 + kq * 8);
#pragma unroll
            for (int n = 0; n < 4; ++n) bfr[n] = ld_frag(UKT + ((size_t)h * 256 + nc * 64 + n * 16 + r16) * 128 + ks * 32 + kq * 8);
#pragma unroll
            for (int m = 0; m < 2; ++m)
#pragma unroll
                for (int n = 0; n < 4; ++n) acc[m][n] = __builtin_amdgcn_mfma_f32_16x16x32_bf16(af[m], bfr[n], acc[m][n], 0, 0, 0); }
#pragma unroll
        for (int m = 0; m < 2; ++m)
#pragma unroll
            for (int n = 0; n < 4; ++n)
#pragma unroll
                for (int j = 0; j < 4; ++j) QL[(size_t)(mt * 32 + m * 16 + kq * 4 + j) * 4096 + h * 256 + nc * 64 + n * 16 + r16] = (bf16)f2bf(acc[m][n][j] * sc);
    }
}
__device__ __forceinline__ void p12_dsa_uv(Frame& F, const Args& A) {
    unsigned char* ws = A.ws; const int lane = F.lane;
    const int gw = F.vcu * NWAVES + F.wave, NGW = F.G * NWAVES;
    const bf16* OL = (const bf16*)(ws + WS_OLAT); const bf16* UVT = (const bf16*)(ws + WS_W_UV); bf16* O = (bf16*)(ws + WS_OATT1);
    const int r16 = lane & 15, kq = lane >> 4;
    for (int it = gw; it < 512 * 16 * 2; it += NGW) {
        const int nc = it & 1, h = (it >> 1) & 15, mt = it >> 5;
        f32x4 acc[2][4];
#pragma unroll
        for (int m = 0; m < 2; ++m)
#pragma unroll
            for (int n = 0; n < 4; ++n) acc[m][n] = (f32x4){0.f, 0.f, 0.f, 0.f};
#pragma unroll
        for (int ks = 0; ks < 8; ++ks) { s8v af[2], bfr[4];
#pragma unroll
            for (int m = 0; m < 2; ++m) af[m] = ld_frag(OL + (size_t)(mt * 32 + m * 16 + r16) * 4096 + h * 256 + ks * 32 + kq * 8);
#pragma unroll
            for (int n = 0; n < 4; ++n) bfr[n] = ld_frag(UVT + ((size_t)h * 128 + nc * 64 + n * 16 + r16) * 256 + ks * 32 + kq * 8);
#pragma unroll
            for (int m = 0; m < 2; ++m)
#pragma unroll
                for (int n = 0; n < 4; ++n) acc[m][n] = __builtin_amdgcn_mfma_f32_16x16x32_bf16(af[m], bfr[n], acc[m][n], 0, 0, 0); }
#pragma unroll
        for (int m = 0; m < 2; ++m)
#pragma unroll
            for (int n = 0; n < 4; ++n)
#pragma unroll
                for (int j = 0; j < 4; ++j) O[(size_t)(mt * 32 + m * 16 + kq * 4 + j) * DM + h * 128 + nc * 64 + n * 16 + r16] = (bf16)f2bf(acc[m][n][j]);
    }
}

__device__ __forceinline__ unsigned f2key(float f) { const unsigned u = __float_as_uint(f); return (u & 0x80000000u) ? ~u : (u | 0x80000000u); }

__device__ __forceinline__ unsigned dsa_off_b(unsigned row, unsigned ch) { return 256u * row + 16u * (ch ^ (((row & 3) << 2) | ((row >> 2) & 3))); }

__device__ __forceinline__ void p13a_dsa_index(Frame& F, const Args& A) {
    unsigned char* ws = A.ws; const int lane = F.lane, wid = F.wave, r32 = lane & 31, hi = lane >> 5;
    const bf16* QI = (const bf16*)(ws + WS_QI); const bf16* KIB = (const bf16*)(ws + WS_KIB); const float* KIWI = (const float*)(ws + WS_KIWI); int* IDX = (int*)(ws + WS_IDX);
    LAS float* sc = (LAS float*)(F.lds + RING_OFF);
    LAS unsigned* hist = (LAS unsigned*)(F.lds + DSA_SCR);
    LAS int* idxl = (LAS int*)(hist + 1024);
    LAS int* tiel = idxl + 1024;
    LAS unsigned* qm = (LAS unsigned*)(tiel + 256);
    const int q = wid >> 1, sub = wid & 1, th = sub * 64 + lane;
    for (int slot = F.vcu; slot < NTOK / 4; slot += F.G) {
        const int rowi = slot >> 8; int cc = slot & 255; if (rowi & 1) cc = 255 - cc;
        const int tok0 = (rowi * 256 + cc) * 4, b = tok0 >> 13, t0 = tok0 & (SEQ - 1), tmax = t0 + 3;
        bf16x8 qa[4];
#pragma unroll
        for (int s = 0; s < 4; ++s) qa[s] = *(const bf16x8*)(QI + (size_t)(tok0 + (r32 >> 3)) * 512 + (r32 & 7) * 64 + 16 * s + 8 * hi);
        float wv[16];
#pragma unroll
        for (int r = 0; r < 16; ++r) wv[r] = KIWI[(size_t)(tok0 + (r >> 2)) * 128 + 64 + (r & 3) + 4 * hi] * 0.35355339059327373f;
        const int ntiles = (tmax >> 5) + 1;
        for (int tile = wid; tile < ntiles; tile += 8) {
            const int key = tile * 32 + r32; const bf16* kp = KIB + (size_t)(b * SEQ + key) * 64 + 8 * hi;
            bf16x8 kb[4];
#pragma unroll
            for (int s = 0; s < 4; ++s) kb[s] = *(const bf16x8*)(kp + 16 * s);
            fa::f32x16 acc;
#pragma unroll
            for (int r = 0; r < 16; ++r) acc[r] = 0.f;
#pragma unroll
            for (int s = 0; s < 4; ++s) acc = __builtin_amdgcn_mfma_f32_32x32x16_bf16(qa[s], kb[s], acc, 0, 0, 0);
#pragma unroll
            for (int qq = 0; qq < 4; ++qq) { float part = 0.f;
#pragma unroll
                for (int r3 = 0; r3 < 4; ++r3) part += wv[4 * qq + r3] * fmaxf(acc[4 * qq + r3], 0.f);
                const float tot = part + __shfl_xor(part, 32);
                if ((qq >> 1) == hi) sc[qq * 8192 + key] = tot + 0.0f; }
        }
        __syncthreads();
        const int tok = tok0 + q, n = t0 + q + 1;
        if (tmax + 1 <= TOPK) {
            for (int i = th; i < TOPK; i += 128) IDX[(size_t)tok * TOPK + i] = (i < n) ? i : 0;
        } else {
            unsigned prefix = 0u, pmask = 0u, need = TOPK;
#pragma unroll 1
            for (int pass = 0; pass < 4; ++pass) {
                const int shift = 24 - 8 * pass;
                hist[q * 256 + th] = 0u; hist[q * 256 + 128 + th] = 0u;
                __syncthreads();
                for (int i = th; i < n; i += 128) { const unsigned u = f2key(sc[q * 8192 + i]); if ((u & pmask) == prefix) __hip_atomic_fetch_add(&hist[q * 256 + ((u >> shift) & 255u)], 1u, __ATOMIC_RELAXED, __HIP_MEMORY_SCOPE_WORKGROUP); }
                __syncthreads();
                if (sub == 0) {
                    const v4u c4 = *(const LAS v4u*)(hist + q * 256 + 4 * lane); const unsigned s4 = c4.x + c4.y + c4.z + c4.w; unsigned S = s4;
#pragma unroll
                    for (int o = 1; o < 64; o <<= 1) { const unsigned v = __shfl_down(S, o); if (lane + o < 64) S += v; }
                    const unsigned above = S - s4;
                    if (above < need && need <= S) { unsigned cum = above; int bin;
                        if (cum + c4.w >= need) bin = 3; else { cum += c4.w; if (cum + c4.z >= need) bin = 2; else { cum += c4.z; if (cum + c4.y >= need) bin = 1; else { cum += c4.y; bin = 0; } } }
                        qm[q * 8 + 0] = prefix | ((unsigned)(4 * lane + bin) << shift); qm[q * 8 + 1] = need - cum; }
                }
                __syncthreads();
                prefix = qm[q * 8 + 0]; need = qm[q * 8 + 1]; pmask |= (255u << shift);
            }
            if (th == 0) { qm[q * 8 + 2] = 0u; qm[q * 8 + 3] = 0u; }
            __syncthreads();
            const unsigned T = prefix;
            for (int i = th; i < n; i += 128) { const unsigned u = f2key(sc[q * 8192 + i]);
                if (u > T) { const unsigned p = __hip_atomic_fetch_add(&qm[q * 8 + 2], 1u, __ATOMIC_RELAXED, __HIP_MEMORY_SCOPE_WORKGROUP); if (p < (unsigned)TOPK) idxl[q * 256 + p] = i; }
                else if (u == T) { const unsigned p = __hip_atomic_fetch_add(&qm[q * 8 + 3], 1u, __ATOMIC_RELAXED, __HIP_MEMORY_SCOPE_WORKGROUP); if (p < 64u) tiel[q * 64 + p] = i; } }
            __syncthreads();
            if (sub == 0) { const int base = (int)qm[q * 8 + 2]; const int nt = (int)min(qm[q * 8 + 3], 64u);
                const int ti = (lane < nt) ? tiel[q * 64 + lane] : 0x7fffffff; int rank = 0;
                for (int j = 0; j < nt; ++j) { const int tj = __shfl(ti, j); rank += (tj < ti) ? 1 : 0; }
                if (lane < nt && rank < (int)need && base + rank < TOPK) idxl[q * 256 + base + rank] = ti; }
            __syncthreads();
            for (int i = th; i < TOPK; i += 128) IDX[(size_t)tok * TOPK + i] = idxl[q * 256 + i];
        }
        __syncthreads();
    }
}

__device__ __forceinline__ void p13b_dsa_attn(Frame& F, const Args& A) {
    unsigned char* ws = A.ws; const int lane = F.lane, wid = F.wave, c16 = lane & 15, g4 = lane >> 4;
    const bf16* CN = (const bf16*)(ws + WS_CN); const bf16* QL = (const bf16*)(ws + WS_QLAT); const int* IDX = (const int*)(ws + WS_IDX); bf16* OL = (bf16*)(ws + WS_OLAT);
    LAS float* lut = (LAS float*)(F.lds + DSA_SCR + 8192);
    for (int i = F.tid; i < 144 * 16; i += 512) { const int n = i >> 4, h = i & 15; lut[i] = A.in[1][rel_bucket(n) * 16 + h]; }
    __syncthreads();
    LAS char* img = (LAS char*)(F.lds + RING_OFF + wid * 16384);
    LAS int* idxw = (LAS int*)(F.lds + DSA_SCR + wid * 1024);
    const unsigned imgb = (unsigned)(uintptr_t)img;
    const int gw = F.vcu * NWAVES + wid, NGW = F.G * NWAVES;
    const unsigned prow0 = 8u * ((lane >> 2) & 3) + (lane & 3);
    for (int tok = gw; tok < NTOK; tok += NGW) {
        const int b = tok >> 13, t = tok & (SEQ - 1), cnt = min(TOPK, t + 1), ntile = (cnt + 31) >> 5;
        bf16x8 qb[8];
#pragma unroll
        for (int ks = 0; ks < 8; ++ks) qb[ks] = *(const bf16x8*)(QL + (size_t)tok * 4096 + c16 * 256 + ks * 32 + g4 * 8);
#pragma unroll
        for (int i = 0; i < 4; ++i) idxw[lane + 64 * i] = IDX[(size_t)tok * TOPK + lane + 64 * i];
        WSYNC();
        f32x4 o[16];
#pragma unroll
        for (int ct = 0; ct < 16; ++ct) o[ct] = (f32x4){0.f, 0.f, 0.f, 0.f};
        float m_run = -1e30f, l_run = 0.f;
        const LAS float* lutcol = lut + c16;
#pragma unroll 1
        for (int tile = 0; tile < ntile; ++tile) {
            { v4u st[16];
#pragma unroll
              for (int i = 0; i < 16; ++i) { const int nn = lane + 64 * i, row = nn >> 5, chg = nn & 31; const int key = idxw[tile * 32 + row];
                  st[i] = *(const v4u*)(CN + (size_t)(b * SEQ + key) * KVR + chg * 8); }
#pragma unroll
              for (int i = 0; i < 16; ++i) { const int nn = lane + 64 * i, row = nn >> 5, chg = nn & 31;
                  *(LAS v4u*)(img + (chg >> 4) * 8192 + dsa_off_b(row, chg & 15)) = st[i]; } }
            WSYNC();
            f32x4 sacc[2];
#pragma unroll
            for (int T = 0; T < 2; ++T) { sacc[T] = (f32x4){0.f, 0.f, 0.f, 0.f};
#pragma unroll
                for (int ks = 0; ks < 8; ++ks) { const bf16x8 a = *(const LAS bf16x8*)(img + (ks >> 2) * 8192 + dsa_off_b(prow0 + 4 * T, 4 * (ks & 3) + g4));
                    sacc[T] = __builtin_amdgcn_mfma_f32_16x16x32_bf16(a, qb[ks], sacc[T], 0, 0, 0); } }
            float pmax = -__builtin_inff();
#pragma unroll
            for (int T = 0; T < 2; ++T) { const int i0 = tile * 32 + 8 * g4 + 4 * T; const v4u kk = *(const LAS v4u*)(idxw + i0);
                const int kidx[4] = {(int)kk.x, (int)kk.y, (int)kk.z, (int)kk.w};
#pragma unroll
                for (int e = 0; e < 4; ++e) { const int dist = min(max(t - kidx[e], 0), 128); float s = sacc[T][e] + lutcol[dist * 16];
                    s = (i0 + e < cnt) ? s : -__builtin_inff(); sacc[T][e] = s; pmax = fmaxf(pmax, s); } }
            pmax = fmaxf(pmax, __shfl_xor(pmax, 16)); pmax = fmaxf(pmax, __shfl_xor(pmax, 32));
            const float mn = fmaxf(m_run, pmax), alpha = __builtin_amdgcn_exp2f((m_run - mn) * fa::C2); m_run = mn;
            float ps = 0.f;
#pragma unroll
            for (int T = 0; T < 2; ++T)
#pragma unroll
                for (int e = 0; e < 4; ++e) { const float pv = __builtin_amdgcn_exp2f((sacc[T][e] - mn) * fa::C2); sacc[T][e] = pv; ps += pv; }
            ps += __shfl_xor(ps, 16); ps += __shfl_xor(ps, 32);
            l_run = l_run * alpha + ps;
            if (__any(alpha < 1.f)) {
                float al[4];
#pragma unroll
                for (int e = 0; e < 4; ++e) al[e] = __shfl(alpha, 4 * g4 + e);
#pragma unroll
                for (int ct = 0; ct < 16; ++ct)
#pragma unroll
                    for (int e = 0; e < 4; ++e) o[ct][e] *= al[e];
            }
            fa::u32x4v pw; pw.x = fa::cvtpk(sacc[0][0], sacc[0][1]); pw.y = fa::cvtpk(sacc[0][2], sacc[0][3]); pw.z = fa::cvtpk(sacc[1][0], sacc[1][1]); pw.w = fa::cvtpk(sacc[1][2], sacc[1][3]);
            const bf16x8 pa = *reinterpret_cast<bf16x8*>(&pw);
            const unsigned qq = (lane & 15) >> 2, pp = lane & 3;
#pragma unroll
            for (int ct = 0; ct < 16; ++ct) { fa::s16x4 b0, b1;
                const unsigned a0 = imgb + (ct >> 3) * 8192 + dsa_off_b(8 * g4 + qq, 2 * (ct & 7) + (pp >> 1)) + 8 * (pp & 1);
                const unsigned a1 = imgb + (ct >> 3) * 8192 + dsa_off_b(8 * g4 + 4 + qq, 2 * (ct & 7) + (pp >> 1)) + 8 * (pp & 1);
                asm volatile("ds_read_b64_tr_b16 %0, %2\n\tds_read_b64_tr_b16 %1, %3\n\ts_waitcnt lgkmcnt(0)" : "=&v"(b0), "=&v"(b1) : "v"(a0), "v"(a1) : "memory");
                FA_SBAR();
                o[ct] = __builtin_amdgcn_mfma_f32_16x16x32_bf16(pa, (bf16x8){b0[0], b0[1], b0[2], b0[3], b1[0], b1[1], b1[2], b1[3]}, o[ct], 0, 0, 0); }
            WSYNC();
        }
        { const float il = (l_run > 0.f) ? 1.0f / l_run : 0.f; float ile[4];
#pragma unroll
          for (int e = 0; e < 4; ++e) ile[e] = __shfl(il, 4 * g4 + e);
#pragma unroll
          for (int ct = 0; ct < 16; ++ct)
#pragma unroll
              for (int e = 0; e < 4; ++e) { const float v = o[ct][e] * ile[e]; const float vn = __shfl_xor(v, 1);
                  if ((lane & 1) == 0) *(unsigned*)(OL + (size_t)tok * 4096 + (4 * g4 + e) * 256 + ct * 16 + c16) = fa::cvtpk(v, vn); } }
        WSYNC();
    }
    __syncthreads();
}

struct MoeTiles { int tend[8]; int pstart[8]; int MT; };
__device__ __forceinline__ void moe_tiles(Frame& F, MoeTiles& T) {
    int acc = 0;
#pragma unroll
    for (int e = 0; e < 8; ++e) { const int c = (int)__builtin_amdgcn_readfirstlane(__hip_atomic_load((unsigned*)(F.ctl + CW_MOECNT + 64 * e), __ATOMIC_RELAXED, __HIP_MEMORY_SCOPE_AGENT));
        T.pstart[e] = acc * 256; acc += (c + 255) >> 8; T.tend[e] = acc; }
    T.MT = acc;
}
__device__ __forceinline__ void p15_gather(Frame& F, const Args& A) {
    MoeTiles T; moe_tiles(F, T);
    const int gw = F.vcu * NWAVES + F.wave, NGW = F.G * NWAVES, lane = F.lane;
    const bf16* XB = (const bf16*)(A.ws + WS_XB); bf16* XG = (bf16*)(A.ws + WS_XG);
    const int* re = (const int*)(A.ws + WS_ROUTE); const int* rp = re + 2 * NTOK;
    for (int tok = gw; tok < NTOK; tok += NGW) {
        const v4u* src = (const v4u*)(XB + (size_t)tok * DM) + lane; v4u v[4];
#pragma unroll
        for (int j = 0; j < 4; ++j) v[j] = src[64 * j];
#pragma unroll
        for (int s = 0; s < 2; ++s) { const int e = re[2 * tok + s], p = rp[2 * tok + s]; int ps = 0;
#pragma unroll
            for (int q = 0; q < 8; ++q) ps = (q == e) ? T.pstart[q] : ps;
            v4u* dst = (v4u*)(XG + (size_t)(ps + p) * DM) + lane;
#pragma unroll
            for (int j = 0; j < 4; ++j) dst[64 * j] = v[j]; }
    }
}
__device__ __forceinline__ void p18_final(Frame& F, const Args& A) {
    MoeTiles T; moe_tiles(F, T);
    const int gw = F.vcu * NWAVES + F.wave, NGW = F.G * NWAVES, lane = F.lane;
    const float* XF = (const float*)(A.ws + WS_XF); const float* Y = (const float*)(A.ws + WS_Y);
    const int* re = (const int*)(A.ws + WS_ROUTE); const int* rp = re + 2 * NTOK; const float* rw = (const float*)(rp + 2 * NTOK);
    const float* gam = A.in[25] + DM; const float* bet = A.in[26] + DM;
    for (int tok = gw; tok < NTOK; tok += NGW) {
        int rows[2]; float w[2];
#pragma unroll
        for (int s = 0; s < 2; ++s) { const int e = re[2 * tok + s]; int ps = 0;
#pragma unroll
            for (int q = 0; q < 8; ++q) ps = (q == e) ? T.pstart[q] : ps;
            rows[s] = ps + rp[2 * tok + s]; w[s] = rw[2 * tok + s]; }
        const f32x4* xr = (const f32x4*)(XF + (size_t)tok * DM) + lane; const f32x4* y0 = (const f32x4*)(Y + (size_t)rows[0] * DM) + lane; const f32x4* y1 = (const f32x4*)(Y + (size_t)rows[1] * DM) + lane;
        f32x4 v[8]; float s = 0.f;
#pragma unroll
        for (int j = 0; j < 8; ++j) { v[j] = xr[64 * j] * ALPHA + y0[64 * j] * w[0] + y1[64 * j] * w[1]; s += (v[j][0] + v[j][1]) + (v[j][2] + v[j][3]); }
        const float mean = wave_sum(s) * (1.f / DM); float s2 = 0.f;
#pragma unroll
        for (int j = 0; j < 8; ++j) { v[j] = v[j] - mean; s2 += (v[j][0] * v[j][0] + v[j][1] * v[j][1]) + (v[j][2] * v[j][2] + v[j][3] * v[j][3]); }
        const float rstd = 1.f / sqrtf(wave_sum(s2) * (1.f / DM) + LN_EPS);
#pragma unroll
        for (int j = 0; j < 8; ++j) { const int c = 4 * lane + 256 * j; const f32x4 gg = *(const f32x4*)(gam + c), bb = *(const f32x4*)(bet + c);
            *(f32x4*)(A.out + (size_t)tok * DM + c) = v[j] * rstd * gg + bb; }
    }
}

__global__ void __launch_bounds__(NWAVES * 64, 2) mega_fwd(Args args) {
    extern __shared__ __attribute__((aligned(16))) unsigned char lds[];
    Frame F;
    F.lds = (LAS unsigned char*)lds;
    F.MISC = (volatile LAS unsigned*)(F.lds + MISC_OFF);
    F.tid = threadIdx.x; F.lane = F.tid & 63; F.wave = __builtin_amdgcn_readfirstlane(F.tid >> 6);
    F.G = gridDim.x; { const int bx = blockIdx.x; F.vcu = (F.G % 8 == 0) ? (bx % 8) * (F.G / 8) + bx / 8 : bx; }
    unsigned char* ws = args.ws;
    F.ctl = (gu32*)(ws + WS_CTL);
    for (int u = F.tid; u < (LDS_BYTES - LDSCTL_OFF) / 4; u += NWAVES * 64) ((LAS unsigned*)(F.lds + LDSCTL_OFF))[u] = 0u;
    __syncthreads();
    XcdBarrier bar; bar.bar = (unsigned*)(F.ctl + CW_BAR); bar.x = 0; bar.st = nullptr;
#if !MK_PER_PHASE
    bar = xcd_barrier_post((unsigned*)(F.ctl + CW_BAR), F.MISC + 8);
#define GRID_BAR() xcd_barrier(bar)
#else
#define GRID_BAR() do { } while (0)
#endif
    const int lo = args.ph_lo, hi = args.ph_hi;
#ifndef PH_MASK
#define PH_MASK 0x3fffff
#endif
#define IN(k) (((PH_MASK >> (k)) & 1) && lo <= (k) && (k) < hi)
#define BOTH(k) (IN(k) && IN((k) + 1))
    bf16* XB = (bf16*)(ws + WS_XB); float* XF = (float*)(ws + WS_XF); float* Z = (float*)(ws + WS_Z);

#ifndef PROBE_MASK
#define PROBE_MASK 0
#endif
#define REPS(k) ((((PROBE_MASK) >> (k)) & 1) ? 2 : 1)
    if (IN(0)) for (int rep_ = 0; rep_ < REPS(0); ++rep_) { relaunder(F); p0_prologue(F, args); if (BOTH(0) || rep_ + 1 < REPS(0)) GRID_BAR(); }
    if (IN(1)) for (int rep_ = 0; rep_ < REPS(1); ++rep_) { relaunder(F);
        pg8::Gemm g{XB, (const bf16*)(ws + WS_W_NSA_IN), NTOK, NSA_NPAD, DM}; pg8::StaticOrder S; S.init(NTOK, NSA_NPAD, F.G, (int)blockIdx.x);
        pg8::EpiNsaIn E{(bf16*)(ws + WS_P0), (float*)(ws + WS_GL), 0.08838834764831845f};
        pg8::gemm_phase<pg8::EpiNsaIn, pg8::StaticOrder, true, true>(F.lds + RING_OFF, g, S, E);
        if (BOTH(1) || rep_ + 1 < REPS(1)) GRID_BAR();
    }
    if (IN(2)) for (int rep_ = 0; rep_ < REPS(2); ++rep_) { relaunder(F); p2_compress(F, args); if (BOTH(2) || rep_ + 1 < REPS(2)) GRID_BAR(); }
    if (IN(3)) for (int rep_ = 0; rep_ < REPS(3); ++rep_) { relaunder(F); p3a_nsa_cmp(F, args); if (BOTH(3) || rep_ + 1 < REPS(3)) GRID_BAR(); }
    if (IN(4)) for (int rep_ = 0; rep_ < REPS(4); ++rep_) { relaunder(F); p3b_nsa_sel(F, args); if (BOTH(4) || rep_ + 1 < REPS(4)) GRID_BAR(); }
    if (IN(5)) for (int rep_ = 0; rep_ < REPS(5); ++rep_) { relaunder(F); p3c_nsa_win(F, args); if (BOTH(5) || rep_ + 1 < REPS(5)) GRID_BAR(); }
    if (IN(6)) for (int rep_ = 0; rep_ < REPS(6); ++rep_) { relaunder(F);
        pg8::Gemm g{(const bf16*)(ws + WS_OATT0), (const bf16*)(ws + WS_W_NSA_OUT), NTOK, DM, DM}; pg8::StaticOrder S; S.init(NTOK, DM, F.G, (int)blockIdx.x);
        pg8::EpiResF32 E{args.in[0], Z, ALPHA, DM};
        pg8::gemm_phase<pg8::EpiResF32, pg8::StaticOrder, true, true>(F.lds + RING_OFF, g, S, E);
        if (BOTH(6) || rep_ + 1 < REPS(6)) GRID_BAR();
    }
    if (IN(7)) for (int rep_ = 0; rep_ < REPS(7); ++rep_) { relaunder(F); ln_phase<false>(F, args, Z, args.in[23], args.in[24], XF, XB); if (BOTH(7) || rep_ + 1 < REPS(7)) GRID_BAR(); }
    if (IN(8)) for (int rep_ = 0; rep_ < REPS(8); ++rep_) { relaunder(F);
        pg8::Gemm g{XB, (const bf16*)(ws + WS_W_FFN_GU), NTOK, 2 * DFF, DM}; pg8::StaticOrder S; S.init(NTOK, 2 * DFF, F.G, (int)blockIdx.x);
        pg8::EpiSwiGLU E{(bf16*)(ws + WS_HFF), DFF};
        pg8::gemm_phase<pg8::EpiSwiGLU, pg8::StaticOrder, true, true>(F.lds + RING_OFF, g, S, E);
        if (BOTH(8) || rep_ + 1 < REPS(8)) GRID_BAR();
    }
    if (IN(9)) for (int rep_ = 0; rep_ < REPS(9); ++rep_) { relaunder(F);
        pg8::Gemm g{(const bf16*)(ws + WS_HFF), (const bf16*)(ws + WS_W_FFN_DN), NTOK, DM, DFF}; pg8::StaticOrder S; S.init(NTOK, DM, F.G, (int)blockIdx.x);
        pg8::EpiResF32 E{XF, Z, ALPHA, DM};
        pg8::gemm_phase<pg8::EpiResF32, pg8::StaticOrder, true, true>(F.lds + RING_OFF, g, S, E);
        if (BOTH(9) || rep_ + 1 < REPS(9)) GRID_BAR();
    }
    if (IN(10)) for (int rep_ = 0; rep_ < REPS(10); ++rep_) { relaunder(F); ln_phase<false>(F, args, Z, args.in[25], args.in[26], XF, XB); if (BOTH(10) || rep_ + 1 < REPS(10)) GRID_BAR(); }
    if (IN(11)) for (int rep_ = 0; rep_ < REPS(11); ++rep_) { relaunder(F);
        pg8::Gemm g{XB, (const bf16*)(ws + WS_W_DSA_IN), NTOK, DSA_NPAD, DM}; pg8::StaticOrder S; S.init(NTOK, DSA_NPAD, F.G, (int)blockIdx.x);
        pg8::EpiDsaIn E{(bf16*)(ws + WS_Q), (float*)(ws + WS_CRAW), (bf16*)(ws + WS_QI), (float*)(ws + WS_KIWI), 0.125f};
        pg8::gemm_phase<pg8::EpiDsaIn, pg8::StaticOrder, true, true>(F.lds + RING_OFF, g, S, E);
        if (BOTH(11) || rep_ + 1 < REPS(11)) GRID_BAR();
    }
    if (IN(12)) for (int rep_ = 0; rep_ < REPS(12); ++rep_) { relaunder(F); p10_dsa_prep(F, args); if (BOTH(12) || rep_ + 1 < REPS(12)) GRID_BAR(); }
    if (IN(13)) for (int rep_ = 0; rep_ < REPS(13); ++rep_) { relaunder(F); p13a_dsa_index(F, args); if (BOTH(13) || rep_ + 1 < REPS(13)) GRID_BAR(); }
    if (IN(14)) for (int rep_ = 0; rep_ < REPS(14); ++rep_) { relaunder(F); p13b_dsa_attn(F, args); if (BOTH(14) || rep_ + 1 < REPS(14)) GRID_BAR(); }
    if (IN(15)) for (int rep_ = 0; rep_ < REPS(15); ++rep_) { relaunder(F); p12_dsa_uv(F, args); if (BOTH(15) || rep_ + 1 < REPS(15)) GRID_BAR(); }
    if (IN(16)) for (int rep_ = 0; rep_ < REPS(16); ++rep_) { relaunder(F);
        pg8::Gemm g{(const bf16*)(ws + WS_OATT1), (const bf16*)(ws + WS_W_DSA_OUT), NTOK, DM, DM}; pg8::StaticOrder S; S.init(NTOK, DM, F.G, (int)blockIdx.x);
        pg8::EpiResF32 E{XF, Z, ALPHA, DM};
        pg8::gemm_phase<pg8::EpiResF32, pg8::StaticOrder, true, true>(F.lds + RING_OFF, g, S, E);
        if (BOTH(16) || rep_ + 1 < REPS(16)) GRID_BAR();
    }
    if (IN(17)) for (int rep_ = 0; rep_ < REPS(17); ++rep_) { relaunder(F); ln_route_phase(F, args, Z, args.in[23] + DM, args.in[24] + DM, XF, XB); if (BOTH(17) || rep_ + 1 < REPS(17)) GRID_BAR(); }
    if (IN(18)) for (int rep_ = 0; rep_ < REPS(18); ++rep_) { relaunder(F); p15_gather(F, args); if (BOTH(18) || rep_ + 1 < REPS(18)) GRID_BAR(); }
    if (IN(19)) for (int rep_ = 0; rep_ < REPS(19); ++rep_) { relaunder(F);
        MoeTiles T; moe_tiles(F, T);
        pg8::Gemm g{(const bf16*)(ws + WS_XG), (const bf16*)(ws + WS_W_MOE_GU), T.MT * 256, 2 * DFFE, DM}; pg8::MoeOrder S; S.init(T.MT * 256, 2 * DFFE, F.G, (int)blockIdx.x); S.nexp_rows = 2 * DFFE;
#pragma unroll
        for (int e = 0; e < 8; ++e) S.tend[e] = T.tend[e];
        pg8::EpiSwiGLU E{(bf16*)(ws + WS_HM), DFFE};
        pg8::gemm_phase<pg8::EpiSwiGLU, pg8::MoeOrder, true, true>(F.lds + RING_OFF, g, S, E);
        if (BOTH(19) || rep_ + 1 < REPS(19)) GRID_BAR();
    }
    if (IN(20)) for (int rep_ = 0; rep_ < REPS(20); ++rep_) { relaunder(F);
        MoeTiles T; moe_tiles(F, T);
        pg8::Gemm g{(const bf16*)(ws + WS_HM), (const bf16*)(ws + WS_W_MOE_DN), T.MT * 256, DM, DFFE}; pg8::MoeOrder S; S.init(T.MT * 256, DM, F.G, (int)blockIdx.x); S.nexp_rows = DM;
#pragma unroll
        for (int e = 0; e < 8; ++e) S.tend[e] = T.tend[e];
        pg8::EpiF32 E{(float*)(ws + WS_Y), DM};
        pg8::gemm_phase<pg8::EpiF32, pg8::MoeOrder, true, true>(F.lds + RING_OFF, g, S, E);
        if (BOTH(20) || rep_ + 1 < REPS(20)) GRID_BAR();
    }
    if (IN(21)) for (int rep_ = 0; rep_ < REPS(21); ++rep_) { relaunder(F); p18_final(F, args); }
#undef IN
#undef BOTH
}

extern "C" void kernel_launch(void* const* d_in, const int* in_sizes, int n_in, void* d_out, int out_size, void* d_ws, size_t ws_size, hipStream_t stream) {
    static int grid = 0;
    if (grid == 0) {
        if (n_in != 27 || out_size != NTOK * DM || ws_size < WS_END) { fprintf(stderr, "kernel_launch: unexpected shapes (n_in %d, out %d, ws %zu); nothing launched\n", n_in, out_size, ws_size); grid = -1; return; }
        int dev = 0, cus = 0, per_cu = 0;
        if (hipGetDevice(&dev) != hipSuccess || hipDeviceGetAttribute(&cus, hipDeviceAttributeMultiprocessorCount, dev) != hipSuccess) { grid = -1; return; }
        if (hipFuncSetAttribute((const void*)mega_fwd, hipFuncAttributeMaxDynamicSharedMemorySize, LDS_BYTES) != hipSuccess) { fprintf(stderr, "kernel_launch: hipFuncSetAttribute failed\n"); grid = -1; return; }
        if (hipOccupancyMaxActiveBlocksPerMultiprocessor(&per_cu, (const void*)mega_fwd, NWAVES * 64, LDS_BYTES) != hipSuccess || per_cu < 1) { fprintf(stderr, "kernel_launch: occupancy query says %d\n", per_cu); }
        (void)hipGetLastError();
        grid = cus;
    }
    if (grid < 0) return;
    if (hipMemsetAsync((char*)d_ws + WS_CTL, 0, CTL_ZERO_BYTES, stream) != hipSuccess) return;
    Args a{};
    for (int i = 0; i < 27; ++i) a.in[i] = (const float*)d_in[i];
    a.out = (float*)d_out; a.ws = (unsigned char*)d_ws;
#if MK_PER_PHASE
    for (int p = 0; p < NPHASE; ++p) { a.ph_lo = p; a.ph_hi = p + 1; hipLaunchKernelGGL(mega_fwd, dim3(grid), dim3(NWAVES * 64), LDS_BYTES, stream, a); }
#else
    a.ph_lo = 0; a.ph_hi = NPHASE;
    hipLaunchKernelGGL(mega_fwd, dim3(grid), dim3(NWAVES * 64), LDS_BYTES, stream, a);
#endif
}
```

```cpp
#include <hip/hip_runtime.h>
#include <cstdio>
#include <cstdint>
namespace pg8 {
#define PG8_LAS __attribute__((address_space(3)))
typedef unsigned short bf16_t;
typedef short bf16x8 __attribute__((ext_vector_type(8)));
typedef float f32x4 __attribute__((ext_vector_type(4)));
typedef unsigned u32x4 __attribute__((ext_vector_type(4)));
constexpr int BM = 256, BK = 64, HALF = 128, HTB = HALF * BK * 2  , STAGE_BYTES = 8 * HTB, NXCD = 8, WGM = 8;

__host__ __device__ __forceinline__ int lds_byte(int r, int c) { const int st = (r >> 4) * 2 + (c >> 5), rr = r & 15, cc = c & 31, ob = rr * 64 + cc * 2; return st * 1024 + (ob ^ (((ob >> 9) & 1) << 5)); }
__host__ __device__ __forceinline__ void stage_rc(int b, int& R, int& C) { const int st = b / 1024, sb = b % 1024, swz = sb ^ (((sb >> 9) & 1) << 5); R = (st >> 1) * 16 + swz / 64; C = (st & 1) * 32 + (swz % 64) / 2; }
__host__ __device__ __forceinline__ int perm32(int rho) { const int n = rho >> 4, i = rho & 15; return 8 * (i >> 2) + 4 * n + (i & 3); }

struct Unit { int pm, pn; };
struct Gemm { const bf16_t* A; const bf16_t* Bt; int M, N, K; int esz = 2; int scale = 0x7f7f7f7f; };

struct StaticOrder {
    int nM, nN, nwg, G, c;
    __host__ __device__ void init(int M, int N, int G_, int c_) { nM = M / BM; nN = N / BM; nwg = nM * nN; G = G_; c = c_; }
    __host__ __device__ bool next(int i, Unit& u) const {
        const long L = (long)i * G + c; if (L >= nwg) return false;
        int wgid = (int)L; { const int q = nwg / NXCD, r = nwg % NXCD, xcd = wgid % NXCD, off = wgid / NXCD; wgid = (xcd < r ? xcd * (q + 1) : r * (q + 1) + (xcd - r) * q) + off; }
        const int nig = WGM * nN, gid = wgid / nig, fm = gid * WGM, gsz = (nM - fm) < WGM ? (nM - fm) : WGM;
        u.pm = fm + ((wgid % nig) % gsz); u.pn = (wgid % nig) / gsz; return true;
    }
    __device__ __forceinline__ void a_ready(const Unit&) const {}
    __device__ __forceinline__ void done(const Unit&) const {}
    __device__ __forceinline__ const char* a_ptr(const Gemm& g, const Unit& u) const { return (const char*)g.A + (size_t)u.pm * ((size_t)BM * g.K * g.esz); }
    __device__ __forceinline__ const char* b_ptr(const Gemm& g, const Unit& u) const { return (const char*)g.Bt + (size_t)u.pn * ((size_t)BM * g.K * g.esz); }
};


__device__ __forceinline__ unsigned cvt_pk_bf16(float lo, float hi) { unsigned r; asm volatile("v_cvt_pk_bf16_f32 %0, %1, %2" : "=v"(r) : "v"(lo), "v"(hi)); return r; }
__device__ __forceinline__ u32x4 pack8(const f32x4 v0, const f32x4 v1) { u32x4 w; w.x = cvt_pk_bf16(v0[0], v0[1]); w.y = cvt_pk_bf16(v0[2], v0[3]); w.z = cvt_pk_bf16(v1[0], v1[1]); w.w = cvt_pk_bf16(v1[2], v1[3]); return w; }

struct EpiNsaIn {
    static constexpr bool PERM = true, AFTER_DRAIN = false;
    bf16_t* P0; float* GL; float qscale;
    __device__ __forceinline__ void operator()(const f32x4 (&acc)[2][2][4][2], const Unit& u, int wr, int wc, int fr, int fq) const {
        const int row0 = u.pm * BM + wr * 64 + fr;
        if (u.pn < 20) {
            const float s = u.pn < 8 ? qscale : 1.0f;
            const int col0 = u.pn * BM + wc * 32 + 8 * fq;
#pragma unroll
            for (int ai = 0; ai < 2; ++ai)
#pragma unroll
                for (int m = 0; m < 4; ++m) { bf16_t* rowp = P0 + (size_t)(row0 + ai * HALF + m * 16) * 5120 + col0;
#pragma unroll
                    for (int bj = 0; bj < 2; ++bj) *(u32x4*)(rowp + bj * HALF) = pack8(acc[ai][bj][m][0] * s, acc[ai][bj][m][1] * s); }
        } else {
            const int c = wc * 32 + 8 * fq;
            if (c < 48) {
#pragma unroll
                for (int ai = 0; ai < 2; ++ai)
#pragma unroll
                    for (int m = 0; m < 4; ++m) { float* gp = GL + (size_t)(row0 + ai * HALF + m * 16) * 48 + c;
                        *(f32x4*)gp = acc[ai][0][m][0]; *(f32x4*)(gp + 4) = acc[ai][0][m][1]; }
            }
        }
    }
};
struct EpiDsaIn {
    static constexpr bool PERM = true, AFTER_DRAIN = false;
    bf16_t* Q; float* CRAW; bf16_t* QI; float* KIWI; float qiscale;
    __device__ __forceinline__ void operator()(const f32x4 (&acc)[2][2][4][2], const Unit& u, int wr, int wc, int fr, int fq) const {
        const int row0 = u.pm * BM + wr * 64 + fr; const int c = wc * 32 + 8 * fq;
        if (u.pn < 8) {
#pragma unroll
            for (int ai = 0; ai < 2; ++ai)
#pragma unroll
                for (int m = 0; m < 4; ++m) { bf16_t* rowp = Q + (size_t)(row0 + ai * HALF + m * 16) * 2048 + u.pn * BM + c;
#pragma unroll
                    for (int bj = 0; bj < 2; ++bj) *(u32x4*)(rowp + bj * HALF) = pack8(acc[ai][bj][m][0], acc[ai][bj][m][1]); }
        } else if (u.pn == 8) {
#pragma unroll
            for (int ai = 0; ai < 2; ++ai)
#pragma unroll
                for (int m = 0; m < 4; ++m) { float* rowp = CRAW + (size_t)(row0 + ai * HALF + m * 16) * 256 + c;
#pragma unroll
                    for (int bj = 0; bj < 2; ++bj) { *(f32x4*)(rowp + bj * HALF) = acc[ai][bj][m][0]; *(f32x4*)(rowp + bj * HALF + 4) = acc[ai][bj][m][1]; } }
        } else if (u.pn < 11) {
#pragma unroll
            for (int ai = 0; ai < 2; ++ai)
#pragma unroll
                for (int m = 0; m < 4; ++m) { bf16_t* rowp = QI + (size_t)(row0 + ai * HALF + m * 16) * 512 + (u.pn - 9) * BM + c;
#pragma unroll
                    for (int bj = 0; bj < 2; ++bj) *(u32x4*)(rowp + bj * HALF) = pack8(acc[ai][bj][m][0] * qiscale, acc[ai][bj][m][1] * qiscale); }
        } else {
#pragma unroll
            for (int ai = 0; ai < 2; ++ai)
#pragma unroll
                for (int m = 0; m < 4; ++m) { float* rowp = KIWI + (size_t)(row0 + ai * HALF + m * 16) * 128 + c;
                    *(f32x4*)rowp = acc[ai][0][m][0]; *(f32x4*)(rowp + 4) = acc[ai][0][m][1]; }
        }
    }
};
struct EpiResF32 {
    static constexpr bool PERM = false, AFTER_DRAIN = false;
    const float* R; float* Z; float alpha; int ldc;
    __device__ __forceinline__ void operator()(const f32x4 (&acc)[2][2][4][2], const Unit& u, int wr, int wc, int fr, int fq) const {
        const int row0 = u.pm * BM + wr * 64 + fr, col0 = u.pn * BM + wc * 32 + 4 * fq;
#pragma unroll
        for (int ai = 0; ai < 2; ++ai)
#pragma unroll
            for (int m = 0; m < 4; ++m) { const size_t off = (size_t)(row0 + ai * HALF + m * 16) * ldc + col0;
#pragma unroll
                for (int bj = 0; bj < 2; ++bj)
#pragma unroll
                    for (int n = 0; n < 2; ++n) { const f32x4 r = *(const f32x4*)(R + off + bj * HALF + n * 16); *(f32x4*)(Z + off + bj * HALF + n * 16) = r * alpha + acc[ai][bj][m][n]; } }
    }
};
struct EpiF32 {
    static constexpr bool PERM = false, AFTER_DRAIN = false;
    float* C; int ldc;
    __device__ __forceinline__ void operator()(const f32x4 (&acc)[2][2][4][2], const Unit& u, int wr, int wc, int fr, int fq) const {
        const int row0 = u.pm * BM + wr * 64 + fr, col0 = u.pn * BM + wc * 32 + 4 * fq;
#pragma unroll
        for (int ai = 0; ai < 2; ++ai)
#pragma unroll
            for (int m = 0; m < 4; ++m) { float* rowp = C + (size_t)(row0 + ai * HALF + m * 16) * ldc + col0;
#pragma unroll
                for (int bj = 0; bj < 2; ++bj)
#pragma unroll
                    for (int n = 0; n < 2; ++n) *(f32x4*)(rowp + bj * HALF + n * 16) = acc[ai][bj][m][n]; }
    }
};
__device__ __forceinline__ float silu_mul(float g, float u) { return g * __builtin_amdgcn_rcpf(1.0f + __expf(-g)) * u; }
struct EpiSwiGLU {
    static constexpr bool PERM = true, AFTER_DRAIN = false;
    bf16_t* H; int ldh;
    __device__ __forceinline__ void operator()(const f32x4 (&acc)[2][2][4][2], const Unit& u, int wr, int wc, int fr, int fq) const {
        const int row0 = u.pm * BM + wr * 64 + fr, col0 = u.pn * HALF + wc * 32 + 8 * fq;
#pragma unroll
        for (int ai = 0; ai < 2; ++ai)
#pragma unroll
            for (int m = 0; m < 4; ++m) { bf16_t* rowp = H + (size_t)(row0 + ai * HALF + m * 16) * ldh + col0;
                f32x4 v0, v1;
#pragma unroll
                for (int j = 0; j < 4; ++j) { v0[j] = silu_mul(acc[ai][0][m][0][j], acc[ai][1][m][0][j]); v1[j] = silu_mul(acc[ai][0][m][1][j], acc[ai][1][m][1][j]); }
                *(u32x4*)rowp = pack8(v0, v1); }
    }
};
struct EpiSwiGLU8 {
    static constexpr bool PERM = true, AFTER_DRAIN = false;
    unsigned char* H; int ldh;
    __device__ __forceinline__ void operator()(const f32x4 (&acc)[2][2][4][2], const Unit& u, int wr, int wc, int fr, int fq) const {
        const int row0 = u.pm * BM + wr * 64 + fr, col0 = u.pn * HALF + wc * 32 + 8 * fq;
#pragma unroll
        for (int ai = 0; ai < 2; ++ai)
#pragma unroll
            for (int m = 0; m < 4; ++m) { unsigned char* rowp = H + (size_t)(row0 + ai * HALF + m * 16) * ldh + col0;
                float v[8];
#pragma unroll
                for (int j = 0; j < 4; ++j) { v[j] = silu_mul(acc[ai][0][m][0][j], acc[ai][1][m][0][j]); v[4 + j] = silu_mul(acc[ai][0][m][1][j], acc[ai][1][m][1][j]); }
                int w0 = __builtin_amdgcn_cvt_pk_fp8_f32(v[0], v[1], 0, false); w0 = __builtin_amdgcn_cvt_pk_fp8_f32(v[2], v[3], w0, true);
                int w1 = __builtin_amdgcn_cvt_pk_fp8_f32(v[4], v[5], 0, false); w1 = __builtin_amdgcn_cvt_pk_fp8_f32(v[6], v[7], w1, true);
                uint2 o; o.x = (unsigned)w0; o.y = (unsigned)w1; *(uint2*)rowp = o; }
    }
};
struct MoeOrder : StaticOrder {
    int tend[8]; int nexp_rows;
    __device__ __forceinline__ int expert(int pm) const { int e = 0;
#pragma unroll
        for (int i = 0; i < 7; ++i) e += (pm >= tend[i]) ? 1 : 0; return e; }
    __device__ __forceinline__ const char* b_ptr(const Gemm& g, const Unit& u) const { return (const char*)g.Bt + ((size_t)expert(u.pm) * nexp_rows + (size_t)u.pn * BM) * ((size_t)g.K * g.esz); }
};
typedef int i32x8 __attribute__((ext_vector_type(8)));
typedef int i32x4 __attribute__((ext_vector_type(4)));
__device__ __forceinline__ i32x8 cat8(bf16x8 lo, bf16x8 hi) { const i32x4 a = *reinterpret_cast<const i32x4*>(&lo), b = *reinterpret_cast<const i32x4*>(&hi); return __builtin_shufflevector(a, b, 0, 1, 2, 3, 4, 5, 6, 7); }
template <class Epi, class Sched, bool ALIGN_EPI = false, bool SP2 = false, bool FP8 = false>
__device__ __forceinline__ void gemm_phase(PG8_LAS unsigned char* lds, const Gemm g, const Sched& S, const Epi& E) {
    int tid = threadIdx.x; asm volatile("" : "+v"(tid));
    const int wid = __builtin_amdgcn_readfirstlane(tid >> 6), lane = tid & 63, wr = wid >> 2, wc = wid & 3, fr = lane & 15, fq = lane >> 4;
    const int K = g.K, nt = K / (FP8 ? 2 * BK : BK);
    unsigned voffA[2], voffB[2];
#pragma unroll
    for (int i = 0; i < 2; ++i) { int R, C; stage_rc(tid * 16 + i * 8192, R, C); const int Rb = Epi::PERM ? ((R & ~31) + perm32(R & 31)) : R;
        voffA[i] = FP8 ? (unsigned)(R * K + C * 2) : (unsigned)(R * K + C) * 2u; voffB[i] = FP8 ? (unsigned)(Rb * K + C * 2) : (unsigned)(Rb * K + C) * 2u; }
    const size_t kstep = (size_t)(BK * 2);
    const size_t hstep = (size_t)HALF * K * (FP8 ? 1 : 2);
    const size_t tstep = 2 * hstep;
    const unsigned ldsw = (unsigned)wid * 1024u;
    const int aoff = lds_byte(wr * 64 + fr, fq * 8), boff = lds_byte(wc * 32 + fr, fq * 8);
#define PG8_SA(b, h) (((b) * 2 + (h)) * HTB)
#define PG8_SB(b, h) ((4 + (b) * 2 + (h)) * HTB)
#define PG8_STAGE(bufoff, gbase, voff) do { _Pragma("unroll") for (int _i = 0; _i < 2; ++_i) \
        __builtin_amdgcn_global_load_lds((const unsigned*)((const char*)(gbase) + (voff)[_i]), (PG8_LAS unsigned*)(lds + (bufoff) + ldsw + _i * 8192), 16, 0, 0); } while (0)
#define PG8_LDA(dst, b, h) do { _Pragma("unroll") for (int m = 0; m < 4; ++m) { if constexpr (FP8) { const i32x4 lo_ = *(const PG8_LAS i32x4*)(lds + PG8_SA(b, h) + aoff + m * 2048), hi_ = *(const PG8_LAS i32x4*)(lds + PG8_SA(b, h) + aoff + m * 2048 + 1024); dst##8[m] = __builtin_shufflevector(lo_, hi_, 0, 1, 2, 3, 4, 5, 6, 7); } else { _Pragma("unroll") for (int k = 0; k < 2; ++k) dst[m][k] = *(const PG8_LAS bf16x8*)(lds + PG8_SA(b, h) + aoff + m * 2048 + k * 1024); } } } while (0)
#define PG8_LDB(dst, b, h) do { _Pragma("unroll") for (int n = 0; n < 2; ++n) { if constexpr (FP8) { const i32x4 lo_ = *(const PG8_LAS i32x4*)(lds + PG8_SB(b, h) + boff + n * 2048), hi_ = *(const PG8_LAS i32x4*)(lds + PG8_SB(b, h) + boff + n * 2048 + 1024); dst##8[n] = __builtin_shufflevector(lo_, hi_, 0, 1, 2, 3, 4, 5, 6, 7); } else { _Pragma("unroll") for (int k = 0; k < 2; ++k) dst[n][k] = *(const PG8_LAS bf16x8*)(lds + PG8_SB(b, h) + boff + n * 2048 + k * 1024); } } } while (0)
#define PG8_MMA(ai, bj, At, Bt) do { __builtin_amdgcn_s_setprio(1); _Pragma("unroll") for (int m = 0; m < 4; ++m) _Pragma("unroll") for (int n = 0; n < 2; ++n) { \
        if constexpr (FP8) { asm volatile("v_mfma_scale_f32_16x16x128_f8f6f4 %0, %1, %2, %0, %3, %4 op_sel_hi:[0,0,0]" : "+v"(acc[ai][bj][m][n]) : "v"(Bt##8[n]), "v"(At##8[m]), "v"(sclA), "v"(sclB)); } \
        else { _Pragma("unroll") for (int k = 0; k < 2; ++k) acc[ai][bj][m][n] = __builtin_amdgcn_mfma_f32_16x16x32_bf16(Bt[n][k], At[m][k], acc[ai][bj][m][n], 0, 0, 0); } } __builtin_amdgcn_s_setprio(0); } while (0)
#define PG8_WAIT_V(n) asm volatile("s_waitcnt vmcnt(" #n ")" ::: "memory")
#define PG8_WAIT_L(n) asm volatile("s_waitcnt lgkmcnt(" #n ")" ::: "memory")
#define PG8_BAR __builtin_amdgcn_s_barrier()
#define PG8_SCHED __builtin_amdgcn_sched_barrier(0)
    Unit cur, nxt; int ui = 0;
    if (!S.next(0, cur)) return;
    f32x4 acc[2][2][4][2];
#pragma unroll
    for (int a = 0; a < 2; ++a)
#pragma unroll
        for (int b = 0; b < 2; ++b)
#pragma unroll
            for (int m = 0; m < 4; ++m)
#pragma unroll
                for (int n = 0; n < 2; ++n) acc[a][b][m][n] = (f32x4){0.f, 0.f, 0.f, 0.f};
    bf16x8 At[4][2], B0[2][2], B1[2][2]; i32x8 At8[4], B08[2], B18[2]; const int sclA = g.scale, sclB = 0x7f7f7f7f;
    const char* cA = S.a_ptr(g, cur); const char* cB = S.b_ptr(g, cur);
    S.a_ready(cur);
    if constexpr (SP2) {
        PG8_STAGE(PG8_SB(0, 0), cB, voffB); PG8_STAGE(PG8_SB(0, 1), cB + hstep, voffB); PG8_STAGE(PG8_SA(0, 0), cA, voffA); PG8_STAGE(PG8_SA(0, 1), cA + hstep, voffA);
        if (wr == 1) PG8_BAR;
        PG8_WAIT_V(2); PG8_BAR;
        PG8_STAGE(PG8_SB(1, 0), cB + kstep, voffB); PG8_STAGE(PG8_SA(1, 0), cA + kstep, voffA); PG8_STAGE(PG8_SB(1, 1), cB + hstep + kstep, voffB);
        PG8_WAIT_V(6); PG8_BAR;
    } else {
        PG8_STAGE(PG8_SB(0, 0), cB, voffB); PG8_STAGE(PG8_SA(0, 0), cA, voffA); PG8_STAGE(PG8_SB(0, 1), cB + hstep, voffB); PG8_STAGE(PG8_SA(0, 1), cA + hstep, voffA);
        if (wr == 1) PG8_BAR;
        PG8_WAIT_V(4); PG8_BAR;
        PG8_STAGE(PG8_SB(1, 0), cB + kstep, voffB); PG8_STAGE(PG8_SA(1, 0), cA + kstep, voffA); PG8_STAGE(PG8_SB(1, 1), cB + hstep + kstep, voffB);
        PG8_WAIT_V(6); PG8_BAR;
    }
    for (;;) {
        const bool has_next = S.next(ui + 1, nxt);
        const char* nA = has_next ? S.a_ptr(g, nxt) : cA; const char* nB = has_next ? S.b_ptr(g, nxt) : cB;
        for (int t = 0; t < nt; t += 2) {
            const bool last = (t == nt - 2);
            const char* a1 = cA + (size_t)(t + 1) * kstep;
            const char* a2 = last ? nA : cA + (size_t)(t + 2) * kstep; const char* b2 = last ? nB : cB + (size_t)(t + 2) * kstep;
            const char* a3 = a2 + kstep; const char* b3 = b2 + kstep;
            if (last && has_next) S.a_ready(nxt);
            if constexpr (SP2) {
            PG8_LDB(B0, 0, 0); PG8_LDB(B1, 0, 1); PG8_SCHED; PG8_LDA(At, 0, 0); PG8_STAGE(PG8_SA(1, 1), a1 + hstep, voffA);
            PG8_WAIT_V(8); PG8_WAIT_L(0); PG8_BAR; PG8_MMA(0, 0, At, B0); PG8_MMA(0, 1, At, B1); PG8_BAR; PG8_SCHED;
            PG8_LDA(At, 0, 1); PG8_STAGE(PG8_SB(0, 0), b2, voffB); PG8_STAGE(PG8_SB(0, 1), b2 + hstep, voffB); PG8_STAGE(PG8_SA(0, 0), a2, voffA);
            PG8_WAIT_V(8); PG8_WAIT_L(0); PG8_BAR; PG8_MMA(1, 0, At, B0); PG8_MMA(1, 1, At, B1); PG8_BAR; PG8_SCHED;
            PG8_LDB(B0, 1, 0); PG8_LDB(B1, 1, 1); PG8_SCHED; PG8_LDA(At, 1, 0); PG8_STAGE(PG8_SA(0, 1), a2 + hstep, voffA);
            PG8_WAIT_V(8); PG8_WAIT_L(0); PG8_BAR; PG8_MMA(0, 0, At, B0); PG8_MMA(0, 1, At, B1); PG8_BAR; PG8_SCHED;
            PG8_LDA(At, 1, 1); PG8_STAGE(PG8_SB(1, 0), b3, voffB); PG8_STAGE(PG8_SB(1, 1), b3 + hstep, voffB); PG8_STAGE(PG8_SA(1, 0), a3, voffA);
            PG8_WAIT_V(8); PG8_WAIT_L(0); PG8_BAR; PG8_MMA(1, 0, At, B0); PG8_MMA(1, 1, At, B1); PG8_BAR; PG8_SCHED;
            } else {
            PG8_LDB(B0, 0, 0); PG8_SCHED; PG8_LDA(At, 0, 0); PG8_STAGE(PG8_SA(1, 1), a1 + hstep, voffA);
            PG8_WAIT_L(8); PG8_BAR; PG8_WAIT_L(0); PG8_MMA(0, 0, At, B0); PG8_BAR; PG8_SCHED;
            PG8_LDB(B1, 0, 1); PG8_STAGE(PG8_SB(0, 0), b2, voffB);
            PG8_BAR; PG8_WAIT_L(0); PG8_MMA(0, 1, At, B1); PG8_BAR;
            PG8_LDA(At, 0, 1); PG8_STAGE(PG8_SA(0, 0), a2, voffA);
            PG8_BAR; PG8_WAIT_L(0); PG8_MMA(1, 0, At, B0); PG8_BAR; PG8_SCHED;
            PG8_STAGE(PG8_SB(0, 1), b2 + hstep, voffB);
            PG8_WAIT_V(6); PG8_BAR; PG8_MMA(1, 1, At, B1); PG8_BAR;
            PG8_LDB(B0, 1, 0); PG8_SCHED; PG8_LDA(At, 1, 0); PG8_STAGE(PG8_SA(0, 1), a2 + hstep, voffA);
            PG8_WAIT_L(8); PG8_BAR; PG8_WAIT_L(0); PG8_MMA(0, 0, At, B0); PG8_BAR; PG8_SCHED;
            PG8_LDB(B1, 1, 1); PG8_STAGE(PG8_SB(1, 0), b3, voffB);
            PG8_BAR; PG8_WAIT_L(0); PG8_MMA(0, 1, At, B1); PG8_BAR;
            PG8_LDA(At, 1, 1); PG8_STAGE(PG8_SA(1, 0), a3, voffA);
            PG8_BAR; PG8_WAIT_L(0); PG8_MMA(1, 0, At, B0); PG8_BAR; PG8_SCHED;
            PG8_STAGE(PG8_SB(1, 1), b3 + hstep, voffB);
            PG8_WAIT_V(6); PG8_BAR; PG8_MMA(1, 1, At, B1); PG8_BAR;
            }
        }
        if constexpr (FP8) asm volatile("s_nop 15\n\ts_nop 15" ::: "memory");
        if constexpr (ALIGN_EPI) { if (wr == 0) PG8_BAR; }
        if constexpr (!Epi::AFTER_DRAIN) { E(acc, cur, wr, wc, fr, fq); S.done(cur); }
        if (!has_next) break;
#pragma unroll
        for (int a = 0; a < 2; ++a)
#pragma unroll
            for (int b = 0; b < 2; ++b)
#pragma unroll
                for (int m = 0; m < 4; ++m)
#pragma unroll
                    for (int n = 0; n < 2; ++n) acc[a][b][m][n] = (f32x4){0.f, 0.f, 0.f, 0.f};
        cur = nxt; cA = nA; cB = nB; ++ui;
        if constexpr (ALIGN_EPI) { if (wr == 1) PG8_BAR; }
    }
    PG8_WAIT_V(0);
    if constexpr (!ALIGN_EPI) { if (wr == 0) PG8_BAR; }
    PG8_BAR;
    if constexpr (Epi::AFTER_DRAIN) { E.fused(acc, cur, wr, wc, fr, fq, lds, wid, lane); S.done(cur); }
#undef PG8_SA
#undef PG8_SB
#undef PG8_STAGE
#undef PG8_LDA
#undef PG8_LDB
#undef PG8_MMA
#undef PG8_WAIT_V
#undef PG8_WAIT_L
#undef PG8_BAR
#undef PG8_SCHED
}
}
#define GAS __attribute__((address_space(1)))
#define LAS __attribute__((address_space(3)))
typedef unsigned short bf16;
typedef unsigned v4u __attribute__((ext_vector_type(4)));
typedef float f32x4 __attribute__((ext_vector_type(4)));
typedef short bf16x8 __attribute__((ext_vector_type(8)));
typedef GAS unsigned gu32;
typedef GAS unsigned long long gu64;
#define RLX_AGENT __ATOMIC_RELAXED, __HIP_MEMORY_SCOPE_AGENT
#define LDS_WAIT() asm volatile("s_waitcnt lgkmcnt(0)" ::: "memory")
#define VM_WAIT() asm volatile("s_waitcnt vmcnt(0)" ::: "memory")
__device__ __forceinline__ unsigned long long rt() { return __builtin_amdgcn_s_memrealtime(); }
__device__ __forceinline__ unsigned f2bf(float f) { unsigned u = __builtin_bit_cast(unsigned, f); return (u + 0x7fffu + ((u >> 16) & 1u)) >> 16; }
__device__ __forceinline__ unsigned pk2(float lo, float hi) { return f2bf(lo) | (f2bf(hi) << 16); }

#define XB_TMO      128
#define XB_XCNT(j)  (256  + 64 * (j))
#define XB_XSUB(j)  (1280 + 64 * (j))
#define XB_XGEN(j)  (2304 + 64 * (j))
#define XB_TOP      3328
#define XB_TOPGEN   3392
#define XCD_BAR_WORDS 3456
#define XB_SPIN_CAP (1u << 18)

__device__ __forceinline__ unsigned xb_ld(unsigned* p)              { return __hip_atomic_load(p, __ATOMIC_RELAXED, __HIP_MEMORY_SCOPE_AGENT); }
__device__ __forceinline__ unsigned xb_add(unsigned* p, unsigned v) { return __hip_atomic_fetch_add(p, v, __ATOMIC_RELAXED, __HIP_MEMORY_SCOPE_AGENT); }
__device__ __forceinline__ unsigned xb_xcc_id() { return (unsigned)__builtin_amdgcn_s_getreg((3 << 11) | 20) & 0xFu; }
#define XB_SPIN(cond, bar) do { unsigned _sp = 0; while (cond) { __builtin_amdgcn_s_sleep(1); \
    if ((++_sp & 255u) == 0u) { if (xb_ld(&(bar)[XB_TMO])) break; if (_sp > XB_SPIN_CAP) { atomicAdd(&(bar)[XB_TMO], 1u); break; } } } } while (0)

struct XcdBarrier {
    unsigned* bar; unsigned x;
    volatile LAS unsigned* st;
};

__device__ __forceinline__ XcdBarrier xcd_barrier_post(unsigned* bar, volatile LAS unsigned* st) {
    XcdBarrier b; b.bar = bar; b.x = xb_xcc_id(); b.st = st;
    if (threadIdx.x == 0) (void)xb_add(&bar[XB_XCNT(b.x)], 1u);
    return b;
}
__device__ __forceinline__ void xcd_barrier_complete(unsigned* bar, unsigned x, unsigned& nloc, unsigned& nx) {
    const unsigned G = gridDim.x * gridDim.y * gridDim.z;
    unsigned sum, cnt, mine, sp = 0u;
    for (;;) {
        sum = 0u; cnt = 0u; mine = 0u;
#pragma unroll
        for (unsigned j = 0; j < 16; ++j) { const unsigned c = xb_ld(&bar[XB_XCNT(j)]); sum += c; cnt += (c > 0u) ? 1u : 0u; mine = (j == x) ? c : mine; }
        if (sum == G) break;
        __builtin_amdgcn_s_sleep(1);
        if ((++sp & 255u) == 0u) { if (xb_ld(&bar[XB_TMO])) break; if (sp > XB_SPIN_CAP) { atomicAdd(&bar[XB_TMO], 1u); break; } }
    }
    nloc = mine > 0u ? mine : 1u; nx = cnt > 0u ? cnt : 1u;
}

__device__ __forceinline__ void xcd_barrier(const XcdBarrier& b) {
    asm volatile("s_waitcnt vmcnt(0)" ::: "memory");
    __syncthreads();
    if (threadIdx.x == 0) {
        unsigned* bar = b.bar;
        __builtin_amdgcn_s_waitcnt(0);
        unsigned nloc = b.st[0], nx = b.st[1];
        if (nloc == 0u) { xcd_barrier_complete(bar, b.x, nloc, nx); b.st[0] = nloc; b.st[1] = nx; }
        const unsigned old = xb_add(&bar[XB_XSUB(b.x)], 1u);
        const unsigned gen = old / nloc;
        if (old + 1u == (gen + 1u) * nloc) {
            __builtin_amdgcn_fence(__ATOMIC_RELEASE, "agent");
            asm volatile("s_waitcnt vmcnt(0)" ::: "memory");
            const unsigned og = xb_add(&bar[XB_TOP], 1u);
            const unsigned tg = og / nx;
            if (og + 1u == (tg + 1u) * nx) xb_add(&bar[XB_TOPGEN], 1u);
            else XB_SPIN(xb_ld(&bar[XB_TOPGEN]) == tg, bar);
            __builtin_amdgcn_fence(__ATOMIC_ACQUIRE, "agent");
            xb_add(&bar[XB_XGEN(b.x)], 1u);
            asm volatile("s_waitcnt vmcnt(0)" ::: "memory");
        } else {
            XB_SPIN(xb_ld(&bar[XB_XGEN(b.x)]) == gen, bar);
            __builtin_amdgcn_fence(__ATOMIC_ACQUIRE, "agent");
            asm volatile("s_waitcnt vmcnt(0)" ::: "memory");
        }
    }
    __syncthreads();
}

constexpr int NWAVES = 8;
#ifndef MK_PER_PHASE
#define MK_PER_PHASE 0
#endif
constexpr int NPHASE = 22;

constexpr int BATCH = 2, SEQ = 8192, DM = 2048, NTOK = BATCH * SEQ, NH = 16, DH = 128;
constexpr int NSA_N = 5168, NSA_NPAD = 5376, P0LD = 5120;
constexpr int NCMP = 511, NSELB = 128;
constexpr int COL_KC = 2048, COL_VC = 2560, COL_KS = 3072, COL_VS = 3584, COL_KW = 4096, COL_VW = 4608;
constexpr int DSA_N = 2888, DSA_NPAD = 3072, KVR = 256, TOPK = 256;
constexpr int DFF = 5632, NEXP = 8, DFFE = 7168, MOE_ROWS = 34816;
constexpr float ALPHA = 1.41421356237309515f, LN_EPS = 1e-5f, RMS_EPS = 1e-6f;

constexpr size_t MiB = (size_t)1 << 20;
constexpr size_t WS_CTL = 0, CTL_ZERO_BYTES = 1 * MiB;
constexpr size_t WS_W_NSA_IN = 2 * MiB, WS_W_NSA_OUT = 23 * MiB, WS_W_FFN_GU = 31 * MiB, WS_W_FFN_DN = 75 * MiB, WS_W_DSA_IN = 97 * MiB, WS_W_DSA_OUT = 109 * MiB;
constexpr size_t WS_W_CMPK = 117 * MiB, WS_W_CMPV = 118 * MiB, WS_W_UK = 119 * MiB, WS_W_UV = 120 * MiB, WS_CBIAS = 121 * MiB;
constexpr size_t WS_KCMP = 122 * MiB, WS_VCMP = 124 * MiB, WS_GL = 126 * MiB, WS_ROUTE = 129 * MiB;
constexpr size_t WS_KIB = 179 * MiB;
constexpr size_t WS_SELM = 178 * MiB;
constexpr size_t WS_CRAW = 130 * MiB, WS_KIWI = 146 * MiB, WS_IDX = 154 * MiB, WS_CN = 170 * MiB;
constexpr size_t WS_W_MOE_GU = 192 * MiB, WS_W_MOE_DN = 640 * MiB;
constexpr size_t WS_XB = 864 * MiB, WS_XF = 928 * MiB, WS_Z = 1056 * MiB;
constexpr size_t WS_P0 = 1184 * MiB, WS_OATT0 = 1344 * MiB, WS_HFF = 1408 * MiB;
constexpr size_t WS_Q = 1184 * MiB, WS_QI = 1248 * MiB, WS_QLAT = 1264 * MiB, WS_OLAT = 1392 * MiB, WS_OATT1 = 1520 * MiB;
constexpr size_t WS_XG = 1056 * MiB, WS_HM = 1192 * MiB, WS_Y = 192 * MiB;
constexpr size_t WS_END = 1668 * MiB;
static_assert(WS_HM + (size_t)MOE_ROWS * DFFE * 2 <= WS_END, "hm fits");
static_assert(WS_XG + (size_t)MOE_ROWS * DM * 2 <= WS_HM, "xg fits");
static_assert(WS_Y + (size_t)MOE_ROWS * DM * 4 <= WS_W_MOE_DN, "y overlays the dead gate/up weights only");
static_assert(WS_HFF + (size_t)NTOK * DFF * 2 <= WS_END, "hff fits");
constexpr int CW_TMO = 0, CW_CODE = 1;
constexpr int CW_BAR = 4096;
constexpr int CW_MOECNT = 16384;

constexpr int RING_OFF = 0, RING_BYTES = 131072;
constexpr int LDSCTL_OFF = RING_BYTES, MISC_OFF = LDSCTL_OFF + 320;
constexpr int LDS_BYTES = 163840;
constexpr int DSA_SCR = 133120;

struct Frame {
    LAS unsigned char* lds;
    volatile LAS unsigned* MISC;
    gu32* ctl;
    int tid, lane, wave, vcu, G;
};

__device__ __forceinline__ void relaunder(Frame& F) { int t = F.tid; asm volatile("" : "+v"(t)); F.tid = t; F.lane = t & 63; }
__device__ __forceinline__ float bf2f(unsigned short h) { return __uint_as_float(((unsigned)h) << 16); }
__device__ __forceinline__ float bflo(unsigned w) { return __uint_as_float(w << 16); }
__device__ __forceinline__ float bfhi(unsigned w) { return __uint_as_float(w & 0xffff0000u); }
__device__ __forceinline__ float wave_sum(float v) {
#pragma unroll
    for (int o = 1; o < 64; o <<= 1) v += __shfl_xor(v, o);
    return v;
}
__device__ __forceinline__ float wave_max(float v) {
#pragma unroll
    for (int o = 1; o < 64; o <<= 1) v = fmaxf(v, __shfl_xor(v, o));
    return v;
}
#define WSYNC() do { __builtin_amdgcn_wave_barrier(); asm volatile("s_waitcnt lgkmcnt(0)" ::: "memory"); __builtin_amdgcn_wave_barrier(); } while (0)

__device__ __forceinline__ int rel_bucket(int n) {
    if (n < 16) return n;
    if (n >= 113) return 31;
    int b = 16;
    b += (n >= 19); b += (n >= 21); b += (n >= 24); b += (n >= 27); b += (n >= 31); b += (n >= 35); b += (n >= 40); b += (n >= 46);
    b += (n >= 52); b += (n >= 59); b += (n >= 67); b += (n >= 77); b += (n >= 87); b += (n >= 99);
    return b;
}

struct Args { const float* in[27]; float* out; unsigned char* ws; int ph_lo, ph_hi; };
struct TrItem { const float* W; bf16* WT; int N, K, k0, n0, drow; float f8scale; };
__device__ __forceinline__ void tr_set(TrItem& T, const float* W, int K, int N, int Npad, bf16* WT, int mode, int item, float f8scale = 0.f) {
    T.f8scale = f8scale;
    const int nblk = Npad / 32, kb = item / nblk, nb = item - kb * nblk, n0 = 32 * nb;
    T.W = W; T.WT = WT; T.N = N; T.K = K; T.k0 = 64 * kb; T.n0 = n0; T.drow = (mode == 0) ? n0 : ((n0 >> 7) * 256 + (mode - 1) * 128 + (n0 & 127));
}
constexpr int TR_I_NSA_IN = (DM / 64) * (NSA_NPAD / 32), TR_I_SQ = (DM / 64) * (DM / 32), TR_I_FFN = (DM / 64) * (DFF / 32), TR_I_FFD = (DFF / 64) * (DM / 32), TR_I_DSA_IN = (DM / 64) * (DSA_NPAD / 32);
constexpr int TR_I_CMP = (4096 / 64) * (128 / 32), TR_I_UK1 = (128 / 64) * (256 / 32), TR_I_UV1 = (256 / 64) * (128 / 32);
constexpr int TR_I_MG1 = (DM / 64) * (DFFE / 32), TR_I_MD1 = (DFFE / 64) * (DM / 32);
constexpr int TR_NITEMS = TR_I_NSA_IN + 2 * TR_I_SQ + 2 * TR_I_FFN + TR_I_FFD + TR_I_DSA_IN + 2 * TR_I_CMP + 16 * TR_I_UK1 + 16 * TR_I_UV1 + 16 * TR_I_MG1 + 8 * TR_I_MD1;
__device__ __forceinline__ void tr_decode(const Args& A, unsigned char* ws, int it, TrItem& T) {
    int r = it;
    if (r < TR_I_NSA_IN) { tr_set(T, A.in[2], DM, NSA_N, NSA_NPAD, (bf16*)(ws + WS_W_NSA_IN), 0, r); return; } r -= TR_I_NSA_IN;
    if (r < TR_I_SQ) { tr_set(T, A.in[9], DM, DM, DM, (bf16*)(ws + WS_W_NSA_OUT), 0, r); return; } r -= TR_I_SQ;
    if (r < TR_I_SQ) { tr_set(T, A.in[14], DM, DM, DM, (bf16*)(ws + WS_W_DSA_OUT), 0, r); return; } r -= TR_I_SQ;
    if (r < TR_I_FFN) { tr_set(T, A.in[15], DM, DFF, DFF, (bf16*)(ws + WS_W_FFN_GU), 1, r); return; } r -= TR_I_FFN;
    if (r < TR_I_FFN) { tr_set(T, A.in[16], DM, DFF, DFF, (bf16*)(ws + WS_W_FFN_GU), 2, r); return; } r -= TR_I_FFN;
    if (r < TR_I_FFD) { tr_set(T, A.in[17], DFF, DM, DM, (bf16*)(ws + WS_W_FFN_DN), 0, r); return; } r -= TR_I_FFD;
    if (r < TR_I_DSA_IN) { tr_set(T, A.in[10], DM, DSA_N, DSA_NPAD, (bf16*)(ws + WS_W_DSA_IN), 0, r); return; } r -= TR_I_DSA_IN;
    if (r < TR_I_CMP) { tr_set(T, A.in[4], 4096, 128, 128, (bf16*)(ws + WS_W_CMPK), 0, r); return; } r -= TR_I_CMP;
    if (r < TR_I_CMP) { tr_set(T, A.in[7], 4096, 128, 128, (bf16*)(ws + WS_W_CMPV), 0, r); return; } r -= TR_I_CMP;
    if (r < 16 * TR_I_UK1) { const int h = r / TR_I_UK1; tr_set(T, A.in[12] + (size_t)h * 128 * 256, 128, 256, 256, (bf16*)(ws + WS_W_UK) + (size_t)h * 256 * 128, 0, r - h * TR_I_UK1); return; } r -= 16 * TR_I_UK1;
    if (r < 16 * TR_I_UV1) { const int h = r / TR_I_UV1; tr_set(T, A.in[13] + (size_t)h * 256 * 128, 256, 128, 128, (bf16*)(ws + WS_W_UV) + (size_t)h * 128 * 256, 0, r - h * TR_I_UV1); return; } r -= 16 * TR_I_UV1;
    if (r < 8 * TR_I_MG1) { const int e = r / TR_I_MG1; tr_set(T, A.in[20] + (size_t)e * DM * DFFE, DM, DFFE, DFFE, (bf16*)(ws + WS_W_MOE_GU + (size_t)e * 2 * DFFE * DM), 1, r - e * TR_I_MG1, 64.f); return; } r -= 8 * TR_I_MG1;
    if (r < 8 * TR_I_MG1) { const int e = r / TR_I_MG1; tr_set(T, A.in[21] + (size_t)e * DM * DFFE, DM, DFFE, DFFE, (bf16*)(ws + WS_W_MOE_GU + (size_t)e * 2 * DFFE * DM), 2, r - e * TR_I_MG1, 64.f); return; } r -= 8 * TR_I_MG1;
    { const int e = r / TR_I_MD1; tr_set(T, A.in[22] + (size_t)e * DFFE * DM, DFFE, DM, DM, (bf16*)(ws + WS_W_MOE_DN + (size_t)e * DM * DFFE), 0, r - e * TR_I_MD1, 256.f); }
}
__device__ __forceinline__ void tr_load(const TrItem& T, f32x4 (&v)[8], int lane) {
    const int kr = lane >> 3, c4 = lane & 7, n = T.n0 + 4 * c4;
#pragma unroll
    for (int i = 0; i < 8; ++i) v[i] = (n < T.N) ? *(const f32x4*)(T.W + (size_t)(T.k0 + 8 * i + kr) * T.N + n) : (f32x4){0.f, 0.f, 0.f, 0.f};
}
__device__ __forceinline__ void tr_store(const TrItem& T, const f32x4 (&v)[8], LAS float* scr, int lane) {
    { const int kr = lane >> 3, c4 = lane & 7;
#pragma unroll
      for (int i = 0; i < 8; ++i) { LAS float* d = scr + (8 * i + kr) * 33 + 4 * c4; d[0] = v[i][0]; d[1] = v[i][1]; d[2] = v[i][2]; d[3] = v[i][3]; } }
    LDS_WAIT(); asm volatile("" ::: "memory");
    const int c = lane & 7;
#pragma unroll
    for (int j = 0; j < 4; ++j) { const int n = (lane >> 3) + 8 * j; const LAS float* s = scr + (8 * c) * 33 + n;
        v4u o; o.x = pg8::cvt_pk_bf16(s[0 * 33], s[1 * 33]); o.y = pg8::cvt_pk_bf16(s[2 * 33], s[3 * 33]); o.z = pg8::cvt_pk_bf16(s[4 * 33], s[5 * 33]); o.w = pg8::cvt_pk_bf16(s[6 * 33], s[7 * 33]);
        *(v4u*)(T.WT + (size_t)(T.drow + n) * T.K + T.k0 + 8 * c) = o; }
    LDS_WAIT(); asm volatile("" ::: "memory");
}

__device__ __forceinline__ void tr_store8(const TrItem& T, const f32x4 (&v)[8], LAS float* scr, int lane) {
    { const int kr = lane >> 3, c4 = lane & 7;
#pragma unroll
      for (int i = 0; i < 8; ++i) { LAS float* d = scr + (8 * i + kr) * 33 + 4 * c4; d[0] = v[i][0]; d[1] = v[i][1]; d[2] = v[i][2]; d[3] = v[i][3]; } }
    LDS_WAIT(); asm volatile("" ::: "memory");
    const int c = lane & 3, nr = lane >> 2; const float sc = T.f8scale;
#pragma unroll
    for (int j = 0; j < 2; ++j) { const int n = nr + 16 * j; const LAS float* s = scr + (16 * c) * 33 + n; int w[4];
#pragma unroll
        for (int q = 0; q < 4; ++q) { w[q] = __builtin_amdgcn_cvt_pk_fp8_f32(s[(4 * q) * 33] * sc, s[(4 * q + 1) * 33] * sc, 0, false); w[q] = __builtin_amdgcn_cvt_pk_fp8_f32(s[(4 * q + 2) * 33] * sc, s[(4 * q + 3) * 33] * sc, w[q], true); }
        v4u o; o.x = (unsigned)w[0]; o.y = (unsigned)w[1]; o.z = (unsigned)w[2]; o.w = (unsigned)w[3];
        *(v4u*)((unsigned char*)T.WT + (size_t)(T.drow + n) * T.K + T.k0 + 16 * c) = o; }
    LDS_WAIT(); asm volatile("" ::: "memory");
}
__device__ __forceinline__ void p0_prologue(Frame& F, const Args& A) {
    LAS float* scr = (LAS float*)(F.lds + RING_OFF + F.wave * 16384);
    unsigned char* ws = A.ws;
    const int gw = F.vcu * NWAVES + F.wave, NGW = F.G * NWAVES, lane = F.lane;
    { TrItem cur, nxt; f32x4 va[8], vb[8]; int it = gw;
      if (it < TR_NITEMS) { tr_decode(A, ws, it, cur); tr_load(cur, va, lane); }
      while (it < TR_NITEMS) {
          int itn = it + NGW; if (itn < TR_NITEMS) { tr_decode(A, ws, itn, nxt); tr_load(nxt, vb, lane); }
          if (cur.f8scale != 0.f) tr_store8(cur, va, scr, lane); else tr_store(cur, va, scr, lane);
          it = itn; if (it >= TR_NITEMS) break;
          itn = it + NGW; if (itn < TR_NITEMS) { tr_decode(A, ws, itn, cur); tr_load(cur, va, lane); }
          if (nxt.f8scale != 0.f) tr_store8(nxt, vb, scr, lane); else tr_store(nxt, vb, scr, lane);
          it = itn;
      } }
    { const float* x = A.in[0]; bf16* xb = (bf16*)(ws + WS_XB); const size_t n8 = (size_t)NTOK * DM / 8;
      for (size_t i = (size_t)F.vcu * 512 + F.tid; i < n8; i += (size_t)F.G * 512) { const f32x4 a = *(const f32x4*)(x + i * 8), b = *(const f32x4*)(x + i * 8 + 4);
          v4u o; o.x = pk2(a[0], a[1]); o.y = pk2(a[2], a[3]); o.z = pk2(b[0], b[1]); o.w = pk2(b[2], b[3]); *(v4u*)(xb + i * 8) = o; } }
    for (int it = gw; it < 64; it += NGW) { const int kv = it >> 5, ch = it & 31; const float* pe = A.in[kv ? 6 : 3]; const float* w1 = A.in[kv ? 7 : 4];
        float s0 = 0.f, s1 = 0.f;
        for (int k = ch * 128; k < ch * 128 + 128; ++k) { const float p = pe[k]; s0 += p * w1[(size_t)k * 128 + lane]; s1 += p * w1[(size_t)k * 128 + 64 + lane]; }
        float* cb = (float*)(ws + WS_CBIAS) + (size_t)(kv * 32 + ch) * 128; cb[lane] = s0; cb[64 + lane] = s1; }
}

typedef short s8v __attribute__((ext_vector_type(8)));
__device__ __forceinline__ s8v ld_frag(const bf16* p) { return *(const s8v*)p; }

__device__ __forceinline__ float gelu_tanh(float x) { const float u = 0.7978845608028654f * (x + 0.044715f * x * x * x); return 0.5f * x * (1.0f + tanhf(u)); }
__device__ __forceinline__ void p2_compress(Frame& F, const Args& A) {
    unsigned char* ws = A.ws; const int lane = F.lane, wid = F.wave, tid = F.tid;
    const bf16* P0 = (const bf16*)(ws + WS_P0);
    LAS float* part = (LAS float*)(F.lds + RING_OFF);
    LAS float* hid = (LAS float*)(F.lds + DSA_SCR);
    LAS float* cbl = hid + 4096;
    if (tid < 256) { const float* cbp = (const float*)(ws + WS_CBIAS) + (size_t)(tid >> 7) * 32 * 128 + (tid & 127); float cb = 0.f; for (int ch = 0; ch < 32; ++ch) cb += cbp[ch * 128]; cbl[tid] = cb; }
    if (F.vcu < 16 && wid == 0) { bf16* zp = (bf16*)(ws + ((F.vcu & 1) ? WS_VCMP : WS_KCMP)) + ((size_t)(F.vcu >> 1) * 512 + 511) * 128; zp[lane] = 0; zp[64 + lane] = 0; }
    __syncthreads();
    const int r16 = lane & 15, kq = lane >> 4;
    for (int it = F.vcu; it < 256; it += F.G) {
        const int kv = it >> 7, tile = it & 127;
        const bf16* W1T = (const bf16*)(ws + (kv ? WS_W_CMPV : WS_W_CMPK));
        const float* w2 = A.in[kv ? 8 : 5];
        bf16* outp = (bf16*)(ws + (kv ? WS_VCMP : WS_KCMP));
        const int colbase = kv ? COL_VC : COL_KC;
        f32x4 acc[2][8];
#pragma unroll
        for (int m = 0; m < 2; ++m)
#pragma unroll
            for (int n = 0; n < 8; ++n) acc[m][n] = (f32x4){0.f, 0.f, 0.f, 0.f};
        const bf16* arow[2];
#pragma unroll
        for (int m = 0; m < 2; ++m) { int R = tile * 32 + m * 16 + r16; if (R > 4087) R = 4087; const int g = R & 3, bn = R >> 2, b = bn / NCMP, n = bn - b * NCMP;
            arow[m] = P0 + (size_t)(b * SEQ + 16 * n) * P0LD + colbase + g * 128 + kq * 8; }
#pragma unroll 2
        for (int kk = 0; kk < 16; ++kk) {
            const int ks = wid * 16 + kk, l = ks >> 2, d0 = (ks & 3) * 32;
            s8v af[2], bfr[8];
#pragma unroll
            for (int m = 0; m < 2; ++m) af[m] = ld_frag(arow[m] + (size_t)l * P0LD + d0);
#pragma unroll
            for (int n = 0; n < 8; ++n) bfr[n] = ld_frag(W1T + (size_t)(n * 16 + r16) * 4096 + ks * 32 + kq * 8);
#pragma unroll
            for (int m = 0; m < 2; ++m)
#pragma unroll
                for (int n = 0; n < 8; ++n) acc[m][n] = __builtin_amdgcn_mfma_f32_16x16x32_bf16(af[m], bfr[n], acc[m][n], 0, 0, 0);
        }
#pragma unroll
        for (int m = 0; m < 2; ++m)
#pragma unroll
            for (int n = 0; n < 8; ++n)
#pragma unroll
                for (int j = 0; j < 4; ++j) part[wid * 4096 + (m * 16 + kq * 4 + j) * 128 + n * 16 + r16] = acc[m][n][j];
        __syncthreads();
        { const int row = tid >> 4, e0 = (tid & 15) * 8; f32x4 s0 = (f32x4){0.f, 0.f, 0.f, 0.f}, s1 = s0;
#pragma unroll
          for (int w = 0; w < 8; ++w) { s0 += *(const LAS f32x4*)(part + w * 4096 + row * 128 + e0); s1 += *(const LAS f32x4*)(part + w * 4096 + row * 128 + e0 + 4); }
#pragma unroll
          for (int j = 0; j < 4; ++j) { hid[row * 128 + e0 + j] = gelu_tanh(s0[j] + cbl[kv * 128 + e0 + j]); hid[row * 128 + e0 + 4 + j] = gelu_tanh(s1[j] + cbl[kv * 128 + e0 + 4 + j]); } }
        __syncthreads();
        { const int rr = tid >> 4, f0 = (tid & 15) * 8, R = tile * 32 + rr; f32x4 o0 = (f32x4){0.f, 0.f, 0.f, 0.f}, o1 = o0;
#pragma unroll 4
          for (int e = 0; e < 128; ++e) { const float hv = hid[rr * 128 + e]; o0 += *(const f32x4*)(w2 + e * 128 + f0) * hv; o1 += *(const f32x4*)(w2 + e * 128 + f0 + 4) * hv; }
          if (R <= 4087) { const int g = R & 3, bn = R >> 2, b = bn / NCMP, n = bn - b * NCMP;
              v4u o; o.x = pk2(o0[0], o0[1]); o.y = pk2(o0[2], o0[3]); o.z = pk2(o1[0], o1[1]); o.w = pk2(o1[2], o1[3]);
              *(v4u*)(outp + ((size_t)(b * 4 + g) * 512 + n) * 128 + f0) = o; } }
        __syncthreads();
    }
}

namespace fa {
typedef float f32x16 __attribute__((ext_vector_type(16)));
typedef short s16x4 __attribute__((ext_vector_type(4)));
typedef unsigned u32x4v __attribute__((ext_vector_type(4)));
constexpr int SHM_K = 16384, SHM_V = 16384;
constexpr int OFF_V = 0, OFF_K = 2 * SHM_V, OFF_WS = 2 * SHM_V + 2 * SHM_K, OFF_LUT = OFF_WS + 8 * 256, OFF_MASK = OFF_LUT + 144 * 16 * 4, OFF_TAB = OFF_MASK + 1024;
constexpr int TABLD = 130;
constexpr float C2 = 1.4426950408889634f, THR = 8.f;
#define FA_KSWZ(row, colB) ((row) * 256 + ((colB) ^ (((row) & 7) << 4)))
#define FA_SBAR() __builtin_amdgcn_sched_barrier(0)
__device__ __forceinline__ int v_st(int k, int c) { const int kk = (k & ~0xC) | ((k & 4) << 1) | ((k & 8) >> 1); return ((kk >> 3) * 4 + (c >> 5)) * 512 + ((kk & 7) * 32 + (c & 31)) * 2; }
__device__ __forceinline__ int v_rd_base(int lane) { return ((lane & 3) << 3) | (((lane >> 2) & 3) << 6) | (((lane >> 4) & 1) << 5) | (((lane >> 5) & 1) << 8); }
constexpr int v_rd_off(int d0, int ks, int half) { return d0 * 512 + ks * 4096 + half * 2048; }
__device__ __forceinline__ int crow(int r, int hi) { return (r & 3) + 8 * (r >> 2) + 4 * hi; }
__device__ __forceinline__ unsigned cvtpk(float lo, float hi) { unsigned r; asm volatile("v_cvt_pk_bf16_f32 %0, %1, %2" : "=v"(r) : "v"(lo), "v"(hi)); return r; }

__device__ __forceinline__ void qkt(f32x16& p0, f32x16& p1, const LAS char* Kb, int r32, int hi, const bf16x8 (&qr)[8], float init) {
#pragma unroll
    for (int r = 0; r < 16; ++r) { p0[r] = init; p1[r] = init; }
    const LAS char* kb[4];
#pragma unroll
    for (int dd = 0; dd < 4; ++dd) kb[dd] = Kb + FA_KSWZ(r32, (dd * 16 + hi * 8) * 2);
#pragma unroll
    for (int d0 = 0; d0 < 8; ++d0) { const LAS char* a = kb[d0 & 3] + (d0 >> 2) * 128;
        const bf16x8 b0 = *(const LAS bf16x8*)a;
        const bf16x8 b1 = *(const LAS bf16x8*)(a + 32 * 256);
        p0 = __builtin_amdgcn_mfma_f32_32x32x16_bf16(b0, qr[d0], p0, 0, 0, 0);
        p1 = __builtin_amdgcn_mfma_f32_32x32x16_bf16(b1, qr[d0], p1, 0, 0, 0); }
}
__device__ __forceinline__ void pv_tile(f32x16 (&o)[4], int vb0, bf16x8 pa0, bf16x8 pa1, bf16x8 pa2, bf16x8 pa3) {
#define FA_TRRD(dst, off) asm volatile("ds_read_b64_tr_b16 %0, %1 offset:%2" : "=&v"(dst) : "v"(vb0), "i"(off) : "memory")
#define FA_PV_D0(d0) do { s16x4 l0, l1, l2, l3, h0, h1, h2, h3; constexpr int b_ = v_rd_off(d0, 0, 0); \
        FA_TRRD(l0, b_); FA_TRRD(h0, b_ + 2048); FA_TRRD(l1, b_ + 4096); FA_TRRD(h1, b_ + 6144); FA_TRRD(l2, b_ + 8192); FA_TRRD(h2, b_ + 10240); FA_TRRD(l3, b_ + 12288); FA_TRRD(h3, b_ + 14336); \
        asm volatile("s_waitcnt lgkmcnt(0)" ::: "memory"); FA_SBAR(); \
        o[d0] = __builtin_amdgcn_mfma_f32_32x32x16_bf16(pa0, (bf16x8){l0[0], l0[1], l0[2], l0[3], h0[0], h0[1], h0[2], h0[3]}, o[d0], 0, 0, 0); \
        o[d0] = __builtin_amdgcn_mfma_f32_32x32x16_bf16(pa1, (bf16x8){l1[0], l1[1], l1[2], l1[3], h1[0], h1[1], h1[2], h1[3]}, o[d0], 0, 0, 0); \
        o[d0] = __builtin_amdgcn_mfma_f32_32x32x16_bf16(pa2, (bf16x8){l2[0], l2[1], l2[2], l2[3], h2[0], h2[1], h2[2], h2[3]}, o[d0], 0, 0, 0); \
        o[d0] = __builtin_amdgcn_mfma_f32_32x32x16_bf16(pa3, (bf16x8){l3[0], l3[1], l3[2], l3[3], h3[0], h3[1], h3[2], h3[3]}, o[d0], 0, 0, 0); } while (0)
    FA_PV_D0(0); FA_PV_D0(1); FA_PV_D0(2); FA_PV_D0(3);
#undef FA_PV_D0
#undef FA_TRRD
}
__device__ __forceinline__ void partialSM(f32x16& p0, f32x16& p1, float& m_reg, float& alpha) {
    float pmax = p0[0];
#pragma unroll
    for (int r = 1; r < 16; ++r) pmax = fmaxf(pmax, p0[r]);
#pragma unroll
    for (int r = 0; r < 16; ++r) pmax = fmaxf(pmax, p1[r]);
    { auto rr = __builtin_amdgcn_permlane32_swap(__float_as_uint(pmax), __float_as_uint(pmax), false, false); pmax = fmaxf(__uint_as_float(rr[0]), __uint_as_float(rr[1])); }
    float mn;
    if (__all(pmax - m_reg <= THR)) { mn = m_reg; alpha = 1.f; }
    else { mn = fmaxf(m_reg, pmax); alpha = __builtin_amdgcn_exp2f((m_reg - mn) * C2); m_reg = mn; }
    const float mnL = -mn * C2;
#pragma unroll
    for (int r = 0; r < 16; ++r) { p0[r] = __builtin_amdgcn_exp2f(fmaf(p0[r], C2, mnL)); p1[r] = __builtin_amdgcn_exp2f(fmaf(p1[r], C2, mnL)); }
}
__device__ __forceinline__ float finishSM(const f32x16& p0, const f32x16& p1, bf16x8& pa0, bf16x8& pa1, bf16x8& pa2, bf16x8& pa3) {
    float ps = 0.f;
#pragma unroll
    for (int r = 0; r < 16; ++r) ps += p0[r];
#pragma unroll
    for (int r = 0; r < 16; ++r) ps += p1[r];
    { auto rr = __builtin_amdgcn_permlane32_swap(__float_as_uint(ps), __float_as_uint(ps), false, false); ps = __uint_as_float(rr[0]) + __uint_as_float(rr[1]); }
#define FA_PK4(P, B_, OUT) do { unsigned a0 = cvtpk(P[B_ + 0], P[B_ + 1]), a1 = cvtpk(P[B_ + 2], P[B_ + 3]); unsigned b0 = cvtpk(P[B_ + 4], P[B_ + 5]), b1 = cvtpk(P[B_ + 6], P[B_ + 7]); \
        auto r0 = __builtin_amdgcn_permlane32_swap(a0, b0, false, false); auto r1 = __builtin_amdgcn_permlane32_swap(a1, b1, false, false); \
        u32x4v w = {r0[0], r1[0], r0[1], r1[1]}; OUT = *reinterpret_cast<bf16x8*>(&w); } while (0)
    FA_PK4(p0, 0, pa0); FA_PK4(p0, 8, pa1); FA_PK4(p1, 0, pa2); FA_PK4(p1, 8, pa3);
#undef FA_PK4
    return ps;
}
__device__ __forceinline__ void rescale(f32x16 (&o)[4], float alpha, LAS float* al_l, int r32, int hi) {
    if (__any(alpha < 1.f)) { if (hi == 0) al_l[r32] = alpha; asm volatile("s_waitcnt lgkmcnt(0)" ::: "memory");
#pragma unroll
        for (int r = 0; r < 16; ++r) { const float a = al_l[crow(r, hi)];
#pragma unroll
            for (int d = 0; d < 4; ++d) o[d][r] *= a; }
        asm volatile("s_waitcnt lgkmcnt(0)" ::: "memory"); }
}
__device__ __forceinline__ void mask_tile(f32x16& p0, f32x16& p1, int dq, unsigned W) {
    const float NEG = -__builtin_inff();
#pragma unroll
    for (int r = 0; r < 16; ++r) { const int c = (r & 3) + 8 * (r >> 2);
        if ((unsigned)(dq - c) >= W) p0[r] = NEG;
        if ((unsigned)(dq - c - 32) >= W) p1[r] = NEG; }
}
__device__ __forceinline__ void mask_all(f32x16& p0, f32x16& p1, bool keep) {
    const float NEG = -__builtin_inff();
#pragma unroll
    for (int r = 0; r < 16; ++r) { p0[r] = keep ? p0[r] : NEG; p1[r] = keep ? p1[r] : NEG; }
}
__device__ __forceinline__ void bias_near(f32x16& p0, f32x16& p1, int dq, int step, const LAS float* lutcol) {
#pragma unroll
    for (int r = 0; r < 16; ++r) { const int c = (r & 3) + 8 * (r >> 2);
        const int d0 = min(max((dq - c) * step, 0), 128), d1 = min(max((dq - c - 32) * step, 0), 128);
        p0[r] += lutcol[d0 * 16]; p1[r] += lutcol[d1 * 16]; }
}
struct Stage { bf16x8 k0, k1, v0, v1; };
__device__ __forceinline__ void stage_load(Stage& S, const bf16* Kp, const bf16* Vp, size_t ld, int row0, int maxrow, int sr, int sc) {
    const int ra = min(row0 + sr, maxrow), rb = min(row0 + 32 + sr, maxrow);
    S.k0 = *(const bf16x8*)(Kp + (size_t)ra * ld + sc); S.k1 = *(const bf16x8*)(Kp + (size_t)rb * ld + sc);
    S.v0 = *(const bf16x8*)(Vp + (size_t)ra * ld + sc); S.v1 = *(const bf16x8*)(Vp + (size_t)rb * ld + sc);
}
__device__ __forceinline__ void stage_write(const Stage& S, LAS char* Kb, LAS char* Vb, int kws, int vst0, int vst1) {
    *(LAS bf16x8*)(Kb + kws) = S.k0; *(LAS bf16x8*)(Kb + kws + 32 * 256) = S.k1;
    *(LAS bf16x8*)(Vb + vst0) = S.v0; *(LAS bf16x8*)(Vb + vst1) = S.v1;
}
}

struct NsaLane { int wid, lane, r32, hi, ql, j, sr, sc, kws, vst0, vst1, vrd; };
__device__ __forceinline__ NsaLane nsa_lane(const Frame& F) {
    NsaLane L; L.wid = F.wave; L.lane = F.lane; L.r32 = F.lane & 31; L.hi = F.lane >> 5; L.ql = L.r32 >> 2; L.j = L.r32 & 3;
    L.sr = F.tid >> 4; L.sc = (F.tid & 15) * 8; L.kws = FA_KSWZ(L.sr, L.sc * 2); L.vst0 = fa::v_st(L.sr, L.sc); L.vst1 = fa::v_st(32 + L.sr, L.sc); L.vrd = fa::v_rd_base(F.lane);
    return L;
}
__device__ __forceinline__ void nsa_load_q(bf16x8 (&qr)[8], const bf16* P0, int tok0, int g, const NsaLane& L) {
    const bf16* qp = P0 + (size_t)(tok0 + L.wid * 8 + L.ql) * P0LD + (g * 4 + L.j) * 128 + L.hi * 8;
#pragma unroll
    for (int d0 = 0; d0 < 8; ++d0) qr[d0] = *(const bf16x8*)(qp + d0 * 16);
}
__device__ __forceinline__ void nsa_lut(Frame& F, const Args& A) {
    LAS float* lut = (LAS float*)(F.lds + RING_OFF + fa::OFF_LUT);
    for (int i = F.tid; i < 144 * 16; i += 512) { const int n = i >> 4, h = i & 15; lut[i] = A.in[1][rel_bucket(n) * 16 + h]; }
    __syncthreads();
}
template <int MODE>
__device__ __forceinline__ void nsa_store(const fa::f32x16 (&o)[4], float l_reg, LAS float* li_l, const float* GL, float* OACC, bf16* OATT, int tok0, int g, int br, const NsaLane& L) {
    if (L.hi == 0) li_l[L.r32] = l_reg;
    asm volatile("s_waitcnt lgkmcnt(0)" ::: "memory");
#pragma unroll
    for (int r = 0; r < 16; ++r) { const int row = fa::crow(r, L.hi), tok = tok0 + L.wid * 8 + (row >> 2), h = g * 4 + (row & 3);
        const float l = li_l[row]; const float gl = GL[(size_t)tok * 48 + h * 3 + br];
        const float sc = (l > 0.f) ? __builtin_amdgcn_rcpf(l) / (1.0f + __expf(-gl)) : 0.f;
        float* ap = OACC + (size_t)tok * DM + h * 128 + L.r32;
#pragma unroll
        for (int d0 = 0; d0 < 4; ++d0) { float v = o[d0][r] * sc;
            if (MODE == 0) ap[d0 * 32] = v;
            else if (MODE == 1) ap[d0 * 32] += v;
            else { v += ap[d0 * 32]; const float vn = __shfl_xor(v, 1); if ((L.r32 & 1) == 0) *(unsigned*)(OATT + (size_t)tok * DM + h * 128 + d0 * 32 + L.r32) = fa::cvtpk(v, vn); } } }
    asm volatile("s_waitcnt lgkmcnt(0)" ::: "memory");
}

__device__ __forceinline__ void p3a_nsa_cmp(Frame& F, const Args& A) {
    unsigned char* ws = A.ws; const NsaLane L = nsa_lane(F);
    const bf16* P0 = (const bf16*)(ws + WS_P0); const bf16* KCB = (const bf16*)(ws + WS_KCMP); const bf16* VCB = (const bf16*)(ws + WS_VCMP);
    const float* GL = (const float*)(ws + WS_GL); float* OACC = (float*)(ws + WS_Z); unsigned* SELM = (unsigned*)(ws + WS_SELM);
    nsa_lut(F, A);
    LAS char* lds = (LAS char*)(F.lds + RING_OFF);
    LAS float* wsf = (LAS float*)(lds + fa::OFF_WS) + L.wid * 64; LAS float* li_l = wsf; LAS float* al_l = wsf + 32;
    const LAS float* lut = (const LAS float*)(lds + fa::OFF_LUT);
    LAS float* tab = (LAS float*)(lds + fa::OFF_TAB);
    for (int ui = 0; ui < 2 * ((512 - F.vcu + F.G - 1) / F.G); ++ui) {
        const int p = F.vcu + (ui >> 1) * F.G, bg = p >> 6, y = p & 63, qb = (ui & 1) ? 127 - y : y, b = bg >> 2, g = bg & 3;
        const int tok0 = b * SEQ + qb * 64;
        bf16x8 qr[8]; nsa_load_q(qr, P0, tok0, g, L);
        const int trow = qb * 64 + L.wid * 8 + L.ql;
        const int h = g * 4 + L.j; const LAS float* lutcol = lut + h; const float bias_far = lutcol[128 * 16];
        const int nmaxrow = (trow >= 31) ? (trow - 31) >> 4 : -1;
        const int NT = (4 * qb + 3 + 63) >> 6;
        const bf16* Kg = KCB + (size_t)(b * 4 + g) * 512 * 128; const bf16* Vg = VCB + (size_t)(b * 4 + g) * 512 * 128;
        for (int i = F.tid; i < 64 * fa::TABLD; i += 512) tab[i] = 0.f;
        float m_reg = -1e30f, l_reg = 0.f;
        fa::Stage S;
        const int rem16 = (trow >= 31) ? ((trow - 31) & 15) : 0;
        fa::stage_load(S, Kg, Vg, 128, 0, 511, L.sr, L.sc); asm volatile("s_waitcnt vmcnt(0)" ::: "memory");
        fa::stage_write(S, lds + fa::OFF_K, lds + fa::OFF_V, L.kws, L.vst0, L.vst1);
        __syncthreads();
#pragma unroll 1
        for (int t = 0; t < NT; ++t) {
            const int buf = t & 1;
            if (t + 1 < NT) fa::stage_load(S, Kg, Vg, 128, (t + 1) * 64, 511, L.sr, L.sc);
            fa::f32x16 p0, p1;
            const bool farT = (qb * 64 + L.wid * 8) - 31 - 16 * (t * 64 + 63) >= 128;
            fa::qkt(p0, p1, lds + fa::OFF_K + buf * fa::SHM_K, L.r32, L.hi, qr, farT ? bias_far : 0.f);
            const int dq = nmaxrow - t * 64 - 4 * L.hi;
            if (!farT) fa::bias_near(p0, p1, dq, 16, lutcol + rem16 * 16);
            fa::mask_tile(p0, p1, dq, 0x40000000u);
            float alpha; fa::partialSM(p0, p1, m_reg, alpha);
            float ps = 0.f;
#pragma unroll
            for (int r = 0; r < 16; ++r) ps += p0[r] + p1[r];
            { auto rr = __builtin_amdgcn_permlane32_swap(__float_as_uint(ps), __float_as_uint(ps), false, false); ps = __uint_as_float(rr[0]) + __uint_as_float(rr[1]); }
            l_reg = l_reg * alpha + ps;
            if (t + 1 < NT) { asm volatile("s_waitcnt vmcnt(0)" ::: "memory"); fa::stage_write(S, lds + fa::OFF_K + (buf ^ 1) * fa::SHM_K, lds + fa::OFF_V + (buf ^ 1) * fa::SHM_V, L.kws, L.vst0, L.vst1); }
            __syncthreads();
        }
        fa::f32x16 o[4];
#pragma unroll
        for (int d = 0; d < 4; ++d)
#pragma unroll
            for (int r = 0; r < 16; ++r) o[d][r] = 0.f;
        fa::stage_load(S, Kg, Vg, 128, 0, 511, L.sr, L.sc); asm volatile("s_waitcnt vmcnt(0)" ::: "memory");
        fa::stage_write(S, lds + fa::OFF_K, lds + fa::OFF_V, L.kws, L.vst0, L.vst1);
        __syncthreads();
        const float inv_l = (l_reg > 0.f) ? 1.0f / l_reg : 0.f; const float mnL = -m_reg * fa::C2;
#pragma unroll 1
        for (int t = 0; t < NT; ++t) {
            const int buf = t & 1;
            if (t + 1 < NT) fa::stage_load(S, Kg, Vg, 128, (t + 1) * 64, 511, L.sr, L.sc);
            fa::f32x16 p0, p1;
            const bool farT = (qb * 64 + L.wid * 8) - 31 - 16 * (t * 64 + 63) >= 128;
            fa::qkt(p0, p1, lds + fa::OFF_K + buf * fa::SHM_K, L.r32, L.hi, qr, farT ? bias_far : 0.f);
            const int dq = nmaxrow - t * 64 - 4 * L.hi;
            if (!farT) fa::bias_near(p0, p1, dq, 16, lutcol + rem16 * 16);
            fa::mask_tile(p0, p1, dq, 0x40000000u);
#pragma unroll
            for (int r = 0; r < 16; ++r) { p0[r] = __builtin_amdgcn_exp2f(fmaf(p0[r], fa::C2, mnL)) * inv_l; p1[r] = __builtin_amdgcn_exp2f(fmaf(p1[r], fa::C2, mnL)) * inv_l; }
            LAS float* tb = tab + (L.wid * 8 + L.ql) * fa::TABLD + t * 16 + L.hi;
#pragma unroll
            for (int half = 0; half < 2; ++half)
#pragma unroll
                for (int gq = 0; gq < 4; ++gq) { const fa::f32x16& pp = half ? p1 : p0;
                    float s4 = pp[4 * gq] + pp[4 * gq + 1] + pp[4 * gq + 2] + 0.5f * pp[4 * gq + 3], cr = 0.5f * pp[4 * gq + 3];
                    s4 += __shfl_xor(s4, 1); s4 += __shfl_xor(s4, 2); cr += __shfl_xor(cr, 1); cr += __shfl_xor(cr, 2);
                    if (L.j == 0) { __hip_atomic_fetch_add(tb + half * 8 + 2 * gq, s4, __ATOMIC_RELAXED, __HIP_MEMORY_SCOPE_WORKGROUP); __hip_atomic_fetch_add(tb + half * 8 + 2 * gq + 1, cr, __ATOMIC_RELAXED, __HIP_MEMORY_SCOPE_WORKGROUP); } }
            bf16x8 a0, a1, a2, a3; (void)fa::finishSM(p0, p1, a0, a1, a2, a3);
            fa::pv_tile(o, (int)(uintptr_t)(lds + fa::OFF_V + buf * fa::SHM_V) + L.vrd, a0, a1, a2, a3);
            if (t + 1 < NT) { asm volatile("s_waitcnt vmcnt(0)" ::: "memory"); fa::stage_write(S, lds + fa::OFF_K + (buf ^ 1) * fa::SHM_K, lds + fa::OFF_V + (buf ^ 1) * fa::SHM_V, L.kws, L.vst0, L.vst1); }
            __syncthreads();
        }
        nsa_store<0>(o, (l_reg > 0.f) ? 1.0f : 0.f, li_l, GL, OACC, nullptr, tok0, g, 0, L);
        __syncthreads();
        for (int qi = 0; qi < 8; ++qi) { const int ql = L.wid * 8 + qi;
            bool s0 = false, s1 = false;
            if (qb < 16) { s0 = (L.lane <= qb); }
            else {
                float v0 = (L.lane >= 1 && L.lane <= qb - 2) ? tab[ql * fa::TABLD + L.lane] : -1.0f, v1 = (L.lane + 64 <= qb - 2) ? tab[ql * fa::TABLD + L.lane + 64] : -1.0f;
                s0 = (L.lane == 0) || (L.lane == qb) || (L.lane == qb - 1); s1 = (L.lane + 64 == qb) || (L.lane + 64 == qb - 1);
                if (s0) v0 = -3e38f; if (s1) v1 = -3e38f;
#pragma unroll 1
                for (int k = 0; k < 13; ++k) { float bv = v0; int bi = L.lane; if (v1 > v0) { bv = v1; bi = L.lane + 64; }
#pragma unroll
                    for (int of = 1; of < 64; of <<= 1) { const float ov = __shfl_xor(bv, of); const int oi = __shfl_xor(bi, of); if (ov > bv || (ov == bv && oi < bi)) { bv = ov; bi = oi; } }
                    if (bi == L.lane) { v0 = -3e38f; s0 = true; } if (bi == L.lane + 64) { v1 = -3e38f; s1 = true; } }
            }
            const unsigned long long b0 = __ballot(s0), b1 = __ballot(s1);
            if (L.lane == 0) { uint4 mv; mv.x = (unsigned)b0; mv.y = (unsigned)(b0 >> 32); mv.z = (unsigned)b1; mv.w = (unsigned)(b1 >> 32); *(uint4*)(SELM + ((size_t)(tok0 + ql) * 4 + g) * 4) = mv; }
        }
        __syncthreads();
    }
}
__device__ __forceinline__ void p3b_nsa_sel(Frame& F, const Args& A) {
    unsigned char* ws = A.ws; const NsaLane L = nsa_lane(F);
    const bf16* P0 = (const bf16*)(ws + WS_P0); const float* GL = (const float*)(ws + WS_GL); float* OACC = (float*)(ws + WS_Z); const unsigned* SELM = (const unsigned*)(ws + WS_SELM);
    nsa_lut(F, A);
    LAS char* lds = (LAS char*)(F.lds + RING_OFF);
    LAS float* wsf = (LAS float*)(lds + fa::OFF_WS) + L.wid * 64; LAS float* li_l = wsf; LAS float* al_l = wsf + 32;
    const LAS float* lut = (const LAS float*)(lds + fa::OFF_LUT);
    for (int ui = 0; ui < 2 * ((512 - F.vcu + F.G - 1) / F.G); ++ui) {
        const int p = F.vcu + (ui >> 1) * F.G, bg = p >> 6, y = p & 63, qb = (ui & 1) ? 127 - y : y, b = bg >> 2, g = bg & 3;
        const int tok0 = b * SEQ + qb * 64;
        bf16x8 qr[8]; nsa_load_q(qr, P0, tok0, g, L);
        const int trow = qb * 64 + L.wid * 8 + L.ql;
        const int h = g * 4 + L.j; const LAS float* lutcol = lut + h; const float bias_far = lutcol[128 * 16];
        const uint4 mv = *(const uint4*)(SELM + ((size_t)(tok0 + L.wid * 8 + L.ql) * 4 + g) * 4);
        const bf16* Kg = P0 + (size_t)b * SEQ * P0LD + COL_KS + g * 128; const bf16* Vg = P0 + (size_t)b * SEQ * P0LD + COL_VS + g * 128;
        const int NT = qb + 1;
        float m_reg = -1e30f, l_reg = 0.f; fa::f32x16 o[4];
#pragma unroll
        for (int d = 0; d < 4; ++d)
#pragma unroll
            for (int r = 0; r < 16; ++r) o[d][r] = 0.f;
        fa::Stage S;
        fa::stage_load(S, Kg, Vg, P0LD, 0, SEQ - 1, L.sr, L.sc); asm volatile("s_waitcnt vmcnt(0)" ::: "memory");
        fa::stage_write(S, lds + fa::OFF_K, lds + fa::OFF_V, L.kws, L.vst0, L.vst1);
        __syncthreads();
#pragma unroll 1
        for (int t = 0; t < NT; ++t) {
            const int buf = t & 1;
            if (t + 1 < NT) fa::stage_load(S, Kg, Vg, P0LD, (t + 1) * 64, SEQ - 1, L.sr, L.sc);
            fa::f32x16 p0, p1;
            const bool farT = (qb * 64 + L.wid * 8) - (t * 64 + 63) >= 128;
            fa::qkt(p0, p1, lds + fa::OFF_K + buf * fa::SHM_K, L.r32, L.hi, qr, farT ? bias_far : 0.f);
            const int dq = trow - t * 64 - 4 * L.hi;
            if (!farT) fa::bias_near(p0, p1, dq, 1, lutcol);
            const unsigned word = (t < 32) ? mv.x : (t < 64) ? mv.y : (t < 96) ? mv.z : mv.w;
            fa::mask_all(p0, p1, ((word >> (t & 31)) & 1u) != 0u);
            if (t == qb) fa::mask_tile(p0, p1, dq, 0x40000000u);
            float alpha; fa::partialSM(p0, p1, m_reg, alpha);
            fa::rescale(o, alpha, al_l, L.r32, L.hi);
            bf16x8 a0, a1, a2, a3; const float ps = fa::finishSM(p0, p1, a0, a1, a2, a3); l_reg = l_reg * alpha + ps;
            fa::pv_tile(o, (int)(uintptr_t)(lds + fa::OFF_V + buf * fa::SHM_V) + L.vrd, a0, a1, a2, a3);
            if (t + 1 < NT) { asm volatile("s_waitcnt vmcnt(0)" ::: "memory"); fa::stage_write(S, lds + fa::OFF_K + (buf ^ 1) * fa::SHM_K, lds + fa::OFF_V + (buf ^ 1) * fa::SHM_V, L.kws, L.vst0, L.vst1); }
            __syncthreads();
        }
        nsa_store<1>(o, l_reg, li_l, GL, OACC, nullptr, tok0, g, 1, L);
        __syncthreads();
    }
}
__device__ __forceinline__ void p3c_nsa_win(Frame& F, const Args& A) {
    unsigned char* ws = A.ws; const NsaLane L = nsa_lane(F);
    const bf16* P0 = (const bf16*)(ws + WS_P0); const float* GL = (const float*)(ws + WS_GL); float* OACC = (float*)(ws + WS_Z); bf16* OATT = (bf16*)(ws + WS_OATT0);
    nsa_lut(F, A);
    LAS char* lds = (LAS char*)(F.lds + RING_OFF);
    LAS float* wsf = (LAS float*)(lds + fa::OFF_WS) + L.wid * 64; LAS float* li_l = wsf; LAS float* al_l = wsf + 32;
    const LAS float* lut = (const LAS float*)(lds + fa::OFF_LUT);
    for (int u = F.vcu; u < 1024; u += F.G) {
        const int bg = u >> 7, qb = u & 127, b = bg >> 2, g = bg & 3;
        const int tok0 = b * SEQ + qb * 64;
        bf16x8 qr[8]; nsa_load_q(qr, P0, tok0, g, L);
        const int trow = qb * 64 + L.wid * 8 + L.ql;
        const int h = g * 4 + L.j; const LAS float* lutcol = lut + h; const float bias_far = lutcol[128 * 16];
        const bf16* Kg = P0 + (size_t)b * SEQ * P0LD + COL_KW + g * 128; const bf16* Vg = P0 + (size_t)b * SEQ * P0LD + COL_VW + g * 128;
        const int t0 = max(0, qb - 8), NT = qb - t0 + 1;
        float m_reg = -1e30f, l_reg = 0.f; fa::f32x16 o[4];
#pragma unroll
        for (int d = 0; d < 4; ++d)
#pragma unroll
            for (int r = 0; r < 16; ++r) o[d][r] = 0.f;
        fa::Stage S;
        fa::stage_load(S, Kg, Vg, P0LD, t0 * 64, SEQ - 1, L.sr, L.sc); asm volatile("s_waitcnt vmcnt(0)" ::: "memory");
        fa::stage_write(S, lds + fa::OFF_K, lds + fa::OFF_V, L.kws, L.vst0, L.vst1);
        __syncthreads();
#pragma unroll 1
        for (int tt = 0; tt < NT; ++tt) {
            const int buf = tt & 1, t = t0 + tt;
            if (tt + 1 < NT) fa::stage_load(S, Kg, Vg, P0LD, (t + 1) * 64, SEQ - 1, L.sr, L.sc);
            fa::f32x16 p0, p1;
            const bool farT = (qb * 64 + L.wid * 8) - (t * 64 + 63) >= 128;
            fa::qkt(p0, p1, lds + fa::OFF_K + buf * fa::SHM_K, L.r32, L.hi, qr, farT ? bias_far : 0.f);
            const int dq = trow - t * 64 - 4 * L.hi;
            if (!farT) fa::bias_near(p0, p1, dq, 1, lutcol);
            if (t == qb || t == t0) fa::mask_tile(p0, p1, dq, 512u);
            float alpha; fa::partialSM(p0, p1, m_reg, alpha);
            fa::rescale(o, alpha, al_l, L.r32, L.hi);
            bf16x8 a0, a1, a2, a3; const float ps = fa::finishSM(p0, p1, a0, a1, a2, a3); l_reg = l_reg * alpha + ps;
            fa::pv_tile(o, (int)(uintptr_t)(lds + fa::OFF_V + buf * fa::SHM_V) + L.vrd, a0, a1, a2, a3);
            if (tt + 1 < NT) { asm volatile("s_waitcnt vmcnt(0)" ::: "memory"); fa::stage_write(S, lds + fa::OFF_K + (buf ^ 1) * fa::SHM_K, lds + fa::OFF_V + (buf ^ 1) * fa::SHM_V, L.kws, L.vst0, L.vst1); }
            __syncthreads();
        }
        nsa_store<2>(o, l_reg, li_l, GL, OACC, OATT, tok0, g, 2, L);
        __syncthreads();
    }
}

template <bool ROUTE>
__device__ __forceinline__ void ln_phase(Frame& F, const Args& A, const float* Z, const float* gam, const float* bet, float* XF, bf16* XB) {
    const int gw = F.vcu * NWAVES + F.wave, NGW = F.G * NWAVES, lane = F.lane;
    LAS float* wrl = (LAS float*)(F.lds + RING_OFF);
    if (ROUTE) { for (int i = F.tid; i < DM * 8 / 4; i += 512) *(LAS f32x4*)(wrl + i * 4) = *(const f32x4*)(A.in[18] + i * 4); __syncthreads(); }
    for (int row = gw; row < NTOK; row += NGW) {
        const f32x4* zr = (const f32x4*)(Z + (size_t)row * DM) + lane;
        f32x4 v[8]; float s = 0.f;
#pragma unroll
        for (int j = 0; j < 8; ++j) { v[j] = zr[64 * j]; s += (v[j][0] + v[j][1]) + (v[j][2] + v[j][3]); }
        const float mean = wave_sum(s) * (1.f / DM); float s2 = 0.f;
#pragma unroll
        for (int j = 0; j < 8; ++j) { v[j] = v[j] - mean; s2 += (v[j][0] * v[j][0] + v[j][1] * v[j][1]) + (v[j][2] * v[j][2] + v[j][3] * v[j][3]); }
        const float rstd = 1.f / sqrtf(wave_sum(s2) * (1.f / DM) + LN_EPS);
        float lg[8];
#pragma unroll
        for (int e = 0; e < 8; ++e) lg[e] = 0.f;
#pragma unroll
        for (int j = 0; j < 8; ++j) { const int c = 4 * lane + 256 * j; const f32x4 gg = *(const f32x4*)(gam + c), bb = *(const f32x4*)(bet + c);
            const f32x4 x = v[j] * rstd * gg + bb;
            *(f32x4*)(XF + (size_t)row * DM + c) = x;
            uint2 o; o.x = pk2(x[0], x[1]); o.y = pk2(x[2], x[3]); *(uint2*)(XB + (size_t)row * DM + c) = o;
            asm volatile("" ::: "memory");
            if (ROUTE) { const LAS float* wr = wrl + c * 8;
#pragma unroll
                for (int q = 0; q < 4; ++q) { const f32x4 w0 = *(const LAS f32x4*)(wr + q * 8), w1 = *(const LAS f32x4*)(wr + q * 8 + 4);
                    lg[0] += x[q] * w0[0]; lg[1] += x[q] * w0[1]; lg[2] += x[q] * w0[2]; lg[3] += x[q] * w0[3]; lg[4] += x[q] * w1[0]; lg[5] += x[q] * w1[1]; lg[6] += x[q] * w1[2]; lg[7] += x[q] * w1[3]; }  asm volatile("" ::: "memory"); }
        }
        if (ROUTE) {
#pragma unroll
            for (int e = 0; e < 8; ++e) lg[e] = wave_sum(lg[e]) + A.in[19][e];
            int e0 = 0; float l0 = lg[0];
#pragma unroll
            for (int e = 1; e < 8; ++e) if (lg[e] > l0) { l0 = lg[e]; e0 = e; }
            int e1 = -1; float l1 = -3e38f;
#pragma unroll
            for (int e = 0; e < 8; ++e) if (e != e0 && lg[e] > l1) { l1 = lg[e]; e1 = e; }
            const float w0 = 1.0f / (1.0f + __expf(l1 - l0)), w1 = 1.0f - w0;
            if (lane == 0) {
                const unsigned p0 = __hip_atomic_fetch_add((unsigned*)(F.ctl + CW_MOECNT + 64 * e0), 1u, __ATOMIC_RELAXED, __HIP_MEMORY_SCOPE_AGENT);
                const unsigned p1 = __hip_atomic_fetch_add((unsigned*)(F.ctl + CW_MOECNT + 64 * e1), 1u, __ATOMIC_RELAXED, __HIP_MEMORY_SCOPE_AGENT);
                int* re = (int*)(A.ws + WS_ROUTE); int* rp = re + 2 * NTOK; float* rw = (float*)(rp + 2 * NTOK);
                re[2 * row] = e0; re[2 * row + 1] = e1; rp[2 * row] = (int)p0; rp[2 * row + 1] = (int)p1; rw[2 * row] = w0; rw[2 * row + 1] = w1;
            }
        }
    }
}

__device__ __forceinline__ void ln_route_phase(Frame& F, const Args& A, const float* Z, const float* gam, const float* bet, float* XF, bf16* XB) {
    const int gw = F.vcu * NWAVES + F.wave, NGW = F.G * NWAVES, lane = F.lane;
    LAS float* wrl = (LAS float*)(F.lds + RING_OFF);
    LAS float* rowb = (LAS float*)(F.lds + RING_OFF + 65536 + F.wave * 8192);
    for (int i = F.tid; i < DM * 8 / 4; i += 512) *(LAS f32x4*)(wrl + i * 4) = *(const f32x4*)(A.in[18] + i * 4);
    __syncthreads();
    for (int row = gw; row < NTOK; row += NGW) {
        float s = 0.f, s2 = 0.f;
#pragma unroll 1
        for (int j = 0; j < 8; ++j) { const f32x4 v = *(const f32x4*)(Z + (size_t)row * DM + 4 * lane + 256 * j); *(LAS f32x4*)(rowb + 4 * lane + 256 * j) = v;
            s += (v[0] + v[1]) + (v[2] + v[3]); }
        const float mean = wave_sum(s) * (1.f / DM);
#pragma unroll 1
        for (int j = 0; j < 8; ++j) { const f32x4 v = *(const LAS f32x4*)(rowb + 4 * lane + 256 * j) - mean; s2 += (v[0] * v[0] + v[1] * v[1]) + (v[2] * v[2] + v[3] * v[3]); }
        const float rstd = 1.f / sqrtf(wave_sum(s2) * (1.f / DM) + LN_EPS);
        float lg[8];
#pragma unroll
        for (int e = 0; e < 8; ++e) lg[e] = 0.f;
#pragma unroll 1
        for (int j = 0; j < 8; ++j) { const int c = 4 * lane + 256 * j; const f32x4 gg = *(const f32x4*)(gam + c), bb = *(const f32x4*)(bet + c);
            const f32x4 x = (*(const LAS f32x4*)(rowb + c) - mean) * rstd * gg + bb;
            *(f32x4*)(XF + (size_t)row * DM + c) = x;
            uint2 o; o.x = pk2(x[0], x[1]); o.y = pk2(x[2], x[3]); *(uint2*)(XB + (size_t)row * DM + c) = o;
            const LAS float* wr = wrl + c * 8;
#pragma unroll
            for (int q = 0; q < 4; ++q) { const f32x4 w0 = *(const LAS f32x4*)(wr + q * 8), w1 = *(const LAS f32x4*)(wr + q * 8 + 4);
                lg[0] += x[q] * w0[0]; lg[1] += x[q] * w0[1]; lg[2] += x[q] * w0[2]; lg[3] += x[q] * w0[3]; lg[4] += x[q] * w1[0]; lg[5] += x[q] * w1[1]; lg[6] += x[q] * w1[2]; lg[7] += x[q] * w1[3]; } }
#pragma unroll
        for (int e = 0; e < 8; ++e) lg[e] = wave_sum(lg[e]) + A.in[19][e];
        int e0 = 0; float l0 = lg[0];
#pragma unroll
        for (int e = 1; e < 8; ++e) if (lg[e] > l0) { l0 = lg[e]; e0 = e; }
        int e1 = -1; float l1 = -3e38f;
#pragma unroll
        for (int e = 0; e < 8; ++e) if (e != e0 && lg[e] > l1) { l1 = lg[e]; e1 = e; }
        const float w0 = 1.0f / (1.0f + __expf(l1 - l0)), w1 = 1.0f - w0;
        if (lane == 0) {
            const unsigned p0 = __hip_atomic_fetch_add((unsigned*)(F.ctl + CW_MOECNT + 64 * e0), 1u, __ATOMIC_RELAXED, __HIP_MEMORY_SCOPE_AGENT);
            const unsigned p1 = __hip_atomic_fetch_add((unsigned*)(F.ctl + CW_MOECNT + 64 * e1), 1u, __ATOMIC_RELAXED, __HIP_MEMORY_SCOPE_AGENT);
            int* re = (int*)(A.ws + WS_ROUTE); int* rp = re + 2 * NTOK; float* rw = (float*)(rp + 2 * NTOK);
            re[2 * row] = e0; re[2 * row + 1] = e1; rp[2 * row] = (int)p0; rp[2 * row + 1] = (int)p1; rw[2 * row] = w0; rw[2 * row + 1] = w1;
        }
        WSYNC();
    }
    __syncthreads();
}

__device__ __forceinline__ void p10_dsa_prep(Frame& F, const Args& A) {
    unsigned char* ws = A.ws; const int lane = F.lane;
    const int gw = F.vcu * NWAVES + F.wave, NGW = F.G * NWAVES;
    { const float* CR = (const float*)(ws + WS_CRAW); bf16* CN = (bf16*)(ws + WS_CN); const f32x4 gg = *(const f32x4*)(A.in[11] + 4 * lane);
      for (int row = gw; row < NTOK; row += NGW) { const f32x4 v = *(const f32x4*)(CR + (size_t)row * KVR + 4 * lane);
          const float ss = wave_sum(v[0] * v[0] + v[1] * v[1] + v[2] * v[2] + v[3] * v[3]); const float r = 1.f / sqrtf(ss * (1.f / KVR) + RMS_EPS);
          uint2 o; o.x = pk2(v[0] * r * gg[0], v[1] * r * gg[1]); o.y = pk2(v[2] * r * gg[2], v[3] * r * gg[3]); *(uint2*)(CN + (size_t)row * KVR + 4 * lane) = o;
          if (lane < 16) { const f32x4 kv = *(const f32x4*)((const float*)(ws + WS_KIWI) + (size_t)row * 128 + 4 * lane); uint2 k2; k2.x = pk2(kv[0], kv[1]); k2.y = pk2(kv[2], kv[3]); *(uint2*)((bf16*)(ws + WS_KIB) + (size_t)row * 64 + 4 * lane) = k2; } } }
    const bf16* Q = (const bf16*)(ws + WS_Q); const bf16* UKT = (const bf16*)(ws + WS_W_UK); bf16* QL = (bf16*)(ws + WS_QLAT);
    const int r16 = lane & 15, kq = lane >> 4; const float sc = 0.08838834764831845f;
    for (int it = gw; it < 512 * 16 * 4; it += NGW) {
        const int nc = it & 3, h = (it >> 2) & 15, mt = it >> 6;
        f32x4 acc[2][4];
#pragma unroll
        for (int m = 0; m < 2; ++m)
#pragma unroll
            for (int n = 0; n < 4; ++n) acc[m][n] = (f32x4){0.f, 0.f, 0.f, 0.f};
#pragma unroll
        for (int ks = 0; ks < 4; ++ks) { s8v af[2], bfr[4];
#pragma unroll
            for (int m = 0; m < 2; ++m) af[m] = ld_frag(Q + (size_t)(mt * 32 + m * 16 + r16) * DM + h * 128 + ks * 32 + kq * 8);
#pragma unroll
            for (int n = 0; n < 4; ++n) bfr[n] = ld_frag(UKT + ((size_t)h * 256 + nc * 64 + n * 16 + r16) * 128 + ks * 32 + kq * 8);
#pragma unroll
            for (int m = 0; m < 2; ++m)
#pragma unroll
                for (int n = 0; n < 4; ++n) acc[m][n] = __builtin_amdgcn_mfma_f32_16x16x32_bf16(af[m], bfr[n], acc[m][n], 0, 0, 0); }
#pragma unroll
        for (int m = 0; m < 2; ++m)
#pragma unroll
            for (int n = 0; n < 4; ++n)
#pragma unroll
                for (int j = 0; j < 4; ++j) QL[(size_t)(mt * 32 + m * 16 + kq * 4 + j) * 4096 + h * 256 + nc * 64 + n * 16 + r16] = (bf16)f2bf(acc[m][n][j] * sc);
    }
}
__device__ __forceinline__ void p12_dsa_uv(Frame& F, const Args& A) {
    unsigned char* ws = A.ws; const int lane = F.lane;
    const int gw = F.vcu * NWAVES + F.wave, NGW = F.G * NWAVES;
    const bf16* OL = (const bf16*)(ws + WS_OLAT); const bf16* UVT = (const bf16*)(ws + WS_W_UV); bf16* O = (bf16*)(ws + WS_OATT1);
    const int r16 = lane & 15, kq = lane >> 4;
    for (int it = gw; it < 512 * 16 * 2; it += NGW) {
        const int nc = it & 1, h = (it >> 1) & 15, mt = it >> 5;
        f32x4 acc[2][4];
#pragma unroll
        for (int m = 0; m < 2; ++m)
#pragma unroll
            for (int n = 0; n < 4; ++n) acc[m][n] = (f32x4){0.f, 0.f, 0.f, 0.f};
#pragma unroll
        for (int ks = 0; ks < 8; ++ks) { s8v af[2], bfr[4];
#pragma unroll
            for (int m = 0; m < 2; ++m) af[m] = ld_frag(OL + (size_t)(mt * 32 + m * 16 + r16) * 4096 + h * 256 + ks * 32 + kq * 8);
#pragma unroll
            for (int n = 0; n < 4; ++n) bfr[n] = ld_frag(UVT + ((size_t)h * 128 + nc * 64 + n * 16 + r16) * 256 + ks * 32 + kq * 8);
#pragma unroll
            for (int m = 0; m < 2; ++m)
#pragma unroll
                for (int n = 0; n < 4; ++n) acc[m][n] = __builtin_amdgcn_mfma_f32_16x16x32_bf16(af[m], bfr[n], acc[m][n], 0, 0, 0); }
#pragma unroll
        for (int m = 0; m < 2; ++m)
#pragma unroll
            for (int n = 0; n < 4; ++n)
#pragma unroll
                for (int j = 0; j < 4; ++j) O[(size_t)(mt * 32 + m * 16 + kq * 4 + j) * DM + h * 128 + nc * 64 + n * 16 + r16] = (bf16)f2bf(acc[m][n][j]);
    }
}

__device__ __forceinline__ unsigned f2key(float f) { const unsigned u = __float_as_uint(f); return (u & 0x80000000u) ? ~u : (u | 0x80000000u); }

__device__ __forceinline__ unsigned dsa_off_b(unsigned row, unsigned ch) { return 256u * row + 16u * (ch ^ (((row & 3) << 2) | ((row >> 2) & 3))); }

__device__ __forceinline__ void p13a_dsa_index(Frame& F, const Args& A) {
    unsigned char* ws = A.ws; const int lane = F.lane, wid = F.wave, r32 = lane & 31, hi = lane >> 5;
    const bf16* QI = (const bf16*)(ws + WS_QI); const bf16* KIB = (const bf16*)(ws + WS_KIB); const float* KIWI = (const float*)(ws + WS_KIWI); int* IDX = (int*)(ws + WS_IDX);
    LAS float* sc = (LAS float*)(F.lds + RING_OFF);
    LAS unsigned* hist = (LAS unsigned*)(F.lds + DSA_SCR);
    LAS int* idxl = (LAS int*)(hist + 1024);
    LAS int* tiel = idxl + 1024;
    LAS unsigned* qm = (LAS unsigned*)(tiel + 256);
    const int q = wid >> 1, sub = wid & 1, th = sub * 64 + lane;
    for (int slot = F.vcu; slot < NTOK / 4; slot += F.G) {
        const int rowi = slot >> 8; int cc = slot & 255; if (rowi & 1) cc = 255 - cc;
        const int tok0 = (rowi * 256 + cc) * 4, b = tok0 >> 13, t0 = tok0 & (SEQ - 1), tmax = t0 + 3;
        bf16x8 qa[4];
#pragma unroll
        for (int s = 0; s < 4; ++s) qa[s] = *(const bf16x8*)(QI + (size_t)(tok0 + (r32 >> 3)) * 512 + (r32 & 7) * 64 + 16 * s + 8 * hi);
        float wv[16];
#pragma unroll
        for (int r = 0; r < 16; ++r) wv[r] = KIWI[(size_t)(tok0 + (r >> 2)) * 128 + 64 + (r & 3) + 4 * hi] * 0.35355339059327373f;
        const int ntiles = (tmax >> 5) + 1;
        for (int tile = wid; tile < ntiles; tile += 8) {
            const int key = tile * 32 + r32; const bf16* kp = KIB + (size_t)(b * SEQ + key) * 64 + 8 * hi;
            bf16x8 kb[4];
#pragma unroll
            for (int s = 0; s < 4; ++s) kb[s] = *(const bf16x8*)(kp + 16 * s);
            fa::f32x16 acc;
#pragma unroll
            for (int r = 0; r < 16; ++r) acc[r] = 0.f;
#pragma unroll
            for (int s = 0; s < 4; ++s) acc = __builtin_amdgcn_mfma_f32_32x32x16_bf16(qa[s], kb[s], acc, 0, 0, 0);
#pragma unroll
            for (int qq = 0; qq < 4; ++qq) { float part = 0.f;
#pragma unroll
                for (int r3 = 0; r3 < 4; ++r3) part += wv[4 * qq + r3] * fmaxf(acc[4 * qq + r3], 0.f);
                const float tot = part + __shfl_xor(part, 32);
                if ((qq >> 1) == hi) sc[qq * 8192 + key] = tot + 0.0f; }
        }
        __syncthreads();
        const int tok = tok0 + q, n = t0 + q + 1;
        if (tmax + 1 <= TOPK) {
            for (int i = th; i < TOPK; i += 128) IDX[(size_t)tok * TOPK + i] = (i < n) ? i : 0;
        } else {
            unsigned prefix = 0u, pmask = 0u, need = TOPK;
#pragma unroll 1
            for (int pass = 0; pass < 4; ++pass) {
                const int shift = 24 - 8 * pass;
                hist[q * 256 + th] = 0u; hist[q * 256 + 128 + th] = 0u;
                __syncthreads();
                for (int i = th; i < n; i += 128) { const unsigned u = f2key(sc[q * 8192 + i]); if ((u & pmask) == prefix) __hip_atomic_fetch_add(&hist[q * 256 + ((u >> shift) & 255u)], 1u, __ATOMIC_RELAXED, __HIP_MEMORY_SCOPE_WORKGROUP); }
                __syncthreads();
                if (sub == 0) {
                    const v4u c4 = *(const LAS v4u*)(hist + q * 256 + 4 * lane); const unsigned s4 = c4.x + c4.y + c4.z + c4.w; unsigned S = s4;
#pragma unroll
                    for (int o = 1; o < 64; o <<= 1) { const unsigned v = __shfl_down(S, o); if (lane + o < 64) S += v; }
                    const unsigned above = S - s4;
                    if (above < need && need <= S) { unsigned cum = above; int bin;
                        if (cum + c4.w >= need) bin = 3; else { cum += c4.w; if (cum + c4.z >= need) bin = 2; else { cum += c4.z; if (cum + c4.y >= need) bin = 1; else { cum += c4.y; bin = 0; } } }
                        qm[q * 8 + 0] = prefix | ((unsigned)(4 * lane + bin) << shift); qm[q * 8 + 1] = need - cum; }
                }
                __syncthreads();
                prefix = qm[q * 8 + 0]; need = qm[q * 8 + 1]; pmask |= (255u << shift);
            }
            if (th == 0) { qm[q * 8 + 2] = 0u; qm[q * 8 + 3] = 0u; }
            __syncthreads();
            const unsigned T = prefix;
            for (int i = th; i < n; i += 128) { const unsigned u = f2key(sc[q * 8192 + i]);
                if (u > T) { const unsigned p = __hip_atomic_fetch_add(&qm[q * 8 + 2], 1u, __ATOMIC_RELAXED, __HIP_MEMORY_SCOPE_WORKGROUP); if (p < (unsigned)TOPK) idxl[q * 256 + p] = i; }
                else if (u == T) { const unsigned p = __hip_atomic_fetch_add(&qm[q * 8 + 3], 1u, __ATOMIC_RELAXED, __HIP_MEMORY_SCOPE_WORKGROUP); if (p < 64u) tiel[q * 64 + p] = i; } }
            __syncthreads();
            if (sub == 0) { const int base = (int)qm[q * 8 + 2]; const int nt = (int)min(qm[q * 8 + 3], 64u);
                const int ti = (lane < nt) ? tiel[q * 64 + lane] : 0x7fffffff; int rank = 0;
                for (int j = 0; j < nt; ++j) { const int tj = __shfl(ti, j); rank += (tj < ti) ? 1 : 0; }
                if (lane < nt && rank < (int)need && base + rank < TOPK) idxl[q * 256 + base + rank] = ti; }
            __syncthreads();
            for (int i = th; i < TOPK; i += 128) IDX[(size_t)tok * TOPK + i] = idxl[q * 256 + i];
        }
        __syncthreads();
    }
}

__device__ __forceinline__ void p13b_dsa_attn(Frame& F, const Args& A) {
    unsigned char* ws = A.ws; const int lane = F.lane, wid = F.wave, c16 = lane & 15, g4 = lane >> 4;
    const bf16* CN = (const bf16*)(ws + WS_CN); const bf16* QL = (const bf16*)(ws + WS_QLAT); const int* IDX = (const int*)(ws + WS_IDX); bf16* OL = (bf16*)(ws + WS_OLAT);
    LAS float* lut = (LAS float*)(F.lds + DSA_SCR + 8192);
    for (int i = F.tid; i < 144 * 16; i += 512) { const int n = i >> 4, h = i & 15; lut[i] = A.in[1][rel_bucket(n) * 16 + h]; }
    __syncthreads();
    LAS char* img = (LAS char*)(F.lds + RING_OFF + wid * 16384);
    LAS int* idxw = (LAS int*)(F.lds + DSA_SCR + wid * 1024);
    const unsigned imgb = (unsigned)(uintptr_t)img;
    const int gw = F.vcu * NWAVES + wid, NGW = F.G * NWAVES;
    const unsigned prow0 = 8u * ((lane >> 2) & 3) + (lane & 3);
    for (int tok = gw; tok < NTOK; tok += NGW) {
        const int b = tok >> 13, t = tok & (SEQ - 1), cnt = min(TOPK, t + 1), ntile = (cnt + 31) >> 5;
        bf16x8 qb[8];
#pragma unroll
        for (int ks = 0; ks < 8; ++ks) qb[ks] = *(const bf16x8*)(QL + (size_t)tok * 4096 + c16 * 256 + ks * 32 + g4 * 8);
#pragma unroll
        for (int i = 0; i < 4; ++i) idxw[lane + 64 * i] = IDX[(size_t)tok * TOPK + lane + 64 * i];
        WSYNC();
        f32x4 o[16];
#pragma unroll
        for (int ct = 0; ct < 16; ++ct) o[ct] = (f32x4){0.f, 0.f, 0.f, 0.f};
        float m_run = -1e30f, l_run = 0.f;
        const LAS float* lutcol = lut + c16;
#pragma unroll 1
        for (int tile = 0; tile < ntile; ++tile) {
            { v4u st[16];
#pragma unroll
              for (int i = 0; i < 16; ++i) { const int nn = lane + 64 * i, row = nn >> 5, chg = nn & 31; const int key = idxw[tile * 32 + row];
                  st[i] = *(const v4u*)(CN + (size_t)(b * SEQ + key) * KVR + chg * 8); }
#pragma unroll
              for (int i = 0; i < 16; ++i) { const int nn = lane + 64 * i, row = nn >> 5, chg = nn & 31;
                  *(LAS v4u*)(img + (chg >> 4) * 8192 + dsa_off_b(row, chg & 15)) = st[i]; } }
            WSYNC();
            f32x4 sacc[2];
#pragma unroll
            for (int T = 0; T < 2; ++T) { sacc[T] = (f32x4){0.f, 0.f, 0.f, 0.f};
#pragma unroll
                for (int ks = 0; ks < 8; ++ks) { const bf16x8 a = *(const LAS bf16x8*)(img + (ks >> 2) * 8192 + dsa_off_b(prow0 + 4 * T, 4 * (ks & 3) + g4));
                    sacc[T] = __builtin_amdgcn_mfma_f32_16x16x32_bf16(a, qb[ks], sacc[T], 0, 0, 0); } }
            float pmax = -__builtin_inff();
#pragma unroll
            for (int T = 0; T < 2; ++T) { const int i0 = tile * 32 + 8 * g4 + 4 * T; const v4u kk = *(const LAS v4u*)(idxw + i0);
                const int kidx[4] = {(int)kk.x, (int)kk.y, (int)kk.z, (int)kk.w};
#pragma unroll
                for (int e = 0; e < 4; ++e) { const int dist = min(max(t - kidx[e], 0), 128); float s = sacc[T][e] + lutcol[dist * 16];
                    s = (i0 + e < cnt) ? s : -__builtin_inff(); sacc[T][e] = s; pmax = fmaxf(pmax, s); } }
            pmax = fmaxf(pmax, __shfl_xor(pmax, 16)); pmax = fmaxf(pmax, __shfl_xor(pmax, 32));
            const float mn = fmaxf(m_run, pmax), alpha = __builtin_amdgcn_exp2f((m_run - mn) * fa::C2); m_run = mn;
            float ps = 0.f;
#pragma unroll
            for (int T = 0; T < 2; ++T)
#pragma unroll
                for (int e = 0; e < 4; ++e) { const float pv = __builtin_amdgcn_exp2f((sacc[T][e] - mn) * fa::C2); sacc[T][e] = pv; ps += pv; }
            ps += __shfl_xor(ps, 16); ps += __shfl_xor(ps, 32);
            l_run = l_run * alpha + ps;
            if (__any(alpha < 1.f)) {
                float al[4];
#pragma unroll
                for (int e = 0; e < 4; ++e) al[e] = __shfl(alpha, 4 * g4 + e);
#pragma unroll
                for (int ct = 0; ct < 16; ++ct)
#pragma unroll
                    for (int e = 0; e < 4; ++e) o[ct][e] *= al[e];
            }
            fa::u32x4v pw; pw.x = fa::cvtpk(sacc[0][0], sacc[0][1]); pw.y = fa::cvtpk(sacc[0][2], sacc[0][3]); pw.z = fa::cvtpk(sacc[1][0], sacc[1][1]); pw.w = fa::cvtpk(sacc[1][2], sacc[1][3]);
            const bf16x8 pa = *reinterpret_cast<bf16x8*>(&pw);
            const unsigned qq = (lane & 15) >> 2, pp = lane & 3;
#pragma unroll
            for (int ct = 0; ct < 16; ++ct) { fa::s16x4 b0, b1;
                const unsigned a0 = imgb + (ct >> 3) * 8192 + dsa_off_b(8 * g4 + qq, 2 * (ct & 7) + (pp >> 1)) + 8 * (pp & 1);
                const unsigned a1 = imgb + (ct >> 3) * 8192 + dsa_off_b(8 * g4 + 4 + qq, 2 * (ct & 7) + (pp >> 1)) + 8 * (pp & 1);
                asm volatile("ds_read_b64_tr_b16 %0, %2\n\tds_read_b64_tr_b16 %1, %3\n\ts_waitcnt lgkmcnt(0)" : "=&v"(b0), "=&v"(b1) : "v"(a0), "v"(a1) : "memory");
                FA_SBAR();
                o[ct] = __builtin_amdgcn_mfma_f32_16x16x32_bf16(pa, (bf16x8){b0[0], b0[1], b0[2], b0[3], b1[0], b1[1], b1[2], b1[3]}, o[ct], 0, 0, 0); }
            WSYNC();
        }
        { const float il = (l_run > 0.f) ? 1.0f / l_run : 0.f; float ile[4];
#pragma unroll
          for (int e = 0; e < 4; ++e) ile[e] = __shfl(il, 4 * g4 + e);
#pragma unroll
          for (int ct = 0; ct < 16; ++ct)
#pragma unroll
              for (int e = 0; e < 4; ++e) { const float v = o[ct][e] * ile[e]; const float vn = __shfl_xor(v, 1);
                  if ((lane & 1) == 0) *(unsigned*)(OL + (size_t)tok * 4096 + (4 * g4 + e) * 256 + ct * 16 + c16) = fa::cvtpk(v, vn); } }
        WSYNC();
    }
    __syncthreads();
}

struct MoeTiles { int tend[8]; int pstart[8]; int MT; };
__device__ __forceinline__ void moe_tiles(Frame& F, MoeTiles& T) {
    int acc = 0;
#pragma unroll
    for (int e = 0; e < 8; ++e) { const int c = (int)__builtin_amdgcn_readfirstlane(__hip_atomic_load((unsigned*)(F.ctl + CW_MOECNT + 64 * e), __ATOMIC_RELAXED, __HIP_MEMORY_SCOPE_AGENT));
        T.pstart[e] = acc * 256; acc += (c + 255) >> 8; T.tend[e] = acc; }
    T.MT = acc;
}
__device__ __forceinline__ void p15_gather(Frame& F, const Args& A) {
    MoeTiles T; moe_tiles(F, T);
    const int gw = F.vcu * NWAVES + F.wave, NGW = F.G * NWAVES, lane = F.lane;
    const float* XF = (const float*)(A.ws + WS_XF); unsigned char* XG = (unsigned char*)(A.ws + WS_XG);
    const int* re = (const int*)(A.ws + WS_ROUTE); const int* rp = re + 2 * NTOK;
    for (int tok = gw; tok < NTOK; tok += NGW) {
        v4u v[2];
#pragma unroll
        for (int j = 0; j < 2; ++j) { const float* src = XF + (size_t)tok * DM + 16 * lane + 1024 * j; int w[4];
#pragma unroll
            for (int q = 0; q < 4; ++q) { const f32x4 x = *(const f32x4*)(src + 4 * q); w[q] = __builtin_amdgcn_cvt_pk_fp8_f32(x[0], x[1], 0, false); w[q] = __builtin_amdgcn_cvt_pk_fp8_f32(x[2], x[3], w[q], true); }
            v[j].x = (unsigned)w[0]; v[j].y = (unsigned)w[1]; v[j].z = (unsigned)w[2]; v[j].w = (unsigned)w[3]; }
#pragma unroll
        for (int s = 0; s < 2; ++s) { const int e = re[2 * tok + s], p = rp[2 * tok + s]; int ps = 0;
#pragma unroll
            for (int q = 0; q < 8; ++q) ps = (q == e) ? T.pstart[q] : ps;
            unsigned char* dst = XG + (size_t)(ps + p) * DM + 16 * lane;
#pragma unroll
            for (int j = 0; j < 2; ++j) *(v4u*)(dst + 1024 * j) = v[j]; }
    }
}
__device__ __forceinline__ void p18_final(Frame& F, const Args& A) {
    MoeTiles T; moe_tiles(F, T);
    const int gw = F.vcu * NWAVES + F.wave, NGW = F.G * NWAVES, lane = F.lane;
    const float* XF = (const float*)(A.ws + WS_XF); const float* Y = (const float*)(A.ws + WS_Y);
    const int* re = (const int*)(A.ws + WS_ROUTE); const int* rp = re + 2 * NTOK; const float* rw = (const float*)(rp + 2 * NTOK);
    const float* gam = A.in[25] + DM; const float* bet = A.in[26] + DM;
    for (int tok = gw; tok < NTOK; tok += NGW) {
        int rows[2]; float w[2];
#pragma unroll
        for (int s = 0; s < 2; ++s) { const int e = re[2 * tok + s]; int ps = 0;
#pragma unroll
            for (int q = 0; q < 8; ++q) ps = (q == e) ? T.pstart[q] : ps;
            rows[s] = ps + rp[2 * tok + s]; w[s] = rw[2 * tok + s]; }
        const f32x4* xr = (const f32x4*)(XF + (size_t)tok * DM) + lane; const f32x4* y0 = (const f32x4*)(Y + (size_t)rows[0] * DM) + lane; const f32x4* y1 = (const f32x4*)(Y + (size_t)rows[1] * DM) + lane;
        f32x4 v[8]; float s = 0.f;
#pragma unroll
        for (int j = 0; j < 8; ++j) { v[j] = xr[64 * j] * ALPHA + y0[64 * j] * w[0] + y1[64 * j] * w[1]; s += (v[j][0] + v[j][1]) + (v[j][2] + v[j][3]); }
        const float mean = wave_sum(s) * (1.f / DM); float s2 = 0.f;
#pragma unroll
        for (int j = 0; j < 8; ++j) { v[j] = v[j] - mean; s2 += (v[j][0] * v[j][0] + v[j][1] * v[j][1]) + (v[j][2] * v[j][2] + v[j][3] * v[j][3]); }
        const float rstd = 1.f / sqrtf(wave_sum(s2) * (1.f / DM) + LN_EPS);
#pragma unroll
        for (int j = 0; j < 8; ++j) { const int c = 4 * lane + 256 * j; const f32x4 gg = *(const f32x4*)(gam + c), bb = *(const f32x4*)(bet + c);
            *(f32x4*)(A.out + (size_t)tok * DM + c) = v[j] * rstd * gg + bb; }
    }
}

__global__ void __launch_bounds__(NWAVES * 64, 2) mega_fwd(Args args) {
    extern __shared__ __attribute__((aligned(16))) unsigned char lds[];
    Frame F;
    F.lds = (LAS unsigned char*)lds;
    F.MISC = (volatile LAS unsigned*)(F.lds + MISC_OFF);
    F.tid = threadIdx.x; F.lane = F.tid & 63; F.wave = __builtin_amdgcn_readfirstlane(F.tid >> 6);
    F.G = gridDim.x; { const int bx = blockIdx.x; F.vcu = (F.G % 8 == 0) ? (bx % 8) * (F.G / 8) + bx / 8 : bx; }
    unsigned char* ws = args.ws;
    F.ctl = (gu32*)(ws + WS_CTL);
    for (int u = F.tid; u < (LDS_BYTES - LDSCTL_OFF) / 4; u += NWAVES * 64) ((LAS unsigned*)(F.lds + LDSCTL_OFF))[u] = 0u;
    __syncthreads();
    XcdBarrier bar; bar.bar = (unsigned*)(F.ctl + CW_BAR); bar.x = 0; bar.st = nullptr;
#if !MK_PER_PHASE
    bar = xcd_barrier_post((unsigned*)(F.ctl + CW_BAR), F.MISC + 8);
#define GRID_BAR() xcd_barrier(bar)
#else
#define GRID_BAR() do { } while (0)
#endif
    const int lo = args.ph_lo, hi = args.ph_hi;
#ifndef PH_MASK
#define PH_MASK 0x3fffff
#endif
#define IN(k) (((PH_MASK >> (k)) & 1) && lo <= (k) && (k) < hi)
#define BOTH(k) (IN(k) && IN((k) + 1))
    bf16* XB = (bf16*)(ws + WS_XB); float* XF = (float*)(ws + WS_XF); float* Z = (float*)(ws + WS_Z);

#ifndef PROBE_MASK
#define PROBE_MASK 0
#endif
#define REPS(k) ((((PROBE_MASK) >> (k)) & 1) ? 2 : 1)
    if (IN(0)) for (int rep_ = 0; rep_ < REPS(0); ++rep_) { relaunder(F); p0_prologue(F, args); if (BOTH(0) || rep_ + 1 < REPS(0)) GRID_BAR(); }
    if (IN(1)) for (int rep_ = 0; rep_ < REPS(1); ++rep_) { relaunder(F);
        pg8::Gemm g{XB, (const bf16*)(ws + WS_W_NSA_IN), NTOK, NSA_NPAD, DM}; pg8::StaticOrder S; S.init(NTOK, NSA_NPAD, F.G, (int)blockIdx.x);
        pg8::EpiNsaIn E{(bf16*)(ws + WS_P0), (float*)(ws + WS_GL), 0.08838834764831845f};
        pg8::gemm_phase<pg8::EpiNsaIn, pg8::StaticOrder, true, true>(F.lds + RING_OFF, g, S, E);
        if (BOTH(1) || rep_ + 1 < REPS(1)) GRID_BAR();
    }
    if (IN(2)) for (int rep_ = 0; rep_ < REPS(2); ++rep_) { relaunder(F); p2_compress(F, args); if (BOTH(2) || rep_ + 1 < REPS(2)) GRID_BAR(); }
    if (IN(3)) for (int rep_ = 0; rep_ < REPS(3); ++rep_) { relaunder(F); p3a_nsa_cmp(F, args); if (BOTH(3) || rep_ + 1 < REPS(3)) GRID_BAR(); }
    if (IN(4)) for (int rep_ = 0; rep_ < REPS(4); ++rep_) { relaunder(F); p3b_nsa_sel(F, args); if (BOTH(4) || rep_ + 1 < REPS(4)) GRID_BAR(); }
    if (IN(5)) for (int rep_ = 0; rep_ < REPS(5); ++rep_) { relaunder(F); p3c_nsa_win(F, args); if (BOTH(5) || rep_ + 1 < REPS(5)) GRID_BAR(); }
    if (IN(6)) for (int rep_ = 0; rep_ < REPS(6); ++rep_) { relaunder(F);
        pg8::Gemm g{(const bf16*)(ws + WS_OATT0), (const bf16*)(ws + WS_W_NSA_OUT), NTOK, DM, DM}; pg8::StaticOrder S; S.init(NTOK, DM, F.G, (int)blockIdx.x);
        pg8::EpiResF32 E{args.in[0], Z, ALPHA, DM};
        pg8::gemm_phase<pg8::EpiResF32, pg8::StaticOrder, true, true>(F.lds + RING_OFF, g, S, E);
        if (BOTH(6) || rep_ + 1 < REPS(6)) GRID_BAR();
    }
    if (IN(7)) for (int rep_ = 0; rep_ < REPS(7); ++rep_) { relaunder(F); ln_phase<false>(F, args, Z, args.in[23], args.in[24], XF, XB); if (BOTH(7) || rep_ + 1 < REPS(7)) GRID_BAR(); }
    if (IN(8)) for (int rep_ = 0; rep_ < REPS(8); ++rep_) { relaunder(F);
        pg8::Gemm g{XB, (const bf16*)(ws + WS_W_FFN_GU), NTOK, 2 * DFF, DM}; pg8::StaticOrder S; S.init(NTOK, 2 * DFF, F.G, (int)blockIdx.x);
        pg8::EpiSwiGLU E{(bf16*)(ws + WS_HFF), DFF};
        pg8::gemm_phase<pg8::EpiSwiGLU, pg8::StaticOrder, true, true>(F.lds + RING_OFF, g, S, E);
        if (BOTH(8) || rep_ + 1 < REPS(8)) GRID_BAR();
    }
    if (IN(9)) for (int rep_ = 0; rep_ < REPS(9); ++rep_) { relaunder(F);
        pg8::Gemm g{(const bf16*)(ws + WS_HFF), (const bf16*)(ws + WS_W_FFN_DN), NTOK, DM, DFF}; pg8::StaticOrder S; S.init(NTOK, DM, F.G, (int)blockIdx.x);
        pg8::EpiResF32 E{XF, Z, ALPHA, DM};
        pg8::gemm_phase<pg8::EpiResF32, pg8::StaticOrder, true, true>(F.lds + RING_OFF, g, S, E);
        if (BOTH(9) || rep_ + 1 < REPS(9)) GRID_BAR();
    }
    if (IN(10)) for (int rep_ = 0; rep_ < REPS(10); ++rep_) { relaunder(F); ln_phase<false>(F, args, Z, args.in[25], args.in[26], XF, XB); if (BOTH(10) || rep_ + 1 < REPS(10)) GRID_BAR(); }
    if (IN(11)) for (int rep_ = 0; rep_ < REPS(11); ++rep_) { relaunder(F);
        pg8::Gemm g{XB, (const bf16*)(ws + WS_W_DSA_IN), NTOK, DSA_NPAD, DM}; pg8::StaticOrder S; S.init(NTOK, DSA_NPAD, F.G, (int)blockIdx.x);
        pg8::EpiDsaIn E{(bf16*)(ws + WS_Q), (float*)(ws + WS_CRAW), (bf16*)(ws + WS_QI), (float*)(ws + WS_KIWI), 0.125f};
        pg8::gemm_phase<pg8::EpiDsaIn, pg8::StaticOrder, true, true>(F.lds + RING_OFF, g, S, E);
        if (BOTH(11) || rep_ + 1 < REPS(11)) GRID_BAR();
    }
    if (IN(12)) for (int rep_ = 0; rep_ < REPS(12); ++rep_) { relaunder(F); p10_dsa_prep(F, args); if (BOTH(12) || rep_ + 1 < REPS(12)) GRID_BAR(); }
    if (IN(13)) for (int rep_ = 0; rep_ < REPS(13); ++rep_) { relaunder(F); p13a_dsa_index(F, args); if (BOTH(13) || rep_ + 1 < REPS(13)) GRID_BAR(); }
    if (IN(14)) for (int rep_ = 0; rep_ < REPS(14); ++rep_) { relaunder(F); p13b_dsa_attn(F, args); if (BOTH(14) || rep_ + 1 < REPS(14)) GRID_BAR(); }
    if (IN(15)) for (int rep_ = 0; rep_ < REPS(15); ++rep_) { relaunder(F); p12_dsa_uv(F, args); if (BOTH(15) || rep_ + 1 < REPS(15)) GRID_BAR(); }
    if (IN(16)) for (int rep_ = 0; rep_ < REPS(16); ++rep_) { relaunder(F);
        pg8::Gemm g{(const bf16*)(ws + WS_OATT1), (const bf16*)(ws + WS_W_DSA_OUT), NTOK, DM, DM}; pg8::StaticOrder S; S.init(NTOK, DM, F.G, (int)blockIdx.x);
        pg8::EpiResF32 E{XF, Z, ALPHA, DM};
        pg8::gemm_phase<pg8::EpiResF32, pg8::StaticOrder, true, true>(F.lds + RING_OFF, g, S, E);
        if (BOTH(16) || rep_ + 1 < REPS(16)) GRID_BAR();
    }
    if (IN(17)) for (int rep_ = 0; rep_ < REPS(17); ++rep_) { relaunder(F); ln_route_phase(F, args, Z, args.in[23] + DM, args.in[24] + DM, XF, XB); if (BOTH(17) || rep_ + 1 < REPS(17)) GRID_BAR(); }
    if (IN(18)) for (int rep_ = 0; rep_ < REPS(18); ++rep_) { relaunder(F); p15_gather(F, args); if (BOTH(18) || rep_ + 1 < REPS(18)) GRID_BAR(); }
    if (IN(19)) for (int rep_ = 0; rep_ < REPS(19); ++rep_) { relaunder(F);
        MoeTiles T; moe_tiles(F, T);
        pg8::Gemm g{(const bf16*)(ws + WS_XG), (const bf16*)(ws + WS_W_MOE_GU), T.MT * 256, 2 * DFFE, DM, 1, 0x79797979}; pg8::MoeOrder S; S.init(T.MT * 256, 2 * DFFE, F.G, (int)blockIdx.x); S.nexp_rows = 2 * DFFE;
#pragma unroll
        for (int e = 0; e < 8; ++e) S.tend[e] = T.tend[e];
        pg8::EpiSwiGLU8 E{(unsigned char*)(ws + WS_HM), DFFE};
        pg8::gemm_phase<pg8::EpiSwiGLU8, pg8::MoeOrder, true, true, true>(F.lds + RING_OFF, g, S, E);
        if (BOTH(19) || rep_ + 1 < REPS(19)) GRID_BAR();
    }
    if (IN(20)) for (int rep_ = 0; rep_ < REPS(20); ++rep_) { relaunder(F);
        MoeTiles T; moe_tiles(F, T);
        pg8::Gemm g{(const bf16*)(ws + WS_HM), (const bf16*)(ws + WS_W_MOE_DN), T.MT * 256, DM, DFFE, 1, 0x77777777}; pg8::MoeOrder S; S.init(T.MT * 256, DM, F.G, (int)blockIdx.x); S.nexp_rows = DM;
#pragma unroll
        for (int e = 0; e < 8; ++e) S.tend[e] = T.tend[e];
        pg8::EpiF32 E{(float*)(ws + WS_Y), DM};
        pg8::gemm_phase<pg8::EpiF32, pg8::MoeOrder, true, true, true>(F.lds + RING_OFF, g, S, E);
        if (BOTH(20) || rep_ + 1 < REPS(20)) GRID_BAR();
    }
    if (IN(21)) for (int rep_ = 0; rep_ < REPS(21); ++rep_) { relaunder(F); p18_final(F, args); }
#undef IN
#undef BOTH
}

extern "C" void kernel_launch(void* const* d_in, const int* in_sizes, int n_in, void* d_out, int out_size, void* d_ws, size_t ws_size, hipStream_t stream) {
    static int grid = 0;
    if (grid == 0) {
        if (n_in != 27 || out_size != NTOK * DM || ws_size < WS_END) { fprintf(stderr, "kernel_launch: unexpected shapes (n_in %d, out %d, ws %zu); nothing launched\n", n_in, out_size, ws_size); grid = -1; return; }
        int dev = 0, cus = 0, per_cu = 0;
        if (hipGetDevice(&dev) != hipSuccess || hipDeviceGetAttribute(&cus, hipDeviceAttributeMultiprocessorCount, dev) != hipSuccess) { grid = -1; return; }
        if (hipFuncSetAttribute((const void*)mega_fwd, hipFuncAttributeMaxDynamicSharedMemorySize, LDS_BYTES) != hipSuccess) { fprintf(stderr, "kernel_launch: hipFuncSetAttribute failed\n"); grid = -1; return; }
        if (hipOccupancyMaxActiveBlocksPerMultiprocessor(&per_cu, (const void*)mega_fwd, NWAVES * 64, LDS_BYTES) != hipSuccess || per_cu < 1) { fprintf(stderr, "kernel_launch: occupancy query says %d\n", per_cu); }
        (void)hipGetLastError();
        grid = cus;
    }
    if (grid < 0) return;
    if (hipMemsetAsync((char*)d_ws + WS_CTL, 0, CTL_ZERO_BYTES, stream) != hipSuccess) return;
    Args a{};
    for (int i = 0; i < 27; ++i) a.in[i] = (const float*)d_in[i];
    a.out = (float*)d_out; a.ws = (unsigned char*)d_ws;
#if MK_PER_PHASE
    for (int p = 0; p < NPHASE; ++p) { a.ph_lo = p; a.ph_hi = p + 1; hipLaunchKernelGGL(mega_fwd, dim3(grid), dim3(NWAVES * 64), LDS_BYTES, stream, a); }
#else
    a.ph_lo = 0; a.ph_hi = NPHASE;
    hipLaunchKernelGGL(mega_fwd, dim3(grid), dim3(NWAVES * 64), LDS_BYTES, stream, a);
#endif
}
```

```cpp
#include <hip/hip_runtime.h>
#include <cstdio>
#include <cstdint>
namespace pg8 {
#define PG8_LAS __attribute__((address_space(3)))
typedef unsigned short bf16_t;
typedef short bf16x8 __attribute__((ext_vector_type(8)));
typedef float f32x4 __attribute__((ext_vector_type(4)));
typedef unsigned u32x4 __attribute__((ext_vector_type(4)));
constexpr int BM = 256, BK = 64, HALF = 128, HTB = HALF * BK * 2  , STAGE_BYTES = 8 * HTB, NXCD = 8, WGM = 8;

__host__ __device__ __forceinline__ int lds_byte(int r, int c) { const int st = (r >> 4) * 2 + (c >> 5), rr = r & 15, cc = c & 31, ob = rr * 64 + cc * 2; return st * 1024 + (ob ^ (((ob >> 9) & 1) << 5)); }
__host__ __device__ __forceinline__ void stage_rc(int b, int& R, int& C) { const int st = b / 1024, sb = b % 1024, swz = sb ^ (((sb >> 9) & 1) << 5); R = (st >> 1) * 16 + swz / 64; C = (st & 1) * 32 + (swz % 64) / 2; }
__host__ __device__ __forceinline__ int perm32(int rho) { const int n = rho >> 4, i = rho & 15; return 8 * (i >> 2) + 4 * n + (i & 3); }

struct Unit { int pm, pn; };
struct Gemm { const bf16_t* A; const bf16_t* Bt; int M, N, K; int esz = 2; int scale = 0x7f7f7f7f; };

struct StaticOrder {
    int nM, nN, nwg, G, c;
    __host__ __device__ void init(int M, int N, int G_, int c_) { nM = M / BM; nN = N / BM; nwg = nM * nN; G = G_; c = c_; }
    __host__ __device__ bool next(int i, Unit& u) const {
        const long L = (long)i * G + c; if (L >= nwg) return false;
        int wgid = (int)L; { const int q = nwg / NXCD, r = nwg % NXCD, xcd = wgid % NXCD, off = wgid / NXCD; wgid = (xcd < r ? xcd * (q + 1) : r * (q + 1) + (xcd - r) * q) + off; }
        const int nig = WGM * nN, gid = wgid / nig, fm = gid * WGM, gsz = (nM - fm) < WGM ? (nM - fm) : WGM;
        u.pm = fm + ((wgid % nig) % gsz); u.pn = (wgid % nig) / gsz; return true;
    }
    __device__ __forceinline__ void a_ready(const Unit&) const {}
    __device__ __forceinline__ void done(const Unit&) const {}
    __device__ __forceinline__ const char* a_ptr(const Gemm& g, const Unit& u) const { return (const char*)g.A + (size_t)u.pm * ((size_t)BM * g.K * g.esz); }
    __device__ __forceinline__ const char* b_ptr(const Gemm& g, const Unit& u) const { return (const char*)g.Bt + (size_t)u.pn * ((size_t)BM * g.K * g.esz); }
};


__device__ __forceinline__ unsigned cvt_pk_bf16(float lo, float hi) { unsigned r; asm volatile("v_cvt_pk_bf16_f32 %0, %1, %2" : "=v"(r) : "v"(lo), "v"(hi)); return r; }
__device__ __forceinline__ u32x4 pack8(const f32x4 v0, const f32x4 v1) { u32x4 w; w.x = cvt_pk_bf16(v0[0], v0[1]); w.y = cvt_pk_bf16(v0[2], v0[3]); w.z = cvt_pk_bf16(v1[0], v1[1]); w.w = cvt_pk_bf16(v1[2], v1[3]); return w; }

struct EpiNsaIn {
    static constexpr bool PERM = true, AFTER_DRAIN = false;
    bf16_t* P0; float* GL; float qscale;
    __device__ __forceinline__ void operator()(const f32x4 (&acc)[2][2][4][2], const Unit& u, int wr, int wc, int fr, int fq) const {
        const int row0 = u.pm * BM + wr * 64 + fr;
        if (u.pn < 20) {
            const float s = u.pn < 8 ? qscale : 1.0f;
            const int col0 = u.pn * BM + wc * 32 + 8 * fq;
#pragma unroll
            for (int ai = 0; ai < 2; ++ai)
#pragma unroll
                for (int m = 0; m < 4; ++m) { bf16_t* rowp = P0 + (size_t)(row0 + ai * HALF + m * 16) * 5120 + col0;
#pragma unroll
                    for (int bj = 0; bj < 2; ++bj) *(u32x4*)(rowp + bj * HALF) = pack8(acc[ai][bj][m][0] * s, acc[ai][bj][m][1] * s); }
        } else {
            const int c = wc * 32 + 8 * fq;
            if (c < 48) {
#pragma unroll
                for (int ai = 0; ai < 2; ++ai)
#pragma unroll
                    for (int m = 0; m < 4; ++m) { float* gp = GL + (size_t)(row0 + ai * HALF + m * 16) * 48 + c;
                        *(f32x4*)gp = acc[ai][0][m][0]; *(f32x4*)(gp + 4) = acc[ai][0][m][1]; }
            }
        }
    }
};
struct EpiDsaIn {
    static constexpr bool PERM = true, AFTER_DRAIN = false;
    bf16_t* Q; float* CRAW; bf16_t* QI; float* KIWI; float qiscale;
    __device__ __forceinline__ void operator()(const f32x4 (&acc)[2][2][4][2], const Unit& u, int wr, int wc, int fr, int fq) const {
        const int row0 = u.pm * BM + wr * 64 + fr; const int c = wc * 32 + 8 * fq;
        if (u.pn < 8) {
#pragma unroll
            for (int ai = 0; ai < 2; ++ai)
#pragma unroll
                for (int m = 0; m < 4; ++m) { bf16_t* rowp = Q + (size_t)(row0 + ai * HALF + m * 16) * 2048 + u.pn * BM + c;
#pragma unroll
                    for (int bj = 0; bj < 2; ++bj) *(u32x4*)(rowp + bj * HALF) = pack8(acc[ai][bj][m][0], acc[ai][bj][m][1]); }
        } else if (u.pn == 8) {
#pragma unroll
            for (int ai = 0; ai < 2; ++ai)
#pragma unroll
                for (int m = 0; m < 4; ++m) { float* rowp = CRAW + (size_t)(row0 + ai * HALF + m * 16) * 256 + c;
#pragma unroll
                    for (int bj = 0; bj < 2; ++bj) { *(f32x4*)(rowp + bj * HALF) = acc[ai][bj][m][0]; *(f32x4*)(rowp + bj * HALF + 4) = acc[ai][bj][m][1]; } }
        } else if (u.pn < 11) {
#pragma unroll
            for (int ai = 0; ai < 2; ++ai)
#pragma unroll
                for (int m = 0; m < 4; ++m) { bf16_t* rowp = QI + (size_t)(row0 + ai * HALF + m * 16) * 512 + (u.pn - 9) * BM + c;
#pragma unroll
                    for (int bj = 0; bj < 2; ++bj) *(u32x4*)(rowp + bj * HALF) = pack8(acc[ai][bj][m][0] * qiscale, acc[ai][bj][m][1] * qiscale); }
        } else {
#pragma unroll
            for (int ai = 0; ai < 2; ++ai)
#pragma unroll
                for (int m = 0; m < 4; ++m) { float* rowp = KIWI + (size_t)(row0 + ai * HALF + m * 16) * 128 + c;
                    *(f32x4*)rowp = acc[ai][0][m][0]; *(f32x4*)(rowp + 4) = acc[ai][0][m][1]; }
        }
    }
};
struct EpiResF32 {
    static constexpr bool PERM = false, AFTER_DRAIN = false;
    const float* R; float* Z; float alpha; int ldc;
    __device__ __forceinline__ void operator()(const f32x4 (&acc)[2][2][4][2], const Unit& u, int wr, int wc, int fr, int fq) const {
        const int row0 = u.pm * BM + wr * 64 + fr, col0 = u.pn * BM + wc * 32 + 4 * fq;
#pragma unroll
        for (int ai = 0; ai < 2; ++ai)
#pragma unroll
            for (int m = 0; m < 4; ++m) { const size_t off = (size_t)(row0 + ai * HALF + m * 16) * ldc + col0;
#pragma unroll
                for (int bj = 0; bj < 2; ++bj)
#pragma unroll
                    for (int n = 0; n < 2; ++n) { const f32x4 r = *(const f32x4*)(R + off + bj * HALF + n * 16); *(f32x4*)(Z + off + bj * HALF + n * 16) = r * alpha + acc[ai][bj][m][n]; } }
    }
};
struct EpiF32 {
    static constexpr bool PERM = false, AFTER_DRAIN = false;
    float* C; int ldc;
    __device__ __forceinline__ void operator()(const f32x4 (&acc)[2][2][4][2], const Unit& u, int wr, int wc, int fr, int fq) const {
        const int row0 = u.pm * BM + wr * 64 + fr, col0 = u.pn * BM + wc * 32 + 4 * fq;
#pragma unroll
        for (int ai = 0; ai < 2; ++ai)
#pragma unroll
            for (int m = 0; m < 4; ++m) { float* rowp = C + (size_t)(row0 + ai * HALF + m * 16) * ldc + col0;
#pragma unroll
                for (int bj = 0; bj < 2; ++bj)
#pragma unroll
                    for (int n = 0; n < 2; ++n) *(f32x4*)(rowp + bj * HALF + n * 16) = acc[ai][bj][m][n]; }
    }
};
__device__ __forceinline__ float silu_mul(float g, float u) { return g * __builtin_amdgcn_rcpf(1.0f + __expf(-g)) * u; }
struct EpiSwiGLU {
    static constexpr bool PERM = true, AFTER_DRAIN = false;
    bf16_t* H; int ldh;
    __device__ __forceinline__ void operator()(const f32x4 (&acc)[2][2][4][2], const Unit& u, int wr, int wc, int fr, int fq) const {
        const int row0 = u.pm * BM + wr * 64 + fr, col0 = u.pn * HALF + wc * 32 + 8 * fq;
#pragma unroll
        for (int ai = 0; ai < 2; ++ai)
#pragma unroll
            for (int m = 0; m < 4; ++m) { bf16_t* rowp = H + (size_t)(row0 + ai * HALF + m * 16) * ldh + col0;
                f32x4 v0, v1;
#pragma unroll
                for (int j = 0; j < 4; ++j) { v0[j] = silu_mul(acc[ai][0][m][0][j], acc[ai][1][m][0][j]); v1[j] = silu_mul(acc[ai][0][m][1][j], acc[ai][1][m][1][j]); }
                *(u32x4*)rowp = pack8(v0, v1); }
    }
};
struct EpiSwiGLU8 {
    static constexpr bool PERM = true, AFTER_DRAIN = false;
    unsigned char* H; int ldh;
    __device__ __forceinline__ void operator()(const f32x4 (&acc)[2][2][4][2], const Unit& u, int wr, int wc, int fr, int fq) const {
        const int row0 = u.pm * BM + wr * 64 + fr, col0 = u.pn * HALF + wc * 32 + 8 * fq;
#pragma unroll
        for (int ai = 0; ai < 2; ++ai)
#pragma unroll
            for (int m = 0; m < 4; ++m) { unsigned char* rowp = H + (size_t)(row0 + ai * HALF + m * 16) * ldh + col0;
                float v[8];
#pragma unroll
                for (int j = 0; j < 4; ++j) { v[j] = silu_mul(acc[ai][0][m][0][j], acc[ai][1][m][0][j]); v[4 + j] = silu_mul(acc[ai][0][m][1][j], acc[ai][1][m][1][j]); }
                int w0 = __builtin_amdgcn_cvt_pk_fp8_f32(v[0], v[1], 0, false); w0 = __builtin_amdgcn_cvt_pk_fp8_f32(v[2], v[3], w0, true);
                int w1 = __builtin_amdgcn_cvt_pk_fp8_f32(v[4], v[5], 0, false); w1 = __builtin_amdgcn_cvt_pk_fp8_f32(v[6], v[7], w1, true);
                uint2 o; o.x = (unsigned)w0; o.y = (unsigned)w1; *(uint2*)rowp = o; }
    }
};
struct MoeOrder : StaticOrder {
    int tend[8]; int nexp_rows;
    __device__ __forceinline__ int expert(int pm) const { int e = 0;
#pragma unroll
        for (int i = 0; i < 7; ++i) e += (pm >= tend[i]) ? 1 : 0; return e; }
    __device__ __forceinline__ const char* b_ptr(const Gemm& g, const Unit& u) const { return (const char*)g.Bt + ((size_t)expert(u.pm) * nexp_rows + (size_t)u.pn * BM) * ((size_t)g.K * g.esz); }
};
typedef int i32x8 __attribute__((ext_vector_type(8)));
typedef int i32x4 __attribute__((ext_vector_type(4)));
__device__ __forceinline__ i32x8 cat8(bf16x8 lo, bf16x8 hi) { const i32x4 a = *reinterpret_cast<const i32x4*>(&lo), b = *reinterpret_cast<const i32x4*>(&hi); return __builtin_shufflevector(a, b, 0, 1, 2, 3, 4, 5, 6, 7); }
template <class Epi, class Sched, bool ALIGN_EPI = false, bool SP2 = false, bool FP8 = false>
__device__ __forceinline__ void gemm_phase(PG8_LAS unsigned char* lds, const Gemm g, const Sched& S, const Epi& E) {
    int tid = threadIdx.x; asm volatile("" : "+v"(tid));
    const int wid = __builtin_amdgcn_readfirstlane(tid >> 6), lane = tid & 63, wr = wid >> 2, wc = wid & 3, fr = lane & 15, fq = lane >> 4;
    const int K = g.K, nt = K / (FP8 ? 2 * BK : BK);
    unsigned voffA[2], voffB[2];
#pragma unroll
    for (int i = 0; i < 2; ++i) { int R, C; stage_rc(tid * 16 + i * 8192, R, C); const int Rb = Epi::PERM ? ((R & ~31) + perm32(R & 31)) : R;
        voffA[i] = FP8 ? (unsigned)(R * K + C * 2) : (unsigned)(R * K + C) * 2u; voffB[i] = FP8 ? (unsigned)(Rb * K + C * 2) : (unsigned)(Rb * K + C) * 2u; }
    const size_t kstep = (size_t)(BK * 2);
    const size_t hstep = (size_t)HALF * K * (FP8 ? 1 : 2);
    const size_t tstep = 2 * hstep;
    const unsigned ldsw = (unsigned)wid * 1024u;
    const int aoff = lds_byte(wr * 64 + fr, fq * 8), boff = lds_byte(wc * 32 + fr, fq * 8);
#define PG8_SA(b, h) (((b) * 2 + (h)) * HTB)
#define PG8_SB(b, h) ((4 + (b) * 2 + (h)) * HTB)
#define PG8_STAGE(bufoff, gbase, voff) do { _Pragma("unroll") for (int _i = 0; _i < 2; ++_i) \
        __builtin_amdgcn_global_load_lds((const unsigned*)((const char*)(gbase) + (voff)[_i]), (PG8_LAS unsigned*)(lds + (bufoff) + ldsw + _i * 8192), 16, 0, 0); } while (0)
#define PG8_LDA(dst, b, h) do { _Pragma("unroll") for (int m = 0; m < 4; ++m) { if constexpr (FP8) { const i32x4 lo_ = *(const PG8_LAS i32x4*)(lds + PG8_SA(b, h) + aoff + m * 2048), hi_ = *(const PG8_LAS i32x4*)(lds + PG8_SA(b, h) + aoff + m * 2048 + 1024); dst##8[m] = __builtin_shufflevector(lo_, hi_, 0, 1, 2, 3, 4, 5, 6, 7); } else { _Pragma("unroll") for (int k = 0; k < 2; ++k) dst[m][k] = *(const PG8_LAS bf16x8*)(lds + PG8_SA(b, h) + aoff + m * 2048 + k * 1024); } } } while (0)
#define PG8_LDB(dst, b, h) do { _Pragma("unroll") for (int n = 0; n < 2; ++n) { if constexpr (FP8) { const i32x4 lo_ = *(const PG8_LAS i32x4*)(lds + PG8_SB(b, h) + boff + n * 2048), hi_ = *(const PG8_LAS i32x4*)(lds + PG8_SB(b, h) + boff + n * 2048 + 1024); dst##8[n] = __builtin_shufflevector(lo_, hi_, 0, 1, 2, 3, 4, 5, 6, 7); } else { _Pragma("unroll") for (int k = 0; k < 2; ++k) dst[n][k] = *(const PG8_LAS bf16x8*)(lds + PG8_SB(b, h) + boff + n * 2048 + k * 1024); } } } while (0)
#define PG8_MMA(ai, bj, At, Bt) do { __builtin_amdgcn_s_setprio(1); _Pragma("unroll") for (int m = 0; m < 4; ++m) _Pragma("unroll") for (int n = 0; n < 2; ++n) { \
        if constexpr (FP8) { asm volatile("v_mfma_scale_f32_16x16x128_f8f6f4 %0, %1, %2, %0, %3, %4 op_sel_hi:[0,0,0]" : "+v"(acc[ai][bj][m][n]) : "v"(Bt##8[n]), "v"(At##8[m]), "v"(sclA), "v"(sclB)); } \
        else { _Pragma("unroll") for (int k = 0; k < 2; ++k) acc[ai][bj][m][n] = __builtin_amdgcn_mfma_f32_16x16x32_bf16(Bt[n][k], At[m][k], acc[ai][bj][m][n], 0, 0, 0); } } __builtin_amdgcn_s_setprio(0); } while (0)
#define PG8_WAIT_V(n) asm volatile("s_waitcnt vmcnt(" #n ")" ::: "memory")
#define PG8_WAIT_L(n) asm volatile("s_waitcnt lgkmcnt(" #n ")" ::: "memory")
#define PG8_BAR __builtin_amdgcn_s_barrier()
#define PG8_SCHED __builtin_amdgcn_sched_barrier(0)
    Unit cur, nxt; int ui = 0;
    if (!S.next(0, cur)) return;
    f32x4 acc[2][2][4][2];
#pragma unroll
    for (int a = 0; a < 2; ++a)
#pragma unroll
        for (int b = 0; b < 2; ++b)
#pragma unroll
            for (int m = 0; m < 4; ++m)
#pragma unroll
                for (int n = 0; n < 2; ++n) acc[a][b][m][n] = (f32x4){0.f, 0.f, 0.f, 0.f};
    bf16x8 At[4][2], B0[2][2], B1[2][2]; i32x8 At8[4], B08[2], B18[2]; const int sclA = g.scale, sclB = 0x7f7f7f7f;
    const char* cA = S.a_ptr(g, cur); const char* cB = S.b_ptr(g, cur);
    S.a_ready(cur);
    if constexpr (SP2) {
        PG8_STAGE(PG8_SB(0, 0), cB, voffB); PG8_STAGE(PG8_SB(0, 1), cB + hstep, voffB); PG8_STAGE(PG8_SA(0, 0), cA, voffA); PG8_STAGE(PG8_SA(0, 1), cA + hstep, voffA);
        if (wr == 1) PG8_BAR;
        PG8_WAIT_V(2); PG8_BAR;
        PG8_STAGE(PG8_SB(1, 0), cB + kstep, voffB); PG8_STAGE(PG8_SA(1, 0), cA + kstep, voffA); PG8_STAGE(PG8_SB(1, 1), cB + hstep + kstep, voffB);
        PG8_WAIT_V(6); PG8_BAR;
    } else {
        PG8_STAGE(PG8_SB(0, 0), cB, voffB); PG8_STAGE(PG8_SA(0, 0), cA, voffA); PG8_STAGE(PG8_SB(0, 1), cB + hstep, voffB); PG8_STAGE(PG8_SA(0, 1), cA + hstep, voffA);
        if (wr == 1) PG8_BAR;
        PG8_WAIT_V(4); PG8_BAR;
        PG8_STAGE(PG8_SB(1, 0), cB + kstep, voffB); PG8_STAGE(PG8_SA(1, 0), cA + kstep, voffA); PG8_STAGE(PG8_SB(1, 1), cB + hstep + kstep, voffB);
        PG8_WAIT_V(6); PG8_BAR;
    }
    for (;;) {
        const bool has_next = S.next(ui + 1, nxt);
        const char* nA = has_next ? S.a_ptr(g, nxt) : cA; const char* nB = has_next ? S.b_ptr(g, nxt) : cB;
        for (int t = 0; t < nt; t += 2) {
            const bool last = (t == nt - 2);
            const char* a1 = cA + (size_t)(t + 1) * kstep;
            const char* a2 = last ? nA : cA + (size_t)(t + 2) * kstep; const char* b2 = last ? nB : cB + (size_t)(t + 2) * kstep;
            const char* a3 = a2 + kstep; const char* b3 = b2 + kstep;
            if (last && has_next) S.a_ready(nxt);
            if constexpr (SP2) {
            PG8_LDB(B0, 0, 0); PG8_LDB(B1, 0, 1); PG8_SCHED; PG8_LDA(At, 0, 0); PG8_STAGE(PG8_SA(1, 1), a1 + hstep, voffA);
            PG8_WAIT_V(8); PG8_WAIT_L(0); PG8_BAR; PG8_MMA(0, 0, At, B0); PG8_MMA(0, 1, At, B1); PG8_BAR; PG8_SCHED;
            PG8_LDA(At, 0, 1); PG8_STAGE(PG8_SB(0, 0), b2, voffB); PG8_STAGE(PG8_SB(0, 1), b2 + hstep, voffB); PG8_STAGE(PG8_SA(0, 0), a2, voffA);
            PG8_WAIT_V(8); PG8_WAIT_L(0); PG8_BAR; PG8_MMA(1, 0, At, B0); PG8_MMA(1, 1, At, B1); PG8_BAR; PG8_SCHED;
            PG8_LDB(B0, 1, 0); PG8_LDB(B1, 1, 1); PG8_SCHED; PG8_LDA(At, 1, 0); PG8_STAGE(PG8_SA(0, 1), a2 + hstep, voffA);
            PG8_WAIT_V(8); PG8_WAIT_L(0); PG8_BAR; PG8_MMA(0, 0, At, B0); PG8_MMA(0, 1, At, B1); PG8_BAR; PG8_SCHED;
            PG8_LDA(At, 1, 1); PG8_STAGE(PG8_SB(1, 0), b3, voffB); PG8_STAGE(PG8_SB(1, 1), b3 + hstep, voffB); PG8_STAGE(PG8_SA(1, 0), a3, voffA);
            PG8_WAIT_V(8); PG8_WAIT_L(0); PG8_BAR; PG8_MMA(1, 0, At, B0); PG8_MMA(1, 1, At, B1); PG8_BAR; PG8_SCHED;
            } else {
            PG8_LDB(B0, 0, 0); PG8_SCHED; PG8_LDA(At, 0, 0); PG8_STAGE(PG8_SA(1, 1), a1 + hstep, voffA);
            PG8_WAIT_L(8); PG8_BAR; PG8_WAIT_L(0); PG8_MMA(0, 0, At, B0); PG8_BAR; PG8_SCHED;
            PG8_LDB(B1, 0, 1); PG8_STAGE(PG8_SB(0, 0), b2, voffB);
            PG8_BAR; PG8_WAIT_L(0); PG8_MMA(0, 1, At, B1); PG8_BAR;
            PG8_LDA(At, 0, 1); PG8_STAGE(PG8_SA(0, 0), a2, voffA);
            PG8_BAR; PG8_WAIT_L(0); PG8_MMA(1, 0, At, B0); PG8_BAR; PG8_SCHED;
            PG8_STAGE(PG8_SB(0, 1), b2 + hstep, voffB);
            PG8_WAIT_V(6); PG8_BAR; PG8_MMA(1, 1, At, B1); PG8_BAR;
            PG8_LDB(B0, 1, 0); PG8_SCHED; PG8_LDA(At, 1, 0); PG8_STAGE(PG8_SA(0, 1), a2 + hstep, voffA);
            PG8_WAIT_L(8); PG8_BAR; PG8_WAIT_L(0); PG8_MMA(0, 0, At, B0); PG8_BAR; PG8_SCHED;
            PG8_LDB(B1, 1, 1); PG8_STAGE(PG8_SB(1, 0), b3, voffB);
            PG8_BAR; PG8_WAIT_L(0); PG8_MMA(0, 1, At, B1); PG8_BAR;
            PG8_LDA(At, 1, 1); PG8_STAGE(PG8_SA(1, 0), a3, voffA);
            PG8_BAR; PG8_WAIT_L(0); PG8_MMA(1, 0, At, B0); PG8_BAR; PG8_SCHED;
            PG8_STAGE(PG8_SB(1, 1), b3 + hstep, voffB);
            PG8_WAIT_V(6); PG8_BAR; PG8_MMA(1, 1, At, B1); PG8_BAR;
            }
        }
        if constexpr (FP8) asm volatile("s_nop 15\n\ts_nop 15" ::: "memory");
        if constexpr (ALIGN_EPI) { if (wr == 0) PG8_BAR; }
        if constexpr (!Epi::AFTER_DRAIN) { E(acc, cur, wr, wc, fr, fq); S.done(cur); }
        if (!has_next) break;
#pragma unroll
        for (int a = 0; a < 2; ++a)
#pragma unroll
            for (int b = 0; b < 2; ++b)
#pragma unroll
                for (int m = 0; m < 4; ++m)
#pragma unroll
                    for (int n = 0; n < 2; ++n) acc[a][b][m][n] = (f32x4){0.f, 0.f, 0.f, 0.f};
        cur = nxt; cA = nA; cB = nB; ++ui;
        if constexpr (ALIGN_EPI) { if (wr == 1) PG8_BAR; }
    }
    PG8_WAIT_V(0);
    if constexpr (!ALIGN_EPI) { if (wr == 0) PG8_BAR; }
    PG8_BAR;
    if constexpr (Epi::AFTER_DRAIN) { E.fused(acc, cur, wr, wc, fr, fq, lds, wid, lane); S.done(cur); }
#undef PG8_SA
#undef PG8_SB
#undef PG8_STAGE
#undef PG8_LDA
#undef PG8_LDB
#undef PG8_MMA
#undef PG8_WAIT_V
#undef PG8_WAIT_L
#undef PG8_BAR
#undef PG8_SCHED
}
}
#define GAS __attribute__((address_space(1)))
#define LAS __attribute__((address_space(3)))
typedef unsigned short bf16;
typedef unsigned v4u __attribute__((ext_vector_type(4)));
typedef float f32x4 __attribute__((ext_vector_type(4)));
typedef short bf16x8 __attribute__((ext_vector_type(8)));
typedef GAS unsigned gu32;
typedef GAS unsigned long long gu64;
#define RLX_AGENT __ATOMIC_RELAXED, __HIP_MEMORY_SCOPE_AGENT
#define LDS_WAIT() asm volatile("s_waitcnt lgkmcnt(0)" ::: "memory")
#define VM_WAIT() asm volatile("s_waitcnt vmcnt(0)" ::: "memory")
__device__ __forceinline__ unsigned long long rt() { return __builtin_amdgcn_s_memrealtime(); }
__device__ __forceinline__ unsigned f2bf(float f) { unsigned u = __builtin_bit_cast(unsigned, f); return (u + 0x7fffu + ((u >> 16) & 1u)) >> 16; }
__device__ __forceinline__ unsigned pk2(float lo, float hi) { return f2bf(lo) | (f2bf(hi) << 16); }

#define XB_TMO      128
#define XB_XCNT(j)  (256  + 64 * (j))
#define XB_XSUB(j)  (1280 + 64 * (j))
#define XB_XGEN(j)  (2304 + 64 * (j))
#define XB_TOP      3328
#define XB_TOPGEN   3392
#define XCD_BAR_WORDS 3456
#define XB_SPIN_CAP (1u << 18)

__device__ __forceinline__ unsigned xb_ld(unsigned* p)              { return __hip_atomic_load(p, __ATOMIC_RELAXED, __HIP_MEMORY_SCOPE_AGENT); }
__device__ __forceinline__ unsigned xb_add(unsigned* p, unsigned v) { return __hip_atomic_fetch_add(p, v, __ATOMIC_RELAXED, __HIP_MEMORY_SCOPE_AGENT); }
__device__ __forceinline__ unsigned xb_xcc_id() { return (unsigned)__builtin_amdgcn_s_getreg((3 << 11) | 20) & 0xFu; }
#define XB_SPIN(cond, bar) do { unsigned _sp = 0; while (cond) { __builtin_amdgcn_s_sleep(1); \
    if ((++_sp & 255u) == 0u) { if (xb_ld(&(bar)[XB_TMO])) break; if (_sp > XB_SPIN_CAP) { atomicAdd(&(bar)[XB_TMO], 1u); break; } } } } while (0)

struct XcdBarrier {
    unsigned* bar; unsigned x;
    volatile LAS unsigned* st;
};

__device__ __forceinline__ XcdBarrier xcd_barrier_post(unsigned* bar, volatile LAS unsigned* st) {
    XcdBarrier b; b.bar = bar; b.x = xb_xcc_id(); b.st = st;
    if (threadIdx.x == 0) (void)xb_add(&bar[XB_XCNT(b.x)], 1u);
    return b;
}
__device__ __forceinline__ void xcd_barrier_complete(unsigned* bar, unsigned x, unsigned& nloc, unsigned& nx) {
    const unsigned G = gridDim.x * gridDim.y * gridDim.z;
    unsigned sum, cnt, mine, sp = 0u;
    for (;;) {
        sum = 0u; cnt = 0u; mine = 0u;
#pragma unroll
        for (unsigned j = 0; j < 16; ++j) { const unsigned c = xb_ld(&bar[XB_XCNT(j)]); sum += c; cnt += (c > 0u) ? 1u : 0u; mine = (j == x) ? c : mine; }
        if (sum == G) break;
        __builtin_amdgcn_s_sleep(1);
        if ((++sp & 255u) == 0u) { if (xb_ld(&bar[XB_TMO])) break; if (sp > XB_SPIN_CAP) { atomicAdd(&bar[XB_TMO], 1u); break; } }
    }
    nloc = mine > 0u ? mine : 1u; nx = cnt > 0u ? cnt : 1u;
}

__device__ __forceinline__ void xcd_barrier(const XcdBarrier& b) {
    asm volatile("s_waitcnt vmcnt(0)" ::: "memory");
    __syncthreads();
    if (threadIdx.x == 0) {
        unsigned* bar = b.bar;
        __builtin_amdgcn_s_waitcnt(0);
        unsigned nloc = b.st[0], nx = b.st[1];
        if (nloc == 0u) { xcd_barrier_complete(bar, b.x, nloc, nx); b.st[0] = nloc; b.st[1] = nx; }
        const unsigned old = xb_add(&bar[XB_XSUB(b.x)], 1u);
        const unsigned gen = old / nloc;
        if (old + 1u == (gen + 1u) * nloc) {
            __builtin_amdgcn_fence(__ATOMIC_RELEASE, "agent");
            asm volatile("s_waitcnt vmcnt(0)" ::: "memory");
            const unsigned og = xb_add(&bar[XB_TOP], 1u);
            const unsigned tg = og / nx;
            if (og + 1u == (tg + 1u) * nx) xb_add(&bar[XB_TOPGEN], 1u);
            else XB_SPIN(xb_ld(&bar[XB_TOPGEN]) == tg, bar);
            __builtin_amdgcn_fence(__ATOMIC_ACQUIRE, "agent");
            xb_add(&bar[XB_XGEN(b.x)], 1u);
            asm volatile("s_waitcnt vmcnt(0)" ::: "memory");
        } else {
            XB_SPIN(xb_ld(&bar[XB_XGEN(b.x)]) == gen, bar);
            __builtin_amdgcn_fence(__ATOMIC_ACQUIRE, "agent");
            asm volatile("s_waitcnt vmcnt(0)" ::: "memory");
        }
    }
    __syncthreads();
}

constexpr int NWAVES = 8;
#ifndef MK_PER_PHASE
#define MK_PER_PHASE 0
#endif
constexpr int NPHASE = 22;

constexpr int BATCH = 2, SEQ = 8192, DM = 2048, NTOK = BATCH * SEQ, NH = 16, DH = 128;
constexpr int NSA_N = 5168, NSA_NPAD = 5376, P0LD = 5120;
constexpr int NCMP = 511, NSELB = 128;
constexpr int COL_KC = 2048, COL_VC = 2560, COL_KS = 3072, COL_VS = 3584, COL_KW = 4096, COL_VW = 4608;
constexpr int DSA_N = 2888, DSA_NPAD = 3072, KVR = 256, TOPK = 256;
constexpr int DFF = 5632, NEXP = 8, DFFE = 7168, MOE_ROWS = 34816;
constexpr float ALPHA = 1.41421356237309515f, LN_EPS = 1e-5f, RMS_EPS = 1e-6f;

constexpr size_t MiB = (size_t)1 << 20;
constexpr size_t WS_CTL = 0, CTL_ZERO_BYTES = 1 * MiB;
constexpr size_t WS_W_NSA_IN = 2 * MiB, WS_W_NSA_OUT = 23 * MiB, WS_W_FFN_GU = 31 * MiB, WS_W_FFN_DN = 75 * MiB, WS_W_DSA_IN = 97 * MiB, WS_W_DSA_OUT = 109 * MiB;
constexpr size_t WS_W_CMPK = 117 * MiB, WS_W_CMPV = 118 * MiB, WS_W_UK = 119 * MiB, WS_W_UV = 120 * MiB, WS_CBIAS = 121 * MiB;
constexpr size_t WS_KCMP = 122 * MiB, WS_VCMP = 124 * MiB, WS_GL = 126 * MiB, WS_ROUTE = 129 * MiB;
constexpr size_t WS_KIB = 179 * MiB;
constexpr size_t WS_SELM = 178 * MiB;
constexpr size_t WS_CRAW = 130 * MiB, WS_KIWI = 146 * MiB, WS_IDX = 154 * MiB, WS_CN = 170 * MiB;
constexpr size_t WS_W_MOE_GU = 192 * MiB, WS_W_MOE_DN = 640 * MiB;
constexpr size_t WS_XB = 864 * MiB, WS_XF = 928 * MiB, WS_Z = 1056 * MiB;
constexpr size_t WS_P0 = 1184 * MiB, WS_OATT0 = 1344 * MiB, WS_HFF = 1408 * MiB;
constexpr size_t WS_Q = 1184 * MiB, WS_QI = 1248 * MiB, WS_QLAT = 1264 * MiB, WS_OLAT = 1392 * MiB, WS_OATT1 = 1520 * MiB;
constexpr size_t WS_XG = 1056 * MiB, WS_HM = 1192 * MiB, WS_Y = 192 * MiB;
constexpr size_t WS_END = 1668 * MiB;
static_assert(WS_HM + (size_t)MOE_ROWS * DFFE * 2 <= WS_END, "hm fits");
static_assert(WS_XG + (size_t)MOE_ROWS * DM * 2 <= WS_HM, "xg fits");
static_assert(WS_Y + (size_t)MOE_ROWS * DM * 4 <= WS_W_MOE_DN, "y overlays the dead gate/up weights only");
static_assert(WS_HFF + (size_t)NTOK * DFF * 2 <= WS_END, "hff fits");
constexpr int CW_TMO = 0, CW_CODE = 1;
constexpr int CW_BAR = 4096;
constexpr int CW_MOECNT = 16384;

constexpr int RING_OFF = 0, RING_BYTES = 131072;
constexpr int LDSCTL_OFF = RING_BYTES, MISC_OFF = LDSCTL_OFF + 320;
constexpr int LDS_BYTES = 163840;
constexpr int DSA_SCR = 133120;

struct Frame {
    LAS unsigned char* lds;
    volatile LAS unsigned* MISC;
    gu32* ctl;
    int tid, lane, wave, vcu, G;
};

__device__ __forceinline__ void relaunder(Frame& F) { int t = F.tid; asm volatile("" : "+v"(t)); F.tid = t; F.lane = t & 63; }
__device__ __forceinline__ float bf2f(unsigned short h) { return __uint_as_float(((unsigned)h) << 16); }
__device__ __forceinline__ float bflo(unsigned w) { return __uint_as_float(w << 16); }
__device__ __forceinline__ float bfhi(unsigned w) { return __uint_as_float(w & 0xffff0000u); }
__device__ __forceinline__ float wave_sum(float v) {
#pragma unroll
    for (int o = 1; o < 64; o <<= 1) v += __shfl_xor(v, o);
    return v;
}
__device__ __forceinline__ float wave_max(float v) {
#pragma unroll
    for (int o = 1; o < 64; o <<= 1) v = fmaxf(v, __shfl_xor(v, o));
    return v;
}
#define WSYNC() do { __builtin_amdgcn_wave_barrier(); asm volatile("s_waitcnt lgkmcnt(0)" ::: "memory"); __builtin_amdgcn_wave_barrier(); } while (0)

__device__ __forceinline__ int rel_bucket(int n) {
    if (n < 16) return n;
    if (n >= 113) return 31;
    int b = 16;
    b += (n >= 19); b += (n >= 21); b += (n >= 24); b += (n >= 27); b += (n >= 31); b += (n >= 35); b += (n >= 40); b += (n >= 46);
    b += (n >= 52); b += (n >= 59); b += (n >= 67); b += (n >= 77); b += (n >= 87); b += (n >= 99);
    return b;
}

struct Args { const float* in[27]; float* out; unsigned char* ws; int ph_lo, ph_hi; };
struct TrItem { const float* W; bf16* WT; int N, K, k0, n0, drow; float f8scale; };
__device__ __forceinline__ void tr_set(TrItem& T, const float* W, int K, int N, int Npad, bf16* WT, int mode, int item, float f8scale = 0.f) {
    T.f8scale = f8scale;
    const int nblk = Npad / 32, kb = item / nblk, nb = item - kb * nblk, n0 = 32 * nb;
    T.W = W; T.WT = WT; T.N = N; T.K = K; T.k0 = 64 * kb; T.n0 = n0; T.drow = (mode == 0) ? n0 : ((n0 >> 7) * 256 + (mode - 1) * 128 + (n0 & 127));
}
constexpr int TR_I_NSA_IN = (DM / 64) * (NSA_NPAD / 32), TR_I_SQ = (DM / 64) * (DM / 32), TR_I_FFN = (DM / 64) * (DFF / 32), TR_I_FFD = (DFF / 64) * (DM / 32), TR_I_DSA_IN = (DM / 64) * (DSA_NPAD / 32);
constexpr int TR_I_CMP = (4096 / 64) * (128 / 32), TR_I_UK1 = (128 / 64) * (256 / 32), TR_I_UV1 = (256 / 64) * (128 / 32);
constexpr int TR_I_MG1 = (DM / 64) * (DFFE / 32), TR_I_MD1 = (DFFE / 64) * (DM / 32);
constexpr int TR_NITEMS = TR_I_NSA_IN + 2 * TR_I_SQ + 2 * TR_I_FFN + TR_I_FFD + TR_I_DSA_IN + 2 * TR_I_CMP + 16 * TR_I_UK1 + 16 * TR_I_UV1 + 16 * TR_I_MG1 + 8 * TR_I_MD1;
__device__ __forceinline__ void tr_decode(const Args& A, unsigned char* ws, int it, TrItem& T) {
    int r = it;
    if (r < TR_I_NSA_IN) { tr_set(T, A.in[2], DM, NSA_N, NSA_NPAD, (bf16*)(ws + WS_W_NSA_IN), 0, r); return; } r -= TR_I_NSA_IN;
    if (r < TR_I_SQ) { tr_set(T, A.in[9], DM, DM, DM, (bf16*)(ws + WS_W_NSA_OUT), 0, r); return; } r -= TR_I_SQ;
    if (r < TR_I_SQ) { tr_set(T, A.in[14], DM, DM, DM, (bf16*)(ws + WS_W_DSA_OUT), 0, r); return; } r -= TR_I_SQ;
    if (r < TR_I_FFN) { tr_set(T, A.in[15], DM, DFF, DFF, (bf16*)(ws + WS_W_FFN_GU), 1, r); return; } r -= TR_I_FFN;
    if (r < TR_I_FFN) { tr_set(T, A.in[16], DM, DFF, DFF, (bf16*)(ws + WS_W_FFN_GU), 2, r); return; } r -= TR_I_FFN;
    if (r < TR_I_FFD) { tr_set(T, A.in[17], DFF, DM, DM, (bf16*)(ws + WS_W_FFN_DN), 0, r); return; } r -= TR_I_FFD;
    if (r < TR_I_DSA_IN) { tr_set(T, A.in[10], DM, DSA_N, DSA_NPAD, (bf16*)(ws + WS_W_DSA_IN), 0, r); return; } r -= TR_I_DSA_IN;
    if (r < TR_I_CMP) { tr_set(T, A.in[4], 4096, 128, 128, (bf16*)(ws + WS_W_CMPK), 0, r); return; } r -= TR_I_CMP;
    if (r < TR_I_CMP) { tr_set(T, A.in[7], 4096, 128, 128, (bf16*)(ws + WS_W_CMPV), 0, r); return; } r -= TR_I_CMP;
    if (r < 16 * TR_I_UK1) { const int h = r / TR_I_UK1; tr_set(T, A.in[12] + (size_t)h * 128 * 256, 128, 256, 256, (bf16*)(ws + WS_W_UK) + (size_t)h * 256 * 128, 0, r - h * TR_I_UK1); return; } r -= 16 * TR_I_UK1;
    if (r < 16 * TR_I_UV1) { const int h = r / TR_I_UV1; tr_set(T, A.in[13] + (size_t)h * 256 * 128, 256, 128, 128, (bf16*)(ws + WS_W_UV) + (size_t)h * 128 * 256, 0, r - h * TR_I_UV1); return; } r -= 16 * TR_I_UV1;
    if (r < 8 * TR_I_MG1) { const int e = r / TR_I_MG1; tr_set(T, A.in[20] + (size_t)e * DM * DFFE, DM, DFFE, DFFE, (bf16*)(ws + WS_W_MOE_GU + (size_t)e * 2 * DFFE * DM), 1, r - e * TR_I_MG1, 64.f); return; } r -= 8 * TR_I_MG1;
    if (r < 8 * TR_I_MG1) { const int e = r / TR_I_MG1; tr_set(T, A.in[21] + (size_t)e * DM * DFFE, DM, DFFE, DFFE, (bf16*)(ws + WS_W_MOE_GU + (size_t)e * 2 * DFFE * DM), 2, r - e * TR_I_MG1, 64.f); return; } r -= 8 * TR_I_MG1;
    { const int e = r / TR_I_MD1; tr_set(T, A.in[22] + (size_t)e * DFFE * DM, DFFE, DM, DM, (bf16*)(ws + WS_W_MOE_DN + (size_t)e * DM * DFFE), 0, r - e * TR_I_MD1, 256.f); }
}
__device__ __forceinline__ void tr_load(const TrItem& T, f32x4 (&v)[8], int lane) {
    const int kr = lane >> 3, c4 = lane & 7, n = T.n0 + 4 * c4;
#pragma unroll
    for (int i = 0; i < 8; ++i) v[i] = (n < T.N) ? *(const f32x4*)(T.W + (size_t)(T.k0 + 8 * i + kr) * T.N + n) : (f32x4){0.f, 0.f, 0.f, 0.f};
}
__device__ __forceinline__ void tr_store(const TrItem& T, const f32x4 (&v)[8], LAS float* scr, int lane) {
    { const int kr = lane >> 3, c4 = lane & 7;
#pragma unroll
      for (int i = 0; i < 8; ++i) { LAS float* d = scr + (8 * i + kr) * 33 + 4 * c4; d[0] = v[i][0]; d[1] = v[i][1]; d[2] = v[i][2]; d[3] = v[i][3]; } }
    LDS_WAIT(); asm volatile("" ::: "memory");
    const int c = lane & 7;
#pragma unroll
    for (int j = 0; j < 4; ++j) { const int n = (lane >> 3) + 8 * j; const LAS float* s = scr + (8 * c) * 33 + n;
        v4u o; o.x = pg8::cvt_pk_bf16(s[0 * 33], s[1 * 33]); o.y = pg8::cvt_pk_bf16(s[2 * 33], s[3 * 33]); o.z = pg8::cvt_pk_bf16(s[4 * 33], s[5 * 33]); o.w = pg8::cvt_pk_bf16(s[6 * 33], s[7 * 33]);
        *(v4u*)(T.WT + (size_t)(T.drow + n) * T.K + T.k0 + 8 * c) = o; }
    LDS_WAIT(); asm volatile("" ::: "memory");
}

__device__ __forceinline__ void tr_store8(const TrItem& T, const f32x4 (&v)[8], LAS float* scr, int lane) {
    { const int kr = lane >> 3, c4 = lane & 7;
#pragma unroll
      for (int i = 0; i < 8; ++i) { LAS float* d = scr + (8 * i + kr) * 33 + 4 * c4; d[0] = v[i][0]; d[1] = v[i][1]; d[2] = v[i][2]; d[3] = v[i][3]; } }
    LDS_WAIT(); asm volatile("" ::: "memory");
    const int c = lane & 3, nr = lane >> 2; const float sc = T.f8scale;
#pragma unroll
    for (int j = 0; j < 2; ++j) { const int n = nr + 16 * j; const LAS float* s = scr + (16 * c) * 33 + n; int w[4];
#pragma unroll
        for (int q = 0; q < 4; ++q) { w[q] = __builtin_amdgcn_cvt_pk_fp8_f32(s[(4 * q) * 33] * sc, s[(4 * q + 1) * 33] * sc, 0, false); w[q] = __builtin_amdgcn_cvt_pk_fp8_f32(s[(4 * q + 2) * 33] * sc, s[(4 * q + 3) * 33] * sc, w[q], true); }
        v4u o; o.x = (unsigned)w[0]; o.y = (unsigned)w[1]; o.z = (unsigned)w[2]; o.w = (unsigned)w[3];
        *(v4u*)((unsigned char*)T.WT + (size_t)(T.drow + n) * T.K + T.k0 + 16 * c) = o; }
    LDS_WAIT(); asm volatile("" ::: "memory");
}
__device__ __forceinline__ void p0_prologue(Frame& F, const Args& A) {
    LAS float* scr = (LAS float*)(F.lds + RING_OFF + F.wave * 16384);
    unsigned char* ws = A.ws;
    const int gw = F.vcu * NWAVES + F.wave, NGW = F.G * NWAVES, lane = F.lane;
    { TrItem cur, nxt; f32x4 va[8], vb[8]; int it = gw;
      if (it < TR_NITEMS) { tr_decode(A, ws, it, cur); tr_load(cur, va, lane); }
      while (it < TR_NITEMS) {
          int itn = it + NGW; if (itn < TR_NITEMS) { tr_decode(A, ws, itn, nxt); tr_load(nxt, vb, lane); }
          if (cur.f8scale != 0.f) tr_store8(cur, va, scr, lane); else tr_store(cur, va, scr, lane);
          it = itn; if (it >= TR_NITEMS) break;
          itn = it + NGW; if (itn < TR_NITEMS) { tr_decode(A, ws, itn, cur); tr_load(cur, va, lane); }
          if (nxt.f8scale != 0.f) tr_store8(nxt, vb, scr, lane); else tr_store(nxt, vb, scr, lane);
          it = itn;
      } }
    { const float* x = A.in[0]; bf16* xb = (bf16*)(ws + WS_XB); const size_t n8 = (size_t)NTOK * DM / 8;
      for (size_t i = (size_t)F.vcu * 512 + F.tid; i < n8; i += (size_t)F.G * 512) { const f32x4 a = *(const f32x4*)(x + i * 8), b = *(const f32x4*)(x + i * 8 + 4);
          v4u o; o.x = pk2(a[0], a[1]); o.y = pk2(a[2], a[3]); o.z = pk2(b[0], b[1]); o.w = pk2(b[2], b[3]); *(v4u*)(xb + i * 8) = o; } }
    for (int it = gw; it < 64; it += NGW) { const int kv = it >> 5, ch = it & 31; const float* pe = A.in[kv ? 6 : 3]; const float* w1 = A.in[kv ? 7 : 4];
        float s0 = 0.f, s1 = 0.f;
        for (int k = ch * 128; k < ch * 128 + 128; ++k) { const float p = pe[k]; s0 += p * w1[(size_t)k * 128 + lane]; s1 += p * w1[(size_t)k * 128 + 64 + lane]; }
        float* cb = (float*)(ws + WS_CBIAS) + (size_t)(kv * 32 + ch) * 128; cb[lane] = s0; cb[64 + lane] = s1; }
}

typedef short s8v __attribute__((ext_vector_type(8)));
__device__ __forceinline__ s8v ld_frag(const bf16* p) { return *(const s8v*)p; }

__device__ __forceinline__ float gelu_tanh(float x) { const float u = 0.7978845608028654f * (x + 0.044715f * x * x * x); return 0.5f * x * (1.0f + tanhf(u)); }
__device__ __forceinline__ void p2_compress(Frame& F, const Args& A) {
    unsigned char* ws = A.ws; const int lane = F.lane, wid = F.wave, tid = F.tid;
    const bf16* P0 = (const bf16*)(ws + WS_P0);
    LAS float* part = (LAS float*)(F.lds + RING_OFF);
    LAS float* hid = (LAS float*)(F.lds + DSA_SCR);
    LAS float* cbl = hid + 4096;
    if (tid < 256) { const float* cbp = (const float*)(ws + WS_CBIAS) + (size_t)(tid >> 7) * 32 * 128 + (tid & 127); float cb = 0.f; for (int ch = 0; ch < 32; ++ch) cb += cbp[ch * 128]; cbl[tid] = cb; }
    if (F.vcu < 16 && wid == 0) { bf16* zp = (bf16*)(ws + ((F.vcu & 1) ? WS_VCMP : WS_KCMP)) + ((size_t)(F.vcu >> 1) * 512 + 511) * 128; zp[lane] = 0; zp[64 + lane] = 0; }
    __syncthreads();
    const int r16 = lane & 15, kq = lane >> 4;
    for (int it = F.vcu; it < 256; it += F.G) {
        const int kv = it >> 7, tile = it & 127;
        const bf16* W1T = (const bf16*)(ws + (kv ? WS_W_CMPV : WS_W_CMPK));
        const float* w2 = A.in[kv ? 8 : 5];
        bf16* outp = (bf16*)(ws + (kv ? WS_VCMP : WS_KCMP));
        const int colbase = kv ? COL_VC : COL_KC;
        f32x4 acc[2][8];
#pragma unroll
        for (int m = 0; m < 2; ++m)
#pragma unroll
            for (int n = 0; n < 8; ++n) acc[m][n] = (f32x4){0.f, 0.f, 0.f, 0.f};
        const bf16* arow[2];
#pragma unroll
        for (int m = 0; m < 2; ++m) { int R = tile * 32 + m * 16 + r16; if (R > 4087) R = 4087; const int g = R & 3, bn = R >> 2, b = bn / NCMP, n = bn - b * NCMP;
            arow[m] = P0 + (size_t)(b * SEQ + 16 * n) * P0LD + colbase + g * 128 + kq * 8; }
#pragma unroll 2
        for (int kk = 0; kk < 16; ++kk) {
            const int ks = wid * 16 + kk, l = ks >> 2, d0 = (ks & 3) * 32;
            s8v af[2], bfr[8];
#pragma unroll
            for (int m = 0; m < 2; ++m) af[m] = ld_frag(arow[m] + (size_t)l * P0LD + d0);
#pragma unroll
            for (int n = 0; n < 8; ++n) bfr[n] = ld_frag(W1T + (size_t)(n * 16 + r16) * 4096 + ks * 32 + kq * 8);
#pragma unroll
            for (int m = 0; m < 2; ++m)
#pragma unroll
                for (int n = 0; n < 8; ++n) acc[m][n] = __builtin_amdgcn_mfma_f32_16x16x32_bf16(af[m], bfr[n], acc[m][n], 0, 0, 0);
        }
#pragma unroll
        for (int m = 0; m < 2; ++m)
#pragma unroll
            for (int n = 0; n < 8; ++n)
#pragma unroll
                for (int j = 0; j < 4; ++j) part[wid * 4096 + (m * 16 + kq * 4 + j) * 128 + n * 16 + r16] = acc[m][n][j];
        __syncthreads();
        { const int row = tid >> 4, e0 = (tid & 15) * 8; f32x4 s0 = (f32x4){0.f, 0.f, 0.f, 0.f}, s1 = s0;
#pragma unroll
          for (int w = 0; w < 8; ++w) { s0 += *(const LAS f32x4*)(part + w * 4096 + row * 128 + e0); s1 += *(const LAS f32x4*)(part + w * 4096 + row * 128 + e0 + 4); }
#pragma unroll
          for (int j = 0; j < 4; ++j) { hid[row * 128 + e0 + j] = gelu_tanh(s0[j] + cbl[kv * 128 + e0 + j]); hid[row * 128 + e0 + 4 + j] = gelu_tanh(s1[j] + cbl[kv * 128 + e0 + 4 + j]); } }
        __syncthreads();
        { const int rr = tid >> 4, f0 = (tid & 15) * 8, R = tile * 32 + rr; f32x4 o0 = (f32x4){0.f, 0.f, 0.f, 0.f}, o1 = o0;
#pragma unroll 4
          for (int e = 0; e < 128; ++e) { const float hv = hid[rr * 128 + e]; o0 += *(const f32x4*)(w2 + e * 128 + f0) * hv; o1 += *(const f32x4*)(w2 + e * 128 + f0 + 4) * hv; }
          if (R <= 4087) { const int g = R & 3, bn = R >> 2, b = bn / NCMP, n = bn - b * NCMP;
              v4u o; o.x = pk2(o0[0], o0[1]); o.y = pk2(o0[2], o0[3]); o.z = pk2(o1[0], o1[1]); o.w = pk2(o1[2], o1[3]);
              *(v4u*)(outp + ((size_t)(b * 4 + g) * 512 + n) * 128 + f0) = o; } }
        __syncthreads();
    }
}

namespace fa {
typedef float f32x16 __attribute__((ext_vector_type(16)));
typedef short s16x4 __attribute__((ext_vector_type(4)));
typedef unsigned u32x4v __attribute__((ext_vector_type(4)));
constexpr int SHM_K = 16384, SHM_V = 16384;
constexpr int OFF_V = 0, OFF_K = 2 * SHM_V, OFF_WS = 2 * SHM_V + 2 * SHM_K, OFF_LUT = OFF_WS + 8 * 256, OFF_MASK = OFF_LUT + 144 * 16 * 4, OFF_TAB = OFF_MASK + 1024;
constexpr int TABLD = 130;
constexpr float C2 = 1.4426950408889634f, THR = 8.f;
#define FA_KSWZ(row, colB) ((row) * 256 + ((colB) ^ (((row) & 7) << 4)))
#define FA_SBAR() __builtin_amdgcn_sched_barrier(0)
__device__ __forceinline__ int v_st(int k, int c) { const int kk = (k & ~0xC) | ((k & 4) << 1) | ((k & 8) >> 1); return ((kk >> 3) * 4 + (c >> 5)) * 512 + ((kk & 7) * 32 + (c & 31)) * 2; }
__device__ __forceinline__ int v_rd_base(int lane) { return ((lane & 3) << 3) | (((lane >> 2) & 3) << 6) | (((lane >> 4) & 1) << 5) | (((lane >> 5) & 1) << 8); }
constexpr int v_rd_off(int d0, int ks, int half) { return d0 * 512 + ks * 4096 + half * 2048; }
__device__ __forceinline__ int crow(int r, int hi) { return (r & 3) + 8 * (r >> 2) + 4 * hi; }
__device__ __forceinline__ unsigned cvtpk(float lo, float hi) { unsigned r; asm volatile("v_cvt_pk_bf16_f32 %0, %1, %2" : "=v"(r) : "v"(lo), "v"(hi)); return r; }

__device__ __forceinline__ void qkt(f32x16& p0, f32x16& p1, const LAS char* Kb, int r32, int hi, const bf16x8 (&qr)[8], float init) {
#pragma unroll
    for (int r = 0; r < 16; ++r) { p0[r] = init; p1[r] = init; }
    const LAS char* kb[4];
#pragma unroll
    for (int dd = 0; dd < 4; ++dd) kb[dd] = Kb + FA_KSWZ(r32, (dd * 16 + hi * 8) * 2);
#pragma unroll
    for (int d0 = 0; d0 < 8; ++d0) { const LAS char* a = kb[d0 & 3] + (d0 >> 2) * 128;
        const bf16x8 b0 = *(const LAS bf16x8*)a;
        const bf16x8 b1 = *(const LAS bf16x8*)(a + 32 * 256);
        p0 = __builtin_amdgcn_mfma_f32_32x32x16_bf16(b0, qr[d0], p0, 0, 0, 0);
        p1 = __builtin_amdgcn_mfma_f32_32x32x16_bf16(b1, qr[d0], p1, 0, 0, 0); }
}
__device__ __forceinline__ void pv_tile(f32x16 (&o)[4], int vb0, bf16x8 pa0, bf16x8 pa1, bf16x8 pa2, bf16x8 pa3) {
#define FA_TRRD(dst, off) asm volatile("ds_read_b64_tr_b16 %0, %1 offset:%2" : "=&v"(dst) : "v"(vb0), "i"(off) : "memory")
#define FA_PV_D0(d0) do { s16x4 l0, l1, l2, l3, h0, h1, h2, h3; constexpr int b_ = v_rd_off(d0, 0, 0); \
        FA_TRRD(l0, b_); FA_TRRD(h0, b_ + 2048); FA_TRRD(l1, b_ + 4096); FA_TRRD(h1, b_ + 6144); FA_TRRD(l2, b_ + 8192); FA_TRRD(h2, b_ + 10240); FA_TRRD(l3, b_ + 12288); FA_TRRD(h3, b_ + 14336); \
        asm volatile("s_waitcnt lgkmcnt(0)" ::: "memory"); FA_SBAR(); \
        o[d0] = __builtin_amdgcn_mfma_f32_32x32x16_bf16(pa0, (bf16x8){l0[0], l0[1], l0[2], l0[3], h0[0], h0[1], h0[2], h0[3]}, o[d0], 0, 0, 0); \
        o[d0] = __builtin_amdgcn_mfma_f32_32x32x16_bf16(pa1, (bf16x8){l1[0], l1[1], l1[2], l1[3], h1[0], h1[1], h1[2], h1[3]}, o[d0], 0, 0, 0); \
        o[d0] = __builtin_amdgcn_mfma_f32_32x32x16_bf16(pa2, (bf16x8){l2[0], l2[1], l2[2], l2[3], h2[0], h2[1], h2[2], h2[3]}, o[d0], 0, 0, 0); \
        o[d0] = __builtin_amdgcn_mfma_f32_32x32x16_bf16(pa3, (bf16x8){l3[0], l3[1], l3[2], l3[3], h3[0], h3[1], h3[2], h3[3]}, o[d0], 0, 0, 0); } while (0)
    FA_PV_D0(0); FA_PV_D0(1); FA_PV_D0(2); FA_PV_D0(3);
#undef FA_PV_D0
#undef FA_TRRD
}
__device__ __forceinline__ void partialSM(f32x16& p0, f32x16& p1, float& m_reg, float& alpha) {
    float pmax = p0[0];
#pragma unroll
    for (int r = 1; r < 16; ++r) pmax = fmaxf(pmax, p0[r]);
#pragma unroll
    for (int r = 0; r < 16; ++r) pmax = fmaxf(pmax, p1[r]);
    { auto rr = __builtin_amdgcn_permlane32_swap(__float_as_uint(pmax), __float_as_uint(pmax), false, false); pmax = fmaxf(__uint_as_float(rr[0]), __uint_as_float(rr[1])); }
    float mn;
    if (__all(pmax - m_reg <= THR)) { mn = m_reg; alpha = 1.f; }
    else { mn = fmaxf(m_reg, pmax); alpha = __builtin_amdgcn_exp2f((m_reg - mn) * C2); m_reg = mn; }
    const float mnL = -mn * C2;
#pragma unroll
    for (int r = 0; r < 16; ++r) { p0[r] = __builtin_amdgcn_exp2f(fmaf(p0[r], C2, mnL)); p1[r] = __builtin_amdgcn_exp2f(fmaf(p1[r], C2, mnL)); }
}
__device__ __forceinline__ float finishSM(const f32x16& p0, const f32x16& p1, bf16x8& pa0, bf16x8& pa1, bf16x8& pa2, bf16x8& pa3) {
    float ps = 0.f;
#pragma unroll
    for (int r = 0; r < 16; ++r) ps += p0[r];
#pragma unroll
    for (int r = 0; r < 16; ++r) ps += p1[r];
    { auto rr = __builtin_amdgcn_permlane32_swap(__float_as_uint(ps), __float_as_uint(ps), false, false); ps = __uint_as_float(rr[0]) + __uint_as_float(rr[1]); }
#define FA_PK4(P, B_, OUT) do { unsigned a0 = cvtpk(P[B_ + 0], P[B_ + 1]), a1 = cvtpk(P[B_ + 2], P[B_ + 3]); unsigned b0 = cvtpk(P[B_ + 4], P[B_ + 5]), b1 = cvtpk(P[B_ + 6], P[B_ + 7]); \
        auto r0 = __builtin_amdgcn_permlane32_swap(a0, b0, false, false); auto r1 = __builtin_amdgcn_permlane32_swap(a1, b1, false, false); \
        u32x4v w = {r0[0], r1[0], r0[1], r1[1]}; OUT = *reinterpret_cast<bf16x8*>(&w); } while (0)
    FA_PK4(p0, 0, pa0); FA_PK4(p0, 8, pa1); FA_PK4(p1, 0, pa2); FA_PK4(p1, 8, pa3);
#undef FA_PK4
    return ps;
}
__device__ __forceinline__ void rescale(f32x16 (&o)[4], float alpha, LAS float* al_l, int r32, int hi) {
    if (__any(alpha < 1.f)) { if (hi == 0) al_l[r32] = alpha; asm volatile("s_waitcnt lgkmcnt(0)" ::: "memory");
#pragma unroll
        for (int r = 0; r < 16; ++r) { const float a = al_l[crow(r, hi)];
#pragma unroll
            for (int d = 0; d < 4; ++d) o[d][r] *= a; }
        asm volatile("s_waitcnt lgkmcnt(0)" ::: "memory"); }
}
__device__ __forceinline__ void mask_tile(f32x16& p0, f32x16& p1, int dq, unsigned W) {
    const float NEG = -__builtin_inff();
#pragma unroll
    for (int r = 0; r < 16; ++r) { const int c = (r & 3) + 8 * (r >> 2);
        if ((unsigned)(dq - c) >= W) p0[r] = NEG;
        if ((unsigned)(dq - c - 32) >= W) p1[r] = NEG; }
}
__device__ __forceinline__ void mask_all(f32x16& p0, f32x16& p1, bool keep) {
    const float NEG = -__builtin_inff();
#pragma unroll
    for (int r = 0; r < 16; ++r) { p0[r] = keep ? p0[r] : NEG; p1[r] = keep ? p1[r] : NEG; }
}
__device__ __forceinline__ void bias_near(f32x16& p0, f32x16& p1, int dq, int step, const LAS float* lutcol) {
#pragma unroll
    for (int r = 0; r < 16; ++r) { const int c = (r & 3) + 8 * (r >> 2);
        const int d0 = min(max((dq - c) * step, 0), 128), d1 = min(max((dq - c - 32) * step, 0), 128);
        p0[r] += lutcol[d0]; p1[r] += lutcol[d1]; }
}
struct Stage { bf16x8 k0, k1, v0, v1; };
__device__ __forceinline__ void stage_load(Stage& S, const bf16* Kp, const bf16* Vp, size_t ld, int row0, int maxrow, int sr, int sc) {
    const int ra = min(row0 + sr, maxrow), rb = min(row0 + 32 + sr, maxrow);
    S.k0 = *(const bf16x8*)(Kp + (size_t)ra * ld + sc); S.k1 = *(const bf16x8*)(Kp + (size_t)rb * ld + sc);
    S.v0 = *(const bf16x8*)(Vp + (size_t)ra * ld + sc); S.v1 = *(const bf16x8*)(Vp + (size_t)rb * ld + sc);
}
__device__ __forceinline__ void stage_write(const Stage& S, LAS char* Kb, LAS char* Vb, int kws, int vst0, int vst1) {
    *(LAS bf16x8*)(Kb + kws) = S.k0; *(LAS bf16x8*)(Kb + kws + 32 * 256) = S.k1;
    *(LAS bf16x8*)(Vb + vst0) = S.v0; *(LAS bf16x8*)(Vb + vst1) = S.v1;
}
}

struct NsaLane { int wid, lane, r32, hi, ql, j, sr, sc, kws, vst0, vst1, vrd; };
__device__ __forceinline__ NsaLane nsa_lane(const Frame& F) {
    NsaLane L; L.wid = F.wave; L.lane = F.lane; L.r32 = F.lane & 31; L.hi = F.lane >> 5; L.ql = L.r32 >> 2; L.j = L.r32 & 3;
    L.sr = F.tid >> 4; L.sc = (F.tid & 15) * 8; L.kws = FA_KSWZ(L.sr, L.sc * 2); L.vst0 = fa::v_st(L.sr, L.sc); L.vst1 = fa::v_st(32 + L.sr, L.sc); L.vrd = fa::v_rd_base(F.lane);
    return L;
}
__device__ __forceinline__ void nsa_load_q(bf16x8 (&qr)[8], const bf16* P0, int tok0, int g, const NsaLane& L) {
    const bf16* qp = P0 + (size_t)(tok0 + L.wid * 8 + L.ql) * P0LD + (g * 4 + L.j) * 128 + L.hi * 8;
#pragma unroll
    for (int d0 = 0; d0 < 8; ++d0) qr[d0] = *(const bf16x8*)(qp + d0 * 16);
}
__device__ __forceinline__ void nsa_lut(Frame& F, const Args& A) {
    LAS float* lut = (LAS float*)(F.lds + RING_OFF + fa::OFF_LUT);
    for (int i = F.tid; i < 144 * 16; i += 512) { const int n = i >> 4, h = i & 15; lut[h * 144 + n] = A.in[1][rel_bucket(n) * 16 + h]; }
    __syncthreads();
}
template <int MODE>
__device__ __forceinline__ void nsa_store(const fa::f32x16 (&o)[4], float l_reg, LAS float* li_l, const float* GL, float* OACC, bf16* OATT, int tok0, int g, int br, const NsaLane& L) {
    if (L.hi == 0) li_l[L.r32] = l_reg;
    asm volatile("s_waitcnt lgkmcnt(0)" ::: "memory");
    float sc[16];
#pragma unroll
    for (int r = 0; r < 16; ++r) { const int row = fa::crow(r, L.hi), tok = tok0 + L.wid * 8 + (row >> 2), h = g * 4 + (row & 3); sc[r] = GL[(size_t)tok * 48 + h * 3 + br]; }
    float prev[4][16];
    if (MODE != 0) {
#pragma unroll
        for (int r = 0; r < 16; ++r) { const int row = fa::crow(r, L.hi), tok = tok0 + L.wid * 8 + (row >> 2), h = g * 4 + (row & 3); const float* ap = OACC + (size_t)tok * DM + h * 128 + L.r32;
#pragma unroll
            for (int d0 = 0; d0 < 4; ++d0) prev[d0][r] = ap[d0 * 32]; } }
#pragma unroll
    for (int r = 0; r < 16; ++r) { const int row = fa::crow(r, L.hi), tok = tok0 + L.wid * 8 + (row >> 2), h = g * 4 + (row & 3);
        const float l = li_l[row]; const float gl = sc[r];
        const float scl = (l > 0.f) ? __builtin_amdgcn_rcpf(l) / (1.0f + __expf(-gl)) : 0.f;
        float* ap = OACC + (size_t)tok * DM + h * 128 + L.r32;
#pragma unroll
        for (int d0 = 0; d0 < 4; ++d0) { float v = o[d0][r] * scl;
            if (MODE == 0) ap[d0 * 32] = v;
            else if (MODE == 1) ap[d0 * 32] = prev[d0][r] + v;
            else { v += prev[d0][r]; const float vn = __shfl_xor(v, 1); if ((L.r32 & 1) == 0) *(unsigned*)(OATT + (size_t)tok * DM + h * 128 + d0 * 32 + L.r32) = fa::cvtpk(v, vn); } } }
    asm volatile("s_waitcnt lgkmcnt(0)" ::: "memory");
}

__device__ __forceinline__ void p3a_nsa_cmp(Frame& F, const Args& A) {
    unsigned char* ws = A.ws; const NsaLane L = nsa_lane(F);
    const bf16* P0 = (const bf16*)(ws + WS_P0); const bf16* KCB = (const bf16*)(ws + WS_KCMP); const bf16* VCB = (const bf16*)(ws + WS_VCMP);
    const float* GL = (const float*)(ws + WS_GL); float* OACC = (float*)(ws + WS_Z); unsigned* SELM = (unsigned*)(ws + WS_SELM);
    nsa_lut(F, A);
    LAS char* lds = (LAS char*)(F.lds + RING_OFF);
    LAS float* wsf = (LAS float*)(lds + fa::OFF_WS) + L.wid * 64; LAS float* li_l = wsf; LAS float* al_l = wsf + 32;
    const LAS float* lut = (const LAS float*)(lds + fa::OFF_LUT);
    LAS float* tab = (LAS float*)(lds + fa::OFF_TAB);
    for (int ui = 0; ui < 2 * ((512 - F.vcu + F.G - 1) / F.G); ++ui) {
        const int p = F.vcu + (ui >> 1) * F.G, bg = p >> 6, y = p & 63, qb = (ui & 1) ? 127 - y : y, b = bg >> 2, g = bg & 3;
        const int tok0 = b * SEQ + qb * 64;
        bf16x8 qr[8]; nsa_load_q(qr, P0, tok0, g, L);
        const int trow = qb * 64 + L.wid * 8 + L.ql;
        const int h = g * 4 + L.j; const LAS float* lutcol = lut + h * 144; const float bias_far = lutcol[128];
        const int nmaxrow = (trow >= 31) ? (trow - 31) >> 4 : -1;
        const int NT = (4 * qb + 3 + 63) >> 6;
        const bf16* Kg = KCB + (size_t)(b * 4 + g) * 512 * 128; const bf16* Vg = VCB + (size_t)(b * 4 + g) * 512 * 128;
        for (int i = F.tid; i < 64 * fa::TABLD; i += 512) tab[i] = 0.f;
        float m_reg = -1e30f, l_reg = 0.f;
        fa::Stage S;
        const int rem16 = (trow >= 31) ? ((trow - 31) & 15) : 0;
        fa::stage_load(S, Kg, Vg, 128, 0, 511, L.sr, L.sc); asm volatile("s_waitcnt vmcnt(0)" ::: "memory");
        fa::stage_write(S, lds + fa::OFF_K, lds + fa::OFF_V, L.kws, L.vst0, L.vst1);
        __syncthreads();
#pragma unroll 1
        for (int t = 0; t < NT; ++t) {
            const int buf = t & 1;
            if (t + 1 < NT) fa::stage_load(S, Kg, Vg, 128, (t + 1) * 64, 511, L.sr, L.sc);
            fa::f32x16 p0, p1;
            const bool farT = (qb * 64 + L.wid * 8) - 31 - 16 * (t * 64 + 63) >= 128;
            fa::qkt(p0, p1, lds + fa::OFF_K + buf * fa::SHM_K, L.r32, L.hi, qr, farT ? bias_far : 0.f);
            const int dq = nmaxrow - t * 64 - 4 * L.hi;
            if (!farT) fa::bias_near(p0, p1, dq, 16, lutcol + rem16);
            fa::mask_tile(p0, p1, dq, 0x40000000u);
            float alpha; fa::partialSM(p0, p1, m_reg, alpha);
            float ps = 0.f;
#pragma unroll
            for (int r = 0; r < 16; ++r) ps += p0[r] + p1[r];
            { auto rr = __builtin_amdgcn_permlane32_swap(__float_as_uint(ps), __float_as_uint(ps), false, false); ps = __uint_as_float(rr[0]) + __uint_as_float(rr[1]); }
            l_reg = l_reg * alpha + ps;
            if (t + 1 < NT) { asm volatile("s_waitcnt vmcnt(0)" ::: "memory"); fa::stage_write(S, lds + fa::OFF_K + (buf ^ 1) * fa::SHM_K, lds + fa::OFF_V + (buf ^ 1) * fa::SHM_V, L.kws, L.vst0, L.vst1); }
            __syncthreads();
        }
        fa::f32x16 o[4];
#pragma unroll
        for (int d = 0; d < 4; ++d)
#pragma unroll
            for (int r = 0; r < 16; ++r) o[d][r] = 0.f;
        fa::stage_load(S, Kg, Vg, 128, 0, 511, L.sr, L.sc); asm volatile("s_waitcnt vmcnt(0)" ::: "memory");
        fa::stage_write(S, lds + fa::OFF_K, lds + fa::OFF_V, L.kws, L.vst0, L.vst1);
        __syncthreads();
        const float inv_l = (l_reg > 0.f) ? 1.0f / l_reg : 0.f; const float mnL = -m_reg * fa::C2;
#pragma unroll 1
        for (int t = 0; t < NT; ++t) {
            const int buf = t & 1;
            if (t + 1 < NT) fa::stage_load(S, Kg, Vg, 128, (t + 1) * 64, 511, L.sr, L.sc);
            fa::f32x16 p0, p1;
            const bool farT = (qb * 64 + L.wid * 8) - 31 - 16 * (t * 64 + 63) >= 128;
            fa::qkt(p0, p1, lds + fa::OFF_K + buf * fa::SHM_K, L.r32, L.hi, qr, farT ? bias_far : 0.f);
            const int dq = nmaxrow - t * 64 - 4 * L.hi;
            if (!farT) fa::bias_near(p0, p1, dq, 16, lutcol + rem16);
            fa::mask_tile(p0, p1, dq, 0x40000000u);
#pragma unroll
            for (int r = 0; r < 16; ++r) { p0[r] = __builtin_amdgcn_exp2f(fmaf(p0[r], fa::C2, mnL)) * inv_l; p1[r] = __builtin_amdgcn_exp2f(fmaf(p1[r], fa::C2, mnL)) * inv_l; }
            LAS float* tb = tab + (L.wid * 8 + L.ql) * fa::TABLD + t * 16 + L.hi;
#pragma unroll
            for (int half = 0; half < 2; ++half)
#pragma unroll
                for (int gq = 0; gq < 4; ++gq) { const fa::f32x16& pp = half ? p1 : p0;
                    float s4 = pp[4 * gq] + pp[4 * gq + 1] + pp[4 * gq + 2] + 0.5f * pp[4 * gq + 3], cr = 0.5f * pp[4 * gq + 3];
                    s4 += __shfl_xor(s4, 1); s4 += __shfl_xor(s4, 2); cr += __shfl_xor(cr, 1); cr += __shfl_xor(cr, 2);
                    if (L.j == 0) { __hip_atomic_fetch_add(tb + half * 8 + 2 * gq, s4, __ATOMIC_RELAXED, __HIP_MEMORY_SCOPE_WORKGROUP); __hip_atomic_fetch_add(tb + half * 8 + 2 * gq + 1, cr, __ATOMIC_RELAXED, __HIP_MEMORY_SCOPE_WORKGROUP); } }
            bf16x8 a0, a1, a2, a3; (void)fa::finishSM(p0, p1, a0, a1, a2, a3);
            fa::pv_tile(o, (int)(uintptr_t)(lds + fa::OFF_V + buf * fa::SHM_V) + L.vrd, a0, a1, a2, a3);
            if (t + 1 < NT) { asm volatile("s_waitcnt vmcnt(0)" ::: "memory"); fa::stage_write(S, lds + fa::OFF_K + (buf ^ 1) * fa::SHM_K, lds + fa::OFF_V + (buf ^ 1) * fa::SHM_V, L.kws, L.vst0, L.vst1); }
            __syncthreads();
        }
        nsa_store<0>(o, (l_reg > 0.f) ? 1.0f : 0.f, li_l, GL, OACC, nullptr, tok0, g, 0, L);
        __syncthreads();
        {
            bool s0[8], s1[8];
            if (qb < 16) {
#pragma unroll
                for (int qi = 0; qi < 8; ++qi) { s0[qi] = (L.lane <= qb); s1[qi] = false; }
            } else {
                float v0[8], v1[8];
#pragma unroll
                for (int qi = 0; qi < 8; ++qi) { const int ql = L.wid * 8 + qi;
                    v0[qi] = (L.lane >= 1 && L.lane <= qb - 2) ? tab[ql * fa::TABLD + L.lane] : -1.0f; v1[qi] = (L.lane + 64 <= qb - 2) ? tab[ql * fa::TABLD + L.lane + 64] : -1.0f;
                    s0[qi] = (L.lane == 0) || (L.lane == qb) || (L.lane == qb - 1); s1[qi] = (L.lane + 64 == qb) || (L.lane + 64 == qb - 1);
                    if (s0[qi]) v0[qi] = -3e38f; if (s1[qi]) v1[qi] = -3e38f; }
#pragma unroll 1
                for (int k = 0; k < 13; ++k) {
#pragma unroll
                    for (int qi = 0; qi < 8; ++qi) { float bv = v0[qi]; int bi = L.lane; if (v1[qi] > v0[qi]) { bv = v1[qi]; bi = L.lane + 64; }
#pragma unroll
                        for (int of = 1; of < 64; of <<= 1) { const float ov = __shfl_xor(bv, of); const int oi = __shfl_xor(bi, of); if (ov > bv || (ov == bv && oi < bi)) { bv = ov; bi = oi; } }
                        if (bi == L.lane) { v0[qi] = -3e38f; s0[qi] = true; } if (bi == L.lane + 64) { v1[qi] = -3e38f; s1[qi] = true; } } }
            }
#pragma unroll
            for (int qi = 0; qi < 8; ++qi) { const int ql = L.wid * 8 + qi; const unsigned long long b0 = __ballot(s0[qi]), b1 = __ballot(s1[qi]);
                if (L.lane == 0) { uint4 mv; mv.x = (unsigned)b0; mv.y = (unsigned)(b0 >> 32); mv.z = (unsigned)b1; mv.w = (unsigned)(b1 >> 32); *(uint4*)(SELM + ((size_t)(tok0 + ql) * 4 + g) * 4) = mv; } }
        }
        __syncthreads();
    }
}
__device__ __forceinline__ void p3b_nsa_sel(Frame& F, const Args& A) {
    unsigned char* ws = A.ws; const NsaLane L = nsa_lane(F);
    const bf16* P0 = (const bf16*)(ws + WS_P0); const float* GL = (const float*)(ws + WS_GL); float* OACC = (float*)(ws + WS_Z); const unsigned* SELM = (const unsigned*)(ws + WS_SELM);
    nsa_lut(F, A);
    LAS char* lds = (LAS char*)(F.lds + RING_OFF);
    LAS float* wsf = (LAS float*)(lds + fa::OFF_WS) + L.wid * 64; LAS float* li_l = wsf; LAS float* al_l = wsf + 32;
    const LAS float* lut = (const LAS float*)(lds + fa::OFF_LUT);
    for (int ui = 0; ui < 2 * ((512 - F.vcu + F.G - 1) / F.G); ++ui) {
        const int p = F.vcu + (ui >> 1) * F.G, bg = p >> 6, y = p & 63, qb = (ui & 1) ? 127 - y : y, b = bg >> 2, g = bg & 3;
        const int tok0 = b * SEQ + qb * 64;
        bf16x8 qr[8]; nsa_load_q(qr, P0, tok0, g, L);
        const int trow = qb * 64 + L.wid * 8 + L.ql;
        const int h = g * 4 + L.j; const LAS float* lutcol = lut + h * 144; const float bias_far = lutcol[128];
        const uint4 mv = *(const uint4*)(SELM + ((size_t)(tok0 + L.wid * 8 + L.ql) * 4 + g) * 4);
        const bf16* Kg = P0 + (size_t)b * SEQ * P0LD + COL_KS + g * 128; const bf16* Vg = P0 + (size_t)b * SEQ * P0LD + COL_VS + g * 128;
        const int NT = qb + 1;
        float m_reg = -1e30f, l_reg = 0.f; fa::f32x16 o[4];
#pragma unroll
        for (int d = 0; d < 4; ++d)
#pragma unroll
            for (int r = 0; r < 16; ++r) o[d][r] = 0.f;
        fa::Stage S;
        fa::stage_load(S, Kg, Vg, P0LD, 0, SEQ - 1, L.sr, L.sc); asm volatile("s_waitcnt vmcnt(0)" ::: "memory");
        fa::stage_write(S, lds + fa::OFF_K, lds + fa::OFF_V, L.kws, L.vst0, L.vst1);
        __syncthreads();
#pragma unroll 1
        for (int t = 0; t < NT; ++t) {
            const int buf = t & 1;
            if (t + 1 < NT) fa::stage_load(S, Kg, Vg, P0LD, (t + 1) * 64, SEQ - 1, L.sr, L.sc);
            const unsigned word = (t < 32) ? mv.x : (t < 64) ? mv.y : (t < 96) ? mv.z : mv.w;
            const bool mine = ((word >> (t & 31)) & 1u) != 0u;
            if (__any(mine)) {
            fa::f32x16 p0, p1;
            const bool farT = (qb * 64 + L.wid * 8) - (t * 64 + 63) >= 128;
            fa::qkt(p0, p1, lds + fa::OFF_K + buf * fa::SHM_K, L.r32, L.hi, qr, farT ? bias_far : 0.f);
            const int dq = trow - t * 64 - 4 * L.hi;
            if (!farT) fa::bias_near(p0, p1, dq, 1, lutcol);
            fa::mask_all(p0, p1, mine);
            if (t == qb) fa::mask_tile(p0, p1, dq, 0x40000000u);
            float alpha; fa::partialSM(p0, p1, m_reg, alpha);
            fa::rescale(o, alpha, al_l, L.r32, L.hi);
            bf16x8 a0, a1, a2, a3; const float ps = fa::finishSM(p0, p1, a0, a1, a2, a3); l_reg = l_reg * alpha + ps;
            fa::pv_tile(o, (int)(uintptr_t)(lds + fa::OFF_V + buf * fa::SHM_V) + L.vrd, a0, a1, a2, a3);
            }
            if (t + 1 < NT) { asm volatile("s_waitcnt vmcnt(0)" ::: "memory"); fa::stage_write(S, lds + fa::OFF_K + (buf ^ 1) * fa::SHM_K, lds + fa::OFF_V + (buf ^ 1) * fa::SHM_V, L.kws, L.vst0, L.vst1); }
            __syncthreads();
        }
        nsa_store<1>(o, l_reg, li_l, GL, OACC, nullptr, tok0, g, 1, L);
        __syncthreads();
    }
}
__device__ __forceinline__ void p3c_nsa_win(Frame& F, const Args& A) {
    unsigned char* ws = A.ws; const NsaLane L = nsa_lane(F);
    const bf16* P0 = (const bf16*)(ws + WS_P0); const float* GL = (const float*)(ws + WS_GL); float* OACC = (float*)(ws + WS_Z); bf16* OATT = (bf16*)(ws + WS_OATT0);
    nsa_lut(F, A);
    LAS char* lds = (LAS char*)(F.lds + RING_OFF);
    LAS float* wsf = (LAS float*)(lds + fa::OFF_WS) + L.wid * 64; LAS float* li_l = wsf; LAS float* al_l = wsf + 32;
    const LAS float* lut = (const LAS float*)(lds + fa::OFF_LUT);
    for (int u = F.vcu; u < 1024; u += F.G) {
        const int bg = u >> 7, qb = u & 127, b = bg >> 2, g = bg & 3;
        const int tok0 = b * SEQ + qb * 64;
        bf16x8 qr[8]; nsa_load_q(qr, P0, tok0, g, L);
        const int trow = qb * 64 + L.wid * 8 + L.ql;
        const int h = g * 4 + L.j; const LAS float* lutcol = lut + h * 144; const float bias_far = lutcol[128];
        const bf16* Kg = P0 + (size_t)b * SEQ * P0LD + COL_KW + g * 128; const bf16* Vg = P0 + (size_t)b * SEQ * P0LD + COL_VW + g * 128;
        const int t0 = max(0, qb - 8), NT = qb - t0 + 1;
        float m_reg = -1e30f, l_reg = 0.f; fa::f32x16 o[4];
#pragma unroll
        for (int d = 0; d < 4; ++d)
#pragma unroll
            for (int r = 0; r < 16; ++r) o[d][r] = 0.f;
        fa::Stage S;
        fa::stage_load(S, Kg, Vg, P0LD, t0 * 64, SEQ - 1, L.sr, L.sc); asm volatile("s_waitcnt vmcnt(0)" ::: "memory");
        fa::stage_write(S, lds + fa::OFF_K, lds + fa::OFF_V, L.kws, L.vst0, L.vst1);
        __syncthreads();
#pragma unroll 1
        for (int tt = 0; tt < NT; ++tt) {
            const int buf = tt & 1, t = t0 + tt;
            if (tt + 1 < NT) fa::stage_load(S, Kg, Vg, P0LD, (t + 1) * 64, SEQ - 1, L.sr, L.sc);
            fa::f32x16 p0, p1;
            const bool farT = (qb * 64 + L.wid * 8) - (t * 64 + 63) >= 128;
            fa::qkt(p0, p1, lds + fa::OFF_K + buf * fa::SHM_K, L.r32, L.hi, qr, farT ? bias_far : 0.f);
            const int dq = trow - t * 64 - 4 * L.hi;
            if (!farT) fa::bias_near(p0, p1, dq, 1, lutcol);
            if (t == qb || t == t0) fa::mask_tile(p0, p1, dq, 512u);
            float alpha; fa::partialSM(p0, p1, m_reg, alpha);
            fa::rescale(o, alpha, al_l, L.r32, L.hi);
            bf16x8 a0, a1, a2, a3; const float ps = fa::finishSM(p0, p1, a0, a1, a2, a3); l_reg = l_reg * alpha + ps;
            fa::pv_tile(o, (int)(uintptr_t)(lds + fa::OFF_V + buf * fa::SHM_V) + L.vrd, a0, a1, a2, a3);
            if (tt + 1 < NT) { asm volatile("s_waitcnt vmcnt(0)" ::: "memory"); fa::stage_write(S, lds + fa::OFF_K + (buf ^ 1) * fa::SHM_K, lds + fa::OFF_V + (buf ^ 1) * fa::SHM_V, L.kws, L.vst0, L.vst1); }
            __syncthreads();
        }
        nsa_store<2>(o, l_reg, li_l, GL, OACC, OATT, tok0, g, 2, L);
        __syncthreads();
    }
}

template <bool ROUTE>
__device__ __forceinline__ void ln_phase(Frame& F, const Args& A, const float* Z, const float* gam, const float* bet, float* XF, bf16* XB) {
    const int gw = F.vcu * NWAVES + F.wave, NGW = F.G * NWAVES, lane = F.lane;
    LAS float* wrl = (LAS float*)(F.lds + RING_OFF);
    if (ROUTE) { for (int i = F.tid; i < DM * 8 / 4; i += 512) *(LAS f32x4*)(wrl + i * 4) = *(const f32x4*)(A.in[18] + i * 4); __syncthreads(); }
    for (int row = gw; row < NTOK; row += NGW) {
        const f32x4* zr = (const f32x4*)(Z + (size_t)row * DM) + lane;
        f32x4 v[8]; float s = 0.f;
#pragma unroll
        for (int j = 0; j < 8; ++j) { v[j] = zr[64 * j]; s += (v[j][0] + v[j][1]) + (v[j][2] + v[j][3]); }
        const float mean = wave_sum(s) * (1.f / DM); float s2 = 0.f;
#pragma unroll
        for (int j = 0; j < 8; ++j) { v[j] = v[j] - mean; s2 += (v[j][0] * v[j][0] + v[j][1] * v[j][1]) + (v[j][2] * v[j][2] + v[j][3] * v[j][3]); }
        const float rstd = 1.f / sqrtf(wave_sum(s2) * (1.f / DM) + LN_EPS);
        float lg[8];
#pragma unroll
        for (int e = 0; e < 8; ++e) lg[e] = 0.f;
#pragma unroll
        for (int j = 0; j < 8; ++j) { const int c = 4 * lane + 256 * j; const f32x4 gg = *(const f32x4*)(gam + c), bb = *(const f32x4*)(bet + c);
            const f32x4 x = v[j] * rstd * gg + bb;
            *(f32x4*)(XF + (size_t)row * DM + c) = x;
            uint2 o; o.x = pk2(x[0], x[1]); o.y = pk2(x[2], x[3]); *(uint2*)(XB + (size_t)row * DM + c) = o;
            asm volatile("" ::: "memory");
            if (ROUTE) { const LAS float* wr = wrl + c * 8;
#pragma unroll
                for (int q = 0; q < 4; ++q) { const f32x4 w0 = *(const LAS f32x4*)(wr + q * 8), w1 = *(const LAS f32x4*)(wr + q * 8 + 4);
                    lg[0] += x[q] * w0[0]; lg[1] += x[q] * w0[1]; lg[2] += x[q] * w0[2]; lg[3] += x[q] * w0[3]; lg[4] += x[q] * w1[0]; lg[5] += x[q] * w1[1]; lg[6] += x[q] * w1[2]; lg[7] += x[q] * w1[3]; }  asm volatile("" ::: "memory"); }
        }
        if (ROUTE) {
#pragma unroll
            for (int e = 0; e < 8; ++e) lg[e] = wave_sum(lg[e]) + A.in[19][e];
            int e0 = 0; float l0 = lg[0];
#pragma unroll
            for (int e = 1; e < 8; ++e) if (lg[e] > l0) { l0 = lg[e]; e0 = e; }
            int e1 = -1; float l1 = -3e38f;
#pragma unroll
            for (int e = 0; e < 8; ++e) if (e != e0 && lg[e] > l1) { l1 = lg[e]; e1 = e; }
            const float w0 = 1.0f / (1.0f + __expf(l1 - l0)), w1 = 1.0f - w0;
            if (lane == 0) {
                const unsigned p0 = __hip_atomic_fetch_add((unsigned*)(F.ctl + CW_MOECNT + 64 * e0), 1u, __ATOMIC_RELAXED, __HIP_MEMORY_SCOPE_AGENT);
                const unsigned p1 = __hip_atomic_fetch_add((unsigned*)(F.ctl + CW_MOECNT + 64 * e1), 1u, __ATOMIC_RELAXED, __HIP_MEMORY_SCOPE_AGENT);
                int* re = (int*)(A.ws + WS_ROUTE); int* rp = re + 2 * NTOK; float* rw = (float*)(rp + 2 * NTOK);
                re[2 * row] = e0; re[2 * row + 1] = e1; rp[2 * row] = (int)p0; rp[2 * row + 1] = (int)p1; rw[2 * row] = w0; rw[2 * row + 1] = w1;
            }
        }
    }
}

__device__ __forceinline__ void ln_route_phase(Frame& F, const Args& A, const float* Z, const float* gam, const float* bet, float* XF, bf16* XB) {
    const int gw = F.vcu * NWAVES + F.wave, NGW = F.G * NWAVES, lane = F.lane;
    LAS float* wrl = (LAS float*)(F.lds + RING_OFF);
    LAS float* rowb = (LAS float*)(F.lds + RING_OFF + 65536 + F.wave * 8192);
    for (int i = F.tid; i < DM * 8 / 4; i += 512) *(LAS f32x4*)(wrl + i * 4) = *(const f32x4*)(A.in[18] + i * 4);
    __syncthreads();
    for (int row = gw; row < NTOK; row += NGW) {
        float s = 0.f, s2 = 0.f;
#pragma unroll 1
        for (int j = 0; j < 8; ++j) { const f32x4 v = *(const f32x4*)(Z + (size_t)row * DM + 4 * lane + 256 * j); *(LAS f32x4*)(rowb + 4 * lane + 256 * j) = v;
            s += (v[0] + v[1]) + (v[2] + v[3]); }
        const float mean = wave_sum(s) * (1.f / DM);
#pragma unroll 1
        for (int j = 0; j < 8; ++j) { const f32x4 v = *(const LAS f32x4*)(rowb + 4 * lane + 256 * j) - mean; s2 += (v[0] * v[0] + v[1] * v[1]) + (v[2] * v[2] + v[3] * v[3]); }
        const float rstd = 1.f / sqrtf(wave_sum(s2) * (1.f / DM) + LN_EPS);
        float lg[8];
#pragma unroll
        for (int e = 0; e < 8; ++e) lg[e] = 0.f;
#pragma unroll 1
        for (int j = 0; j < 8; ++j) { const int c = 4 * lane + 256 * j; const f32x4 gg = *(const f32x4*)(gam + c), bb = *(const f32x4*)(bet + c);
            const f32x4 x = (*(const LAS f32x4*)(rowb + c) - mean) * rstd * gg + bb;
            *(f32x4*)(XF + (size_t)row * DM + c) = x;
            uint2 o; o.x = pk2(x[0], x[1]); o.y = pk2(x[2], x[3]); *(uint2*)(XB + (size_t)row * DM + c) = o;
            const LAS float* wr = wrl + c * 8;
#pragma unroll
            for (int q = 0; q < 4; ++q) { const f32x4 w0 = *(const LAS f32x4*)(wr + q * 8), w1 = *(const LAS f32x4*)(wr + q * 8 + 4);
                lg[0] += x[q] * w0[0]; lg[1] += x[q] * w0[1]; lg[2] += x[q] * w0[2]; lg[3] += x[q] * w0[3]; lg[4] += x[q] * w1[0]; lg[5] += x[q] * w1[1]; lg[6] += x[q] * w1[2]; lg[7] += x[q] * w1[3]; } }
#pragma unroll
        for (int e = 0; e < 8; ++e) lg[e] = wave_sum(lg[e]) + A.in[19][e];
        int e0 = 0; float l0 = lg[0];
#pragma unroll
        for (int e = 1; e < 8; ++e) if (lg[e] > l0) { l0 = lg[e]; e0 = e; }
        int e1 = -1; float l1 = -3e38f;
#pragma unroll
        for (int e = 0; e < 8; ++e) if (e != e0 && lg[e] > l1) { l1 = lg[e]; e1 = e; }
        const float w0 = 1.0f / (1.0f + __expf(l1 - l0)), w1 = 1.0f - w0;
        if (lane == 0) {
            const unsigned p0 = __hip_atomic_fetch_add((unsigned*)(F.ctl + CW_MOECNT + 64 * e0), 1u, __ATOMIC_RELAXED, __HIP_MEMORY_SCOPE_AGENT);
            const unsigned p1 = __hip_atomic_fetch_add((unsigned*)(F.ctl + CW_MOECNT + 64 * e1), 1u, __ATOMIC_RELAXED, __HIP_MEMORY_SCOPE_AGENT);
            int* re = (int*)(A.ws + WS_ROUTE); int* rp = re + 2 * NTOK; float* rw = (float*)(rp + 2 * NTOK);
            re[2 * row] = e0; re[2 * row + 1] = e1; rp[2 * row] = (int)p0; rp[2 * row + 1] = (int)p1; rw[2 * row] = w0; rw[2 * row + 1] = w1;
        }
        WSYNC();
    }
    __syncthreads();
}

__device__ __forceinline__ void p10_dsa_prep(Frame& F, const Args& A) {
    unsigned char* ws = A.ws; const int lane = F.lane;
    const int gw = F.vcu * NWAVES + F.wave, NGW = F.G * NWAVES;
    { const float* CR = (const float*)(ws + WS_CRAW); bf16* CN = (bf16*)(ws + WS_CN); const f32x4 gg = *(const f32x4*)(A.in[11] + 4 * lane);
      for (int row = gw; row < NTOK; row += NGW) { const f32x4 v = *(const f32x4*)(CR + (size_t)row * KVR + 4 * lane);
          const float ss = wave_sum(v[0] * v[0] + v[1] * v[1] + v[2] * v[2] + v[3] * v[3]); const float r = 1.f / sqrtf(ss * (1.f / KVR) + RMS_EPS);
          uint2 o; o.x = pk2(v[0] * r * gg[0], v[1] * r * gg[1]); o.y = pk2(v[2] * r * gg[2], v[3] * r * gg[3]); *(uint2*)(CN + (size_t)row * KVR + 4 * lane) = o;
          if (lane < 16) { const f32x4 kv = *(const f32x4*)((const float*)(ws + WS_KIWI) + (size_t)row * 128 + 4 * lane); uint2 k2; k2.x = pk2(kv[0], kv[1]); k2.y = pk2(kv[2], kv[3]); *(uint2*)((bf16*)(ws + WS_KIB) + (size_t)row * 64 + 4 * lane) = k2; } } }
    const bf16* Q = (const bf16*)(ws + WS_Q); const bf16* UKT = (const bf16*)(ws + WS_W_UK); bf16* QL = (bf16*)(ws + WS_QLAT);
    const int r16 = lane & 15, kq = lane >> 4; const float sc = 0.08838834764831845f;
    for (int it = gw; it < 512 * 16 * 4; it += NGW) {
        const int nc = it & 3, h = (it >> 2) & 15, mt = it >> 6;
        f32x4 acc[2][4];
#pragma unroll
        for (int m = 0; m < 2; ++m)
#pragma unroll
            for (int n = 0; n < 4; ++n) acc[m][n] = (f32x4){0.f, 0.f, 0.f, 0.f};
#pragma unroll
        for (int ks = 0; ks < 4; ++ks) { s8v af[2], bfr[4];
#pragma unroll
            for (int m = 0; m < 2; ++m) af[m] = ld_frag(Q + (size_t)(mt * 32 + m * 16 + r16) * DM + h * 128 + ks * 32 + kq * 8);
#pragma unroll
            for (int n = 0; n < 4; ++n) bfr[n] = ld_frag(UKT + ((size_t)h * 256 + nc * 64 + n * 16 + r16) * 128 + ks * 32 + kq * 8);
#pragma unroll
            for (int m = 0; m < 2; ++m)
#pragma unroll
                for (int n = 0; n < 4; ++n) acc[m][n] = __builtin_amdgcn_mfma_f32_16x16x32_bf16(af[m], bfr[n], acc[m][n], 0, 0, 0); }
#pragma unroll
        for (int m = 0; m < 2; ++m)
#pragma unroll
            for (int n = 0; n < 4; ++n)
#pragma unroll
                for (int j = 0; j < 4; ++j) QL[(size_t)(mt * 32 + m * 16 + kq * 4 + j) * 4096 + h * 256 + nc * 64 + n * 16 + r16] = (bf16)f2bf(acc[m][n][j] * sc);
    }
}
__device__ __forceinline__ void p12_dsa_uv(Frame& F, const Args& A) {
    unsigned char* ws = A.ws; const int lane = F.lane;
    const int gw = F.vcu * NWAVES + F.wave, NGW = F.G * NWAVES;
    const bf16* OL = (const bf16*)(ws + WS_OLAT); const bf16* UVT = (const bf16*)(ws + WS_W_UV); bf16* O = (bf16*)(ws + WS_OATT1);
    const int r16 = lane & 15, kq = lane >> 4;
    for (int it = gw; it < 512 * 16 * 2; it += NGW) {
        const int nc = it & 1, h = (it >> 1) & 15, mt = it >> 5;
        f32x4 acc[2][4];
#pragma unroll
        for (int m = 0; m < 2; ++m)
#pragma unroll
            for (int n = 0; n < 4; ++n) acc[m][n] = (f32x4){0.f, 0.f, 0.f, 0.f};
#pragma unroll
        for (int ks = 0; ks < 8; ++ks) { s8v af[2], bfr[4];
#pragma unroll
            for (int m = 0; m < 2; ++m) af[m] = ld_frag(OL + (size_t)(mt * 32 + m * 16 + r16) * 4096 + h * 256 + ks * 32 + kq * 8);
#pragma unroll
            for (int n = 0; n < 4; ++n) bfr[n] = ld_frag(UVT + ((size_t)h * 128 + nc * 64 + n * 16 + r16) * 256 + ks * 32 + kq * 8);
#pragma unroll
            for (int m = 0; m < 2; ++m)
#pragma unroll
                for (int n = 0; n < 4; ++n) acc[m][n] = __builtin_amdgcn_mfma_f32_16x16x32_bf16(af[m], bfr[n], acc[m][n], 0, 0, 0); }
#pragma unroll
        for (int m = 0; m < 2; ++m)
#pragma unroll
            for (int n = 0; n < 4; ++n)
#pragma unroll
                for (int j = 0; j < 4; ++j) O[(size_t)(mt * 32 + m * 16 + kq * 4 + j) * DM + h * 128 + nc * 64 + n * 16 + r16] = (bf16)f2bf(acc[m][n][j]);
    }
}

__device__ __forceinline__ unsigned f2key(float f) { const unsigned u = __float_as_uint(f); return (u & 0x80000000u) ? ~u : (u | 0x80000000u); }

__device__ __forceinline__ unsigned dsa_off_b(unsigned row, unsigned ch) { return 256u * row + 16u * (ch ^ (((row & 3) << 2) | ((row >> 2) & 3))); }

__device__ __forceinline__ void p13a_dsa_index(Frame& F, const Args& A) {
    unsigned char* ws = A.ws; const int lane = F.lane, wid = F.wave, r32 = lane & 31, hi = lane >> 5;
    const bf16* QI = (const bf16*)(ws + WS_QI); const bf16* KIB = (const bf16*)(ws + WS_KIB); const float* KIWI = (const float*)(ws + WS_KIWI); int* IDX = (int*)(ws + WS_IDX);
    LAS float* sc = (LAS float*)(F.lds + RING_OFF);
    LAS unsigned* hist = (LAS unsigned*)(F.lds + DSA_SCR);
    LAS unsigned* cntG = hist + 1024;
    LAS unsigned* cntE = cntG + 512;
    LAS unsigned* qm = cntE + 512;
    const int q = wid >> 1, sub = wid & 1, th = sub * 64 + lane;
    for (int slot = F.vcu; slot < NTOK / 4; slot += F.G) {
        const int rowi = slot >> 8; int cc = slot & 255; if (rowi & 1) cc = 255 - cc;
        const int tok0 = (rowi * 256 + cc) * 4, b = tok0 >> 13, t0 = tok0 & (SEQ - 1), tmax = t0 + 3;
        bf16x8 qa[4];
#pragma unroll
        for (int s = 0; s < 4; ++s) qa[s] = *(const bf16x8*)(QI + (size_t)(tok0 + (r32 >> 3)) * 512 + (r32 & 7) * 64 + 16 * s + 8 * hi);
        float wv[16];
#pragma unroll
        for (int r = 0; r < 16; ++r) wv[r] = KIWI[(size_t)(tok0 + (r >> 2)) * 128 + 64 + (r & 3) + 4 * hi] * 0.35355339059327373f;
        const int ntiles = (tmax >> 5) + 1;
#ifndef PROBE_IDX2
#define PROBE_IDX2 0
#endif
#ifndef PROBE_SEL2
#define PROBE_SEL2 0
#endif
        for (int rep2_ = 0; rep2_ < (PROBE_IDX2 ? 2 : 1); ++rep2_)
        {
            bf16x8 kb[4], kn[4]; int tile = wid;
#pragma unroll
            for (int s = 0; s < 4; ++s) kb[s] = (bf16x8){0, 0, 0, 0, 0, 0, 0, 0};
            if (tile < ntiles) { const bf16* kp = KIB + (size_t)(b * SEQ + tile * 32 + r32) * 64 + 8 * hi;
#pragma unroll
                for (int s = 0; s < 4; ++s) kb[s] = *(const bf16x8*)(kp + 16 * s); }
#pragma unroll
            for (int s = 0; s < 4; ++s) kn[s] = (bf16x8){0, 0, 0, 0, 0, 0, 0, 0};
            while (tile < ntiles) {
                const int tn = tile + 8;
                if (tn < ntiles) { const bf16* kp = KIB + (size_t)(b * SEQ + tn * 32 + r32) * 64 + 8 * hi;
#pragma unroll
                    for (int s = 0; s < 4; ++s) kn[s] = *(const bf16x8*)(kp + 16 * s); }
                const int key = tile * 32 + r32;
                fa::f32x16 acc;
#pragma unroll
                for (int r = 0; r < 16; ++r) acc[r] = 0.f;
#pragma unroll
                for (int s = 0; s < 4; ++s) acc = __builtin_amdgcn_mfma_f32_32x32x16_bf16(qa[s], kb[s], acc, 0, 0, 0);
#pragma unroll
                for (int qq = 0; qq < 4; ++qq) { float part = 0.f;
#pragma unroll
                    for (int r3 = 0; r3 < 4; ++r3) part += wv[4 * qq + r3] * fmaxf(acc[4 * qq + r3], 0.f);
                    const float tot = part + __shfl_xor(part, 32);
                    if ((qq >> 1) == hi) sc[qq * 8192 + key] = tot + 0.0f; }
#pragma unroll
                for (int s = 0; s < 4; ++s) kb[s] = kn[s];
                tile = tn;
            }
        }
        __syncthreads();
        const int tok = tok0 + q, n = t0 + q + 1;
        for (int rep3_ = 0; rep3_ < (PROBE_SEL2 ? 2 : 1); ++rep3_) {
        if (tmax + 1 <= TOPK) {
            for (int i = th; i < TOPK; i += 128) IDX[(size_t)tok * TOPK + i] = (i < n) ? i : 0;
        } else {
            const LAS float* scq = sc + q * 8192; const int nsl = (n + 127) >> 7;
#ifndef PROBE_T2
#define PROBE_T2 0
#endif
#ifndef PROBE_C2
#define PROBE_C2 0
#endif
            unsigned T_out = 0u, need_out = 0u;
            for (int repa_ = 0; repa_ < (PROBE_T2 ? 2 : 1); ++repa_) { if (repa_) __syncthreads();
            unsigned mnv = 0xffffffffu, mxv = 0u;
#pragma unroll 4
            for (int s2 = 0; s2 < nsl; ++s2) { const int i = s2 * 128 + th; if (i < n) { const unsigned k = f2key(scq[i]); mnv = min(mnv, k); mxv = max(mxv, k); } }
#pragma unroll
            for (int o = 1; o < 64; o <<= 1) { mnv = min(mnv, (unsigned)__shfl_xor((int)mnv, o)); mxv = max(mxv, (unsigned)__shfl_xor((int)mxv, o)); }
            if (lane == 0) { qm[q * 16 + 4 + sub * 2] = mnv; qm[q * 16 + 5 + sub * 2] = mxv; }
            __syncthreads();
            mnv = min(qm[q * 16 + 4], qm[q * 16 + 6]); mxv = max(qm[q * 16 + 5], qm[q * 16 + 7]);
            unsigned need = TOPK; unsigned long long inb = 0ull;
            const float fmn = __uint_as_float((mnv & 0x80000000u) ? (mnv & 0x7fffffffu) : ~mnv), fmx = __uint_as_float((mxv & 0x80000000u) ? (mxv & 0x7fffffffu) : ~mxv);
            const float bsc = (fmx > fmn) ? 255.99f / (fmx - fmn) : 0.f;
            hist[q * 256 + th] = 0u; hist[q * 256 + 128 + th] = 0u;
            __syncthreads();
#pragma unroll 4
            for (int s2 = 0; s2 < nsl; ++s2) { const int i = s2 * 128 + th; if (i < n) { const int bin = min(max((int)((scq[i] + 0.0f - fmn) * bsc), 0), 255);
                __hip_atomic_fetch_add(&hist[q * 256 + bin], 1u, __ATOMIC_RELAXED, __HIP_MEMORY_SCOPE_WORKGROUP); } }
            __syncthreads();
            if (sub == 0) {
                const v4u c4 = *(const LAS v4u*)(hist + q * 256 + 4 * lane); const unsigned s4 = c4.x + c4.y + c4.z + c4.w; unsigned S = s4;
#pragma unroll
                for (int o = 1; o < 64; o <<= 1) { const unsigned v = __shfl_down(S, o); if (lane + o < 64) S += v; }
                const unsigned above = S - s4;
                if (above < need && need <= S) { unsigned cum = above; int bin;
                    if (cum + c4.w >= need) bin = 3; else { cum += c4.w; if (cum + c4.z >= need) bin = 2; else { cum += c4.z; if (cum + c4.y >= need) bin = 1; else { cum += c4.y; bin = 0; } } }
                    qm[q * 16 + 0] = (unsigned)(4 * lane + bin); qm[q * 16 + 1] = need - cum; }
            }
            __syncthreads();
            { const int bstar = (int)qm[q * 16 + 0]; need = qm[q * 16 + 1];
#pragma unroll 4
              for (int s2 = 0; s2 < nsl; ++s2) { const int i = s2 * 128 + th; if (i < n) { const int bin = min(max((int)((scq[i] + 0.0f - fmn) * bsc), 0), 255); if (bin == bstar) inb |= (1ull << s2); } } }
            int hib = 32; unsigned pmask = 0u, prefix = 0u;
#pragma unroll 1
            for (int pass = 0; pass < 4; ++pass) {
                const int lob = hib - 8; const unsigned dmask = 255u;
                hist[q * 256 + th] = 0u; hist[q * 256 + 128 + th] = 0u;
                __syncthreads();
                for (int s2 = 0; s2 < nsl; ++s2) { if ((inb >> s2) & 1ull) { const unsigned k = f2key(scq[s2 * 128 + th]); if ((k & pmask) == prefix) __hip_atomic_fetch_add(&hist[q * 256 + ((k >> lob) & dmask)], 1u, __ATOMIC_RELAXED, __HIP_MEMORY_SCOPE_WORKGROUP); } }
                __syncthreads();
                if (sub == 0) {
                    const v4u c4 = *(const LAS v4u*)(hist + q * 256 + 4 * lane); const unsigned s4 = c4.x + c4.y + c4.z + c4.w; unsigned S = s4;
#pragma unroll
                    for (int o = 1; o < 64; o <<= 1) { const unsigned v = __shfl_down(S, o); if (lane + o < 64) S += v; }
                    const unsigned above = S - s4;
                    if (above < need && need <= S) { unsigned cum = above; int bin;
                        if (cum + c4.w >= need) bin = 3; else { cum += c4.w; if (cum + c4.z >= need) bin = 2; else { cum += c4.z; if (cum + c4.y >= need) bin = 1; else { cum += c4.y; bin = 0; } } }
                        qm[q * 16 + 0] = prefix | ((unsigned)(4 * lane + bin) << lob); qm[q * 16 + 1] = need - cum; }
                }
                __syncthreads();
                prefix = qm[q * 16 + 0]; need = qm[q * 16 + 1]; pmask |= (dmask << lob); hib = lob;
            }
            T_out = prefix; need_out = need; }
            const unsigned T = T_out; const unsigned need = need_out;
            for (int repc_ = 0; repc_ < (PROBE_C2 ? 2 : 1); ++repc_) { if (repc_) __syncthreads();
            unsigned myG = 0u, myE = 0u;
#pragma unroll 4
            for (int s2 = 0; s2 < nsl; ++s2) { const int i = s2 * 128 + th; const bool ok = i < n; const unsigned k = ok ? f2key(scq[i]) : 0u; const unsigned long long bg = __ballot(ok && k > T), be = __ballot(ok && k == T);
                const unsigned cg = (unsigned)__popcll(bg), ce = (unsigned)__popcll(be); myG = (lane == s2) ? cg : myG; myE = (lane == s2) ? ce : myE; }
            cntG[(q * 2 + sub) * 64 + lane] = myG; cntE[(q * 2 + sub) * 64 + lane] = myE;
            __syncthreads();
            unsigned tbase, pbase;
            { const unsigned e0 = cntE[(q * 2) * 64 + lane], e1 = cntE[(q * 2 + 1) * 64 + lane], g0 = cntG[(q * 2) * 64 + lane], g1 = cntG[(q * 2 + 1) * 64 + lane];
              unsigned inc = e0 + e1;
#pragma unroll
              for (int o = 1; o < 64; o <<= 1) { const unsigned v = __shfl_up(inc, o); if (lane >= o) inc += v; }
              const unsigned tb0 = inc - (e0 + e1), tb1 = tb0 + e0;
              const unsigned se0 = (need > tb0) ? min(need - tb0, e0) : 0u, se1 = (need > tb1) ? min(need - tb1, e1) : 0u;
              const unsigned c0 = g0 + se0, c1 = g1 + se1; unsigned inc2 = c0 + c1;
#pragma unroll
              for (int o = 1; o < 64; o <<= 1) { const unsigned v = __shfl_up(inc2, o); if (lane >= o) inc2 += v; }
              const unsigned pb0 = inc2 - (c0 + c1);
              tbase = sub ? tb1 : tb0; pbase = sub ? pb0 + c0 : pb0; }
#pragma unroll 4
            for (int s2 = 0; s2 < nsl; ++s2) { const int i = s2 * 128 + th; const bool ok = i < n; const unsigned k = ok ? f2key(scq[i]) : 0u; const bool g = ok && k > T, e = ok && k == T;
                const unsigned long long be = __ballot(e);
                const unsigned trank = (unsigned)__builtin_amdgcn_readlane((int)tbase, s2) + __builtin_amdgcn_mbcnt_hi((unsigned)(be >> 32), __builtin_amdgcn_mbcnt_lo((unsigned)be, 0u));
                const bool sel = g || (e && trank < need);
                const unsigned long long bs = __ballot(sel);
                const unsigned pos = (unsigned)__builtin_amdgcn_readlane((int)pbase, s2) + __builtin_amdgcn_mbcnt_hi((unsigned)(bs >> 32), __builtin_amdgcn_mbcnt_lo((unsigned)bs, 0u));
                if (sel && pos < (unsigned)TOPK) IDX[(size_t)tok * TOPK + pos] = i; }
            }
        }
        __syncthreads();
        }
    }
}

__device__ __forceinline__ void p13b_dsa_attn(Frame& F, const Args& A) {
    unsigned char* ws = A.ws; const int lane = F.lane, wid = F.wave, c16 = lane & 15, g4 = lane >> 4;
    const bf16* CN = (const bf16*)(ws + WS_CN); const bf16* QL = (const bf16*)(ws + WS_QLAT); const int* IDX = (const int*)(ws + WS_IDX); bf16* OL = (bf16*)(ws + WS_OLAT);
    LAS float* lut = (LAS float*)(F.lds + DSA_SCR + 8192);
    for (int i = F.tid; i < 144 * 16; i += 512) { const int n = i >> 4, h = i & 15; lut[i] = A.in[1][rel_bucket(n) * 16 + h]; }
    __syncthreads();
    LAS char* img = (LAS char*)(F.lds + RING_OFF + wid * 16384);
    LAS int* idxw = (LAS int*)(F.lds + DSA_SCR + wid * 1024);
    const unsigned imgb = (unsigned)(uintptr_t)img;
    const int gw = F.vcu * NWAVES + wid, NGW = F.G * NWAVES;
    const unsigned prow0 = 8u * ((lane >> 2) & 3) + (lane & 3);
    unsigned ta0[8], ta1[8];
    { const unsigned qq = (lane & 15) >> 2, pp = lane & 3;
#pragma unroll
      for (int c = 0; c < 8; ++c) { ta0[c] = imgb + dsa_off_b(8 * g4 + qq, 2 * c + (pp >> 1)) + 8 * (pp & 1); ta1[c] = imgb + dsa_off_b(8 * g4 + 4 + qq, 2 * c + (pp >> 1)) + 8 * (pp & 1); } }
    for (int tok = gw; tok < NTOK; tok += NGW) {
        const int b = tok >> 13, t = tok & (SEQ - 1), cnt = min(TOPK, t + 1), ntile = (cnt + 31) >> 5;
        bf16x8 qb[8];
#pragma unroll
        for (int ks = 0; ks < 8; ++ks) qb[ks] = *(const bf16x8*)(QL + (size_t)tok * 4096 + c16 * 256 + ks * 32 + g4 * 8);
#pragma unroll
        for (int i = 0; i < 4; ++i) idxw[lane + 64 * i] = IDX[(size_t)tok * TOPK + lane + 64 * i];
        WSYNC();
        f32x4 o[16];
#pragma unroll
        for (int ct = 0; ct < 16; ++ct) o[ct] = (f32x4){0.f, 0.f, 0.f, 0.f};
        float m_run = -1e30f, l_run = 0.f;
        const LAS float* lutcol = lut + c16;
#pragma unroll 1
        for (int tile = 0; tile < ntile; ++tile) {
            { v4u st[16];
#pragma unroll
              for (int i = 0; i < 16; ++i) { const int nn = lane + 64 * i, row = nn >> 5, chg = nn & 31; const int key = idxw[tile * 32 + row];
                  st[i] = *(const v4u*)(CN + (size_t)(b * SEQ + key) * KVR + chg * 8); }
#pragma unroll
              for (int i = 0; i < 16; ++i) { const int nn = lane + 64 * i, row = nn >> 5, chg = nn & 31;
                  *(LAS v4u*)(img + (chg >> 4) * 8192 + dsa_off_b(row, chg & 15)) = st[i]; } }
            WSYNC();
            f32x4 sacc[2];
#pragma unroll
            for (int T = 0; T < 2; ++T) { sacc[T] = (f32x4){0.f, 0.f, 0.f, 0.f};
#pragma unroll
                for (int ks = 0; ks < 8; ++ks) { const bf16x8 a = *(const LAS bf16x8*)(img + (ks >> 2) * 8192 + dsa_off_b(prow0 + 4 * T, 4 * (ks & 3) + g4));
                    sacc[T] = __builtin_amdgcn_mfma_f32_16x16x32_bf16(a, qb[ks], sacc[T], 0, 0, 0); } }
            float pmax = -__builtin_inff();
#pragma unroll
            for (int T = 0; T < 2; ++T) { const int i0 = tile * 32 + 8 * g4 + 4 * T; const v4u kk = *(const LAS v4u*)(idxw + i0);
                const int kidx[4] = {(int)kk.x, (int)kk.y, (int)kk.z, (int)kk.w};
#pragma unroll
                for (int e = 0; e < 4; ++e) { const int dist = min(max(t - kidx[e], 0), 128); float s = sacc[T][e] + lutcol[dist * 16];
                    s = (i0 + e < cnt) ? s : -__builtin_inff(); sacc[T][e] = s; pmax = fmaxf(pmax, s); } }
            pmax = fmaxf(pmax, __shfl_xor(pmax, 16)); pmax = fmaxf(pmax, __shfl_xor(pmax, 32));
            const float mn = fmaxf(m_run, pmax), alpha = __builtin_amdgcn_exp2f((m_run - mn) * fa::C2); m_run = mn;
            float ps = 0.f;
#pragma unroll
            for (int T = 0; T < 2; ++T)
#pragma unroll
                for (int e = 0; e < 4; ++e) { const float pv = __builtin_amdgcn_exp2f((sacc[T][e] - mn) * fa::C2); sacc[T][e] = pv; ps += pv; }
            ps += __shfl_xor(ps, 16); ps += __shfl_xor(ps, 32);
            l_run = l_run * alpha + ps;
            if (__any(alpha < 1.f)) {
                float al[4];
#pragma unroll
                for (int e = 0; e < 4; ++e) al[e] = __shfl(alpha, 4 * g4 + e);
#pragma unroll
                for (int ct = 0; ct < 16; ++ct)
#pragma unroll
                    for (int e = 0; e < 4; ++e) o[ct][e] *= al[e];
            }
            fa::u32x4v pw; pw.x = fa::cvtpk(sacc[0][0], sacc[0][1]); pw.y = fa::cvtpk(sacc[0][2], sacc[0][3]); pw.z = fa::cvtpk(sacc[1][0], sacc[1][1]); pw.w = fa::cvtpk(sacc[1][2], sacc[1][3]);
            const bf16x8 pa = *reinterpret_cast<bf16x8*>(&pw);
#pragma unroll
            for (int cg = 0; cg < 4; ++cg) { fa::s16x4 b0[4], b1[4];
                asm volatile("ds_read_b64_tr_b16 %0, %8 offset:%c16\n\tds_read_b64_tr_b16 %1, %9 offset:%c16\n\tds_read_b64_tr_b16 %2, %10 offset:%c16\n\tds_read_b64_tr_b16 %3, %11 offset:%c16\n\t"
                             "ds_read_b64_tr_b16 %4, %12 offset:%c16\n\tds_read_b64_tr_b16 %5, %13 offset:%c16\n\tds_read_b64_tr_b16 %6, %14 offset:%c16\n\tds_read_b64_tr_b16 %7, %15 offset:%c16\n\ts_waitcnt lgkmcnt(0)"
                             : "=&v"(b0[0]), "=&v"(b1[0]), "=&v"(b0[1]), "=&v"(b1[1]), "=&v"(b0[2]), "=&v"(b1[2]), "=&v"(b0[3]), "=&v"(b1[3])
                             : "v"(ta0[(cg & 1) * 4 + 0]), "v"(ta1[(cg & 1) * 4 + 0]), "v"(ta0[(cg & 1) * 4 + 1]), "v"(ta1[(cg & 1) * 4 + 1]), "v"(ta0[(cg & 1) * 4 + 2]), "v"(ta1[(cg & 1) * 4 + 2]), "v"(ta0[(cg & 1) * 4 + 3]), "v"(ta1[(cg & 1) * 4 + 3]), "i"((cg >> 1) * 8192) : "memory");
                FA_SBAR();
#pragma unroll
                for (int k = 0; k < 4; ++k) o[cg * 4 + k] = __builtin_amdgcn_mfma_f32_16x16x32_bf16(pa, (bf16x8){b0[k][0], b0[k][1], b0[k][2], b0[k][3], b1[k][0], b1[k][1], b1[k][2], b1[k][3]}, o[cg * 4 + k], 0, 0, 0); }
            WSYNC();
        }
        { const float il = (l_run > 0.f) ? 1.0f / l_run : 0.f; float ile[4];
#pragma unroll
          for (int e = 0; e < 4; ++e) ile[e] = __shfl(il, 4 * g4 + e);
#pragma unroll
          for (int ct = 0; ct < 16; ++ct)
#pragma unroll
              for (int e = 0; e < 4; ++e) { const float v = o[ct][e] * ile[e]; const float vn = __shfl_xor(v, 1);
                  if ((lane & 1) == 0) *(unsigned*)(OL + (size_t)tok * 4096 + (4 * g4 + e) * 256 + ct * 16 + c16) = fa::cvtpk(v, vn); } }
        WSYNC();
    }
    __syncthreads();
}

struct MoeTiles { int tend[8]; int pstart[8]; int MT; };
__device__ __forceinline__ void moe_tiles(Frame& F, MoeTiles& T) {
    int acc = 0;
#pragma unroll
    for (int e = 0; e < 8; ++e) { const int c = (int)__builtin_amdgcn_readfirstlane(__hip_atomic_load((unsigned*)(F.ctl + CW_MOECNT + 64 * e), __ATOMIC_RELAXED, __HIP_MEMORY_SCOPE_AGENT));
        T.pstart[e] = acc * 256; acc += (c + 255) >> 8; T.tend[e] = acc; }
    T.MT = acc;
}
__device__ __forceinline__ void p15_gather(Frame& F, const Args& A) {
    MoeTiles T; moe_tiles(F, T);
    const int gw = F.vcu * NWAVES + F.wave, NGW = F.G * NWAVES, lane = F.lane;
    const float* XF = (const float*)(A.ws + WS_XF); unsigned char* XG = (unsigned char*)(A.ws + WS_XG);
    const int* re = (const int*)(A.ws + WS_ROUTE); const int* rp = re + 2 * NTOK;
    for (int tok = gw; tok < NTOK; tok += NGW) {
        v4u v[2];
#pragma unroll
        for (int j = 0; j < 2; ++j) { const float* src = XF + (size_t)tok * DM + 16 * lane + 1024 * j; int w[4];
#pragma unroll
            for (int q = 0; q < 4; ++q) { const f32x4 x = *(const f32x4*)(src + 4 * q); w[q] = __builtin_amdgcn_cvt_pk_fp8_f32(x[0], x[1], 0, false); w[q] = __builtin_amdgcn_cvt_pk_fp8_f32(x[2], x[3], w[q], true); }
            v[j].x = (unsigned)w[0]; v[j].y = (unsigned)w[1]; v[j].z = (unsigned)w[2]; v[j].w = (unsigned)w[3]; }
#pragma unroll
        for (int s = 0; s < 2; ++s) { const int e = re[2 * tok + s], p = rp[2 * tok + s]; int ps = 0;
#pragma unroll
            for (int q = 0; q < 8; ++q) ps = (q == e) ? T.pstart[q] : ps;
            unsigned char* dst = XG + (size_t)(ps + p) * DM + 16 * lane;
#pragma unroll
            for (int j = 0; j < 2; ++j) *(v4u*)(dst + 1024 * j) = v[j]; }
    }
}
__device__ __forceinline__ void p18_final(Frame& F, const Args& A) {
    MoeTiles T; moe_tiles(F, T);
    const int gw = F.vcu * NWAVES + F.wave, NGW = F.G * NWAVES, lane = F.lane;
    const float* XF = (const float*)(A.ws + WS_XF); const float* Y = (const float*)(A.ws + WS_Y);
    const int* re = (const int*)(A.ws + WS_ROUTE); const int* rp = re + 2 * NTOK; const float* rw = (const float*)(rp + 2 * NTOK);
    const float* gam = A.in[25] + DM; const float* bet = A.in[26] + DM;
    for (int tok = gw; tok < NTOK; tok += NGW) {
        int rows[2]; float w[2];
#pragma unroll
        for (int s = 0; s < 2; ++s) { const int e = re[2 * tok + s]; int ps = 0;
#pragma unroll
            for (int q = 0; q < 8; ++q) ps = (q == e) ? T.pstart[q] : ps;
            rows[s] = ps + rp[2 * tok + s]; w[s] = rw[2 * tok + s]; }
        const f32x4* xr = (const f32x4*)(XF + (size_t)tok * DM) + lane; const f32x4* y0 = (const f32x4*)(Y + (size_t)rows[0] * DM) + lane; const f32x4* y1 = (const f32x4*)(Y + (size_t)rows[1] * DM) + lane;
        f32x4 v[8]; float s = 0.f;
#pragma unroll
        for (int j = 0; j < 8; ++j) { v[j] = xr[64 * j] * ALPHA + y0[64 * j] * w[0] + y1[64 * j] * w[1]; s += (v[j][0] + v[j][1]) + (v[j][2] + v[j][3]); }
        const float mean = wave_sum(s) * (1.f / DM); float s2 = 0.f;
#pragma unroll
        for (int j = 0; j < 8; ++j) { v[j] = v[j] - mean; s2 += (v[j][0] * v[j][0] + v[j][1] * v[j][1]) + (v[j][2] * v[j][2] + v[j][3] * v[j][3]); }
        const float rstd = 1.f / sqrtf(wave_sum(s2) * (1.f / DM) + LN_EPS);
#pragma unroll
        for (int j = 0; j < 8; ++j) { const int c = 4 * lane + 256 * j; const f32x4 gg = *(const f32x4*)(gam + c), bb = *(const f32x4*)(bet + c);
            *(f32x4*)(A.out + (size_t)tok * DM + c) = v[j] * rstd * gg + bb; }
    }
}

__global__ void __launch_bounds__(NWAVES * 64, 2) mega_fwd(Args args) {
    extern __shared__ __attribute__((aligned(16))) unsigned char lds[];
    Frame F;
    F.lds = (LAS unsigned char*)lds;
    F.MISC = (volatile LAS unsigned*)(F.lds + MISC_OFF);
    F.tid = threadIdx.x; F.lane = F.tid & 63; F.wave = __builtin_amdgcn_readfirstlane(F.tid >> 6);
    F.G = gridDim.x; { const int bx = blockIdx.x; F.vcu = (F.G % 8 == 0) ? (bx % 8) * (F.G / 8) + bx / 8 : bx; }
    unsigned char* ws = args.ws;
    F.ctl = (gu32*)(ws + WS_CTL);
    for (int u = F.tid; u < (LDS_BYTES - LDSCTL_OFF) / 4; u += NWAVES * 64) ((LAS unsigned*)(F.lds + LDSCTL_OFF))[u] = 0u;
    __syncthreads();
    XcdBarrier bar; bar.bar = (unsigned*)(F.ctl + CW_BAR); bar.x = 0; bar.st = nullptr;
#if !MK_PER_PHASE
    bar = xcd_barrier_post((unsigned*)(F.ctl + CW_BAR), F.MISC + 8);
#define GRID_BAR() xcd_barrier(bar)
#else
#define GRID_BAR() do { } while (0)
#endif
    const int lo = args.ph_lo, hi = args.ph_hi;
#ifndef PH_MASK
#define PH_MASK 0x3fffff
#endif
#define IN(k) (((PH_MASK >> (k)) & 1) && lo <= (k) && (k) < hi)
#define BOTH(k) (IN(k) && IN((k) + 1))
    bf16* XB = (bf16*)(ws + WS_XB); float* XF = (float*)(ws + WS_XF); float* Z = (float*)(ws + WS_Z);

#ifndef PROBE_MASK
#define PROBE_MASK 0
#endif
#define REPS(k) ((((PROBE_MASK) >> (k)) & 1) ? 2 : 1)
    if (IN(0)) for (int rep_ = 0; rep_ < REPS(0); ++rep_) { relaunder(F); p0_prologue(F, args); if (BOTH(0) || rep_ + 1 < REPS(0)) GRID_BAR(); }
    if (IN(1)) for (int rep_ = 0; rep_ < REPS(1); ++rep_) { relaunder(F);
        pg8::Gemm g{XB, (const bf16*)(ws + WS_W_NSA_IN), NTOK, NSA_NPAD, DM}; pg8::StaticOrder S; S.init(NTOK, NSA_NPAD, F.G, (int)blockIdx.x);
        pg8::EpiNsaIn E{(bf16*)(ws + WS_P0), (float*)(ws + WS_GL), 0.08838834764831845f};
        pg8::gemm_phase<pg8::EpiNsaIn, pg8::StaticOrder, true, true>(F.lds + RING_OFF, g, S, E);
        if (BOTH(1) || rep_ + 1 < REPS(1)) GRID_BAR();
    }
    if (IN(2)) for (int rep_ = 0; rep_ < REPS(2); ++rep_) { relaunder(F); p2_compress(F, args); if (BOTH(2) || rep_ + 1 < REPS(2)) GRID_BAR(); }
#ifndef PROBE_NSA2
#define PROBE_NSA2 0
#endif
    for (int repn_ = 0; repn_ < (PROBE_NSA2 ? 2 : 1); ++repn_) {
    if (IN(3)) for (int rep_ = 0; rep_ < REPS(3); ++rep_) { relaunder(F); p3a_nsa_cmp(F, args); if (BOTH(3) || rep_ + 1 < REPS(3)) GRID_BAR(); }
    if (IN(4)) for (int rep_ = 0; rep_ < REPS(4); ++rep_) { relaunder(F); p3b_nsa_sel(F, args); if (BOTH(4) || rep_ + 1 < REPS(4) || repn_ + 1 < (PROBE_NSA2 ? 2 : 1)) GRID_BAR(); }
    }
    if (IN(5)) for (int rep_ = 0; rep_ < REPS(5); ++rep_) { relaunder(F); p3c_nsa_win(F, args); if (BOTH(5) || rep_ + 1 < REPS(5)) GRID_BAR(); }
    if (IN(6)) for (int rep_ = 0; rep_ < REPS(6); ++rep_) { relaunder(F);
        pg8::Gemm g{(const bf16*)(ws + WS_OATT0), (const bf16*)(ws + WS_W_NSA_OUT), NTOK, DM, DM}; pg8::StaticOrder S; S.init(NTOK, DM, F.G, (int)blockIdx.x);
        pg8::EpiResF32 E{args.in[0], Z, ALPHA, DM};
        pg8::gemm_phase<pg8::EpiResF32, pg8::StaticOrder, true, true>(F.lds + RING_OFF, g, S, E);
        if (BOTH(6) || rep_ + 1 < REPS(6)) GRID_BAR();
    }
    if (IN(7)) for (int rep_ = 0; rep_ < REPS(7); ++rep_) { relaunder(F); ln_phase<false>(F, args, Z, args.in[23], args.in[24], XF, XB); if (BOTH(7) || rep_ + 1 < REPS(7)) GRID_BAR(); }
    if (IN(8)) for (int rep_ = 0; rep_ < REPS(8); ++rep_) { relaunder(F);
        pg8::Gemm g{XB, (const bf16*)(ws + WS_W_FFN_GU), NTOK, 2 * DFF, DM}; pg8::StaticOrder S; S.init(NTOK, 2 * DFF, F.G, (int)blockIdx.x);
        pg8::EpiSwiGLU E{(bf16*)(ws + WS_HFF), DFF};
        pg8::gemm_phase<pg8::EpiSwiGLU, pg8::StaticOrder, true, true>(F.lds + RING_OFF, g, S, E);
        if (BOTH(8) || rep_ + 1 < REPS(8)) GRID_BAR();
    }
    if (IN(9)) for (int rep_ = 0; rep_ < REPS(9); ++rep_) { relaunder(F);
        pg8::Gemm g{(const bf16*)(ws + WS_HFF), (const bf16*)(ws + WS_W_FFN_DN), NTOK, DM, DFF}; pg8::StaticOrder S; S.init(NTOK, DM, F.G, (int)blockIdx.x);
        pg8::EpiResF32 E{XF, Z, ALPHA, DM};
        pg8::gemm_phase<pg8::EpiResF32, pg8::StaticOrder, true, true>(F.lds + RING_OFF, g, S, E);
        if (BOTH(9) || rep_ + 1 < REPS(9)) GRID_BAR();
    }
    if (IN(10)) for (int rep_ = 0; rep_ < REPS(10); ++rep_) { relaunder(F); ln_phase<false>(F, args, Z, args.in[25], args.in[26], XF, XB); if (BOTH(10) || rep_ + 1 < REPS(10)) GRID_BAR(); }
    if (IN(11)) for (int rep_ = 0; rep_ < REPS(11); ++rep_) { relaunder(F);
        pg8::Gemm g{XB, (const bf16*)(ws + WS_W_DSA_IN), NTOK, DSA_NPAD, DM}; pg8::StaticOrder S; S.init(NTOK, DSA_NPAD, F.G, (int)blockIdx.x);
        pg8::EpiDsaIn E{(bf16*)(ws + WS_Q), (float*)(ws + WS_CRAW), (bf16*)(ws + WS_QI), (float*)(ws + WS_KIWI), 0.125f};
        pg8::gemm_phase<pg8::EpiDsaIn, pg8::StaticOrder, true, true>(F.lds + RING_OFF, g, S, E);
        if (BOTH(11) || rep_ + 1 < REPS(11)) GRID_BAR();
    }
    if (IN(12)) for (int rep_ = 0; rep_ < REPS(12); ++rep_) { relaunder(F); p10_dsa_prep(F, args); if (BOTH(12) || rep_ + 1 < REPS(12)) GRID_BAR(); }
    if (IN(13)) for (int rep_ = 0; rep_ < REPS(13); ++rep_) { relaunder(F); p13a_dsa_index(F, args); if (BOTH(13) || rep_ + 1 < REPS(13)) GRID_BAR(); }
    if (IN(14)) for (int rep_ = 0; rep_ < REPS(14); ++rep_) { relaunder(F); p13b_dsa_attn(F, args); if (BOTH(14) || rep_ + 1 < REPS(14)) GRID_BAR(); }
    if (IN(15)) for (int rep_ = 0; rep_ < REPS(15); ++rep_) { relaunder(F); p12_dsa_uv(F, args); if (BOTH(15) || rep_ + 1 < REPS(15)) GRID_BAR(); }
    if (IN(16)) for (int rep_ = 0; rep_ < REPS(16); ++rep_) { relaunder(F);
        pg8::Gemm g{(const bf16*)(ws + WS_OATT1), (const bf16*)(ws + WS_W_DSA_OUT), NTOK, DM, DM}; pg8::StaticOrder S; S.init(NTOK, DM, F.G, (int)blockIdx.x);
        pg8::EpiResF32 E{XF, Z, ALPHA, DM};
        pg8::gemm_phase<pg8::EpiResF32, pg8::StaticOrder, true, true>(F.lds + RING_OFF, g, S, E);
        if (BOTH(16) || rep_ + 1 < REPS(16)) GRID_BAR();
    }
    if (IN(17)) for (int rep_ = 0; rep_ < REPS(17); ++rep_) { relaunder(F); ln_route_phase(F, args, Z, args.in[23] + DM, args.in[24] + DM, XF, XB); if (BOTH(17) || rep_ + 1 < REPS(17)) GRID_BAR(); }
    if (IN(18)) for (int rep_ = 0; rep_ < REPS(18); ++rep_) { relaunder(F); p15_gather(F, args); if (BOTH(18) || rep_ + 1 < REPS(18)) GRID_BAR(); }
    if (IN(19)) for (int rep_ = 0; rep_ < REPS(19); ++rep_) { relaunder(F);
        MoeTiles T; moe_tiles(F, T);
        pg8::Gemm g{(const bf16*)(ws + WS_XG), (const bf16*)(ws + WS_W_MOE_GU), T.MT * 256, 2 * DFFE, DM, 1, 0x79797979}; pg8::MoeOrder S; S.init(T.MT * 256, 2 * DFFE, F.G, (int)blockIdx.x); S.nexp_rows = 2 * DFFE;
#pragma unroll
        for (int e = 0; e < 8; ++e) S.tend[e] = T.tend[e];
        pg8::EpiSwiGLU8 E{(unsigned char*)(ws + WS_HM), DFFE};
        pg8::gemm_phase<pg8::EpiSwiGLU8, pg8::MoeOrder, true, true, true>(F.lds + RING_OFF, g, S, E);
        if (BOTH(19) || rep_ + 1 < REPS(19)) GRID_BAR();
    }
    if (IN(20)) for (int rep_ = 0; rep_ < REPS(20); ++rep_) { relaunder(F);
        MoeTiles T; moe_tiles(F, T);
        pg8::Gemm g{(const bf16*)(ws + WS_HM), (const bf16*)(ws + WS_W_MOE_DN), T.MT * 256, DM, DFFE, 1, 0x77777777}; pg8::MoeOrder S; S.init(T.MT * 256, DM, F.G, (int)blockIdx.x); S.nexp_rows = DM;
#pragma unroll
        for (int e = 0; e < 8; ++e) S.tend[e] = T.tend[e];
        pg8::EpiF32 E{(float*)(ws + WS_Y), DM};
        pg8::gemm_phase<pg8::EpiF32, pg8::MoeOrder, true, true, true>(F.lds + RING_OFF, g, S, E);
        if (BOTH(20) || rep_ + 1 < REPS(20)) GRID_BAR();
    }
    if (IN(21)) for (int rep_ = 0; rep_ < REPS(21); ++rep_) { relaunder(F); p18_final(F, args); }
#undef IN
#undef BOTH
}

extern "C" void kernel_launch(void* const* d_in, const int* in_sizes, int n_in, void* d_out, int out_size, void* d_ws, size_t ws_size, hipStream_t stream) {
    static int grid = 0;
    if (grid == 0) {
        if (n_in != 27 || out_size != NTOK * DM || ws_size < WS_END) { fprintf(stderr, "kernel_launch: unexpected shapes (n_in %d, out %d, ws %zu); nothing launched\n", n_in, out_size, ws_size); grid = -1; return; }
        int dev = 0, cus = 0, per_cu = 0;
        if (hipGetDevice(&dev) != hipSuccess || hipDeviceGetAttribute(&cus, hipDeviceAttributeMultiprocessorCount, dev) != hipSuccess) { grid = -1; return; }
        if (hipFuncSetAttribute((const void*)mega_fwd, hipFuncAttributeMaxDynamicSharedMemorySize, LDS_BYTES) != hipSuccess) { fprintf(stderr, "kernel_launch: hipFuncSetAttribute failed\n"); grid = -1; return; }
        if (hipOccupancyMaxActiveBlocksPerMultiprocessor(&per_cu, (const void*)mega_fwd, NWAVES * 64, LDS_BYTES) != hipSuccess || per_cu < 1) { fprintf(stderr, "kernel_launch: occupancy query says %d\n", per_cu); }
        (void)hipGetLastError();
        grid = cus;
    }
    if (grid < 0) return;
    if (hipMemsetAsync((char*)d_ws + WS_CTL, 0, CTL_ZERO_BYTES, stream) != hipSuccess) return;
    Args a{};
    for (int i = 0; i < 27; ++i) a.in[i] = (const float*)d_in[i];
    a.out = (float*)d_out; a.ws = (unsigned char*)d_ws;
#if MK_PER_PHASE
    for (int p = 0; p < NPHASE; ++p) { a.ph_lo = p; a.ph_hi = p + 1; hipLaunchKernelGGL(mega_fwd, dim3(grid), dim3(NWAVES * 64), LDS_BYTES, stream, a); }
#else
    a.ph_lo = 0; a.ph_hi = NPHASE;
    hipLaunchKernelGGL(mega_fwd, dim3(grid), dim3(NWAVES * 64), LDS_BYTES, stream, a);
#endif
}
```

```cpp
#include <hip/hip_runtime.h>
#include <cstdio>
#include <cstdint>
namespace pg8 {
#define PG8_LAS __attribute__((address_space(3)))
typedef unsigned short bf16_t;
typedef short bf16x8 __attribute__((ext_vector_type(8)));
typedef float f32x4 __attribute__((ext_vector_type(4)));
typedef unsigned u32x4 __attribute__((ext_vector_type(4)));
constexpr int BM = 256, BK = 64, HALF = 128, HTB = HALF * BK * 2  , STAGE_BYTES = 8 * HTB, NXCD = 8, WGM = 8;

__host__ __device__ __forceinline__ int lds_byte(int r, int c) { const int st = (r >> 4) * 2 + (c >> 5), rr = r & 15, cc = c & 31, ob = rr * 64 + cc * 2; return st * 1024 + (ob ^ (((ob >> 9) & 1) << 5)); }
__host__ __device__ __forceinline__ void stage_rc(int b, int& R, int& C) { const int st = b / 1024, sb = b % 1024, swz = sb ^ (((sb >> 9) & 1) << 5); R = (st >> 1) * 16 + swz / 64; C = (st & 1) * 32 + (swz % 64) / 2; }
__host__ __device__ __forceinline__ int perm32(int rho) { const int n = rho >> 4, i = rho & 15; return 8 * (i >> 2) + 4 * n + (i & 3); }

struct Unit { int pm, pn; };
struct Gemm { const bf16_t* A; const bf16_t* Bt; int M, N, K; int esz = 2; int scale = 0x7f7f7f7f; };

struct StaticOrder {
    int nM, nN, nwg, G, c;
    __host__ __device__ void init(int M, int N, int G_, int c_) { nM = M / BM; nN = N / BM; nwg = nM * nN; G = G_; c = c_; }
    __host__ __device__ bool next(int i, Unit& u) const {
        const long L = (long)i * G + c; if (L >= nwg) return false;
        int wgid = (int)L; { const int q = nwg / NXCD, r = nwg % NXCD, xcd = wgid % NXCD, off = wgid / NXCD; wgid = (xcd < r ? xcd * (q + 1) : r * (q + 1) + (xcd - r) * q) + off; }
        const int nig = WGM * nN, gid = wgid / nig, fm = gid * WGM, gsz = (nM - fm) < WGM ? (nM - fm) : WGM;
        u.pm = fm + ((wgid % nig) % gsz); u.pn = (wgid % nig) / gsz; return true;
    }
    __device__ __forceinline__ void a_ready(const Unit&) const {}
    __device__ __forceinline__ void done(const Unit&) const {}
    __device__ __forceinline__ const char* a_ptr(const Gemm& g, const Unit& u) const { return (const char*)g.A + (size_t)u.pm * ((size_t)BM * g.K * g.esz); }
    __device__ __forceinline__ const char* b_ptr(const Gemm& g, const Unit& u) const { return (const char*)g.Bt + (size_t)u.pn * ((size_t)BM * g.K * g.esz); }
};


__device__ __forceinline__ unsigned cvt_pk_bf16(float lo, float hi) { unsigned r; asm volatile("v_cvt_pk_bf16_f32 %0, %1, %2" : "=v"(r) : "v"(lo), "v"(hi)); return r; }
__device__ __forceinline__ u32x4 pack8(const f32x4 v0, const f32x4 v1) { u32x4 w; w.x = cvt_pk_bf16(v0[0], v0[1]); w.y = cvt_pk_bf16(v0[2], v0[3]); w.z = cvt_pk_bf16(v1[0], v1[1]); w.w = cvt_pk_bf16(v1[2], v1[3]); return w; }

struct EpiNsaIn {
    static constexpr bool PERM = true, AFTER_DRAIN = false;
    bf16_t* P0; float* GL; float qscale;
    __device__ __forceinline__ void operator()(const f32x4 (&acc)[2][2][4][2], const Unit& u, int wr, int wc, int fr, int fq) const {
        const int row0 = u.pm * BM + wr * 64 + fr;
        if (u.pn < 20) {
            const float s = u.pn < 8 ? qscale : 1.0f;
            const int col0 = u.pn * BM + wc * 32 + 8 * fq;
#pragma unroll
            for (int ai = 0; ai < 2; ++ai)
#pragma unroll
                for (int m = 0; m < 4; ++m) { bf16_t* rowp = P0 + (size_t)(row0 + ai * HALF + m * 16) * 5120 + col0;
#pragma unroll
                    for (int bj = 0; bj < 2; ++bj) *(u32x4*)(rowp + bj * HALF) = pack8(acc[ai][bj][m][0] * s, acc[ai][bj][m][1] * s); }
        } else {
            const int c = wc * 32 + 8 * fq;
            if (c < 48) {
#pragma unroll
                for (int ai = 0; ai < 2; ++ai)
#pragma unroll
                    for (int m = 0; m < 4; ++m) { float* gp = GL + (size_t)(row0 + ai * HALF + m * 16) * 48 + c;
                        *(f32x4*)gp = acc[ai][0][m][0]; *(f32x4*)(gp + 4) = acc[ai][0][m][1]; }
            }
        }
    }
};
struct EpiDsaIn {
    static constexpr bool PERM = true, AFTER_DRAIN = false;
    bf16_t* Q; float* CRAW; bf16_t* QI; float* KIWI; float qiscale;
    __device__ __forceinline__ void operator()(const f32x4 (&acc)[2][2][4][2], const Unit& u, int wr, int wc, int fr, int fq) const {
        const int row0 = u.pm * BM + wr * 64 + fr; const int c = wc * 32 + 8 * fq;
        if (u.pn < 8) {
#pragma unroll
            for (int ai = 0; ai < 2; ++ai)
#pragma unroll
                for (int m = 0; m < 4; ++m) { bf16_t* rowp = Q + (size_t)(row0 + ai * HALF + m * 16) * 2048 + u.pn * BM + c;
#pragma unroll
                    for (int bj = 0; bj < 2; ++bj) *(u32x4*)(rowp + bj * HALF) = pack8(acc[ai][bj][m][0], acc[ai][bj][m][1]); }
        } else if (u.pn == 8) {
#pragma unroll
            for (int ai = 0; ai < 2; ++ai)
#pragma unroll
                for (int m = 0; m < 4; ++m) { float* rowp = CRAW + (size_t)(row0 + ai * HALF + m * 16) * 256 + c;
#pragma unroll
                    for (int bj = 0; bj < 2; ++bj) { *(f32x4*)(rowp + bj * HALF) = acc[ai][bj][m][0]; *(f32x4*)(rowp + bj * HALF + 4) = acc[ai][bj][m][1]; } }
        } else if (u.pn < 11) {
#pragma unroll
            for (int ai = 0; ai < 2; ++ai)
#pragma unroll
                for (int m = 0; m < 4; ++m) { bf16_t* rowp = QI + (size_t)(row0 + ai * HALF + m * 16) * 512 + (u.pn - 9) * BM + c;
#pragma unroll
                    for (int bj = 0; bj < 2; ++bj) *(u32x4*)(rowp + bj * HALF) = pack8(acc[ai][bj][m][0] * qiscale, acc[ai][bj][m][1] * qiscale); }
        } else {
#pragma unroll
            for (int ai = 0; ai < 2; ++ai)
#pragma unroll
                for (int m = 0; m < 4; ++m) { float* rowp = KIWI + (size_t)(row0 + ai * HALF + m * 16) * 128 + c;
                    *(f32x4*)rowp = acc[ai][0][m][0]; *(f32x4*)(rowp + 4) = acc[ai][0][m][1]; }
        }
    }
};
struct EpiResF32 {
    static constexpr bool PERM = false, AFTER_DRAIN = false;
    const float* R; float* Z; float alpha; int ldc;
    __device__ __forceinline__ void operator()(const f32x4 (&acc)[2][2][4][2], const Unit& u, int wr, int wc, int fr, int fq) const {
        const int row0 = u.pm * BM + wr * 64 + fr, col0 = u.pn * BM + wc * 32 + 4 * fq;
#pragma unroll
        for (int ai = 0; ai < 2; ++ai)
#pragma unroll
            for (int m = 0; m < 4; ++m) { const size_t off = (size_t)(row0 + ai * HALF + m * 16) * ldc + col0;
#pragma unroll
                for (int bj = 0; bj < 2; ++bj)
#pragma unroll
                    for (int n = 0; n < 2; ++n) { const f32x4 r = *(const f32x4*)(R + off + bj * HALF + n * 16); *(f32x4*)(Z + off + bj * HALF + n * 16) = r * alpha + acc[ai][bj][m][n]; } }
    }
};
struct EpiF32 {
    static constexpr bool PERM = false, AFTER_DRAIN = false;
    float* C; int ldc;
    __device__ __forceinline__ void operator()(const f32x4 (&acc)[2][2][4][2], const Unit& u, int wr, int wc, int fr, int fq) const {
        const int row0 = u.pm * BM + wr * 64 + fr, col0 = u.pn * BM + wc * 32 + 4 * fq;
#pragma unroll
        for (int ai = 0; ai < 2; ++ai)
#pragma unroll
            for (int m = 0; m < 4; ++m) { float* rowp = C + (size_t)(row0 + ai * HALF + m * 16) * ldc + col0;
#pragma unroll
                for (int bj = 0; bj < 2; ++bj)
#pragma unroll
                    for (int n = 0; n < 2; ++n) *(f32x4*)(rowp + bj * HALF + n * 16) = acc[ai][bj][m][n]; }
    }
};
__device__ __forceinline__ float silu_mul(float g, float u) { return g * __builtin_amdgcn_rcpf(1.0f + __expf(-g)) * u; }
struct EpiSwiGLU {
    static constexpr bool PERM = true, AFTER_DRAIN = false;
    bf16_t* H; int ldh;
    __device__ __forceinline__ void operator()(const f32x4 (&acc)[2][2][4][2], const Unit& u, int wr, int wc, int fr, int fq) const {
        const int row0 = u.pm * BM + wr * 64 + fr, col0 = u.pn * HALF + wc * 32 + 8 * fq;
#pragma unroll
        for (int ai = 0; ai < 2; ++ai)
#pragma unroll
            for (int m = 0; m < 4; ++m) { bf16_t* rowp = H + (size_t)(row0 + ai * HALF + m * 16) * ldh + col0;
                f32x4 v0, v1;
#pragma unroll
                for (int j = 0; j < 4; ++j) { v0[j] = silu_mul(acc[ai][0][m][0][j], acc[ai][1][m][0][j]); v1[j] = silu_mul(acc[ai][0][m][1][j], acc[ai][1][m][1][j]); }
                *(u32x4*)rowp = pack8(v0, v1); }
    }
};
struct EpiSwiGLU8 {
    static constexpr bool PERM = true, AFTER_DRAIN = false;
    unsigned char* H; int ldh;
    __device__ __forceinline__ void operator()(const f32x4 (&acc)[2][2][4][2], const Unit& u, int wr, int wc, int fr, int fq) const {
        const int row0 = u.pm * BM + wr * 64 + fr, col0 = u.pn * HALF + wc * 32 + 8 * fq;
#pragma unroll
        for (int ai = 0; ai < 2; ++ai)
#pragma unroll
            for (int m = 0; m < 4; ++m) { unsigned char* rowp = H + (size_t)(row0 + ai * HALF + m * 16) * ldh + col0;
                float v[8];
#pragma unroll
                for (int j = 0; j < 4; ++j) { v[j] = silu_mul(acc[ai][0][m][0][j], acc[ai][1][m][0][j]); v[4 + j] = silu_mul(acc[ai][0][m][1][j], acc[ai][1][m][1][j]); }
                int w0 = __builtin_amdgcn_cvt_pk_fp8_f32(v[0], v[1], 0, false); w0 = __builtin_amdgcn_cvt_pk_fp8_f32(v[2], v[3], w0, true);
                int w1 = __builtin_amdgcn_cvt_pk_fp8_f32(v[4], v[5], 0, false); w1 = __builtin_amdgcn_cvt_pk_fp8_f32(v[6], v[7], w1, true);
                uint2 o; o.x = (unsigned)w0; o.y = (unsigned)w1; *(uint2*)rowp = o; }
    }
};
struct MoeOrder : StaticOrder {
    int tend[8]; int nexp_rows;
    __device__ __forceinline__ int expert(int pm) const { int e = 0;
#pragma unroll
        for (int i = 0; i < 7; ++i) e += (pm >= tend[i]) ? 1 : 0; return e; }
    __device__ __forceinline__ const char* b_ptr(const Gemm& g, const Unit& u) const { return (const char*)g.Bt + ((size_t)expert(u.pm) * nexp_rows + (size_t)u.pn * BM) * ((size_t)g.K * g.esz); }
};
typedef int i32x8 __attribute__((ext_vector_type(8)));
typedef int i32x4 __attribute__((ext_vector_type(4)));
__device__ __forceinline__ i32x8 cat8(bf16x8 lo, bf16x8 hi) { const i32x4 a = *reinterpret_cast<const i32x4*>(&lo), b = *reinterpret_cast<const i32x4*>(&hi); return __builtin_shufflevector(a, b, 0, 1, 2, 3, 4, 5, 6, 7); }
template <class Epi, class Sched, bool ALIGN_EPI = false, bool SP2 = false, bool FP8 = false>
__device__ __forceinline__ void gemm_phase(PG8_LAS unsigned char* lds, const Gemm g, const Sched& S, const Epi& E) {
    int tid = threadIdx.x; asm volatile("" : "+v"(tid));
    const int wid = __builtin_amdgcn_readfirstlane(tid >> 6), lane = tid & 63, wr = wid >> 2, wc = wid & 3, fr = lane & 15, fq = lane >> 4;
    const int K = g.K, nt = K / (FP8 ? 2 * BK : BK);
    unsigned voffA[2], voffB[2];
#pragma unroll
    for (int i = 0; i < 2; ++i) { int R, C; stage_rc(tid * 16 + i * 8192, R, C); const int Rb = Epi::PERM ? ((R & ~31) + perm32(R & 31)) : R;
        voffA[i] = FP8 ? (unsigned)(R * K + C * 2) : (unsigned)(R * K + C) * 2u; voffB[i] = FP8 ? (unsigned)(Rb * K + C * 2) : (unsigned)(Rb * K + C) * 2u; }
    const size_t kstep = (size_t)(BK * 2);
    const size_t hstep = (size_t)HALF * K * (FP8 ? 1 : 2);
    const size_t tstep = 2 * hstep;
    const unsigned ldsw = (unsigned)wid * 1024u;
    const int aoff = lds_byte(wr * 64 + fr, fq * 8), boff = lds_byte(wc * 32 + fr, fq * 8);
#define PG8_SA(b, h) (((b) * 2 + (h)) * HTB)
#define PG8_SB(b, h) ((4 + (b) * 2 + (h)) * HTB)
#define PG8_STAGE(bufoff, gbase, voff) do { _Pragma("unroll") for (int _i = 0; _i < 2; ++_i) \
        __builtin_amdgcn_global_load_lds((const unsigned*)((const char*)(gbase) + (voff)[_i]), (PG8_LAS unsigned*)(lds + (bufoff) + ldsw + _i * 8192), 16, 0, 0); } while (0)
#define PG8_LDA(dst, b, h) do { _Pragma("unroll") for (int m = 0; m < 4; ++m) { if constexpr (FP8) { const i32x4 lo_ = *(const PG8_LAS i32x4*)(lds + PG8_SA(b, h) + aoff + m * 2048), hi_ = *(const PG8_LAS i32x4*)(lds + PG8_SA(b, h) + aoff + m * 2048 + 1024); dst##8[m] = __builtin_shufflevector(lo_, hi_, 0, 1, 2, 3, 4, 5, 6, 7); } else { _Pragma("unroll") for (int k = 0; k < 2; ++k) dst[m][k] = *(const PG8_LAS bf16x8*)(lds + PG8_SA(b, h) + aoff + m * 2048 + k * 1024); } } } while (0)
#define PG8_LDB(dst, b, h) do { _Pragma("unroll") for (int n = 0; n < 2; ++n) { if constexpr (FP8) { const i32x4 lo_ = *(const PG8_LAS i32x4*)(lds + PG8_SB(b, h) + boff + n * 2048), hi_ = *(const PG8_LAS i32x4*)(lds + PG8_SB(b, h) + boff + n * 2048 + 1024); dst##8[n] = __builtin_shufflevector(lo_, hi_, 0, 1, 2, 3, 4, 5, 6, 7); } else { _Pragma("unroll") for (int k = 0; k < 2; ++k) dst[n][k] = *(const PG8_LAS bf16x8*)(lds + PG8_SB(b, h) + boff + n * 2048 + k * 1024); } } } while (0)
#define PG8_MMA(ai, bj, At, Bt) do { __builtin_amdgcn_s_setprio(1); _Pragma("unroll") for (int m = 0; m < 4; ++m) _Pragma("unroll") for (int n = 0; n < 2; ++n) { \
        if constexpr (FP8) { asm volatile("v_mfma_scale_f32_16x16x128_f8f6f4 %0, %1, %2, %0, %3, %4 op_sel_hi:[0,0,0]" : "+v"(acc[ai][bj][m][n]) : "v"(Bt##8[n]), "v"(At##8[m]), "v"(sclA), "v"(sclB)); } \
        else { _Pragma("unroll") for (int k = 0; k < 2; ++k) acc[ai][bj][m][n] = __builtin_amdgcn_mfma_f32_16x16x32_bf16(Bt[n][k], At[m][k], acc[ai][bj][m][n], 0, 0, 0); } } __builtin_amdgcn_s_setprio(0); } while (0)
#define PG8_WAIT_V(n) asm volatile("s_waitcnt vmcnt(" #n ")" ::: "memory")
#define PG8_WAIT_L(n) asm volatile("s_waitcnt lgkmcnt(" #n ")" ::: "memory")
#define PG8_BAR __builtin_amdgcn_s_barrier()
#define PG8_SCHED __builtin_amdgcn_sched_barrier(0)
    Unit cur, nxt; int ui = 0;
    if (!S.next(0, cur)) return;
    f32x4 acc[2][2][4][2];
#pragma unroll
    for (int a = 0; a < 2; ++a)
#pragma unroll
        for (int b = 0; b < 2; ++b)
#pragma unroll
            for (int m = 0; m < 4; ++m)
#pragma unroll
                for (int n = 0; n < 2; ++n) acc[a][b][m][n] = (f32x4){0.f, 0.f, 0.f, 0.f};
    bf16x8 At[4][2], B0[2][2], B1[2][2]; i32x8 At8[4], B08[2], B18[2]; const int sclA = g.scale, sclB = 0x7f7f7f7f;
    const char* cA = S.a_ptr(g, cur); const char* cB = S.b_ptr(g, cur);
    S.a_ready(cur);
    if constexpr (SP2) {
        PG8_STAGE(PG8_SB(0, 0), cB, voffB); PG8_STAGE(PG8_SB(0, 1), cB + hstep, voffB); PG8_STAGE(PG8_SA(0, 0), cA, voffA); PG8_STAGE(PG8_SA(0, 1), cA + hstep, voffA);
        if (wr == 1) PG8_BAR;
        PG8_WAIT_V(2); PG8_BAR;
        PG8_STAGE(PG8_SB(1, 0), cB + kstep, voffB); PG8_STAGE(PG8_SA(1, 0), cA + kstep, voffA); PG8_STAGE(PG8_SB(1, 1), cB + hstep + kstep, voffB);
        PG8_WAIT_V(6); PG8_BAR;
    } else {
        PG8_STAGE(PG8_SB(0, 0), cB, voffB); PG8_STAGE(PG8_SA(0, 0), cA, voffA); PG8_STAGE(PG8_SB(0, 1), cB + hstep, voffB); PG8_STAGE(PG8_SA(0, 1), cA + hstep, voffA);
        if (wr == 1) PG8_BAR;
        PG8_WAIT_V(4); PG8_BAR;
        PG8_STAGE(PG8_SB(1, 0), cB + kstep, voffB); PG8_STAGE(PG8_SA(1, 0), cA + kstep, voffA); PG8_STAGE(PG8_SB(1, 1), cB + hstep + kstep, voffB);
        PG8_WAIT_V(6); PG8_BAR;
    }
    for (;;) {
        const bool has_next = S.next(ui + 1, nxt);
        const char* nA = has_next ? S.a_ptr(g, nxt) : cA; const char* nB = has_next ? S.b_ptr(g, nxt) : cB;
        for (int t = 0; t < nt; t += 2) {
            const bool last = (t == nt - 2);
            const char* a1 = cA + (size_t)(t + 1) * kstep;
            const char* a2 = last ? nA : cA + (size_t)(t + 2) * kstep; const char* b2 = last ? nB : cB + (size_t)(t + 2) * kstep;
            const char* a3 = a2 + kstep; const char* b3 = b2 + kstep;
            if (last && has_next) S.a_ready(nxt);
            if constexpr (SP2) {
            PG8_LDB(B0, 0, 0); PG8_LDB(B1, 0, 1); PG8_SCHED; PG8_LDA(At, 0, 0); PG8_STAGE(PG8_SA(1, 1), a1 + hstep, voffA);
            PG8_WAIT_V(8); PG8_WAIT_L(0); PG8_BAR; PG8_MMA(0, 0, At, B0); PG8_MMA(0, 1, At, B1); PG8_BAR; PG8_SCHED;
            PG8_LDA(At, 0, 1); PG8_STAGE(PG8_SB(0, 0), b2, voffB); PG8_STAGE(PG8_SB(0, 1), b2 + hstep, voffB); PG8_STAGE(PG8_SA(0, 0), a2, voffA);
            PG8_WAIT_V(8); PG8_WAIT_L(0); PG8_BAR; PG8_MMA(1, 0, At, B0); PG8_MMA(1, 1, At, B1); PG8_BAR; PG8_SCHED;
            PG8_LDB(B0, 1, 0); PG8_LDB(B1, 1, 1); PG8_SCHED; PG8_LDA(At, 1, 0); PG8_STAGE(PG8_SA(0, 1), a2 + hstep, voffA);
            PG8_WAIT_V(8); PG8_WAIT_L(0); PG8_BAR; PG8_MMA(0, 0, At, B0); PG8_MMA(0, 1, At, B1); PG8_BAR; PG8_SCHED;
            PG8_LDA(At, 1, 1); PG8_STAGE(PG8_SB(1, 0), b3, voffB); PG8_STAGE(PG8_SB(1, 1), b3 + hstep, voffB); PG8_STAGE(PG8_SA(1, 0), a3, voffA);
            PG8_WAIT_V(8); PG8_WAIT_L(0); PG8_BAR; PG8_MMA(1, 0, At, B0); PG8_MMA(1, 1, At, B1); PG8_BAR; PG8_SCHED;
            } else {
            PG8_LDB(B0, 0, 0); PG8_SCHED; PG8_LDA(At, 0, 0); PG8_STAGE(PG8_SA(1, 1), a1 + hstep, voffA);
            PG8_WAIT_L(8); PG8_BAR; PG8_WAIT_L(0); PG8_MMA(0, 0, At, B0); PG8_BAR; PG8_SCHED;
            PG8_LDB(B1, 0, 1); PG8_STAGE(PG8_SB(0, 0), b2, voffB);
            PG8_BAR; PG8_WAIT_L(0); PG8_MMA(0, 1, At, B1); PG8_BAR;
            PG8_LDA(At, 0, 1); PG8_STAGE(PG8_SA(0, 0), a2, voffA);
            PG8_BAR; PG8_WAIT_L(0); PG8_MMA(1, 0, At, B0); PG8_BAR; PG8_SCHED;
            PG8_STAGE(PG8_SB(0, 1), b2 + hstep, voffB);
            PG8_WAIT_V(6); PG8_BAR; PG8_MMA(1, 1, At, B1); PG8_BAR;
            PG8_LDB(B0, 1, 0); PG8_SCHED; PG8_LDA(At, 1, 0); PG8_STAGE(PG8_SA(0, 1), a2 + hstep, voffA);
            PG8_WAIT_L(8); PG8_BAR; PG8_WAIT_L(0); PG8_MMA(0, 0, At, B0); PG8_BAR; PG8_SCHED;
            PG8_LDB(B1, 1, 1); PG8_STAGE(PG8_SB(1, 0), b3, voffB);
            PG8_BAR; PG8_WAIT_L(0); PG8_MMA(0, 1, At, B1); PG8_BAR;
            PG8_LDA(At, 1, 1); PG8_STAGE(PG8_SA(1, 0), a3, voffA);
            PG8_BAR; PG8_WAIT_L(0); PG8_MMA(1, 0, At, B0); PG8_BAR; PG8_SCHED;
            PG8_STAGE(PG8_SB(1, 1), b3 + hstep, voffB);
            PG8_WAIT_V(6); PG8_BAR; PG8_MMA(1, 1, At, B1); PG8_BAR;
            }
        }
        if constexpr (FP8) asm volatile("s_nop 15\n\ts_nop 15" ::: "memory");
        if constexpr (ALIGN_EPI) { if (wr == 0) PG8_BAR; }
        if constexpr (!Epi::AFTER_DRAIN) { E(acc, cur, wr, wc, fr, fq); S.done(cur); }
        if (!has_next) break;
#pragma unroll
        for (int a = 0; a < 2; ++a)
#pragma unroll
            for (int b = 0; b < 2; ++b)
#pragma unroll
                for (int m = 0; m < 4; ++m)
#pragma unroll
                    for (int n = 0; n < 2; ++n) acc[a][b][m][n] = (f32x4){0.f, 0.f, 0.f, 0.f};
        cur = nxt; cA = nA; cB = nB; ++ui;
        if constexpr (ALIGN_EPI) { if (wr == 1) PG8_BAR; }
    }
    PG8_WAIT_V(0);
    if constexpr (!ALIGN_EPI) { if (wr == 0) PG8_BAR; }
    PG8_BAR;
    if constexpr (Epi::AFTER_DRAIN) { E.fused(acc, cur, wr, wc, fr, fq, lds, wid, lane); S.done(cur); }
#undef PG8_SA
#undef PG8_SB
#undef PG8_STAGE
#undef PG8_LDA
#undef PG8_LDB
#undef PG8_MMA
#undef PG8_WAIT_V
#undef PG8_WAIT_L
#undef PG8_BAR
#undef PG8_SCHED
}
}
#define GAS __attribute__((address_space(1)))
#define LAS __attribute__((address_space(3)))
typedef unsigned short bf16;
typedef unsigned v4u __attribute__((ext_vector_type(4)));
typedef float f32x4 __attribute__((ext_vector_type(4)));
typedef short bf16x8 __attribute__((ext_vector_type(8)));
typedef GAS unsigned gu32;
typedef GAS unsigned long long gu64;
#define RLX_AGENT __ATOMIC_RELAXED, __HIP_MEMORY_SCOPE_AGENT
#define LDS_WAIT() asm volatile("s_waitcnt lgkmcnt(0)" ::: "memory")
#define VM_WAIT() asm volatile("s_waitcnt vmcnt(0)" ::: "memory")
__device__ __forceinline__ unsigned long long rt() { return __builtin_amdgcn_s_memrealtime(); }
__device__ __forceinline__ unsigned f2bf(float f) { unsigned u = __builtin_bit_cast(unsigned, f); return (u + 0x7fffu + ((u >> 16) & 1u)) >> 16; }
__device__ __forceinline__ unsigned pk2(float lo, float hi) { return f2bf(lo) | (f2bf(hi) << 16); }

#define XB_TMO      128
#define XB_XCNT(j)  (256  + 64 * (j))
#define XB_XSUB(j)  (1280 + 64 * (j))
#define XB_XGEN(j)  (2304 + 64 * (j))
#define XB_TOP      3328
#define XB_TOPGEN   3392
#define XCD_BAR_WORDS 3456
#define XB_SPIN_CAP (1u << 18)

__device__ __forceinline__ unsigned xb_ld(unsigned* p)              { return __hip_atomic_load(p, __ATOMIC_RELAXED, __HIP_MEMORY_SCOPE_AGENT); }
__device__ __forceinline__ unsigned xb_add(unsigned* p, unsigned v) { return __hip_atomic_fetch_add(p, v, __ATOMIC_RELAXED, __HIP_MEMORY_SCOPE_AGENT); }
__device__ __forceinline__ unsigned xb_xcc_id() { return (unsigned)__builtin_amdgcn_s_getreg((3 << 11) | 20) & 0xFu; }
#define XB_SPIN(cond, bar) do { unsigned _sp = 0; while (cond) { __builtin_amdgcn_s_sleep(1); \
    if ((++_sp & 255u) == 0u) { if (xb_ld(&(bar)[XB_TMO])) break; if (_sp > XB_SPIN_CAP) { atomicAdd(&(bar)[XB_TMO], 1u); break; } } } } while (0)

struct XcdBarrier {
    unsigned* bar; unsigned x;
    volatile LAS unsigned* st;
};

__device__ __forceinline__ XcdBarrier xcd_barrier_post(unsigned* bar, volatile LAS unsigned* st) {
    XcdBarrier b; b.bar = bar; b.x = xb_xcc_id(); b.st = st;
    if (threadIdx.x == 0) (void)xb_add(&bar[XB_XCNT(b.x)], 1u);
    return b;
}
__device__ __forceinline__ void xcd_barrier_complete(unsigned* bar, unsigned x, unsigned& nloc, unsigned& nx) {
    const unsigned G = gridDim.x * gridDim.y * gridDim.z;
    unsigned sum, cnt, mine, sp = 0u;
    for (;;) {
        sum = 0u; cnt = 0u; mine = 0u;
#pragma unroll
        for (unsigned j = 0; j < 16; ++j) { const unsigned c = xb_ld(&bar[XB_XCNT(j)]); sum += c; cnt += (c > 0u) ? 1u : 0u; mine = (j == x) ? c : mine; }
        if (sum == G) break;
        __builtin_amdgcn_s_sleep(1);
        if ((++sp & 255u) == 0u) { if (xb_ld(&bar[XB_TMO])) break; if (sp > XB_SPIN_CAP) { atomicAdd(&bar[XB_TMO], 1u); break; } }
    }
    nloc = mine > 0u ? mine : 1u; nx = cnt > 0u ? cnt : 1u;
}

__device__ __forceinline__ void xcd_barrier(const XcdBarrier& b) {
    asm volatile("s_waitcnt vmcnt(0)" ::: "memory");
    __syncthreads();
    if (threadIdx.x == 0) {
        unsigned* bar = b.bar;
        __builtin_amdgcn_s_waitcnt(0);
        unsigned nloc = b.st[0], nx = b.st[1];
        if (nloc == 0u) { xcd_barrier_complete(bar, b.x, nloc, nx); b.st[0] = nloc; b.st[1] = nx; }
        const unsigned old = xb_add(&bar[XB_XSUB(b.x)], 1u);
        const unsigned gen = old / nloc;
        if (old + 1u == (gen + 1u) * nloc) {
            __builtin_amdgcn_fence(__ATOMIC_RELEASE, "agent");
            asm volatile("s_waitcnt vmcnt(0)" ::: "memory");
            const unsigned og = xb_add(&bar[XB_TOP], 1u);
            const unsigned tg = og / nx;
            if (og + 1u == (tg + 1u) * nx) xb_add(&bar[XB_TOPGEN], 1u);
            else XB_SPIN(xb_ld(&bar[XB_TOPGEN]) == tg, bar);
            __builtin_amdgcn_fence(__ATOMIC_ACQUIRE, "agent");
            xb_add(&bar[XB_XGEN(b.x)], 1u);
            asm volatile("s_waitcnt vmcnt(0)" ::: "memory");
        } else {
            XB_SPIN(xb_ld(&bar[XB_XGEN(b.x)]) == gen, bar);
            __builtin_amdgcn_fence(__ATOMIC_ACQUIRE, "agent");
            asm volatile("s_waitcnt vmcnt(0)" ::: "memory");
        }
    }
    __syncthreads();
}

constexpr int NWAVES = 8;
#ifndef MK_PER_PHASE
#define MK_PER_PHASE 0
#endif
constexpr int NPHASE = 22;

constexpr int BATCH = 2, SEQ = 8192, DM = 2048, NTOK = BATCH * SEQ, NH = 16, DH = 128;
constexpr int NSA_N = 5168, NSA_NPAD = 5376, P0LD = 5120;
constexpr int NCMP = 511, NSELB = 128;
constexpr int COL_KC = 2048, COL_VC = 2560, COL_KS = 3072, COL_VS = 3584, COL_KW = 4096, COL_VW = 4608;
constexpr int DSA_N = 2888, DSA_NPAD = 3072, KVR = 256, TOPK = 256;
constexpr int DFF = 5632, NEXP = 8, DFFE = 7168, MOE_ROWS = 34816;
constexpr float ALPHA = 1.41421356237309515f, LN_EPS = 1e-5f, RMS_EPS = 1e-6f;

constexpr size_t MiB = (size_t)1 << 20;
constexpr size_t WS_CTL = 0, CTL_ZERO_BYTES = 1 * MiB;
constexpr size_t WS_W_NSA_IN = 2 * MiB, WS_W_NSA_OUT = 23 * MiB, WS_W_FFN_GU = 31 * MiB, WS_W_FFN_DN = 75 * MiB, WS_W_DSA_IN = 97 * MiB, WS_W_DSA_OUT = 109 * MiB;
constexpr size_t WS_W_CMPK = 117 * MiB, WS_W_CMPV = 118 * MiB, WS_W_UK = 119 * MiB, WS_W_UV = 120 * MiB, WS_CBIAS = 121 * MiB;
constexpr size_t WS_KCMP = 122 * MiB, WS_VCMP = 124 * MiB, WS_GL = 126 * MiB, WS_ROUTE = 129 * MiB;
constexpr size_t WS_KIB = 179 * MiB;
constexpr size_t WS_SELM = 178 * MiB;
constexpr size_t WS_CRAW = 130 * MiB, WS_KIWI = 146 * MiB, WS_IDX = 154 * MiB, WS_CN = 170 * MiB;
constexpr size_t WS_W_MOE_GU = 192 * MiB, WS_W_MOE_DN = 640 * MiB;
constexpr size_t WS_XB = 864 * MiB, WS_XF = 928 * MiB, WS_Z = 1056 * MiB;
constexpr size_t WS_P0 = 1184 * MiB, WS_OATT0 = 1344 * MiB, WS_HFF = 1408 * MiB;
constexpr size_t WS_Q = 1184 * MiB, WS_QI = 1248 * MiB, WS_QLAT = 1264 * MiB, WS_OLAT = 1392 * MiB, WS_OATT1 = 1520 * MiB;
constexpr size_t WS_XG = 1056 * MiB, WS_HM = 1192 * MiB, WS_Y = 192 * MiB;
constexpr size_t WS_END = 1668 * MiB;
static_assert(WS_HM + (size_t)MOE_ROWS * DFFE * 2 <= WS_END, "hm fits");
static_assert(WS_XG + (size_t)MOE_ROWS * DM * 2 <= WS_HM, "xg fits");
static_assert(WS_Y + (size_t)MOE_ROWS * DM * 4 <= WS_W_MOE_DN, "y overlays the dead gate/up weights only");
static_assert(WS_HFF + (size_t)NTOK * DFF * 2 <= WS_END, "hff fits");
constexpr int CW_TMO = 0, CW_CODE = 1;
constexpr int CW_BAR = 4096;
constexpr int CW_MOECNT = 16384;

constexpr int RING_OFF = 0, RING_BYTES = 131072;
constexpr int LDSCTL_OFF = RING_BYTES, MISC_OFF = LDSCTL_OFF + 320;
constexpr int LDS_BYTES = 163840;
constexpr int DSA_SCR = 133120;

struct Frame {
    LAS unsigned char* lds;
    volatile LAS unsigned* MISC;
    gu32* ctl;
    int tid, lane, wave, vcu, G;
};

__device__ __forceinline__ void relaunder(Frame& F) { int t = F.tid; asm volatile("" : "+v"(t)); F.tid = t; F.lane = t & 63; }
__device__ __forceinline__ float bf2f(unsigned short h) { return __uint_as_float(((unsigned)h) << 16); }
__device__ __forceinline__ float bflo(unsigned w) { return __uint_as_float(w << 16); }
__device__ __forceinline__ float bfhi(unsigned w) { return __uint_as_float(w & 0xffff0000u); }
__device__ __forceinline__ float wave_sum(float v) {
#pragma unroll
    for (int o = 1; o < 64; o <<= 1) v += __shfl_xor(v, o);
    return v;
}
__device__ __forceinline__ float wave_max(float v) {
#pragma unroll
    for (int o = 1; o < 64; o <<= 1) v = fmaxf(v, __shfl_xor(v, o));
    return v;
}
#define WSYNC() do { __builtin_amdgcn_wave_barrier(); asm volatile("s_waitcnt lgkmcnt(0)" ::: "memory"); __builtin_amdgcn_wave_barrier(); } while (0)

__device__ __forceinline__ int rel_bucket(int n) {
    if (n < 16) return n;
    if (n >= 113) return 31;
    int b = 16;
    b += (n >= 19); b += (n >= 21); b += (n >= 24); b += (n >= 27); b += (n >= 31); b += (n >= 35); b += (n >= 40); b += (n >= 46);
    b += (n >= 52); b += (n >= 59); b += (n >= 67); b += (n >= 77); b += (n >= 87); b += (n >= 99);
    return b;
}

struct Args { const float* in[27]; float* out; unsigned char* ws; int ph_lo, ph_hi; };
#ifndef FFN_F8
#define FFN_F8 1
#endif
struct TrItem { const float* W; bf16* WT; int N, K, k0, n0, drow; float f8scale; };
__device__ __forceinline__ void tr_set(TrItem& T, const float* W, int K, int N, int Npad, bf16* WT, int mode, int item, float f8scale = 0.f) {
    T.f8scale = f8scale;
    const int nblk = Npad / 32, kb = item / nblk, nb = item - kb * nblk, n0 = 32 * nb;
    T.W = W; T.WT = WT; T.N = N; T.K = K; T.k0 = 64 * kb; T.n0 = n0; T.drow = (mode == 0) ? n0 : ((n0 >> 7) * 256 + (mode - 1) * 128 + (n0 & 127));
}
constexpr int TR_I_NSA_IN = (DM / 64) * (NSA_NPAD / 32), TR_I_SQ = (DM / 64) * (DM / 32), TR_I_FFN = (DM / 64) * (DFF / 32), TR_I_FFD = (DFF / 64) * (DM / 32), TR_I_DSA_IN = (DM / 64) * (DSA_NPAD / 32);
constexpr int TR_I_CMP = (4096 / 64) * (128 / 32), TR_I_UK1 = (128 / 64) * (256 / 32), TR_I_UV1 = (256 / 64) * (128 / 32);
constexpr int TR_I_MG1 = (DM / 64) * (DFFE / 32), TR_I_MD1 = (DFFE / 64) * (DM / 32);
constexpr int TR_NITEMS = TR_I_NSA_IN + 2 * TR_I_SQ + 2 * TR_I_FFN + TR_I_FFD + TR_I_DSA_IN + 2 * TR_I_CMP + 16 * TR_I_UK1 + 16 * TR_I_UV1 + 16 * TR_I_MG1 + 8 * TR_I_MD1;
__device__ __forceinline__ void tr_decode(const Args& A, unsigned char* ws, int it, TrItem& T) {
    int r = it;
    if (r < TR_I_NSA_IN) { tr_set(T, A.in[2], DM, NSA_N, NSA_NPAD, (bf16*)(ws + WS_W_NSA_IN), 0, r); return; } r -= TR_I_NSA_IN;
    if (r < TR_I_SQ) { tr_set(T, A.in[9], DM, DM, DM, (bf16*)(ws + WS_W_NSA_OUT), 0, r); return; } r -= TR_I_SQ;
    if (r < TR_I_SQ) { tr_set(T, A.in[14], DM, DM, DM, (bf16*)(ws + WS_W_DSA_OUT), 0, r); return; } r -= TR_I_SQ;
    if (r < TR_I_FFN) { tr_set(T, A.in[15], DM, DFF, DFF, (bf16*)(ws + WS_W_FFN_GU), 1, r, FFN_F8 ? 64.f : 0.f); return; } r -= TR_I_FFN;
    if (r < TR_I_FFN) { tr_set(T, A.in[16], DM, DFF, DFF, (bf16*)(ws + WS_W_FFN_GU), 2, r, FFN_F8 ? 64.f : 0.f); return; } r -= TR_I_FFN;
    if (r < TR_I_FFD) { tr_set(T, A.in[17], DFF, DM, DM, (bf16*)(ws + WS_W_FFN_DN), 0, r, FFN_F8 ? 256.f : 0.f); return; } r -= TR_I_FFD;
    if (r < TR_I_DSA_IN) { tr_set(T, A.in[10], DM, DSA_N, DSA_NPAD, (bf16*)(ws + WS_W_DSA_IN), 0, r); return; } r -= TR_I_DSA_IN;
    if (r < TR_I_CMP) { tr_set(T, A.in[4], 4096, 128, 128, (bf16*)(ws + WS_W_CMPK), 0, r); return; } r -= TR_I_CMP;
    if (r < TR_I_CMP) { tr_set(T, A.in[7], 4096, 128, 128, (bf16*)(ws + WS_W_CMPV), 0, r); return; } r -= TR_I_CMP;
    if (r < 16 * TR_I_UK1) { const int h = r / TR_I_UK1; tr_set(T, A.in[12] + (size_t)h * 128 * 256, 128, 256, 256, (bf16*)(ws + WS_W_UK) + (size_t)h * 256 * 128, 0, r - h * TR_I_UK1); return; } r -= 16 * TR_I_UK1;
    if (r < 16 * TR_I_UV1) { const int h = r / TR_I_UV1; tr_set(T, A.in[13] + (size_t)h * 256 * 128, 256, 128, 128, (bf16*)(ws + WS_W_UV) + (size_t)h * 128 * 256, 0, r - h * TR_I_UV1); return; } r -= 16 * TR_I_UV1;
    if (r < 8 * TR_I_MG1) { const int e = r / TR_I_MG1; tr_set(T, A.in[20] + (size_t)e * DM * DFFE, DM, DFFE, DFFE, (bf16*)(ws + WS_W_MOE_GU + (size_t)e * 2 * DFFE * DM), 1, r - e * TR_I_MG1, 64.f); return; } r -= 8 * TR_I_MG1;
    if (r < 8 * TR_I_MG1) { const int e = r / TR_I_MG1; tr_set(T, A.in[21] + (size_t)e * DM * DFFE, DM, DFFE, DFFE, (bf16*)(ws + WS_W_MOE_GU + (size_t)e * 2 * DFFE * DM), 2, r - e * TR_I_MG1, 64.f); return; } r -= 8 * TR_I_MG1;
    { const int e = r / TR_I_MD1; tr_set(T, A.in[22] + (size_t)e * DFFE * DM, DFFE, DM, DM, (bf16*)(ws + WS_W_MOE_DN + (size_t)e * DM * DFFE), 0, r - e * TR_I_MD1, 256.f); }
}
__device__ __forceinline__ void tr_load(const TrItem& T, f32x4 (&v)[8], int lane) {
    const int kr = lane >> 3, c4 = lane & 7, n = T.n0 + 4 * c4;
#pragma unroll
    for (int i = 0; i < 8; ++i) v[i] = (n < T.N) ? *(const f32x4*)(T.W + (size_t)(T.k0 + 8 * i + kr) * T.N + n) : (f32x4){0.f, 0.f, 0.f, 0.f};
}
__device__ __forceinline__ void tr_store(const TrItem& T, const f32x4 (&v)[8], LAS float* scr, int lane) {
    { const int kr = lane >> 3, c4 = lane & 7;
#pragma unroll
      for (int i = 0; i < 8; ++i) { LAS float* d = scr + (8 * i + kr) * 33 + 4 * c4; d[0] = v[i][0]; d[1] = v[i][1]; d[2] = v[i][2]; d[3] = v[i][3]; } }
    LDS_WAIT(); asm volatile("" ::: "memory");
    const int c = lane & 7;
#pragma unroll
    for (int j = 0; j < 4; ++j) { const int n = (lane >> 3) + 8 * j; const LAS float* s = scr + (8 * c) * 33 + n;
        v4u o; o.x = pg8::cvt_pk_bf16(s[0 * 33], s[1 * 33]); o.y = pg8::cvt_pk_bf16(s[2 * 33], s[3 * 33]); o.z = pg8::cvt_pk_bf16(s[4 * 33], s[5 * 33]); o.w = pg8::cvt_pk_bf16(s[6 * 33], s[7 * 33]);
        *(v4u*)(T.WT + (size_t)(T.drow + n) * T.K + T.k0 + 8 * c) = o; }
    LDS_WAIT(); asm volatile("" ::: "memory");
}

__device__ __forceinline__ void tr_store8(const TrItem& T, const f32x4 (&v)[8], LAS float* scr, int lane) {
    { const int kr = lane >> 3, c4 = lane & 7;
#pragma unroll
      for (int i = 0; i < 8; ++i) { LAS float* d = scr + (8 * i + kr) * 33 + 4 * c4; d[0] = v[i][0]; d[1] = v[i][1]; d[2] = v[i][2]; d[3] = v[i][3]; } }
    LDS_WAIT(); asm volatile("" ::: "memory");
    const int c = lane & 3, nr = lane >> 2; const float sc = T.f8scale;
#pragma unroll
    for (int j = 0; j < 2; ++j) { const int n = nr + 16 * j; const LAS float* s = scr + (16 * c) * 33 + n; int w[4];
#pragma unroll
        for (int q = 0; q < 4; ++q) { w[q] = __builtin_amdgcn_cvt_pk_fp8_f32(s[(4 * q) * 33] * sc, s[(4 * q + 1) * 33] * sc, 0, false); w[q] = __builtin_amdgcn_cvt_pk_fp8_f32(s[(4 * q + 2) * 33] * sc, s[(4 * q + 3) * 33] * sc, w[q], true); }
        v4u o; o.x = (unsigned)w[0]; o.y = (unsigned)w[1]; o.z = (unsigned)w[2]; o.w = (unsigned)w[3];
        *(v4u*)((unsigned char*)T.WT + (size_t)(T.drow + n) * T.K + T.k0 + 16 * c) = o; }
    LDS_WAIT(); asm volatile("" ::: "memory");
}
__device__ __forceinline__ void p0_prologue(Frame& F, const Args& A) {
    LAS float* scr = (LAS float*)(F.lds + RING_OFF + F.wave * 16384);
    unsigned char* ws = A.ws;
    const int gw = F.vcu * NWAVES + F.wave, NGW = F.G * NWAVES, lane = F.lane;
    { TrItem cur, nxt; f32x4 va[8], vb[8]; int it = gw;
      if (it < TR_NITEMS) { tr_decode(A, ws, it, cur); tr_load(cur, va, lane); }
      while (it < TR_NITEMS) {
          int itn = it + NGW; if (itn < TR_NITEMS) { tr_decode(A, ws, itn, nxt); tr_load(nxt, vb, lane); }
          if (cur.f8scale != 0.f) tr_store8(cur, va, scr, lane); else tr_store(cur, va, scr, lane);
          it = itn; if (it >= TR_NITEMS) break;
          itn = it + NGW; if (itn < TR_NITEMS) { tr_decode(A, ws, itn, cur); tr_load(cur, va, lane); }
          if (nxt.f8scale != 0.f) tr_store8(nxt, vb, scr, lane); else tr_store(nxt, vb, scr, lane);
          it = itn;
      } }
    { const float* x = A.in[0]; bf16* xb = (bf16*)(ws + WS_XB); const size_t n8 = (size_t)NTOK * DM / 8;
      for (size_t i = (size_t)F.vcu * 512 + F.tid; i < n8; i += (size_t)F.G * 512) { const f32x4 a = *(const f32x4*)(x + i * 8), b = *(const f32x4*)(x + i * 8 + 4);
          v4u o; o.x = pk2(a[0], a[1]); o.y = pk2(a[2], a[3]); o.z = pk2(b[0], b[1]); o.w = pk2(b[2], b[3]); *(v4u*)(xb + i * 8) = o; } }
    for (int it = gw; it < 64; it += NGW) { const int kv = it >> 5, ch = it & 31; const float* pe = A.in[kv ? 6 : 3]; const float* w1 = A.in[kv ? 7 : 4];
        float s0 = 0.f, s1 = 0.f;
        for (int k = ch * 128; k < ch * 128 + 128; ++k) { const float p = pe[k]; s0 += p * w1[(size_t)k * 128 + lane]; s1 += p * w1[(size_t)k * 128 + 64 + lane]; }
        float* cb = (float*)(ws + WS_CBIAS) + (size_t)(kv * 32 + ch) * 128; cb[lane] = s0; cb[64 + lane] = s1; }
}

typedef short s8v __attribute__((ext_vector_type(8)));
__device__ __forceinline__ s8v ld_frag(const bf16* p) { return *(const s8v*)p; }

__device__ __forceinline__ float gelu_tanh(float x) { const float u = 0.7978845608028654f * (x + 0.044715f * x * x * x); return 0.5f * x * (1.0f + tanhf(u)); }
__device__ __forceinline__ void p2_compress(Frame& F, const Args& A) {
    unsigned char* ws = A.ws; const int lane = F.lane, wid = F.wave, tid = F.tid;
    const bf16* P0 = (const bf16*)(ws + WS_P0);
    LAS float* part = (LAS float*)(F.lds + RING_OFF);
    LAS float* hid = (LAS float*)(F.lds + DSA_SCR);
    LAS float* cbl = hid + 4096;
    if (tid < 256) { const float* cbp = (const float*)(ws + WS_CBIAS) + (size_t)(tid >> 7) * 32 * 128 + (tid & 127); float cb = 0.f; for (int ch = 0; ch < 32; ++ch) cb += cbp[ch * 128]; cbl[tid] = cb; }
    if (F.vcu < 16 && wid == 0) { bf16* zp = (bf16*)(ws + ((F.vcu & 1) ? WS_VCMP : WS_KCMP)) + ((size_t)(F.vcu >> 1) * 512 + 511) * 128; zp[lane] = 0; zp[64 + lane] = 0; }
    __syncthreads();
    const int r16 = lane & 15, kq = lane >> 4;
    for (int it = F.vcu; it < 256; it += F.G) {
        const int kv = it >> 7, tile = it & 127;
        const bf16* W1T = (const bf16*)(ws + (kv ? WS_W_CMPV : WS_W_CMPK));
        const float* w2 = A.in[kv ? 8 : 5];
        bf16* outp = (bf16*)(ws + (kv ? WS_VCMP : WS_KCMP));
        const int colbase = kv ? COL_VC : COL_KC;
        f32x4 acc[2][8];
#pragma unroll
        for (int m = 0; m < 2; ++m)
#pragma unroll
            for (int n = 0; n < 8; ++n) acc[m][n] = (f32x4){0.f, 0.f, 0.f, 0.f};
        const bf16* arow[2];
#pragma unroll
        for (int m = 0; m < 2; ++m) { int R = tile * 32 + m * 16 + r16; if (R > 4087) R = 4087; const int g = R & 3, bn = R >> 2, b = bn / NCMP, n = bn - b * NCMP;
            arow[m] = P0 + (size_t)(b * SEQ + 16 * n) * P0LD + colbase + g * 128 + kq * 8; }
#pragma unroll 2
        for (int kk = 0; kk < 16; ++kk) {
            const int ks = wid * 16 + kk, l = ks >> 2, d0 = (ks & 3) * 32;
            s8v af[2], bfr[8];
#pragma unroll
            for (int m = 0; m < 2; ++m) af[m] = ld_frag(arow[m] + (size_t)l * P0LD + d0);
#pragma unroll
            for (int n = 0; n < 8; ++n) bfr[n] = ld_frag(W1T + (size_t)(n * 16 + r16) * 4096 + ks * 32 + kq * 8);
#pragma unroll
            for (int m = 0; m < 2; ++m)
#pragma unroll
                for (int n = 0; n < 8; ++n) acc[m][n] = __builtin_amdgcn_mfma_f32_16x16x32_bf16(af[m], bfr[n], acc[m][n], 0, 0, 0);
        }
#pragma unroll
        for (int m = 0; m < 2; ++m)
#pragma unroll
            for (int n = 0; n < 8; ++n)
#pragma unroll
                for (int j = 0; j < 4; ++j) part[wid * 4096 + (m * 16 + kq * 4 + j) * 128 + n * 16 + r16] = acc[m][n][j];
        __syncthreads();
        { const int row = tid >> 4, e0 = (tid & 15) * 8; f32x4 s0 = (f32x4){0.f, 0.f, 0.f, 0.f}, s1 = s0;
#pragma unroll
          for (int w = 0; w < 8; ++w) { s0 += *(const LAS f32x4*)(part + w * 4096 + row * 128 + e0); s1 += *(const LAS f32x4*)(part + w * 4096 + row * 128 + e0 + 4); }
#pragma unroll
          for (int j = 0; j < 4; ++j) { hid[row * 128 + e0 + j] = gelu_tanh(s0[j] + cbl[kv * 128 + e0 + j]); hid[row * 128 + e0 + 4 + j] = gelu_tanh(s1[j] + cbl[kv * 128 + e0 + 4 + j]); } }
        __syncthreads();
        { const int rr = tid >> 4, f0 = (tid & 15) * 8, R = tile * 32 + rr; f32x4 o0 = (f32x4){0.f, 0.f, 0.f, 0.f}, o1 = o0;
#pragma unroll 4
          for (int e = 0; e < 128; ++e) { const float hv = hid[rr * 128 + e]; o0 += *(const f32x4*)(w2 + e * 128 + f0) * hv; o1 += *(const f32x4*)(w2 + e * 128 + f0 + 4) * hv; }
          if (R <= 4087) { const int g = R & 3, bn = R >> 2, b = bn / NCMP, n = bn - b * NCMP;
              v4u o; o.x = pk2(o0[0], o0[1]); o.y = pk2(o0[2], o0[3]); o.z = pk2(o1[0], o1[1]); o.w = pk2(o1[2], o1[3]);
              *(v4u*)(outp + ((size_t)(b * 4 + g) * 512 + n) * 128 + f0) = o; } }
        __syncthreads();
    }
}

namespace fa {
typedef float f32x16 __attribute__((ext_vector_type(16)));
typedef short s16x4 __attribute__((ext_vector_type(4)));
typedef unsigned u32x4v __attribute__((ext_vector_type(4)));
constexpr int SHM_K = 16384, SHM_V = 16384;
constexpr int OFF_V = 0, OFF_K = 2 * SHM_V, OFF_WS = 2 * SHM_V + 2 * SHM_K, OFF_LUT = OFF_WS + 8 * 256, OFF_MASK = OFF_LUT + 144 * 16 * 4, OFF_TAB = OFF_MASK + 1024;
constexpr int TABLD = 130;
constexpr float C2 = 1.4426950408889634f, THR = 8.f;
#define FA_KSWZ(row, colB) ((row) * 256 + ((colB) ^ (((row) & 7) << 4)))
#define FA_SBAR() __builtin_amdgcn_sched_barrier(0)
__device__ __forceinline__ int v_st(int k, int c) { const int kk = (k & ~0xC) | ((k & 4) << 1) | ((k & 8) >> 1); return ((kk >> 3) * 4 + (c >> 5)) * 512 + ((kk & 7) * 32 + (c & 31)) * 2; }
__device__ __forceinline__ int v_rd_base(int lane) { return ((lane & 3) << 3) | (((lane >> 2) & 3) << 6) | (((lane >> 4) & 1) << 5) | (((lane >> 5) & 1) << 8); }
constexpr int v_rd_off(int d0, int ks, int half) { return d0 * 512 + ks * 4096 + half * 2048; }
__device__ __forceinline__ int crow(int r, int hi) { return (r & 3) + 8 * (r >> 2) + 4 * hi; }
__device__ __forceinline__ unsigned cvtpk(float lo, float hi) { unsigned r; asm volatile("v_cvt_pk_bf16_f32 %0, %1, %2" : "=v"(r) : "v"(lo), "v"(hi)); return r; }

__device__ __forceinline__ void qkt(f32x16& p0, f32x16& p1, const LAS char* Kb, int r32, int hi, const bf16x8 (&qr)[8], float init) {
#pragma unroll
    for (int r = 0; r < 16; ++r) { p0[r] = init; p1[r] = init; }
    const LAS char* kb[4];
#pragma unroll
    for (int dd = 0; dd < 4; ++dd) kb[dd] = Kb + FA_KSWZ(r32, (dd * 16 + hi * 8) * 2);
#pragma unroll
    for (int d0 = 0; d0 < 8; ++d0) { const LAS char* a = kb[d0 & 3] + (d0 >> 2) * 128;
        const bf16x8 b0 = *(const LAS bf16x8*)a;
        const bf16x8 b1 = *(const LAS bf16x8*)(a + 32 * 256);
        p0 = __builtin_amdgcn_mfma_f32_32x32x16_bf16(b0, qr[d0], p0, 0, 0, 0);
        p1 = __builtin_amdgcn_mfma_f32_32x32x16_bf16(b1, qr[d0], p1, 0, 0, 0); }
}
__device__ __forceinline__ void pv_tile(f32x16 (&o)[4], int vb0, bf16x8 pa0, bf16x8 pa1, bf16x8 pa2, bf16x8 pa3) {
#define FA_TRRD(dst, off) asm volatile("ds_read_b64_tr_b16 %0, %1 offset:%2" : "=&v"(dst) : "v"(vb0), "i"(off) : "memory")
#define FA_PV_D0(d0) do { s16x4 l0, l1, l2, l3, h0, h1, h2, h3; constexpr int b_ = v_rd_off(d0, 0, 0); \
        FA_TRRD(l0, b_); FA_TRRD(h0, b_ + 2048); FA_TRRD(l1, b_ + 4096); FA_TRRD(h1, b_ + 6144); FA_TRRD(l2, b_ + 8192); FA_TRRD(h2, b_ + 10240); FA_TRRD(l3, b_ + 12288); FA_TRRD(h3, b_ + 14336); \
        asm volatile("s_waitcnt lgkmcnt(0)" ::: "memory"); FA_SBAR(); \
        o[d0] = __builtin_amdgcn_mfma_f32_32x32x16_bf16(pa0, (bf16x8){l0[0], l0[1], l0[2], l0[3], h0[0], h0[1], h0[2], h0[3]}, o[d0], 0, 0, 0); \
        o[d0] = __builtin_amdgcn_mfma_f32_32x32x16_bf16(pa1, (bf16x8){l1[0], l1[1], l1[2], l1[3], h1[0], h1[1], h1[2], h1[3]}, o[d0], 0, 0, 0); \
        o[d0] = __builtin_amdgcn_mfma_f32_32x32x16_bf16(pa2, (bf16x8){l2[0], l2[1], l2[2], l2[3], h2[0], h2[1], h2[2], h2[3]}, o[d0], 0, 0, 0); \
        o[d0] = __builtin_amdgcn_mfma_f32_32x32x16_bf16(pa3, (bf16x8){l3[0], l3[1], l3[2], l3[3], h3[0], h3[1], h3[2], h3[3]}, o[d0], 0, 0, 0); } while (0)
    FA_PV_D0(0); FA_PV_D0(1); FA_PV_D0(2); FA_PV_D0(3);
#undef FA_PV_D0
#undef FA_TRRD
}
__device__ __forceinline__ void partialSM(f32x16& p0, f32x16& p1, float& m_reg, float& alpha) {
    float pmax = p0[0];
#pragma unroll
    for (int r = 1; r < 16; ++r) pmax = fmaxf(pmax, p0[r]);
#pragma unroll
    for (int r = 0; r < 16; ++r) pmax = fmaxf(pmax, p1[r]);
    { auto rr = __builtin_amdgcn_permlane32_swap(__float_as_uint(pmax), __float_as_uint(pmax), false, false); pmax = fmaxf(__uint_as_float(rr[0]), __uint_as_float(rr[1])); }
    float mn;
    if (__all(pmax - m_reg <= THR)) { mn = m_reg; alpha = 1.f; }
    else { mn = fmaxf(m_reg, pmax); alpha = __builtin_amdgcn_exp2f((m_reg - mn) * C2); m_reg = mn; }
    const float mnL = -mn * C2;
#pragma unroll
    for (int r = 0; r < 16; ++r) { p0[r] = __builtin_amdgcn_exp2f(fmaf(p0[r], C2, mnL)); p1[r] = __builtin_amdgcn_exp2f(fmaf(p1[r], C2, mnL)); }
}
__device__ __forceinline__ float finishSM(const f32x16& p0, const f32x16& p1, bf16x8& pa0, bf16x8& pa1, bf16x8& pa2, bf16x8& pa3) {
    float ps = 0.f;
#pragma unroll
    for (int r = 0; r < 16; ++r) ps += p0[r];
#pragma unroll
    for (int r = 0; r < 16; ++r) ps += p1[r];
    { auto rr = __builtin_amdgcn_permlane32_swap(__float_as_uint(ps), __float_as_uint(ps), false, false); ps = __uint_as_float(rr[0]) + __uint_as_float(rr[1]); }
#define FA_PK4(P, B_, OUT) do { unsigned a0 = cvtpk(P[B_ + 0], P[B_ + 1]), a1 = cvtpk(P[B_ + 2], P[B_ + 3]); unsigned b0 = cvtpk(P[B_ + 4], P[B_ + 5]), b1 = cvtpk(P[B_ + 6], P[B_ + 7]); \
        auto r0 = __builtin_amdgcn_permlane32_swap(a0, b0, false, false); auto r1 = __builtin_amdgcn_permlane32_swap(a1, b1, false, false); \
        u32x4v w = {r0[0], r1[0], r0[1], r1[1]}; OUT = *reinterpret_cast<bf16x8*>(&w); } while (0)
    FA_PK4(p0, 0, pa0); FA_PK4(p0, 8, pa1); FA_PK4(p1, 0, pa2); FA_PK4(p1, 8, pa3);
#undef FA_PK4
    return ps;
}
__device__ __forceinline__ void rescale(f32x16 (&o)[4], float alpha, LAS float* al_l, int r32, int hi) {
    if (__any(alpha < 1.f)) { if (hi == 0) al_l[r32] = alpha; asm volatile("s_waitcnt lgkmcnt(0)" ::: "memory");
#pragma unroll
        for (int r = 0; r < 16; ++r) { const float a = al_l[crow(r, hi)];
#pragma unroll
            for (int d = 0; d < 4; ++d) o[d][r] *= a; }
        asm volatile("s_waitcnt lgkmcnt(0)" ::: "memory"); }
}
__device__ __forceinline__ void mask_tile(f32x16& p0, f32x16& p1, int dq, unsigned W) {
    const float NEG = -__builtin_inff();
#pragma unroll
    for (int r = 0; r < 16; ++r) { const int c = (r & 3) + 8 * (r >> 2);
        if ((unsigned)(dq - c) >= W) p0[r] = NEG;
        if ((unsigned)(dq - c - 32) >= W) p1[r] = NEG; }
}
__device__ __forceinline__ void mask_all(f32x16& p0, f32x16& p1, bool keep) {
    const float NEG = -__builtin_inff();
#pragma unroll
    for (int r = 0; r < 16; ++r) { p0[r] = keep ? p0[r] : NEG; p1[r] = keep ? p1[r] : NEG; }
}
__device__ __forceinline__ void bias_near(f32x16& p0, f32x16& p1, int dq, int step, const LAS float* lutcol) {
#pragma unroll
    for (int r = 0; r < 16; ++r) { const int c = (r & 3) + 8 * (r >> 2);
        const int d0 = min(max((dq - c) * step, 0), 128), d1 = min(max((dq - c - 32) * step, 0), 128);
        p0[r] += lutcol[d0]; p1[r] += lutcol[d1]; }
}
struct Stage { bf16x8 k0, k1, v0, v1; };
__device__ __forceinline__ void stage_load(Stage& S, const bf16* Kp, const bf16* Vp, size_t ld, int row0, int maxrow, int sr, int sc) {
    const int ra = min(row0 + sr, maxrow), rb = min(row0 + 32 + sr, maxrow);
    S.k0 = *(const bf16x8*)(Kp + (size_t)ra * ld + sc); S.k1 = *(const bf16x8*)(Kp + (size_t)rb * ld + sc);
    S.v0 = *(const bf16x8*)(Vp + (size_t)ra * ld + sc); S.v1 = *(const bf16x8*)(Vp + (size_t)rb * ld + sc);
}
__device__ __forceinline__ void stage_write(const Stage& S, LAS char* Kb, LAS char* Vb, int kws, int vst0, int vst1) {
    *(LAS bf16x8*)(Kb + kws) = S.k0; *(LAS bf16x8*)(Kb + kws + 32 * 256) = S.k1;
    *(LAS bf16x8*)(Vb + vst0) = S.v0; *(LAS bf16x8*)(Vb + vst1) = S.v1;
}
}

struct NsaLane { int wid, lane, r32, hi, ql, j, sr, sc, kws, vst0, vst1, vrd; };
__device__ __forceinline__ NsaLane nsa_lane(const Frame& F) {
    NsaLane L; L.wid = F.wave; L.lane = F.lane; L.r32 = F.lane & 31; L.hi = F.lane >> 5; L.ql = L.r32 >> 2; L.j = L.r32 & 3;
    L.sr = F.tid >> 4; L.sc = (F.tid & 15) * 8; L.kws = FA_KSWZ(L.sr, L.sc * 2); L.vst0 = fa::v_st(L.sr, L.sc); L.vst1 = fa::v_st(32 + L.sr, L.sc); L.vrd = fa::v_rd_base(F.lane);
    return L;
}
__device__ __forceinline__ void nsa_load_q(bf16x8 (&qr)[8], const bf16* P0, int tok0, int g, const NsaLane& L) {
    const bf16* qp = P0 + (size_t)(tok0 + L.wid * 8 + L.ql) * P0LD + (g * 4 + L.j) * 128 + L.hi * 8;
#pragma unroll
    for (int d0 = 0; d0 < 8; ++d0) qr[d0] = *(const bf16x8*)(qp + d0 * 16);
}
__device__ __forceinline__ void nsa_lut(Frame& F, const Args& A) {
    LAS float* lut = (LAS float*)(F.lds + RING_OFF + fa::OFF_LUT);
    for (int i = F.tid; i < 144 * 16; i += 512) { const int n = i >> 4, h = i & 15; lut[h * 144 + n] = A.in[1][rel_bucket(n) * 16 + h]; }
    __syncthreads();
}
template <int MODE>
__device__ __forceinline__ void nsa_store(const fa::f32x16 (&o)[4], float l_reg, LAS float* li_l, const float* GL, float* OACC, bf16* OATT, int tok0, int g, int br, const NsaLane& L) {
    if (L.hi == 0) li_l[L.r32] = l_reg;
    asm volatile("s_waitcnt lgkmcnt(0)" ::: "memory");
    float sc[16];
#pragma unroll
    for (int r = 0; r < 16; ++r) { const int row = fa::crow(r, L.hi), tok = tok0 + L.wid * 8 + (row >> 2), h = g * 4 + (row & 3); sc[r] = GL[(size_t)tok * 48 + h * 3 + br]; }
    float prev[4][16];
    if (MODE != 0) {
#pragma unroll
        for (int r = 0; r < 16; ++r) { const int row = fa::crow(r, L.hi), tok = tok0 + L.wid * 8 + (row >> 2), h = g * 4 + (row & 3); const float* ap = OACC + (size_t)tok * DM + h * 128 + L.r32;
#pragma unroll
            for (int d0 = 0; d0 < 4; ++d0) prev[d0][r] = ap[d0 * 32]; } }
#pragma unroll
    for (int r = 0; r < 16; ++r) { const int row = fa::crow(r, L.hi), tok = tok0 + L.wid * 8 + (row >> 2), h = g * 4 + (row & 3);
        const float l = li_l[row]; const float gl = sc[r];
        const float scl = (l > 0.f) ? __builtin_amdgcn_rcpf(l) / (1.0f + __expf(-gl)) : 0.f;
        float* ap = OACC + (size_t)tok * DM + h * 128 + L.r32;
#pragma unroll
        for (int d0 = 0; d0 < 4; ++d0) { float v = o[d0][r] * scl;
            if (MODE == 0) ap[d0 * 32] = v;
            else if (MODE == 1) ap[d0 * 32] = prev[d0][r] + v;
            else { v += prev[d0][r]; const float vn = __shfl_xor(v, 1); if ((L.r32 & 1) == 0) *(unsigned*)(OATT + (size_t)tok * DM + h * 128 + d0 * 32 + L.r32) = fa::cvtpk(v, vn); } } }
    asm volatile("s_waitcnt lgkmcnt(0)" ::: "memory");
}

__device__ __forceinline__ void p3a_nsa_cmp(Frame& F, const Args& A) {
    unsigned char* ws = A.ws; const NsaLane L = nsa_lane(F);
    const bf16* P0 = (const bf16*)(ws + WS_P0); const bf16* KCB = (const bf16*)(ws + WS_KCMP); const bf16* VCB = (const bf16*)(ws + WS_VCMP);
    const float* GL = (const float*)(ws + WS_GL); float* OACC = (float*)(ws + WS_Z); unsigned* SELM = (unsigned*)(ws + WS_SELM);
    nsa_lut(F, A);
    LAS char* lds = (LAS char*)(F.lds + RING_OFF);
    LAS float* wsf = (LAS float*)(lds + fa::OFF_WS) + L.wid * 64; LAS float* li_l = wsf; LAS float* al_l = wsf + 32;
    const LAS float* lut = (const LAS float*)(lds + fa::OFF_LUT);
    LAS float* tab = (LAS float*)(lds + fa::OFF_TAB);
    for (int ui = 0; ui < 2 * ((512 - F.vcu + F.G - 1) / F.G); ++ui) {
        const int p = F.vcu + (ui >> 1) * F.G, bg = p >> 6, y = p & 63, qb = (ui & 1) ? 127 - y : y, b = bg >> 2, g = bg & 3;
        const int tok0 = b * SEQ + qb * 64;
        bf16x8 qr[8]; nsa_load_q(qr, P0, tok0, g, L);
        const int trow = qb * 64 + L.wid * 8 + L.ql;
        const int h = g * 4 + L.j; const LAS float* lutcol = lut + h * 144; const float bias_far = lutcol[128];
        const int nmaxrow = (trow >= 31) ? (trow - 31) >> 4 : -1;
        const int NT = (4 * qb + 3 + 63) >> 6;
        const bf16* Kg = KCB + (size_t)(b * 4 + g) * 512 * 128; const bf16* Vg = VCB + (size_t)(b * 4 + g) * 512 * 128;
        for (int i = F.tid; i < 64 * fa::TABLD; i += 512) tab[i] = 0.f;
        float m_reg = -1e30f, l_reg = 0.f;
        fa::Stage S;
        const int rem16 = (trow >= 31) ? ((trow - 31) & 15) : 0;
        fa::stage_load(S, Kg, Vg, 128, 0, 511, L.sr, L.sc); asm volatile("s_waitcnt vmcnt(0)" ::: "memory");
        fa::stage_write(S, lds + fa::OFF_K, lds + fa::OFF_V, L.kws, L.vst0, L.vst1);
        __syncthreads();
#pragma unroll 1
        for (int t = 0; t < NT; ++t) {
            const int buf = t & 1;
            if (t + 1 < NT) fa::stage_load(S, Kg, Vg, 128, (t + 1) * 64, 511, L.sr, L.sc);
            fa::f32x16 p0, p1;
            const bool farT = (qb * 64 + L.wid * 8) - 31 - 16 * (t * 64 + 63) >= 128;
            fa::qkt(p0, p1, lds + fa::OFF_K + buf * fa::SHM_K, L.r32, L.hi, qr, farT ? bias_far : 0.f);
            const int dq = nmaxrow - t * 64 - 4 * L.hi;
            if (!farT) fa::bias_near(p0, p1, dq, 16, lutcol + rem16);
            fa::mask_tile(p0, p1, dq, 0x40000000u);
            float alpha; fa::partialSM(p0, p1, m_reg, alpha);
            float ps = 0.f;
#pragma unroll
            for (int r = 0; r < 16; ++r) ps += p0[r] + p1[r];
            { auto rr = __builtin_amdgcn_permlane32_swap(__float_as_uint(ps), __float_as_uint(ps), false, false); ps = __uint_as_float(rr[0]) + __uint_as_float(rr[1]); }
            l_reg = l_reg * alpha + ps;
            if (t + 1 < NT) { asm volatile("s_waitcnt vmcnt(0)" ::: "memory"); fa::stage_write(S, lds + fa::OFF_K + (buf ^ 1) * fa::SHM_K, lds + fa::OFF_V + (buf ^ 1) * fa::SHM_V, L.kws, L.vst0, L.vst1); }
            __syncthreads();
        }
        fa::f32x16 o[4];
#pragma unroll
        for (int d = 0; d < 4; ++d)
#pragma unroll
            for (int r = 0; r < 16; ++r) o[d][r] = 0.f;
        fa::stage_load(S, Kg, Vg, 128, 0, 511, L.sr, L.sc); asm volatile("s_waitcnt vmcnt(0)" ::: "memory");
        fa::stage_write(S, lds + fa::OFF_K, lds + fa::OFF_V, L.kws, L.vst0, L.vst1);
        __syncthreads();
        const float inv_l = (l_reg > 0.f) ? 1.0f / l_reg : 0.f; const float mnL = -m_reg * fa::C2;
#pragma unroll 1
        for (int t = 0; t < NT; ++t) {
            const int buf = t & 1;
            if (t + 1 < NT) fa::stage_load(S, Kg, Vg, 128, (t + 1) * 64, 511, L.sr, L.sc);
            fa::f32x16 p0, p1;
            const bool farT = (qb * 64 + L.wid * 8) - 31 - 16 * (t * 64 + 63) >= 128;
            fa::qkt(p0, p1, lds + fa::OFF_K + buf * fa::SHM_K, L.r32, L.hi, qr, farT ? bias_far : 0.f);
            const int dq = nmaxrow - t * 64 - 4 * L.hi;
            if (!farT) fa::bias_near(p0, p1, dq, 16, lutcol + rem16);
            fa::mask_tile(p0, p1, dq, 0x40000000u);
#pragma unroll
            for (int r = 0; r < 16; ++r) { p0[r] = __builtin_amdgcn_exp2f(fmaf(p0[r], fa::C2, mnL)) * inv_l; p1[r] = __builtin_amdgcn_exp2f(fmaf(p1[r], fa::C2, mnL)) * inv_l; }
            LAS float* tb = tab + (L.wid * 8 + L.ql) * fa::TABLD + t * 16 + L.hi;
#pragma unroll
            for (int half = 0; half < 2; ++half)
#pragma unroll
                for (int gq = 0; gq < 4; ++gq) { const fa::f32x16& pp = half ? p1 : p0;
                    float s4 = pp[4 * gq] + pp[4 * gq + 1] + pp[4 * gq + 2] + 0.5f * pp[4 * gq + 3], cr = 0.5f * pp[4 * gq + 3];
                    s4 += __shfl_xor(s4, 1); s4 += __shfl_xor(s4, 2); cr += __shfl_xor(cr, 1); cr += __shfl_xor(cr, 2);
                    if (L.j == 0) { __hip_atomic_fetch_add(tb + half * 8 + 2 * gq, s4, __ATOMIC_RELAXED, __HIP_MEMORY_SCOPE_WORKGROUP); __hip_atomic_fetch_add(tb + half * 8 + 2 * gq + 1, cr, __ATOMIC_RELAXED, __HIP_MEMORY_SCOPE_WORKGROUP); } }
            bf16x8 a0, a1, a2, a3; (void)fa::finishSM(p0, p1, a0, a1, a2, a3);
            fa::pv_tile(o, (int)(uintptr_t)(lds + fa::OFF_V + buf * fa::SHM_V) + L.vrd, a0, a1, a2, a3);
            if (t + 1 < NT) { asm volatile("s_waitcnt vmcnt(0)" ::: "memory"); fa::stage_write(S, lds + fa::OFF_K + (buf ^ 1) * fa::SHM_K, lds + fa::OFF_V + (buf ^ 1) * fa::SHM_V, L.kws, L.vst0, L.vst1); }
            __syncthreads();
        }
        nsa_store<0>(o, (l_reg > 0.f) ? 1.0f : 0.f, li_l, GL, OACC, nullptr, tok0, g, 0, L);
        __syncthreads();
        {
            bool s0[8], s1[8];
            if (qb < 16) {
#pragma unroll
                for (int qi = 0; qi < 8; ++qi) { s0[qi] = (L.lane <= qb); s1[qi] = false; }
            } else {
                float v0[8], v1[8];
#pragma unroll
                for (int qi = 0; qi < 8; ++qi) { const int ql = L.wid * 8 + qi;
                    v0[qi] = (L.lane >= 1 && L.lane <= qb - 2) ? tab[ql * fa::TABLD + L.lane] : -1.0f; v1[qi] = (L.lane + 64 <= qb - 2) ? tab[ql * fa::TABLD + L.lane + 64] : -1.0f;
                    s0[qi] = (L.lane == 0) || (L.lane == qb) || (L.lane == qb - 1); s1[qi] = (L.lane + 64 == qb) || (L.lane + 64 == qb - 1);
                    if (s0[qi]) v0[qi] = -3e38f; if (s1[qi]) v1[qi] = -3e38f; }
#pragma unroll 1
                for (int k = 0; k < 13; ++k) {
#pragma unroll
                    for (int qi = 0; qi < 8; ++qi) { float bv = v0[qi]; int bi = L.lane; if (v1[qi] > v0[qi]) { bv = v1[qi]; bi = L.lane + 64; }
#pragma unroll
                        for (int of = 1; of < 64; of <<= 1) { const float ov = __shfl_xor(bv, of); const int oi = __shfl_xor(bi, of); if (ov > bv || (ov == bv && oi < bi)) { bv = ov; bi = oi; } }
                        if (bi == L.lane) { v0[qi] = -3e38f; s0[qi] = true; } if (bi == L.lane + 64) { v1[qi] = -3e38f; s1[qi] = true; } } }
            }
#pragma unroll
            for (int qi = 0; qi < 8; ++qi) { const int ql = L.wid * 8 + qi; const unsigned long long b0 = __ballot(s0[qi]), b1 = __ballot(s1[qi]);
                if (L.lane == 0) { uint4 mv; mv.x = (unsigned)b0; mv.y = (unsigned)(b0 >> 32); mv.z = (unsigned)b1; mv.w = (unsigned)(b1 >> 32); *(uint4*)(SELM + ((size_t)(tok0 + ql) * 4 + g) * 4) = mv; } }
        }
        __syncthreads();
    }
}
__device__ __forceinline__ void p3b_nsa_sel(Frame& F, const Args& A) {
    unsigned char* ws = A.ws; const NsaLane L = nsa_lane(F);
    const bf16* P0 = (const bf16*)(ws + WS_P0); const float* GL = (const float*)(ws + WS_GL); float* OACC = (float*)(ws + WS_Z); const unsigned* SELM = (const unsigned*)(ws + WS_SELM);
    nsa_lut(F, A);
    LAS char* lds = (LAS char*)(F.lds + RING_OFF);
    LAS float* wsf = (LAS float*)(lds + fa::OFF_WS) + L.wid * 64; LAS float* li_l = wsf; LAS float* al_l = wsf + 32;
    const LAS float* lut = (const LAS float*)(lds + fa::OFF_LUT);
    for (int ui = 0; ui < 2 * ((512 - F.vcu + F.G - 1) / F.G); ++ui) {
        const int p = F.vcu + (ui >> 1) * F.G, bg = p >> 6, y = p & 63, qb = (ui & 1) ? 127 - y : y, b = bg >> 2, g = bg & 3;
        const int tok0 = b * SEQ + qb * 64;
        bf16x8 qr[8]; nsa_load_q(qr, P0, tok0, g, L);
        const int trow = qb * 64 + L.wid * 8 + L.ql;
        const int h = g * 4 + L.j; const LAS float* lutcol = lut + h * 144; const float bias_far = lutcol[128];
        const uint4 mv = *(const uint4*)(SELM + ((size_t)(tok0 + L.wid * 8 + L.ql) * 4 + g) * 4);
        const bf16* Kg = P0 + (size_t)b * SEQ * P0LD + COL_KS + g * 128; const bf16* Vg = P0 + (size_t)b * SEQ * P0LD + COL_VS + g * 128;
        const int NT = qb + 1;
        float m_reg = -1e30f, l_reg = 0.f; fa::f32x16 o[4];
#pragma unroll
        for (int d = 0; d < 4; ++d)
#pragma unroll
            for (int r = 0; r < 16; ++r) o[d][r] = 0.f;
        fa::Stage S;
        fa::stage_load(S, Kg, Vg, P0LD, 0, SEQ - 1, L.sr, L.sc); asm volatile("s_waitcnt vmcnt(0)" ::: "memory");
        fa::stage_write(S, lds + fa::OFF_K, lds + fa::OFF_V, L.kws, L.vst0, L.vst1);
        __syncthreads();
#pragma unroll 1
        for (int t = 0; t < NT; ++t) {
            const int buf = t & 1;
            if (t + 1 < NT) fa::stage_load(S, Kg, Vg, P0LD, (t + 1) * 64, SEQ - 1, L.sr, L.sc);
            const unsigned word = (t < 32) ? mv.x : (t < 64) ? mv.y : (t < 96) ? mv.z : mv.w;
            const bool mine = ((word >> (t & 31)) & 1u) != 0u;
            if (__any(mine)) {
            fa::f32x16 p0, p1;
            const bool farT = (qb * 64 + L.wid * 8) - (t * 64 + 63) >= 128;
            fa::qkt(p0, p1, lds + fa::OFF_K + buf * fa::SHM_K, L.r32, L.hi, qr, farT ? bias_far : 0.f);
            const int dq = trow - t * 64 - 4 * L.hi;
            if (!farT) fa::bias_near(p0, p1, dq, 1, lutcol);
            fa::mask_all(p0, p1, mine);
            if (t == qb) fa::mask_tile(p0, p1, dq, 0x40000000u);
            float alpha; fa::partialSM(p0, p1, m_reg, alpha);
            fa::rescale(o, alpha, al_l, L.r32, L.hi);
            bf16x8 a0, a1, a2, a3; const float ps = fa::finishSM(p0, p1, a0, a1, a2, a3); l_reg = l_reg * alpha + ps;
            fa::pv_tile(o, (int)(uintptr_t)(lds + fa::OFF_V + buf * fa::SHM_V) + L.vrd, a0, a1, a2, a3);
            }
            if (t + 1 < NT) { asm volatile("s_waitcnt vmcnt(0)" ::: "memory"); fa::stage_write(S, lds + fa::OFF_K + (buf ^ 1) * fa::SHM_K, lds + fa::OFF_V + (buf ^ 1) * fa::SHM_V, L.kws, L.vst0, L.vst1); }
            __syncthreads();
        }
        nsa_store<1>(o, l_reg, li_l, GL, OACC, nullptr, tok0, g, 1, L);
        __syncthreads();
    }
}
__device__ __forceinline__ void p3c_nsa_win(Frame& F, const Args& A) {
    unsigned char* ws = A.ws; const NsaLane L = nsa_lane(F);
    const bf16* P0 = (const bf16*)(ws + WS_P0); const float* GL = (const float*)(ws + WS_GL); float* OACC = (float*)(ws + WS_Z); bf16* OATT = (bf16*)(ws + WS_OATT0);
    nsa_lut(F, A);
    LAS char* lds = (LAS char*)(F.lds + RING_OFF);
    LAS float* wsf = (LAS float*)(lds + fa::OFF_WS) + L.wid * 64; LAS float* li_l = wsf; LAS float* al_l = wsf + 32;
    const LAS float* lut = (const LAS float*)(lds + fa::OFF_LUT);
    for (int u = F.vcu; u < 1024; u += F.G) {
        const int bg = u >> 7, qb = u & 127, b = bg >> 2, g = bg & 3;
        const int tok0 = b * SEQ + qb * 64;
        bf16x8 qr[8]; nsa_load_q(qr, P0, tok0, g, L);
        const int trow = qb * 64 + L.wid * 8 + L.ql;
        const int h = g * 4 + L.j; const LAS float* lutcol = lut + h * 144; const float bias_far = lutcol[128];
        const bf16* Kg = P0 + (size_t)b * SEQ * P0LD + COL_KW + g * 128; const bf16* Vg = P0 + (size_t)b * SEQ * P0LD + COL_VW + g * 128;
        const int t0 = max(0, qb - 8), NT = qb - t0 + 1;
        float m_reg = -1e30f, l_reg = 0.f; fa::f32x16 o[4];
#pragma unroll
        for (int d = 0; d < 4; ++d)
#pragma unroll
            for (int r = 0; r < 16; ++r) o[d][r] = 0.f;
        fa::Stage S;
        fa::stage_load(S, Kg, Vg, P0LD, t0 * 64, SEQ - 1, L.sr, L.sc); asm volatile("s_waitcnt vmcnt(0)" ::: "memory");
        fa::stage_write(S, lds + fa::OFF_K, lds + fa::OFF_V, L.kws, L.vst0, L.vst1);
        __syncthreads();
#pragma unroll 1
        for (int tt = 0; tt < NT; ++tt) {
            const int buf = tt & 1, t = t0 + tt;
            if (tt + 1 < NT) fa::stage_load(S, Kg, Vg, P0LD, (t + 1) * 64, SEQ - 1, L.sr, L.sc);
            fa::f32x16 p0, p1;
            const bool farT = (qb * 64 + L.wid * 8) - (t * 64 + 63) >= 128;
            fa::qkt(p0, p1, lds + fa::OFF_K + buf * fa::SHM_K, L.r32, L.hi, qr, farT ? bias_far : 0.f);
            const int dq = trow - t * 64 - 4 * L.hi;
            if (!farT) fa::bias_near(p0, p1, dq, 1, lutcol);
            if (t == qb || t == t0) fa::mask_tile(p0, p1, dq, 512u);
            float alpha; fa::partialSM(p0, p1, m_reg, alpha);
            fa::rescale(o, alpha, al_l, L.r32, L.hi);
            bf16x8 a0, a1, a2, a3; const float ps = fa::finishSM(p0, p1, a0, a1, a2, a3); l_reg = l_reg * alpha + ps;
            fa::pv_tile(o, (int)(uintptr_t)(lds + fa::OFF_V + buf * fa::SHM_V) + L.vrd, a0, a1, a2, a3);
            if (tt + 1 < NT) { asm volatile("s_waitcnt vmcnt(0)" ::: "memory"); fa::stage_write(S, lds + fa::OFF_K + (buf ^ 1) * fa::SHM_K, lds + fa::OFF_V + (buf ^ 1) * fa::SHM_V, L.kws, L.vst0, L.vst1); }
            __syncthreads();
        }
        nsa_store<2>(o, l_reg, li_l, GL, OACC, OATT, tok0, g, 2, L);
        __syncthreads();
    }
}

template <bool ROUTE, bool F8 = false>
__device__ __forceinline__ void ln_phase(Frame& F, const Args& A, const float* Z, const float* gam, const float* bet, float* XF, bf16* XB) {
    const int gw = F.vcu * NWAVES + F.wave, NGW = F.G * NWAVES, lane = F.lane;
    LAS float* wrl = (LAS float*)(F.lds + RING_OFF);
    if (ROUTE) { for (int i = F.tid; i < DM * 8 / 4; i += 512) *(LAS f32x4*)(wrl + i * 4) = *(const f32x4*)(A.in[18] + i * 4); __syncthreads(); }
    for (int row = gw; row < NTOK; row += NGW) {
        const f32x4* zr = (const f32x4*)(Z + (size_t)row * DM) + lane;
        f32x4 v[8]; float s = 0.f;
#pragma unroll
        for (int j = 0; j < 8; ++j) { v[j] = zr[64 * j]; s += (v[j][0] + v[j][1]) + (v[j][2] + v[j][3]); }
        const float mean = wave_sum(s) * (1.f / DM); float s2 = 0.f;
#pragma unroll
        for (int j = 0; j < 8; ++j) { v[j] = v[j] - mean; s2 += (v[j][0] * v[j][0] + v[j][1] * v[j][1]) + (v[j][2] * v[j][2] + v[j][3] * v[j][3]); }
        const float rstd = 1.f / sqrtf(wave_sum(s2) * (1.f / DM) + LN_EPS);
        float lg[8];
#pragma unroll
        for (int e = 0; e < 8; ++e) lg[e] = 0.f;
#pragma unroll
        for (int j = 0; j < 8; ++j) { const int c = 4 * lane + 256 * j; const f32x4 gg = *(const f32x4*)(gam + c), bb = *(const f32x4*)(bet + c);
            const f32x4 x = v[j] * rstd * gg + bb;
            *(f32x4*)(XF + (size_t)row * DM + c) = x;
            if (F8) { int w = __builtin_amdgcn_cvt_pk_fp8_f32(x[0], x[1], 0, false); w = __builtin_amdgcn_cvt_pk_fp8_f32(x[2], x[3], w, true); *(int*)((unsigned char*)XB + (size_t)row * DM + c) = w; }
            else { uint2 o; o.x = pk2(x[0], x[1]); o.y = pk2(x[2], x[3]); *(uint2*)(XB + (size_t)row * DM + c) = o; }
            asm volatile("" ::: "memory");
            if (ROUTE) { const LAS float* wr = wrl + c * 8;
#pragma unroll
                for (int q = 0; q < 4; ++q) { const f32x4 w0 = *(const LAS f32x4*)(wr + q * 8), w1 = *(const LAS f32x4*)(wr + q * 8 + 4);
                    lg[0] += x[q] * w0[0]; lg[1] += x[q] * w0[1]; lg[2] += x[q] * w0[2]; lg[3] += x[q] * w0[3]; lg[4] += x[q] * w1[0]; lg[5] += x[q] * w1[1]; lg[6] += x[q] * w1[2]; lg[7] += x[q] * w1[3]; }  asm volatile("" ::: "memory"); }
        }
        if (ROUTE) {
#pragma unroll
            for (int e = 0; e < 8; ++e) lg[e] = wave_sum(lg[e]) + A.in[19][e];
            int e0 = 0; float l0 = lg[0];
#pragma unroll
            for (int e = 1; e < 8; ++e) if (lg[e] > l0) { l0 = lg[e]; e0 = e; }
            int e1 = -1; float l1 = -3e38f;
#pragma unroll
            for (int e = 0; e < 8; ++e) if (e != e0 && lg[e] > l1) { l1 = lg[e]; e1 = e; }
            const float w0 = 1.0f / (1.0f + __expf(l1 - l0)), w1 = 1.0f - w0;
            if (lane == 0) {
                const unsigned p0 = __hip_atomic_fetch_add((unsigned*)(F.ctl + CW_MOECNT + 64 * e0), 1u, __ATOMIC_RELAXED, __HIP_MEMORY_SCOPE_AGENT);
                const unsigned p1 = __hip_atomic_fetch_add((unsigned*)(F.ctl + CW_MOECNT + 64 * e1), 1u, __ATOMIC_RELAXED, __HIP_MEMORY_SCOPE_AGENT);
                int* re = (int*)(A.ws + WS_ROUTE); int* rp = re + 2 * NTOK; float* rw = (float*)(rp + 2 * NTOK);
                re[2 * row] = e0; re[2 * row + 1] = e1; rp[2 * row] = (int)p0; rp[2 * row + 1] = (int)p1; rw[2 * row] = w0; rw[2 * row + 1] = w1;
            }
        }
    }
}

__device__ __forceinline__ void ln_route_phase(Frame& F, const Args& A, const float* Z, const float* gam, const float* bet, float* XF, bf16* XB) {
    const int gw = F.vcu * NWAVES + F.wave, NGW = F.G * NWAVES, lane = F.lane;
    LAS float* wrl = (LAS float*)(F.lds + RING_OFF);
    LAS float* rowb = (LAS float*)(F.lds + RING_OFF + 65536 + F.wave * 8192);
    for (int i = F.tid; i < DM * 8 / 4; i += 512) *(LAS f32x4*)(wrl + i * 4) = *(const f32x4*)(A.in[18] + i * 4);
    __syncthreads();
    for (int row = gw; row < NTOK; row += NGW) {
        float s = 0.f, s2 = 0.f;
#pragma unroll 1
        for (int j = 0; j < 8; ++j) { const f32x4 v = *(const f32x4*)(Z + (size_t)row * DM + 4 * lane + 256 * j); *(LAS f32x4*)(rowb + 4 * lane + 256 * j) = v;
            s += (v[0] + v[1]) + (v[2] + v[3]); }
        const float mean = wave_sum(s) * (1.f / DM);
#pragma unroll 1
        for (int j = 0; j < 8; ++j) { const f32x4 v = *(const LAS f32x4*)(rowb + 4 * lane + 256 * j) - mean; s2 += (v[0] * v[0] + v[1] * v[1]) + (v[2] * v[2] + v[3] * v[3]); }
        const float rstd = 1.f / sqrtf(wave_sum(s2) * (1.f / DM) + LN_EPS);
        float lg[8];
#pragma unroll
        for (int e = 0; e < 8; ++e) lg[e] = 0.f;
#pragma unroll 1
        for (int j = 0; j < 8; ++j) { const int c = 4 * lane + 256 * j; const f32x4 gg = *(const f32x4*)(gam + c), bb = *(const f32x4*)(bet + c);
            const f32x4 x = (*(const LAS f32x4*)(rowb + c) - mean) * rstd * gg + bb;
            *(f32x4*)(XF + (size_t)row * DM + c) = x;
            uint2 o; o.x = pk2(x[0], x[1]); o.y = pk2(x[2], x[3]); *(uint2*)(XB + (size_t)row * DM + c) = o;
            const LAS float* wr = wrl + c * 8;
#pragma unroll
            for (int q = 0; q < 4; ++q) { const f32x4 w0 = *(const LAS f32x4*)(wr + q * 8), w1 = *(const LAS f32x4*)(wr + q * 8 + 4);
                lg[0] += x[q] * w0[0]; lg[1] += x[q] * w0[1]; lg[2] += x[q] * w0[2]; lg[3] += x[q] * w0[3]; lg[4] += x[q] * w1[0]; lg[5] += x[q] * w1[1]; lg[6] += x[q] * w1[2]; lg[7] += x[q] * w1[3]; } }
#pragma unroll
        for (int e = 0; e < 8; ++e) lg[e] = wave_sum(lg[e]) + A.in[19][e];
        int e0 = 0; float l0 = lg[0];
#pragma unroll
        for (int e = 1; e < 8; ++e) if (lg[e] > l0) { l0 = lg[e]; e0 = e; }
        int e1 = -1; float l1 = -3e38f;
#pragma unroll
        for (int e = 0; e < 8; ++e) if (e != e0 && lg[e] > l1) { l1 = lg[e]; e1 = e; }
        const float w0 = 1.0f / (1.0f + __expf(l1 - l0)), w1 = 1.0f - w0;
        if (lane == 0) {
            const unsigned p0 = __hip_atomic_fetch_add((unsigned*)(F.ctl + CW_MOECNT + 64 * e0), 1u, __ATOMIC_RELAXED, __HIP_MEMORY_SCOPE_AGENT);
            const unsigned p1 = __hip_atomic_fetch_add((unsigned*)(F.ctl + CW_MOECNT + 64 * e1), 1u, __ATOMIC_RELAXED, __HIP_MEMORY_SCOPE_AGENT);
            int* re = (int*)(A.ws + WS_ROUTE); int* rp = re + 2 * NTOK; float* rw = (float*)(rp + 2 * NTOK);
            re[2 * row] = e0; re[2 * row + 1] = e1; rp[2 * row] = (int)p0; rp[2 * row + 1] = (int)p1; rw[2 * row] = w0; rw[2 * row + 1] = w1;
        }
        WSYNC();
    }
    __syncthreads();
}

__device__ __forceinline__ void p10_dsa_prep(Frame& F, const Args& A) {
    unsigned char* ws = A.ws; const int lane = F.lane;
    const int gw = F.vcu * NWAVES + F.wave, NGW = F.G * NWAVES;
    { const float* CR = (const float*)(ws + WS_CRAW); bf16* CN = (bf16*)(ws + WS_CN); const f32x4 gg = *(const f32x4*)(A.in[11] + 4 * lane);
      for (int row = gw; row < NTOK; row += NGW) { const f32x4 v = *(const f32x4*)(CR + (size_t)row * KVR + 4 * lane);
          const float ss = wave_sum(v[0] * v[0] + v[1] * v[1] + v[2] * v[2] + v[3] * v[3]); const float r = 1.f / sqrtf(ss * (1.f / KVR) + RMS_EPS);
          uint2 o; o.x = pk2(v[0] * r * gg[0], v[1] * r * gg[1]); o.y = pk2(v[2] * r * gg[2], v[3] * r * gg[3]); *(uint2*)(CN + (size_t)row * KVR + 4 * lane) = o;
          if (lane < 16) { const f32x4 kv = *(const f32x4*)((const float*)(ws + WS_KIWI) + (size_t)row * 128 + 4 * lane); uint2 k2; k2.x = pk2(kv[0], kv[1]); k2.y = pk2(kv[2], kv[3]); *(uint2*)((bf16*)(ws + WS_KIB) + (size_t)row * 64 + 4 * lane) = k2; } } }
    const bf16* Q = (const bf16*)(ws + WS_Q); const bf16* UKT = (const bf16*)(ws + WS_W_UK); bf16* QL = (bf16*)(ws + WS_QLAT);
    const int r16 = lane & 15, kq = lane >> 4; const float sc = 0.08838834764831845f;
    for (int it = gw; it < 512 * 16 * 4; it += NGW) {
        const int nc = it & 3, h = (it >> 2) & 15, mt = it >> 6;
        f32x4 acc[2][4];
#pragma unroll
        for (int m = 0; m < 2; ++m)
#pragma unroll
            for (int n = 0; n < 4; ++n) acc[m][n] = (f32x4){0.f, 0.f, 0.f, 0.f};
#pragma unroll
        for (int ks = 0; ks < 4; ++ks) { s8v af[2], bfr[4];
#pragma unroll
            for (int m = 0; m < 2; ++m) af[m] = ld_frag(Q + (size_t)(mt * 32 + m * 16 + r16) * DM + h * 128 + ks * 32 + kq * 8);
#pragma unroll
            for (int n = 0; n < 4; ++n) bfr[n] = ld_frag(UKT + ((size_t)h * 256 + nc * 64 + n * 16 + r16) * 128 + ks * 32 + kq * 8);
#pragma unroll
            for (int m = 0; m < 2; ++m)
#pragma unroll
                for (int n = 0; n < 4; ++n) acc[m][n] = __builtin_amdgcn_mfma_f32_16x16x32_bf16(af[m], bfr[n], acc[m][n], 0, 0, 0); }
#pragma unroll
        for (int m = 0; m < 2; ++m)
#pragma unroll
            for (int n = 0; n < 4; ++n)
#pragma unroll
                for (int j = 0; j < 4; ++j) QL[(size_t)(mt * 32 + m * 16 + kq * 4 + j) * 4096 + h * 256 + nc * 64 + n * 16 + r16] = (bf16)f2bf(acc[m][n][j] * sc);
    }
}
__device__ __forceinline__ void p12_dsa_uv(Frame& F, const Args& A) {
    unsigned char* ws = A.ws; const int lane = F.lane;
    const int gw = F.vcu * NWAVES + F.wave, NGW = F.G * NWAVES;
    const bf16* OL = (const bf16*)(ws + WS_OLAT); const bf16* UVT = (const bf16*)(ws + WS_W_UV); bf16* O = (bf16*)(ws + WS_OATT1);
    const int r16 = lane & 15, kq = lane >> 4;
    for (int it = gw; it < 512 * 16 * 2; it += NGW) {
        const int nc = it & 1, h = (it >> 1) & 15, mt = it >> 5;
        f32x4 acc[2][4];
#pragma unroll
        for (int m = 0; m < 2; ++m)
#pragma unroll
            for (int n = 0; n < 4; ++n) acc[m][n] = (f32x4){0.f, 0.f, 0.f, 0.f};
#pragma unroll
        for (int ks = 0; ks < 8; ++ks) { s8v af[2], bfr[4];
#pragma unroll
            for (int m = 0; m < 2; ++m) af[m] = ld_frag(OL + (size_t)(mt * 32 + m * 16 + r16) * 4096 + h * 256 + ks * 32 + kq * 8);
#pragma unroll
            for (int n = 0; n < 4; ++n) bfr[n] = ld_frag(UVT + ((size_t)h * 128 + nc * 64 + n * 16 + r16) * 256 + ks * 32 + kq * 8);
#pragma unroll
            for (int m = 0; m < 2; ++m)
#pragma unroll
                for (int n = 0; n < 4; ++n) acc[m][n] = __builtin_amdgcn_mfma_f32_16x16x32_bf16(af[m], bfr[n], acc[m][n], 0, 0, 0); }
#pragma unroll
        for (int m = 0; m < 2; ++m)
#pragma unroll
            for (int n = 0; n < 4; ++n)
#pragma unroll
                for (int j = 0; j < 4; ++j) O[(size_t)(mt * 32 + m * 16 + kq * 4 + j) * DM + h * 128 + nc * 64 + n * 16 + r16] = (bf16)f2bf(acc[m][n][j]);
    }
}

__device__ __forceinline__ unsigned f2key(float f) { const unsigned u = __float_as_uint(f); return (u & 0x80000000u) ? ~u : (u | 0x80000000u); }

__device__ __forceinline__ unsigned dsa_off_b(unsigned row, unsigned ch) { return 256u * row + 16u * (ch ^ (((row & 3) << 2) | ((row >> 2) & 3))); }

__device__ __forceinline__ void p13a_dsa_index(Frame& F, const Args& A) {
    unsigned char* ws = A.ws; const int lane = F.lane, wid = F.wave, r32 = lane & 31, hi = lane >> 5;
    const bf16* QI = (const bf16*)(ws + WS_QI); const bf16* KIB = (const bf16*)(ws + WS_KIB); const float* KIWI = (const float*)(ws + WS_KIWI); int* IDX = (int*)(ws + WS_IDX);
    LAS float* sc = (LAS float*)(F.lds + RING_OFF);
    LAS unsigned* hist = (LAS unsigned*)(F.lds + DSA_SCR);
    LAS unsigned* cntG = hist + 1024;
    LAS unsigned* cntE = cntG + 512;
    LAS unsigned* qm = cntE + 512;
    const int q = wid >> 1, sub = wid & 1, th = sub * 64 + lane;
    for (int slot = F.vcu; slot < NTOK / 4; slot += F.G) {
        const int rowi = slot >> 8; int cc = slot & 255; if (rowi & 1) cc = 255 - cc;
        const int tok0 = (rowi * 256 + cc) * 4, b = tok0 >> 13, t0 = tok0 & (SEQ - 1), tmax = t0 + 3;
        bf16x8 qa[4];
#pragma unroll
        for (int s = 0; s < 4; ++s) qa[s] = *(const bf16x8*)(QI + (size_t)(tok0 + (r32 >> 3)) * 512 + (r32 & 7) * 64 + 16 * s + 8 * hi);
        float wv[16];
#pragma unroll
        for (int r = 0; r < 16; ++r) wv[r] = KIWI[(size_t)(tok0 + (r >> 2)) * 128 + 64 + (r & 3) + 4 * hi] * 0.35355339059327373f;
        const int ntiles = (tmax >> 5) + 1;
#ifndef PROBE_IDX2
#define PROBE_IDX2 0
#endif
#ifndef PROBE_SEL2
#define PROBE_SEL2 0
#endif
        for (int rep2_ = 0; rep2_ < (PROBE_IDX2 ? 2 : 1); ++rep2_)
        {
            bf16x8 kb[4], kn[4]; int tile = wid;
#pragma unroll
            for (int s = 0; s < 4; ++s) kb[s] = (bf16x8){0, 0, 0, 0, 0, 0, 0, 0};
            if (tile < ntiles) { const bf16* kp = KIB + (size_t)(b * SEQ + tile * 32 + r32) * 64 + 8 * hi;
#pragma unroll
                for (int s = 0; s < 4; ++s) kb[s] = *(const bf16x8*)(kp + 16 * s); }
#pragma unroll
            for (int s = 0; s < 4; ++s) kn[s] = (bf16x8){0, 0, 0, 0, 0, 0, 0, 0};
            while (tile < ntiles) {
                const int tn = tile + 8;
                if (tn < ntiles) { const bf16* kp = KIB + (size_t)(b * SEQ + tn * 32 + r32) * 64 + 8 * hi;
#pragma unroll
                    for (int s = 0; s < 4; ++s) kn[s] = *(const bf16x8*)(kp + 16 * s); }
                const int key = tile * 32 + r32;
                fa::f32x16 acc;
#pragma unroll
                for (int r = 0; r < 16; ++r) acc[r] = 0.f;
#pragma unroll
                for (int s = 0; s < 4; ++s) acc = __builtin_amdgcn_mfma_f32_32x32x16_bf16(qa[s], kb[s], acc, 0, 0, 0);
#pragma unroll
                for (int qq = 0; qq < 4; ++qq) { float part = 0.f;
#pragma unroll
                    for (int r3 = 0; r3 < 4; ++r3) part += wv[4 * qq + r3] * fmaxf(acc[4 * qq + r3], 0.f);
                    const float tot = part + __shfl_xor(part, 32);
                    if ((qq >> 1) == hi) sc[qq * 8192 + key] = tot + 0.0f; }
#pragma unroll
                for (int s = 0; s < 4; ++s) kb[s] = kn[s];
                tile = tn;
            }
        }
        __syncthreads();
        const int tok = tok0 + q, n = t0 + q + 1;
        for (int rep3_ = 0; rep3_ < (PROBE_SEL2 ? 2 : 1); ++rep3_) {
        if (tmax + 1 <= TOPK) {
            for (int i = th; i < TOPK; i += 128) IDX[(size_t)tok * TOPK + i] = (i < n) ? i : 0;
        } else {
            const LAS float* scq = sc + q * 8192; const int nsl = (n + 127) >> 7;
#ifndef PROBE_T2
#define PROBE_T2 0
#endif
#ifndef PROBE_C2
#define PROBE_C2 0
#endif
            unsigned T_out = 0u, need_out = 0u;
            for (int repa_ = 0; repa_ < (PROBE_T2 ? 2 : 1); ++repa_) { if (repa_) __syncthreads();
            unsigned mnv = 0xffffffffu, mxv = 0u;
            for (int s0 = 0; s0 < nsl; s0 += 8) { float v[8];
#pragma unroll
                for (int j = 0; j < 8; ++j) { const int i = (s0 + j) * 128 + th; v[j] = scq[min(i, n - 1)]; }
#pragma unroll
                for (int j = 0; j < 8; ++j) { const int i = (s0 + j) * 128 + th; const bool ok = i < n; const unsigned k = f2key(v[j]); mnv = min(mnv, ok ? k : 0xffffffffu); mxv = max(mxv, ok ? k : 0u); } }
#pragma unroll
            for (int o = 1; o < 64; o <<= 1) { mnv = min(mnv, (unsigned)__shfl_xor((int)mnv, o)); mxv = max(mxv, (unsigned)__shfl_xor((int)mxv, o)); }
            if (lane == 0) { qm[q * 16 + 4 + sub * 2] = mnv; qm[q * 16 + 5 + sub * 2] = mxv; }
            __syncthreads();
            mnv = min(qm[q * 16 + 4], qm[q * 16 + 6]); mxv = max(qm[q * 16 + 5], qm[q * 16 + 7]);
            unsigned need = TOPK; unsigned long long inb = 0ull;
            const float fmn = __uint_as_float((mnv & 0x80000000u) ? (mnv & 0x7fffffffu) : ~mnv), fmx = __uint_as_float((mxv & 0x80000000u) ? (mxv & 0x7fffffffu) : ~mxv);
            const float bsc = (fmx > fmn) ? 255.99f / (fmx - fmn) : 0.f;
            hist[q * 256 + th] = 0u; hist[q * 256 + 128 + th] = 0u;
            __syncthreads();
            for (int s0 = 0; s0 < nsl; s0 += 8) { float v[8];
#pragma unroll
                for (int j = 0; j < 8; ++j) { const int i = (s0 + j) * 128 + th; v[j] = scq[min(i, n - 1)]; }
#pragma unroll
                for (int j = 0; j < 8; ++j) { const int i = (s0 + j) * 128 + th; const int bin = min(max((int)((v[j] + 0.0f - fmn) * bsc), 0), 255);
                    LAS unsigned* tgt = (i < n) ? &hist[q * 256 + bin] : &qm[q * 16 + 8];
                    __hip_atomic_fetch_add(tgt, 1u, __ATOMIC_RELAXED, __HIP_MEMORY_SCOPE_WORKGROUP); } }
            __syncthreads();
            if (sub == 0) {
                const v4u c4 = *(const LAS v4u*)(hist + q * 256 + 4 * lane); const unsigned s4 = c4.x + c4.y + c4.z + c4.w; unsigned S = s4;
#pragma unroll
                for (int o = 1; o < 64; o <<= 1) { const unsigned v = __shfl_down(S, o); if (lane + o < 64) S += v; }
                const unsigned above = S - s4;
                if (above < need && need <= S) { unsigned cum = above; int bin;
                    if (cum + c4.w >= need) bin = 3; else { cum += c4.w; if (cum + c4.z >= need) bin = 2; else { cum += c4.z; if (cum + c4.y >= need) bin = 1; else { cum += c4.y; bin = 0; } } }
                    qm[q * 16 + 0] = (unsigned)(4 * lane + bin); qm[q * 16 + 1] = need - cum; }
            }
            __syncthreads();
            { const int bstar = (int)qm[q * 16 + 0]; need = qm[q * 16 + 1];
              for (int s0 = 0; s0 < nsl; s0 += 8) { float v[8];
#pragma unroll
                  for (int j = 0; j < 8; ++j) { const int i = (s0 + j) * 128 + th; v[j] = scq[min(i, n - 1)]; }
#pragma unroll
                  for (int j = 0; j < 8; ++j) { const int i = (s0 + j) * 128 + th; const int bin = min(max((int)((v[j] + 0.0f - fmn) * bsc), 0), 255); inb |= (i < n && bin == bstar) ? (1ull << (s0 + j)) : 0ull; } } }
            int hib = 32; unsigned pmask = 0u, prefix = 0u;
#pragma unroll 1
            for (int pass = 0; pass < 4; ++pass) {
                const int lob = hib - 8; const unsigned dmask = 255u;
                hist[q * 256 + th] = 0u; hist[q * 256 + 128 + th] = 0u;
                __syncthreads();
                for (int s2 = 0; s2 < nsl; ++s2) { if ((inb >> s2) & 1ull) { const unsigned k = f2key(scq[s2 * 128 + th]); if ((k & pmask) == prefix) __hip_atomic_fetch_add(&hist[q * 256 + ((k >> lob) & dmask)], 1u, __ATOMIC_RELAXED, __HIP_MEMORY_SCOPE_WORKGROUP); } }
                __syncthreads();
                if (sub == 0) {
                    const v4u c4 = *(const LAS v4u*)(hist + q * 256 + 4 * lane); const unsigned s4 = c4.x + c4.y + c4.z + c4.w; unsigned S = s4;
#pragma unroll
                    for (int o = 1; o < 64; o <<= 1) { const unsigned v = __shfl_down(S, o); if (lane + o < 64) S += v; }
                    const unsigned above = S - s4;
                    if (above < need && need <= S) { unsigned cum = above; int bin;
                        if (cum + c4.w >= need) bin = 3; else { cum += c4.w; if (cum + c4.z >= need) bin = 2; else { cum += c4.z; if (cum + c4.y >= need) bin = 1; else { cum += c4.y; bin = 0; } } }
                        qm[q * 16 + 0] = prefix | ((unsigned)(4 * lane + bin) << lob); qm[q * 16 + 1] = need - cum; }
                }
                __syncthreads();
                prefix = qm[q * 16 + 0]; need = qm[q * 16 + 1]; pmask |= (dmask << lob); hib = lob;
            }
            T_out = prefix; need_out = need; }
            const unsigned T = T_out; const unsigned need = need_out;
            for (int repc_ = 0; repc_ < (PROBE_C2 ? 2 : 1); ++repc_) { if (repc_) __syncthreads();
            unsigned myG = 0u, myE = 0u;
            for (int s0 = 0; s0 < nsl; s0 += 8) { float v[8];
#pragma unroll
                for (int j = 0; j < 8; ++j) { const int i = (s0 + j) * 128 + th; v[j] = scq[min(i, n - 1)]; }
#pragma unroll
                for (int j = 0; j < 8; ++j) { const int s2 = s0 + j, i = s2 * 128 + th; const bool ok = i < n; const unsigned k = f2key(v[j]); const unsigned long long bg = __ballot(ok && k > T), be = __ballot(ok && k == T);
                    const unsigned cg = (unsigned)__popcll(bg), ce = (unsigned)__popcll(be); myG = (lane == s2) ? cg : myG; myE = (lane == s2) ? ce : myE; } }
            cntG[(q * 2 + sub) * 64 + lane] = myG; cntE[(q * 2 + sub) * 64 + lane] = myE;
            __syncthreads();
            unsigned tbase, pbase;
            { const unsigned e0 = cntE[(q * 2) * 64 + lane], e1 = cntE[(q * 2 + 1) * 64 + lane], g0 = cntG[(q * 2) * 64 + lane], g1 = cntG[(q * 2 + 1) * 64 + lane];
              unsigned inc = e0 + e1;
#pragma unroll
              for (int o = 1; o < 64; o <<= 1) { const unsigned v = __shfl_up(inc, o); if (lane >= o) inc += v; }
              const unsigned tb0 = inc - (e0 + e1), tb1 = tb0 + e0;
              const unsigned se0 = (need > tb0) ? min(need - tb0, e0) : 0u, se1 = (need > tb1) ? min(need - tb1, e1) : 0u;
              const unsigned c0 = g0 + se0, c1 = g1 + se1; unsigned inc2 = c0 + c1;
#pragma unroll
              for (int o = 1; o < 64; o <<= 1) { const unsigned v = __shfl_up(inc2, o); if (lane >= o) inc2 += v; }
              const unsigned pb0 = inc2 - (c0 + c1);
              tbase = sub ? tb1 : tb0; pbase = sub ? pb0 + c0 : pb0; }
            for (int s0 = 0; s0 < nsl; s0 += 8) { float v[8];
#pragma unroll
            for (int j = 0; j < 8; ++j) { const int i = (s0 + j) * 128 + th; v[j] = scq[min(i, n - 1)]; }
#pragma unroll
            for (int j = 0; j < 8; ++j) { const int s2 = s0 + j; if (s2 < nsl) { const int i = s2 * 128 + th; const bool ok = i < n; const unsigned k = f2key(v[j]); const bool g = ok && k > T, e = ok && k == T;
                const unsigned long long be = __ballot(e);
                const unsigned trank = (unsigned)__builtin_amdgcn_readlane((int)tbase, s2) + __builtin_amdgcn_mbcnt_hi((unsigned)(be >> 32), __builtin_amdgcn_mbcnt_lo((unsigned)be, 0u));
                const bool sel = g || (e && trank < need);
                const unsigned long long bs = __ballot(sel);
                const unsigned pos = (unsigned)__builtin_amdgcn_readlane((int)pbase, s2) + __builtin_amdgcn_mbcnt_hi((unsigned)(bs >> 32), __builtin_amdgcn_mbcnt_lo((unsigned)bs, 0u));
                if (sel && pos < (unsigned)TOPK) IDX[(size_t)tok * TOPK + pos] = i; } } }
            }
        }
        __syncthreads();
        }
    }
}

__device__ __forceinline__ void p13b_dsa_attn(Frame& F, const Args& A) {
    unsigned char* ws = A.ws; const int lane = F.lane, wid = F.wave, c16 = lane & 15, g4 = lane >> 4;
    const bf16* CN = (const bf16*)(ws + WS_CN); const bf16* QL = (const bf16*)(ws + WS_QLAT); const int* IDX = (const int*)(ws + WS_IDX); bf16* OL = (bf16*)(ws + WS_OLAT);
    LAS float* lut = (LAS float*)(F.lds + DSA_SCR + 8192);
    for (int i = F.tid; i < 144 * 16; i += 512) { const int n = i >> 4, h = i & 15; lut[i] = A.in[1][rel_bucket(n) * 16 + h]; }
    __syncthreads();
    LAS char* img = (LAS char*)(F.lds + RING_OFF + wid * 16384);
    LAS int* idxw = (LAS int*)(F.lds + DSA_SCR + wid * 1024);
    const unsigned imgb = (unsigned)(uintptr_t)img;
    const int gw = F.vcu * NWAVES + wid, NGW = F.G * NWAVES;
    const unsigned prow0 = 8u * ((lane >> 2) & 3) + (lane & 3);
    unsigned ta0[8], ta1[8];
    { const unsigned qq = (lane & 15) >> 2, pp = lane & 3;
#pragma unroll
      for (int c = 0; c < 8; ++c) { ta0[c] = imgb + dsa_off_b(8 * g4 + qq, 2 * c + (pp >> 1)) + 8 * (pp & 1); ta1[c] = imgb + dsa_off_b(8 * g4 + 4 + qq, 2 * c + (pp >> 1)) + 8 * (pp & 1); } }
    for (int tok = gw; tok < NTOK; tok += NGW) {
        const int b = tok >> 13, t = tok & (SEQ - 1), cnt = min(TOPK, t + 1), ntile = (cnt + 31) >> 5;
        bf16x8 qb[8];
#pragma unroll
        for (int ks = 0; ks < 8; ++ks) qb[ks] = *(const bf16x8*)(QL + (size_t)tok * 4096 + c16 * 256 + ks * 32 + g4 * 8);
#pragma unroll
        for (int i = 0; i < 4; ++i) idxw[lane + 64 * i] = IDX[(size_t)tok * TOPK + lane + 64 * i];
        WSYNC();
        f32x4 o[16];
#pragma unroll
        for (int ct = 0; ct < 16; ++ct) o[ct] = (f32x4){0.f, 0.f, 0.f, 0.f};
        float m_run = -1e30f, l_run = 0.f;
        const LAS float* lutcol = lut + c16;
#pragma unroll 1
        for (int tile = 0; tile < ntile; ++tile) {
            { v4u st[16];
#pragma unroll
              for (int i = 0; i < 16; ++i) { const int nn = lane + 64 * i, row = nn >> 5, chg = nn & 31; const int key = idxw[tile * 32 + row];
                  st[i] = *(const v4u*)(CN + (size_t)(b * SEQ + key) * KVR + chg * 8); }
#pragma unroll
              for (int i = 0; i < 16; ++i) { const int nn = lane + 64 * i, row = nn >> 5, chg = nn & 31;
                  *(LAS v4u*)(img + (chg >> 4) * 8192 + dsa_off_b(row, chg & 15)) = st[i]; } }
            WSYNC();
            f32x4 sacc[2];
#pragma unroll
            for (int T = 0; T < 2; ++T) { sacc[T] = (f32x4){0.f, 0.f, 0.f, 0.f};
#pragma unroll
                for (int ks = 0; ks < 8; ++ks) { const bf16x8 a = *(const LAS bf16x8*)(img + (ks >> 2) * 8192 + dsa_off_b(prow0 + 4 * T, 4 * (ks & 3) + g4));
                    sacc[T] = __builtin_amdgcn_mfma_f32_16x16x32_bf16(a, qb[ks], sacc[T], 0, 0, 0); } }
            float pmax = -__builtin_inff();
#pragma unroll
            for (int T = 0; T < 2; ++T) { const int i0 = tile * 32 + 8 * g4 + 4 * T; const v4u kk = *(const LAS v4u*)(idxw + i0);
                const int kidx[4] = {(int)kk.x, (int)kk.y, (int)kk.z, (int)kk.w};
#pragma unroll
                for (int e = 0; e < 4; ++e) { const int dist = min(max(t - kidx[e], 0), 128); float s = sacc[T][e] + lutcol[dist * 16];
                    s = (i0 + e < cnt) ? s : -__builtin_inff(); sacc[T][e] = s; pmax = fmaxf(pmax, s); } }
            pmax = fmaxf(pmax, __shfl_xor(pmax, 16)); pmax = fmaxf(pmax, __shfl_xor(pmax, 32));
            const float mn = fmaxf(m_run, pmax), alpha = __builtin_amdgcn_exp2f((m_run - mn) * fa::C2); m_run = mn;
            float ps = 0.f;
#pragma unroll
            for (int T = 0; T < 2; ++T)
#pragma unroll
                for (int e = 0; e < 4; ++e) { const float pv = __builtin_amdgcn_exp2f((sacc[T][e] - mn) * fa::C2); sacc[T][e] = pv; ps += pv; }
            ps += __shfl_xor(ps, 16); ps += __shfl_xor(ps, 32);
            l_run = l_run * alpha + ps;
            if (__any(alpha < 1.f)) {
                float al[4];
#pragma unroll
                for (int e = 0; e < 4; ++e) al[e] = __shfl(alpha, 4 * g4 + e);
#pragma unroll
                for (int ct = 0; ct < 16; ++ct)
#pragma unroll
                    for (int e = 0; e < 4; ++e) o[ct][e] *= al[e];
            }
            fa::u32x4v pw; pw.x = fa::cvtpk(sacc[0][0], sacc[0][1]); pw.y = fa::cvtpk(sacc[0][2], sacc[0][3]); pw.z = fa::cvtpk(sacc[1][0], sacc[1][1]); pw.w = fa::cvtpk(sacc[1][2], sacc[1][3]);
            const bf16x8 pa = *reinterpret_cast<bf16x8*>(&pw);
#pragma unroll
            for (int cg = 0; cg < 4; ++cg) { fa::s16x4 b0[4], b1[4];
                asm volatile("ds_read_b64_tr_b16 %0, %8 offset:%c16\n\tds_read_b64_tr_b16 %1, %9 offset:%c16\n\tds_read_b64_tr_b16 %2, %10 offset:%c16\n\tds_read_b64_tr_b16 %3, %11 offset:%c16\n\t"
                             "ds_read_b64_tr_b16 %4, %12 offset:%c16\n\tds_read_b64_tr_b16 %5, %13 offset:%c16\n\tds_read_b64_tr_b16 %6, %14 offset:%c16\n\tds_read_b64_tr_b16 %7, %15 offset:%c16\n\ts_waitcnt lgkmcnt(0)"
                             : "=&v"(b0[0]), "=&v"(b1[0]), "=&v"(b0[1]), "=&v"(b1[1]), "=&v"(b0[2]), "=&v"(b1[2]), "=&v"(b0[3]), "=&v"(b1[3])
                             : "v"(ta0[(cg & 1) * 4 + 0]), "v"(ta1[(cg & 1) * 4 + 0]), "v"(ta0[(cg & 1) * 4 + 1]), "v"(ta1[(cg & 1) * 4 + 1]), "v"(ta0[(cg & 1) * 4 + 2]), "v"(ta1[(cg & 1) * 4 + 2]), "v"(ta0[(cg & 1) * 4 + 3]), "v"(ta1[(cg & 1) * 4 + 3]), "i"((cg >> 1) * 8192) : "memory");
                FA_SBAR();
#pragma unroll
                for (int k = 0; k < 4; ++k) o[cg * 4 + k] = __builtin_amdgcn_mfma_f32_16x16x32_bf16(pa, (bf16x8){b0[k][0], b0[k][1], b0[k][2], b0[k][3], b1[k][0], b1[k][1], b1[k][2], b1[k][3]}, o[cg * 4 + k], 0, 0, 0); }
            WSYNC();
        }
        { const float il = (l_run > 0.f) ? 1.0f / l_run : 0.f; float ile[4];
#pragma unroll
          for (int e = 0; e < 4; ++e) ile[e] = __shfl(il, 4 * g4 + e);
#pragma unroll
          for (int ct = 0; ct < 16; ++ct)
#pragma unroll
              for (int e = 0; e < 4; ++e) { const float v = o[ct][e] * ile[e]; const float vn = __shfl_xor(v, 1);
                  if ((lane & 1) == 0) *(unsigned*)(OL + (size_t)tok * 4096 + (4 * g4 + e) * 256 + ct * 16 + c16) = fa::cvtpk(v, vn); } }
        WSYNC();
    }
    __syncthreads();
}

struct MoeTiles { int tend[8]; int pstart[8]; int MT; };
__device__ __forceinline__ void moe_tiles(Frame& F, MoeTiles& T) {
    int acc = 0;
#pragma unroll
    for (int e = 0; e < 8; ++e) { const int c = (int)__builtin_amdgcn_readfirstlane(__hip_atomic_load((unsigned*)(F.ctl + CW_MOECNT + 64 * e), __ATOMIC_RELAXED, __HIP_MEMORY_SCOPE_AGENT));
        T.pstart[e] = acc * 256; acc += (c + 255) >> 8; T.tend[e] = acc; }
    T.MT = acc;
}
__device__ __forceinline__ void p15_gather(Frame& F, const Args& A) {
    MoeTiles T; moe_tiles(F, T);
    const int gw = F.vcu * NWAVES + F.wave, NGW = F.G * NWAVES, lane = F.lane;
    const float* XF = (const float*)(A.ws + WS_XF); unsigned char* XG = (unsigned char*)(A.ws + WS_XG);
    const int* re = (const int*)(A.ws + WS_ROUTE); const int* rp = re + 2 * NTOK;
    for (int tok = gw; tok < NTOK; tok += NGW) {
        v4u v[2];
#pragma unroll
        for (int j = 0; j < 2; ++j) { const float* src = XF + (size_t)tok * DM + 16 * lane + 1024 * j; int w[4];
#pragma unroll
            for (int q = 0; q < 4; ++q) { const f32x4 x = *(const f32x4*)(src + 4 * q); w[q] = __builtin_amdgcn_cvt_pk_fp8_f32(x[0], x[1], 0, false); w[q] = __builtin_amdgcn_cvt_pk_fp8_f32(x[2], x[3], w[q], true); }
            v[j].x = (unsigned)w[0]; v[j].y = (unsigned)w[1]; v[j].z = (unsigned)w[2]; v[j].w = (unsigned)w[3]; }
#pragma unroll
        for (int s = 0; s < 2; ++s) { const int e = re[2 * tok + s], p = rp[2 * tok + s]; int ps = 0;
#pragma unroll
            for (int q = 0; q < 8; ++q) ps = (q == e) ? T.pstart[q] : ps;
            unsigned char* dst = XG + (size_t)(ps + p) * DM + 16 * lane;
#pragma unroll
            for (int j = 0; j < 2; ++j) *(v4u*)(dst + 1024 * j) = v[j]; }
    }
}
__device__ __forceinline__ void p18_final(Frame& F, const Args& A) {
    MoeTiles T; moe_tiles(F, T);
    const int gw = F.vcu * NWAVES + F.wave, NGW = F.G * NWAVES, lane = F.lane;
    const float* XF = (const float*)(A.ws + WS_XF); const float* Y = (const float*)(A.ws + WS_Y);
    const int* re = (const int*)(A.ws + WS_ROUTE); const int* rp = re + 2 * NTOK; const float* rw = (const float*)(rp + 2 * NTOK);
    const float* gam = A.in[25] + DM; const float* bet = A.in[26] + DM;
    for (int tok = gw; tok < NTOK; tok += NGW) {
        int rows[2]; float w[2];
#pragma unroll
        for (int s = 0; s < 2; ++s) { const int e = re[2 * tok + s]; int ps = 0;
#pragma unroll
            for (int q = 0; q < 8; ++q) ps = (q == e) ? T.pstart[q] : ps;
            rows[s] = ps + rp[2 * tok + s]; w[s] = rw[2 * tok + s]; }
        const f32x4* xr = (const f32x4*)(XF + (size_t)tok * DM) + lane; const f32x4* y0 = (const f32x4*)(Y + (size_t)rows[0] * DM) + lane; const f32x4* y1 = (const f32x4*)(Y + (size_t)rows[1] * DM) + lane;
        f32x4 v[8]; float s = 0.f;
#pragma unroll
        for (int j = 0; j < 8; ++j) { v[j] = xr[64 * j] * ALPHA + y0[64 * j] * w[0] + y1[64 * j] * w[1]; s += (v[j][0] + v[j][1]) + (v[j][2] + v[j][3]); }
        const float mean = wave_sum(s) * (1.f / DM); float s2 = 0.f;
#pragma unroll
        for (int j = 0; j < 8; ++j) { v[j] = v[j] - mean; s2 += (v[j][0] * v[j][0] + v[j][1] * v[j][1]) + (v[j][2] * v[j][2] + v[j][3] * v[j][3]); }
        const float rstd = 1.f / sqrtf(wave_sum(s2) * (1.f / DM) + LN_EPS);
#pragma unroll
        for (int j = 0; j < 8; ++j) { const int c = 4 * lane + 256 * j; const f32x4 gg = *(const f32x4*)(gam + c), bb = *(const f32x4*)(bet + c);
            *(f32x4*)(A.out + (size_t)tok * DM + c) = v[j] * rstd * gg + bb; }
    }
}

__global__ void __launch_bounds__(NWAVES * 64, 2) mega_fwd(Args args) {
    extern __shared__ __attribute__((aligned(16))) unsigned char lds[];
    Frame F;
    F.lds = (LAS unsigned char*)lds;
    F.MISC = (volatile LAS unsigned*)(F.lds + MISC_OFF);
    F.tid = threadIdx.x; F.lane = F.tid & 63; F.wave = __builtin_amdgcn_readfirstlane(F.tid >> 6);
    F.G = gridDim.x; { const int bx = blockIdx.x; F.vcu = (F.G % 8 == 0) ? (bx % 8) * (F.G / 8) + bx / 8 : bx; }
    unsigned char* ws = args.ws;
    F.ctl = (gu32*)(ws + WS_CTL);
    for (int u = F.tid; u < (LDS_BYTES - LDSCTL_OFF) / 4; u += NWAVES * 64) ((LAS unsigned*)(F.lds + LDSCTL_OFF))[u] = 0u;
    __syncthreads();
    XcdBarrier bar; bar.bar = (unsigned*)(F.ctl + CW_BAR); bar.x = 0; bar.st = nullptr;
#if !MK_PER_PHASE
    bar = xcd_barrier_post((unsigned*)(F.ctl + CW_BAR), F.MISC + 8);
#define GRID_BAR() xcd_barrier(bar)
#else
#define GRID_BAR() do { } while (0)
#endif
    const int lo = args.ph_lo, hi = args.ph_hi;
#ifndef PH_MASK
#define PH_MASK 0x3fffff
#endif
#define IN(k) (((PH_MASK >> (k)) & 1) && lo <= (k) && (k) < hi)
#define BOTH(k) (IN(k) && IN((k) + 1))
    bf16* XB = (bf16*)(ws + WS_XB); float* XF = (float*)(ws + WS_XF); float* Z = (float*)(ws + WS_Z);

#ifndef PROBE_MASK
#define PROBE_MASK 0
#endif
#define REPS(k) ((((PROBE_MASK) >> (k)) & 1) ? 2 : 1)
    if (IN(0)) for (int rep_ = 0; rep_ < REPS(0); ++rep_) { relaunder(F); p0_prologue(F, args); if (BOTH(0) || rep_ + 1 < REPS(0)) GRID_BAR(); }
    if (IN(1)) for (int rep_ = 0; rep_ < REPS(1); ++rep_) { relaunder(F);
        pg8::Gemm g{XB, (const bf16*)(ws + WS_W_NSA_IN), NTOK, NSA_NPAD, DM}; pg8::StaticOrder S; S.init(NTOK, NSA_NPAD, F.G, (int)blockIdx.x);
        pg8::EpiNsaIn E{(bf16*)(ws + WS_P0), (float*)(ws + WS_GL), 0.08838834764831845f};
        pg8::gemm_phase<pg8::EpiNsaIn, pg8::StaticOrder, true, true>(F.lds + RING_OFF, g, S, E);
        if (BOTH(1) || rep_ + 1 < REPS(1)) GRID_BAR();
    }
    if (IN(2)) for (int rep_ = 0; rep_ < REPS(2); ++rep_) { relaunder(F); p2_compress(F, args); if (BOTH(2) || rep_ + 1 < REPS(2)) GRID_BAR(); }
#ifndef PROBE_NSA2
#define PROBE_NSA2 0
#endif
    for (int repn_ = 0; repn_ < (PROBE_NSA2 ? 2 : 1); ++repn_) {
    if (IN(3)) for (int rep_ = 0; rep_ < REPS(3); ++rep_) { relaunder(F); p3a_nsa_cmp(F, args); if (BOTH(3) || rep_ + 1 < REPS(3)) GRID_BAR(); }
    if (IN(4)) for (int rep_ = 0; rep_ < REPS(4); ++rep_) { relaunder(F); p3b_nsa_sel(F, args); if (BOTH(4) || rep_ + 1 < REPS(4) || repn_ + 1 < (PROBE_NSA2 ? 2 : 1)) GRID_BAR(); }
    }
    if (IN(5)) for (int rep_ = 0; rep_ < REPS(5); ++rep_) { relaunder(F); p3c_nsa_win(F, args); if (BOTH(5) || rep_ + 1 < REPS(5)) GRID_BAR(); }
    if (IN(6)) for (int rep_ = 0; rep_ < REPS(6); ++rep_) { relaunder(F);
        pg8::Gemm g{(const bf16*)(ws + WS_OATT0), (const bf16*)(ws + WS_W_NSA_OUT), NTOK, DM, DM}; pg8::StaticOrder S; S.init(NTOK, DM, F.G, (int)blockIdx.x);
        pg8::EpiResF32 E{args.in[0], Z, ALPHA, DM};
        pg8::gemm_phase<pg8::EpiResF32, pg8::StaticOrder, true, true>(F.lds + RING_OFF, g, S, E);
        if (BOTH(6) || rep_ + 1 < REPS(6)) GRID_BAR();
    }
    if (IN(7)) for (int rep_ = 0; rep_ < REPS(7); ++rep_) { relaunder(F); ln_phase<false, FFN_F8 != 0>(F, args, Z, args.in[23], args.in[24], XF, XB); if (BOTH(7) || rep_ + 1 < REPS(7)) GRID_BAR(); }
    if (IN(8)) for (int rep_ = 0; rep_ < REPS(8); ++rep_) { relaunder(F);
        pg8::StaticOrder S; S.init(NTOK, 2 * DFF, F.G, (int)blockIdx.x);
#if FFN_F8
        pg8::Gemm g{XB, (const bf16*)(ws + WS_W_FFN_GU), NTOK, 2 * DFF, DM, 1, 0x79797979};
        pg8::EpiSwiGLU8 E{(unsigned char*)(ws + WS_HFF), DFF};
        pg8::gemm_phase<pg8::EpiSwiGLU8, pg8::StaticOrder, true, true, true>(F.lds + RING_OFF, g, S, E);
#else
        pg8::Gemm g{XB, (const bf16*)(ws + WS_W_FFN_GU), NTOK, 2 * DFF, DM};
        pg8::EpiSwiGLU E{(bf16*)(ws + WS_HFF), DFF};
        pg8::gemm_phase<pg8::EpiSwiGLU, pg8::StaticOrder, true, true>(F.lds + RING_OFF, g, S, E);
#endif
        if (BOTH(8) || rep_ + 1 < REPS(8)) GRID_BAR();
    }
    if (IN(9)) for (int rep_ = 0; rep_ < REPS(9); ++rep_) { relaunder(F);
        pg8::StaticOrder S; S.init(NTOK, DM, F.G, (int)blockIdx.x);
        pg8::EpiResF32 E{XF, Z, ALPHA, DM};
#if FFN_F8
        pg8::Gemm g{(const bf16*)(ws + WS_HFF), (const bf16*)(ws + WS_W_FFN_DN), NTOK, DM, DFF, 1, 0x77777777};
        pg8::gemm_phase<pg8::EpiResF32, pg8::StaticOrder, true, true, true>(F.lds + RING_OFF, g, S, E);
#else
        pg8::Gemm g{(const bf16*)(ws + WS_HFF), (const bf16*)(ws + WS_W_FFN_DN), NTOK, DM, DFF};
        pg8::gemm_phase<pg8::EpiResF32, pg8::StaticOrder, true, true>(F.lds + RING_OFF, g, S, E);
#endif
        if (BOTH(9) || rep_ + 1 < REPS(9)) GRID_BAR();
    }
    if (IN(10)) for (int rep_ = 0; rep_ < REPS(10); ++rep_) { relaunder(F); ln_phase<false>(F, args, Z, args.in[25], args.in[26], XF, XB); if (BOTH(10) || rep_ + 1 < REPS(10)) GRID_BAR(); }
    if (IN(11)) for (int rep_ = 0; rep_ < REPS(11); ++rep_) { relaunder(F);
        pg8::Gemm g{XB, (const bf16*)(ws + WS_W_DSA_IN), NTOK, DSA_NPAD, DM}; pg8::StaticOrder S; S.init(NTOK, DSA_NPAD, F.G, (int)blockIdx.x);
        pg8::EpiDsaIn E{(bf16*)(ws + WS_Q), (float*)(ws + WS_CRAW), (bf16*)(ws + WS_QI), (float*)(ws + WS_KIWI), 0.125f};
        pg8::gemm_phase<pg8::EpiDsaIn, pg8::StaticOrder, true, true>(F.lds + RING_OFF, g, S, E);
        if (BOTH(11) || rep_ + 1 < REPS(11)) GRID_BAR();
    }
    if (IN(12)) for (int rep_ = 0; rep_ < REPS(12); ++rep_) { relaunder(F); p10_dsa_prep(F, args); if (BOTH(12) || rep_ + 1 < REPS(12)) GRID_BAR(); }
    if (IN(13)) for (int rep_ = 0; rep_ < REPS(13); ++rep_) { relaunder(F); p13a_dsa_index(F, args); if (BOTH(13) || rep_ + 1 < REPS(13)) GRID_BAR(); }
    if (IN(14)) for (int rep_ = 0; rep_ < REPS(14); ++rep_) { relaunder(F); p13b_dsa_attn(F, args); if (BOTH(14) || rep_ + 1 < REPS(14)) GRID_BAR(); }
    if (IN(15)) for (int rep_ = 0; rep_ < REPS(15); ++rep_) { relaunder(F); p12_dsa_uv(F, args); if (BOTH(15) || rep_ + 1 < REPS(15)) GRID_BAR(); }
    if (IN(16)) for (int rep_ = 0; rep_ < REPS(16); ++rep_) { relaunder(F);
        pg8::Gemm g{(const bf16*)(ws + WS_OATT1), (const bf16*)(ws + WS_W_DSA_OUT), NTOK, DM, DM}; pg8::StaticOrder S; S.init(NTOK, DM, F.G, (int)blockIdx.x);
        pg8::EpiResF32 E{XF, Z, ALPHA, DM};
        pg8::gemm_phase<pg8::EpiResF32, pg8::StaticOrder, true, true>(F.lds + RING_OFF, g, S, E);
        if (BOTH(16) || rep_ + 1 < REPS(16)) GRID_BAR();
    }
    if (IN(17)) for (int rep_ = 0; rep_ < REPS(17); ++rep_) { relaunder(F); ln_route_phase(F, args, Z, args.in[23] + DM, args.in[24] + DM, XF, XB); if (BOTH(17) || rep_ + 1 < REPS(17)) GRID_BAR(); }
    if (IN(18)) for (int rep_ = 0; rep_ < REPS(18); ++rep_) { relaunder(F); p15_gather(F, args); if (BOTH(18) || rep_ + 1 < REPS(18)) GRID_BAR(); }
    if (IN(19)) for (int rep_ = 0; rep_ < REPS(19); ++rep_) { relaunder(F);
        MoeTiles T; moe_tiles(F, T);
        pg8::Gemm g{(const bf16*)(ws + WS_XG), (const bf16*)(ws + WS_W_MOE_GU), T.MT * 256, 2 * DFFE, DM, 1, 0x79797979}; pg8::MoeOrder S; S.init(T.MT * 256, 2 * DFFE, F.G, (int)blockIdx.x); S.nexp_rows = 2 * DFFE;
#pragma unroll
        for (int e = 0; e < 8; ++e) S.tend[e] = T.tend[e];
        pg8::EpiSwiGLU8 E{(unsigned char*)(ws + WS_HM), DFFE};
        pg8::gemm_phase<pg8::EpiSwiGLU8, pg8::MoeOrder, true, true, true>(F.lds + RING_OFF, g, S, E);
        if (BOTH(19) || rep_ + 1 < REPS(19)) GRID_BAR();
    }
    if (IN(20)) for (int rep_ = 0; rep_ < REPS(20); ++rep_) { relaunder(F);
        MoeTiles T; moe_tiles(F, T);
        pg8::Gemm g{(const bf16*)(ws + WS_HM), (const bf16*)(ws + WS_W_MOE_DN), T.MT * 256, DM, DFFE, 1, 0x77777777}; pg8::MoeOrder S; S.init(T.MT * 256, DM, F.G, (int)blockIdx.x); S.nexp_rows = DM;
#pragma unroll
        for (int e = 0; e < 8; ++e) S.tend[e] = T.tend[e];
        pg8::EpiF32 E{(float*)(ws + WS_Y), DM};
        pg8::gemm_phase<pg8::EpiF32, pg8::MoeOrder, true, true, true>(F.lds + RING_OFF, g, S, E);
        if (BOTH(20) || rep_ + 1 < REPS(20)) GRID_BAR();
    }
    if (IN(21)) for (int rep_ = 0; rep_ < REPS(21); ++rep_) { relaunder(F); p18_final(F, args); }
#undef IN
#undef BOTH
}

extern "C" void kernel_launch(void* const* d_in, const int* in_sizes, int n_in, void* d_out, int out_size, void* d_ws, size_t ws_size, hipStream_t stream) {
    static int grid = 0;
    if (grid == 0) {
        if (n_in != 27 || out_size != NTOK * DM || ws_size < WS_END) { fprintf(stderr, "kernel_launch: unexpected shapes (n_in %d, out %d, ws %zu); nothing launched\n", n_in, out_size, ws_size); grid = -1; return; }
        int dev = 0, cus = 0, per_cu = 0;
        if (hipGetDevice(&dev) != hipSuccess || hipDeviceGetAttribute(&cus, hipDeviceAttributeMultiprocessorCount, dev) != hipSuccess) { grid = -1; return; }
        if (hipFuncSetAttribute((const void*)mega_fwd, hipFuncAttributeMaxDynamicSharedMemorySize, LDS_BYTES) != hipSuccess) { fprintf(stderr, "kernel_launch: hipFuncSetAttribute failed\n"); grid = -1; return; }
        if (hipOccupancyMaxActiveBlocksPerMultiprocessor(&per_cu, (const void*)mega_fwd, NWAVES * 64, LDS_BYTES) != hipSuccess || per_cu < 1) { fprintf(stderr, "kernel_launch: occupancy query says %d\n", per_cu); }
        (void)hipGetLastError();
        grid = cus;
    }
    if (grid < 0) return;
    if (hipMemsetAsync((char*)d_ws + WS_CTL, 0, CTL_ZERO_BYTES, stream) != hipSuccess) return;
    Args a{};
    for (int i = 0; i < 27; ++i) a.in[i] = (const float*)d_in[i];
    a.out = (float*)d_out; a.ws = (unsigned char*)d_ws;
#if MK_PER_PHASE
    for (int p = 0; p < NPHASE; ++p) { a.ph_lo = p; a.ph_hi = p + 1; hipLaunchKernelGGL(mega_fwd, dim3(grid), dim3(NWAVES * 64), LDS_BYTES, stream, a); }
#else
    a.ph_lo = 0; a.ph_hi = NPHASE;
    hipLaunchKernelGGL(mega_fwd, dim3(grid), dim3(NWAVES * 64), LDS_BYTES, stream, a);
#endif
}
```

```cpp
#include <hip/hip_runtime.h>
#include <cstdio>
#include <cstdint>
namespace pg8 {
#define PG8_LAS __attribute__((address_space(3)))
typedef unsigned short bf16_t;
typedef short bf16x8 __attribute__((ext_vector_type(8)));
typedef float f32x4 __attribute__((ext_vector_type(4)));
typedef unsigned u32x4 __attribute__((ext_vector_type(4)));
constexpr int BM = 256, BK = 64, HALF = 128, HTB = HALF * BK * 2  , STAGE_BYTES = 8 * HTB, NXCD = 8, WGM = 8;

__host__ __device__ __forceinline__ int lds_byte(int r, int c) { const int st = (r >> 4) * 2 + (c >> 5), rr = r & 15, cc = c & 31, ob = rr * 64 + cc * 2; return st * 1024 + (ob ^ (((ob >> 9) & 1) << 5)); }
__host__ __device__ __forceinline__ void stage_rc(int b, int& R, int& C) { const int st = b / 1024, sb = b % 1024, swz = sb ^ (((sb >> 9) & 1) << 5); R = (st >> 1) * 16 + swz / 64; C = (st & 1) * 32 + (swz % 64) / 2; }
__host__ __device__ __forceinline__ int perm32(int rho) { const int n = rho >> 4, i = rho & 15; return 8 * (i >> 2) + 4 * n + (i & 3); }

struct Unit { int pm, pn; };
struct Gemm { const bf16_t* A; const bf16_t* Bt; int M, N, K; int esz = 2; int scale = 0x7f7f7f7f; };

struct StaticOrder {
    int nM, nN, nwg, G, c;
    __host__ __device__ void init(int M, int N, int G_, int c_) { nM = M / BM; nN = N / BM; nwg = nM * nN; G = G_; c = c_; }
    __host__ __device__ bool next(int i, Unit& u) const {
        const long L = (long)i * G + c; if (L >= nwg) return false;
        int wgid = (int)L; { const int q = nwg / NXCD, r = nwg % NXCD, xcd = wgid % NXCD, off = wgid / NXCD; wgid = (xcd < r ? xcd * (q + 1) : r * (q + 1) + (xcd - r) * q) + off; }
        const int nig = WGM * nN, gid = wgid / nig, fm = gid * WGM, gsz = (nM - fm) < WGM ? (nM - fm) : WGM;
        u.pm = fm + ((wgid % nig) % gsz); u.pn = (wgid % nig) / gsz; return true;
    }
    __device__ __forceinline__ void a_ready(const Unit&) const {}
    __device__ __forceinline__ void done(const Unit&) const {}
    __device__ __forceinline__ const char* a_ptr(const Gemm& g, const Unit& u) const { return (const char*)g.A + (size_t)u.pm * ((size_t)BM * g.K * g.esz); }
    __device__ __forceinline__ const char* b_ptr(const Gemm& g, const Unit& u) const { return (const char*)g.Bt + (size_t)u.pn * ((size_t)BM * g.K * g.esz); }
};


__device__ __forceinline__ unsigned cvt_pk_bf16(float lo, float hi) { unsigned r; asm volatile("v_cvt_pk_bf16_f32 %0, %1, %2" : "=v"(r) : "v"(lo), "v"(hi)); return r; }
__device__ __forceinline__ u32x4 pack8(const f32x4 v0, const f32x4 v1) { u32x4 w; w.x = cvt_pk_bf16(v0[0], v0[1]); w.y = cvt_pk_bf16(v0[2], v0[3]); w.z = cvt_pk_bf16(v1[0], v1[1]); w.w = cvt_pk_bf16(v1[2], v1[3]); return w; }

struct EpiNsaIn {
    static constexpr bool PERM = true, AFTER_DRAIN = false;
    bf16_t* P0; float* GL; float qscale;
    __device__ __forceinline__ void operator()(const f32x4 (&acc)[2][2][4][2], const Unit& u, int wr, int wc, int fr, int fq) const {
        const int row0 = u.pm * BM + wr * 64 + fr;
        if (u.pn < 20) {
            const float s = u.pn < 8 ? qscale : 1.0f;
            const int col0 = u.pn * BM + wc * 32 + 8 * fq;
#pragma unroll
            for (int ai = 0; ai < 2; ++ai)
#pragma unroll
                for (int m = 0; m < 4; ++m) { bf16_t* rowp = P0 + (size_t)(row0 + ai * HALF + m * 16) * 5120 + col0;
#pragma unroll
                    for (int bj = 0; bj < 2; ++bj) *(u32x4*)(rowp + bj * HALF) = pack8(acc[ai][bj][m][0] * s, acc[ai][bj][m][1] * s); }
        } else {
            const int c = wc * 32 + 8 * fq;
            if (c < 48) {
#pragma unroll
                for (int ai = 0; ai < 2; ++ai)
#pragma unroll
                    for (int m = 0; m < 4; ++m) { float* gp = GL + (size_t)(row0 + ai * HALF + m * 16) * 48 + c;
                        *(f32x4*)gp = acc[ai][0][m][0]; *(f32x4*)(gp + 4) = acc[ai][0][m][1]; }
            }
        }
    }
};
struct EpiDsaIn {
    static constexpr bool PERM = true, AFTER_DRAIN = false;
    bf16_t* Q; float* CRAW; bf16_t* QI; float* KIWI; float qiscale;
    __device__ __forceinline__ void operator()(const f32x4 (&acc)[2][2][4][2], const Unit& u, int wr, int wc, int fr, int fq) const {
        const int row0 = u.pm * BM + wr * 64 + fr; const int c = wc * 32 + 8 * fq;
        if (u.pn < 8) {
#pragma unroll
            for (int ai = 0; ai < 2; ++ai)
#pragma unroll
                for (int m = 0; m < 4; ++m) { bf16_t* rowp = Q + (size_t)(row0 + ai * HALF + m * 16) * 2048 + u.pn * BM + c;
#pragma unroll
                    for (int bj = 0; bj < 2; ++bj) *(u32x4*)(rowp + bj * HALF) = pack8(acc[ai][bj][m][0], acc[ai][bj][m][1]); }
        } else if (u.pn == 8) {
#pragma unroll
            for (int ai = 0; ai < 2; ++ai)
#pragma unroll
                for (int m = 0; m < 4; ++m) { float* rowp = CRAW + (size_t)(row0 + ai * HALF + m * 16) * 256 + c;
#pragma unroll
                    for (int bj = 0; bj < 2; ++bj) { *(f32x4*)(rowp + bj * HALF) = acc[ai][bj][m][0]; *(f32x4*)(rowp + bj * HALF + 4) = acc[ai][bj][m][1]; } }
        } else if (u.pn < 11) {
#pragma unroll
            for (int ai = 0; ai < 2; ++ai)
#pragma unroll
                for (int m = 0; m < 4; ++m) { bf16_t* rowp = QI + (size_t)(row0 + ai * HALF + m * 16) * 512 + (u.pn - 9) * BM + c;
#pragma unroll
                    for (int bj = 0; bj < 2; ++bj) *(u32x4*)(rowp + bj * HALF) = pack8(acc[ai][bj][m][0] * qiscale, acc[ai][bj][m][1] * qiscale); }
        } else {
#pragma unroll
            for (int ai = 0; ai < 2; ++ai)
#pragma unroll
                for (int m = 0; m < 4; ++m) { float* rowp = KIWI + (size_t)(row0 + ai * HALF + m * 16) * 128 + c;
                    *(f32x4*)rowp = acc[ai][0][m][0]; *(f32x4*)(rowp + 4) = acc[ai][0][m][1]; }
        }
    }
};
struct EpiResF32 {
    static constexpr bool PERM = false, AFTER_DRAIN = false;
    const float* R; float* Z; float alpha; int ldc;
    __device__ __forceinline__ void operator()(const f32x4 (&acc)[2][2][4][2], const Unit& u, int wr, int wc, int fr, int fq) const {
        const int row0 = u.pm * BM + wr * 64 + fr, col0 = u.pn * BM + wc * 32 + 4 * fq;
#pragma unroll
        for (int ai = 0; ai < 2; ++ai)
#pragma unroll
            for (int m = 0; m < 4; ++m) { const size_t off = (size_t)(row0 + ai * HALF + m * 16) * ldc + col0;
#pragma unroll
                for (int bj = 0; bj < 2; ++bj)
#pragma unroll
                    for (int n = 0; n < 2; ++n) { const f32x4 r = *(const f32x4*)(R + off + bj * HALF + n * 16); *(f32x4*)(Z + off + bj * HALF + n * 16) = r * alpha + acc[ai][bj][m][n]; } }
    }
};
struct EpiF32 {
    static constexpr bool PERM = false, AFTER_DRAIN = false;
    float* C; int ldc;
    __device__ __forceinline__ void operator()(const f32x4 (&acc)[2][2][4][2], const Unit& u, int wr, int wc, int fr, int fq) const {
        const int row0 = u.pm * BM + wr * 64 + fr, col0 = u.pn * BM + wc * 32 + 4 * fq;
#pragma unroll
        for (int ai = 0; ai < 2; ++ai)
#pragma unroll
            for (int m = 0; m < 4; ++m) { float* rowp = C + (size_t)(row0 + ai * HALF + m * 16) * ldc + col0;
#pragma unroll
                for (int bj = 0; bj < 2; ++bj)
#pragma unroll
                    for (int n = 0; n < 2; ++n) *(f32x4*)(rowp + bj * HALF + n * 16) = acc[ai][bj][m][n]; }
    }
};
__device__ __forceinline__ float silu_mul(float g, float u) { return g * __builtin_amdgcn_rcpf(1.0f + __expf(-g)) * u; }
struct EpiSwiGLU {
    static constexpr bool PERM = true, AFTER_DRAIN = false;
    bf16_t* H; int ldh;
    __device__ __forceinline__ void operator()(const f32x4 (&acc)[2][2][4][2], const Unit& u, int wr, int wc, int fr, int fq) const {
        const int row0 = u.pm * BM + wr * 64 + fr, col0 = u.pn * HALF + wc * 32 + 8 * fq;
#pragma unroll
        for (int ai = 0; ai < 2; ++ai)
#pragma unroll
            for (int m = 0; m < 4; ++m) { bf16_t* rowp = H + (size_t)(row0 + ai * HALF + m * 16) * ldh + col0;
                f32x4 v0, v1;
#pragma unroll
                for (int j = 0; j < 4; ++j) { v0[j] = silu_mul(acc[ai][0][m][0][j], acc[ai][1][m][0][j]); v1[j] = silu_mul(acc[ai][0][m][1][j], acc[ai][1][m][1][j]); }
                *(u32x4*)rowp = pack8(v0, v1); }
    }
};
struct EpiSwiGLU8 {
    static constexpr bool PERM = true, AFTER_DRAIN = false;
    unsigned char* H; int ldh;
    __device__ __forceinline__ void operator()(const f32x4 (&acc)[2][2][4][2], const Unit& u, int wr, int wc, int fr, int fq) const {
        const int row0 = u.pm * BM + wr * 64 + fr, col0 = u.pn * HALF + wc * 32 + 8 * fq;
#pragma unroll
        for (int ai = 0; ai < 2; ++ai)
#pragma unroll
            for (int m = 0; m < 4; ++m) { unsigned char* rowp = H + (size_t)(row0 + ai * HALF + m * 16) * ldh + col0;
                float v[8];
#pragma unroll
                for (int j = 0; j < 4; ++j) { v[j] = silu_mul(acc[ai][0][m][0][j], acc[ai][1][m][0][j]); v[4 + j] = silu_mul(acc[ai][0][m][1][j], acc[ai][1][m][1][j]); }
                int w0 = __builtin_amdgcn_cvt_pk_fp8_f32(v[0], v[1], 0, false); w0 = __builtin_amdgcn_cvt_pk_fp8_f32(v[2], v[3], w0, true);
                int w1 = __builtin_amdgcn_cvt_pk_fp8_f32(v[4], v[5], 0, false); w1 = __builtin_amdgcn_cvt_pk_fp8_f32(v[6], v[7], w1, true);
                uint2 o; o.x = (unsigned)w0; o.y = (unsigned)w1; *(uint2*)rowp = o; }
    }
};
struct MoeOrder : StaticOrder {
    int tend[8]; int nexp_rows;
    __device__ __forceinline__ int expert(int pm) const { int e = 0;
#pragma unroll
        for (int i = 0; i < 7; ++i) e += (pm >= tend[i]) ? 1 : 0; return e; }
    __device__ __forceinline__ const char* b_ptr(const Gemm& g, const Unit& u) const { return (const char*)g.Bt + ((size_t)expert(u.pm) * nexp_rows + (size_t)u.pn * BM) * ((size_t)g.K * g.esz); }
};
typedef int i32x8 __attribute__((ext_vector_type(8)));
typedef int i32x4 __attribute__((ext_vector_type(4)));
__device__ __forceinline__ i32x8 cat8(bf16x8 lo, bf16x8 hi) { const i32x4 a = *reinterpret_cast<const i32x4*>(&lo), b = *reinterpret_cast<const i32x4*>(&hi); return __builtin_shufflevector(a, b, 0, 1, 2, 3, 4, 5, 6, 7); }
template <class Epi, class Sched, bool ALIGN_EPI = false, bool SP2 = false, bool FP8 = false>
__device__ __forceinline__ void gemm_phase(PG8_LAS unsigned char* lds, const Gemm g, const Sched& S, const Epi& E) {
    int tid = threadIdx.x; asm volatile("" : "+v"(tid));
    const int wid = __builtin_amdgcn_readfirstlane(tid >> 6), lane = tid & 63, wr = wid >> 2, wc = wid & 3, fr = lane & 15, fq = lane >> 4;
    const int K = g.K, nt = K / (FP8 ? 2 * BK : BK);
    unsigned voffA[2], voffB[2];
#pragma unroll
    for (int i = 0; i < 2; ++i) { int R, C; stage_rc(tid * 16 + i * 8192, R, C); const int Rb = Epi::PERM ? ((R & ~31) + perm32(R & 31)) : R;
        voffA[i] = FP8 ? (unsigned)(R * K + C * 2) : (unsigned)(R * K + C) * 2u; voffB[i] = FP8 ? (unsigned)(Rb * K + C * 2) : (unsigned)(Rb * K + C) * 2u; }
    const size_t kstep = (size_t)(BK * 2);
    const size_t hstep = (size_t)HALF * K * (FP8 ? 1 : 2);
    const size_t tstep = 2 * hstep;
    const unsigned ldsw = (unsigned)wid * 1024u;
    const int aoff = lds_byte(wr * 64 + fr, fq * 8), boff = lds_byte(wc * 32 + fr, fq * 8);
#define PG8_SA(b, h) (((b) * 2 + (h)) * HTB)
#define PG8_SB(b, h) ((4 + (b) * 2 + (h)) * HTB)
#define PG8_STAGE(bufoff, gbase, voff) do { _Pragma("unroll") for (int _i = 0; _i < 2; ++_i) \
        __builtin_amdgcn_global_load_lds((const unsigned*)((const char*)(gbase) + (voff)[_i]), (PG8_LAS unsigned*)(lds + (bufoff) + ldsw + _i * 8192), 16, 0, 0); } while (0)
#define PG8_LDA(dst, b, h) do { _Pragma("unroll") for (int m = 0; m < 4; ++m) { if constexpr (FP8) { const i32x4 lo_ = *(const PG8_LAS i32x4*)(lds + PG8_SA(b, h) + aoff + m * 2048), hi_ = *(const PG8_LAS i32x4*)(lds + PG8_SA(b, h) + aoff + m * 2048 + 1024); dst##8[m] = __builtin_shufflevector(lo_, hi_, 0, 1, 2, 3, 4, 5, 6, 7); } else { _Pragma("unroll") for (int k = 0; k < 2; ++k) dst[m][k] = *(const PG8_LAS bf16x8*)(lds + PG8_SA(b, h) + aoff + m * 2048 + k * 1024); } } } while (0)
#define PG8_LDB(dst, b, h) do { _Pragma("unroll") for (int n = 0; n < 2; ++n) { if constexpr (FP8) { const i32x4 lo_ = *(const PG8_LAS i32x4*)(lds + PG8_SB(b, h) + boff + n * 2048), hi_ = *(const PG8_LAS i32x4*)(lds + PG8_SB(b, h) + boff + n * 2048 + 1024); dst##8[n] = __builtin_shufflevector(lo_, hi_, 0, 1, 2, 3, 4, 5, 6, 7); } else { _Pragma("unroll") for (int k = 0; k < 2; ++k) dst[n][k] = *(const PG8_LAS bf16x8*)(lds + PG8_SB(b, h) + boff + n * 2048 + k * 1024); } } } while (0)
#define PG8_MMA(ai, bj, At, Bt) do { __builtin_amdgcn_s_setprio(1); _Pragma("unroll") for (int m = 0; m < 4; ++m) _Pragma("unroll") for (int n = 0; n < 2; ++n) { \
        if constexpr (FP8) { asm volatile("v_mfma_scale_f32_16x16x128_f8f6f4 %0, %1, %2, %0, %3, %4 op_sel_hi:[0,0,0]" : "+v"(acc[ai][bj][m][n]) : "v"(Bt##8[n]), "v"(At##8[m]), "v"(sclA), "v"(sclB)); } \
        else { _Pragma("unroll") for (int k = 0; k < 2; ++k) acc[ai][bj][m][n] = __builtin_amdgcn_mfma_f32_16x16x32_bf16(Bt[n][k], At[m][k], acc[ai][bj][m][n], 0, 0, 0); } } __builtin_amdgcn_s_setprio(0); } while (0)
#define PG8_WAIT_V(n) asm volatile("s_waitcnt vmcnt(" #n ")" ::: "memory")
#define PG8_WAIT_L(n) asm volatile("s_waitcnt lgkmcnt(" #n ")" ::: "memory")
#define PG8_BAR __builtin_amdgcn_s_barrier()
#define PG8_SCHED __builtin_amdgcn_sched_barrier(0)
    Unit cur, nxt; int ui = 0;
    if (!S.next(0, cur)) return;
    f32x4 acc[2][2][4][2];
#pragma unroll
    for (int a = 0; a < 2; ++a)
#pragma unroll
        for (int b = 0; b < 2; ++b)
#pragma unroll
            for (int m = 0; m < 4; ++m)
#pragma unroll
                for (int n = 0; n < 2; ++n) acc[a][b][m][n] = (f32x4){0.f, 0.f, 0.f, 0.f};
    bf16x8 At[4][2], B0[2][2], B1[2][2]; i32x8 At8[4], B08[2], B18[2]; const int sclA = g.scale, sclB = 0x7f7f7f7f;
    const char* cA = S.a_ptr(g, cur); const char* cB = S.b_ptr(g, cur);
    S.a_ready(cur);
    if constexpr (SP2) {
        PG8_STAGE(PG8_SB(0, 0), cB, voffB); PG8_STAGE(PG8_SB(0, 1), cB + hstep, voffB); PG8_STAGE(PG8_SA(0, 0), cA, voffA); PG8_STAGE(PG8_SA(0, 1), cA + hstep, voffA);
        if (wr == 1) PG8_BAR;
        PG8_WAIT_V(2); PG8_BAR;
        PG8_STAGE(PG8_SB(1, 0), cB + kstep, voffB); PG8_STAGE(PG8_SA(1, 0), cA + kstep, voffA); PG8_STAGE(PG8_SB(1, 1), cB + hstep + kstep, voffB);
        PG8_WAIT_V(6); PG8_BAR;
    } else {
        PG8_STAGE(PG8_SB(0, 0), cB, voffB); PG8_STAGE(PG8_SA(0, 0), cA, voffA); PG8_STAGE(PG8_SB(0, 1), cB + hstep, voffB); PG8_STAGE(PG8_SA(0, 1), cA + hstep, voffA);
        if (wr == 1) PG8_BAR;
        PG8_WAIT_V(4); PG8_BAR;
        PG8_STAGE(PG8_SB(1, 0), cB + kstep, voffB); PG8_STAGE(PG8_SA(1, 0), cA + kstep, voffA); PG8_STAGE(PG8_SB(1, 1), cB + hstep + kstep, voffB);
        PG8_WAIT_V(6); PG8_BAR;
    }
    for (;;) {
        const bool has_next = S.next(ui + 1, nxt);
        const char* nA = has_next ? S.a_ptr(g, nxt) : cA; const char* nB = has_next ? S.b_ptr(g, nxt) : cB;
        for (int t = 0; t < nt; t += 2) {
            const bool last = (t == nt - 2);
            const char* a1 = cA + (size_t)(t + 1) * kstep;
            const char* a2 = last ? nA : cA + (size_t)(t + 2) * kstep; const char* b2 = last ? nB : cB + (size_t)(t + 2) * kstep;
            const char* a3 = a2 + kstep; const char* b3 = b2 + kstep;
            if (last && has_next) S.a_ready(nxt);
            if constexpr (SP2) {
            PG8_LDB(B0, 0, 0); PG8_LDB(B1, 0, 1); PG8_SCHED; PG8_LDA(At, 0, 0); PG8_STAGE(PG8_SA(1, 1), a1 + hstep, voffA);
            PG8_WAIT_V(8); PG8_WAIT_L(0); PG8_BAR; PG8_MMA(0, 0, At, B0); PG8_MMA(0, 1, At, B1); PG8_BAR; PG8_SCHED;
            PG8_LDA(At, 0, 1); PG8_STAGE(PG8_SB(0, 0), b2, voffB); PG8_STAGE(PG8_SB(0, 1), b2 + hstep, voffB); PG8_STAGE(PG8_SA(0, 0), a2, voffA);
            PG8_WAIT_V(8); PG8_WAIT_L(0); PG8_BAR; PG8_MMA(1, 0, At, B0); PG8_MMA(1, 1, At, B1); PG8_BAR; PG8_SCHED;
            PG8_LDB(B0, 1, 0); PG8_LDB(B1, 1, 1); PG8_SCHED; PG8_LDA(At, 1, 0); PG8_STAGE(PG8_SA(0, 1), a2 + hstep, voffA);
            PG8_WAIT_V(8); PG8_WAIT_L(0); PG8_BAR; PG8_MMA(0, 0, At, B0); PG8_MMA(0, 1, At, B1); PG8_BAR; PG8_SCHED;
            PG8_LDA(At, 1, 1); PG8_STAGE(PG8_SB(1, 0), b3, voffB); PG8_STAGE(PG8_SB(1, 1), b3 + hstep, voffB); PG8_STAGE(PG8_SA(1, 0), a3, voffA);
            PG8_WAIT_V(8); PG8_WAIT_L(0); PG8_BAR; PG8_MMA(1, 0, At, B0); PG8_MMA(1, 1, At, B1); PG8_BAR; PG8_SCHED;
            } else {
            PG8_LDB(B0, 0, 0); PG8_SCHED; PG8_LDA(At, 0, 0); PG8_STAGE(PG8_SA(1, 1), a1 + hstep, voffA);
            PG8_WAIT_L(8); PG8_BAR; PG8_WAIT_L(0); PG8_MMA(0, 0, At, B0); PG8_BAR; PG8_SCHED;
            PG8_LDB(B1, 0, 1); PG8_STAGE(PG8_SB(0, 0), b2, voffB);
            PG8_BAR; PG8_WAIT_L(0); PG8_MMA(0, 1, At, B1); PG8_BAR;
            PG8_LDA(At, 0, 1); PG8_STAGE(PG8_SA(0, 0), a2, voffA);
            PG8_BAR; PG8_WAIT_L(0); PG8_MMA(1, 0, At, B0); PG8_BAR; PG8_SCHED;
            PG8_STAGE(PG8_SB(0, 1), b2 + hstep, voffB);
            PG8_WAIT_V(6); PG8_BAR; PG8_MMA(1, 1, At, B1); PG8_BAR;
            PG8_LDB(B0, 1, 0); PG8_SCHED; PG8_LDA(At, 1, 0); PG8_STAGE(PG8_SA(0, 1), a2 + hstep, voffA);
            PG8_WAIT_L(8); PG8_BAR; PG8_WAIT_L(0); PG8_MMA(0, 0, At, B0); PG8_BAR; PG8_SCHED;
            PG8_LDB(B1, 1, 1); PG8_STAGE(PG8_SB(1, 0), b3, voffB);
            PG8_BAR; PG8_WAIT_L(0); PG8_MMA(0, 1, At, B1); PG8_BAR;
            PG8_LDA(At, 1, 1); PG8_STAGE(PG8_SA(1, 0), a3, voffA);
            PG8_BAR; PG8_WAIT_L(0); PG8_MMA(1, 0, At, B0); PG8_BAR; PG8_SCHED;
            PG8_STAGE(PG8_SB(1, 1), b3 + hstep, voffB);
            PG8_WAIT_V(6); PG8_BAR; PG8_MMA(1, 1, At, B1); PG8_BAR;
            }
        }
        if constexpr (FP8) asm volatile("s_nop 15\n\ts_nop 15" ::: "memory");
        if constexpr (ALIGN_EPI) { if (wr == 0) PG8_BAR; }
        if constexpr (!Epi::AFTER_DRAIN) { E(acc, cur, wr, wc, fr, fq); S.done(cur); }
        if (!has_next) break;
#pragma unroll
        for (int a = 0; a < 2; ++a)
#pragma unroll
            for (int b = 0; b < 2; ++b)
#pragma unroll
                for (int m = 0; m < 4; ++m)
#pragma unroll
                    for (int n = 0; n < 2; ++n) acc[a][b][m][n] = (f32x4){0.f, 0.f, 0.f, 0.f};
        cur = nxt; cA = nA; cB = nB; ++ui;
        if constexpr (ALIGN_EPI) { if (wr == 1) PG8_BAR; }
    }
    PG8_WAIT_V(0);
    if constexpr (!ALIGN_EPI) { if (wr == 0) PG8_BAR; }
    PG8_BAR;
    if constexpr (Epi::AFTER_DRAIN) { E.fused(acc, cur, wr, wc, fr, fq, lds, wid, lane); S.done(cur); }
#undef PG8_SA
#undef PG8_SB
#undef PG8_STAGE
#undef PG8_LDA
#undef PG8_LDB
#undef PG8_MMA
#undef PG8_WAIT_V
#undef PG8_WAIT_L
#undef PG8_BAR
#undef PG8_SCHED
}
}
#define GAS __attribute__((address_space(1)))
#define LAS __attribute__((address_space(3)))
typedef unsigned short bf16;
typedef unsigned v4u __attribute__((ext_vector_type(4)));
typedef float f32x4 __attribute__((ext_vector_type(4)));
typedef short bf16x8 __attribute__((ext_vector_type(8)));
typedef GAS unsigned gu32;
typedef GAS unsigned long long gu64;
#define RLX_AGENT __ATOMIC_RELAXED, __HIP_MEMORY_SCOPE_AGENT
#define LDS_WAIT() asm volatile("s_waitcnt lgkmcnt(0)" ::: "memory")
#define VM_WAIT() asm volatile("s_waitcnt vmcnt(0)" ::: "memory")
__device__ __forceinline__ unsigned long long rt() { return __builtin_amdgcn_s_memrealtime(); }
__device__ __forceinline__ unsigned f2bf(float f) { unsigned u = __builtin_bit_cast(unsigned, f); return (u + 0x7fffu + ((u >> 16) & 1u)) >> 16; }
__device__ __forceinline__ unsigned pk2(float lo, float hi) { return f2bf(lo) | (f2bf(hi) << 16); }

#define XB_TMO      128
#define XB_XCNT(j)  (256  + 64 * (j))
#define XB_XSUB(j)  (1280 + 64 * (j))
#define XB_XGEN(j)  (2304 + 64 * (j))
#define XB_TOP      3328
#define XB_TOPGEN   3392
#define XCD_BAR_WORDS 3456
#define XB_SPIN_CAP (1u << 18)

__device__ __forceinline__ unsigned xb_ld(unsigned* p)              { return __hip_atomic_load(p, __ATOMIC_RELAXED, __HIP_MEMORY_SCOPE_AGENT); }
__device__ __forceinline__ unsigned xb_add(unsigned* p, unsigned v) { return __hip_atomic_fetch_add(p, v, __ATOMIC_RELAXED, __HIP_MEMORY_SCOPE_AGENT); }
__device__ __forceinline__ unsigned xb_xcc_id() { return (unsigned)__builtin_amdgcn_s_getreg((3 << 11) | 20) & 0xFu; }
#define XB_SPIN(cond, bar) do { unsigned _sp = 0; while (cond) { __builtin_amdgcn_s_sleep(1); \
    if ((++_sp & 255u) == 0u) { if (xb_ld(&(bar)[XB_TMO])) break; if (_sp > XB_SPIN_CAP) { atomicAdd(&(bar)[XB_TMO], 1u); break; } } } } while (0)

struct XcdBarrier {
    unsigned* bar; unsigned x;
    volatile LAS unsigned* st;
};

__device__ __forceinline__ XcdBarrier xcd_barrier_post(unsigned* bar, volatile LAS unsigned* st) {
    XcdBarrier b; b.bar = bar; b.x = xb_xcc_id(); b.st = st;
    if (threadIdx.x == 0) (void)xb_add(&bar[XB_XCNT(b.x)], 1u);
    return b;
}
__device__ __forceinline__ void xcd_barrier_complete(unsigned* bar, unsigned x, unsigned& nloc, unsigned& nx) {
    const unsigned G = gridDim.x * gridDim.y * gridDim.z;
    unsigned sum, cnt, mine, sp = 0u;
    for (;;) {
        sum = 0u; cnt = 0u; mine = 0u;
#pragma unroll
        for (unsigned j = 0; j < 16; ++j) { const unsigned c = xb_ld(&bar[XB_XCNT(j)]); sum += c; cnt += (c > 0u) ? 1u : 0u; mine = (j == x) ? c : mine; }
        if (sum == G) break;
        __builtin_amdgcn_s_sleep(1);
        if ((++sp & 255u) == 0u) { if (xb_ld(&bar[XB_TMO])) break; if (sp > XB_SPIN_CAP) { atomicAdd(&bar[XB_TMO], 1u); break; } }
    }
    nloc = mine > 0u ? mine : 1u; nx = cnt > 0u ? cnt : 1u;
}

__device__ __forceinline__ void xcd_barrier(const XcdBarrier& b) {
    asm volatile("s_waitcnt vmcnt(0)" ::: "memory");
    __syncthreads();
    if (threadIdx.x == 0) {
        unsigned* bar = b.bar;
        __builtin_amdgcn_s_waitcnt(0);
        unsigned nloc = b.st[0], nx = b.st[1];
        if (nloc == 0u) { xcd_barrier_complete(bar, b.x, nloc, nx); b.st[0] = nloc; b.st[1] = nx; }
        const unsigned old = xb_add(&bar[XB_XSUB(b.x)], 1u);
        const unsigned gen = old / nloc;
        if (old + 1u == (gen + 1u) * nloc) {
            __builtin_amdgcn_fence(__ATOMIC_RELEASE, "agent");
            asm volatile("s_waitcnt vmcnt(0)" ::: "memory");
            const unsigned og = xb_add(&bar[XB_TOP], 1u);
            const unsigned tg = og / nx;
            if (og + 1u == (tg + 1u) * nx) xb_add(&bar[XB_TOPGEN], 1u);
            else XB_SPIN(xb_ld(&bar[XB_TOPGEN]) == tg, bar);
            __builtin_amdgcn_fence(__ATOMIC_ACQUIRE, "agent");
            xb_add(&bar[XB_XGEN(b.x)], 1u);
            asm volatile("s_waitcnt vmcnt(0)" ::: "memory");
        } else {
            XB_SPIN(xb_ld(&bar[XB_XGEN(b.x)]) == gen, bar);
            __builtin_amdgcn_fence(__ATOMIC_ACQUIRE, "agent");
            asm volatile("s_waitcnt vmcnt(0)" ::: "memory");
        }
    }
    __syncthreads();
}

constexpr int NWAVES = 8;
#ifndef MK_PER_PHASE
#define MK_PER_PHASE 0
#endif
constexpr int NPHASE = 22;

constexpr int BATCH = 2, SEQ = 8192, DM = 2048, NTOK = BATCH * SEQ, NH = 16, DH = 128;
constexpr int NSA_N = 5168, NSA_NPAD = 5376, P0LD = 5120;
constexpr int NCMP = 511, NSELB = 128;
constexpr int COL_KC = 2048, COL_VC = 2560, COL_KS = 3072, COL_VS = 3584, COL_KW = 4096, COL_VW = 4608;
constexpr int DSA_N = 2888, DSA_NPAD = 3072, KVR = 256, TOPK = 256;
constexpr int DFF = 5632, NEXP = 8, DFFE = 7168, MOE_ROWS = 34816;
constexpr float ALPHA = 1.41421356237309515f, LN_EPS = 1e-5f, RMS_EPS = 1e-6f;

constexpr size_t MiB = (size_t)1 << 20;
constexpr size_t WS_CTL = 0, CTL_ZERO_BYTES = 128 * 1024;
constexpr size_t WS_W_NSA_IN = 2 * MiB, WS_W_NSA_OUT = 23 * MiB, WS_W_FFN_GU = 31 * MiB, WS_W_FFN_DN = 75 * MiB, WS_W_DSA_IN = 97 * MiB, WS_W_DSA_OUT = 109 * MiB;
constexpr size_t WS_W_CMPK = 117 * MiB, WS_W_CMPV = 118 * MiB, WS_W_UK = 119 * MiB, WS_W_UV = 120 * MiB, WS_CBIAS = 121 * MiB;
constexpr size_t WS_KCMP = 122 * MiB, WS_VCMP = 124 * MiB, WS_GL = 126 * MiB, WS_ROUTE = 129 * MiB;
constexpr size_t WS_KIB = 179 * MiB;
constexpr size_t WS_SELM = 178 * MiB;
constexpr size_t WS_CRAW = 130 * MiB, WS_KIWI = 146 * MiB, WS_IDX = 154 * MiB, WS_CN = 170 * MiB;
constexpr size_t WS_W_MOE_GU = 192 * MiB, WS_W_MOE_DN = 640 * MiB;
constexpr size_t WS_XB = 864 * MiB, WS_XF = 928 * MiB, WS_Z = 1056 * MiB;
constexpr size_t WS_P0 = 1184 * MiB, WS_OATT0 = 1344 * MiB, WS_HFF = 1408 * MiB;
constexpr size_t WS_Q = 1184 * MiB, WS_QI = 1248 * MiB, WS_QLAT = 1264 * MiB, WS_OLAT = 1392 * MiB, WS_OATT1 = 1520 * MiB;
constexpr size_t WS_XG = 1056 * MiB, WS_HM = 1192 * MiB, WS_Y = 192 * MiB;
constexpr size_t WS_END = 1668 * MiB;
static_assert(WS_HM + (size_t)MOE_ROWS * DFFE * 2 <= WS_END, "hm fits");
static_assert(WS_XG + (size_t)MOE_ROWS * DM * 2 <= WS_HM, "xg fits");
static_assert(WS_Y + (size_t)MOE_ROWS * DM * 4 <= WS_W_MOE_DN, "y overlays the dead gate/up weights only");
static_assert(WS_HFF + (size_t)NTOK * DFF * 2 <= WS_END, "hff fits");
constexpr int CW_TMO = 0, CW_CODE = 1;
constexpr int CW_BAR = 4096;
constexpr int CW_MOECNT = 16384;

constexpr int RING_OFF = 0, RING_BYTES = 131072;
constexpr int LDSCTL_OFF = RING_BYTES, MISC_OFF = LDSCTL_OFF + 320;
constexpr int LDS_BYTES = 163840;
constexpr int DSA_SCR = 133120;

struct Frame {
    LAS unsigned char* lds;
    volatile LAS unsigned* MISC;
    gu32* ctl;
    int tid, lane, wave, vcu, G;
};

__device__ __forceinline__ void relaunder(Frame& F) { int t = F.tid; asm volatile("" : "+v"(t)); F.tid = t; F.lane = t & 63; }
__device__ __forceinline__ float bf2f(unsigned short h) { return __uint_as_float(((unsigned)h) << 16); }
__device__ __forceinline__ float bflo(unsigned w) { return __uint_as_float(w << 16); }
__device__ __forceinline__ float bfhi(unsigned w) { return __uint_as_float(w & 0xffff0000u); }
__device__ __forceinline__ float wave_sum(float v) {
#pragma unroll
    for (int o = 1; o < 64; o <<= 1) v += __shfl_xor(v, o);
    return v;
}
__device__ __forceinline__ float wave_max(float v) {
#pragma unroll
    for (int o = 1; o < 64; o <<= 1) v = fmaxf(v, __shfl_xor(v, o));
    return v;
}
#define WSYNC() do { __builtin_amdgcn_wave_barrier(); asm volatile("s_waitcnt lgkmcnt(0)" ::: "memory"); __builtin_amdgcn_wave_barrier(); } while (0)

__device__ __forceinline__ int rel_bucket(int n) {
    if (n < 16) return n;
    if (n >= 113) return 31;
    int b = 16;
    b += (n >= 19); b += (n >= 21); b += (n >= 24); b += (n >= 27); b += (n >= 31); b += (n >= 35); b += (n >= 40); b += (n >= 46);
    b += (n >= 52); b += (n >= 59); b += (n >= 67); b += (n >= 77); b += (n >= 87); b += (n >= 99);
    return b;
}

struct Args { const float* in[27]; float* out; unsigned char* ws; int ph_lo, ph_hi; };
#ifndef FFN_F8
#define FFN_F8 1
#endif
struct TrItem { const float* W; bf16* WT; int N, K, k0, n0, drow; float f8scale; };
__device__ __forceinline__ void tr_set(TrItem& T, const float* W, int K, int N, int Npad, bf16* WT, int mode, int item, float f8scale = 0.f) {
    T.f8scale = f8scale;
    const int nblk = Npad / 32, kb = item / nblk, nb = item - kb * nblk, n0 = 32 * nb;
    T.W = W; T.WT = WT; T.N = N; T.K = K; T.k0 = 64 * kb; T.n0 = n0; T.drow = (mode == 0) ? n0 : ((n0 >> 7) * 256 + (mode - 1) * 128 + (n0 & 127));
}
constexpr int TR_I_NSA_IN = (DM / 64) * (NSA_NPAD / 32), TR_I_SQ = (DM / 64) * (DM / 32), TR_I_FFN = (DM / 64) * (DFF / 32), TR_I_FFD = (DFF / 64) * (DM / 32), TR_I_DSA_IN = (DM / 64) * (DSA_NPAD / 32);
constexpr int TR_I_CMP = (4096 / 64) * (128 / 32), TR_I_UK1 = (128 / 64) * (256 / 32), TR_I_UV1 = (256 / 64) * (128 / 32);
constexpr int TR_I_MG1 = (DM / 64) * (DFFE / 32), TR_I_MD1 = (DFFE / 64) * (DM / 32);
constexpr int TR_NITEMS = TR_I_NSA_IN + 2 * TR_I_SQ + 2 * TR_I_FFN + TR_I_FFD + TR_I_DSA_IN + 2 * TR_I_CMP + 16 * TR_I_UK1 + 16 * TR_I_UV1 + 16 * TR_I_MG1 + 8 * TR_I_MD1;
__device__ __forceinline__ void tr_decode(const Args& A, unsigned char* ws, int it, TrItem& T) {
    int r = it;
    if (r < TR_I_NSA_IN) { tr_set(T, A.in[2], DM, NSA_N, NSA_NPAD, (bf16*)(ws + WS_W_NSA_IN), 0, r); return; } r -= TR_I_NSA_IN;
    if (r < TR_I_SQ) { tr_set(T, A.in[9], DM, DM, DM, (bf16*)(ws + WS_W_NSA_OUT), 0, r); return; } r -= TR_I_SQ;
    if (r < TR_I_SQ) { tr_set(T, A.in[14], DM, DM, DM, (bf16*)(ws + WS_W_DSA_OUT), 0, r); return; } r -= TR_I_SQ;
    if (r < TR_I_FFN) { tr_set(T, A.in[15], DM, DFF, DFF, (bf16*)(ws + WS_W_FFN_GU), 1, r, FFN_F8 ? 64.f : 0.f); return; } r -= TR_I_FFN;
    if (r < TR_I_FFN) { tr_set(T, A.in[16], DM, DFF, DFF, (bf16*)(ws + WS_W_FFN_GU), 2, r, FFN_F8 ? 64.f : 0.f); return; } r -= TR_I_FFN;
    if (r < TR_I_FFD) { tr_set(T, A.in[17], DFF, DM, DM, (bf16*)(ws + WS_W_FFN_DN), 0, r, FFN_F8 ? 256.f : 0.f); return; } r -= TR_I_FFD;
    if (r < TR_I_DSA_IN) { tr_set(T, A.in[10], DM, DSA_N, DSA_NPAD, (bf16*)(ws + WS_W_DSA_IN), 0, r); return; } r -= TR_I_DSA_IN;
    if (r < TR_I_CMP) { tr_set(T, A.in[4], 4096, 128, 128, (bf16*)(ws + WS_W_CMPK), 0, r); return; } r -= TR_I_CMP;
    if (r < TR_I_CMP) { tr_set(T, A.in[7], 4096, 128, 128, (bf16*)(ws + WS_W_CMPV), 0, r); return; } r -= TR_I_CMP;
    if (r < 16 * TR_I_UK1) { const int h = r / TR_I_UK1; tr_set(T, A.in[12] + (size_t)h * 128 * 256, 128, 256, 256, (bf16*)(ws + WS_W_UK) + (size_t)h * 256 * 128, 0, r - h * TR_I_UK1); return; } r -= 16 * TR_I_UK1;
    if (r < 16 * TR_I_UV1) { const int h = r / TR_I_UV1; tr_set(T, A.in[13] + (size_t)h * 256 * 128, 256, 128, 128, (bf16*)(ws + WS_W_UV) + (size_t)h * 128 * 256, 0, r - h * TR_I_UV1); return; } r -= 16 * TR_I_UV1;
    if (r < 8 * TR_I_MG1) { const int e = r / TR_I_MG1; tr_set(T, A.in[20] + (size_t)e * DM * DFFE, DM, DFFE, DFFE, (bf16*)(ws + WS_W_MOE_GU + (size_t)e * 2 * DFFE * DM), 1, r - e * TR_I_MG1, 64.f); return; } r -= 8 * TR_I_MG1;
    if (r < 8 * TR_I_MG1) { const int e = r / TR_I_MG1; tr_set(T, A.in[21] + (size_t)e * DM * DFFE, DM, DFFE, DFFE, (bf16*)(ws + WS_W_MOE_GU + (size_t)e * 2 * DFFE * DM), 2, r - e * TR_I_MG1, 64.f); return; } r -= 8 * TR_I_MG1;
    { const int e = r / TR_I_MD1; tr_set(T, A.in[22] + (size_t)e * DFFE * DM, DFFE, DM, DM, (bf16*)(ws + WS_W_MOE_DN + (size_t)e * DM * DFFE), 0, r - e * TR_I_MD1, 256.f); }
}
__device__ __forceinline__ void tr_load(const TrItem& T, f32x4 (&v)[8], int lane) {
    const int kr = lane >> 3, c4 = lane & 7, n = T.n0 + 4 * c4;
#pragma unroll
    for (int i = 0; i < 8; ++i) v[i] = (n < T.N) ? *(const f32x4*)(T.W + (size_t)(T.k0 + 8 * i + kr) * T.N + n) : (f32x4){0.f, 0.f, 0.f, 0.f};
}
__device__ __forceinline__ void tr_store(const TrItem& T, const f32x4 (&v)[8], LAS float* scr, int lane) {
    { const int kr = lane >> 3, c4 = lane & 7;
#pragma unroll
      for (int i = 0; i < 8; ++i) { LAS float* d = scr + (8 * i + kr) * 33 + 4 * c4; d[0] = v[i][0]; d[1] = v[i][1]; d[2] = v[i][2]; d[3] = v[i][3]; } }
    LDS_WAIT(); asm volatile("" ::: "memory");
    const int c = lane & 7;
#pragma unroll
    for (int j = 0; j < 4; ++j) { const int n = (lane >> 3) + 8 * j; const LAS float* s = scr + (8 * c) * 33 + n;
        v4u o; o.x = pg8::cvt_pk_bf16(s[0 * 33], s[1 * 33]); o.y = pg8::cvt_pk_bf16(s[2 * 33], s[3 * 33]); o.z = pg8::cvt_pk_bf16(s[4 * 33], s[5 * 33]); o.w = pg8::cvt_pk_bf16(s[6 * 33], s[7 * 33]);
        *(v4u*)(T.WT + (size_t)(T.drow + n) * T.K + T.k0 + 8 * c) = o; }
    LDS_WAIT(); asm volatile("" ::: "memory");
}

__device__ __forceinline__ void tr_store8(const TrItem& T, const f32x4 (&v)[8], LAS float* scr, int lane) {
    { const int kr = lane >> 3, c4 = lane & 7;
#pragma unroll
      for (int i = 0; i < 8; ++i) { LAS float* d = scr + (8 * i + kr) * 33 + 4 * c4; d[0] = v[i][0]; d[1] = v[i][1]; d[2] = v[i][2]; d[3] = v[i][3]; } }
    LDS_WAIT(); asm volatile("" ::: "memory");
    const int c = lane & 3, nr = lane >> 2; const float sc = T.f8scale;
#pragma unroll
    for (int j = 0; j < 2; ++j) { const int n = nr + 16 * j; const LAS float* s = scr + (16 * c) * 33 + n; int w[4];
#pragma unroll
        for (int q = 0; q < 4; ++q) { w[q] = __builtin_amdgcn_cvt_pk_fp8_f32(s[(4 * q) * 33] * sc, s[(4 * q + 1) * 33] * sc, 0, false); w[q] = __builtin_amdgcn_cvt_pk_fp8_f32(s[(4 * q + 2) * 33] * sc, s[(4 * q + 3) * 33] * sc, w[q], true); }
        v4u o; o.x = (unsigned)w[0]; o.y = (unsigned)w[1]; o.z = (unsigned)w[2]; o.w = (unsigned)w[3];
        *(v4u*)((unsigned char*)T.WT + (size_t)(T.drow + n) * T.K + T.k0 + 16 * c) = o; }
    LDS_WAIT(); asm volatile("" ::: "memory");
}
__device__ __forceinline__ void p0_prologue(Frame& F, const Args& A) {
    LAS float* scr = (LAS float*)(F.lds + RING_OFF + F.wave * 16384);
    unsigned char* ws = A.ws;
    const int gw = F.vcu * NWAVES + F.wave, NGW = F.G * NWAVES, lane = F.lane;
    { TrItem cur, nxt; f32x4 va[8], vb[8]; int it = gw;
      if (it < TR_NITEMS) { tr_decode(A, ws, it, cur); tr_load(cur, va, lane); }
      while (it < TR_NITEMS) {
          int itn = it + NGW; if (itn < TR_NITEMS) { tr_decode(A, ws, itn, nxt); tr_load(nxt, vb, lane); }
          if (cur.f8scale != 0.f) tr_store8(cur, va, scr, lane); else tr_store(cur, va, scr, lane);
          it = itn; if (it >= TR_NITEMS) break;
          itn = it + NGW; if (itn < TR_NITEMS) { tr_decode(A, ws, itn, cur); tr_load(cur, va, lane); }
          if (nxt.f8scale != 0.f) tr_store8(nxt, vb, scr, lane); else tr_store(nxt, vb, scr, lane);
          it = itn;
      } }
    { const float* x = A.in[0]; bf16* xb = (bf16*)(ws + WS_XB); const size_t n8 = (size_t)NTOK * DM / 8;
      for (size_t i = (size_t)F.vcu * 512 + F.tid; i < n8; i += (size_t)F.G * 512) { const f32x4 a = *(const f32x4*)(x + i * 8), b = *(const f32x4*)(x + i * 8 + 4);
          v4u o; o.x = pk2(a[0], a[1]); o.y = pk2(a[2], a[3]); o.z = pk2(b[0], b[1]); o.w = pk2(b[2], b[3]); *(v4u*)(xb + i * 8) = o; } }
    for (int it = gw; it < 64; it += NGW) { const int kv = it >> 5, ch = it & 31; const float* pe = A.in[kv ? 6 : 3]; const float* w1 = A.in[kv ? 7 : 4];
        float s0 = 0.f, s1 = 0.f;
        for (int k = ch * 128; k < ch * 128 + 128; ++k) { const float p = pe[k]; s0 += p * w1[(size_t)k * 128 + lane]; s1 += p * w1[(size_t)k * 128 + 64 + lane]; }
        float* cb = (float*)(ws + WS_CBIAS) + (size_t)(kv * 32 + ch) * 128; cb[lane] = s0; cb[64 + lane] = s1; }
}

typedef short s8v __attribute__((ext_vector_type(8)));
__device__ __forceinline__ s8v ld_frag(const bf16* p) { return *(const s8v*)p; }

__device__ __forceinline__ float gelu_tanh(float x) { const float u = 0.7978845608028654f * (x + 0.044715f * x * x * x); return 0.5f * x * (1.0f + tanhf(u)); }
__device__ __forceinline__ void p2_compress(Frame& F, const Args& A) {
    unsigned char* ws = A.ws; const int lane = F.lane, wid = F.wave, tid = F.tid;
    const bf16* P0 = (const bf16*)(ws + WS_P0);
    LAS float* part = (LAS float*)(F.lds + RING_OFF);
    LAS float* hid = (LAS float*)(F.lds + DSA_SCR);
    LAS float* cbl = hid + 4096;
    if (tid < 256) { const float* cbp = (const float*)(ws + WS_CBIAS) + (size_t)(tid >> 7) * 32 * 128 + (tid & 127); float cb = 0.f; for (int ch = 0; ch < 32; ++ch) cb += cbp[ch * 128]; cbl[tid] = cb; }
    if (F.vcu < 16 && wid == 0) { bf16* zp = (bf16*)(ws + ((F.vcu & 1) ? WS_VCMP : WS_KCMP)) + ((size_t)(F.vcu >> 1) * 512 + 511) * 128; zp[lane] = 0; zp[64 + lane] = 0; }
    __syncthreads();
    const int r16 = lane & 15, kq = lane >> 4;
    for (int it = F.vcu; it < 256; it += F.G) {
        const int kv = it >> 7, tile = it & 127;
        const bf16* W1T = (const bf16*)(ws + (kv ? WS_W_CMPV : WS_W_CMPK));
        const float* w2 = A.in[kv ? 8 : 5];
        bf16* outp = (bf16*)(ws + (kv ? WS_VCMP : WS_KCMP));
        const int colbase = kv ? COL_VC : COL_KC;
        f32x4 acc[2][8];
#pragma unroll
        for (int m = 0; m < 2; ++m)
#pragma unroll
            for (int n = 0; n < 8; ++n) acc[m][n] = (f32x4){0.f, 0.f, 0.f, 0.f};
        const bf16* arow[2];
#pragma unroll
        for (int m = 0; m < 2; ++m) { int R = tile * 32 + m * 16 + r16; if (R > 4087) R = 4087; const int g = R & 3, bn = R >> 2, b = bn / NCMP, n = bn - b * NCMP;
            arow[m] = P0 + (size_t)(b * SEQ + 16 * n) * P0LD + colbase + g * 128 + kq * 8; }
#pragma unroll 2
        for (int kk = 0; kk < 16; ++kk) {
            const int ks = wid * 16 + kk, l = ks >> 2, d0 = (ks & 3) * 32;
            s8v af[2], bfr[8];
#pragma unroll
            for (int m = 0; m < 2; ++m) af[m] = ld_frag(arow[m] + (size_t)l * P0LD + d0);
#pragma unroll
            for (int n = 0; n < 8; ++n) bfr[n] = ld_frag(W1T + (size_t)(n * 16 + r16) * 4096 + ks * 32 + kq * 8);
#pragma unroll
            for (int m = 0; m < 2; ++m)
#pragma unroll
                for (int n = 0; n < 8; ++n) acc[m][n] = __builtin_amdgcn_mfma_f32_16x16x32_bf16(af[m], bfr[n], acc[m][n], 0, 0, 0);
        }
#pragma unroll
        for (int m = 0; m < 2; ++m)
#pragma unroll
            for (int n = 0; n < 8; ++n)
#pragma unroll
                for (int j = 0; j < 4; ++j) part[wid * 4096 + (m * 16 + kq * 4 + j) * 128 + n * 16 + r16] = acc[m][n][j];
        __syncthreads();
        { const int row = tid >> 4, e0 = (tid & 15) * 8; f32x4 s0 = (f32x4){0.f, 0.f, 0.f, 0.f}, s1 = s0;
#pragma unroll
          for (int w = 0; w < 8; ++w) { s0 += *(const LAS f32x4*)(part + w * 4096 + row * 128 + e0); s1 += *(const LAS f32x4*)(part + w * 4096 + row * 128 + e0 + 4); }
#pragma unroll
          for (int j = 0; j < 4; ++j) { hid[row * 128 + e0 + j] = gelu_tanh(s0[j] + cbl[kv * 128 + e0 + j]); hid[row * 128 + e0 + 4 + j] = gelu_tanh(s1[j] + cbl[kv * 128 + e0 + 4 + j]); } }
        __syncthreads();
        { const int rr = tid >> 4, f0 = (tid & 15) * 8, R = tile * 32 + rr; f32x4 o0 = (f32x4){0.f, 0.f, 0.f, 0.f}, o1 = o0;
#pragma unroll 4
          for (int e = 0; e < 128; ++e) { const float hv = hid[rr * 128 + e]; o0 += *(const f32x4*)(w2 + e * 128 + f0) * hv; o1 += *(const f32x4*)(w2 + e * 128 + f0 + 4) * hv; }
          if (R <= 4087) { const int g = R & 3, bn = R >> 2, b = bn / NCMP, n = bn - b * NCMP;
              v4u o; o.x = pk2(o0[0], o0[1]); o.y = pk2(o0[2], o0[3]); o.z = pk2(o1[0], o1[1]); o.w = pk2(o1[2], o1[3]);
              *(v4u*)(outp + ((size_t)(b * 4 + g) * 512 + n) * 128 + f0) = o; } }
        __syncthreads();
    }
}

namespace fa {
typedef float f32x16 __attribute__((ext_vector_type(16)));
typedef short s16x4 __attribute__((ext_vector_type(4)));
typedef unsigned u32x4v __attribute__((ext_vector_type(4)));
constexpr int SHM_K = 16384, SHM_V = 16384;
constexpr int OFF_V = 0, OFF_K = 2 * SHM_V, OFF_WS = 2 * SHM_V + 2 * SHM_K, OFF_LUT = OFF_WS + 8 * 256, OFF_MASK = OFF_LUT + 144 * 16 * 4, OFF_TAB = OFF_MASK + 1024;
constexpr int TABLD = 130;
constexpr float C2 = 1.4426950408889634f, THR = 8.f;
#define FA_KSWZ(row, colB) ((row) * 256 + ((colB) ^ (((row) & 7) << 4)))
#define FA_SBAR() __builtin_amdgcn_sched_barrier(0)
__device__ __forceinline__ int v_st(int k, int c) { const int kk = (k & ~0xC) | ((k & 4) << 1) | ((k & 8) >> 1); return ((kk >> 3) * 4 + (c >> 5)) * 512 + ((kk & 7) * 32 + (c & 31)) * 2; }
__device__ __forceinline__ int v_rd_base(int lane) { return ((lane & 3) << 3) | (((lane >> 2) & 3) << 6) | (((lane >> 4) & 1) << 5) | (((lane >> 5) & 1) << 8); }
constexpr int v_rd_off(int d0, int ks, int half) { return d0 * 512 + ks * 4096 + half * 2048; }
__device__ __forceinline__ int crow(int r, int hi) { return (r & 3) + 8 * (r >> 2) + 4 * hi; }
__device__ __forceinline__ unsigned cvtpk(float lo, float hi) { unsigned r; asm volatile("v_cvt_pk_bf16_f32 %0, %1, %2" : "=v"(r) : "v"(lo), "v"(hi)); return r; }

__device__ __forceinline__ void qkt(f32x16& p0, f32x16& p1, const LAS char* Kb, int r32, int hi, const bf16x8 (&qr)[8], float init) {
#pragma unroll
    for (int r = 0; r < 16; ++r) { p0[r] = init; p1[r] = init; }
    const LAS char* kb[4];
#pragma unroll
    for (int dd = 0; dd < 4; ++dd) kb[dd] = Kb + FA_KSWZ(r32, (dd * 16 + hi * 8) * 2);
#pragma unroll
    for (int d0 = 0; d0 < 8; ++d0) { const LAS char* a = kb[d0 & 3] + (d0 >> 2) * 128;
        const bf16x8 b0 = *(const LAS bf16x8*)a;
        const bf16x8 b1 = *(const LAS bf16x8*)(a + 32 * 256);
        p0 = __builtin_amdgcn_mfma_f32_32x32x16_bf16(b0, qr[d0], p0, 0, 0, 0);
        p1 = __builtin_amdgcn_mfma_f32_32x32x16_bf16(b1, qr[d0], p1, 0, 0, 0); }
}
__device__ __forceinline__ void pv_tile(f32x16 (&o)[4], int vb0, bf16x8 pa0, bf16x8 pa1, bf16x8 pa2, bf16x8 pa3) {
#define FA_TRRD(dst, off) asm volatile("ds_read_b64_tr_b16 %0, %1 offset:%2" : "=&v"(dst) : "v"(vb0), "i"(off) : "memory")
#define FA_PV_D0(d0) do { s16x4 l0, l1, l2, l3, h0, h1, h2, h3; constexpr int b_ = v_rd_off(d0, 0, 0); \
        FA_TRRD(l0, b_); FA_TRRD(h0, b_ + 2048); FA_TRRD(l1, b_ + 4096); FA_TRRD(h1, b_ + 6144); FA_TRRD(l2, b_ + 8192); FA_TRRD(h2, b_ + 10240); FA_TRRD(l3, b_ + 12288); FA_TRRD(h3, b_ + 14336); \
        asm volatile("s_waitcnt lgkmcnt(0)" ::: "memory"); FA_SBAR(); \
        o[d0] = __builtin_amdgcn_mfma_f32_32x32x16_bf16(pa0, (bf16x8){l0[0], l0[1], l0[2], l0[3], h0[0], h0[1], h0[2], h0[3]}, o[d0], 0, 0, 0); \
        o[d0] = __builtin_amdgcn_mfma_f32_32x32x16_bf16(pa1, (bf16x8){l1[0], l1[1], l1[2], l1[3], h1[0], h1[1], h1[2], h1[3]}, o[d0], 0, 0, 0); \
        o[d0] = __builtin_amdgcn_mfma_f32_32x32x16_bf16(pa2, (bf16x8){l2[0], l2[1], l2[2], l2[3], h2[0], h2[1], h2[2], h2[3]}, o[d0], 0, 0, 0); \
        o[d0] = __builtin_amdgcn_mfma_f32_32x32x16_bf16(pa3, (bf16x8){l3[0], l3[1], l3[2], l3[3], h3[0], h3[1], h3[2], h3[3]}, o[d0], 0, 0, 0); } while (0)
    FA_PV_D0(0); FA_PV_D0(1); FA_PV_D0(2); FA_PV_D0(3);
#undef FA_PV_D0
#undef FA_TRRD
}
__device__ __forceinline__ void partialSM(f32x16& p0, f32x16& p1, float& m_reg, float& alpha) {
    float pmax = p0[0];
#pragma unroll
    for (int r = 1; r < 16; ++r) pmax = fmaxf(pmax, p0[r]);
#pragma unroll
    for (int r = 0; r < 16; ++r) pmax = fmaxf(pmax, p1[r]);
    { auto rr = __builtin_amdgcn_permlane32_swap(__float_as_uint(pmax), __float_as_uint(pmax), false, false); pmax = fmaxf(__uint_as_float(rr[0]), __uint_as_float(rr[1])); }
    float mn;
    if (__all(pmax - m_reg <= THR)) { mn = m_reg; alpha = 1.f; }
    else { mn = fmaxf(m_reg, pmax); alpha = __builtin_amdgcn_exp2f((m_reg - mn) * C2); m_reg = mn; }
    const float mnL = -mn * C2;
#pragma unroll
    for (int r = 0; r < 16; ++r) { p0[r] = __builtin_amdgcn_exp2f(fmaf(p0[r], C2, mnL)); p1[r] = __builtin_amdgcn_exp2f(fmaf(p1[r], C2, mnL)); }
}
__device__ __forceinline__ float finishSM(const f32x16& p0, const f32x16& p1, bf16x8& pa0, bf16x8& pa1, bf16x8& pa2, bf16x8& pa3) {
    float ps = 0.f;
#pragma unroll
    for (int r = 0; r < 16; ++r) ps += p0[r];
#pragma unroll
    for (int r = 0; r < 16; ++r) ps += p1[r];
    { auto rr = __builtin_amdgcn_permlane32_swap(__float_as_uint(ps), __float_as_uint(ps), false, false); ps = __uint_as_float(rr[0]) + __uint_as_float(rr[1]); }
#define FA_PK4(P, B_, OUT) do { unsigned a0 = cvtpk(P[B_ + 0], P[B_ + 1]), a1 = cvtpk(P[B_ + 2], P[B_ + 3]); unsigned b0 = cvtpk(P[B_ + 4], P[B_ + 5]), b1 = cvtpk(P[B_ + 6], P[B_ + 7]); \
        auto r0 = __builtin_amdgcn_permlane32_swap(a0, b0, false, false); auto r1 = __builtin_amdgcn_permlane32_swap(a1, b1, false, false); \
        u32x4v w = {r0[0], r1[0], r0[1], r1[1]}; OUT = *reinterpret_cast<bf16x8*>(&w); } while (0)
    FA_PK4(p0, 0, pa0); FA_PK4(p0, 8, pa1); FA_PK4(p1, 0, pa2); FA_PK4(p1, 8, pa3);
#undef FA_PK4
    return ps;
}
__device__ __forceinline__ void rescale(f32x16 (&o)[4], float alpha, LAS float* al_l, int r32, int hi) {
    if (__any(alpha < 1.f)) { if (hi == 0) al_l[r32] = alpha; asm volatile("s_waitcnt lgkmcnt(0)" ::: "memory");
#pragma unroll
        for (int r = 0; r < 16; ++r) { const float a = al_l[crow(r, hi)];
#pragma unroll
            for (int d = 0; d < 4; ++d) o[d][r] *= a; }
        asm volatile("s_waitcnt lgkmcnt(0)" ::: "memory"); }
}
__device__ __forceinline__ void mask_tile(f32x16& p0, f32x16& p1, int dq, unsigned W) {
    const float NEG = -__builtin_inff();
#pragma unroll
    for (int r = 0; r < 16; ++r) { const int c = (r & 3) + 8 * (r >> 2);
        if ((unsigned)(dq - c) >= W) p0[r] = NEG;
        if ((unsigned)(dq - c - 32) >= W) p1[r] = NEG; }
}
__device__ __forceinline__ void mask_all(f32x16& p0, f32x16& p1, bool keep) {
    const float NEG = -__builtin_inff();
#pragma unroll
    for (int r = 0; r < 16; ++r) { p0[r] = keep ? p0[r] : NEG; p1[r] = keep ? p1[r] : NEG; }
}
__device__ __forceinline__ void bias_near(f32x16& p0, f32x16& p1, int dq, int step, const LAS float* lutcol) {
#pragma unroll
    for (int r = 0; r < 16; ++r) { const int c = (r & 3) + 8 * (r >> 2);
        const int d0 = min(max((dq - c) * step, 0), 128), d1 = min(max((dq - c - 32) * step, 0), 128);
        p0[r] += lutcol[d0]; p1[r] += lutcol[d1]; }
}
struct Stage { bf16x8 k0, k1, v0, v1; };
__device__ __forceinline__ void stage_load(Stage& S, const bf16* Kp, const bf16* Vp, size_t ld, int row0, int maxrow, int sr, int sc) {
    const int ra = min(row0 + sr, maxrow), rb = min(row0 + 32 + sr, maxrow);
    S.k0 = *(const bf16x8*)(Kp + (size_t)ra * ld + sc); S.k1 = *(const bf16x8*)(Kp + (size_t)rb * ld + sc);
    S.v0 = *(const bf16x8*)(Vp + (size_t)ra * ld + sc); S.v1 = *(const bf16x8*)(Vp + (size_t)rb * ld + sc);
}
__device__ __forceinline__ void stage_write(const Stage& S, LAS char* Kb, LAS char* Vb, int kws, int vst0, int vst1) {
    *(LAS bf16x8*)(Kb + kws) = S.k0; *(LAS bf16x8*)(Kb + kws + 32 * 256) = S.k1;
    *(LAS bf16x8*)(Vb + vst0) = S.v0; *(LAS bf16x8*)(Vb + vst1) = S.v1;
}
}

struct NsaLane { int wid, lane, r32, hi, ql, j, sr, sc, kws, vst0, vst1, vrd; };
__device__ __forceinline__ NsaLane nsa_lane(const Frame& F) {
    NsaLane L; L.wid = F.wave; L.lane = F.lane; L.r32 = F.lane & 31; L.hi = F.lane >> 5; L.ql = L.r32 >> 2; L.j = L.r32 & 3;
    L.sr = F.tid >> 4; L.sc = (F.tid & 15) * 8; L.kws = FA_KSWZ(L.sr, L.sc * 2); L.vst0 = fa::v_st(L.sr, L.sc); L.vst1 = fa::v_st(32 + L.sr, L.sc); L.vrd = fa::v_rd_base(F.lane);
    return L;
}
__device__ __forceinline__ void nsa_load_q(bf16x8 (&qr)[8], const bf16* P0, int tok0, int g, const NsaLane& L) {
    const bf16* qp = P0 + (size_t)(tok0 + L.wid * 8 + L.ql) * P0LD + (g * 4 + L.j) * 128 + L.hi * 8;
#pragma unroll
    for (int d0 = 0; d0 < 8; ++d0) qr[d0] = *(const bf16x8*)(qp + d0 * 16);
}
__device__ __forceinline__ void nsa_lut(Frame& F, const Args& A) {
    LAS float* lut = (LAS float*)(F.lds + RING_OFF + fa::OFF_LUT);
    for (int i = F.tid; i < 144 * 16; i += 512) { const int n = i >> 4, h = i & 15; lut[h * 144 + n] = A.in[1][rel_bucket(n) * 16 + h]; }
    __syncthreads();
}
template <int MODE>
__device__ __forceinline__ void nsa_store(const fa::f32x16 (&o)[4], float l_reg, LAS float* li_l, const float* GL, float* OACC, bf16* OATT, int tok0, int g, int br, const NsaLane& L) {
    if (L.hi == 0) li_l[L.r32] = l_reg;
    asm volatile("s_waitcnt lgkmcnt(0)" ::: "memory");
    float sc[16];
#pragma unroll
    for (int r = 0; r < 16; ++r) { const int row = fa::crow(r, L.hi), tok = tok0 + L.wid * 8 + (row >> 2), h = g * 4 + (row & 3); sc[r] = GL[(size_t)tok * 48 + h * 3 + br]; }
    float prev[4][16];
    if (MODE != 0) {
#pragma unroll
        for (int r = 0; r < 16; ++r) { const int row = fa::crow(r, L.hi), tok = tok0 + L.wid * 8 + (row >> 2), h = g * 4 + (row & 3); const float* ap = OACC + (size_t)tok * DM + h * 128 + L.r32;
#pragma unroll
            for (int d0 = 0; d0 < 4; ++d0) prev[d0][r] = ap[d0 * 32]; } }
#pragma unroll
    for (int r = 0; r < 16; ++r) { const int row = fa::crow(r, L.hi), tok = tok0 + L.wid * 8 + (row >> 2), h = g * 4 + (row & 3);
        const float l = li_l[row]; const float gl = sc[r];
        const float scl = (l > 0.f) ? __builtin_amdgcn_rcpf(l) / (1.0f + __expf(-gl)) : 0.f;
        float* ap = OACC + (size_t)tok * DM + h * 128 + L.r32;
#pragma unroll
        for (int d0 = 0; d0 < 4; ++d0) { float v = o[d0][r] * scl;
            if (MODE == 0) ap[d0 * 32] = v;
            else if (MODE == 1) ap[d0 * 32] = prev[d0][r] + v;
            else { v += prev[d0][r]; const float vn = __shfl_xor(v, 1); if ((L.r32 & 1) == 0) *(unsigned*)(OATT + (size_t)tok * DM + h * 128 + d0 * 32 + L.r32) = fa::cvtpk(v, vn); } } }
    asm volatile("s_waitcnt lgkmcnt(0)" ::: "memory");
}

__device__ __forceinline__ void p3a_nsa_cmp(Frame& F, const Args& A) {
    unsigned char* ws = A.ws; const NsaLane L = nsa_lane(F);
    const bf16* P0 = (const bf16*)(ws + WS_P0); const bf16* KCB = (const bf16*)(ws + WS_KCMP); const bf16* VCB = (const bf16*)(ws + WS_VCMP);
    const float* GL = (const float*)(ws + WS_GL); float* OACC = (float*)(ws + WS_Z); unsigned* SELM = (unsigned*)(ws + WS_SELM);
    nsa_lut(F, A);
    LAS char* lds = (LAS char*)(F.lds + RING_OFF);
    LAS float* wsf = (LAS float*)(lds + fa::OFF_WS) + L.wid * 64; LAS float* li_l = wsf; LAS float* al_l = wsf + 32;
    const LAS float* lut = (const LAS float*)(lds + fa::OFF_LUT);
    LAS float* tab = (LAS float*)(lds + fa::OFF_TAB);
    for (int ui = 0; ui < 2 * ((512 - F.vcu + F.G - 1) / F.G); ++ui) {
        const int p = F.vcu + (ui >> 1) * F.G, bg = p >> 6, y = p & 63, qb = (ui & 1) ? 127 - y : y, b = bg >> 2, g = bg & 3;
        const int tok0 = b * SEQ + qb * 64;
        bf16x8 qr[8]; nsa_load_q(qr, P0, tok0, g, L);
        const int trow = qb * 64 + L.wid * 8 + L.ql;
        const int h = g * 4 + L.j; const LAS float* lutcol = lut + h * 144; const float bias_far = lutcol[128];
        const int nmaxrow = (trow >= 31) ? (trow - 31) >> 4 : -1;
        const int NT = (4 * qb + 3 + 63) >> 6;
        const bf16* Kg = KCB + (size_t)(b * 4 + g) * 512 * 128; const bf16* Vg = VCB + (size_t)(b * 4 + g) * 512 * 128;
        for (int i = F.tid; i < 64 * fa::TABLD; i += 512) tab[i] = 0.f;
        float m_reg = -1e30f, l_reg = 0.f;
        fa::Stage S;
        const int rem16 = (trow >= 31) ? ((trow - 31) & 15) : 0;
        fa::stage_load(S, Kg, Vg, 128, 0, 511, L.sr, L.sc); asm volatile("s_waitcnt vmcnt(0)" ::: "memory");
        fa::stage_write(S, lds + fa::OFF_K, lds + fa::OFF_V, L.kws, L.vst0, L.vst1);
        __syncthreads();
#pragma unroll 1
        for (int t = 0; t < NT; ++t) {
            const int buf = t & 1;
            if (t + 1 < NT) fa::stage_load(S, Kg, Vg, 128, (t + 1) * 64, 511, L.sr, L.sc);
            fa::f32x16 p0, p1;
            const bool farT = (qb * 64 + L.wid * 8) - 31 - 16 * (t * 64 + 63) >= 128;
            fa::qkt(p0, p1, lds + fa::OFF_K + buf * fa::SHM_K, L.r32, L.hi, qr, farT ? bias_far : 0.f);
            const int dq = nmaxrow - t * 64 - 4 * L.hi;
            if (!farT) fa::bias_near(p0, p1, dq, 16, lutcol + rem16);
            fa::mask_tile(p0, p1, dq, 0x40000000u);
            float alpha; fa::partialSM(p0, p1, m_reg, alpha);
            float ps = 0.f;
#pragma unroll
            for (int r = 0; r < 16; ++r) ps += p0[r] + p1[r];
            { auto rr = __builtin_amdgcn_permlane32_swap(__float_as_uint(ps), __float_as_uint(ps), false, false); ps = __uint_as_float(rr[0]) + __uint_as_float(rr[1]); }
            l_reg = l_reg * alpha + ps;
            if (t + 1 < NT) { asm volatile("s_waitcnt vmcnt(0)" ::: "memory"); fa::stage_write(S, lds + fa::OFF_K + (buf ^ 1) * fa::SHM_K, lds + fa::OFF_V + (buf ^ 1) * fa::SHM_V, L.kws, L.vst0, L.vst1); }
            __syncthreads();
        }
        fa::f32x16 o[4];
#pragma unroll
        for (int d = 0; d < 4; ++d)
#pragma unroll
            for (int r = 0; r < 16; ++r) o[d][r] = 0.f;
        fa::stage_load(S, Kg, Vg, 128, 0, 511, L.sr, L.sc); asm volatile("s_waitcnt vmcnt(0)" ::: "memory");
        fa::stage_write(S, lds + fa::OFF_K, lds + fa::OFF_V, L.kws, L.vst0, L.vst1);
        __syncthreads();
        const float inv_l = (l_reg > 0.f) ? 1.0f / l_reg : 0.f; const float mnL = -m_reg * fa::C2;
#pragma unroll 1
        for (int t = 0; t < NT; ++t) {
            const int buf = t & 1;
            if (t + 1 < NT) fa::stage_load(S, Kg, Vg, 128, (t + 1) * 64, 511, L.sr, L.sc);
            fa::f32x16 p0, p1;
            const bool farT = (qb * 64 + L.wid * 8) - 31 - 16 * (t * 64 + 63) >= 128;
            fa::qkt(p0, p1, lds + fa::OFF_K + buf * fa::SHM_K, L.r32, L.hi, qr, farT ? bias_far : 0.f);
            const int dq = nmaxrow - t * 64 - 4 * L.hi;
            if (!farT) fa::bias_near(p0, p1, dq, 16, lutcol + rem16);
            fa::mask_tile(p0, p1, dq, 0x40000000u);
#pragma unroll
            for (int r = 0; r < 16; ++r) { p0[r] = __builtin_amdgcn_exp2f(fmaf(p0[r], fa::C2, mnL)) * inv_l; p1[r] = __builtin_amdgcn_exp2f(fmaf(p1[r], fa::C2, mnL)) * inv_l; }
            LAS float* tb = tab + (L.wid * 8 + L.ql) * fa::TABLD + t * 16 + L.hi;
#pragma unroll
            for (int half = 0; half < 2; ++half)
#pragma unroll
                for (int gq = 0; gq < 4; ++gq) { const fa::f32x16& pp = half ? p1 : p0;
                    float s4 = pp[4 * gq] + pp[4 * gq + 1] + pp[4 * gq + 2] + 0.5f * pp[4 * gq + 3], cr = 0.5f * pp[4 * gq + 3];
                    s4 += __shfl_xor(s4, 1); s4 += __shfl_xor(s4, 2); cr += __shfl_xor(cr, 1); cr += __shfl_xor(cr, 2);
                    if (L.j == 0) { __hip_atomic_fetch_add(tb + half * 8 + 2 * gq, s4, __ATOMIC_RELAXED, __HIP_MEMORY_SCOPE_WORKGROUP); __hip_atomic_fetch_add(tb + half * 8 + 2 * gq + 1, cr, __ATOMIC_RELAXED, __HIP_MEMORY_SCOPE_WORKGROUP); } }
            bf16x8 a0, a1, a2, a3; (void)fa::finishSM(p0, p1, a0, a1, a2, a3);
            fa::pv_tile(o, (int)(uintptr_t)(lds + fa::OFF_V + buf * fa::SHM_V) + L.vrd, a0, a1, a2, a3);
            if (t + 1 < NT) { asm volatile("s_waitcnt vmcnt(0)" ::: "memory"); fa::stage_write(S, lds + fa::OFF_K + (buf ^ 1) * fa::SHM_K, lds + fa::OFF_V + (buf ^ 1) * fa::SHM_V, L.kws, L.vst0, L.vst1); }
            __syncthreads();
        }
        nsa_store<0>(o, (l_reg > 0.f) ? 1.0f : 0.f, li_l, GL, OACC, nullptr, tok0, g, 0, L);
        __syncthreads();
        {
            bool s0[8], s1[8];
            if (qb < 16) {
#pragma unroll
                for (int qi = 0; qi < 8; ++qi) { s0[qi] = (L.lane <= qb); s1[qi] = false; }
            } else {
                float v0[8], v1[8];
#pragma unroll
                for (int qi = 0; qi < 8; ++qi) { const int ql = L.wid * 8 + qi;
                    v0[qi] = (L.lane >= 1 && L.lane <= qb - 2) ? tab[ql * fa::TABLD + L.lane] : -1.0f; v1[qi] = (L.lane + 64 <= qb - 2) ? tab[ql * fa::TABLD + L.lane + 64] : -1.0f;
                    s0[qi] = (L.lane == 0) || (L.lane == qb) || (L.lane == qb - 1); s1[qi] = (L.lane + 64 == qb) || (L.lane + 64 == qb - 1);
                    if (s0[qi]) v0[qi] = -3e38f; if (s1[qi]) v1[qi] = -3e38f; }
#pragma unroll 1
                for (int k = 0; k < 13; ++k) {
#pragma unroll
                    for (int qi = 0; qi < 8; ++qi) { float bv = v0[qi]; int bi = L.lane; if (v1[qi] > v0[qi]) { bv = v1[qi]; bi = L.lane + 64; }
#pragma unroll
                        for (int of = 1; of < 64; of <<= 1) { const float ov = __shfl_xor(bv, of); const int oi = __shfl_xor(bi, of); if (ov > bv || (ov == bv && oi < bi)) { bv = ov; bi = oi; } }
                        if (bi == L.lane) { v0[qi] = -3e38f; s0[qi] = true; } if (bi == L.lane + 64) { v1[qi] = -3e38f; s1[qi] = true; } } }
            }
#pragma unroll
            for (int qi = 0; qi < 8; ++qi) { const int ql = L.wid * 8 + qi; const unsigned long long b0 = __ballot(s0[qi]), b1 = __ballot(s1[qi]);
                if (L.lane == 0) { uint4 mv; mv.x = (unsigned)b0; mv.y = (unsigned)(b0 >> 32); mv.z = (unsigned)b1; mv.w = (unsigned)(b1 >> 32); *(uint4*)(SELM + ((size_t)(tok0 + ql) * 4 + g) * 4) = mv; } }
        }
        __syncthreads();
    }
}
__device__ __forceinline__ void p3b_nsa_sel(Frame& F, const Args& A) {
    unsigned char* ws = A.ws; const NsaLane L = nsa_lane(F);
    const bf16* P0 = (const bf16*)(ws + WS_P0); const float* GL = (const float*)(ws + WS_GL); float* OACC = (float*)(ws + WS_Z); const unsigned* SELM = (const unsigned*)(ws + WS_SELM);
    nsa_lut(F, A);
    LAS char* lds = (LAS char*)(F.lds + RING_OFF);
    LAS float* wsf = (LAS float*)(lds + fa::OFF_WS) + L.wid * 64; LAS float* li_l = wsf; LAS float* al_l = wsf + 32;
    const LAS float* lut = (const LAS float*)(lds + fa::OFF_LUT);
    for (int ui = 0; ui < 2 * ((512 - F.vcu + F.G - 1) / F.G); ++ui) {
        const int p = F.vcu + (ui >> 1) * F.G, bg = p >> 6, y = p & 63, qb = (ui & 1) ? 127 - y : y, b = bg >> 2, g = bg & 3;
        const int tok0 = b * SEQ + qb * 64;
        bf16x8 qr[8]; nsa_load_q(qr, P0, tok0, g, L);
        const int trow = qb * 64 + L.wid * 8 + L.ql;
        const int h = g * 4 + L.j; const LAS float* lutcol = lut + h * 144; const float bias_far = lutcol[128];
        const uint4 mv = *(const uint4*)(SELM + ((size_t)(tok0 + L.wid * 8 + L.ql) * 4 + g) * 4);
        const bf16* Kg = P0 + (size_t)b * SEQ * P0LD + COL_KS + g * 128; const bf16* Vg = P0 + (size_t)b * SEQ * P0LD + COL_VS + g * 128;
        const int NT = qb + 1;
        float m_reg = -1e30f, l_reg = 0.f; fa::f32x16 o[4];
#pragma unroll
        for (int d = 0; d < 4; ++d)
#pragma unroll
            for (int r = 0; r < 16; ++r) o[d][r] = 0.f;
        fa::Stage S;
        fa::stage_load(S, Kg, Vg, P0LD, 0, SEQ - 1, L.sr, L.sc); asm volatile("s_waitcnt vmcnt(0)" ::: "memory");
        fa::stage_write(S, lds + fa::OFF_K, lds + fa::OFF_V, L.kws, L.vst0, L.vst1);
        __syncthreads();
#pragma unroll 1
        for (int t = 0; t < NT; ++t) {
            const int buf = t & 1;
            if (t + 1 < NT) fa::stage_load(S, Kg, Vg, P0LD, (t + 1) * 64, SEQ - 1, L.sr, L.sc);
            const unsigned word = (t < 32) ? mv.x : (t < 64) ? mv.y : (t < 96) ? mv.z : mv.w;
            const bool mine = ((word >> (t & 31)) & 1u) != 0u;
            if (__any(mine)) {
            fa::f32x16 p0, p1;
            const bool farT = (qb * 64 + L.wid * 8) - (t * 64 + 63) >= 128;
            fa::qkt(p0, p1, lds + fa::OFF_K + buf * fa::SHM_K, L.r32, L.hi, qr, farT ? bias_far : 0.f);
            const int dq = trow - t * 64 - 4 * L.hi;
            if (!farT) fa::bias_near(p0, p1, dq, 1, lutcol);
            fa::mask_all(p0, p1, mine);
            if (t == qb) fa::mask_tile(p0, p1, dq, 0x40000000u);
            float alpha; fa::partialSM(p0, p1, m_reg, alpha);
            fa::rescale(o, alpha, al_l, L.r32, L.hi);
            bf16x8 a0, a1, a2, a3; const float ps = fa::finishSM(p0, p1, a0, a1, a2, a3); l_reg = l_reg * alpha + ps;
            fa::pv_tile(o, (int)(uintptr_t)(lds + fa::OFF_V + buf * fa::SHM_V) + L.vrd, a0, a1, a2, a3);
            }
            if (t + 1 < NT) { asm volatile("s_waitcnt vmcnt(0)" ::: "memory"); fa::stage_write(S, lds + fa::OFF_K + (buf ^ 1) * fa::SHM_K, lds + fa::OFF_V + (buf ^ 1) * fa::SHM_V, L.kws, L.vst0, L.vst1); }
            __syncthreads();
        }
        nsa_store<1>(o, l_reg, li_l, GL, OACC, nullptr, tok0, g, 1, L);
        __syncthreads();
    }
}
__device__ __forceinline__ void p3c_nsa_win(Frame& F, const Args& A) {
    unsigned char* ws = A.ws; const NsaLane L = nsa_lane(F);
    const bf16* P0 = (const bf16*)(ws + WS_P0); const float* GL = (const float*)(ws + WS_GL); float* OACC = (float*)(ws + WS_Z); bf16* OATT = (bf16*)(ws + WS_OATT0);
    nsa_lut(F, A);
    LAS char* lds = (LAS char*)(F.lds + RING_OFF);
    LAS float* wsf = (LAS float*)(lds + fa::OFF_WS) + L.wid * 64; LAS float* li_l = wsf; LAS float* al_l = wsf + 32;
    const LAS float* lut = (const LAS float*)(lds + fa::OFF_LUT);
    for (int u = F.vcu; u < 1024; u += F.G) {
        const int bg = u >> 7, qb = u & 127, b = bg >> 2, g = bg & 3;
        const int tok0 = b * SEQ + qb * 64;
        bf16x8 qr[8]; nsa_load_q(qr, P0, tok0, g, L);
        const int trow = qb * 64 + L.wid * 8 + L.ql;
        const int h = g * 4 + L.j; const LAS float* lutcol = lut + h * 144; const float bias_far = lutcol[128];
        const bf16* Kg = P0 + (size_t)b * SEQ * P0LD + COL_KW + g * 128; const bf16* Vg = P0 + (size_t)b * SEQ * P0LD + COL_VW + g * 128;
        const int t0 = max(0, qb - 8), NT = qb - t0 + 1;
        float m_reg = -1e30f, l_reg = 0.f; fa::f32x16 o[4];
#pragma unroll
        for (int d = 0; d < 4; ++d)
#pragma unroll
            for (int r = 0; r < 16; ++r) o[d][r] = 0.f;
        fa::Stage S;
        fa::stage_load(S, Kg, Vg, P0LD, t0 * 64, SEQ - 1, L.sr, L.sc); asm volatile("s_waitcnt vmcnt(0)" ::: "memory");
        fa::stage_write(S, lds + fa::OFF_K, lds + fa::OFF_V, L.kws, L.vst0, L.vst1);
        __syncthreads();
#pragma unroll 1
        for (int tt = 0; tt < NT; ++tt) {
            const int buf = tt & 1, t = t0 + tt;
            if (tt + 1 < NT) fa::stage_load(S, Kg, Vg, P0LD, (t + 1) * 64, SEQ - 1, L.sr, L.sc);
            fa::f32x16 p0, p1;
            const bool farT = (qb * 64 + L.wid * 8) - (t * 64 + 63) >= 128;
            fa::qkt(p0, p1, lds + fa::OFF_K + buf * fa::SHM_K, L.r32, L.hi, qr, farT ? bias_far : 0.f);
            const int dq = trow - t * 64 - 4 * L.hi;
            if (!farT) fa::bias_near(p0, p1, dq, 1, lutcol);
            if (t == qb || t == t0) fa::mask_tile(p0, p1, dq, 512u);
            float alpha; fa::partialSM(p0, p1, m_reg, alpha);
            fa::rescale(o, alpha, al_l, L.r32, L.hi);
            bf16x8 a0, a1, a2, a3; const float ps = fa::finishSM(p0, p1, a0, a1, a2, a3); l_reg = l_reg * alpha + ps;
            fa::pv_tile(o, (int)(uintptr_t)(lds + fa::OFF_V + buf * fa::SHM_V) + L.vrd, a0, a1, a2, a3);
            if (tt + 1 < NT) { asm volatile("s_waitcnt vmcnt(0)" ::: "memory"); fa::stage_write(S, lds + fa::OFF_K + (buf ^ 1) * fa::SHM_K, lds + fa::OFF_V + (buf ^ 1) * fa::SHM_V, L.kws, L.vst0, L.vst1); }
            __syncthreads();
        }
        nsa_store<2>(o, l_reg, li_l, GL, OACC, OATT, tok0, g, 2, L);
        __syncthreads();
    }
}

template <bool ROUTE, bool F8 = false>
__device__ __forceinline__ void ln_phase(Frame& F, const Args& A, const float* Z, const float* gam, const float* bet, float* XF, bf16* XB) {
    const int gw = F.vcu * NWAVES + F.wave, NGW = F.G * NWAVES, lane = F.lane;
    LAS float* wrl = (LAS float*)(F.lds + RING_OFF);
    if (ROUTE) { for (int i = F.tid; i < DM * 8 / 4; i += 512) *(LAS f32x4*)(wrl + i * 4) = *(const f32x4*)(A.in[18] + i * 4); __syncthreads(); }
    for (int row = gw; row < NTOK; row += NGW) {
        const f32x4* zr = (const f32x4*)(Z + (size_t)row * DM) + lane;
        f32x4 v[8]; float s = 0.f;
#pragma unroll
        for (int j = 0; j < 8; ++j) { v[j] = zr[64 * j]; s += (v[j][0] + v[j][1]) + (v[j][2] + v[j][3]); }
        const float mean = wave_sum(s) * (1.f / DM); float s2 = 0.f;
#pragma unroll
        for (int j = 0; j < 8; ++j) { v[j] = v[j] - mean; s2 += (v[j][0] * v[j][0] + v[j][1] * v[j][1]) + (v[j][2] * v[j][2] + v[j][3] * v[j][3]); }
        const float rstd = 1.f / sqrtf(wave_sum(s2) * (1.f / DM) + LN_EPS);
        float lg[8];
#pragma unroll
        for (int e = 0; e < 8; ++e) lg[e] = 0.f;
#pragma unroll
        for (int j = 0; j < 8; ++j) { const int c = 4 * lane + 256 * j; const f32x4 gg = *(const f32x4*)(gam + c), bb = *(const f32x4*)(bet + c);
            const f32x4 x = v[j] * rstd * gg + bb;
            *(f32x4*)(XF + (size_t)row * DM + c) = x;
            if (F8) { int w = __builtin_amdgcn_cvt_pk_fp8_f32(x[0], x[1], 0, false); w = __builtin_amdgcn_cvt_pk_fp8_f32(x[2], x[3], w, true); *(int*)((unsigned char*)XB + (size_t)row * DM + c) = w; }
            else { uint2 o; o.x = pk2(x[0], x[1]); o.y = pk2(x[2], x[3]); *(uint2*)(XB + (size_t)row * DM + c) = o; }
            asm volatile("" ::: "memory");
            if (ROUTE) { const LAS float* wr = wrl + c * 8;
#pragma unroll
                for (int q = 0; q < 4; ++q) { const f32x4 w0 = *(const LAS f32x4*)(wr + q * 8), w1 = *(const LAS f32x4*)(wr + q * 8 + 4);
                    lg[0] += x[q] * w0[0]; lg[1] += x[q] * w0[1]; lg[2] += x[q] * w0[2]; lg[3] += x[q] * w0[3]; lg[4] += x[q] * w1[0]; lg[5] += x[q] * w1[1]; lg[6] += x[q] * w1[2]; lg[7] += x[q] * w1[3]; }  asm volatile("" ::: "memory"); }
        }
        if (ROUTE) {
#pragma unroll
            for (int e = 0; e < 8; ++e) lg[e] = wave_sum(lg[e]) + A.in[19][e];
            int e0 = 0; float l0 = lg[0];
#pragma unroll
            for (int e = 1; e < 8; ++e) if (lg[e] > l0) { l0 = lg[e]; e0 = e; }
            int e1 = -1; float l1 = -3e38f;
#pragma unroll
            for (int e = 0; e < 8; ++e) if (e != e0 && lg[e] > l1) { l1 = lg[e]; e1 = e; }
            const float w0 = 1.0f / (1.0f + __expf(l1 - l0)), w1 = 1.0f - w0;
            if (lane == 0) {
                const unsigned p0 = __hip_atomic_fetch_add((unsigned*)(F.ctl + CW_MOECNT + 64 * e0), 1u, __ATOMIC_RELAXED, __HIP_MEMORY_SCOPE_AGENT);
                const unsigned p1 = __hip_atomic_fetch_add((unsigned*)(F.ctl + CW_MOECNT + 64 * e1), 1u, __ATOMIC_RELAXED, __HIP_MEMORY_SCOPE_AGENT);
                int* re = (int*)(A.ws + WS_ROUTE); int* rp = re + 2 * NTOK; float* rw = (float*)(rp + 2 * NTOK);
                re[2 * row] = e0; re[2 * row + 1] = e1; rp[2 * row] = (int)p0; rp[2 * row + 1] = (int)p1; rw[2 * row] = w0; rw[2 * row + 1] = w1;
            }
        }
    }
}

__device__ __forceinline__ void ln_route_phase(Frame& F, const Args& A, const float* Z, const float* gam, const float* bet, float* XF, bf16* XB) {
    const int gw = F.vcu * NWAVES + F.wave, NGW = F.G * NWAVES, lane = F.lane;
    LAS float* wrl = (LAS float*)(F.lds + RING_OFF);
    LAS float* rowb = (LAS float*)(F.lds + RING_OFF + 65536 + F.wave * 8192);
    for (int i = F.tid; i < DM * 8 / 4; i += 512) *(LAS f32x4*)(wrl + i * 4) = *(const f32x4*)(A.in[18] + i * 4);
    __syncthreads();
    for (int row = gw; row < NTOK; row += NGW) {
        float s = 0.f, s2 = 0.f;
#pragma unroll 1
        for (int j = 0; j < 8; ++j) { const f32x4 v = *(const f32x4*)(Z + (size_t)row * DM + 4 * lane + 256 * j); *(LAS f32x4*)(rowb + 4 * lane + 256 * j) = v;
            s += (v[0] + v[1]) + (v[2] + v[3]); }
        const float mean = wave_sum(s) * (1.f / DM);
#pragma unroll 1
        for (int j = 0; j < 8; ++j) { const f32x4 v = *(const LAS f32x4*)(rowb + 4 * lane + 256 * j) - mean; s2 += (v[0] * v[0] + v[1] * v[1]) + (v[2] * v[2] + v[3] * v[3]); }
        const float rstd = 1.f / sqrtf(wave_sum(s2) * (1.f / DM) + LN_EPS);
        float lg[8];
#pragma unroll
        for (int e = 0; e < 8; ++e) lg[e] = 0.f;
#pragma unroll 1
        for (int j = 0; j < 8; ++j) { const int c = 4 * lane + 256 * j; const f32x4 gg = *(const f32x4*)(gam + c), bb = *(const f32x4*)(bet + c);
            const f32x4 x = (*(const LAS f32x4*)(rowb + c) - mean) * rstd * gg + bb;
            *(f32x4*)(XF + (size_t)row * DM + c) = x;
            const LAS float* wr = wrl + c * 8;
#pragma unroll
            for (int q = 0; q < 4; ++q) { const f32x4 w0 = *(const LAS f32x4*)(wr + q * 8), w1 = *(const LAS f32x4*)(wr + q * 8 + 4);
                lg[0] += x[q] * w0[0]; lg[1] += x[q] * w0[1]; lg[2] += x[q] * w0[2]; lg[3] += x[q] * w0[3]; lg[4] += x[q] * w1[0]; lg[5] += x[q] * w1[1]; lg[6] += x[q] * w1[2]; lg[7] += x[q] * w1[3]; } }
#pragma unroll
        for (int e = 0; e < 8; ++e) lg[e] = wave_sum(lg[e]) + A.in[19][e];
        int e0 = 0; float l0 = lg[0];
#pragma unroll
        for (int e = 1; e < 8; ++e) if (lg[e] > l0) { l0 = lg[e]; e0 = e; }
        int e1 = -1; float l1 = -3e38f;
#pragma unroll
        for (int e = 0; e < 8; ++e) if (e != e0 && lg[e] > l1) { l1 = lg[e]; e1 = e; }
        const float w0 = 1.0f / (1.0f + __expf(l1 - l0)), w1 = 1.0f - w0;
        if (lane == 0) {
            const unsigned p0 = __hip_atomic_fetch_add((unsigned*)(F.ctl + CW_MOECNT + 64 * e0), 1u, __ATOMIC_RELAXED, __HIP_MEMORY_SCOPE_AGENT);
            const unsigned p1 = __hip_atomic_fetch_add((unsigned*)(F.ctl + CW_MOECNT + 64 * e1), 1u, __ATOMIC_RELAXED, __HIP_MEMORY_SCOPE_AGENT);
            int* re = (int*)(A.ws + WS_ROUTE); int* rp = re + 2 * NTOK; float* rw = (float*)(rp + 2 * NTOK);
            re[2 * row] = e0; re[2 * row + 1] = e1; rp[2 * row] = (int)p0; rp[2 * row + 1] = (int)p1; rw[2 * row] = w0; rw[2 * row + 1] = w1;
        }
        WSYNC();
    }
    __syncthreads();
}

__device__ __forceinline__ void p10_dsa_prep(Frame& F, const Args& A) {
    unsigned char* ws = A.ws; const int lane = F.lane;
    const int gw = F.vcu * NWAVES + F.wave, NGW = F.G * NWAVES;
    { const float* CR = (const float*)(ws + WS_CRAW); bf16* CN = (bf16*)(ws + WS_CN); const f32x4 gg = *(const f32x4*)(A.in[11] + 4 * lane);
      for (int row = gw; row < NTOK; row += NGW) { const f32x4 v = *(const f32x4*)(CR + (size_t)row * KVR + 4 * lane);
          const float ss = wave_sum(v[0] * v[0] + v[1] * v[1] + v[2] * v[2] + v[3] * v[3]); const float r = 1.f / sqrtf(ss * (1.f / KVR) + RMS_EPS);
          uint2 o; o.x = pk2(v[0] * r * gg[0], v[1] * r * gg[1]); o.y = pk2(v[2] * r * gg[2], v[3] * r * gg[3]); *(uint2*)(CN + (size_t)row * KVR + 4 * lane) = o;
          if (lane < 16) { const f32x4 kv = *(const f32x4*)((const float*)(ws + WS_KIWI) + (size_t)row * 128 + 4 * lane); uint2 k2; k2.x = pk2(kv[0], kv[1]); k2.y = pk2(kv[2], kv[3]); *(uint2*)((bf16*)(ws + WS_KIB) + (size_t)row * 64 + 4 * lane) = k2; } } }
    const bf16* Q = (const bf16*)(ws + WS_Q); const bf16* UKT = (const bf16*)(ws + WS_W_UK); bf16* QL = (bf16*)(ws + WS_QLAT);
    const int r16 = lane & 15, kq = lane >> 4; const float sc = 0.08838834764831845f;
    for (int it = gw; it < 512 * 16 * 4; it += NGW) {
        const int nc = it & 3, h = (it >> 2) & 15, mt = it >> 6;
        f32x4 acc[2][4];
#pragma unroll
        for (int m = 0; m < 2; ++m)
#pragma unroll
            for (int n = 0; n < 4; ++n) acc[m][n] = (f32x4){0.f, 0.f, 0.f, 0.f};
#pragma unroll
        for (int ks = 0; ks < 4; ++ks) { s8v af[2], bfr[4];
#pragma unroll
            for (int m = 0; m < 2; ++m) af[m] = ld_frag(Q + (size_t)(mt * 32 + m * 16 + r16) * DM + h * 128 + ks * 32 + kq * 8);
#pragma unroll
            for (int n = 0; n < 4; ++n) bfr[n] = ld_frag(UKT + ((size_t)h * 256 + nc * 64 + n * 16 + r16) * 128 + ks * 32 + kq * 8);
#pragma unroll
            for (int m = 0; m < 2; ++m)
#pragma unroll
                for (int n = 0; n < 4; ++n) acc[m][n] = __builtin_amdgcn_mfma_f32_16x16x32_bf16(bfr[n], af[m], acc[m][n], 0, 0, 0); }
#pragma unroll
        for (int m = 0; m < 2; ++m)
#pragma unroll
            for (int n = 0; n < 4; ++n) { uint2 o; o.x = pg8::cvt_pk_bf16(acc[m][n][0] * sc, acc[m][n][1] * sc); o.y = pg8::cvt_pk_bf16(acc[m][n][2] * sc, acc[m][n][3] * sc);
                *(uint2*)(QL + (size_t)(mt * 32 + m * 16 + r16) * 4096 + h * 256 + nc * 64 + n * 16 + kq * 4) = o; }
    }
}
__device__ __forceinline__ void p12_dsa_uv(Frame& F, const Args& A) {
    unsigned char* ws = A.ws; const int lane = F.lane;
    const int gw = F.vcu * NWAVES + F.wave, NGW = F.G * NWAVES;
    const bf16* OL = (const bf16*)(ws + WS_OLAT); const bf16* UVT = (const bf16*)(ws + WS_W_UV); bf16* O = (bf16*)(ws + WS_OATT1);
    const int r16 = lane & 15, kq = lane >> 4;
    for (int it = gw; it < 512 * 16 * 2; it += NGW) {
        const int nc = it & 1, h = (it >> 1) & 15, mt = it >> 5;
        f32x4 acc[2][4];
#pragma unroll
        for (int m = 0; m < 2; ++m)
#pragma unroll
            for (int n = 0; n < 4; ++n) acc[m][n] = (f32x4){0.f, 0.f, 0.f, 0.f};
#pragma unroll
        for (int ks = 0; ks < 8; ++ks) { s8v af[2], bfr[4];
#pragma unroll
            for (int m = 0; m < 2; ++m) af[m] = ld_frag(OL + (size_t)(mt * 32 + m * 16 + r16) * 4096 + h * 256 + ks * 32 + kq * 8);
#pragma unroll
            for (int n = 0; n < 4; ++n) bfr[n] = ld_frag(UVT + ((size_t)h * 128 + nc * 64 + n * 16 + r16) * 256 + ks * 32 + kq * 8);
#pragma unroll
            for (int m = 0; m < 2; ++m)
#pragma unroll
                for (int n = 0; n < 4; ++n) acc[m][n] = __builtin_amdgcn_mfma_f32_16x16x32_bf16(bfr[n], af[m], acc[m][n], 0, 0, 0); }
#pragma unroll
        for (int m = 0; m < 2; ++m)
#pragma unroll
            for (int n = 0; n < 4; ++n) { uint2 o; o.x = pg8::cvt_pk_bf16(acc[m][n][0], acc[m][n][1]); o.y = pg8::cvt_pk_bf16(acc[m][n][2], acc[m][n][3]);
                *(uint2*)(O + (size_t)(mt * 32 + m * 16 + r16) * DM + h * 128 + nc * 64 + n * 16 + kq * 4) = o; }
    }
}

__device__ __forceinline__ unsigned f2key(float f) { const unsigned u = __float_as_uint(f); return (u & 0x80000000u) ? ~u : (u | 0x80000000u); }

__device__ __forceinline__ unsigned dsa_off_b(unsigned row, unsigned ch) { return 256u * row + 16u * (ch ^ (((row & 3) << 2) | ((row >> 2) & 3))); }

__device__ __forceinline__ float key2f(unsigned k) { return __uint_as_float((k & 0x80000000u) ? (k & 0x7fffffffu) : ~k); }
__device__ __forceinline__ void p13a_dsa_index(Frame& F, const Args& A) {
    unsigned char* ws = A.ws; const int lane = F.lane, wid = F.wave, r32 = lane & 31, hi = lane >> 5;
    const bf16* QI = (const bf16*)(ws + WS_QI); const bf16* KIB = (const bf16*)(ws + WS_KIB); const float* KIWI = (const float*)(ws + WS_KIWI); int* IDX = (int*)(ws + WS_IDX);
    LAS float* sc = (LAS float*)(F.lds + RING_OFF);
    LAS unsigned* hist = (LAS unsigned*)(F.lds + DSA_SCR);
    LAS unsigned* cntG = hist + 1024;
    LAS unsigned* cntE = cntG + 512;
    LAS unsigned* qm = cntE + 512;
    LAS float* mmx = (LAS float*)(qm + 64);
    LAS unsigned* candk = (LAS unsigned*)(mmx + 64);
    constexpr int CAP = 256;
    const int q = wid >> 1, sub = wid & 1, th = sub * 64 + lane;
    for (int slot = F.vcu; slot < NTOK / 4; slot += F.G) {
        const int rowi = slot >> 8; int cc = slot & 255; if (rowi & 1) cc = 255 - cc;
        const int tok0 = (rowi * 256 + cc) * 4, b = tok0 >> 13, t0 = tok0 & (SEQ - 1), tmax = t0 + 3;
        bf16x8 qa[4];
#pragma unroll
        for (int s = 0; s < 4; ++s) qa[s] = *(const bf16x8*)(QI + (size_t)(tok0 + (r32 >> 3)) * 512 + (r32 & 7) * 64 + 16 * s + 8 * hi);
        float wv[16];
#pragma unroll
        for (int r = 0; r < 16; ++r) wv[r] = KIWI[(size_t)(tok0 + (r >> 2)) * 128 + 64 + (r & 3) + 4 * hi] * 0.35355339059327373f;
        const int ntiles = (tmax >> 5) + 1;
        hist[q * 256 + th] = 0u; hist[q * 256 + 128 + th] = 0u; if (th == 0) qm[q * 16 + 2] = 0u;
        float mn0 = 3e38f, mx0 = -3e38f, mn1 = 3e38f, mx1 = -3e38f;
        {
            bf16x8 kb[4], kn[4]; int tile = wid;
#pragma unroll
            for (int s = 0; s < 4; ++s) { kb[s] = (bf16x8){0, 0, 0, 0, 0, 0, 0, 0}; kn[s] = kb[s]; }
            if (tile < ntiles) { const bf16* kp = KIB + (size_t)(b * SEQ + tile * 32 + r32) * 64 + 8 * hi;
#pragma unroll
                for (int s = 0; s < 4; ++s) kb[s] = *(const bf16x8*)(kp + 16 * s); }
            while (tile < ntiles) {
                const int tn = tile + 8;
                if (tn < ntiles) { const bf16* kp = KIB + (size_t)(b * SEQ + tn * 32 + r32) * 64 + 8 * hi;
#pragma unroll
                    for (int s = 0; s < 4; ++s) kn[s] = *(const bf16x8*)(kp + 16 * s); }
                const int key = tile * 32 + r32;
                fa::f32x16 acc;
#pragma unroll
                for (int r = 0; r < 16; ++r) acc[r] = 0.f;
#pragma unroll
                for (int s = 0; s < 4; ++s) acc = __builtin_amdgcn_mfma_f32_32x32x16_bf16(qa[s], kb[s], acc, 0, 0, 0);
                float tot[4];
#pragma unroll
                for (int qq = 0; qq < 4; ++qq) { float part = 0.f;
#pragma unroll
                    for (int r3 = 0; r3 < 4; ++r3) part += wv[4 * qq + r3] * fmaxf(acc[4 * qq + r3], 0.f);
                    tot[qq] = part + __shfl_xor(part, 32) + 0.0f; }
                const float ta = hi ? tot[2] : tot[0], tb = hi ? tot[3] : tot[1];
                sc[(2 * hi) * 8192 + key] = ta; sc[(2 * hi + 1) * 8192 + key] = tb;
                if (key <= t0 + 2 * hi) { mn0 = fminf(mn0, ta); mx0 = fmaxf(mx0, ta); }
                if (key <= t0 + 2 * hi + 1) { mn1 = fminf(mn1, tb); mx1 = fmaxf(mx1, tb); }
#pragma unroll
                for (int s = 0; s < 4; ++s) kb[s] = kn[s];
                tile = tn;
            }
        }
#pragma unroll
        for (int o = 1; o < 32; o <<= 1) { mn0 = fminf(mn0, __shfl_xor(mn0, o)); mx0 = fmaxf(mx0, __shfl_xor(mx0, o)); mn1 = fminf(mn1, __shfl_xor(mn1, o)); mx1 = fmaxf(mx1, __shfl_xor(mx1, o)); }
        if (r32 == 0) { mmx[(wid * 4 + 2 * hi) * 2] = mn0; mmx[(wid * 4 + 2 * hi) * 2 + 1] = mx0; mmx[(wid * 4 + 2 * hi + 1) * 2] = mn1; mmx[(wid * 4 + 2 * hi + 1) * 2 + 1] = mx1; }
        __syncthreads();
        const int tok = tok0 + q, n = t0 + q + 1;
        if (tmax + 1 <= TOPK) {
            for (int i = th; i < TOPK; i += 128) IDX[(size_t)tok * TOPK + i] = (i < n) ? i : 0;
        } else {
            const LAS float* scq = sc + q * 8192; const int nsl = (n + 127) >> 7;
            float fmn = 3e38f, fmx = -3e38f;
#pragma unroll
            for (int w = 0; w < 8; ++w) { fmn = fminf(fmn, mmx[(w * 4 + q) * 2]); fmx = fmaxf(fmx, mmx[(w * 4 + q) * 2 + 1]); }
            const float bsc = (fmx > fmn) ? 255.99f / (fmx - fmn) : 0.f;
            for (int s0 = 0; s0 < nsl; s0 += 8) { float v[8];
#pragma unroll
                for (int j = 0; j < 8; ++j) { const int i = (s0 + j) * 128 + th; v[j] = scq[min(i, n - 1)]; }
#pragma unroll
                for (int j = 0; j < 8; ++j) { const int i = (s0 + j) * 128 + th; const int bin = min(max((int)((v[j] - fmn) * bsc), 0), 255);
                    LAS unsigned* tgt = (i < n) ? &hist[q * 256 + bin] : &qm[q * 16 + 8];
                    __hip_atomic_fetch_add(tgt, 1u, __ATOMIC_RELAXED, __HIP_MEMORY_SCOPE_WORKGROUP); } }
            __syncthreads();
            if (sub == 0) {
                const v4u c4 = *(const LAS v4u*)(hist + q * 256 + 4 * lane); const unsigned s4 = c4.x + c4.y + c4.z + c4.w; unsigned S = s4;
#pragma unroll
                for (int o = 1; o < 64; o <<= 1) { const unsigned v = __shfl_down(S, o); if (lane + o < 64) S += v; }
                const unsigned above = S - s4;
                if (above < (unsigned)TOPK && (unsigned)TOPK <= S) { unsigned cum = above; int bin;
                    if (cum + c4.w >= (unsigned)TOPK) bin = 3; else { cum += c4.w; if (cum + c4.z >= (unsigned)TOPK) bin = 2; else { cum += c4.z; if (cum + c4.y >= (unsigned)TOPK) bin = 1; else { cum += c4.y; bin = 0; } } }
                    qm[q * 16 + 0] = (unsigned)(4 * lane + bin); qm[q * 16 + 1] = (unsigned)TOPK - cum; }
            }
            __syncthreads();
            const int bstar = (int)qm[q * 16 + 0]; const unsigned need1 = qm[q * 16 + 1];
            for (int s0 = 0; s0 < nsl; s0 += 8) { float v[8];
#pragma unroll
                for (int j = 0; j < 8; ++j) { const int i = (s0 + j) * 128 + th; v[j] = scq[min(i, n - 1)]; }
#pragma unroll
                for (int j = 0; j < 8; ++j) { const int i = (s0 + j) * 128 + th; const int bin = min(max((int)((v[j] - fmn) * bsc), 0), 255);
                    if (i < n && bin == bstar) { const unsigned pc = __hip_atomic_fetch_add(&qm[q * 16 + 2], 1u, __ATOMIC_RELAXED, __HIP_MEMORY_SCOPE_WORKGROUP); if (pc < (unsigned)CAP) candk[q * CAP + pc] = f2key(v[j]); } } }
            __syncthreads();
            if (sub == 0) {
                const unsigned mc = qm[q * 16 + 2]; unsigned T = 0u, nt = 0u; bool found = false;
                if (mc <= (unsigned)CAP) {
                    unsigned kc[4], gt[4], ge[4];
#pragma unroll
                    for (int c = 0; c < 4; ++c) { kc[c] = (lane + 64 * c < (int)mc) ? candk[q * CAP + lane + 64 * c] : 0u; gt[c] = 0u; ge[c] = 0u; }
                    for (unsigned j = 0; j < mc; ++j) { const unsigned kj = candk[q * CAP + j];
#pragma unroll
                        for (int c = 0; c < 4; ++c) { gt[c] += (kj > kc[c]) ? 1u : 0u; ge[c] += (kj >= kc[c]) ? 1u : 0u; } }
#pragma unroll
                    for (int c = 0; c < 4; ++c) if (lane + 64 * c < (int)mc && gt[c] < need1 && need1 <= ge[c]) { T = kc[c]; nt = need1 - gt[c]; found = true; }
                } else {
                    unsigned lo = 0u;
                    for (int bit = 31; bit >= 0; --bit) { const unsigned cand = lo | (1u << bit); unsigned c = 0u;
                        for (int i = lane; i < n; i += 64) c += (f2key(scq[i]) >= cand) ? 1u : 0u;
#pragma unroll
                        for (int o = 1; o < 64; o <<= 1) c += __shfl_xor(c, o);
                        if (c >= (unsigned)TOPK) lo = cand; }
                    unsigned cg = 0u;
                    for (int i = lane; i < n; i += 64) cg += (f2key(scq[i]) > lo) ? 1u : 0u;
#pragma unroll
                    for (int o = 1; o < 64; o <<= 1) cg += __shfl_xor(cg, o);
                    T = lo; nt = (unsigned)TOPK - cg; found = (lane == 0);
                }
                if (found) { qm[q * 16 + 0] = T; qm[q * 16 + 1] = nt; }
            }
            __syncthreads();
            const unsigned T = qm[q * 16 + 0], need = qm[q * 16 + 1];
            unsigned myG = 0u, myE = 0u;
            for (int s0 = 0; s0 < nsl; s0 += 8) { float v[8];
#pragma unroll
                for (int j = 0; j < 8; ++j) { const int i = (s0 + j) * 128 + th; v[j] = scq[min(i, n - 1)]; }
#pragma unroll
                for (int j = 0; j < 8; ++j) { const int s2 = s0 + j, i = s2 * 128 + th; const bool ok = i < n; const unsigned k = f2key(v[j]); const unsigned long long bg = __ballot(ok && k > T), be = __ballot(ok && k == T);
                    const unsigned cg = (unsigned)__popcll(bg), ce = (unsigned)__popcll(be); myG = (lane == s2) ? cg : myG; myE = (lane == s2) ? ce : myE; } }
            cntG[(q * 2 + sub) * 64 + lane] = myG; cntE[(q * 2 + sub) * 64 + lane] = myE;
            __syncthreads();
            unsigned tbase, pbase;
            { const unsigned e0 = cntE[(q * 2) * 64 + lane], e1 = cntE[(q * 2 + 1) * 64 + lane], g0 = cntG[(q * 2) * 64 + lane], g1 = cntG[(q * 2 + 1) * 64 + lane];
              unsigned inc = e0 + e1;
#pragma unroll
              for (int o = 1; o < 64; o <<= 1) { const unsigned v = __shfl_up(inc, o); if (lane >= o) inc += v; }
              const unsigned tb0 = inc - (e0 + e1), tb1 = tb0 + e0;
              const unsigned se0 = (need > tb0) ? min(need - tb0, e0) : 0u, se1 = (need > tb1) ? min(need - tb1, e1) : 0u;
              const unsigned c0 = g0 + se0, c1 = g1 + se1; unsigned inc2 = c0 + c1;
#pragma unroll
              for (int o = 1; o < 64; o <<= 1) { const unsigned v = __shfl_up(inc2, o); if (lane >= o) inc2 += v; }
              const unsigned pb0 = inc2 - (c0 + c1);
              tbase = sub ? tb1 : tb0; pbase = sub ? pb0 + c0 : pb0; }
            for (int s0 = 0; s0 < nsl; s0 += 8) { float v[8];
#pragma unroll
                for (int j = 0; j < 8; ++j) { const int i = (s0 + j) * 128 + th; v[j] = scq[min(i, n - 1)]; }
#pragma unroll
                for (int j = 0; j < 8; ++j) { const int s2 = s0 + j; if (s2 < nsl) { const int i = s2 * 128 + th; const bool ok = i < n; const unsigned k = f2key(v[j]); const bool g = ok && k > T, e = ok && k == T;
                    const unsigned long long be = __ballot(e);
                    const unsigned trank = (unsigned)__builtin_amdgcn_readlane((int)tbase, s2) + __builtin_amdgcn_mbcnt_hi((unsigned)(be >> 32), __builtin_amdgcn_mbcnt_lo((unsigned)be, 0u));
                    const bool sel = g || (e && trank < need);
                    const unsigned long long bs = __ballot(sel);
                    const unsigned pos = (unsigned)__builtin_amdgcn_readlane((int)pbase, s2) + __builtin_amdgcn_mbcnt_hi((unsigned)(bs >> 32), __builtin_amdgcn_mbcnt_lo((unsigned)bs, 0u));
                    if (sel && pos < (unsigned)TOPK) IDX[(size_t)tok * TOPK + pos] = i; } } }
        }
        __syncthreads();
    }
}

__device__ __forceinline__ void p13b_dsa_attn(Frame& F, const Args& A) {
    unsigned char* ws = A.ws; const int lane = F.lane, wid = F.wave, c16 = lane & 15, g4 = lane >> 4;
    const bf16* CN = (const bf16*)(ws + WS_CN); const bf16* QL = (const bf16*)(ws + WS_QLAT); const int* IDX = (const int*)(ws + WS_IDX); bf16* OL = (bf16*)(ws + WS_OLAT);
    LAS float* lut = (LAS float*)(F.lds + DSA_SCR + 8192);
    for (int i = F.tid; i < 144 * 16; i += 512) { const int n = i >> 4, h = i & 15; lut[i] = A.in[1][rel_bucket(n) * 16 + h]; }
    __syncthreads();
    LAS char* img = (LAS char*)(F.lds + RING_OFF + wid * 16384);
    LAS int* idxw = (LAS int*)(F.lds + DSA_SCR + wid * 1024);
    const unsigned imgb = (unsigned)(uintptr_t)img;
    const int gw = F.vcu * NWAVES + wid, NGW = F.G * NWAVES;
    const unsigned prow0 = 8u * ((lane >> 2) & 3) + (lane & 3);
    unsigned ta0[8], ta1[8];
    { const unsigned qq = (lane & 15) >> 2, pp = lane & 3;
#pragma unroll
      for (int c = 0; c < 8; ++c) { ta0[c] = imgb + dsa_off_b(8 * g4 + qq, 2 * c + (pp >> 1)) + 8 * (pp & 1); ta1[c] = imgb + dsa_off_b(8 * g4 + 4 + qq, 2 * c + (pp >> 1)) + 8 * (pp & 1); } }
    for (int tok = gw; tok < NTOK; tok += NGW) {
        const int b = tok >> 13, t = tok & (SEQ - 1), cnt = min(TOPK, t + 1), ntile = (cnt + 31) >> 5;
        bf16x8 qb[8];
#pragma unroll
        for (int ks = 0; ks < 8; ++ks) qb[ks] = *(const bf16x8*)(QL + (size_t)tok * 4096 + c16 * 256 + ks * 32 + g4 * 8);
#pragma unroll
        for (int i = 0; i < 4; ++i) idxw[lane + 64 * i] = IDX[(size_t)tok * TOPK + lane + 64 * i];
        WSYNC();
        f32x4 o[16];
#pragma unroll
        for (int ct = 0; ct < 16; ++ct) o[ct] = (f32x4){0.f, 0.f, 0.f, 0.f};
        float m_run = -1e30f, l_run = 0.f;
        const LAS float* lutcol = lut + c16;
#pragma unroll 1
        for (int tile = 0; tile < ntile; ++tile) {
            { v4u st[16];
#pragma unroll
              for (int i = 0; i < 16; ++i) { const int nn = lane + 64 * i, row = nn >> 5, chg = nn & 31; const int key = idxw[tile * 32 + row];
                  st[i] = *(const v4u*)(CN + (size_t)(b * SEQ + key) * KVR + chg * 8); }
#pragma unroll
              for (int i = 0; i < 16; ++i) { const int nn = lane + 64 * i, row = nn >> 5, chg = nn & 31;
                  *(LAS v4u*)(img + (chg >> 4) * 8192 + dsa_off_b(row, chg & 15)) = st[i]; } }
            WSYNC();
            f32x4 sacc[2];
#pragma unroll
            for (int T = 0; T < 2; ++T) { sacc[T] = (f32x4){0.f, 0.f, 0.f, 0.f};
#pragma unroll
                for (int ks = 0; ks < 8; ++ks) { const bf16x8 a = *(const LAS bf16x8*)(img + (ks >> 2) * 8192 + dsa_off_b(prow0 + 4 * T, 4 * (ks & 3) + g4));
                    sacc[T] = __builtin_amdgcn_mfma_f32_16x16x32_bf16(a, qb[ks], sacc[T], 0, 0, 0); } }
            float pmax = -__builtin_inff();
#pragma unroll
            for (int T = 0; T < 2; ++T) { const int i0 = tile * 32 + 8 * g4 + 4 * T; const v4u kk = *(const LAS v4u*)(idxw + i0);
                const int kidx[4] = {(int)kk.x, (int)kk.y, (int)kk.z, (int)kk.w};
#pragma unroll
                for (int e = 0; e < 4; ++e) { const int dist = min(max(t - kidx[e], 0), 128); float s = sacc[T][e] + lutcol[dist * 16];
                    s = (i0 + e < cnt) ? s : -__builtin_inff(); sacc[T][e] = s; pmax = fmaxf(pmax, s); } }
            pmax = fmaxf(pmax, __shfl_xor(pmax, 16)); pmax = fmaxf(pmax, __shfl_xor(pmax, 32));
            const float mn = fmaxf(m_run, pmax), alpha = __builtin_amdgcn_exp2f((m_run - mn) * fa::C2); m_run = mn;
            float ps = 0.f;
#pragma unroll
            for (int T = 0; T < 2; ++T)
#pragma unroll
                for (int e = 0; e < 4; ++e) { const float pv = __builtin_amdgcn_exp2f((sacc[T][e] - mn) * fa::C2); sacc[T][e] = pv; ps += pv; }
            ps += __shfl_xor(ps, 16); ps += __shfl_xor(ps, 32);
            l_run = l_run * alpha + ps;
            if (__any(alpha < 1.f)) {
                float al[4];
#pragma unroll
                for (int e = 0; e < 4; ++e) al[e] = __shfl(alpha, 4 * g4 + e);
#pragma unroll
                for (int ct = 0; ct < 16; ++ct)
#pragma unroll
                    for (int e = 0; e < 4; ++e) o[ct][e] *= al[e];
            }
            fa::u32x4v pw; pw.x = fa::cvtpk(sacc[0][0], sacc[0][1]); pw.y = fa::cvtpk(sacc[0][2], sacc[0][3]); pw.z = fa::cvtpk(sacc[1][0], sacc[1][1]); pw.w = fa::cvtpk(sacc[1][2], sacc[1][3]);
            const bf16x8 pa = *reinterpret_cast<bf16x8*>(&pw);
#pragma unroll
            for (int cg = 0; cg < 4; ++cg) { fa::s16x4 b0[4], b1[4];
                asm volatile("ds_read_b64_tr_b16 %0, %8 offset:%c16\n\tds_read_b64_tr_b16 %1, %9 offset:%c16\n\tds_read_b64_tr_b16 %2, %10 offset:%c16\n\tds_read_b64_tr_b16 %3, %11 offset:%c16\n\t"
                             "ds_read_b64_tr_b16 %4, %12 offset:%c16\n\tds_read_b64_tr_b16 %5, %13 offset:%c16\n\tds_read_b64_tr_b16 %6, %14 offset:%c16\n\tds_read_b64_tr_b16 %7, %15 offset:%c16\n\ts_waitcnt lgkmcnt(0)"
                             : "=&v"(b0[0]), "=&v"(b1[0]), "=&v"(b0[1]), "=&v"(b1[1]), "=&v"(b0[2]), "=&v"(b1[2]), "=&v"(b0[3]), "=&v"(b1[3])
                             : "v"(ta0[(cg & 1) * 4 + 0]), "v"(ta1[(cg & 1) * 4 + 0]), "v"(ta0[(cg & 1) * 4 + 1]), "v"(ta1[(cg & 1) * 4 + 1]), "v"(ta0[(cg & 1) * 4 + 2]), "v"(ta1[(cg & 1) * 4 + 2]), "v"(ta0[(cg & 1) * 4 + 3]), "v"(ta1[(cg & 1) * 4 + 3]), "i"((cg >> 1) * 8192) : "memory");
                FA_SBAR();
#pragma unroll
                for (int k = 0; k < 4; ++k) o[cg * 4 + k] = __builtin_amdgcn_mfma_f32_16x16x32_bf16(pa, (bf16x8){b0[k][0], b0[k][1], b0[k][2], b0[k][3], b1[k][0], b1[k][1], b1[k][2], b1[k][3]}, o[cg * 4 + k], 0, 0, 0); }
            WSYNC();
        }
        { const float il = (l_run > 0.f) ? 1.0f / l_run : 0.f; float ile[4];
#pragma unroll
          for (int e = 0; e < 4; ++e) ile[e] = __shfl(il, 4 * g4 + e);
#pragma unroll
          for (int ct = 0; ct < 16; ++ct)
#pragma unroll
              for (int e = 0; e < 4; ++e) { const float v = o[ct][e] * ile[e]; const float vn = __shfl_xor(v, 1);
                  if ((lane & 1) == 0) *(unsigned*)(OL + (size_t)tok * 4096 + (4 * g4 + e) * 256 + ct * 16 + c16) = fa::cvtpk(v, vn); } }
        WSYNC();
    }
    __syncthreads();
}

struct MoeTiles { int tend[8]; int pstart[8]; int MT; };
__device__ __forceinline__ void moe_tiles(Frame& F, MoeTiles& T) {
    int acc = 0;
#pragma unroll
    for (int e = 0; e < 8; ++e) { const int c = (int)__builtin_amdgcn_readfirstlane(__hip_atomic_load((unsigned*)(F.ctl + CW_MOECNT + 64 * e), __ATOMIC_RELAXED, __HIP_MEMORY_SCOPE_AGENT));
        T.pstart[e] = acc * 256; acc += (c + 255) >> 8; T.tend[e] = acc; }
    T.MT = acc;
}
__device__ __forceinline__ void p15_gather(Frame& F, const Args& A) {
    MoeTiles T; moe_tiles(F, T);
    const int gw = F.vcu * NWAVES + F.wave, NGW = F.G * NWAVES, lane = F.lane;
    const float* XF = (const float*)(A.ws + WS_XF); unsigned char* XG = (unsigned char*)(A.ws + WS_XG);
    const int* re = (const int*)(A.ws + WS_ROUTE); const int* rp = re + 2 * NTOK;
    for (int tok = gw; tok < NTOK; tok += NGW) {
        v4u v[2];
#pragma unroll
        for (int j = 0; j < 2; ++j) { const float* src = XF + (size_t)tok * DM + 16 * lane + 1024 * j; int w[4];
#pragma unroll
            for (int q = 0; q < 4; ++q) { const f32x4 x = *(const f32x4*)(src + 4 * q); w[q] = __builtin_amdgcn_cvt_pk_fp8_f32(x[0], x[1], 0, false); w[q] = __builtin_amdgcn_cvt_pk_fp8_f32(x[2], x[3], w[q], true); }
            v[j].x = (unsigned)w[0]; v[j].y = (unsigned)w[1]; v[j].z = (unsigned)w[2]; v[j].w = (unsigned)w[3]; }
#pragma unroll
        for (int s = 0; s < 2; ++s) { const int e = re[2 * tok + s], p = rp[2 * tok + s]; int ps = 0;
#pragma unroll
            for (int q = 0; q < 8; ++q) ps = (q == e) ? T.pstart[q] : ps;
            unsigned char* dst = XG + (size_t)(ps + p) * DM + 16 * lane;
#pragma unroll
            for (int j = 0; j < 2; ++j) *(v4u*)(dst + 1024 * j) = v[j]; }
    }
}
__device__ __forceinline__ void p18_final(Frame& F, const Args& A) {
    MoeTiles T; moe_tiles(F, T);
    const int gw = F.vcu * NWAVES + F.wave, NGW = F.G * NWAVES, lane = F.lane;
    const float* XF = (const float*)(A.ws + WS_XF); const float* Y = (const float*)(A.ws + WS_Y);
    const int* re = (const int*)(A.ws + WS_ROUTE); const int* rp = re + 2 * NTOK; const float* rw = (const float*)(rp + 2 * NTOK);
    const float* gam = A.in[25] + DM; const float* bet = A.in[26] + DM;
    for (int tok = gw; tok < NTOK; tok += NGW) {
        int rows[2]; float w[2];
#pragma unroll
        for (int s = 0; s < 2; ++s) { const int e = re[2 * tok + s]; int ps = 0;
#pragma unroll
            for (int q = 0; q < 8; ++q) ps = (q == e) ? T.pstart[q] : ps;
            rows[s] = ps + rp[2 * tok + s]; w[s] = rw[2 * tok + s]; }
        const f32x4* xr = (const f32x4*)(XF + (size_t)tok * DM) + lane; const f32x4* y0 = (const f32x4*)(Y + (size_t)rows[0] * DM) + lane; const f32x4* y1 = (const f32x4*)(Y + (size_t)rows[1] * DM) + lane;
        f32x4 v[8]; float s = 0.f;
#pragma unroll
        for (int j = 0; j < 8; ++j) { v[j] = xr[64 * j] * ALPHA + y0[64 * j] * w[0] + y1[64 * j] * w[1]; s += (v[j][0] + v[j][1]) + (v[j][2] + v[j][3]); }
        const float mean = wave_sum(s) * (1.f / DM); float s2 = 0.f;
#pragma unroll
        for (int j = 0; j < 8; ++j) { v[j] = v[j] - mean; s2 += (v[j][0] * v[j][0] + v[j][1] * v[j][1]) + (v[j][2] * v[j][2] + v[j][3] * v[j][3]); }
        const float rstd = 1.f / sqrtf(wave_sum(s2) * (1.f / DM) + LN_EPS);
#pragma unroll
        for (int j = 0; j < 8; ++j) { const int c = 4 * lane + 256 * j; const f32x4 gg = *(const f32x4*)(gam + c), bb = *(const f32x4*)(bet + c);
            *(f32x4*)(A.out + (size_t)tok * DM + c) = v[j] * rstd * gg + bb; }
    }
}

__global__ void __launch_bounds__(NWAVES * 64, 2) mega_fwd(Args args) {
    extern __shared__ __attribute__((aligned(16))) unsigned char lds[];
    Frame F;
    F.lds = (LAS unsigned char*)lds;
    F.MISC = (volatile LAS unsigned*)(F.lds + MISC_OFF);
    F.tid = threadIdx.x; F.lane = F.tid & 63; F.wave = __builtin_amdgcn_readfirstlane(F.tid >> 6);
    F.G = gridDim.x; { const int bx = blockIdx.x; F.vcu = (F.G % 8 == 0) ? (bx % 8) * (F.G / 8) + bx / 8 : bx; }
    unsigned char* ws = args.ws;
    F.ctl = (gu32*)(ws + WS_CTL);
    for (int u = F.tid; u < (LDS_BYTES - LDSCTL_OFF) / 4; u += NWAVES * 64) ((LAS unsigned*)(F.lds + LDSCTL_OFF))[u] = 0u;
    __syncthreads();
    XcdBarrier bar; bar.bar = (unsigned*)(F.ctl + CW_BAR); bar.x = 0; bar.st = nullptr;
#if !MK_PER_PHASE
    bar = xcd_barrier_post((unsigned*)(F.ctl + CW_BAR), F.MISC + 8);
#define GRID_BAR() xcd_barrier(bar)
#else
#define GRID_BAR() do { } while (0)
#endif
    const int lo = args.ph_lo, hi = args.ph_hi;
#ifndef PH_MASK
#define PH_MASK 0x3fffff
#endif
#define IN(k) (((PH_MASK >> (k)) & 1) && lo <= (k) && (k) < hi)
#define BOTH(k) (IN(k) && IN((k) + 1))
    bf16* XB = (bf16*)(ws + WS_XB); float* XF = (float*)(ws + WS_XF); float* Z = (float*)(ws + WS_Z);

#ifndef PROBE_MASK
#define PROBE_MASK 0
#endif
#define REPS(k) ((((PROBE_MASK) >> (k)) & 1) ? 2 : 1)
    if (IN(0)) for (int rep_ = 0; rep_ < REPS(0); ++rep_) { relaunder(F); p0_prologue(F, args); if (BOTH(0) || rep_ + 1 < REPS(0)) GRID_BAR(); }
    if (IN(1)) for (int rep_ = 0; rep_ < REPS(1); ++rep_) { relaunder(F);
        pg8::Gemm g{XB, (const bf16*)(ws + WS_W_NSA_IN), NTOK, NSA_NPAD, DM}; pg8::StaticOrder S; S.init(NTOK, NSA_NPAD, F.G, (int)blockIdx.x);
        pg8::EpiNsaIn E{(bf16*)(ws + WS_P0), (float*)(ws + WS_GL), 0.08838834764831845f};
        pg8::gemm_phase<pg8::EpiNsaIn, pg8::StaticOrder, true, true>(F.lds + RING_OFF, g, S, E);
        if (BOTH(1) || rep_ + 1 < REPS(1)) GRID_BAR();
    }
    if (IN(2)) for (int rep_ = 0; rep_ < REPS(2); ++rep_) { relaunder(F); p2_compress(F, args); if (BOTH(2) || rep_ + 1 < REPS(2)) GRID_BAR(); }
#ifndef PROBE_NSA2
#define PROBE_NSA2 0
#endif
    for (int repn_ = 0; repn_ < (PROBE_NSA2 ? 2 : 1); ++repn_) {
    if (IN(3)) for (int rep_ = 0; rep_ < REPS(3); ++rep_) { relaunder(F); p3a_nsa_cmp(F, args); if (BOTH(3) || rep_ + 1 < REPS(3)) GRID_BAR(); }
    if (IN(4)) for (int rep_ = 0; rep_ < REPS(4); ++rep_) { relaunder(F); p3b_nsa_sel(F, args); if (BOTH(4) || rep_ + 1 < REPS(4) || repn_ + 1 < (PROBE_NSA2 ? 2 : 1)) GRID_BAR(); }
    }
    if (IN(5)) for (int rep_ = 0; rep_ < REPS(5); ++rep_) { relaunder(F); p3c_nsa_win(F, args); if (BOTH(5) || rep_ + 1 < REPS(5)) GRID_BAR(); }
    if (IN(6)) for (int rep_ = 0; rep_ < REPS(6); ++rep_) { relaunder(F);
        pg8::Gemm g{(const bf16*)(ws + WS_OATT0), (const bf16*)(ws + WS_W_NSA_OUT), NTOK, DM, DM}; pg8::StaticOrder S; S.init(NTOK, DM, F.G, (int)blockIdx.x);
        pg8::EpiResF32 E{args.in[0], Z, ALPHA, DM};
        pg8::gemm_phase<pg8::EpiResF32, pg8::StaticOrder, true, true>(F.lds + RING_OFF, g, S, E);
        if (BOTH(6) || rep_ + 1 < REPS(6)) GRID_BAR();
    }
    if (IN(7)) for (int rep_ = 0; rep_ < REPS(7); ++rep_) { relaunder(F); ln_phase<false, FFN_F8 != 0>(F, args, Z, args.in[23], args.in[24], XF, XB); if (BOTH(7) || rep_ + 1 < REPS(7)) GRID_BAR(); }
    if (IN(8)) for (int rep_ = 0; rep_ < REPS(8); ++rep_) { relaunder(F);
        pg8::StaticOrder S; S.init(NTOK, 2 * DFF, F.G, (int)blockIdx.x);
#if FFN_F8
        pg8::Gemm g{XB, (const bf16*)(ws + WS_W_FFN_GU), NTOK, 2 * DFF, DM, 1, 0x79797979};
        pg8::EpiSwiGLU8 E{(unsigned char*)(ws + WS_HFF), DFF};
        pg8::gemm_phase<pg8::EpiSwiGLU8, pg8::StaticOrder, true, true, true>(F.lds + RING_OFF, g, S, E);
#else
        pg8::Gemm g{XB, (const bf16*)(ws + WS_W_FFN_GU), NTOK, 2 * DFF, DM};
        pg8::EpiSwiGLU E{(bf16*)(ws + WS_HFF), DFF};
        pg8::gemm_phase<pg8::EpiSwiGLU, pg8::StaticOrder, true, true>(F.lds + RING_OFF, g, S, E);
#endif
        if (BOTH(8) || rep_ + 1 < REPS(8)) GRID_BAR();
    }
    if (IN(9)) for (int rep_ = 0; rep_ < REPS(9); ++rep_) { relaunder(F);
        pg8::StaticOrder S; S.init(NTOK, DM, F.G, (int)blockIdx.x);
        pg8::EpiResF32 E{XF, Z, ALPHA, DM};
#if FFN_F8
        pg8::Gemm g{(const bf16*)(ws + WS_HFF), (const bf16*)(ws + WS_W_FFN_DN), NTOK, DM, DFF, 1, 0x77777777};
        pg8::gemm_phase<pg8::EpiResF32, pg8::StaticOrder, true, true, true>(F.lds + RING_OFF, g, S, E);
#else
        pg8::Gemm g{(const bf16*)(ws + WS_HFF), (const bf16*)(ws + WS_W_FFN_DN), NTOK, DM, DFF};
        pg8::gemm_phase<pg8::EpiResF32, pg8::StaticOrder, true, true>(F.lds + RING_OFF, g, S, E);
#endif
        if (BOTH(9) || rep_ + 1 < REPS(9)) GRID_BAR();
    }
    if (IN(10)) for (int rep_ = 0; rep_ < REPS(10); ++rep_) { relaunder(F); ln_phase<false>(F, args, Z, args.in[25], args.in[26], XF, XB); if (BOTH(10) || rep_ + 1 < REPS(10)) GRID_BAR(); }
    if (IN(11)) for (int rep_ = 0; rep_ < REPS(11); ++rep_) { relaunder(F);
        pg8::Gemm g{XB, (const bf16*)(ws + WS_W_DSA_IN), NTOK, DSA_NPAD, DM}; pg8::StaticOrder S; S.init(NTOK, DSA_NPAD, F.G, (int)blockIdx.x);
        pg8::EpiDsaIn E{(bf16*)(ws + WS_Q), (float*)(ws + WS_CRAW), (bf16*)(ws + WS_QI), (float*)(ws + WS_KIWI), 0.125f};
        pg8::gemm_phase<pg8::EpiDsaIn, pg8::StaticOrder, true, true>(F.lds + RING_OFF, g, S, E);
        if (BOTH(11) || rep_ + 1 < REPS(11)) GRID_BAR();
    }
    if (IN(12)) for (int rep_ = 0; rep_ < REPS(12); ++rep_) { relaunder(F); p10_dsa_prep(F, args); if (BOTH(12) || rep_ + 1 < REPS(12)) GRID_BAR(); }
    if (IN(13)) for (int rep_ = 0; rep_ < REPS(13); ++rep_) { relaunder(F); p13a_dsa_index(F, args); if (BOTH(13) || rep_ + 1 < REPS(13)) GRID_BAR(); }
    if (IN(14)) for (int rep_ = 0; rep_ < REPS(14); ++rep_) { relaunder(F); p13b_dsa_attn(F, args); if (BOTH(14) || rep_ + 1 < REPS(14)) GRID_BAR(); }
    if (IN(15)) for (int rep_ = 0; rep_ < REPS(15); ++rep_) { relaunder(F); p12_dsa_uv(F, args); if (BOTH(15) || rep_ + 1 < REPS(15)) GRID_BAR(); }
    if (IN(16)) for (int rep_ = 0; rep_ < REPS(16); ++rep_) { relaunder(F);
        pg8::Gemm g{(const bf16*)(ws + WS_OATT1), (const bf16*)(ws + WS_W_DSA_OUT), NTOK, DM, DM}; pg8::StaticOrder S; S.init(NTOK, DM, F.G, (int)blockIdx.x);
        pg8::EpiResF32 E{XF, Z, ALPHA, DM};
        pg8::gemm_phase<pg8::EpiResF32, pg8::StaticOrder, true, true>(F.lds + RING_OFF, g, S, E);
        if (BOTH(16) || rep_ + 1 < REPS(16)) GRID_BAR();
    }
    if (IN(17)) for (int rep_ = 0; rep_ < REPS(17); ++rep_) { relaunder(F); ln_route_phase(F, args, Z, args.in[23] + DM, args.in[24] + DM, XF, XB); if (BOTH(17) || rep_ + 1 < REPS(17)) GRID_BAR(); }
    if (IN(18)) for (int rep_ = 0; rep_ < REPS(18); ++rep_) { relaunder(F); p15_gather(F, args); if (BOTH(18) || rep_ + 1 < REPS(18)) GRID_BAR(); }
    if (IN(19)) for (int rep_ = 0; rep_ < REPS(19); ++rep_) { relaunder(F);
        MoeTiles T; moe_tiles(F, T);
        pg8::Gemm g{(const bf16*)(ws + WS_XG), (const bf16*)(ws + WS_W_MOE_GU), T.MT * 256, 2 * DFFE, DM, 1, 0x79797979}; pg8::MoeOrder S; S.init(T.MT * 256, 2 * DFFE, F.G, (int)blockIdx.x); S.nexp_rows = 2 * DFFE;
#pragma unroll
        for (int e = 0; e < 8; ++e) S.tend[e] = T.tend[e];
        pg8::EpiSwiGLU8 E{(unsigned char*)(ws + WS_HM), DFFE};
        pg8::gemm_phase<pg8::EpiSwiGLU8, pg8::MoeOrder, true, true, true>(F.lds + RING_OFF, g, S, E);
        if (BOTH(19) || rep_ + 1 < REPS(19)) GRID_BAR();
    }
    if (IN(20)) for (int rep_ = 0; rep_ < REPS(20); ++rep_) { relaunder(F);
        MoeTiles T; moe_tiles(F, T);
        pg8::Gemm g{(const bf16*)(ws + WS_HM), (const bf16*)(ws + WS_W_MOE_DN), T.MT * 256, DM, DFFE, 1, 0x77777777}; pg8::MoeOrder S; S.init(T.MT * 256, DM, F.G, (int)blockIdx.x); S.nexp_rows = DM;
#pragma unroll
        for (int e = 0; e < 8; ++e) S.tend[e] = T.tend[e];
        pg8::EpiF32 E{(float*)(ws + WS_Y), DM};
        pg8::gemm_phase<pg8::EpiF32, pg8::MoeOrder, true, true, true>(F.lds + RING_OFF, g, S, E);
        if (BOTH(20) || rep_ + 1 < REPS(20)) GRID_BAR();
    }
    if (IN(21)) for (int rep_ = 0; rep_ < REPS(21); ++rep_) { relaunder(F); p18_final(F, args); }
#undef IN
#undef BOTH
}

extern "C" void kernel_launch(void* const* d_in, const int* in_sizes, int n_in, void* d_out, int out_size, void* d_ws, size_t ws_size, hipStream_t stream) {
    static int grid = 0;
    if (grid == 0) {
        if (n_in != 27 || out_size != NTOK * DM || ws_size < WS_END) { fprintf(stderr, "kernel_launch: unexpected shapes (n_in %d, out %d, ws %zu); nothing launched\n", n_in, out_size, ws_size); grid = -1; return; }
        int dev = 0, cus = 0, per_cu = 0;
        if (hipGetDevice(&dev) != hipSuccess || hipDeviceGetAttribute(&cus, hipDeviceAttributeMultiprocessorCount, dev) != hipSuccess) { grid = -1; return; }
        if (hipFuncSetAttribute((const void*)mega_fwd, hipFuncAttributeMaxDynamicSharedMemorySize, LDS_BYTES) != hipSuccess) { fprintf(stderr, "kernel_launch: hipFuncSetAttribute failed\n"); grid = -1; return; }
        if (hipOccupancyMaxActiveBlocksPerMultiprocessor(&per_cu, (const void*)mega_fwd, NWAVES * 64, LDS_BYTES) != hipSuccess || per_cu < 1) { fprintf(stderr, "kernel_launch: occupancy query says %d\n", per_cu); }
        (void)hipGetLastError();
        grid = cus;
    }
    if (grid < 0) return;
    if (hipMemsetAsync((char*)d_ws + WS_CTL, 0, CTL_ZERO_BYTES, stream) != hipSuccess) return;
    Args a{};
    for (int i = 0; i < 27; ++i) a.in[i] = (const float*)d_in[i];
    a.out = (float*)d_out; a.ws = (unsigned char*)d_ws;
#if MK_PER_PHASE
    for (int p = 0; p < NPHASE; ++p) { a.ph_lo = p; a.ph_hi = p + 1; hipLaunchKernelGGL(mega_fwd, dim3(grid), dim3(NWAVES * 64), LDS_BYTES, stream, a); }
#else
    a.ph_lo = 0; a.ph_hi = NPHASE;
    hipLaunchKernelGGL(mega_fwd, dim3(grid), dim3(NWAVES * 64), LDS_BYTES, stream, a);
#endif
}
```

```cpp
#include <hip/hip_runtime.h>
#include <cstdio>
#include <cstdint>
namespace pg8 {
#define PG8_LAS __attribute__((address_space(3)))
typedef unsigned short bf16_t;
typedef short bf16x8 __attribute__((ext_vector_type(8)));
typedef float f32x4 __attribute__((ext_vector_type(4)));
typedef unsigned u32x4 __attribute__((ext_vector_type(4)));
constexpr int BM = 256, BK = 64, HALF = 128, HTB = HALF * BK * 2  , STAGE_BYTES = 8 * HTB, NXCD = 8, WGM = 8;

__host__ __device__ __forceinline__ int lds_byte(int r, int c) { const int st = (r >> 4) * 2 + (c >> 5), rr = r & 15, cc = c & 31, ob = rr * 64 + cc * 2; return st * 1024 + (ob ^ (((ob >> 9) & 1) << 5)); }
__host__ __device__ __forceinline__ void stage_rc(int b, int& R, int& C) { const int st = b / 1024, sb = b % 1024, swz = sb ^ (((sb >> 9) & 1) << 5); R = (st >> 1) * 16 + swz / 64; C = (st & 1) * 32 + (swz % 64) / 2; }
__host__ __device__ __forceinline__ int perm32(int rho) { const int n = rho >> 4, i = rho & 15; return 8 * (i >> 2) + 4 * n + (i & 3); }

struct Unit { int pm, pn; };
struct Gemm { const bf16_t* A; const bf16_t* Bt; int M, N, K; int esz = 2; int scale = 0x7f7f7f7f; };

struct StaticOrder {
    int nM, nN, nwg, G, c;
    __host__ __device__ void init(int M, int N, int G_, int c_) { nM = M / BM; nN = N / BM; nwg = nM * nN; G = G_; c = c_; }
    __host__ __device__ bool next(int i, Unit& u) const {
        const long L = (long)i * G + c; if (L >= nwg) return false;
        int wgid = (int)L; { const int q = nwg / NXCD, r = nwg % NXCD, xcd = wgid % NXCD, off = wgid / NXCD; wgid = (xcd < r ? xcd * (q + 1) : r * (q + 1) + (xcd - r) * q) + off; }
        const int nig = WGM * nN, gid = wgid / nig, fm = gid * WGM, gsz = (nM - fm) < WGM ? (nM - fm) : WGM;
        u.pm = fm + ((wgid % nig) % gsz); u.pn = (wgid % nig) / gsz; return true;
    }
    __device__ __forceinline__ void a_ready(const Unit&) const {}
    __device__ __forceinline__ void done(const Unit&) const {}
    __device__ __forceinline__ const char* a_ptr(const Gemm& g, const Unit& u) const { return (const char*)g.A + (size_t)u.pm * ((size_t)BM * g.K * g.esz); }
    __device__ __forceinline__ const char* b_ptr(const Gemm& g, const Unit& u) const { return (const char*)g.Bt + (size_t)u.pn * ((size_t)BM * g.K * g.esz); }
};


__device__ __forceinline__ unsigned cvt_pk_bf16(float lo, float hi) { unsigned r; asm volatile("v_cvt_pk_bf16_f32 %0, %1, %2" : "=v"(r) : "v"(lo), "v"(hi)); return r; }
__device__ __forceinline__ u32x4 pack8(const f32x4 v0, const f32x4 v1) { u32x4 w; w.x = cvt_pk_bf16(v0[0], v0[1]); w.y = cvt_pk_bf16(v0[2], v0[3]); w.z = cvt_pk_bf16(v1[0], v1[1]); w.w = cvt_pk_bf16(v1[2], v1[3]); return w; }

struct EpiNsaIn {
    static constexpr bool PERM = true, AFTER_DRAIN = false;
    bf16_t* P0; float* GL; float qscale;
    __device__ __forceinline__ void operator()(const f32x4 (&acc)[2][2][4][2], const Unit& u, int wr, int wc, int fr, int fq) const {
        const int row0 = u.pm * BM + wr * 64 + fr;
        if (u.pn < 20) {
            const float s = u.pn < 8 ? qscale : 1.0f;
            const int col0 = u.pn * BM + wc * 32 + 8 * fq;
#pragma unroll
            for (int ai = 0; ai < 2; ++ai)
#pragma unroll
                for (int m = 0; m < 4; ++m) { bf16_t* rowp = P0 + (size_t)(row0 + ai * HALF + m * 16) * 5120 + col0;
#pragma unroll
                    for (int bj = 0; bj < 2; ++bj) *(u32x4*)(rowp + bj * HALF) = pack8(acc[ai][bj][m][0] * s, acc[ai][bj][m][1] * s); }
        } else {
            const int c = wc * 32 + 8 * fq;
            if (c < 48) {
#pragma unroll
                for (int ai = 0; ai < 2; ++ai)
#pragma unroll
                    for (int m = 0; m < 4; ++m) { float* gp = GL + (size_t)(row0 + ai * HALF + m * 16) * 48 + c;
                        *(f32x4*)gp = acc[ai][0][m][0]; *(f32x4*)(gp + 4) = acc[ai][0][m][1]; }
            }
        }
    }
};
struct EpiDsaIn {
    static constexpr bool PERM = true, AFTER_DRAIN = false;
    bf16_t* Q; float* CRAW; bf16_t* QI; float* KIWI; float qiscale;
    __device__ __forceinline__ void operator()(const f32x4 (&acc)[2][2][4][2], const Unit& u, int wr, int wc, int fr, int fq) const {
        const int row0 = u.pm * BM + wr * 64 + fr; const int c = wc * 32 + 8 * fq;
        if (u.pn < 8) {
#pragma unroll
            for (int ai = 0; ai < 2; ++ai)
#pragma unroll
                for (int m = 0; m < 4; ++m) { bf16_t* rowp = Q + (size_t)(row0 + ai * HALF + m * 16) * 2048 + u.pn * BM + c;
#pragma unroll
                    for (int bj = 0; bj < 2; ++bj) *(u32x4*)(rowp + bj * HALF) = pack8(acc[ai][bj][m][0], acc[ai][bj][m][1]); }
        } else if (u.pn == 8) {
#pragma unroll
            for (int ai = 0; ai < 2; ++ai)
#pragma unroll
                for (int m = 0; m < 4; ++m) { float* rowp = CRAW + (size_t)(row0 + ai * HALF + m * 16) * 256 + c;
#pragma unroll
                    for (int bj = 0; bj < 2; ++bj) { *(f32x4*)(rowp + bj * HALF) = acc[ai][bj][m][0]; *(f32x4*)(rowp + bj * HALF + 4) = acc[ai][bj][m][1]; } }
        } else if (u.pn < 11) {
#pragma unroll
            for (int ai = 0; ai < 2; ++ai)
#pragma unroll
                for (int m = 0; m < 4; ++m) { bf16_t* rowp = QI + (size_t)(row0 + ai * HALF + m * 16) * 512 + (u.pn - 9) * BM + c;
#pragma unroll
                    for (int bj = 0; bj < 2; ++bj) *(u32x4*)(rowp + bj * HALF) = pack8(acc[ai][bj][m][0] * qiscale, acc[ai][bj][m][1] * qiscale); }
        } else {
#pragma unroll
            for (int ai = 0; ai < 2; ++ai)
#pragma unroll
                for (int m = 0; m < 4; ++m) { float* rowp = KIWI + (size_t)(row0 + ai * HALF + m * 16) * 128 + c;
                    *(f32x4*)rowp = acc[ai][0][m][0]; *(f32x4*)(rowp + 4) = acc[ai][0][m][1]; }
        }
    }
};
struct EpiResF32 {
    static constexpr bool PERM = false, AFTER_DRAIN = false;
    const float* R; float* Z; float alpha; int ldc;
    __device__ __forceinline__ void operator()(const f32x4 (&acc)[2][2][4][2], const Unit& u, int wr, int wc, int fr, int fq) const {
        const int row0 = u.pm * BM + wr * 64 + fr, col0 = u.pn * BM + wc * 32 + 4 * fq;
#pragma unroll
        for (int ai = 0; ai < 2; ++ai)
#pragma unroll
            for (int m = 0; m < 4; ++m) { const size_t off = (size_t)(row0 + ai * HALF + m * 16) * ldc + col0;
#pragma unroll
                for (int bj = 0; bj < 2; ++bj)
#pragma unroll
                    for (int n = 0; n < 2; ++n) { const f32x4 r = *(const f32x4*)(R + off + bj * HALF + n * 16); *(f32x4*)(Z + off + bj * HALF + n * 16) = r * alpha + acc[ai][bj][m][n]; } }
    }
};
struct EpiF32 {
    static constexpr bool PERM = false, AFTER_DRAIN = false;
    float* C; int ldc;
    __device__ __forceinline__ void operator()(const f32x4 (&acc)[2][2][4][2], const Unit& u, int wr, int wc, int fr, int fq) const {
        const int row0 = u.pm * BM + wr * 64 + fr, col0 = u.pn * BM + wc * 32 + 4 * fq;
#pragma unroll
        for (int ai = 0; ai < 2; ++ai)
#pragma unroll
            for (int m = 0; m < 4; ++m) { float* rowp = C + (size_t)(row0 + ai * HALF + m * 16) * ldc + col0;
#pragma unroll
                for (int bj = 0; bj < 2; ++bj)
#pragma unroll
                    for (int n = 0; n < 2; ++n) *(f32x4*)(rowp + bj * HALF + n * 16) = acc[ai][bj][m][n]; }
    }
};
__device__ __forceinline__ float silu_mul(float g, float u) { return g * __builtin_amdgcn_rcpf(1.0f + __expf(-g)) * u; }
struct EpiSwiGLU {
    static constexpr bool PERM = true, AFTER_DRAIN = false;
    bf16_t* H; int ldh;
    __device__ __forceinline__ void operator()(const f32x4 (&acc)[2][2][4][2], const Unit& u, int wr, int wc, int fr, int fq) const {
        const int row0 = u.pm * BM + wr * 64 + fr, col0 = u.pn * HALF + wc * 32 + 8 * fq;
#pragma unroll
        for (int ai = 0; ai < 2; ++ai)
#pragma unroll
            for (int m = 0; m < 4; ++m) { bf16_t* rowp = H + (size_t)(row0 + ai * HALF + m * 16) * ldh + col0;
                f32x4 v0, v1;
#pragma unroll
                for (int j = 0; j < 4; ++j) { v0[j] = silu_mul(acc[ai][0][m][0][j], acc[ai][1][m][0][j]); v1[j] = silu_mul(acc[ai][0][m][1][j], acc[ai][1][m][1][j]); }
                *(u32x4*)rowp = pack8(v0, v1); }
    }
};
struct EpiSwiGLU8 {
    static constexpr bool PERM = true, AFTER_DRAIN = false;
    unsigned char* H; int ldh;
    __device__ __forceinline__ void operator()(const f32x4 (&acc)[2][2][4][2], const Unit& u, int wr, int wc, int fr, int fq) const {
        const int row0 = u.pm * BM + wr * 64 + fr, col0 = u.pn * HALF + wc * 32 + 8 * fq;
#pragma unroll
        for (int ai = 0; ai < 2; ++ai)
#pragma unroll
            for (int m = 0; m < 4; ++m) { unsigned char* rowp = H + (size_t)(row0 + ai * HALF + m * 16) * ldh + col0;
                float v[8];
#pragma unroll
                for (int j = 0; j < 4; ++j) { v[j] = silu_mul(acc[ai][0][m][0][j], acc[ai][1][m][0][j]); v[4 + j] = silu_mul(acc[ai][0][m][1][j], acc[ai][1][m][1][j]); }
                int w0 = __builtin_amdgcn_cvt_pk_fp8_f32(v[0], v[1], 0, false); w0 = __builtin_amdgcn_cvt_pk_fp8_f32(v[2], v[3], w0, true);
                int w1 = __builtin_amdgcn_cvt_pk_fp8_f32(v[4], v[5], 0, false); w1 = __builtin_amdgcn_cvt_pk_fp8_f32(v[6], v[7], w1, true);
                uint2 o; o.x = (unsigned)w0; o.y = (unsigned)w1; *(uint2*)rowp = o; }
    }
};
struct MoeOrder : StaticOrder {
    int tend[8]; int nexp_rows;
    __device__ __forceinline__ int expert(int pm) const { int e = 0;
#pragma unroll
        for (int i = 0; i < 7; ++i) e += (pm >= tend[i]) ? 1 : 0; return e; }
    __device__ __forceinline__ const char* b_ptr(const Gemm& g, const Unit& u) const { return (const char*)g.Bt + ((size_t)expert(u.pm) * nexp_rows + (size_t)u.pn * BM) * ((size_t)g.K * g.esz); }
};
typedef int i32x8 __attribute__((ext_vector_type(8)));
typedef int i32x4 __attribute__((ext_vector_type(4)));
__device__ __forceinline__ i32x8 cat8(bf16x8 lo, bf16x8 hi) { const i32x4 a = *reinterpret_cast<const i32x4*>(&lo), b = *reinterpret_cast<const i32x4*>(&hi); return __builtin_shufflevector(a, b, 0, 1, 2, 3, 4, 5, 6, 7); }
template <class Epi, class Sched, bool ALIGN_EPI = false, bool SP2 = false, bool FP8 = false>
__device__ __forceinline__ void gemm_phase(PG8_LAS unsigned char* lds, const Gemm g, const Sched& S, const Epi& E) {
    int tid = threadIdx.x; asm volatile("" : "+v"(tid));
    const int wid = __builtin_amdgcn_readfirstlane(tid >> 6), lane = tid & 63, wr = wid >> 2, wc = wid & 3, fr = lane & 15, fq = lane >> 4;
    const int K = g.K, nt = K / (FP8 ? 2 * BK : BK);
    unsigned voffA[2], voffB[2];
#pragma unroll
    for (int i = 0; i < 2; ++i) { int R, C; stage_rc(tid * 16 + i * 8192, R, C); const int Rb = Epi::PERM ? ((R & ~31) + perm32(R & 31)) : R;
        voffA[i] = FP8 ? (unsigned)(R * K + C * 2) : (unsigned)(R * K + C) * 2u; voffB[i] = FP8 ? (unsigned)(Rb * K + C * 2) : (unsigned)(Rb * K + C) * 2u; }
    const size_t kstep = (size_t)(BK * 2);
    const size_t hstep = (size_t)HALF * K * (FP8 ? 1 : 2);
    const size_t tstep = 2 * hstep;
    const unsigned ldsw = (unsigned)wid * 1024u;
    const int aoff = lds_byte(wr * 64 + fr, fq * 8), boff = lds_byte(wc * 32 + fr, fq * 8);
#define PG8_SA(b, h) (((b) * 2 + (h)) * HTB)
#define PG8_SB(b, h) ((4 + (b) * 2 + (h)) * HTB)
#define PG8_STAGE(bufoff, gbase, voff) do { _Pragma("unroll") for (int _i = 0; _i < 2; ++_i) \
        __builtin_amdgcn_global_load_lds((const unsigned*)((const char*)(gbase) + (voff)[_i]), (PG8_LAS unsigned*)(lds + (bufoff) + ldsw + _i * 8192), 16, 0, 0); } while (0)
#define PG8_LDA(dst, b, h) do { _Pragma("unroll") for (int m = 0; m < 4; ++m) { if constexpr (FP8) { const i32x4 lo_ = *(const PG8_LAS i32x4*)(lds + PG8_SA(b, h) + aoff + m * 2048), hi_ = *(const PG8_LAS i32x4*)(lds + PG8_SA(b, h) + aoff + m * 2048 + 1024); dst##8[m] = __builtin_shufflevector(lo_, hi_, 0, 1, 2, 3, 4, 5, 6, 7); } else { _Pragma("unroll") for (int k = 0; k < 2; ++k) dst[m][k] = *(const PG8_LAS bf16x8*)(lds + PG8_SA(b, h) + aoff + m * 2048 + k * 1024); } } } while (0)
#define PG8_LDB(dst, b, h) do { _Pragma("unroll") for (int n = 0; n < 2; ++n) { if constexpr (FP8) { const i32x4 lo_ = *(const PG8_LAS i32x4*)(lds + PG8_SB(b, h) + boff + n * 2048), hi_ = *(const PG8_LAS i32x4*)(lds + PG8_SB(b, h) + boff + n * 2048 + 1024); dst##8[n] = __builtin_shufflevector(lo_, hi_, 0, 1, 2, 3, 4, 5, 6, 7); } else { _Pragma("unroll") for (int k = 0; k < 2; ++k) dst[n][k] = *(const PG8_LAS bf16x8*)(lds + PG8_SB(b, h) + boff + n * 2048 + k * 1024); } } } while (0)
#define PG8_MMA(ai, bj, At, Bt) do { __builtin_amdgcn_s_setprio(1); _Pragma("unroll") for (int m = 0; m < 4; ++m) _Pragma("unroll") for (int n = 0; n < 2; ++n) { \
        if constexpr (FP8) { asm volatile("v_mfma_scale_f32_16x16x128_f8f6f4 %0, %1, %2, %0, %3, %4 op_sel_hi:[0,0,0]" : "+v"(acc[ai][bj][m][n]) : "v"(Bt##8[n]), "v"(At##8[m]), "v"(sclA), "v"(sclB)); } \
        else { _Pragma("unroll") for (int k = 0; k < 2; ++k) acc[ai][bj][m][n] = __builtin_amdgcn_mfma_f32_16x16x32_bf16(Bt[n][k], At[m][k], acc[ai][bj][m][n], 0, 0, 0); } } __builtin_amdgcn_s_setprio(0); } while (0)
#define PG8_WAIT_V(n) asm volatile("s_waitcnt vmcnt(" #n ")" ::: "memory")
#define PG8_WAIT_L(n) asm volatile("s_waitcnt lgkmcnt(" #n ")" ::: "memory")
#define PG8_BAR __builtin_amdgcn_s_barrier()
#define PG8_SCHED __builtin_amdgcn_sched_barrier(0)
    Unit cur, nxt; int ui = 0;
    if (!S.next(0, cur)) return;
    f32x4 acc[2][2][4][2];
#pragma unroll
    for (int a = 0; a < 2; ++a)
#pragma unroll
        for (int b = 0; b < 2; ++b)
#pragma unroll
            for (int m = 0; m < 4; ++m)
#pragma unroll
                for (int n = 0; n < 2; ++n) acc[a][b][m][n] = (f32x4){0.f, 0.f, 0.f, 0.f};
    bf16x8 At[4][2], B0[2][2], B1[2][2]; i32x8 At8[4], B08[2], B18[2]; const int sclA = g.scale, sclB = 0x7f7f7f7f;
    const char* cA = S.a_ptr(g, cur); const char* cB = S.b_ptr(g, cur);
    S.a_ready(cur);
    if constexpr (SP2) {
        PG8_STAGE(PG8_SB(0, 0), cB, voffB); PG8_STAGE(PG8_SB(0, 1), cB + hstep, voffB); PG8_STAGE(PG8_SA(0, 0), cA, voffA); PG8_STAGE(PG8_SA(0, 1), cA + hstep, voffA);
        if (wr == 1) PG8_BAR;
        PG8_WAIT_V(2); PG8_BAR;
        PG8_STAGE(PG8_SB(1, 0), cB + kstep, voffB); PG8_STAGE(PG8_SA(1, 0), cA + kstep, voffA); PG8_STAGE(PG8_SB(1, 1), cB + hstep + kstep, voffB);
        PG8_WAIT_V(6); PG8_BAR;
    } else {
        PG8_STAGE(PG8_SB(0, 0), cB, voffB); PG8_STAGE(PG8_SA(0, 0), cA, voffA); PG8_STAGE(PG8_SB(0, 1), cB + hstep, voffB); PG8_STAGE(PG8_SA(0, 1), cA + hstep, voffA);
        if (wr == 1) PG8_BAR;
        PG8_WAIT_V(4); PG8_BAR;
        PG8_STAGE(PG8_SB(1, 0), cB + kstep, voffB); PG8_STAGE(PG8_SA(1, 0), cA + kstep, voffA); PG8_STAGE(PG8_SB(1, 1), cB + hstep + kstep, voffB);
        PG8_WAIT_V(6); PG8_BAR;
    }
    for (;;) {
        const bool has_next = S.next(ui + 1, nxt);
        const char* nA = has_next ? S.a_ptr(g, nxt) : cA; const char* nB = has_next ? S.b_ptr(g, nxt) : cB;
        for (int t = 0; t < nt; t += 2) {
            const bool last = (t == nt - 2);
            const char* a1 = cA + (size_t)(t + 1) * kstep;
            const char* a2 = last ? nA : cA + (size_t)(t + 2) * kstep; const char* b2 = last ? nB : cB + (size_t)(t + 2) * kstep;
            const char* a3 = a2 + kstep; const char* b3 = b2 + kstep;
            if (last && has_next) S.a_ready(nxt);
            if constexpr (SP2) {
            PG8_LDB(B0, 0, 0); PG8_LDB(B1, 0, 1); PG8_SCHED; PG8_LDA(At, 0, 0); PG8_STAGE(PG8_SA(1, 1), a1 + hstep, voffA);
            PG8_WAIT_V(8); PG8_WAIT_L(0); PG8_BAR; PG8_MMA(0, 0, At, B0); PG8_MMA(0, 1, At, B1); PG8_BAR; PG8_SCHED;
            PG8_LDA(At, 0, 1); PG8_STAGE(PG8_SB(0, 0), b2, voffB); PG8_STAGE(PG8_SB(0, 1), b2 + hstep, voffB); PG8_STAGE(PG8_SA(0, 0), a2, voffA);
            PG8_WAIT_V(8); PG8_WAIT_L(0); PG8_BAR; PG8_MMA(1, 0, At, B0); PG8_MMA(1, 1, At, B1); PG8_BAR; PG8_SCHED;
            PG8_LDB(B0, 1, 0); PG8_LDB(B1, 1, 1); PG8_SCHED; PG8_LDA(At, 1, 0); PG8_STAGE(PG8_SA(0, 1), a2 + hstep, voffA);
            PG8_WAIT_V(8); PG8_WAIT_L(0); PG8_BAR; PG8_MMA(0, 0, At, B0); PG8_MMA(0, 1, At, B1); PG8_BAR; PG8_SCHED;
            PG8_LDA(At, 1, 1); PG8_STAGE(PG8_SB(1, 0), b3, voffB); PG8_STAGE(PG8_SB(1, 1), b3 + hstep, voffB); PG8_STAGE(PG8_SA(1, 0), a3, voffA);
            PG8_WAIT_V(8); PG8_WAIT_L(0); PG8_BAR; PG8_MMA(1, 0, At, B0); PG8_MMA(1, 1, At, B1); PG8_BAR; PG8_SCHED;
            } else {
            PG8_LDB(B0, 0, 0); PG8_SCHED; PG8_LDA(At, 0, 0); PG8_STAGE(PG8_SA(1, 1), a1 + hstep, voffA);
            PG8_WAIT_L(8); PG8_BAR; PG8_WAIT_L(0); PG8_MMA(0, 0, At, B0); PG8_BAR; PG8_SCHED;
            PG8_LDB(B1, 0, 1); PG8_STAGE(PG8_SB(0, 0), b2, voffB);
            PG8_BAR; PG8_WAIT_L(0); PG8_MMA(0, 1, At, B1); PG8_BAR;
            PG8_LDA(At, 0, 1); PG8_STAGE(PG8_SA(0, 0), a2, voffA);
            PG8_BAR; PG8_WAIT_L(0); PG8_MMA(1, 0, At, B0); PG8_BAR; PG8_SCHED;
            PG8_STAGE(PG8_SB(0, 1), b2 + hstep, voffB);
            PG8_WAIT_V(6); PG8_BAR; PG8_MMA(1, 1, At, B1); PG8_BAR;
            PG8_LDB(B0, 1, 0); PG8_SCHED; PG8_LDA(At, 1, 0); PG8_STAGE(PG8_SA(0, 1), a2 + hstep, voffA);
            PG8_WAIT_L(8); PG8_BAR; PG8_WAIT_L(0); PG8_MMA(0, 0, At, B0); PG8_BAR; PG8_SCHED;
            PG8_LDB(B1, 1, 1); PG8_STAGE(PG8_SB(1, 0), b3, voffB);
            PG8_BAR; PG8_WAIT_L(0); PG8_MMA(0, 1, At, B1); PG8_BAR;
            PG8_LDA(At, 1, 1); PG8_STAGE(PG8_SA(1, 0), a3, voffA);
            PG8_BAR; PG8_WAIT_L(0); PG8_MMA(1, 0, At, B0); PG8_BAR; PG8_SCHED;
            PG8_STAGE(PG8_SB(1, 1), b3 + hstep, voffB);
            PG8_WAIT_V(6); PG8_BAR; PG8_MMA(1, 1, At, B1); PG8_BAR;
            }
        }
        if constexpr (FP8) asm volatile("s_nop 15\n\ts_nop 15" ::: "memory");
        if constexpr (ALIGN_EPI) { if (wr == 0) PG8_BAR; }
        if constexpr (!Epi::AFTER_DRAIN) { E(acc, cur, wr, wc, fr, fq); S.done(cur); }
        if (!has_next) break;
#pragma unroll
        for (int a = 0; a < 2; ++a)
#pragma unroll
            for (int b = 0; b < 2; ++b)
#pragma unroll
                for (int m = 0; m < 4; ++m)
#pragma unroll
                    for (int n = 0; n < 2; ++n) acc[a][b][m][n] = (f32x4){0.f, 0.f, 0.f, 0.f};
        cur = nxt; cA = nA; cB = nB; ++ui;
        if constexpr (ALIGN_EPI) { if (wr == 1) PG8_BAR; }
    }
    PG8_WAIT_V(0);
    if constexpr (!ALIGN_EPI) { if (wr == 0) PG8_BAR; }
    PG8_BAR;
    if constexpr (Epi::AFTER_DRAIN) { E.fused(acc, cur, wr, wc, fr, fq, lds, wid, lane); S.done(cur); }
#undef PG8_SA
#undef PG8_SB
#undef PG8_STAGE
#undef PG8_LDA
#undef PG8_LDB
#undef PG8_MMA
#undef PG8_WAIT_V
#undef PG8_WAIT_L
#undef PG8_BAR
#undef PG8_SCHED
}
}
#define GAS __attribute__((address_space(1)))
#define LAS __attribute__((address_space(3)))
typedef unsigned short bf16;
typedef unsigned v4u __attribute__((ext_vector_type(4)));
typedef float f32x4 __attribute__((ext_vector_type(4)));
typedef short bf16x8 __attribute__((ext_vector_type(8)));
typedef GAS unsigned gu32;
typedef GAS unsigned long long gu64;
#define RLX_AGENT __ATOMIC_RELAXED, __HIP_MEMORY_SCOPE_AGENT
#define LDS_WAIT() asm volatile("s_waitcnt lgkmcnt(0)" ::: "memory")
#define VM_WAIT() asm volatile("s_waitcnt vmcnt(0)" ::: "memory")
__device__ __forceinline__ unsigned long long rt() { return __builtin_amdgcn_s_memrealtime(); }
__device__ __forceinline__ unsigned f2bf(float f) { unsigned u = __builtin_bit_cast(unsigned, f); return (u + 0x7fffu + ((u >> 16) & 1u)) >> 16; }
__device__ __forceinline__ unsigned pk2(float lo, float hi) { return f2bf(lo) | (f2bf(hi) << 16); }

#define XB_TMO      128
#define XB_XCNT(j)  (256  + 64 * (j))
#define XB_XSUB(j)  (1280 + 64 * (j))
#define XB_XGEN(j)  (2304 + 64 * (j))
#define XB_TOP      3328
#define XB_TOPGEN   3392
#define XCD_BAR_WORDS 3456
#define XB_SPIN_CAP (1u << 18)

__device__ __forceinline__ unsigned xb_ld(unsigned* p)              { return __hip_atomic_load(p, __ATOMIC_RELAXED, __HIP_MEMORY_SCOPE_AGENT); }
__device__ __forceinline__ unsigned xb_add(unsigned* p, unsigned v) { return __hip_atomic_fetch_add(p, v, __ATOMIC_RELAXED, __HIP_MEMORY_SCOPE_AGENT); }
__device__ __forceinline__ unsigned xb_xcc_id() { return (unsigned)__builtin_amdgcn_s_getreg((3 << 11) | 20) & 0xFu; }
#define XB_SPIN(cond, bar) do { unsigned _sp = 0; while (cond) { __builtin_amdgcn_s_sleep(1); \
    if ((++_sp & 255u) == 0u) { if (xb_ld(&(bar)[XB_TMO])) break; if (_sp > XB_SPIN_CAP) { atomicAdd(&(bar)[XB_TMO], 1u); break; } } } } while (0)

struct XcdBarrier {
    unsigned* bar; unsigned x;
    volatile LAS unsigned* st;
};

__device__ __forceinline__ XcdBarrier xcd_barrier_post(unsigned* bar, volatile LAS unsigned* st) {
    XcdBarrier b; b.bar = bar; b.x = xb_xcc_id(); b.st = st;
    if (threadIdx.x == 0) (void)xb_add(&bar[XB_XCNT(b.x)], 1u);
    return b;
}
__device__ __forceinline__ void xcd_barrier_complete(unsigned* bar, unsigned x, unsigned& nloc, unsigned& nx) {
    const unsigned G = gridDim.x * gridDim.y * gridDim.z;
    unsigned sum, cnt, mine, sp = 0u;
    for (;;) {
        sum = 0u; cnt = 0u; mine = 0u;
#pragma unroll
        for (unsigned j = 0; j < 16; ++j) { const unsigned c = xb_ld(&bar[XB_XCNT(j)]); sum += c; cnt += (c > 0u) ? 1u : 0u; mine = (j == x) ? c : mine; }
        if (sum == G) break;
        __builtin_amdgcn_s_sleep(1);
        if ((++sp & 255u) == 0u) { if (xb_ld(&bar[XB_TMO])) break; if (sp > XB_SPIN_CAP) { atomicAdd(&bar[XB_TMO], 1u); break; } }
    }
    nloc = mine > 0u ? mine : 1u; nx = cnt > 0u ? cnt : 1u;
}

__device__ __forceinline__ void xcd_barrier(const XcdBarrier& b) {
    asm volatile("s_waitcnt vmcnt(0)" ::: "memory");
    __syncthreads();
    if (threadIdx.x == 0) {
        unsigned* bar = b.bar;
        __builtin_amdgcn_s_waitcnt(0);
        unsigned nloc = b.st[0], nx = b.st[1];
        if (nloc == 0u) { xcd_barrier_complete(bar, b.x, nloc, nx); b.st[0] = nloc; b.st[1] = nx; }
        const unsigned old = xb_add(&bar[XB_XSUB(b.x)], 1u);
        const unsigned gen = old / nloc;
        if (old + 1u == (gen + 1u) * nloc) {
            __builtin_amdgcn_fence(__ATOMIC_RELEASE, "agent");
            asm volatile("s_waitcnt vmcnt(0)" ::: "memory");
            const unsigned og = xb_add(&bar[XB_TOP], 1u);
            const unsigned tg = og / nx;
            if (og + 1u == (tg + 1u) * nx) xb_add(&bar[XB_TOPGEN], 1u);
            else XB_SPIN(xb_ld(&bar[XB_TOPGEN]) == tg, bar);
            __builtin_amdgcn_fence(__ATOMIC_ACQUIRE, "agent");
            xb_add(&bar[XB_XGEN(b.x)], 1u);
            asm volatile("s_waitcnt vmcnt(0)" ::: "memory");
        } else {
            XB_SPIN(xb_ld(&bar[XB_XGEN(b.x)]) == gen, bar);
            __builtin_amdgcn_fence(__ATOMIC_ACQUIRE, "agent");
            asm volatile("s_waitcnt vmcnt(0)" ::: "memory");
        }
    }
    __syncthreads();
}

constexpr int NWAVES = 8;
#ifndef MK_PER_PHASE
#define MK_PER_PHASE 0
#endif
constexpr int NPHASE = 22;

constexpr int BATCH = 2, SEQ = 8192, DM = 2048, NTOK = BATCH * SEQ, NH = 16, DH = 128;
constexpr int NSA_N = 5168, NSA_NPAD = 5376, P0LD = 5120;
constexpr int NCMP = 511, NSELB = 128;
constexpr int COL_KC = 2048, COL_VC = 2560, COL_KS = 3072, COL_VS = 3584, COL_KW = 4096, COL_VW = 4608;
constexpr int DSA_N = 2888, DSA_NPAD = 3072, KVR = 256, TOPK = 256;
constexpr int DFF = 5632, NEXP = 8, DFFE = 7168, MOE_ROWS = 34816;
constexpr float ALPHA = 1.41421356237309515f, LN_EPS = 1e-5f, RMS_EPS = 1e-6f;

constexpr size_t MiB = (size_t)1 << 20;
constexpr size_t WS_CTL = 0, CTL_ZERO_BYTES = 128 * 1024;
constexpr size_t WS_W_NSA_IN = 2 * MiB, WS_W_NSA_OUT = 23 * MiB, WS_W_FFN_GU = 31 * MiB, WS_W_FFN_DN = 75 * MiB, WS_W_DSA_IN = 97 * MiB, WS_W_DSA_OUT = 109 * MiB;
constexpr size_t WS_W_CMPK = 117 * MiB, WS_W_CMPV = 118 * MiB, WS_W_UK = 119 * MiB, WS_W_UV = 120 * MiB, WS_CBIAS = 121 * MiB;
constexpr size_t WS_KCMP = 122 * MiB, WS_VCMP = 124 * MiB, WS_GL = 126 * MiB, WS_ROUTE = 129 * MiB;
constexpr size_t WS_KIB = 179 * MiB;
constexpr size_t WS_SELM = 178 * MiB;
constexpr size_t WS_CRAW = 130 * MiB, WS_KIWI = 146 * MiB, WS_IDX = 154 * MiB, WS_CN = 170 * MiB;
constexpr size_t WS_W_MOE_GU = 192 * MiB, WS_W_MOE_DN = 640 * MiB;
constexpr size_t WS_XB = 864 * MiB, WS_XF = 928 * MiB, WS_Z = 1056 * MiB;
constexpr size_t WS_P0 = 1184 * MiB, WS_OATT0 = 1344 * MiB, WS_HFF = 1408 * MiB;
constexpr size_t WS_Q = 1184 * MiB, WS_QI = 1248 * MiB, WS_QLAT = 1264 * MiB, WS_OLAT = 1392 * MiB, WS_OATT1 = 1520 * MiB;
constexpr size_t WS_XG = 1056 * MiB, WS_HM = 1192 * MiB, WS_Y = 192 * MiB;
constexpr size_t WS_END = 1668 * MiB;
static_assert(WS_HM + (size_t)MOE_ROWS * DFFE * 2 <= WS_END, "hm fits");
static_assert(WS_XG + (size_t)MOE_ROWS * DM * 2 <= WS_HM, "xg fits");
static_assert(WS_Y + (size_t)MOE_ROWS * DM * 4 <= WS_W_MOE_DN, "y overlays the dead gate/up weights only");
static_assert(WS_HFF + (size_t)NTOK * DFF * 2 <= WS_END, "hff fits");
constexpr int CW_TMO = 0, CW_CODE = 1;
constexpr int CW_BAR = 4096;
constexpr int CW_MOECNT = 16384;

constexpr int RING_OFF = 0, RING_BYTES = 131072;
constexpr int LDSCTL_OFF = RING_BYTES, MISC_OFF = LDSCTL_OFF + 320;
constexpr int LDS_BYTES = 163840;
constexpr int DSA_SCR = 133120;

struct Frame {
    LAS unsigned char* lds;
    volatile LAS unsigned* MISC;
    gu32* ctl;
    int tid, lane, wave, vcu, G;
};

__device__ __forceinline__ void relaunder(Frame& F) { int t = F.tid; asm volatile("" : "+v"(t)); F.tid = t; F.lane = t & 63; }
__device__ __forceinline__ float bf2f(unsigned short h) { return __uint_as_float(((unsigned)h) << 16); }
__device__ __forceinline__ float bflo(unsigned w) { return __uint_as_float(w << 16); }
__device__ __forceinline__ float bfhi(unsigned w) { return __uint_as_float(w & 0xffff0000u); }
__device__ __forceinline__ float wave_sum(float v) {
#pragma unroll
    for (int o = 1; o < 64; o <<= 1) v += __shfl_xor(v, o);
    return v;
}
__device__ __forceinline__ float wave_max(float v) {
#pragma unroll
    for (int o = 1; o < 64; o <<= 1) v = fmaxf(v, __shfl_xor(v, o));
    return v;
}
__device__ __forceinline__ float dpp_xor1(float v) { return __int_as_float(__builtin_amdgcn_mov_dpp(__float_as_int(v), 0xB1, 0xF, 0xF, true)); }
__device__ __forceinline__ float dpp_xor2(float v) { return __int_as_float(__builtin_amdgcn_mov_dpp(__float_as_int(v), 0x4E, 0xF, 0xF, true)); }
__device__ __forceinline__ float sum_xor32(float v) { auto r = __builtin_amdgcn_permlane32_swap(__float_as_uint(v), __float_as_uint(v), false, false); return __uint_as_float(r[0]) + __uint_as_float(r[1]); }
__device__ __forceinline__ float max_xor32(float v) { auto r = __builtin_amdgcn_permlane32_swap(__float_as_uint(v), __float_as_uint(v), false, false); return fmaxf(__uint_as_float(r[0]), __uint_as_float(r[1])); }
__device__ __forceinline__ float sum_xor16(float v) { auto r = __builtin_amdgcn_permlane16_swap(__float_as_uint(v), __float_as_uint(v), false, false); return __uint_as_float(r[0]) + __uint_as_float(r[1]); }
__device__ __forceinline__ float max_xor16(float v) { auto r = __builtin_amdgcn_permlane16_swap(__float_as_uint(v), __float_as_uint(v), false, false); return fmaxf(__uint_as_float(r[0]), __uint_as_float(r[1])); }
#define WSYNC() do { __builtin_amdgcn_wave_barrier(); asm volatile("s_waitcnt lgkmcnt(0)" ::: "memory"); __builtin_amdgcn_wave_barrier(); } while (0)

__device__ __forceinline__ int rel_bucket(int n) {
    if (n < 16) return n;
    if (n >= 113) return 31;
    int b = 16;
    b += (n >= 19); b += (n >= 21); b += (n >= 24); b += (n >= 27); b += (n >= 31); b += (n >= 35); b += (n >= 40); b += (n >= 46);
    b += (n >= 52); b += (n >= 59); b += (n >= 67); b += (n >= 77); b += (n >= 87); b += (n >= 99);
    return b;
}

struct Args { const float* in[27]; float* out; unsigned char* ws; int ph_lo, ph_hi; };
#ifndef FFN_F8
#define FFN_F8 1
#endif
struct TrItem { const float* W; bf16* WT; int N, K, k0, n0, drow; float f8scale; };
__device__ __forceinline__ void tr_set(TrItem& T, const float* W, int K, int N, int Npad, bf16* WT, int mode, int item, float f8scale = 0.f) {
    T.f8scale = f8scale;
    const int nblk = Npad / 32, kb = item / nblk, nb = item - kb * nblk, n0 = 32 * nb;
    T.W = W; T.WT = WT; T.N = N; T.K = K; T.k0 = 64 * kb; T.n0 = n0; T.drow = (mode == 0) ? n0 : ((n0 >> 7) * 256 + (mode - 1) * 128 + (n0 & 127));
}
constexpr int TR_I_NSA_IN = (DM / 64) * (NSA_NPAD / 32), TR_I_SQ = (DM / 64) * (DM / 32), TR_I_FFN = (DM / 64) * (DFF / 32), TR_I_FFD = (DFF / 64) * (DM / 32), TR_I_DSA_IN = (DM / 64) * (DSA_NPAD / 32);
constexpr int TR_I_CMP = (4096 / 64) * (128 / 32), TR_I_UK1 = (128 / 64) * (256 / 32), TR_I_UV1 = (256 / 64) * (128 / 32);
constexpr int TR_I_MG1 = (DM / 64) * (DFFE / 32), TR_I_MD1 = (DFFE / 64) * (DM / 32);
constexpr int TR_NITEMS = TR_I_NSA_IN + 2 * TR_I_SQ + 2 * TR_I_FFN + TR_I_FFD + TR_I_DSA_IN + 2 * TR_I_CMP + 16 * TR_I_UK1 + 16 * TR_I_UV1 + 16 * TR_I_MG1 + 8 * TR_I_MD1;
__device__ __forceinline__ void tr_decode(const Args& A, unsigned char* ws, int it, TrItem& T) {
    int r = it;
    if (r < TR_I_NSA_IN) { tr_set(T, A.in[2], DM, NSA_N, NSA_NPAD, (bf16*)(ws + WS_W_NSA_IN), 0, r); return; } r -= TR_I_NSA_IN;
    if (r < TR_I_SQ) { tr_set(T, A.in[9], DM, DM, DM, (bf16*)(ws + WS_W_NSA_OUT), 0, r); return; } r -= TR_I_SQ;
    if (r < TR_I_SQ) { tr_set(T, A.in[14], DM, DM, DM, (bf16*)(ws + WS_W_DSA_OUT), 0, r); return; } r -= TR_I_SQ;
    if (r < TR_I_FFN) { tr_set(T, A.in[15], DM, DFF, DFF, (bf16*)(ws + WS_W_FFN_GU), 1, r, FFN_F8 ? 64.f : 0.f); return; } r -= TR_I_FFN;
    if (r < TR_I_FFN) { tr_set(T, A.in[16], DM, DFF, DFF, (bf16*)(ws + WS_W_FFN_GU), 2, r, FFN_F8 ? 64.f : 0.f); return; } r -= TR_I_FFN;
    if (r < TR_I_FFD) { tr_set(T, A.in[17], DFF, DM, DM, (bf16*)(ws + WS_W_FFN_DN), 0, r, FFN_F8 ? 256.f : 0.f); return; } r -= TR_I_FFD;
    if (r < TR_I_DSA_IN) { tr_set(T, A.in[10], DM, DSA_N, DSA_NPAD, (bf16*)(ws + WS_W_DSA_IN), 0, r); return; } r -= TR_I_DSA_IN;
    if (r < TR_I_CMP) { tr_set(T, A.in[4], 4096, 128, 128, (bf16*)(ws + WS_W_CMPK), 0, r); return; } r -= TR_I_CMP;
    if (r < TR_I_CMP) { tr_set(T, A.in[7], 4096, 128, 128, (bf16*)(ws + WS_W_CMPV), 0, r); return; } r -= TR_I_CMP;
    if (r < 16 * TR_I_UK1) { const int h = r / TR_I_UK1; tr_set(T, A.in[12] + (size_t)h * 128 * 256, 128, 256, 256, (bf16*)(ws + WS_W_UK) + (size_t)h * 256 * 128, 0, r - h * TR_I_UK1); return; } r -= 16 * TR_I_UK1;
    if (r < 16 * TR_I_UV1) { const int h = r / TR_I_UV1; tr_set(T, A.in[13] + (size_t)h * 256 * 128, 256, 128, 128, (bf16*)(ws + WS_W_UV) + (size_t)h * 128 * 256, 0, r - h * TR_I_UV1); return; } r -= 16 * TR_I_UV1;
    if (r < 8 * TR_I_MG1) { const int e = r / TR_I_MG1; tr_set(T, A.in[20] + (size_t)e * DM * DFFE, DM, DFFE, DFFE, (bf16*)(ws + WS_W_MOE_GU + (size_t)e * 2 * DFFE * DM), 1, r - e * TR_I_MG1, 64.f); return; } r -= 8 * TR_I_MG1;
    if (r < 8 * TR_I_MG1) { const int e = r / TR_I_MG1; tr_set(T, A.in[21] + (size_t)e * DM * DFFE, DM, DFFE, DFFE, (bf16*)(ws + WS_W_MOE_GU + (size_t)e * 2 * DFFE * DM), 2, r - e * TR_I_MG1, 64.f); return; } r -= 8 * TR_I_MG1;
    { const int e = r / TR_I_MD1; tr_set(T, A.in[22] + (size_t)e * DFFE * DM, DFFE, DM, DM, (bf16*)(ws + WS_W_MOE_DN + (size_t)e * DM * DFFE), 0, r - e * TR_I_MD1, 256.f); }
}
__device__ __forceinline__ void tr_load(const TrItem& T, f32x4 (&v)[8], int lane) {
    const int kr = lane >> 3, c4 = lane & 7, n = T.n0 + 4 * c4;
#pragma unroll
    for (int i = 0; i < 8; ++i) v[i] = (n < T.N) ? *(const f32x4*)(T.W + (size_t)(T.k0 + 8 * i + kr) * T.N + n) : (f32x4){0.f, 0.f, 0.f, 0.f};
}
__device__ __forceinline__ void tr_store(const TrItem& T, const f32x4 (&v)[8], LAS float* scr, int lane) {
    { const int kr = lane >> 3, c4 = lane & 7;
#pragma unroll
      for (int i = 0; i < 8; ++i) { LAS float* d = scr + (8 * i + kr) * 33 + 4 * c4; d[0] = v[i][0]; d[1] = v[i][1]; d[2] = v[i][2]; d[3] = v[i][3]; } }
    LDS_WAIT(); asm volatile("" ::: "memory");
    const int c = lane & 7;
#pragma unroll
    for (int j = 0; j < 4; ++j) { const int n = (lane >> 3) + 8 * j; const LAS float* s = scr + (8 * c) * 33 + n;
        v4u o; o.x = pg8::cvt_pk_bf16(s[0 * 33], s[1 * 33]); o.y = pg8::cvt_pk_bf16(s[2 * 33], s[3 * 33]); o.z = pg8::cvt_pk_bf16(s[4 * 33], s[5 * 33]); o.w = pg8::cvt_pk_bf16(s[6 * 33], s[7 * 33]);
        *(v4u*)(T.WT + (size_t)(T.drow + n) * T.K + T.k0 + 8 * c) = o; }
    LDS_WAIT(); asm volatile("" ::: "memory");
}

__device__ __forceinline__ void tr_store8(const TrItem& T, const f32x4 (&v)[8], LAS float* scr, int lane) {
    { const int kr = lane >> 3, c4 = lane & 7;
#pragma unroll
      for (int i = 0; i < 8; ++i) { LAS float* d = scr + (8 * i + kr) * 33 + 4 * c4; d[0] = v[i][0]; d[1] = v[i][1]; d[2] = v[i][2]; d[3] = v[i][3]; } }
    LDS_WAIT(); asm volatile("" ::: "memory");
    const int c = lane & 3, nr = lane >> 2; const float sc = T.f8scale;
#pragma unroll
    for (int j = 0; j < 2; ++j) { const int n = nr + 16 * j; const LAS float* s = scr + (16 * c) * 33 + n; int w[4];
#pragma unroll
        for (int q = 0; q < 4; ++q) { w[q] = __builtin_amdgcn_cvt_pk_fp8_f32(s[(4 * q) * 33] * sc, s[(4 * q + 1) * 33] * sc, 0, false); w[q] = __builtin_amdgcn_cvt_pk_fp8_f32(s[(4 * q + 2) * 33] * sc, s[(4 * q + 3) * 33] * sc, w[q], true); }
        v4u o; o.x = (unsigned)w[0]; o.y = (unsigned)w[1]; o.z = (unsigned)w[2]; o.w = (unsigned)w[3];
        *(v4u*)((unsigned char*)T.WT + (size_t)(T.drow + n) * T.K + T.k0 + 16 * c) = o; }
    LDS_WAIT(); asm volatile("" ::: "memory");
}
__device__ __forceinline__ void p0_prologue(Frame& F, const Args& A) {
    LAS float* scr = (LAS float*)(F.lds + RING_OFF + F.wave * 16384);
    unsigned char* ws = A.ws;
    const int gw = F.vcu * NWAVES + F.wave, NGW = F.G * NWAVES, lane = F.lane;
    {
        TrItem T0, T1, T2, T3; f32x4 v0[8], v1[8], v2[8], v3[8]; int it = gw;
#define TR_ISSUE(T, v, idx) do { if ((idx) < TR_NITEMS) { tr_decode(A, ws, (idx), T); tr_load(T, v, lane); } } while (0)
#define TR_RETIRE(T, v, idx) do { if ((idx) < TR_NITEMS) { if (T.f8scale != 0.f) tr_store8(T, v, scr, lane); else tr_store(T, v, scr, lane); } } while (0)
        TR_ISSUE(T0, v0, it); TR_ISSUE(T1, v1, it + NGW); TR_ISSUE(T2, v2, it + 2 * NGW);
        while (it < TR_NITEMS) {
            TR_ISSUE(T3, v3, it + 3 * NGW); TR_RETIRE(T0, v0, it);
            TR_ISSUE(T0, v0, it + 4 * NGW); TR_RETIRE(T1, v1, it + NGW);
            TR_ISSUE(T1, v1, it + 5 * NGW); TR_RETIRE(T2, v2, it + 2 * NGW);
            TR_ISSUE(T2, v2, it + 6 * NGW); TR_RETIRE(T3, v3, it + 3 * NGW);
            it += 4 * NGW;
        }
#undef TR_ISSUE
#undef TR_RETIRE
    }
    { const float* x = A.in[0]; bf16* xb = (bf16*)(ws + WS_XB); const size_t n8 = (size_t)NTOK * DM / 8;
      for (size_t i = (size_t)F.vcu * 512 + F.tid; i < n8; i += (size_t)F.G * 512) { const f32x4 a = *(const f32x4*)(x + i * 8), b = *(const f32x4*)(x + i * 8 + 4);
          v4u o; o.x = pk2(a[0], a[1]); o.y = pk2(a[2], a[3]); o.z = pk2(b[0], b[1]); o.w = pk2(b[2], b[3]); *(v4u*)(xb + i * 8) = o; } }
    for (int it = gw; it < 64; it += NGW) { const int kv = it >> 5, ch = it & 31; const float* pe = A.in[kv ? 6 : 3]; const float* w1 = A.in[kv ? 7 : 4];
        float s0 = 0.f, s1 = 0.f;
        for (int k = ch * 128; k < ch * 128 + 128; ++k) { const float p = pe[k]; s0 += p * w1[(size_t)k * 128 + lane]; s1 += p * w1[(size_t)k * 128 + 64 + lane]; }
        float* cb = (float*)(ws + WS_CBIAS) + (size_t)(kv * 32 + ch) * 128; cb[lane] = s0; cb[64 + lane] = s1; }
}

typedef short s8v __attribute__((ext_vector_type(8)));
__device__ __forceinline__ s8v ld_frag(const bf16* p) { return *(const s8v*)p; }

__device__ __forceinline__ float gelu_tanh(float x) { const float u = 0.7978845608028654f * (x + 0.044715f * x * x * x); return 0.5f * x * (1.0f + tanhf(u)); }
__device__ __forceinline__ void p2_compress(Frame& F, const Args& A) {
    unsigned char* ws = A.ws; const int lane = F.lane, wid = F.wave, tid = F.tid;
    const bf16* P0 = (const bf16*)(ws + WS_P0);
    LAS float* part = (LAS float*)(F.lds + RING_OFF);
    LAS float* hid = (LAS float*)(F.lds + DSA_SCR);
    LAS float* cbl = hid + 4096;
    if (tid < 256) { const float* cbp = (const float*)(ws + WS_CBIAS) + (size_t)(tid >> 7) * 32 * 128 + (tid & 127); float cb = 0.f; for (int ch = 0; ch < 32; ++ch) cb += cbp[ch * 128]; cbl[tid] = cb; }
    if (F.vcu < 16 && wid == 0) { bf16* zp = (bf16*)(ws + ((F.vcu & 1) ? WS_VCMP : WS_KCMP)) + ((size_t)(F.vcu >> 1) * 512 + 511) * 128; zp[lane] = 0; zp[64 + lane] = 0; }
    __syncthreads();
    const int r16 = lane & 15, kq = lane >> 4;
    for (int it = F.vcu; it < 256; it += F.G) {
        const int kv = it >> 7, tile = it & 127;
        const bf16* W1T = (const bf16*)(ws + (kv ? WS_W_CMPV : WS_W_CMPK));
        const float* w2 = A.in[kv ? 8 : 5];
        bf16* outp = (bf16*)(ws + (kv ? WS_VCMP : WS_KCMP));
        const int colbase = kv ? COL_VC : COL_KC;
        f32x4 acc[2][8];
#pragma unroll
        for (int m = 0; m < 2; ++m)
#pragma unroll
            for (int n = 0; n < 8; ++n) acc[m][n] = (f32x4){0.f, 0.f, 0.f, 0.f};
        const bf16* arow[2];
#pragma unroll
        for (int m = 0; m < 2; ++m) { int R = tile * 32 + m * 16 + r16; if (R > 4087) R = 4087; const int g = R & 3, bn = R >> 2, b = bn / NCMP, n = bn - b * NCMP;
            arow[m] = P0 + (size_t)(b * SEQ + 16 * n) * P0LD + colbase + g * 128 + kq * 8; }
#pragma unroll 2
        for (int kk = 0; kk < 16; ++kk) {
            const int ks = wid * 16 + kk, l = ks >> 2, d0 = (ks & 3) * 32;
            s8v af[2], bfr[8];
#pragma unroll
            for (int m = 0; m < 2; ++m) af[m] = ld_frag(arow[m] + (size_t)l * P0LD + d0);
#pragma unroll
            for (int n = 0; n < 8; ++n) bfr[n] = ld_frag(W1T + (size_t)(n * 16 + r16) * 4096 + ks * 32 + kq * 8);
#pragma unroll
            for (int m = 0; m < 2; ++m)
#pragma unroll
                for (int n = 0; n < 8; ++n) acc[m][n] = __builtin_amdgcn_mfma_f32_16x16x32_bf16(af[m], bfr[n], acc[m][n], 0, 0, 0);
        }
#pragma unroll
        for (int m = 0; m < 2; ++m)
#pragma unroll
            for (int n = 0; n < 8; ++n)
#pragma unroll
                for (int j = 0; j < 4; ++j) part[wid * 4096 + (m * 16 + kq * 4 + j) * 128 + n * 16 + r16] = acc[m][n][j];
        __syncthreads();
        { const int row = tid >> 4, e0 = (tid & 15) * 8; f32x4 s0 = (f32x4){0.f, 0.f, 0.f, 0.f}, s1 = s0;
#pragma unroll
          for (int w = 0; w < 8; ++w) { s0 += *(const LAS f32x4*)(part + w * 4096 + row * 128 + e0); s1 += *(const LAS f32x4*)(part + w * 4096 + row * 128 + e0 + 4); }
#pragma unroll
          for (int j = 0; j < 4; ++j) { hid[row * 128 + e0 + j] = gelu_tanh(s0[j] + cbl[kv * 128 + e0 + j]); hid[row * 128 + e0 + 4 + j] = gelu_tanh(s1[j] + cbl[kv * 128 + e0 + 4 + j]); } }
        __syncthreads();
        { const int rr = tid >> 4, f0 = (tid & 15) * 8, R = tile * 32 + rr; f32x4 o0 = (f32x4){0.f, 0.f, 0.f, 0.f}, o1 = o0;
#pragma unroll 4
          for (int e = 0; e < 128; ++e) { const float hv = hid[rr * 128 + e]; o0 += *(const f32x4*)(w2 + e * 128 + f0) * hv; o1 += *(const f32x4*)(w2 + e * 128 + f0 + 4) * hv; }
          if (R <= 4087) { const int g = R & 3, bn = R >> 2, b = bn / NCMP, n = bn - b * NCMP;
              v4u o; o.x = pk2(o0[0], o0[1]); o.y = pk2(o0[2], o0[3]); o.z = pk2(o1[0], o1[1]); o.w = pk2(o1[2], o1[3]);
              *(v4u*)(outp + ((size_t)(b * 4 + g) * 512 + n) * 128 + f0) = o; } }
        __syncthreads();
    }
}

namespace fa {
typedef float f32x16 __attribute__((ext_vector_type(16)));
typedef short s16x4 __attribute__((ext_vector_type(4)));
typedef unsigned u32x4v __attribute__((ext_vector_type(4)));
constexpr int SHM_K = 16384, SHM_V = 16384;
constexpr int OFF_V = 0, OFF_K = 2 * SHM_V, OFF_WS = 2 * SHM_V + 2 * SHM_K, OFF_LUT = OFF_WS + 8 * 256, OFF_MASK = OFF_LUT + 144 * 16 * 4, OFF_TAB = OFF_MASK + 1024;
constexpr int TABLD = 130;
constexpr float C2 = 1.4426950408889634f, THR = 8.f;
#define FA_KSWZ(row, colB) ((row) * 256 + ((colB) ^ (((row) & 7) << 4)))
#define FA_SBAR() __builtin_amdgcn_sched_barrier(0)
__device__ __forceinline__ int v_st(int k, int c) { const int kk = (k & ~0xC) | ((k & 4) << 1) | ((k & 8) >> 1); return ((kk >> 3) * 4 + (c >> 5)) * 512 + ((kk & 7) * 32 + (c & 31)) * 2; }
__device__ __forceinline__ int v_rd_base(int lane) { return ((lane & 3) << 3) | (((lane >> 2) & 3) << 6) | (((lane >> 4) & 1) << 5) | (((lane >> 5) & 1) << 8); }
constexpr int v_rd_off(int d0, int ks, int half) { return d0 * 512 + ks * 4096 + half * 2048; }
__device__ __forceinline__ int crow(int r, int hi) { return (r & 3) + 8 * (r >> 2) + 4 * hi; }
__device__ __forceinline__ unsigned cvtpk(float lo, float hi) { unsigned r; asm volatile("v_cvt_pk_bf16_f32 %0, %1, %2" : "=v"(r) : "v"(lo), "v"(hi)); return r; }

__device__ __forceinline__ void qkt(f32x16& p0, f32x16& p1, const LAS char* Kb, int r32, int hi, const bf16x8 (&qr)[8], float init) {
#pragma unroll
    for (int r = 0; r < 16; ++r) { p0[r] = init; p1[r] = init; }
    const LAS char* kb[4];
#pragma unroll
    for (int dd = 0; dd < 4; ++dd) kb[dd] = Kb + FA_KSWZ(r32, (dd * 16 + hi * 8) * 2);
#pragma unroll
    for (int d0 = 0; d0 < 8; ++d0) { const LAS char* a = kb[d0 & 3] + (d0 >> 2) * 128;
        const bf16x8 b0 = *(const LAS bf16x8*)a;
        const bf16x8 b1 = *(const LAS bf16x8*)(a + 32 * 256);
        p0 = __builtin_amdgcn_mfma_f32_32x32x16_bf16(b0, qr[d0], p0, 0, 0, 0);
        p1 = __builtin_amdgcn_mfma_f32_32x32x16_bf16(b1, qr[d0], p1, 0, 0, 0); }
}
__device__ __forceinline__ void pv_tile(f32x16 (&o)[4], int vb0, bf16x8 pa0, bf16x8 pa1, bf16x8 pa2, bf16x8 pa3) {
#define FA_TRRD(dst, off) asm volatile("ds_read_b64_tr_b16 %0, %1 offset:%2" : "=&v"(dst) : "v"(vb0), "i"(off) : "memory")
#define FA_PV_D0(d0) do { s16x4 l0, l1, l2, l3, h0, h1, h2, h3; constexpr int b_ = v_rd_off(d0, 0, 0); \
        FA_TRRD(l0, b_); FA_TRRD(h0, b_ + 2048); FA_TRRD(l1, b_ + 4096); FA_TRRD(h1, b_ + 6144); FA_TRRD(l2, b_ + 8192); FA_TRRD(h2, b_ + 10240); FA_TRRD(l3, b_ + 12288); FA_TRRD(h3, b_ + 14336); \
        asm volatile("s_waitcnt lgkmcnt(0)" ::: "memory"); FA_SBAR(); \
        o[d0] = __builtin_amdgcn_mfma_f32_32x32x16_bf16(pa0, (bf16x8){l0[0], l0[1], l0[2], l0[3], h0[0], h0[1], h0[2], h0[3]}, o[d0], 0, 0, 0); \
        o[d0] = __builtin_amdgcn_mfma_f32_32x32x16_bf16(pa1, (bf16x8){l1[0], l1[1], l1[2], l1[3], h1[0], h1[1], h1[2], h1[3]}, o[d0], 0, 0, 0); \
        o[d0] = __builtin_amdgcn_mfma_f32_32x32x16_bf16(pa2, (bf16x8){l2[0], l2[1], l2[2], l2[3], h2[0], h2[1], h2[2], h2[3]}, o[d0], 0, 0, 0); \
        o[d0] = __builtin_amdgcn_mfma_f32_32x32x16_bf16(pa3, (bf16x8){l3[0], l3[1], l3[2], l3[3], h3[0], h3[1], h3[2], h3[3]}, o[d0], 0, 0, 0); } while (0)
    FA_PV_D0(0); FA_PV_D0(1); FA_PV_D0(2); FA_PV_D0(3);
#undef FA_PV_D0
#undef FA_TRRD
}
__device__ __forceinline__ void partialSM(f32x16& p0, f32x16& p1, float& m_reg, float& alpha) {
    float pmax = p0[0];
#pragma unroll
    for (int r = 1; r < 16; ++r) pmax = fmaxf(pmax, p0[r]);
#pragma unroll
    for (int r = 0; r < 16; ++r) pmax = fmaxf(pmax, p1[r]);
    { auto rr = __builtin_amdgcn_permlane32_swap(__float_as_uint(pmax), __float_as_uint(pmax), false, false); pmax = fmaxf(__uint_as_float(rr[0]), __uint_as_float(rr[1])); }
    float mn;
    if (__all(pmax - m_reg <= THR)) { mn = m_reg; alpha = 1.f; }
    else { mn = fmaxf(m_reg, pmax); alpha = __builtin_amdgcn_exp2f((m_reg - mn) * C2); m_reg = mn; }
    const float mnL = -mn * C2;
#pragma unroll
    for (int r = 0; r < 16; ++r) { p0[r] = __builtin_amdgcn_exp2f(fmaf(p0[r], C2, mnL)); p1[r] = __builtin_amdgcn_exp2f(fmaf(p1[r], C2, mnL)); }
}
__device__ __forceinline__ float finishSM(const f32x16& p0, const f32x16& p1, bf16x8& pa0, bf16x8& pa1, bf16x8& pa2, bf16x8& pa3) {
    float ps = 0.f;
#pragma unroll
    for (int r = 0; r < 16; ++r) ps += p0[r];
#pragma unroll
    for (int r = 0; r < 16; ++r) ps += p1[r];
    { auto rr = __builtin_amdgcn_permlane32_swap(__float_as_uint(ps), __float_as_uint(ps), false, false); ps = __uint_as_float(rr[0]) + __uint_as_float(rr[1]); }
#define FA_PK4(P, B_, OUT) do { unsigned a0 = cvtpk(P[B_ + 0], P[B_ + 1]), a1 = cvtpk(P[B_ + 2], P[B_ + 3]); unsigned b0 = cvtpk(P[B_ + 4], P[B_ + 5]), b1 = cvtpk(P[B_ + 6], P[B_ + 7]); \
        auto r0 = __builtin_amdgcn_permlane32_swap(a0, b0, false, false); auto r1 = __builtin_amdgcn_permlane32_swap(a1, b1, false, false); \
        u32x4v w = {r0[0], r1[0], r0[1], r1[1]}; OUT = *reinterpret_cast<bf16x8*>(&w); } while (0)
    FA_PK4(p0, 0, pa0); FA_PK4(p0, 8, pa1); FA_PK4(p1, 0, pa2); FA_PK4(p1, 8, pa3);
#undef FA_PK4
    return ps;
}
__device__ __forceinline__ void rescale(f32x16 (&o)[4], float alpha, LAS float* al_l, int r32, int hi) {
    if (__any(alpha < 1.f)) { if (hi == 0) al_l[r32] = alpha; asm volatile("s_waitcnt lgkmcnt(0)" ::: "memory");
#pragma unroll
        for (int r = 0; r < 16; ++r) { const float a = al_l[crow(r, hi)];
#pragma unroll
            for (int d = 0; d < 4; ++d) o[d][r] *= a; }
        asm volatile("s_waitcnt lgkmcnt(0)" ::: "memory"); }
}
__device__ __forceinline__ void mask_tile(f32x16& p0, f32x16& p1, int dq, unsigned W) {
    const float NEG = -__builtin_inff();
#pragma unroll
    for (int r = 0; r < 16; ++r) { const int c = (r & 3) + 8 * (r >> 2);
        if ((unsigned)(dq - c) >= W) p0[r] = NEG;
        if ((unsigned)(dq - c - 32) >= W) p1[r] = NEG; }
}
__device__ __forceinline__ void mask_all(f32x16& p0, f32x16& p1, bool keep) {
    const float NEG = -__builtin_inff();
#pragma unroll
    for (int r = 0; r < 16; ++r) { p0[r] = keep ? p0[r] : NEG; p1[r] = keep ? p1[r] : NEG; }
}
__device__ __forceinline__ void bias_near(f32x16& p0, f32x16& p1, int dq, int step, const LAS float* lutcol) {
#pragma unroll
    for (int r = 0; r < 16; ++r) { const int c = (r & 3) + 8 * (r >> 2);
        const int d0 = min(max((dq - c) * step, 0), 128), d1 = min(max((dq - c - 32) * step, 0), 128);
        p0[r] += lutcol[d0]; p1[r] += lutcol[d1]; }
}
struct Stage { bf16x8 k0, k1, v0, v1; };
__device__ __forceinline__ void stage_load(Stage& S, const bf16* Kp, const bf16* Vp, size_t ld, int row0, int maxrow, int sr, int sc) {
    const int ra = min(row0 + sr, maxrow), rb = min(row0 + 32 + sr, maxrow);
    S.k0 = *(const bf16x8*)(Kp + (size_t)ra * ld + sc); S.k1 = *(const bf16x8*)(Kp + (size_t)rb * ld + sc);
    S.v0 = *(const bf16x8*)(Vp + (size_t)ra * ld + sc); S.v1 = *(const bf16x8*)(Vp + (size_t)rb * ld + sc);
}
__device__ __forceinline__ void stage_write(const Stage& S, LAS char* Kb, LAS char* Vb, int kws, int vst0, int vst1) {
    *(LAS bf16x8*)(Kb + kws) = S.k0; *(LAS bf16x8*)(Kb + kws + 32 * 256) = S.k1;
    *(LAS bf16x8*)(Vb + vst0) = S.v0; *(LAS bf16x8*)(Vb + vst1) = S.v1;
}
}

struct NsaLane { int wid, lane, r32, hi, ql, j, sr, sc, kws, vst0, vst1, vrd; };
__device__ __forceinline__ NsaLane nsa_lane(const Frame& F) {
    NsaLane L; L.wid = F.wave; L.lane = F.lane; L.r32 = F.lane & 31; L.hi = F.lane >> 5; L.ql = L.r32 >> 2; L.j = L.r32 & 3;
    L.sr = F.tid >> 4; L.sc = (F.tid & 15) * 8; L.kws = FA_KSWZ(L.sr, L.sc * 2); L.vst0 = fa::v_st(L.sr, L.sc); L.vst1 = fa::v_st(32 + L.sr, L.sc); L.vrd = fa::v_rd_base(F.lane);
    return L;
}
__device__ __forceinline__ void nsa_load_q(bf16x8 (&qr)[8], const bf16* P0, int tok0, int g, const NsaLane& L) {
    const bf16* qp = P0 + (size_t)(tok0 + L.wid * 8 + L.ql) * P0LD + (g * 4 + L.j) * 128 + L.hi * 8;
#pragma unroll
    for (int d0 = 0; d0 < 8; ++d0) qr[d0] = *(const bf16x8*)(qp + d0 * 16);
}
__device__ __forceinline__ void nsa_lut(Frame& F, const Args& A) {
    LAS float* lut = (LAS float*)(F.lds + RING_OFF + fa::OFF_LUT);
    for (int i = F.tid; i < 144 * 16; i += 512) { const int n = i >> 4, h = i & 15; lut[h * 144 + n] = A.in[1][rel_bucket(n) * 16 + h]; }
    __syncthreads();
}
template <int MODE>
__device__ __forceinline__ void nsa_store(const fa::f32x16 (&o)[4], float l_reg, LAS float* li_l, const float* GL, float* OACC, bf16* OATT, int tok0, int g, int br, const NsaLane& L) {
    if (L.hi == 0) li_l[L.r32] = l_reg;
    asm volatile("s_waitcnt lgkmcnt(0)" ::: "memory");
    float sc[16];
#pragma unroll
    for (int r = 0; r < 16; ++r) { const int row = fa::crow(r, L.hi), tok = tok0 + L.wid * 8 + (row >> 2), h = g * 4 + (row & 3); sc[r] = GL[(size_t)tok * 48 + h * 3 + br]; }
    float prev[4][16];
    if (MODE != 0) {
#pragma unroll
        for (int r = 0; r < 16; ++r) { const int row = fa::crow(r, L.hi), tok = tok0 + L.wid * 8 + (row >> 2), h = g * 4 + (row & 3); const float* ap = OACC + (size_t)tok * DM + h * 128 + L.r32;
#pragma unroll
            for (int d0 = 0; d0 < 4; ++d0) prev[d0][r] = ap[d0 * 32]; } }
#pragma unroll
    for (int r = 0; r < 16; ++r) { const int row = fa::crow(r, L.hi), tok = tok0 + L.wid * 8 + (row >> 2), h = g * 4 + (row & 3);
        const float l = li_l[row]; const float gl = sc[r];
        const float scl = (l > 0.f) ? __builtin_amdgcn_rcpf(l) / (1.0f + __expf(-gl)) : 0.f;
        float* ap = OACC + (size_t)tok * DM + h * 128 + L.r32;
#pragma unroll
        for (int d0 = 0; d0 < 4; ++d0) { float v = o[d0][r] * scl;
            if (MODE == 0) ap[d0 * 32] = v;
            else if (MODE == 1) ap[d0 * 32] = prev[d0][r] + v;
            else { v += prev[d0][r]; const float vn = dpp_xor1(v); if ((L.r32 & 1) == 0) *(unsigned*)(OATT + (size_t)tok * DM + h * 128 + d0 * 32 + L.r32) = fa::cvtpk(v, vn); } } }
    asm volatile("s_waitcnt lgkmcnt(0)" ::: "memory");
}

__device__ __forceinline__ void p3a_nsa_cmp(Frame& F, const Args& A) {
    unsigned char* ws = A.ws; const NsaLane L = nsa_lane(F);
    const bf16* P0 = (const bf16*)(ws + WS_P0); const bf16* KCB = (const bf16*)(ws + WS_KCMP); const bf16* VCB = (const bf16*)(ws + WS_VCMP);
    const float* GL = (const float*)(ws + WS_GL); float* OACC = (float*)(ws + WS_Z); unsigned* SELM = (unsigned*)(ws + WS_SELM);
    nsa_lut(F, A);
    LAS char* lds = (LAS char*)(F.lds + RING_OFF);
    LAS float* wsf = (LAS float*)(lds + fa::OFF_WS) + L.wid * 64; LAS float* li_l = wsf; LAS float* al_l = wsf + 32;
    const LAS float* lut = (const LAS float*)(lds + fa::OFF_LUT);
    LAS float* tab = (LAS float*)(lds + fa::OFF_TAB);
    for (int ui = 0; ui < 2 * ((512 - F.vcu + F.G - 1) / F.G); ++ui) {
        const int p = F.vcu + (ui >> 1) * F.G, bg = p >> 6, y = p & 63, qb = (ui & 1) ? 127 - y : y, b = bg >> 2, g = bg & 3;
        const int tok0 = b * SEQ + qb * 64;
        bf16x8 qr[8]; nsa_load_q(qr, P0, tok0, g, L);
        const int trow = qb * 64 + L.wid * 8 + L.ql;
        const int h = g * 4 + L.j; const LAS float* lutcol = lut + h * 144; const float bias_far = lutcol[128];
        const int nmaxrow = (trow >= 31) ? (trow - 31) >> 4 : -1;
        const int NT = (4 * qb + 3 + 63) >> 6;
        const bf16* Kg = KCB + (size_t)(b * 4 + g) * 512 * 128; const bf16* Vg = VCB + (size_t)(b * 4 + g) * 512 * 128;
        for (int i = F.tid; i < 64 * fa::TABLD; i += 512) tab[i] = 0.f;
        float m_reg = -1e30f, l_reg = 0.f;
        fa::Stage S;
        const int rem16 = (trow >= 31) ? ((trow - 31) & 15) : 0;
        fa::stage_load(S, Kg, Vg, 128, 0, 511, L.sr, L.sc); asm volatile("s_waitcnt vmcnt(0)" ::: "memory");
        fa::stage_write(S, lds + fa::OFF_K, lds + fa::OFF_V, L.kws, L.vst0, L.vst1);
        __syncthreads();
#pragma unroll 1
        for (int t = 0; t < NT; ++t) {
            const int buf = t & 1;
            if (t + 1 < NT) fa::stage_load(S, Kg, Vg, 128, (t + 1) * 64, 511, L.sr, L.sc);
            fa::f32x16 p0, p1;
            const bool farT = (qb * 64 + L.wid * 8) - 31 - 16 * (t * 64 + 63) >= 128;
            fa::qkt(p0, p1, lds + fa::OFF_K + buf * fa::SHM_K, L.r32, L.hi, qr, farT ? bias_far : 0.f);
            const int dq = nmaxrow - t * 64 - 4 * L.hi;
            if (!farT) fa::bias_near(p0, p1, dq, 16, lutcol + rem16);
            fa::mask_tile(p0, p1, dq, 0x40000000u);
            float alpha; fa::partialSM(p0, p1, m_reg, alpha);
            float ps = 0.f;
#pragma unroll
            for (int r = 0; r < 16; ++r) ps += p0[r] + p1[r];
            { auto rr = __builtin_amdgcn_permlane32_swap(__float_as_uint(ps), __float_as_uint(ps), false, false); ps = __uint_as_float(rr[0]) + __uint_as_float(rr[1]); }
            l_reg = l_reg * alpha + ps;
            if (t + 1 < NT) { asm volatile("s_waitcnt vmcnt(0)" ::: "memory"); fa::stage_write(S, lds + fa::OFF_K + (buf ^ 1) * fa::SHM_K, lds + fa::OFF_V + (buf ^ 1) * fa::SHM_V, L.kws, L.vst0, L.vst1); }
            __syncthreads();
        }
        fa::f32x16 o[4];
#pragma unroll
        for (int d = 0; d < 4; ++d)
#pragma unroll
            for (int r = 0; r < 16; ++r) o[d][r] = 0.f;
        fa::stage_load(S, Kg, Vg, 128, 0, 511, L.sr, L.sc); asm volatile("s_waitcnt vmcnt(0)" ::: "memory");
        fa::stage_write(S, lds + fa::OFF_K, lds + fa::OFF_V, L.kws, L.vst0, L.vst1);
        __syncthreads();
        const float inv_l = (l_reg > 0.f) ? 1.0f / l_reg : 0.f; const float mnL = -m_reg * fa::C2;
#pragma unroll 1
        for (int t = 0; t < NT; ++t) {
            const int buf = t & 1;
            if (t + 1 < NT) fa::stage_load(S, Kg, Vg, 128, (t + 1) * 64, 511, L.sr, L.sc);
            fa::f32x16 p0, p1;
            const bool farT = (qb * 64 + L.wid * 8) - 31 - 16 * (t * 64 + 63) >= 128;
            fa::qkt(p0, p1, lds + fa::OFF_K + buf * fa::SHM_K, L.r32, L.hi, qr, farT ? bias_far : 0.f);
            const int dq = nmaxrow - t * 64 - 4 * L.hi;
            if (!farT) fa::bias_near(p0, p1, dq, 16, lutcol + rem16);
            fa::mask_tile(p0, p1, dq, 0x40000000u);
#pragma unroll
            for (int r = 0; r < 16; ++r) { p0[r] = __builtin_amdgcn_exp2f(fmaf(p0[r], fa::C2, mnL)) * inv_l; p1[r] = __builtin_amdgcn_exp2f(fmaf(p1[r], fa::C2, mnL)) * inv_l; }
            LAS float* tb = tab + (L.wid * 8 + L.ql) * fa::TABLD + t * 16 + L.hi;
#pragma unroll
            for (int half = 0; half < 2; ++half)
#pragma unroll
                for (int gq = 0; gq < 4; ++gq) { const fa::f32x16& pp = half ? p1 : p0;
                    float s4 = pp[4 * gq] + pp[4 * gq + 1] + pp[4 * gq + 2] + 0.5f * pp[4 * gq + 3], cr = 0.5f * pp[4 * gq + 3];
                    s4 += dpp_xor1(s4); s4 += dpp_xor2(s4); cr += dpp_xor1(cr); cr += dpp_xor2(cr);
                    if (L.j == 0) { __hip_atomic_fetch_add(tb + half * 8 + 2 * gq, s4, __ATOMIC_RELAXED, __HIP_MEMORY_SCOPE_WORKGROUP); __hip_atomic_fetch_add(tb + half * 8 + 2 * gq + 1, cr, __ATOMIC_RELAXED, __HIP_MEMORY_SCOPE_WORKGROUP); } }
            bf16x8 a0, a1, a2, a3; (void)fa::finishSM(p0, p1, a0, a1, a2, a3);
            fa::pv_tile(o, (int)(uintptr_t)(lds + fa::OFF_V + buf * fa::SHM_V) + L.vrd, a0, a1, a2, a3);
            if (t + 1 < NT) { asm volatile("s_waitcnt vmcnt(0)" ::: "memory"); fa::stage_write(S, lds + fa::OFF_K + (buf ^ 1) * fa::SHM_K, lds + fa::OFF_V + (buf ^ 1) * fa::SHM_V, L.kws, L.vst0, L.vst1); }
            __syncthreads();
        }
        nsa_store<0>(o, (l_reg > 0.f) ? 1.0f : 0.f, li_l, GL, OACC, nullptr, tok0, g, 0, L);
        __syncthreads();
        {
            bool s0[8], s1[8];
            if (qb < 16) {
#pragma unroll
                for (int qi = 0; qi < 8; ++qi) { s0[qi] = (L.lane <= qb); s1[qi] = false; }
            } else {
                unsigned k0[8], k1[8], lo[8];
#pragma unroll
                for (int qi = 0; qi < 8; ++qi) { const int ql = L.wid * 8 + qi;
                    const bool c0 = (L.lane >= 1 && L.lane <= qb - 2), c1 = (L.lane + 64 <= qb - 2);
                    k0[qi] = c0 ? __float_as_uint(tab[ql * fa::TABLD + L.lane]) + 1u : 0u; k1[qi] = c1 ? __float_as_uint(tab[ql * fa::TABLD + L.lane + 64]) + 1u : 0u;
                    s0[qi] = (L.lane == 0) || (L.lane == qb) || (L.lane == qb - 1); s1[qi] = (L.lane + 64 == qb) || (L.lane + 64 == qb - 1); lo[qi] = 0u; }
#pragma unroll 1
                for (int bit = 30; bit >= 0; --bit) {
#pragma unroll
                    for (int qi = 0; qi < 8; ++qi) { const unsigned cand = lo[qi] | (1u << bit);
                        const int cnt = __popcll(__ballot(k0[qi] >= cand)) + __popcll(__ballot(k1[qi] >= cand));
                        lo[qi] = (cnt >= 13) ? cand : lo[qi]; } }
#pragma unroll
                for (int qi = 0; qi < 8; ++qi) { const unsigned T = lo[qi];
                    const bool g0 = k0[qi] > T, g1 = k1[qi] > T, e0 = k0[qi] == T, e1 = k1[qi] == T;
                    const int need = 13 - (__popcll(__ballot(g0)) + __popcll(__ballot(g1)));
                    const unsigned long long be0 = __ballot(e0), be1 = __ballot(e1);
                    const int r0 = (int)__builtin_amdgcn_mbcnt_hi((unsigned)(be0 >> 32), __builtin_amdgcn_mbcnt_lo((unsigned)be0, 0u));
                    const int r1 = __popcll(be0) + (int)__builtin_amdgcn_mbcnt_hi((unsigned)(be1 >> 32), __builtin_amdgcn_mbcnt_lo((unsigned)be1, 0u));
                    s0[qi] = s0[qi] || g0 || (e0 && r0 < need); s1[qi] = s1[qi] || g1 || (e1 && r1 < need); }
            }
#pragma unroll
            for (int qi = 0; qi < 8; ++qi) { const int ql = L.wid * 8 + qi; const unsigned long long b0 = __ballot(s0[qi]), b1 = __ballot(s1[qi]);
                if (L.lane == 0) { uint4 mv; mv.x = (unsigned)b0; mv.y = (unsigned)(b0 >> 32); mv.z = (unsigned)b1; mv.w = (unsigned)(b1 >> 32); *(uint4*)(SELM + ((size_t)(tok0 + ql) * 4 + g) * 4) = mv; } }
        }
        __syncthreads();
    }
}
__device__ __forceinline__ void p3b_nsa_sel(Frame& F, const Args& A) {
    unsigned char* ws = A.ws; const NsaLane L = nsa_lane(F);
    const bf16* P0 = (const bf16*)(ws + WS_P0); const float* GL = (const float*)(ws + WS_GL); float* OACC = (float*)(ws + WS_Z); const unsigned* SELM = (const unsigned*)(ws + WS_SELM);
    nsa_lut(F, A);
    LAS char* lds = (LAS char*)(F.lds + RING_OFF);
    LAS float* wsf = (LAS float*)(lds + fa::OFF_WS) + L.wid * 64; LAS float* li_l = wsf; LAS float* al_l = wsf + 32;
    const LAS float* lut = (const LAS float*)(lds + fa::OFF_LUT);
    for (int ui = 0; ui < 2 * ((512 - F.vcu + F.G - 1) / F.G); ++ui) {
        const int p = F.vcu + (ui >> 1) * F.G, bg = p >> 6, y = p & 63, qb = (ui & 1) ? 127 - y : y, b = bg >> 2, g = bg & 3;
        const int tok0 = b * SEQ + qb * 64;
        bf16x8 qr[8]; nsa_load_q(qr, P0, tok0, g, L);
        const int trow = qb * 64 + L.wid * 8 + L.ql;
        const int h = g * 4 + L.j; const LAS float* lutcol = lut + h * 144; const float bias_far = lutcol[128];
        const uint4 mv = *(const uint4*)(SELM + ((size_t)(tok0 + L.wid * 8 + L.ql) * 4 + g) * 4);
        const bf16* Kg = P0 + (size_t)b * SEQ * P0LD + COL_KS + g * 128; const bf16* Vg = P0 + (size_t)b * SEQ * P0LD + COL_VS + g * 128;
        const int NT = qb + 1;
        float m_reg = -1e30f, l_reg = 0.f; fa::f32x16 o[4];
#pragma unroll
        for (int d = 0; d < 4; ++d)
#pragma unroll
            for (int r = 0; r < 16; ++r) o[d][r] = 0.f;
        fa::Stage S;
        fa::stage_load(S, Kg, Vg, P0LD, 0, SEQ - 1, L.sr, L.sc); asm volatile("s_waitcnt vmcnt(0)" ::: "memory");
        fa::stage_write(S, lds + fa::OFF_K, lds + fa::OFF_V, L.kws, L.vst0, L.vst1);
        __syncthreads();
#pragma unroll 1
        for (int t = 0; t < NT; ++t) {
            const int buf = t & 1;
            if (t + 1 < NT) fa::stage_load(S, Kg, Vg, P0LD, (t + 1) * 64, SEQ - 1, L.sr, L.sc);
            const unsigned word = (t < 32) ? mv.x : (t < 64) ? mv.y : (t < 96) ? mv.z : mv.w;
            const bool mine = ((word >> (t & 31)) & 1u) != 0u;
            if (__any(mine)) {
            fa::f32x16 p0, p1;
            const bool farT = (qb * 64 + L.wid * 8) - (t * 64 + 63) >= 128;
            fa::qkt(p0, p1, lds + fa::OFF_K + buf * fa::SHM_K, L.r32, L.hi, qr, farT ? bias_far : 0.f);
            const int dq = trow - t * 64 - 4 * L.hi;
            if (!farT) fa::bias_near(p0, p1, dq, 1, lutcol);
            fa::mask_all(p0, p1, mine);
            if (t == qb) fa::mask_tile(p0, p1, dq, 0x40000000u);
            float alpha; fa::partialSM(p0, p1, m_reg, alpha);
            fa::rescale(o, alpha, al_l, L.r32, L.hi);
            bf16x8 a0, a1, a2, a3; const float ps = fa::finishSM(p0, p1, a0, a1, a2, a3); l_reg = l_reg * alpha + ps;
            fa::pv_tile(o, (int)(uintptr_t)(lds + fa::OFF_V + buf * fa::SHM_V) + L.vrd, a0, a1, a2, a3);
            }
            if (t + 1 < NT) { asm volatile("s_waitcnt vmcnt(0)" ::: "memory"); fa::stage_write(S, lds + fa::OFF_K + (buf ^ 1) * fa::SHM_K, lds + fa::OFF_V + (buf ^ 1) * fa::SHM_V, L.kws, L.vst0, L.vst1); }
            __syncthreads();
        }
        nsa_store<1>(o, l_reg, li_l, GL, OACC, nullptr, tok0, g, 1, L);
        __syncthreads();
    }
}
__device__ __forceinline__ void p3c_nsa_win(Frame& F, const Args& A) {
    unsigned char* ws = A.ws; const NsaLane L = nsa_lane(F);
    const bf16* P0 = (const bf16*)(ws + WS_P0); const float* GL = (const float*)(ws + WS_GL); float* OACC = (float*)(ws + WS_Z); bf16* OATT = (bf16*)(ws + WS_OATT0);
    nsa_lut(F, A);
    LAS char* lds = (LAS char*)(F.lds + RING_OFF);
    LAS float* wsf = (LAS float*)(lds + fa::OFF_WS) + L.wid * 64; LAS float* li_l = wsf; LAS float* al_l = wsf + 32;
    const LAS float* lut = (const LAS float*)(lds + fa::OFF_LUT);
    for (int u = F.vcu; u < 1024; u += F.G) {
        const int bg = u >> 7, qb = u & 127, b = bg >> 2, g = bg & 3;
        const int tok0 = b * SEQ + qb * 64;
        bf16x8 qr[8]; nsa_load_q(qr, P0, tok0, g, L);
        const int trow = qb * 64 + L.wid * 8 + L.ql;
        const int h = g * 4 + L.j; const LAS float* lutcol = lut + h * 144; const float bias_far = lutcol[128];
        const bf16* Kg = P0 + (size_t)b * SEQ * P0LD + COL_KW + g * 128; const bf16* Vg = P0 + (size_t)b * SEQ * P0LD + COL_VW + g * 128;
        const int t0 = max(0, qb - 8), NT = qb - t0 + 1;
        float m_reg = -1e30f, l_reg = 0.f; fa::f32x16 o[4];
#pragma unroll
        for (int d = 0; d < 4; ++d)
#pragma unroll
            for (int r = 0; r < 16; ++r) o[d][r] = 0.f;
        fa::Stage S;
        fa::stage_load(S, Kg, Vg, P0LD, t0 * 64, SEQ - 1, L.sr, L.sc); asm volatile("s_waitcnt vmcnt(0)" ::: "memory");
        fa::stage_write(S, lds + fa::OFF_K, lds + fa::OFF_V, L.kws, L.vst0, L.vst1);
        __syncthreads();
#pragma unroll 1
        for (int tt = 0; tt < NT; ++tt) {
            const int buf = tt & 1, t = t0 + tt;
            if (tt + 1 < NT) fa::stage_load(S, Kg, Vg, P0LD, (t + 1) * 64, SEQ - 1, L.sr, L.sc);
            fa::f32x16 p0, p1;
            const bool farT = (qb * 64 + L.wid * 8) - (t * 64 + 63) >= 128;
            fa::qkt(p0, p1, lds + fa::OFF_K + buf * fa::SHM_K, L.r32, L.hi, qr, farT ? bias_far : 0.f);
            const int dq = trow - t * 64 - 4 * L.hi;
            if (!farT) fa::bias_near(p0, p1, dq, 1, lutcol);
            if (t == qb || t == t0) fa::mask_tile(p0, p1, dq, 512u);
            float alpha; fa::partialSM(p0, p1, m_reg, alpha);
            fa::rescale(o, alpha, al_l, L.r32, L.hi);
            bf16x8 a0, a1, a2, a3; const float ps = fa::finishSM(p0, p1, a0, a1, a2, a3); l_reg = l_reg * alpha + ps;
            fa::pv_tile(o, (int)(uintptr_t)(lds + fa::OFF_V + buf * fa::SHM_V) + L.vrd, a0, a1, a2, a3);
            if (tt + 1 < NT) { asm volatile("s_waitcnt vmcnt(0)" ::: "memory"); fa::stage_write(S, lds + fa::OFF_K + (buf ^ 1) * fa::SHM_K, lds + fa::OFF_V + (buf ^ 1) * fa::SHM_V, L.kws, L.vst0, L.vst1); }
            __syncthreads();
        }
        nsa_store<2>(o, l_reg, li_l, GL, OACC, OATT, tok0, g, 2, L);
        __syncthreads();
    }
}

template <bool ROUTE, bool F8 = false>
__device__ __forceinline__ void ln_phase(Frame& F, const Args& A, const float* Z, const float* gam, const float* bet, float* XF, bf16* XB) {
    const int gw = F.vcu * NWAVES + F.wave, NGW = F.G * NWAVES, lane = F.lane;
    LAS float* wrl = (LAS float*)(F.lds + RING_OFF);
    if (ROUTE) { for (int i = F.tid; i < DM * 8 / 4; i += 512) *(LAS f32x4*)(wrl + i * 4) = *(const f32x4*)(A.in[18] + i * 4); __syncthreads(); }
    for (int row = gw; row < NTOK; row += NGW) {
        const f32x4* zr = (const f32x4*)(Z + (size_t)row * DM) + lane;
        f32x4 v[8]; float s = 0.f;
#pragma unroll
        for (int j = 0; j < 8; ++j) { v[j] = zr[64 * j]; s += (v[j][0] + v[j][1]) + (v[j][2] + v[j][3]); }
        const float mean = wave_sum(s) * (1.f / DM); float s2 = 0.f;
#pragma unroll
        for (int j = 0; j < 8; ++j) { v[j] = v[j] - mean; s2 += (v[j][0] * v[j][0] + v[j][1] * v[j][1]) + (v[j][2] * v[j][2] + v[j][3] * v[j][3]); }
        const float rstd = 1.f / sqrtf(wave_sum(s2) * (1.f / DM) + LN_EPS);
        float lg[8];
#pragma unroll
        for (int e = 0; e < 8; ++e) lg[e] = 0.f;
#pragma unroll
        for (int j = 0; j < 8; ++j) { const int c = 4 * lane + 256 * j; const f32x4 gg = *(const f32x4*)(gam + c), bb = *(const f32x4*)(bet + c);
            const f32x4 x = v[j] * rstd * gg + bb;
            *(f32x4*)(XF + (size_t)row * DM + c) = x;
            if (F8) { int w = __builtin_amdgcn_cvt_pk_fp8_f32(x[0], x[1], 0, false); w = __builtin_amdgcn_cvt_pk_fp8_f32(x[2], x[3], w, true); *(int*)((unsigned char*)XB + (size_t)row * DM + c) = w; }
            else { uint2 o; o.x = pk2(x[0], x[1]); o.y = pk2(x[2], x[3]); *(uint2*)(XB + (size_t)row * DM + c) = o; }
            asm volatile("" ::: "memory");
            if (ROUTE) { const LAS float* wr = wrl + c * 8;
#pragma unroll
                for (int q = 0; q < 4; ++q) { const f32x4 w0 = *(const LAS f32x4*)(wr + q * 8), w1 = *(const LAS f32x4*)(wr + q * 8 + 4);
                    lg[0] += x[q] * w0[0]; lg[1] += x[q] * w0[1]; lg[2] += x[q] * w0[2]; lg[3] += x[q] * w0[3]; lg[4] += x[q] * w1[0]; lg[5] += x[q] * w1[1]; lg[6] += x[q] * w1[2]; lg[7] += x[q] * w1[3]; }  asm volatile("" ::: "memory"); }
        }
        if (ROUTE) {
#pragma unroll
            for (int e = 0; e < 8; ++e) lg[e] = wave_sum(lg[e]) + A.in[19][e];
            int e0 = 0; float l0 = lg[0];
#pragma unroll
            for (int e = 1; e < 8; ++e) if (lg[e] > l0) { l0 = lg[e]; e0 = e; }
            int e1 = -1; float l1 = -3e38f;
#pragma unroll
            for (int e = 0; e < 8; ++e) if (e != e0 && lg[e] > l1) { l1 = lg[e]; e1 = e; }
            const float w0 = 1.0f / (1.0f + __expf(l1 - l0)), w1 = 1.0f - w0;
            if (lane == 0) {
                const unsigned p0 = __hip_atomic_fetch_add((unsigned*)(F.ctl + CW_MOECNT + 64 * e0), 1u, __ATOMIC_RELAXED, __HIP_MEMORY_SCOPE_AGENT);
                const unsigned p1 = __hip_atomic_fetch_add((unsigned*)(F.ctl + CW_MOECNT + 64 * e1), 1u, __ATOMIC_RELAXED, __HIP_MEMORY_SCOPE_AGENT);
                int* re = (int*)(A.ws + WS_ROUTE); int* rp = re + 2 * NTOK; float* rw = (float*)(rp + 2 * NTOK);
                re[2 * row] = e0; re[2 * row + 1] = e1; rp[2 * row] = (int)p0; rp[2 * row + 1] = (int)p1; rw[2 * row] = w0; rw[2 * row + 1] = w1;
            }
        }
    }
}

__device__ __forceinline__ void ln_route_phase(Frame& F, const Args& A, const float* Z, const float* gam, const float* bet, float* XF, bf16* XB) {
    const int gw = F.vcu * NWAVES + F.wave, NGW = F.G * NWAVES, lane = F.lane;
    LAS float* wrl = (LAS float*)(F.lds + RING_OFF);
    LAS float* rowb = (LAS float*)(F.lds + RING_OFF + 65536 + F.wave * 8192);
    for (int i = F.tid; i < DM * 8 / 4; i += 512) *(LAS f32x4*)(wrl + i * 4) = *(const f32x4*)(A.in[18] + i * 4);
    __syncthreads();
    for (int row = gw; row < NTOK; row += NGW) {
        float s = 0.f, s2 = 0.f;
#pragma unroll 1
        for (int j = 0; j < 8; ++j) { const f32x4 v = *(const f32x4*)(Z + (size_t)row * DM + 4 * lane + 256 * j); *(LAS f32x4*)(rowb + 4 * lane + 256 * j) = v;
            s += (v[0] + v[1]) + (v[2] + v[3]); }
        const float mean = wave_sum(s) * (1.f / DM);
#pragma unroll 1
        for (int j = 0; j < 8; ++j) { const f32x4 v = *(const LAS f32x4*)(rowb + 4 * lane + 256 * j) - mean; s2 += (v[0] * v[0] + v[1] * v[1]) + (v[2] * v[2] + v[3] * v[3]); }
        const float rstd = 1.f / sqrtf(wave_sum(s2) * (1.f / DM) + LN_EPS);
        float lg[8];
#pragma unroll
        for (int e = 0; e < 8; ++e) lg[e] = 0.f;
#pragma unroll 1
        for (int j = 0; j < 8; ++j) { const int c = 4 * lane + 256 * j; const f32x4 gg = *(const f32x4*)(gam + c), bb = *(const f32x4*)(bet + c);
            const f32x4 x = (*(const LAS f32x4*)(rowb + c) - mean) * rstd * gg + bb;
            *(f32x4*)(XF + (size_t)row * DM + c) = x;
            const LAS float* wr = wrl + c * 8;
#pragma unroll
            for (int q = 0; q < 4; ++q) { const f32x4 w0 = *(const LAS f32x4*)(wr + q * 8), w1 = *(const LAS f32x4*)(wr + q * 8 + 4);
                lg[0] += x[q] * w0[0]; lg[1] += x[q] * w0[1]; lg[2] += x[q] * w0[2]; lg[3] += x[q] * w0[3]; lg[4] += x[q] * w1[0]; lg[5] += x[q] * w1[1]; lg[6] += x[q] * w1[2]; lg[7] += x[q] * w1[3]; } }
#pragma unroll
        for (int e = 0; e < 8; ++e) lg[e] = wave_sum(lg[e]) + A.in[19][e];
        int e0 = 0; float l0 = lg[0];
#pragma unroll
        for (int e = 1; e < 8; ++e) if (lg[e] > l0) { l0 = lg[e]; e0 = e; }
        int e1 = -1; float l1 = -3e38f;
#pragma unroll
        for (int e = 0; e < 8; ++e) if (e != e0 && lg[e] > l1) { l1 = lg[e]; e1 = e; }
        const float w0 = 1.0f / (1.0f + __expf(l1 - l0)), w1 = 1.0f - w0;
        if (lane == 0) {
            const unsigned p0 = __hip_atomic_fetch_add((unsigned*)(F.ctl + CW_MOECNT + 64 * e0), 1u, __ATOMIC_RELAXED, __HIP_MEMORY_SCOPE_AGENT);
            const unsigned p1 = __hip_atomic_fetch_add((unsigned*)(F.ctl + CW_MOECNT + 64 * e1), 1u, __ATOMIC_RELAXED, __HIP_MEMORY_SCOPE_AGENT);
            int* re = (int*)(A.ws + WS_ROUTE); int* rp = re + 2 * NTOK; float* rw = (float*)(rp + 2 * NTOK);
            re[2 * row] = e0; re[2 * row + 1] = e1; rp[2 * row] = (int)p0; rp[2 * row + 1] = (int)p1; rw[2 * row] = w0; rw[2 * row + 1] = w1;
        }
        WSYNC();
    }
    __syncthreads();
}

__device__ __forceinline__ void p10_dsa_prep(Frame& F, const Args& A) {
    unsigned char* ws = A.ws; const int lane = F.lane;
    const int gw = F.vcu * NWAVES + F.wave, NGW = F.G * NWAVES;
    { const float* CR = (const float*)(ws + WS_CRAW); bf16* CN = (bf16*)(ws + WS_CN); const f32x4 gg = *(const f32x4*)(A.in[11] + 4 * lane);
      for (int row = gw; row < NTOK; row += NGW) { const f32x4 v = *(const f32x4*)(CR + (size_t)row * KVR + 4 * lane);
          const float ss = wave_sum(v[0] * v[0] + v[1] * v[1] + v[2] * v[2] + v[3] * v[3]); const float r = 1.f / sqrtf(ss * (1.f / KVR) + RMS_EPS);
          uint2 o; o.x = pk2(v[0] * r * gg[0], v[1] * r * gg[1]); o.y = pk2(v[2] * r * gg[2], v[3] * r * gg[3]); *(uint2*)(CN + (size_t)row * KVR + 4 * lane) = o;
          if (lane < 16) { const f32x4 kv = *(const f32x4*)((const float*)(ws + WS_KIWI) + (size_t)row * 128 + 4 * lane); uint2 k2; k2.x = pk2(kv[0], kv[1]); k2.y = pk2(kv[2], kv[3]); *(uint2*)((bf16*)(ws + WS_KIB) + (size_t)row * 64 + 4 * lane) = k2; } } }
    const bf16* Q = (const bf16*)(ws + WS_Q); const bf16* UKT = (const bf16*)(ws + WS_W_UK); bf16* QL = (bf16*)(ws + WS_QLAT);
    const int r16 = lane & 15, kq = lane >> 4; const float sc = 0.08838834764831845f;
    for (int it = gw; it < 512 * 16 * 4; it += NGW) {
        const int nc = it & 3, h = (it >> 2) & 15, mt = it >> 6;
        f32x4 acc[2][4];
#pragma unroll
        for (int m = 0; m < 2; ++m)
#pragma unroll
            for (int n = 0; n < 4; ++n) acc[m][n] = (f32x4){0.f, 0.f, 0.f, 0.f};
#pragma unroll
        for (int ks = 0; ks < 4; ++ks) { s8v af[2], bfr[4];
#pragma unroll
            for (int m = 0; m < 2; ++m) af[m] = ld_frag(Q + (size_t)(mt * 32 + m * 16 + r16) * DM + h * 128 + ks * 32 + kq * 8);
#pragma unroll
            for (int n = 0; n < 4; ++n) bfr[n] = ld_frag(UKT + ((size_t)h * 256 + nc * 64 + n * 16 + r16) * 128 + ks * 32 + kq * 8);
#pragma unroll
            for (int m = 0; m < 2; ++m)
#pragma unroll
                for (int n = 0; n < 4; ++n) acc[m][n] = __builtin_amdgcn_mfma_f32_16x16x32_bf16(bfr[n], af[m], acc[m][n], 0, 0, 0); }
#pragma unroll
        for (int m = 0; m < 2; ++m)
#pragma unroll
            for (int n = 0; n < 4; ++n) { uint2 o; o.x = pg8::cvt_pk_bf16(acc[m][n][0] * sc, acc[m][n][1] * sc); o.y = pg8::cvt_pk_bf16(acc[m][n][2] * sc, acc[m][n][3] * sc);
                *(uint2*)(QL + (size_t)(mt * 32 + m * 16 + r16) * 4096 + h * 256 + nc * 64 + n * 16 + kq * 4) = o; }
    }
}
__device__ __forceinline__ void p12_dsa_uv(Frame& F, const Args& A) {
    unsigned char* ws = A.ws; const int lane = F.lane;
    const int gw = F.vcu * NWAVES + F.wave, NGW = F.G * NWAVES;
    const bf16* OL = (const bf16*)(ws + WS_OLAT); const bf16* UVT = (const bf16*)(ws + WS_W_UV); bf16* O = (bf16*)(ws + WS_OATT1);
    const int r16 = lane & 15, kq = lane >> 4;
    for (int it = gw; it < 512 * 16 * 2; it += NGW) {
        const int nc = it & 1, h = (it >> 1) & 15, mt = it >> 5;
        f32x4 acc[2][4];
#pragma unroll
        for (int m = 0; m < 2; ++m)
#pragma unroll
            for (int n = 0; n < 4; ++n) acc[m][n] = (f32x4){0.f, 0.f, 0.f, 0.f};
#pragma unroll
        for (int ks = 0; ks < 8; ++ks) { s8v af[2], bfr[4];
#pragma unroll
            for (int m = 0; m < 2; ++m) af[m] = ld_frag(OL + (size_t)(mt * 32 + m * 16 + r16) * 4096 + h * 256 + ks * 32 + kq * 8);
#pragma unroll
            for (int n = 0; n < 4; ++n) bfr[n] = ld_frag(UVT + ((size_t)h * 128 + nc * 64 + n * 16 + r16) * 256 + ks * 32 + kq * 8);
#pragma unroll
            for (int m = 0; m < 2; ++m)
#pragma unroll
                for (int n = 0; n < 4; ++n) acc[m][n] = __builtin_amdgcn_mfma_f32_16x16x32_bf16(bfr[n], af[m], acc[m][n], 0, 0, 0); }
#pragma unroll
        for (int m = 0; m < 2; ++m)
#pragma unroll
            for (int n = 0; n < 4; ++n) { uint2 o; o.x = pg8::cvt_pk_bf16(acc[m][n][0], acc[m][n][1]); o.y = pg8::cvt_pk_bf16(acc[m][n][2], acc[m][n][3]);
                *(uint2*)(O + (size_t)(mt * 32 + m * 16 + r16) * DM + h * 128 + nc * 64 + n * 16 + kq * 4) = o; }
    }
}

__device__ __forceinline__ unsigned f2key(float f) { const unsigned u = __float_as_uint(f); return (u & 0x80000000u) ? ~u : (u | 0x80000000u); }

__device__ __forceinline__ unsigned dsa_off_b(unsigned row, unsigned ch) { return 256u * row + 16u * (ch ^ (((row & 3) << 2) | ((row >> 2) & 3))); }

__device__ __forceinline__ float key2f(unsigned k) { return __uint_as_float((k & 0x80000000u) ? (k & 0x7fffffffu) : ~k); }
__device__ __forceinline__ void p13a_dsa_index(Frame& F, const Args& A) {
    unsigned char* ws = A.ws; const int lane = F.lane, wid = F.wave, r32 = lane & 31, hi = lane >> 5;
    const bf16* QI = (const bf16*)(ws + WS_QI); const bf16* KIB = (const bf16*)(ws + WS_KIB); const float* KIWI = (const float*)(ws + WS_KIWI); int* IDX = (int*)(ws + WS_IDX);
    LAS float* sc = (LAS float*)(F.lds + RING_OFF);
    LAS unsigned* hist = (LAS unsigned*)(F.lds + DSA_SCR);
    LAS unsigned* cntG = hist + 1024;
    LAS unsigned* cntE = cntG + 512;
    LAS unsigned* qm = cntE + 512;
    LAS float* mmx = (LAS float*)(qm + 64);
    LAS unsigned* candk = (LAS unsigned*)(mmx + 64);
    constexpr int CAP = 256;
    const int q = wid >> 1, sub = wid & 1, th = sub * 64 + lane;
    for (int slot = F.vcu; slot < NTOK / 4; slot += F.G) {
        const int rowi = slot >> 8; int cc = slot & 255; if (rowi & 1) cc = 255 - cc;
        const int tok0 = (rowi * 256 + cc) * 4, b = tok0 >> 13, t0 = tok0 & (SEQ - 1), tmax = t0 + 3;
        bf16x8 qa[4];
#pragma unroll
        for (int s = 0; s < 4; ++s) qa[s] = *(const bf16x8*)(QI + (size_t)(tok0 + (r32 >> 3)) * 512 + (r32 & 7) * 64 + 16 * s + 8 * hi);
        float wv[16];
#pragma unroll
        for (int r = 0; r < 16; ++r) wv[r] = KIWI[(size_t)(tok0 + (r >> 2)) * 128 + 64 + (r & 3) + 4 * hi] * 0.35355339059327373f;
        const int ntiles = (tmax >> 5) + 1;
        hist[q * 256 + th] = 0u; hist[q * 256 + 128 + th] = 0u; if (th == 0) qm[q * 16 + 2] = 0u;
        float mn0 = 3e38f, mx0 = -3e38f, mn1 = 3e38f, mx1 = -3e38f;
        {
            bf16x8 kb[4], kn[4]; int tile = wid;
#pragma unroll
            for (int s = 0; s < 4; ++s) { kb[s] = (bf16x8){0, 0, 0, 0, 0, 0, 0, 0}; kn[s] = kb[s]; }
            if (tile < ntiles) { const bf16* kp = KIB + (size_t)(b * SEQ + tile * 32 + r32) * 64 + 8 * hi;
#pragma unroll
                for (int s = 0; s < 4; ++s) kb[s] = *(const bf16x8*)(kp + 16 * s); }
            while (tile < ntiles) {
                const int tn = tile + 8;
                if (tn < ntiles) { const bf16* kp = KIB + (size_t)(b * SEQ + tn * 32 + r32) * 64 + 8 * hi;
#pragma unroll
                    for (int s = 0; s < 4; ++s) kn[s] = *(const bf16x8*)(kp + 16 * s); }
                const int key = tile * 32 + r32;
                fa::f32x16 acc;
#pragma unroll
                for (int r = 0; r < 16; ++r) acc[r] = 0.f;
#pragma unroll
                for (int s = 0; s < 4; ++s) acc = __builtin_amdgcn_mfma_f32_32x32x16_bf16(qa[s], kb[s], acc, 0, 0, 0);
                float tot[4];
#pragma unroll
                for (int qq = 0; qq < 4; ++qq) { float part = 0.f;
#pragma unroll
                    for (int r3 = 0; r3 < 4; ++r3) part += wv[4 * qq + r3] * fmaxf(acc[4 * qq + r3], 0.f);
                    tot[qq] = sum_xor32(part) + 0.0f; }
                const float ta = hi ? tot[2] : tot[0], tb = hi ? tot[3] : tot[1];
                sc[(2 * hi) * 8192 + key] = ta; sc[(2 * hi + 1) * 8192 + key] = tb;
                if (key <= t0 + 2 * hi) { mn0 = fminf(mn0, ta); mx0 = fmaxf(mx0, ta); }
                if (key <= t0 + 2 * hi + 1) { mn1 = fminf(mn1, tb); mx1 = fmaxf(mx1, tb); }
#pragma unroll
                for (int s = 0; s < 4; ++s) kb[s] = kn[s];
                tile = tn;
            }
        }
#pragma unroll
        for (int o = 1; o < 32; o <<= 1) { mn0 = fminf(mn0, __shfl_xor(mn0, o)); mx0 = fmaxf(mx0, __shfl_xor(mx0, o)); mn1 = fminf(mn1, __shfl_xor(mn1, o)); mx1 = fmaxf(mx1, __shfl_xor(mx1, o)); }
        if (r32 == 0) { mmx[(wid * 4 + 2 * hi) * 2] = mn0; mmx[(wid * 4 + 2 * hi) * 2 + 1] = mx0; mmx[(wid * 4 + 2 * hi + 1) * 2] = mn1; mmx[(wid * 4 + 2 * hi + 1) * 2 + 1] = mx1; }
        __syncthreads();
        const int tok = tok0 + q, n = t0 + q + 1;
        if (tmax + 1 <= TOPK) {
            for (int i = th; i < TOPK; i += 128) IDX[(size_t)tok * TOPK + i] = (i < n) ? i : 0;
        } else {
            const LAS float* scq = sc + q * 8192; const int nsl = (n + 127) >> 7;
            float fmn = 3e38f, fmx = -3e38f;
#pragma unroll
            for (int w = 0; w < 8; ++w) { fmn = fminf(fmn, mmx[(w * 4 + q) * 2]); fmx = fmaxf(fmx, mmx[(w * 4 + q) * 2 + 1]); }
            const float bsc = (fmx > fmn) ? 255.99f / (fmx - fmn) : 0.f;
            for (int s0 = 0; s0 < nsl; s0 += 8) { float v[8];
#pragma unroll
                for (int j = 0; j < 8; ++j) { const int i = (s0 + j) * 128 + th; v[j] = scq[min(i, n - 1)]; }
#pragma unroll
                for (int j = 0; j < 8; ++j) { const int i = (s0 + j) * 128 + th; const int bin = min(max((int)((v[j] - fmn) * bsc), 0), 255);
                    LAS unsigned* tgt = (i < n) ? &hist[q * 256 + bin] : &qm[q * 16 + 8];
                    __hip_atomic_fetch_add(tgt, 1u, __ATOMIC_RELAXED, __HIP_MEMORY_SCOPE_WORKGROUP); } }
            __syncthreads();
            if (sub == 0) {
                const v4u c4 = *(const LAS v4u*)(hist + q * 256 + 4 * lane); const unsigned s4 = c4.x + c4.y + c4.z + c4.w; unsigned S = s4;
#pragma unroll
                for (int o = 1; o < 64; o <<= 1) { const unsigned v = __shfl_down(S, o); if (lane + o < 64) S += v; }
                const unsigned above = S - s4;
                if (above < (unsigned)TOPK && (unsigned)TOPK <= S) { unsigned cum = above; int bin;
                    if (cum + c4.w >= (unsigned)TOPK) bin = 3; else { cum += c4.w; if (cum + c4.z >= (unsigned)TOPK) bin = 2; else { cum += c4.z; if (cum + c4.y >= (unsigned)TOPK) bin = 1; else { cum += c4.y; bin = 0; } } }
                    qm[q * 16 + 0] = (unsigned)(4 * lane + bin); qm[q * 16 + 1] = (unsigned)TOPK - cum; }
            }
            __syncthreads();
            const int bstar = (int)qm[q * 16 + 0]; const unsigned need1 = qm[q * 16 + 1];
            for (int s0 = 0; s0 < nsl; s0 += 8) { float v[8];
#pragma unroll
                for (int j = 0; j < 8; ++j) { const int i = (s0 + j) * 128 + th; v[j] = scq[min(i, n - 1)]; }
#pragma unroll
                for (int j = 0; j < 8; ++j) { const int i = (s0 + j) * 128 + th; const int bin = min(max((int)((v[j] - fmn) * bsc), 0), 255);
                    if (i < n && bin == bstar) { const unsigned pc = __hip_atomic_fetch_add(&qm[q * 16 + 2], 1u, __ATOMIC_RELAXED, __HIP_MEMORY_SCOPE_WORKGROUP); if (pc < (unsigned)CAP) candk[q * CAP + pc] = f2key(v[j]); } } }
            __syncthreads();
            if (sub == 0) {
                const unsigned mc = qm[q * 16 + 2]; unsigned T = 0u, nt = 0u; bool found = false;
                if (mc <= (unsigned)CAP) {
                    unsigned kc[4], gt[4], ge[4];
#pragma unroll
                    for (int c = 0; c < 4; ++c) { kc[c] = (lane + 64 * c < (int)mc) ? candk[q * CAP + lane + 64 * c] : 0u; gt[c] = 0u; ge[c] = 0u; }
                    for (unsigned j = 0; j < mc; ++j) { const unsigned kj = candk[q * CAP + j];
#pragma unroll
                        for (int c = 0; c < 4; ++c) { gt[c] += (kj > kc[c]) ? 1u : 0u; ge[c] += (kj >= kc[c]) ? 1u : 0u; } }
#pragma unroll
                    for (int c = 0; c < 4; ++c) if (lane + 64 * c < (int)mc && gt[c] < need1 && need1 <= ge[c]) { T = kc[c]; nt = need1 - gt[c]; found = true; }
                } else {
                    unsigned lo = 0u;
                    for (int bit = 31; bit >= 0; --bit) { const unsigned cand = lo | (1u << bit); unsigned c = 0u;
                        for (int i = lane; i < n; i += 64) c += (f2key(scq[i]) >= cand) ? 1u : 0u;
#pragma unroll
                        for (int o = 1; o < 64; o <<= 1) c += __shfl_xor(c, o);
                        if (c >= (unsigned)TOPK) lo = cand; }
                    unsigned cg = 0u;
                    for (int i = lane; i < n; i += 64) cg += (f2key(scq[i]) > lo) ? 1u : 0u;
#pragma unroll
                    for (int o = 1; o < 64; o <<= 1) cg += __shfl_xor(cg, o);
                    T = lo; nt = (unsigned)TOPK - cg; found = (lane == 0);
                }
                if (found) { qm[q * 16 + 0] = T; qm[q * 16 + 1] = nt; }
            }
            __syncthreads();
            const unsigned T = qm[q * 16 + 0], need = qm[q * 16 + 1];
            unsigned myG = 0u, myE = 0u;
            for (int s0 = 0; s0 < nsl; s0 += 8) { float v[8];
#pragma unroll
                for (int j = 0; j < 8; ++j) { const int i = (s0 + j) * 128 + th; v[j] = scq[min(i, n - 1)]; }
#pragma unroll
                for (int j = 0; j < 8; ++j) { const int s2 = s0 + j, i = s2 * 128 + th; const bool ok = i < n; const unsigned k = f2key(v[j]); const unsigned long long bg = __ballot(ok && k > T), be = __ballot(ok && k == T);
                    const unsigned cg = (unsigned)__popcll(bg), ce = (unsigned)__popcll(be); myG = (lane == s2) ? cg : myG; myE = (lane == s2) ? ce : myE; } }
            cntG[(q * 2 + sub) * 64 + lane] = myG; cntE[(q * 2 + sub) * 64 + lane] = myE;
            __syncthreads();
            unsigned tbase, pbase;
            { const unsigned e0 = cntE[(q * 2) * 64 + lane], e1 = cntE[(q * 2 + 1) * 64 + lane], g0 = cntG[(q * 2) * 64 + lane], g1 = cntG[(q * 2 + 1) * 64 + lane];
              unsigned inc = e0 + e1;
#pragma unroll
              for (int o = 1; o < 64; o <<= 1) { const unsigned v = __shfl_up(inc, o); if (lane >= o) inc += v; }
              const unsigned tb0 = inc - (e0 + e1), tb1 = tb0 + e0;
              const unsigned se0 = (need > tb0) ? min(need - tb0, e0) : 0u, se1 = (need > tb1) ? min(need - tb1, e1) : 0u;
              const unsigned c0 = g0 + se0, c1 = g1 + se1; unsigned inc2 = c0 + c1;
#pragma unroll
              for (int o = 1; o < 64; o <<= 1) { const unsigned v = __shfl_up(inc2, o); if (lane >= o) inc2 += v; }
              const unsigned pb0 = inc2 - (c0 + c1);
              tbase = sub ? tb1 : tb0; pbase = sub ? pb0 + c0 : pb0; }
            for (int s0 = 0; s0 < nsl; s0 += 8) { float v[8];
#pragma unroll
                for (int j = 0; j < 8; ++j) { const int i = (s0 + j) * 128 + th; v[j] = scq[min(i, n - 1)]; }
#pragma unroll
                for (int j = 0; j < 8; ++j) { const int s2 = s0 + j; if (s2 < nsl) { const int i = s2 * 128 + th; const bool ok = i < n; const unsigned k = f2key(v[j]); const bool g = ok && k > T, e = ok && k == T;
                    const unsigned long long be = __ballot(e);
                    const unsigned trank = (unsigned)__builtin_amdgcn_readlane((int)tbase, s2) + __builtin_amdgcn_mbcnt_hi((unsigned)(be >> 32), __builtin_amdgcn_mbcnt_lo((unsigned)be, 0u));
                    const bool sel = g || (e && trank < need);
                    const unsigned long long bs = __ballot(sel);
                    const unsigned pos = (unsigned)__builtin_amdgcn_readlane((int)pbase, s2) + __builtin_amdgcn_mbcnt_hi((unsigned)(bs >> 32), __builtin_amdgcn_mbcnt_lo((unsigned)bs, 0u));
                    if (sel && pos < (unsigned)TOPK) IDX[(size_t)tok * TOPK + pos] = i; } } }
        }
        __syncthreads();
    }
}

__device__ __forceinline__ void p13b_dsa_attn(Frame& F, const Args& A) {
    unsigned char* ws = A.ws; const int lane = F.lane, wid = F.wave, c16 = lane & 15, g4 = lane >> 4;
    const bf16* CN = (const bf16*)(ws + WS_CN); const bf16* QL = (const bf16*)(ws + WS_QLAT); const int* IDX = (const int*)(ws + WS_IDX); bf16* OL = (bf16*)(ws + WS_OLAT);
    LAS float* lut = (LAS float*)(F.lds + DSA_SCR + 8192);
    for (int i = F.tid; i < 144 * 16; i += 512) { const int n = i >> 4, h = i & 15; lut[i] = A.in[1][rel_bucket(n) * 16 + h]; }
    __syncthreads();
    LAS char* img = (LAS char*)(F.lds + RING_OFF + wid * 16384);
    LAS int* idxw = (LAS int*)(F.lds + DSA_SCR + wid * 1024);
    const unsigned imgb = (unsigned)(uintptr_t)img;
    const int gw = F.vcu * NWAVES + wid, NGW = F.G * NWAVES;
    const unsigned prow0 = 8u * ((lane >> 2) & 3) + (lane & 3);
    unsigned ta0[8], ta1[8];
    { const unsigned qq = (lane & 15) >> 2, pp = lane & 3;
#pragma unroll
      for (int c = 0; c < 8; ++c) { ta0[c] = imgb + dsa_off_b(8 * g4 + qq, 2 * c + (pp >> 1)) + 8 * (pp & 1); ta1[c] = imgb + dsa_off_b(8 * g4 + 4 + qq, 2 * c + (pp >> 1)) + 8 * (pp & 1); } }
    for (int tok = gw; tok < NTOK; tok += NGW) {
        const int b = tok >> 13, t = tok & (SEQ - 1), cnt = min(TOPK, t + 1), ntile = (cnt + 31) >> 5;
        bf16x8 qb[8];
#pragma unroll
        for (int ks = 0; ks < 8; ++ks) qb[ks] = *(const bf16x8*)(QL + (size_t)tok * 4096 + c16 * 256 + ks * 32 + g4 * 8);
#pragma unroll
        for (int i = 0; i < 4; ++i) idxw[lane + 64 * i] = IDX[(size_t)tok * TOPK + lane + 64 * i];
        WSYNC();
        f32x4 o[16];
#pragma unroll
        for (int ct = 0; ct < 16; ++ct) o[ct] = (f32x4){0.f, 0.f, 0.f, 0.f};
        float m_run = -1e30f, l_run = 0.f;
        const LAS float* lutcol = lut + c16;
#pragma unroll 1
        for (int tile = 0; tile < ntile; ++tile) {
            { v4u st[16];
#pragma unroll
              for (int i = 0; i < 16; ++i) { const int nn = lane + 64 * i, row = nn >> 5, chg = nn & 31; const int key = idxw[tile * 32 + row];
                  st[i] = *(const v4u*)(CN + (size_t)(b * SEQ + key) * KVR + chg * 8); }
#pragma unroll
              for (int i = 0; i < 16; ++i) { const int nn = lane + 64 * i, row = nn >> 5, chg = nn & 31;
                  *(LAS v4u*)(img + (chg >> 4) * 8192 + dsa_off_b(row, chg & 15)) = st[i]; } }
            WSYNC();
            f32x4 sacc[2];
#pragma unroll
            for (int T = 0; T < 2; ++T) { sacc[T] = (f32x4){0.f, 0.f, 0.f, 0.f};
#pragma unroll
                for (int ks = 0; ks < 8; ++ks) { const bf16x8 a = *(const LAS bf16x8*)(img + (ks >> 2) * 8192 + dsa_off_b(prow0 + 4 * T, 4 * (ks & 3) + g4));
                    sacc[T] = __builtin_amdgcn_mfma_f32_16x16x32_bf16(a, qb[ks], sacc[T], 0, 0, 0); } }
            float pmax = -__builtin_inff();
#pragma unroll
            for (int T = 0; T < 2; ++T) { const int i0 = tile * 32 + 8 * g4 + 4 * T; const v4u kk = *(const LAS v4u*)(idxw + i0);
                const int kidx[4] = {(int)kk.x, (int)kk.y, (int)kk.z, (int)kk.w};
#pragma unroll
                for (int e = 0; e < 4; ++e) { const int dist = min(max(t - kidx[e], 0), 128); float s = sacc[T][e] + lutcol[dist * 16];
                    s = (i0 + e < cnt) ? s : -__builtin_inff(); sacc[T][e] = s; pmax = fmaxf(pmax, s); } }
            pmax = max_xor16(pmax); pmax = max_xor32(pmax);
            const float mn = fmaxf(m_run, pmax), alpha = __builtin_amdgcn_exp2f((m_run - mn) * fa::C2); m_run = mn;
            float ps = 0.f;
#pragma unroll
            for (int T = 0; T < 2; ++T)
#pragma unroll
                for (int e = 0; e < 4; ++e) { const float pv = __builtin_amdgcn_exp2f((sacc[T][e] - mn) * fa::C2); sacc[T][e] = pv; ps += pv; }
            ps = sum_xor16(ps); ps = sum_xor32(ps);
            l_run = l_run * alpha + ps;
            if (__any(alpha < 1.f)) {
                float al[4];
#pragma unroll
                for (int e = 0; e < 4; ++e) al[e] = __shfl(alpha, 4 * g4 + e);
#pragma unroll
                for (int ct = 0; ct < 16; ++ct)
#pragma unroll
                    for (int e = 0; e < 4; ++e) o[ct][e] *= al[e];
            }
            fa::u32x4v pw; pw.x = fa::cvtpk(sacc[0][0], sacc[0][1]); pw.y = fa::cvtpk(sacc[0][2], sacc[0][3]); pw.z = fa::cvtpk(sacc[1][0], sacc[1][1]); pw.w = fa::cvtpk(sacc[1][2], sacc[1][3]);
            const bf16x8 pa = *reinterpret_cast<bf16x8*>(&pw);
#pragma unroll
            for (int cg = 0; cg < 4; ++cg) { fa::s16x4 b0[4], b1[4];
                asm volatile("ds_read_b64_tr_b16 %0, %8 offset:%c16\n\tds_read_b64_tr_b16 %1, %9 offset:%c16\n\tds_read_b64_tr_b16 %2, %10 offset:%c16\n\tds_read_b64_tr_b16 %3, %11 offset:%c16\n\t"
                             "ds_read_b64_tr_b16 %4, %12 offset:%c16\n\tds_read_b64_tr_b16 %5, %13 offset:%c16\n\tds_read_b64_tr_b16 %6, %14 offset:%c16\n\tds_read_b64_tr_b16 %7, %15 offset:%c16\n\ts_waitcnt lgkmcnt(0)"
                             : "=&v"(b0[0]), "=&v"(b1[0]), "=&v"(b0[1]), "=&v"(b1[1]), "=&v"(b0[2]), "=&v"(b1[2]), "=&v"(b0[3]), "=&v"(b1[3])
                             : "v"(ta0[(cg & 1) * 4 + 0]), "v"(ta1[(cg & 1) * 4 + 0]), "v"(ta0[(cg & 1) * 4 + 1]), "v"(ta1[(cg & 1) * 4 + 1]), "v"(ta0[(cg & 1) * 4 + 2]), "v"(ta1[(cg & 1) * 4 + 2]), "v"(ta0[(cg & 1) * 4 + 3]), "v"(ta1[(cg & 1) * 4 + 3]), "i"((cg >> 1) * 8192) : "memory");
                FA_SBAR();
#pragma unroll
                for (int k = 0; k < 4; ++k) o[cg * 4 + k] = __builtin_amdgcn_mfma_f32_16x16x32_bf16(pa, (bf16x8){b0[k][0], b0[k][1], b0[k][2], b0[k][3], b1[k][0], b1[k][1], b1[k][2], b1[k][3]}, o[cg * 4 + k], 0, 0, 0); }
            WSYNC();
        }
        { const float il = (l_run > 0.f) ? 1.0f / l_run : 0.f; float ile[4];
#pragma unroll
          for (int e = 0; e < 4; ++e) ile[e] = __shfl(il, 4 * g4 + e);
#pragma unroll
          for (int ct = 0; ct < 16; ++ct)
#pragma unroll
              for (int e = 0; e < 4; ++e) { const float v = o[ct][e] * ile[e]; const float vn = dpp_xor1(v);
                  if ((lane & 1) == 0) *(unsigned*)(OL + (size_t)tok * 4096 + (4 * g4 + e) * 256 + ct * 16 + c16) = fa::cvtpk(v, vn); } }
        WSYNC();
    }
    __syncthreads();
}

struct MoeTiles { int tend[8]; int pstart[8]; int MT; };
__device__ __forceinline__ void moe_tiles(Frame& F, MoeTiles& T) {
    int acc = 0;
#pragma unroll
    for (int e = 0; e < 8; ++e) { const int c = (int)__builtin_amdgcn_readfirstlane(__hip_atomic_load((unsigned*)(F.ctl + CW_MOECNT + 64 * e), __ATOMIC_RELAXED, __HIP_MEMORY_SCOPE_AGENT));
        T.pstart[e] = acc * 256; acc += (c + 255) >> 8; T.tend[e] = acc; }
    T.MT = acc;
}
__device__ __forceinline__ void p15_gather(Frame& F, const Args& A) {
    MoeTiles T; moe_tiles(F, T);
    const int gw = F.vcu * NWAVES + F.wave, NGW = F.G * NWAVES, lane = F.lane;
    const float* XF = (const float*)(A.ws + WS_XF); unsigned char* XG = (unsigned char*)(A.ws + WS_XG);
    const int* re = (const int*)(A.ws + WS_ROUTE); const int* rp = re + 2 * NTOK;
    for (int tok = gw; tok < NTOK; tok += NGW) {
        v4u v[2];
#pragma unroll
        for (int j = 0; j < 2; ++j) { const float* src = XF + (size_t)tok * DM + 16 * lane + 1024 * j; int w[4];
#pragma unroll
            for (int q = 0; q < 4; ++q) { const f32x4 x = *(const f32x4*)(src + 4 * q); w[q] = __builtin_amdgcn_cvt_pk_fp8_f32(x[0], x[1], 0, false); w[q] = __builtin_amdgcn_cvt_pk_fp8_f32(x[2], x[3], w[q], true); }
            v[j].x = (unsigned)w[0]; v[j].y = (unsigned)w[1]; v[j].z = (unsigned)w[2]; v[j].w = (unsigned)w[3]; }
#pragma unroll
        for (int s = 0; s < 2; ++s) { const int e = re[2 * tok + s], p = rp[2 * tok + s]; int ps = 0;
#pragma unroll
            for (int q = 0; q < 8; ++q) ps = (q == e) ? T.pstart[q] : ps;
            unsigned char* dst = XG + (size_t)(ps + p) * DM + 16 * lane;
#pragma unroll
            for (int j = 0; j < 2; ++j) *(v4u*)(dst + 1024 * j) = v[j]; }
    }
}
__device__ __forceinline__ void p18_final(Frame& F, const Args& A) {
    MoeTiles T; moe_tiles(F, T);
    const int gw = F.vcu * NWAVES + F.wave, NGW = F.G * NWAVES, lane = F.lane;
    const float* XF = (const float*)(A.ws + WS_XF); const float* Y = (const float*)(A.ws + WS_Y);
    const int* re = (const int*)(A.ws + WS_ROUTE); const int* rp = re + 2 * NTOK; const float* rw = (const float*)(rp + 2 * NTOK);
    const float* gam = A.in[25] + DM; const float* bet = A.in[26] + DM;
    for (int tok = gw; tok < NTOK; tok += NGW) {
        int rows[2]; float w[2];
#pragma unroll
        for (int s = 0; s < 2; ++s) { const int e = re[2 * tok + s]; int ps = 0;
#pragma unroll
            for (int q = 0; q < 8; ++q) ps = (q == e) ? T.pstart[q] : ps;
            rows[s] = ps + rp[2 * tok + s]; w[s] = rw[2 * tok + s]; }
        const f32x4* xr = (const f32x4*)(XF + (size_t)tok * DM) + lane; const f32x4* y0 = (const f32x4*)(Y + (size_t)rows[0] * DM) + lane; const f32x4* y1 = (const f32x4*)(Y + (size_t)rows[1] * DM) + lane;
        f32x4 v[8]; float s = 0.f;
#pragma unroll
        for (int j = 0; j < 8; ++j) { v[j] = xr[64 * j] * ALPHA + y0[64 * j] * w[0] + y1[64 * j] * w[1]; s += (v[j][0] + v[j][1]) + (v[j][2] + v[j][3]); }
        const float mean = wave_sum(s) * (1.f / DM); float s2 = 0.f;
#pragma unroll
        for (int j = 0; j < 8; ++j) { v[j] = v[j] - mean; s2 += (v[j][0] * v[j][0] + v[j][1] * v[j][1]) + (v[j][2] * v[j][2] + v[j][3] * v[j][3]); }
        const float rstd = 1.f / sqrtf(wave_sum(s2) * (1.f / DM) + LN_EPS);
#pragma unroll
        for (int j = 0; j < 8; ++j) { const int c = 4 * lane + 256 * j; const f32x4 gg = *(const f32x4*)(gam + c), bb = *(const f32x4*)(bet + c);
            *(f32x4*)(A.out + (size_t)tok * DM + c) = v[j] * rstd * gg + bb; }
    }
}

__global__ void __launch_bounds__(NWAVES * 64, 2) mega_fwd(Args args) {
    extern __shared__ __attribute__((aligned(16))) unsigned char lds[];
    Frame F;
    F.lds = (LAS unsigned char*)lds;
    F.MISC = (volatile LAS unsigned*)(F.lds + MISC_OFF);
    F.tid = threadIdx.x; F.lane = F.tid & 63; F.wave = __builtin_amdgcn_readfirstlane(F.tid >> 6);
    F.G = gridDim.x; { const int bx = blockIdx.x; F.vcu = (F.G % 8 == 0) ? (bx % 8) * (F.G / 8) + bx / 8 : bx; }
    unsigned char* ws = args.ws;
    F.ctl = (gu32*)(ws + WS_CTL);
    for (int u = F.tid; u < (LDS_BYTES - LDSCTL_OFF) / 4; u += NWAVES * 64) ((LAS unsigned*)(F.lds + LDSCTL_OFF))[u] = 0u;
    __syncthreads();
    XcdBarrier bar; bar.bar = (unsigned*)(F.ctl + CW_BAR); bar.x = 0; bar.st = nullptr;
#if !MK_PER_PHASE
    bar = xcd_barrier_post((unsigned*)(F.ctl + CW_BAR), F.MISC + 8);
#define GRID_BAR() xcd_barrier(bar)
#else
#define GRID_BAR() do { } while (0)
#endif
    const int lo = args.ph_lo, hi = args.ph_hi;
#ifndef PH_MASK
#define PH_MASK 0x3fffff
#endif
#define IN(k) (((PH_MASK >> (k)) & 1) && lo <= (k) && (k) < hi)
#define BOTH(k) (IN(k) && IN((k) + 1))
    bf16* XB = (bf16*)(ws + WS_XB); float* XF = (float*)(ws + WS_XF); float* Z = (float*)(ws + WS_Z);

#ifndef PROBE_MASK
#define PROBE_MASK 0
#endif
#define REPS(k) ((((PROBE_MASK) >> (k)) & 1) ? 2 : 1)
    if (IN(0)) for (int rep_ = 0; rep_ < REPS(0); ++rep_) { relaunder(F); p0_prologue(F, args); if (BOTH(0) || rep_ + 1 < REPS(0)) GRID_BAR(); }
    if (IN(1)) for (int rep_ = 0; rep_ < REPS(1); ++rep_) { relaunder(F);
        pg8::Gemm g{XB, (const bf16*)(ws + WS_W_NSA_IN), NTOK, NSA_NPAD, DM}; pg8::StaticOrder S; S.init(NTOK, NSA_NPAD, F.G, (int)blockIdx.x);
        pg8::EpiNsaIn E{(bf16*)(ws + WS_P0), (float*)(ws + WS_GL), 0.08838834764831845f};
        pg8::gemm_phase<pg8::EpiNsaIn, pg8::StaticOrder, true, true>(F.lds + RING_OFF, g, S, E);
        if (BOTH(1) || rep_ + 1 < REPS(1)) GRID_BAR();
    }
    if (IN(2)) for (int rep_ = 0; rep_ < REPS(2); ++rep_) { relaunder(F); p2_compress(F, args); if (BOTH(2) || rep_ + 1 < REPS(2)) GRID_BAR(); }
#ifndef PROBE_NSA2
#define PROBE_NSA2 0
#endif
    for (int repn_ = 0; repn_ < (PROBE_NSA2 ? 2 : 1); ++repn_) {
    if (IN(3)) for (int rep_ = 0; rep_ < REPS(3); ++rep_) { relaunder(F); p3a_nsa_cmp(F, args); if (BOTH(3) || rep_ + 1 < REPS(3)) GRID_BAR(); }
    if (IN(4)) for (int rep_ = 0; rep_ < REPS(4); ++rep_) { relaunder(F); p3b_nsa_sel(F, args); if (BOTH(4) || rep_ + 1 < REPS(4) || repn_ + 1 < (PROBE_NSA2 ? 2 : 1)) GRID_BAR(); }
    }
    if (IN(5)) for (int rep_ = 0; rep_ < REPS(5); ++rep_) { relaunder(F); p3c_nsa_win(F, args); if (BOTH(5) || rep_ + 1 < REPS(5)) GRID_BAR(); }
    if (IN(6)) for (int rep_ = 0; rep_ < REPS(6); ++rep_) { relaunder(F);
        pg8::Gemm g{(const bf16*)(ws + WS_OATT0), (const bf16*)(ws + WS_W_NSA_OUT), NTOK, DM, DM}; pg8::StaticOrder S; S.init(NTOK, DM, F.G, (int)blockIdx.x);
        pg8::EpiResF32 E{args.in[0], Z, ALPHA, DM};
        pg8::gemm_phase<pg8::EpiResF32, pg8::StaticOrder, true, true>(F.lds + RING_OFF, g, S, E);
        if (BOTH(6) || rep_ + 1 < REPS(6)) GRID_BAR();
    }
    if (IN(7)) for (int rep_ = 0; rep_ < REPS(7); ++rep_) { relaunder(F); ln_phase<false, FFN_F8 != 0>(F, args, Z, args.in[23], args.in[24], XF, XB); if (BOTH(7) || rep_ + 1 < REPS(7)) GRID_BAR(); }
    if (IN(8)) for (int rep_ = 0; rep_ < REPS(8); ++rep_) { relaunder(F);
        pg8::StaticOrder S; S.init(NTOK, 2 * DFF, F.G, (int)blockIdx.x);
#if FFN_F8
        pg8::Gemm g{XB, (const bf16*)(ws + WS_W_FFN_GU), NTOK, 2 * DFF, DM, 1, 0x79797979};
        pg8::EpiSwiGLU8 E{(unsigned char*)(ws + WS_HFF), DFF};
        pg8::gemm_phase<pg8::EpiSwiGLU8, pg8::StaticOrder, true, true, true>(F.lds + RING_OFF, g, S, E);
#else
        pg8::Gemm g{XB, (const bf16*)(ws + WS_W_FFN_GU), NTOK, 2 * DFF, DM};
        pg8::EpiSwiGLU E{(bf16*)(ws + WS_HFF), DFF};
        pg8::gemm_phase<pg8::EpiSwiGLU, pg8::StaticOrder, true, true>(F.lds + RING_OFF, g, S, E);
#endif
        if (BOTH(8) || rep_ + 1 < REPS(8)) GRID_BAR();
    }
    if (IN(9)) for (int rep_ = 0; rep_ < REPS(9); ++rep_) { relaunder(F);
        pg8::StaticOrder S; S.init(NTOK, DM, F.G, (int)blockIdx.x);
        pg8::EpiResF32 E{XF, Z, ALPHA, DM};
#if FFN_F8
        pg8::Gemm g{(const bf16*)(ws + WS_HFF), (const bf16*)(ws + WS_W_FFN_DN), NTOK, DM, DFF, 1, 0x77777777};
        pg8::gemm_phase<pg8::EpiResF32, pg8::StaticOrder, true, true, true>(F.lds + RING_OFF, g, S, E);
#else
        pg8::Gemm g{(const bf16*)(ws + WS_HFF), (const bf16*)(ws + WS_W_FFN_DN), NTOK, DM, DFF};
        pg8::gemm_phase<pg8::EpiResF32, pg8::StaticOrder, true, true>(F.lds + RING_OFF, g, S, E);
#endif
        if (BOTH(9) || rep_ + 1 < REPS(9)) GRID_BAR();
    }
    if (IN(10)) for (int rep_ = 0; rep_ < REPS(10); ++rep_) { relaunder(F); ln_phase<false>(F, args, Z, args.in[25], args.in[26], XF, XB); if (BOTH(10) || rep_ + 1 < REPS(10)) GRID_BAR(); }
    if (IN(11)) for (int rep_ = 0; rep_ < REPS(11); ++rep_) { relaunder(F);
        pg8::Gemm g{XB, (const bf16*)(ws + WS_W_DSA_IN), NTOK, DSA_NPAD, DM}; pg8::StaticOrder S; S.init(NTOK, DSA_NPAD, F.G, (int)blockIdx.x);
        pg8::EpiDsaIn E{(bf16*)(ws + WS_Q), (float*)(ws + WS_CRAW), (bf16*)(ws + WS_QI), (float*)(ws + WS_KIWI), 0.125f};
        pg8::gemm_phase<pg8::EpiDsaIn, pg8::StaticOrder, true, true>(F.lds + RING_OFF, g, S, E);
        if (BOTH(11) || rep_ + 1 < REPS(11)) GRID_BAR();
    }
    if (IN(12)) for (int rep_ = 0; rep_ < REPS(12); ++rep_) { relaunder(F); p10_dsa_prep(F, args); if (BOTH(12) || rep_ + 1 < REPS(12)) GRID_BAR(); }
    if (IN(13)) for (int rep_ = 0; rep_ < REPS(13); ++rep_) { relaunder(F); p13a_dsa_index(F, args); if (BOTH(13) || rep_ + 1 < REPS(13)) GRID_BAR(); }
    if (IN(14)) for (int rep_ = 0; rep_ < REPS(14); ++rep_) { relaunder(F); p13b_dsa_attn(F, args); if (BOTH(14) || rep_ + 1 < REPS(14)) GRID_BAR(); }
    if (IN(15)) for (int rep_ = 0; rep_ < REPS(15); ++rep_) { relaunder(F); p12_dsa_uv(F, args); if (BOTH(15) || rep_ + 1 < REPS(15)) GRID_BAR(); }
    if (IN(16)) for (int rep_ = 0; rep_ < REPS(16); ++rep_) { relaunder(F);
        pg8::Gemm g{(const bf16*)(ws + WS_OATT1), (const bf16*)(ws + WS_W_DSA_OUT), NTOK, DM, DM}; pg8::StaticOrder S; S.init(NTOK, DM, F.G, (int)blockIdx.x);
        pg8::EpiResF32 E{XF, Z, ALPHA, DM};
        pg8::gemm_phase<pg8::EpiResF32, pg8::StaticOrder, true, true>(F.lds + RING_OFF, g, S, E);
        if (BOTH(16) || rep_ + 1 < REPS(16)) GRID_BAR();
    }
    if (IN(17)) for (int rep_ = 0; rep_ < REPS(17); ++rep_) { relaunder(F); ln_route_phase(F, args, Z, args.in[23] + DM, args.in[24] + DM, XF, XB); if (BOTH(17) || rep_ + 1 < REPS(17)) GRID_BAR(); }
    if (IN(18)) for (int rep_ = 0; rep_ < REPS(18); ++rep_) { relaunder(F); p15_gather(F, args); if (BOTH(18) || rep_ + 1 < REPS(18)) GRID_BAR(); }
    if (IN(19)) for (int rep_ = 0; rep_ < REPS(19); ++rep_) { relaunder(F);
        MoeTiles T; moe_tiles(F, T);
        pg8::Gemm g{(const bf16*)(ws + WS_XG), (const bf16*)(ws + WS_W_MOE_GU), T.MT * 256, 2 * DFFE, DM, 1, 0x79797979}; pg8::MoeOrder S; S.init(T.MT * 256, 2 * DFFE, F.G, (int)blockIdx.x); S.nexp_rows = 2 * DFFE;
#pragma unroll
        for (int e = 0; e < 8; ++e) S.tend[e] = T.tend[e];
        pg8::EpiSwiGLU8 E{(unsigned char*)(ws + WS_HM), DFFE};
        pg8::gemm_phase<pg8::EpiSwiGLU8, pg8::MoeOrder, true, true, true>(F.lds + RING_OFF, g, S, E);
        if (BOTH(19) || rep_ + 1 < REPS(19)) GRID_BAR();
    }
    if (IN(20)) for (int rep_ = 0; rep_ < REPS(20); ++rep_) { relaunder(F);
        MoeTiles T; moe_tiles(F, T);
        pg8::Gemm g{(const bf16*)(ws + WS_HM), (const bf16*)(ws + WS_W_MOE_DN), T.MT * 256, DM, DFFE, 1, 0x77777777}; pg8::MoeOrder S; S.init(T.MT * 256, DM, F.G, (int)blockIdx.x); S.nexp_rows = DM;
#pragma unroll
        for (int e = 0; e < 8; ++e) S.tend[e] = T.tend[e];
        pg8::EpiF32 E{(float*)(ws + WS_Y), DM};
        pg8::gemm_phase<pg8::EpiF32, pg8::MoeOrder, true, true, true>(F.lds + RING_OFF, g, S, E);
        if (BOTH(20) || rep_ + 1 < REPS(20)) GRID_BAR();
    }
    if (IN(21)) for (int rep_ = 0; rep_ < REPS(21); ++rep_) { relaunder(F); p18_final(F, args); }
#undef IN
#undef BOTH
}

extern "C" void kernel_launch(void* const* d_in, const int* in_sizes, int n_in, void* d_out, int out_size, void* d_ws, size_t ws_size, hipStream_t stream) {
    static int grid = 0;
    if (grid == 0) {
        if (n_in != 27 || out_size != NTOK * DM || ws_size < WS_END) { fprintf(stderr, "kernel_launch: unexpected shapes (n_in %d, out %d, ws %zu); nothing launched\n", n_in, out_size, ws_size); grid = -1; return; }
        int dev = 0, cus = 0, per_cu = 0;
        if (hipGetDevice(&dev) != hipSuccess || hipDeviceGetAttribute(&cus, hipDeviceAttributeMultiprocessorCount, dev) != hipSuccess) { grid = -1; return; }
        if (hipFuncSetAttribute((const void*)mega_fwd, hipFuncAttributeMaxDynamicSharedMemorySize, LDS_BYTES) != hipSuccess) { fprintf(stderr, "kernel_launch: hipFuncSetAttribute failed\n"); grid = -1; return; }
        if (hipOccupancyMaxActiveBlocksPerMultiprocessor(&per_cu, (const void*)mega_fwd, NWAVES * 64, LDS_BYTES) != hipSuccess || per_cu < 1) { fprintf(stderr, "kernel_launch: occupancy query says %d\n", per_cu); }
        (void)hipGetLastError();
        grid = cus;
    }
    if (grid < 0) return;
    if (hipMemsetAsync((char*)d_ws + WS_CTL, 0, CTL_ZERO_BYTES, stream) != hipSuccess) return;
    Args a{};
    for (int i = 0; i < 27; ++i) a.in[i] = (const float*)d_in[i];
    a.out = (float*)d_out; a.ws = (unsigned char*)d_ws;
#if MK_PER_PHASE
    for (int p = 0; p < NPHASE; ++p) { a.ph_lo = p; a.ph_hi = p + 1; hipLaunchKernelGGL(mega_fwd, dim3(grid), dim3(NWAVES * 64), LDS_BYTES, stream, a); }
#else
    a.ph_lo = 0; a.ph_hi = NPHASE;
    hipLaunchKernelGGL(mega_fwd, dim3(grid), dim3(NWAVES * 64), LDS_BYTES, stream, a);
#endif
}
```

```cpp
#include <hip/hip_runtime.h>
#include <cstdio>
#include <cstdint>
namespace pg8 {
#define PG8_LAS __attribute__((address_space(3)))
typedef unsigned short bf16_t;
typedef short bf16x8 __attribute__((ext_vector_type(8)));
typedef float f32x4 __attribute__((ext_vector_type(4)));
typedef unsigned u32x4 __attribute__((ext_vector_type(4)));
constexpr int BM = 256, BK = 64, HALF = 128, HTB = HALF * BK * 2  , STAGE_BYTES = 8 * HTB, NXCD = 8, WGM = 8;

__host__ __device__ __forceinline__ int lds_byte(int r, int c) { const int st = (r >> 4) * 2 + (c >> 5), rr = r & 15, cc = c & 31, ob = rr * 64 + cc * 2; return st * 1024 + (ob ^ (((ob >> 9) & 1) << 5)); }
__host__ __device__ __forceinline__ void stage_rc(int b, int& R, int& C) { const int st = b / 1024, sb = b % 1024, swz = sb ^ (((sb >> 9) & 1) << 5); R = (st >> 1) * 16 + swz / 64; C = (st & 1) * 32 + (swz % 64) / 2; }
__host__ __device__ __forceinline__ int perm32(int rho) { const int n = rho >> 4, i = rho & 15; return 8 * (i >> 2) + 4 * n + (i & 3); }

struct Unit { int pm, pn; };
struct Gemm { const bf16_t* A; const bf16_t* Bt; int M, N, K; int esz = 2; int scale = 0x7f7f7f7f; };

struct StaticOrder {
    int nM, nN, nwg, G, c;
    __host__ __device__ void init(int M, int N, int G_, int c_) { nM = M / BM; nN = N / BM; nwg = nM * nN; G = G_; c = c_; }
    __host__ __device__ bool next(int i, Unit& u) const {
        const long L = (long)i * G + c; if (L >= nwg) return false;
        int wgid = (int)L; { const int q = nwg / NXCD, r = nwg % NXCD, xcd = wgid % NXCD, off = wgid / NXCD; wgid = (xcd < r ? xcd * (q + 1) : r * (q + 1) + (xcd - r) * q) + off; }
        const int nig = WGM * nN, gid = wgid / nig, fm = gid * WGM, gsz = (nM - fm) < WGM ? (nM - fm) : WGM;
        u.pm = fm + ((wgid % nig) % gsz); u.pn = (wgid % nig) / gsz; return true;
    }
    __device__ __forceinline__ void a_ready(const Unit&) const {}
    __device__ __forceinline__ void done(const Unit&) const {}
    __device__ __forceinline__ const char* a_ptr(const Gemm& g, const Unit& u) const { return (const char*)g.A + (size_t)u.pm * ((size_t)BM * g.K * g.esz); }
    __device__ __forceinline__ const char* b_ptr(const Gemm& g, const Unit& u) const { return (const char*)g.Bt + (size_t)u.pn * ((size_t)BM * g.K * g.esz); }
};


__device__ __forceinline__ unsigned cvt_pk_bf16(float lo, float hi) { unsigned r; asm volatile("v_cvt_pk_bf16_f32 %0, %1, %2" : "=v"(r) : "v"(lo), "v"(hi)); return r; }
__device__ __forceinline__ u32x4 pack8(const f32x4 v0, const f32x4 v1) { u32x4 w; w.x = cvt_pk_bf16(v0[0], v0[1]); w.y = cvt_pk_bf16(v0[2], v0[3]); w.z = cvt_pk_bf16(v1[0], v1[1]); w.w = cvt_pk_bf16(v1[2], v1[3]); return w; }

struct EpiNsaIn {
    static constexpr bool PERM = true, AFTER_DRAIN = false;
    bf16_t* P0; float* GL; float qscale;
    __device__ __forceinline__ void operator()(const f32x4 (&acc)[2][2][4][2], const Unit& u, int wr, int wc, int fr, int fq) const {
        const int row0 = u.pm * BM + wr * 64 + fr;
        if (u.pn < 20) {
            const float s = u.pn < 8 ? qscale : 1.0f;
            const int col0 = u.pn * BM + wc * 32 + 8 * fq;
#pragma unroll
            for (int ai = 0; ai < 2; ++ai)
#pragma unroll
                for (int m = 0; m < 4; ++m) { bf16_t* rowp = P0 + (size_t)(row0 + ai * HALF + m * 16) * 5120 + col0;
#pragma unroll
                    for (int bj = 0; bj < 2; ++bj) *(u32x4*)(rowp + bj * HALF) = pack8(acc[ai][bj][m][0] * s, acc[ai][bj][m][1] * s); }
        } else {
            const int c = wc * 32 + 8 * fq;
            if (c < 48) {
#pragma unroll
                for (int ai = 0; ai < 2; ++ai)
#pragma unroll
                    for (int m = 0; m < 4; ++m) { float* gp = GL + (size_t)(row0 + ai * HALF + m * 16) * 48 + c;
                        *(f32x4*)gp = acc[ai][0][m][0]; *(f32x4*)(gp + 4) = acc[ai][0][m][1]; }
            }
        }
    }
};
struct EpiDsaIn {
    static constexpr bool PERM = true, AFTER_DRAIN = false;
    bf16_t* Q; float* CRAW; bf16_t* QI; float* KIWI; float qiscale;
    __device__ __forceinline__ void operator()(const f32x4 (&acc)[2][2][4][2], const Unit& u, int wr, int wc, int fr, int fq) const {
        const int row0 = u.pm * BM + wr * 64 + fr; const int c = wc * 32 + 8 * fq;
        if (u.pn < 8) {
#pragma unroll
            for (int ai = 0; ai < 2; ++ai)
#pragma unroll
                for (int m = 0; m < 4; ++m) { bf16_t* rowp = Q + (size_t)(row0 + ai * HALF + m * 16) * 2048 + u.pn * BM + c;
#pragma unroll
                    for (int bj = 0; bj < 2; ++bj) *(u32x4*)(rowp + bj * HALF) = pack8(acc[ai][bj][m][0], acc[ai][bj][m][1]); }
        } else if (u.pn == 8) {
#pragma unroll
            for (int ai = 0; ai < 2; ++ai)
#pragma unroll
                for (int m = 0; m < 4; ++m) { float* rowp = CRAW + (size_t)(row0 + ai * HALF + m * 16) * 256 + c;
#pragma unroll
                    for (int bj = 0; bj < 2; ++bj) { *(f32x4*)(rowp + bj * HALF) = acc[ai][bj][m][0]; *(f32x4*)(rowp + bj * HALF + 4) = acc[ai][bj][m][1]; } }
        } else if (u.pn < 11) {
#pragma unroll
            for (int ai = 0; ai < 2; ++ai)
#pragma unroll
                for (int m = 0; m < 4; ++m) { bf16_t* rowp = QI + (size_t)(row0 + ai * HALF + m * 16) * 512 + (u.pn - 9) * BM + c;
#pragma unroll
                    for (int bj = 0; bj < 2; ++bj) *(u32x4*)(rowp + bj * HALF) = pack8(acc[ai][bj][m][0] * qiscale, acc[ai][bj][m][1] * qiscale); }
        } else {
#pragma unroll
            for (int ai = 0; ai < 2; ++ai)
#pragma unroll
                for (int m = 0; m < 4; ++m) { float* rowp = KIWI + (size_t)(row0 + ai * HALF + m * 16) * 128 + c;
                    *(f32x4*)rowp = acc[ai][0][m][0]; *(f32x4*)(rowp + 4) = acc[ai][0][m][1]; }
        }
    }
};
struct EpiResF32 {
    static constexpr bool PERM = false, AFTER_DRAIN = false;
    const float* R; float* Z; float alpha; int ldc;
    __device__ __forceinline__ void operator()(const f32x4 (&acc)[2][2][4][2], const Unit& u, int wr, int wc, int fr, int fq) const {
        const int row0 = u.pm * BM + wr * 64 + fr, col0 = u.pn * BM + wc * 32 + 4 * fq;
#pragma unroll
        for (int ai = 0; ai < 2; ++ai)
#pragma unroll
            for (int m = 0; m < 4; ++m) { const size_t off = (size_t)(row0 + ai * HALF + m * 16) * ldc + col0;
#pragma unroll
                for (int bj = 0; bj < 2; ++bj)
#pragma unroll
                    for (int n = 0; n < 2; ++n) { const f32x4 r = *(const f32x4*)(R + off + bj * HALF + n * 16); *(f32x4*)(Z + off + bj * HALF + n * 16) = r * alpha + acc[ai][bj][m][n]; } }
    }
};
struct EpiF32 {
    static constexpr bool PERM = false, AFTER_DRAIN = false;
    float* C; int ldc;
    __device__ __forceinline__ void operator()(const f32x4 (&acc)[2][2][4][2], const Unit& u, int wr, int wc, int fr, int fq) const {
        const int row0 = u.pm * BM + wr * 64 + fr, col0 = u.pn * BM + wc * 32 + 4 * fq;
#pragma unroll
        for (int ai = 0; ai < 2; ++ai)
#pragma unroll
            for (int m = 0; m < 4; ++m) { float* rowp = C + (size_t)(row0 + ai * HALF + m * 16) * ldc + col0;
#pragma unroll
                for (int bj = 0; bj < 2; ++bj)
#pragma unroll
                    for (int n = 0; n < 2; ++n) *(f32x4*)(rowp + bj * HALF + n * 16) = acc[ai][bj][m][n]; }
    }
};
__device__ __forceinline__ float silu_mul(float g, float u) { return g * __builtin_amdgcn_rcpf(1.0f + __expf(-g)) * u; }
struct EpiSwiGLU {
    static constexpr bool PERM = true, AFTER_DRAIN = false;
    bf16_t* H; int ldh;
    __device__ __forceinline__ void operator()(const f32x4 (&acc)[2][2][4][2], const Unit& u, int wr, int wc, int fr, int fq) const {
        const int row0 = u.pm * BM + wr * 64 + fr, col0 = u.pn * HALF + wc * 32 + 8 * fq;
#pragma unroll
        for (int ai = 0; ai < 2; ++ai)
#pragma unroll
            for (int m = 0; m < 4; ++m) { bf16_t* rowp = H + (size_t)(row0 + ai * HALF + m * 16) * ldh + col0;
                f32x4 v0, v1;
#pragma unroll
                for (int j = 0; j < 4; ++j) { v0[j] = silu_mul(acc[ai][0][m][0][j], acc[ai][1][m][0][j]); v1[j] = silu_mul(acc[ai][0][m][1][j], acc[ai][1][m][1][j]); }
                *(u32x4*)rowp = pack8(v0, v1); }
    }
};
struct EpiSwiGLU8 {
    static constexpr bool PERM = true, AFTER_DRAIN = false;
    unsigned char* H; int ldh;
    __device__ __forceinline__ void operator()(const f32x4 (&acc)[2][2][4][2], const Unit& u, int wr, int wc, int fr, int fq) const {
        const int row0 = u.pm * BM + wr * 64 + fr, col0 = u.pn * HALF + wc * 32 + 8 * fq;
#pragma unroll
        for (int ai = 0; ai < 2; ++ai)
#pragma unroll
            for (int m = 0; m < 4; ++m) { unsigned char* rowp = H + (size_t)(row0 + ai * HALF + m * 16) * ldh + col0;
                float v[8];
#pragma unroll
                for (int j = 0; j < 4; ++j) { v[j] = silu_mul(acc[ai][0][m][0][j], acc[ai][1][m][0][j]); v[4 + j] = silu_mul(acc[ai][0][m][1][j], acc[ai][1][m][1][j]); }
                int w0 = __builtin_amdgcn_cvt_pk_fp8_f32(v[0], v[1], 0, false); w0 = __builtin_amdgcn_cvt_pk_fp8_f32(v[2], v[3], w0, true);
                int w1 = __builtin_amdgcn_cvt_pk_fp8_f32(v[4], v[5], 0, false); w1 = __builtin_amdgcn_cvt_pk_fp8_f32(v[6], v[7], w1, true);
                uint2 o; o.x = (unsigned)w0; o.y = (unsigned)w1; *(uint2*)rowp = o; }
    }
};
struct MoeOrder : StaticOrder {
    int tend[8]; int nexp_rows;
    __device__ __forceinline__ int expert(int pm) const { int e = 0;
#pragma unroll
        for (int i = 0; i < 7; ++i) e += (pm >= tend[i]) ? 1 : 0; return e; }
    __device__ __forceinline__ const char* b_ptr(const Gemm& g, const Unit& u) const { return (const char*)g.Bt + ((size_t)expert(u.pm) * nexp_rows + (size_t)u.pn * BM) * ((size_t)g.K * g.esz); }
};
typedef int i32x8 __attribute__((ext_vector_type(8)));
typedef int i32x4 __attribute__((ext_vector_type(4)));
__device__ __forceinline__ i32x8 cat8(bf16x8 lo, bf16x8 hi) { const i32x4 a = *reinterpret_cast<const i32x4*>(&lo), b = *reinterpret_cast<const i32x4*>(&hi); return __builtin_shufflevector(a, b, 0, 1, 2, 3, 4, 5, 6, 7); }
template <class Epi, class Sched, bool ALIGN_EPI = false, bool SP2 = false, bool FP8 = false>
__device__ __forceinline__ void gemm_phase(PG8_LAS unsigned char* lds, const Gemm g, const Sched& S, const Epi& E) {
    int tid = threadIdx.x; asm volatile("" : "+v"(tid));
    const int wid = __builtin_amdgcn_readfirstlane(tid >> 6), lane = tid & 63, wr = wid >> 2, wc = wid & 3, fr = lane & 15, fq = lane >> 4;
    const int K = g.K, nt = K / (FP8 ? 2 * BK : BK);
    unsigned voffA[2], voffB[2];
#pragma unroll
    for (int i = 0; i < 2; ++i) { int R, C; stage_rc(tid * 16 + i * 8192, R, C); const int Rb = Epi::PERM ? ((R & ~31) + perm32(R & 31)) : R;
        voffA[i] = FP8 ? (unsigned)(R * K + C * 2) : (unsigned)(R * K + C) * 2u; voffB[i] = FP8 ? (unsigned)(Rb * K + C * 2) : (unsigned)(Rb * K + C) * 2u; }
    const size_t kstep = (size_t)(BK * 2);
    const size_t hstep = (size_t)HALF * K * (FP8 ? 1 : 2);
    const size_t tstep = 2 * hstep;
    const unsigned ldsw = (unsigned)wid * 1024u;
    const int aoff = lds_byte(wr * 64 + fr, fq * 8), boff = lds_byte(wc * 32 + fr, fq * 8);
#define PG8_SA(b, h) (((b) * 2 + (h)) * HTB)
#define PG8_SB(b, h) ((4 + (b) * 2 + (h)) * HTB)
#define PG8_STAGE(bufoff, gbase, voff) do { _Pragma("unroll") for (int _i = 0; _i < 2; ++_i) \
        __builtin_amdgcn_global_load_lds((const unsigned*)((const char*)(gbase) + (voff)[_i]), (PG8_LAS unsigned*)(lds + (bufoff) + ldsw + _i * 8192), 16, 0, 0); } while (0)
#define PG8_LDA(dst, b, h) do { _Pragma("unroll") for (int m = 0; m < 4; ++m) { if constexpr (FP8) { const i32x4 lo_ = *(const PG8_LAS i32x4*)(lds + PG8_SA(b, h) + aoff + m * 2048), hi_ = *(const PG8_LAS i32x4*)(lds + PG8_SA(b, h) + aoff + m * 2048 + 1024); dst##8[m] = __builtin_shufflevector(lo_, hi_, 0, 1, 2, 3, 4, 5, 6, 7); } else { _Pragma("unroll") for (int k = 0; k < 2; ++k) dst[m][k] = *(const PG8_LAS bf16x8*)(lds + PG8_SA(b, h) + aoff + m * 2048 + k * 1024); } } } while (0)
#define PG8_LDB(dst, b, h) do { _Pragma("unroll") for (int n = 0; n < 2; ++n) { if constexpr (FP8) { const i32x4 lo_ = *(const PG8_LAS i32x4*)(lds + PG8_SB(b, h) + boff + n * 2048), hi_ = *(const PG8_LAS i32x4*)(lds + PG8_SB(b, h) + boff + n * 2048 + 1024); dst##8[n] = __builtin_shufflevector(lo_, hi_, 0, 1, 2, 3, 4, 5, 6, 7); } else { _Pragma("unroll") for (int k = 0; k < 2; ++k) dst[n][k] = *(const PG8_LAS bf16x8*)(lds + PG8_SB(b, h) + boff + n * 2048 + k * 1024); } } } while (0)
#define PG8_MMA(ai, bj, At, Bt) do { __builtin_amdgcn_s_setprio(1); _Pragma("unroll") for (int m = 0; m < 4; ++m) _Pragma("unroll") for (int n = 0; n < 2; ++n) { \
        if constexpr (FP8) { asm volatile("v_mfma_scale_f32_16x16x128_f8f6f4 %0, %1, %2, %0, %3, %4 op_sel_hi:[0,0,0]" : "+v"(acc[ai][bj][m][n]) : "v"(Bt##8[n]), "v"(At##8[m]), "v"(sclA), "v"(sclB)); } \
        else { _Pragma("unroll") for (int k = 0; k < 2; ++k) acc[ai][bj][m][n] = __builtin_amdgcn_mfma_f32_16x16x32_bf16(Bt[n][k], At[m][k], acc[ai][bj][m][n], 0, 0, 0); } } __builtin_amdgcn_s_setprio(0); } while (0)
#define PG8_WAIT_V(n) asm volatile("s_waitcnt vmcnt(" #n ")" ::: "memory")
#define PG8_WAIT_L(n) asm volatile("s_waitcnt lgkmcnt(" #n ")" ::: "memory")
#define PG8_BAR __builtin_amdgcn_s_barrier()
#define PG8_SCHED __builtin_amdgcn_sched_barrier(0)
    Unit cur, nxt; int ui = 0;
    if (!S.next(0, cur)) return;
    f32x4 acc[2][2][4][2];
#pragma unroll
    for (int a = 0; a < 2; ++a)
#pragma unroll
        for (int b = 0; b < 2; ++b)
#pragma unroll
            for (int m = 0; m < 4; ++m)
#pragma unroll
                for (int n = 0; n < 2; ++n) acc[a][b][m][n] = (f32x4){0.f, 0.f, 0.f, 0.f};
    bf16x8 At[4][2], B0[2][2], B1[2][2]; i32x8 At8[4], B08[2], B18[2]; const int sclA = g.scale, sclB = 0x7f7f7f7f;
    const char* cA = S.a_ptr(g, cur); const char* cB = S.b_ptr(g, cur);
    S.a_ready(cur);
    if constexpr (SP2) {
        PG8_STAGE(PG8_SB(0, 0), cB, voffB); PG8_STAGE(PG8_SB(0, 1), cB + hstep, voffB); PG8_STAGE(PG8_SA(0, 0), cA, voffA); PG8_STAGE(PG8_SA(0, 1), cA + hstep, voffA);
        if (wr == 1) PG8_BAR;
        PG8_WAIT_V(2); PG8_BAR;
        PG8_STAGE(PG8_SB(1, 0), cB + kstep, voffB); PG8_STAGE(PG8_SA(1, 0), cA + kstep, voffA); PG8_STAGE(PG8_SB(1, 1), cB + hstep + kstep, voffB);
        PG8_WAIT_V(6); PG8_BAR;
    } else {
        PG8_STAGE(PG8_SB(0, 0), cB, voffB); PG8_STAGE(PG8_SA(0, 0), cA, voffA); PG8_STAGE(PG8_SB(0, 1), cB + hstep, voffB); PG8_STAGE(PG8_SA(0, 1), cA + hstep, voffA);
        if (wr == 1) PG8_BAR;
        PG8_WAIT_V(4); PG8_BAR;
        PG8_STAGE(PG8_SB(1, 0), cB + kstep, voffB); PG8_STAGE(PG8_SA(1, 0), cA + kstep, voffA); PG8_STAGE(PG8_SB(1, 1), cB + hstep + kstep, voffB);
        PG8_WAIT_V(6); PG8_BAR;
    }
    for (;;) {
        const bool has_next = S.next(ui + 1, nxt);
        const char* nA = has_next ? S.a_ptr(g, nxt) : cA; const char* nB = has_next ? S.b_ptr(g, nxt) : cB;
        for (int t = 0; t < nt; t += 2) {
            const bool last = (t == nt - 2);
            const char* a1 = cA + (size_t)(t + 1) * kstep;
            const char* a2 = last ? nA : cA + (size_t)(t + 2) * kstep; const char* b2 = last ? nB : cB + (size_t)(t + 2) * kstep;
            const char* a3 = a2 + kstep; const char* b3 = b2 + kstep;
            if (last && has_next) S.a_ready(nxt);
            if constexpr (SP2) {
            PG8_LDB(B0, 0, 0); PG8_LDB(B1, 0, 1); PG8_SCHED; PG8_LDA(At, 0, 0); PG8_STAGE(PG8_SA(1, 1), a1 + hstep, voffA);
            PG8_WAIT_V(8); PG8_WAIT_L(0); PG8_BAR; PG8_MMA(0, 0, At, B0); PG8_MMA(0, 1, At, B1); PG8_BAR; PG8_SCHED;
            PG8_LDA(At, 0, 1); PG8_STAGE(PG8_SB(0, 0), b2, voffB); PG8_STAGE(PG8_SB(0, 1), b2 + hstep, voffB); PG8_STAGE(PG8_SA(0, 0), a2, voffA);
            PG8_WAIT_V(8); PG8_WAIT_L(0); PG8_BAR; PG8_MMA(1, 0, At, B0); PG8_MMA(1, 1, At, B1); PG8_BAR; PG8_SCHED;
            PG8_LDB(B0, 1, 0); PG8_LDB(B1, 1, 1); PG8_SCHED; PG8_LDA(At, 1, 0); PG8_STAGE(PG8_SA(0, 1), a2 + hstep, voffA);
            PG8_WAIT_V(8); PG8_WAIT_L(0); PG8_BAR; PG8_MMA(0, 0, At, B0); PG8_MMA(0, 1, At, B1); PG8_BAR; PG8_SCHED;
            PG8_LDA(At, 1, 1); PG8_STAGE(PG8_SB(1, 0), b3, voffB); PG8_STAGE(PG8_SB(1, 1), b3 + hstep, voffB); PG8_STAGE(PG8_SA(1, 0), a3, voffA);
            PG8_WAIT_V(8); PG8_WAIT_L(0); PG8_BAR; PG8_MMA(1, 0, At, B0); PG8_MMA(1, 1, At, B1); PG8_BAR; PG8_SCHED;
            } else {
            PG8_LDB(B0, 0, 0); PG8_SCHED; PG8_LDA(At, 0, 0); PG8_STAGE(PG8_SA(1, 1), a1 + hstep, voffA);
            PG8_WAIT_L(8); PG8_BAR; PG8_WAIT_L(0); PG8_MMA(0, 0, At, B0); PG8_BAR; PG8_SCHED;
            PG8_LDB(B1, 0, 1); PG8_STAGE(PG8_SB(0, 0), b2, voffB);
            PG8_BAR; PG8_WAIT_L(0); PG8_MMA(0, 1, At, B1); PG8_BAR;
            PG8_LDA(At, 0, 1); PG8_STAGE(PG8_SA(0, 0), a2, voffA);
            PG8_BAR; PG8_WAIT_L(0); PG8_MMA(1, 0, At, B0); PG8_BAR; PG8_SCHED;
            PG8_STAGE(PG8_SB(0, 1), b2 + hstep, voffB);
            PG8_WAIT_V(6); PG8_BAR; PG8_MMA(1, 1, At, B1); PG8_BAR;
            PG8_LDB(B0, 1, 0); PG8_SCHED; PG8_LDA(At, 1, 0); PG8_STAGE(PG8_SA(0, 1), a2 + hstep, voffA);
            PG8_WAIT_L(8); PG8_BAR; PG8_WAIT_L(0); PG8_MMA(0, 0, At, B0); PG8_BAR; PG8_SCHED;
            PG8_LDB(B1, 1, 1); PG8_STAGE(PG8_SB(1, 0), b3, voffB);
            PG8_BAR; PG8_WAIT_L(0); PG8_MMA(0, 1, At, B1); PG8_BAR;
            PG8_LDA(At, 1, 1); PG8_STAGE(PG8_SA(1, 0), a3, voffA);
            PG8_BAR; PG8_WAIT_L(0); PG8_MMA(1, 0, At, B0); PG8_BAR; PG8_SCHED;
            PG8_STAGE(PG8_SB(1, 1), b3 + hstep, voffB);
            PG8_WAIT_V(6); PG8_BAR; PG8_MMA(1, 1, At, B1); PG8_BAR;
            }
        }
        if constexpr (FP8) asm volatile("s_nop 15\n\ts_nop 15" ::: "memory");
        if constexpr (ALIGN_EPI) { if (wr == 0) PG8_BAR; }
        if constexpr (!Epi::AFTER_DRAIN) { E(acc, cur, wr, wc, fr, fq); S.done(cur); }
        if (!has_next) break;
#pragma unroll
        for (int a = 0; a < 2; ++a)
#pragma unroll
            for (int b = 0; b < 2; ++b)
#pragma unroll
                for (int m = 0; m < 4; ++m)
#pragma unroll
                    for (int n = 0; n < 2; ++n) acc[a][b][m][n] = (f32x4){0.f, 0.f, 0.f, 0.f};
        cur = nxt; cA = nA; cB = nB; ++ui;
        if constexpr (ALIGN_EPI) { if (wr == 1) PG8_BAR; }
    }
    PG8_WAIT_V(0);
    if constexpr (!ALIGN_EPI) { if (wr == 0) PG8_BAR; }
    PG8_BAR;
    if constexpr (Epi::AFTER_DRAIN) { E.fused(acc, cur, wr, wc, fr, fq, lds, wid, lane); S.done(cur); }
#undef PG8_SA
#undef PG8_SB
#undef PG8_STAGE
#undef PG8_LDA
#undef PG8_LDB
#undef PG8_MMA
#undef PG8_WAIT_V
#undef PG8_WAIT_L
#undef PG8_BAR
#undef PG8_SCHED
}
}
#define GAS __attribute__((address_space(1)))
#define LAS __attribute__((address_space(3)))
typedef unsigned short bf16;
typedef unsigned v4u __attribute__((ext_vector_type(4)));
typedef float f32x4 __attribute__((ext_vector_type(4)));
typedef short bf16x8 __attribute__((ext_vector_type(8)));
typedef GAS unsigned gu32;
typedef GAS unsigned long long gu64;
#define RLX_AGENT __ATOMIC_RELAXED, __HIP_MEMORY_SCOPE_AGENT
#define LDS_WAIT() asm volatile("s_waitcnt lgkmcnt(0)" ::: "memory")
#define VM_WAIT() asm volatile("s_waitcnt vmcnt(0)" ::: "memory")
__device__ __forceinline__ unsigned long long rt() { return __builtin_amdgcn_s_memrealtime(); }
__device__ __forceinline__ unsigned f2bf(float f) { unsigned u = __builtin_bit_cast(unsigned, f); return (u + 0x7fffu + ((u >> 16) & 1u)) >> 16; }
__device__ __forceinline__ unsigned pk2(float lo, float hi) { return f2bf(lo) | (f2bf(hi) << 16); }

#define XB_TMO      128
#define XB_XCNT(j)  (256  + 64 * (j))
#define XB_XSUB(j)  (1280 + 64 * (j))
#define XB_XGEN(j)  (2304 + 64 * (j))
#define XB_TOP      3328
#define XB_TOPGEN   3392
#define XCD_BAR_WORDS 3456
#define XB_SPIN_CAP (1u << 18)

__device__ __forceinline__ unsigned xb_ld(unsigned* p)              { return __hip_atomic_load(p, __ATOMIC_RELAXED, __HIP_MEMORY_SCOPE_AGENT); }
__device__ __forceinline__ unsigned xb_add(unsigned* p, unsigned v) { return __hip_atomic_fetch_add(p, v, __ATOMIC_RELAXED, __HIP_MEMORY_SCOPE_AGENT); }
__device__ __forceinline__ unsigned xb_xcc_id() { return (unsigned)__builtin_amdgcn_s_getreg((3 << 11) | 20) & 0xFu; }
#define XB_SPIN(cond, bar) do { unsigned _sp = 0; while (cond) { __builtin_amdgcn_s_sleep(1); \
    if ((++_sp & 255u) == 0u) { if (xb_ld(&(bar)[XB_TMO])) break; if (_sp > XB_SPIN_CAP) { atomicAdd(&(bar)[XB_TMO], 1u); break; } } } } while (0)

struct XcdBarrier {
    unsigned* bar; unsigned x;
    volatile LAS unsigned* st;
};

__device__ __forceinline__ XcdBarrier xcd_barrier_post(unsigned* bar, volatile LAS unsigned* st) {
    XcdBarrier b; b.bar = bar; b.x = xb_xcc_id(); b.st = st;
    if (threadIdx.x == 0) (void)xb_add(&bar[XB_XCNT(b.x)], 1u);
    return b;
}
__device__ __forceinline__ void xcd_barrier_complete(unsigned* bar, unsigned x, unsigned& nloc, unsigned& nx) {
    const unsigned G = gridDim.x * gridDim.y * gridDim.z;
    unsigned sum, cnt, mine, sp = 0u;
    for (;;) {
        sum = 0u; cnt = 0u; mine = 0u;
#pragma unroll
        for (unsigned j = 0; j < 16; ++j) { const unsigned c = xb_ld(&bar[XB_XCNT(j)]); sum += c; cnt += (c > 0u) ? 1u : 0u; mine = (j == x) ? c : mine; }
        if (sum == G) break;
        __builtin_amdgcn_s_sleep(1);
        if ((++sp & 255u) == 0u) { if (xb_ld(&bar[XB_TMO])) break; if (sp > XB_SPIN_CAP) { atomicAdd(&bar[XB_TMO], 1u); break; } }
    }
    nloc = mine > 0u ? mine : 1u; nx = cnt > 0u ? cnt : 1u;
}

__device__ __forceinline__ void xcd_barrier(const XcdBarrier& b) {
    asm volatile("s_waitcnt vmcnt(0)" ::: "memory");
    __syncthreads();
    if (threadIdx.x == 0) {
        unsigned* bar = b.bar;
        __builtin_amdgcn_s_waitcnt(0);
        unsigned nloc = b.st[0], nx = b.st[1];
        if (nloc == 0u) { xcd_barrier_complete(bar, b.x, nloc, nx); b.st[0] = nloc; b.st[1] = nx; }
        const unsigned old = xb_add(&bar[XB_XSUB(b.x)], 1u);
        const unsigned gen = old / nloc;
        if (old + 1u == (gen + 1u) * nloc) {
            __builtin_amdgcn_fence(__ATOMIC_RELEASE, "agent");
            asm volatile("s_waitcnt vmcnt(0)" ::: "memory");
            const unsigned og = xb_add(&bar[XB_TOP], 1u);
            const unsigned tg = og / nx;
            if (og + 1u == (tg + 1u) * nx) xb_add(&bar[XB_TOPGEN], 1u);
            else XB_SPIN(xb_ld(&bar[XB_TOPGEN]) == tg, bar);
            __builtin_amdgcn_fence(__ATOMIC_ACQUIRE, "agent");
            xb_add(&bar[XB_XGEN(b.x)], 1u);
            asm volatile("s_waitcnt vmcnt(0)" ::: "memory");
        } else {
            XB_SPIN(xb_ld(&bar[XB_XGEN(b.x)]) == gen, bar);
            __builtin_amdgcn_fence(__ATOMIC_ACQUIRE, "agent");
            asm volatile("s_waitcnt vmcnt(0)" ::: "memory");
        }
    }
    __syncthreads();
}

constexpr int NWAVES = 8;
#ifndef MK_PER_PHASE
#define MK_PER_PHASE 0
#endif
constexpr int NPHASE = 22;

constexpr int BATCH = 2, SEQ = 8192, DM = 2048, NTOK = BATCH * SEQ, NH = 16, DH = 128;
constexpr int NSA_N = 5168, NSA_NPAD = 5376, P0LD = 5120;
constexpr int NCMP = 511, NSELB = 128;
constexpr int COL_KC = 2048, COL_VC = 2560, COL_KS = 3072, COL_VS = 3584, COL_KW = 4096, COL_VW = 4608;
constexpr int DSA_N = 2888, DSA_NPAD = 3072, KVR = 256, TOPK = 256;
constexpr int DFF = 5632, NEXP = 8, DFFE = 7168, MOE_ROWS = 34816;
constexpr float ALPHA = 1.41421356237309515f, LN_EPS = 1e-5f, RMS_EPS = 1e-6f;

constexpr size_t MiB = (size_t)1 << 20;
constexpr size_t WS_CTL = 0, CTL_ZERO_BYTES = 128 * 1024;
constexpr size_t WS_W_NSA_IN = 2 * MiB, WS_W_NSA_OUT = 23 * MiB, WS_W_FFN_GU = 31 * MiB, WS_W_FFN_DN = 75 * MiB, WS_W_DSA_IN = 97 * MiB, WS_W_DSA_OUT = 109 * MiB;
constexpr size_t WS_W_CMPK = 117 * MiB, WS_W_CMPV = 118 * MiB, WS_W_UK = 119 * MiB, WS_W_UV = 120 * MiB, WS_CBIAS = 121 * MiB;
constexpr size_t WS_KCMP = 122 * MiB, WS_VCMP = 124 * MiB, WS_GL = 126 * MiB, WS_ROUTE = 129 * MiB;
constexpr size_t WS_KIB = 179 * MiB;
constexpr size_t WS_SELM = 178 * MiB;
constexpr size_t WS_CRAW = 130 * MiB, WS_KIWI = 146 * MiB, WS_IDX = 154 * MiB, WS_CN = 170 * MiB;
constexpr size_t WS_W_MOE_GU = 192 * MiB, WS_W_MOE_DN = 640 * MiB;
constexpr size_t WS_XB = 864 * MiB, WS_XF = 928 * MiB, WS_Z = 1056 * MiB;
constexpr size_t WS_P0 = 1184 * MiB, WS_OATT0 = 1344 * MiB, WS_HFF = 1408 * MiB;
constexpr size_t WS_Q = 1184 * MiB, WS_QI = 1248 * MiB, WS_QLAT = 1264 * MiB, WS_OLAT = 1392 * MiB, WS_OATT1 = 1520 * MiB;
constexpr size_t WS_XG = 1056 * MiB, WS_HM = 1192 * MiB, WS_Y = 192 * MiB;
constexpr size_t WS_END = 1668 * MiB;
static_assert(WS_HM + (size_t)MOE_ROWS * DFFE * 2 <= WS_END, "hm fits");
static_assert(WS_XG + (size_t)MOE_ROWS * DM * 2 <= WS_HM, "xg fits");
static_assert(WS_Y + (size_t)MOE_ROWS * DM * 4 <= WS_W_MOE_DN, "y overlays the dead gate/up weights only");
static_assert(WS_HFF + (size_t)NTOK * DFF * 2 <= WS_END, "hff fits");
constexpr int CW_TMO = 0, CW_CODE = 1;
constexpr int CW_BAR = 4096;
constexpr int CW_MOECNT = 16384;

constexpr int RING_OFF = 0, RING_BYTES = 131072;
constexpr int LDSCTL_OFF = RING_BYTES, MISC_OFF = LDSCTL_OFF + 320;
constexpr int LDS_BYTES = 163840;
constexpr int DSA_SCR = 133120;

struct Frame {
    LAS unsigned char* lds;
    volatile LAS unsigned* MISC;
    gu32* ctl;
    int tid, lane, wave, vcu, G;
};

__device__ __forceinline__ void relaunder(Frame& F) { int t = F.tid; asm volatile("" : "+v"(t)); F.tid = t; F.lane = t & 63; }
__device__ __forceinline__ float bf2f(unsigned short h) { return __uint_as_float(((unsigned)h) << 16); }
__device__ __forceinline__ float bflo(unsigned w) { return __uint_as_float(w << 16); }
__device__ __forceinline__ float bfhi(unsigned w) { return __uint_as_float(w & 0xffff0000u); }
__device__ __forceinline__ float wave_sum(float v) {
#pragma unroll
    for (int o = 1; o < 64; o <<= 1) v += __shfl_xor(v, o);
    return v;
}
__device__ __forceinline__ float wave_max(float v) {
#pragma unroll
    for (int o = 1; o < 64; o <<= 1) v = fmaxf(v, __shfl_xor(v, o));
    return v;
}
__device__ __forceinline__ float dpp_xor1(float v) { return __int_as_float(__builtin_amdgcn_mov_dpp(__float_as_int(v), 0xB1, 0xF, 0xF, true)); }
__device__ __forceinline__ float dpp_xor2(float v) { return __int_as_float(__builtin_amdgcn_mov_dpp(__float_as_int(v), 0x4E, 0xF, 0xF, true)); }
__device__ __forceinline__ float sum_xor32(float v) { auto r = __builtin_amdgcn_permlane32_swap(__float_as_uint(v), __float_as_uint(v), false, false); return __uint_as_float(r[0]) + __uint_as_float(r[1]); }
__device__ __forceinline__ float max_xor32(float v) { auto r = __builtin_amdgcn_permlane32_swap(__float_as_uint(v), __float_as_uint(v), false, false); return fmaxf(__uint_as_float(r[0]), __uint_as_float(r[1])); }
__device__ __forceinline__ float sum_xor16(float v) { auto r = __builtin_amdgcn_permlane16_swap(__float_as_uint(v), __float_as_uint(v), false, false); return __uint_as_float(r[0]) + __uint_as_float(r[1]); }
__device__ __forceinline__ float max_xor16(float v) { auto r = __builtin_amdgcn_permlane16_swap(__float_as_uint(v), __float_as_uint(v), false, false); return fmaxf(__uint_as_float(r[0]), __uint_as_float(r[1])); }
#define WSYNC() do { __builtin_amdgcn_wave_barrier(); asm volatile("s_waitcnt lgkmcnt(0)" ::: "memory"); __builtin_amdgcn_wave_barrier(); } while (0)

__device__ __forceinline__ int rel_bucket(int n) {
    if (n < 16) return n;
    if (n >= 113) return 31;
    int b = 16;
    b += (n >= 19); b += (n >= 21); b += (n >= 24); b += (n >= 27); b += (n >= 31); b += (n >= 35); b += (n >= 40); b += (n >= 46);
    b += (n >= 52); b += (n >= 59); b += (n >= 67); b += (n >= 77); b += (n >= 87); b += (n >= 99);
    return b;
}

struct Args { const float* in[27]; float* out; unsigned char* ws; int ph_lo, ph_hi; };
#ifndef FFN_F8
#define FFN_F8 1
#endif
struct TrItem { const float* W; bf16* WT; int N, K, k0, n0, drow; float f8scale; };
__device__ __forceinline__ void tr_set(TrItem& T, const float* W, int K, int N, int Npad, bf16* WT, int mode, int item, float f8scale = 0.f) {
    T.f8scale = f8scale;
    const int nblk = Npad / 32, kb = item / nblk, nb = item - kb * nblk, n0 = 32 * nb;
    T.W = W; T.WT = WT; T.N = N; T.K = K; T.k0 = 64 * kb; T.n0 = n0; T.drow = (mode == 0) ? n0 : ((n0 >> 7) * 256 + (mode - 1) * 128 + (n0 & 127));
}
constexpr int TR_I_NSA_IN = (DM / 64) * (NSA_NPAD / 32), TR_I_SQ = (DM / 64) * (DM / 32), TR_I_FFN = (DM / 64) * (DFF / 32), TR_I_FFD = (DFF / 64) * (DM / 32), TR_I_DSA_IN = (DM / 64) * (DSA_NPAD / 32);
constexpr int TR_I_CMP = (4096 / 64) * (128 / 32), TR_I_UK1 = (128 / 64) * (256 / 32), TR_I_UV1 = (256 / 64) * (128 / 32);
constexpr int TR_I_MG1 = (DM / 64) * (DFFE / 32), TR_I_MD1 = (DFFE / 64) * (DM / 32);
constexpr int TR_NITEMS = TR_I_NSA_IN + 2 * TR_I_SQ + 2 * TR_I_FFN + TR_I_FFD + TR_I_DSA_IN + 2 * TR_I_CMP + 16 * TR_I_UK1 + 16 * TR_I_UV1 + 16 * TR_I_MG1 + 8 * TR_I_MD1;
__device__ __forceinline__ void tr_decode(const Args& A, unsigned char* ws, int it, TrItem& T) {
    int r = it;
    if (r < TR_I_NSA_IN) { tr_set(T, A.in[2], DM, NSA_N, NSA_NPAD, (bf16*)(ws + WS_W_NSA_IN), 0, r); return; } r -= TR_I_NSA_IN;
    if (r < TR_I_SQ) { tr_set(T, A.in[9], DM, DM, DM, (bf16*)(ws + WS_W_NSA_OUT), 0, r); return; } r -= TR_I_SQ;
    if (r < TR_I_SQ) { tr_set(T, A.in[14], DM, DM, DM, (bf16*)(ws + WS_W_DSA_OUT), 0, r); return; } r -= TR_I_SQ;
    if (r < TR_I_FFN) { tr_set(T, A.in[15], DM, DFF, DFF, (bf16*)(ws + WS_W_FFN_GU), 1, r, FFN_F8 ? 64.f : 0.f); return; } r -= TR_I_FFN;
    if (r < TR_I_FFN) { tr_set(T, A.in[16], DM, DFF, DFF, (bf16*)(ws + WS_W_FFN_GU), 2, r, FFN_F8 ? 64.f : 0.f); return; } r -= TR_I_FFN;
    if (r < TR_I_FFD) { tr_set(T, A.in[17], DFF, DM, DM, (bf16*)(ws + WS_W_FFN_DN), 0, r, FFN_F8 ? 256.f : 0.f); return; } r -= TR_I_FFD;
    if (r < TR_I_DSA_IN) { tr_set(T, A.in[10], DM, DSA_N, DSA_NPAD, (bf16*)(ws + WS_W_DSA_IN), 0, r); return; } r -= TR_I_DSA_IN;
    if (r < TR_I_CMP) { tr_set(T, A.in[4], 4096, 128, 128, (bf16*)(ws + WS_W_CMPK), 0, r); return; } r -= TR_I_CMP;
    if (r < TR_I_CMP) { tr_set(T, A.in[7], 4096, 128, 128, (bf16*)(ws + WS_W_CMPV), 0, r); return; } r -= TR_I_CMP;
    if (r < 16 * TR_I_UK1) { const int h = r / TR_I_UK1; tr_set(T, A.in[12] + (size_t)h * 128 * 256, 128, 256, 256, (bf16*)(ws + WS_W_UK) + (size_t)h * 256 * 128, 0, r - h * TR_I_UK1); return; } r -= 16 * TR_I_UK1;
    if (r < 16 * TR_I_UV1) { const int h = r / TR_I_UV1; tr_set(T, A.in[13] + (size_t)h * 256 * 128, 256, 128, 128, (bf16*)(ws + WS_W_UV) + (size_t)h * 128 * 256, 0, r - h * TR_I_UV1); return; } r -= 16 * TR_I_UV1;
    if (r < 8 * TR_I_MG1) { const int e = r / TR_I_MG1; tr_set(T, A.in[20] + (size_t)e * DM * DFFE, DM, DFFE, DFFE, (bf16*)(ws + WS_W_MOE_GU + (size_t)e * 2 * DFFE * DM), 1, r - e * TR_I_MG1, 64.f); return; } r -= 8 * TR_I_MG1;
    if (r < 8 * TR_I_MG1) { const int e = r / TR_I_MG1; tr_set(T, A.in[21] + (size_t)e * DM * DFFE, DM, DFFE, DFFE, (bf16*)(ws + WS_W_MOE_GU + (size_t)e * 2 * DFFE * DM), 2, r - e * TR_I_MG1, 64.f); return; } r -= 8 * TR_I_MG1;
    { const int e = r / TR_I_MD1; tr_set(T, A.in[22] + (size_t)e * DFFE * DM, DFFE, DM, DM, (bf16*)(ws + WS_W_MOE_DN + (size_t)e * DM * DFFE), 0, r - e * TR_I_MD1, 256.f); }
}
__device__ __forceinline__ void tr_load(const TrItem& T, f32x4 (&v)[8], int lane) {
    const int kr = lane >> 3, c4 = lane & 7, n = T.n0 + 4 * c4;
#pragma unroll
    for (int i = 0; i < 8; ++i) v[i] = (n < T.N) ? *(const f32x4*)(T.W + (size_t)(T.k0 + 8 * i + kr) * T.N + n) : (f32x4){0.f, 0.f, 0.f, 0.f};
}
__device__ __forceinline__ void tr_store(const TrItem& T, const f32x4 (&v)[8], LAS float* scr, int lane) {
    { const int kr = lane >> 3, c4 = lane & 7;
#pragma unroll
      for (int i = 0; i < 8; ++i) { LAS float* d = scr + (8 * i + kr) * 33 + 4 * c4; d[0] = v[i][0]; d[1] = v[i][1]; d[2] = v[i][2]; d[3] = v[i][3]; } }
    LDS_WAIT(); asm volatile("" ::: "memory");
    const int c = lane & 7;
#pragma unroll
    for (int j = 0; j < 4; ++j) { const int n = (lane >> 3) + 8 * j; const LAS float* s = scr + (8 * c) * 33 + n;
        v4u o; o.x = pg8::cvt_pk_bf16(s[0 * 33], s[1 * 33]); o.y = pg8::cvt_pk_bf16(s[2 * 33], s[3 * 33]); o.z = pg8::cvt_pk_bf16(s[4 * 33], s[5 * 33]); o.w = pg8::cvt_pk_bf16(s[6 * 33], s[7 * 33]);
        *(v4u*)(T.WT + (size_t)(T.drow + n) * T.K + T.k0 + 8 * c) = o; }
    LDS_WAIT(); asm volatile("" ::: "memory");
}

__device__ __forceinline__ void tr_store8(const TrItem& T, const f32x4 (&v)[8], LAS float* scr, int lane) {
    { const int kr = lane >> 3, c4 = lane & 7;
#pragma unroll
      for (int i = 0; i < 8; ++i) { LAS float* d = scr + (8 * i + kr) * 33 + 4 * c4; d[0] = v[i][0]; d[1] = v[i][1]; d[2] = v[i][2]; d[3] = v[i][3]; } }
    LDS_WAIT(); asm volatile("" ::: "memory");
    const int c = lane & 3, nr = lane >> 2; const float sc = T.f8scale;
#pragma unroll
    for (int j = 0; j < 2; ++j) { const int n = nr + 16 * j; const LAS float* s = scr + (16 * c) * 33 + n; int w[4];
#pragma unroll
        for (int q = 0; q < 4; ++q) { w[q] = __builtin_amdgcn_cvt_pk_fp8_f32(s[(4 * q) * 33] * sc, s[(4 * q + 1) * 33] * sc, 0, false); w[q] = __builtin_amdgcn_cvt_pk_fp8_f32(s[(4 * q + 2) * 33] * sc, s[(4 * q + 3) * 33] * sc, w[q], true); }
        v4u o; o.x = (unsigned)w[0]; o.y = (unsigned)w[1]; o.z = (unsigned)w[2]; o.w = (unsigned)w[3];
        *(v4u*)((unsigned char*)T.WT + (size_t)(T.drow + n) * T.K + T.k0 + 16 * c) = o; }
    LDS_WAIT(); asm volatile("" ::: "memory");
}
__device__ __forceinline__ void p0_prologue(Frame& F, const Args& A) {
    LAS float* scr = (LAS float*)(F.lds + RING_OFF + F.wave * 16384);
    unsigned char* ws = A.ws;
    const int gw = F.vcu * NWAVES + F.wave, NGW = F.G * NWAVES, lane = F.lane;
    {
        TrItem T0, T1, T2, T3; f32x4 v0[8], v1[8], v2[8], v3[8]; int it = gw;
#define TR_ISSUE(T, v, idx) do { if ((idx) < TR_NITEMS) { tr_decode(A, ws, (idx), T); tr_load(T, v, lane); } } while (0)
#define TR_RETIRE(T, v, idx) do { if ((idx) < TR_NITEMS) { if (T.f8scale != 0.f) tr_store8(T, v, scr, lane); else tr_store(T, v, scr, lane); } } while (0)
        TR_ISSUE(T0, v0, it); TR_ISSUE(T1, v1, it + NGW); TR_ISSUE(T2, v2, it + 2 * NGW);
        while (it < TR_NITEMS) {
            TR_ISSUE(T3, v3, it + 3 * NGW); TR_RETIRE(T0, v0, it);
            TR_ISSUE(T0, v0, it + 4 * NGW); TR_RETIRE(T1, v1, it + NGW);
            TR_ISSUE(T1, v1, it + 5 * NGW); TR_RETIRE(T2, v2, it + 2 * NGW);
            TR_ISSUE(T2, v2, it + 6 * NGW); TR_RETIRE(T3, v3, it + 3 * NGW);
            it += 4 * NGW;
        }
#undef TR_ISSUE
#undef TR_RETIRE
    }
    { const float* x = A.in[0]; bf16* xb = (bf16*)(ws + WS_XB); const size_t n8 = (size_t)NTOK * DM / 8;
      for (size_t i = (size_t)F.vcu * 512 + F.tid; i < n8; i += (size_t)F.G * 512) { const f32x4 a = *(const f32x4*)(x + i * 8), b = *(const f32x4*)(x + i * 8 + 4);
          v4u o; o.x = pk2(a[0], a[1]); o.y = pk2(a[2], a[3]); o.z = pk2(b[0], b[1]); o.w = pk2(b[2], b[3]); *(v4u*)(xb + i * 8) = o; } }
    for (int it = gw; it < 64; it += NGW) { const int kv = it >> 5, ch = it & 31; const float* pe = A.in[kv ? 6 : 3]; const float* w1 = A.in[kv ? 7 : 4];
        float s0 = 0.f, s1 = 0.f;
        for (int k = ch * 128; k < ch * 128 + 128; ++k) { const float p = pe[k]; s0 += p * w1[(size_t)k * 128 + lane]; s1 += p * w1[(size_t)k * 128 + 64 + lane]; }
        float* cb = (float*)(ws + WS_CBIAS) + (size_t)(kv * 32 + ch) * 128; cb[lane] = s0; cb[64 + lane] = s1; }
}

typedef short s8v __attribute__((ext_vector_type(8)));
__device__ __forceinline__ s8v ld_frag(const bf16* p) { return *(const s8v*)p; }

__device__ __forceinline__ float gelu_tanh(float x) { const float u = 0.7978845608028654f * (x + 0.044715f * x * x * x); return 0.5f * x * (1.0f + tanhf(u)); }
__device__ __forceinline__ void p2_compress(Frame& F, const Args& A) {
    unsigned char* ws = A.ws; const int lane = F.lane, wid = F.wave, tid = F.tid;
    const bf16* P0 = (const bf16*)(ws + WS_P0);
    LAS float* part = (LAS float*)(F.lds + RING_OFF);
    LAS float* hid = (LAS float*)(F.lds + DSA_SCR);
    LAS float* cbl = hid + 4096;
    if (tid < 256) { const float* cbp = (const float*)(ws + WS_CBIAS) + (size_t)(tid >> 7) * 32 * 128 + (tid & 127); float cb = 0.f; for (int ch = 0; ch < 32; ++ch) cb += cbp[ch * 128]; cbl[tid] = cb; }
    if (F.vcu < 16 && wid == 0) { bf16* zp = (bf16*)(ws + ((F.vcu & 1) ? WS_VCMP : WS_KCMP)) + ((size_t)(F.vcu >> 1) * 512 + 511) * 128; zp[lane] = 0; zp[64 + lane] = 0; }
    __syncthreads();
    const int r16 = lane & 15, kq = lane >> 4;
    for (int it = F.vcu; it < 256; it += F.G) {
        const int kv = it >> 7, tile = it & 127;
        const bf16* W1T = (const bf16*)(ws + (kv ? WS_W_CMPV : WS_W_CMPK));
        const float* w2 = A.in[kv ? 8 : 5];
        bf16* outp = (bf16*)(ws + (kv ? WS_VCMP : WS_KCMP));
        const int colbase = kv ? COL_VC : COL_KC;
        f32x4 acc[2][8];
#pragma unroll
        for (int m = 0; m < 2; ++m)
#pragma unroll
            for (int n = 0; n < 8; ++n) acc[m][n] = (f32x4){0.f, 0.f, 0.f, 0.f};
        const bf16* arow[2];
#pragma unroll
        for (int m = 0; m < 2; ++m) { int R = tile * 32 + m * 16 + r16; if (R > 4087) R = 4087; const int g = R & 3, bn = R >> 2, b = bn / NCMP, n = bn - b * NCMP;
            arow[m] = P0 + (size_t)(b * SEQ + 16 * n) * P0LD + colbase + g * 128 + kq * 8; }
#pragma unroll 2
        for (int kk = 0; kk < 16; ++kk) {
            const int ks = wid * 16 + kk, l = ks >> 2, d0 = (ks & 3) * 32;
            s8v af[2], bfr[8];
#pragma unroll
            for (int m = 0; m < 2; ++m) af[m] = ld_frag(arow[m] + (size_t)l * P0LD + d0);
#pragma unroll
            for (int n = 0; n < 8; ++n) bfr[n] = ld_frag(W1T + (size_t)(n * 16 + r16) * 4096 + ks * 32 + kq * 8);
#pragma unroll
            for (int m = 0; m < 2; ++m)
#pragma unroll
                for (int n = 0; n < 8; ++n) acc[m][n] = __builtin_amdgcn_mfma_f32_16x16x32_bf16(af[m], bfr[n], acc[m][n], 0, 0, 0);
        }
#pragma unroll
        for (int m = 0; m < 2; ++m)
#pragma unroll
            for (int n = 0; n < 8; ++n)
#pragma unroll
                for (int j = 0; j < 4; ++j) part[wid * 4096 + (m * 16 + kq * 4 + j) * 128 + n * 16 + r16] = acc[m][n][j];
        __syncthreads();
        { const int row = tid >> 4, e0 = (tid & 15) * 8; f32x4 s0 = (f32x4){0.f, 0.f, 0.f, 0.f}, s1 = s0;
#pragma unroll
          for (int w = 0; w < 8; ++w) { s0 += *(const LAS f32x4*)(part + w * 4096 + row * 128 + e0); s1 += *(const LAS f32x4*)(part + w * 4096 + row * 128 + e0 + 4); }
#pragma unroll
          for (int j = 0; j < 4; ++j) { hid[row * 128 + e0 + j] = gelu_tanh(s0[j] + cbl[kv * 128 + e0 + j]); hid[row * 128 + e0 + 4 + j] = gelu_tanh(s1[j] + cbl[kv * 128 + e0 + 4 + j]); } }
        __syncthreads();
        { const int rr = tid >> 4, f0 = (tid & 15) * 8, R = tile * 32 + rr; f32x4 o0 = (f32x4){0.f, 0.f, 0.f, 0.f}, o1 = o0;
#pragma unroll 4
          for (int e = 0; e < 128; ++e) { const float hv = hid[rr * 128 + e]; o0 += *(const f32x4*)(w2 + e * 128 + f0) * hv; o1 += *(const f32x4*)(w2 + e * 128 + f0 + 4) * hv; }
          if (R <= 4087) { const int g = R & 3, bn = R >> 2, b = bn / NCMP, n = bn - b * NCMP;
              v4u o; o.x = pk2(o0[0], o0[1]); o.y = pk2(o0[2], o0[3]); o.z = pk2(o1[0], o1[1]); o.w = pk2(o1[2], o1[3]);
              *(v4u*)(outp + ((size_t)(b * 4 + g) * 512 + n) * 128 + f0) = o; } }
        __syncthreads();
    }
}

namespace fa {
typedef float f32x16 __attribute__((ext_vector_type(16)));
typedef short s16x4 __attribute__((ext_vector_type(4)));
typedef unsigned u32x4v __attribute__((ext_vector_type(4)));
constexpr int SHM_K = 16384, SHM_V = 16384;
constexpr int OFF_V = 0, OFF_K = 2 * SHM_V, OFF_WS = 2 * SHM_V + 2 * SHM_K, OFF_LUT = OFF_WS + 8 * 256, OFF_MASK = OFF_LUT + 144 * 16 * 4, OFF_TAB = OFF_MASK + 1024;
constexpr int TABLD = 130;
constexpr float C2 = 1.4426950408889634f, THR = 8.f;
#define FA_KSWZ(row, colB) ((row) * 256 + ((colB) ^ (((row) & 7) << 4)))
#define FA_SBAR() __builtin_amdgcn_sched_barrier(0)
__device__ __forceinline__ int v_st(int k, int c) { const int kk = (k & ~0xC) | ((k & 4) << 1) | ((k & 8) >> 1); return ((kk >> 3) * 4 + (c >> 5)) * 512 + ((kk & 7) * 32 + (c & 31)) * 2; }
__device__ __forceinline__ int v_rd_base(int lane) { return ((lane & 3) << 3) | (((lane >> 2) & 3) << 6) | (((lane >> 4) & 1) << 5) | (((lane >> 5) & 1) << 8); }
constexpr int v_rd_off(int d0, int ks, int half) { return d0 * 512 + ks * 4096 + half * 2048; }
__device__ __forceinline__ int crow(int r, int hi) { return (r & 3) + 8 * (r >> 2) + 4 * hi; }
__device__ __forceinline__ unsigned cvtpk(float lo, float hi) { unsigned r; asm volatile("v_cvt_pk_bf16_f32 %0, %1, %2" : "=v"(r) : "v"(lo), "v"(hi)); return r; }

__device__ __forceinline__ void qkt(f32x16& p0, f32x16& p1, const LAS char* Kb, int r32, int hi, const bf16x8 (&qr)[8], float init) {
#pragma unroll
    for (int r = 0; r < 16; ++r) { p0[r] = init; p1[r] = init; }
    const LAS char* kb[4];
#pragma unroll
    for (int dd = 0; dd < 4; ++dd) kb[dd] = Kb + FA_KSWZ(r32, (dd * 16 + hi * 8) * 2);
#pragma unroll
    for (int d0 = 0; d0 < 8; ++d0) { const LAS char* a = kb[d0 & 3] + (d0 >> 2) * 128;
        const bf16x8 b0 = *(const LAS bf16x8*)a;
        const bf16x8 b1 = *(const LAS bf16x8*)(a + 32 * 256);
        p0 = __builtin_amdgcn_mfma_f32_32x32x16_bf16(b0, qr[d0], p0, 0, 0, 0);
        p1 = __builtin_amdgcn_mfma_f32_32x32x16_bf16(b1, qr[d0], p1, 0, 0, 0); }
}
__device__ __forceinline__ void pv_tile(f32x16 (&o)[4], int vb0, bf16x8 pa0, bf16x8 pa1, bf16x8 pa2, bf16x8 pa3) {
#define FA_TRRD(dst, off) asm volatile("ds_read_b64_tr_b16 %0, %1 offset:%2" : "=&v"(dst) : "v"(vb0), "i"(off) : "memory")
#define FA_PV_D0(d0) do { s16x4 l0, l1, l2, l3, h0, h1, h2, h3; constexpr int b_ = v_rd_off(d0, 0, 0); \
        FA_TRRD(l0, b_); FA_TRRD(h0, b_ + 2048); FA_TRRD(l1, b_ + 4096); FA_TRRD(h1, b_ + 6144); FA_TRRD(l2, b_ + 8192); FA_TRRD(h2, b_ + 10240); FA_TRRD(l3, b_ + 12288); FA_TRRD(h3, b_ + 14336); \
        asm volatile("s_waitcnt lgkmcnt(0)" ::: "memory"); FA_SBAR(); \
        o[d0] = __builtin_amdgcn_mfma_f32_32x32x16_bf16(pa0, (bf16x8){l0[0], l0[1], l0[2], l0[3], h0[0], h0[1], h0[2], h0[3]}, o[d0], 0, 0, 0); \
        o[d0] = __builtin_amdgcn_mfma_f32_32x32x16_bf16(pa1, (bf16x8){l1[0], l1[1], l1[2], l1[3], h1[0], h1[1], h1[2], h1[3]}, o[d0], 0, 0, 0); \
        o[d0] = __builtin_amdgcn_mfma_f32_32x32x16_bf16(pa2, (bf16x8){l2[0], l2[1], l2[2], l2[3], h2[0], h2[1], h2[2], h2[3]}, o[d0], 0, 0, 0); \
        o[d0] = __builtin_amdgcn_mfma_f32_32x32x16_bf16(pa3, (bf16x8){l3[0], l3[1], l3[2], l3[3], h3[0], h3[1], h3[2], h3[3]}, o[d0], 0, 0, 0); } while (0)
    FA_PV_D0(0); FA_PV_D0(1); FA_PV_D0(2); FA_PV_D0(3);
#undef FA_PV_D0
#undef FA_TRRD
}
__device__ __forceinline__ void partialSM(f32x16& p0, f32x16& p1, float& m_reg, float& alpha) {
    float pmax = p0[0];
#pragma unroll
    for (int r = 1; r < 16; ++r) pmax = fmaxf(pmax, p0[r]);
#pragma unroll
    for (int r = 0; r < 16; ++r) pmax = fmaxf(pmax, p1[r]);
    { auto rr = __builtin_amdgcn_permlane32_swap(__float_as_uint(pmax), __float_as_uint(pmax), false, false); pmax = fmaxf(__uint_as_float(rr[0]), __uint_as_float(rr[1])); }
    float mn;
    if (__all(pmax - m_reg <= THR)) { mn = m_reg; alpha = 1.f; }
    else { mn = fmaxf(m_reg, pmax); alpha = __builtin_amdgcn_exp2f((m_reg - mn) * C2); m_reg = mn; }
    const float mnL = -mn * C2;
#pragma unroll
    for (int r = 0; r < 16; ++r) { p0[r] = __builtin_amdgcn_exp2f(fmaf(p0[r], C2, mnL)); p1[r] = __builtin_amdgcn_exp2f(fmaf(p1[r], C2, mnL)); }
}
__device__ __forceinline__ float finishSM(const f32x16& p0, const f32x16& p1, bf16x8& pa0, bf16x8& pa1, bf16x8& pa2, bf16x8& pa3) {
    float ps = 0.f;
#pragma unroll
    for (int r = 0; r < 16; ++r) ps += p0[r];
#pragma unroll
    for (int r = 0; r < 16; ++r) ps += p1[r];
    { auto rr = __builtin_amdgcn_permlane32_swap(__float_as_uint(ps), __float_as_uint(ps), false, false); ps = __uint_as_float(rr[0]) + __uint_as_float(rr[1]); }
#define FA_PK4(P, B_, OUT) do { unsigned a0 = cvtpk(P[B_ + 0], P[B_ + 1]), a1 = cvtpk(P[B_ + 2], P[B_ + 3]); unsigned b0 = cvtpk(P[B_ + 4], P[B_ + 5]), b1 = cvtpk(P[B_ + 6], P[B_ + 7]); \
        auto r0 = __builtin_amdgcn_permlane32_swap(a0, b0, false, false); auto r1 = __builtin_amdgcn_permlane32_swap(a1, b1, false, false); \
        u32x4v w = {r0[0], r1[0], r0[1], r1[1]}; OUT = *reinterpret_cast<bf16x8*>(&w); } while (0)
    FA_PK4(p0, 0, pa0); FA_PK4(p0, 8, pa1); FA_PK4(p1, 0, pa2); FA_PK4(p1, 8, pa3);
#undef FA_PK4
    return ps;
}
__device__ __forceinline__ void rescale(f32x16 (&o)[4], float alpha, LAS float* al_l, int r32, int hi) {
    if (__any(alpha < 1.f)) { if (hi == 0) al_l[r32] = alpha; asm volatile("s_waitcnt lgkmcnt(0)" ::: "memory");
#pragma unroll
        for (int r = 0; r < 16; ++r) { const float a = al_l[crow(r, hi)];
#pragma unroll
            for (int d = 0; d < 4; ++d) o[d][r] *= a; }
        asm volatile("s_waitcnt lgkmcnt(0)" ::: "memory"); }
}
__device__ __forceinline__ void mask_tile(f32x16& p0, f32x16& p1, int dq, unsigned W) {
    const float NEG = -__builtin_inff();
#pragma unroll
    for (int r = 0; r < 16; ++r) { const int c = (r & 3) + 8 * (r >> 2);
        if ((unsigned)(dq - c) >= W) p0[r] = NEG;
        if ((unsigned)(dq - c - 32) >= W) p1[r] = NEG; }
}
__device__ __forceinline__ void mask_all(f32x16& p0, f32x16& p1, bool keep) {
    const float NEG = -__builtin_inff();
#pragma unroll
    for (int r = 0; r < 16; ++r) { p0[r] = keep ? p0[r] : NEG; p1[r] = keep ? p1[r] : NEG; }
}
__device__ __forceinline__ void bias_near(f32x16& p0, f32x16& p1, int dq, int step, const LAS float* lutcol) {
#pragma unroll
    for (int r = 0; r < 16; ++r) { const int c = (r & 3) + 8 * (r >> 2);
        const int d0 = min(max((dq - c) * step, 0), 128), d1 = min(max((dq - c - 32) * step, 0), 128);
        p0[r] += lutcol[d0]; p1[r] += lutcol[d1]; }
}
struct Stage { bf16x8 k0, k1, v0, v1; };
__device__ __forceinline__ void stage_load(Stage& S, const bf16* Kp, const bf16* Vp, size_t ld, int row0, int maxrow, int sr, int sc) {
    const int ra = min(row0 + sr, maxrow), rb = min(row0 + 32 + sr, maxrow);
    S.k0 = *(const bf16x8*)(Kp + (size_t)ra * ld + sc); S.k1 = *(const bf16x8*)(Kp + (size_t)rb * ld + sc);
    S.v0 = *(const bf16x8*)(Vp + (size_t)ra * ld + sc); S.v1 = *(const bf16x8*)(Vp + (size_t)rb * ld + sc);
}
__device__ __forceinline__ void stage_write(const Stage& S, LAS char* Kb, LAS char* Vb, int kws, int vst0, int vst1) {
    *(LAS bf16x8*)(Kb + kws) = S.k0; *(LAS bf16x8*)(Kb + kws + 32 * 256) = S.k1;
    *(LAS bf16x8*)(Vb + vst0) = S.v0; *(LAS bf16x8*)(Vb + vst1) = S.v1;
}
}

struct NsaLane { int wid, lane, r32, hi, ql, j, sr, sc, kws, vst0, vst1, vrd; };
__device__ __forceinline__ NsaLane nsa_lane(const Frame& F) {
    NsaLane L; L.wid = F.wave; L.lane = F.lane; L.r32 = F.lane & 31; L.hi = F.lane >> 5; L.ql = L.r32 >> 2; L.j = L.r32 & 3;
    L.sr = F.tid >> 4; L.sc = (F.tid & 15) * 8; L.kws = FA_KSWZ(L.sr, L.sc * 2); L.vst0 = fa::v_st(L.sr, L.sc); L.vst1 = fa::v_st(32 + L.sr, L.sc); L.vrd = fa::v_rd_base(F.lane);
    return L;
}
__device__ __forceinline__ void nsa_load_q(bf16x8 (&qr)[8], const bf16* P0, int tok0, int g, const NsaLane& L) {
    const bf16* qp = P0 + (size_t)(tok0 + L.wid * 8 + L.ql) * P0LD + (g * 4 + L.j) * 128 + L.hi * 8;
#pragma unroll
    for (int d0 = 0; d0 < 8; ++d0) qr[d0] = *(const bf16x8*)(qp + d0 * 16);
}
__device__ __forceinline__ void nsa_lut(Frame& F, const Args& A) {
    LAS float* lut = (LAS float*)(F.lds + RING_OFF + fa::OFF_LUT);
    for (int i = F.tid; i < 144 * 16; i += 512) { const int n = i >> 4, h = i & 15; lut[h * 144 + n] = A.in[1][rel_bucket(n) * 16 + h]; }
    __syncthreads();
}
template <int MODE>
__device__ __forceinline__ void nsa_store(const fa::f32x16 (&o)[4], float l_reg, LAS float* li_l, const float* GL, float* OACC, bf16* OATT, int tok0, int g, int br, const NsaLane& L) {
    if (L.hi == 0) li_l[L.r32] = l_reg;
    asm volatile("s_waitcnt lgkmcnt(0)" ::: "memory");
    float sc[16];
#pragma unroll
    for (int r = 0; r < 16; ++r) { const int row = fa::crow(r, L.hi), tok = tok0 + L.wid * 8 + (row >> 2), h = g * 4 + (row & 3); sc[r] = GL[(size_t)tok * 48 + h * 3 + br]; }
    float prev[4][16];
    if (MODE != 0) {
#pragma unroll
        for (int r = 0; r < 16; ++r) { const int row = fa::crow(r, L.hi), tok = tok0 + L.wid * 8 + (row >> 2), h = g * 4 + (row & 3); const float* ap = OACC + (size_t)tok * DM + h * 128 + L.r32;
#pragma unroll
            for (int d0 = 0; d0 < 4; ++d0) prev[d0][r] = ap[d0 * 32]; } }
#pragma unroll
    for (int r = 0; r < 16; ++r) { const int row = fa::crow(r, L.hi), tok = tok0 + L.wid * 8 + (row >> 2), h = g * 4 + (row & 3);
        const float l = li_l[row]; const float gl = sc[r];
        const float scl = (l > 0.f) ? __builtin_amdgcn_rcpf(l) / (1.0f + __expf(-gl)) : 0.f;
        float* ap = OACC + (size_t)tok * DM + h * 128 + L.r32;
#pragma unroll
        for (int d0 = 0; d0 < 4; ++d0) { float v = o[d0][r] * scl;
            if (MODE == 0) ap[d0 * 32] = v;
            else if (MODE == 1) ap[d0 * 32] = prev[d0][r] + v;
            else { v += prev[d0][r]; const float vn = dpp_xor1(v); if ((L.r32 & 1) == 0) *(unsigned*)(OATT + (size_t)tok * DM + h * 128 + d0 * 32 + L.r32) = fa::cvtpk(v, vn); } } }
    asm volatile("s_waitcnt lgkmcnt(0)" ::: "memory");
}

__device__ __forceinline__ void p3a_nsa_cmp(Frame& F, const Args& A) {
    unsigned char* ws = A.ws; const NsaLane L = nsa_lane(F);
    const bf16* P0 = (const bf16*)(ws + WS_P0); const bf16* KCB = (const bf16*)(ws + WS_KCMP); const bf16* VCB = (const bf16*)(ws + WS_VCMP);
    const float* GL = (const float*)(ws + WS_GL); float* OACC = (float*)(ws + WS_Z); unsigned* SELM = (unsigned*)(ws + WS_SELM);
    nsa_lut(F, A);
    LAS char* lds = (LAS char*)(F.lds + RING_OFF);
    LAS float* wsf = (LAS float*)(lds + fa::OFF_WS) + L.wid * 64; LAS float* li_l = wsf; LAS float* al_l = wsf + 32;
    const LAS float* lut = (const LAS float*)(lds + fa::OFF_LUT);
    LAS float* tab = (LAS float*)(lds + fa::OFF_TAB);
    for (int ui = 0; ui < 2 * ((512 - F.vcu + F.G - 1) / F.G); ++ui) {
        const int p = F.vcu + (ui >> 1) * F.G, bg = p >> 6, y = p & 63, qb = (ui & 1) ? 127 - y : y, b = bg >> 2, g = bg & 3;
        const int tok0 = b * SEQ + qb * 64;
        bf16x8 qr[8]; nsa_load_q(qr, P0, tok0, g, L);
        const int trow = qb * 64 + L.wid * 8 + L.ql;
        const int h = g * 4 + L.j; const LAS float* lutcol = lut + h * 144; const float bias_far = lutcol[128];
        const int nmaxrow = (trow >= 31) ? (trow - 31) >> 4 : -1;
        const int NT = (4 * qb + 3 + 63) >> 6;
        const bf16* Kg = KCB + (size_t)(b * 4 + g) * 512 * 128; const bf16* Vg = VCB + (size_t)(b * 4 + g) * 512 * 128;
        for (int i = F.tid; i < 64 * fa::TABLD; i += 512) tab[i] = 0.f;
        float m_reg = -1e30f, l_reg = 0.f;
        fa::Stage S;
        const int rem16 = (trow >= 31) ? ((trow - 31) & 15) : 0;
        fa::stage_load(S, Kg, Vg, 128, 0, 511, L.sr, L.sc); asm volatile("s_waitcnt vmcnt(0)" ::: "memory");
        fa::stage_write(S, lds + fa::OFF_K, lds + fa::OFF_V, L.kws, L.vst0, L.vst1);
        __syncthreads();
#pragma unroll 1
        for (int t = 0; t < NT; ++t) {
            const int buf = t & 1;
            if (t + 1 < NT) fa::stage_load(S, Kg, Vg, 128, (t + 1) * 64, 511, L.sr, L.sc);
            fa::f32x16 p0, p1;
            const bool farT = (qb * 64 + L.wid * 8) - 31 - 16 * (t * 64 + 63) >= 128;
            fa::qkt(p0, p1, lds + fa::OFF_K + buf * fa::SHM_K, L.r32, L.hi, qr, farT ? bias_far : 0.f);
            const int dq = nmaxrow - t * 64 - 4 * L.hi;
            if (!farT) fa::bias_near(p0, p1, dq, 16, lutcol + rem16);
            fa::mask_tile(p0, p1, dq, 0x40000000u);
            float alpha; fa::partialSM(p0, p1, m_reg, alpha);
            float ps = 0.f;
#pragma unroll
            for (int r = 0; r < 16; ++r) ps += p0[r] + p1[r];
            { auto rr = __builtin_amdgcn_permlane32_swap(__float_as_uint(ps), __float_as_uint(ps), false, false); ps = __uint_as_float(rr[0]) + __uint_as_float(rr[1]); }
            l_reg = l_reg * alpha + ps;
            if (t + 1 < NT) { asm volatile("s_waitcnt vmcnt(0)" ::: "memory"); fa::stage_write(S, lds + fa::OFF_K + (buf ^ 1) * fa::SHM_K, lds + fa::OFF_V + (buf ^ 1) * fa::SHM_V, L.kws, L.vst0, L.vst1); }
            __syncthreads();
        }
        fa::f32x16 o[4];
#pragma unroll
        for (int d = 0; d < 4; ++d)
#pragma unroll
            for (int r = 0; r < 16; ++r) o[d][r] = 0.f;
        fa::stage_load(S, Kg, Vg, 128, 0, 511, L.sr, L.sc); asm volatile("s_waitcnt vmcnt(0)" ::: "memory");
        fa::stage_write(S, lds + fa::OFF_K, lds + fa::OFF_V, L.kws, L.vst0, L.vst1);
        __syncthreads();
        const float inv_l = (l_reg > 0.f) ? 1.0f / l_reg : 0.f; const float mnL = -m_reg * fa::C2;
#pragma unroll 1
        for (int t = 0; t < NT; ++t) {
            const int buf = t & 1;
            if (t + 1 < NT) fa::stage_load(S, Kg, Vg, 128, (t + 1) * 64, 511, L.sr, L.sc);
            fa::f32x16 p0, p1;
            const bool farT = (qb * 64 + L.wid * 8) - 31 - 16 * (t * 64 + 63) >= 128;
            fa::qkt(p0, p1, lds + fa::OFF_K + buf * fa::SHM_K, L.r32, L.hi, qr, farT ? bias_far : 0.f);
            const int dq = nmaxrow - t * 64 - 4 * L.hi;
            if (!farT) fa::bias_near(p0, p1, dq, 16, lutcol + rem16);
            fa::mask_tile(p0, p1, dq, 0x40000000u);
#pragma unroll
            for (int r = 0; r < 16; ++r) { p0[r] = __builtin_amdgcn_exp2f(fmaf(p0[r], fa::C2, mnL)) * inv_l; p1[r] = __builtin_amdgcn_exp2f(fmaf(p1[r], fa::C2, mnL)) * inv_l; }
            LAS float* tb = tab + (L.wid * 8 + L.ql) * fa::TABLD + t * 16 + L.hi;
#pragma unroll
            for (int half = 0; half < 2; ++half)
#pragma unroll
                for (int gq = 0; gq < 4; ++gq) { const fa::f32x16& pp = half ? p1 : p0;
                    float s4 = pp[4 * gq] + pp[4 * gq + 1] + pp[4 * gq + 2] + 0.5f * pp[4 * gq + 3], cr = 0.5f * pp[4 * gq + 3];
                    s4 += dpp_xor1(s4); s4 += dpp_xor2(s4); cr += dpp_xor1(cr); cr += dpp_xor2(cr);
                    if (L.j == 0) { __hip_atomic_fetch_add(tb + half * 8 + 2 * gq, s4, __ATOMIC_RELAXED, __HIP_MEMORY_SCOPE_WORKGROUP); __hip_atomic_fetch_add(tb + half * 8 + 2 * gq + 1, cr, __ATOMIC_RELAXED, __HIP_MEMORY_SCOPE_WORKGROUP); } }
            bf16x8 a0, a1, a2, a3; (void)fa::finishSM(p0, p1, a0, a1, a2, a3);
            fa::pv_tile(o, (int)(uintptr_t)(lds + fa::OFF_V + buf * fa::SHM_V) + L.vrd, a0, a1, a2, a3);
            if (t + 1 < NT) { asm volatile("s_waitcnt vmcnt(0)" ::: "memory"); fa::stage_write(S, lds + fa::OFF_K + (buf ^ 1) * fa::SHM_K, lds + fa::OFF_V + (buf ^ 1) * fa::SHM_V, L.kws, L.vst0, L.vst1); }
            __syncthreads();
        }
        nsa_store<0>(o, (l_reg > 0.f) ? 1.0f : 0.f, li_l, GL, OACC, nullptr, tok0, g, 0, L);
        __syncthreads();
        {
            bool s0[8], s1[8];
            if (qb < 16) {
#pragma unroll
                for (int qi = 0; qi < 8; ++qi) { s0[qi] = (L.lane <= qb); s1[qi] = false; }
            } else {
                unsigned k0[8], k1[8], lo[8];
#pragma unroll
                for (int qi = 0; qi < 8; ++qi) { const int ql = L.wid * 8 + qi;
                    const bool c0 = (L.lane >= 1 && L.lane <= qb - 2), c1 = (L.lane + 64 <= qb - 2);
                    k0[qi] = c0 ? __float_as_uint(tab[ql * fa::TABLD + L.lane]) + 1u : 0u; k1[qi] = c1 ? __float_as_uint(tab[ql * fa::TABLD + L.lane + 64]) + 1u : 0u;
                    s0[qi] = (L.lane == 0) || (L.lane == qb) || (L.lane == qb - 1); s1[qi] = (L.lane + 64 == qb) || (L.lane + 64 == qb - 1); lo[qi] = 0u; }
#pragma unroll 1
                for (int bit = 30; bit >= 0; --bit) {
#pragma unroll
                    for (int qi = 0; qi < 8; ++qi) { const unsigned cand = lo[qi] | (1u << bit);
                        const int cnt = __popcll(__ballot(k0[qi] >= cand)) + __popcll(__ballot(k1[qi] >= cand));
                        lo[qi] = (cnt >= 13) ? cand : lo[qi]; } }
#pragma unroll
                for (int qi = 0; qi < 8; ++qi) { const unsigned T = lo[qi];
                    const bool g0 = k0[qi] > T, g1 = k1[qi] > T, e0 = k0[qi] == T, e1 = k1[qi] == T;
                    const int need = 13 - (__popcll(__ballot(g0)) + __popcll(__ballot(g1)));
                    const unsigned long long be0 = __ballot(e0), be1 = __ballot(e1);
                    const int r0 = (int)__builtin_amdgcn_mbcnt_hi((unsigned)(be0 >> 32), __builtin_amdgcn_mbcnt_lo((unsigned)be0, 0u));
                    const int r1 = __popcll(be0) + (int)__builtin_amdgcn_mbcnt_hi((unsigned)(be1 >> 32), __builtin_amdgcn_mbcnt_lo((unsigned)be1, 0u));
                    s0[qi] = s0[qi] || g0 || (e0 && r0 < need); s1[qi] = s1[qi] || g1 || (e1 && r1 < need); }
            }
#pragma unroll
            for (int qi = 0; qi < 8; ++qi) { const int ql = L.wid * 8 + qi; const unsigned long long b0 = __ballot(s0[qi]), b1 = __ballot(s1[qi]);
                if (L.lane == 0) { uint4 mv; mv.x = (unsigned)b0; mv.y = (unsigned)(b0 >> 32); mv.z = (unsigned)b1; mv.w = (unsigned)(b1 >> 32); *(uint4*)(SELM + ((size_t)(tok0 + ql) * 4 + g) * 4) = mv; } }
        }
        __syncthreads();
    }
}
constexpr int N3_OFF_V = 0, N3_OFF_K = 3 * fa::SHM_V, N3_OFF_WS = 3 * fa::SHM_V + 3 * fa::SHM_K, N3_OFF_LUT = N3_OFF_WS + 8 * 256;
__device__ __forceinline__ void nsa_lut3(Frame& F, const Args& A) {
    LAS float* lut = (LAS float*)(F.lds + RING_OFF + N3_OFF_LUT);
    for (int i = F.tid; i < 144 * 16; i += 512) { const int n = i >> 4, h = i & 15; lut[h * 144 + n] = A.in[1][rel_bucket(n) * 16 + h]; }
    __syncthreads();
}
__device__ __forceinline__ void p3b_nsa_sel(Frame& F, const Args& A) {
    unsigned char* ws = A.ws; const NsaLane L = nsa_lane(F);
    const bf16* P0 = (const bf16*)(ws + WS_P0); const float* GL = (const float*)(ws + WS_GL); float* OACC = (float*)(ws + WS_Z); const unsigned* SELM = (const unsigned*)(ws + WS_SELM);
    nsa_lut3(F, A);
    LAS char* lds = (LAS char*)(F.lds + RING_OFF);
    LAS float* wsf = (LAS float*)(lds + N3_OFF_WS) + L.wid * 64; LAS float* li_l = wsf; LAS float* al_l = wsf + 32;
    const LAS float* lut = (const LAS float*)(lds + N3_OFF_LUT);
    const bool grpB = L.wid >= 4;
    for (int ui = 0; ui < 2 * ((512 - F.vcu + F.G - 1) / F.G); ++ui) {
        const int p = F.vcu + (ui >> 1) * F.G, bg = p >> 6, y = p & 63, qb = (ui & 1) ? 127 - y : y, b = bg >> 2, g = bg & 3;
        const int tok0 = b * SEQ + qb * 64;
        bf16x8 qr[8]; nsa_load_q(qr, P0, tok0, g, L);
        const int trow = qb * 64 + L.wid * 8 + L.ql;
        const int h = g * 4 + L.j; const LAS float* lutcol = lut + h * 144; const float bias_far = lutcol[128];
        const uint4 mv = *(const uint4*)(SELM + ((size_t)(tok0 + L.wid * 8 + L.ql) * 4 + g) * 4);
        const bf16* Kg = P0 + (size_t)b * SEQ * P0LD + COL_KS + g * 128; const bf16* Vg = P0 + (size_t)b * SEQ * P0LD + COL_VS + g * 128;
        const int NT = qb + 1;
        float m_reg = -1e30f, l_reg = 0.f; fa::f32x16 o[4];
#pragma unroll
        for (int d = 0; d < 4; ++d)
#pragma unroll
            for (int r = 0; r < 16; ++r) o[d][r] = 0.f;
        fa::Stage S;
        fa::stage_load(S, Kg, Vg, P0LD, 0, SEQ - 1, L.sr, L.sc); asm volatile("s_waitcnt vmcnt(0)" ::: "memory");
        fa::stage_write(S, lds + N3_OFF_K, lds + N3_OFF_V, L.kws, L.vst0, L.vst1);
        __syncthreads();
        bf16x8 a0 = {0, 0, 0, 0, 0, 0, 0, 0}, a1 = a0, a2 = a0, a3 = a0; bool actp = false;
        int bcur = 0, bprev = 2;
#pragma unroll 1
        for (int t = 0; t < NT; ++t) {
            const int bnext = (bcur == 2) ? 0 : bcur + 1;
            if (t + 1 < NT) fa::stage_load(S, Kg, Vg, P0LD, (t + 1) * 64, SEQ - 1, L.sr, L.sc);
            const unsigned word = (t < 32) ? mv.x : (t < 64) ? mv.y : (t < 96) ? mv.z : mv.w;
            const bool mine = ((word >> (t & 31)) & 1u) != 0u;
            const bool act = __any(mine);
            if (grpB && actp) fa::pv_tile(o, (int)(uintptr_t)(lds + N3_OFF_V + bprev * fa::SHM_V) + L.vrd, a0, a1, a2, a3);
            if (act) {
                fa::f32x16 p0, p1;
                const bool farT = (qb * 64 + L.wid * 8) - (t * 64 + 63) >= 128;
                fa::qkt(p0, p1, lds + N3_OFF_K + bcur * fa::SHM_K, L.r32, L.hi, qr, mine ? (farT ? bias_far : 0.f) : -__builtin_inff());
                const int dq = trow - t * 64 - 4 * L.hi;
                if (!farT) fa::bias_near(p0, p1, dq, 1, lutcol);
                if (t == qb) fa::mask_tile(p0, p1, dq, 0x40000000u);
                float alpha; fa::partialSM(p0, p1, m_reg, alpha);
                fa::rescale(o, alpha, al_l, L.r32, L.hi);
                const float ps = fa::finishSM(p0, p1, a0, a1, a2, a3); l_reg = l_reg * alpha + ps;
                if (!grpB) fa::pv_tile(o, (int)(uintptr_t)(lds + N3_OFF_V + bcur * fa::SHM_V) + L.vrd, a0, a1, a2, a3);
            }
            actp = act;
            if (t + 1 < NT) { asm volatile("s_waitcnt vmcnt(0)" ::: "memory"); fa::stage_write(S, lds + N3_OFF_K + bnext * fa::SHM_K, lds + N3_OFF_V + bnext * fa::SHM_V, L.kws, L.vst0, L.vst1); }
            __syncthreads();
            bprev = bcur; bcur = bnext;
        }
        if (grpB && actp) fa::pv_tile(o, (int)(uintptr_t)(lds + N3_OFF_V + bprev * fa::SHM_V) + L.vrd, a0, a1, a2, a3);
        nsa_store<1>(o, l_reg, li_l, GL, OACC, nullptr, tok0, g, 1, L);
        __syncthreads();
    }
}
__device__ __forceinline__ void p3c_nsa_win(Frame& F, const Args& A) {
    unsigned char* ws = A.ws; const NsaLane L = nsa_lane(F);
    const bf16* P0 = (const bf16*)(ws + WS_P0); const float* GL = (const float*)(ws + WS_GL); float* OACC = (float*)(ws + WS_Z); bf16* OATT = (bf16*)(ws + WS_OATT0);
    nsa_lut(F, A);
    LAS char* lds = (LAS char*)(F.lds + RING_OFF);
    LAS float* wsf = (LAS float*)(lds + fa::OFF_WS) + L.wid * 64; LAS float* li_l = wsf; LAS float* al_l = wsf + 32;
    const LAS float* lut = (const LAS float*)(lds + fa::OFF_LUT);
    for (int u = F.vcu; u < 1024; u += F.G) {
        const int bg = u >> 7, qb = u & 127, b = bg >> 2, g = bg & 3;
        const int tok0 = b * SEQ + qb * 64;
        bf16x8 qr[8]; nsa_load_q(qr, P0, tok0, g, L);
        const int trow = qb * 64 + L.wid * 8 + L.ql;
        const int h = g * 4 + L.j; const LAS float* lutcol = lut + h * 144; const float bias_far = lutcol[128];
        const bf16* Kg = P0 + (size_t)b * SEQ * P0LD + COL_KW + g * 128; const bf16* Vg = P0 + (size_t)b * SEQ * P0LD + COL_VW + g * 128;
        const int t0 = max(0, qb - 8), NT = qb - t0 + 1;
        float m_reg = -1e30f, l_reg = 0.f; fa::f32x16 o[4];
#pragma unroll
        for (int d = 0; d < 4; ++d)
#pragma unroll
            for (int r = 0; r < 16; ++r) o[d][r] = 0.f;
        fa::Stage S;
        fa::stage_load(S, Kg, Vg, P0LD, t0 * 64, SEQ - 1, L.sr, L.sc); asm volatile("s_waitcnt vmcnt(0)" ::: "memory");
        fa::stage_write(S, lds + fa::OFF_K, lds + fa::OFF_V, L.kws, L.vst0, L.vst1);
        __syncthreads();
#pragma unroll 1
        for (int tt = 0; tt < NT; ++tt) {
            const int buf = tt & 1, t = t0 + tt;
            if (tt + 1 < NT) fa::stage_load(S, Kg, Vg, P0LD, (t + 1) * 64, SEQ - 1, L.sr, L.sc);
            fa::f32x16 p0, p1;
            const bool farT = (qb * 64 + L.wid * 8) - (t * 64 + 63) >= 128;
            fa::qkt(p0, p1, lds + fa::OFF_K + buf * fa::SHM_K, L.r32, L.hi, qr, farT ? bias_far : 0.f);
            const int dq = trow - t * 64 - 4 * L.hi;
            if (!farT) fa::bias_near(p0, p1, dq, 1, lutcol);
            if (t == qb || t == t0) fa::mask_tile(p0, p1, dq, 512u);
            float alpha; fa::partialSM(p0, p1, m_reg, alpha);
            fa::rescale(o, alpha, al_l, L.r32, L.hi);
            bf16x8 a0, a1, a2, a3; const float ps = fa::finishSM(p0, p1, a0, a1, a2, a3); l_reg = l_reg * alpha + ps;
            fa::pv_tile(o, (int)(uintptr_t)(lds + fa::OFF_V + buf * fa::SHM_V) + L.vrd, a0, a1, a2, a3);
            if (tt + 1 < NT) { asm volatile("s_waitcnt vmcnt(0)" ::: "memory"); fa::stage_write(S, lds + fa::OFF_K + (buf ^ 1) * fa::SHM_K, lds + fa::OFF_V + (buf ^ 1) * fa::SHM_V, L.kws, L.vst0, L.vst1); }
            __syncthreads();
        }
        nsa_store<2>(o, l_reg, li_l, GL, OACC, OATT, tok0, g, 2, L);
        __syncthreads();
    }
}

template <bool ROUTE, bool F8 = false>
__device__ __forceinline__ void ln_phase(Frame& F, const Args& A, const float* Z, const float* gam, const float* bet, float* XF, bf16* XB) {
    const int gw = F.vcu * NWAVES + F.wave, NGW = F.G * NWAVES, lane = F.lane;
    LAS float* wrl = (LAS float*)(F.lds + RING_OFF);
    if (ROUTE) { for (int i = F.tid; i < DM * 8 / 4; i += 512) *(LAS f32x4*)(wrl + i * 4) = *(const f32x4*)(A.in[18] + i * 4); __syncthreads(); }
    for (int row = gw; row < NTOK; row += NGW) {
        const f32x4* zr = (const f32x4*)(Z + (size_t)row * DM) + lane;
        f32x4 v[8]; float s = 0.f;
#pragma unroll
        for (int j = 0; j < 8; ++j) { v[j] = zr[64 * j]; s += (v[j][0] + v[j][1]) + (v[j][2] + v[j][3]); }
        const float mean = wave_sum(s) * (1.f / DM); float s2 = 0.f;
#pragma unroll
        for (int j = 0; j < 8; ++j) { v[j] = v[j] - mean; s2 += (v[j][0] * v[j][0] + v[j][1] * v[j][1]) + (v[j][2] * v[j][2] + v[j][3] * v[j][3]); }
        const float rstd = 1.f / sqrtf(wave_sum(s2) * (1.f / DM) + LN_EPS);
        float lg[8];
#pragma unroll
        for (int e = 0; e < 8; ++e) lg[e] = 0.f;
#pragma unroll
        for (int j = 0; j < 8; ++j) { const int c = 4 * lane + 256 * j; const f32x4 gg = *(const f32x4*)(gam + c), bb = *(const f32x4*)(bet + c);
            const f32x4 x = v[j] * rstd * gg + bb;
            *(f32x4*)(XF + (size_t)row * DM + c) = x;
            if (F8) { int w = __builtin_amdgcn_cvt_pk_fp8_f32(x[0], x[1], 0, false); w = __builtin_amdgcn_cvt_pk_fp8_f32(x[2], x[3], w, true); *(int*)((unsigned char*)XB + (size_t)row * DM + c) = w; }
            else { uint2 o; o.x = pk2(x[0], x[1]); o.y = pk2(x[2], x[3]); *(uint2*)(XB + (size_t)row * DM + c) = o; }
            asm volatile("" ::: "memory");
            if (ROUTE) { const LAS float* wr = wrl + c * 8;
#pragma unroll
                for (int q = 0; q < 4; ++q) { const f32x4 w0 = *(const LAS f32x4*)(wr + q * 8), w1 = *(const LAS f32x4*)(wr + q * 8 + 4);
                    lg[0] += x[q] * w0[0]; lg[1] += x[q] * w0[1]; lg[2] += x[q] * w0[2]; lg[3] += x[q] * w0[3]; lg[4] += x[q] * w1[0]; lg[5] += x[q] * w1[1]; lg[6] += x[q] * w1[2]; lg[7] += x[q] * w1[3]; }  asm volatile("" ::: "memory"); }
        }
        if (ROUTE) {
#pragma unroll
            for (int e = 0; e < 8; ++e) lg[e] = wave_sum(lg[e]) + A.in[19][e];
            int e0 = 0; float l0 = lg[0];
#pragma unroll
            for (int e = 1; e < 8; ++e) if (lg[e] > l0) { l0 = lg[e]; e0 = e; }
            int e1 = -1; float l1 = -3e38f;
#pragma unroll
            for (int e = 0; e < 8; ++e) if (e != e0 && lg[e] > l1) { l1 = lg[e]; e1 = e; }
            const float w0 = 1.0f / (1.0f + __expf(l1 - l0)), w1 = 1.0f - w0;
            if (lane == 0) {
                const unsigned p0 = __hip_atomic_fetch_add((unsigned*)(F.ctl + CW_MOECNT + 64 * e0), 1u, __ATOMIC_RELAXED, __HIP_MEMORY_SCOPE_AGENT);
                const unsigned p1 = __hip_atomic_fetch_add((unsigned*)(F.ctl + CW_MOECNT + 64 * e1), 1u, __ATOMIC_RELAXED, __HIP_MEMORY_SCOPE_AGENT);
                int* re = (int*)(A.ws + WS_ROUTE); int* rp = re + 2 * NTOK; float* rw = (float*)(rp + 2 * NTOK);
                re[2 * row] = e0; re[2 * row + 1] = e1; rp[2 * row] = (int)p0; rp[2 * row + 1] = (int)p1; rw[2 * row] = w0; rw[2 * row + 1] = w1;
            }
        }
    }
}

__device__ __forceinline__ void ln_route_phase(Frame& F, const Args& A, const float* Z, const float* gam, const float* bet, float* XF, bf16* XB) {
    const int gw = F.vcu * NWAVES + F.wave, NGW = F.G * NWAVES, lane = F.lane;
    LAS float* wrl = (LAS float*)(F.lds + RING_OFF);
    LAS float* rowb = (LAS float*)(F.lds + RING_OFF + 65536 + F.wave * 8192);
    for (int i = F.tid; i < DM * 8 / 4; i += 512) *(LAS f32x4*)(wrl + i * 4) = *(const f32x4*)(A.in[18] + i * 4);
    __syncthreads();
    for (int row = gw; row < NTOK; row += NGW) {
        float s = 0.f, s2 = 0.f;
#pragma unroll 1
        for (int j = 0; j < 8; ++j) { const f32x4 v = *(const f32x4*)(Z + (size_t)row * DM + 4 * lane + 256 * j); *(LAS f32x4*)(rowb + 4 * lane + 256 * j) = v;
            s += (v[0] + v[1]) + (v[2] + v[3]); }
        const float mean = wave_sum(s) * (1.f / DM);
#pragma unroll 1
        for (int j = 0; j < 8; ++j) { const f32x4 v = *(const LAS f32x4*)(rowb + 4 * lane + 256 * j) - mean; s2 += (v[0] * v[0] + v[1] * v[1]) + (v[2] * v[2] + v[3] * v[3]); }
        const float rstd = 1.f / sqrtf(wave_sum(s2) * (1.f / DM) + LN_EPS);
        float lg[8];
#pragma unroll
        for (int e = 0; e < 8; ++e) lg[e] = 0.f;
#pragma unroll 1
        for (int j = 0; j < 8; ++j) { const int c = 4 * lane + 256 * j; const f32x4 gg = *(const f32x4*)(gam + c), bb = *(const f32x4*)(bet + c);
            const f32x4 x = (*(const LAS f32x4*)(rowb + c) - mean) * rstd * gg + bb;
            *(f32x4*)(XF + (size_t)row * DM + c) = x;
            const LAS float* wr = wrl + c * 8;
#pragma unroll
            for (int q = 0; q < 4; ++q) { const f32x4 w0 = *(const LAS f32x4*)(wr + q * 8), w1 = *(const LAS f32x4*)(wr + q * 8 + 4);
                lg[0] += x[q] * w0[0]; lg[1] += x[q] * w0[1]; lg[2] += x[q] * w0[2]; lg[3] += x[q] * w0[3]; lg[4] += x[q] * w1[0]; lg[5] += x[q] * w1[1]; lg[6] += x[q] * w1[2]; lg[7] += x[q] * w1[3]; } }
#pragma unroll
        for (int e = 0; e < 8; ++e) lg[e] = wave_sum(lg[e]) + A.in[19][e];
        int e0 = 0; float l0 = lg[0];
#pragma unroll
        for (int e = 1; e < 8; ++e) if (lg[e] > l0) { l0 = lg[e]; e0 = e; }
        int e1 = -1; float l1 = -3e38f;
#pragma unroll
        for (int e = 0; e < 8; ++e) if (e != e0 && lg[e] > l1) { l1 = lg[e]; e1 = e; }
        const float w0 = 1.0f / (1.0f + __expf(l1 - l0)), w1 = 1.0f - w0;
        if (lane == 0) {
            const unsigned p0 = __hip_atomic_fetch_add((unsigned*)(F.ctl + CW_MOECNT + 64 * e0), 1u, __ATOMIC_RELAXED, __HIP_MEMORY_SCOPE_AGENT);
            const unsigned p1 = __hip_atomic_fetch_add((unsigned*)(F.ctl + CW_MOECNT + 64 * e1), 1u, __ATOMIC_RELAXED, __HIP_MEMORY_SCOPE_AGENT);
            int* re = (int*)(A.ws + WS_ROUTE); int* rp = re + 2 * NTOK; float* rw = (float*)(rp + 2 * NTOK);
            re[2 * row] = e0; re[2 * row + 1] = e1; rp[2 * row] = (int)p0; rp[2 * row + 1] = (int)p1; rw[2 * row] = w0; rw[2 * row + 1] = w1;
        }
        WSYNC();
    }
    __syncthreads();
}

__device__ __forceinline__ void p10_dsa_prep(Frame& F, const Args& A) {
    unsigned char* ws = A.ws; const int lane = F.lane;
    const int gw = F.vcu * NWAVES + F.wave, NGW = F.G * NWAVES;
    { const float* CR = (const float*)(ws + WS_CRAW); bf16* CN = (bf16*)(ws + WS_CN); const f32x4 gg = *(const f32x4*)(A.in[11] + 4 * lane);
      for (int row = gw; row < NTOK; row += NGW) { const f32x4 v = *(const f32x4*)(CR + (size_t)row * KVR + 4 * lane);
          const float ss = wave_sum(v[0] * v[0] + v[1] * v[1] + v[2] * v[2] + v[3] * v[3]); const float r = 1.f / sqrtf(ss * (1.f / KVR) + RMS_EPS);
          uint2 o; o.x = pk2(v[0] * r * gg[0], v[1] * r * gg[1]); o.y = pk2(v[2] * r * gg[2], v[3] * r * gg[3]); *(uint2*)(CN + (size_t)row * KVR + 4 * lane) = o;
          if (lane < 16) { const f32x4 kv = *(const f32x4*)((const float*)(ws + WS_KIWI) + (size_t)row * 128 + 4 * lane); uint2 k2; k2.x = pk2(kv[0], kv[1]); k2.y = pk2(kv[2], kv[3]); *(uint2*)((bf16*)(ws + WS_KIB) + (size_t)row * 64 + 4 * lane) = k2; } } }
    const bf16* Q = (const bf16*)(ws + WS_Q); const bf16* UKT = (const bf16*)(ws + WS_W_UK); bf16* QL = (bf16*)(ws + WS_QLAT);
    const int r16 = lane & 15, kq = lane >> 4; const float sc = 0.08838834764831845f;
    for (int it = gw; it < 512 * 16 * 4; it += NGW) {
        const int nc = it & 3, h = (it >> 2) & 15, mt = it >> 6;
        f32x4 acc[2][4];
#pragma unroll
        for (int m = 0; m < 2; ++m)
#pragma unroll
            for (int n = 0; n < 4; ++n) acc[m][n] = (f32x4){0.f, 0.f, 0.f, 0.f};
#pragma unroll
        for (int ks = 0; ks < 4; ++ks) { s8v af[2], bfr[4];
#pragma unroll
            for (int m = 0; m < 2; ++m) af[m] = ld_frag(Q + (size_t)(mt * 32 + m * 16 + r16) * DM + h * 128 + ks * 32 + kq * 8);
#pragma unroll
            for (int n = 0; n < 4; ++n) bfr[n] = ld_frag(UKT + ((size_t)h * 256 + nc * 64 + n * 16 + r16) * 128 + ks * 32 + kq * 8);
#pragma unroll
            for (int m = 0; m < 2; ++m)
#pragma unroll
                for (int n = 0; n < 4; ++n) acc[m][n] = __builtin_amdgcn_mfma_f32_16x16x32_bf16(bfr[n], af[m], acc[m][n], 0, 0, 0); }
#pragma unroll
        for (int m = 0; m < 2; ++m)
#pragma unroll
            for (int n = 0; n < 4; ++n) { uint2 o; o.x = pg8::cvt_pk_bf16(acc[m][n][0] * sc, acc[m][n][1] * sc); o.y = pg8::cvt_pk_bf16(acc[m][n][2] * sc, acc[m][n][3] * sc);
                *(uint2*)(QL + (size_t)(mt * 32 + m * 16 + r16) * 4096 + h * 256 + nc * 64 + n * 16 + kq * 4) = o; }
    }
}
__device__ __forceinline__ void p12_dsa_uv(Frame& F, const Args& A) {
    unsigned char* ws = A.ws; const int lane = F.lane;
    const int gw = F.vcu * NWAVES + F.wave, NGW = F.G * NWAVES;
    const bf16* OL = (const bf16*)(ws + WS_OLAT); const bf16* UVT = (const bf16*)(ws + WS_W_UV); bf16* O = (bf16*)(ws + WS_OATT1);
    const int r16 = lane & 15, kq = lane >> 4;
    for (int it = gw; it < 512 * 16 * 2; it += NGW) {
        const int nc = it & 1, h = (it >> 1) & 15, mt = it >> 5;
        f32x4 acc[2][4];
#pragma unroll
        for (int m = 0; m < 2; ++m)
#pragma unroll
            for (int n = 0; n < 4; ++n) acc[m][n] = (f32x4){0.f, 0.f, 0.f, 0.f};
#pragma unroll
        for (int ks = 0; ks < 8; ++ks) { s8v af[2], bfr[4];
#pragma unroll
            for (int m = 0; m < 2; ++m) af[m] = ld_frag(OL + (size_t)(mt * 32 + m * 16 + r16) * 4096 + h * 256 + ks * 32 + kq * 8);
#pragma unroll
            for (int n = 0; n < 4; ++n) bfr[n] = ld_frag(UVT + ((size_t)h * 128 + nc * 64 + n * 16 + r16) * 256 + ks * 32 + kq * 8);
#pragma unroll
            for (int m = 0; m < 2; ++m)
#pragma unroll
                for (int n = 0; n < 4; ++n) acc[m][n] = __builtin_amdgcn_mfma_f32_16x16x32_bf16(bfr[n], af[m], acc[m][n], 0, 0, 0); }
#pragma unroll
        for (int m = 0; m < 2; ++m)
#pragma unroll
            for (int n = 0; n < 4; ++n) { uint2 o; o.x = pg8::cvt_pk_bf16(acc[m][n][0], acc[m][n][1]); o.y = pg8::cvt_pk_bf16(acc[m][n][2], acc[m][n][3]);
                *(uint2*)(O + (size_t)(mt * 32 + m * 16 + r16) * DM + h * 128 + nc * 64 + n * 16 + kq * 4) = o; }
    }
}

__device__ __forceinline__ unsigned f2key(float f) { const unsigned u = __float_as_uint(f); return (u & 0x80000000u) ? ~u : (u | 0x80000000u); }

__device__ __forceinline__ unsigned dsa_off_b(unsigned row, unsigned ch) { return 256u * row + 16u * (ch ^ (((row & 3) << 2) | ((row >> 2) & 3))); }

__device__ __forceinline__ float key2f(unsigned k) { return __uint_as_float((k & 0x80000000u) ? (k & 0x7fffffffu) : ~k); }
__device__ __forceinline__ void p13a_dsa_index(Frame& F, const Args& A) {
    unsigned char* ws = A.ws; const int lane = F.lane, wid = F.wave, r32 = lane & 31, hi = lane >> 5;
    const bf16* QI = (const bf16*)(ws + WS_QI); const bf16* KIB = (const bf16*)(ws + WS_KIB); const float* KIWI = (const float*)(ws + WS_KIWI); int* IDX = (int*)(ws + WS_IDX);
    LAS float* sc = (LAS float*)(F.lds + RING_OFF);
    LAS unsigned* hist = (LAS unsigned*)(F.lds + DSA_SCR);
    LAS unsigned* cntG = hist + 1024;
    LAS unsigned* cntE = cntG + 512;
    LAS unsigned* qm = cntE + 512;
    LAS float* mmx = (LAS float*)(qm + 64);
    LAS unsigned* candk = (LAS unsigned*)(mmx + 64);
    constexpr int CAP = 256;
    const int q = wid >> 1, sub = wid & 1, th = sub * 64 + lane;
    for (int slot = F.vcu; slot < NTOK / 4; slot += F.G) {
        const int rowi = slot >> 8; int cc = slot & 255; if (rowi & 1) cc = 255 - cc;
        const int tok0 = (rowi * 256 + cc) * 4, b = tok0 >> 13, t0 = tok0 & (SEQ - 1), tmax = t0 + 3;
        bf16x8 qa[4];
#pragma unroll
        for (int s = 0; s < 4; ++s) qa[s] = *(const bf16x8*)(QI + (size_t)(tok0 + (r32 >> 3)) * 512 + (r32 & 7) * 64 + 16 * s + 8 * hi);
        float wv[16];
#pragma unroll
        for (int r = 0; r < 16; ++r) wv[r] = KIWI[(size_t)(tok0 + (r >> 2)) * 128 + 64 + (r & 3) + 4 * hi] * 0.35355339059327373f;
        const int ntiles = (tmax >> 5) + 1;
        hist[q * 256 + th] = 0u; hist[q * 256 + 128 + th] = 0u; if (th == 0) qm[q * 16 + 2] = 0u;
        float mn0 = 3e38f, mx0 = -3e38f, mn1 = 3e38f, mx1 = -3e38f;
        {
            bf16x8 kb[4], kn[4]; int tile = wid;
#pragma unroll
            for (int s = 0; s < 4; ++s) { kb[s] = (bf16x8){0, 0, 0, 0, 0, 0, 0, 0}; kn[s] = kb[s]; }
            if (tile < ntiles) { const bf16* kp = KIB + (size_t)(b * SEQ + tile * 32 + r32) * 64 + 8 * hi;
#pragma unroll
                for (int s = 0; s < 4; ++s) kb[s] = *(const bf16x8*)(kp + 16 * s); }
            while (tile < ntiles) {
                const int tn = tile + 8;
                if (tn < ntiles) { const bf16* kp = KIB + (size_t)(b * SEQ + tn * 32 + r32) * 64 + 8 * hi;
#pragma unroll
                    for (int s = 0; s < 4; ++s) kn[s] = *(const bf16x8*)(kp + 16 * s); }
                const int key = tile * 32 + r32;
                fa::f32x16 acc;
#pragma unroll
                for (int r = 0; r < 16; ++r) acc[r] = 0.f;
#pragma unroll
                for (int s = 0; s < 4; ++s) acc = __builtin_amdgcn_mfma_f32_32x32x16_bf16(qa[s], kb[s], acc, 0, 0, 0);
                float tot[4];
#pragma unroll
                for (int qq = 0; qq < 4; ++qq) { float part = 0.f;
#pragma unroll
                    for (int r3 = 0; r3 < 4; ++r3) part += wv[4 * qq + r3] * fmaxf(acc[4 * qq + r3], 0.f);
                    tot[qq] = sum_xor32(part) + 0.0f; }
                const float ta = hi ? tot[2] : tot[0], tb = hi ? tot[3] : tot[1];
                sc[(2 * hi) * 8192 + key] = ta; sc[(2 * hi + 1) * 8192 + key] = tb;
                if (key <= t0 + 2 * hi) { mn0 = fminf(mn0, ta); mx0 = fmaxf(mx0, ta); }
                if (key <= t0 + 2 * hi + 1) { mn1 = fminf(mn1, tb); mx1 = fmaxf(mx1, tb); }
#pragma unroll
                for (int s = 0; s < 4; ++s) kb[s] = kn[s];
                tile = tn;
            }
        }
#pragma unroll
        for (int o = 1; o < 32; o <<= 1) { mn0 = fminf(mn0, __shfl_xor(mn0, o)); mx0 = fmaxf(mx0, __shfl_xor(mx0, o)); mn1 = fminf(mn1, __shfl_xor(mn1, o)); mx1 = fmaxf(mx1, __shfl_xor(mx1, o)); }
        if (r32 == 0) { mmx[(wid * 4 + 2 * hi) * 2] = mn0; mmx[(wid * 4 + 2 * hi) * 2 + 1] = mx0; mmx[(wid * 4 + 2 * hi + 1) * 2] = mn1; mmx[(wid * 4 + 2 * hi + 1) * 2 + 1] = mx1; }
        __syncthreads();
        const int tok = tok0 + q, n = t0 + q + 1;
        if (tmax + 1 <= TOPK) {
            for (int i = th; i < TOPK; i += 128) IDX[(size_t)tok * TOPK + i] = (i < n) ? i : 0;
        } else {
            const LAS float* scq = sc + q * 8192; const int nsl = (n + 127) >> 7;
            float fmn = 3e38f, fmx = -3e38f;
#pragma unroll
            for (int w = 0; w < 8; ++w) { fmn = fminf(fmn, mmx[(w * 4 + q) * 2]); fmx = fmaxf(fmx, mmx[(w * 4 + q) * 2 + 1]); }
            const float bsc = (fmx > fmn) ? 255.99f / (fmx - fmn) : 0.f;
            for (int s0 = 0; s0 < nsl; s0 += 8) { float v[8];
#pragma unroll
                for (int j = 0; j < 8; ++j) { const int i = (s0 + j) * 128 + th; v[j] = scq[min(i, n - 1)]; }
#pragma unroll
                for (int j = 0; j < 8; ++j) { const int i = (s0 + j) * 128 + th; const int bin = min(max((int)((v[j] - fmn) * bsc), 0), 255);
                    LAS unsigned* tgt = (i < n) ? &hist[q * 256 + bin] : &qm[q * 16 + 8];
                    __hip_atomic_fetch_add(tgt, 1u, __ATOMIC_RELAXED, __HIP_MEMORY_SCOPE_WORKGROUP); } }
            __syncthreads();
            if (sub == 0) {
                const v4u c4 = *(const LAS v4u*)(hist + q * 256 + 4 * lane); const unsigned s4 = c4.x + c4.y + c4.z + c4.w; unsigned S = s4;
#pragma unroll
                for (int o = 1; o < 64; o <<= 1) { const unsigned v = __shfl_down(S, o); if (lane + o < 64) S += v; }
                const unsigned above = S - s4;
                if (above < (unsigned)TOPK && (unsigned)TOPK <= S) { unsigned cum = above; int bin;
                    if (cum + c4.w >= (unsigned)TOPK) bin = 3; else { cum += c4.w; if (cum + c4.z >= (unsigned)TOPK) bin = 2; else { cum += c4.z; if (cum + c4.y >= (unsigned)TOPK) bin = 1; else { cum += c4.y; bin = 0; } } }
                    qm[q * 16 + 0] = (unsigned)(4 * lane + bin); qm[q * 16 + 1] = (unsigned)TOPK - cum; }
            }
            __syncthreads();
            const int bstar = (int)qm[q * 16 + 0]; const unsigned need1 = qm[q * 16 + 1];
            for (int s0 = 0; s0 < nsl; s0 += 8) { float v[8];
#pragma unroll
                for (int j = 0; j < 8; ++j) { const int i = (s0 + j) * 128 + th; v[j] = scq[min(i, n - 1)]; }
#pragma unroll
                for (int j = 0; j < 8; ++j) { const int i = (s0 + j) * 128 + th; const int bin = min(max((int)((v[j] - fmn) * bsc), 0), 255);
                    if (i < n && bin == bstar) { const unsigned pc = __hip_atomic_fetch_add(&qm[q * 16 + 2], 1u, __ATOMIC_RELAXED, __HIP_MEMORY_SCOPE_WORKGROUP); if (pc < (unsigned)CAP) candk[q * CAP + pc] = f2key(v[j]); } } }
            __syncthreads();
            if (sub == 0) {
                const unsigned mc = qm[q * 16 + 2]; unsigned T = 0u, nt = 0u; bool found = false;
                if (mc <= (unsigned)CAP) {
                    unsigned kc[4], gt[4], ge[4];
#pragma unroll
                    for (int c = 0; c < 4; ++c) { kc[c] = (lane + 64 * c < (int)mc) ? candk[q * CAP + lane + 64 * c] : 0u; gt[c] = 0u; ge[c] = 0u; }
                    for (unsigned j = 0; j < mc; ++j) { const unsigned kj = candk[q * CAP + j];
#pragma unroll
                        for (int c = 0; c < 4; ++c) { gt[c] += (kj > kc[c]) ? 1u : 0u; ge[c] += (kj >= kc[c]) ? 1u : 0u; } }
#pragma unroll
                    for (int c = 0; c < 4; ++c) if (lane + 64 * c < (int)mc && gt[c] < need1 && need1 <= ge[c]) { T = kc[c]; nt = need1 - gt[c]; found = true; }
                } else {
                    unsigned lo = 0u;
                    for (int bit = 31; bit >= 0; --bit) { const unsigned cand = lo | (1u << bit); unsigned c = 0u;
                        for (int i = lane; i < n; i += 64) c += (f2key(scq[i]) >= cand) ? 1u : 0u;
#pragma unroll
                        for (int o = 1; o < 64; o <<= 1) c += __shfl_xor(c, o);
                        if (c >= (unsigned)TOPK) lo = cand; }
                    unsigned cg = 0u;
                    for (int i = lane; i < n; i += 64) cg += (f2key(scq[i]) > lo) ? 1u : 0u;
#pragma unroll
                    for (int o = 1; o < 64; o <<= 1) cg += __shfl_xor(cg, o);
                    T = lo; nt = (unsigned)TOPK - cg; found = (lane == 0);
                }
                if (found) { qm[q * 16 + 0] = T; qm[q * 16 + 1] = nt; }
            }
            __syncthreads();
            const unsigned T = qm[q * 16 + 0], need = qm[q * 16 + 1];
            unsigned Gs = 0u, Es = 0u;
            for (int s0 = 0; s0 < nsl; s0 += 8) { float v[8];
#pragma unroll
                for (int j = 0; j < 8; ++j) { const int i = (s0 + j) * 128 + th; v[j] = scq[min(i, n - 1)]; }
#pragma unroll
                for (int j = 0; j < 8; ++j) { const int i = (s0 + j) * 128 + th; const bool ok = i < n; const unsigned k = f2key(v[j]);
                    Gs += (unsigned)__popcll(__ballot(ok && k > T)); Es += (unsigned)__popcll(__ballot(ok && k == T)); } }
            if (lane == 0) { qm[q * 16 + 10 + sub * 2] = Gs; qm[q * 16 + 11 + sub * 2] = Es; }
            __syncthreads();
            const unsigned G0 = qm[q * 16 + 10], E0 = qm[q * 16 + 11], E1 = qm[q * 16 + 13];
            bool slow = false;
#pragma unroll
            for (int qx = 0; qx < 4; ++qx) slow = slow || (qm[qx * 16 + 11] + qm[qx * 16 + 13] != qm[qx * 16 + 1]);
            (void)E1;
            if (!slow) {
                unsigned run = sub ? (G0 + E0) : 0u;
                for (int s0 = 0; s0 < nsl; s0 += 8) { float v[8];
#pragma unroll
                    for (int j = 0; j < 8; ++j) { const int i = (s0 + j) * 128 + th; v[j] = scq[min(i, n - 1)]; }
#pragma unroll
                    for (int j = 0; j < 8; ++j) { const int i = (s0 + j) * 128 + th; const bool sel = (i < n) && f2key(v[j]) >= T; const unsigned long long bs = __ballot(sel);
                        const unsigned pos = run + __builtin_amdgcn_mbcnt_hi((unsigned)(bs >> 32), __builtin_amdgcn_mbcnt_lo((unsigned)bs, 0u));
                        if (sel && pos < (unsigned)TOPK) candk[q * CAP + pos] = (unsigned)i; run += (unsigned)__popcll(bs); } }
            } else {
            unsigned myG = 0u, myE = 0u;
            for (int s0 = 0; s0 < nsl; s0 += 8) { float v[8];
#pragma unroll
                for (int j = 0; j < 8; ++j) { const int i = (s0 + j) * 128 + th; v[j] = scq[min(i, n - 1)]; }
#pragma unroll
                for (int j = 0; j < 8; ++j) { const int s2 = s0 + j, i = s2 * 128 + th; const bool ok = i < n; const unsigned k = f2key(v[j]); const unsigned long long bg = __ballot(ok && k > T), be = __ballot(ok && k == T);
                    const unsigned cg = (unsigned)__popcll(bg), ce = (unsigned)__popcll(be); myG = (lane == s2) ? cg : myG; myE = (lane == s2) ? ce : myE; } }
            cntG[(q * 2 + sub) * 64 + lane] = myG; cntE[(q * 2 + sub) * 64 + lane] = myE;
            __syncthreads();
            unsigned tbase, pbase;
            { const unsigned e0 = cntE[(q * 2) * 64 + lane], e1 = cntE[(q * 2 + 1) * 64 + lane], g0 = cntG[(q * 2) * 64 + lane], g1 = cntG[(q * 2 + 1) * 64 + lane];
              unsigned inc = e0 + e1;
#pragma unroll
              for (int o = 1; o < 64; o <<= 1) { const unsigned v = __shfl_up(inc, o); if (lane >= o) inc += v; }
              const unsigned tb0 = inc - (e0 + e1), tb1 = tb0 + e0;
              const unsigned se0 = (need > tb0) ? min(need - tb0, e0) : 0u, se1 = (need > tb1) ? min(need - tb1, e1) : 0u;
              const unsigned c0 = g0 + se0, c1 = g1 + se1; unsigned inc2 = c0 + c1;
#pragma unroll
              for (int o = 1; o < 64; o <<= 1) { const unsigned v = __shfl_up(inc2, o); if (lane >= o) inc2 += v; }
              const unsigned pb0 = inc2 - (c0 + c1);
              tbase = sub ? tb1 : tb0; pbase = sub ? pb0 + c0 : pb0; }
            for (int s0 = 0; s0 < nsl; s0 += 8) { float v[8];
#pragma unroll
                for (int j = 0; j < 8; ++j) { const int i = (s0 + j) * 128 + th; v[j] = scq[min(i, n - 1)]; }
#pragma unroll
                for (int j = 0; j < 8; ++j) { const int s2 = s0 + j; if (s2 < nsl) { const int i = s2 * 128 + th; const bool ok = i < n; const unsigned k = f2key(v[j]); const bool g = ok && k > T, e = ok && k == T;
                    const unsigned long long be = __ballot(e);
                    const unsigned trank = (unsigned)__builtin_amdgcn_readlane((int)tbase, s2) + __builtin_amdgcn_mbcnt_hi((unsigned)(be >> 32), __builtin_amdgcn_mbcnt_lo((unsigned)be, 0u));
                    const bool sel = g || (e && trank < need);
                    const unsigned long long bs = __ballot(sel);
                    const unsigned pos = (unsigned)__builtin_amdgcn_readlane((int)pbase, s2) + __builtin_amdgcn_mbcnt_hi((unsigned)(bs >> 32), __builtin_amdgcn_mbcnt_lo((unsigned)bs, 0u));
                    if (sel && pos < (unsigned)TOPK) candk[q * CAP + pos] = (unsigned)i; } } }
            }
        }
        __syncthreads();
        if (tmax + 1 > TOPK) { for (int i = th; i < TOPK; i += 128) IDX[(size_t)tok * TOPK + i] = (int)candk[q * CAP + i]; }
    }
}

__device__ __forceinline__ void p13b_dsa_attn(Frame& F, const Args& A) {
    unsigned char* ws = A.ws; const int lane = F.lane, wid = F.wave, c16 = lane & 15, g4 = lane >> 4;
    const bf16* CN = (const bf16*)(ws + WS_CN); const bf16* QL = (const bf16*)(ws + WS_QLAT); const int* IDX = (const int*)(ws + WS_IDX); bf16* OL = (bf16*)(ws + WS_OLAT);
    LAS float* lut = (LAS float*)(F.lds + DSA_SCR + 8192);
    for (int i = F.tid; i < 144 * 16; i += 512) { const int n = i >> 4, h = i & 15; lut[i] = A.in[1][rel_bucket(n) * 16 + h]; }
    __syncthreads();
    LAS char* img = (LAS char*)(F.lds + RING_OFF + wid * 16384);
    LAS int* idxw = (LAS int*)(F.lds + DSA_SCR + wid * 1024);
    const unsigned imgb = (unsigned)(uintptr_t)img;
    const int gw = F.vcu * NWAVES + wid, NGW = F.G * NWAVES;
    const unsigned prow0 = 8u * ((lane >> 2) & 3) + (lane & 3);
    unsigned ta0[8], ta1[8];
    { const unsigned qq = (lane & 15) >> 2, pp = lane & 3;
#pragma unroll
      for (int c = 0; c < 8; ++c) { ta0[c] = imgb + dsa_off_b(8 * g4 + qq, 2 * c + (pp >> 1)) + 8 * (pp & 1); ta1[c] = imgb + dsa_off_b(8 * g4 + 4 + qq, 2 * c + (pp >> 1)) + 8 * (pp & 1); } }
    for (int tok = gw; tok < NTOK; tok += NGW) {
        const int b = tok >> 13, t = tok & (SEQ - 1), cnt = min(TOPK, t + 1), ntile = (cnt + 31) >> 5;
        bf16x8 qb[8];
#pragma unroll
        for (int ks = 0; ks < 8; ++ks) qb[ks] = *(const bf16x8*)(QL + (size_t)tok * 4096 + c16 * 256 + ks * 32 + g4 * 8);
#pragma unroll
        for (int i = 0; i < 4; ++i) idxw[lane + 64 * i] = IDX[(size_t)tok * TOPK + lane + 64 * i];
        WSYNC();
        f32x4 o[16];
#pragma unroll
        for (int ct = 0; ct < 16; ++ct) o[ct] = (f32x4){0.f, 0.f, 0.f, 0.f};
        float m_run = -1e30f, l_run = 0.f;
        const LAS float* lutcol = lut + c16;
#pragma unroll 1
        for (int tile = 0; tile < ntile; ++tile) {
            { v4u st[16];
#pragma unroll
              for (int i = 0; i < 16; ++i) { const int nn = lane + 64 * i, row = nn >> 5, chg = nn & 31; const int key = idxw[tile * 32 + row];
                  st[i] = *(const v4u*)(CN + (size_t)(b * SEQ + key) * KVR + chg * 8); }
#pragma unroll
              for (int i = 0; i < 16; ++i) { const int nn = lane + 64 * i, row = nn >> 5, chg = nn & 31;
                  *(LAS v4u*)(img + (chg >> 4) * 8192 + dsa_off_b(row, chg & 15)) = st[i]; } }
            WSYNC();
            f32x4 sacc[2];
#pragma unroll
            for (int T = 0; T < 2; ++T) { sacc[T] = (f32x4){0.f, 0.f, 0.f, 0.f};
#pragma unroll
                for (int ks = 0; ks < 8; ++ks) { const bf16x8 a = *(const LAS bf16x8*)(img + (ks >> 2) * 8192 + dsa_off_b(prow0 + 4 * T, 4 * (ks & 3) + g4));
                    sacc[T] = __builtin_amdgcn_mfma_f32_16x16x32_bf16(a, qb[ks], sacc[T], 0, 0, 0); } }
            float pmax = -__builtin_inff();
#pragma unroll
            for (int T = 0; T < 2; ++T) { const int i0 = tile * 32 + 8 * g4 + 4 * T; const v4u kk = *(const LAS v4u*)(idxw + i0);
                const int kidx[4] = {(int)kk.x, (int)kk.y, (int)kk.z, (int)kk.w};
#pragma unroll
                for (int e = 0; e < 4; ++e) { const int dist = min(max(t - kidx[e], 0), 128); float s = sacc[T][e] + lutcol[dist * 16];
                    s = (i0 + e < cnt) ? s : -__builtin_inff(); sacc[T][e] = s; pmax = fmaxf(pmax, s); } }
            pmax = max_xor16(pmax); pmax = max_xor32(pmax);
            const float mn = fmaxf(m_run, pmax), alpha = __builtin_amdgcn_exp2f((m_run - mn) * fa::C2); m_run = mn;
            float ps = 0.f;
#pragma unroll
            for (int T = 0; T < 2; ++T)
#pragma unroll
                for (int e = 0; e < 4; ++e) { const float pv = __builtin_amdgcn_exp2f((sacc[T][e] - mn) * fa::C2); sacc[T][e] = pv; ps += pv; }
            ps = sum_xor16(ps); ps = sum_xor32(ps);
            l_run = l_run * alpha + ps;
            if (__any(alpha < 1.f)) {
                float al[4];
#pragma unroll
                for (int e = 0; e < 4; ++e) al[e] = __shfl(alpha, 4 * g4 + e);
#pragma unroll
                for (int ct = 0; ct < 16; ++ct)
#pragma unroll
                    for (int e = 0; e < 4; ++e) o[ct][e] *= al[e];
            }
            fa::u32x4v pw; pw.x = fa::cvtpk(sacc[0][0], sacc[0][1]); pw.y = fa::cvtpk(sacc[0][2], sacc[0][3]); pw.z = fa::cvtpk(sacc[1][0], sacc[1][1]); pw.w = fa::cvtpk(sacc[1][2], sacc[1][3]);
            const bf16x8 pa = *reinterpret_cast<bf16x8*>(&pw);
#pragma unroll
            for (int cg = 0; cg < 4; ++cg) { fa::s16x4 b0[4], b1[4];
                asm volatile("ds_read_b64_tr_b16 %0, %8 offset:%c16\n\tds_read_b64_tr_b16 %1, %9 offset:%c16\n\tds_read_b64_tr_b16 %2, %10 offset:%c16\n\tds_read_b64_tr_b16 %3, %11 offset:%c16\n\t"
                             "ds_read_b64_tr_b16 %4, %12 offset:%c16\n\tds_read_b64_tr_b16 %5, %13 offset:%c16\n\tds_read_b64_tr_b16 %6, %14 offset:%c16\n\tds_read_b64_tr_b16 %7, %15 offset:%c16\n\ts_waitcnt lgkmcnt(0)"
                             : "=&v"(b0[0]), "=&v"(b1[0]), "=&v"(b0[1]), "=&v"(b1[1]), "=&v"(b0[2]), "=&v"(b1[2]), "=&v"(b0[3]), "=&v"(b1[3])
                             : "v"(ta0[(cg & 1) * 4 + 0]), "v"(ta1[(cg & 1) * 4 + 0]), "v"(ta0[(cg & 1) * 4 + 1]), "v"(ta1[(cg & 1) * 4 + 1]), "v"(ta0[(cg & 1) * 4 + 2]), "v"(ta1[(cg & 1) * 4 + 2]), "v"(ta0[(cg & 1) * 4 + 3]), "v"(ta1[(cg & 1) * 4 + 3]), "i"((cg >> 1) * 8192) : "memory");
                FA_SBAR();
#pragma unroll
                for (int k = 0; k < 4; ++k) o[cg * 4 + k] = __builtin_amdgcn_mfma_f32_16x16x32_bf16(pa, (bf16x8){b0[k][0], b0[k][1], b0[k][2], b0[k][3], b1[k][0], b1[k][1], b1[k][2], b1[k][3]}, o[cg * 4 + k], 0, 0, 0); }
            WSYNC();
        }
        { const float il = (l_run > 0.f) ? 1.0f / l_run : 0.f; float ile[4];
#pragma unroll
          for (int e = 0; e < 4; ++e) ile[e] = __shfl(il, 4 * g4 + e);
#pragma unroll
          for (int ct = 0; ct < 16; ++ct)
#pragma unroll
              for (int e = 0; e < 4; ++e) { const float v = o[ct][e] * ile[e]; const float vn = dpp_xor1(v);
                  if ((lane & 1) == 0) *(unsigned*)(OL + (size_t)tok * 4096 + (4 * g4 + e) * 256 + ct * 16 + c16) = fa::cvtpk(v, vn); } }
        WSYNC();
    }
    __syncthreads();
}

struct MoeTiles { int tend[8]; int pstart[8]; int MT; };
__device__ __forceinline__ void moe_tiles(Frame& F, MoeTiles& T) {
    int acc = 0;
#pragma unroll
    for (int e = 0; e < 8; ++e) { const int c = (int)__builtin_amdgcn_readfirstlane(__hip_atomic_load((unsigned*)(F.ctl + CW_MOECNT + 64 * e), __ATOMIC_RELAXED, __HIP_MEMORY_SCOPE_AGENT));
        T.pstart[e] = acc * 256; acc += (c + 255) >> 8; T.tend[e] = acc; }
    T.MT = acc;
}
__device__ __forceinline__ void p15_gather(Frame& F, const Args& A) {
    MoeTiles T; moe_tiles(F, T);
    const int gw = F.vcu * NWAVES + F.wave, NGW = F.G * NWAVES, lane = F.lane;
    const float* XF = (const float*)(A.ws + WS_XF); unsigned char* XG = (unsigned char*)(A.ws + WS_XG);
    const int* re = (const int*)(A.ws + WS_ROUTE); const int* rp = re + 2 * NTOK;
    for (int tok = gw; tok < NTOK; tok += NGW) {
        v4u v[2];
#pragma unroll
        for (int j = 0; j < 2; ++j) { const float* src = XF + (size_t)tok * DM + 16 * lane + 1024 * j; int w[4];
#pragma unroll
            for (int q = 0; q < 4; ++q) { const f32x4 x = *(const f32x4*)(src + 4 * q); w[q] = __builtin_amdgcn_cvt_pk_fp8_f32(x[0], x[1], 0, false); w[q] = __builtin_amdgcn_cvt_pk_fp8_f32(x[2], x[3], w[q], true); }
            v[j].x = (unsigned)w[0]; v[j].y = (unsigned)w[1]; v[j].z = (unsigned)w[2]; v[j].w = (unsigned)w[3]; }
#pragma unroll
        for (int s = 0; s < 2; ++s) { const int e = re[2 * tok + s], p = rp[2 * tok + s]; int ps = 0;
#pragma unroll
            for (int q = 0; q < 8; ++q) ps = (q == e) ? T.pstart[q] : ps;
            unsigned char* dst = XG + (size_t)(ps + p) * DM + 16 * lane;
#pragma unroll
            for (int j = 0; j < 2; ++j) *(v4u*)(dst + 1024 * j) = v[j]; }
    }
}
__device__ __forceinline__ void p18_final(Frame& F, const Args& A) {
    MoeTiles T; moe_tiles(F, T);
    const int gw = F.vcu * NWAVES + F.wave, NGW = F.G * NWAVES, lane = F.lane;
    const float* XF = (const float*)(A.ws + WS_XF); const float* Y = (const float*)(A.ws + WS_Y);
    const int* re = (const int*)(A.ws + WS_ROUTE); const int* rp = re + 2 * NTOK; const float* rw = (const float*)(rp + 2 * NTOK);
    const float* gam = A.in[25] + DM; const float* bet = A.in[26] + DM;
    for (int tok = gw; tok < NTOK; tok += NGW) {
        int rows[2]; float w[2];
#pragma unroll
        for (int s = 0; s < 2; ++s) { const int e = re[2 * tok + s]; int ps = 0;
#pragma unroll
            for (int q = 0; q < 8; ++q) ps = (q == e) ? T.pstart[q] : ps;
            rows[s] = ps + rp[2 * tok + s]; w[s] = rw[2 * tok + s]; }
        const f32x4* xr = (const f32x4*)(XF + (size_t)tok * DM) + lane; const f32x4* y0 = (const f32x4*)(Y + (size_t)rows[0] * DM) + lane; const f32x4* y1 = (const f32x4*)(Y + (size_t)rows[1] * DM) + lane;
        f32x4 v[8]; float s = 0.f;
#pragma unroll
        for (int j = 0; j < 8; ++j) { v[j] = xr[64 * j] * ALPHA + y0[64 * j] * w[0] + y1[64 * j] * w[1]; s += (v[j][0] + v[j][1]) + (v[j][2] + v[j][3]); }
        const float mean = wave_sum(s) * (1.f / DM); float s2 = 0.f;
#pragma unroll
        for (int j = 0; j < 8; ++j) { v[j] = v[j] - mean; s2 += (v[j][0] * v[j][0] + v[j][1] * v[j][1]) + (v[j][2] * v[j][2] + v[j][3] * v[j][3]); }
        const float rstd = 1.f / sqrtf(wave_sum(s2) * (1.f / DM) + LN_EPS);
#pragma unroll
        for (int j = 0; j < 8; ++j) { const int c = 4 * lane + 256 * j; const f32x4 gg = *(const f32x4*)(gam + c), bb = *(const f32x4*)(bet + c);
            *(f32x4*)(A.out + (size_t)tok * DM + c) = v[j] * rstd * gg + bb; }
    }
}

__global__ void __launch_bounds__(NWAVES * 64, 2) mega_fwd(Args args) {
    extern __shared__ __attribute__((aligned(16))) unsigned char lds[];
    Frame F;
    F.lds = (LAS unsigned char*)lds;
    F.MISC = (volatile LAS unsigned*)(F.lds + MISC_OFF);
    F.tid = threadIdx.x; F.lane = F.tid & 63; F.wave = __builtin_amdgcn_readfirstlane(F.tid >> 6);
    F.G = gridDim.x; { const int bx = blockIdx.x; F.vcu = (F.G % 8 == 0) ? (bx % 8) * (F.G / 8) + bx / 8 : bx; }
    unsigned char* ws = args.ws;
    F.ctl = (gu32*)(ws + WS_CTL);
    for (int u = F.tid; u < (LDS_BYTES - LDSCTL_OFF) / 4; u += NWAVES * 64) ((LAS unsigned*)(F.lds + LDSCTL_OFF))[u] = 0u;
    __syncthreads();
    XcdBarrier bar; bar.bar = (unsigned*)(F.ctl + CW_BAR); bar.x = 0; bar.st = nullptr;
#if !MK_PER_PHASE
    bar = xcd_barrier_post((unsigned*)(F.ctl + CW_BAR), F.MISC + 8);
#define GRID_BAR() xcd_barrier(bar)
#else
#define GRID_BAR() do { } while (0)
#endif
    const int lo = args.ph_lo, hi = args.ph_hi;
#ifndef PH_MASK
#define PH_MASK 0x3fffff
#endif
#define IN(k) (((PH_MASK >> (k)) & 1) && lo <= (k) && (k) < hi)
#define BOTH(k) (IN(k) && IN((k) + 1))
    bf16* XB = (bf16*)(ws + WS_XB); float* XF = (float*)(ws + WS_XF); float* Z = (float*)(ws + WS_Z);

#ifndef PROBE_MASK
#define PROBE_MASK 0
#endif
#define REPS(k) ((((PROBE_MASK) >> (k)) & 1) ? 2 : 1)
    if (IN(0)) for (int rep_ = 0; rep_ < REPS(0); ++rep_) { relaunder(F); p0_prologue(F, args); if (BOTH(0) || rep_ + 1 < REPS(0)) GRID_BAR(); }
    if (IN(1)) for (int rep_ = 0; rep_ < REPS(1); ++rep_) { relaunder(F);
        pg8::Gemm g{XB, (const bf16*)(ws + WS_W_NSA_IN), NTOK, NSA_NPAD, DM}; pg8::StaticOrder S; S.init(NTOK, NSA_NPAD, F.G, (int)blockIdx.x);
        pg8::EpiNsaIn E{(bf16*)(ws + WS_P0), (float*)(ws + WS_GL), 0.08838834764831845f};
        pg8::gemm_phase<pg8::EpiNsaIn, pg8::StaticOrder, true, true>(F.lds + RING_OFF, g, S, E);
        if (BOTH(1) || rep_ + 1 < REPS(1)) GRID_BAR();
    }
    if (IN(2)) for (int rep_ = 0; rep_ < REPS(2); ++rep_) { relaunder(F); p2_compress(F, args); if (BOTH(2) || rep_ + 1 < REPS(2)) GRID_BAR(); }
#ifndef PROBE_NSA2
#define PROBE_NSA2 0
#endif
    for (int repn_ = 0; repn_ < (PROBE_NSA2 ? 2 : 1); ++repn_) {
    if (IN(3)) for (int rep_ = 0; rep_ < REPS(3); ++rep_) { relaunder(F); p3a_nsa_cmp(F, args); if (BOTH(3) || rep_ + 1 < REPS(3)) GRID_BAR(); }
    if (IN(4)) for (int rep_ = 0; rep_ < REPS(4); ++rep_) { relaunder(F); p3b_nsa_sel(F, args); if (BOTH(4) || rep_ + 1 < REPS(4) || repn_ + 1 < (PROBE_NSA2 ? 2 : 1)) GRID_BAR(); }
    }
    if (IN(5)) for (int rep_ = 0; rep_ < REPS(5); ++rep_) { relaunder(F); p3c_nsa_win(F, args); if (BOTH(5) || rep_ + 1 < REPS(5)) GRID_BAR(); }
    if (IN(6)) for (int rep_ = 0; rep_ < REPS(6); ++rep_) { relaunder(F);
        pg8::Gemm g{(const bf16*)(ws + WS_OATT0), (const bf16*)(ws + WS_W_NSA_OUT), NTOK, DM, DM}; pg8::StaticOrder S; S.init(NTOK, DM, F.G, (int)blockIdx.x);
        pg8::EpiResF32 E{args.in[0], Z, ALPHA, DM};
        pg8::gemm_phase<pg8::EpiResF32, pg8::StaticOrder, true, true>(F.lds + RING_OFF, g, S, E);
        if (BOTH(6) || rep_ + 1 < REPS(6)) GRID_BAR();
    }
    if (IN(7)) for (int rep_ = 0; rep_ < REPS(7); ++rep_) { relaunder(F); ln_phase<false, FFN_F8 != 0>(F, args, Z, args.in[23], args.in[24], XF, XB); if (BOTH(7) || rep_ + 1 < REPS(7)) GRID_BAR(); }
    if (IN(8)) for (int rep_ = 0; rep_ < REPS(8); ++rep_) { relaunder(F);
        pg8::StaticOrder S; S.init(NTOK, 2 * DFF, F.G, (int)blockIdx.x);
#if FFN_F8
        pg8::Gemm g{XB, (const bf16*)(ws + WS_W_FFN_GU), NTOK, 2 * DFF, DM, 1, 0x79797979};
        pg8::EpiSwiGLU8 E{(unsigned char*)(ws + WS_HFF), DFF};
        pg8::gemm_phase<pg8::EpiSwiGLU8, pg8::StaticOrder, true, true, true>(F.lds + RING_OFF, g, S, E);
#else
        pg8::Gemm g{XB, (const bf16*)(ws + WS_W_FFN_GU), NTOK, 2 * DFF, DM};
        pg8::EpiSwiGLU E{(bf16*)(ws + WS_HFF), DFF};
        pg8::gemm_phase<pg8::EpiSwiGLU, pg8::StaticOrder, true, true>(F.lds + RING_OFF, g, S, E);
#endif
        if (BOTH(8) || rep_ + 1 < REPS(8)) GRID_BAR();
    }
    if (IN(9)) for (int rep_ = 0; rep_ < REPS(9); ++rep_) { relaunder(F);
        pg8::StaticOrder S; S.init(NTOK, DM, F.G, (int)blockIdx.x);
        pg8::EpiResF32 E{XF, Z, ALPHA, DM};
#if FFN_F8
        pg8::Gemm g{(const bf16*)(ws + WS_HFF), (const bf16*)(ws + WS_W_FFN_DN), NTOK, DM, DFF, 1, 0x77777777};
        pg8::gemm_phase<pg8::EpiResF32, pg8::StaticOrder, true, true, true>(F.lds + RING_OFF, g, S, E);
#else
        pg8::Gemm g{(const bf16*)(ws + WS_HFF), (const bf16*)(ws + WS_W_FFN_DN), NTOK, DM, DFF};
        pg8::gemm_phase<pg8::EpiResF32, pg8::StaticOrder, true, true>(F.lds + RING_OFF, g, S, E);
#endif
        if (BOTH(9) || rep_ + 1 < REPS(9)) GRID_BAR();
    }
    if (IN(10)) for (int rep_ = 0; rep_ < REPS(10); ++rep_) { relaunder(F); ln_phase<false>(F, args, Z, args.in[25], args.in[26], XF, XB); if (BOTH(10) || rep_ + 1 < REPS(10)) GRID_BAR(); }
    if (IN(11)) for (int rep_ = 0; rep_ < REPS(11); ++rep_) { relaunder(F);
        pg8::Gemm g{XB, (const bf16*)(ws + WS_W_DSA_IN), NTOK, DSA_NPAD, DM}; pg8::StaticOrder S; S.init(NTOK, DSA_NPAD, F.G, (int)blockIdx.x);
        pg8::EpiDsaIn E{(bf16*)(ws + WS_Q), (float*)(ws + WS_CRAW), (bf16*)(ws + WS_QI), (float*)(ws + WS_KIWI), 0.125f};
        pg8::gemm_phase<pg8::EpiDsaIn, pg8::StaticOrder, true, true>(F.lds + RING_OFF, g, S, E);
        if (BOTH(11) || rep_ + 1 < REPS(11)) GRID_BAR();
    }
    if (IN(12)) for (int rep_ = 0; rep_ < REPS(12); ++rep_) { relaunder(F); p10_dsa_prep(F, args); if (BOTH(12) || rep_ + 1 < REPS(12)) GRID_BAR(); }
    if (IN(13)) for (int rep_ = 0; rep_ < REPS(13); ++rep_) { relaunder(F); p13a_dsa_index(F, args); if (BOTH(13) || rep_ + 1 < REPS(13)) GRID_BAR(); }
    if (IN(14)) for (int rep_ = 0; rep_ < REPS(14); ++rep_) { relaunder(F); p13b_dsa_attn(F, args); if (BOTH(14) || rep_ + 1 < REPS(14)) GRID_BAR(); }
    if (IN(15)) for (int rep_ = 0; rep_ < REPS(15); ++rep_) { relaunder(F); p12_dsa_uv(F, args); if (BOTH(15) || rep_ + 1 < REPS(15)) GRID_BAR(); }
    if (IN(16)) for (int rep_ = 0; rep_ < REPS(16); ++rep_) { relaunder(F);
        pg8::Gemm g{(const bf16*)(ws + WS_OATT1), (const bf16*)(ws + WS_W_DSA_OUT), NTOK, DM, DM}; pg8::StaticOrder S; S.init(NTOK, DM, F.G, (int)blockIdx.x);
        pg8::EpiResF32 E{XF, Z, ALPHA, DM};
        pg8::gemm_phase<pg8::EpiResF32, pg8::StaticOrder, true, true>(F.lds + RING_OFF, g, S, E);
        if (BOTH(16) || rep_ + 1 < REPS(16)) GRID_BAR();
    }
    if (IN(17)) for (int rep_ = 0; rep_ < REPS(17); ++rep_) { relaunder(F); ln_route_phase(F, args, Z, args.in[23] + DM, args.in[24] + DM, XF, XB); if (BOTH(17) || rep_ + 1 < REPS(17)) GRID_BAR(); }
    if (IN(18)) for (int rep_ = 0; rep_ < REPS(18); ++rep_) { relaunder(F); p15_gather(F, args); if (BOTH(18) || rep_ + 1 < REPS(18)) GRID_BAR(); }
    if (IN(19)) for (int rep_ = 0; rep_ < REPS(19); ++rep_) { relaunder(F);
        MoeTiles T; moe_tiles(F, T);
        pg8::Gemm g{(const bf16*)(ws + WS_XG), (const bf16*)(ws + WS_W_MOE_GU), T.MT * 256, 2 * DFFE, DM, 1, 0x79797979}; pg8::MoeOrder S; S.init(T.MT * 256, 2 * DFFE, F.G, (int)blockIdx.x); S.nexp_rows = 2 * DFFE;
#pragma unroll
        for (int e = 0; e < 8; ++e) S.tend[e] = T.tend[e];
        pg8::EpiSwiGLU8 E{(unsigned char*)(ws + WS_HM), DFFE};
        pg8::gemm_phase<pg8::EpiSwiGLU8, pg8::MoeOrder, true, true, true>(F.lds + RING_OFF, g, S, E);
        if (BOTH(19) || rep_ + 1 < REPS(19)) GRID_BAR();
    }
    if (IN(20)) for (int rep_ = 0; rep_ < REPS(20); ++rep_) { relaunder(F);
        MoeTiles T; moe_tiles(F, T);
        pg8::Gemm g{(const bf16*)(ws + WS_HM), (const bf16*)(ws + WS_W_MOE_DN), T.MT * 256, DM, DFFE, 1, 0x77777777}; pg8::MoeOrder S; S.init(T.MT * 256, DM, F.G, (int)blockIdx.x); S.nexp_rows = DM;
#pragma unroll
        for (int e = 0; e < 8; ++e) S.tend[e] = T.tend[e];
        pg8::EpiF32 E{(float*)(ws + WS_Y), DM};
        pg8::gemm_phase<pg8::EpiF32, pg8::MoeOrder, true, true, true>(F.lds + RING_OFF, g, S, E);
        if (BOTH(20) || rep_ + 1 < REPS(20)) GRID_BAR();
    }
    if (IN(21)) for (int rep_ = 0; rep_ < REPS(21); ++rep_) { relaunder(F); p18_final(F, args); }
#undef IN
#undef BOTH
}

extern "C" void kernel_launch(void* const* d_in, const int* in_sizes, int n_in, void* d_out, int out_size, void* d_ws, size_t ws_size, hipStream_t stream) {
    static int grid = 0;
    if (grid == 0) {
        if (n_in != 27 || out_size != NTOK * DM || ws_size < WS_END) { fprintf(stderr, "kernel_launch: unexpected shapes (n_in %d, out %d, ws %zu); nothing launched\n", n_in, out_size, ws_size); grid = -1; return; }
        int dev = 0, cus = 0, per_cu = 0;
        if (hipGetDevice(&dev) != hipSuccess || hipDeviceGetAttribute(&cus, hipDeviceAttributeMultiprocessorCount, dev) != hipSuccess) { grid = -1; return; }
        if (hipFuncSetAttribute((const void*)mega_fwd, hipFuncAttributeMaxDynamicSharedMemorySize, LDS_BYTES) != hipSuccess) { fprintf(stderr, "kernel_launch: hipFuncSetAttribute failed\n"); grid = -1; return; }
        if (hipOccupancyMaxActiveBlocksPerMultiprocessor(&per_cu, (const void*)mega_fwd, NWAVES * 64, LDS_BYTES) != hipSuccess || per_cu < 1) { fprintf(stderr, "kernel_launch: occupancy query says %d\n", per_cu); }
        (void)hipGetLastError();
        grid = cus;
    }
    if (grid < 0) return;
    if (hipMemsetAsync((char*)d_ws + WS_CTL, 0, CTL_ZERO_BYTES, stream) != hipSuccess) return;
    Args a{};
    for (int i = 0; i < 27; ++i) a.in[i] = (const float*)d_in[i];
    a.out = (float*)d_out; a.ws = (unsigned char*)d_ws;
#if MK_PER_PHASE
    for (int p = 0; p < NPHASE; ++p) { a.ph_lo = p; a.ph_hi = p + 1; hipLaunchKernelGGL(mega_fwd, dim3(grid), dim3(NWAVES * 64), LDS_BYTES, stream, a); }
#else
    a.ph_lo = 0; a.ph_hi = NPHASE;
    hipLaunchKernelGGL(mega_fwd, dim3(grid), dim3(NWAVES * 64), LDS_BYTES, stream, a);
#endif
}
```

```cpp
#include <hip/hip_runtime.h>
#include <cstdio>
#include <cstdint>
namespace pg8 {
#define PG8_LAS __attribute__((address_space(3)))
typedef unsigned short bf16_t;
typedef short bf16x8 __attribute__((ext_vector_type(8)));
typedef float f32x4 __attribute__((ext_vector_type(4)));
typedef unsigned u32x4 __attribute__((ext_vector_type(4)));
constexpr int BM = 256, BK = 64, HALF = 128, HTB = HALF * BK * 2  , STAGE_BYTES = 8 * HTB, NXCD = 8, WGM = 8;

__host__ __device__ __forceinline__ int lds_byte(int r, int c) { const int st = (r >> 4) * 2 + (c >> 5), rr = r & 15, cc = c & 31, ob = rr * 64 + cc * 2; return st * 1024 + (ob ^ (((ob >> 9) & 1) << 5)); }
__host__ __device__ __forceinline__ void stage_rc(int b, int& R, int& C) { const int st = b / 1024, sb = b % 1024, swz = sb ^ (((sb >> 9) & 1) << 5); R = (st >> 1) * 16 + swz / 64; C = (st & 1) * 32 + (swz % 64) / 2; }
__host__ __device__ __forceinline__ int perm32(int rho) { const int n = rho >> 4, i = rho & 15; return 8 * (i >> 2) + 4 * n + (i & 3); }

struct Unit { int pm, pn; };
struct Gemm { const bf16_t* A; const bf16_t* Bt; int M, N, K; int esz = 2; int scale = 0x7f7f7f7f; };

struct StaticOrder {
    int nM, nN, nwg, G, c;
    __host__ __device__ void init(int M, int N, int G_, int c_) { nM = M / BM; nN = N / BM; nwg = nM * nN; G = G_; c = c_; }
    __host__ __device__ bool next(int i, Unit& u) const {
        const long L = (long)i * G + c; if (L >= nwg) return false;
        int wgid = (int)L; { const int q = nwg / NXCD, r = nwg % NXCD, xcd = wgid % NXCD, off = wgid / NXCD; wgid = (xcd < r ? xcd * (q + 1) : r * (q + 1) + (xcd - r) * q) + off; }
        const int nig = WGM * nN, gid = wgid / nig, fm = gid * WGM, gsz = (nM - fm) < WGM ? (nM - fm) : WGM;
        u.pm = fm + ((wgid % nig) % gsz); u.pn = (wgid % nig) / gsz; return true;
    }
    __device__ __forceinline__ void a_ready(const Unit&) const {}
    __device__ __forceinline__ void done(const Unit&) const {}
    __device__ __forceinline__ const char* a_ptr(const Gemm& g, const Unit& u) const { return (const char*)g.A + (size_t)u.pm * ((size_t)BM * g.K * g.esz); }
    __device__ __forceinline__ const char* b_ptr(const Gemm& g, const Unit& u) const { return (const char*)g.Bt + (size_t)u.pn * ((size_t)BM * g.K * g.esz); }
};


__device__ __forceinline__ unsigned cvt_pk_bf16(float lo, float hi) { unsigned r; asm volatile("v_cvt_pk_bf16_f32 %0, %1, %2" : "=v"(r) : "v"(lo), "v"(hi)); return r; }
__device__ __forceinline__ u32x4 pack8(const f32x4 v0, const f32x4 v1) { u32x4 w; w.x = cvt_pk_bf16(v0[0], v0[1]); w.y = cvt_pk_bf16(v0[2], v0[3]); w.z = cvt_pk_bf16(v1[0], v1[1]); w.w = cvt_pk_bf16(v1[2], v1[3]); return w; }

struct EpiNsaIn {
    static constexpr bool PERM = true, AFTER_DRAIN = false;
    bf16_t* P0; float* GL; float qscale;
    __device__ __forceinline__ void operator()(const f32x4 (&acc)[2][2][4][2], const Unit& u, int wr, int wc, int fr, int fq) const {
        const int row0 = u.pm * BM + wr * 64 + fr;
        if (u.pn < 20) {
            const float s = u.pn < 8 ? qscale : 1.0f;
            const int col0 = u.pn * BM + wc * 32 + 8 * fq;
#pragma unroll
            for (int ai = 0; ai < 2; ++ai)
#pragma unroll
                for (int m = 0; m < 4; ++m) { bf16_t* rowp = P0 + (size_t)(row0 + ai * HALF + m * 16) * 5120 + col0;
#pragma unroll
                    for (int bj = 0; bj < 2; ++bj) *(u32x4*)(rowp + bj * HALF) = pack8(acc[ai][bj][m][0] * s, acc[ai][bj][m][1] * s); }
        } else {
            const int c = wc * 32 + 8 * fq;
            if (c < 48) {
#pragma unroll
                for (int ai = 0; ai < 2; ++ai)
#pragma unroll
                    for (int m = 0; m < 4; ++m) { float* gp = GL + (size_t)(row0 + ai * HALF + m * 16) * 48 + c;
                        *(f32x4*)gp = acc[ai][0][m][0]; *(f32x4*)(gp + 4) = acc[ai][0][m][1]; }
            }
        }
    }
};
struct EpiDsaIn {
    static constexpr bool PERM = true, AFTER_DRAIN = false;
    bf16_t* Q; float* CRAW; bf16_t* QI; float* KIWI; float qiscale;
    __device__ __forceinline__ void operator()(const f32x4 (&acc)[2][2][4][2], const Unit& u, int wr, int wc, int fr, int fq) const {
        const int row0 = u.pm * BM + wr * 64 + fr; const int c = wc * 32 + 8 * fq;
        if (u.pn < 8) {
#pragma unroll
            for (int ai = 0; ai < 2; ++ai)
#pragma unroll
                for (int m = 0; m < 4; ++m) { bf16_t* rowp = Q + (size_t)(row0 + ai * HALF + m * 16) * 2048 + u.pn * BM + c;
#pragma unroll
                    for (int bj = 0; bj < 2; ++bj) *(u32x4*)(rowp + bj * HALF) = pack8(acc[ai][bj][m][0], acc[ai][bj][m][1]); }
        } else if (u.pn == 8) {
#pragma unroll
            for (int ai = 0; ai < 2; ++ai)
#pragma unroll
                for (int m = 0; m < 4; ++m) { float* rowp = CRAW + (size_t)(row0 + ai * HALF + m * 16) * 256 + c;
#pragma unroll
                    for (int bj = 0; bj < 2; ++bj) { *(f32x4*)(rowp + bj * HALF) = acc[ai][bj][m][0]; *(f32x4*)(rowp + bj * HALF + 4) = acc[ai][bj][m][1]; } }
        } else if (u.pn < 11) {
#pragma unroll
            for (int ai = 0; ai < 2; ++ai)
#pragma unroll
                for (int m = 0; m < 4; ++m) { bf16_t* rowp = QI + (size_t)(row0 + ai * HALF + m * 16) * 512 + (u.pn - 9) * BM + c;
#pragma unroll
                    for (int bj = 0; bj < 2; ++bj) *(u32x4*)(rowp + bj * HALF) = pack8(acc[ai][bj][m][0] * qiscale, acc[ai][bj][m][1] * qiscale); }
        } else {
#pragma unroll
            for (int ai = 0; ai < 2; ++ai)
#pragma unroll
                for (int m = 0; m < 4; ++m) { float* rowp = KIWI + (size_t)(row0 + ai * HALF + m * 16) * 128 + c;
                    *(f32x4*)rowp = acc[ai][0][m][0]; *(f32x4*)(rowp + 4) = acc[ai][0][m][1]; }
        }
    }
};
struct EpiResF32 {
    static constexpr bool PERM = false, AFTER_DRAIN = false;
    const float* R; bf16_t* Z; float alpha; int ldc;
    __device__ __forceinline__ void operator()(const f32x4 (&acc)[2][2][4][2], const Unit& u, int wr, int wc, int fr, int fq) const {
        const int row0 = u.pm * BM + wr * 64 + fr, col0 = u.pn * BM + wc * 32 + 4 * fq;
#pragma unroll
        for (int ai = 0; ai < 2; ++ai)
#pragma unroll
            for (int m = 0; m < 4; ++m) { const size_t off = (size_t)(row0 + ai * HALF + m * 16) * ldc + col0;
#pragma unroll
                for (int bj = 0; bj < 2; ++bj)
#pragma unroll
                    for (int n = 0; n < 2; ++n) { const f32x4 r = *(const f32x4*)(R + off + bj * HALF + n * 16); const f32x4 v = r * alpha + acc[ai][bj][m][n];
                        uint2 o; o.x = cvt_pk_bf16(v[0], v[1]); o.y = cvt_pk_bf16(v[2], v[3]); *(uint2*)(Z + off + bj * HALF + n * 16) = o; } }
    }
};
struct EpiF32 {
    static constexpr bool PERM = false, AFTER_DRAIN = false;
    float* C; int ldc;
    __device__ __forceinline__ void operator()(const f32x4 (&acc)[2][2][4][2], const Unit& u, int wr, int wc, int fr, int fq) const {
        const int row0 = u.pm * BM + wr * 64 + fr, col0 = u.pn * BM + wc * 32 + 4 * fq;
#pragma unroll
        for (int ai = 0; ai < 2; ++ai)
#pragma unroll
            for (int m = 0; m < 4; ++m) { float* rowp = C + (size_t)(row0 + ai * HALF + m * 16) * ldc + col0;
#pragma unroll
                for (int bj = 0; bj < 2; ++bj)
#pragma unroll
                    for (int n = 0; n < 2; ++n) *(f32x4*)(rowp + bj * HALF + n * 16) = acc[ai][bj][m][n]; }
    }
};
struct EpiBf16Plain {
    static constexpr bool PERM = false, AFTER_DRAIN = false;
    bf16_t* C; int ldc;
    __device__ __forceinline__ void operator()(const f32x4 (&acc)[2][2][4][2], const Unit& u, int wr, int wc, int fr, int fq) const {
        const int row0 = u.pm * BM + wr * 64 + fr, col0 = u.pn * BM + wc * 32 + 4 * fq;
#pragma unroll
        for (int ai = 0; ai < 2; ++ai)
#pragma unroll
            for (int m = 0; m < 4; ++m) { bf16_t* rowp = C + (size_t)(row0 + ai * HALF + m * 16) * ldc + col0;
#pragma unroll
                for (int bj = 0; bj < 2; ++bj)
#pragma unroll
                    for (int n = 0; n < 2; ++n) { const f32x4 v = acc[ai][bj][m][n]; uint2 o; o.x = cvt_pk_bf16(v[0], v[1]); o.y = cvt_pk_bf16(v[2], v[3]); *(uint2*)(rowp + bj * HALF + n * 16) = o; } }
    }
};
__device__ __forceinline__ float silu_mul(float g, float u) { return g * __builtin_amdgcn_rcpf(1.0f + __expf(-g)) * u; }
struct EpiSwiGLU {
    static constexpr bool PERM = true, AFTER_DRAIN = false;
    bf16_t* H; int ldh;
    __device__ __forceinline__ void operator()(const f32x4 (&acc)[2][2][4][2], const Unit& u, int wr, int wc, int fr, int fq) const {
        const int row0 = u.pm * BM + wr * 64 + fr, col0 = u.pn * HALF + wc * 32 + 8 * fq;
#pragma unroll
        for (int ai = 0; ai < 2; ++ai)
#pragma unroll
            for (int m = 0; m < 4; ++m) { bf16_t* rowp = H + (size_t)(row0 + ai * HALF + m * 16) * ldh + col0;
                f32x4 v0, v1;
#pragma unroll
                for (int j = 0; j < 4; ++j) { v0[j] = silu_mul(acc[ai][0][m][0][j], acc[ai][1][m][0][j]); v1[j] = silu_mul(acc[ai][0][m][1][j], acc[ai][1][m][1][j]); }
                *(u32x4*)rowp = pack8(v0, v1); }
    }
};
struct EpiSwiGLU8 {
    static constexpr bool PERM = true, AFTER_DRAIN = false;
    unsigned char* H; int ldh;
    __device__ __forceinline__ void operator()(const f32x4 (&acc)[2][2][4][2], const Unit& u, int wr, int wc, int fr, int fq) const {
        const int row0 = u.pm * BM + wr * 64 + fr, col0 = u.pn * HALF + wc * 32 + 8 * fq;
#pragma unroll
        for (int ai = 0; ai < 2; ++ai)
#pragma unroll
            for (int m = 0; m < 4; ++m) { unsigned char* rowp = H + (size_t)(row0 + ai * HALF + m * 16) * ldh + col0;
                float v[8];
#pragma unroll
                for (int j = 0; j < 4; ++j) { v[j] = silu_mul(acc[ai][0][m][0][j], acc[ai][1][m][0][j]); v[4 + j] = silu_mul(acc[ai][0][m][1][j], acc[ai][1][m][1][j]); }
                int w0 = __builtin_amdgcn_cvt_pk_fp8_f32(v[0], v[1], 0, false); w0 = __builtin_amdgcn_cvt_pk_fp8_f32(v[2], v[3], w0, true);
                int w1 = __builtin_amdgcn_cvt_pk_fp8_f32(v[4], v[5], 0, false); w1 = __builtin_amdgcn_cvt_pk_fp8_f32(v[6], v[7], w1, true);
                uint2 o; o.x = (unsigned)w0; o.y = (unsigned)w1; *(uint2*)rowp = o; }
    }
};
struct MoeOrder : StaticOrder {
    int tend[8]; int nexp_rows;
    __device__ __forceinline__ int expert(int pm) const { int e = 0;
#pragma unroll
        for (int i = 0; i < 7; ++i) e += (pm >= tend[i]) ? 1 : 0; return e; }
    __device__ __forceinline__ const char* b_ptr(const Gemm& g, const Unit& u) const { return (const char*)g.Bt + ((size_t)expert(u.pm) * nexp_rows + (size_t)u.pn * BM) * ((size_t)g.K * g.esz); }
};
typedef int i32x8 __attribute__((ext_vector_type(8)));
typedef int i32x4 __attribute__((ext_vector_type(4)));
__device__ __forceinline__ i32x8 cat8(bf16x8 lo, bf16x8 hi) { const i32x4 a = *reinterpret_cast<const i32x4*>(&lo), b = *reinterpret_cast<const i32x4*>(&hi); return __builtin_shufflevector(a, b, 0, 1, 2, 3, 4, 5, 6, 7); }
template <class Epi, class Sched, bool ALIGN_EPI = false, bool SP2 = false, bool FP8 = false>
__device__ __forceinline__ void gemm_phase(PG8_LAS unsigned char* lds, const Gemm g, const Sched& S, const Epi& E) {
    int tid = threadIdx.x; asm volatile("" : "+v"(tid));
    const int wid = __builtin_amdgcn_readfirstlane(tid >> 6), lane = tid & 63, wr = wid >> 2, wc = wid & 3, fr = lane & 15, fq = lane >> 4;
    const int K = g.K, nt = K / (FP8 ? 2 * BK : BK);
    unsigned voffA[2], voffB[2];
#pragma unroll
    for (int i = 0; i < 2; ++i) { int R, C; stage_rc(tid * 16 + i * 8192, R, C); const int Rb = Epi::PERM ? ((R & ~31) + perm32(R & 31)) : R;
        voffA[i] = FP8 ? (unsigned)(R * K + C * 2) : (unsigned)(R * K + C) * 2u; voffB[i] = FP8 ? (unsigned)(Rb * K + C * 2) : (unsigned)(Rb * K + C) * 2u; }
    const size_t kstep = (size_t)(BK * 2);
    const size_t hstep = (size_t)HALF * K * (FP8 ? 1 : 2);
    const size_t tstep = 2 * hstep;
    const unsigned ldsw = (unsigned)wid * 1024u;
    const int aoff = lds_byte(wr * 64 + fr, fq * 8), boff = lds_byte(wc * 32 + fr, fq * 8);
#define PG8_SA(b, h) (((b) * 2 + (h)) * HTB)
#define PG8_SB(b, h) ((4 + (b) * 2 + (h)) * HTB)
#define PG8_STAGE(bufoff, gbase, voff) do { _Pragma("unroll") for (int _i = 0; _i < 2; ++_i) \
        __builtin_amdgcn_global_load_lds((const unsigned*)((const char*)(gbase) + (voff)[_i]), (PG8_LAS unsigned*)(lds + (bufoff) + ldsw + _i * 8192), 16, 0, 0); } while (0)
#define PG8_LDA(dst, b, h) do { _Pragma("unroll") for (int m = 0; m < 4; ++m) { if constexpr (FP8) { const i32x4 lo_ = *(const PG8_LAS i32x4*)(lds + PG8_SA(b, h) + aoff + m * 2048), hi_ = *(const PG8_LAS i32x4*)(lds + PG8_SA(b, h) + aoff + m * 2048 + 1024); dst##8[m] = __builtin_shufflevector(lo_, hi_, 0, 1, 2, 3, 4, 5, 6, 7); } else { _Pragma("unroll") for (int k = 0; k < 2; ++k) dst[m][k] = *(const PG8_LAS bf16x8*)(lds + PG8_SA(b, h) + aoff + m * 2048 + k * 1024); } } } while (0)
#define PG8_LDB(dst, b, h) do { _Pragma("unroll") for (int n = 0; n < 2; ++n) { if constexpr (FP8) { const i32x4 lo_ = *(const PG8_LAS i32x4*)(lds + PG8_SB(b, h) + boff + n * 2048), hi_ = *(const PG8_LAS i32x4*)(lds + PG8_SB(b, h) + boff + n * 2048 + 1024); dst##8[n] = __builtin_shufflevector(lo_, hi_, 0, 1, 2, 3, 4, 5, 6, 7); } else { _Pragma("unroll") for (int k = 0; k < 2; ++k) dst[n][k] = *(const PG8_LAS bf16x8*)(lds + PG8_SB(b, h) + boff + n * 2048 + k * 1024); } } } while (0)
#define PG8_MMA(ai, bj, At, Bt) do { __builtin_amdgcn_s_setprio(1); _Pragma("unroll") for (int m = 0; m < 4; ++m) _Pragma("unroll") for (int n = 0; n < 2; ++n) { \
        if constexpr (FP8) { asm volatile("v_mfma_scale_f32_16x16x128_f8f6f4 %0, %1, %2, %0, %3, %4 op_sel_hi:[0,0,0]" : "+v"(acc[ai][bj][m][n]) : "v"(Bt##8[n]), "v"(At##8[m]), "v"(sclA), "v"(sclB)); } \
        else { _Pragma("unroll") for (int k = 0; k < 2; ++k) acc[ai][bj][m][n] = __builtin_amdgcn_mfma_f32_16x16x32_bf16(Bt[n][k], At[m][k], acc[ai][bj][m][n], 0, 0, 0); } } __builtin_amdgcn_s_setprio(0); } while (0)
#define PG8_WAIT_V(n) asm volatile("s_waitcnt vmcnt(" #n ")" ::: "memory")
#define PG8_WAIT_L(n) asm volatile("s_waitcnt lgkmcnt(" #n ")" ::: "memory")
#define PG8_BAR __builtin_amdgcn_s_barrier()
#define PG8_SCHED __builtin_amdgcn_sched_barrier(0)
    Unit cur, nxt; int ui = 0;
    if (!S.next(0, cur)) return;
    f32x4 acc[2][2][4][2];
#pragma unroll
    for (int a = 0; a < 2; ++a)
#pragma unroll
        for (int b = 0; b < 2; ++b)
#pragma unroll
            for (int m = 0; m < 4; ++m)
#pragma unroll
                for (int n = 0; n < 2; ++n) acc[a][b][m][n] = (f32x4){0.f, 0.f, 0.f, 0.f};
    bf16x8 At[4][2], B0[2][2], B1[2][2]; i32x8 At8[4], B08[2], B18[2]; const int sclA = g.scale, sclB = 0x7f7f7f7f;
    const char* cA = S.a_ptr(g, cur); const char* cB = S.b_ptr(g, cur);
    S.a_ready(cur);
    if constexpr (SP2) {
        PG8_STAGE(PG8_SB(0, 0), cB, voffB); PG8_STAGE(PG8_SB(0, 1), cB + hstep, voffB); PG8_STAGE(PG8_SA(0, 0), cA, voffA); PG8_STAGE(PG8_SA(0, 1), cA + hstep, voffA);
        if (wr == 1) PG8_BAR;
        PG8_WAIT_V(2); PG8_BAR;
        PG8_STAGE(PG8_SB(1, 0), cB + kstep, voffB); PG8_STAGE(PG8_SA(1, 0), cA + kstep, voffA); PG8_STAGE(PG8_SB(1, 1), cB + hstep + kstep, voffB);
        PG8_WAIT_V(6); PG8_BAR;
    } else {
        PG8_STAGE(PG8_SB(0, 0), cB, voffB); PG8_STAGE(PG8_SA(0, 0), cA, voffA); PG8_STAGE(PG8_SB(0, 1), cB + hstep, voffB); PG8_STAGE(PG8_SA(0, 1), cA + hstep, voffA);
        if (wr == 1) PG8_BAR;
        PG8_WAIT_V(4); PG8_BAR;
        PG8_STAGE(PG8_SB(1, 0), cB + kstep, voffB); PG8_STAGE(PG8_SA(1, 0), cA + kstep, voffA); PG8_STAGE(PG8_SB(1, 1), cB + hstep + kstep, voffB);
        PG8_WAIT_V(6); PG8_BAR;
    }
    for (;;) {
        const bool has_next = S.next(ui + 1, nxt);
        const char* nA = has_next ? S.a_ptr(g, nxt) : cA; const char* nB = has_next ? S.b_ptr(g, nxt) : cB;
        for (int t = 0; t < nt; t += 2) {
            const bool last = (t == nt - 2);
            const char* a1 = cA + (size_t)(t + 1) * kstep;
            const char* a2 = last ? nA : cA + (size_t)(t + 2) * kstep; const char* b2 = last ? nB : cB + (size_t)(t + 2) * kstep;
            const char* a3 = a2 + kstep; const char* b3 = b2 + kstep;
            if (last && has_next) S.a_ready(nxt);
            if constexpr (SP2) {
            PG8_LDB(B0, 0, 0); PG8_LDB(B1, 0, 1); PG8_SCHED; PG8_LDA(At, 0, 0); PG8_STAGE(PG8_SA(1, 1), a1 + hstep, voffA);
            PG8_WAIT_V(8); PG8_WAIT_L(0); PG8_BAR; PG8_MMA(0, 0, At, B0); PG8_MMA(0, 1, At, B1); PG8_BAR; PG8_SCHED;
            PG8_LDA(At, 0, 1); PG8_STAGE(PG8_SB(0, 0), b2, voffB); PG8_STAGE(PG8_SB(0, 1), b2 + hstep, voffB); PG8_STAGE(PG8_SA(0, 0), a2, voffA);
            PG8_WAIT_V(8); PG8_WAIT_L(0); PG8_BAR; PG8_MMA(1, 0, At, B0); PG8_MMA(1, 1, At, B1); PG8_BAR; PG8_SCHED;
            PG8_LDB(B0, 1, 0); PG8_LDB(B1, 1, 1); PG8_SCHED; PG8_LDA(At, 1, 0); PG8_STAGE(PG8_SA(0, 1), a2 + hstep, voffA);
            PG8_WAIT_V(8); PG8_WAIT_L(0); PG8_BAR; PG8_MMA(0, 0, At, B0); PG8_MMA(0, 1, At, B1); PG8_BAR; PG8_SCHED;
            PG8_LDA(At, 1, 1); PG8_STAGE(PG8_SB(1, 0), b3, voffB); PG8_STAGE(PG8_SB(1, 1), b3 + hstep, voffB); PG8_STAGE(PG8_SA(1, 0), a3, voffA);
            PG8_WAIT_V(8); PG8_WAIT_L(0); PG8_BAR; PG8_MMA(1, 0, At, B0); PG8_MMA(1, 1, At, B1); PG8_BAR; PG8_SCHED;
            } else {
            PG8_LDB(B0, 0, 0); PG8_SCHED; PG8_LDA(At, 0, 0); PG8_STAGE(PG8_SA(1, 1), a1 + hstep, voffA);
            PG8_WAIT_L(8); PG8_BAR; PG8_WAIT_L(0); PG8_MMA(0, 0, At, B0); PG8_BAR; PG8_SCHED;
            PG8_LDB(B1, 0, 1); PG8_STAGE(PG8_SB(0, 0), b2, voffB);
            PG8_BAR; PG8_WAIT_L(0); PG8_MMA(0, 1, At, B1); PG8_BAR;
            PG8_LDA(At, 0, 1); PG8_STAGE(PG8_SA(0, 0), a2, voffA);
            PG8_BAR; PG8_WAIT_L(0); PG8_MMA(1, 0, At, B0); PG8_BAR; PG8_SCHED;
            PG8_STAGE(PG8_SB(0, 1), b2 + hstep, voffB);
            PG8_WAIT_V(6); PG8_BAR; PG8_MMA(1, 1, At, B1); PG8_BAR;
            PG8_LDB(B0, 1, 0); PG8_SCHED; PG8_LDA(At, 1, 0); PG8_STAGE(PG8_SA(0, 1), a2 + hstep, voffA);
            PG8_WAIT_L(8); PG8_BAR; PG8_WAIT_L(0); PG8_MMA(0, 0, At, B0); PG8_BAR; PG8_SCHED;
            PG8_LDB(B1, 1, 1); PG8_STAGE(PG8_SB(1, 0), b3, voffB);
            PG8_BAR; PG8_WAIT_L(0); PG8_MMA(0, 1, At, B1); PG8_BAR;
            PG8_LDA(At, 1, 1); PG8_STAGE(PG8_SA(1, 0), a3, voffA);
            PG8_BAR; PG8_WAIT_L(0); PG8_MMA(1, 0, At, B0); PG8_BAR; PG8_SCHED;
            PG8_STAGE(PG8_SB(1, 1), b3 + hstep, voffB);
            PG8_WAIT_V(6); PG8_BAR; PG8_MMA(1, 1, At, B1); PG8_BAR;
            }
        }
        if constexpr (FP8) asm volatile("s_nop 15\n\ts_nop 15" ::: "memory");
        if constexpr (ALIGN_EPI) { if (wr == 0) PG8_BAR; }
        if constexpr (!Epi::AFTER_DRAIN) { E(acc, cur, wr, wc, fr, fq); S.done(cur); }
        if (!has_next) break;
#pragma unroll
        for (int a = 0; a < 2; ++a)
#pragma unroll
            for (int b = 0; b < 2; ++b)
#pragma unroll
                for (int m = 0; m < 4; ++m)
#pragma unroll
                    for (int n = 0; n < 2; ++n) acc[a][b][m][n] = (f32x4){0.f, 0.f, 0.f, 0.f};
        cur = nxt; cA = nA; cB = nB; ++ui;
        if constexpr (ALIGN_EPI) { if (wr == 1) PG8_BAR; }
    }
    PG8_WAIT_V(0);
    if constexpr (!ALIGN_EPI) { if (wr == 0) PG8_BAR; }
    PG8_BAR;
    if constexpr (Epi::AFTER_DRAIN) { E.fused(acc, cur, wr, wc, fr, fq, lds, wid, lane); S.done(cur); }
#undef PG8_SA
#undef PG8_SB
#undef PG8_STAGE
#undef PG8_LDA
#undef PG8_LDB
#undef PG8_MMA
#undef PG8_WAIT_V
#undef PG8_WAIT_L
#undef PG8_BAR
#undef PG8_SCHED
}
}
#define GAS __attribute__((address_space(1)))
#define LAS __attribute__((address_space(3)))
typedef unsigned short bf16;
typedef unsigned v4u __attribute__((ext_vector_type(4)));
typedef float f32x4 __attribute__((ext_vector_type(4)));
typedef short bf16x8 __attribute__((ext_vector_type(8)));
typedef GAS unsigned gu32;
typedef GAS unsigned long long gu64;
#define RLX_AGENT __ATOMIC_RELAXED, __HIP_MEMORY_SCOPE_AGENT
#define LDS_WAIT() asm volatile("s_waitcnt lgkmcnt(0)" ::: "memory")
#define VM_WAIT() asm volatile("s_waitcnt vmcnt(0)" ::: "memory")
__device__ __forceinline__ unsigned long long rt() { return __builtin_amdgcn_s_memrealtime(); }
__device__ __forceinline__ unsigned f2bf(float f) { unsigned u = __builtin_bit_cast(unsigned, f); return (u + 0x7fffu + ((u >> 16) & 1u)) >> 16; }
__device__ __forceinline__ unsigned pk2(float lo, float hi) { return f2bf(lo) | (f2bf(hi) << 16); }

#define XB_TMO      128
#define XB_XCNT(j)  (256  + 64 * (j))
#define XB_XSUB(j)  (1280 + 64 * (j))
#define XB_XGEN(j)  (2304 + 64 * (j))
#define XB_TOP      3328
#define XB_TOPGEN   3392
#define XCD_BAR_WORDS 3456
#define XB_SPIN_CAP (1u << 18)

__device__ __forceinline__ unsigned xb_ld(unsigned* p)              { return __hip_atomic_load(p, __ATOMIC_RELAXED, __HIP_MEMORY_SCOPE_AGENT); }
__device__ __forceinline__ unsigned xb_add(unsigned* p, unsigned v) { return __hip_atomic_fetch_add(p, v, __ATOMIC_RELAXED, __HIP_MEMORY_SCOPE_AGENT); }
__device__ __forceinline__ unsigned xb_xcc_id() { return (unsigned)__builtin_amdgcn_s_getreg((3 << 11) | 20) & 0xFu; }
#define XB_SPIN(cond, bar) do { unsigned _sp = 0; while (cond) { __builtin_amdgcn_s_sleep(1); \
    if ((++_sp & 255u) == 0u) { if (xb_ld(&(bar)[XB_TMO])) break; if (_sp > XB_SPIN_CAP) { atomicAdd(&(bar)[XB_TMO], 1u); break; } } } } while (0)

struct XcdBarrier {
    unsigned* bar; unsigned x;
    volatile LAS unsigned* st;
};

__device__ __forceinline__ XcdBarrier xcd_barrier_post(unsigned* bar, volatile LAS unsigned* st) {
    XcdBarrier b; b.bar = bar; b.x = xb_xcc_id(); b.st = st;
    if (threadIdx.x == 0) (void)xb_add(&bar[XB_XCNT(b.x)], 1u);
    return b;
}
__device__ __forceinline__ void xcd_barrier_complete(unsigned* bar, unsigned x, unsigned& nloc, unsigned& nx) {
    const unsigned G = gridDim.x * gridDim.y * gridDim.z;
    unsigned sum, cnt, mine, sp = 0u;
    for (;;) {
        sum = 0u; cnt = 0u; mine = 0u;
#pragma unroll
        for (unsigned j = 0; j < 16; ++j) { const unsigned c = xb_ld(&bar[XB_XCNT(j)]); sum += c; cnt += (c > 0u) ? 1u : 0u; mine = (j == x) ? c : mine; }
        if (sum == G) break;
        __builtin_amdgcn_s_sleep(1);
        if ((++sp & 255u) == 0u) { if (xb_ld(&bar[XB_TMO])) break; if (sp > XB_SPIN_CAP) { atomicAdd(&bar[XB_TMO], 1u); break; } }
    }
    nloc = mine > 0u ? mine : 1u; nx = cnt > 0u ? cnt : 1u;
}

__device__ __forceinline__ void xcd_barrier(const XcdBarrier& b) {
    asm volatile("s_waitcnt vmcnt(0)" ::: "memory");
    __syncthreads();
    if (threadIdx.x == 0) {
        unsigned* bar = b.bar;
        __builtin_amdgcn_s_waitcnt(0);
        unsigned nloc = b.st[0], nx = b.st[1];
        if (nloc == 0u) { xcd_barrier_complete(bar, b.x, nloc, nx); b.st[0] = nloc; b.st[1] = nx; }
        const unsigned old = xb_add(&bar[XB_XSUB(b.x)], 1u);
        const unsigned gen = old / nloc;
        if (old + 1u == (gen + 1u) * nloc) {
            __builtin_amdgcn_fence(__ATOMIC_RELEASE, "agent");
            asm volatile("s_waitcnt vmcnt(0)" ::: "memory");
            const unsigned og = xb_add(&bar[XB_TOP], 1u);
            const unsigned tg = og / nx;
            if (og + 1u == (tg + 1u) * nx) xb_add(&bar[XB_TOPGEN], 1u);
            else XB_SPIN(xb_ld(&bar[XB_TOPGEN]) == tg, bar);
            __builtin_amdgcn_fence(__ATOMIC_ACQUIRE, "agent");
            xb_add(&bar[XB_XGEN(b.x)], 1u);
            asm volatile("s_waitcnt vmcnt(0)" ::: "memory");
        } else {
            XB_SPIN(xb_ld(&bar[XB_XGEN(b.x)]) == gen, bar);
            __builtin_amdgcn_fence(__ATOMIC_ACQUIRE, "agent");
            asm volatile("s_waitcnt vmcnt(0)" ::: "memory");
        }
    }
    __syncthreads();
}

constexpr int NWAVES = 8;
#ifndef MK_PER_PHASE
#define MK_PER_PHASE 0
#endif
constexpr int NPHASE = 22;

constexpr int BATCH = 2, SEQ = 8192, DM = 2048, NTOK = BATCH * SEQ, NH = 16, DH = 128;
constexpr int NSA_N = 5168, NSA_NPAD = 5376, P0LD = 5120;
constexpr int NCMP = 511, NSELB = 128;
constexpr int COL_KC = 2048, COL_VC = 2560, COL_KS = 3072, COL_VS = 3584, COL_KW = 4096, COL_VW = 4608;
constexpr int DSA_N = 2888, DSA_NPAD = 3072, KVR = 256, TOPK = 256;
constexpr int DFF = 5632, NEXP = 8, DFFE = 7168, MOE_ROWS = 34816;
constexpr float ALPHA = 1.41421356237309515f, LN_EPS = 1e-5f, RMS_EPS = 1e-6f;

constexpr size_t MiB = (size_t)1 << 20;
constexpr size_t WS_CTL = 0, CTL_ZERO_BYTES = 128 * 1024;
constexpr size_t WS_W_NSA_IN = 2 * MiB, WS_W_NSA_OUT = 23 * MiB, WS_W_FFN_GU = 31 * MiB, WS_W_FFN_DN = 75 * MiB, WS_W_DSA_IN = 97 * MiB, WS_W_DSA_OUT = 109 * MiB;
constexpr size_t WS_W_CMPK = 117 * MiB, WS_W_CMPV = 118 * MiB, WS_W_UK = 119 * MiB, WS_W_UV = 120 * MiB, WS_CBIAS = 121 * MiB;
constexpr size_t WS_KCMP = 122 * MiB, WS_VCMP = 124 * MiB, WS_GL = 126 * MiB, WS_ROUTE = 129 * MiB;
constexpr size_t WS_KIB = 179 * MiB;
constexpr size_t WS_SELM = 178 * MiB;
constexpr size_t WS_CRAW = 130 * MiB, WS_KIWI = 146 * MiB, WS_IDX = 154 * MiB, WS_CN = 170 * MiB;
constexpr size_t WS_W_MOE_GU = 192 * MiB, WS_W_MOE_DN = 640 * MiB;
constexpr size_t WS_XB = 864 * MiB, WS_XF = 928 * MiB, WS_Z = 1056 * MiB;
constexpr size_t WS_P0 = 1184 * MiB, WS_OATT0 = 1344 * MiB, WS_HFF = 1408 * MiB;
constexpr size_t WS_Q = 1184 * MiB, WS_QI = 1248 * MiB, WS_QLAT = 1264 * MiB, WS_OLAT = 1392 * MiB, WS_OATT1 = 1520 * MiB;
constexpr size_t WS_XG = 1056 * MiB, WS_HM = 1192 * MiB, WS_Y = 192 * MiB;
constexpr size_t WS_END = 1668 * MiB;
static_assert(WS_HM + (size_t)MOE_ROWS * DFFE * 2 <= WS_END, "hm fits");
static_assert(WS_XG + (size_t)MOE_ROWS * DM * 2 <= WS_HM, "xg fits");
static_assert(WS_Y + (size_t)MOE_ROWS * DM * 4 <= WS_W_MOE_DN, "y overlays the dead gate/up weights only");
static_assert(WS_HFF + (size_t)NTOK * DFF * 2 <= WS_END, "hff fits");
constexpr int CW_TMO = 0, CW_CODE = 1;
constexpr int CW_BAR = 4096;
constexpr int CW_MOECNT = 16384;

constexpr int RING_OFF = 0, RING_BYTES = 131072;
constexpr int LDSCTL_OFF = RING_BYTES, MISC_OFF = LDSCTL_OFF + 320;
constexpr int LDS_BYTES = 163840;
constexpr int DSA_SCR = 133120;

struct Frame {
    LAS unsigned char* lds;
    volatile LAS unsigned* MISC;
    gu32* ctl;
    int tid, lane, wave, vcu, G;
};

__device__ __forceinline__ void relaunder(Frame& F) { int t = F.tid; asm volatile("" : "+v"(t)); F.tid = t; F.lane = t & 63; }
__device__ __forceinline__ float bf2f(unsigned short h) { return __uint_as_float(((unsigned)h) << 16); }
__device__ __forceinline__ float bflo(unsigned w) { return __uint_as_float(w << 16); }
__device__ __forceinline__ float bfhi(unsigned w) { return __uint_as_float(w & 0xffff0000u); }
__device__ __forceinline__ float wave_sum(float v) {
#pragma unroll
    for (int o = 1; o < 64; o <<= 1) v += __shfl_xor(v, o);
    return v;
}
__device__ __forceinline__ float wave_max(float v) {
#pragma unroll
    for (int o = 1; o < 64; o <<= 1) v = fmaxf(v, __shfl_xor(v, o));
    return v;
}
__device__ __forceinline__ float dpp_xor1(float v) { return __int_as_float(__builtin_amdgcn_mov_dpp(__float_as_int(v), 0xB1, 0xF, 0xF, true)); }
__device__ __forceinline__ float dpp_xor2(float v) { return __int_as_float(__builtin_amdgcn_mov_dpp(__float_as_int(v), 0x4E, 0xF, 0xF, true)); }
__device__ __forceinline__ float sum_xor32(float v) { auto r = __builtin_amdgcn_permlane32_swap(__float_as_uint(v), __float_as_uint(v), false, false); return __uint_as_float(r[0]) + __uint_as_float(r[1]); }
__device__ __forceinline__ float max_xor32(float v) { auto r = __builtin_amdgcn_permlane32_swap(__float_as_uint(v), __float_as_uint(v), false, false); return fmaxf(__uint_as_float(r[0]), __uint_as_float(r[1])); }
__device__ __forceinline__ float sum_xor16(float v) { auto r = __builtin_amdgcn_permlane16_swap(__float_as_uint(v), __float_as_uint(v), false, false); return __uint_as_float(r[0]) + __uint_as_float(r[1]); }
__device__ __forceinline__ float max_xor16(float v) { auto r = __builtin_amdgcn_permlane16_swap(__float_as_uint(v), __float_as_uint(v), false, false); return fmaxf(__uint_as_float(r[0]), __uint_as_float(r[1])); }
#define WSYNC() do { __builtin_amdgcn_wave_barrier(); asm volatile("s_waitcnt lgkmcnt(0)" ::: "memory"); __builtin_amdgcn_wave_barrier(); } while (0)

__device__ __forceinline__ int rel_bucket(int n) {
    if (n < 16) return n;
    if (n >= 113) return 31;
    int b = 16;
    b += (n >= 19); b += (n >= 21); b += (n >= 24); b += (n >= 27); b += (n >= 31); b += (n >= 35); b += (n >= 40); b += (n >= 46);
    b += (n >= 52); b += (n >= 59); b += (n >= 67); b += (n >= 77); b += (n >= 87); b += (n >= 99);
    return b;
}

struct Args { const float* in[27]; float* out; unsigned char* ws; int ph_lo, ph_hi; };
#ifndef FFN_F8
#define FFN_F8 1
#endif
struct TrItem { const float* W; bf16* WT; int N, K, k0, n0, drow; float f8scale; };
__device__ __forceinline__ void tr_set(TrItem& T, const float* W, int K, int N, int Npad, bf16* WT, int mode, int item, float f8scale = 0.f) {
    T.f8scale = f8scale;
    const int nblk = Npad / 32, kb = item / nblk, nb = item - kb * nblk, n0 = 32 * nb;
    T.W = W; T.WT = WT; T.N = N; T.K = K; T.k0 = 64 * kb; T.n0 = n0; T.drow = (mode == 0) ? n0 : ((n0 >> 7) * 256 + (mode - 1) * 128 + (n0 & 127));
}
constexpr int TR_I_NSA_IN = (DM / 64) * (NSA_NPAD / 32), TR_I_SQ = (DM / 64) * (DM / 32), TR_I_FFN = (DM / 64) * (DFF / 32), TR_I_FFD = (DFF / 64) * (DM / 32), TR_I_DSA_IN = (DM / 64) * (DSA_NPAD / 32);
constexpr int TR_I_CMP = (4096 / 64) * (128 / 32), TR_I_UK1 = (128 / 64) * (256 / 32), TR_I_UV1 = (256 / 64) * (128 / 32);
constexpr int TR_I_MG1 = (DM / 64) * (DFFE / 32), TR_I_MD1 = (DFFE / 64) * (DM / 32);
constexpr int TR_NITEMS = TR_I_NSA_IN + 2 * TR_I_SQ + 2 * TR_I_FFN + TR_I_FFD + TR_I_DSA_IN + 2 * TR_I_CMP + 16 * TR_I_UK1 + 16 * TR_I_UV1 + 16 * TR_I_MG1 + 8 * TR_I_MD1;
__device__ __forceinline__ void tr_decode(const Args& A, unsigned char* ws, int it, TrItem& T) {
    int r = it;
    if (r < TR_I_NSA_IN) { tr_set(T, A.in[2], DM, NSA_N, NSA_NPAD, (bf16*)(ws + WS_W_NSA_IN), 0, r); return; } r -= TR_I_NSA_IN;
    if (r < TR_I_SQ) { tr_set(T, A.in[9], DM, DM, DM, (bf16*)(ws + WS_W_NSA_OUT), 0, r); return; } r -= TR_I_SQ;
    if (r < TR_I_SQ) { tr_set(T, A.in[14], DM, DM, DM, (bf16*)(ws + WS_W_DSA_OUT), 0, r); return; } r -= TR_I_SQ;
    if (r < TR_I_FFN) { tr_set(T, A.in[15], DM, DFF, DFF, (bf16*)(ws + WS_W_FFN_GU), 1, r, FFN_F8 ? 64.f : 0.f); return; } r -= TR_I_FFN;
    if (r < TR_I_FFN) { tr_set(T, A.in[16], DM, DFF, DFF, (bf16*)(ws + WS_W_FFN_GU), 2, r, FFN_F8 ? 64.f : 0.f); return; } r -= TR_I_FFN;
    if (r < TR_I_FFD) { tr_set(T, A.in[17], DFF, DM, DM, (bf16*)(ws + WS_W_FFN_DN), 0, r, FFN_F8 ? 256.f : 0.f); return; } r -= TR_I_FFD;
    if (r < TR_I_DSA_IN) { tr_set(T, A.in[10], DM, DSA_N, DSA_NPAD, (bf16*)(ws + WS_W_DSA_IN), 0, r); return; } r -= TR_I_DSA_IN;
    if (r < TR_I_CMP) { tr_set(T, A.in[4], 4096, 128, 128, (bf16*)(ws + WS_W_CMPK), 0, r); return; } r -= TR_I_CMP;
    if (r < TR_I_CMP) { tr_set(T, A.in[7], 4096, 128, 128, (bf16*)(ws + WS_W_CMPV), 0, r); return; } r -= TR_I_CMP;
    if (r < 16 * TR_I_UK1) { const int h = r / TR_I_UK1; tr_set(T, A.in[12] + (size_t)h * 128 * 256, 128, 256, 256, (bf16*)(ws + WS_W_UK) + (size_t)h * 256 * 128, 0, r - h * TR_I_UK1); return; } r -= 16 * TR_I_UK1;
    if (r < 16 * TR_I_UV1) { const int h = r / TR_I_UV1; tr_set(T, A.in[13] + (size_t)h * 256 * 128, 256, 128, 128, (bf16*)(ws + WS_W_UV) + (size_t)h * 128 * 256, 0, r - h * TR_I_UV1); return; } r -= 16 * TR_I_UV1;
    if (r < 8 * TR_I_MG1) { const int e = r / TR_I_MG1; tr_set(T, A.in[20] + (size_t)e * DM * DFFE, DM, DFFE, DFFE, (bf16*)(ws + WS_W_MOE_GU + (size_t)e * 2 * DFFE * DM), 1, r - e * TR_I_MG1, 64.f); return; } r -= 8 * TR_I_MG1;
    if (r < 8 * TR_I_MG1) { const int e = r / TR_I_MG1; tr_set(T, A.in[21] + (size_t)e * DM * DFFE, DM, DFFE, DFFE, (bf16*)(ws + WS_W_MOE_GU + (size_t)e * 2 * DFFE * DM), 2, r - e * TR_I_MG1, 64.f); return; } r -= 8 * TR_I_MG1;
    { const int e = r / TR_I_MD1; tr_set(T, A.in[22] + (size_t)e * DFFE * DM, DFFE, DM, DM, (bf16*)(ws + WS_W_MOE_DN + (size_t)e * DM * DFFE), 0, r - e * TR_I_MD1, 256.f); }
}
__device__ __forceinline__ void tr_load(const TrItem& T, f32x4 (&v)[8], int lane) {
    const int kr = lane >> 3, c4 = lane & 7, n = T.n0 + 4 * c4;
#pragma unroll
    for (int i = 0; i < 8; ++i) v[i] = (n < T.N) ? *(const f32x4*)(T.W + (size_t)(T.k0 + 8 * i + kr) * T.N + n) : (f32x4){0.f, 0.f, 0.f, 0.f};
}
__device__ __forceinline__ void tr_store(const TrItem& T, const f32x4 (&v)[8], LAS float* scr, int lane) {
    { const int kr = lane >> 3, c4 = lane & 7;
#pragma unroll
      for (int i = 0; i < 8; ++i) { LAS float* d = scr + (8 * i + kr) * 33 + 4 * c4; d[0] = v[i][0]; d[1] = v[i][1]; d[2] = v[i][2]; d[3] = v[i][3]; } }
    LDS_WAIT(); asm volatile("" ::: "memory");
    const int c = lane & 7;
#pragma unroll
    for (int j = 0; j < 4; ++j) { const int n = (lane >> 3) + 8 * j; const LAS float* s = scr + (8 * c) * 33 + n;
        v4u o; o.x = pg8::cvt_pk_bf16(s[0 * 33], s[1 * 33]); o.y = pg8::cvt_pk_bf16(s[2 * 33], s[3 * 33]); o.z = pg8::cvt_pk_bf16(s[4 * 33], s[5 * 33]); o.w = pg8::cvt_pk_bf16(s[6 * 33], s[7 * 33]);
        *(v4u*)(T.WT + (size_t)(T.drow + n) * T.K + T.k0 + 8 * c) = o; }
    LDS_WAIT(); asm volatile("" ::: "memory");
}

__device__ __forceinline__ void tr_store8(const TrItem& T, const f32x4 (&v)[8], LAS float* scr, int lane) {
    { const int kr = lane >> 3, c4 = lane & 7;
#pragma unroll
      for (int i = 0; i < 8; ++i) { LAS float* d = scr + (8 * i + kr) * 33 + 4 * c4; d[0] = v[i][0]; d[1] = v[i][1]; d[2] = v[i][2]; d[3] = v[i][3]; } }
    LDS_WAIT(); asm volatile("" ::: "memory");
    const int c = lane & 3, nr = lane >> 2; const float sc = T.f8scale;
#pragma unroll
    for (int j = 0; j < 2; ++j) { const int n = nr + 16 * j; const LAS float* s = scr + (16 * c) * 33 + n; int w[4];
#pragma unroll
        for (int q = 0; q < 4; ++q) { w[q] = __builtin_amdgcn_cvt_pk_fp8_f32(s[(4 * q) * 33] * sc, s[(4 * q + 1) * 33] * sc, 0, false); w[q] = __builtin_amdgcn_cvt_pk_fp8_f32(s[(4 * q + 2) * 33] * sc, s[(4 * q + 3) * 33] * sc, w[q], true); }
        v4u o; o.x = (unsigned)w[0]; o.y = (unsigned)w[1]; o.z = (unsigned)w[2]; o.w = (unsigned)w[3];
        *(v4u*)((unsigned char*)T.WT + (size_t)(T.drow + n) * T.K + T.k0 + 16 * c) = o; }
    LDS_WAIT(); asm volatile("" ::: "memory");
}
__device__ __forceinline__ void p0_prologue(Frame& F, const Args& A) {
    LAS float* scr = (LAS float*)(F.lds + RING_OFF + F.wave * 16384);
    unsigned char* ws = A.ws;
    const int gw = F.vcu * NWAVES + F.wave, NGW = F.G * NWAVES, lane = F.lane;
    {
        TrItem T0, T1, T2, T3; f32x4 v0[8], v1[8], v2[8], v3[8]; int it = gw;
#define TR_ISSUE(T, v, idx) do { if ((idx) < TR_NITEMS) { tr_decode(A, ws, (idx), T); tr_load(T, v, lane); } } while (0)
#define TR_RETIRE(T, v, idx) do { if ((idx) < TR_NITEMS) { if (T.f8scale != 0.f) tr_store8(T, v, scr, lane); else tr_store(T, v, scr, lane); } } while (0)
        TR_ISSUE(T0, v0, it); TR_ISSUE(T1, v1, it + NGW); TR_ISSUE(T2, v2, it + 2 * NGW);
        while (it < TR_NITEMS) {
            TR_ISSUE(T3, v3, it + 3 * NGW); TR_RETIRE(T0, v0, it);
            TR_ISSUE(T0, v0, it + 4 * NGW); TR_RETIRE(T1, v1, it + NGW);
            TR_ISSUE(T1, v1, it + 5 * NGW); TR_RETIRE(T2, v2, it + 2 * NGW);
            TR_ISSUE(T2, v2, it + 6 * NGW); TR_RETIRE(T3, v3, it + 3 * NGW);
            it += 4 * NGW;
        }
#undef TR_ISSUE
#undef TR_RETIRE
    }
    { const float* x = A.in[0]; bf16* xb = (bf16*)(ws + WS_XB); const size_t n8 = (size_t)NTOK * DM / 8;
      for (size_t i = (size_t)F.vcu * 512 + F.tid; i < n8; i += (size_t)F.G * 512) { const f32x4 a = *(const f32x4*)(x + i * 8), b = *(const f32x4*)(x + i * 8 + 4);
          v4u o; o.x = pk2(a[0], a[1]); o.y = pk2(a[2], a[3]); o.z = pk2(b[0], b[1]); o.w = pk2(b[2], b[3]); *(v4u*)(xb + i * 8) = o; } }
    for (int it = gw; it < 64; it += NGW) { const int kv = it >> 5, ch = it & 31; const float* pe = A.in[kv ? 6 : 3]; const float* w1 = A.in[kv ? 7 : 4];
        float s0 = 0.f, s1 = 0.f;
        for (int k = ch * 128; k < ch * 128 + 128; ++k) { const float p = pe[k]; s0 += p * w1[(size_t)k * 128 + lane]; s1 += p * w1[(size_t)k * 128 + 64 + lane]; }
        float* cb = (float*)(ws + WS_CBIAS) + (size_t)(kv * 32 + ch) * 128; cb[lane] = s0; cb[64 + lane] = s1; }
}

typedef short s8v __attribute__((ext_vector_type(8)));
__device__ __forceinline__ s8v ld_frag(const bf16* p) { return *(const s8v*)p; }

__device__ __forceinline__ float gelu_tanh(float x) { const float u = 0.7978845608028654f * (x + 0.044715f * x * x * x); return 0.5f * x * (1.0f + tanhf(u)); }
__device__ __forceinline__ void p2_compress(Frame& F, const Args& A) {
    unsigned char* ws = A.ws; const int lane = F.lane, wid = F.wave, tid = F.tid;
    const bf16* P0 = (const bf16*)(ws + WS_P0);
    LAS float* part = (LAS float*)(F.lds + RING_OFF);
    LAS float* hid = (LAS float*)(F.lds + DSA_SCR);
    LAS float* cbl = hid + 4096;
    if (tid < 256) { const float* cbp = (const float*)(ws + WS_CBIAS) + (size_t)(tid >> 7) * 32 * 128 + (tid & 127); float cb = 0.f; for (int ch = 0; ch < 32; ++ch) cb += cbp[ch * 128]; cbl[tid] = cb; }
    if (F.vcu < 16 && wid == 0) { bf16* zp = (bf16*)(ws + ((F.vcu & 1) ? WS_VCMP : WS_KCMP)) + ((size_t)(F.vcu >> 1) * 512 + 511) * 128; zp[lane] = 0; zp[64 + lane] = 0; }
    __syncthreads();
    const int r16 = lane & 15, kq = lane >> 4;
    for (int it = F.vcu; it < 256; it += F.G) {
        const int kv = it >> 7, tile = it & 127;
        const bf16* W1T = (const bf16*)(ws + (kv ? WS_W_CMPV : WS_W_CMPK));
        const float* w2 = A.in[kv ? 8 : 5];
        bf16* outp = (bf16*)(ws + (kv ? WS_VCMP : WS_KCMP));
        const int colbase = kv ? COL_VC : COL_KC;
        f32x4 acc[2][8];
#pragma unroll
        for (int m = 0; m < 2; ++m)
#pragma unroll
            for (int n = 0; n < 8; ++n) acc[m][n] = (f32x4){0.f, 0.f, 0.f, 0.f};
        const bf16* arow[2];
#pragma unroll
        for (int m = 0; m < 2; ++m) { int R = tile * 32 + m * 16 + r16; if (R > 4087) R = 4087; const int g = R & 3, bn = R >> 2, b = bn / NCMP, n = bn - b * NCMP;
            arow[m] = P0 + (size_t)(b * SEQ + 16 * n) * P0LD + colbase + g * 128 + kq * 8; }
#pragma unroll 2
        for (int kk = 0; kk < 16; ++kk) {
            const int ks = wid * 16 + kk, l = ks >> 2, d0 = (ks & 3) * 32;
            s8v af[2], bfr[8];
#pragma unroll
            for (int m = 0; m < 2; ++m) af[m] = ld_frag(arow[m] + (size_t)l * P0LD + d0);
#pragma unroll
            for (int n = 0; n < 8; ++n) bfr[n] = ld_frag(W1T + (size_t)(n * 16 + r16) * 4096 + ks * 32 + kq * 8);
#pragma unroll
            for (int m = 0; m < 2; ++m)
#pragma unroll
                for (int n = 0; n < 8; ++n) acc[m][n] = __builtin_amdgcn_mfma_f32_16x16x32_bf16(af[m], bfr[n], acc[m][n], 0, 0, 0);
        }
#pragma unroll
        for (int m = 0; m < 2; ++m)
#pragma unroll
            for (int n = 0; n < 8; ++n)
#pragma unroll
                for (int j = 0; j < 4; ++j) part[wid * 4096 + (m * 16 + kq * 4 + j) * 128 + n * 16 + r16] = acc[m][n][j];
        __syncthreads();
        { const int row = tid >> 4, e0 = (tid & 15) * 8; f32x4 s0 = (f32x4){0.f, 0.f, 0.f, 0.f}, s1 = s0;
#pragma unroll
          for (int w = 0; w < 8; ++w) { s0 += *(const LAS f32x4*)(part + w * 4096 + row * 128 + e0); s1 += *(const LAS f32x4*)(part + w * 4096 + row * 128 + e0 + 4); }
#pragma unroll
          for (int j = 0; j < 4; ++j) { hid[row * 128 + e0 + j] = gelu_tanh(s0[j] + cbl[kv * 128 + e0 + j]); hid[row * 128 + e0 + 4 + j] = gelu_tanh(s1[j] + cbl[kv * 128 + e0 + 4 + j]); } }
        __syncthreads();
        { const int rr = tid >> 4, f0 = (tid & 15) * 8, R = tile * 32 + rr; f32x4 o0 = (f32x4){0.f, 0.f, 0.f, 0.f}, o1 = o0;
#pragma unroll 4
          for (int e = 0; e < 128; ++e) { const float hv = hid[rr * 128 + e]; o0 += *(const f32x4*)(w2 + e * 128 + f0) * hv; o1 += *(const f32x4*)(w2 + e * 128 + f0 + 4) * hv; }
          if (R <= 4087) { const int g = R & 3, bn = R >> 2, b = bn / NCMP, n = bn - b * NCMP;
              v4u o; o.x = pk2(o0[0], o0[1]); o.y = pk2(o0[2], o0[3]); o.z = pk2(o1[0], o1[1]); o.w = pk2(o1[2], o1[3]);
              *(v4u*)(outp + ((size_t)(b * 4 + g) * 512 + n) * 128 + f0) = o; } }
        __syncthreads();
    }
}

namespace fa {
typedef float f32x16 __attribute__((ext_vector_type(16)));
typedef short s16x4 __attribute__((ext_vector_type(4)));
typedef unsigned u32x4v __attribute__((ext_vector_type(4)));
constexpr int SHM_K = 16384, SHM_V = 16384;
constexpr int OFF_V = 0, OFF_K = 2 * SHM_V, OFF_WS = 2 * SHM_V + 2 * SHM_K, OFF_LUT = OFF_WS + 8 * 256, OFF_MASK = OFF_LUT + 144 * 16 * 4, OFF_TAB = OFF_MASK + 1024;
constexpr int TABLD = 130;
constexpr float C2 = 1.4426950408889634f, THR = 8.f;
#define FA_KSWZ(row, colB) ((row) * 256 + ((colB) ^ (((row) & 7) << 4)))
#define FA_SBAR() __builtin_amdgcn_sched_barrier(0)
__device__ __forceinline__ int v_st(int k, int c) { const int kk = (k & ~0xC) | ((k & 4) << 1) | ((k & 8) >> 1); return ((kk >> 3) * 4 + (c >> 5)) * 512 + ((kk & 7) * 32 + (c & 31)) * 2; }
__device__ __forceinline__ int v_rd_base(int lane) { return ((lane & 3) << 3) | (((lane >> 2) & 3) << 6) | (((lane >> 4) & 1) << 5) | (((lane >> 5) & 1) << 8); }
constexpr int v_rd_off(int d0, int ks, int half) { return d0 * 512 + ks * 4096 + half * 2048; }
__device__ __forceinline__ int crow(int r, int hi) { return (r & 3) + 8 * (r >> 2) + 4 * hi; }
__device__ __forceinline__ unsigned cvtpk(float lo, float hi) { unsigned r; asm volatile("v_cvt_pk_bf16_f32 %0, %1, %2" : "=v"(r) : "v"(lo), "v"(hi)); return r; }

__device__ __forceinline__ void qkt(f32x16& p0, f32x16& p1, const LAS char* Kb, int r32, int hi, const bf16x8 (&qr)[8], float init) {
#pragma unroll
    for (int r = 0; r < 16; ++r) { p0[r] = init; p1[r] = init; }
    const LAS char* kb[4];
#pragma unroll
    for (int dd = 0; dd < 4; ++dd) kb[dd] = Kb + FA_KSWZ(r32, (dd * 16 + hi * 8) * 2);
#pragma unroll
    for (int d0 = 0; d0 < 8; ++d0) { const LAS char* a = kb[d0 & 3] + (d0 >> 2) * 128;
        const bf16x8 b0 = *(const LAS bf16x8*)a;
        const bf16x8 b1 = *(const LAS bf16x8*)(a + 32 * 256);
        p0 = __builtin_amdgcn_mfma_f32_32x32x16_bf16(b0, qr[d0], p0, 0, 0, 0);
        p1 = __builtin_amdgcn_mfma_f32_32x32x16_bf16(b1, qr[d0], p1, 0, 0, 0); }
}
__device__ __forceinline__ void pv_tile(f32x16 (&o)[4], int vb0, bf16x8 pa0, bf16x8 pa1, bf16x8 pa2, bf16x8 pa3) {
#define FA_TRRD(dst, off) asm volatile("ds_read_b64_tr_b16 %0, %1 offset:%2" : "=&v"(dst) : "v"(vb0), "i"(off) : "memory")
#define FA_PV_D0(d0) do { s16x4 l0, l1, l2, l3, h0, h1, h2, h3; constexpr int b_ = v_rd_off(d0, 0, 0); \
        FA_TRRD(l0, b_); FA_TRRD(h0, b_ + 2048); FA_TRRD(l1, b_ + 4096); FA_TRRD(h1, b_ + 6144); FA_TRRD(l2, b_ + 8192); FA_TRRD(h2, b_ + 10240); FA_TRRD(l3, b_ + 12288); FA_TRRD(h3, b_ + 14336); \
        asm volatile("s_waitcnt lgkmcnt(0)" ::: "memory"); FA_SBAR(); \
        o[d0] = __builtin_amdgcn_mfma_f32_32x32x16_bf16(pa0, (bf16x8){l0[0], l0[1], l0[2], l0[3], h0[0], h0[1], h0[2], h0[3]}, o[d0], 0, 0, 0); \
        o[d0] = __builtin_amdgcn_mfma_f32_32x32x16_bf16(pa1, (bf16x8){l1[0], l1[1], l1[2], l1[3], h1[0], h1[1], h1[2], h1[3]}, o[d0], 0, 0, 0); \
        o[d0] = __builtin_amdgcn_mfma_f32_32x32x16_bf16(pa2, (bf16x8){l2[0], l2[1], l2[2], l2[3], h2[0], h2[1], h2[2], h2[3]}, o[d0], 0, 0, 0); \
        o[d0] = __builtin_amdgcn_mfma_f32_32x32x16_bf16(pa3, (bf16x8){l3[0], l3[1], l3[2], l3[3], h3[0], h3[1], h3[2], h3[3]}, o[d0], 0, 0, 0); } while (0)
    FA_PV_D0(0); FA_PV_D0(1); FA_PV_D0(2); FA_PV_D0(3);
#undef FA_PV_D0
#undef FA_TRRD
}
__device__ __forceinline__ void partialSM(f32x16& p0, f32x16& p1, float& m_reg, float& alpha) {
    float pmax = p0[0];
#pragma unroll
    for (int r = 1; r < 16; ++r) pmax = fmaxf(pmax, p0[r]);
#pragma unroll
    for (int r = 0; r < 16; ++r) pmax = fmaxf(pmax, p1[r]);
    { auto rr = __builtin_amdgcn_permlane32_swap(__float_as_uint(pmax), __float_as_uint(pmax), false, false); pmax = fmaxf(__uint_as_float(rr[0]), __uint_as_float(rr[1])); }
    float mn;
    if (__all(pmax - m_reg <= THR)) { mn = m_reg; alpha = 1.f; }
    else { mn = fmaxf(m_reg, pmax); alpha = __builtin_amdgcn_exp2f((m_reg - mn) * C2); m_reg = mn; }
    const float mnL = -mn * C2;
#pragma unroll
    for (int r = 0; r < 16; ++r) { p0[r] = __builtin_amdgcn_exp2f(fmaf(p0[r], C2, mnL)); p1[r] = __builtin_amdgcn_exp2f(fmaf(p1[r], C2, mnL)); }
}
__device__ __forceinline__ float finishSM(const f32x16& p0, const f32x16& p1, bf16x8& pa0, bf16x8& pa1, bf16x8& pa2, bf16x8& pa3) {
    float ps = 0.f;
#pragma unroll
    for (int r = 0; r < 16; ++r) ps += p0[r];
#pragma unroll
    for (int r = 0; r < 16; ++r) ps += p1[r];
    { auto rr = __builtin_amdgcn_permlane32_swap(__float_as_uint(ps), __float_as_uint(ps), false, false); ps = __uint_as_float(rr[0]) + __uint_as_float(rr[1]); }
#define FA_PK4(P, B_, OUT) do { unsigned a0 = cvtpk(P[B_ + 0], P[B_ + 1]), a1 = cvtpk(P[B_ + 2], P[B_ + 3]); unsigned b0 = cvtpk(P[B_ + 4], P[B_ + 5]), b1 = cvtpk(P[B_ + 6], P[B_ + 7]); \
        auto r0 = __builtin_amdgcn_permlane32_swap(a0, b0, false, false); auto r1 = __builtin_amdgcn_permlane32_swap(a1, b1, false, false); \
        u32x4v w = {r0[0], r1[0], r0[1], r1[1]}; OUT = *reinterpret_cast<bf16x8*>(&w); } while (0)
    FA_PK4(p0, 0, pa0); FA_PK4(p0, 8, pa1); FA_PK4(p1, 0, pa2); FA_PK4(p1, 8, pa3);
#undef FA_PK4
    return ps;
}
__device__ __forceinline__ void rescale(f32x16 (&o)[4], float alpha, LAS float* al_l, int r32, int hi) {
    if (__any(alpha < 1.f)) { if (hi == 0) al_l[r32] = alpha; asm volatile("s_waitcnt lgkmcnt(0)" ::: "memory");
#pragma unroll
        for (int r = 0; r < 16; ++r) { const float a = al_l[crow(r, hi)];
#pragma unroll
            for (int d = 0; d < 4; ++d) o[d][r] *= a; }
        asm volatile("s_waitcnt lgkmcnt(0)" ::: "memory"); }
}
__device__ __forceinline__ void mask_tile(f32x16& p0, f32x16& p1, int dq, unsigned W) {
    const float NEG = -__builtin_inff();
#pragma unroll
    for (int r = 0; r < 16; ++r) { const int c = (r & 3) + 8 * (r >> 2);
        if ((unsigned)(dq - c) >= W) p0[r] = NEG;
        if ((unsigned)(dq - c - 32) >= W) p1[r] = NEG; }
}
__device__ __forceinline__ void mask_all(f32x16& p0, f32x16& p1, bool keep) {
    const float NEG = -__builtin_inff();
#pragma unroll
    for (int r = 0; r < 16; ++r) { p0[r] = keep ? p0[r] : NEG; p1[r] = keep ? p1[r] : NEG; }
}
__device__ __forceinline__ void bias_near(f32x16& p0, f32x16& p1, int dq, int step, const LAS float* lutcol) {
#pragma unroll
    for (int r = 0; r < 16; ++r) { const int c = (r & 3) + 8 * (r >> 2);
        const int d0 = min(max((dq - c) * step, 0), 128), d1 = min(max((dq - c - 32) * step, 0), 128);
        p0[r] += lutcol[d0]; p1[r] += lutcol[d1]; }
}
struct Stage { bf16x8 k0, k1, v0, v1; };
__device__ __forceinline__ void stage_load(Stage& S, const bf16* Kp, const bf16* Vp, size_t ld, int row0, int maxrow, int sr, int sc) {
    const int ra = min(row0 + sr, maxrow), rb = min(row0 + 32 + sr, maxrow);
    S.k0 = *(const bf16x8*)(Kp + (size_t)ra * ld + sc); S.k1 = *(const bf16x8*)(Kp + (size_t)rb * ld + sc);
    S.v0 = *(const bf16x8*)(Vp + (size_t)ra * ld + sc); S.v1 = *(const bf16x8*)(Vp + (size_t)rb * ld + sc);
}
__device__ __forceinline__ void stage_write(const Stage& S, LAS char* Kb, LAS char* Vb, int kws, int vst0, int vst1) {
    *(LAS bf16x8*)(Kb + kws) = S.k0; *(LAS bf16x8*)(Kb + kws + 32 * 256) = S.k1;
    *(LAS bf16x8*)(Vb + vst0) = S.v0; *(LAS bf16x8*)(Vb + vst1) = S.v1;
}
}

struct NsaLane { int wid, lane, r32, hi, ql, j, sr, sc, kws, vst0, vst1, vrd; };
__device__ __forceinline__ NsaLane nsa_lane(const Frame& F) {
    NsaLane L; L.wid = F.wave; L.lane = F.lane; L.r32 = F.lane & 31; L.hi = F.lane >> 5; L.ql = L.r32 >> 2; L.j = L.r32 & 3;
    L.sr = F.tid >> 4; L.sc = (F.tid & 15) * 8; L.kws = FA_KSWZ(L.sr, L.sc * 2); L.vst0 = fa::v_st(L.sr, L.sc); L.vst1 = fa::v_st(32 + L.sr, L.sc); L.vrd = fa::v_rd_base(F.lane);
    return L;
}
__device__ __forceinline__ void nsa_load_q(bf16x8 (&qr)[8], const bf16* P0, int tok0, int g, const NsaLane& L) {
    const bf16* qp = P0 + (size_t)(tok0 + L.wid * 8 + L.ql) * P0LD + (g * 4 + L.j) * 128 + L.hi * 8;
#pragma unroll
    for (int d0 = 0; d0 < 8; ++d0) qr[d0] = *(const bf16x8*)(qp + d0 * 16);
}
__device__ __forceinline__ void nsa_lut(Frame& F, const Args& A) {
    LAS float* lut = (LAS float*)(F.lds + RING_OFF + fa::OFF_LUT);
    for (int i = F.tid; i < 144 * 16; i += 512) { const int n = i >> 4, h = i & 15; lut[h * 144 + n] = A.in[1][rel_bucket(n) * 16 + h]; }
    __syncthreads();
}
template <int MODE>
__device__ __forceinline__ void nsa_store(const fa::f32x16 (&o)[4], float l_reg, LAS float* li_l, const float* GL, bf16* OACC, bf16* OATT, int tok0, int g, int br, const NsaLane& L) {
    if (L.hi == 0) li_l[L.r32] = l_reg;
    asm volatile("s_waitcnt lgkmcnt(0)" ::: "memory");
    float sc[16];
#pragma unroll
    for (int r = 0; r < 16; ++r) { const int row = fa::crow(r, L.hi), tok = tok0 + L.wid * 8 + (row >> 2), h = g * 4 + (row & 3); sc[r] = GL[(size_t)tok * 48 + h * 3 + br]; }
    unsigned prev[4][16];
    if (MODE != 0) {
#pragma unroll
        for (int r = 0; r < 16; ++r) { const int row = fa::crow(r, L.hi), tok = tok0 + L.wid * 8 + (row >> 2), h = g * 4 + (row & 3); const bf16* ap = OACC + (size_t)tok * DM + h * 128 + (L.r32 & ~1);
#pragma unroll
            for (int d0 = 0; d0 < 4; ++d0) prev[d0][r] = *(const unsigned*)(ap + d0 * 32); } }
#pragma unroll
    for (int r = 0; r < 16; ++r) { const int row = fa::crow(r, L.hi), tok = tok0 + L.wid * 8 + (row >> 2), h = g * 4 + (row & 3);
        const float l = li_l[row]; const float gl = sc[r];
        const float scl = (l > 0.f) ? __builtin_amdgcn_rcpf(l) / (1.0f + __expf(-gl)) : 0.f;
        bf16* dst = ((MODE == 2) ? OATT : OACC) + (size_t)tok * DM + h * 128 + L.r32;
#pragma unroll
        for (int d0 = 0; d0 < 4; ++d0) { float v = o[d0][r] * scl;
            if (MODE != 0) v += (L.r32 & 1) ? bfhi(prev[d0][r]) : bflo(prev[d0][r]);
            const float vn = dpp_xor1(v); if ((L.r32 & 1) == 0) *(unsigned*)(dst + d0 * 32) = fa::cvtpk(v, vn); } }
    asm volatile("s_waitcnt lgkmcnt(0)" ::: "memory");
}

__device__ __forceinline__ void p3a_nsa_cmp(Frame& F, const Args& A) {
    unsigned char* ws = A.ws; const NsaLane L = nsa_lane(F);
    const bf16* P0 = (const bf16*)(ws + WS_P0); const bf16* KCB = (const bf16*)(ws + WS_KCMP); const bf16* VCB = (const bf16*)(ws + WS_VCMP);
    const float* GL = (const float*)(ws + WS_GL); bf16* OACC = (bf16*)(ws + WS_Z + 64 * MiB); unsigned* SELM = (unsigned*)(ws + WS_SELM);
    nsa_lut(F, A);
    LAS char* lds = (LAS char*)(F.lds + RING_OFF);
    LAS float* wsf = (LAS float*)(lds + fa::OFF_WS) + L.wid * 64; LAS float* li_l = wsf; LAS float* al_l = wsf + 32;
    const LAS float* lut = (const LAS float*)(lds + fa::OFF_LUT);
    LAS float* tab = (LAS float*)(lds + fa::OFF_TAB);
    for (int ui = 0; ui < 2 * ((512 - F.vcu + F.G - 1) / F.G); ++ui) {
        const int p = F.vcu + (ui >> 1) * F.G, bg = p >> 6, y = p & 63, qb = (ui & 1) ? 127 - y : y, b = bg >> 2, g = bg & 3;
        const int tok0 = b * SEQ + qb * 64;
        bf16x8 qr[8]; nsa_load_q(qr, P0, tok0, g, L);
        const int trow = qb * 64 + L.wid * 8 + L.ql;
        const int h = g * 4 + L.j; const LAS float* lutcol = lut + h * 144; const float bias_far = lutcol[128];
        const int nmaxrow = (trow >= 31) ? (trow - 31) >> 4 : -1;
        const int NT = (4 * qb + 3 + 63) >> 6;
        const bf16* Kg = KCB + (size_t)(b * 4 + g) * 512 * 128; const bf16* Vg = VCB + (size_t)(b * 4 + g) * 512 * 128;
        for (int i = F.tid; i < 64 * fa::TABLD; i += 512) tab[i] = 0.f;
        float m_reg = -1e30f, l_reg = 0.f;
        fa::Stage S;
        const int rem16 = (trow >= 31) ? ((trow - 31) & 15) : 0;
        fa::stage_load(S, Kg, Vg, 128, 0, 511, L.sr, L.sc); asm volatile("s_waitcnt vmcnt(0)" ::: "memory");
        fa::stage_write(S, lds + fa::OFF_K, lds + fa::OFF_V, L.kws, L.vst0, L.vst1);
        __syncthreads();
#pragma unroll 1
        for (int t = 0; t < NT; ++t) {
            const int buf = t & 1;
            if (t + 1 < NT) fa::stage_load(S, Kg, Vg, 128, (t + 1) * 64, 511, L.sr, L.sc);
            fa::f32x16 p0, p1;
            const bool farT = (qb * 64 + L.wid * 8) - 31 - 16 * (t * 64 + 63) >= 128;
            fa::qkt(p0, p1, lds + fa::OFF_K + buf * fa::SHM_K, L.r32, L.hi, qr, farT ? bias_far : 0.f);
            const int dq = nmaxrow - t * 64 - 4 * L.hi;
            if (!farT) fa::bias_near(p0, p1, dq, 16, lutcol + rem16);
            fa::mask_tile(p0, p1, dq, 0x40000000u);
            float alpha; fa::partialSM(p0, p1, m_reg, alpha);
            float ps = 0.f;
#pragma unroll
            for (int r = 0; r < 16; ++r) ps += p0[r] + p1[r];
            { auto rr = __builtin_amdgcn_permlane32_swap(__float_as_uint(ps), __float_as_uint(ps), false, false); ps = __uint_as_float(rr[0]) + __uint_as_float(rr[1]); }
            l_reg = l_reg * alpha + ps;
            if (t + 1 < NT) { asm volatile("s_waitcnt vmcnt(0)" ::: "memory"); fa::stage_write(S, lds + fa::OFF_K + (buf ^ 1) * fa::SHM_K, lds + fa::OFF_V + (buf ^ 1) * fa::SHM_V, L.kws, L.vst0, L.vst1); }
            __syncthreads();
        }
        fa::f32x16 o[4];
#pragma unroll
        for (int d = 0; d < 4; ++d)
#pragma unroll
            for (int r = 0; r < 16; ++r) o[d][r] = 0.f;
        fa::stage_load(S, Kg, Vg, 128, 0, 511, L.sr, L.sc); asm volatile("s_waitcnt vmcnt(0)" ::: "memory");
        fa::stage_write(S, lds + fa::OFF_K, lds + fa::OFF_V, L.kws, L.vst0, L.vst1);
        __syncthreads();
        const float inv_l = (l_reg > 0.f) ? 1.0f / l_reg : 0.f; const float mnL = -m_reg * fa::C2;
#pragma unroll 1
        for (int t = 0; t < NT; ++t) {
            const int buf = t & 1;
            if (t + 1 < NT) fa::stage_load(S, Kg, Vg, 128, (t + 1) * 64, 511, L.sr, L.sc);
            fa::f32x16 p0, p1;
            const bool farT = (qb * 64 + L.wid * 8) - 31 - 16 * (t * 64 + 63) >= 128;
            fa::qkt(p0, p1, lds + fa::OFF_K + buf * fa::SHM_K, L.r32, L.hi, qr, farT ? bias_far : 0.f);
            const int dq = nmaxrow - t * 64 - 4 * L.hi;
            if (!farT) fa::bias_near(p0, p1, dq, 16, lutcol + rem16);
            fa::mask_tile(p0, p1, dq, 0x40000000u);
#pragma unroll
            for (int r = 0; r < 16; ++r) { p0[r] = __builtin_amdgcn_exp2f(fmaf(p0[r], fa::C2, mnL)) * inv_l; p1[r] = __builtin_amdgcn_exp2f(fmaf(p1[r], fa::C2, mnL)) * inv_l; }
            LAS float* tb = tab + (L.wid * 8 + L.ql) * fa::TABLD + t * 16 + L.hi;
#pragma unroll
            for (int half = 0; half < 2; ++half)
#pragma unroll
                for (int gq = 0; gq < 4; ++gq) { const fa::f32x16& pp = half ? p1 : p0;
                    float s4 = pp[4 * gq] + pp[4 * gq + 1] + pp[4 * gq + 2] + 0.5f * pp[4 * gq + 3], cr = 0.5f * pp[4 * gq + 3];
                    s4 += dpp_xor1(s4); s4 += dpp_xor2(s4); cr += dpp_xor1(cr); cr += dpp_xor2(cr);
                    if (L.j == 0) { __hip_atomic_fetch_add(tb + half * 8 + 2 * gq, s4, __ATOMIC_RELAXED, __HIP_MEMORY_SCOPE_WORKGROUP); __hip_atomic_fetch_add(tb + half * 8 + 2 * gq + 1, cr, __ATOMIC_RELAXED, __HIP_MEMORY_SCOPE_WORKGROUP); } }
            bf16x8 a0, a1, a2, a3; (void)fa::finishSM(p0, p1, a0, a1, a2, a3);
            fa::pv_tile(o, (int)(uintptr_t)(lds + fa::OFF_V + buf * fa::SHM_V) + L.vrd, a0, a1, a2, a3);
            if (t + 1 < NT) { asm volatile("s_waitcnt vmcnt(0)" ::: "memory"); fa::stage_write(S, lds + fa::OFF_K + (buf ^ 1) * fa::SHM_K, lds + fa::OFF_V + (buf ^ 1) * fa::SHM_V, L.kws, L.vst0, L.vst1); }
            __syncthreads();
        }
        nsa_store<0>(o, (l_reg > 0.f) ? 1.0f : 0.f, li_l, GL, OACC, nullptr, tok0, g, 0, L);
        __syncthreads();
        {
            bool s0[8], s1[8];
            if (qb < 16) {
#pragma unroll
                for (int qi = 0; qi < 8; ++qi) { s0[qi] = (L.lane <= qb); s1[qi] = false; }
            } else {
                unsigned k0[8], k1[8], lo[8];
#pragma unroll
                for (int qi = 0; qi < 8; ++qi) { const int ql = L.wid * 8 + qi;
                    const bool c0 = (L.lane >= 1 && L.lane <= qb - 2), c1 = (L.lane + 64 <= qb - 2);
                    k0[qi] = c0 ? __float_as_uint(tab[ql * fa::TABLD + L.lane]) + 1u : 0u; k1[qi] = c1 ? __float_as_uint(tab[ql * fa::TABLD + L.lane + 64]) + 1u : 0u;
                    s0[qi] = (L.lane == 0) || (L.lane == qb) || (L.lane == qb - 1); s1[qi] = (L.lane + 64 == qb) || (L.lane + 64 == qb - 1); lo[qi] = 0u; }
#pragma unroll 1
                for (int bit = 30; bit >= 0; --bit) {
#pragma unroll
                    for (int qi = 0; qi < 8; ++qi) { const unsigned cand = lo[qi] | (1u << bit);
                        const int cnt = __popcll(__ballot(k0[qi] >= cand)) + __popcll(__ballot(k1[qi] >= cand));
                        lo[qi] = (cnt >= 13) ? cand : lo[qi]; } }
#pragma unroll
                for (int qi = 0; qi < 8; ++qi) { const unsigned T = lo[qi];
                    const bool g0 = k0[qi] > T, g1 = k1[qi] > T, e0 = k0[qi] == T, e1 = k1[qi] == T;
                    const int need = 13 - (__popcll(__ballot(g0)) + __popcll(__ballot(g1)));
                    const unsigned long long be0 = __ballot(e0), be1 = __ballot(e1);
                    const int r0 = (int)__builtin_amdgcn_mbcnt_hi((unsigned)(be0 >> 32), __builtin_amdgcn_mbcnt_lo((unsigned)be0, 0u));
                    const int r1 = __popcll(be0) + (int)__builtin_amdgcn_mbcnt_hi((unsigned)(be1 >> 32), __builtin_amdgcn_mbcnt_lo((unsigned)be1, 0u));
                    s0[qi] = s0[qi] || g0 || (e0 && r0 < need); s1[qi] = s1[qi] || g1 || (e1 && r1 < need); }
            }
#pragma unroll
            for (int qi = 0; qi < 8; ++qi) { const int ql = L.wid * 8 + qi; const unsigned long long b0 = __ballot(s0[qi]), b1 = __ballot(s1[qi]);
                if (L.lane == 0) { uint4 mv; mv.x = (unsigned)b0; mv.y = (unsigned)(b0 >> 32); mv.z = (unsigned)b1; mv.w = (unsigned)(b1 >> 32); *(uint4*)(SELM + ((size_t)(tok0 + ql) * 4 + g) * 4) = mv; } }
        }
        __syncthreads();
    }
}
constexpr int N3_OFF_V = 0, N3_OFF_K = 3 * fa::SHM_V, N3_OFF_WS = 3 * fa::SHM_V + 3 * fa::SHM_K, N3_OFF_LUT = N3_OFF_WS + 8 * 256;
__device__ __forceinline__ void nsa_lut3(Frame& F, const Args& A) {
    LAS float* lut = (LAS float*)(F.lds + RING_OFF + N3_OFF_LUT);
    for (int i = F.tid; i < 144 * 16; i += 512) { const int n = i >> 4, h = i & 15; lut[h * 144 + n] = A.in[1][rel_bucket(n) * 16 + h]; }
    __syncthreads();
}
__device__ __forceinline__ void p3b_nsa_sel(Frame& F, const Args& A) {
    unsigned char* ws = A.ws; const NsaLane L = nsa_lane(F);
    const bf16* P0 = (const bf16*)(ws + WS_P0); const float* GL = (const float*)(ws + WS_GL); bf16* OACC = (bf16*)(ws + WS_Z + 64 * MiB); const unsigned* SELM = (const unsigned*)(ws + WS_SELM);
    nsa_lut3(F, A);
    LAS char* lds = (LAS char*)(F.lds + RING_OFF);
    LAS float* wsf = (LAS float*)(lds + N3_OFF_WS) + L.wid * 64; LAS float* li_l = wsf; LAS float* al_l = wsf + 32;
    const LAS float* lut = (const LAS float*)(lds + N3_OFF_LUT);
    const bool grpB = L.wid >= 4;
    for (int ui = 0; ui < 2 * ((512 - F.vcu + F.G - 1) / F.G); ++ui) {
        const int p = F.vcu + (ui >> 1) * F.G, bg = p >> 6, y = p & 63, qb = (ui & 1) ? 127 - y : y, b = bg >> 2, g = bg & 3;
        const int tok0 = b * SEQ + qb * 64;
        bf16x8 qr[8]; nsa_load_q(qr, P0, tok0, g, L);
        const int trow = qb * 64 + L.wid * 8 + L.ql;
        const int h = g * 4 + L.j; const LAS float* lutcol = lut + h * 144; const float bias_far = lutcol[128];
        const uint4 mv = *(const uint4*)(SELM + ((size_t)(tok0 + L.wid * 8 + L.ql) * 4 + g) * 4);
        const bf16* Kg = P0 + (size_t)b * SEQ * P0LD + COL_KS + g * 128; const bf16* Vg = P0 + (size_t)b * SEQ * P0LD + COL_VS + g * 128;
        const int NT = qb + 1;
        float m_reg = -1e30f, l_reg = 0.f; fa::f32x16 o[4];
#pragma unroll
        for (int d = 0; d < 4; ++d)
#pragma unroll
            for (int r = 0; r < 16; ++r) o[d][r] = 0.f;
        fa::Stage S;
        fa::stage_load(S, Kg, Vg, P0LD, 0, SEQ - 1, L.sr, L.sc); asm volatile("s_waitcnt vmcnt(0)" ::: "memory");
        fa::stage_write(S, lds + N3_OFF_K, lds + N3_OFF_V, L.kws, L.vst0, L.vst1);
        __syncthreads();
        bf16x8 a0 = {0, 0, 0, 0, 0, 0, 0, 0}, a1 = a0, a2 = a0, a3 = a0; bool actp = false;
        int bcur = 0, bprev = 2;
#pragma unroll 1
        for (int t = 0; t < NT; ++t) {
            const int bnext = (bcur == 2) ? 0 : bcur + 1;
            if (t + 1 < NT) fa::stage_load(S, Kg, Vg, P0LD, (t + 1) * 64, SEQ - 1, L.sr, L.sc);
            const unsigned word = (t < 32) ? mv.x : (t < 64) ? mv.y : (t < 96) ? mv.z : mv.w;
            const bool mine = ((word >> (t & 31)) & 1u) != 0u;
            const bool act = __any(mine);
            if (grpB && actp) fa::pv_tile(o, (int)(uintptr_t)(lds + N3_OFF_V + bprev * fa::SHM_V) + L.vrd, a0, a1, a2, a3);
            if (act) {
                fa::f32x16 p0, p1;
                const bool farT = (qb * 64 + L.wid * 8) - (t * 64 + 63) >= 128;
                fa::qkt(p0, p1, lds + N3_OFF_K + bcur * fa::SHM_K, L.r32, L.hi, qr, mine ? (farT ? bias_far : 0.f) : -__builtin_inff());
                const int dq = trow - t * 64 - 4 * L.hi;
                if (!farT) fa::bias_near(p0, p1, dq, 1, lutcol);
                if (t == qb) fa::mask_tile(p0, p1, dq, 0x40000000u);
                float alpha; fa::partialSM(p0, p1, m_reg, alpha);
                fa::rescale(o, alpha, al_l, L.r32, L.hi);
                const float ps = fa::finishSM(p0, p1, a0, a1, a2, a3); l_reg = l_reg * alpha + ps;
                if (!grpB) fa::pv_tile(o, (int)(uintptr_t)(lds + N3_OFF_V + bcur * fa::SHM_V) + L.vrd, a0, a1, a2, a3);
            }
            actp = act;
            if (t + 1 < NT) { asm volatile("s_waitcnt vmcnt(0)" ::: "memory"); fa::stage_write(S, lds + N3_OFF_K + bnext * fa::SHM_K, lds + N3_OFF_V + bnext * fa::SHM_V, L.kws, L.vst0, L.vst1); }
            __syncthreads();
            bprev = bcur; bcur = bnext;
        }
        if (grpB && actp) fa::pv_tile(o, (int)(uintptr_t)(lds + N3_OFF_V + bprev * fa::SHM_V) + L.vrd, a0, a1, a2, a3);
        nsa_store<1>(o, l_reg, li_l, GL, OACC, nullptr, tok0, g, 1, L);
        __syncthreads();
    }
}
__device__ __forceinline__ void p3c_nsa_win(Frame& F, const Args& A) {
    unsigned char* ws = A.ws; const NsaLane L = nsa_lane(F);
    const bf16* P0 = (const bf16*)(ws + WS_P0); const float* GL = (const float*)(ws + WS_GL); bf16* OACC = (bf16*)(ws + WS_Z + 64 * MiB); bf16* OATT = (bf16*)(ws + WS_OATT0);
    nsa_lut(F, A);
    LAS char* lds = (LAS char*)(F.lds + RING_OFF);
    LAS float* wsf = (LAS float*)(lds + fa::OFF_WS) + L.wid * 64; LAS float* li_l = wsf; LAS float* al_l = wsf + 32;
    const LAS float* lut = (const LAS float*)(lds + fa::OFF_LUT);
    for (int u = F.vcu; u < 1024; u += F.G) {
        const int bg = u >> 7, qb = u & 127, b = bg >> 2, g = bg & 3;
        const int tok0 = b * SEQ + qb * 64;
        bf16x8 qr[8]; nsa_load_q(qr, P0, tok0, g, L);
        const int trow = qb * 64 + L.wid * 8 + L.ql;
        const int h = g * 4 + L.j; const LAS float* lutcol = lut + h * 144; const float bias_far = lutcol[128];
        const bf16* Kg = P0 + (size_t)b * SEQ * P0LD + COL_KW + g * 128; const bf16* Vg = P0 + (size_t)b * SEQ * P0LD + COL_VW + g * 128;
        const int t0 = max(0, qb - 8), NT = qb - t0 + 1;
        float m_reg = -1e30f, l_reg = 0.f; fa::f32x16 o[4];
#pragma unroll
        for (int d = 0; d < 4; ++d)
#pragma unroll
            for (int r = 0; r < 16; ++r) o[d][r] = 0.f;
        fa::Stage S;
        fa::stage_load(S, Kg, Vg, P0LD, t0 * 64, SEQ - 1, L.sr, L.sc); asm volatile("s_waitcnt vmcnt(0)" ::: "memory");
        fa::stage_write(S, lds + fa::OFF_K, lds + fa::OFF_V, L.kws, L.vst0, L.vst1);
        __syncthreads();
#pragma unroll 1
        for (int tt = 0; tt < NT; ++tt) {
            const int buf = tt & 1, t = t0 + tt;
            if (tt + 1 < NT) fa::stage_load(S, Kg, Vg, P0LD, (t + 1) * 64, SEQ - 1, L.sr, L.sc);
            fa::f32x16 p0, p1;
            const bool farT = (qb * 64 + L.wid * 8) - (t * 64 + 63) >= 128;
            fa::qkt(p0, p1, lds + fa::OFF_K + buf * fa::SHM_K, L.r32, L.hi, qr, farT ? bias_far : 0.f);
            const int dq = trow - t * 64 - 4 * L.hi;
            if (!farT) fa::bias_near(p0, p1, dq, 1, lutcol);
            if (t == qb || t == t0) fa::mask_tile(p0, p1, dq, 512u);
            float alpha; fa::partialSM(p0, p1, m_reg, alpha);
            fa::rescale(o, alpha, al_l, L.r32, L.hi);
            bf16x8 a0, a1, a2, a3; const float ps = fa::finishSM(p0, p1, a0, a1, a2, a3); l_reg = l_reg * alpha + ps;
            fa::pv_tile(o, (int)(uintptr_t)(lds + fa::OFF_V + buf * fa::SHM_V) + L.vrd, a0, a1, a2, a3);
            if (tt + 1 < NT) { asm volatile("s_waitcnt vmcnt(0)" ::: "memory"); fa::stage_write(S, lds + fa::OFF_K + (buf ^ 1) * fa::SHM_K, lds + fa::OFF_V + (buf ^ 1) * fa::SHM_V, L.kws, L.vst0, L.vst1); }
            __syncthreads();
        }
        nsa_store<2>(o, l_reg, li_l, GL, OACC, OATT, tok0, g, 2, L);
        __syncthreads();
    }
}

template <bool ROUTE, bool F8 = false>
__device__ __forceinline__ void ln_phase(Frame& F, const Args& A, const bf16* Z, const float* gam, const float* bet, float* XF, bf16* XB) {
    const int gw = F.vcu * NWAVES + F.wave, NGW = F.G * NWAVES, lane = F.lane;
    LAS float* wrl = (LAS float*)(F.lds + RING_OFF);
    if (ROUTE) { for (int i = F.tid; i < DM * 8 / 4; i += 512) *(LAS f32x4*)(wrl + i * 4) = *(const f32x4*)(A.in[18] + i * 4); __syncthreads(); }
    for (int row = gw; row < NTOK; row += NGW) {
        const uint2* zr = (const uint2*)(Z + (size_t)row * DM) + lane;
        f32x4 v[8]; float s = 0.f;
#pragma unroll
        for (int j = 0; j < 8; ++j) { const uint2 z2 = zr[64 * j]; v[j] = (f32x4){bflo(z2.x), bfhi(z2.x), bflo(z2.y), bfhi(z2.y)}; s += (v[j][0] + v[j][1]) + (v[j][2] + v[j][3]); }
        const float mean = wave_sum(s) * (1.f / DM); float s2 = 0.f;
#pragma unroll
        for (int j = 0; j < 8; ++j) { v[j] = v[j] - mean; s2 += (v[j][0] * v[j][0] + v[j][1] * v[j][1]) + (v[j][2] * v[j][2] + v[j][3] * v[j][3]); }
        const float rstd = 1.f / sqrtf(wave_sum(s2) * (1.f / DM) + LN_EPS);
        float lg[8];
#pragma unroll
        for (int e = 0; e < 8; ++e) lg[e] = 0.f;
#pragma unroll
        for (int j = 0; j < 8; ++j) { const int c = 4 * lane + 256 * j; const f32x4 gg = *(const f32x4*)(gam + c), bb = *(const f32x4*)(bet + c);
            const f32x4 x = v[j] * rstd * gg + bb;
            *(f32x4*)(XF + (size_t)row * DM + c) = x;
            if (F8) { int w = __builtin_amdgcn_cvt_pk_fp8_f32(x[0], x[1], 0, false); w = __builtin_amdgcn_cvt_pk_fp8_f32(x[2], x[3], w, true); *(int*)((unsigned char*)XB + (size_t)row * DM + c) = w; }
            else { uint2 o; o.x = pk2(x[0], x[1]); o.y = pk2(x[2], x[3]); *(uint2*)(XB + (size_t)row * DM + c) = o; }
            asm volatile("" ::: "memory");
            if (ROUTE) { const LAS float* wr = wrl + c * 8;
#pragma unroll
                for (int q = 0; q < 4; ++q) { const f32x4 w0 = *(const LAS f32x4*)(wr + q * 8), w1 = *(const LAS f32x4*)(wr + q * 8 + 4);
                    lg[0] += x[q] * w0[0]; lg[1] += x[q] * w0[1]; lg[2] += x[q] * w0[2]; lg[3] += x[q] * w0[3]; lg[4] += x[q] * w1[0]; lg[5] += x[q] * w1[1]; lg[6] += x[q] * w1[2]; lg[7] += x[q] * w1[3]; }  asm volatile("" ::: "memory"); }
        }
        if (ROUTE) {
#pragma unroll
            for (int e = 0; e < 8; ++e) lg[e] = wave_sum(lg[e]) + A.in[19][e];
            int e0 = 0; float l0 = lg[0];
#pragma unroll
            for (int e = 1; e < 8; ++e) if (lg[e] > l0) { l0 = lg[e]; e0 = e; }
            int e1 = -1; float l1 = -3e38f;
#pragma unroll
            for (int e = 0; e < 8; ++e) if (e != e0 && lg[e] > l1) { l1 = lg[e]; e1 = e; }
            const float w0 = 1.0f / (1.0f + __expf(l1 - l0)), w1 = 1.0f - w0;
            if (lane == 0) {
                const unsigned p0 = __hip_atomic_fetch_add((unsigned*)(F.ctl + CW_MOECNT + 64 * e0), 1u, __ATOMIC_RELAXED, __HIP_MEMORY_SCOPE_AGENT);
                const unsigned p1 = __hip_atomic_fetch_add((unsigned*)(F.ctl + CW_MOECNT + 64 * e1), 1u, __ATOMIC_RELAXED, __HIP_MEMORY_SCOPE_AGENT);
                int* re = (int*)(A.ws + WS_ROUTE); int* rp = re + 2 * NTOK; float* rw = (float*)(rp + 2 * NTOK);
                re[2 * row] = e0; re[2 * row + 1] = e1; rp[2 * row] = (int)p0; rp[2 * row + 1] = (int)p1; rw[2 * row] = w0; rw[2 * row + 1] = w1;
            }
        }
    }
}

__device__ __forceinline__ void ln_route_phase(Frame& F, const Args& A, const bf16* Z, const float* gam, const float* bet, float* XF, bf16* XB) {
    const int gw = F.vcu * NWAVES + F.wave, NGW = F.G * NWAVES, lane = F.lane;
    LAS float* wrl = (LAS float*)(F.lds + RING_OFF);
    LAS float* rowb = (LAS float*)(F.lds + RING_OFF + 65536 + F.wave * 8192);
    for (int i = F.tid; i < DM * 8 / 4; i += 512) *(LAS f32x4*)(wrl + i * 4) = *(const f32x4*)(A.in[18] + i * 4);
    __syncthreads();
    for (int row = gw; row < NTOK; row += NGW) {
        float s = 0.f, s2 = 0.f;
#pragma unroll 1
        for (int j = 0; j < 8; ++j) { const uint2 z2 = *(const uint2*)(Z + (size_t)row * DM + 4 * lane + 256 * j); const f32x4 v = (f32x4){bflo(z2.x), bfhi(z2.x), bflo(z2.y), bfhi(z2.y)}; *(LAS f32x4*)(rowb + 4 * lane + 256 * j) = v;
            s += (v[0] + v[1]) + (v[2] + v[3]); }
        const float mean = wave_sum(s) * (1.f / DM);
#pragma unroll 1
        for (int j = 0; j < 8; ++j) { const f32x4 v = *(const LAS f32x4*)(rowb + 4 * lane + 256 * j) - mean; s2 += (v[0] * v[0] + v[1] * v[1]) + (v[2] * v[2] + v[3] * v[3]); }
        const float rstd = 1.f / sqrtf(wave_sum(s2) * (1.f / DM) + LN_EPS);
        float lg[8];
#pragma unroll
        for (int e = 0; e < 8; ++e) lg[e] = 0.f;
#pragma unroll 1
        for (int j = 0; j < 8; ++j) { const int c = 4 * lane + 256 * j; const f32x4 gg = *(const f32x4*)(gam + c), bb = *(const f32x4*)(bet + c);
            const f32x4 x = (*(const LAS f32x4*)(rowb + c) - mean) * rstd * gg + bb;
            *(f32x4*)(XF + (size_t)row * DM + c) = x;
            const LAS float* wr = wrl + c * 8;
#pragma unroll
            for (int q = 0; q < 4; ++q) { const f32x4 w0 = *(const LAS f32x4*)(wr + q * 8), w1 = *(const LAS f32x4*)(wr + q * 8 + 4);
                lg[0] += x[q] * w0[0]; lg[1] += x[q] * w0[1]; lg[2] += x[q] * w0[2]; lg[3] += x[q] * w0[3]; lg[4] += x[q] * w1[0]; lg[5] += x[q] * w1[1]; lg[6] += x[q] * w1[2]; lg[7] += x[q] * w1[3]; } }
#pragma unroll
        for (int e = 0; e < 8; ++e) lg[e] = wave_sum(lg[e]) + A.in[19][e];
        int e0 = 0; float l0 = lg[0];
#pragma unroll
        for (int e = 1; e < 8; ++e) if (lg[e] > l0) { l0 = lg[e]; e0 = e; }
        int e1 = -1; float l1 = -3e38f;
#pragma unroll
        for (int e = 0; e < 8; ++e) if (e != e0 && lg[e] > l1) { l1 = lg[e]; e1 = e; }
        const float w0 = 1.0f / (1.0f + __expf(l1 - l0)), w1 = 1.0f - w0;
        if (lane == 0) {
            const unsigned p0 = __hip_atomic_fetch_add((unsigned*)(F.ctl + CW_MOECNT + 64 * e0), 1u, __ATOMIC_RELAXED, __HIP_MEMORY_SCOPE_AGENT);
            const unsigned p1 = __hip_atomic_fetch_add((unsigned*)(F.ctl + CW_MOECNT + 64 * e1), 1u, __ATOMIC_RELAXED, __HIP_MEMORY_SCOPE_AGENT);
            int* re = (int*)(A.ws + WS_ROUTE); int* rp = re + 2 * NTOK; float* rw = (float*)(rp + 2 * NTOK);
            re[2 * row] = e0; re[2 * row + 1] = e1; rp[2 * row] = (int)p0; rp[2 * row + 1] = (int)p1; rw[2 * row] = w0; rw[2 * row + 1] = w1;
        }
        WSYNC();
    }
    __syncthreads();
}

__device__ __forceinline__ void p10_dsa_prep(Frame& F, const Args& A) {
    unsigned char* ws = A.ws; const int lane = F.lane;
    const int gw = F.vcu * NWAVES + F.wave, NGW = F.G * NWAVES;
    { const float* CR = (const float*)(ws + WS_CRAW); bf16* CN = (bf16*)(ws + WS_CN); const f32x4 gg = *(const f32x4*)(A.in[11] + 4 * lane);
      for (int row = gw; row < NTOK; row += NGW) { const f32x4 v = *(const f32x4*)(CR + (size_t)row * KVR + 4 * lane);
          const float ss = wave_sum(v[0] * v[0] + v[1] * v[1] + v[2] * v[2] + v[3] * v[3]); const float r = 1.f / sqrtf(ss * (1.f / KVR) + RMS_EPS);
          uint2 o; o.x = pk2(v[0] * r * gg[0], v[1] * r * gg[1]); o.y = pk2(v[2] * r * gg[2], v[3] * r * gg[3]); *(uint2*)(CN + (size_t)row * KVR + 4 * lane) = o;
          if (lane < 16) { const f32x4 kv = *(const f32x4*)((const float*)(ws + WS_KIWI) + (size_t)row * 128 + 4 * lane); uint2 k2; k2.x = pk2(kv[0], kv[1]); k2.y = pk2(kv[2], kv[3]); *(uint2*)((bf16*)(ws + WS_KIB) + (size_t)row * 64 + 4 * lane) = k2; } } }
    const bf16* Q = (const bf16*)(ws + WS_Q); const bf16* UKT = (const bf16*)(ws + WS_W_UK); bf16* QL = (bf16*)(ws + WS_QLAT);
    const int r16 = lane & 15, kq = lane >> 4; const float sc = 0.08838834764831845f;
    for (int it = gw; it < 512 * 16 * 4; it += NGW) {
        const int nc = it & 3, h = (it >> 2) & 15, mt = it >> 6;
        f32x4 acc[2][4];
#pragma unroll
        for (int m = 0; m < 2; ++m)
#pragma unroll
            for (int n = 0; n < 4; ++n) acc[m][n] = (f32x4){0.f, 0.f, 0.f, 0.f};
#pragma unroll
        for (int ks = 0; ks < 4; ++ks) { s8v af[2], bfr[4];
#pragma unroll
            for (int m = 0; m < 2; ++m) af[m] = ld_frag(Q + (size_t)(mt * 32 + m * 16 + r16) * DM + h * 128 + ks * 32 + kq * 8);
#pragma unroll
            for (int n = 0; n < 4; ++n) bfr[n] = ld_frag(UKT + ((size_t)h * 256 + nc * 64 + n * 16 + r16) * 128 + ks * 32 + kq * 8);
#pragma unroll
            for (int m = 0; m < 2; ++m)
#pragma unroll
                for (int n = 0; n < 4; ++n) acc[m][n] = __builtin_amdgcn_mfma_f32_16x16x32_bf16(bfr[n], af[m], acc[m][n], 0, 0, 0); }
#pragma unroll
        for (int m = 0; m < 2; ++m)
#pragma unroll
            for (int n = 0; n < 4; ++n) { uint2 o; o.x = pg8::cvt_pk_bf16(acc[m][n][0] * sc, acc[m][n][1] * sc); o.y = pg8::cvt_pk_bf16(acc[m][n][2] * sc, acc[m][n][3] * sc);
                *(uint2*)(QL + (size_t)(mt * 32 + m * 16 + r16) * 4096 + h * 256 + nc * 64 + n * 16 + kq * 4) = o; }
    }
}
__device__ __forceinline__ void p12_dsa_uv(Frame& F, const Args& A) {
    unsigned char* ws = A.ws; const int lane = F.lane;
    const int gw = F.vcu * NWAVES + F.wave, NGW = F.G * NWAVES;
    const bf16* OL = (const bf16*)(ws + WS_OLAT); const bf16* UVT = (const bf16*)(ws + WS_W_UV); bf16* O = (bf16*)(ws + WS_OATT1);
    const int r16 = lane & 15, kq = lane >> 4;
    for (int it = gw; it < 512 * 16 * 2; it += NGW) {
        const int nc = it & 1, h = (it >> 1) & 15, mt = it >> 5;
        f32x4 acc[2][4];
#pragma unroll
        for (int m = 0; m < 2; ++m)
#pragma unroll
            for (int n = 0; n < 4; ++n) acc[m][n] = (f32x4){0.f, 0.f, 0.f, 0.f};
#pragma unroll
        for (int ks = 0; ks < 8; ++ks) { s8v af[2], bfr[4];
#pragma unroll
            for (int m = 0; m < 2; ++m) af[m] = ld_frag(OL + (size_t)(mt * 32 + m * 16 + r16) * 4096 + h * 256 + ks * 32 + kq * 8);
#pragma unroll
            for (int n = 0; n < 4; ++n) bfr[n] = ld_frag(UVT + ((size_t)h * 128 + nc * 64 + n * 16 + r16) * 256 + ks * 32 + kq * 8);
#pragma unroll
            for (int m = 0; m < 2; ++m)
#pragma unroll
                for (int n = 0; n < 4; ++n) acc[m][n] = __builtin_amdgcn_mfma_f32_16x16x32_bf16(bfr[n], af[m], acc[m][n], 0, 0, 0); }
#pragma unroll
        for (int m = 0; m < 2; ++m)
#pragma unroll
            for (int n = 0; n < 4; ++n) { uint2 o; o.x = pg8::cvt_pk_bf16(acc[m][n][0], acc[m][n][1]); o.y = pg8::cvt_pk_bf16(acc[m][n][2], acc[m][n][3]);
                *(uint2*)(O + (size_t)(mt * 32 + m * 16 + r16) * DM + h * 128 + nc * 64 + n * 16 + kq * 4) = o; }
    }
}

__device__ __forceinline__ unsigned f2key(float f) { const unsigned u = __float_as_uint(f); return (u & 0x80000000u) ? ~u : (u | 0x80000000u); }

__device__ __forceinline__ unsigned dsa_off_b(unsigned row, unsigned ch) { return 256u * row + 16u * (ch ^ (((row & 3) << 2) | ((row >> 2) & 3))); }

__device__ __forceinline__ float key2f(unsigned k) { return __uint_as_float((k & 0x80000000u) ? (k & 0x7fffffffu) : ~k); }
__device__ __forceinline__ void p13a_dsa_index(Frame& F, const Args& A) {
    unsigned char* ws = A.ws; const int lane = F.lane, wid = F.wave, r32 = lane & 31, hi = lane >> 5;
    const bf16* QI = (const bf16*)(ws + WS_QI); const bf16* KIB = (const bf16*)(ws + WS_KIB); const float* KIWI = (const float*)(ws + WS_KIWI); int* IDX = (int*)(ws + WS_IDX);
    LAS float* sc = (LAS float*)(F.lds + RING_OFF);
    LAS unsigned* hist = (LAS unsigned*)(F.lds + DSA_SCR);
    LAS unsigned* cntG = hist + 1024;
    LAS unsigned* cntE = cntG + 512;
    LAS unsigned* qm = cntE + 512;
    LAS float* mmx = (LAS float*)(qm + 64);
    LAS unsigned* candk = (LAS unsigned*)(mmx + 64);
    constexpr int CAP = 256;
    const int q = wid >> 1, sub = wid & 1, th = sub * 64 + lane;
    for (int slot = F.vcu; slot < NTOK / 4; slot += F.G) {
        const int rowi = slot >> 8; int cc = slot & 255; if (rowi & 1) cc = 255 - cc;
        const int tok0 = (rowi * 256 + cc) * 4, b = tok0 >> 13, t0 = tok0 & (SEQ - 1), tmax = t0 + 3;
        bf16x8 qa[4];
#pragma unroll
        for (int s = 0; s < 4; ++s) qa[s] = *(const bf16x8*)(QI + (size_t)(tok0 + (r32 >> 3)) * 512 + (r32 & 7) * 64 + 16 * s + 8 * hi);
        float wv[16];
#pragma unroll
        for (int r = 0; r < 16; ++r) wv[r] = KIWI[(size_t)(tok0 + (r >> 2)) * 128 + 64 + (r & 3) + 4 * hi] * 0.35355339059327373f;
        const int ntiles = (tmax >> 5) + 1;
        hist[q * 256 + th] = 0u; hist[q * 256 + 128 + th] = 0u; if (th == 0) qm[q * 16 + 2] = 0u;
        float mn0 = 3e38f, mx0 = -3e38f, mn1 = 3e38f, mx1 = -3e38f;
        {
            bf16x8 kb[4], kn[4]; int tile = wid;
#pragma unroll
            for (int s = 0; s < 4; ++s) { kb[s] = (bf16x8){0, 0, 0, 0, 0, 0, 0, 0}; kn[s] = kb[s]; }
            if (tile < ntiles) { const bf16* kp = KIB + (size_t)(b * SEQ + tile * 32 + r32) * 64 + 8 * hi;
#pragma unroll
                for (int s = 0; s < 4; ++s) kb[s] = *(const bf16x8*)(kp + 16 * s); }
            while (tile < ntiles) {
                const int tn = tile + 8;
                if (tn < ntiles) { const bf16* kp = KIB + (size_t)(b * SEQ + tn * 32 + r32) * 64 + 8 * hi;
#pragma unroll
                    for (int s = 0; s < 4; ++s) kn[s] = *(const bf16x8*)(kp + 16 * s); }
                const int key = tile * 32 + r32;
                fa::f32x16 acc;
#pragma unroll
                for (int r = 0; r < 16; ++r) acc[r] = 0.f;
#pragma unroll
                for (int s = 0; s < 4; ++s) acc = __builtin_amdgcn_mfma_f32_32x32x16_bf16(qa[s], kb[s], acc, 0, 0, 0);
                float tot[4];
#pragma unroll
                for (int qq = 0; qq < 4; ++qq) { float part = 0.f;
#pragma unroll
                    for (int r3 = 0; r3 < 4; ++r3) part += wv[4 * qq + r3] * fmaxf(acc[4 * qq + r3], 0.f);
                    tot[qq] = sum_xor32(part) + 0.0f; }
                const float ta = hi ? tot[2] : tot[0], tb = hi ? tot[3] : tot[1];
                sc[(2 * hi) * 8192 + key] = ta; sc[(2 * hi + 1) * 8192 + key] = tb;
                if (key <= t0 + 2 * hi) { mn0 = fminf(mn0, ta); mx0 = fmaxf(mx0, ta); }
                if (key <= t0 + 2 * hi + 1) { mn1 = fminf(mn1, tb); mx1 = fmaxf(mx1, tb); }
#pragma unroll
                for (int s = 0; s < 4; ++s) kb[s] = kn[s];
                tile = tn;
            }
        }
#pragma unroll
        for (int o = 1; o < 32; o <<= 1) { mn0 = fminf(mn0, __shfl_xor(mn0, o)); mx0 = fmaxf(mx0, __shfl_xor(mx0, o)); mn1 = fminf(mn1, __shfl_xor(mn1, o)); mx1 = fmaxf(mx1, __shfl_xor(mx1, o)); }
        if (r32 == 0) { mmx[(wid * 4 + 2 * hi) * 2] = mn0; mmx[(wid * 4 + 2 * hi) * 2 + 1] = mx0; mmx[(wid * 4 + 2 * hi + 1) * 2] = mn1; mmx[(wid * 4 + 2 * hi + 1) * 2 + 1] = mx1; }
        __syncthreads();
        const int tok = tok0 + q, n = t0 + q + 1;
        if (tmax + 1 <= TOPK) {
            for (int i = th; i < TOPK; i += 128) IDX[(size_t)tok * TOPK + i] = (i < n) ? i : 0;
        } else {
            const LAS float* scq = sc + q * 8192; const int nsl = (n + 127) >> 7;
            float fmn = 3e38f, fmx = -3e38f;
#pragma unroll
            for (int w = 0; w < 8; ++w) { fmn = fminf(fmn, mmx[(w * 4 + q) * 2]); fmx = fmaxf(fmx, mmx[(w * 4 + q) * 2 + 1]); }
            const float bsc = (fmx > fmn) ? 255.99f / (fmx - fmn) : 0.f;
            for (int s0 = 0; s0 < nsl; s0 += 8) { float v[8];
#pragma unroll
                for (int j = 0; j < 8; ++j) { const int i = (s0 + j) * 128 + th; v[j] = scq[min(i, n - 1)]; }
#pragma unroll
                for (int j = 0; j < 8; ++j) { const int i = (s0 + j) * 128 + th; const int bin = min(max((int)((v[j] - fmn) * bsc), 0), 255);
                    LAS unsigned* tgt = (i < n) ? &hist[q * 256 + bin] : &qm[q * 16 + 8];
                    __hip_atomic_fetch_add(tgt, 1u, __ATOMIC_RELAXED, __HIP_MEMORY_SCOPE_WORKGROUP); } }
            __syncthreads();
            if (sub == 0) {
                const v4u c4 = *(const LAS v4u*)(hist + q * 256 + 4 * lane); const unsigned s4 = c4.x + c4.y + c4.z + c4.w; unsigned S = s4;
#pragma unroll
                for (int o = 1; o < 64; o <<= 1) { const unsigned v = __shfl_down(S, o); if (lane + o < 64) S += v; }
                const unsigned above = S - s4;
                if (above < (unsigned)TOPK && (unsigned)TOPK <= S) { unsigned cum = above; int bin;
                    if (cum + c4.w >= (unsigned)TOPK) bin = 3; else { cum += c4.w; if (cum + c4.z >= (unsigned)TOPK) bin = 2; else { cum += c4.z; if (cum + c4.y >= (unsigned)TOPK) bin = 1; else { cum += c4.y; bin = 0; } } }
                    qm[q * 16 + 0] = (unsigned)(4 * lane + bin); qm[q * 16 + 1] = (unsigned)TOPK - cum; }
            }
            __syncthreads();
            const int bstar = (int)qm[q * 16 + 0]; const unsigned need1 = qm[q * 16 + 1];
            for (int s0 = 0; s0 < nsl; s0 += 8) { float v[8];
#pragma unroll
                for (int j = 0; j < 8; ++j) { const int i = (s0 + j) * 128 + th; v[j] = scq[min(i, n - 1)]; }
#pragma unroll
                for (int j = 0; j < 8; ++j) { const int i = (s0 + j) * 128 + th; const int bin = min(max((int)((v[j] - fmn) * bsc), 0), 255);
                    if (i < n && bin == bstar) { const unsigned pc = __hip_atomic_fetch_add(&qm[q * 16 + 2], 1u, __ATOMIC_RELAXED, __HIP_MEMORY_SCOPE_WORKGROUP); if (pc < (unsigned)CAP) candk[q * CAP + pc] = f2key(v[j]); } } }
            __syncthreads();
            if (sub == 0) {
                const unsigned mc = qm[q * 16 + 2]; unsigned T = 0u, nt = 0u; bool found = false;
                if (mc <= (unsigned)CAP) {
                    unsigned kc[4], gt[4], ge[4];
#pragma unroll
                    for (int c = 0; c < 4; ++c) { kc[c] = (lane + 64 * c < (int)mc) ? candk[q * CAP + lane + 64 * c] : 0u; gt[c] = 0u; ge[c] = 0u; }
                    for (unsigned j = 0; j < mc; ++j) { const unsigned kj = candk[q * CAP + j];
#pragma unroll
                        for (int c = 0; c < 4; ++c) { gt[c] += (kj > kc[c]) ? 1u : 0u; ge[c] += (kj >= kc[c]) ? 1u : 0u; } }
#pragma unroll
                    for (int c = 0; c < 4; ++c) if (lane + 64 * c < (int)mc && gt[c] < need1 && need1 <= ge[c]) { T = kc[c]; nt = need1 - gt[c]; found = true; }
                } else {
                    unsigned lo = 0u;
                    for (int bit = 31; bit >= 0; --bit) { const unsigned cand = lo | (1u << bit); unsigned c = 0u;
                        for (int i = lane; i < n; i += 64) c += (f2key(scq[i]) >= cand) ? 1u : 0u;
#pragma unroll
                        for (int o = 1; o < 64; o <<= 1) c += __shfl_xor(c, o);
                        if (c >= (unsigned)TOPK) lo = cand; }
                    unsigned cg = 0u;
                    for (int i = lane; i < n; i += 64) cg += (f2key(scq[i]) > lo) ? 1u : 0u;
#pragma unroll
                    for (int o = 1; o < 64; o <<= 1) cg += __shfl_xor(cg, o);
                    T = lo; nt = (unsigned)TOPK - cg; found = (lane == 0);
                }
                if (found) { qm[q * 16 + 0] = T; qm[q * 16 + 1] = nt; }
            }
            __syncthreads();
            const unsigned T = qm[q * 16 + 0], need = qm[q * 16 + 1];
            unsigned Gs = 0u, Es = 0u;
            for (int s0 = 0; s0 < nsl; s0 += 8) { float v[8];
#pragma unroll
                for (int j = 0; j < 8; ++j) { const int i = (s0 + j) * 128 + th; v[j] = scq[min(i, n - 1)]; }
#pragma unroll
                for (int j = 0; j < 8; ++j) { const int i = (s0 + j) * 128 + th; const bool ok = i < n; const unsigned k = f2key(v[j]);
                    Gs += (unsigned)__popcll(__ballot(ok && k > T)); Es += (unsigned)__popcll(__ballot(ok && k == T)); } }
            if (lane == 0) { qm[q * 16 + 10 + sub * 2] = Gs; qm[q * 16 + 11 + sub * 2] = Es; }
            __syncthreads();
            const unsigned G0 = qm[q * 16 + 10], E0 = qm[q * 16 + 11], E1 = qm[q * 16 + 13];
            bool slow = false;
#pragma unroll
            for (int qx = 0; qx < 4; ++qx) slow = slow || (qm[qx * 16 + 11] + qm[qx * 16 + 13] != qm[qx * 16 + 1]);
            (void)E1;
            if (!slow) {
                unsigned run = sub ? (G0 + E0) : 0u;
                for (int s0 = 0; s0 < nsl; s0 += 8) { float v[8];
#pragma unroll
                    for (int j = 0; j < 8; ++j) { const int i = (s0 + j) * 128 + th; v[j] = scq[min(i, n - 1)]; }
#pragma unroll
                    for (int j = 0; j < 8; ++j) { const int i = (s0 + j) * 128 + th; const bool sel = (i < n) && f2key(v[j]) >= T; const unsigned long long bs = __ballot(sel);
                        const unsigned pos = run + __builtin_amdgcn_mbcnt_hi((unsigned)(bs >> 32), __builtin_amdgcn_mbcnt_lo((unsigned)bs, 0u));
                        if (sel && pos < (unsigned)TOPK) candk[q * CAP + pos] = (unsigned)i; run += (unsigned)__popcll(bs); } }
            } else {
            unsigned myG = 0u, myE = 0u;
            for (int s0 = 0; s0 < nsl; s0 += 8) { float v[8];
#pragma unroll
                for (int j = 0; j < 8; ++j) { const int i = (s0 + j) * 128 + th; v[j] = scq[min(i, n - 1)]; }
#pragma unroll
                for (int j = 0; j < 8; ++j) { const int s2 = s0 + j, i = s2 * 128 + th; const bool ok = i < n; const unsigned k = f2key(v[j]); const unsigned long long bg = __ballot(ok && k > T), be = __ballot(ok && k == T);
                    const unsigned cg = (unsigned)__popcll(bg), ce = (unsigned)__popcll(be); myG = (lane == s2) ? cg : myG; myE = (lane == s2) ? ce : myE; } }
            cntG[(q * 2 + sub) * 64 + lane] = myG; cntE[(q * 2 + sub) * 64 + lane] = myE;
            __syncthreads();
            unsigned tbase, pbase;
            { const unsigned e0 = cntE[(q * 2) * 64 + lane], e1 = cntE[(q * 2 + 1) * 64 + lane], g0 = cntG[(q * 2) * 64 + lane], g1 = cntG[(q * 2 + 1) * 64 + lane];
              unsigned inc = e0 + e1;
#pragma unroll
              for (int o = 1; o < 64; o <<= 1) { const unsigned v = __shfl_up(inc, o); if (lane >= o) inc += v; }
              const unsigned tb0 = inc - (e0 + e1), tb1 = tb0 + e0;
              const unsigned se0 = (need > tb0) ? min(need - tb0, e0) : 0u, se1 = (need > tb1) ? min(need - tb1, e1) : 0u;
              const unsigned c0 = g0 + se0, c1 = g1 + se1; unsigned inc2 = c0 + c1;
#pragma unroll
              for (int o = 1; o < 64; o <<= 1) { const unsigned v = __shfl_up(inc2, o); if (lane >= o) inc2 += v; }
              const unsigned pb0 = inc2 - (c0 + c1);
              tbase = sub ? tb1 : tb0; pbase = sub ? pb0 + c0 : pb0; }
            for (int s0 = 0; s0 < nsl; s0 += 8) { float v[8];
#pragma unroll
                for (int j = 0; j < 8; ++j) { const int i = (s0 + j) * 128 + th; v[j] = scq[min(i, n - 1)]; }
#pragma unroll
                for (int j = 0; j < 8; ++j) { const int s2 = s0 + j; if (s2 < nsl) { const int i = s2 * 128 + th; const bool ok = i < n; const unsigned k = f2key(v[j]); const bool g = ok && k > T, e = ok && k == T;
                    const unsigned long long be = __ballot(e);
                    const unsigned trank = (unsigned)__builtin_amdgcn_readlane((int)tbase, s2) + __builtin_amdgcn_mbcnt_hi((unsigned)(be >> 32), __builtin_amdgcn_mbcnt_lo((unsigned)be, 0u));
                    const bool sel = g || (e && trank < need);
                    const unsigned long long bs = __ballot(sel);
                    const unsigned pos = (unsigned)__builtin_amdgcn_readlane((int)pbase, s2) + __builtin_amdgcn_mbcnt_hi((unsigned)(bs >> 32), __builtin_amdgcn_mbcnt_lo((unsigned)bs, 0u));
                    if (sel && pos < (unsigned)TOPK) candk[q * CAP + pos] = (unsigned)i; } } }
            }
        }
        __syncthreads();
        if (tmax + 1 > TOPK) { for (int i = th; i < TOPK; i += 128) IDX[(size_t)tok * TOPK + i] = (int)candk[q * CAP + i]; }
    }
}

__device__ __forceinline__ void p13b_dsa_attn(Frame& F, const Args& A) {
    unsigned char* ws = A.ws; const int lane = F.lane, wid = F.wave, c16 = lane & 15, g4 = lane >> 4;
    const bf16* CN = (const bf16*)(ws + WS_CN); const bf16* QL = (const bf16*)(ws + WS_QLAT); const int* IDX = (const int*)(ws + WS_IDX); bf16* OL = (bf16*)(ws + WS_OLAT);
    LAS float* lut = (LAS float*)(F.lds + DSA_SCR + 8192);
    for (int i = F.tid; i < 144 * 16; i += 512) { const int n = i >> 4, h = i & 15; lut[i] = A.in[1][rel_bucket(n) * 16 + h]; }
    __syncthreads();
    LAS char* img = (LAS char*)(F.lds + RING_OFF + wid * 16384);
    LAS int* idxw = (LAS int*)(F.lds + DSA_SCR + wid * 1024);
    const unsigned imgb = (unsigned)(uintptr_t)img;
    const int gw = F.vcu * NWAVES + wid, NGW = F.G * NWAVES;
    const unsigned prow0 = 8u * ((lane >> 2) & 3) + (lane & 3);
    unsigned ta0[8], ta1[8];
    { const unsigned qq = (lane & 15) >> 2, pp = lane & 3;
#pragma unroll
      for (int c = 0; c < 8; ++c) { ta0[c] = imgb + dsa_off_b(8 * g4 + qq, 2 * c + (pp >> 1)) + 8 * (pp & 1); ta1[c] = imgb + dsa_off_b(8 * g4 + 4 + qq, 2 * c + (pp >> 1)) + 8 * (pp & 1); } }
    for (int tok = gw; tok < NTOK; tok += NGW) {
        const int b = tok >> 13, t = tok & (SEQ - 1), cnt = min(TOPK, t + 1), ntile = (cnt + 31) >> 5;
        bf16x8 qb[8];
#pragma unroll
        for (int ks = 0; ks < 8; ++ks) qb[ks] = *(const bf16x8*)(QL + (size_t)tok * 4096 + c16 * 256 + ks * 32 + g4 * 8);
#pragma unroll
        for (int i = 0; i < 4; ++i) idxw[lane + 64 * i] = IDX[(size_t)tok * TOPK + lane + 64 * i];
        WSYNC();
        f32x4 o[16];
#pragma unroll
        for (int ct = 0; ct < 16; ++ct) o[ct] = (f32x4){0.f, 0.f, 0.f, 0.f};
        float m_run = -1e30f, l_run = 0.f;
        const LAS float* lutcol = lut + c16;
#pragma unroll 1
        for (int tile = 0; tile < ntile; ++tile) {
            { v4u st[16];
#pragma unroll
              for (int i = 0; i < 16; ++i) { const int nn = lane + 64 * i, row = nn >> 5, chg = nn & 31; const int key = idxw[tile * 32 + row];
                  st[i] = *(const v4u*)(CN + (size_t)(b * SEQ + key) * KVR + chg * 8); }
#pragma unroll
              for (int i = 0; i < 16; ++i) { const int nn = lane + 64 * i, row = nn >> 5, chg = nn & 31;
                  *(LAS v4u*)(img + (chg >> 4) * 8192 + dsa_off_b(row, chg & 15)) = st[i]; } }
            WSYNC();
            f32x4 sacc[2];
#pragma unroll
            for (int T = 0; T < 2; ++T) { sacc[T] = (f32x4){0.f, 0.f, 0.f, 0.f};
#pragma unroll
                for (int ks = 0; ks < 8; ++ks) { const bf16x8 a = *(const LAS bf16x8*)(img + (ks >> 2) * 8192 + dsa_off_b(prow0 + 4 * T, 4 * (ks & 3) + g4));
                    sacc[T] = __builtin_amdgcn_mfma_f32_16x16x32_bf16(a, qb[ks], sacc[T], 0, 0, 0); } }
            float pmax = -__builtin_inff();
#pragma unroll
            for (int T = 0; T < 2; ++T) { const int i0 = tile * 32 + 8 * g4 + 4 * T; const v4u kk = *(const LAS v4u*)(idxw + i0);
                const int kidx[4] = {(int)kk.x, (int)kk.y, (int)kk.z, (int)kk.w};
#pragma unroll
                for (int e = 0; e < 4; ++e) { const int dist = min(max(t - kidx[e], 0), 128); float s = sacc[T][e] + lutcol[dist * 16];
                    s = (i0 + e < cnt) ? s : -__builtin_inff(); sacc[T][e] = s; pmax = fmaxf(pmax, s); } }
            pmax = max_xor16(pmax); pmax = max_xor32(pmax);
            const float mn = fmaxf(m_run, pmax), alpha = __builtin_amdgcn_exp2f((m_run - mn) * fa::C2); m_run = mn;
            float ps = 0.f;
#pragma unroll
            for (int T = 0; T < 2; ++T)
#pragma unroll
                for (int e = 0; e < 4; ++e) { const float pv = __builtin_amdgcn_exp2f((sacc[T][e] - mn) * fa::C2); sacc[T][e] = pv; ps += pv; }
            ps = sum_xor16(ps); ps = sum_xor32(ps);
            l_run = l_run * alpha + ps;
            if (__any(alpha < 1.f)) {
                float al[4];
#pragma unroll
                for (int e = 0; e < 4; ++e) al[e] = __shfl(alpha, 4 * g4 + e);
#pragma unroll
                for (int ct = 0; ct < 16; ++ct)
#pragma unroll
                    for (int e = 0; e < 4; ++e) o[ct][e] *= al[e];
            }
            fa::u32x4v pw; pw.x = fa::cvtpk(sacc[0][0], sacc[0][1]); pw.y = fa::cvtpk(sacc[0][2], sacc[0][3]); pw.z = fa::cvtpk(sacc[1][0], sacc[1][1]); pw.w = fa::cvtpk(sacc[1][2], sacc[1][3]);
            const bf16x8 pa = *reinterpret_cast<bf16x8*>(&pw);
#pragma unroll
            for (int cg = 0; cg < 4; ++cg) { fa::s16x4 b0[4], b1[4];
                asm volatile("ds_read_b64_tr_b16 %0, %8 offset:%c16\n\tds_read_b64_tr_b16 %1, %9 offset:%c16\n\tds_read_b64_tr_b16 %2, %10 offset:%c16\n\tds_read_b64_tr_b16 %3, %11 offset:%c16\n\t"
                             "ds_read_b64_tr_b16 %4, %12 offset:%c16\n\tds_read_b64_tr_b16 %5, %13 offset:%c16\n\tds_read_b64_tr_b16 %6, %14 offset:%c16\n\tds_read_b64_tr_b16 %7, %15 offset:%c16\n\ts_waitcnt lgkmcnt(0)"
                             : "=&v"(b0[0]), "=&v"(b1[0]), "=&v"(b0[1]), "=&v"(b1[1]), "=&v"(b0[2]), "=&v"(b1[2]), "=&v"(b0[3]), "=&v"(b1[3])
                             : "v"(ta0[(cg & 1) * 4 + 0]), "v"(ta1[(cg & 1) * 4 + 0]), "v"(ta0[(cg & 1) * 4 + 1]), "v"(ta1[(cg & 1) * 4 + 1]), "v"(ta0[(cg & 1) * 4 + 2]), "v"(ta1[(cg & 1) * 4 + 2]), "v"(ta0[(cg & 1) * 4 + 3]), "v"(ta1[(cg & 1) * 4 + 3]), "i"((cg >> 1) * 8192) : "memory");
                FA_SBAR();
#pragma unroll
                for (int k = 0; k < 4; ++k) o[cg * 4 + k] = __builtin_amdgcn_mfma_f32_16x16x32_bf16(pa, (bf16x8){b0[k][0], b0[k][1], b0[k][2], b0[k][3], b1[k][0], b1[k][1], b1[k][2], b1[k][3]}, o[cg * 4 + k], 0, 0, 0); }
            WSYNC();
        }
        { const float il = (l_run > 0.f) ? 1.0f / l_run : 0.f; float ile[4];
#pragma unroll
          for (int e = 0; e < 4; ++e) ile[e] = __shfl(il, 4 * g4 + e);
#pragma unroll
          for (int ct = 0; ct < 16; ++ct)
#pragma unroll
              for (int e = 0; e < 4; ++e) { const float v = o[ct][e] * ile[e]; const float vn = dpp_xor1(v);
                  if ((lane & 1) == 0) *(unsigned*)(OL + (size_t)tok * 4096 + (4 * g4 + e) * 256 + ct * 16 + c16) = fa::cvtpk(v, vn); } }
        WSYNC();
    }
    __syncthreads();
}

struct MoeTiles { int tend[8]; int pstart[8]; int MT; };
__device__ __forceinline__ void moe_tiles(Frame& F, MoeTiles& T) {
    int acc = 0;
#pragma unroll
    for (int e = 0; e < 8; ++e) { const int c = (int)__builtin_amdgcn_readfirstlane(__hip_atomic_load((unsigned*)(F.ctl + CW_MOECNT + 64 * e), __ATOMIC_RELAXED, __HIP_MEMORY_SCOPE_AGENT));
        T.pstart[e] = acc * 256; acc += (c + 255) >> 8; T.tend[e] = acc; }
    T.MT = acc;
}
__device__ __forceinline__ void p15_gather(Frame& F, const Args& A) {
    MoeTiles T; moe_tiles(F, T);
    const int gw = F.vcu * NWAVES + F.wave, NGW = F.G * NWAVES, lane = F.lane;
    const float* XF = (const float*)(A.ws + WS_XF); unsigned char* XG = (unsigned char*)(A.ws + WS_XG);
    const int* re = (const int*)(A.ws + WS_ROUTE); const int* rp = re + 2 * NTOK;
    for (int tok = gw; tok < NTOK; tok += NGW) {
        v4u v[2];
#pragma unroll
        for (int j = 0; j < 2; ++j) { const float* src = XF + (size_t)tok * DM + 16 * lane + 1024 * j; int w[4];
#pragma unroll
            for (int q = 0; q < 4; ++q) { const f32x4 x = *(const f32x4*)(src + 4 * q); w[q] = __builtin_amdgcn_cvt_pk_fp8_f32(x[0], x[1], 0, false); w[q] = __builtin_amdgcn_cvt_pk_fp8_f32(x[2], x[3], w[q], true); }
            v[j].x = (unsigned)w[0]; v[j].y = (unsigned)w[1]; v[j].z = (unsigned)w[2]; v[j].w = (unsigned)w[3]; }
#pragma unroll
        for (int s = 0; s < 2; ++s) { const int e = re[2 * tok + s], p = rp[2 * tok + s]; int ps = 0;
#pragma unroll
            for (int q = 0; q < 8; ++q) ps = (q == e) ? T.pstart[q] : ps;
            unsigned char* dst = XG + (size_t)(ps + p) * DM + 16 * lane;
#pragma unroll
            for (int j = 0; j < 2; ++j) *(v4u*)(dst + 1024 * j) = v[j]; }
    }
}
__device__ __forceinline__ void p18_final(Frame& F, const Args& A) {
    MoeTiles T; moe_tiles(F, T);
    const int gw = F.vcu * NWAVES + F.wave, NGW = F.G * NWAVES, lane = F.lane;
    const float* XF = (const float*)(A.ws + WS_XF); const bf16* Y = (const bf16*)(A.ws + WS_Y);
    const int* re = (const int*)(A.ws + WS_ROUTE); const int* rp = re + 2 * NTOK; const float* rw = (const float*)(rp + 2 * NTOK);
    const float* gam = A.in[25] + DM; const float* bet = A.in[26] + DM;
    for (int tok = gw; tok < NTOK; tok += NGW) {
        int rows[2]; float w[2];
#pragma unroll
        for (int s = 0; s < 2; ++s) { const int e = re[2 * tok + s]; int ps = 0;
#pragma unroll
            for (int q = 0; q < 8; ++q) ps = (q == e) ? T.pstart[q] : ps;
            rows[s] = ps + rp[2 * tok + s]; w[s] = rw[2 * tok + s]; }
        const f32x4* xr = (const f32x4*)(XF + (size_t)tok * DM) + lane; const uint2* y0 = (const uint2*)(Y + (size_t)rows[0] * DM) + lane; const uint2* y1 = (const uint2*)(Y + (size_t)rows[1] * DM) + lane;
        f32x4 v[8]; float s = 0.f;
#pragma unroll
        for (int j = 0; j < 8; ++j) { const uint2 a = y0[64 * j], bq = y1[64 * j]; const f32x4 ya = (f32x4){bflo(a.x), bfhi(a.x), bflo(a.y), bfhi(a.y)}, yb = (f32x4){bflo(bq.x), bfhi(bq.x), bflo(bq.y), bfhi(bq.y)};
            v[j] = xr[64 * j] * ALPHA + ya * w[0] + yb * w[1]; s += (v[j][0] + v[j][1]) + (v[j][2] + v[j][3]); }
        const float mean = wave_sum(s) * (1.f / DM); float s2 = 0.f;
#pragma unroll
        for (int j = 0; j < 8; ++j) { v[j] = v[j] - mean; s2 += (v[j][0] * v[j][0] + v[j][1] * v[j][1]) + (v[j][2] * v[j][2] + v[j][3] * v[j][3]); }
        const float rstd = 1.f / sqrtf(wave_sum(s2) * (1.f / DM) + LN_EPS);
#pragma unroll
        for (int j = 0; j < 8; ++j) { const int c = 4 * lane + 256 * j; const f32x4 gg = *(const f32x4*)(gam + c), bb = *(const f32x4*)(bet + c);
            *(f32x4*)(A.out + (size_t)tok * DM + c) = v[j] * rstd * gg + bb; }
    }
}

__global__ void __launch_bounds__(NWAVES * 64, 2) mega_fwd(Args args) {
    extern __shared__ __attribute__((aligned(16))) unsigned char lds[];
    Frame F;
    F.lds = (LAS unsigned char*)lds;
    F.MISC = (volatile LAS unsigned*)(F.lds + MISC_OFF);
    F.tid = threadIdx.x; F.lane = F.tid & 63; F.wave = __builtin_amdgcn_readfirstlane(F.tid >> 6);
    F.G = gridDim.x; { const int bx = blockIdx.x; F.vcu = (F.G % 8 == 0) ? (bx % 8) * (F.G / 8) + bx / 8 : bx; }
    unsigned char* ws = args.ws;
    F.ctl = (gu32*)(ws + WS_CTL);
    for (int u = F.tid; u < (LDS_BYTES - LDSCTL_OFF) / 4; u += NWAVES * 64) ((LAS unsigned*)(F.lds + LDSCTL_OFF))[u] = 0u;
    __syncthreads();
    XcdBarrier bar; bar.bar = (unsigned*)(F.ctl + CW_BAR); bar.x = 0; bar.st = nullptr;
#if !MK_PER_PHASE
    bar = xcd_barrier_post((unsigned*)(F.ctl + CW_BAR), F.MISC + 8);
#define GRID_BAR() xcd_barrier(bar)
#else
#define GRID_BAR() do { } while (0)
#endif
    const int lo = args.ph_lo, hi = args.ph_hi;
#ifndef PH_MASK
#define PH_MASK 0x3fffff
#endif
#define IN(k) (((PH_MASK >> (k)) & 1) && lo <= (k) && (k) < hi)
#define BOTH(k) (IN(k) && IN((k) + 1))
    bf16* XB = (bf16*)(ws + WS_XB); float* XF = (float*)(ws + WS_XF); bf16* Z = (bf16*)(ws + WS_Z);

#ifndef PROBE_MASK
#define PROBE_MASK 0
#endif
#define REPS(k) ((((PROBE_MASK) >> (k)) & 1) ? 2 : 1)
    if (IN(0)) for (int rep_ = 0; rep_ < REPS(0); ++rep_) { relaunder(F); p0_prologue(F, args); if (BOTH(0) || rep_ + 1 < REPS(0)) GRID_BAR(); }
    if (IN(1)) for (int rep_ = 0; rep_ < REPS(1); ++rep_) { relaunder(F);
        pg8::Gemm g{XB, (const bf16*)(ws + WS_W_NSA_IN), NTOK, NSA_NPAD, DM}; pg8::StaticOrder S; S.init(NTOK, NSA_NPAD, F.G, (int)blockIdx.x);
        pg8::EpiNsaIn E{(bf16*)(ws + WS_P0), (float*)(ws + WS_GL), 0.08838834764831845f};
        pg8::gemm_phase<pg8::EpiNsaIn, pg8::StaticOrder, true, true>(F.lds + RING_OFF, g, S, E);
        if (BOTH(1) || rep_ + 1 < REPS(1)) GRID_BAR();
    }
    if (IN(2)) for (int rep_ = 0; rep_ < REPS(2); ++rep_) { relaunder(F); p2_compress(F, args); if (BOTH(2) || rep_ + 1 < REPS(2)) GRID_BAR(); }
#ifndef PROBE_NSA2
#define PROBE_NSA2 0
#endif
    for (int repn_ = 0; repn_ < (PROBE_NSA2 ? 2 : 1); ++repn_) {
    if (IN(3)) for (int rep_ = 0; rep_ < REPS(3); ++rep_) { relaunder(F); p3a_nsa_cmp(F, args); if (BOTH(3) || rep_ + 1 < REPS(3)) GRID_BAR(); }
    if (IN(4)) for (int rep_ = 0; rep_ < REPS(4); ++rep_) { relaunder(F); p3b_nsa_sel(F, args); if (BOTH(4) || rep_ + 1 < REPS(4) || repn_ + 1 < (PROBE_NSA2 ? 2 : 1)) GRID_BAR(); }
    }
    if (IN(5)) for (int rep_ = 0; rep_ < REPS(5); ++rep_) { relaunder(F); p3c_nsa_win(F, args); if (BOTH(5) || rep_ + 1 < REPS(5)) GRID_BAR(); }
    if (IN(6)) for (int rep_ = 0; rep_ < REPS(6); ++rep_) { relaunder(F);
        pg8::Gemm g{(const bf16*)(ws + WS_OATT0), (const bf16*)(ws + WS_W_NSA_OUT), NTOK, DM, DM}; pg8::StaticOrder S; S.init(NTOK, DM, F.G, (int)blockIdx.x);
        pg8::EpiResF32 E{args.in[0], Z, ALPHA, DM};
        pg8::gemm_phase<pg8::EpiResF32, pg8::StaticOrder, true, true>(F.lds + RING_OFF, g, S, E);
        if (BOTH(6) || rep_ + 1 < REPS(6)) GRID_BAR();
    }
    if (IN(7)) for (int rep_ = 0; rep_ < REPS(7); ++rep_) { relaunder(F); ln_phase<false, FFN_F8 != 0>(F, args, Z, args.in[23], args.in[24], XF, XB); if (BOTH(7) || rep_ + 1 < REPS(7)) GRID_BAR(); }
    if (IN(8)) for (int rep_ = 0; rep_ < REPS(8); ++rep_) { relaunder(F);
        pg8::StaticOrder S; S.init(NTOK, 2 * DFF, F.G, (int)blockIdx.x);
#if FFN_F8
        pg8::Gemm g{XB, (const bf16*)(ws + WS_W_FFN_GU), NTOK, 2 * DFF, DM, 1, 0x79797979};
        pg8::EpiSwiGLU8 E{(unsigned char*)(ws + WS_HFF), DFF};
        pg8::gemm_phase<pg8::EpiSwiGLU8, pg8::StaticOrder, true, true, true>(F.lds + RING_OFF, g, S, E);
#else
        pg8::Gemm g{XB, (const bf16*)(ws + WS_W_FFN_GU), NTOK, 2 * DFF, DM};
        pg8::EpiSwiGLU E{(bf16*)(ws + WS_HFF), DFF};
        pg8::gemm_phase<pg8::EpiSwiGLU, pg8::StaticOrder, true, true>(F.lds + RING_OFF, g, S, E);
#endif
        if (BOTH(8) || rep_ + 1 < REPS(8)) GRID_BAR();
    }
    if (IN(9)) for (int rep_ = 0; rep_ < REPS(9); ++rep_) { relaunder(F);
        pg8::StaticOrder S; S.init(NTOK, DM, F.G, (int)blockIdx.x);
        pg8::EpiResF32 E{XF, Z, ALPHA, DM};
#if FFN_F8
        pg8::Gemm g{(const bf16*)(ws + WS_HFF), (const bf16*)(ws + WS_W_FFN_DN), NTOK, DM, DFF, 1, 0x77777777};
        pg8::gemm_phase<pg8::EpiResF32, pg8::StaticOrder, true, true, true>(F.lds + RING_OFF, g, S, E);
#else
        pg8::Gemm g{(const bf16*)(ws + WS_HFF), (const bf16*)(ws + WS_W_FFN_DN), NTOK, DM, DFF};
        pg8::gemm_phase<pg8::EpiResF32, pg8::StaticOrder, true, true>(F.lds + RING_OFF, g, S, E);
#endif
        if (BOTH(9) || rep_ + 1 < REPS(9)) GRID_BAR();
    }
    if (IN(10)) for (int rep_ = 0; rep_ < REPS(10); ++rep_) { relaunder(F); ln_phase<false>(F, args, Z, args.in[25], args.in[26], XF, XB); if (BOTH(10) || rep_ + 1 < REPS(10)) GRID_BAR(); }
    if (IN(11)) for (int rep_ = 0; rep_ < REPS(11); ++rep_) { relaunder(F);
        pg8::Gemm g{XB, (const bf16*)(ws + WS_W_DSA_IN), NTOK, DSA_NPAD, DM}; pg8::StaticOrder S; S.init(NTOK, DSA_NPAD, F.G, (int)blockIdx.x);
        pg8::EpiDsaIn E{(bf16*)(ws + WS_Q), (float*)(ws + WS_CRAW), (bf16*)(ws + WS_QI), (float*)(ws + WS_KIWI), 0.125f};
        pg8::gemm_phase<pg8::EpiDsaIn, pg8::StaticOrder, true, true>(F.lds + RING_OFF, g, S, E);
        if (BOTH(11) || rep_ + 1 < REPS(11)) GRID_BAR();
    }
    if (IN(12)) for (int rep_ = 0; rep_ < REPS(12); ++rep_) { relaunder(F); p10_dsa_prep(F, args); if (BOTH(12) || rep_ + 1 < REPS(12)) GRID_BAR(); }
    if (IN(13)) for (int rep_ = 0; rep_ < REPS(13); ++rep_) { relaunder(F); p13a_dsa_index(F, args); if (BOTH(13) || rep_ + 1 < REPS(13)) GRID_BAR(); }
    if (IN(14)) for (int rep_ = 0; rep_ < REPS(14); ++rep_) { relaunder(F); p13b_dsa_attn(F, args); if (BOTH(14) || rep_ + 1 < REPS(14)) GRID_BAR(); }
    if (IN(15)) for (int rep_ = 0; rep_ < REPS(15); ++rep_) { relaunder(F); p12_dsa_uv(F, args); if (BOTH(15) || rep_ + 1 < REPS(15)) GRID_BAR(); }
    if (IN(16)) for (int rep_ = 0; rep_ < REPS(16); ++rep_) { relaunder(F);
        pg8::Gemm g{(const bf16*)(ws + WS_OATT1), (const bf16*)(ws + WS_W_DSA_OUT), NTOK, DM, DM}; pg8::StaticOrder S; S.init(NTOK, DM, F.G, (int)blockIdx.x);
        pg8::EpiResF32 E{XF, Z, ALPHA, DM};
        pg8::gemm_phase<pg8::EpiResF32, pg8::StaticOrder, true, true>(F.lds + RING_OFF, g, S, E);
        if (BOTH(16) || rep_ + 1 < REPS(16)) GRID_BAR();
    }
    if (IN(17)) for (int rep_ = 0; rep_ < REPS(17); ++rep_) { relaunder(F); ln_route_phase(F, args, Z, args.in[23] + DM, args.in[24] + DM, XF, XB); if (BOTH(17) || rep_ + 1 < REPS(17)) GRID_BAR(); }
    if (IN(18)) for (int rep_ = 0; rep_ < REPS(18); ++rep_) { relaunder(F); p15_gather(F, args); if (BOTH(18) || rep_ + 1 < REPS(18)) GRID_BAR(); }
    if (IN(19)) for (int rep_ = 0; rep_ < REPS(19); ++rep_) { relaunder(F);
        MoeTiles T; moe_tiles(F, T);
        pg8::Gemm g{(const bf16*)(ws + WS_XG), (const bf16*)(ws + WS_W_MOE_GU), T.MT * 256, 2 * DFFE, DM, 1, 0x79797979}; pg8::MoeOrder S; S.init(T.MT * 256, 2 * DFFE, F.G, (int)blockIdx.x); S.nexp_rows = 2 * DFFE;
#pragma unroll
        for (int e = 0; e < 8; ++e) S.tend[e] = T.tend[e];
        pg8::EpiSwiGLU8 E{(unsigned char*)(ws + WS_HM), DFFE};
        pg8::gemm_phase<pg8::EpiSwiGLU8, pg8::MoeOrder, true, true, true>(F.lds + RING_OFF, g, S, E);
        if (BOTH(19) || rep_ + 1 < REPS(19)) GRID_BAR();
    }
    if (IN(20)) for (int rep_ = 0; rep_ < REPS(20); ++rep_) { relaunder(F);
        MoeTiles T; moe_tiles(F, T);
        pg8::Gemm g{(const bf16*)(ws + WS_HM), (const bf16*)(ws + WS_W_MOE_DN), T.MT * 256, DM, DFFE, 1, 0x77777777}; pg8::MoeOrder S; S.init(T.MT * 256, DM, F.G, (int)blockIdx.x); S.nexp_rows = DM;
#pragma unroll
        for (int e = 0; e < 8; ++e) S.tend[e] = T.tend[e];
        pg8::EpiBf16Plain E{(bf16*)(ws + WS_Y), DM};
        pg8::gemm_phase<pg8::EpiBf16Plain, pg8::MoeOrder, true, true, true>(F.lds + RING_OFF, g, S, E);
        if (BOTH(20) || rep_ + 1 < REPS(20)) GRID_BAR();
    }
    if (IN(21)) for (int rep_ = 0; rep_ < REPS(21); ++rep_) { relaunder(F); p18_final(F, args); }
#undef IN
#undef BOTH
}

extern "C" void kernel_launch(void* const* d_in, const int* in_sizes, int n_in, void* d_out, int out_size, void* d_ws, size_t ws_size, hipStream_t stream) {
    static int grid = 0;
    if (grid == 0) {
        if (n_in != 27 || out_size != NTOK * DM || ws_size < WS_END) { fprintf(stderr, "kernel_launch: unexpected shapes (n_in %d, out %d, ws %zu); nothing launched\n", n_in, out_size, ws_size); grid = -1; return; }
        int dev = 0, cus = 0, per_cu = 0;
        if (hipGetDevice(&dev) != hipSuccess || hipDeviceGetAttribute(&cus, hipDeviceAttributeMultiprocessorCount, dev) != hipSuccess) { grid = -1; return; }
        if (hipFuncSetAttribute((const void*)mega_fwd, hipFuncAttributeMaxDynamicSharedMemorySize, LDS_BYTES) != hipSuccess) { fprintf(stderr, "kernel_launch: hipFuncSetAttribute failed\n"); grid = -1; return; }
        if (hipOccupancyMaxActiveBlocksPerMultiprocessor(&per_cu, (const void*)mega_fwd, NWAVES * 64, LDS_BYTES) != hipSuccess || per_cu < 1) { fprintf(stderr, "kernel_launch: occupancy query says %d\n", per_cu); }
        (void)hipGetLastError();
        grid = cus;
    }
    if (grid < 0) return;
    if (hipMemsetAsync((char*)d_ws + WS_CTL, 0, CTL_ZERO_BYTES, stream) != hipSuccess) return;
    Args a{};
    for (int i = 0; i < 27; ++i) a.in[i] = (const float*)d_in[i];
    a.out = (float*)d_out; a.ws = (unsigned char*)d_ws;
#if MK_PER_PHASE
    for (int p = 0; p < NPHASE; ++p) { a.ph_lo = p; a.ph_hi = p + 1; hipLaunchKernelGGL(mega_fwd, dim3(grid), dim3(NWAVES * 64), LDS_BYTES, stream, a); }
#else
    a.ph_lo = 0; a.ph_hi = NPHASE;
    hipLaunchKernelGGL(mega_fwd, dim3(grid), dim3(NWAVES * 64), LDS_BYTES, stream, a);
#endif
}
```

```cpp
#include <hip/hip_runtime.h>
#include <cstdio>
#include <cstdint>
namespace pg8 {
#define PG8_LAS __attribute__((address_space(3)))
typedef unsigned short bf16_t;
typedef short bf16x8 __attribute__((ext_vector_type(8)));
typedef float f32x4 __attribute__((ext_vector_type(4)));
typedef unsigned u32x4 __attribute__((ext_vector_type(4)));
constexpr int BM = 256, BK = 64, HALF = 128, HTB = HALF * BK * 2  , STAGE_BYTES = 8 * HTB, NXCD = 8, WGM = 8;

__host__ __device__ __forceinline__ int lds_byte(int r, int c) { const int st = (r >> 4) * 2 + (c >> 5), rr = r & 15, cc = c & 31, ob = rr * 64 + cc * 2; return st * 1024 + (ob ^ (((ob >> 9) & 1) << 5)); }
__host__ __device__ __forceinline__ void stage_rc(int b, int& R, int& C) { const int st = b / 1024, sb = b % 1024, swz = sb ^ (((sb >> 9) & 1) << 5); R = (st >> 1) * 16 + swz / 64; C = (st & 1) * 32 + (swz % 64) / 2; }
__host__ __device__ __forceinline__ int perm32(int rho) { const int n = rho >> 4, i = rho & 15; return 8 * (i >> 2) + 4 * n + (i & 3); }

struct Unit { int pm, pn; };
struct Gemm { const bf16_t* A; const bf16_t* Bt; int M, N, K; int esz = 2; int scale = 0x7f7f7f7f; };

struct StaticOrder {
    int nM, nN, nwg, G, c;
    __host__ __device__ void init(int M, int N, int G_, int c_) { nM = M / BM; nN = N / BM; nwg = nM * nN; G = G_; c = c_; }
    __host__ __device__ bool next(int i, Unit& u) const {
        const long L = (long)i * G + c; if (L >= nwg) return false;
        int wgid = (int)L; { const int q = nwg / NXCD, r = nwg % NXCD, xcd = wgid % NXCD, off = wgid / NXCD; wgid = (xcd < r ? xcd * (q + 1) : r * (q + 1) + (xcd - r) * q) + off; }
        const int nig = WGM * nN, gid = wgid / nig, fm = gid * WGM, gsz = (nM - fm) < WGM ? (nM - fm) : WGM;
        u.pm = fm + ((wgid % nig) % gsz); u.pn = (wgid % nig) / gsz; return true;
    }
    __device__ __forceinline__ void a_ready(const Unit&) const {}
    __device__ __forceinline__ void done(const Unit&) const {}
    __device__ __forceinline__ const char* a_ptr(const Gemm& g, const Unit& u) const { return (const char*)g.A + (size_t)u.pm * ((size_t)BM * g.K * g.esz); }
    __device__ __forceinline__ const char* b_ptr(const Gemm& g, const Unit& u) const { return (const char*)g.Bt + (size_t)u.pn * ((size_t)BM * g.K * g.esz); }
};


__device__ __forceinline__ unsigned cvt_pk_bf16(float lo, float hi) { unsigned r; asm volatile("v_cvt_pk_bf16_f32 %0, %1, %2" : "=v"(r) : "v"(lo), "v"(hi)); return r; }
__device__ __forceinline__ u32x4 pack8(const f32x4 v0, const f32x4 v1) { u32x4 w; w.x = cvt_pk_bf16(v0[0], v0[1]); w.y = cvt_pk_bf16(v0[2], v0[3]); w.z = cvt_pk_bf16(v1[0], v1[1]); w.w = cvt_pk_bf16(v1[2], v1[3]); return w; }

struct EpiNsaIn {
    static constexpr bool PERM = true, AFTER_DRAIN = false;
    bf16_t* P0; float* GL; float qscale;
    __device__ __forceinline__ void operator()(const f32x4 (&acc)[2][2][4][2], const Unit& u, int wr, int wc, int fr, int fq) const {
        const int row0 = u.pm * BM + wr * 64 + fr;
        if (u.pn < 20) {
            const float s = u.pn < 8 ? qscale : 1.0f;
            const int col0 = u.pn * BM + wc * 32 + 8 * fq;
#pragma unroll
            for (int ai = 0; ai < 2; ++ai)
#pragma unroll
                for (int m = 0; m < 4; ++m) { bf16_t* rowp = P0 + (size_t)(row0 + ai * HALF + m * 16) * 5120 + col0;
#pragma unroll
                    for (int bj = 0; bj < 2; ++bj) *(u32x4*)(rowp + bj * HALF) = pack8(acc[ai][bj][m][0] * s, acc[ai][bj][m][1] * s); }
        } else {
            const int c = wc * 32 + 8 * fq;
            if (c < 48) {
#pragma unroll
                for (int ai = 0; ai < 2; ++ai)
#pragma unroll
                    for (int m = 0; m < 4; ++m) { float* gp = GL + (size_t)(row0 + ai * HALF + m * 16) * 48 + c;
                        *(f32x4*)gp = acc[ai][0][m][0]; *(f32x4*)(gp + 4) = acc[ai][0][m][1]; }
            }
        }
    }
};
struct EpiDsaIn {
    static constexpr bool PERM = true, AFTER_DRAIN = false;
    bf16_t* Q; float* CRAW; bf16_t* QI; float* KIWI; float qiscale;
    __device__ __forceinline__ void operator()(const f32x4 (&acc)[2][2][4][2], const Unit& u, int wr, int wc, int fr, int fq) const {
        const int row0 = u.pm * BM + wr * 64 + fr; const int c = wc * 32 + 8 * fq;
        if (u.pn < 8) {
#pragma unroll
            for (int ai = 0; ai < 2; ++ai)
#pragma unroll
                for (int m = 0; m < 4; ++m) { bf16_t* rowp = Q + (size_t)(row0 + ai * HALF + m * 16) * 2048 + u.pn * BM + c;
#pragma unroll
                    for (int bj = 0; bj < 2; ++bj) *(u32x4*)(rowp + bj * HALF) = pack8(acc[ai][bj][m][0], acc[ai][bj][m][1]); }
        } else if (u.pn == 8) {
#pragma unroll
            for (int ai = 0; ai < 2; ++ai)
#pragma unroll
                for (int m = 0; m < 4; ++m) { float* rowp = CRAW + (size_t)(row0 + ai * HALF + m * 16) * 256 + c;
#pragma unroll
                    for (int bj = 0; bj < 2; ++bj) { *(f32x4*)(rowp + bj * HALF) = acc[ai][bj][m][0]; *(f32x4*)(rowp + bj * HALF + 4) = acc[ai][bj][m][1]; } }
        } else if (u.pn < 11) {
#pragma unroll
            for (int ai = 0; ai < 2; ++ai)
#pragma unroll
                for (int m = 0; m < 4; ++m) { bf16_t* rowp = QI + (size_t)(row0 + ai * HALF + m * 16) * 512 + (u.pn - 9) * BM + c;
#pragma unroll
                    for (int bj = 0; bj < 2; ++bj) *(u32x4*)(rowp + bj * HALF) = pack8(acc[ai][bj][m][0] * qiscale, acc[ai][bj][m][1] * qiscale); }
        } else {
#pragma unroll
            for (int ai = 0; ai < 2; ++ai)
#pragma unroll
                for (int m = 0; m < 4; ++m) { float* rowp = KIWI + (size_t)(row0 + ai * HALF + m * 16) * 128 + c;
                    *(f32x4*)rowp = acc[ai][0][m][0]; *(f32x4*)(rowp + 4) = acc[ai][0][m][1]; }
        }
    }
};
struct EpiResF32 {
    static constexpr bool PERM = true, AFTER_DRAIN = false;
    const float* R; bf16_t* Z; float alpha; int ldc;
    __device__ __forceinline__ void operator()(const f32x4 (&acc)[2][2][4][2], const Unit& u, int wr, int wc, int fr, int fq) const {
        const int row0 = u.pm * BM + wr * 64 + fr, col0 = u.pn * BM + wc * 32 + 8 * fq;
#pragma unroll
        for (int ai = 0; ai < 2; ++ai)
#pragma unroll
            for (int m = 0; m < 4; ++m) { const size_t off = (size_t)(row0 + ai * HALF + m * 16) * ldc + col0;
#pragma unroll
                for (int bj = 0; bj < 2; ++bj) { const f32x4 r0 = *(const f32x4*)(R + off + bj * HALF), r1 = *(const f32x4*)(R + off + bj * HALF + 4);
                    *(u32x4*)(Z + off + bj * HALF) = pack8(r0 * alpha + acc[ai][bj][m][0], r1 * alpha + acc[ai][bj][m][1]); } }
    }
};
struct EpiResH {
    static constexpr bool PERM = true, AFTER_DRAIN = false;
    const bf16_t* R; bf16_t* Z; float alpha; int ldc;
    __device__ __forceinline__ void operator()(const f32x4 (&acc)[2][2][4][2], const Unit& u, int wr, int wc, int fr, int fq) const {
        const int row0 = u.pm * BM + wr * 64 + fr, col0 = u.pn * BM + wc * 32 + 8 * fq;
#pragma unroll
        for (int ai = 0; ai < 2; ++ai)
#pragma unroll
            for (int m = 0; m < 4; ++m) { const size_t off = (size_t)(row0 + ai * HALF + m * 16) * ldc + col0;
#pragma unroll
                for (int bj = 0; bj < 2; ++bj) { const u32x4 rr = *(const u32x4*)(R + off + bj * HALF);
                    const f32x4 r0 = (f32x4){__uint_as_float(rr.x << 16), __uint_as_float(rr.x & 0xffff0000u), __uint_as_float(rr.y << 16), __uint_as_float(rr.y & 0xffff0000u)};
                    const f32x4 r1 = (f32x4){__uint_as_float(rr.z << 16), __uint_as_float(rr.z & 0xffff0000u), __uint_as_float(rr.w << 16), __uint_as_float(rr.w & 0xffff0000u)};
                    *(u32x4*)(Z + off + bj * HALF) = pack8(r0 * alpha + acc[ai][bj][m][0], r1 * alpha + acc[ai][bj][m][1]); } }
    }
};
struct EpiF32 {
    static constexpr bool PERM = false, AFTER_DRAIN = false;
    float* C; int ldc;
    __device__ __forceinline__ void operator()(const f32x4 (&acc)[2][2][4][2], const Unit& u, int wr, int wc, int fr, int fq) const {
        const int row0 = u.pm * BM + wr * 64 + fr, col0 = u.pn * BM + wc * 32 + 4 * fq;
#pragma unroll
        for (int ai = 0; ai < 2; ++ai)
#pragma unroll
            for (int m = 0; m < 4; ++m) { float* rowp = C + (size_t)(row0 + ai * HALF + m * 16) * ldc + col0;
#pragma unroll
                for (int bj = 0; bj < 2; ++bj)
#pragma unroll
                    for (int n = 0; n < 2; ++n) *(f32x4*)(rowp + bj * HALF + n * 16) = acc[ai][bj][m][n]; }
    }
};
struct EpiBf16Plain {
    static constexpr bool PERM = true, AFTER_DRAIN = false;
    bf16_t* C; int ldc;
    __device__ __forceinline__ void operator()(const f32x4 (&acc)[2][2][4][2], const Unit& u, int wr, int wc, int fr, int fq) const {
        const int row0 = u.pm * BM + wr * 64 + fr, col0 = u.pn * BM + wc * 32 + 8 * fq;
#pragma unroll
        for (int ai = 0; ai < 2; ++ai)
#pragma unroll
            for (int m = 0; m < 4; ++m) { bf16_t* rowp = C + (size_t)(row0 + ai * HALF + m * 16) * ldc + col0;
#pragma unroll
                for (int bj = 0; bj < 2; ++bj) *(u32x4*)(rowp + bj * HALF) = pack8(acc[ai][bj][m][0], acc[ai][bj][m][1]); }
    }
};
__device__ __forceinline__ float silu_mul(float g, float u) { return g * __builtin_amdgcn_rcpf(1.0f + __expf(-g)) * u; }
struct EpiSwiGLU {
    static constexpr bool PERM = true, AFTER_DRAIN = false;
    bf16_t* H; int ldh;
    __device__ __forceinline__ void operator()(const f32x4 (&acc)[2][2][4][2], const Unit& u, int wr, int wc, int fr, int fq) const {
        const int row0 = u.pm * BM + wr * 64 + fr, col0 = u.pn * HALF + wc * 32 + 8 * fq;
#pragma unroll
        for (int ai = 0; ai < 2; ++ai)
#pragma unroll
            for (int m = 0; m < 4; ++m) { bf16_t* rowp = H + (size_t)(row0 + ai * HALF + m * 16) * ldh + col0;
                f32x4 v0, v1;
#pragma unroll
                for (int j = 0; j < 4; ++j) { v0[j] = silu_mul(acc[ai][0][m][0][j], acc[ai][1][m][0][j]); v1[j] = silu_mul(acc[ai][0][m][1][j], acc[ai][1][m][1][j]); }
                *(u32x4*)rowp = pack8(v0, v1); }
    }
};
struct EpiSwiGLU8 {
    static constexpr bool PERM = true, AFTER_DRAIN = false;
    unsigned char* H; int ldh;
    __device__ __forceinline__ void operator()(const f32x4 (&acc)[2][2][4][2], const Unit& u, int wr, int wc, int fr, int fq) const {
        const int row0 = u.pm * BM + wr * 64 + fr, col0 = u.pn * HALF + wc * 32 + 8 * fq;
#pragma unroll
        for (int ai = 0; ai < 2; ++ai)
#pragma unroll
            for (int m = 0; m < 4; ++m) { unsigned char* rowp = H + (size_t)(row0 + ai * HALF + m * 16) * ldh + col0;
                float v[8];
#pragma unroll
                for (int j = 0; j < 4; ++j) { v[j] = silu_mul(acc[ai][0][m][0][j], acc[ai][1][m][0][j]); v[4 + j] = silu_mul(acc[ai][0][m][1][j], acc[ai][1][m][1][j]); }
                int w0 = __builtin_amdgcn_cvt_pk_fp8_f32(v[0], v[1], 0, false); w0 = __builtin_amdgcn_cvt_pk_fp8_f32(v[2], v[3], w0, true);
                int w1 = __builtin_amdgcn_cvt_pk_fp8_f32(v[4], v[5], 0, false); w1 = __builtin_amdgcn_cvt_pk_fp8_f32(v[6], v[7], w1, true);
                uint2 o; o.x = (unsigned)w0; o.y = (unsigned)w1; *(uint2*)rowp = o; }
    }
};
struct MoeOrder : StaticOrder {
    int tend[8]; int nexp_rows;
    __device__ __forceinline__ int expert(int pm) const { int e = 0;
#pragma unroll
        for (int i = 0; i < 7; ++i) e += (pm >= tend[i]) ? 1 : 0; return e; }
    __device__ __forceinline__ const char* b_ptr(const Gemm& g, const Unit& u) const { return (const char*)g.Bt + ((size_t)expert(u.pm) * nexp_rows + (size_t)u.pn * BM) * ((size_t)g.K * g.esz); }
};
typedef int i32x8 __attribute__((ext_vector_type(8)));
typedef int i32x4 __attribute__((ext_vector_type(4)));
__device__ __forceinline__ i32x8 cat8(bf16x8 lo, bf16x8 hi) { const i32x4 a = *reinterpret_cast<const i32x4*>(&lo), b = *reinterpret_cast<const i32x4*>(&hi); return __builtin_shufflevector(a, b, 0, 1, 2, 3, 4, 5, 6, 7); }
template <class Epi, class Sched, bool ALIGN_EPI = false, bool SP2 = false, bool FP8 = false>
__device__ __forceinline__ void gemm_phase(PG8_LAS unsigned char* lds, const Gemm g, const Sched& S, const Epi& E) {
    int tid = threadIdx.x; asm volatile("" : "+v"(tid));
    const int wid = __builtin_amdgcn_readfirstlane(tid >> 6), lane = tid & 63, wr = wid >> 2, wc = wid & 3, fr = lane & 15, fq = lane >> 4;
    const int K = g.K, nt = K / (FP8 ? 2 * BK : BK);
    unsigned voffA[2], voffB[2];
#pragma unroll
    for (int i = 0; i < 2; ++i) { int R, C; stage_rc(tid * 16 + i * 8192, R, C); const int Rb = Epi::PERM ? ((R & ~31) + perm32(R & 31)) : R;
        voffA[i] = FP8 ? (unsigned)(R * K + C * 2) : (unsigned)(R * K + C) * 2u; voffB[i] = FP8 ? (unsigned)(Rb * K + C * 2) : (unsigned)(Rb * K + C) * 2u; }
    const size_t kstep = (size_t)(BK * 2);
    const size_t hstep = (size_t)HALF * K * (FP8 ? 1 : 2);
    const size_t tstep = 2 * hstep;
    const unsigned ldsw = (unsigned)wid * 1024u;
    const int aoff = lds_byte(wr * 64 + fr, fq * 8), boff = lds_byte(wc * 32 + fr, fq * 8);
#define PG8_SA(b, h) (((b) * 2 + (h)) * HTB)
#define PG8_SB(b, h) ((4 + (b) * 2 + (h)) * HTB)
#define PG8_STAGE(bufoff, gbase, voff) do { _Pragma("unroll") for (int _i = 0; _i < 2; ++_i) \
        __builtin_amdgcn_global_load_lds((const unsigned*)((const char*)(gbase) + (voff)[_i]), (PG8_LAS unsigned*)(lds + (bufoff) + ldsw + _i * 8192), 16, 0, 0); } while (0)
#define PG8_LDA(dst, b, h) do { _Pragma("unroll") for (int m = 0; m < 4; ++m) { if constexpr (FP8) { const i32x4 lo_ = *(const PG8_LAS i32x4*)(lds + PG8_SA(b, h) + aoff + m * 2048), hi_ = *(const PG8_LAS i32x4*)(lds + PG8_SA(b, h) + aoff + m * 2048 + 1024); dst##8[m] = __builtin_shufflevector(lo_, hi_, 0, 1, 2, 3, 4, 5, 6, 7); } else { _Pragma("unroll") for (int k = 0; k < 2; ++k) dst[m][k] = *(const PG8_LAS bf16x8*)(lds + PG8_SA(b, h) + aoff + m * 2048 + k * 1024); } } } while (0)
#define PG8_LDB(dst, b, h) do { _Pragma("unroll") for (int n = 0; n < 2; ++n) { if constexpr (FP8) { const i32x4 lo_ = *(const PG8_LAS i32x4*)(lds + PG8_SB(b, h) + boff + n * 2048), hi_ = *(const PG8_LAS i32x4*)(lds + PG8_SB(b, h) + boff + n * 2048 + 1024); dst##8[n] = __builtin_shufflevector(lo_, hi_, 0, 1, 2, 3, 4, 5, 6, 7); } else { _Pragma("unroll") for (int k = 0; k < 2; ++k) dst[n][k] = *(const PG8_LAS bf16x8*)(lds + PG8_SB(b, h) + boff + n * 2048 + k * 1024); } } } while (0)
#define PG8_MMA(ai, bj, At, Bt) do { __builtin_amdgcn_s_setprio(1); _Pragma("unroll") for (int m = 0; m < 4; ++m) _Pragma("unroll") for (int n = 0; n < 2; ++n) { \
        if constexpr (FP8) { asm volatile("v_mfma_scale_f32_16x16x128_f8f6f4 %0, %1, %2, %0, %3, %4 op_sel_hi:[0,0,0]" : "+v"(acc[ai][bj][m][n]) : "v"(Bt##8[n]), "v"(At##8[m]), "v"(sclA), "v"(sclB)); } \
        else { _Pragma("unroll") for (int k = 0; k < 2; ++k) acc[ai][bj][m][n] = __builtin_amdgcn_mfma_f32_16x16x32_bf16(Bt[n][k], At[m][k], acc[ai][bj][m][n], 0, 0, 0); } } __builtin_amdgcn_s_setprio(0); } while (0)
#define PG8_WAIT_V(n) asm volatile("s_waitcnt vmcnt(" #n ")" ::: "memory")
#define PG8_WAIT_L(n) asm volatile("s_waitcnt lgkmcnt(" #n ")" ::: "memory")
#define PG8_BAR __builtin_amdgcn_s_barrier()
#define PG8_SCHED __builtin_amdgcn_sched_barrier(0)
    Unit cur, nxt; int ui = 0;
    if (!S.next(0, cur)) return;
    f32x4 acc[2][2][4][2];
#pragma unroll
    for (int a = 0; a < 2; ++a)
#pragma unroll
        for (int b = 0; b < 2; ++b)
#pragma unroll
            for (int m = 0; m < 4; ++m)
#pragma unroll
                for (int n = 0; n < 2; ++n) acc[a][b][m][n] = (f32x4){0.f, 0.f, 0.f, 0.f};
    bf16x8 At[4][2], B0[2][2], B1[2][2]; i32x8 At8[4], B08[2], B18[2]; const int sclA = g.scale, sclB = 0x7f7f7f7f;
    const char* cA = S.a_ptr(g, cur); const char* cB = S.b_ptr(g, cur);
    S.a_ready(cur);
    if constexpr (SP2) {
        PG8_STAGE(PG8_SB(0, 0), cB, voffB); PG8_STAGE(PG8_SB(0, 1), cB + hstep, voffB); PG8_STAGE(PG8_SA(0, 0), cA, voffA); PG8_STAGE(PG8_SA(0, 1), cA + hstep, voffA);
        if (wr == 1) PG8_BAR;
        PG8_WAIT_V(2); PG8_BAR;
        PG8_STAGE(PG8_SB(1, 0), cB + kstep, voffB); PG8_STAGE(PG8_SA(1, 0), cA + kstep, voffA); PG8_STAGE(PG8_SB(1, 1), cB + hstep + kstep, voffB);
        PG8_WAIT_V(6); PG8_BAR;
    } else {
        PG8_STAGE(PG8_SB(0, 0), cB, voffB); PG8_STAGE(PG8_SA(0, 0), cA, voffA); PG8_STAGE(PG8_SB(0, 1), cB + hstep, voffB); PG8_STAGE(PG8_SA(0, 1), cA + hstep, voffA);
        if (wr == 1) PG8_BAR;
        PG8_WAIT_V(4); PG8_BAR;
        PG8_STAGE(PG8_SB(1, 0), cB + kstep, voffB); PG8_STAGE(PG8_SA(1, 0), cA + kstep, voffA); PG8_STAGE(PG8_SB(1, 1), cB + hstep + kstep, voffB);
        PG8_WAIT_V(6); PG8_BAR;
    }
    for (;;) {
        const bool has_next = S.next(ui + 1, nxt);
        const char* nA = has_next ? S.a_ptr(g, nxt) : cA; const char* nB = has_next ? S.b_ptr(g, nxt) : cB;
        for (int t = 0; t < nt; t += 2) {
            const bool last = (t == nt - 2);
            const char* a1 = cA + (size_t)(t + 1) * kstep;
            const char* a2 = last ? nA : cA + (size_t)(t + 2) * kstep; const char* b2 = last ? nB : cB + (size_t)(t + 2) * kstep;
            const char* a3 = a2 + kstep; const char* b3 = b2 + kstep;
            if (last && has_next) S.a_ready(nxt);
            if constexpr (SP2) {
            PG8_LDB(B0, 0, 0); PG8_LDB(B1, 0, 1); PG8_SCHED; PG8_LDA(At, 0, 0); PG8_STAGE(PG8_SA(1, 1), a1 + hstep, voffA);
            PG8_WAIT_V(8); PG8_WAIT_L(0); PG8_BAR; PG8_MMA(0, 0, At, B0); PG8_MMA(0, 1, At, B1); PG8_BAR; PG8_SCHED;
            PG8_LDA(At, 0, 1); PG8_STAGE(PG8_SB(0, 0), b2, voffB); PG8_STAGE(PG8_SB(0, 1), b2 + hstep, voffB); PG8_STAGE(PG8_SA(0, 0), a2, voffA);
            PG8_WAIT_V(8); PG8_WAIT_L(0); PG8_BAR; PG8_MMA(1, 0, At, B0); PG8_MMA(1, 1, At, B1); PG8_BAR; PG8_SCHED;
            PG8_LDB(B0, 1, 0); PG8_LDB(B1, 1, 1); PG8_SCHED; PG8_LDA(At, 1, 0); PG8_STAGE(PG8_SA(0, 1), a2 + hstep, voffA);
            PG8_WAIT_V(8); PG8_WAIT_L(0); PG8_BAR; PG8_MMA(0, 0, At, B0); PG8_MMA(0, 1, At, B1); PG8_BAR; PG8_SCHED;
            PG8_LDA(At, 1, 1); PG8_STAGE(PG8_SB(1, 0), b3, voffB); PG8_STAGE(PG8_SB(1, 1), b3 + hstep, voffB); PG8_STAGE(PG8_SA(1, 0), a3, voffA);
            PG8_WAIT_V(8); PG8_WAIT_L(0); PG8_BAR; PG8_MMA(1, 0, At, B0); PG8_MMA(1, 1, At, B1); PG8_BAR; PG8_SCHED;
            } else {
            PG8_LDB(B0, 0, 0); PG8_SCHED; PG8_LDA(At, 0, 0); PG8_STAGE(PG8_SA(1, 1), a1 + hstep, voffA);
            PG8_WAIT_L(8); PG8_BAR; PG8_WAIT_L(0); PG8_MMA(0, 0, At, B0); PG8_BAR; PG8_SCHED;
            PG8_LDB(B1, 0, 1); PG8_STAGE(PG8_SB(0, 0), b2, voffB);
            PG8_BAR; PG8_WAIT_L(0); PG8_MMA(0, 1, At, B1); PG8_BAR;
            PG8_LDA(At, 0, 1); PG8_STAGE(PG8_SA(0, 0), a2, voffA);
            PG8_BAR; PG8_WAIT_L(0); PG8_MMA(1, 0, At, B0); PG8_BAR; PG8_SCHED;
            PG8_STAGE(PG8_SB(0, 1), b2 + hstep, voffB);
            PG8_WAIT_V(6); PG8_BAR; PG8_MMA(1, 1, At, B1); PG8_BAR;
            PG8_LDB(B0, 1, 0); PG8_SCHED; PG8_LDA(At, 1, 0); PG8_STAGE(PG8_SA(0, 1), a2 + hstep, voffA);
            PG8_WAIT_L(8); PG8_BAR; PG8_WAIT_L(0); PG8_MMA(0, 0, At, B0); PG8_BAR; PG8_SCHED;
            PG8_LDB(B1, 1, 1); PG8_STAGE(PG8_SB(1, 0), b3, voffB);
            PG8_BAR; PG8_WAIT_L(0); PG8_MMA(0, 1, At, B1); PG8_BAR;
            PG8_LDA(At, 1, 1); PG8_STAGE(PG8_SA(1, 0), a3, voffA);
            PG8_BAR; PG8_WAIT_L(0); PG8_MMA(1, 0, At, B0); PG8_BAR; PG8_SCHED;
            PG8_STAGE(PG8_SB(1, 1), b3 + hstep, voffB);
            PG8_WAIT_V(6); PG8_BAR; PG8_MMA(1, 1, At, B1); PG8_BAR;
            }
        }
        if constexpr (FP8) asm volatile("s_nop 15\n\ts_nop 15" ::: "memory");
        if constexpr (ALIGN_EPI) { if (wr == 0) PG8_BAR; }
        if constexpr (!Epi::AFTER_DRAIN) { E(acc, cur, wr, wc, fr, fq); S.done(cur); }
        if (!has_next) break;
#pragma unroll
        for (int a = 0; a < 2; ++a)
#pragma unroll
            for (int b = 0; b < 2; ++b)
#pragma unroll
                for (int m = 0; m < 4; ++m)
#pragma unroll
                    for (int n = 0; n < 2; ++n) acc[a][b][m][n] = (f32x4){0.f, 0.f, 0.f, 0.f};
        cur = nxt; cA = nA; cB = nB; ++ui;
        if constexpr (ALIGN_EPI) { if (wr == 1) PG8_BAR; }
    }
    PG8_WAIT_V(0);
    if constexpr (!ALIGN_EPI) { if (wr == 0) PG8_BAR; }
    PG8_BAR;
    if constexpr (Epi::AFTER_DRAIN) { E.fused(acc, cur, wr, wc, fr, fq, lds, wid, lane); S.done(cur); }
#undef PG8_SA
#undef PG8_SB
#undef PG8_STAGE
#undef PG8_LDA
#undef PG8_LDB
#undef PG8_MMA
#undef PG8_WAIT_V
#undef PG8_WAIT_L
#undef PG8_BAR
#undef PG8_SCHED
}
}
#define GAS __attribute__((address_space(1)))
#define LAS __attribute__((address_space(3)))
typedef unsigned short bf16;
typedef unsigned v4u __attribute__((ext_vector_type(4)));
typedef float f32x4 __attribute__((ext_vector_type(4)));
typedef short bf16x8 __attribute__((ext_vector_type(8)));
typedef GAS unsigned gu32;
typedef GAS unsigned long long gu64;
#define RLX_AGENT __ATOMIC_RELAXED, __HIP_MEMORY_SCOPE_AGENT
#define LDS_WAIT() asm volatile("s_waitcnt lgkmcnt(0)" ::: "memory")
#define VM_WAIT() asm volatile("s_waitcnt vmcnt(0)" ::: "memory")
__device__ __forceinline__ unsigned long long rt() { return __builtin_amdgcn_s_memrealtime(); }
__device__ __forceinline__ unsigned f2bf(float f) { unsigned u = __builtin_bit_cast(unsigned, f); return (u + 0x7fffu + ((u >> 16) & 1u)) >> 16; }
__device__ __forceinline__ unsigned pk2(float lo, float hi) { return f2bf(lo) | (f2bf(hi) << 16); }

#define XB_TMO      128
#define XB_XCNT(j)  (256  + 64 * (j))
#define XB_XSUB(j)  (1280 + 64 * (j))
#define XB_XGEN(j)  (2304 + 64 * (j))
#define XB_TOP      3328
#define XB_TOPGEN   3392
#define XCD_BAR_WORDS 3456
#define XB_SPIN_CAP (1u << 18)

__device__ __forceinline__ unsigned xb_ld(unsigned* p)              { return __hip_atomic_load(p, __ATOMIC_RELAXED, __HIP_MEMORY_SCOPE_AGENT); }
__device__ __forceinline__ unsigned xb_add(unsigned* p, unsigned v) { return __hip_atomic_fetch_add(p, v, __ATOMIC_RELAXED, __HIP_MEMORY_SCOPE_AGENT); }
__device__ __forceinline__ unsigned xb_xcc_id() { return (unsigned)__builtin_amdgcn_s_getreg((3 << 11) | 20) & 0xFu; }
#define XB_SPIN(cond, bar) do { unsigned _sp = 0; while (cond) { __builtin_amdgcn_s_sleep(1); \
    if ((++_sp & 255u) == 0u) { if (xb_ld(&(bar)[XB_TMO])) break; if (_sp > XB_SPIN_CAP) { atomicAdd(&(bar)[XB_TMO], 1u); break; } } } } while (0)

struct XcdBarrier {
    unsigned* bar; unsigned x;
    volatile LAS unsigned* st;
};

__device__ __forceinline__ XcdBarrier xcd_barrier_post(unsigned* bar, volatile LAS unsigned* st) {
    XcdBarrier b; b.bar = bar; b.x = xb_xcc_id(); b.st = st;
    if (threadIdx.x == 0) (void)xb_add(&bar[XB_XCNT(b.x)], 1u);
    return b;
}
__device__ __forceinline__ void xcd_barrier_complete(unsigned* bar, unsigned x, unsigned& nloc, unsigned& nx) {
    const unsigned G = gridDim.x * gridDim.y * gridDim.z;
    unsigned sum, cnt, mine, sp = 0u;
    for (;;) {
        sum = 0u; cnt = 0u; mine = 0u;
#pragma unroll
        for (unsigned j = 0; j < 16; ++j) { const unsigned c = xb_ld(&bar[XB_XCNT(j)]); sum += c; cnt += (c > 0u) ? 1u : 0u; mine = (j == x) ? c : mine; }
        if (sum == G) break;
        __builtin_amdgcn_s_sleep(1);
        if ((++sp & 255u) == 0u) { if (xb_ld(&bar[XB_TMO])) break; if (sp > XB_SPIN_CAP) { atomicAdd(&bar[XB_TMO], 1u); break; } }
    }
    nloc = mine > 0u ? mine : 1u; nx = cnt > 0u ? cnt : 1u;
}

__device__ __forceinline__ void xcd_barrier(const XcdBarrier& b) {
    asm volatile("s_waitcnt vmcnt(0)" ::: "memory");
    __syncthreads();
    if (threadIdx.x == 0) {
        unsigned* bar = b.bar;
        __builtin_amdgcn_s_waitcnt(0);
        unsigned nloc = b.st[0], nx = b.st[1];
        if (nloc == 0u) { xcd_barrier_complete(bar, b.x, nloc, nx); b.st[0] = nloc; b.st[1] = nx; }
        const unsigned old = xb_add(&bar[XB_XSUB(b.x)], 1u);
        const unsigned gen = old / nloc;
        if (old + 1u == (gen + 1u) * nloc) {
            __builtin_amdgcn_fence(__ATOMIC_RELEASE, "agent");
            asm volatile("s_waitcnt vmcnt(0)" ::: "memory");
            const unsigned og = xb_add(&bar[XB_TOP], 1u);
            const unsigned tg = og / nx;
            if (og + 1u == (tg + 1u) * nx) xb_add(&bar[XB_TOPGEN], 1u);
            else XB_SPIN(xb_ld(&bar[XB_TOPGEN]) == tg, bar);
            __builtin_amdgcn_fence(__ATOMIC_ACQUIRE, "agent");
            xb_add(&bar[XB_XGEN(b.x)], 1u);
            asm volatile("s_waitcnt vmcnt(0)" ::: "memory");
        } else {
            XB_SPIN(xb_ld(&bar[XB_XGEN(b.x)]) == gen, bar);
            __builtin_amdgcn_fence(__ATOMIC_ACQUIRE, "agent");
            asm volatile("s_waitcnt vmcnt(0)" ::: "memory");
        }
    }
    __syncthreads();
}

constexpr int NWAVES = 8;
#ifndef MK_PER_PHASE
#define MK_PER_PHASE 0
#endif
constexpr int NPHASE = 22;

constexpr int BATCH = 2, SEQ = 8192, DM = 2048, NTOK = BATCH * SEQ, NH = 16, DH = 128;
constexpr int NSA_N = 5168, NSA_NPAD = 5376, P0LD = 5120;
constexpr int NCMP = 511, NSELB = 128;
constexpr int COL_KC = 2048, COL_VC = 2560, COL_KS = 3072, COL_VS = 3584, COL_KW = 4096, COL_VW = 4608;
constexpr int DSA_N = 2888, DSA_NPAD = 3072, KVR = 256, TOPK = 256;
constexpr int DFF = 5632, NEXP = 8, DFFE = 7168, MOE_ROWS = 34816;
constexpr float ALPHA = 1.41421356237309515f, LN_EPS = 1e-5f, RMS_EPS = 1e-6f;

constexpr size_t MiB = (size_t)1 << 20;
constexpr size_t WS_CTL = 0, CTL_ZERO_BYTES = 128 * 1024;
constexpr size_t WS_W_NSA_IN = 2 * MiB, WS_W_NSA_OUT = 23 * MiB, WS_W_FFN_GU = 31 * MiB, WS_W_FFN_DN = 75 * MiB, WS_W_DSA_IN = 97 * MiB, WS_W_DSA_OUT = 109 * MiB;
constexpr size_t WS_W_CMPK = 117 * MiB, WS_W_CMPV = 118 * MiB, WS_W_UK = 119 * MiB, WS_W_UV = 120 * MiB, WS_CBIAS = 121 * MiB;
constexpr size_t WS_KCMP = 122 * MiB, WS_VCMP = 124 * MiB, WS_GL = 126 * MiB, WS_ROUTE = 129 * MiB;
constexpr size_t WS_KIB = 179 * MiB;
constexpr size_t WS_SELM = 178 * MiB;
constexpr size_t WS_CRAW = 130 * MiB, WS_KIWI = 146 * MiB, WS_IDX = 154 * MiB, WS_CN = 170 * MiB;
constexpr size_t WS_W_MOE_GU = 192 * MiB, WS_W_MOE_DN = 640 * MiB;
constexpr size_t WS_XB = 864 * MiB, WS_XF = 928 * MiB, WS_Z = 1056 * MiB;
constexpr size_t WS_P0 = 1184 * MiB, WS_OATT0 = 1344 * MiB, WS_HFF = 1408 * MiB;
constexpr size_t WS_Q = 1184 * MiB, WS_QI = 1248 * MiB, WS_QLAT = 1264 * MiB, WS_OLAT = 1392 * MiB, WS_OATT1 = 1520 * MiB;
constexpr size_t WS_XG = 1056 * MiB, WS_HM = 1192 * MiB, WS_Y = 192 * MiB;
constexpr size_t WS_END = 1668 * MiB;
static_assert(WS_HM + (size_t)MOE_ROWS * DFFE * 2 <= WS_END, "hm fits");
static_assert(WS_XG + (size_t)MOE_ROWS * DM * 2 <= WS_HM, "xg fits");
static_assert(WS_Y + (size_t)MOE_ROWS * DM * 4 <= WS_W_MOE_DN, "y overlays the dead gate/up weights only");
static_assert(WS_HFF + (size_t)NTOK * DFF * 2 <= WS_END, "hff fits");
constexpr int CW_TMO = 0, CW_CODE = 1;
constexpr int CW_BAR = 4096;
constexpr int CW_MOECNT = 16384;

constexpr int RING_OFF = 0, RING_BYTES = 131072;
constexpr int LDSCTL_OFF = RING_BYTES, MISC_OFF = LDSCTL_OFF + 320;
constexpr int LDS_BYTES = 163840;
constexpr int DSA_SCR = 133120;

struct Frame {
    LAS unsigned char* lds;
    volatile LAS unsigned* MISC;
    gu32* ctl;
    int tid, lane, wave, vcu, G;
};

__device__ __forceinline__ void relaunder(Frame& F) { int t = F.tid; asm volatile("" : "+v"(t)); F.tid = t; F.lane = t & 63; }
__device__ __forceinline__ float bf2f(unsigned short h) { return __uint_as_float(((unsigned)h) << 16); }
__device__ __forceinline__ float bflo(unsigned w) { return __uint_as_float(w << 16); }
__device__ __forceinline__ float bfhi(unsigned w) { return __uint_as_float(w & 0xffff0000u); }
__device__ __forceinline__ float wave_sum(float v) {
#pragma unroll
    for (int o = 1; o < 64; o <<= 1) v += __shfl_xor(v, o);
    return v;
}
__device__ __forceinline__ float wave_max(float v) {
#pragma unroll
    for (int o = 1; o < 64; o <<= 1) v = fmaxf(v, __shfl_xor(v, o));
    return v;
}
__device__ __forceinline__ float dpp_xor1(float v) { return __int_as_float(__builtin_amdgcn_mov_dpp(__float_as_int(v), 0xB1, 0xF, 0xF, true)); }
__device__ __forceinline__ float dpp_xor2(float v) { return __int_as_float(__builtin_amdgcn_mov_dpp(__float_as_int(v), 0x4E, 0xF, 0xF, true)); }
__device__ __forceinline__ float sum_xor32(float v) { auto r = __builtin_amdgcn_permlane32_swap(__float_as_uint(v), __float_as_uint(v), false, false); return __uint_as_float(r[0]) + __uint_as_float(r[1]); }
__device__ __forceinline__ float max_xor32(float v) { auto r = __builtin_amdgcn_permlane32_swap(__float_as_uint(v), __float_as_uint(v), false, false); return fmaxf(__uint_as_float(r[0]), __uint_as_float(r[1])); }
__device__ __forceinline__ float sum_xor16(float v) { auto r = __builtin_amdgcn_permlane16_swap(__float_as_uint(v), __float_as_uint(v), false, false); return __uint_as_float(r[0]) + __uint_as_float(r[1]); }
__device__ __forceinline__ float max_xor16(float v) { auto r = __builtin_amdgcn_permlane16_swap(__float_as_uint(v), __float_as_uint(v), false, false); return fmaxf(__uint_as_float(r[0]), __uint_as_float(r[1])); }
#define WSYNC() do { __builtin_amdgcn_wave_barrier(); asm volatile("s_waitcnt lgkmcnt(0)" ::: "memory"); __builtin_amdgcn_wave_barrier(); } while (0)

__device__ __forceinline__ int rel_bucket(int n) {
    if (n < 16) return n;
    if (n >= 113) return 31;
    int b = 16;
    b += (n >= 19); b += (n >= 21); b += (n >= 24); b += (n >= 27); b += (n >= 31); b += (n >= 35); b += (n >= 40); b += (n >= 46);
    b += (n >= 52); b += (n >= 59); b += (n >= 67); b += (n >= 77); b += (n >= 87); b += (n >= 99);
    return b;
}

struct Args { const float* in[27]; float* out; unsigned char* ws; int ph_lo, ph_hi; };
#ifndef FFN_F8
#define FFN_F8 1
#endif
struct TrItem { const float* W; bf16* WT; int N, K, k0, n0, drow; float f8scale; };
__device__ __forceinline__ void tr_set(TrItem& T, const float* W, int K, int N, int Npad, bf16* WT, int mode, int item, float f8scale = 0.f) {
    T.f8scale = f8scale;
    const int nblk = Npad / 32, kb = item / nblk, nb = item - kb * nblk, n0 = 32 * nb;
    T.W = W; T.WT = WT; T.N = N; T.K = K; T.k0 = 64 * kb; T.n0 = n0; T.drow = (mode == 0) ? n0 : ((n0 >> 7) * 256 + (mode - 1) * 128 + (n0 & 127));
}
constexpr int TR_I_NSA_IN = (DM / 64) * (NSA_NPAD / 32), TR_I_SQ = (DM / 64) * (DM / 32), TR_I_FFN = (DM / 64) * (DFF / 32), TR_I_FFD = (DFF / 64) * (DM / 32), TR_I_DSA_IN = (DM / 64) * (DSA_NPAD / 32);
constexpr int TR_I_CMP = (4096 / 64) * (128 / 32), TR_I_UK1 = (128 / 64) * (256 / 32), TR_I_UV1 = (256 / 64) * (128 / 32);
constexpr int TR_I_MG1 = (DM / 64) * (DFFE / 32), TR_I_MD1 = (DFFE / 64) * (DM / 32);
constexpr int TR_NITEMS = TR_I_NSA_IN + 2 * TR_I_SQ + 2 * TR_I_FFN + TR_I_FFD + TR_I_DSA_IN + 2 * TR_I_CMP + 16 * TR_I_UK1 + 16 * TR_I_UV1 + 16 * TR_I_MG1 + 8 * TR_I_MD1;
__device__ __forceinline__ void tr_decode(const Args& A, unsigned char* ws, int it, TrItem& T) {
    int r = it;
    if (r < TR_I_NSA_IN) { tr_set(T, A.in[2], DM, NSA_N, NSA_NPAD, (bf16*)(ws + WS_W_NSA_IN), 0, r); return; } r -= TR_I_NSA_IN;
    if (r < TR_I_SQ) { tr_set(T, A.in[9], DM, DM, DM, (bf16*)(ws + WS_W_NSA_OUT), 0, r); return; } r -= TR_I_SQ;
    if (r < TR_I_SQ) { tr_set(T, A.in[14], DM, DM, DM, (bf16*)(ws + WS_W_DSA_OUT), 0, r); return; } r -= TR_I_SQ;
    if (r < TR_I_FFN) { tr_set(T, A.in[15], DM, DFF, DFF, (bf16*)(ws + WS_W_FFN_GU), 1, r, FFN_F8 ? 64.f : 0.f); return; } r -= TR_I_FFN;
    if (r < TR_I_FFN) { tr_set(T, A.in[16], DM, DFF, DFF, (bf16*)(ws + WS_W_FFN_GU), 2, r, FFN_F8 ? 64.f : 0.f); return; } r -= TR_I_FFN;
    if (r < TR_I_FFD) { tr_set(T, A.in[17], DFF, DM, DM, (bf16*)(ws + WS_W_FFN_DN), 0, r, FFN_F8 ? 256.f : 0.f); return; } r -= TR_I_FFD;
    if (r < TR_I_DSA_IN) { tr_set(T, A.in[10], DM, DSA_N, DSA_NPAD, (bf16*)(ws + WS_W_DSA_IN), 0, r); return; } r -= TR_I_DSA_IN;
    if (r < TR_I_CMP) { tr_set(T, A.in[4], 4096, 128, 128, (bf16*)(ws + WS_W_CMPK), 0, r); return; } r -= TR_I_CMP;
    if (r < TR_I_CMP) { tr_set(T, A.in[7], 4096, 128, 128, (bf16*)(ws + WS_W_CMPV), 0, r); return; } r -= TR_I_CMP;
    if (r < 16 * TR_I_UK1) { const int h = r / TR_I_UK1; tr_set(T, A.in[12] + (size_t)h * 128 * 256, 128, 256, 256, (bf16*)(ws + WS_W_UK) + (size_t)h * 256 * 128, 0, r - h * TR_I_UK1); return; } r -= 16 * TR_I_UK1;
    if (r < 16 * TR_I_UV1) { const int h = r / TR_I_UV1; tr_set(T, A.in[13] + (size_t)h * 256 * 128, 256, 128, 128, (bf16*)(ws + WS_W_UV) + (size_t)h * 128 * 256, 0, r - h * TR_I_UV1); return; } r -= 16 * TR_I_UV1;
    if (r < 8 * TR_I_MG1) { const int e = r / TR_I_MG1; tr_set(T, A.in[20] + (size_t)e * DM * DFFE, DM, DFFE, DFFE, (bf16*)(ws + WS_W_MOE_GU + (size_t)e * 2 * DFFE * DM), 1, r - e * TR_I_MG1, 64.f); return; } r -= 8 * TR_I_MG1;
    if (r < 8 * TR_I_MG1) { const int e = r / TR_I_MG1; tr_set(T, A.in[21] + (size_t)e * DM * DFFE, DM, DFFE, DFFE, (bf16*)(ws + WS_W_MOE_GU + (size_t)e * 2 * DFFE * DM), 2, r - e * TR_I_MG1, 64.f); return; } r -= 8 * TR_I_MG1;
    { const int e = r / TR_I_MD1; tr_set(T, A.in[22] + (size_t)e * DFFE * DM, DFFE, DM, DM, (bf16*)(ws + WS_W_MOE_DN + (size_t)e * DM * DFFE), 0, r - e * TR_I_MD1, 256.f); }
}
__device__ __forceinline__ void tr_load(const TrItem& T, f32x4 (&v)[8], int lane) {
    const int kr = lane >> 3, c4 = lane & 7, n = T.n0 + 4 * c4;
#pragma unroll
    for (int i = 0; i < 8; ++i) v[i] = (n < T.N) ? *(const f32x4*)(T.W + (size_t)(T.k0 + 8 * i + kr) * T.N + n) : (f32x4){0.f, 0.f, 0.f, 0.f};
}
__device__ __forceinline__ void tr_store(const TrItem& T, const f32x4 (&v)[8], LAS float* scr, int lane) {
    { const int kr = lane >> 3, c4 = lane & 7;
#pragma unroll
      for (int i = 0; i < 8; ++i) { LAS float* d = scr + (8 * i + kr) * 33 + 4 * c4; d[0] = v[i][0]; d[1] = v[i][1]; d[2] = v[i][2]; d[3] = v[i][3]; } }
    LDS_WAIT(); asm volatile("" ::: "memory");
    const int c = lane & 7;
#pragma unroll
    for (int j = 0; j < 4; ++j) { const int n = (lane >> 3) + 8 * j; const LAS float* s = scr + (8 * c) * 33 + n;
        v4u o; o.x = pg8::cvt_pk_bf16(s[0 * 33], s[1 * 33]); o.y = pg8::cvt_pk_bf16(s[2 * 33], s[3 * 33]); o.z = pg8::cvt_pk_bf16(s[4 * 33], s[5 * 33]); o.w = pg8::cvt_pk_bf16(s[6 * 33], s[7 * 33]);
        *(v4u*)(T.WT + (size_t)(T.drow + n) * T.K + T.k0 + 8 * c) = o; }
    LDS_WAIT(); asm volatile("" ::: "memory");
}

__device__ __forceinline__ void tr_store8(const TrItem& T, const f32x4 (&v)[8], LAS float* scr, int lane) {
    { const int kr = lane >> 3, c4 = lane & 7;
#pragma unroll
      for (int i = 0; i < 8; ++i) { LAS float* d = scr + (8 * i + kr) * 33 + 4 * c4; d[0] = v[i][0]; d[1] = v[i][1]; d[2] = v[i][2]; d[3] = v[i][3]; } }
    LDS_WAIT(); asm volatile("" ::: "memory");
    const int c = lane & 3, nr = lane >> 2; const float sc = T.f8scale;
#pragma unroll
    for (int j = 0; j < 2; ++j) { const int n = nr + 16 * j; const LAS float* s = scr + (16 * c) * 33 + n; int w[4];
#pragma unroll
        for (int q = 0; q < 4; ++q) { w[q] = __builtin_amdgcn_cvt_pk_fp8_f32(s[(4 * q) * 33] * sc, s[(4 * q + 1) * 33] * sc, 0, false); w[q] = __builtin_amdgcn_cvt_pk_fp8_f32(s[(4 * q + 2) * 33] * sc, s[(4 * q + 3) * 33] * sc, w[q], true); }
        v4u o; o.x = (unsigned)w[0]; o.y = (unsigned)w[1]; o.z = (unsigned)w[2]; o.w = (unsigned)w[3];
        *(v4u*)((unsigned char*)T.WT + (size_t)(T.drow + n) * T.K + T.k0 + 16 * c) = o; }
    LDS_WAIT(); asm volatile("" ::: "memory");
}
__device__ __forceinline__ void p0_prologue(Frame& F, const Args& A) {
    LAS float* scr = (LAS float*)(F.lds + RING_OFF + F.wave * 16384);
    unsigned char* ws = A.ws;
    const int gw = F.vcu * NWAVES + F.wave, NGW = F.G * NWAVES, lane = F.lane;
    {
        TrItem T0, T1, T2, T3; f32x4 v0[8], v1[8], v2[8], v3[8]; int it = gw;
#define TR_ISSUE(T, v, idx) do { if ((idx) < TR_NITEMS) { tr_decode(A, ws, (idx), T); tr_load(T, v, lane); } } while (0)
#define TR_RETIRE(T, v, idx) do { if ((idx) < TR_NITEMS) { if (T.f8scale != 0.f) tr_store8(T, v, scr, lane); else tr_store(T, v, scr, lane); } } while (0)
        TR_ISSUE(T0, v0, it); TR_ISSUE(T1, v1, it + NGW); TR_ISSUE(T2, v2, it + 2 * NGW);
        while (it < TR_NITEMS) {
            TR_ISSUE(T3, v3, it + 3 * NGW); TR_RETIRE(T0, v0, it);
            TR_ISSUE(T0, v0, it + 4 * NGW); TR_RETIRE(T1, v1, it + NGW);
            TR_ISSUE(T1, v1, it + 5 * NGW); TR_RETIRE(T2, v2, it + 2 * NGW);
            TR_ISSUE(T2, v2, it + 6 * NGW); TR_RETIRE(T3, v3, it + 3 * NGW);
            it += 4 * NGW;
        }
#undef TR_ISSUE
#undef TR_RETIRE
    }
    { const float* x = A.in[0]; bf16* xb = (bf16*)(ws + WS_XB); const size_t n8 = (size_t)NTOK * DM / 8;
      for (size_t i = (size_t)F.vcu * 512 + F.tid; i < n8; i += (size_t)F.G * 512) { const f32x4 a = *(const f32x4*)(x + i * 8), b = *(const f32x4*)(x + i * 8 + 4);
          v4u o; o.x = pk2(a[0], a[1]); o.y = pk2(a[2], a[3]); o.z = pk2(b[0], b[1]); o.w = pk2(b[2], b[3]); *(v4u*)(xb + i * 8) = o; } }
    for (int it = gw; it < 64; it += NGW) { const int kv = it >> 5, ch = it & 31; const float* pe = A.in[kv ? 6 : 3]; const float* w1 = A.in[kv ? 7 : 4];
        float s0 = 0.f, s1 = 0.f;
        for (int k = ch * 128; k < ch * 128 + 128; ++k) { const float p = pe[k]; s0 += p * w1[(size_t)k * 128 + lane]; s1 += p * w1[(size_t)k * 128 + 64 + lane]; }
        float* cb = (float*)(ws + WS_CBIAS) + (size_t)(kv * 32 + ch) * 128; cb[lane] = s0; cb[64 + lane] = s1; }
}

typedef short s8v __attribute__((ext_vector_type(8)));
__device__ __forceinline__ s8v ld_frag(const bf16* p) { return *(const s8v*)p; }

__device__ __forceinline__ float gelu_tanh(float x) { const float u = 0.7978845608028654f * (x + 0.044715f * x * x * x); return 0.5f * x * (1.0f + tanhf(u)); }
__device__ __forceinline__ void p2_compress(Frame& F, const Args& A) {
    unsigned char* ws = A.ws; const int lane = F.lane, wid = F.wave, tid = F.tid;
    const bf16* P0 = (const bf16*)(ws + WS_P0);
    LAS float* part = (LAS float*)(F.lds + RING_OFF);
    LAS float* hid = (LAS float*)(F.lds + DSA_SCR);
    LAS float* cbl = hid + 4096;
    if (tid < 256) { const float* cbp = (const float*)(ws + WS_CBIAS) + (size_t)(tid >> 7) * 32 * 128 + (tid & 127); float cb = 0.f; for (int ch = 0; ch < 32; ++ch) cb += cbp[ch * 128]; cbl[tid] = cb; }
    if (F.vcu < 16 && wid == 0) { bf16* zp = (bf16*)(ws + ((F.vcu & 1) ? WS_VCMP : WS_KCMP)) + ((size_t)(F.vcu >> 1) * 512 + 511) * 128; zp[lane] = 0; zp[64 + lane] = 0; }
    __syncthreads();
    const int r16 = lane & 15, kq = lane >> 4;
    for (int it = F.vcu; it < 256; it += F.G) {
        const int kv = it >> 7, tile = it & 127;
        const bf16* W1T = (const bf16*)(ws + (kv ? WS_W_CMPV : WS_W_CMPK));
        const float* w2 = A.in[kv ? 8 : 5];
        bf16* outp = (bf16*)(ws + (kv ? WS_VCMP : WS_KCMP));
        const int colbase = kv ? COL_VC : COL_KC;
        f32x4 acc[2][8];
#pragma unroll
        for (int m = 0; m < 2; ++m)
#pragma unroll
            for (int n = 0; n < 8; ++n) acc[m][n] = (f32x4){0.f, 0.f, 0.f, 0.f};
        const bf16* arow[2];
#pragma unroll
        for (int m = 0; m < 2; ++m) { int R = tile * 32 + m * 16 + r16; if (R > 4087) R = 4087; const int g = R & 3, bn = R >> 2, b = bn / NCMP, n = bn - b * NCMP;
            arow[m] = P0 + (size_t)(b * SEQ + 16 * n) * P0LD + colbase + g * 128 + kq * 8; }
#pragma unroll 2
        for (int kk = 0; kk < 16; ++kk) {
            const int ks = wid * 16 + kk, l = ks >> 2, d0 = (ks & 3) * 32;
            s8v af[2], bfr[8];
#pragma unroll
            for (int m = 0; m < 2; ++m) af[m] = ld_frag(arow[m] + (size_t)l * P0LD + d0);
#pragma unroll
            for (int n = 0; n < 8; ++n) bfr[n] = ld_frag(W1T + (size_t)(n * 16 + r16) * 4096 + ks * 32 + kq * 8);
#pragma unroll
            for (int m = 0; m < 2; ++m)
#pragma unroll
                for (int n = 0; n < 8; ++n) acc[m][n] = __builtin_amdgcn_mfma_f32_16x16x32_bf16(af[m], bfr[n], acc[m][n], 0, 0, 0);
        }
#pragma unroll
        for (int m = 0; m < 2; ++m)
#pragma unroll
            for (int n = 0; n < 8; ++n)
#pragma unroll
                for (int j = 0; j < 4; ++j) part[wid * 4096 + (m * 16 + kq * 4 + j) * 128 + n * 16 + r16] = acc[m][n][j];
        __syncthreads();
        { const int row = tid >> 4, e0 = (tid & 15) * 8; f32x4 s0 = (f32x4){0.f, 0.f, 0.f, 0.f}, s1 = s0;
#pragma unroll
          for (int w = 0; w < 8; ++w) { s0 += *(const LAS f32x4*)(part + w * 4096 + row * 128 + e0); s1 += *(const LAS f32x4*)(part + w * 4096 + row * 128 + e0 + 4); }
#pragma unroll
          for (int j = 0; j < 4; ++j) { hid[row * 128 + e0 + j] = gelu_tanh(s0[j] + cbl[kv * 128 + e0 + j]); hid[row * 128 + e0 + 4 + j] = gelu_tanh(s1[j] + cbl[kv * 128 + e0 + 4 + j]); } }
        __syncthreads();
        { const int rr = tid >> 4, f0 = (tid & 15) * 8, R = tile * 32 + rr; f32x4 o0 = (f32x4){0.f, 0.f, 0.f, 0.f}, o1 = o0;
#pragma unroll 4
          for (int e = 0; e < 128; ++e) { const float hv = hid[rr * 128 + e]; o0 += *(const f32x4*)(w2 + e * 128 + f0) * hv; o1 += *(const f32x4*)(w2 + e * 128 + f0 + 4) * hv; }
          if (R <= 4087) { const int g = R & 3, bn = R >> 2, b = bn / NCMP, n = bn - b * NCMP;
              v4u o; o.x = pk2(o0[0], o0[1]); o.y = pk2(o0[2], o0[3]); o.z = pk2(o1[0], o1[1]); o.w = pk2(o1[2], o1[3]);
              *(v4u*)(outp + ((size_t)(b * 4 + g) * 512 + n) * 128 + f0) = o; } }
        __syncthreads();
    }
}

namespace fa {
typedef float f32x16 __attribute__((ext_vector_type(16)));
typedef short s16x4 __attribute__((ext_vector_type(4)));
typedef unsigned u32x4v __attribute__((ext_vector_type(4)));
constexpr int SHM_K = 16384, SHM_V = 16384;
constexpr int OFF_V = 0, OFF_K = 2 * SHM_V, OFF_WS = 2 * SHM_V + 2 * SHM_K, OFF_LUT = OFF_WS + 8 * 256, OFF_MASK = OFF_LUT + 144 * 16 * 4, OFF_TAB = OFF_MASK + 1024;
constexpr int TABLD = 130;
constexpr float C2 = 1.4426950408889634f, THR = 8.f;
#define FA_KSWZ(row, colB) ((row) * 256 + ((colB) ^ (((row) & 7) << 4)))
#define FA_SBAR() __builtin_amdgcn_sched_barrier(0)
__device__ __forceinline__ int v_st(int k, int c) { const int kk = (k & ~0xC) | ((k & 4) << 1) | ((k & 8) >> 1); return ((kk >> 3) * 4 + (c >> 5)) * 512 + ((kk & 7) * 32 + (c & 31)) * 2; }
__device__ __forceinline__ int v_rd_base(int lane) { return ((lane & 3) << 3) | (((lane >> 2) & 3) << 6) | (((lane >> 4) & 1) << 5) | (((lane >> 5) & 1) << 8); }
constexpr int v_rd_off(int d0, int ks, int half) { return d0 * 512 + ks * 4096 + half * 2048; }
__device__ __forceinline__ int crow(int r, int hi) { return (r & 3) + 8 * (r >> 2) + 4 * hi; }
__device__ __forceinline__ unsigned cvtpk(float lo, float hi) { unsigned r; asm volatile("v_cvt_pk_bf16_f32 %0, %1, %2" : "=v"(r) : "v"(lo), "v"(hi)); return r; }

__device__ __forceinline__ void qkt(f32x16& p0, f32x16& p1, const LAS char* Kb, int r32, int hi, const bf16x8 (&qr)[8], float init) {
#pragma unroll
    for (int r = 0; r < 16; ++r) { p0[r] = init; p1[r] = init; }
    const LAS char* kb[4];
#pragma unroll
    for (int dd = 0; dd < 4; ++dd) kb[dd] = Kb + FA_KSWZ(r32, (dd * 16 + hi * 8) * 2);
#pragma unroll
    for (int d0 = 0; d0 < 8; ++d0) { const LAS char* a = kb[d0 & 3] + (d0 >> 2) * 128;
        const bf16x8 b0 = *(const LAS bf16x8*)a;
        const bf16x8 b1 = *(const LAS bf16x8*)(a + 32 * 256);
        p0 = __builtin_amdgcn_mfma_f32_32x32x16_bf16(b0, qr[d0], p0, 0, 0, 0);
        p1 = __builtin_amdgcn_mfma_f32_32x32x16_bf16(b1, qr[d0], p1, 0, 0, 0); }
}
__device__ __forceinline__ void pv_tile(f32x16 (&o)[4], int vb0, bf16x8 pa0, bf16x8 pa1, bf16x8 pa2, bf16x8 pa3) {
#define FA_TRRD(dst, off) asm volatile("ds_read_b64_tr_b16 %0, %1 offset:%2" : "=&v"(dst) : "v"(vb0), "i"(off) : "memory")
#define FA_PV_D0(d0) do { s16x4 l0, l1, l2, l3, h0, h1, h2, h3; constexpr int b_ = v_rd_off(d0, 0, 0); \
        FA_TRRD(l0, b_); FA_TRRD(h0, b_ + 2048); FA_TRRD(l1, b_ + 4096); FA_TRRD(h1, b_ + 6144); FA_TRRD(l2, b_ + 8192); FA_TRRD(h2, b_ + 10240); FA_TRRD(l3, b_ + 12288); FA_TRRD(h3, b_ + 14336); \
        asm volatile("s_waitcnt lgkmcnt(0)" ::: "memory"); FA_SBAR(); \
        o[d0] = __builtin_amdgcn_mfma_f32_32x32x16_bf16(pa0, (bf16x8){l0[0], l0[1], l0[2], l0[3], h0[0], h0[1], h0[2], h0[3]}, o[d0], 0, 0, 0); \
        o[d0] = __builtin_amdgcn_mfma_f32_32x32x16_bf16(pa1, (bf16x8){l1[0], l1[1], l1[2], l1[3], h1[0], h1[1], h1[2], h1[3]}, o[d0], 0, 0, 0); \
        o[d0] = __builtin_amdgcn_mfma_f32_32x32x16_bf16(pa2, (bf16x8){l2[0], l2[1], l2[2], l2[3], h2[0], h2[1], h2[2], h2[3]}, o[d0], 0, 0, 0); \
        o[d0] = __builtin_amdgcn_mfma_f32_32x32x16_bf16(pa3, (bf16x8){l3[0], l3[1], l3[2], l3[3], h3[0], h3[1], h3[2], h3[3]}, o[d0], 0, 0, 0); } while (0)
    FA_PV_D0(0); FA_PV_D0(1); FA_PV_D0(2); FA_PV_D0(3);
#undef FA_PV_D0
#undef FA_TRRD
}
__device__ __forceinline__ void partialSM(f32x16& p0, f32x16& p1, float& m_reg, float& alpha) {
    float pmax = p0[0];
#pragma unroll
    for (int r = 1; r < 16; ++r) pmax = fmaxf(pmax, p0[r]);
#pragma unroll
    for (int r = 0; r < 16; ++r) pmax = fmaxf(pmax, p1[r]);
    { auto rr = __builtin_amdgcn_permlane32_swap(__float_as_uint(pmax), __float_as_uint(pmax), false, false); pmax = fmaxf(__uint_as_float(rr[0]), __uint_as_float(rr[1])); }
    float mn;
    if (__all(pmax - m_reg <= THR)) { mn = m_reg; alpha = 1.f; }
    else { mn = fmaxf(m_reg, pmax); alpha = __builtin_amdgcn_exp2f((m_reg - mn) * C2); m_reg = mn; }
    const float mnL = -mn * C2;
#pragma unroll
    for (int r = 0; r < 16; ++r) { p0[r] = __builtin_amdgcn_exp2f(fmaf(p0[r], C2, mnL)); p1[r] = __builtin_amdgcn_exp2f(fmaf(p1[r], C2, mnL)); }
}
__device__ __forceinline__ float finishSM(const f32x16& p0, const f32x16& p1, bf16x8& pa0, bf16x8& pa1, bf16x8& pa2, bf16x8& pa3) {
    float ps = 0.f;
#pragma unroll
    for (int r = 0; r < 16; ++r) ps += p0[r];
#pragma unroll
    for (int r = 0; r < 16; ++r) ps += p1[r];
    { auto rr = __builtin_amdgcn_permlane32_swap(__float_as_uint(ps), __float_as_uint(ps), false, false); ps = __uint_as_float(rr[0]) + __uint_as_float(rr[1]); }
#define FA_PK4(P, B_, OUT) do { unsigned a0 = cvtpk(P[B_ + 0], P[B_ + 1]), a1 = cvtpk(P[B_ + 2], P[B_ + 3]); unsigned b0 = cvtpk(P[B_ + 4], P[B_ + 5]), b1 = cvtpk(P[B_ + 6], P[B_ + 7]); \
        auto r0 = __builtin_amdgcn_permlane32_swap(a0, b0, false, false); auto r1 = __builtin_amdgcn_permlane32_swap(a1, b1, false, false); \
        u32x4v w = {r0[0], r1[0], r0[1], r1[1]}; OUT = *reinterpret_cast<bf16x8*>(&w); } while (0)
    FA_PK4(p0, 0, pa0); FA_PK4(p0, 8, pa1); FA_PK4(p1, 0, pa2); FA_PK4(p1, 8, pa3);
#undef FA_PK4
    return ps;
}
__device__ __forceinline__ void rescale(f32x16 (&o)[4], float alpha, LAS float* al_l, int r32, int hi) {
    if (__any(alpha < 1.f)) { if (hi == 0) al_l[r32] = alpha; asm volatile("s_waitcnt lgkmcnt(0)" ::: "memory");
#pragma unroll
        for (int r = 0; r < 16; ++r) { const float a = al_l[crow(r, hi)];
#pragma unroll
            for (int d = 0; d < 4; ++d) o[d][r] *= a; }
        asm volatile("s_waitcnt lgkmcnt(0)" ::: "memory"); }
}
__device__ __forceinline__ void mask_tile(f32x16& p0, f32x16& p1, int dq, unsigned W) {
    const float NEG = -__builtin_inff();
#pragma unroll
    for (int r = 0; r < 16; ++r) { const int c = (r & 3) + 8 * (r >> 2);
        if ((unsigned)(dq - c) >= W) p0[r] = NEG;
        if ((unsigned)(dq - c - 32) >= W) p1[r] = NEG; }
}
__device__ __forceinline__ void mask_all(f32x16& p0, f32x16& p1, bool keep) {
    const float NEG = -__builtin_inff();
#pragma unroll
    for (int r = 0; r < 16; ++r) { p0[r] = keep ? p0[r] : NEG; p1[r] = keep ? p1[r] : NEG; }
}
__device__ __forceinline__ void bias_near(f32x16& p0, f32x16& p1, int dq, int step, const LAS float* lutcol) {
#pragma unroll
    for (int r = 0; r < 16; ++r) { const int c = (r & 3) + 8 * (r >> 2);
        const int d0 = min(max((dq - c) * step, 0), 128), d1 = min(max((dq - c - 32) * step, 0), 128);
        p0[r] += lutcol[d0]; p1[r] += lutcol[d1]; }
}
struct Stage { bf16x8 k0, k1, v0, v1; };
__device__ __forceinline__ void stage_load(Stage& S, const bf16* Kp, const bf16* Vp, size_t ld, int row0, int maxrow, int sr, int sc) {
    const int ra = min(row0 + sr, maxrow), rb = min(row0 + 32 + sr, maxrow);
    S.k0 = *(const bf16x8*)(Kp + (size_t)ra * ld + sc); S.k1 = *(const bf16x8*)(Kp + (size_t)rb * ld + sc);
    S.v0 = *(const bf16x8*)(Vp + (size_t)ra * ld + sc); S.v1 = *(const bf16x8*)(Vp + (size_t)rb * ld + sc);
}
__device__ __forceinline__ void stage_write(const Stage& S, LAS char* Kb, LAS char* Vb, int kws, int vst0, int vst1) {
    *(LAS bf16x8*)(Kb + kws) = S.k0; *(LAS bf16x8*)(Kb + kws + 32 * 256) = S.k1;
    *(LAS bf16x8*)(Vb + vst0) = S.v0; *(LAS bf16x8*)(Vb + vst1) = S.v1;
}
}

struct NsaLane { int wid, lane, r32, hi, ql, j, sr, sc, kws, vst0, vst1, vrd; };
__device__ __forceinline__ NsaLane nsa_lane(const Frame& F) {
    NsaLane L; L.wid = F.wave; L.lane = F.lane; L.r32 = F.lane & 31; L.hi = F.lane >> 5; L.ql = L.r32 >> 2; L.j = L.r32 & 3;
    L.sr = F.tid >> 4; L.sc = (F.tid & 15) * 8; L.kws = FA_KSWZ(L.sr, L.sc * 2); L.vst0 = fa::v_st(L.sr, L.sc); L.vst1 = fa::v_st(32 + L.sr, L.sc); L.vrd = fa::v_rd_base(F.lane);
    return L;
}
__device__ __forceinline__ void nsa_load_q(bf16x8 (&qr)[8], const bf16* P0, int tok0, int g, const NsaLane& L) {
    const bf16* qp = P0 + (size_t)(tok0 + L.wid * 8 + L.ql) * P0LD + (g * 4 + L.j) * 128 + L.hi * 8;
#pragma unroll
    for (int d0 = 0; d0 < 8; ++d0) qr[d0] = *(const bf16x8*)(qp + d0 * 16);
}
__device__ __forceinline__ void nsa_lut(Frame& F, const Args& A) {
    LAS float* lut = (LAS float*)(F.lds + RING_OFF + fa::OFF_LUT);
    for (int i = F.tid; i < 144 * 16; i += 512) { const int n = i >> 4, h = i & 15; lut[h * 144 + n] = A.in[1][rel_bucket(n) * 16 + h]; }
    __syncthreads();
}
template <int MODE>
__device__ __forceinline__ void nsa_store(const fa::f32x16 (&o)[4], float l_reg, LAS float* li_l, const float* GL, bf16* OACC, bf16* OATT, int tok0, int g, int br, const NsaLane& L) {
    if (L.hi == 0) li_l[L.r32] = l_reg;
    asm volatile("s_waitcnt lgkmcnt(0)" ::: "memory");
    float sc[16];
#pragma unroll
    for (int r = 0; r < 16; ++r) { const int row = fa::crow(r, L.hi), tok = tok0 + L.wid * 8 + (row >> 2), h = g * 4 + (row & 3); sc[r] = GL[(size_t)tok * 48 + h * 3 + br]; }
    unsigned prev[4][16];
    if (MODE != 0) {
#pragma unroll
        for (int r = 0; r < 16; ++r) { const int row = fa::crow(r, L.hi), tok = tok0 + L.wid * 8 + (row >> 2), h = g * 4 + (row & 3); const bf16* ap = OACC + (size_t)tok * DM + h * 128 + (L.r32 & ~1);
#pragma unroll
            for (int d0 = 0; d0 < 4; ++d0) prev[d0][r] = *(const unsigned*)(ap + d0 * 32); } }
#pragma unroll
    for (int r = 0; r < 16; ++r) { const int row = fa::crow(r, L.hi), tok = tok0 + L.wid * 8 + (row >> 2), h = g * 4 + (row & 3);
        const float l = li_l[row]; const float gl = sc[r];
        const float scl = (l > 0.f) ? __builtin_amdgcn_rcpf(l) / (1.0f + __expf(-gl)) : 0.f;
        bf16* dst = ((MODE == 2) ? OATT : OACC) + (size_t)tok * DM + h * 128 + L.r32;
#pragma unroll
        for (int d0 = 0; d0 < 4; ++d0) { float v = o[d0][r] * scl;
            if (MODE != 0) v += (L.r32 & 1) ? bfhi(prev[d0][r]) : bflo(prev[d0][r]);
            const float vn = dpp_xor1(v); if ((L.r32 & 1) == 0) *(unsigned*)(dst + d0 * 32) = fa::cvtpk(v, vn); } }
    asm volatile("s_waitcnt lgkmcnt(0)" ::: "memory");
}

__device__ __forceinline__ void p3a_nsa_cmp(Frame& F, const Args& A) {
    unsigned char* ws = A.ws; const NsaLane L = nsa_lane(F);
    const bf16* P0 = (const bf16*)(ws + WS_P0); const bf16* KCB = (const bf16*)(ws + WS_KCMP); const bf16* VCB = (const bf16*)(ws + WS_VCMP);
    const float* GL = (const float*)(ws + WS_GL); bf16* OACC = (bf16*)(ws + WS_Z + 64 * MiB); unsigned* SELM = (unsigned*)(ws + WS_SELM);
    nsa_lut(F, A);
    LAS char* lds = (LAS char*)(F.lds + RING_OFF);
    LAS float* wsf = (LAS float*)(lds + fa::OFF_WS) + L.wid * 64; LAS float* li_l = wsf; LAS float* al_l = wsf + 32;
    const LAS float* lut = (const LAS float*)(lds + fa::OFF_LUT);
    LAS float* tab = (LAS float*)(lds + fa::OFF_TAB);
    for (int ui = 0; ui < 2 * ((512 - F.vcu + F.G - 1) / F.G); ++ui) {
        const int p = F.vcu + (ui >> 1) * F.G, bg = p >> 6, y = p & 63, qb = (ui & 1) ? 127 - y : y, b = bg >> 2, g = bg & 3;
        const int tok0 = b * SEQ + qb * 64;
        bf16x8 qr[8]; nsa_load_q(qr, P0, tok0, g, L);
        const int trow = qb * 64 + L.wid * 8 + L.ql;
        const int h = g * 4 + L.j; const LAS float* lutcol = lut + h * 144; const float bias_far = lutcol[128];
        const int nmaxrow = (trow >= 31) ? (trow - 31) >> 4 : -1;
        const int NT = (4 * qb + 3 + 63) >> 6;
        const bf16* Kg = KCB + (size_t)(b * 4 + g) * 512 * 128; const bf16* Vg = VCB + (size_t)(b * 4 + g) * 512 * 128;
        for (int i = F.tid; i < 64 * fa::TABLD; i += 512) tab[i] = 0.f;
        float m_reg = -1e30f, l_reg = 0.f;
        fa::Stage S;
        const int rem16 = (trow >= 31) ? ((trow - 31) & 15) : 0;
        fa::stage_load(S, Kg, Vg, 128, 0, 511, L.sr, L.sc); asm volatile("s_waitcnt vmcnt(0)" ::: "memory");
        fa::stage_write(S, lds + fa::OFF_K, lds + fa::OFF_V, L.kws, L.vst0, L.vst1);
        __syncthreads();
#pragma unroll 1
        for (int t = 0; t < NT; ++t) {
            const int buf = t & 1;
            if (t + 1 < NT) fa::stage_load(S, Kg, Vg, 128, (t + 1) * 64, 511, L.sr, L.sc);
            fa::f32x16 p0, p1;
            const bool farT = (qb * 64 + L.wid * 8) - 31 - 16 * (t * 64 + 63) >= 128;
            fa::qkt(p0, p1, lds + fa::OFF_K + buf * fa::SHM_K, L.r32, L.hi, qr, farT ? bias_far : 0.f);
            const int dq = nmaxrow - t * 64 - 4 * L.hi;
            if (!farT) fa::bias_near(p0, p1, dq, 16, lutcol + rem16);
            fa::mask_tile(p0, p1, dq, 0x40000000u);
            float alpha; fa::partialSM(p0, p1, m_reg, alpha);
            float ps = 0.f;
#pragma unroll
            for (int r = 0; r < 16; ++r) ps += p0[r] + p1[r];
            { auto rr = __builtin_amdgcn_permlane32_swap(__float_as_uint(ps), __float_as_uint(ps), false, false); ps = __uint_as_float(rr[0]) + __uint_as_float(rr[1]); }
            l_reg = l_reg * alpha + ps;
            if (t + 1 < NT) { asm volatile("s_waitcnt vmcnt(0)" ::: "memory"); fa::stage_write(S, lds + fa::OFF_K + (buf ^ 1) * fa::SHM_K, lds + fa::OFF_V + (buf ^ 1) * fa::SHM_V, L.kws, L.vst0, L.vst1); }
            __syncthreads();
        }
        fa::f32x16 o[4];
#pragma unroll
        for (int d = 0; d < 4; ++d)
#pragma unroll
            for (int r = 0; r < 16; ++r) o[d][r] = 0.f;
        fa::stage_load(S, Kg, Vg, 128, 0, 511, L.sr, L.sc); asm volatile("s_waitcnt vmcnt(0)" ::: "memory");
        fa::stage_write(S, lds + fa::OFF_K, lds + fa::OFF_V, L.kws, L.vst0, L.vst1);
        __syncthreads();
        const float inv_l = (l_reg > 0.f) ? 1.0f / l_reg : 0.f; const float mnL = -m_reg * fa::C2;
#pragma unroll 1
        for (int t = 0; t < NT; ++t) {
            const int buf = t & 1;
            if (t + 1 < NT) fa::stage_load(S, Kg, Vg, 128, (t + 1) * 64, 511, L.sr, L.sc);
            fa::f32x16 p0, p1;
            const bool farT = (qb * 64 + L.wid * 8) - 31 - 16 * (t * 64 + 63) >= 128;
            fa::qkt(p0, p1, lds + fa::OFF_K + buf * fa::SHM_K, L.r32, L.hi, qr, farT ? bias_far : 0.f);
            const int dq = nmaxrow - t * 64 - 4 * L.hi;
            if (!farT) fa::bias_near(p0, p1, dq, 16, lutcol + rem16);
            fa::mask_tile(p0, p1, dq, 0x40000000u);
#pragma unroll
            for (int r = 0; r < 16; ++r) { p0[r] = __builtin_amdgcn_exp2f(fmaf(p0[r], fa::C2, mnL)) * inv_l; p1[r] = __builtin_amdgcn_exp2f(fmaf(p1[r], fa::C2, mnL)) * inv_l; }
            LAS float* tb = tab + (L.wid * 8 + L.ql) * fa::TABLD + t * 16 + L.hi;
#pragma unroll
            for (int half = 0; half < 2; ++half)
#pragma unroll
                for (int gq = 0; gq < 4; ++gq) { const fa::f32x16& pp = half ? p1 : p0;
                    float s4 = pp[4 * gq] + pp[4 * gq + 1] + pp[4 * gq + 2] + 0.5f * pp[4 * gq + 3], cr = 0.5f * pp[4 * gq + 3];
                    s4 += dpp_xor1(s4); s4 += dpp_xor2(s4); cr += dpp_xor1(cr); cr += dpp_xor2(cr);
                    if (L.j == 0) { __hip_atomic_fetch_add(tb + half * 8 + 2 * gq, s4, __ATOMIC_RELAXED, __HIP_MEMORY_SCOPE_WORKGROUP); __hip_atomic_fetch_add(tb + half * 8 + 2 * gq + 1, cr, __ATOMIC_RELAXED, __HIP_MEMORY_SCOPE_WORKGROUP); } }
            bf16x8 a0, a1, a2, a3; (void)fa::finishSM(p0, p1, a0, a1, a2, a3);
            fa::pv_tile(o, (int)(uintptr_t)(lds + fa::OFF_V + buf * fa::SHM_V) + L.vrd, a0, a1, a2, a3);
            if (t + 1 < NT) { asm volatile("s_waitcnt vmcnt(0)" ::: "memory"); fa::stage_write(S, lds + fa::OFF_K + (buf ^ 1) * fa::SHM_K, lds + fa::OFF_V + (buf ^ 1) * fa::SHM_V, L.kws, L.vst0, L.vst1); }
            __syncthreads();
        }
        nsa_store<0>(o, (l_reg > 0.f) ? 1.0f : 0.f, li_l, GL, OACC, nullptr, tok0, g, 0, L);
        __syncthreads();
        {
            bool s0[8], s1[8];
            if (qb < 16) {
#pragma unroll
                for (int qi = 0; qi < 8; ++qi) { s0[qi] = (L.lane <= qb); s1[qi] = false; }
            } else {
                unsigned k0[8], k1[8], lo[8];
#pragma unroll
                for (int qi = 0; qi < 8; ++qi) { const int ql = L.wid * 8 + qi;
                    const bool c0 = (L.lane >= 1 && L.lane <= qb - 2), c1 = (L.lane + 64 <= qb - 2);
                    k0[qi] = c0 ? __float_as_uint(tab[ql * fa::TABLD + L.lane]) + 1u : 0u; k1[qi] = c1 ? __float_as_uint(tab[ql * fa::TABLD + L.lane + 64]) + 1u : 0u;
                    s0[qi] = (L.lane == 0) || (L.lane == qb) || (L.lane == qb - 1); s1[qi] = (L.lane + 64 == qb) || (L.lane + 64 == qb - 1); lo[qi] = 0u; }
#pragma unroll 1
                for (int bit = 30; bit >= 0; --bit) {
#pragma unroll
                    for (int qi = 0; qi < 8; ++qi) { const unsigned cand = lo[qi] | (1u << bit);
                        const int cnt = __popcll(__ballot(k0[qi] >= cand)) + __popcll(__ballot(k1[qi] >= cand));
                        lo[qi] = (cnt >= 13) ? cand : lo[qi]; } }
#pragma unroll
                for (int qi = 0; qi < 8; ++qi) { const unsigned T = lo[qi];
                    const bool g0 = k0[qi] > T, g1 = k1[qi] > T, e0 = k0[qi] == T, e1 = k1[qi] == T;
                    const int need = 13 - (__popcll(__ballot(g0)) + __popcll(__ballot(g1)));
                    const unsigned long long be0 = __ballot(e0), be1 = __ballot(e1);
                    const int r0 = (int)__builtin_amdgcn_mbcnt_hi((unsigned)(be0 >> 32), __builtin_amdgcn_mbcnt_lo((unsigned)be0, 0u));
                    const int r1 = __popcll(be0) + (int)__builtin_amdgcn_mbcnt_hi((unsigned)(be1 >> 32), __builtin_amdgcn_mbcnt_lo((unsigned)be1, 0u));
                    s0[qi] = s0[qi] || g0 || (e0 && r0 < need); s1[qi] = s1[qi] || g1 || (e1 && r1 < need); }
            }
#pragma unroll
            for (int qi = 0; qi < 8; ++qi) { const int ql = L.wid * 8 + qi; const unsigned long long b0 = __ballot(s0[qi]), b1 = __ballot(s1[qi]);
                if (L.lane == 0) { uint4 mv; mv.x = (unsigned)b0; mv.y = (unsigned)(b0 >> 32); mv.z = (unsigned)b1; mv.w = (unsigned)(b1 >> 32); *(uint4*)(SELM + ((size_t)(tok0 + ql) * 4 + g) * 4) = mv; } }
        }
        __syncthreads();
    }
}
constexpr int N3_OFF_V = 0, N3_OFF_K = 3 * fa::SHM_V, N3_OFF_WS = 3 * fa::SHM_V + 3 * fa::SHM_K, N3_OFF_LUT = N3_OFF_WS + 8 * 256;
__device__ __forceinline__ void nsa_lut3(Frame& F, const Args& A) {
    LAS float* lut = (LAS float*)(F.lds + RING_OFF + N3_OFF_LUT);
    for (int i = F.tid; i < 144 * 16; i += 512) { const int n = i >> 4, h = i & 15; lut[h * 144 + n] = A.in[1][rel_bucket(n) * 16 + h]; }
    __syncthreads();
}
__device__ __forceinline__ void p3b_nsa_sel(Frame& F, const Args& A) {
    unsigned char* ws = A.ws; const NsaLane L = nsa_lane(F);
    const bf16* P0 = (const bf16*)(ws + WS_P0); const float* GL = (const float*)(ws + WS_GL); bf16* OACC = (bf16*)(ws + WS_Z + 64 * MiB); const unsigned* SELM = (const unsigned*)(ws + WS_SELM);
    nsa_lut3(F, A);
    LAS char* lds = (LAS char*)(F.lds + RING_OFF);
    LAS float* wsf = (LAS float*)(lds + N3_OFF_WS) + L.wid * 64; LAS float* li_l = wsf; LAS float* al_l = wsf + 32;
    const LAS float* lut = (const LAS float*)(lds + N3_OFF_LUT);
    const bool grpB = L.wid >= 4;
    for (int ui = 0; ui < 2 * ((512 - F.vcu + F.G - 1) / F.G); ++ui) {
        const int p = F.vcu + (ui >> 1) * F.G, bg = p >> 6, y = p & 63, qb = (ui & 1) ? 127 - y : y, b = bg >> 2, g = bg & 3;
        const int tok0 = b * SEQ + qb * 64;
        bf16x8 qr[8]; nsa_load_q(qr, P0, tok0, g, L);
        const int trow = qb * 64 + L.wid * 8 + L.ql;
        const int h = g * 4 + L.j; const LAS float* lutcol = lut + h * 144; const float bias_far = lutcol[128];
        const uint4 mv = *(const uint4*)(SELM + ((size_t)(tok0 + L.wid * 8 + L.ql) * 4 + g) * 4);
        const bf16* Kg = P0 + (size_t)b * SEQ * P0LD + COL_KS + g * 128; const bf16* Vg = P0 + (size_t)b * SEQ * P0LD + COL_VS + g * 128;
        const int NT = qb + 1;
        float m_reg = -1e30f, l_reg = 0.f; fa::f32x16 o[4];
#pragma unroll
        for (int d = 0; d < 4; ++d)
#pragma unroll
            for (int r = 0; r < 16; ++r) o[d][r] = 0.f;
        fa::Stage S;
        fa::stage_load(S, Kg, Vg, P0LD, 0, SEQ - 1, L.sr, L.sc); asm volatile("s_waitcnt vmcnt(0)" ::: "memory");
        fa::stage_write(S, lds + N3_OFF_K, lds + N3_OFF_V, L.kws, L.vst0, L.vst1);
        __syncthreads();
        bf16x8 a0 = {0, 0, 0, 0, 0, 0, 0, 0}, a1 = a0, a2 = a0, a3 = a0; bool actp = false;
        int bcur = 0, bprev = 2;
#pragma unroll 1
        for (int t = 0; t < NT; ++t) {
            const int bnext = (bcur == 2) ? 0 : bcur + 1;
            if (t + 1 < NT) fa::stage_load(S, Kg, Vg, P0LD, (t + 1) * 64, SEQ - 1, L.sr, L.sc);
            const unsigned word = (t < 32) ? mv.x : (t < 64) ? mv.y : (t < 96) ? mv.z : mv.w;
            const bool mine = ((word >> (t & 31)) & 1u) != 0u;
            const bool act = __any(mine);
            if (grpB && actp) fa::pv_tile(o, (int)(uintptr_t)(lds + N3_OFF_V + bprev * fa::SHM_V) + L.vrd, a0, a1, a2, a3);
            if (act) {
                fa::f32x16 p0, p1;
                const bool farT = (qb * 64 + L.wid * 8) - (t * 64 + 63) >= 128;
                fa::qkt(p0, p1, lds + N3_OFF_K + bcur * fa::SHM_K, L.r32, L.hi, qr, mine ? (farT ? bias_far : 0.f) : -__builtin_inff());
                const int dq = trow - t * 64 - 4 * L.hi;
                if (!farT) fa::bias_near(p0, p1, dq, 1, lutcol);
                if (t == qb) fa::mask_tile(p0, p1, dq, 0x40000000u);
                float alpha; fa::partialSM(p0, p1, m_reg, alpha);
                fa::rescale(o, alpha, al_l, L.r32, L.hi);
                const float ps = fa::finishSM(p0, p1, a0, a1, a2, a3); l_reg = l_reg * alpha + ps;
                if (!grpB) fa::pv_tile(o, (int)(uintptr_t)(lds + N3_OFF_V + bcur * fa::SHM_V) + L.vrd, a0, a1, a2, a3);
            }
            actp = act;
            if (t + 1 < NT) { asm volatile("s_waitcnt vmcnt(0)" ::: "memory"); fa::stage_write(S, lds + N3_OFF_K + bnext * fa::SHM_K, lds + N3_OFF_V + bnext * fa::SHM_V, L.kws, L.vst0, L.vst1); }
            __syncthreads();
            bprev = bcur; bcur = bnext;
        }
        if (grpB && actp) fa::pv_tile(o, (int)(uintptr_t)(lds + N3_OFF_V + bprev * fa::SHM_V) + L.vrd, a0, a1, a2, a3);
        nsa_store<1>(o, l_reg, li_l, GL, OACC, nullptr, tok0, g, 1, L);
        __syncthreads();
    }
}
__device__ __forceinline__ void p3c_nsa_win(Frame& F, const Args& A) {
    unsigned char* ws = A.ws; const NsaLane L = nsa_lane(F);
    const bf16* P0 = (const bf16*)(ws + WS_P0); const float* GL = (const float*)(ws + WS_GL); bf16* OACC = (bf16*)(ws + WS_Z + 64 * MiB); bf16* OATT = (bf16*)(ws + WS_OATT0);
    nsa_lut(F, A);
    LAS char* lds = (LAS char*)(F.lds + RING_OFF);
    LAS float* wsf = (LAS float*)(lds + fa::OFF_WS) + L.wid * 64; LAS float* li_l = wsf; LAS float* al_l = wsf + 32;
    const LAS float* lut = (const LAS float*)(lds + fa::OFF_LUT);
    for (int u = F.vcu; u < 1024; u += F.G) {
        const int bg = u >> 7, qb = u & 127, b = bg >> 2, g = bg & 3;
        const int tok0 = b * SEQ + qb * 64;
        bf16x8 qr[8]; nsa_load_q(qr, P0, tok0, g, L);
        const int trow = qb * 64 + L.wid * 8 + L.ql;
        const int h = g * 4 + L.j; const LAS float* lutcol = lut + h * 144; const float bias_far = lutcol[128];
        const bf16* Kg = P0 + (size_t)b * SEQ * P0LD + COL_KW + g * 128; const bf16* Vg = P0 + (size_t)b * SEQ * P0LD + COL_VW + g * 128;
        const int t0 = max(0, qb - 8), NT = qb - t0 + 1;
        float m_reg = -1e30f, l_reg = 0.f; fa::f32x16 o[4];
#pragma unroll
        for (int d = 0; d < 4; ++d)
#pragma unroll
            for (int r = 0; r < 16; ++r) o[d][r] = 0.f;
        fa::Stage S;
        fa::stage_load(S, Kg, Vg, P0LD, t0 * 64, SEQ - 1, L.sr, L.sc); asm volatile("s_waitcnt vmcnt(0)" ::: "memory");
        fa::stage_write(S, lds + fa::OFF_K, lds + fa::OFF_V, L.kws, L.vst0, L.vst1);
        __syncthreads();
#pragma unroll 1
        for (int tt = 0; tt < NT; ++tt) {
            const int buf = tt & 1, t = t0 + tt;
            if (tt + 1 < NT) fa::stage_load(S, Kg, Vg, P0LD, (t + 1) * 64, SEQ - 1, L.sr, L.sc);
            fa::f32x16 p0, p1;
            const bool farT = (qb * 64 + L.wid * 8) - (t * 64 + 63) >= 128;
            fa::qkt(p0, p1, lds + fa::OFF_K + buf * fa::SHM_K, L.r32, L.hi, qr, farT ? bias_far : 0.f);
            const int dq = trow - t * 64 - 4 * L.hi;
            if (!farT) fa::bias_near(p0, p1, dq, 1, lutcol);
            if (t == qb || t == t0) fa::mask_tile(p0, p1, dq, 512u);
            float alpha; fa::partialSM(p0, p1, m_reg, alpha);
            fa::rescale(o, alpha, al_l, L.r32, L.hi);
            bf16x8 a0, a1, a2, a3; const float ps = fa::finishSM(p0, p1, a0, a1, a2, a3); l_reg = l_reg * alpha + ps;
            fa::pv_tile(o, (int)(uintptr_t)(lds + fa::OFF_V + buf * fa::SHM_V) + L.vrd, a0, a1, a2, a3);
            if (tt + 1 < NT) { asm volatile("s_waitcnt vmcnt(0)" ::: "memory"); fa::stage_write(S, lds + fa::OFF_K + (buf ^ 1) * fa::SHM_K, lds + fa::OFF_V + (buf ^ 1) * fa::SHM_V, L.kws, L.vst0, L.vst1); }
            __syncthreads();
        }
        nsa_store<2>(o, l_reg, li_l, GL, OACC, OATT, tok0, g, 2, L);
        __syncthreads();
    }
}

template <bool ROUTE, bool F8 = false>
__device__ __forceinline__ void ln_phase(Frame& F, const Args& A, const bf16* Z, const float* gam, const float* bet, bf16* XH, unsigned char* X8) {
    const int gw = F.vcu * NWAVES + F.wave, NGW = F.G * NWAVES, lane = F.lane;
    LAS float* wrl = (LAS float*)(F.lds + RING_OFF);
    if (ROUTE) { for (int i = F.tid; i < DM * 8 / 4; i += 512) *(LAS f32x4*)(wrl + i * 4) = *(const f32x4*)(A.in[18] + i * 4); __syncthreads(); }
    for (int row = gw; row < NTOK; row += NGW) {
        const uint2* zr = (const uint2*)(Z + (size_t)row * DM) + lane;
        f32x4 v[8]; float s = 0.f;
#pragma unroll
        for (int j = 0; j < 8; ++j) { const uint2 z2 = zr[64 * j]; v[j] = (f32x4){bflo(z2.x), bfhi(z2.x), bflo(z2.y), bfhi(z2.y)}; s += (v[j][0] + v[j][1]) + (v[j][2] + v[j][3]); }
        const float mean = wave_sum(s) * (1.f / DM); float s2 = 0.f;
#pragma unroll
        for (int j = 0; j < 8; ++j) { v[j] = v[j] - mean; s2 += (v[j][0] * v[j][0] + v[j][1] * v[j][1]) + (v[j][2] * v[j][2] + v[j][3] * v[j][3]); }
        const float rstd = 1.f / sqrtf(wave_sum(s2) * (1.f / DM) + LN_EPS);
        float lg[8];
#pragma unroll
        for (int e = 0; e < 8; ++e) lg[e] = 0.f;
#pragma unroll
        for (int j = 0; j < 8; ++j) { const int c = 4 * lane + 256 * j; const f32x4 gg = *(const f32x4*)(gam + c), bb = *(const f32x4*)(bet + c);
            const f32x4 x = v[j] * rstd * gg + bb;
            { uint2 o; o.x = pk2(x[0], x[1]); o.y = pk2(x[2], x[3]); *(uint2*)(XH + (size_t)row * DM + c) = o; }
            if (F8) { int w = __builtin_amdgcn_cvt_pk_fp8_f32(x[0], x[1], 0, false); w = __builtin_amdgcn_cvt_pk_fp8_f32(x[2], x[3], w, true); *(int*)(X8 + (size_t)row * DM + c) = w; }
            asm volatile("" ::: "memory");
            if (ROUTE) { const LAS float* wr = wrl + c * 8;
#pragma unroll
                for (int q = 0; q < 4; ++q) { const f32x4 w0 = *(const LAS f32x4*)(wr + q * 8), w1 = *(const LAS f32x4*)(wr + q * 8 + 4);
                    lg[0] += x[q] * w0[0]; lg[1] += x[q] * w0[1]; lg[2] += x[q] * w0[2]; lg[3] += x[q] * w0[3]; lg[4] += x[q] * w1[0]; lg[5] += x[q] * w1[1]; lg[6] += x[q] * w1[2]; lg[7] += x[q] * w1[3]; }  asm volatile("" ::: "memory"); }
        }
        if (ROUTE) {
#pragma unroll
            for (int e = 0; e < 8; ++e) lg[e] = wave_sum(lg[e]) + A.in[19][e];
            int e0 = 0; float l0 = lg[0];
#pragma unroll
            for (int e = 1; e < 8; ++e) if (lg[e] > l0) { l0 = lg[e]; e0 = e; }
            int e1 = -1; float l1 = -3e38f;
#pragma unroll
            for (int e = 0; e < 8; ++e) if (e != e0 && lg[e] > l1) { l1 = lg[e]; e1 = e; }
            const float w0 = 1.0f / (1.0f + __expf(l1 - l0)), w1 = 1.0f - w0;
            if (lane == 0) {
                const unsigned p0 = __hip_atomic_fetch_add((unsigned*)(F.ctl + CW_MOECNT + 64 * e0), 1u, __ATOMIC_RELAXED, __HIP_MEMORY_SCOPE_AGENT);
                const unsigned p1 = __hip_atomic_fetch_add((unsigned*)(F.ctl + CW_MOECNT + 64 * e1), 1u, __ATOMIC_RELAXED, __HIP_MEMORY_SCOPE_AGENT);
                int* re = (int*)(A.ws + WS_ROUTE); int* rp = re + 2 * NTOK; float* rw = (float*)(rp + 2 * NTOK);
                re[2 * row] = e0; re[2 * row + 1] = e1; rp[2 * row] = (int)p0; rp[2 * row + 1] = (int)p1; rw[2 * row] = w0; rw[2 * row + 1] = w1;
            }
        }
    }
}

__device__ __forceinline__ void ln_route_phase(Frame& F, const Args& A, const bf16* Z, const float* gam, const float* bet, bf16* XH) {
    const int gw = F.vcu * NWAVES + F.wave, NGW = F.G * NWAVES, lane = F.lane;
    LAS float* wrl = (LAS float*)(F.lds + RING_OFF);
    LAS float* rowb = (LAS float*)(F.lds + RING_OFF + 65536 + F.wave * 8192);
    for (int i = F.tid; i < DM * 8 / 4; i += 512) *(LAS f32x4*)(wrl + i * 4) = *(const f32x4*)(A.in[18] + i * 4);
    __syncthreads();
    for (int row = gw; row < NTOK; row += NGW) {
        float s = 0.f, s2 = 0.f;
#pragma unroll 1
        for (int j = 0; j < 8; ++j) { const uint2 z2 = *(const uint2*)(Z + (size_t)row * DM + 4 * lane + 256 * j); const f32x4 v = (f32x4){bflo(z2.x), bfhi(z2.x), bflo(z2.y), bfhi(z2.y)}; *(LAS f32x4*)(rowb + 4 * lane + 256 * j) = v;
            s += (v[0] + v[1]) + (v[2] + v[3]); }
        const float mean = wave_sum(s) * (1.f / DM);
#pragma unroll 1
        for (int j = 0; j < 8; ++j) { const f32x4 v = *(const LAS f32x4*)(rowb + 4 * lane + 256 * j) - mean; s2 += (v[0] * v[0] + v[1] * v[1]) + (v[2] * v[2] + v[3] * v[3]); }
        const float rstd = 1.f / sqrtf(wave_sum(s2) * (1.f / DM) + LN_EPS);
        float lg[8];
#pragma unroll
        for (int e = 0; e < 8; ++e) lg[e] = 0.f;
#pragma unroll 1
        for (int j = 0; j < 8; ++j) { const int c = 4 * lane + 256 * j; const f32x4 gg = *(const f32x4*)(gam + c), bb = *(const f32x4*)(bet + c);
            const f32x4 x = (*(const LAS f32x4*)(rowb + c) - mean) * rstd * gg + bb;
            { uint2 o; o.x = pk2(x[0], x[1]); o.y = pk2(x[2], x[3]); *(uint2*)(XH + (size_t)row * DM + c) = o; }
            const LAS float* wr = wrl + c * 8;
#pragma unroll
            for (int q = 0; q < 4; ++q) { const f32x4 w0 = *(const LAS f32x4*)(wr + q * 8), w1 = *(const LAS f32x4*)(wr + q * 8 + 4);
                lg[0] += x[q] * w0[0]; lg[1] += x[q] * w0[1]; lg[2] += x[q] * w0[2]; lg[3] += x[q] * w0[3]; lg[4] += x[q] * w1[0]; lg[5] += x[q] * w1[1]; lg[6] += x[q] * w1[2]; lg[7] += x[q] * w1[3]; } }
#pragma unroll
        for (int e = 0; e < 8; ++e) lg[e] = wave_sum(lg[e]) + A.in[19][e];
        int e0 = 0; float l0 = lg[0];
#pragma unroll
        for (int e = 1; e < 8; ++e) if (lg[e] > l0) { l0 = lg[e]; e0 = e; }
        int e1 = -1; float l1 = -3e38f;
#pragma unroll
        for (int e = 0; e < 8; ++e) if (e != e0 && lg[e] > l1) { l1 = lg[e]; e1 = e; }
        const float w0 = 1.0f / (1.0f + __expf(l1 - l0)), w1 = 1.0f - w0;
        if (lane == 0) {
            const unsigned p0 = __hip_atomic_fetch_add((unsigned*)(F.ctl + CW_MOECNT + 64 * e0), 1u, __ATOMIC_RELAXED, __HIP_MEMORY_SCOPE_AGENT);
            const unsigned p1 = __hip_atomic_fetch_add((unsigned*)(F.ctl + CW_MOECNT + 64 * e1), 1u, __ATOMIC_RELAXED, __HIP_MEMORY_SCOPE_AGENT);
            int* re = (int*)(A.ws + WS_ROUTE); int* rp = re + 2 * NTOK; float* rw = (float*)(rp + 2 * NTOK);
            re[2 * row] = e0; re[2 * row + 1] = e1; rp[2 * row] = (int)p0; rp[2 * row + 1] = (int)p1; rw[2 * row] = w0; rw[2 * row + 1] = w1;
        }
        WSYNC();
    }
    __syncthreads();
}

__device__ __forceinline__ void p10_dsa_prep(Frame& F, const Args& A) {
    unsigned char* ws = A.ws; const int lane = F.lane;
    const int gw = F.vcu * NWAVES + F.wave, NGW = F.G * NWAVES;
    { const float* CR = (const float*)(ws + WS_CRAW); bf16* CN = (bf16*)(ws + WS_CN); const f32x4 gg = *(const f32x4*)(A.in[11] + 4 * lane);
      for (int row = gw; row < NTOK; row += NGW) { const f32x4 v = *(const f32x4*)(CR + (size_t)row * KVR + 4 * lane);
          const float ss = wave_sum(v[0] * v[0] + v[1] * v[1] + v[2] * v[2] + v[3] * v[3]); const float r = 1.f / sqrtf(ss * (1.f / KVR) + RMS_EPS);
          uint2 o; o.x = pk2(v[0] * r * gg[0], v[1] * r * gg[1]); o.y = pk2(v[2] * r * gg[2], v[3] * r * gg[3]); *(uint2*)(CN + (size_t)row * KVR + 4 * lane) = o;
          if (lane < 16) { const f32x4 kv = *(const f32x4*)((const float*)(ws + WS_KIWI) + (size_t)row * 128 + 4 * lane); uint2 k2; k2.x = pk2(kv[0], kv[1]); k2.y = pk2(kv[2], kv[3]); *(uint2*)((bf16*)(ws + WS_KIB) + (size_t)row * 64 + 4 * lane) = k2; } } }
    const bf16* Q = (const bf16*)(ws + WS_Q); const bf16* UKT = (const bf16*)(ws + WS_W_UK); bf16* QL = (bf16*)(ws + WS_QLAT);
    const int r16 = lane & 15, kq = lane >> 4; const float sc = 0.08838834764831845f;
    for (int it = gw; it < 512 * 16 * 4; it += NGW) {
        const int nc = it & 3, h = (it >> 2) & 15, mt = it >> 6;
        f32x4 acc[2][4];
#pragma unroll
        for (int m = 0; m < 2; ++m)
#pragma unroll
            for (int n = 0; n < 4; ++n) acc[m][n] = (f32x4){0.f, 0.f, 0.f, 0.f};
#pragma unroll
        for (int ks = 0; ks < 4; ++ks) { s8v af[2], bfr[4];
#pragma unroll
            for (int m = 0; m < 2; ++m) af[m] = ld_frag(Q + (size_t)(mt * 32 + m * 16 + r16) * DM + h * 128 + ks * 32 + kq * 8);
#pragma unroll
            for (int n = 0; n < 4; ++n) bfr[n] = ld_frag(UKT + ((size_t)h * 256 + nc * 64 + n * 16 + r16) * 128 + ks * 32 + kq * 8);
#pragma unroll
            for (int m = 0; m < 2; ++m)
#pragma unroll
                for (int n = 0; n < 4; ++n) acc[m][n] = __builtin_amdgcn_mfma_f32_16x16x32_bf16(bfr[n], af[m], acc[m][n], 0, 0, 0); }
#pragma unroll
        for (int m = 0; m < 2; ++m)
#pragma unroll
            for (int n = 0; n < 4; ++n) { uint2 o; o.x = pg8::cvt_pk_bf16(acc[m][n][0] * sc, acc[m][n][1] * sc); o.y = pg8::cvt_pk_bf16(acc[m][n][2] * sc, acc[m][n][3] * sc);
                *(uint2*)(QL + (size_t)(mt * 32 + m * 16 + r16) * 4096 + h * 256 + nc * 64 + n * 16 + kq * 4) = o; }
    }
}
__device__ __forceinline__ void p12_dsa_uv(Frame& F, const Args& A) {
    unsigned char* ws = A.ws; const int lane = F.lane;
    const int gw = F.vcu * NWAVES + F.wave, NGW = F.G * NWAVES;
    const bf16* OL = (const bf16*)(ws + WS_OLAT); const bf16* UVT = (const bf16*)(ws + WS_W_UV); bf16* O = (bf16*)(ws + WS_OATT1);
    const int r16 = lane & 15, kq = lane >> 4;
    for (int it = gw; it < 512 * 16 * 2; it += NGW) {
        const int nc = it & 1, h = (it >> 1) & 15, mt = it >> 5;
        f32x4 acc[2][4];
#pragma unroll
        for (int m = 0; m < 2; ++m)
#pragma unroll
            for (int n = 0; n < 4; ++n) acc[m][n] = (f32x4){0.f, 0.f, 0.f, 0.f};
#pragma unroll
        for (int ks = 0; ks < 8; ++ks) { s8v af[2], bfr[4];
#pragma unroll
            for (int m = 0; m < 2; ++m) af[m] = ld_frag(OL + (size_t)(mt * 32 + m * 16 + r16) * 4096 + h * 256 + ks * 32 + kq * 8);
#pragma unroll
            for (int n = 0; n < 4; ++n) bfr[n] = ld_frag(UVT + ((size_t)h * 128 + nc * 64 + n * 16 + r16) * 256 + ks * 32 + kq * 8);
#pragma unroll
            for (int m = 0; m < 2; ++m)
#pragma unroll
                for (int n = 0; n < 4; ++n) acc[m][n] = __builtin_amdgcn_mfma_f32_16x16x32_bf16(bfr[n], af[m], acc[m][n], 0, 0, 0); }
#pragma unroll
        for (int m = 0; m < 2; ++m)
#pragma unroll
            for (int n = 0; n < 4; ++n) { uint2 o; o.x = pg8::cvt_pk_bf16(acc[m][n][0], acc[m][n][1]); o.y = pg8::cvt_pk_bf16(acc[m][n][2], acc[m][n][3]);
                *(uint2*)(O + (size_t)(mt * 32 + m * 16 + r16) * DM + h * 128 + nc * 64 + n * 16 + kq * 4) = o; }
    }
}

__device__ __forceinline__ unsigned f2key(float f) { const unsigned u = __float_as_uint(f); return (u & 0x80000000u) ? ~u : (u | 0x80000000u); }

__device__ __forceinline__ unsigned dsa_off_b(unsigned row, unsigned ch) { return 256u * row + 16u * (ch ^ (((row & 3) << 2) | ((row >> 2) & 3))); }

__device__ __forceinline__ float key2f(unsigned k) { return __uint_as_float((k & 0x80000000u) ? (k & 0x7fffffffu) : ~k); }
__device__ __forceinline__ void p13a_dsa_index(Frame& F, const Args& A) {
    unsigned char* ws = A.ws; const int lane = F.lane, wid = F.wave, r32 = lane & 31, hi = lane >> 5;
    const bf16* QI = (const bf16*)(ws + WS_QI); const bf16* KIB = (const bf16*)(ws + WS_KIB); const float* KIWI = (const float*)(ws + WS_KIWI); int* IDX = (int*)(ws + WS_IDX);
    LAS float* sc = (LAS float*)(F.lds + RING_OFF);
    LAS unsigned* hist = (LAS unsigned*)(F.lds + DSA_SCR);
    LAS unsigned* cntG = hist + 1024;
    LAS unsigned* cntE = cntG + 512;
    LAS unsigned* qm = cntE + 512;
    LAS float* mmx = (LAS float*)(qm + 64);
    LAS unsigned* candk = (LAS unsigned*)(mmx + 64);
    constexpr int CAP = 256;
    const int q = wid >> 1, sub = wid & 1, th = sub * 64 + lane;
    for (int slot = F.vcu; slot < NTOK / 4; slot += F.G) {
        const int rowi = slot >> 8; int cc = slot & 255; if (rowi & 1) cc = 255 - cc;
        const int tok0 = (rowi * 256 + cc) * 4, b = tok0 >> 13, t0 = tok0 & (SEQ - 1), tmax = t0 + 3;
        bf16x8 qa[4];
#pragma unroll
        for (int s = 0; s < 4; ++s) qa[s] = *(const bf16x8*)(QI + (size_t)(tok0 + (r32 >> 3)) * 512 + (r32 & 7) * 64 + 16 * s + 8 * hi);
        float wv[16];
#pragma unroll
        for (int r = 0; r < 16; ++r) wv[r] = KIWI[(size_t)(tok0 + (r >> 2)) * 128 + 64 + (r & 3) + 4 * hi] * 0.35355339059327373f;
        const int ntiles = (tmax >> 5) + 1;
        hist[q * 256 + th] = 0u; hist[q * 256 + 128 + th] = 0u; if (th == 0) qm[q * 16 + 2] = 0u;
        float mn0 = 3e38f, mx0 = -3e38f, mn1 = 3e38f, mx1 = -3e38f;
        {
            bf16x8 kb[4], kn[4]; int tile = wid;
#pragma unroll
            for (int s = 0; s < 4; ++s) { kb[s] = (bf16x8){0, 0, 0, 0, 0, 0, 0, 0}; kn[s] = kb[s]; }
            if (tile < ntiles) { const bf16* kp = KIB + (size_t)(b * SEQ + tile * 32 + r32) * 64 + 8 * hi;
#pragma unroll
                for (int s = 0; s < 4; ++s) kb[s] = *(const bf16x8*)(kp + 16 * s); }
            while (tile < ntiles) {
                const int tn = tile + 8;
                if (tn < ntiles) { const bf16* kp = KIB + (size_t)(b * SEQ + tn * 32 + r32) * 64 + 8 * hi;
#pragma unroll
                    for (int s = 0; s < 4; ++s) kn[s] = *(const bf16x8*)(kp + 16 * s); }
                const int key = tile * 32 + r32;
                fa::f32x16 acc;
#pragma unroll
                for (int r = 0; r < 16; ++r) acc[r] = 0.f;
#pragma unroll
                for (int s = 0; s < 4; ++s) acc = __builtin_amdgcn_mfma_f32_32x32x16_bf16(qa[s], kb[s], acc, 0, 0, 0);
                float tot[4];
#pragma unroll
                for (int qq = 0; qq < 4; ++qq) { float part = 0.f;
#pragma unroll
                    for (int r3 = 0; r3 < 4; ++r3) part += wv[4 * qq + r3] * fmaxf(acc[4 * qq + r3], 0.f);
                    tot[qq] = sum_xor32(part) + 0.0f; }
                const float ta = hi ? tot[2] : tot[0], tb = hi ? tot[3] : tot[1];
                sc[(2 * hi) * 8192 + key] = ta; sc[(2 * hi + 1) * 8192 + key] = tb;
                if (key <= t0 + 2 * hi) { mn0 = fminf(mn0, ta); mx0 = fmaxf(mx0, ta); }
                if (key <= t0 + 2 * hi + 1) { mn1 = fminf(mn1, tb); mx1 = fmaxf(mx1, tb); }
#pragma unroll
                for (int s = 0; s < 4; ++s) kb[s] = kn[s];
                tile = tn;
            }
        }
#pragma unroll
        for (int o = 1; o < 32; o <<= 1) { mn0 = fminf(mn0, __shfl_xor(mn0, o)); mx0 = fmaxf(mx0, __shfl_xor(mx0, o)); mn1 = fminf(mn1, __shfl_xor(mn1, o)); mx1 = fmaxf(mx1, __shfl_xor(mx1, o)); }
        if (r32 == 0) { mmx[(wid * 4 + 2 * hi) * 2] = mn0; mmx[(wid * 4 + 2 * hi) * 2 + 1] = mx0; mmx[(wid * 4 + 2 * hi + 1) * 2] = mn1; mmx[(wid * 4 + 2 * hi + 1) * 2 + 1] = mx1; }
        __syncthreads();
        const int tok = tok0 + q, n = t0 + q + 1;
        if (tmax + 1 <= TOPK) {
            for (int i = th; i < TOPK; i += 128) IDX[(size_t)tok * TOPK + i] = (i < n) ? i : 0;
        } else {
            const LAS float* scq = sc + q * 8192; const int nsl = (n + 127) >> 7;
            float fmn = 3e38f, fmx = -3e38f;
#pragma unroll
            for (int w = 0; w < 8; ++w) { fmn = fminf(fmn, mmx[(w * 4 + q) * 2]); fmx = fmaxf(fmx, mmx[(w * 4 + q) * 2 + 1]); }
            const float bsc = (fmx > fmn) ? 255.99f / (fmx - fmn) : 0.f;
            for (int s0 = 0; s0 < nsl; s0 += 8) { float v[8];
#pragma unroll
                for (int j = 0; j < 8; ++j) { const int i = (s0 + j) * 128 + th; v[j] = scq[min(i, n - 1)]; }
#pragma unroll
                for (int j = 0; j < 8; ++j) { const int i = (s0 + j) * 128 + th; const int bin = min(max((int)((v[j] - fmn) * bsc), 0), 255);
                    LAS unsigned* tgt = (i < n) ? &hist[q * 256 + bin] : &qm[q * 16 + 8];
                    __hip_atomic_fetch_add(tgt, 1u, __ATOMIC_RELAXED, __HIP_MEMORY_SCOPE_WORKGROUP); } }
            __syncthreads();
            if (sub == 0) {
                const v4u c4 = *(const LAS v4u*)(hist + q * 256 + 4 * lane); const unsigned s4 = c4.x + c4.y + c4.z + c4.w; unsigned S = s4;
#pragma unroll
                for (int o = 1; o < 64; o <<= 1) { const unsigned v = __shfl_down(S, o); if (lane + o < 64) S += v; }
                const unsigned above = S - s4;
                if (above < (unsigned)TOPK && (unsigned)TOPK <= S) { unsigned cum = above; int bin;
                    if (cum + c4.w >= (unsigned)TOPK) bin = 3; else { cum += c4.w; if (cum + c4.z >= (unsigned)TOPK) bin = 2; else { cum += c4.z; if (cum + c4.y >= (unsigned)TOPK) bin = 1; else { cum += c4.y; bin = 0; } } }
                    qm[q * 16 + 0] = (unsigned)(4 * lane + bin); qm[q * 16 + 1] = (unsigned)TOPK - cum; }
            }
            __syncthreads();
            const int bstar = (int)qm[q * 16 + 0]; const unsigned need1 = qm[q * 16 + 1];
            for (int s0 = 0; s0 < nsl; s0 += 8) { float v[8];
#pragma unroll
                for (int j = 0; j < 8; ++j) { const int i = (s0 + j) * 128 + th; v[j] = scq[min(i, n - 1)]; }
#pragma unroll
                for (int j = 0; j < 8; ++j) { const int i = (s0 + j) * 128 + th; const int bin = min(max((int)((v[j] - fmn) * bsc), 0), 255);
                    if (i < n && bin == bstar) { const unsigned pc = __hip_atomic_fetch_add(&qm[q * 16 + 2], 1u, __ATOMIC_RELAXED, __HIP_MEMORY_SCOPE_WORKGROUP); if (pc < (unsigned)CAP) candk[q * CAP + pc] = f2key(v[j]); } } }
            __syncthreads();
            if (sub == 0) {
                const unsigned mc = qm[q * 16 + 2]; unsigned T = 0u, nt = 0u; bool found = false;
                if (mc <= (unsigned)CAP) {
                    unsigned kc[4], gt[4], ge[4];
#pragma unroll
                    for (int c = 0; c < 4; ++c) { kc[c] = (lane + 64 * c < (int)mc) ? candk[q * CAP + lane + 64 * c] : 0u; gt[c] = 0u; ge[c] = 0u; }
                    for (unsigned j = 0; j < mc; ++j) { const unsigned kj = candk[q * CAP + j];
#pragma unroll
                        for (int c = 0; c < 4; ++c) { gt[c] += (kj > kc[c]) ? 1u : 0u; ge[c] += (kj >= kc[c]) ? 1u : 0u; } }
#pragma unroll
                    for (int c = 0; c < 4; ++c) if (lane + 64 * c < (int)mc && gt[c] < need1 && need1 <= ge[c]) { T = kc[c]; nt = need1 - gt[c]; found = true; }
                } else {
                    unsigned lo = 0u;
                    for (int bit = 31; bit >= 0; --bit) { const unsigned cand = lo | (1u << bit); unsigned c = 0u;
                        for (int i = lane; i < n; i += 64) c += (f2key(scq[i]) >= cand) ? 1u : 0u;
#pragma unroll
                        for (int o = 1; o < 64; o <<= 1) c += __shfl_xor(c, o);
                        if (c >= (unsigned)TOPK) lo = cand; }
                    unsigned cg = 0u;
                    for (int i = lane; i < n; i += 64) cg += (f2key(scq[i]) > lo) ? 1u : 0u;
#pragma unroll
                    for (int o = 1; o < 64; o <<= 1) cg += __shfl_xor(cg, o);
                    T = lo; nt = (unsigned)TOPK - cg; found = (lane == 0);
                }
                if (found) { qm[q * 16 + 0] = T; qm[q * 16 + 1] = nt; }
            }
            __syncthreads();
            const unsigned T = qm[q * 16 + 0], need = qm[q * 16 + 1];
            unsigned Gs = 0u, Es = 0u;
            for (int s0 = 0; s0 < nsl; s0 += 8) { float v[8];
#pragma unroll
                for (int j = 0; j < 8; ++j) { const int i = (s0 + j) * 128 + th; v[j] = scq[min(i, n - 1)]; }
#pragma unroll
                for (int j = 0; j < 8; ++j) { const int i = (s0 + j) * 128 + th; const bool ok = i < n; const unsigned k = f2key(v[j]);
                    Gs += (unsigned)__popcll(__ballot(ok && k > T)); Es += (unsigned)__popcll(__ballot(ok && k == T)); } }
            if (lane == 0) { qm[q * 16 + 10 + sub * 2] = Gs; qm[q * 16 + 11 + sub * 2] = Es; }
            __syncthreads();
            const unsigned G0 = qm[q * 16 + 10], E0 = qm[q * 16 + 11], E1 = qm[q * 16 + 13];
            bool slow = false;
#pragma unroll
            for (int qx = 0; qx < 4; ++qx) slow = slow || (qm[qx * 16 + 11] + qm[qx * 16 + 13] != qm[qx * 16 + 1]);
            (void)E1;
            if (!slow) {
                unsigned run = sub ? (G0 + E0) : 0u;
                for (int s0 = 0; s0 < nsl; s0 += 8) { float v[8];
#pragma unroll
                    for (int j = 0; j < 8; ++j) { const int i = (s0 + j) * 128 + th; v[j] = scq[min(i, n - 1)]; }
#pragma unroll
                    for (int j = 0; j < 8; ++j) { const int i = (s0 + j) * 128 + th; const bool sel = (i < n) && f2key(v[j]) >= T; const unsigned long long bs = __ballot(sel);
                        const unsigned pos = run + __builtin_amdgcn_mbcnt_hi((unsigned)(bs >> 32), __builtin_amdgcn_mbcnt_lo((unsigned)bs, 0u));
                        if (sel && pos < (unsigned)TOPK) candk[q * CAP + pos] = (unsigned)i; run += (unsigned)__popcll(bs); } }
            } else {
            unsigned myG = 0u, myE = 0u;
            for (int s0 = 0; s0 < nsl; s0 += 8) { float v[8];
#pragma unroll
                for (int j = 0; j < 8; ++j) { const int i = (s0 + j) * 128 + th; v[j] = scq[min(i, n - 1)]; }
#pragma unroll
                for (int j = 0; j < 8; ++j) { const int s2 = s0 + j, i = s2 * 128 + th; const bool ok = i < n; const unsigned k = f2key(v[j]); const unsigned long long bg = __ballot(ok && k > T), be = __ballot(ok && k == T);
                    const unsigned cg = (unsigned)__popcll(bg), ce = (unsigned)__popcll(be); myG = (lane == s2) ? cg : myG; myE = (lane == s2) ? ce : myE; } }
            cntG[(q * 2 + sub) * 64 + lane] = myG; cntE[(q * 2 + sub) * 64 + lane] = myE;
            __syncthreads();
            unsigned tbase, pbase;
            { const unsigned e0 = cntE[(q * 2) * 64 + lane], e1 = cntE[(q * 2 + 1) * 64 + lane], g0 = cntG[(q * 2) * 64 + lane], g1 = cntG[(q * 2 + 1) * 64 + lane];
              unsigned inc = e0 + e1;
#pragma unroll
              for (int o = 1; o < 64; o <<= 1) { const unsigned v = __shfl_up(inc, o); if (lane >= o) inc += v; }
              const unsigned tb0 = inc - (e0 + e1), tb1 = tb0 + e0;
              const unsigned se0 = (need > tb0) ? min(need - tb0, e0) : 0u, se1 = (need > tb1) ? min(need - tb1, e1) : 0u;
              const unsigned c0 = g0 + se0, c1 = g1 + se1; unsigned inc2 = c0 + c1;
#pragma unroll
              for (int o = 1; o < 64; o <<= 1) { const unsigned v = __shfl_up(inc2, o); if (lane >= o) inc2 += v; }
              const unsigned pb0 = inc2 - (c0 + c1);
              tbase = sub ? tb1 : tb0; pbase = sub ? pb0 + c0 : pb0; }
            for (int s0 = 0; s0 < nsl; s0 += 8) { float v[8];
#pragma unroll
                for (int j = 0; j < 8; ++j) { const int i = (s0 + j) * 128 + th; v[j] = scq[min(i, n - 1)]; }
#pragma unroll
                for (int j = 0; j < 8; ++j) { const int s2 = s0 + j; if (s2 < nsl) { const int i = s2 * 128 + th; const bool ok = i < n; const unsigned k = f2key(v[j]); const bool g = ok && k > T, e = ok && k == T;
                    const unsigned long long be = __ballot(e);
                    const unsigned trank = (unsigned)__builtin_amdgcn_readlane((int)tbase, s2) + __builtin_amdgcn_mbcnt_hi((unsigned)(be >> 32), __builtin_amdgcn_mbcnt_lo((unsigned)be, 0u));
                    const bool sel = g || (e && trank < need);
                    const unsigned long long bs = __ballot(sel);
                    const unsigned pos = (unsigned)__builtin_amdgcn_readlane((int)pbase, s2) + __builtin_amdgcn_mbcnt_hi((unsigned)(bs >> 32), __builtin_amdgcn_mbcnt_lo((unsigned)bs, 0u));
                    if (sel && pos < (unsigned)TOPK) candk[q * CAP + pos] = (unsigned)i; } } }
            }
        }
        __syncthreads();
        if (tmax + 1 > TOPK) { for (int i = th; i < TOPK; i += 128) IDX[(size_t)tok * TOPK + i] = (int)candk[q * CAP + i]; }
    }
}

__device__ __forceinline__ void p13b_dsa_attn(Frame& F, const Args& A) {
    unsigned char* ws = A.ws; const int lane = F.lane, wid = F.wave, c16 = lane & 15, g4 = lane >> 4;
    const bf16* CN = (const bf16*)(ws + WS_CN); const bf16* QL = (const bf16*)(ws + WS_QLAT); const int* IDX = (const int*)(ws + WS_IDX); bf16* OL = (bf16*)(ws + WS_OLAT);
    LAS float* lut = (LAS float*)(F.lds + DSA_SCR + 8192);
    for (int i = F.tid; i < 144 * 16; i += 512) { const int n = i >> 4, h = i & 15; lut[i] = A.in[1][rel_bucket(n) * 16 + h]; }
    __syncthreads();
    LAS char* img = (LAS char*)(F.lds + RING_OFF + wid * 16384);
    LAS int* idxw = (LAS int*)(F.lds + DSA_SCR + wid * 1024);
    const unsigned imgb = (unsigned)(uintptr_t)img;
    const int gw = F.vcu * NWAVES + wid, NGW = F.G * NWAVES;
    const unsigned prow0 = 8u * ((lane >> 2) & 3) + (lane & 3);
    unsigned ta0[8], ta1[8];
    { const unsigned qq = (lane & 15) >> 2, pp = lane & 3;
#pragma unroll
      for (int c = 0; c < 8; ++c) { ta0[c] = imgb + dsa_off_b(8 * g4 + qq, 2 * c + (pp >> 1)) + 8 * (pp & 1); ta1[c] = imgb + dsa_off_b(8 * g4 + 4 + qq, 2 * c + (pp >> 1)) + 8 * (pp & 1); } }
    for (int tok = gw; tok < NTOK; tok += NGW) {
        const int b = tok >> 13, t = tok & (SEQ - 1), cnt = min(TOPK, t + 1), ntile = (cnt + 31) >> 5;
        bf16x8 qb[8];
#pragma unroll
        for (int ks = 0; ks < 8; ++ks) qb[ks] = *(const bf16x8*)(QL + (size_t)tok * 4096 + c16 * 256 + ks * 32 + g4 * 8);
#pragma unroll
        for (int i = 0; i < 4; ++i) idxw[lane + 64 * i] = IDX[(size_t)tok * TOPK + lane + 64 * i];
        WSYNC();
        f32x4 o[16];
#pragma unroll
        for (int ct = 0; ct < 16; ++ct) o[ct] = (f32x4){0.f, 0.f, 0.f, 0.f};
        float m_run = -1e30f, l_run = 0.f;
        const LAS float* lutcol = lut + c16;
#pragma unroll 1
        for (int tile = 0; tile < ntile; ++tile) {
            { v4u st[16];
#pragma unroll
              for (int i = 0; i < 16; ++i) { const int nn = lane + 64 * i, row = nn >> 5, chg = nn & 31; const int key = idxw[tile * 32 + row];
                  st[i] = *(const v4u*)(CN + (size_t)(b * SEQ + key) * KVR + chg * 8); }
#pragma unroll
              for (int i = 0; i < 16; ++i) { const int nn = lane + 64 * i, row = nn >> 5, chg = nn & 31;
                  *(LAS v4u*)(img + (chg >> 4) * 8192 + dsa_off_b(row, chg & 15)) = st[i]; } }
            WSYNC();
            f32x4 sacc[2];
#pragma unroll
            for (int T = 0; T < 2; ++T) { sacc[T] = (f32x4){0.f, 0.f, 0.f, 0.f};
#pragma unroll
                for (int ks = 0; ks < 8; ++ks) { const bf16x8 a = *(const LAS bf16x8*)(img + (ks >> 2) * 8192 + dsa_off_b(prow0 + 4 * T, 4 * (ks & 3) + g4));
                    sacc[T] = __builtin_amdgcn_mfma_f32_16x16x32_bf16(a, qb[ks], sacc[T], 0, 0, 0); } }
            float pmax = -__builtin_inff();
#pragma unroll
            for (int T = 0; T < 2; ++T) { const int i0 = tile * 32 + 8 * g4 + 4 * T; const v4u kk = *(const LAS v4u*)(idxw + i0);
                const int kidx[4] = {(int)kk.x, (int)kk.y, (int)kk.z, (int)kk.w};
#pragma unroll
                for (int e = 0; e < 4; ++e) { const int dist = min(max(t - kidx[e], 0), 128); float s = sacc[T][e] + lutcol[dist * 16];
                    s = (i0 + e < cnt) ? s : -__builtin_inff(); sacc[T][e] = s; pmax = fmaxf(pmax, s); } }
            pmax = max_xor16(pmax); pmax = max_xor32(pmax);
            const float mn = fmaxf(m_run, pmax), alpha = __builtin_amdgcn_exp2f((m_run - mn) * fa::C2); m_run = mn;
            float ps = 0.f;
#pragma unroll
            for (int T = 0; T < 2; ++T)
#pragma unroll
                for (int e = 0; e < 4; ++e) { const float pv = __builtin_amdgcn_exp2f((sacc[T][e] - mn) * fa::C2); sacc[T][e] = pv; ps += pv; }
            ps = sum_xor16(ps); ps = sum_xor32(ps);
            l_run = l_run * alpha + ps;
            if (__any(alpha < 1.f)) {
                float al[4];
#pragma unroll
                for (int e = 0; e < 4; ++e) al[e] = __shfl(alpha, 4 * g4 + e);
#pragma unroll
                for (int ct = 0; ct < 16; ++ct)
#pragma unroll
                    for (int e = 0; e < 4; ++e) o[ct][e] *= al[e];
            }
            fa::u32x4v pw; pw.x = fa::cvtpk(sacc[0][0], sacc[0][1]); pw.y = fa::cvtpk(sacc[0][2], sacc[0][3]); pw.z = fa::cvtpk(sacc[1][0], sacc[1][1]); pw.w = fa::cvtpk(sacc[1][2], sacc[1][3]);
            const bf16x8 pa = *reinterpret_cast<bf16x8*>(&pw);
#pragma unroll
            for (int cg = 0; cg < 4; ++cg) { fa::s16x4 b0[4], b1[4];
                asm volatile("ds_read_b64_tr_b16 %0, %8 offset:%c16\n\tds_read_b64_tr_b16 %1, %9 offset:%c16\n\tds_read_b64_tr_b16 %2, %10 offset:%c16\n\tds_read_b64_tr_b16 %3, %11 offset:%c16\n\t"
                             "ds_read_b64_tr_b16 %4, %12 offset:%c16\n\tds_read_b64_tr_b16 %5, %13 offset:%c16\n\tds_read_b64_tr_b16 %6, %14 offset:%c16\n\tds_read_b64_tr_b16 %7, %15 offset:%c16\n\ts_waitcnt lgkmcnt(0)"
                             : "=&v"(b0[0]), "=&v"(b1[0]), "=&v"(b0[1]), "=&v"(b1[1]), "=&v"(b0[2]), "=&v"(b1[2]), "=&v"(b0[3]), "=&v"(b1[3])
                             : "v"(ta0[(cg & 1) * 4 + 0]), "v"(ta1[(cg & 1) * 4 + 0]), "v"(ta0[(cg & 1) * 4 + 1]), "v"(ta1[(cg & 1) * 4 + 1]), "v"(ta0[(cg & 1) * 4 + 2]), "v"(ta1[(cg & 1) * 4 + 2]), "v"(ta0[(cg & 1) * 4 + 3]), "v"(ta1[(cg & 1) * 4 + 3]), "i"((cg >> 1) * 8192) : "memory");
                FA_SBAR();
#pragma unroll
                for (int k = 0; k < 4; ++k) o[cg * 4 + k] = __builtin_amdgcn_mfma_f32_16x16x32_bf16(pa, (bf16x8){b0[k][0], b0[k][1], b0[k][2], b0[k][3], b1[k][0], b1[k][1], b1[k][2], b1[k][3]}, o[cg * 4 + k], 0, 0, 0); }
            WSYNC();
        }
        { const float il = (l_run > 0.f) ? 1.0f / l_run : 0.f; float ile[4];
#pragma unroll
          for (int e = 0; e < 4; ++e) ile[e] = __shfl(il, 4 * g4 + e);
#pragma unroll
          for (int ct = 0; ct < 16; ++ct)
#pragma unroll
              for (int e = 0; e < 4; ++e) { const float v = o[ct][e] * ile[e]; const float vn = dpp_xor1(v);
                  if ((lane & 1) == 0) *(unsigned*)(OL + (size_t)tok * 4096 + (4 * g4 + e) * 256 + ct * 16 + c16) = fa::cvtpk(v, vn); } }
        WSYNC();
    }
    __syncthreads();
}

struct MoeTiles { int tend[8]; int pstart[8]; int MT; };
__device__ __forceinline__ void moe_tiles(Frame& F, MoeTiles& T) {
    int acc = 0;
#pragma unroll
    for (int e = 0; e < 8; ++e) { const int c = (int)__builtin_amdgcn_readfirstlane(__hip_atomic_load((unsigned*)(F.ctl + CW_MOECNT + 64 * e), __ATOMIC_RELAXED, __HIP_MEMORY_SCOPE_AGENT));
        T.pstart[e] = acc * 256; acc += (c + 255) >> 8; T.tend[e] = acc; }
    T.MT = acc;
}
__device__ __forceinline__ void p15_gather(Frame& F, const Args& A) {
    MoeTiles T; moe_tiles(F, T);
    const int gw = F.vcu * NWAVES + F.wave, NGW = F.G * NWAVES, lane = F.lane;
    const bf16* XH = (const bf16*)(A.ws + WS_XF); unsigned char* XG = (unsigned char*)(A.ws + WS_XG);
    const int* re = (const int*)(A.ws + WS_ROUTE); const int* rp = re + 2 * NTOK;
    for (int tok = gw; tok < NTOK; tok += NGW) {
        v4u v[2];
#pragma unroll
        for (int j = 0; j < 2; ++j) { const bf16* src = XH + (size_t)tok * DM + 16 * lane + 1024 * j; int w[4];
#pragma unroll
            for (int q = 0; q < 4; ++q) { const uint2 xx = *(const uint2*)(src + 4 * q); w[q] = __builtin_amdgcn_cvt_pk_fp8_f32(bflo(xx.x), bfhi(xx.x), 0, false); w[q] = __builtin_amdgcn_cvt_pk_fp8_f32(bflo(xx.y), bfhi(xx.y), w[q], true); }
            v[j].x = (unsigned)w[0]; v[j].y = (unsigned)w[1]; v[j].z = (unsigned)w[2]; v[j].w = (unsigned)w[3]; }
#pragma unroll
        for (int s = 0; s < 2; ++s) { const int e = re[2 * tok + s], p = rp[2 * tok + s]; int ps = 0;
#pragma unroll
            for (int q = 0; q < 8; ++q) ps = (q == e) ? T.pstart[q] : ps;
            unsigned char* dst = XG + (size_t)(ps + p) * DM + 16 * lane;
#pragma unroll
            for (int j = 0; j < 2; ++j) *(v4u*)(dst + 1024 * j) = v[j]; }
    }
}
__device__ __forceinline__ void p18_final(Frame& F, const Args& A) {
    MoeTiles T; moe_tiles(F, T);
    const int gw = F.vcu * NWAVES + F.wave, NGW = F.G * NWAVES, lane = F.lane;
    const bf16* XH = (const bf16*)(A.ws + WS_XF); const bf16* Y = (const bf16*)(A.ws + WS_Y);
    const int* re = (const int*)(A.ws + WS_ROUTE); const int* rp = re + 2 * NTOK; const float* rw = (const float*)(rp + 2 * NTOK);
    const float* gam = A.in[25] + DM; const float* bet = A.in[26] + DM;
    for (int tok = gw; tok < NTOK; tok += NGW) {
        int rows[2]; float w[2];
#pragma unroll
        for (int s = 0; s < 2; ++s) { const int e = re[2 * tok + s]; int ps = 0;
#pragma unroll
            for (int q = 0; q < 8; ++q) ps = (q == e) ? T.pstart[q] : ps;
            rows[s] = ps + rp[2 * tok + s]; w[s] = rw[2 * tok + s]; }
        const uint2* xr = (const uint2*)(XH + (size_t)tok * DM) + lane; const uint2* y0 = (const uint2*)(Y + (size_t)rows[0] * DM) + lane; const uint2* y1 = (const uint2*)(Y + (size_t)rows[1] * DM) + lane;
        f32x4 v[8]; float s = 0.f;
#pragma unroll
        for (int j = 0; j < 8; ++j) { const uint2 a = y0[64 * j], bq = y1[64 * j]; const f32x4 ya = (f32x4){bflo(a.x), bfhi(a.x), bflo(a.y), bfhi(a.y)}, yb = (f32x4){bflo(bq.x), bfhi(bq.x), bflo(bq.y), bfhi(bq.y)};
            const uint2 xq = xr[64 * j]; const f32x4 xv = (f32x4){bflo(xq.x), bfhi(xq.x), bflo(xq.y), bfhi(xq.y)};
            v[j] = xv * ALPHA + ya * w[0] + yb * w[1]; s += (v[j][0] + v[j][1]) + (v[j][2] + v[j][3]); }
        const float mean = wave_sum(s) * (1.f / DM); float s2 = 0.f;
#pragma unroll
        for (int j = 0; j < 8; ++j) { v[j] = v[j] - mean; s2 += (v[j][0] * v[j][0] + v[j][1] * v[j][1]) + (v[j][2] * v[j][2] + v[j][3] * v[j][3]); }
        const float rstd = 1.f / sqrtf(wave_sum(s2) * (1.f / DM) + LN_EPS);
#pragma unroll
        for (int j = 0; j < 8; ++j) { const int c = 4 * lane + 256 * j; const f32x4 gg = *(const f32x4*)(gam + c), bb = *(const f32x4*)(bet + c);
            *(f32x4*)(A.out + (size_t)tok * DM + c) = v[j] * rstd * gg + bb; }
    }
}

__global__ void __launch_bounds__(NWAVES * 64, 2) mega_fwd(Args args) {
    extern __shared__ __attribute__((aligned(16))) unsigned char lds[];
    Frame F;
    F.lds = (LAS unsigned char*)lds;
    F.MISC = (volatile LAS unsigned*)(F.lds + MISC_OFF);
    F.tid = threadIdx.x; F.lane = F.tid & 63; F.wave = __builtin_amdgcn_readfirstlane(F.tid >> 6);
    F.G = gridDim.x; { const int bx = blockIdx.x; F.vcu = (F.G % 8 == 0) ? (bx % 8) * (F.G / 8) + bx / 8 : bx; }
    unsigned char* ws = args.ws;
    F.ctl = (gu32*)(ws + WS_CTL);
    for (int u = F.tid; u < (LDS_BYTES - LDSCTL_OFF) / 4; u += NWAVES * 64) ((LAS unsigned*)(F.lds + LDSCTL_OFF))[u] = 0u;
    __syncthreads();
    XcdBarrier bar; bar.bar = (unsigned*)(F.ctl + CW_BAR); bar.x = 0; bar.st = nullptr;
#if !MK_PER_PHASE
    bar = xcd_barrier_post((unsigned*)(F.ctl + CW_BAR), F.MISC + 8);
#define GRID_BAR() xcd_barrier(bar)
#else
#define GRID_BAR() do { } while (0)
#endif
    const int lo = args.ph_lo, hi = args.ph_hi;
#ifndef PH_MASK
#define PH_MASK 0x3fffff
#endif
#define IN(k) (((PH_MASK >> (k)) & 1) && lo <= (k) && (k) < hi)
#define BOTH(k) (IN(k) && IN((k) + 1))
    bf16* XB = (bf16*)(ws + WS_XB); bf16* XH = (bf16*)(ws + WS_XF); bf16* Z = (bf16*)(ws + WS_Z);

#ifndef PROBE_MASK
#define PROBE_MASK 0
#endif
#define REPS(k) ((((PROBE_MASK) >> (k)) & 1) ? 2 : 1)
    if (IN(0)) for (int rep_ = 0; rep_ < REPS(0); ++rep_) { relaunder(F); p0_prologue(F, args); if (BOTH(0) || rep_ + 1 < REPS(0)) GRID_BAR(); }
    if (IN(1)) for (int rep_ = 0; rep_ < REPS(1); ++rep_) { relaunder(F);
        pg8::Gemm g{XB, (const bf16*)(ws + WS_W_NSA_IN), NTOK, NSA_NPAD, DM}; pg8::StaticOrder S; S.init(NTOK, NSA_NPAD, F.G, (int)blockIdx.x);
        pg8::EpiNsaIn E{(bf16*)(ws + WS_P0), (float*)(ws + WS_GL), 0.08838834764831845f};
        pg8::gemm_phase<pg8::EpiNsaIn, pg8::StaticOrder, true, true>(F.lds + RING_OFF, g, S, E);
        if (BOTH(1) || rep_ + 1 < REPS(1)) GRID_BAR();
    }
    if (IN(2)) for (int rep_ = 0; rep_ < REPS(2); ++rep_) { relaunder(F); p2_compress(F, args); if (BOTH(2) || rep_ + 1 < REPS(2)) GRID_BAR(); }
#ifndef PROBE_NSA2
#define PROBE_NSA2 0
#endif
    for (int repn_ = 0; repn_ < (PROBE_NSA2 ? 2 : 1); ++repn_) {
    if (IN(3)) for (int rep_ = 0; rep_ < REPS(3); ++rep_) { relaunder(F); p3a_nsa_cmp(F, args); if (BOTH(3) || rep_ + 1 < REPS(3)) GRID_BAR(); }
    if (IN(4)) for (int rep_ = 0; rep_ < REPS(4); ++rep_) { relaunder(F); p3b_nsa_sel(F, args); if (BOTH(4) || rep_ + 1 < REPS(4) || repn_ + 1 < (PROBE_NSA2 ? 2 : 1)) GRID_BAR(); }
    }
    if (IN(5)) for (int rep_ = 0; rep_ < REPS(5); ++rep_) { relaunder(F); p3c_nsa_win(F, args); if (BOTH(5) || rep_ + 1 < REPS(5)) GRID_BAR(); }
    if (IN(6)) for (int rep_ = 0; rep_ < REPS(6); ++rep_) { relaunder(F);
        pg8::Gemm g{(const bf16*)(ws + WS_OATT0), (const bf16*)(ws + WS_W_NSA_OUT), NTOK, DM, DM}; pg8::StaticOrder S; S.init(NTOK, DM, F.G, (int)blockIdx.x);
        pg8::EpiResF32 E{args.in[0], Z, ALPHA, DM};
        pg8::gemm_phase<pg8::EpiResF32, pg8::StaticOrder, true, true>(F.lds + RING_OFF, g, S, E);
        if (BOTH(6) || rep_ + 1 < REPS(6)) GRID_BAR();
    }
    if (IN(7)) for (int rep_ = 0; rep_ < REPS(7); ++rep_) { relaunder(F); ln_phase<false, FFN_F8 != 0>(F, args, Z, args.in[23], args.in[24], XH, (unsigned char*)XB); if (BOTH(7) || rep_ + 1 < REPS(7)) GRID_BAR(); }
    if (IN(8)) for (int rep_ = 0; rep_ < REPS(8); ++rep_) { relaunder(F);
        pg8::StaticOrder S; S.init(NTOK, 2 * DFF, F.G, (int)blockIdx.x);
#if FFN_F8
        pg8::Gemm g{XB, (const bf16*)(ws + WS_W_FFN_GU), NTOK, 2 * DFF, DM, 1, 0x79797979};
        pg8::EpiSwiGLU8 E{(unsigned char*)(ws + WS_HFF), DFF};
        pg8::gemm_phase<pg8::EpiSwiGLU8, pg8::StaticOrder, true, true, true>(F.lds + RING_OFF, g, S, E);
#else
        pg8::Gemm g{XB, (const bf16*)(ws + WS_W_FFN_GU), NTOK, 2 * DFF, DM};
        pg8::EpiSwiGLU E{(bf16*)(ws + WS_HFF), DFF};
        pg8::gemm_phase<pg8::EpiSwiGLU, pg8::StaticOrder, true, true>(F.lds + RING_OFF, g, S, E);
#endif
        if (BOTH(8) || rep_ + 1 < REPS(8)) GRID_BAR();
    }
    if (IN(9)) for (int rep_ = 0; rep_ < REPS(9); ++rep_) { relaunder(F);
        pg8::StaticOrder S; S.init(NTOK, DM, F.G, (int)blockIdx.x);
        pg8::EpiResH E{XH, Z, ALPHA, DM};
#if FFN_F8
        pg8::Gemm g{(const bf16*)(ws + WS_HFF), (const bf16*)(ws + WS_W_FFN_DN), NTOK, DM, DFF, 1, 0x77777777};
        pg8::gemm_phase<pg8::EpiResH, pg8::StaticOrder, true, true, true>(F.lds + RING_OFF, g, S, E);
#else
        pg8::Gemm g{(const bf16*)(ws + WS_HFF), (const bf16*)(ws + WS_W_FFN_DN), NTOK, DM, DFF};
        pg8::gemm_phase<pg8::EpiResH, pg8::StaticOrder, true, true>(F.lds + RING_OFF, g, S, E);
#endif
        if (BOTH(9) || rep_ + 1 < REPS(9)) GRID_BAR();
    }
    if (IN(10)) for (int rep_ = 0; rep_ < REPS(10); ++rep_) { relaunder(F); ln_phase<false>(F, args, Z, args.in[25], args.in[26], XH, nullptr); if (BOTH(10) || rep_ + 1 < REPS(10)) GRID_BAR(); }
    if (IN(11)) for (int rep_ = 0; rep_ < REPS(11); ++rep_) { relaunder(F);
        pg8::Gemm g{XH, (const bf16*)(ws + WS_W_DSA_IN), NTOK, DSA_NPAD, DM}; pg8::StaticOrder S; S.init(NTOK, DSA_NPAD, F.G, (int)blockIdx.x);
        pg8::EpiDsaIn E{(bf16*)(ws + WS_Q), (float*)(ws + WS_CRAW), (bf16*)(ws + WS_QI), (float*)(ws + WS_KIWI), 0.125f};
        pg8::gemm_phase<pg8::EpiDsaIn, pg8::StaticOrder, true, true>(F.lds + RING_OFF, g, S, E);
        if (BOTH(11) || rep_ + 1 < REPS(11)) GRID_BAR();
    }
    if (IN(12)) for (int rep_ = 0; rep_ < REPS(12); ++rep_) { relaunder(F); p10_dsa_prep(F, args); if (BOTH(12) || rep_ + 1 < REPS(12)) GRID_BAR(); }
    if (IN(13)) for (int rep_ = 0; rep_ < REPS(13); ++rep_) { relaunder(F); p13a_dsa_index(F, args); if (BOTH(13) || rep_ + 1 < REPS(13)) GRID_BAR(); }
    if (IN(14)) for (int rep_ = 0; rep_ < REPS(14); ++rep_) { relaunder(F); p13b_dsa_attn(F, args); if (BOTH(14) || rep_ + 1 < REPS(14)) GRID_BAR(); }
    if (IN(15)) for (int rep_ = 0; rep_ < REPS(15); ++rep_) { relaunder(F); p12_dsa_uv(F, args); if (BOTH(15) || rep_ + 1 < REPS(15)) GRID_BAR(); }
    if (IN(16)) for (int rep_ = 0; rep_ < REPS(16); ++rep_) { relaunder(F);
        pg8::Gemm g{(const bf16*)(ws + WS_OATT1), (const bf16*)(ws + WS_W_DSA_OUT), NTOK, DM, DM}; pg8::StaticOrder S; S.init(NTOK, DM, F.G, (int)blockIdx.x);
        pg8::EpiResH E{XH, Z, ALPHA, DM};
        pg8::gemm_phase<pg8::EpiResH, pg8::StaticOrder, true, true>(F.lds + RING_OFF, g, S, E);
        if (BOTH(16) || rep_ + 1 < REPS(16)) GRID_BAR();
    }
    if (IN(17)) for (int rep_ = 0; rep_ < REPS(17); ++rep_) { relaunder(F); ln_route_phase(F, args, Z, args.in[23] + DM, args.in[24] + DM, XH); if (BOTH(17) || rep_ + 1 < REPS(17)) GRID_BAR(); }
    if (IN(18)) for (int rep_ = 0; rep_ < REPS(18); ++rep_) { relaunder(F); p15_gather(F, args); if (BOTH(18) || rep_ + 1 < REPS(18)) GRID_BAR(); }
    if (IN(19)) for (int rep_ = 0; rep_ < REPS(19); ++rep_) { relaunder(F);
        MoeTiles T; moe_tiles(F, T);
        pg8::Gemm g{(const bf16*)(ws + WS_XG), (const bf16*)(ws + WS_W_MOE_GU), T.MT * 256, 2 * DFFE, DM, 1, 0x79797979}; pg8::MoeOrder S; S.init(T.MT * 256, 2 * DFFE, F.G, (int)blockIdx.x); S.nexp_rows = 2 * DFFE;
#pragma unroll
        for (int e = 0; e < 8; ++e) S.tend[e] = T.tend[e];
        pg8::EpiSwiGLU8 E{(unsigned char*)(ws + WS_HM), DFFE};
        pg8::gemm_phase<pg8::EpiSwiGLU8, pg8::MoeOrder, true, true, true>(F.lds + RING_OFF, g, S, E);
        if (BOTH(19) || rep_ + 1 < REPS(19)) GRID_BAR();
    }
    if (IN(20)) for (int rep_ = 0; rep_ < REPS(20); ++rep_) { relaunder(F);
        MoeTiles T; moe_tiles(F, T);
        pg8::Gemm g{(const bf16*)(ws + WS_HM), (const bf16*)(ws + WS_W_MOE_DN), T.MT * 256, DM, DFFE, 1, 0x77777777}; pg8::MoeOrder S; S.init(T.MT * 256, DM, F.G, (int)blockIdx.x); S.nexp_rows = DM;
#pragma unroll
        for (int e = 0; e < 8; ++e) S.tend[e] = T.tend[e];
        pg8::EpiBf16Plain E{(bf16*)(ws + WS_Y), DM};
        pg8::gemm_phase<pg8::EpiBf16Plain, pg8::MoeOrder, true, true, true>(F.lds + RING_OFF, g, S, E);
        if (BOTH(20) || rep_ + 1 < REPS(20)) GRID_BAR();
    }
    if (IN(21)) for (int rep_ = 0; rep_ < REPS(21); ++rep_) { relaunder(F); p18_final(F, args); }
#undef IN
#undef BOTH
}

extern "C" void kernel_launch(void* const* d_in, const int* in_sizes, int n_in, void* d_out, int out_size, void* d_ws, size_t ws_size, hipStream_t stream) {
    static int grid = 0;
    if (grid == 0) {
        if (n_in != 27 || out_size != NTOK * DM || ws_size < WS_END) { fprintf(stderr, "kernel_launch: unexpected shapes (n_in %d, out %d, ws %zu); nothing launched\n", n_in, out_size, ws_size); grid = -1; return; }
        int dev = 0, cus = 0, per_cu = 0;
        if (hipGetDevice(&dev) != hipSuccess || hipDeviceGetAttribute(&cus, hipDeviceAttributeMultiprocessorCount, dev) != hipSuccess) { grid = -1; return; }
        if (hipFuncSetAttribute((const void*)mega_fwd, hipFuncAttributeMaxDynamicSharedMemorySize, LDS_BYTES) != hipSuccess) { fprintf(stderr, "kernel_launch: hipFuncSetAttribute failed\n"); grid = -1; return; }
        if (hipOccupancyMaxActiveBlocksPerMultiprocessor(&per_cu, (const void*)mega_fwd, NWAVES * 64, LDS_BYTES) != hipSuccess || per_cu < 1) { fprintf(stderr, "kernel_launch: occupancy query says %d\n", per_cu); }
        (void)hipGetLastError();
        grid = cus;
    }
    if (grid < 0) return;
    if (hipMemsetAsync((char*)d_ws + WS_CTL, 0, CTL_ZERO_BYTES, stream) != hipSuccess) return;
    Args a{};
    for (int i = 0; i < 27; ++i) a.in[i] = (const float*)d_in[i];
    a.out = (float*)d_out; a.ws = (unsigned char*)d_ws;
#if MK_PER_PHASE
    for (int p = 0; p < NPHASE; ++p) { a.ph_lo = p; a.ph_hi = p + 1; hipLaunchKernelGGL(mega_fwd, dim3(grid), dim3(NWAVES * 64), LDS_BYTES, stream, a); }
#else
    a.ph_lo = 0; a.ph_hi = NPHASE;
    hipLaunchKernelGGL(mega_fwd, dim3(grid), dim3(NWAVES * 64), LDS_BYTES, stream, a);
#endif
}
```

```cpp
#include <hip/hip_runtime.h>
#include <cstdio>
#include <cstdint>
namespace pg8 {
#define PG8_LAS __attribute__((address_space(3)))
typedef unsigned short bf16_t;
typedef short bf16x8 __attribute__((ext_vector_type(8)));
typedef float f32x4 __attribute__((ext_vector_type(4)));
typedef unsigned u32x4 __attribute__((ext_vector_type(4)));
constexpr int BM = 256, BK = 64, HALF = 128, HTB = HALF * BK * 2  , STAGE_BYTES = 8 * HTB, NXCD = 8, WGM = 8;

__host__ __device__ __forceinline__ int lds_byte(int r, int c) { const int st = (r >> 4) * 2 + (c >> 5), rr = r & 15, cc = c & 31, ob = rr * 64 + cc * 2; return st * 1024 + (ob ^ (((ob >> 9) & 1) << 5)); }
__host__ __device__ __forceinline__ void stage_rc(int b, int& R, int& C) { const int st = b / 1024, sb = b % 1024, swz = sb ^ (((sb >> 9) & 1) << 5); R = (st >> 1) * 16 + swz / 64; C = (st & 1) * 32 + (swz % 64) / 2; }
__host__ __device__ __forceinline__ int perm32(int rho) { const int n = rho >> 4, i = rho & 15; return 8 * (i >> 2) + 4 * n + (i & 3); }

struct Unit { int pm, pn; };
struct Gemm { const bf16_t* A; const bf16_t* Bt; int M, N, K; int esz = 2; int scale = 0x7f7f7f7f; };

struct StaticOrder {
    int nM, nN, nwg, G, c;
    __host__ __device__ void init(int M, int N, int G_, int c_) { nM = M / BM; nN = N / BM; nwg = nM * nN; G = G_; c = c_; }
    __host__ __device__ bool next(int i, Unit& u) const {
        const long L = (long)i * G + c; if (L >= nwg) return false;
        int wgid = (int)L; { const int q = nwg / NXCD, r = nwg % NXCD, xcd = wgid % NXCD, off = wgid / NXCD; wgid = (xcd < r ? xcd * (q + 1) : r * (q + 1) + (xcd - r) * q) + off; }
        const int nig = WGM * nN, gid = wgid / nig, fm = gid * WGM, gsz = (nM - fm) < WGM ? (nM - fm) : WGM;
        u.pm = fm + ((wgid % nig) % gsz); u.pn = (wgid % nig) / gsz; return true;
    }
    __device__ __forceinline__ void a_ready(const Unit&) const {}
    __device__ __forceinline__ void done(const Unit&) const {}
    __device__ __forceinline__ const char* a_ptr(const Gemm& g, const Unit& u) const { return (const char*)g.A + (size_t)u.pm * ((size_t)BM * g.K * g.esz); }
    __device__ __forceinline__ const char* b_ptr(const Gemm& g, const Unit& u) const { return (const char*)g.Bt + (size_t)u.pn * ((size_t)BM * g.K * g.esz); }
};


__device__ __forceinline__ unsigned cvt_pk_bf16(float lo, float hi) { unsigned r; asm volatile("v_cvt_pk_bf16_f32 %0, %1, %2" : "=v"(r) : "v"(lo), "v"(hi)); return r; }
__device__ __forceinline__ u32x4 pack8(const f32x4 v0, const f32x4 v1) { u32x4 w; w.x = cvt_pk_bf16(v0[0], v0[1]); w.y = cvt_pk_bf16(v0[2], v0[3]); w.z = cvt_pk_bf16(v1[0], v1[1]); w.w = cvt_pk_bf16(v1[2], v1[3]); return w; }

struct EpiNsaIn {
    static constexpr bool PERM = true, AFTER_DRAIN = false;
    bf16_t* P0; float* GL; float qscale;
    __device__ __forceinline__ void operator()(const f32x4 (&acc)[2][2][4][2], const Unit& u, int wr, int wc, int fr, int fq) const {
        const int row0 = u.pm * BM + wr * 64 + fr;
        if (u.pn < 20) {
            const float s = u.pn < 8 ? qscale : 1.0f;
            const int col0 = u.pn * BM + wc * 32 + 8 * fq;
#pragma unroll
            for (int ai = 0; ai < 2; ++ai)
#pragma unroll
                for (int m = 0; m < 4; ++m) { bf16_t* rowp = P0 + (size_t)(row0 + ai * HALF + m * 16) * 5120 + col0;
#pragma unroll
                    for (int bj = 0; bj < 2; ++bj) *(u32x4*)(rowp + bj * HALF) = pack8(acc[ai][bj][m][0] * s, acc[ai][bj][m][1] * s); }
        } else {
            const int c = wc * 32 + 8 * fq;
            if (c < 48) {
#pragma unroll
                for (int ai = 0; ai < 2; ++ai)
#pragma unroll
                    for (int m = 0; m < 4; ++m) { float* gp = GL + (size_t)(row0 + ai * HALF + m * 16) * 48 + c;
                        *(f32x4*)gp = acc[ai][0][m][0]; *(f32x4*)(gp + 4) = acc[ai][0][m][1]; }
            }
        }
    }
};
struct EpiDsaIn {
    static constexpr bool PERM = true, AFTER_DRAIN = false;
    bf16_t* Q; float* CRAW; bf16_t* QI; float* KIWI; float qiscale;
    __device__ __forceinline__ void operator()(const f32x4 (&acc)[2][2][4][2], const Unit& u, int wr, int wc, int fr, int fq) const {
        const int row0 = u.pm * BM + wr * 64 + fr; const int c = wc * 32 + 8 * fq;
        if (u.pn < 8) {
#pragma unroll
            for (int ai = 0; ai < 2; ++ai)
#pragma unroll
                for (int m = 0; m < 4; ++m) { bf16_t* rowp = Q + (size_t)(row0 + ai * HALF + m * 16) * 2048 + u.pn * BM + c;
#pragma unroll
                    for (int bj = 0; bj < 2; ++bj) *(u32x4*)(rowp + bj * HALF) = pack8(acc[ai][bj][m][0], acc[ai][bj][m][1]); }
        } else if (u.pn == 8) {
#pragma unroll
            for (int ai = 0; ai < 2; ++ai)
#pragma unroll
                for (int m = 0; m < 4; ++m) { float* rowp = CRAW + (size_t)(row0 + ai * HALF + m * 16) * 256 + c;
#pragma unroll
                    for (int bj = 0; bj < 2; ++bj) { *(f32x4*)(rowp + bj * HALF) = acc[ai][bj][m][0]; *(f32x4*)(rowp + bj * HALF + 4) = acc[ai][bj][m][1]; } }
        } else if (u.pn < 11) {
#pragma unroll
            for (int ai = 0; ai < 2; ++ai)
#pragma unroll
                for (int m = 0; m < 4; ++m) { bf16_t* rowp = QI + (size_t)(row0 + ai * HALF + m * 16) * 512 + (u.pn - 9) * BM + c;
#pragma unroll
                    for (int bj = 0; bj < 2; ++bj) *(u32x4*)(rowp + bj * HALF) = pack8(acc[ai][bj][m][0] * qiscale, acc[ai][bj][m][1] * qiscale); }
        } else {
#pragma unroll
            for (int ai = 0; ai < 2; ++ai)
#pragma unroll
                for (int m = 0; m < 4; ++m) { float* rowp = KIWI + (size_t)(row0 + ai * HALF + m * 16) * 128 + c;
                    *(f32x4*)rowp = acc[ai][0][m][0]; *(f32x4*)(rowp + 4) = acc[ai][0][m][1]; }
        }
    }
};
struct EpiResF32 {
    static constexpr bool PERM = true, AFTER_DRAIN = false;
    const float* R; bf16_t* Z; float alpha; int ldc;
    __device__ __forceinline__ void operator()(const f32x4 (&acc)[2][2][4][2], const Unit& u, int wr, int wc, int fr, int fq) const {
        const int row0 = u.pm * BM + wr * 64 + fr, col0 = u.pn * BM + wc * 32 + 8 * fq;
#pragma unroll
        for (int ai = 0; ai < 2; ++ai)
#pragma unroll
            for (int m = 0; m < 4; ++m) { const size_t off = (size_t)(row0 + ai * HALF + m * 16) * ldc + col0;
#pragma unroll
                for (int bj = 0; bj < 2; ++bj) { const f32x4 r0 = *(const f32x4*)(R + off + bj * HALF), r1 = *(const f32x4*)(R + off + bj * HALF + 4);
                    *(u32x4*)(Z + off + bj * HALF) = pack8(r0 * alpha + acc[ai][bj][m][0], r1 * alpha + acc[ai][bj][m][1]); } }
    }
};
struct EpiResH {
    static constexpr bool PERM = true, AFTER_DRAIN = false;
    const bf16_t* R; bf16_t* Z; float alpha; int ldc;
    __device__ __forceinline__ void operator()(const f32x4 (&acc)[2][2][4][2], const Unit& u, int wr, int wc, int fr, int fq) const {
        const int row0 = u.pm * BM + wr * 64 + fr, col0 = u.pn * BM + wc * 32 + 8 * fq;
#pragma unroll
        for (int ai = 0; ai < 2; ++ai)
#pragma unroll
            for (int m = 0; m < 4; ++m) { const size_t off = (size_t)(row0 + ai * HALF + m * 16) * ldc + col0;
#pragma unroll
                for (int bj = 0; bj < 2; ++bj) { const u32x4 rr = *(const u32x4*)(R + off + bj * HALF);
                    const f32x4 r0 = (f32x4){__uint_as_float(rr.x << 16), __uint_as_float(rr.x & 0xffff0000u), __uint_as_float(rr.y << 16), __uint_as_float(rr.y & 0xffff0000u)};
                    const f32x4 r1 = (f32x4){__uint_as_float(rr.z << 16), __uint_as_float(rr.z & 0xffff0000u), __uint_as_float(rr.w << 16), __uint_as_float(rr.w & 0xffff0000u)};
                    *(u32x4*)(Z + off + bj * HALF) = pack8(r0 * alpha + acc[ai][bj][m][0], r1 * alpha + acc[ai][bj][m][1]); } }
    }
};
struct EpiF32 {
    static constexpr bool PERM = false, AFTER_DRAIN = false;
    float* C; int ldc;
    __device__ __forceinline__ void operator()(const f32x4 (&acc)[2][2][4][2], const Unit& u, int wr, int wc, int fr, int fq) const {
        const int row0 = u.pm * BM + wr * 64 + fr, col0 = u.pn * BM + wc * 32 + 4 * fq;
#pragma unroll
        for (int ai = 0; ai < 2; ++ai)
#pragma unroll
            for (int m = 0; m < 4; ++m) { float* rowp = C + (size_t)(row0 + ai * HALF + m * 16) * ldc + col0;
#pragma unroll
                for (int bj = 0; bj < 2; ++bj)
#pragma unroll
                    for (int n = 0; n < 2; ++n) *(f32x4*)(rowp + bj * HALF + n * 16) = acc[ai][bj][m][n]; }
    }
};
struct EpiBf16Plain {
    static constexpr bool PERM = true, AFTER_DRAIN = false;
    bf16_t* C; int ldc;
    __device__ __forceinline__ void operator()(const f32x4 (&acc)[2][2][4][2], const Unit& u, int wr, int wc, int fr, int fq) const {
        const int row0 = u.pm * BM + wr * 64 + fr, col0 = u.pn * BM + wc * 32 + 8 * fq;
#pragma unroll
        for (int ai = 0; ai < 2; ++ai)
#pragma unroll
            for (int m = 0; m < 4; ++m) { bf16_t* rowp = C + (size_t)(row0 + ai * HALF + m * 16) * ldc + col0;
#pragma unroll
                for (int bj = 0; bj < 2; ++bj) *(u32x4*)(rowp + bj * HALF) = pack8(acc[ai][bj][m][0], acc[ai][bj][m][1]); }
    }
};
__device__ __forceinline__ float silu_mul(float g, float u) { return g * __builtin_amdgcn_rcpf(1.0f + __expf(-g)) * u; }
struct EpiSwiGLU {
    static constexpr bool PERM = true, AFTER_DRAIN = false;
    bf16_t* H; int ldh;
    __device__ __forceinline__ void operator()(const f32x4 (&acc)[2][2][4][2], const Unit& u, int wr, int wc, int fr, int fq) const {
        const int row0 = u.pm * BM + wr * 64 + fr, col0 = u.pn * HALF + wc * 32 + 8 * fq;
#pragma unroll
        for (int ai = 0; ai < 2; ++ai)
#pragma unroll
            for (int m = 0; m < 4; ++m) { bf16_t* rowp = H + (size_t)(row0 + ai * HALF + m * 16) * ldh + col0;
                f32x4 v0, v1;
#pragma unroll
                for (int j = 0; j < 4; ++j) { v0[j] = silu_mul(acc[ai][0][m][0][j], acc[ai][1][m][0][j]); v1[j] = silu_mul(acc[ai][0][m][1][j], acc[ai][1][m][1][j]); }
                *(u32x4*)rowp = pack8(v0, v1); }
    }
};
struct EpiSwiGLU8 {
    static constexpr bool PERM = true, AFTER_DRAIN = false;
    unsigned char* H; int ldh;
    __device__ __forceinline__ void operator()(const f32x4 (&acc)[2][2][4][2], const Unit& u, int wr, int wc, int fr, int fq) const {
        const int row0 = u.pm * BM + wr * 64 + fr, col0 = u.pn * HALF + wc * 32 + 8 * fq;
#pragma unroll
        for (int ai = 0; ai < 2; ++ai)
#pragma unroll
            for (int m = 0; m < 4; ++m) { unsigned char* rowp = H + (size_t)(row0 + ai * HALF + m * 16) * ldh + col0;
                float v[8];
#pragma unroll
                for (int j = 0; j < 4; ++j) { v[j] = silu_mul(acc[ai][0][m][0][j], acc[ai][1][m][0][j]); v[4 + j] = silu_mul(acc[ai][0][m][1][j], acc[ai][1][m][1][j]); }
                int w0 = __builtin_amdgcn_cvt_pk_fp8_f32(v[0], v[1], 0, false); w0 = __builtin_amdgcn_cvt_pk_fp8_f32(v[2], v[3], w0, true);
                int w1 = __builtin_amdgcn_cvt_pk_fp8_f32(v[4], v[5], 0, false); w1 = __builtin_amdgcn_cvt_pk_fp8_f32(v[6], v[7], w1, true);
                uint2 o; o.x = (unsigned)w0; o.y = (unsigned)w1; *(uint2*)rowp = o; }
    }
};
struct MoeOrder : StaticOrder {
    int tend[8]; int nexp_rows;
    __device__ __forceinline__ int expert(int pm) const { int e = 0;
#pragma unroll
        for (int i = 0; i < 7; ++i) e += (pm >= tend[i]) ? 1 : 0; return e; }
    __device__ __forceinline__ const char* b_ptr(const Gemm& g, const Unit& u) const { return (const char*)g.Bt + ((size_t)expert(u.pm) * nexp_rows + (size_t)u.pn * BM) * ((size_t)g.K * g.esz); }
};
typedef int i32x8 __attribute__((ext_vector_type(8)));
typedef int i32x4 __attribute__((ext_vector_type(4)));
__device__ __forceinline__ i32x8 cat8(bf16x8 lo, bf16x8 hi) { const i32x4 a = *reinterpret_cast<const i32x4*>(&lo), b = *reinterpret_cast<const i32x4*>(&hi); return __builtin_shufflevector(a, b, 0, 1, 2, 3, 4, 5, 6, 7); }
template <class Epi, class Sched, bool ALIGN_EPI = false, bool SP2 = false, bool FP8 = false>
__device__ __forceinline__ void gemm_phase(PG8_LAS unsigned char* lds, const Gemm g, const Sched& S, const Epi& E) {
    int tid = threadIdx.x; asm volatile("" : "+v"(tid));
    const int wid = __builtin_amdgcn_readfirstlane(tid >> 6), lane = tid & 63, wr = wid >> 2, wc = wid & 3, fr = lane & 15, fq = lane >> 4;
    const int K = g.K, nt = K / (FP8 ? 2 * BK : BK);
    unsigned voffA[2], voffB[2];
#pragma unroll
    for (int i = 0; i < 2; ++i) { int R, C; stage_rc(tid * 16 + i * 8192, R, C); const int Rb = Epi::PERM ? ((R & ~31) + perm32(R & 31)) : R;
        voffA[i] = FP8 ? (unsigned)(R * K + C * 2) : (unsigned)(R * K + C) * 2u; voffB[i] = FP8 ? (unsigned)(Rb * K + C * 2) : (unsigned)(Rb * K + C) * 2u; }
    const size_t kstep = (size_t)(BK * 2);
    const size_t hstep = (size_t)HALF * K * (FP8 ? 1 : 2);
    const size_t tstep = 2 * hstep;
    const unsigned ldsw = (unsigned)wid * 1024u;
    const int aoff = lds_byte(wr * 64 + fr, fq * 8), boff = lds_byte(wc * 32 + fr, fq * 8);
#define PG8_SA(b, h) (((b) * 2 + (h)) * HTB)
#define PG8_SB(b, h) ((4 + (b) * 2 + (h)) * HTB)
#define PG8_STAGE(bufoff, gbase, voff) do { _Pragma("unroll") for (int _i = 0; _i < 2; ++_i) \
        __builtin_amdgcn_global_load_lds((const unsigned*)((const char*)(gbase) + (voff)[_i]), (PG8_LAS unsigned*)(lds + (bufoff) + ldsw + _i * 8192), 16, 0, 0); } while (0)
#define PG8_LDA(dst, b, h) do { _Pragma("unroll") for (int m = 0; m < 4; ++m) { if constexpr (FP8) { const i32x4 lo_ = *(const PG8_LAS i32x4*)(lds + PG8_SA(b, h) + aoff + m * 2048), hi_ = *(const PG8_LAS i32x4*)(lds + PG8_SA(b, h) + aoff + m * 2048 + 1024); dst##8[m] = __builtin_shufflevector(lo_, hi_, 0, 1, 2, 3, 4, 5, 6, 7); } else { _Pragma("unroll") for (int k = 0; k < 2; ++k) dst[m][k] = *(const PG8_LAS bf16x8*)(lds + PG8_SA(b, h) + aoff + m * 2048 + k * 1024); } } } while (0)
#define PG8_LDB(dst, b, h) do { _Pragma("unroll") for (int n = 0; n < 2; ++n) { if constexpr (FP8) { const i32x4 lo_ = *(const PG8_LAS i32x4*)(lds + PG8_SB(b, h) + boff + n * 2048), hi_ = *(const PG8_LAS i32x4*)(lds + PG8_SB(b, h) + boff + n * 2048 + 1024); dst##8[n] = __builtin_shufflevector(lo_, hi_, 0, 1, 2, 3, 4, 5, 6, 7); } else { _Pragma("unroll") for (int k = 0; k < 2; ++k) dst[n][k] = *(const PG8_LAS bf16x8*)(lds + PG8_SB(b, h) + boff + n * 2048 + k * 1024); } } } while (0)
#define PG8_MMA(ai, bj, At, Bt) do { __builtin_amdgcn_s_setprio(1); _Pragma("unroll") for (int m = 0; m < 4; ++m) _Pragma("unroll") for (int n = 0; n < 2; ++n) { \
        if constexpr (FP8) { asm volatile("v_mfma_scale_f32_16x16x128_f8f6f4 %0, %1, %2, %0, %3, %4 op_sel_hi:[0,0,0]" : "+v"(acc[ai][bj][m][n]) : "v"(Bt##8[n]), "v"(At##8[m]), "v"(sclA), "v"(sclB)); } \
        else { _Pragma("unroll") for (int k = 0; k < 2; ++k) acc[ai][bj][m][n] = __builtin_amdgcn_mfma_f32_16x16x32_bf16(Bt[n][k], At[m][k], acc[ai][bj][m][n], 0, 0, 0); } } __builtin_amdgcn_s_setprio(0); } while (0)
#define PG8_WAIT_V(n) asm volatile("s_waitcnt vmcnt(" #n ")" ::: "memory")
#define PG8_WAIT_L(n) asm volatile("s_waitcnt lgkmcnt(" #n ")" ::: "memory")
#define PG8_BAR __builtin_amdgcn_s_barrier()
#define PG8_SCHED __builtin_amdgcn_sched_barrier(0)
    Unit cur, nxt; int ui = 0;
    if (!S.next(0, cur)) return;
    f32x4 acc[2][2][4][2];
#pragma unroll
    for (int a = 0; a < 2; ++a)
#pragma unroll
        for (int b = 0; b < 2; ++b)
#pragma unroll
            for (int m = 0; m < 4; ++m)
#pragma unroll
                for (int n = 0; n < 2; ++n) acc[a][b][m][n] = (f32x4){0.f, 0.f, 0.f, 0.f};
    bf16x8 At[4][2], B0[2][2], B1[2][2]; i32x8 At8[4], B08[2], B18[2]; const int sclA = g.scale, sclB = 0x7f7f7f7f;
    const char* cA = S.a_ptr(g, cur); const char* cB = S.b_ptr(g, cur);
    S.a_ready(cur);
    if constexpr (SP2) {
        PG8_STAGE(PG8_SB(0, 0), cB, voffB); PG8_STAGE(PG8_SB(0, 1), cB + hstep, voffB); PG8_STAGE(PG8_SA(0, 0), cA, voffA); PG8_STAGE(PG8_SA(0, 1), cA + hstep, voffA);
        if (wr == 1) PG8_BAR;
        PG8_WAIT_V(2); PG8_BAR;
        PG8_STAGE(PG8_SB(1, 0), cB + kstep, voffB); PG8_STAGE(PG8_SA(1, 0), cA + kstep, voffA); PG8_STAGE(PG8_SB(1, 1), cB + hstep + kstep, voffB);
        PG8_WAIT_V(6); PG8_BAR;
    } else {
        PG8_STAGE(PG8_SB(0, 0), cB, voffB); PG8_STAGE(PG8_SA(0, 0), cA, voffA); PG8_STAGE(PG8_SB(0, 1), cB + hstep, voffB); PG8_STAGE(PG8_SA(0, 1), cA + hstep, voffA);
        if (wr == 1) PG8_BAR;
        PG8_WAIT_V(4); PG8_BAR;
        PG8_STAGE(PG8_SB(1, 0), cB + kstep, voffB); PG8_STAGE(PG8_SA(1, 0), cA + kstep, voffA); PG8_STAGE(PG8_SB(1, 1), cB + hstep + kstep, voffB);
        PG8_WAIT_V(6); PG8_BAR;
    }
    for (;;) {
        const bool has_next = S.next(ui + 1, nxt);
        const char* nA = has_next ? S.a_ptr(g, nxt) : cA; const char* nB = has_next ? S.b_ptr(g, nxt) : cB;
        for (int t = 0; t < nt; t += 2) {
            const bool last = (t == nt - 2);
            const char* a1 = cA + (size_t)(t + 1) * kstep;
            const char* a2 = last ? nA : cA + (size_t)(t + 2) * kstep; const char* b2 = last ? nB : cB + (size_t)(t + 2) * kstep;
            const char* a3 = a2 + kstep; const char* b3 = b2 + kstep;
            if (last && has_next) S.a_ready(nxt);
            if constexpr (SP2) {
            PG8_LDB(B0, 0, 0); PG8_LDB(B1, 0, 1); PG8_SCHED; PG8_LDA(At, 0, 0); PG8_STAGE(PG8_SA(1, 1), a1 + hstep, voffA);
            PG8_WAIT_V(8); PG8_WAIT_L(0); PG8_BAR; PG8_MMA(0, 0, At, B0); PG8_MMA(0, 1, At, B1); PG8_BAR; PG8_SCHED;
            PG8_LDA(At, 0, 1); PG8_STAGE(PG8_SB(0, 0), b2, voffB); PG8_STAGE(PG8_SB(0, 1), b2 + hstep, voffB); PG8_STAGE(PG8_SA(0, 0), a2, voffA);
            PG8_WAIT_V(8); PG8_WAIT_L(0); PG8_BAR; PG8_MMA(1, 0, At, B0); PG8_MMA(1, 1, At, B1); PG8_BAR; PG8_SCHED;
            PG8_LDB(B0, 1, 0); PG8_LDB(B1, 1, 1); PG8_SCHED; PG8_LDA(At, 1, 0); PG8_STAGE(PG8_SA(0, 1), a2 + hstep, voffA);
            PG8_WAIT_V(8); PG8_WAIT_L(0); PG8_BAR; PG8_MMA(0, 0, At, B0); PG8_MMA(0, 1, At, B1); PG8_BAR; PG8_SCHED;
            PG8_LDA(At, 1, 1); PG8_STAGE(PG8_SB(1, 0), b3, voffB); PG8_STAGE(PG8_SB(1, 1), b3 + hstep, voffB); PG8_STAGE(PG8_SA(1, 0), a3, voffA);
            PG8_WAIT_V(8); PG8_WAIT_L(0); PG8_BAR; PG8_MMA(1, 0, At, B0); PG8_MMA(1, 1, At, B1); PG8_BAR; PG8_SCHED;
            } else {
            PG8_LDB(B0, 0, 0); PG8_SCHED; PG8_LDA(At, 0, 0); PG8_STAGE(PG8_SA(1, 1), a1 + hstep, voffA);
            PG8_WAIT_L(8); PG8_BAR; PG8_WAIT_L(0); PG8_MMA(0, 0, At, B0); PG8_BAR; PG8_SCHED;
            PG8_LDB(B1, 0, 1); PG8_STAGE(PG8_SB(0, 0), b2, voffB);
            PG8_BAR; PG8_WAIT_L(0); PG8_MMA(0, 1, At, B1); PG8_BAR;
            PG8_LDA(At, 0, 1); PG8_STAGE(PG8_SA(0, 0), a2, voffA);
            PG8_BAR; PG8_WAIT_L(0); PG8_MMA(1, 0, At, B0); PG8_BAR; PG8_SCHED;
            PG8_STAGE(PG8_SB(0, 1), b2 + hstep, voffB);
            PG8_WAIT_V(6); PG8_BAR; PG8_MMA(1, 1, At, B1); PG8_BAR;
            PG8_LDB(B0, 1, 0); PG8_SCHED; PG8_LDA(At, 1, 0); PG8_STAGE(PG8_SA(0, 1), a2 + hstep, voffA);
            PG8_WAIT_L(8); PG8_BAR; PG8_WAIT_L(0); PG8_MMA(0, 0, At, B0); PG8_BAR; PG8_SCHED;
            PG8_LDB(B1, 1, 1); PG8_STAGE(PG8_SB(1, 0), b3, voffB);
            PG8_BAR; PG8_WAIT_L(0); PG8_MMA(0, 1, At, B1); PG8_BAR;
            PG8_LDA(At, 1, 1); PG8_STAGE(PG8_SA(1, 0), a3, voffA);
            PG8_BAR; PG8_WAIT_L(0); PG8_MMA(1, 0, At, B0); PG8_BAR; PG8_SCHED;
            PG8_STAGE(PG8_SB(1, 1), b3 + hstep, voffB);
            PG8_WAIT_V(6); PG8_BAR; PG8_MMA(1, 1, At, B1); PG8_BAR;
            }
        }
        if constexpr (FP8) asm volatile("s_nop 15\n\ts_nop 15" ::: "memory");
        if constexpr (ALIGN_EPI) { if (wr == 0) PG8_BAR; }
        if constexpr (!Epi::AFTER_DRAIN) { E(acc, cur, wr, wc, fr, fq); S.done(cur); }
        if (!has_next) break;
#pragma unroll
        for (int a = 0; a < 2; ++a)
#pragma unroll
            for (int b = 0; b < 2; ++b)
#pragma unroll
                for (int m = 0; m < 4; ++m)
#pragma unroll
                    for (int n = 0; n < 2; ++n) acc[a][b][m][n] = (f32x4){0.f, 0.f, 0.f, 0.f};
        cur = nxt; cA = nA; cB = nB; ++ui;
        if constexpr (ALIGN_EPI) { if (wr == 1) PG8_BAR; }
    }
    PG8_WAIT_V(0);
    if constexpr (!ALIGN_EPI) { if (wr == 0) PG8_BAR; }
    PG8_BAR;
    if constexpr (Epi::AFTER_DRAIN) { E.fused(acc, cur, wr, wc, fr, fq, lds, wid, lane); S.done(cur); }
#undef PG8_SA
#undef PG8_SB
#undef PG8_STAGE
#undef PG8_LDA
#undef PG8_LDB
#undef PG8_MMA
#undef PG8_WAIT_V
#undef PG8_WAIT_L
#undef PG8_BAR
#undef PG8_SCHED
}
}
#define GAS __attribute__((address_space(1)))
#define LAS __attribute__((address_space(3)))
typedef unsigned short bf16;
typedef unsigned v4u __attribute__((ext_vector_type(4)));
typedef float f32x4 __attribute__((ext_vector_type(4)));
typedef short bf16x8 __attribute__((ext_vector_type(8)));
typedef GAS unsigned gu32;
typedef GAS unsigned long long gu64;
#define RLX_AGENT __ATOMIC_RELAXED, __HIP_MEMORY_SCOPE_AGENT
#define LDS_WAIT() asm volatile("s_waitcnt lgkmcnt(0)" ::: "memory")
#define VM_WAIT() asm volatile("s_waitcnt vmcnt(0)" ::: "memory")
__device__ __forceinline__ unsigned long long rt() { return __builtin_amdgcn_s_memrealtime(); }
__device__ __forceinline__ unsigned f2bf(float f) { unsigned u = __builtin_bit_cast(unsigned, f); return (u + 0x7fffu + ((u >> 16) & 1u)) >> 16; }
__device__ __forceinline__ unsigned pk2(float lo, float hi) { return f2bf(lo) | (f2bf(hi) << 16); }

#define XB_TMO      128
#define XB_XCNT(j)  (256  + 64 * (j))
#define XB_XSUB(j)  (1280 + 64 * (j))
#define XB_XGEN(j)  (2304 + 64 * (j))
#define XB_TOP      3328
#define XB_TOPGEN   3392
#define XCD_BAR_WORDS 3456
#define XB_SPIN_CAP (1u << 18)

__device__ __forceinline__ unsigned xb_ld(unsigned* p)              { return __hip_atomic_load(p, __ATOMIC_RELAXED, __HIP_MEMORY_SCOPE_AGENT); }
__device__ __forceinline__ unsigned xb_add(unsigned* p, unsigned v) { return __hip_atomic_fetch_add(p, v, __ATOMIC_RELAXED, __HIP_MEMORY_SCOPE_AGENT); }
__device__ __forceinline__ unsigned xb_xcc_id() { return (unsigned)__builtin_amdgcn_s_getreg((3 << 11) | 20) & 0xFu; }
#define XB_SPIN(cond, bar) do { unsigned _sp = 0; while (cond) { __builtin_amdgcn_s_sleep(1); \
    if ((++_sp & 255u) == 0u) { if (xb_ld(&(bar)[XB_TMO])) break; if (_sp > XB_SPIN_CAP) { atomicAdd(&(bar)[XB_TMO], 1u); break; } } } } while (0)

struct XcdBarrier {
    unsigned* bar; unsigned x;
    volatile LAS unsigned* st;
};

__device__ __forceinline__ XcdBarrier xcd_barrier_post(unsigned* bar, volatile LAS unsigned* st) {
    XcdBarrier b; b.bar = bar; b.x = xb_xcc_id(); b.st = st;
    if (threadIdx.x == 0) (void)xb_add(&bar[XB_XCNT(b.x)], 1u);
    return b;
}
__device__ __forceinline__ void xcd_barrier_complete(unsigned* bar, unsigned x, unsigned& nloc, unsigned& nx) {
    const unsigned G = gridDim.x * gridDim.y * gridDim.z;
    unsigned sum, cnt, mine, sp = 0u;
    for (;;) {
        sum = 0u; cnt = 0u; mine = 0u;
#pragma unroll
        for (unsigned j = 0; j < 16; ++j) { const unsigned c = xb_ld(&bar[XB_XCNT(j)]); sum += c; cnt += (c > 0u) ? 1u : 0u; mine = (j == x) ? c : mine; }
        if (sum == G) break;
        __builtin_amdgcn_s_sleep(1);
        if ((++sp & 255u) == 0u) { if (xb_ld(&bar[XB_TMO])) break; if (sp > XB_SPIN_CAP) { atomicAdd(&bar[XB_TMO], 1u); break; } }
    }
    nloc = mine > 0u ? mine : 1u; nx = cnt > 0u ? cnt : 1u;
}

__device__ __forceinline__ void xcd_barrier(const XcdBarrier& b) {
    asm volatile("s_waitcnt vmcnt(0)" ::: "memory");
    __syncthreads();
    if (threadIdx.x == 0) {
        unsigned* bar = b.bar;
        __builtin_amdgcn_s_waitcnt(0);
        unsigned nloc = b.st[0], nx = b.st[1];
        if (nloc == 0u) { xcd_barrier_complete(bar, b.x, nloc, nx); b.st[0] = nloc; b.st[1] = nx; }
        const unsigned old = xb_add(&bar[XB_XSUB(b.x)], 1u);
        const unsigned gen = old / nloc;
        if (old + 1u == (gen + 1u) * nloc) {
            __builtin_amdgcn_fence(__ATOMIC_RELEASE, "agent");
            asm volatile("s_waitcnt vmcnt(0)" ::: "memory");
            const unsigned og = xb_add(&bar[XB_TOP], 1u);
            const unsigned tg = og / nx;
            if (og + 1u == (tg + 1u) * nx) xb_add(&bar[XB_TOPGEN], 1u);
            else XB_SPIN(xb_ld(&bar[XB_TOPGEN]) == tg, bar);
            __builtin_amdgcn_fence(__ATOMIC_ACQUIRE, "agent");
            xb_add(&bar[XB_XGEN(b.x)], 1u);
            asm volatile("s_waitcnt vmcnt(0)" ::: "memory");
        } else {
            XB_SPIN(xb_ld(&bar[XB_XGEN(b.x)]) == gen, bar);
            __builtin_amdgcn_fence(__ATOMIC_ACQUIRE, "agent");
            asm volatile("s_waitcnt vmcnt(0)" ::: "memory");
        }
    }
    __syncthreads();
}

constexpr int NWAVES = 8;
#ifndef MK_PER_PHASE
#define MK_PER_PHASE 0
#endif
constexpr int NPHASE = 22;

constexpr int BATCH = 2, SEQ = 8192, DM = 2048, NTOK = BATCH * SEQ, NH = 16, DH = 128;
constexpr int NSA_N = 5168, NSA_NPAD = 5376, P0LD = 5120;
constexpr int NCMP = 511, NSELB = 128;
constexpr int COL_KC = 2048, COL_VC = 2560, COL_KS = 3072, COL_VS = 3584, COL_KW = 4096, COL_VW = 4608;
constexpr int DSA_N = 2888, DSA_NPAD = 3072, KVR = 256, TOPK = 256;
constexpr int DFF = 5632, NEXP = 8, DFFE = 7168, MOE_ROWS = 34816;
constexpr float ALPHA = 1.41421356237309515f, LN_EPS = 1e-5f, RMS_EPS = 1e-6f;

constexpr size_t MiB = (size_t)1 << 20;
constexpr size_t WS_CTL = 0, CTL_ZERO_BYTES = 128 * 1024;
constexpr size_t WS_W_NSA_IN = 2 * MiB, WS_W_NSA_OUT = 23 * MiB, WS_W_FFN_GU = 31 * MiB, WS_W_FFN_DN = 75 * MiB, WS_W_DSA_IN = 97 * MiB, WS_W_DSA_OUT = 109 * MiB;
constexpr size_t WS_W_CMPK = 117 * MiB, WS_W_CMPV = 118 * MiB, WS_W_UK = 119 * MiB, WS_W_UV = 120 * MiB, WS_CBIAS = 121 * MiB;
constexpr size_t WS_KCMP = 122 * MiB, WS_VCMP = 124 * MiB, WS_GL = 126 * MiB, WS_ROUTE = 129 * MiB;
constexpr size_t WS_KIB = 179 * MiB;
constexpr size_t WS_SELM = 178 * MiB;
constexpr size_t WS_CRAW = 130 * MiB, WS_KIWI = 146 * MiB, WS_IDX = 154 * MiB, WS_CN = 170 * MiB;
constexpr size_t WS_W_MOE_GU = 192 * MiB, WS_W_MOE_DN = 640 * MiB;
constexpr size_t WS_XB = 864 * MiB, WS_XF = 928 * MiB, WS_Z = 1056 * MiB;
constexpr size_t WS_P0 = 1184 * MiB, WS_OATT0 = 1344 * MiB, WS_HFF = 1408 * MiB;
constexpr size_t WS_Q = 1184 * MiB, WS_QI = 1248 * MiB, WS_QLAT = 1264 * MiB, WS_OLAT = 1392 * MiB, WS_OATT1 = 1520 * MiB;
constexpr size_t WS_XG = 1056 * MiB, WS_HM = 1192 * MiB, WS_Y = 192 * MiB;
constexpr size_t WS_END = 1668 * MiB;
static_assert(WS_HM + (size_t)MOE_ROWS * DFFE * 2 <= WS_END, "hm fits");
static_assert(WS_XG + (size_t)MOE_ROWS * DM * 2 <= WS_HM, "xg fits");
static_assert(WS_Y + (size_t)MOE_ROWS * DM * 4 <= WS_W_MOE_DN, "y overlays the dead gate/up weights only");
static_assert(WS_HFF + (size_t)NTOK * DFF * 2 <= WS_END, "hff fits");
constexpr int CW_TMO = 0, CW_CODE = 1;
constexpr int CW_BAR = 4096;
constexpr int CW_MOECNT = 16384;

constexpr int RING_OFF = 0, RING_BYTES = 131072;
constexpr int LDSCTL_OFF = RING_BYTES, MISC_OFF = LDSCTL_OFF + 320;
constexpr int LDS_BYTES = 163840;
constexpr int DSA_SCR = 133120;

struct Frame {
    LAS unsigned char* lds;
    volatile LAS unsigned* MISC;
    gu32* ctl;
    int tid, lane, wave, vcu, G;
};

__device__ __forceinline__ void relaunder(Frame& F) { int t = F.tid; asm volatile("" : "+v"(t)); F.tid = t; F.lane = t & 63; }
__device__ __forceinline__ float bf2f(unsigned short h) { return __uint_as_float(((unsigned)h) << 16); }
__device__ __forceinline__ float bflo(unsigned w) { return __uint_as_float(w << 16); }
__device__ __forceinline__ float bfhi(unsigned w) { return __uint_as_float(w & 0xffff0000u); }
__device__ __forceinline__ float wave_sum(float v) {
#pragma unroll
    for (int o = 1; o < 64; o <<= 1) v += __shfl_xor(v, o);
    return v;
}
__device__ __forceinline__ float wave_max(float v) {
#pragma unroll
    for (int o = 1; o < 64; o <<= 1) v = fmaxf(v, __shfl_xor(v, o));
    return v;
}
__device__ __forceinline__ float dpp_xor1(float v) { return __int_as_float(__builtin_amdgcn_mov_dpp(__float_as_int(v), 0xB1, 0xF, 0xF, true)); }
__device__ __forceinline__ float dpp_xor2(float v) { return __int_as_float(__builtin_amdgcn_mov_dpp(__float_as_int(v), 0x4E, 0xF, 0xF, true)); }
__device__ __forceinline__ float sum_xor32(float v) { auto r = __builtin_amdgcn_permlane32_swap(__float_as_uint(v), __float_as_uint(v), false, false); return __uint_as_float(r[0]) + __uint_as_float(r[1]); }
__device__ __forceinline__ float max_xor32(float v) { auto r = __builtin_amdgcn_permlane32_swap(__float_as_uint(v), __float_as_uint(v), false, false); return fmaxf(__uint_as_float(r[0]), __uint_as_float(r[1])); }
__device__ __forceinline__ float sum_xor16(float v) { auto r = __builtin_amdgcn_permlane16_swap(__float_as_uint(v), __float_as_uint(v), false, false); return __uint_as_float(r[0]) + __uint_as_float(r[1]); }
__device__ __forceinline__ float max_xor16(float v) { auto r = __builtin_amdgcn_permlane16_swap(__float_as_uint(v), __float_as_uint(v), false, false); return fmaxf(__uint_as_float(r[0]), __uint_as_float(r[1])); }
#define WSYNC() do { __builtin_amdgcn_wave_barrier(); asm volatile("s_waitcnt lgkmcnt(0)" ::: "memory"); __builtin_amdgcn_wave_barrier(); } while (0)

__device__ __forceinline__ int rel_bucket(int n) {
    if (n < 16) return n;
    if (n >= 113) return 31;
    int b = 16;
    b += (n >= 19); b += (n >= 21); b += (n >= 24); b += (n >= 27); b += (n >= 31); b += (n >= 35); b += (n >= 40); b += (n >= 46);
    b += (n >= 52); b += (n >= 59); b += (n >= 67); b += (n >= 77); b += (n >= 87); b += (n >= 99);
    return b;
}

struct Args { const float* in[27]; float* out; unsigned char* ws; int ph_lo, ph_hi; };
#ifndef FFN_F8
#define FFN_F8 1
#endif
struct TrItem { const float* W; bf16* WT; int N, K, k0, n0, drow; float f8scale; };
__device__ __forceinline__ void tr_set(TrItem& T, const float* W, int K, int N, int Npad, bf16* WT, int mode, int item, float f8scale = 0.f) {
    T.f8scale = f8scale;
    const int nblk = Npad / 32, kb = item / nblk, nb = item - kb * nblk, n0 = 32 * nb;
    T.W = W; T.WT = WT; T.N = N; T.K = K; T.k0 = 64 * kb; T.n0 = n0; T.drow = (mode == 0) ? n0 : ((n0 >> 7) * 256 + (mode - 1) * 128 + (n0 & 127));
}
constexpr int TR_I_NSA_IN = (DM / 64) * (NSA_NPAD / 32), TR_I_SQ = (DM / 64) * (DM / 32), TR_I_FFN = (DM / 64) * (DFF / 32), TR_I_FFD = (DFF / 64) * (DM / 32), TR_I_DSA_IN = (DM / 64) * (DSA_NPAD / 32);
constexpr int TR_I_CMP = (4096 / 64) * (128 / 32), TR_I_UK1 = (128 / 64) * (256 / 32), TR_I_UV1 = (256 / 64) * (128 / 32);
constexpr int TR_I_MG1 = (DM / 64) * (DFFE / 32), TR_I_MD1 = (DFFE / 64) * (DM / 32);
constexpr int TR_NITEMS = TR_I_NSA_IN + 2 * TR_I_SQ + 2 * TR_I_FFN + TR_I_FFD + TR_I_DSA_IN + 2 * TR_I_CMP + 16 * TR_I_UK1 + 16 * TR_I_UV1 + 16 * TR_I_MG1 + 8 * TR_I_MD1;
__device__ __forceinline__ void tr_decode(const Args& A, unsigned char* ws, int it, TrItem& T) {
    int r = it;
    if (r < TR_I_NSA_IN) { tr_set(T, A.in[2], DM, NSA_N, NSA_NPAD, (bf16*)(ws + WS_W_NSA_IN), 0, r); return; } r -= TR_I_NSA_IN;
    if (r < TR_I_SQ) { tr_set(T, A.in[9], DM, DM, DM, (bf16*)(ws + WS_W_NSA_OUT), 0, r); return; } r -= TR_I_SQ;
    if (r < TR_I_SQ) { tr_set(T, A.in[14], DM, DM, DM, (bf16*)(ws + WS_W_DSA_OUT), 0, r); return; } r -= TR_I_SQ;
    if (r < TR_I_FFN) { tr_set(T, A.in[15], DM, DFF, DFF, (bf16*)(ws + WS_W_FFN_GU), 1, r, FFN_F8 ? 64.f : 0.f); return; } r -= TR_I_FFN;
    if (r < TR_I_FFN) { tr_set(T, A.in[16], DM, DFF, DFF, (bf16*)(ws + WS_W_FFN_GU), 2, r, FFN_F8 ? 64.f : 0.f); return; } r -= TR_I_FFN;
    if (r < TR_I_FFD) { tr_set(T, A.in[17], DFF, DM, DM, (bf16*)(ws + WS_W_FFN_DN), 0, r, FFN_F8 ? 256.f : 0.f); return; } r -= TR_I_FFD;
    if (r < TR_I_DSA_IN) { tr_set(T, A.in[10], DM, DSA_N, DSA_NPAD, (bf16*)(ws + WS_W_DSA_IN), 0, r); return; } r -= TR_I_DSA_IN;
    if (r < TR_I_CMP) { tr_set(T, A.in[4], 4096, 128, 128, (bf16*)(ws + WS_W_CMPK), 0, r); return; } r -= TR_I_CMP;
    if (r < TR_I_CMP) { tr_set(T, A.in[7], 4096, 128, 128, (bf16*)(ws + WS_W_CMPV), 0, r); return; } r -= TR_I_CMP;
    if (r < 16 * TR_I_UK1) { const int h = r / TR_I_UK1; tr_set(T, A.in[12] + (size_t)h * 128 * 256, 128, 256, 256, (bf16*)(ws + WS_W_UK) + (size_t)h * 256 * 128, 0, r - h * TR_I_UK1); return; } r -= 16 * TR_I_UK1;
    if (r < 16 * TR_I_UV1) { const int h = r / TR_I_UV1; tr_set(T, A.in[13] + (size_t)h * 256 * 128, 256, 128, 128, (bf16*)(ws + WS_W_UV) + (size_t)h * 128 * 256, 0, r - h * TR_I_UV1); return; } r -= 16 * TR_I_UV1;
    if (r < 8 * TR_I_MG1) { const int e = r / TR_I_MG1; tr_set(T, A.in[20] + (size_t)e * DM * DFFE, DM, DFFE, DFFE, (bf16*)(ws + WS_W_MOE_GU + (size_t)e * 2 * DFFE * DM), 1, r - e * TR_I_MG1, 64.f); return; } r -= 8 * TR_I_MG1;
    if (r < 8 * TR_I_MG1) { const int e = r / TR_I_MG1; tr_set(T, A.in[21] + (size_t)e * DM * DFFE, DM, DFFE, DFFE, (bf16*)(ws + WS_W_MOE_GU + (size_t)e * 2 * DFFE * DM), 2, r - e * TR_I_MG1, 64.f); return; } r -= 8 * TR_I_MG1;
    { const int e = r / TR_I_MD1; tr_set(T, A.in[22] + (size_t)e * DFFE * DM, DFFE, DM, DM, (bf16*)(ws + WS_W_MOE_DN + (size_t)e * DM * DFFE), 0, r - e * TR_I_MD1, 256.f); }
}
__device__ __forceinline__ void tr_load(const TrItem& T, f32x4 (&v)[8], int lane) {
    const int kr = lane >> 3, c4 = lane & 7, n = T.n0 + 4 * c4;
#pragma unroll
    for (int i = 0; i < 8; ++i) v[i] = (n < T.N) ? *(const f32x4*)(T.W + (size_t)(T.k0 + 8 * i + kr) * T.N + n) : (f32x4){0.f, 0.f, 0.f, 0.f};
}
__device__ __forceinline__ void tr_store(const TrItem& T, const f32x4 (&v)[8], LAS float* scr, int lane) {
    { const int kr = lane >> 3, c4 = lane & 7;
#pragma unroll
      for (int i = 0; i < 8; ++i) { LAS float* d = scr + (8 * i + kr) * 33 + 4 * c4; d[0] = v[i][0]; d[1] = v[i][1]; d[2] = v[i][2]; d[3] = v[i][3]; } }
    LDS_WAIT(); asm volatile("" ::: "memory");
    const int c = lane & 7;
#pragma unroll
    for (int j = 0; j < 4; ++j) { const int n = (lane >> 3) + 8 * j; const LAS float* s = scr + (8 * c) * 33 + n;
        v4u o; o.x = pg8::cvt_pk_bf16(s[0 * 33], s[1 * 33]); o.y = pg8::cvt_pk_bf16(s[2 * 33], s[3 * 33]); o.z = pg8::cvt_pk_bf16(s[4 * 33], s[5 * 33]); o.w = pg8::cvt_pk_bf16(s[6 * 33], s[7 * 33]);
        *(v4u*)(T.WT + (size_t)(T.drow + n) * T.K + T.k0 + 8 * c) = o; }
    LDS_WAIT(); asm volatile("" ::: "memory");
}

__device__ __forceinline__ void tr_store8(const TrItem& T, const f32x4 (&v)[8], LAS float* scr, int lane) {
    { const int kr = lane >> 3, c4 = lane & 7;
#pragma unroll
      for (int i = 0; i < 8; ++i) { LAS float* d = scr + (8 * i + kr) * 33 + 4 * c4; d[0] = v[i][0]; d[1] = v[i][1]; d[2] = v[i][2]; d[3] = v[i][3]; } }
    LDS_WAIT(); asm volatile("" ::: "memory");
    const int c = lane & 3, nr = lane >> 2; const float sc = T.f8scale;
#pragma unroll
    for (int j = 0; j < 2; ++j) { const int n = nr + 16 * j; const LAS float* s = scr + (16 * c) * 33 + n; int w[4];
#pragma unroll
        for (int q = 0; q < 4; ++q) { w[q] = __builtin_amdgcn_cvt_pk_fp8_f32(s[(4 * q) * 33] * sc, s[(4 * q + 1) * 33] * sc, 0, false); w[q] = __builtin_amdgcn_cvt_pk_fp8_f32(s[(4 * q + 2) * 33] * sc, s[(4 * q + 3) * 33] * sc, w[q], true); }
        v4u o; o.x = (unsigned)w[0]; o.y = (unsigned)w[1]; o.z = (unsigned)w[2]; o.w = (unsigned)w[3];
        *(v4u*)((unsigned char*)T.WT + (size_t)(T.drow + n) * T.K + T.k0 + 16 * c) = o; }
    LDS_WAIT(); asm volatile("" ::: "memory");
}
__device__ __forceinline__ void p0_prologue(Frame& F, const Args& A) {
    LAS float* scr = (LAS float*)(F.lds + RING_OFF + F.wave * 16384);
    unsigned char* ws = A.ws;
    const int gw = F.vcu * NWAVES + F.wave, NGW = F.G * NWAVES, lane = F.lane;
    {
        TrItem T0, T1, T2, T3; f32x4 v0[8], v1[8], v2[8], v3[8]; int it = gw;
#define TR_ISSUE(T, v, idx) do { if ((idx) < TR_NITEMS) { tr_decode(A, ws, (idx), T); tr_load(T, v, lane); } } while (0)
#define TR_RETIRE(T, v, idx) do { if ((idx) < TR_NITEMS) { if (T.f8scale != 0.f) tr_store8(T, v, scr, lane); else tr_store(T, v, scr, lane); } } while (0)
        TR_ISSUE(T0, v0, it); TR_ISSUE(T1, v1, it + NGW); TR_ISSUE(T2, v2, it + 2 * NGW);
        while (it < TR_NITEMS) {
            TR_ISSUE(T3, v3, it + 3 * NGW); TR_RETIRE(T0, v0, it);
            TR_ISSUE(T0, v0, it + 4 * NGW); TR_RETIRE(T1, v1, it + NGW);
            TR_ISSUE(T1, v1, it + 5 * NGW); TR_RETIRE(T2, v2, it + 2 * NGW);
            TR_ISSUE(T2, v2, it + 6 * NGW); TR_RETIRE(T3, v3, it + 3 * NGW);
            it += 4 * NGW;
        }
#undef TR_ISSUE
#undef TR_RETIRE
    }
    { const float* x = A.in[0]; bf16* xb = (bf16*)(ws + WS_XB); const size_t n8 = (size_t)NTOK * DM / 8;
      for (size_t i = (size_t)F.vcu * 512 + F.tid; i < n8; i += (size_t)F.G * 512) { const f32x4 a = *(const f32x4*)(x + i * 8), b = *(const f32x4*)(x + i * 8 + 4);
          v4u o; o.x = pk2(a[0], a[1]); o.y = pk2(a[2], a[3]); o.z = pk2(b[0], b[1]); o.w = pk2(b[2], b[3]); *(v4u*)(xb + i * 8) = o; } }
    for (int it = gw; it < 64; it += NGW) { const int kv = it >> 5, ch = it & 31; const float* pe = A.in[kv ? 6 : 3]; const float* w1 = A.in[kv ? 7 : 4];
        float s0 = 0.f, s1 = 0.f;
        for (int k = ch * 128; k < ch * 128 + 128; ++k) { const float p = pe[k]; s0 += p * w1[(size_t)k * 128 + lane]; s1 += p * w1[(size_t)k * 128 + 64 + lane]; }
        float* cb = (float*)(ws + WS_CBIAS) + (size_t)(kv * 32 + ch) * 128; cb[lane] = s0; cb[64 + lane] = s1; }
}

typedef short s8v __attribute__((ext_vector_type(8)));
__device__ __forceinline__ s8v ld_frag(const bf16* p) { return *(const s8v*)p; }

__device__ __forceinline__ float gelu_tanh(float x) { const float u = 0.7978845608028654f * (x + 0.044715f * x * x * x); return 0.5f * x * (1.0f + tanhf(u)); }
__device__ __forceinline__ void p2_compress(Frame& F, const Args& A) {
    unsigned char* ws = A.ws; const int lane = F.lane, wid = F.wave, tid = F.tid;
    const bf16* P0 = (const bf16*)(ws + WS_P0);
    LAS float* part = (LAS float*)(F.lds + RING_OFF);
    LAS float* hid = (LAS float*)(F.lds + DSA_SCR);
    LAS float* cbl = hid + 4096;
    if (tid < 256) { const float* cbp = (const float*)(ws + WS_CBIAS) + (size_t)(tid >> 7) * 32 * 128 + (tid & 127); float cb = 0.f; for (int ch = 0; ch < 32; ++ch) cb += cbp[ch * 128]; cbl[tid] = cb; }
    if (F.vcu < 16 && wid == 0) { bf16* zp = (bf16*)(ws + ((F.vcu & 1) ? WS_VCMP : WS_KCMP)) + ((size_t)(F.vcu >> 1) * 512 + 511) * 128; zp[lane] = 0; zp[64 + lane] = 0; }
    __syncthreads();
    const int r16 = lane & 15, kq = lane >> 4;
    for (int it = F.vcu; it < 256; it += F.G) {
        const int kv = it >> 7, tile = it & 127;
        const bf16* W1T = (const bf16*)(ws + (kv ? WS_W_CMPV : WS_W_CMPK));
        const float* w2 = A.in[kv ? 8 : 5];
        bf16* outp = (bf16*)(ws + (kv ? WS_VCMP : WS_KCMP));
        const int colbase = kv ? COL_VC : COL_KC;
        f32x4 acc[2][8];
#pragma unroll
        for (int m = 0; m < 2; ++m)
#pragma unroll
            for (int n = 0; n < 8; ++n) acc[m][n] = (f32x4){0.f, 0.f, 0.f, 0.f};
        const bf16* arow[2];
#pragma unroll
        for (int m = 0; m < 2; ++m) { int R = tile * 32 + m * 16 + r16; if (R > 4087) R = 4087; const int g = R & 3, bn = R >> 2, b = bn / NCMP, n = bn - b * NCMP;
            arow[m] = P0 + (size_t)(b * SEQ + 16 * n) * P0LD + colbase + g * 128 + kq * 8; }
#pragma unroll 2
        for (int kk = 0; kk < 16; ++kk) {
            const int ks = wid * 16 + kk, l = ks >> 2, d0 = (ks & 3) * 32;
            s8v af[2], bfr[8];
#pragma unroll
            for (int m = 0; m < 2; ++m) af[m] = ld_frag(arow[m] + (size_t)l * P0LD + d0);
#pragma unroll
            for (int n = 0; n < 8; ++n) bfr[n] = ld_frag(W1T + (size_t)(n * 16 + r16) * 4096 + ks * 32 + kq * 8);
#pragma unroll
            for (int m = 0; m < 2; ++m)
#pragma unroll
                for (int n = 0; n < 8; ++n) acc[m][n] = __builtin_amdgcn_mfma_f32_16x16x32_bf16(af[m], bfr[n], acc[m][n], 0, 0, 0);
        }
#pragma unroll
        for (int m = 0; m < 2; ++m)
#pragma unroll
            for (int n = 0; n < 8; ++n)
#pragma unroll
                for (int j = 0; j < 4; ++j) part[wid * 4096 + (m * 16 + kq * 4 + j) * 128 + n * 16 + r16] = acc[m][n][j];
        __syncthreads();
        { const int row = tid >> 4, e0 = (tid & 15) * 8; f32x4 s0 = (f32x4){0.f, 0.f, 0.f, 0.f}, s1 = s0;
#pragma unroll
          for (int w = 0; w < 8; ++w) { s0 += *(const LAS f32x4*)(part + w * 4096 + row * 128 + e0); s1 += *(const LAS f32x4*)(part + w * 4096 + row * 128 + e0 + 4); }
#pragma unroll
          for (int j = 0; j < 4; ++j) { hid[row * 128 + e0 + j] = gelu_tanh(s0[j] + cbl[kv * 128 + e0 + j]); hid[row * 128 + e0 + 4 + j] = gelu_tanh(s1[j] + cbl[kv * 128 + e0 + 4 + j]); } }
        __syncthreads();
        { const int rr = tid >> 4, f0 = (tid & 15) * 8, R = tile * 32 + rr; f32x4 o0 = (f32x4){0.f, 0.f, 0.f, 0.f}, o1 = o0;
#pragma unroll 4
          for (int e = 0; e < 128; ++e) { const float hv = hid[rr * 128 + e]; o0 += *(const f32x4*)(w2 + e * 128 + f0) * hv; o1 += *(const f32x4*)(w2 + e * 128 + f0 + 4) * hv; }
          if (R <= 4087) { const int g = R & 3, bn = R >> 2, b = bn / NCMP, n = bn - b * NCMP;
              v4u o; o.x = pk2(o0[0], o0[1]); o.y = pk2(o0[2], o0[3]); o.z = pk2(o1[0], o1[1]); o.w = pk2(o1[2], o1[3]);
              *(v4u*)(outp + ((size_t)(b * 4 + g) * 512 + n) * 128 + f0) = o; } }
        __syncthreads();
    }
}

namespace fa {
typedef float f32x16 __attribute__((ext_vector_type(16)));
typedef short s16x4 __attribute__((ext_vector_type(4)));
typedef unsigned u32x4v __attribute__((ext_vector_type(4)));
constexpr int SHM_K = 16384, SHM_V = 16384;
constexpr int OFF_V = 0, OFF_K = 2 * SHM_V, OFF_WS = 2 * SHM_V + 2 * SHM_K, OFF_LUT = OFF_WS + 8 * 256, OFF_MASK = OFF_LUT + 144 * 16 * 4, OFF_TAB = OFF_MASK + 1024;
constexpr int TABLD = 130;
constexpr float C2 = 1.4426950408889634f, THR = 8.f;
#define FA_KSWZ(row, colB) ((row) * 256 + ((colB) ^ (((row) & 7) << 4)))
#define FA_SBAR() __builtin_amdgcn_sched_barrier(0)
__device__ __forceinline__ int v_st(int k, int c) { const int kk = (k & ~0xC) | ((k & 4) << 1) | ((k & 8) >> 1); return ((kk >> 3) * 4 + (c >> 5)) * 512 + ((kk & 7) * 32 + (c & 31)) * 2; }
__device__ __forceinline__ int v_rd_base(int lane) { return ((lane & 3) << 3) | (((lane >> 2) & 3) << 6) | (((lane >> 4) & 1) << 5) | (((lane >> 5) & 1) << 8); }
constexpr int v_rd_off(int d0, int ks, int half) { return d0 * 512 + ks * 4096 + half * 2048; }
__device__ __forceinline__ int crow(int r, int hi) { return (r & 3) + 8 * (r >> 2) + 4 * hi; }
__device__ __forceinline__ unsigned cvtpk(float lo, float hi) { unsigned r; asm volatile("v_cvt_pk_bf16_f32 %0, %1, %2" : "=v"(r) : "v"(lo), "v"(hi)); return r; }

__device__ __forceinline__ void qkt(f32x16& p0, f32x16& p1, const LAS char* Kb, int r32, int hi, const bf16x8 (&qr)[8], float init) {
#pragma unroll
    for (int r = 0; r < 16; ++r) { p0[r] = init; p1[r] = init; }
    const LAS char* kb[4];
#pragma unroll
    for (int dd = 0; dd < 4; ++dd) kb[dd] = Kb + FA_KSWZ(r32, (dd * 16 + hi * 8) * 2);
#pragma unroll
    for (int d0 = 0; d0 < 8; ++d0) { const LAS char* a = kb[d0 & 3] + (d0 >> 2) * 128;
        const bf16x8 b0 = *(const LAS bf16x8*)a;
        const bf16x8 b1 = *(const LAS bf16x8*)(a + 32 * 256);
        p0 = __builtin_amdgcn_mfma_f32_32x32x16_bf16(b0, qr[d0], p0, 0, 0, 0);
        p1 = __builtin_amdgcn_mfma_f32_32x32x16_bf16(b1, qr[d0], p1, 0, 0, 0); }
}
__device__ __forceinline__ void pv_tile(f32x16 (&o)[4], int vb0, bf16x8 pa0, bf16x8 pa1, bf16x8 pa2, bf16x8 pa3) {
#define FA_TRRD(dst, off) asm volatile("ds_read_b64_tr_b16 %0, %1 offset:%2" : "=&v"(dst) : "v"(vb0), "i"(off) : "memory")
#define FA_PV_D0(d0) do { s16x4 l0, l1, l2, l3, h0, h1, h2, h3; constexpr int b_ = v_rd_off(d0, 0, 0); \
        FA_TRRD(l0, b_); FA_TRRD(h0, b_ + 2048); FA_TRRD(l1, b_ + 4096); FA_TRRD(h1, b_ + 6144); FA_TRRD(l2, b_ + 8192); FA_TRRD(h2, b_ + 10240); FA_TRRD(l3, b_ + 12288); FA_TRRD(h3, b_ + 14336); \
        asm volatile("s_waitcnt lgkmcnt(0)" ::: "memory"); FA_SBAR(); \
        o[d0] = __builtin_amdgcn_mfma_f32_32x32x16_bf16(pa0, (bf16x8){l0[0], l0[1], l0[2], l0[3], h0[0], h0[1], h0[2], h0[3]}, o[d0], 0, 0, 0); \
        o[d0] = __builtin_amdgcn_mfma_f32_32x32x16_bf16(pa1, (bf16x8){l1[0], l1[1], l1[2], l1[3], h1[0], h1[1], h1[2], h1[3]}, o[d0], 0, 0, 0); \
        o[d0] = __builtin_amdgcn_mfma_f32_32x32x16_bf16(pa2, (bf16x8){l2[0], l2[1], l2[2], l2[3], h2[0], h2[1], h2[2], h2[3]}, o[d0], 0, 0, 0); \
        o[d0] = __builtin_amdgcn_mfma_f32_32x32x16_bf16(pa3, (bf16x8){l3[0], l3[1], l3[2], l3[3], h3[0], h3[1], h3[2], h3[3]}, o[d0], 0, 0, 0); } while (0)
    FA_PV_D0(0); FA_PV_D0(1); FA_PV_D0(2); FA_PV_D0(3);
#undef FA_PV_D0
#undef FA_TRRD
}
__device__ __forceinline__ void partialSM(f32x16& p0, f32x16& p1, float& m_reg, float& alpha) {
    float pmax = p0[0];
#pragma unroll
    for (int r = 1; r < 16; ++r) pmax = fmaxf(pmax, p0[r]);
#pragma unroll
    for (int r = 0; r < 16; ++r) pmax = fmaxf(pmax, p1[r]);
    { auto rr = __builtin_amdgcn_permlane32_swap(__float_as_uint(pmax), __float_as_uint(pmax), false, false); pmax = fmaxf(__uint_as_float(rr[0]), __uint_as_float(rr[1])); }
    float mn;
    if (__all(pmax - m_reg <= THR)) { mn = m_reg; alpha = 1.f; }
    else { mn = fmaxf(m_reg, pmax); alpha = __builtin_amdgcn_exp2f((m_reg - mn) * C2); m_reg = mn; }
    const float mnL = -mn * C2;
#pragma unroll
    for (int r = 0; r < 16; ++r) { p0[r] = __builtin_amdgcn_exp2f(fmaf(p0[r], C2, mnL)); p1[r] = __builtin_amdgcn_exp2f(fmaf(p1[r], C2, mnL)); }
}
__device__ __forceinline__ float finishSM(const f32x16& p0, const f32x16& p1, bf16x8& pa0, bf16x8& pa1, bf16x8& pa2, bf16x8& pa3) {
    float ps = 0.f;
#pragma unroll
    for (int r = 0; r < 16; ++r) ps += p0[r];
#pragma unroll
    for (int r = 0; r < 16; ++r) ps += p1[r];
    { auto rr = __builtin_amdgcn_permlane32_swap(__float_as_uint(ps), __float_as_uint(ps), false, false); ps = __uint_as_float(rr[0]) + __uint_as_float(rr[1]); }
#define FA_PK4(P, B_, OUT) do { unsigned a0 = cvtpk(P[B_ + 0], P[B_ + 1]), a1 = cvtpk(P[B_ + 2], P[B_ + 3]); unsigned b0 = cvtpk(P[B_ + 4], P[B_ + 5]), b1 = cvtpk(P[B_ + 6], P[B_ + 7]); \
        auto r0 = __builtin_amdgcn_permlane32_swap(a0, b0, false, false); auto r1 = __builtin_amdgcn_permlane32_swap(a1, b1, false, false); \
        u32x4v w = {r0[0], r1[0], r0[1], r1[1]}; OUT = *reinterpret_cast<bf16x8*>(&w); } while (0)
    FA_PK4(p0, 0, pa0); FA_PK4(p0, 8, pa1); FA_PK4(p1, 0, pa2); FA_PK4(p1, 8, pa3);
#undef FA_PK4
    return ps;
}
__device__ __forceinline__ void rescale(f32x16 (&o)[4], float alpha, LAS float* al_l, int r32, int hi) {
    if (__any(alpha < 1.f)) { if (hi == 0) al_l[r32] = alpha; asm volatile("s_waitcnt lgkmcnt(0)" ::: "memory");
#pragma unroll
        for (int r = 0; r < 16; ++r) { const float a = al_l[crow(r, hi)];
#pragma unroll
            for (int d = 0; d < 4; ++d) o[d][r] *= a; }
        asm volatile("s_waitcnt lgkmcnt(0)" ::: "memory"); }
}
__device__ __forceinline__ void mask_tile(f32x16& p0, f32x16& p1, int dq, unsigned W) {
    const float NEG = -__builtin_inff();
#pragma unroll
    for (int r = 0; r < 16; ++r) { const int c = (r & 3) + 8 * (r >> 2);
        if ((unsigned)(dq - c) >= W) p0[r] = NEG;
        if ((unsigned)(dq - c - 32) >= W) p1[r] = NEG; }
}
__device__ __forceinline__ void mask_all(f32x16& p0, f32x16& p1, bool keep) {
    const float NEG = -__builtin_inff();
#pragma unroll
    for (int r = 0; r < 16; ++r) { p0[r] = keep ? p0[r] : NEG; p1[r] = keep ? p1[r] : NEG; }
}
__device__ __forceinline__ void bias_near(f32x16& p0, f32x16& p1, int dq, int step, const LAS float* lutcol) {
#pragma unroll
    for (int r = 0; r < 16; ++r) { const int c = (r & 3) + 8 * (r >> 2);
        const int d0 = min(max((dq - c) * step, 0), 128), d1 = min(max((dq - c - 32) * step, 0), 128);
        p0[r] += lutcol[d0]; p1[r] += lutcol[d1]; }
}
struct Stage { bf16x8 k0, k1, v0, v1; };
__device__ __forceinline__ void stage_load(Stage& S, const bf16* Kp, const bf16* Vp, size_t ld, int row0, int maxrow, int sr, int sc) {
    const int ra = min(row0 + sr, maxrow), rb = min(row0 + 32 + sr, maxrow);
    S.k0 = *(const bf16x8*)(Kp + (size_t)ra * ld + sc); S.k1 = *(const bf16x8*)(Kp + (size_t)rb * ld + sc);
    S.v0 = *(const bf16x8*)(Vp + (size_t)ra * ld + sc); S.v1 = *(const bf16x8*)(Vp + (size_t)rb * ld + sc);
}
__device__ __forceinline__ void stage_write(const Stage& S, LAS char* Kb, LAS char* Vb, int kws, int vst0, int vst1) {
    *(LAS bf16x8*)(Kb + kws) = S.k0; *(LAS bf16x8*)(Kb + kws + 32 * 256) = S.k1;
    *(LAS bf16x8*)(Vb + vst0) = S.v0; *(LAS bf16x8*)(Vb + vst1) = S.v1;
}
}

struct NsaLane { int wid, lane, r32, hi, ql, j, sr, sc, kws, vst0, vst1, vrd; };
__device__ __forceinline__ NsaLane nsa_lane(const Frame& F) {
    NsaLane L; L.wid = F.wave; L.lane = F.lane; L.r32 = F.lane & 31; L.hi = F.lane >> 5; L.ql = L.r32 >> 2; L.j = L.r32 & 3;
    L.sr = F.tid >> 4; L.sc = (F.tid & 15) * 8; L.kws = FA_KSWZ(L.sr, L.sc * 2); L.vst0 = fa::v_st(L.sr, L.sc); L.vst1 = fa::v_st(32 + L.sr, L.sc); L.vrd = fa::v_rd_base(F.lane);
    return L;
}
__device__ __forceinline__ void nsa_load_q(bf16x8 (&qr)[8], const bf16* P0, int tok0, int g, const NsaLane& L) {
    const bf16* qp = P0 + (size_t)(tok0 + L.wid * 8 + L.ql) * P0LD + (g * 4 + L.j) * 128 + L.hi * 8;
#pragma unroll
    for (int d0 = 0; d0 < 8; ++d0) qr[d0] = *(const bf16x8*)(qp + d0 * 16);
}
__device__ __forceinline__ void nsa_lut(Frame& F, const Args& A) {
    LAS float* lut = (LAS float*)(F.lds + RING_OFF + fa::OFF_LUT);
    for (int i = F.tid; i < 144 * 16; i += 512) { const int n = i >> 4, h = i & 15; lut[h * 144 + n] = A.in[1][rel_bucket(n) * 16 + h]; }
    __syncthreads();
}
template <int MODE>
__device__ __forceinline__ void nsa_store(const fa::f32x16 (&o)[4], float l_reg, LAS float* li_l, const float* GL, bf16* OACC, bf16* OATT, int tok0, int g, int br, const NsaLane& L) {
    if (L.hi == 0) li_l[L.r32] = l_reg;
    asm volatile("s_waitcnt lgkmcnt(0)" ::: "memory");
    float sc[16];
#pragma unroll
    for (int r = 0; r < 16; ++r) { const int row = fa::crow(r, L.hi), tok = tok0 + L.wid * 8 + (row >> 2), h = g * 4 + (row & 3); sc[r] = GL[(size_t)tok * 48 + h * 3 + br]; }
    unsigned prev[4][16];
    if (MODE != 0) {
#pragma unroll
        for (int r = 0; r < 16; ++r) { const int row = fa::crow(r, L.hi), tok = tok0 + L.wid * 8 + (row >> 2), h = g * 4 + (row & 3); const bf16* ap = OACC + (size_t)tok * DM + h * 128 + (L.r32 & ~1);
#pragma unroll
            for (int d0 = 0; d0 < 4; ++d0) prev[d0][r] = *(const unsigned*)(ap + d0 * 32); } }
#pragma unroll
    for (int r = 0; r < 16; ++r) { const int row = fa::crow(r, L.hi), tok = tok0 + L.wid * 8 + (row >> 2), h = g * 4 + (row & 3);
        const float l = li_l[row]; const float gl = sc[r];
        const float scl = (l > 0.f) ? __builtin_amdgcn_rcpf(l) / (1.0f + __expf(-gl)) : 0.f;
        bf16* dst = ((MODE == 2) ? OATT : OACC) + (size_t)tok * DM + h * 128 + L.r32;
#pragma unroll
        for (int d0 = 0; d0 < 4; ++d0) { float v = o[d0][r] * scl;
            if (MODE != 0) v += (L.r32 & 1) ? bfhi(prev[d0][r]) : bflo(prev[d0][r]);
            const float vn = dpp_xor1(v); if ((L.r32 & 1) == 0) *(unsigned*)(dst + d0 * 32) = fa::cvtpk(v, vn); } }
    asm volatile("s_waitcnt lgkmcnt(0)" ::: "memory");
}

__device__ __forceinline__ void p3a_nsa_cmp(Frame& F, const Args& A) {
    unsigned char* ws = A.ws; const NsaLane L = nsa_lane(F);
    const bf16* P0 = (const bf16*)(ws + WS_P0); const bf16* KCB = (const bf16*)(ws + WS_KCMP); const bf16* VCB = (const bf16*)(ws + WS_VCMP);
    const float* GL = (const float*)(ws + WS_GL); bf16* OACC = (bf16*)(ws + WS_Z + 64 * MiB); unsigned* SELM = (unsigned*)(ws + WS_SELM);
    nsa_lut(F, A);
    LAS char* lds = (LAS char*)(F.lds + RING_OFF);
    LAS float* wsf = (LAS float*)(lds + fa::OFF_WS) + L.wid * 64; LAS float* li_l = wsf; LAS float* al_l = wsf + 32;
    const LAS float* lut = (const LAS float*)(lds + fa::OFF_LUT);
    LAS float* tab = (LAS float*)(lds + fa::OFF_TAB);
    for (int ui = 0; ui < 2 * ((512 - F.vcu + F.G - 1) / F.G); ++ui) {
        const int p = F.vcu + (ui >> 1) * F.G, bg = p >> 6, y = p & 63, qb = (ui & 1) ? 127 - y : y, b = bg >> 2, g = bg & 3;
        const int tok0 = b * SEQ + qb * 64;
        bf16x8 qr[8]; nsa_load_q(qr, P0, tok0, g, L);
        const int trow = qb * 64 + L.wid * 8 + L.ql;
        const int h = g * 4 + L.j; const LAS float* lutcol = lut + h * 144; const float bias_far = lutcol[128];
        const int nmaxrow = (trow >= 31) ? (trow - 31) >> 4 : -1;
        const int NT = (4 * qb + 3 + 63) >> 6;
        const bf16* Kg = KCB + (size_t)(b * 4 + g) * 512 * 128; const bf16* Vg = VCB + (size_t)(b * 4 + g) * 512 * 128;
        for (int i = F.tid; i < 64 * fa::TABLD; i += 512) tab[i] = 0.f;
        float m_reg = -1e30f, l_reg = 0.f;
        fa::Stage S;
        const int rem16 = (trow >= 31) ? ((trow - 31) & 15) : 0;
        fa::stage_load(S, Kg, Vg, 128, 0, 511, L.sr, L.sc); asm volatile("s_waitcnt vmcnt(0)" ::: "memory");
        fa::stage_write(S, lds + fa::OFF_K, lds + fa::OFF_V, L.kws, L.vst0, L.vst1);
        __syncthreads();
#pragma unroll 1
        for (int t = 0; t < NT; ++t) {
            const int buf = t & 1;
            if (t + 1 < NT) fa::stage_load(S, Kg, Vg, 128, (t + 1) * 64, 511, L.sr, L.sc);
            fa::f32x16 p0, p1;
            const bool farT = (qb * 64 + L.wid * 8) - 31 - 16 * (t * 64 + 63) >= 128;
            fa::qkt(p0, p1, lds + fa::OFF_K + buf * fa::SHM_K, L.r32, L.hi, qr, farT ? bias_far : 0.f);
            const int dq = nmaxrow - t * 64 - 4 * L.hi;
            if (!farT) fa::bias_near(p0, p1, dq, 16, lutcol + rem16);
            fa::mask_tile(p0, p1, dq, 0x40000000u);
            float alpha; fa::partialSM(p0, p1, m_reg, alpha);
            float ps = 0.f;
#pragma unroll
            for (int r = 0; r < 16; ++r) ps += p0[r] + p1[r];
            { auto rr = __builtin_amdgcn_permlane32_swap(__float_as_uint(ps), __float_as_uint(ps), false, false); ps = __uint_as_float(rr[0]) + __uint_as_float(rr[1]); }
            l_reg = l_reg * alpha + ps;
            if (t + 1 < NT) { asm volatile("s_waitcnt vmcnt(0)" ::: "memory"); fa::stage_write(S, lds + fa::OFF_K + (buf ^ 1) * fa::SHM_K, lds + fa::OFF_V + (buf ^ 1) * fa::SHM_V, L.kws, L.vst0, L.vst1); }
            __syncthreads();
        }
        fa::f32x16 o[4];
#pragma unroll
        for (int d = 0; d < 4; ++d)
#pragma unroll
            for (int r = 0; r < 16; ++r) o[d][r] = 0.f;
        fa::stage_load(S, Kg, Vg, 128, 0, 511, L.sr, L.sc); asm volatile("s_waitcnt vmcnt(0)" ::: "memory");
        fa::stage_write(S, lds + fa::OFF_K, lds + fa::OFF_V, L.kws, L.vst0, L.vst1);
        __syncthreads();
        const float inv_l = (l_reg > 0.f) ? 1.0f / l_reg : 0.f; const float mnL = -m_reg * fa::C2;
#pragma unroll 1
        for (int t = 0; t < NT; ++t) {
            const int buf = t & 1;
            if (t + 1 < NT) fa::stage_load(S, Kg, Vg, 128, (t + 1) * 64, 511, L.sr, L.sc);
            fa::f32x16 p0, p1;
            const bool farT = (qb * 64 + L.wid * 8) - 31 - 16 * (t * 64 + 63) >= 128;
            fa::qkt(p0, p1, lds + fa::OFF_K + buf * fa::SHM_K, L.r32, L.hi, qr, farT ? bias_far : 0.f);
            const int dq = nmaxrow - t * 64 - 4 * L.hi;
            if (!farT) fa::bias_near(p0, p1, dq, 16, lutcol + rem16);
            fa::mask_tile(p0, p1, dq, 0x40000000u);
#pragma unroll
            for (int r = 0; r < 16; ++r) { p0[r] = __builtin_amdgcn_exp2f(fmaf(p0[r], fa::C2, mnL)) * inv_l; p1[r] = __builtin_amdgcn_exp2f(fmaf(p1[r], fa::C2, mnL)) * inv_l; }
            LAS float* tb = tab + (L.wid * 8 + L.ql) * fa::TABLD + t * 16 + L.hi;
#pragma unroll
            for (int half = 0; half < 2; ++half)
#pragma unroll
                for (int gq = 0; gq < 4; ++gq) { const fa::f32x16& pp = half ? p1 : p0;
                    float s4 = pp[4 * gq] + pp[4 * gq + 1] + pp[4 * gq + 2] + 0.5f * pp[4 * gq + 3], cr = 0.5f * pp[4 * gq + 3];
                    s4 += dpp_xor1(s4); s4 += dpp_xor2(s4); cr += dpp_xor1(cr); cr += dpp_xor2(cr);
                    if (L.j == 0) { __hip_atomic_fetch_add(tb + half * 8 + 2 * gq, s4, __ATOMIC_RELAXED, __HIP_MEMORY_SCOPE_WORKGROUP); __hip_atomic_fetch_add(tb + half * 8 + 2 * gq + 1, cr, __ATOMIC_RELAXED, __HIP_MEMORY_SCOPE_WORKGROUP); } }
            bf16x8 a0, a1, a2, a3; (void)fa::finishSM(p0, p1, a0, a1, a2, a3);
            fa::pv_tile(o, (int)(uintptr_t)(lds + fa::OFF_V + buf * fa::SHM_V) + L.vrd, a0, a1, a2, a3);
            if (t + 1 < NT) { asm volatile("s_waitcnt vmcnt(0)" ::: "memory"); fa::stage_write(S, lds + fa::OFF_K + (buf ^ 1) * fa::SHM_K, lds + fa::OFF_V + (buf ^ 1) * fa::SHM_V, L.kws, L.vst0, L.vst1); }
            __syncthreads();
        }
        nsa_store<0>(o, (l_reg > 0.f) ? 1.0f : 0.f, li_l, GL, OACC, nullptr, tok0, g, 0, L);
        __syncthreads();
        {
            bool s0[8], s1[8];
            if (qb < 16) {
#pragma unroll
                for (int qi = 0; qi < 8; ++qi) { s0[qi] = (L.lane <= qb); s1[qi] = false; }
            } else {
                unsigned k0[8], k1[8], lo[8];
#pragma unroll
                for (int qi = 0; qi < 8; ++qi) { const int ql = L.wid * 8 + qi;
                    const bool c0 = (L.lane >= 1 && L.lane <= qb - 2), c1 = (L.lane + 64 <= qb - 2);
                    k0[qi] = c0 ? __float_as_uint(tab[ql * fa::TABLD + L.lane]) + 1u : 0u; k1[qi] = c1 ? __float_as_uint(tab[ql * fa::TABLD + L.lane + 64]) + 1u : 0u;
                    s0[qi] = (L.lane == 0) || (L.lane == qb) || (L.lane == qb - 1); s1[qi] = (L.lane + 64 == qb) || (L.lane + 64 == qb - 1); lo[qi] = 0u; }
#pragma unroll 1
                for (int bit = 30; bit >= 0; --bit) {
#pragma unroll
                    for (int qi = 0; qi < 8; ++qi) { const unsigned cand = lo[qi] | (1u << bit);
                        const int cnt = __popcll(__ballot(k0[qi] >= cand)) + __popcll(__ballot(k1[qi] >= cand));
                        lo[qi] = (cnt >= 13) ? cand : lo[qi]; } }
#pragma unroll
                for (int qi = 0; qi < 8; ++qi) { const unsigned T = lo[qi];
                    const bool g0 = k0[qi] > T, g1 = k1[qi] > T, e0 = k0[qi] == T, e1 = k1[qi] == T;
                    const int need = 13 - (__popcll(__ballot(g0)) + __popcll(__ballot(g1)));
                    const unsigned long long be0 = __ballot(e0), be1 = __ballot(e1);
                    const int r0 = (int)__builtin_amdgcn_mbcnt_hi((unsigned)(be0 >> 32), __builtin_amdgcn_mbcnt_lo((unsigned)be0, 0u));
                    const int r1 = __popcll(be0) + (int)__builtin_amdgcn_mbcnt_hi((unsigned)(be1 >> 32), __builtin_amdgcn_mbcnt_lo((unsigned)be1, 0u));
                    s0[qi] = s0[qi] || g0 || (e0 && r0 < need); s1[qi] = s1[qi] || g1 || (e1 && r1 < need); }
            }
#pragma unroll
            for (int qi = 0; qi < 8; ++qi) { const int ql = L.wid * 8 + qi; const unsigned long long b0 = __ballot(s0[qi]), b1 = __ballot(s1[qi]);
                if (L.lane == 0) { uint4 mv; mv.x = (unsigned)b0; mv.y = (unsigned)(b0 >> 32); mv.z = (unsigned)b1; mv.w = (unsigned)(b1 >> 32); *(uint4*)(SELM + ((size_t)(tok0 + ql) * 4 + g) * 4) = mv; } }
        }
        __syncthreads();
    }
}
constexpr int N3_OFF_V = 0, N3_OFF_K = 3 * fa::SHM_V, N3_OFF_WS = 3 * fa::SHM_V + 3 * fa::SHM_K, N3_OFF_LUT = N3_OFF_WS + 8 * 256;
__device__ __forceinline__ void nsa_lut3(Frame& F, const Args& A) {
    LAS float* lut = (LAS float*)(F.lds + RING_OFF + N3_OFF_LUT);
    for (int i = F.tid; i < 144 * 16; i += 512) { const int n = i >> 4, h = i & 15; lut[h * 144 + n] = A.in[1][rel_bucket(n) * 16 + h]; }
    __syncthreads();
}
__device__ __forceinline__ void p3b_nsa_sel(Frame& F, const Args& A) {
    unsigned char* ws = A.ws; const NsaLane L = nsa_lane(F);
    const bf16* P0 = (const bf16*)(ws + WS_P0); const float* GL = (const float*)(ws + WS_GL); bf16* OACC = (bf16*)(ws + WS_Z + 64 * MiB); const unsigned* SELM = (const unsigned*)(ws + WS_SELM);
    nsa_lut3(F, A);
    LAS char* lds = (LAS char*)(F.lds + RING_OFF);
    LAS float* wsf = (LAS float*)(lds + N3_OFF_WS) + L.wid * 64; LAS float* li_l = wsf; LAS float* al_l = wsf + 32;
    const LAS float* lut = (const LAS float*)(lds + N3_OFF_LUT);
    const bool grpB = L.wid >= 4;
    for (int ui = 0; ui < 2 * ((512 - F.vcu + F.G - 1) / F.G); ++ui) {
        const int p = F.vcu + (ui >> 1) * F.G, bg = p >> 6, y = p & 63, qb = (ui & 1) ? 127 - y : y, b = bg >> 2, g = bg & 3;
        const int tok0 = b * SEQ + qb * 64;
        bf16x8 qr[8]; nsa_load_q(qr, P0, tok0, g, L);
        const int trow = qb * 64 + L.wid * 8 + L.ql;
        const int h = g * 4 + L.j; const LAS float* lutcol = lut + h * 144; const float bias_far = lutcol[128];
        const uint4 mv = *(const uint4*)(SELM + ((size_t)(tok0 + L.wid * 8 + L.ql) * 4 + g) * 4);
        const bf16* Kg = P0 + (size_t)b * SEQ * P0LD + COL_KS + g * 128; const bf16* Vg = P0 + (size_t)b * SEQ * P0LD + COL_VS + g * 128;
        const int NT = qb + 1;
        float m_reg = -1e30f, l_reg = 0.f; fa::f32x16 o[4];
#pragma unroll
        for (int d = 0; d < 4; ++d)
#pragma unroll
            for (int r = 0; r < 16; ++r) o[d][r] = 0.f;
        fa::Stage Sa, Sb;
        fa::stage_load(Sa, Kg, Vg, P0LD, 0, SEQ - 1, L.sr, L.sc); asm volatile("s_waitcnt vmcnt(0)" ::: "memory");
        fa::stage_write(Sa, lds + N3_OFF_K, lds + N3_OFF_V, L.kws, L.vst0, L.vst1);
        if (NT > 1) fa::stage_load(Sb, Kg, Vg, P0LD, 64, SEQ - 1, L.sr, L.sc);
        __syncthreads();
        bf16x8 a0 = {0, 0, 0, 0, 0, 0, 0, 0}, a1 = a0, a2 = a0, a3 = a0; bool actp = false;
        int bcur = 0, bprev = 2;
#define P3B_STEP(t, SNEXT2, SNEXT1) do { \
            const int bnext = (bcur == 2) ? 0 : bcur + 1; \
            if ((t) + 2 < NT) fa::stage_load(SNEXT2, Kg, Vg, P0LD, ((t) + 2) * 64, SEQ - 1, L.sr, L.sc); \
            FA_SBAR();     \
            const unsigned word = ((t) < 32) ? mv.x : ((t) < 64) ? mv.y : ((t) < 96) ? mv.z : mv.w; \
            const bool mine = ((word >> ((t) & 31)) & 1u) != 0u; \
            const bool act = __any(mine); \
            if (grpB && actp) fa::pv_tile(o, (int)(uintptr_t)(lds + N3_OFF_V + bprev * fa::SHM_V) + L.vrd, a0, a1, a2, a3); \
            if (act) { \
                fa::f32x16 p0, p1; \
                const bool farT = (qb * 64 + L.wid * 8) - ((t) * 64 + 63) >= 128; \
                fa::qkt(p0, p1, lds + N3_OFF_K + bcur * fa::SHM_K, L.r32, L.hi, qr, mine ? (farT ? bias_far : 0.f) : -__builtin_inff()); \
                const int dq = trow - (t) * 64 - 4 * L.hi; \
                if (!farT) fa::bias_near(p0, p1, dq, 1, lutcol); \
                if ((t) == qb) fa::mask_tile(p0, p1, dq, 0x40000000u); \
                float alpha; fa::partialSM(p0, p1, m_reg, alpha); \
                fa::rescale(o, alpha, al_l, L.r32, L.hi); \
                const float ps = fa::finishSM(p0, p1, a0, a1, a2, a3); l_reg = l_reg * alpha + ps; \
                if (!grpB) fa::pv_tile(o, (int)(uintptr_t)(lds + N3_OFF_V + bcur * fa::SHM_V) + L.vrd, a0, a1, a2, a3); \
            } \
            actp = act; \
            if ((t) + 1 < NT) fa::stage_write(SNEXT1, lds + N3_OFF_K + bnext * fa::SHM_K, lds + N3_OFF_V + bnext * fa::SHM_V, L.kws, L.vst0, L.vst1);     \
            __syncthreads(); \
            bprev = bcur; bcur = bnext; } while (0)
#pragma unroll 1
        for (int t = 0; t < NT; t += 2) {
            P3B_STEP(t, Sa, Sb);
            if (t + 1 < NT) P3B_STEP(t + 1, Sb, Sa);
        }
#undef P3B_STEP
        if (grpB && actp) fa::pv_tile(o, (int)(uintptr_t)(lds + N3_OFF_V + bprev * fa::SHM_V) + L.vrd, a0, a1, a2, a3);
        nsa_store<1>(o, l_reg, li_l, GL, OACC, nullptr, tok0, g, 1, L);
        __syncthreads();
    }
}
__device__ __forceinline__ void p3c_nsa_win(Frame& F, const Args& A) {
    unsigned char* ws = A.ws; const NsaLane L = nsa_lane(F);
    const bf16* P0 = (const bf16*)(ws + WS_P0); const float* GL = (const float*)(ws + WS_GL); bf16* OACC = (bf16*)(ws + WS_Z + 64 * MiB); bf16* OATT = (bf16*)(ws + WS_OATT0);
    nsa_lut(F, A);
    LAS char* lds = (LAS char*)(F.lds + RING_OFF);
    LAS float* wsf = (LAS float*)(lds + fa::OFF_WS) + L.wid * 64; LAS float* li_l = wsf; LAS float* al_l = wsf + 32;
    const LAS float* lut = (const LAS float*)(lds + fa::OFF_LUT);
    for (int u = F.vcu; u < 1024; u += F.G) {
        const int bg = u >> 7, qb = u & 127, b = bg >> 2, g = bg & 3;
        const int tok0 = b * SEQ + qb * 64;
        bf16x8 qr[8]; nsa_load_q(qr, P0, tok0, g, L);
        const int trow = qb * 64 + L.wid * 8 + L.ql;
        const int h = g * 4 + L.j; const LAS float* lutcol = lut + h * 144; const float bias_far = lutcol[128];
        const bf16* Kg = P0 + (size_t)b * SEQ * P0LD + COL_KW + g * 128; const bf16* Vg = P0 + (size_t)b * SEQ * P0LD + COL_VW + g * 128;
        const int t0 = max(0, qb - 8), NT = qb - t0 + 1;
        float m_reg = -1e30f, l_reg = 0.f; fa::f32x16 o[4];
#pragma unroll
        for (int d = 0; d < 4; ++d)
#pragma unroll
            for (int r = 0; r < 16; ++r) o[d][r] = 0.f;
        fa::Stage S;
        fa::stage_load(S, Kg, Vg, P0LD, t0 * 64, SEQ - 1, L.sr, L.sc); asm volatile("s_waitcnt vmcnt(0)" ::: "memory");
        fa::stage_write(S, lds + fa::OFF_K, lds + fa::OFF_V, L.kws, L.vst0, L.vst1);
        __syncthreads();
#pragma unroll 1
        for (int tt = 0; tt < NT; ++tt) {
            const int buf = tt & 1, t = t0 + tt;
            if (tt + 1 < NT) fa::stage_load(S, Kg, Vg, P0LD, (t + 1) * 64, SEQ - 1, L.sr, L.sc);
            fa::f32x16 p0, p1;
            const bool farT = (qb * 64 + L.wid * 8) - (t * 64 + 63) >= 128;
            fa::qkt(p0, p1, lds + fa::OFF_K + buf * fa::SHM_K, L.r32, L.hi, qr, farT ? bias_far : 0.f);
            const int dq = trow - t * 64 - 4 * L.hi;
            if (!farT) fa::bias_near(p0, p1, dq, 1, lutcol);
            if (t == qb || t == t0) fa::mask_tile(p0, p1, dq, 512u);
            float alpha; fa::partialSM(p0, p1, m_reg, alpha);
            fa::rescale(o, alpha, al_l, L.r32, L.hi);
            bf16x8 a0, a1, a2, a3; const float ps = fa::finishSM(p0, p1, a0, a1, a2, a3); l_reg = l_reg * alpha + ps;
            fa::pv_tile(o, (int)(uintptr_t)(lds + fa::OFF_V + buf * fa::SHM_V) + L.vrd, a0, a1, a2, a3);
            if (tt + 1 < NT) { asm volatile("s_waitcnt vmcnt(0)" ::: "memory"); fa::stage_write(S, lds + fa::OFF_K + (buf ^ 1) * fa::SHM_K, lds + fa::OFF_V + (buf ^ 1) * fa::SHM_V, L.kws, L.vst0, L.vst1); }
            __syncthreads();
        }
        nsa_store<2>(o, l_reg, li_l, GL, OACC, OATT, tok0, g, 2, L);
        __syncthreads();
    }
}

template <bool ROUTE, bool F8 = false>
__device__ __forceinline__ void ln_phase(Frame& F, const Args& A, const bf16* Z, const float* gam, const float* bet, bf16* XH, unsigned char* X8) {
    const int gw = F.vcu * NWAVES + F.wave, NGW = F.G * NWAVES, lane = F.lane;
    LAS float* wrl = (LAS float*)(F.lds + RING_OFF);
    if (ROUTE) { for (int i = F.tid; i < DM * 8 / 4; i += 512) *(LAS f32x4*)(wrl + i * 4) = *(const f32x4*)(A.in[18] + i * 4); __syncthreads(); }
    for (int row = gw; row < NTOK; row += NGW) {
        const uint2* zr = (const uint2*)(Z + (size_t)row * DM) + lane;
        f32x4 v[8]; float s = 0.f;
#pragma unroll
        for (int j = 0; j < 8; ++j) { const uint2 z2 = zr[64 * j]; v[j] = (f32x4){bflo(z2.x), bfhi(z2.x), bflo(z2.y), bfhi(z2.y)}; s += (v[j][0] + v[j][1]) + (v[j][2] + v[j][3]); }
        const float mean = wave_sum(s) * (1.f / DM); float s2 = 0.f;
#pragma unroll
        for (int j = 0; j < 8; ++j) { v[j] = v[j] - mean; s2 += (v[j][0] * v[j][0] + v[j][1] * v[j][1]) + (v[j][2] * v[j][2] + v[j][3] * v[j][3]); }
        const float rstd = 1.f / sqrtf(wave_sum(s2) * (1.f / DM) + LN_EPS);
        float lg[8];
#pragma unroll
        for (int e = 0; e < 8; ++e) lg[e] = 0.f;
#pragma unroll
        for (int j = 0; j < 8; ++j) { const int c = 4 * lane + 256 * j; const f32x4 gg = *(const f32x4*)(gam + c), bb = *(const f32x4*)(bet + c);
            const f32x4 x = v[j] * rstd * gg + bb;
            { uint2 o; o.x = pk2(x[0], x[1]); o.y = pk2(x[2], x[3]); *(uint2*)(XH + (size_t)row * DM + c) = o; }
            if (F8) { int w = __builtin_amdgcn_cvt_pk_fp8_f32(x[0], x[1], 0, false); w = __builtin_amdgcn_cvt_pk_fp8_f32(x[2], x[3], w, true); *(int*)(X8 + (size_t)row * DM + c) = w; }
            asm volatile("" ::: "memory");
            if (ROUTE) { const LAS float* wr = wrl + c * 8;
#pragma unroll
                for (int q = 0; q < 4; ++q) { const f32x4 w0 = *(const LAS f32x4*)(wr + q * 8), w1 = *(const LAS f32x4*)(wr + q * 8 + 4);
                    lg[0] += x[q] * w0[0]; lg[1] += x[q] * w0[1]; lg[2] += x[q] * w0[2]; lg[3] += x[q] * w0[3]; lg[4] += x[q] * w1[0]; lg[5] += x[q] * w1[1]; lg[6] += x[q] * w1[2]; lg[7] += x[q] * w1[3]; }  asm volatile("" ::: "memory"); }
        }
        if (ROUTE) {
#pragma unroll
            for (int e = 0; e < 8; ++e) lg[e] = wave_sum(lg[e]) + A.in[19][e];
            int e0 = 0; float l0 = lg[0];
#pragma unroll
            for (int e = 1; e < 8; ++e) if (lg[e] > l0) { l0 = lg[e]; e0 = e; }
            int e1 = -1; float l1 = -3e38f;
#pragma unroll
            for (int e = 0; e < 8; ++e) if (e != e0 && lg[e] > l1) { l1 = lg[e]; e1 = e; }
            const float w0 = 1.0f / (1.0f + __expf(l1 - l0)), w1 = 1.0f - w0;
            if (lane == 0) {
                const unsigned p0 = __hip_atomic_fetch_add((unsigned*)(F.ctl + CW_MOECNT + 64 * e0), 1u, __ATOMIC_RELAXED, __HIP_MEMORY_SCOPE_AGENT);
                const unsigned p1 = __hip_atomic_fetch_add((unsigned*)(F.ctl + CW_MOECNT + 64 * e1), 1u, __ATOMIC_RELAXED, __HIP_MEMORY_SCOPE_AGENT);
                int* re = (int*)(A.ws + WS_ROUTE); int* rp = re + 2 * NTOK; float* rw = (float*)(rp + 2 * NTOK);
                re[2 * row] = e0; re[2 * row + 1] = e1; rp[2 * row] = (int)p0; rp[2 * row + 1] = (int)p1; rw[2 * row] = w0; rw[2 * row + 1] = w1;
            }
        }
    }
}

__device__ __forceinline__ void ln_route_phase(Frame& F, const Args& A, const bf16* Z, const float* gam, const float* bet, bf16* XH) {
    const int gw = F.vcu * NWAVES + F.wave, NGW = F.G * NWAVES, lane = F.lane;
    LAS float* wrl = (LAS float*)(F.lds + RING_OFF);
    LAS float* rowb = (LAS float*)(F.lds + RING_OFF + 65536 + F.wave * 8192);
    for (int i = F.tid; i < DM * 8 / 4; i += 512) *(LAS f32x4*)(wrl + i * 4) = *(const f32x4*)(A.in[18] + i * 4);
    __syncthreads();
    for (int row = gw; row < NTOK; row += NGW) {
        float s = 0.f, s2 = 0.f;
#pragma unroll 1
        for (int j = 0; j < 8; ++j) { const uint2 z2 = *(const uint2*)(Z + (size_t)row * DM + 4 * lane + 256 * j); const f32x4 v = (f32x4){bflo(z2.x), bfhi(z2.x), bflo(z2.y), bfhi(z2.y)}; *(LAS f32x4*)(rowb + 4 * lane + 256 * j) = v;
            s += (v[0] + v[1]) + (v[2] + v[3]); }
        const float mean = wave_sum(s) * (1.f / DM);
#pragma unroll 1
        for (int j = 0; j < 8; ++j) { const f32x4 v = *(const LAS f32x4*)(rowb + 4 * lane + 256 * j) - mean; s2 += (v[0] * v[0] + v[1] * v[1]) + (v[2] * v[2] + v[3] * v[3]); }
        const float rstd = 1.f / sqrtf(wave_sum(s2) * (1.f / DM) + LN_EPS);
        float lg[8];
#pragma unroll
        for (int e = 0; e < 8; ++e) lg[e] = 0.f;
#pragma unroll 1
        for (int j = 0; j < 8; ++j) { const int c = 4 * lane + 256 * j; const f32x4 gg = *(const f32x4*)(gam + c), bb = *(const f32x4*)(bet + c);
            const f32x4 x = (*(const LAS f32x4*)(rowb + c) - mean) * rstd * gg + bb;
            { uint2 o; o.x = pk2(x[0], x[1]); o.y = pk2(x[2], x[3]); *(uint2*)(XH + (size_t)row * DM + c) = o; }
            const LAS float* wr = wrl + c * 8;
#pragma unroll
            for (int q = 0; q < 4; ++q) { const f32x4 w0 = *(const LAS f32x4*)(wr + q * 8), w1 = *(const LAS f32x4*)(wr + q * 8 + 4);
                lg[0] += x[q] * w0[0]; lg[1] += x[q] * w0[1]; lg[2] += x[q] * w0[2]; lg[3] += x[q] * w0[3]; lg[4] += x[q] * w1[0]; lg[5] += x[q] * w1[1]; lg[6] += x[q] * w1[2]; lg[7] += x[q] * w1[3]; } }
#pragma unroll
        for (int e = 0; e < 8; ++e) lg[e] = wave_sum(lg[e]) + A.in[19][e];
        int e0 = 0; float l0 = lg[0];
#pragma unroll
        for (int e = 1; e < 8; ++e) if (lg[e] > l0) { l0 = lg[e]; e0 = e; }
        int e1 = -1; float l1 = -3e38f;
#pragma unroll
        for (int e = 0; e < 8; ++e) if (e != e0 && lg[e] > l1) { l1 = lg[e]; e1 = e; }
        const float w0 = 1.0f / (1.0f + __expf(l1 - l0)), w1 = 1.0f - w0;
        if (lane == 0) {
            const unsigned p0 = __hip_atomic_fetch_add((unsigned*)(F.ctl + CW_MOECNT + 64 * e0), 1u, __ATOMIC_RELAXED, __HIP_MEMORY_SCOPE_AGENT);
            const unsigned p1 = __hip_atomic_fetch_add((unsigned*)(F.ctl + CW_MOECNT + 64 * e1), 1u, __ATOMIC_RELAXED, __HIP_MEMORY_SCOPE_AGENT);
            int* re = (int*)(A.ws + WS_ROUTE); int* rp = re + 2 * NTOK; float* rw = (float*)(rp + 2 * NTOK);
            re[2 * row] = e0; re[2 * row + 1] = e1; rp[2 * row] = (int)p0; rp[2 * row + 1] = (int)p1; rw[2 * row] = w0; rw[2 * row + 1] = w1;
        }
        WSYNC();
    }
    __syncthreads();
}

__device__ __forceinline__ void p10_dsa_prep(Frame& F, const Args& A) {
    unsigned char* ws = A.ws; const int lane = F.lane;
    const int gw = F.vcu * NWAVES + F.wave, NGW = F.G * NWAVES;
    { const float* CR = (const float*)(ws + WS_CRAW); bf16* CN = (bf16*)(ws + WS_CN); const f32x4 gg = *(const f32x4*)(A.in[11] + 4 * lane);
      for (int row = gw; row < NTOK; row += NGW) { const f32x4 v = *(const f32x4*)(CR + (size_t)row * KVR + 4 * lane);
          const float ss = wave_sum(v[0] * v[0] + v[1] * v[1] + v[2] * v[2] + v[3] * v[3]); const float r = 1.f / sqrtf(ss * (1.f / KVR) + RMS_EPS);
          uint2 o; o.x = pk2(v[0] * r * gg[0], v[1] * r * gg[1]); o.y = pk2(v[2] * r * gg[2], v[3] * r * gg[3]); *(uint2*)(CN + (size_t)row * KVR + 4 * lane) = o;
          if (lane < 16) { const f32x4 kv = *(const f32x4*)((const float*)(ws + WS_KIWI) + (size_t)row * 128 + 4 * lane); uint2 k2; k2.x = pk2(kv[0], kv[1]); k2.y = pk2(kv[2], kv[3]); *(uint2*)((bf16*)(ws + WS_KIB) + (size_t)row * 64 + 4 * lane) = k2; } } }
    const bf16* Q = (const bf16*)(ws + WS_Q); const bf16* UKT = (const bf16*)(ws + WS_W_UK); bf16* QL = (bf16*)(ws + WS_QLAT);
    const int r16 = lane & 15, kq = lane >> 4; const float sc = 0.08838834764831845f;
    for (int it = gw; it < 512 * 16 * 4; it += NGW) {
        const int nc = it & 3, h = (it >> 2) & 15, mt = it >> 6;
        f32x4 acc[2][4];
#pragma unroll
        for (int m = 0; m < 2; ++m)
#pragma unroll
            for (int n = 0; n < 4; ++n) acc[m][n] = (f32x4){0.f, 0.f, 0.f, 0.f};
#pragma unroll
        for (int ks = 0; ks < 4; ++ks) { s8v af[2], bfr[4];
#pragma unroll
            for (int m = 0; m < 2; ++m) af[m] = ld_frag(Q + (size_t)(mt * 32 + m * 16 + r16) * DM + h * 128 + ks * 32 + kq * 8);
#pragma unroll
            for (int n = 0; n < 4; ++n) bfr[n] = ld_frag(UKT + ((size_t)h * 256 + nc * 64 + n * 16 + r16) * 128 + ks * 32 + kq * 8);
#pragma unroll
            for (int m = 0; m < 2; ++m)
#pragma unroll
                for (int n = 0; n < 4; ++n) acc[m][n] = __builtin_amdgcn_mfma_f32_16x16x32_bf16(bfr[n], af[m], acc[m][n], 0, 0, 0); }
#pragma unroll
        for (int m = 0; m < 2; ++m)
#pragma unroll
            for (int n = 0; n < 4; ++n) { uint2 o; o.x = pg8::cvt_pk_bf16(acc[m][n][0] * sc, acc[m][n][1] * sc); o.y = pg8::cvt_pk_bf16(acc[m][n][2] * sc, acc[m][n][3] * sc);
                *(uint2*)(QL + (size_t)(mt * 32 + m * 16 + r16) * 4096 + h * 256 + nc * 64 + n * 16 + kq * 4) = o; }
    }
}
__device__ __forceinline__ void p12_dsa_uv(Frame& F, const Args& A) {
    unsigned char* ws = A.ws; const int lane = F.lane;
    const int gw = F.vcu * NWAVES + F.wave, NGW = F.G * NWAVES;
    const bf16* OL = (const bf16*)(ws + WS_OLAT); const bf16* UVT = (const bf16*)(ws + WS_W_UV); bf16* O = (bf16*)(ws + WS_OATT1);
    const int r16 = lane & 15, kq = lane >> 4;
    for (int it = gw; it < 512 * 16 * 2; it += NGW) {
        const int nc = it & 1, h = (it >> 1) & 15, mt = it >> 5;
        f32x4 acc[2][4];
#pragma unroll
        for (int m = 0; m < 2; ++m)
#pragma unroll
            for (int n = 0; n < 4; ++n) acc[m][n] = (f32x4){0.f, 0.f, 0.f, 0.f};
#pragma unroll
        for (int ks = 0; ks < 8; ++ks) { s8v af[2], bfr[4];
#pragma unroll
            for (int m = 0; m < 2; ++m) af[m] = ld_frag(OL + (size_t)(mt * 32 + m * 16 + r16) * 4096 + h * 256 + ks * 32 + kq * 8);
#pragma unroll
            for (int n = 0; n < 4; ++n) bfr[n] = ld_frag(UVT + ((size_t)h * 128 + nc * 64 + n * 16 + r16) * 256 + ks * 32 + kq * 8);
#pragma unroll
            for (int m = 0; m < 2; ++m)
#pragma unroll
                for (int n = 0; n < 4; ++n) acc[m][n] = __builtin_amdgcn_mfma_f32_16x16x32_bf16(bfr[n], af[m], acc[m][n], 0, 0, 0); }
#pragma unroll
        for (int m = 0; m < 2; ++m)
#pragma unroll
            for (int n = 0; n < 4; ++n) { uint2 o; o.x = pg8::cvt_pk_bf16(acc[m][n][0], acc[m][n][1]); o.y = pg8::cvt_pk_bf16(acc[m][n][2], acc[m][n][3]);
                *(uint2*)(O + (size_t)(mt * 32 + m * 16 + r16) * DM + h * 128 + nc * 64 + n * 16 + kq * 4) = o; }
    }
}

__device__ __forceinline__ unsigned f2key(float f) { const unsigned u = __float_as_uint(f); return (u & 0x80000000u) ? ~u : (u | 0x80000000u); }

__device__ __forceinline__ unsigned dsa_off_b(unsigned row, unsigned ch) { return 256u * row + 16u * (ch ^ (((row & 3) << 2) | ((row >> 2) & 3))); }

__device__ __forceinline__ float key2f(unsigned k) { return __uint_as_float((k & 0x80000000u) ? (k & 0x7fffffffu) : ~k); }
__device__ __forceinline__ void p13a_dsa_index(Frame& F, const Args& A) {
    unsigned char* ws = A.ws; const int lane = F.lane, wid = F.wave, r32 = lane & 31, hi = lane >> 5;
    const bf16* QI = (const bf16*)(ws + WS_QI); const bf16* KIB = (const bf16*)(ws + WS_KIB); const float* KIWI = (const float*)(ws + WS_KIWI); int* IDX = (int*)(ws + WS_IDX);
    LAS float* sc = (LAS float*)(F.lds + RING_OFF);
    LAS unsigned* hist = (LAS unsigned*)(F.lds + DSA_SCR);
    LAS unsigned* cntG = hist + 1024;
    LAS unsigned* cntE = cntG + 512;
    LAS unsigned* qm = cntE + 512;
    LAS float* mmx = (LAS float*)(qm + 64);
    LAS unsigned* candk = (LAS unsigned*)(mmx + 64);
    constexpr int CAP = 256;
    const int q = wid >> 1, sub = wid & 1, th = sub * 64 + lane;
    for (int slot = F.vcu; slot < NTOK / 4; slot += F.G) {
        const int rowi = slot >> 8; int cc = slot & 255; if (rowi & 1) cc = 255 - cc;
        const int tok0 = (rowi * 256 + cc) * 4, b = tok0 >> 13, t0 = tok0 & (SEQ - 1), tmax = t0 + 3;
        bf16x8 qa[4];
#pragma unroll
        for (int s = 0; s < 4; ++s) qa[s] = *(const bf16x8*)(QI + (size_t)(tok0 + (r32 >> 3)) * 512 + (r32 & 7) * 64 + 16 * s + 8 * hi);
        float wv[16];
#pragma unroll
        for (int r = 0; r < 16; ++r) wv[r] = KIWI[(size_t)(tok0 + (r >> 2)) * 128 + 64 + (r & 3) + 4 * hi] * 0.35355339059327373f;
        const int ntiles = (tmax >> 5) + 1;
        hist[q * 256 + th] = 0u; hist[q * 256 + 128 + th] = 0u; if (th == 0) qm[q * 16 + 2] = 0u;
        float mn0 = 3e38f, mx0 = -3e38f, mn1 = 3e38f, mx1 = -3e38f;
        {
            bf16x8 kb[4], kn[4]; int tile = wid;
#pragma unroll
            for (int s = 0; s < 4; ++s) { kb[s] = (bf16x8){0, 0, 0, 0, 0, 0, 0, 0}; kn[s] = kb[s]; }
            if (tile < ntiles) { const bf16* kp = KIB + (size_t)(b * SEQ + tile * 32 + r32) * 64 + 8 * hi;
#pragma unroll
                for (int s = 0; s < 4; ++s) kb[s] = *(const bf16x8*)(kp + 16 * s); }
            while (tile < ntiles) {
                const int tn = tile + 8;
                if (tn < ntiles) { const bf16* kp = KIB + (size_t)(b * SEQ + tn * 32 + r32) * 64 + 8 * hi;
#pragma unroll
                    for (int s = 0; s < 4; ++s) kn[s] = *(const bf16x8*)(kp + 16 * s); }
                const int key = tile * 32 + r32;
                fa::f32x16 acc;
#pragma unroll
                for (int r = 0; r < 16; ++r) acc[r] = 0.f;
#pragma unroll
                for (int s = 0; s < 4; ++s) acc = __builtin_amdgcn_mfma_f32_32x32x16_bf16(qa[s], kb[s], acc, 0, 0, 0);
                float tot[4];
#pragma unroll
                for (int qq = 0; qq < 4; ++qq) { float part = 0.f;
#pragma unroll
                    for (int r3 = 0; r3 < 4; ++r3) part += wv[4 * qq + r3] * fmaxf(acc[4 * qq + r3], 0.f);
                    tot[qq] = sum_xor32(part) + 0.0f; }
                const float ta = hi ? tot[2] : tot[0], tb = hi ? tot[3] : tot[1];
                sc[(2 * hi) * 8192 + key] = ta; sc[(2 * hi + 1) * 8192 + key] = tb;
                if (key <= t0 + 2 * hi) { mn0 = fminf(mn0, ta); mx0 = fmaxf(mx0, ta); }
                if (key <= t0 + 2 * hi + 1) { mn1 = fminf(mn1, tb); mx1 = fmaxf(mx1, tb); }
#pragma unroll
                for (int s = 0; s < 4; ++s) kb[s] = kn[s];
                tile = tn;
            }
        }
#pragma unroll
        for (int o = 1; o < 32; o <<= 1) { mn0 = fminf(mn0, __shfl_xor(mn0, o)); mx0 = fmaxf(mx0, __shfl_xor(mx0, o)); mn1 = fminf(mn1, __shfl_xor(mn1, o)); mx1 = fmaxf(mx1, __shfl_xor(mx1, o)); }
        if (r32 == 0) { mmx[(wid * 4 + 2 * hi) * 2] = mn0; mmx[(wid * 4 + 2 * hi) * 2 + 1] = mx0; mmx[(wid * 4 + 2 * hi + 1) * 2] = mn1; mmx[(wid * 4 + 2 * hi + 1) * 2 + 1] = mx1; }
        __syncthreads();
        const int tok = tok0 + q, n = t0 + q + 1;
        if (tmax + 1 <= TOPK) {
            for (int i = th; i < TOPK; i += 128) IDX[(size_t)tok * TOPK + i] = (i < n) ? i : 0;
        } else {
            const LAS float* scq = sc + q * 8192; const int nsl = (n + 127) >> 7;
            float fmn = 3e38f, fmx = -3e38f;
#pragma unroll
            for (int w = 0; w < 8; ++w) { fmn = fminf(fmn, mmx[(w * 4 + q) * 2]); fmx = fmaxf(fmx, mmx[(w * 4 + q) * 2 + 1]); }
            const float bsc = (fmx > fmn) ? 255.99f / (fmx - fmn) : 0.f;
            for (int s0 = 0; s0 < nsl; s0 += 8) { float v[8];
#pragma unroll
                for (int j = 0; j < 8; ++j) { const int i = (s0 + j) * 128 + th; v[j] = scq[min(i, n - 1)]; }
#pragma unroll
                for (int j = 0; j < 8; ++j) { const int i = (s0 + j) * 128 + th; const int bin = min(max((int)((v[j] - fmn) * bsc), 0), 255);
                    LAS unsigned* tgt = (i < n) ? &hist[q * 256 + bin] : &qm[q * 16 + 8];
                    __hip_atomic_fetch_add(tgt, 1u, __ATOMIC_RELAXED, __HIP_MEMORY_SCOPE_WORKGROUP); } }
            __syncthreads();
            if (sub == 0) {
                const v4u c4 = *(const LAS v4u*)(hist + q * 256 + 4 * lane); const unsigned s4 = c4.x + c4.y + c4.z + c4.w; unsigned S = s4;
#pragma unroll
                for (int o = 1; o < 64; o <<= 1) { const unsigned v = __shfl_down(S, o); if (lane + o < 64) S += v; }
                const unsigned above = S - s4;
                if (above < (unsigned)TOPK && (unsigned)TOPK <= S) { unsigned cum = above; int bin;
                    if (cum + c4.w >= (unsigned)TOPK) bin = 3; else { cum += c4.w; if (cum + c4.z >= (unsigned)TOPK) bin = 2; else { cum += c4.z; if (cum + c4.y >= (unsigned)TOPK) bin = 1; else { cum += c4.y; bin = 0; } } }
                    qm[q * 16 + 0] = (unsigned)(4 * lane + bin); qm[q * 16 + 1] = (unsigned)TOPK - cum; }
            }
            __syncthreads();
            const int bstar = (int)qm[q * 16 + 0]; const unsigned need1 = qm[q * 16 + 1];
            for (int s0 = 0; s0 < nsl; s0 += 8) { float v[8];
#pragma unroll
                for (int j = 0; j < 8; ++j) { const int i = (s0 + j) * 128 + th; v[j] = scq[min(i, n - 1)]; }
#pragma unroll
                for (int j = 0; j < 8; ++j) { const int i = (s0 + j) * 128 + th; const int bin = min(max((int)((v[j] - fmn) * bsc), 0), 255);
                    if (i < n && bin == bstar) { const unsigned pc = __hip_atomic_fetch_add(&qm[q * 16 + 2], 1u, __ATOMIC_RELAXED, __HIP_MEMORY_SCOPE_WORKGROUP); if (pc < (unsigned)CAP) candk[q * CAP + pc] = f2key(v[j]); } } }
            __syncthreads();
            if (sub == 0) {
                const unsigned mc = qm[q * 16 + 2]; unsigned T = 0u, nt = 0u; bool found = false;
                if (mc <= (unsigned)CAP) {
                    unsigned kc[4], gt[4], ge[4];
#pragma unroll
                    for (int c = 0; c < 4; ++c) { kc[c] = (lane + 64 * c < (int)mc) ? candk[q * CAP + lane + 64 * c] : 0u; gt[c] = 0u; ge[c] = 0u; }
                    for (unsigned j = 0; j < mc; ++j) { const unsigned kj = candk[q * CAP + j];
#pragma unroll
                        for (int c = 0; c < 4; ++c) { gt[c] += (kj > kc[c]) ? 1u : 0u; ge[c] += (kj >= kc[c]) ? 1u : 0u; } }
#pragma unroll
                    for (int c = 0; c < 4; ++c) if (lane + 64 * c < (int)mc && gt[c] < need1 && need1 <= ge[c]) { T = kc[c]; nt = need1 - gt[c]; found = true; }
                } else {
                    unsigned lo = 0u;
                    for (int bit = 31; bit >= 0; --bit) { const unsigned cand = lo | (1u << bit); unsigned c = 0u;
                        for (int i = lane; i < n; i += 64) c += (f2key(scq[i]) >= cand) ? 1u : 0u;
#pragma unroll
                        for (int o = 1; o < 64; o <<= 1) c += __shfl_xor(c, o);
                        if (c >= (unsigned)TOPK) lo = cand; }
                    unsigned cg = 0u;
                    for (int i = lane; i < n; i += 64) cg += (f2key(scq[i]) > lo) ? 1u : 0u;
#pragma unroll
                    for (int o = 1; o < 64; o <<= 1) cg += __shfl_xor(cg, o);
                    T = lo; nt = (unsigned)TOPK - cg; found = (lane == 0);
                }
                if (found) { qm[q * 16 + 0] = T; qm[q * 16 + 1] = nt; }
            }
            __syncthreads();
            const unsigned T = qm[q * 16 + 0], need = qm[q * 16 + 1];
            unsigned Gs = 0u, Es = 0u;
            for (int s0 = 0; s0 < nsl; s0 += 8) { float v[8];
#pragma unroll
                for (int j = 0; j < 8; ++j) { const int i = (s0 + j) * 128 + th; v[j] = scq[min(i, n - 1)]; }
#pragma unroll
                for (int j = 0; j < 8; ++j) { const int i = (s0 + j) * 128 + th; const bool ok = i < n; const unsigned k = f2key(v[j]);
                    Gs += (unsigned)__popcll(__ballot(ok && k > T)); Es += (unsigned)__popcll(__ballot(ok && k == T)); } }
            if (lane == 0) { qm[q * 16 + 10 + sub * 2] = Gs; qm[q * 16 + 11 + sub * 2] = Es; }
            __syncthreads();
            const unsigned G0 = qm[q * 16 + 10], E0 = qm[q * 16 + 11], E1 = qm[q * 16 + 13];
            bool slow = false;
#pragma unroll
            for (int qx = 0; qx < 4; ++qx) slow = slow || (qm[qx * 16 + 11] + qm[qx * 16 + 13] != qm[qx * 16 + 1]);
            (void)E1;
            if (!slow) {
                unsigned run = sub ? (G0 + E0) : 0u;
                for (int s0 = 0; s0 < nsl; s0 += 8) { float v[8];
#pragma unroll
                    for (int j = 0; j < 8; ++j) { const int i = (s0 + j) * 128 + th; v[j] = scq[min(i, n - 1)]; }
#pragma unroll
                    for (int j = 0; j < 8; ++j) { const int i = (s0 + j) * 128 + th; const bool sel = (i < n) && f2key(v[j]) >= T; const unsigned long long bs = __ballot(sel);
                        const unsigned pos = run + __builtin_amdgcn_mbcnt_hi((unsigned)(bs >> 32), __builtin_amdgcn_mbcnt_lo((unsigned)bs, 0u));
                        if (sel && pos < (unsigned)TOPK) candk[q * CAP + pos] = (unsigned)i; run += (unsigned)__popcll(bs); } }
            } else {
            unsigned myG = 0u, myE = 0u;
            for (int s0 = 0; s0 < nsl; s0 += 8) { float v[8];
#pragma unroll
                for (int j = 0; j < 8; ++j) { const int i = (s0 + j) * 128 + th; v[j] = scq[min(i, n - 1)]; }
#pragma unroll
                for (int j = 0; j < 8; ++j) { const int s2 = s0 + j, i = s2 * 128 + th; const bool ok = i < n; const unsigned k = f2key(v[j]); const unsigned long long bg = __ballot(ok && k > T), be = __ballot(ok && k == T);
                    const unsigned cg = (unsigned)__popcll(bg), ce = (unsigned)__popcll(be); myG = (lane == s2) ? cg : myG; myE = (lane == s2) ? ce : myE; } }
            cntG[(q * 2 + sub) * 64 + lane] = myG; cntE[(q * 2 + sub) * 64 + lane] = myE;
            __syncthreads();
            unsigned tbase, pbase;
            { const unsigned e0 = cntE[(q * 2) * 64 + lane], e1 = cntE[(q * 2 + 1) * 64 + lane], g0 = cntG[(q * 2) * 64 + lane], g1 = cntG[(q * 2 + 1) * 64 + lane];
              unsigned inc = e0 + e1;
#pragma unroll
              for (int o = 1; o < 64; o <<= 1) { const unsigned v = __shfl_up(inc, o); if (lane >= o) inc += v; }
              const unsigned tb0 = inc - (e0 + e1), tb1 = tb0 + e0;
              const unsigned se0 = (need > tb0) ? min(need - tb0, e0) : 0u, se1 = (need > tb1) ? min(need - tb1, e1) : 0u;
              const unsigned c0 = g0 + se0, c1 = g1 + se1; unsigned inc2 = c0 + c1;
#pragma unroll
              for (int o = 1; o < 64; o <<= 1) { const unsigned v = __shfl_up(inc2, o); if (lane >= o) inc2 += v; }
              const unsigned pb0 = inc2 - (c0 + c1);
              tbase = sub ? tb1 : tb0; pbase = sub ? pb0 + c0 : pb0; }
            for (int s0 = 0; s0 < nsl; s0 += 8) { float v[8];
#pragma unroll
                for (int j = 0; j < 8; ++j) { const int i = (s0 + j) * 128 + th; v[j] = scq[min(i, n - 1)]; }
#pragma unroll
                for (int j = 0; j < 8; ++j) { const int s2 = s0 + j; if (s2 < nsl) { const int i = s2 * 128 + th; const bool ok = i < n; const unsigned k = f2key(v[j]); const bool g = ok && k > T, e = ok && k == T;
                    const unsigned long long be = __ballot(e);
                    const unsigned trank = (unsigned)__builtin_amdgcn_readlane((int)tbase, s2) + __builtin_amdgcn_mbcnt_hi((unsigned)(be >> 32), __builtin_amdgcn_mbcnt_lo((unsigned)be, 0u));
                    const bool sel = g || (e && trank < need);
                    const unsigned long long bs = __ballot(sel);
                    const unsigned pos = (unsigned)__builtin_amdgcn_readlane((int)pbase, s2) + __builtin_amdgcn_mbcnt_hi((unsigned)(bs >> 32), __builtin_amdgcn_mbcnt_lo((unsigned)bs, 0u));
                    if (sel && pos < (unsigned)TOPK) candk[q * CAP + pos] = (unsigned)i; } } }
            }
        }
        __syncthreads();
        if (tmax + 1 > TOPK) { for (int i = th; i < TOPK; i += 128) IDX[(size_t)tok * TOPK + i] = (int)candk[q * CAP + i]; }
    }
}

__device__ __forceinline__ void p13b_dsa_attn(Frame& F, const Args& A) {
    unsigned char* ws = A.ws; const int lane = F.lane, wid = F.wave, c16 = lane & 15, g4 = lane >> 4;
    const bf16* CN = (const bf16*)(ws + WS_CN); const bf16* QL = (const bf16*)(ws + WS_QLAT); const int* IDX = (const int*)(ws + WS_IDX); bf16* OL = (bf16*)(ws + WS_OLAT);
    LAS float* lut = (LAS float*)(F.lds + DSA_SCR + 8192);
    for (int i = F.tid; i < 144 * 16; i += 512) { const int n = i >> 4, h = i & 15; lut[i] = A.in[1][rel_bucket(n) * 16 + h]; }
    __syncthreads();
    LAS char* img = (LAS char*)(F.lds + RING_OFF + wid * 16384);
    LAS int* idxw = (LAS int*)(F.lds + DSA_SCR + wid * 1024);
    const unsigned imgb = (unsigned)(uintptr_t)img;
    const int gw = F.vcu * NWAVES + wid, NGW = F.G * NWAVES;
    const unsigned prow0 = 8u * ((lane >> 2) & 3) + (lane & 3);
    unsigned ta0[8], ta1[8];
    { const unsigned qq = (lane & 15) >> 2, pp = lane & 3;
#pragma unroll
      for (int c = 0; c < 8; ++c) { ta0[c] = imgb + dsa_off_b(8 * g4 + qq, 2 * c + (pp >> 1)) + 8 * (pp & 1); ta1[c] = imgb + dsa_off_b(8 * g4 + 4 + qq, 2 * c + (pp >> 1)) + 8 * (pp & 1); } }
    for (int tok = gw; tok < NTOK; tok += NGW) {
        const int b = tok >> 13, t = tok & (SEQ - 1), cnt = min(TOPK, t + 1), ntile = (cnt + 31) >> 5;
        bf16x8 qb[8];
#pragma unroll
        for (int ks = 0; ks < 8; ++ks) qb[ks] = *(const bf16x8*)(QL + (size_t)tok * 4096 + c16 * 256 + ks * 32 + g4 * 8);
#pragma unroll
        for (int i = 0; i < 4; ++i) idxw[lane + 64 * i] = IDX[(size_t)tok * TOPK + lane + 64 * i];
        WSYNC();
        f32x4 o[16];
#pragma unroll
        for (int ct = 0; ct < 16; ++ct) o[ct] = (f32x4){0.f, 0.f, 0.f, 0.f};
        float m_run = -1e30f, l_run = 0.f;
        const LAS float* lutcol = lut + c16;
#pragma unroll 1
        for (int tile = 0; tile < ntile; ++tile) {
            { v4u st[16];
#pragma unroll
              for (int i = 0; i < 16; ++i) { const int nn = lane + 64 * i, row = nn >> 5, chg = nn & 31; const int key = idxw[tile * 32 + row];
                  st[i] = *(const v4u*)(CN + (size_t)(b * SEQ + key) * KVR + chg * 8); }
#pragma unroll
              for (int i = 0; i < 16; ++i) { const int nn = lane + 64 * i, row = nn >> 5, chg = nn & 31;
                  *(LAS v4u*)(img + (chg >> 4) * 8192 + dsa_off_b(row, chg & 15)) = st[i]; } }
            WSYNC();
            f32x4 sacc[2];
#pragma unroll
            for (int T = 0; T < 2; ++T) { sacc[T] = (f32x4){0.f, 0.f, 0.f, 0.f};
#pragma unroll
                for (int ks = 0; ks < 8; ++ks) { const bf16x8 a = *(const LAS bf16x8*)(img + (ks >> 2) * 8192 + dsa_off_b(prow0 + 4 * T, 4 * (ks & 3) + g4));
                    sacc[T] = __builtin_amdgcn_mfma_f32_16x16x32_bf16(a, qb[ks], sacc[T], 0, 0, 0); } }
            float pmax = -__builtin_inff();
#pragma unroll
            for (int T = 0; T < 2; ++T) { const int i0 = tile * 32 + 8 * g4 + 4 * T; const v4u kk = *(const LAS v4u*)(idxw + i0);
                const int kidx[4] = {(int)kk.x, (int)kk.y, (int)kk.z, (int)kk.w};
#pragma unroll
                for (int e = 0; e < 4; ++e) { const int dist = min(max(t - kidx[e], 0), 128); float s = sacc[T][e] + lutcol[dist * 16];
                    s = (i0 + e < cnt) ? s : -__builtin_inff(); sacc[T][e] = s; pmax = fmaxf(pmax, s); } }
            pmax = max_xor16(pmax); pmax = max_xor32(pmax);
            const float mn = fmaxf(m_run, pmax), alpha = __builtin_amdgcn_exp2f((m_run - mn) * fa::C2); m_run = mn;
            float ps = 0.f;
#pragma unroll
            for (int T = 0; T < 2; ++T)
#pragma unroll
                for (int e = 0; e < 4; ++e) { const float pv = __builtin_amdgcn_exp2f((sacc[T][e] - mn) * fa::C2); sacc[T][e] = pv; ps += pv; }
            ps = sum_xor16(ps); ps = sum_xor32(ps);
            l_run = l_run * alpha + ps;
            if (__any(alpha < 1.f)) {
                float al[4];
#pragma unroll
                for (int e = 0; e < 4; ++e) al[e] = __shfl(alpha, 4 * g4 + e);
#pragma unroll
                for (int ct = 0; ct < 16; ++ct)
#pragma unroll
                    for (int e = 0; e < 4; ++e) o[ct][e] *= al[e];
            }
            fa::u32x4v pw; pw.x = fa::cvtpk(sacc[0][0], sacc[0][1]); pw.y = fa::cvtpk(sacc[0][2], sacc[0][3]); pw.z = fa::cvtpk(sacc[1][0], sacc[1][1]); pw.w = fa::cvtpk(sacc[1][2], sacc[1][3]);
            const bf16x8 pa = *reinterpret_cast<bf16x8*>(&pw);
#pragma unroll
            for (int cg = 0; cg < 4; ++cg) { fa::s16x4 b0[4], b1[4];
                asm volatile("ds_read_b64_tr_b16 %0, %8 offset:%c16\n\tds_read_b64_tr_b16 %1, %9 offset:%c16\n\tds_read_b64_tr_b16 %2, %10 offset:%c16\n\tds_read_b64_tr_b16 %3, %11 offset:%c16\n\t"
                             "ds_read_b64_tr_b16 %4, %12 offset:%c16\n\tds_read_b64_tr_b16 %5, %13 offset:%c16\n\tds_read_b64_tr_b16 %6, %14 offset:%c16\n\tds_read_b64_tr_b16 %7, %15 offset:%c16\n\ts_waitcnt lgkmcnt(0)"
                             : "=&v"(b0[0]), "=&v"(b1[0]), "=&v"(b0[1]), "=&v"(b1[1]), "=&v"(b0[2]), "=&v"(b1[2]), "=&v"(b0[3]), "=&v"(b1[3])
                             : "v"(ta0[(cg & 1) * 4 + 0]), "v"(ta1[(cg & 1) * 4 + 0]), "v"(ta0[(cg & 1) * 4 + 1]), "v"(ta1[(cg & 1) * 4 + 1]), "v"(ta0[(cg & 1) * 4 + 2]), "v"(ta1[(cg & 1) * 4 + 2]), "v"(ta0[(cg & 1) * 4 + 3]), "v"(ta1[(cg & 1) * 4 + 3]), "i"((cg >> 1) * 8192) : "memory");
                FA_SBAR();
#pragma unroll
                for (int k = 0; k < 4; ++k) o[cg * 4 + k] = __builtin_amdgcn_mfma_f32_16x16x32_bf16(pa, (bf16x8){b0[k][0], b0[k][1], b0[k][2], b0[k][3], b1[k][0], b1[k][1], b1[k][2], b1[k][3]}, o[cg * 4 + k], 0, 0, 0); }
            WSYNC();
        }
        { const float il = (l_run > 0.f) ? 1.0f / l_run : 0.f; float ile[4];
#pragma unroll
          for (int e = 0; e < 4; ++e) ile[e] = __shfl(il, 4 * g4 + e);
#pragma unroll
          for (int ct = 0; ct < 16; ++ct)
#pragma unroll
              for (int e = 0; e < 4; ++e) { const float v = o[ct][e] * ile[e]; const float vn = dpp_xor1(v);
                  if ((lane & 1) == 0) *(unsigned*)(OL + (size_t)tok * 4096 + (4 * g4 + e) * 256 + ct * 16 + c16) = fa::cvtpk(v, vn); } }
        WSYNC();
    }
    __syncthreads();
}

struct MoeTiles { int tend[8]; int pstart[8]; int MT; };
__device__ __forceinline__ void moe_tiles(Frame& F, MoeTiles& T) {
    int acc = 0;
#pragma unroll
    for (int e = 0; e < 8; ++e) { const int c = (int)__builtin_amdgcn_readfirstlane(__hip_atomic_load((unsigned*)(F.ctl + CW_MOECNT + 64 * e), __ATOMIC_RELAXED, __HIP_MEMORY_SCOPE_AGENT));
        T.pstart[e] = acc * 256; acc += (c + 255) >> 8; T.tend[e] = acc; }
    T.MT = acc;
}
__device__ __forceinline__ void p15_gather(Frame& F, const Args& A) {
    MoeTiles T; moe_tiles(F, T);
    const int gw = F.vcu * NWAVES + F.wave, NGW = F.G * NWAVES, lane = F.lane;
    const bf16* XH = (const bf16*)(A.ws + WS_XF); unsigned char* XG = (unsigned char*)(A.ws + WS_XG);
    const int* re = (const int*)(A.ws + WS_ROUTE); const int* rp = re + 2 * NTOK;
    for (int tok = gw; tok < NTOK; tok += NGW) {
        v4u v[2];
#pragma unroll
        for (int j = 0; j < 2; ++j) { const bf16* src = XH + (size_t)tok * DM + 16 * lane + 1024 * j; int w[4];
#pragma unroll
            for (int q = 0; q < 4; ++q) { const uint2 xx = *(const uint2*)(src + 4 * q); w[q] = __builtin_amdgcn_cvt_pk_fp8_f32(bflo(xx.x), bfhi(xx.x), 0, false); w[q] = __builtin_amdgcn_cvt_pk_fp8_f32(bflo(xx.y), bfhi(xx.y), w[q], true); }
            v[j].x = (unsigned)w[0]; v[j].y = (unsigned)w[1]; v[j].z = (unsigned)w[2]; v[j].w = (unsigned)w[3]; }
#pragma unroll
        for (int s = 0; s < 2; ++s) { const int e = re[2 * tok + s], p = rp[2 * tok + s]; int ps = 0;
#pragma unroll
            for (int q = 0; q < 8; ++q) ps = (q == e) ? T.pstart[q] : ps;
            unsigned char* dst = XG + (size_t)(ps + p) * DM + 16 * lane;
#pragma unroll
            for (int j = 0; j < 2; ++j) *(v4u*)(dst + 1024 * j) = v[j]; }
    }
}
__device__ __forceinline__ void p18_final(Frame& F, const Args& A) {
    MoeTiles T; moe_tiles(F, T);
    const int gw = F.vcu * NWAVES + F.wave, NGW = F.G * NWAVES, lane = F.lane;
    const bf16* XH = (const bf16*)(A.ws + WS_XF); const bf16* Y = (const bf16*)(A.ws + WS_Y);
    const int* re = (const int*)(A.ws + WS_ROUTE); const int* rp = re + 2 * NTOK; const float* rw = (const float*)(rp + 2 * NTOK);
    const float* gam = A.in[25] + DM; const float* bet = A.in[26] + DM;
    for (int tok = gw; tok < NTOK; tok += NGW) {
        int rows[2]; float w[2];
#pragma unroll
        for (int s = 0; s < 2; ++s) { const int e = re[2 * tok + s]; int ps = 0;
#pragma unroll
            for (int q = 0; q < 8; ++q) ps = (q == e) ? T.pstart[q] : ps;
            rows[s] = ps + rp[2 * tok + s]; w[s] = rw[2 * tok + s]; }
        const uint2* xr = (const uint2*)(XH + (size_t)tok * DM) + lane; const uint2* y0 = (const uint2*)(Y + (size_t)rows[0] * DM) + lane; const uint2* y1 = (const uint2*)(Y + (size_t)rows[1] * DM) + lane;
        f32x4 v[8]; float s = 0.f;
#pragma unroll
        for (int j = 0; j < 8; ++j) { const uint2 a = y0[64 * j], bq = y1[64 * j]; const f32x4 ya = (f32x4){bflo(a.x), bfhi(a.x), bflo(a.y), bfhi(a.y)}, yb = (f32x4){bflo(bq.x), bfhi(bq.x), bflo(bq.y), bfhi(bq.y)};
            const uint2 xq = xr[64 * j]; const f32x4 xv = (f32x4){bflo(xq.x), bfhi(xq.x), bflo(xq.y), bfhi(xq.y)};
            v[j] = xv * ALPHA + ya * w[0] + yb * w[1]; s += (v[j][0] + v[j][1]) + (v[j][2] + v[j][3]); }
        const float mean = wave_sum(s) * (1.f / DM); float s2 = 0.f;
#pragma unroll
        for (int j = 0; j < 8; ++j) { v[j] = v[j] - mean; s2 += (v[j][0] * v[j][0] + v[j][1] * v[j][1]) + (v[j][2] * v[j][2] + v[j][3] * v[j][3]); }
        const float rstd = 1.f / sqrtf(wave_sum(s2) * (1.f / DM) + LN_EPS);
#pragma unroll
        for (int j = 0; j < 8; ++j) { const int c = 4 * lane + 256 * j; const f32x4 gg = *(const f32x4*)(gam + c), bb = *(const f32x4*)(bet + c);
            *(f32x4*)(A.out + (size_t)tok * DM + c) = v[j] * rstd * gg + bb; }
    }
}

__global__ void __launch_bounds__(NWAVES * 64, 2) mega_fwd(Args args) {
    extern __shared__ __attribute__((aligned(16))) unsigned char lds[];
    Frame F;
    F.lds = (LAS unsigned char*)lds;
    F.MISC = (volatile LAS unsigned*)(F.lds + MISC_OFF);
    F.tid = threadIdx.x; F.lane = F.tid & 63; F.wave = __builtin_amdgcn_readfirstlane(F.tid >> 6);
    F.G = gridDim.x; { const int bx = blockIdx.x; F.vcu = (F.G % 8 == 0) ? (bx % 8) * (F.G / 8) + bx / 8 : bx; }
    unsigned char* ws = args.ws;
    F.ctl = (gu32*)(ws + WS_CTL);
    for (int u = F.tid; u < (LDS_BYTES - LDSCTL_OFF) / 4; u += NWAVES * 64) ((LAS unsigned*)(F.lds + LDSCTL_OFF))[u] = 0u;
    __syncthreads();
    XcdBarrier bar; bar.bar = (unsigned*)(F.ctl + CW_BAR); bar.x = 0; bar.st = nullptr;
#if !MK_PER_PHASE
    bar = xcd_barrier_post((unsigned*)(F.ctl + CW_BAR), F.MISC + 8);
#define GRID_BAR() xcd_barrier(bar)
#else
#define GRID_BAR() do { } while (0)
#endif
    const int lo = args.ph_lo, hi = args.ph_hi;
#ifndef PH_MASK
#define PH_MASK 0x3fffff
#endif
#define IN(k) (((PH_MASK >> (k)) & 1) && lo <= (k) && (k) < hi)
#define BOTH(k) (IN(k) && IN((k) + 1))
    bf16* XB = (bf16*)(ws + WS_XB); bf16* XH = (bf16*)(ws + WS_XF); bf16* Z = (bf16*)(ws + WS_Z);

#ifndef PROBE_MASK
#define PROBE_MASK 0
#endif
#define REPS(k) ((((PROBE_MASK) >> (k)) & 1) ? 2 : 1)
    if (IN(0)) for (int rep_ = 0; rep_ < REPS(0); ++rep_) { relaunder(F); p0_prologue(F, args); if (BOTH(0) || rep_ + 1 < REPS(0)) GRID_BAR(); }
    if (IN(1)) for (int rep_ = 0; rep_ < REPS(1); ++rep_) { relaunder(F);
        pg8::Gemm g{XB, (const bf16*)(ws + WS_W_NSA_IN), NTOK, NSA_NPAD, DM}; pg8::StaticOrder S; S.init(NTOK, NSA_NPAD, F.G, (int)blockIdx.x);
        pg8::EpiNsaIn E{(bf16*)(ws + WS_P0), (float*)(ws + WS_GL), 0.08838834764831845f};
        pg8::gemm_phase<pg8::EpiNsaIn, pg8::StaticOrder, true, true>(F.lds + RING_OFF, g, S, E);
        if (BOTH(1) || rep_ + 1 < REPS(1)) GRID_BAR();
    }
    if (IN(2)) for (int rep_ = 0; rep_ < REPS(2); ++rep_) { relaunder(F); p2_compress(F, args); if (BOTH(2) || rep_ + 1 < REPS(2)) GRID_BAR(); }
#ifndef PROBE_NSA2
#define PROBE_NSA2 0
#endif
    for (int repn_ = 0; repn_ < (PROBE_NSA2 ? 2 : 1); ++repn_) {
    if (IN(3)) for (int rep_ = 0; rep_ < REPS(3); ++rep_) { relaunder(F); p3a_nsa_cmp(F, args); if (BOTH(3) || rep_ + 1 < REPS(3)) GRID_BAR(); }
    if (IN(4)) for (int rep_ = 0; rep_ < REPS(4); ++rep_) { relaunder(F); p3b_nsa_sel(F, args); if (BOTH(4) || rep_ + 1 < REPS(4) || repn_ + 1 < (PROBE_NSA2 ? 2 : 1)) GRID_BAR(); }
    }
    if (IN(5)) for (int rep_ = 0; rep_ < REPS(5); ++rep_) { relaunder(F); p3c_nsa_win(F, args); if (BOTH(5) || rep_ + 1 < REPS(5)) GRID_BAR(); }
    if (IN(6)) for (int rep_ = 0; rep_ < REPS(6); ++rep_) { relaunder(F);
        pg8::Gemm g{(const bf16*)(ws + WS_OATT0), (const bf16*)(ws + WS_W_NSA_OUT), NTOK, DM, DM}; pg8::StaticOrder S; S.init(NTOK, DM, F.G, (int)blockIdx.x);
        pg8::EpiResF32 E{args.in[0], Z, ALPHA, DM};
        pg8::gemm_phase<pg8::EpiResF32, pg8::StaticOrder, true, true>(F.lds + RING_OFF, g, S, E);
        if (BOTH(6) || rep_ + 1 < REPS(6)) GRID_BAR();
    }
    if (IN(7)) for (int rep_ = 0; rep_ < REPS(7); ++rep_) { relaunder(F); ln_phase<false, FFN_F8 != 0>(F, args, Z, args.in[23], args.in[24], XH, (unsigned char*)XB); if (BOTH(7) || rep_ + 1 < REPS(7)) GRID_BAR(); }
    if (IN(8)) for (int rep_ = 0; rep_ < REPS(8); ++rep_) { relaunder(F);
        pg8::StaticOrder S; S.init(NTOK, 2 * DFF, F.G, (int)blockIdx.x);
#if FFN_F8
        pg8::Gemm g{XB, (const bf16*)(ws + WS_W_FFN_GU), NTOK, 2 * DFF, DM, 1, 0x79797979};
        pg8::EpiSwiGLU8 E{(unsigned char*)(ws + WS_HFF), DFF};
        pg8::gemm_phase<pg8::EpiSwiGLU8, pg8::StaticOrder, true, true, true>(F.lds + RING_OFF, g, S, E);
#else
        pg8::Gemm g{XB, (const bf16*)(ws + WS_W_FFN_GU), NTOK, 2 * DFF, DM};
        pg8::EpiSwiGLU E{(bf16*)(ws + WS_HFF), DFF};
        pg8::gemm_phase<pg8::EpiSwiGLU, pg8::StaticOrder, true, true>(F.lds + RING_OFF, g, S, E);
#endif
        if (BOTH(8) || rep_ + 1 < REPS(8)) GRID_BAR();
    }
    if (IN(9)) for (int rep_ = 0; rep_ < REPS(9); ++rep_) { relaunder(F);
        pg8::StaticOrder S; S.init(NTOK, DM, F.G, (int)blockIdx.x);
        pg8::EpiResH E{XH, Z, ALPHA, DM};
#if FFN_F8
        pg8::Gemm g{(const bf16*)(ws + WS_HFF), (const bf16*)(ws + WS_W_FFN_DN), NTOK, DM, DFF, 1, 0x77777777};
        pg8::gemm_phase<pg8::EpiResH, pg8::StaticOrder, true, true, true>(F.lds + RING_OFF, g, S, E);
#else
        pg8::Gemm g{(const bf16*)(ws + WS_HFF), (const bf16*)(ws + WS_W_FFN_DN), NTOK, DM, DFF};
        pg8::gemm_phase<pg8::EpiResH, pg8::StaticOrder, true, true>(F.lds + RING_OFF, g, S, E);
#endif
        if (BOTH(9) || rep_ + 1 < REPS(9)) GRID_BAR();
    }
    if (IN(10)) for (int rep_ = 0; rep_ < REPS(10); ++rep_) { relaunder(F); ln_phase<false>(F, args, Z, args.in[25], args.in[26], XH, nullptr); if (BOTH(10) || rep_ + 1 < REPS(10)) GRID_BAR(); }
    if (IN(11)) for (int rep_ = 0; rep_ < REPS(11); ++rep_) { relaunder(F);
        pg8::Gemm g{XH, (const bf16*)(ws + WS_W_DSA_IN), NTOK, DSA_NPAD, DM}; pg8::StaticOrder S; S.init(NTOK, DSA_NPAD, F.G, (int)blockIdx.x);
        pg8::EpiDsaIn E{(bf16*)(ws + WS_Q), (float*)(ws + WS_CRAW), (bf16*)(ws + WS_QI), (float*)(ws + WS_KIWI), 0.125f};
        pg8::gemm_phase<pg8::EpiDsaIn, pg8::StaticOrder, true, true>(F.lds + RING_OFF, g, S, E);
        if (BOTH(11) || rep_ + 1 < REPS(11)) GRID_BAR();
    }
    if (IN(12)) for (int rep_ = 0; rep_ < REPS(12); ++rep_) { relaunder(F); p10_dsa_prep(F, args); if (BOTH(12) || rep_ + 1 < REPS(12)) GRID_BAR(); }
    if (IN(13)) for (int rep_ = 0; rep_ < REPS(13); ++rep_) { relaunder(F); p13a_dsa_index(F, args); if (BOTH(13) || rep_ + 1 < REPS(13)) GRID_BAR(); }
    if (IN(14)) for (int rep_ = 0; rep_ < REPS(14); ++rep_) { relaunder(F); p13b_dsa_attn(F, args); if (BOTH(14) || rep_ + 1 < REPS(14)) GRID_BAR(); }
    if (IN(15)) for (int rep_ = 0; rep_ < REPS(15); ++rep_) { relaunder(F); p12_dsa_uv(F, args); if (BOTH(15) || rep_ + 1 < REPS(15)) GRID_BAR(); }
    if (IN(16)) for (int rep_ = 0; rep_ < REPS(16); ++rep_) { relaunder(F);
        pg8::Gemm g{(const bf16*)(ws + WS_OATT1), (const bf16*)(ws + WS_W_DSA_OUT), NTOK, DM, DM}; pg8::StaticOrder S; S.init(NTOK, DM, F.G, (int)blockIdx.x);
        pg8::EpiResH E{XH, Z, ALPHA, DM};
        pg8::gemm_phase<pg8::EpiResH, pg8::StaticOrder, true, true>(F.lds + RING_OFF, g, S, E);
        if (BOTH(16) || rep_ + 1 < REPS(16)) GRID_BAR();
    }
    if (IN(17)) for (int rep_ = 0; rep_ < REPS(17); ++rep_) { relaunder(F); ln_route_phase(F, args, Z, args.in[23] + DM, args.in[24] + DM, XH); if (BOTH(17) || rep_ + 1 < REPS(17)) GRID_BAR(); }
    if (IN(18)) for (int rep_ = 0; rep_ < REPS(18); ++rep_) { relaunder(F); p15_gather(F, args); if (BOTH(18) || rep_ + 1 < REPS(18)) GRID_BAR(); }
    if (IN(19)) for (int rep_ = 0; rep_ < REPS(19); ++rep_) { relaunder(F);
        MoeTiles T; moe_tiles(F, T);
        pg8::Gemm g{(const bf16*)(ws + WS_XG), (const bf16*)(ws + WS_W_MOE_GU), T.MT * 256, 2 * DFFE, DM, 1, 0x79797979}; pg8::MoeOrder S; S.init(T.MT * 256, 2 * DFFE, F.G, (int)blockIdx.x); S.nexp_rows = 2 * DFFE;
#pragma unroll
        for (int e = 0; e < 8; ++e) S.tend[e] = T.tend[e];
        pg8::EpiSwiGLU8 E{(unsigned char*)(ws + WS_HM), DFFE};
        pg8::gemm_phase<pg8::EpiSwiGLU8, pg8::MoeOrder, true, true, true>(F.lds + RING_OFF, g, S, E);
        if (BOTH(19) || rep_ + 1 < REPS(19)) GRID_BAR();
    }
    if (IN(20)) for (int rep_ = 0; rep_ < REPS(20); ++rep_) { relaunder(F);
        MoeTiles T; moe_tiles(F, T);
        pg8::Gemm g{(const bf16*)(ws + WS_HM), (const bf16*)(ws + WS_W_MOE_DN), T.MT * 256, DM, DFFE, 1, 0x77777777}; pg8::MoeOrder S; S.init(T.MT * 256, DM, F.G, (int)blockIdx.x); S.nexp_rows = DM;
#pragma unroll
        for (int e = 0; e < 8; ++e) S.tend[e] = T.tend[e];
        pg8::EpiBf16Plain E{(bf16*)(ws + WS_Y), DM};
        pg8::gemm_phase<pg8::EpiBf16Plain, pg8::MoeOrder, true, true, true>(F.lds + RING_OFF, g, S, E);
        if (BOTH(20) || rep_ + 1 < REPS(20)) GRID_BAR();
    }
    if (IN(21)) for (int rep_ = 0; rep_ < REPS(21); ++rep_) { relaunder(F); p18_final(F, args); }
#undef IN
#undef BOTH
}

extern "C" void kernel_launch(void* const* d_in, const int* in_sizes, int n_in, void* d_out, int out_size, void* d_ws, size_t ws_size, hipStream_t stream) {
    static int grid = 0;
    if (grid == 0) {
        if (n_in != 27 || out_size != NTOK * DM || ws_size < WS_END) { fprintf(stderr, "kernel_launch: unexpected shapes (n_in %d, out %d, ws %zu); nothing launched\n", n_in, out_size, ws_size); grid = -1; return; }
        int dev = 0, cus = 0, per_cu = 0;
        if (hipGetDevice(&dev) != hipSuccess || hipDeviceGetAttribute(&cus, hipDeviceAttributeMultiprocessorCount, dev) != hipSuccess) { grid = -1; return; }
        if (hipFuncSetAttribute((const void*)mega_fwd, hipFuncAttributeMaxDynamicSharedMemorySize, LDS_BYTES) != hipSuccess) { fprintf(stderr, "kernel_launch: hipFuncSetAttribute failed\n"); grid = -1; return; }
        if (hipOccupancyMaxActiveBlocksPerMultiprocessor(&per_cu, (const void*)mega_fwd, NWAVES * 64, LDS_BYTES) != hipSuccess || per_cu < 1) { fprintf(stderr, "kernel_launch: occupancy query says %d\n", per_cu); }
        (void)hipGetLastError();
        grid = cus;
    }
    if (grid < 0) return;
    if (hipMemsetAsync((char*)d_ws + WS_CTL, 0, CTL_ZERO_BYTES, stream) != hipSuccess) return;
    Args a{};
    for (int i = 0; i < 27; ++i) a.in[i] = (const float*)d_in[i];
    a.out = (float*)d_out; a.ws = (unsigned char*)d_ws;
#if MK_PER_PHASE
    for (int p = 0; p < NPHASE; ++p) { a.ph_lo = p; a.ph_hi = p + 1; hipLaunchKernelGGL(mega_fwd, dim3(grid), dim3(NWAVES * 64), LDS_BYTES, stream, a); }
#else
    a.ph_lo = 0; a.ph_hi = NPHASE;
    hipLaunchKernelGGL(mega_fwd, dim3(grid), dim3(NWAVES * 64), LDS_BYTES, stream, a);
#endif
}
```

```cpp
#include <hip/hip_runtime.h>
#include <cstdio>
#include <cstdint>
namespace pg8 {
#define PG8_LAS __attribute__((address_space(3)))
typedef unsigned short bf16_t;
typedef short bf16x8 __attribute__((ext_vector_type(8)));
typedef float f32x4 __attribute__((ext_vector_type(4)));
typedef unsigned u32x4 __attribute__((ext_vector_type(4)));
constexpr int BM = 256, BK = 64, HALF = 128, HTB = HALF * BK * 2  , STAGE_BYTES = 8 * HTB, NXCD = 8, WGM = 8;

__host__ __device__ __forceinline__ int lds_byte(int r, int c) { const int st = (r >> 4) * 2 + (c >> 5), rr = r & 15, cc = c & 31, ob = rr * 64 + cc * 2; return st * 1024 + (ob ^ (((ob >> 9) & 1) << 5)); }
__host__ __device__ __forceinline__ void stage_rc(int b, int& R, int& C) { const int st = b / 1024, sb = b % 1024, swz = sb ^ (((sb >> 9) & 1) << 5); R = (st >> 1) * 16 + swz / 64; C = (st & 1) * 32 + (swz % 64) / 2; }
__host__ __device__ __forceinline__ int perm32(int rho) { const int n = rho >> 4, i = rho & 15; return 8 * (i >> 2) + 4 * n + (i & 3); }

struct Unit { int pm, pn; };
struct Gemm { const bf16_t* A; const bf16_t* Bt; int M, N, K; int esz = 2; int scale = 0x7f7f7f7f; int lda = 0; };

struct StaticOrder {
    int nM, nN, nwg, G, c;
    __host__ __device__ void init(int M, int N, int G_, int c_) { nM = M / BM; nN = N / BM; nwg = nM * nN; G = G_; c = c_; }
    __host__ __device__ bool next(int i, Unit& u) const {
        const long L = (long)i * G + c; if (L >= nwg) return false;
        int wgid = (int)L; { const int q = nwg / NXCD, r = nwg % NXCD, xcd = wgid % NXCD, off = wgid / NXCD; wgid = (xcd < r ? xcd * (q + 1) : r * (q + 1) + (xcd - r) * q) + off; }
        const int nig = WGM * nN, gid = wgid / nig, fm = gid * WGM, gsz = (nM - fm) < WGM ? (nM - fm) : WGM;
        u.pm = fm + ((wgid % nig) % gsz); u.pn = (wgid % nig) / gsz; return true;
    }
    __device__ __forceinline__ void a_ready(const Unit&) const {}
    __device__ __forceinline__ void done(const Unit&) const {}
    __device__ __forceinline__ const char* a_ptr(const Gemm& g, const Unit& u) const { return (const char*)g.A + (size_t)u.pm * ((size_t)BM * (g.lda ? g.lda : g.K) * g.esz); }
    __device__ __forceinline__ const char* b_ptr(const Gemm& g, const Unit& u) const { return (const char*)g.Bt + (size_t)u.pn * ((size_t)BM * g.K * g.esz); }
};


__device__ __forceinline__ unsigned cvt_pk_bf16(float lo, float hi) { unsigned r; asm volatile("v_cvt_pk_bf16_f32 %0, %1, %2" : "=v"(r) : "v"(lo), "v"(hi)); return r; }
__device__ __forceinline__ u32x4 pack8(const f32x4 v0, const f32x4 v1) { u32x4 w; w.x = cvt_pk_bf16(v0[0], v0[1]); w.y = cvt_pk_bf16(v0[2], v0[3]); w.z = cvt_pk_bf16(v1[0], v1[1]); w.w = cvt_pk_bf16(v1[2], v1[3]); return w; }

struct EpiNsaIn {
    static constexpr bool PERM = true, AFTER_DRAIN = false;
    bf16_t* P0; float* GL; float qscale;
    __device__ __forceinline__ void operator()(const f32x4 (&acc)[2][2][4][2], const Unit& u, int wr, int wc, int fr, int fq) const {
        const int row0 = u.pm * BM + wr * 64 + fr;
        if (u.pn < 20) {
            const float s = u.pn < 8 ? qscale : 1.0f;
            const int col0 = u.pn * BM + wc * 32 + 8 * fq;
#pragma unroll
            for (int ai = 0; ai < 2; ++ai)
#pragma unroll
                for (int m = 0; m < 4; ++m) { bf16_t* rowp = P0 + (size_t)(row0 + ai * HALF + m * 16) * 5120 + col0;
#pragma unroll
                    for (int bj = 0; bj < 2; ++bj) *(u32x4*)(rowp + bj * HALF) = pack8(acc[ai][bj][m][0] * s, acc[ai][bj][m][1] * s); }
        } else {
            const int c = wc * 32 + 8 * fq;
            if (c < 48) {
#pragma unroll
                for (int ai = 0; ai < 2; ++ai)
#pragma unroll
                    for (int m = 0; m < 4; ++m) { float* gp = GL + (size_t)(row0 + ai * HALF + m * 16) * 48 + c;
                        *(f32x4*)gp = acc[ai][0][m][0]; *(f32x4*)(gp + 4) = acc[ai][0][m][1]; }
            }
        }
    }
};
struct EpiDsaIn {
    static constexpr bool PERM = true, AFTER_DRAIN = false;
    bf16_t* Q; float* CRAW; bf16_t* QI; float* KIWI; float qiscale;
    __device__ __forceinline__ void operator()(const f32x4 (&acc)[2][2][4][2], const Unit& u, int wr, int wc, int fr, int fq) const {
        const int row0 = u.pm * BM + wr * 64 + fr; const int c = wc * 32 + 8 * fq;
        if (u.pn < 8) {
#pragma unroll
            for (int ai = 0; ai < 2; ++ai)
#pragma unroll
                for (int m = 0; m < 4; ++m) { bf16_t* rowp = Q + (size_t)(row0 + ai * HALF + m * 16) * 2048 + u.pn * BM + c;
#pragma unroll
                    for (int bj = 0; bj < 2; ++bj) *(u32x4*)(rowp + bj * HALF) = pack8(acc[ai][bj][m][0], acc[ai][bj][m][1]); }
        } else if (u.pn == 8) {
#pragma unroll
            for (int ai = 0; ai < 2; ++ai)
#pragma unroll
                for (int m = 0; m < 4; ++m) { float* rowp = CRAW + (size_t)(row0 + ai * HALF + m * 16) * 256 + c;
#pragma unroll
                    for (int bj = 0; bj < 2; ++bj) { *(f32x4*)(rowp + bj * HALF) = acc[ai][bj][m][0]; *(f32x4*)(rowp + bj * HALF + 4) = acc[ai][bj][m][1]; } }
        } else if (u.pn < 11) {
#pragma unroll
            for (int ai = 0; ai < 2; ++ai)
#pragma unroll
                for (int m = 0; m < 4; ++m) { bf16_t* rowp = QI + (size_t)(row0 + ai * HALF + m * 16) * 512 + (u.pn - 9) * BM + c;
#pragma unroll
                    for (int bj = 0; bj < 2; ++bj) *(u32x4*)(rowp + bj * HALF) = pack8(acc[ai][bj][m][0] * qiscale, acc[ai][bj][m][1] * qiscale); }
        } else {
#pragma unroll
            for (int ai = 0; ai < 2; ++ai)
#pragma unroll
                for (int m = 0; m < 4; ++m) { float* rowp = KIWI + (size_t)(row0 + ai * HALF + m * 16) * 128 + c;
                    *(f32x4*)rowp = acc[ai][0][m][0]; *(f32x4*)(rowp + 4) = acc[ai][0][m][1]; }
        }
    }
};
struct EpiResF32 {
    static constexpr bool PERM = true, AFTER_DRAIN = false;
    const float* R; bf16_t* Z; float alpha; int ldc;
    __device__ __forceinline__ void operator()(const f32x4 (&acc)[2][2][4][2], const Unit& u, int wr, int wc, int fr, int fq) const {
        const int row0 = u.pm * BM + wr * 64 + fr, col0 = u.pn * BM + wc * 32 + 8 * fq;
#pragma unroll
        for (int ai = 0; ai < 2; ++ai)
#pragma unroll
            for (int m = 0; m < 4; ++m) { const size_t off = (size_t)(row0 + ai * HALF + m * 16) * ldc + col0;
#pragma unroll
                for (int bj = 0; bj < 2; ++bj) { const f32x4 r0 = *(const f32x4*)(R + off + bj * HALF), r1 = *(const f32x4*)(R + off + bj * HALF + 4);
                    *(u32x4*)(Z + off + bj * HALF) = pack8(r0 * alpha + acc[ai][bj][m][0], r1 * alpha + acc[ai][bj][m][1]); } }
    }
};
struct EpiResH {
    static constexpr bool PERM = true, AFTER_DRAIN = false;
    const bf16_t* R; bf16_t* Z; float alpha; int ldc;
    __device__ __forceinline__ void operator()(const f32x4 (&acc)[2][2][4][2], const Unit& u, int wr, int wc, int fr, int fq) const {
        const int row0 = u.pm * BM + wr * 64 + fr, col0 = u.pn * BM + wc * 32 + 8 * fq;
#pragma unroll
        for (int ai = 0; ai < 2; ++ai)
#pragma unroll
            for (int m = 0; m < 4; ++m) { const size_t off = (size_t)(row0 + ai * HALF + m * 16) * ldc + col0;
#pragma unroll
                for (int bj = 0; bj < 2; ++bj) { const u32x4 rr = *(const u32x4*)(R + off + bj * HALF);
                    const f32x4 r0 = (f32x4){__uint_as_float(rr.x << 16), __uint_as_float(rr.x & 0xffff0000u), __uint_as_float(rr.y << 16), __uint_as_float(rr.y & 0xffff0000u)};
                    const f32x4 r1 = (f32x4){__uint_as_float(rr.z << 16), __uint_as_float(rr.z & 0xffff0000u), __uint_as_float(rr.w << 16), __uint_as_float(rr.w & 0xffff0000u)};
                    *(u32x4*)(Z + off + bj * HALF) = pack8(r0 * alpha + acc[ai][bj][m][0], r1 * alpha + acc[ai][bj][m][1]); } }
    }
};
struct EpiF32 {
    static constexpr bool PERM = false, AFTER_DRAIN = false;
    float* C; int ldc;
    __device__ __forceinline__ void operator()(const f32x4 (&acc)[2][2][4][2], const Unit& u, int wr, int wc, int fr, int fq) const {
        const int row0 = u.pm * BM + wr * 64 + fr, col0 = u.pn * BM + wc * 32 + 4 * fq;
#pragma unroll
        for (int ai = 0; ai < 2; ++ai)
#pragma unroll
            for (int m = 0; m < 4; ++m) { float* rowp = C + (size_t)(row0 + ai * HALF + m * 16) * ldc + col0;
#pragma unroll
                for (int bj = 0; bj < 2; ++bj)
#pragma unroll
                    for (int n = 0; n < 2; ++n) *(f32x4*)(rowp + bj * HALF + n * 16) = acc[ai][bj][m][n]; }
    }
};
struct EpiBf16Plain {
    static constexpr bool PERM = true, AFTER_DRAIN = false;
    bf16_t* C; int ldc;
    __device__ __forceinline__ void operator()(const f32x4 (&acc)[2][2][4][2], const Unit& u, int wr, int wc, int fr, int fq) const {
        const int row0 = u.pm * BM + wr * 64 + fr, col0 = u.pn * BM + wc * 32 + 8 * fq;
#pragma unroll
        for (int ai = 0; ai < 2; ++ai)
#pragma unroll
            for (int m = 0; m < 4; ++m) { bf16_t* rowp = C + (size_t)(row0 + ai * HALF + m * 16) * ldc + col0;
#pragma unroll
                for (int bj = 0; bj < 2; ++bj) *(u32x4*)(rowp + bj * HALF) = pack8(acc[ai][bj][m][0], acc[ai][bj][m][1]); }
    }
};
__device__ __forceinline__ float silu_mul(float g, float u) { return g * __builtin_amdgcn_rcpf(1.0f + __expf(-g)) * u; }
struct EpiSwiGLU {
    static constexpr bool PERM = true, AFTER_DRAIN = false;
    bf16_t* H; int ldh;
    __device__ __forceinline__ void operator()(const f32x4 (&acc)[2][2][4][2], const Unit& u, int wr, int wc, int fr, int fq) const {
        const int row0 = u.pm * BM + wr * 64 + fr, col0 = u.pn * HALF + wc * 32 + 8 * fq;
#pragma unroll
        for (int ai = 0; ai < 2; ++ai)
#pragma unroll
            for (int m = 0; m < 4; ++m) { bf16_t* rowp = H + (size_t)(row0 + ai * HALF + m * 16) * ldh + col0;
                f32x4 v0, v1;
#pragma unroll
                for (int j = 0; j < 4; ++j) { v0[j] = silu_mul(acc[ai][0][m][0][j], acc[ai][1][m][0][j]); v1[j] = silu_mul(acc[ai][0][m][1][j], acc[ai][1][m][1][j]); }
                *(u32x4*)rowp = pack8(v0, v1); }
    }
};
struct EpiSwiGLU8 {
    static constexpr bool PERM = true, AFTER_DRAIN = false;
    unsigned char* H; int ldh;
    __device__ __forceinline__ void operator()(const f32x4 (&acc)[2][2][4][2], const Unit& u, int wr, int wc, int fr, int fq) const {
        const int row0 = u.pm * BM + wr * 64 + fr, col0 = u.pn * HALF + wc * 32 + 8 * fq;
#pragma unroll
        for (int ai = 0; ai < 2; ++ai)
#pragma unroll
            for (int m = 0; m < 4; ++m) { unsigned char* rowp = H + (size_t)(row0 + ai * HALF + m * 16) * ldh + col0;
                float v[8];
#pragma unroll
                for (int j = 0; j < 4; ++j) { v[j] = silu_mul(acc[ai][0][m][0][j], acc[ai][1][m][0][j]); v[4 + j] = silu_mul(acc[ai][0][m][1][j], acc[ai][1][m][1][j]); }
                int w0 = __builtin_amdgcn_cvt_pk_fp8_f32(v[0], v[1], 0, false); w0 = __builtin_amdgcn_cvt_pk_fp8_f32(v[2], v[3], w0, true);
                int w1 = __builtin_amdgcn_cvt_pk_fp8_f32(v[4], v[5], 0, false); w1 = __builtin_amdgcn_cvt_pk_fp8_f32(v[6], v[7], w1, true);
                uint2 o; o.x = (unsigned)w0; o.y = (unsigned)w1; *(uint2*)rowp = o; }
    }
};
struct PairOrder : StaticOrder {
    int pn_shift, kslice;
    __device__ __forceinline__ const char* a_ptr(const Gemm& g, const Unit& u) const { return (const char*)g.A + ((size_t)u.pm * BM * g.lda + (size_t)(u.pn >> pn_shift) * kslice) * 2; }
};
struct EpiBf16Scale {
    static constexpr bool PERM = true, AFTER_DRAIN = false;
    bf16_t* C; int ldc; float scale;
    __device__ __forceinline__ void operator()(const f32x4 (&acc)[2][2][4][2], const Unit& u, int wr, int wc, int fr, int fq) const {
        const int row0 = u.pm * BM + wr * 64 + fr, col0 = u.pn * BM + wc * 32 + 8 * fq;
#pragma unroll
        for (int ai = 0; ai < 2; ++ai)
#pragma unroll
            for (int m = 0; m < 4; ++m) { bf16_t* rowp = C + (size_t)(row0 + ai * HALF + m * 16) * ldc + col0;
#pragma unroll
                for (int bj = 0; bj < 2; ++bj) *(u32x4*)(rowp + bj * HALF) = pack8(acc[ai][bj][m][0] * scale, acc[ai][bj][m][1] * scale); }
    }
};
struct MoeOrder : StaticOrder {
    int tend[8]; int nexp_rows;
    __device__ __forceinline__ int expert(int pm) const { int e = 0;
#pragma unroll
        for (int i = 0; i < 7; ++i) e += (pm >= tend[i]) ? 1 : 0; return e; }
    __device__ __forceinline__ const char* b_ptr(const Gemm& g, const Unit& u) const { return (const char*)g.Bt + ((size_t)expert(u.pm) * nexp_rows + (size_t)u.pn * BM) * ((size_t)g.K * g.esz); }
};
typedef int i32x8 __attribute__((ext_vector_type(8)));
typedef int i32x4 __attribute__((ext_vector_type(4)));
__device__ __forceinline__ i32x8 cat8(bf16x8 lo, bf16x8 hi) { const i32x4 a = *reinterpret_cast<const i32x4*>(&lo), b = *reinterpret_cast<const i32x4*>(&hi); return __builtin_shufflevector(a, b, 0, 1, 2, 3, 4, 5, 6, 7); }
template <class Epi, class Sched, bool ALIGN_EPI = false, bool SP2 = false, bool FP8 = false>
__device__ __forceinline__ void gemm_phase(PG8_LAS unsigned char* lds, const Gemm g, const Sched& S, const Epi& E) {
    int tid = threadIdx.x; asm volatile("" : "+v"(tid));
    const int wid = __builtin_amdgcn_readfirstlane(tid >> 6), lane = tid & 63, wr = wid >> 2, wc = wid & 3, fr = lane & 15, fq = lane >> 4;
    const int K = g.K, nt = K / (FP8 ? 2 * BK : BK), LDA = g.lda ? g.lda : g.K;
    unsigned voffA[2], voffB[2];
#pragma unroll
    for (int i = 0; i < 2; ++i) { int R, C; stage_rc(tid * 16 + i * 8192, R, C); const int Rb = Epi::PERM ? ((R & ~31) + perm32(R & 31)) : R;
        voffA[i] = FP8 ? (unsigned)(R * LDA + C * 2) : (unsigned)(R * LDA + C) * 2u; voffB[i] = FP8 ? (unsigned)(Rb * K + C * 2) : (unsigned)(Rb * K + C) * 2u; }
    const size_t kstep = (size_t)(BK * 2);
    const size_t hstep = (size_t)HALF * K * (FP8 ? 1 : 2), hstepA = (size_t)HALF * LDA * (FP8 ? 1 : 2);
    const size_t tstep = 2 * hstep;
    const unsigned ldsw = (unsigned)wid * 1024u;
    const int aoff = lds_byte(wr * 64 + fr, fq * 8), boff = lds_byte(wc * 32 + fr, fq * 8);
#define PG8_SA(b, h) (((b) * 2 + (h)) * HTB)
#define PG8_SB(b, h) ((4 + (b) * 2 + (h)) * HTB)
#define PG8_STAGE(bufoff, gbase, voff) do { _Pragma("unroll") for (int _i = 0; _i < 2; ++_i) \
        __builtin_amdgcn_global_load_lds((const unsigned*)((const char*)(gbase) + (voff)[_i]), (PG8_LAS unsigned*)(lds + (bufoff) + ldsw + _i * 8192), 16, 0, 0); } while (0)
#define PG8_LDA(dst, b, h) do { _Pragma("unroll") for (int m = 0; m < 4; ++m) { if constexpr (FP8) { const i32x4 lo_ = *(const PG8_LAS i32x4*)(lds + PG8_SA(b, h) + aoff + m * 2048), hi_ = *(const PG8_LAS i32x4*)(lds + PG8_SA(b, h) + aoff + m * 2048 + 1024); dst##8[m] = __builtin_shufflevector(lo_, hi_, 0, 1, 2, 3, 4, 5, 6, 7); } else { _Pragma("unroll") for (int k = 0; k < 2; ++k) dst[m][k] = *(const PG8_LAS bf16x8*)(lds + PG8_SA(b, h) + aoff + m * 2048 + k * 1024); } } } while (0)
#define PG8_LDB(dst, b, h) do { _Pragma("unroll") for (int n = 0; n < 2; ++n) { if constexpr (FP8) { const i32x4 lo_ = *(const PG8_LAS i32x4*)(lds + PG8_SB(b, h) + boff + n * 2048), hi_ = *(const PG8_LAS i32x4*)(lds + PG8_SB(b, h) + boff + n * 2048 + 1024); dst##8[n] = __builtin_shufflevector(lo_, hi_, 0, 1, 2, 3, 4, 5, 6, 7); } else { _Pragma("unroll") for (int k = 0; k < 2; ++k) dst[n][k] = *(const PG8_LAS bf16x8*)(lds + PG8_SB(b, h) + boff + n * 2048 + k * 1024); } } } while (0)
#define PG8_MMA(ai, bj, At, Bt) do { __builtin_amdgcn_s_setprio(1); _Pragma("unroll") for (int m = 0; m < 4; ++m) _Pragma("unroll") for (int n = 0; n < 2; ++n) { \
        if constexpr (FP8) { asm volatile("v_mfma_scale_f32_16x16x128_f8f6f4 %0, %1, %2, %0, %3, %4 op_sel_hi:[0,0,0]" : "+v"(acc[ai][bj][m][n]) : "v"(Bt##8[n]), "v"(At##8[m]), "v"(sclA), "v"(sclB)); } \
        else { _Pragma("unroll") for (int k = 0; k < 2; ++k) acc[ai][bj][m][n] = __builtin_amdgcn_mfma_f32_16x16x32_bf16(Bt[n][k], At[m][k], acc[ai][bj][m][n], 0, 0, 0); } } __builtin_amdgcn_s_setprio(0); } while (0)
#define PG8_WAIT_V(n) asm volatile("s_waitcnt vmcnt(" #n ")" ::: "memory")
#define PG8_WAIT_L(n) asm volatile("s_waitcnt lgkmcnt(" #n ")" ::: "memory")
#define PG8_BAR __builtin_amdgcn_s_barrier()
#define PG8_SCHED __builtin_amdgcn_sched_barrier(0)
    Unit cur, nxt; int ui = 0;
    if (!S.next(0, cur)) return;
    f32x4 acc[2][2][4][2];
#pragma unroll
    for (int a = 0; a < 2; ++a)
#pragma unroll
        for (int b = 0; b < 2; ++b)
#pragma unroll
            for (int m = 0; m < 4; ++m)
#pragma unroll
                for (int n = 0; n < 2; ++n) acc[a][b][m][n] = (f32x4){0.f, 0.f, 0.f, 0.f};
    bf16x8 At[4][2], B0[2][2], B1[2][2]; i32x8 At8[4], B08[2], B18[2]; const int sclA = g.scale, sclB = 0x7f7f7f7f;
    const char* cA = S.a_ptr(g, cur); const char* cB = S.b_ptr(g, cur);
    S.a_ready(cur);
    if constexpr (SP2) {
        PG8_STAGE(PG8_SB(0, 0), cB, voffB); PG8_STAGE(PG8_SB(0, 1), cB + hstep, voffB); PG8_STAGE(PG8_SA(0, 0), cA, voffA); PG8_STAGE(PG8_SA(0, 1), cA + hstepA, voffA);
        if (wr == 1) PG8_BAR;
        PG8_WAIT_V(2); PG8_BAR;
        PG8_STAGE(PG8_SB(1, 0), cB + kstep, voffB); PG8_STAGE(PG8_SA(1, 0), cA + kstep, voffA); PG8_STAGE(PG8_SB(1, 1), cB + hstep + kstep, voffB);
        PG8_WAIT_V(6); PG8_BAR;
    } else {
        PG8_STAGE(PG8_SB(0, 0), cB, voffB); PG8_STAGE(PG8_SA(0, 0), cA, voffA); PG8_STAGE(PG8_SB(0, 1), cB + hstep, voffB); PG8_STAGE(PG8_SA(0, 1), cA + hstepA, voffA);
        if (wr == 1) PG8_BAR;
        PG8_WAIT_V(4); PG8_BAR;
        PG8_STAGE(PG8_SB(1, 0), cB + kstep, voffB); PG8_STAGE(PG8_SA(1, 0), cA + kstep, voffA); PG8_STAGE(PG8_SB(1, 1), cB + hstep + kstep, voffB);
        PG8_WAIT_V(6); PG8_BAR;
    }
    for (;;) {
        const bool has_next = S.next(ui + 1, nxt);
        const char* nA = has_next ? S.a_ptr(g, nxt) : cA; const char* nB = has_next ? S.b_ptr(g, nxt) : cB;
        for (int t = 0; t < nt; t += 2) {
            const bool last = (t == nt - 2);
            const char* a1 = cA + (size_t)(t + 1) * kstep;
            const char* a2 = last ? nA : cA + (size_t)(t + 2) * kstep; const char* b2 = last ? nB : cB + (size_t)(t + 2) * kstep;
            const char* a3 = a2 + kstep; const char* b3 = b2 + kstep;
            if (last && has_next) S.a_ready(nxt);
            if constexpr (SP2) {
            PG8_LDB(B0, 0, 0); PG8_LDB(B1, 0, 1); PG8_SCHED; PG8_LDA(At, 0, 0); PG8_STAGE(PG8_SA(1, 1), a1 + hstepA, voffA);
            PG8_WAIT_V(8); PG8_WAIT_L(0); PG8_BAR; PG8_MMA(0, 0, At, B0); PG8_MMA(0, 1, At, B1); PG8_BAR; PG8_SCHED;
            PG8_LDA(At, 0, 1); PG8_STAGE(PG8_SB(0, 0), b2, voffB); PG8_STAGE(PG8_SB(0, 1), b2 + hstep, voffB); PG8_STAGE(PG8_SA(0, 0), a2, voffA);
            PG8_WAIT_V(8); PG8_WAIT_L(0); PG8_BAR; PG8_MMA(1, 0, At, B0); PG8_MMA(1, 1, At, B1); PG8_BAR; PG8_SCHED;
            PG8_LDB(B0, 1, 0); PG8_LDB(B1, 1, 1); PG8_SCHED; PG8_LDA(At, 1, 0); PG8_STAGE(PG8_SA(0, 1), a2 + hstepA, voffA);
            PG8_WAIT_V(8); PG8_WAIT_L(0); PG8_BAR; PG8_MMA(0, 0, At, B0); PG8_MMA(0, 1, At, B1); PG8_BAR; PG8_SCHED;
            PG8_LDA(At, 1, 1); PG8_STAGE(PG8_SB(1, 0), b3, voffB); PG8_STAGE(PG8_SB(1, 1), b3 + hstep, voffB); PG8_STAGE(PG8_SA(1, 0), a3, voffA);
            PG8_WAIT_V(8); PG8_WAIT_L(0); PG8_BAR; PG8_MMA(1, 0, At, B0); PG8_MMA(1, 1, At, B1); PG8_BAR; PG8_SCHED;
            } else {
            PG8_LDB(B0, 0, 0); PG8_SCHED; PG8_LDA(At, 0, 0); PG8_STAGE(PG8_SA(1, 1), a1 + hstepA, voffA);
            PG8_WAIT_L(8); PG8_BAR; PG8_WAIT_L(0); PG8_MMA(0, 0, At, B0); PG8_BAR; PG8_SCHED;
            PG8_LDB(B1, 0, 1); PG8_STAGE(PG8_SB(0, 0), b2, voffB);
            PG8_BAR; PG8_WAIT_L(0); PG8_MMA(0, 1, At, B1); PG8_BAR;
            PG8_LDA(At, 0, 1); PG8_STAGE(PG8_SA(0, 0), a2, voffA);
            PG8_BAR; PG8_WAIT_L(0); PG8_MMA(1, 0, At, B0); PG8_BAR; PG8_SCHED;
            PG8_STAGE(PG8_SB(0, 1), b2 + hstep, voffB);
            PG8_WAIT_V(6); PG8_BAR; PG8_MMA(1, 1, At, B1); PG8_BAR;
            PG8_LDB(B0, 1, 0); PG8_SCHED; PG8_LDA(At, 1, 0); PG8_STAGE(PG8_SA(0, 1), a2 + hstepA, voffA);
            PG8_WAIT_L(8); PG8_BAR; PG8_WAIT_L(0); PG8_MMA(0, 0, At, B0); PG8_BAR; PG8_SCHED;
            PG8_LDB(B1, 1, 1); PG8_STAGE(PG8_SB(1, 0), b3, voffB);
            PG8_BAR; PG8_WAIT_L(0); PG8_MMA(0, 1, At, B1); PG8_BAR;
            PG8_LDA(At, 1, 1); PG8_STAGE(PG8_SA(1, 0), a3, voffA);
            PG8_BAR; PG8_WAIT_L(0); PG8_MMA(1, 0, At, B0); PG8_BAR; PG8_SCHED;
            PG8_STAGE(PG8_SB(1, 1), b3 + hstep, voffB);
            PG8_WAIT_V(6); PG8_BAR; PG8_MMA(1, 1, At, B1); PG8_BAR;
            }
        }
        if constexpr (FP8) asm volatile("s_nop 15\n\ts_nop 15" ::: "memory");
        if constexpr (ALIGN_EPI) { if (wr == 0) PG8_BAR; }
        if constexpr (!Epi::AFTER_DRAIN) { E(acc, cur, wr, wc, fr, fq); S.done(cur); }
        if (!has_next) break;
#pragma unroll
        for (int a = 0; a < 2; ++a)
#pragma unroll
            for (int b = 0; b < 2; ++b)
#pragma unroll
                for (int m = 0; m < 4; ++m)
#pragma unroll
                    for (int n = 0; n < 2; ++n) acc[a][b][m][n] = (f32x4){0.f, 0.f, 0.f, 0.f};
        cur = nxt; cA = nA; cB = nB; ++ui;
        if constexpr (ALIGN_EPI) { if (wr == 1) PG8_BAR; }
    }
    PG8_WAIT_V(0);
    if constexpr (!ALIGN_EPI) { if (wr == 0) PG8_BAR; }
    PG8_BAR;
    if constexpr (Epi::AFTER_DRAIN) { E.fused(acc, cur, wr, wc, fr, fq, lds, wid, lane); S.done(cur); }
#undef PG8_SA
#undef PG8_SB
#undef PG8_STAGE
#undef PG8_LDA
#undef PG8_LDB
#undef PG8_MMA
#undef PG8_WAIT_V
#undef PG8_WAIT_L
#undef PG8_BAR
#undef PG8_SCHED
}
}
#define GAS __attribute__((address_space(1)))
#define LAS __attribute__((address_space(3)))
typedef unsigned short bf16;
typedef unsigned v4u __attribute__((ext_vector_type(4)));
typedef float f32x4 __attribute__((ext_vector_type(4)));
typedef short bf16x8 __attribute__((ext_vector_type(8)));
typedef GAS unsigned gu32;
typedef GAS unsigned long long gu64;
#define RLX_AGENT __ATOMIC_RELAXED, __HIP_MEMORY_SCOPE_AGENT
#define LDS_WAIT() asm volatile("s_waitcnt lgkmcnt(0)" ::: "memory")
#define VM_WAIT() asm volatile("s_waitcnt vmcnt(0)" ::: "memory")
__device__ __forceinline__ unsigned long long rt() { return __builtin_amdgcn_s_memrealtime(); }
__device__ __forceinline__ unsigned f2bf(float f) { unsigned u = __builtin_bit_cast(unsigned, f); return (u + 0x7fffu + ((u >> 16) & 1u)) >> 16; }
__device__ __forceinline__ unsigned pk2(float lo, float hi) { return f2bf(lo) | (f2bf(hi) << 16); }

#define XB_TMO      128
#define XB_XCNT(j)  (256  + 64 * (j))
#define XB_XSUB(j)  (1280 + 64 * (j))
#define XB_XGEN(j)  (2304 + 64 * (j))
#define XB_TOP      3328
#define XB_TOPGEN   3392
#define XCD_BAR_WORDS 3456
#define XB_SPIN_CAP (1u << 18)

__device__ __forceinline__ unsigned xb_ld(unsigned* p)              { return __hip_atomic_load(p, __ATOMIC_RELAXED, __HIP_MEMORY_SCOPE_AGENT); }
__device__ __forceinline__ unsigned xb_add(unsigned* p, unsigned v) { return __hip_atomic_fetch_add(p, v, __ATOMIC_RELAXED, __HIP_MEMORY_SCOPE_AGENT); }
__device__ __forceinline__ unsigned xb_xcc_id() { return (unsigned)__builtin_amdgcn_s_getreg((3 << 11) | 20) & 0xFu; }
#define XB_SPIN(cond, bar) do { unsigned _sp = 0; while (cond) { __builtin_amdgcn_s_sleep(1); \
    if ((++_sp & 255u) == 0u) { if (xb_ld(&(bar)[XB_TMO])) break; if (_sp > XB_SPIN_CAP) { atomicAdd(&(bar)[XB_TMO], 1u); break; } } } } while (0)

struct XcdBarrier {
    unsigned* bar; unsigned x;
    volatile LAS unsigned* st;
};

__device__ __forceinline__ XcdBarrier xcd_barrier_post(unsigned* bar, volatile LAS unsigned* st) {
    XcdBarrier b; b.bar = bar; b.x = xb_xcc_id(); b.st = st;
    if (threadIdx.x == 0) (void)xb_add(&bar[XB_XCNT(b.x)], 1u);
    return b;
}
__device__ __forceinline__ void xcd_barrier_complete(unsigned* bar, unsigned x, unsigned& nloc, unsigned& nx) {
    const unsigned G = gridDim.x * gridDim.y * gridDim.z;
    unsigned sum, cnt, mine, sp = 0u;
    for (;;) {
        sum = 0u; cnt = 0u; mine = 0u;
#pragma unroll
        for (unsigned j = 0; j < 16; ++j) { const unsigned c = xb_ld(&bar[XB_XCNT(j)]); sum += c; cnt += (c > 0u) ? 1u : 0u; mine = (j == x) ? c : mine; }
        if (sum == G) break;
        __builtin_amdgcn_s_sleep(1);
        if ((++sp & 255u) == 0u) { if (xb_ld(&bar[XB_TMO])) break; if (sp > XB_SPIN_CAP) { atomicAdd(&bar[XB_TMO], 1u); break; } }
    }
    nloc = mine > 0u ? mine : 1u; nx = cnt > 0u ? cnt : 1u;
}

__device__ __forceinline__ void xcd_barrier(const XcdBarrier& b) {
    asm volatile("s_waitcnt vmcnt(0)" ::: "memory");
    __syncthreads();
    if (threadIdx.x == 0) {
        unsigned* bar = b.bar;
        __builtin_amdgcn_s_waitcnt(0);
        unsigned nloc = b.st[0], nx = b.st[1];
        if (nloc == 0u) { xcd_barrier_complete(bar, b.x, nloc, nx); b.st[0] = nloc; b.st[1] = nx; }
        const unsigned old = xb_add(&bar[XB_XSUB(b.x)], 1u);
        const unsigned gen = old / nloc;
        if (old + 1u == (gen + 1u) * nloc) {
            __builtin_amdgcn_fence(__ATOMIC_RELEASE, "agent");
            asm volatile("s_waitcnt vmcnt(0)" ::: "memory");
            const unsigned og = xb_add(&bar[XB_TOP], 1u);
            const unsigned tg = og / nx;
            if (og + 1u == (tg + 1u) * nx) xb_add(&bar[XB_TOPGEN], 1u);
            else XB_SPIN(xb_ld(&bar[XB_TOPGEN]) == tg, bar);
            __builtin_amdgcn_fence(__ATOMIC_ACQUIRE, "agent");
            xb_add(&bar[XB_XGEN(b.x)], 1u);
            asm volatile("s_waitcnt vmcnt(0)" ::: "memory");
        } else {
            XB_SPIN(xb_ld(&bar[XB_XGEN(b.x)]) == gen, bar);
            __builtin_amdgcn_fence(__ATOMIC_ACQUIRE, "agent");
            asm volatile("s_waitcnt vmcnt(0)" ::: "memory");
        }
    }
    __syncthreads();
}

constexpr int NWAVES = 8;
#ifndef MK_PER_PHASE
#define MK_PER_PHASE 0
#endif
constexpr int NPHASE = 22;

constexpr int BATCH = 2, SEQ = 8192, DM = 2048, NTOK = BATCH * SEQ, NH = 16, DH = 128;
constexpr int NSA_N = 5168, NSA_NPAD = 5376, P0LD = 5120;
constexpr int NCMP = 511, NSELB = 128;
constexpr int COL_KC = 2048, COL_VC = 2560, COL_KS = 3072, COL_VS = 3584, COL_KW = 4096, COL_VW = 4608;
constexpr int DSA_N = 2888, DSA_NPAD = 3072, KVR = 256, TOPK = 256;
constexpr int DFF = 5632, NEXP = 8, DFFE = 7168, MOE_ROWS = 34816;
constexpr float ALPHA = 1.41421356237309515f, LN_EPS = 1e-5f, RMS_EPS = 1e-6f;

constexpr size_t MiB = (size_t)1 << 20;
constexpr size_t WS_CTL = 0, CTL_ZERO_BYTES = 128 * 1024;
constexpr size_t WS_W_NSA_IN = 2 * MiB, WS_W_NSA_OUT = 23 * MiB, WS_W_FFN_GU = 31 * MiB, WS_W_FFN_DN = 75 * MiB, WS_W_DSA_IN = 97 * MiB, WS_W_DSA_OUT = 109 * MiB;
constexpr size_t WS_W_CMPK = 117 * MiB, WS_W_CMPV = 118 * MiB, WS_W_UK = 181 * MiB, WS_W_UV = 183 * MiB, WS_CBIAS = 121 * MiB;
constexpr size_t WS_KCMP = 122 * MiB, WS_VCMP = 124 * MiB, WS_GL = 126 * MiB, WS_ROUTE = 129 * MiB;
constexpr size_t WS_KIB = 179 * MiB;
constexpr size_t WS_SELM = 178 * MiB;
constexpr size_t WS_CRAW = 130 * MiB, WS_KIWI = 146 * MiB, WS_IDX = 154 * MiB, WS_CN = 170 * MiB;
constexpr size_t WS_W_MOE_GU = 192 * MiB, WS_W_MOE_DN = 640 * MiB;
constexpr size_t WS_XB = 864 * MiB, WS_XF = 928 * MiB, WS_Z = 1056 * MiB;
constexpr size_t WS_P0 = 1184 * MiB, WS_OATT0 = 1344 * MiB, WS_HFF = 1408 * MiB;
constexpr size_t WS_Q = 1184 * MiB, WS_QI = 1248 * MiB, WS_QLAT = 1264 * MiB, WS_OLAT = 1392 * MiB, WS_OATT1 = 1520 * MiB;
constexpr size_t WS_XG = 1056 * MiB, WS_HM = 1192 * MiB, WS_Y = 192 * MiB;
constexpr size_t WS_END = 1668 * MiB;
static_assert(WS_HM + (size_t)MOE_ROWS * DFFE * 2 <= WS_END, "hm fits");
static_assert(WS_XG + (size_t)MOE_ROWS * DM * 2 <= WS_HM, "xg fits");
static_assert(WS_Y + (size_t)MOE_ROWS * DM * 4 <= WS_W_MOE_DN, "y overlays the dead gate/up weights only");
static_assert(WS_HFF + (size_t)NTOK * DFF * 2 <= WS_END, "hff fits");
constexpr int CW_TMO = 0, CW_CODE = 1;
constexpr int CW_BAR = 4096;
constexpr int CW_MOECNT = 16384;

constexpr int RING_OFF = 0, RING_BYTES = 131072;
constexpr int LDSCTL_OFF = RING_BYTES, MISC_OFF = LDSCTL_OFF + 320;
constexpr int LDS_BYTES = 163840;
constexpr int DSA_SCR = 133120;

struct Frame {
    LAS unsigned char* lds;
    volatile LAS unsigned* MISC;
    gu32* ctl;
    int tid, lane, wave, vcu, G;
};

__device__ __forceinline__ void relaunder(Frame& F) { int t = F.tid; asm volatile("" : "+v"(t)); F.tid = t; F.lane = t & 63; }
__device__ __forceinline__ float bf2f(unsigned short h) { return __uint_as_float(((unsigned)h) << 16); }
__device__ __forceinline__ float bflo(unsigned w) { return __uint_as_float(w << 16); }
__device__ __forceinline__ float bfhi(unsigned w) { return __uint_as_float(w & 0xffff0000u); }
__device__ __forceinline__ float dpp_xor1(float v) { return __int_as_float(__builtin_amdgcn_mov_dpp(__float_as_int(v), 0xB1, 0xF, 0xF, true)); }
__device__ __forceinline__ float dpp_xor2(float v) { return __int_as_float(__builtin_amdgcn_mov_dpp(__float_as_int(v), 0x4E, 0xF, 0xF, true)); }
__device__ __forceinline__ float sum_xor32(float v) { auto r = __builtin_amdgcn_permlane32_swap(__float_as_uint(v), __float_as_uint(v), false, false); return __uint_as_float(r[0]) + __uint_as_float(r[1]); }
__device__ __forceinline__ float max_xor32(float v) { auto r = __builtin_amdgcn_permlane32_swap(__float_as_uint(v), __float_as_uint(v), false, false); return fmaxf(__uint_as_float(r[0]), __uint_as_float(r[1])); }
__device__ __forceinline__ float sum_xor16(float v) { auto r = __builtin_amdgcn_permlane16_swap(__float_as_uint(v), __float_as_uint(v), false, false); return __uint_as_float(r[0]) + __uint_as_float(r[1]); }
__device__ __forceinline__ float max_xor16(float v) { auto r = __builtin_amdgcn_permlane16_swap(__float_as_uint(v), __float_as_uint(v), false, false); return fmaxf(__uint_as_float(r[0]), __uint_as_float(r[1])); }
__device__ __forceinline__ float wave_sum(float v) {
    v += dpp_xor1(v); v += dpp_xor2(v);
    v += __int_as_float(__builtin_amdgcn_mov_dpp(__float_as_int(v), 0x141, 0xF, 0xF, true));
    v += __int_as_float(__builtin_amdgcn_mov_dpp(__float_as_int(v), 0x140, 0xF, 0xF, true));
    return sum_xor32(sum_xor16(v));
}
__device__ __forceinline__ float wave_max(float v) {
    v = fmaxf(v, dpp_xor1(v)); v = fmaxf(v, dpp_xor2(v));
    v = fmaxf(v, __int_as_float(__builtin_amdgcn_mov_dpp(__float_as_int(v), 0x141, 0xF, 0xF, true)));
    v = fmaxf(v, __int_as_float(__builtin_amdgcn_mov_dpp(__float_as_int(v), 0x140, 0xF, 0xF, true)));
    return max_xor32(max_xor16(v));
}
#define WSYNC() do { __builtin_amdgcn_wave_barrier(); asm volatile("s_waitcnt lgkmcnt(0)" ::: "memory"); __builtin_amdgcn_wave_barrier(); } while (0)

__device__ __forceinline__ int rel_bucket(int n) {
    if (n < 16) return n;
    if (n >= 113) return 31;
    int b = 16;
    b += (n >= 19); b += (n >= 21); b += (n >= 24); b += (n >= 27); b += (n >= 31); b += (n >= 35); b += (n >= 40); b += (n >= 46);
    b += (n >= 52); b += (n >= 59); b += (n >= 67); b += (n >= 77); b += (n >= 87); b += (n >= 99);
    return b;
}

struct Args { const float* in[27]; float* out; unsigned char* ws; int ph_lo, ph_hi; };
#ifndef FFN_F8
#define FFN_F8 1
#endif
struct TrItem { const float* W; bf16* WT; int N, K, k0, n0, drow, kdoff; float f8scale; };
__device__ __forceinline__ void tr_set(TrItem& T, const float* W, int K, int N, int Npad, bf16* WT, int mode, int item, float f8scale = 0.f, int Kdst = 0, int kdoff = 0, int drow_off = 0) {
    T.f8scale = f8scale; T.kdoff = kdoff;
    const int nblk = Npad / 32, kb = item / nblk, nb = item - kb * nblk, n0 = 32 * nb;
    T.W = W; T.WT = WT; T.N = N; T.K = Kdst ? Kdst : K; T.k0 = 64 * kb; T.n0 = n0; T.drow = drow_off + ((mode == 0) ? n0 : ((n0 >> 7) * 256 + (mode - 1) * 128 + (n0 & 127)));
}
constexpr int TR_I_NSA_IN = (DM / 64) * (NSA_NPAD / 32), TR_I_SQ = (DM / 64) * (DM / 32), TR_I_FFN = (DM / 64) * (DFF / 32), TR_I_FFD = (DFF / 64) * (DM / 32), TR_I_DSA_IN = (DM / 64) * (DSA_NPAD / 32);
constexpr int TR_I_CMP = (4096 / 64) * (128 / 32), TR_I_UK1 = (128 / 64) * (256 / 32), TR_I_UV1 = (256 / 64) * (128 / 32);
constexpr int TR_I_MG1 = (DM / 64) * (DFFE / 32), TR_I_MD1 = (DFFE / 64) * (DM / 32);
constexpr int TR_NITEMS = TR_I_NSA_IN + 2 * TR_I_SQ + 2 * TR_I_FFN + TR_I_FFD + TR_I_DSA_IN + 2 * TR_I_CMP + 16 * TR_I_UK1 + 16 * TR_I_UV1 + 16 * TR_I_MG1 + 8 * TR_I_MD1;
__device__ __forceinline__ void tr_decode(const Args& A, unsigned char* ws, int it, TrItem& T) {
    int r = it;
    if (r < TR_I_NSA_IN) { tr_set(T, A.in[2], DM, NSA_N, NSA_NPAD, (bf16*)(ws + WS_W_NSA_IN), 0, r); return; } r -= TR_I_NSA_IN;
    if (r < TR_I_SQ) { tr_set(T, A.in[9], DM, DM, DM, (bf16*)(ws + WS_W_NSA_OUT), 0, r); return; } r -= TR_I_SQ;
    if (r < TR_I_SQ) { tr_set(T, A.in[14], DM, DM, DM, (bf16*)(ws + WS_W_DSA_OUT), 0, r); return; } r -= TR_I_SQ;
    if (r < TR_I_FFN) { tr_set(T, A.in[15], DM, DFF, DFF, (bf16*)(ws + WS_W_FFN_GU), 1, r, FFN_F8 ? 64.f : 0.f); return; } r -= TR_I_FFN;
    if (r < TR_I_FFN) { tr_set(T, A.in[16], DM, DFF, DFF, (bf16*)(ws + WS_W_FFN_GU), 2, r, FFN_F8 ? 64.f : 0.f); return; } r -= TR_I_FFN;
    if (r < TR_I_FFD) { tr_set(T, A.in[17], DFF, DM, DM, (bf16*)(ws + WS_W_FFN_DN), 0, r, FFN_F8 ? 256.f : 0.f); return; } r -= TR_I_FFD;
    if (r < TR_I_DSA_IN) { tr_set(T, A.in[10], DM, DSA_N, DSA_NPAD, (bf16*)(ws + WS_W_DSA_IN), 0, r); return; } r -= TR_I_DSA_IN;
    if (r < TR_I_CMP) { tr_set(T, A.in[4], 4096, 128, 128, (bf16*)(ws + WS_W_CMPK), 0, r); return; } r -= TR_I_CMP;
    if (r < TR_I_CMP) { tr_set(T, A.in[7], 4096, 128, 128, (bf16*)(ws + WS_W_CMPV), 0, r); return; } r -= TR_I_CMP;
    if (r < 16 * TR_I_UK1) { const int h = r / TR_I_UK1; tr_set(T, A.in[12] + (size_t)h * 128 * 256, 128, 256, 256, (bf16*)(ws + WS_W_UK), 0, r - h * TR_I_UK1, 0.f, 256, (h & 1) * 128, h * 256); return; } r -= 16 * TR_I_UK1;
    if (r < 16 * TR_I_UV1) { const int h = r / TR_I_UV1; tr_set(T, A.in[13] + (size_t)h * 256 * 128, 256, 128, 128, (bf16*)(ws + WS_W_UV), 0, r - h * TR_I_UV1, 0.f, 512, (h & 1) * 256, h * 128); return; } r -= 16 * TR_I_UV1;
    if (r < 8 * TR_I_MG1) { const int e = r / TR_I_MG1; tr_set(T, A.in[20] + (size_t)e * DM * DFFE, DM, DFFE, DFFE, (bf16*)(ws + WS_W_MOE_GU + (size_t)e * 2 * DFFE * DM), 1, r - e * TR_I_MG1, 64.f); return; } r -= 8 * TR_I_MG1;
    if (r < 8 * TR_I_MG1) { const int e = r / TR_I_MG1; tr_set(T, A.in[21] + (size_t)e * DM * DFFE, DM, DFFE, DFFE, (bf16*)(ws + WS_W_MOE_GU + (size_t)e * 2 * DFFE * DM), 2, r - e * TR_I_MG1, 64.f); return; } r -= 8 * TR_I_MG1;
    { const int e = r / TR_I_MD1; tr_set(T, A.in[22] + (size_t)e * DFFE * DM, DFFE, DM, DM, (bf16*)(ws + WS_W_MOE_DN + (size_t)e * DM * DFFE), 0, r - e * TR_I_MD1, 256.f); }
}
__device__ __forceinline__ void tr_load(const TrItem& T, f32x4 (&v)[8], int lane) {
    const int kr = lane >> 3, c4 = lane & 7, n = T.n0 + 4 * c4;
#pragma unroll
    for (int i = 0; i < 8; ++i) v[i] = (n < T.N) ? __builtin_nontemporal_load((const f32x4*)(T.W + (size_t)(T.k0 + 8 * i + kr) * T.N + n)) : (f32x4){0.f, 0.f, 0.f, 0.f};
}
__device__ __forceinline__ void tr_store(const TrItem& T, const f32x4 (&v)[8], LAS float* scr, int lane) {
    { const int kr = lane >> 3, c4 = lane & 7;
#pragma unroll
      for (int i = 0; i < 8; ++i) { LAS float* d = scr + (8 * i + kr) * 33 + 4 * c4; d[0] = v[i][0]; d[1] = v[i][1]; d[2] = v[i][2]; d[3] = v[i][3]; } }
    LDS_WAIT(); asm volatile("" ::: "memory");
    const int c = lane & 7;
#pragma unroll
    for (int j = 0; j < 4; ++j) { const int n = (lane >> 3) + 8 * j; const LAS float* s = scr + (8 * c) * 33 + n;
        v4u o; o.x = pg8::cvt_pk_bf16(s[0 * 33], s[1 * 33]); o.y = pg8::cvt_pk_bf16(s[2 * 33], s[3 * 33]); o.z = pg8::cvt_pk_bf16(s[4 * 33], s[5 * 33]); o.w = pg8::cvt_pk_bf16(s[6 * 33], s[7 * 33]);
        *(v4u*)(T.WT + (size_t)(T.drow + n) * T.K + T.kdoff + T.k0 + 8 * c) = o; }
    LDS_WAIT(); asm volatile("" ::: "memory");
}

__device__ __forceinline__ void tr_store8(const TrItem& T, const f32x4 (&v)[8], LAS float* scr, int lane) {
    { const int kr = lane >> 3, c4 = lane & 7;
#pragma unroll
      for (int i = 0; i < 8; ++i) { LAS float* d = scr + (8 * i + kr) * 33 + 4 * c4; d[0] = v[i][0]; d[1] = v[i][1]; d[2] = v[i][2]; d[3] = v[i][3]; } }
    LDS_WAIT(); asm volatile("" ::: "memory");
    const int c = lane & 3, nr = lane >> 2; const float sc = T.f8scale;
#pragma unroll
    for (int j = 0; j < 2; ++j) { const int n = nr + 16 * j; const LAS float* s = scr + (16 * c) * 33 + n; int w[4];
#pragma unroll
        for (int q = 0; q < 4; ++q) { w[q] = __builtin_amdgcn_cvt_pk_fp8_f32(s[(4 * q) * 33] * sc, s[(4 * q + 1) * 33] * sc, 0, false); w[q] = __builtin_amdgcn_cvt_pk_fp8_f32(s[(4 * q + 2) * 33] * sc, s[(4 * q + 3) * 33] * sc, w[q], true); }
        v4u o; o.x = (unsigned)w[0]; o.y = (unsigned)w[1]; o.z = (unsigned)w[2]; o.w = (unsigned)w[3];
        __builtin_nontemporal_store(o, (v4u*)((unsigned char*)T.WT + (size_t)(T.drow + n) * T.K + T.kdoff + T.k0 + 16 * c)); }
    LDS_WAIT(); asm volatile("" ::: "memory");
}
__device__ __forceinline__ void p0_prologue(Frame& F, const Args& A) {
    LAS float* scr = (LAS float*)(F.lds + RING_OFF + F.wave * 16384);
    unsigned char* ws = A.ws;
    const int gw = F.vcu * NWAVES + F.wave, NGW = F.G * NWAVES, lane = F.lane;
    {
        TrItem T0, T1, T2, T3; f32x4 v0[8], v1[8], v2[8], v3[8]; int it = gw;
#define TR_ISSUE(T, v, idx) do { if ((idx) < TR_NITEMS) { tr_decode(A, ws, (idx), T); tr_load(T, v, lane); } } while (0)
#define TR_RETIRE(T, v, idx) do { if ((idx) < TR_NITEMS) { if (T.f8scale != 0.f) tr_store8(T, v, scr, lane); else tr_store(T, v, scr, lane); } } while (0)
        TR_ISSUE(T0, v0, it); TR_ISSUE(T1, v1, it + NGW); TR_ISSUE(T2, v2, it + 2 * NGW);
        while (it < TR_NITEMS) {
            TR_ISSUE(T3, v3, it + 3 * NGW); TR_RETIRE(T0, v0, it);
            TR_ISSUE(T0, v0, it + 4 * NGW); TR_RETIRE(T1, v1, it + NGW);
            TR_ISSUE(T1, v1, it + 5 * NGW); TR_RETIRE(T2, v2, it + 2 * NGW);
            TR_ISSUE(T2, v2, it + 6 * NGW); TR_RETIRE(T3, v3, it + 3 * NGW);
            it += 4 * NGW;
        }
#undef TR_ISSUE
#undef TR_RETIRE
    }
    { const v4u z = {0u, 0u, 0u, 0u};
      for (int i = F.vcu * 512 + F.tid; i < 4096 * 16; i += F.G * 512) { const int n = i >> 4, ch = i & 15, h = n >> 8; *(v4u*)((bf16*)(ws + WS_W_UK) + (size_t)n * 256 + (1 - (h & 1)) * 128 + ch * 8) = z; }
      for (int i = F.vcu * 512 + F.tid; i < 2048 * 32; i += F.G * 512) { const int n = i >> 5, ch = i & 31, h = n >> 7; *(v4u*)((bf16*)(ws + WS_W_UV) + (size_t)n * 512 + (1 - (h & 1)) * 256 + ch * 8) = z; } }
    { const float* x = A.in[0]; bf16* xb = (bf16*)(ws + WS_XB); const size_t n8 = (size_t)NTOK * DM / 8;
      const size_t st = (size_t)F.G * 512;
      size_t i = (size_t)F.vcu * 512 + F.tid;
      for (; i + 3 * st < n8; i += 4 * st) { f32x4 a[4], b[4];
#pragma unroll
          for (int u = 0; u < 4; ++u) { a[u] = __builtin_nontemporal_load((const f32x4*)(x + (i + u * st) * 8)); b[u] = __builtin_nontemporal_load((const f32x4*)(x + (i + u * st) * 8 + 4)); }
#pragma unroll
          for (int u = 0; u < 4; ++u) { v4u o; o.x = pk2(a[u][0], a[u][1]); o.y = pk2(a[u][2], a[u][3]); o.z = pk2(b[u][0], b[u][1]); o.w = pk2(b[u][2], b[u][3]); *(v4u*)(xb + (i + u * st) * 8) = o; } }
      for (; i < n8; i += st) { const f32x4 a = *(const f32x4*)(x + i * 8), b = *(const f32x4*)(x + i * 8 + 4);
          v4u o; o.x = pk2(a[0], a[1]); o.y = pk2(a[2], a[3]); o.z = pk2(b[0], b[1]); o.w = pk2(b[2], b[3]); *(v4u*)(xb + i * 8) = o; } }
    for (int it = gw; it < 64; it += NGW) { const int kv = it >> 5, ch = it & 31; const float* pe = A.in[kv ? 6 : 3]; const float* w1 = A.in[kv ? 7 : 4];
        float s0 = 0.f, s1 = 0.f;
#pragma unroll 1
        for (int k0 = ch * 128; k0 < ch * 128 + 128; k0 += 32) { float pv[32], wa[32], wb[32];
#pragma unroll
            for (int j = 0; j < 32; ++j) { pv[j] = pe[k0 + j]; wa[j] = w1[(size_t)(k0 + j) * 128 + lane]; wb[j] = w1[(size_t)(k0 + j) * 128 + 64 + lane]; }
#pragma unroll
            for (int j = 0; j < 32; ++j) { s0 += pv[j] * wa[j]; s1 += pv[j] * wb[j]; } }
        float* cb = (float*)(ws + WS_CBIAS) + (size_t)(kv * 32 + ch) * 128; cb[lane] = s0; cb[64 + lane] = s1; }
}

typedef short s8v __attribute__((ext_vector_type(8)));
__device__ __forceinline__ s8v ld_frag(const bf16* p) { return *(const s8v*)p; }

__device__ __forceinline__ float gelu_tanh(float x) { const float u = 0.7978845608028654f * (x + 0.044715f * x * x * x); return 0.5f * x * (1.0f + tanhf(u)); }
__device__ __forceinline__ void p2_compress(Frame& F, const Args& A) {
    unsigned char* ws = A.ws; const int lane = F.lane, wid = F.wave, tid = F.tid;
    const bf16* P0 = (const bf16*)(ws + WS_P0);
    LAS float* part = (LAS float*)(F.lds + RING_OFF);
    LAS float* hid = (LAS float*)(F.lds + DSA_SCR);
    LAS float* cbl = hid + 4096;
    if (tid < 256) { const float* cbp = (const float*)(ws + WS_CBIAS) + (size_t)(tid >> 7) * 32 * 128 + (tid & 127); float cb = 0.f; for (int ch = 0; ch < 32; ++ch) cb += cbp[ch * 128]; cbl[tid] = cb; }
    if (F.vcu < 16 && wid == 0) { bf16* zp = (bf16*)(ws + ((F.vcu & 1) ? WS_VCMP : WS_KCMP)) + ((size_t)(F.vcu >> 1) * 512 + 511) * 128; zp[lane] = 0; zp[64 + lane] = 0; }
    __syncthreads();
    const int r16 = lane & 15, kq = lane >> 4;
    for (int it = F.vcu; it < 256; it += F.G) {
        const int kv = it >> 7, tile = it & 127;
        const bf16* W1T = (const bf16*)(ws + (kv ? WS_W_CMPV : WS_W_CMPK));
        const float* w2 = A.in[kv ? 8 : 5];
        bf16* outp = (bf16*)(ws + (kv ? WS_VCMP : WS_KCMP));
        const int colbase = kv ? COL_VC : COL_KC;
        f32x4 acc[2][8];
#pragma unroll
        for (int m = 0; m < 2; ++m)
#pragma unroll
            for (int n = 0; n < 8; ++n) acc[m][n] = (f32x4){0.f, 0.f, 0.f, 0.f};
        const bf16* arow[2];
#pragma unroll
        for (int m = 0; m < 2; ++m) { int R = tile * 32 + m * 16 + r16; if (R > 4087) R = 4087; const int g = R & 3, bn = R >> 2, b = bn / NCMP, n = bn - b * NCMP;
            arow[m] = P0 + (size_t)(b * SEQ + 16 * n) * P0LD + colbase + g * 128 + kq * 8; }
#pragma unroll 2
        for (int kk = 0; kk < 16; ++kk) {
            const int ks = wid * 16 + kk, l = ks >> 2, d0 = (ks & 3) * 32;
            s8v af[2], bfr[8];
#pragma unroll
            for (int m = 0; m < 2; ++m) af[m] = ld_frag(arow[m] + (size_t)l * P0LD + d0);
#pragma unroll
            for (int n = 0; n < 8; ++n) bfr[n] = ld_frag(W1T + (size_t)(n * 16 + r16) * 4096 + ks * 32 + kq * 8);
#pragma unroll
            for (int m = 0; m < 2; ++m)
#pragma unroll
                for (int n = 0; n < 8; ++n) acc[m][n] = __builtin_amdgcn_mfma_f32_16x16x32_bf16(af[m], bfr[n], acc[m][n], 0, 0, 0);
        }
#pragma unroll
        for (int m = 0; m < 2; ++m)
#pragma unroll
            for (int n = 0; n < 8; ++n)
#pragma unroll
                for (int j = 0; j < 4; ++j) part[wid * 4096 + (m * 16 + kq * 4 + j) * 128 + n * 16 + r16] = acc[m][n][j];
        __syncthreads();
        { const int row = tid >> 4, e0 = (tid & 15) * 8; f32x4 s0 = (f32x4){0.f, 0.f, 0.f, 0.f}, s1 = s0;
#pragma unroll
          for (int w = 0; w < 8; ++w) { s0 += *(const LAS f32x4*)(part + w * 4096 + row * 128 + e0); s1 += *(const LAS f32x4*)(part + w * 4096 + row * 128 + e0 + 4); }
#pragma unroll
          for (int j = 0; j < 4; ++j) { hid[row * 128 + e0 + j] = gelu_tanh(s0[j] + cbl[kv * 128 + e0 + j]); hid[row * 128 + e0 + 4 + j] = gelu_tanh(s1[j] + cbl[kv * 128 + e0 + 4 + j]); } }
        __syncthreads();
        { const int rr = tid >> 4, f0 = (tid & 15) * 8, R = tile * 32 + rr; f32x4 o0 = (f32x4){0.f, 0.f, 0.f, 0.f}, o1 = o0;
#pragma unroll 16
          for (int e = 0; e < 128; ++e) { const float hv = hid[rr * 128 + e]; o0 += *(const f32x4*)(w2 + e * 128 + f0) * hv; o1 += *(const f32x4*)(w2 + e * 128 + f0 + 4) * hv; }
          if (R <= 4087) { const int g = R & 3, bn = R >> 2, b = bn / NCMP, n = bn - b * NCMP;
              v4u o; o.x = pk2(o0[0], o0[1]); o.y = pk2(o0[2], o0[3]); o.z = pk2(o1[0], o1[1]); o.w = pk2(o1[2], o1[3]);
              *(v4u*)(outp + ((size_t)(b * 4 + g) * 512 + n) * 128 + f0) = o; } }
        __syncthreads();
    }
    for (int tb = F.vcu; tb < NTOK / 64; tb += F.G) {
        const bf16* XBp = (const bf16*)(ws + WS_XB); const bf16* WG = (const bf16*)(ws + WS_W_NSA_IN) + (size_t)5120 * DM; float* GL = (float*)(ws + WS_GL);
        const int rt = wid & 3, kh = wid >> 2, tokr = tb * 64 + rt * 16;
        f32x4 ga[3];
#pragma unroll
        for (int n = 0; n < 3; ++n) ga[n] = (f32x4){0.f, 0.f, 0.f, 0.f};
        const bf16* ap = XBp + (size_t)(tokr + r16) * DM + kh * 1024 + kq * 8; const bf16* bp = WG + (size_t)r16 * DM + kh * 1024 + kq * 8;
#pragma unroll 8
        for (int ks = 0; ks < 32; ++ks) { const s8v af = ld_frag(ap + ks * 32);
#pragma unroll
            for (int n = 0; n < 3; ++n) ga[n] = __builtin_amdgcn_mfma_f32_16x16x32_bf16(af, ld_frag(bp + (size_t)n * 16 * DM + ks * 32), ga[n], 0, 0, 0); }
        if (kh == 1) {
#pragma unroll
            for (int n = 0; n < 3; ++n) *(LAS f32x4*)(part + (rt * 3 + n) * 256 + lane * 4) = ga[n]; }
        __syncthreads();
        if (kh == 0) {
#pragma unroll
            for (int n = 0; n < 3; ++n) { const f32x4 o = ga[n] + *(const LAS f32x4*)(part + (rt * 3 + n) * 256 + lane * 4);
#pragma unroll
                for (int j = 0; j < 4; ++j) GL[(size_t)(tokr + kq * 4 + j) * 48 + n * 16 + r16] = o[j]; } }
        __syncthreads();
    }
}

namespace fa {
typedef float f32x16 __attribute__((ext_vector_type(16)));
typedef short s16x4 __attribute__((ext_vector_type(4)));
typedef unsigned u32x4v __attribute__((ext_vector_type(4)));
constexpr int SHM_K = 16384, SHM_V = 16384;
constexpr int OFF_V = 0, OFF_K = 2 * SHM_V, OFF_WS = 2 * SHM_V + 2 * SHM_K, OFF_LUT = OFF_WS + 8 * 256, OFF_MASK = OFF_LUT + 144 * 16 * 4, OFF_TAB = OFF_MASK + 1024;
constexpr int TABLD = 130;
constexpr float C2 = 1.4426950408889634f, THR = 8.f;
#define FA_KSWZ(row, colB) ((row) * 256 + ((colB) ^ (((row) & 7) << 4)))
#define FA_SBAR() __builtin_amdgcn_sched_barrier(0)
__device__ __forceinline__ int v_st(int k, int c) { const int kk = (k & ~0xC) | ((k & 4) << 1) | ((k & 8) >> 1); return ((kk >> 3) * 4 + (c >> 5)) * 512 + ((kk & 7) * 32 + (c & 31)) * 2; }
__device__ __forceinline__ int v_rd_base(int lane) { return ((lane & 3) << 3) | (((lane >> 2) & 3) << 6) | (((lane >> 4) & 1) << 5) | (((lane >> 5) & 1) << 8); }
constexpr int v_rd_off(int d0, int ks, int half) { return d0 * 512 + ks * 4096 + half * 2048; }
__device__ __forceinline__ int crow(int r, int hi) { return (r & 3) + 8 * (r >> 2) + 4 * hi; }
__device__ __forceinline__ unsigned cvtpk(float lo, float hi) { unsigned r; asm volatile("v_cvt_pk_bf16_f32 %0, %1, %2" : "=v"(r) : "v"(lo), "v"(hi)); return r; }

__device__ __forceinline__ void qkt(f32x16& p0, f32x16& p1, const LAS char* Kb, int r32, int hi, const bf16x8 (&qr)[8], float init) {
#pragma unroll
    for (int r = 0; r < 16; ++r) { p0[r] = init; p1[r] = init; }
    int kb[4];
#pragma unroll
    for (int dd = 0; dd < 4; ++dd) kb[dd] = (int)(uintptr_t)(Kb + FA_KSWZ(r32, (dd * 16 + hi * 8) * 2));
    bf16x8 fa_[4], fb_[4];
#define FA_QRD(dst, addr, off) asm volatile("ds_read_b128 %0, %1 offset:%2" : "=&v"(dst) : "v"(addr), "i"(off) : "memory")
#define FA_QRD4(F_, ka_, kb_, off_) do { FA_QRD(F_[0], ka_, off_); FA_QRD(F_[1], ka_, (off_) + 8192); FA_QRD(F_[2], kb_, off_); FA_QRD(F_[3], kb_, (off_) + 8192); } while (0)
#define FA_QWAIT(F_, n_) asm volatile("s_waitcnt lgkmcnt(" #n_ ")" : "+v"(F_[0]), "+v"(F_[1]), "+v"(F_[2]), "+v"(F_[3]) :: "memory")
#define FA_QMMA(F_, d_) do { p0 = __builtin_amdgcn_mfma_f32_32x32x16_bf16(F_[0], qr[d_], p0, 0, 0, 0); p1 = __builtin_amdgcn_mfma_f32_32x32x16_bf16(F_[1], qr[d_], p1, 0, 0, 0); \
        p0 = __builtin_amdgcn_mfma_f32_32x32x16_bf16(F_[2], qr[(d_) + 1], p0, 0, 0, 0); p1 = __builtin_amdgcn_mfma_f32_32x32x16_bf16(F_[3], qr[(d_) + 1], p1, 0, 0, 0); } while (0)
    FA_QRD4(fa_, kb[0], kb[1], 0);
    FA_QRD4(fb_, kb[2], kb[3], 0);   FA_QWAIT(fa_, 4); FA_QMMA(fa_, 0);
    FA_QRD4(fa_, kb[0], kb[1], 128); FA_QWAIT(fb_, 4); FA_QMMA(fb_, 2);
    FA_QRD4(fb_, kb[2], kb[3], 128); FA_QWAIT(fa_, 4); FA_QMMA(fa_, 4);
    FA_QWAIT(fb_, 0); FA_QMMA(fb_, 6);
#undef FA_QRD
#undef FA_QRD4
#undef FA_QWAIT
#undef FA_QMMA
}
__device__ __forceinline__ void pv_tile(f32x16 (&o)[4], int vb0, bf16x8 pa0, bf16x8 pa1, bf16x8 pa2, bf16x8 pa3) {
#define FA_TRRD(dst, off) asm volatile("ds_read_b64_tr_b16 %0, %1 offset:%2" : "=&v"(dst) : "v"(vb0), "i"(off) : "memory")
#define FA_PV_D0(d0) do { s16x4 l0, l1, l2, l3, h0, h1, h2, h3; constexpr int b_ = v_rd_off(d0, 0, 0); \
        FA_TRRD(l0, b_); FA_TRRD(h0, b_ + 2048); FA_TRRD(l1, b_ + 4096); FA_TRRD(h1, b_ + 6144); FA_TRRD(l2, b_ + 8192); FA_TRRD(h2, b_ + 10240); FA_TRRD(l3, b_ + 12288); FA_TRRD(h3, b_ + 14336); \
        asm volatile("s_waitcnt lgkmcnt(0)" ::: "memory"); FA_SBAR(); \
        o[d0] = __builtin_amdgcn_mfma_f32_32x32x16_bf16(pa0, (bf16x8){l0[0], l0[1], l0[2], l0[3], h0[0], h0[1], h0[2], h0[3]}, o[d0], 0, 0, 0); \
        o[d0] = __builtin_amdgcn_mfma_f32_32x32x16_bf16(pa1, (bf16x8){l1[0], l1[1], l1[2], l1[3], h1[0], h1[1], h1[2], h1[3]}, o[d0], 0, 0, 0); \
        o[d0] = __builtin_amdgcn_mfma_f32_32x32x16_bf16(pa2, (bf16x8){l2[0], l2[1], l2[2], l2[3], h2[0], h2[1], h2[2], h2[3]}, o[d0], 0, 0, 0); \
        o[d0] = __builtin_amdgcn_mfma_f32_32x32x16_bf16(pa3, (bf16x8){l3[0], l3[1], l3[2], l3[3], h3[0], h3[1], h3[2], h3[3]}, o[d0], 0, 0, 0); } while (0)
    FA_PV_D0(0); FA_PV_D0(1); FA_PV_D0(2); FA_PV_D0(3);
#undef FA_PV_D0
#undef FA_TRRD
}
__device__ __forceinline__ void partialSM(f32x16& p0, f32x16& p1, float& m_reg, float& alpha) {
    float pmax = p0[0];
#pragma unroll
    for (int r = 1; r < 16; ++r) pmax = fmaxf(pmax, p0[r]);
#pragma unroll
    for (int r = 0; r < 16; ++r) pmax = fmaxf(pmax, p1[r]);
    { auto rr = __builtin_amdgcn_permlane32_swap(__float_as_uint(pmax), __float_as_uint(pmax), false, false); pmax = fmaxf(__uint_as_float(rr[0]), __uint_as_float(rr[1])); }
    float mn;
    if (__all(pmax - m_reg <= THR)) { mn = m_reg; alpha = 1.f; }
    else { mn = fmaxf(m_reg, pmax); alpha = __builtin_amdgcn_exp2f((m_reg - mn) * C2); m_reg = mn; }
    const float mnL = -mn * C2;
#pragma unroll
    for (int r = 0; r < 16; ++r) { p0[r] = __builtin_amdgcn_exp2f(fmaf(p0[r], C2, mnL)); p1[r] = __builtin_amdgcn_exp2f(fmaf(p1[r], C2, mnL)); }
}
__device__ __forceinline__ float finishSM(const f32x16& p0, const f32x16& p1, bf16x8& pa0, bf16x8& pa1, bf16x8& pa2, bf16x8& pa3) {
    float ps = 0.f;
#pragma unroll
    for (int r = 0; r < 16; ++r) ps += p0[r];
#pragma unroll
    for (int r = 0; r < 16; ++r) ps += p1[r];
    { auto rr = __builtin_amdgcn_permlane32_swap(__float_as_uint(ps), __float_as_uint(ps), false, false); ps = __uint_as_float(rr[0]) + __uint_as_float(rr[1]); }
#define FA_PK4(P, B_, OUT) do { unsigned a0 = cvtpk(P[B_ + 0], P[B_ + 1]), a1 = cvtpk(P[B_ + 2], P[B_ + 3]); unsigned b0 = cvtpk(P[B_ + 4], P[B_ + 5]), b1 = cvtpk(P[B_ + 6], P[B_ + 7]); \
        auto r0 = __builtin_amdgcn_permlane32_swap(a0, b0, false, false); auto r1 = __builtin_amdgcn_permlane32_swap(a1, b1, false, false); \
        u32x4v w = {r0[0], r1[0], r0[1], r1[1]}; OUT = *reinterpret_cast<bf16x8*>(&w); } while (0)
    FA_PK4(p0, 0, pa0); FA_PK4(p0, 8, pa1); FA_PK4(p1, 0, pa2); FA_PK4(p1, 8, pa3);
#undef FA_PK4
    return ps;
}
__device__ __forceinline__ void rescale(f32x16 (&o)[4], float alpha, LAS float* al_l, int r32, int hi) {
    if (__any(alpha < 1.f)) { if (hi == 0) al_l[r32] = alpha; asm volatile("s_waitcnt lgkmcnt(0)" ::: "memory");
#pragma unroll
        for (int r = 0; r < 16; ++r) { const float a = al_l[crow(r, hi)];
#pragma unroll
            for (int d = 0; d < 4; ++d) o[d][r] *= a; }
        asm volatile("s_waitcnt lgkmcnt(0)" ::: "memory"); }
}
__device__ __forceinline__ void mask_tile(f32x16& p0, f32x16& p1, int dq, unsigned W) {
    const float NEG = -__builtin_inff();
#pragma unroll
    for (int r = 0; r < 16; ++r) { const int c = (r & 3) + 8 * (r >> 2);
        if ((unsigned)(dq - c) >= W) p0[r] = NEG;
        if ((unsigned)(dq - c - 32) >= W) p1[r] = NEG; }
}
__device__ __forceinline__ void mask_all(f32x16& p0, f32x16& p1, bool keep) {
    const float NEG = -__builtin_inff();
#pragma unroll
    for (int r = 0; r < 16; ++r) { p0[r] = keep ? p0[r] : NEG; p1[r] = keep ? p1[r] : NEG; }
}
__device__ __forceinline__ void bias_near(f32x16& p0, f32x16& p1, int dq, int step, const LAS float* lutcol) {
#pragma unroll
    for (int r = 0; r < 16; ++r) { const int c = (r & 3) + 8 * (r >> 2);
        const int d0 = min(max((dq - c) * step, 0), 128), d1 = min(max((dq - c - 32) * step, 0), 128);
        p0[r] += lutcol[d0]; p1[r] += lutcol[d1]; }
}
struct Stage { bf16x8 k0, k1, v0, v1; };
__device__ __forceinline__ void stage_load(Stage& S, const bf16* Kp, const bf16* Vp, size_t ld, int row0, int maxrow, int sr, int sc) {
    const int ra = min(row0 + sr, maxrow), rb = min(row0 + 32 + sr, maxrow);
    S.k0 = *(const bf16x8*)(Kp + (size_t)ra * ld + sc); S.k1 = *(const bf16x8*)(Kp + (size_t)rb * ld + sc);
    S.v0 = *(const bf16x8*)(Vp + (size_t)ra * ld + sc); S.v1 = *(const bf16x8*)(Vp + (size_t)rb * ld + sc);
}
__device__ __forceinline__ void stage_write(const Stage& S, LAS char* Kb, LAS char* Vb, int kws, int vst0, int vst1) {
    *(LAS bf16x8*)(Kb + kws) = S.k0; *(LAS bf16x8*)(Kb + kws + 32 * 256) = S.k1;
    *(LAS bf16x8*)(Vb + vst0) = S.v0; *(LAS bf16x8*)(Vb + vst1) = S.v1;
}
}

struct NsaLane { int wid, lane, r32, hi, ql, j, sr, sc, kws, vst0, vst1, vrd; };
__device__ __forceinline__ NsaLane nsa_lane(const Frame& F) {
    NsaLane L; L.wid = F.wave; L.lane = F.lane; L.r32 = F.lane & 31; L.hi = F.lane >> 5; L.ql = L.r32 >> 2; L.j = L.r32 & 3;
    L.sr = F.tid >> 4; L.sc = (F.tid & 15) * 8; L.kws = FA_KSWZ(L.sr, L.sc * 2); L.vst0 = fa::v_st(L.sr, L.sc); L.vst1 = fa::v_st(32 + L.sr, L.sc); L.vrd = fa::v_rd_base(F.lane);
    return L;
}
__device__ __forceinline__ void nsa_load_q(bf16x8 (&qr)[8], const bf16* P0, int tok0, int g, const NsaLane& L) {
    const bf16* qp = P0 + (size_t)(tok0 + L.wid * 8 + L.ql) * P0LD + (g * 4 + L.j) * 128 + L.hi * 8;
#pragma unroll
    for (int d0 = 0; d0 < 8; ++d0) qr[d0] = *(const bf16x8*)(qp + d0 * 16);
}
__device__ __forceinline__ void nsa_lut(Frame& F, const Args& A) {
    LAS float* lut = (LAS float*)(F.lds + RING_OFF + fa::OFF_LUT);
    for (int i = F.tid; i < 144 * 16; i += 512) { const int n = i >> 4, h = i & 15; lut[h * 144 + n] = A.in[1][rel_bucket(n) * 16 + h]; }
    __syncthreads();
}
template <int MODE>
__device__ __forceinline__ void nsa_store(const fa::f32x16 (&o)[4], float l_reg, LAS float* li_l, const float* GL, bf16* OACC, bf16* OATT, int tok0, int g, int br, const NsaLane& L) {
    if (L.hi == 0) li_l[L.r32] = l_reg;
    asm volatile("s_waitcnt lgkmcnt(0)" ::: "memory");
    float sc[16];
#pragma unroll
    for (int r = 0; r < 16; ++r) { const int row = fa::crow(r, L.hi), tok = tok0 + L.wid * 8 + (row >> 2), h = g * 4 + (row & 3); sc[r] = GL[(size_t)tok * 48 + h * 3 + br]; }
    unsigned prev[4][16];
    if (MODE != 0) {
#pragma unroll
        for (int r = 0; r < 16; ++r) { const int row = fa::crow(r, L.hi), tok = tok0 + L.wid * 8 + (row >> 2), h = g * 4 + (row & 3); const bf16* ap = OACC + (size_t)tok * DM + h * 128 + (L.r32 & ~1);
#pragma unroll
            for (int d0 = 0; d0 < 4; ++d0) prev[d0][r] = *(const unsigned*)(ap + d0 * 32); } }
#pragma unroll
    for (int r = 0; r < 16; ++r) { const int row = fa::crow(r, L.hi), tok = tok0 + L.wid * 8 + (row >> 2), h = g * 4 + (row & 3);
        const float l = li_l[row]; const float gl = sc[r];
        const float scl = (l > 0.f) ? __builtin_amdgcn_rcpf(l) / (1.0f + __expf(-gl)) : 0.f;
        bf16* dst = ((MODE == 2) ? OATT : OACC) + (size_t)tok * DM + h * 128 + L.r32;
#pragma unroll
        for (int d0 = 0; d0 < 4; ++d0) { float v = o[d0][r] * scl;
            if (MODE != 0) v += (L.r32 & 1) ? bfhi(prev[d0][r]) : bflo(prev[d0][r]);
            const float vn = dpp_xor1(v); if ((L.r32 & 1) == 0) *(unsigned*)(dst + d0 * 32) = fa::cvtpk(v, vn); } }
    asm volatile("s_waitcnt lgkmcnt(0)" ::: "memory");
}

__device__ __forceinline__ void nsa_scales(float (&scl)[16], float l_reg, LAS float* li_l, const float* GL, int tok0, int g, int br, const NsaLane& L) {
    if (L.hi == 0) li_l[L.r32] = l_reg;
    asm volatile("s_waitcnt lgkmcnt(0)" ::: "memory");
    float sc[16];
#pragma unroll
    for (int r = 0; r < 16; ++r) { const int row = fa::crow(r, L.hi), tok = tok0 + L.wid * 8 + (row >> 2), h = g * 4 + (row & 3); sc[r] = GL[(size_t)tok * 48 + h * 3 + br]; }
#pragma unroll
    for (int r = 0; r < 16; ++r) { const float l = li_l[fa::crow(r, L.hi)]; scl[r] = (l > 0.f) ? __builtin_amdgcn_rcpf(l) / (1.0f + __expf(-sc[r])) : 0.f; }
    asm volatile("s_waitcnt lgkmcnt(0)" ::: "memory");
}
__device__ __forceinline__ void p3a_nsa_cmp(Frame& F, const Args& A) {
    unsigned char* ws = A.ws; const NsaLane L = nsa_lane(F);
    const bf16* P0 = (const bf16*)(ws + WS_P0); const bf16* KCB = (const bf16*)(ws + WS_KCMP); const bf16* VCB = (const bf16*)(ws + WS_VCMP);
    const float* GL = (const float*)(ws + WS_GL); bf16* OACC = (bf16*)(ws + WS_Z + 64 * MiB); unsigned* SELM = (unsigned*)(ws + WS_SELM);
    nsa_lut(F, A);
    LAS char* lds = (LAS char*)(F.lds + RING_OFF);
    LAS float* wsf = (LAS float*)(lds + fa::OFF_WS) + L.wid * 64; LAS float* li_l = wsf; LAS float* al_l = wsf + 32;
    const LAS float* lut = (const LAS float*)(lds + fa::OFF_LUT);
    LAS float* tab = (LAS float*)(lds + fa::OFF_TAB);
    for (int ui = 0; ui < 2 * ((512 - F.vcu + F.G - 1) / F.G); ++ui) {
        const int p = F.vcu + (ui >> 1) * F.G, bg = p >> 6, y = p & 63, qb = (ui & 1) ? 127 - y : y, b = bg >> 2, g = bg & 3;
        const int tok0 = b * SEQ + qb * 64;
        bf16x8 qr[8]; nsa_load_q(qr, P0, tok0, g, L);
        const int trow = qb * 64 + L.wid * 8 + L.ql;
        const int h = g * 4 + L.j; const LAS float* lutcol = lut + h * 144; const float bias_far = lutcol[128];
        const int nmaxrow = (trow >= 31) ? (trow - 31) >> 4 : -1;
        const int NT = (4 * qb + 3 + 63) >> 6;
        const bf16* Kg = KCB + (size_t)(b * 4 + g) * 512 * 128; const bf16* Vg = VCB + (size_t)(b * 4 + g) * 512 * 128;
        for (int i = F.tid; i < 64 * fa::TABLD; i += 512) tab[i] = 0.f;
        float m_reg = -1e30f, l_reg = 0.f;
        fa::Stage S;
        const int rem16 = (trow >= 31) ? ((trow - 31) & 15) : 0;
        fa::stage_load(S, Kg, Vg, 128, 0, 511, L.sr, L.sc); asm volatile("s_waitcnt vmcnt(0)" ::: "memory");
        fa::stage_write(S, lds + fa::OFF_K, lds + fa::OFF_V, L.kws, L.vst0, L.vst1);
        __syncthreads();
#pragma unroll 1
        for (int t = 0; t < NT; ++t) {
            const int buf = t & 1;
            fa::stage_load(S, Kg, Vg, 128, (t + 1 < NT) ? (t + 1) * 64 : 0, 511, L.sr, L.sc);
            fa::f32x16 p0, p1;
            const bool farT = (qb * 64 + L.wid * 8) - 31 - 16 * (t * 64 + 63) >= 128;
            fa::qkt(p0, p1, lds + fa::OFF_K + buf * fa::SHM_K, L.r32, L.hi, qr, farT ? bias_far : 0.f);
            const int dq = nmaxrow - t * 64 - 4 * L.hi;
            if (!farT) fa::bias_near(p0, p1, dq, 16, lutcol + rem16);
            fa::mask_tile(p0, p1, dq, 0x40000000u);
            float alpha; fa::partialSM(p0, p1, m_reg, alpha);
            float ps = 0.f;
#pragma unroll
            for (int r = 0; r < 16; ++r) ps += p0[r] + p1[r];
            { auto rr = __builtin_amdgcn_permlane32_swap(__float_as_uint(ps), __float_as_uint(ps), false, false); ps = __uint_as_float(rr[0]) + __uint_as_float(rr[1]); }
            l_reg = l_reg * alpha + ps;
            if (t + 1 < NT) { asm volatile("s_waitcnt vmcnt(0)" ::: "memory"); fa::stage_write(S, lds + fa::OFF_K + (buf ^ 1) * fa::SHM_K, lds + fa::OFF_V + (buf ^ 1) * fa::SHM_V, L.kws, L.vst0, L.vst1); }
            __syncthreads();
        }
        fa::f32x16 o[4];
#pragma unroll
        for (int d = 0; d < 4; ++d)
#pragma unroll
            for (int r = 0; r < 16; ++r) o[d][r] = 0.f;
        asm volatile("s_waitcnt vmcnt(0)" ::: "memory");
        fa::stage_write(S, lds + fa::OFF_K, lds + fa::OFF_V, L.kws, L.vst0, L.vst1);
        __syncthreads();
        const float inv_l = (l_reg > 0.f) ? 1.0f / l_reg : 0.f; const float mnL = -m_reg * fa::C2;
#pragma unroll 1
        for (int t = 0; t < NT; ++t) {
            const int buf = t & 1;
            if (t + 1 < NT) fa::stage_load(S, Kg, Vg, 128, (t + 1) * 64, 511, L.sr, L.sc);
            fa::f32x16 p0, p1;
            const bool farT = (qb * 64 + L.wid * 8) - 31 - 16 * (t * 64 + 63) >= 128;
            fa::qkt(p0, p1, lds + fa::OFF_K + buf * fa::SHM_K, L.r32, L.hi, qr, farT ? bias_far : 0.f);
            const int dq = nmaxrow - t * 64 - 4 * L.hi;
            if (!farT) fa::bias_near(p0, p1, dq, 16, lutcol + rem16);
            fa::mask_tile(p0, p1, dq, 0x40000000u);
#pragma unroll
            for (int r = 0; r < 16; ++r) { p0[r] = __builtin_amdgcn_exp2f(fmaf(p0[r], fa::C2, mnL)) * inv_l; p1[r] = __builtin_amdgcn_exp2f(fmaf(p1[r], fa::C2, mnL)) * inv_l; }
            LAS float* tb = tab + (L.wid * 8 + L.ql) * fa::TABLD + t * 16 + L.hi;
#pragma unroll
            for (int half = 0; half < 2; ++half)
#pragma unroll
                for (int gq = 0; gq < 4; ++gq) { const fa::f32x16& pp = half ? p1 : p0;
                    float s4 = pp[4 * gq] + pp[4 * gq + 1] + pp[4 * gq + 2] + 0.5f * pp[4 * gq + 3], cr = 0.5f * pp[4 * gq + 3];
                    s4 += dpp_xor1(s4); s4 += dpp_xor2(s4); cr += dpp_xor1(cr); cr += dpp_xor2(cr);
                    if (L.j == 0) { __hip_atomic_fetch_add(tb + half * 8 + 2 * gq, s4, __ATOMIC_RELAXED, __HIP_MEMORY_SCOPE_WORKGROUP); __hip_atomic_fetch_add(tb + half * 8 + 2 * gq + 1, cr, __ATOMIC_RELAXED, __HIP_MEMORY_SCOPE_WORKGROUP); } }
            bf16x8 a0, a1, a2, a3; (void)fa::finishSM(p0, p1, a0, a1, a2, a3);
            fa::pv_tile(o, (int)(uintptr_t)(lds + fa::OFF_V + buf * fa::SHM_V) + L.vrd, a0, a1, a2, a3);
            if (t + 1 < NT) { asm volatile("s_waitcnt vmcnt(0)" ::: "memory"); fa::stage_write(S, lds + fa::OFF_K + (buf ^ 1) * fa::SHM_K, lds + fa::OFF_V + (buf ^ 1) * fa::SHM_V, L.kws, L.vst0, L.vst1); }
            __syncthreads();
        }
        const bf16* Kw = P0 + (size_t)b * SEQ * P0LD + COL_KW + g * 128; const bf16* Vw = P0 + (size_t)b * SEQ * P0LD + COL_VW + g * 128;
        const int t0 = max(0, qb - 8), NTW = qb - t0 + 1;
        fa::stage_load(S, Kw, Vw, P0LD, t0 * 64, SEQ - 1, L.sr, L.sc);
        unsigned tot[4][8];
        { float scl[16]; nsa_scales(scl, (l_reg > 0.f) ? 1.0f : 0.f, li_l, GL, tok0, g, 0, L);
#pragma unroll
          for (int d0 = 0; d0 < 4; ++d0)
#pragma unroll
              for (int r2 = 0; r2 < 8; ++r2) tot[d0][r2] = fa::cvtpk(o[d0][2 * r2] * scl[2 * r2], o[d0][2 * r2 + 1] * scl[2 * r2 + 1]); }
        __syncthreads();
        {
            bool s0[8], s1[8];
            if (qb < 16) {
#pragma unroll
                for (int qi = 0; qi < 8; ++qi) { s0[qi] = (L.lane <= qb); s1[qi] = false; }
            } else {
                unsigned k0[8], k1[8], lo[8];
#pragma unroll
                for (int qi = 0; qi < 8; ++qi) { const int ql = L.wid * 8 + qi;
                    const bool c0 = (L.lane >= 1 && L.lane <= qb - 2), c1 = (L.lane + 64 <= qb - 2);
                    k0[qi] = c0 ? __float_as_uint(tab[ql * fa::TABLD + L.lane]) + 1u : 0u; k1[qi] = c1 ? __float_as_uint(tab[ql * fa::TABLD + L.lane + 64]) + 1u : 0u;
                    s0[qi] = (L.lane == 0) || (L.lane == qb) || (L.lane == qb - 1); s1[qi] = (L.lane + 64 == qb) || (L.lane + 64 == qb - 1); lo[qi] = 0u; }
#pragma unroll 1
                for (int bit = 30; bit >= 0; --bit) {
#pragma unroll
                    for (int qi = 0; qi < 8; ++qi) { const unsigned cand = lo[qi] | (1u << bit);
                        const int cnt = __popcll(__ballot(k0[qi] >= cand)) + __popcll(__ballot(k1[qi] >= cand));
                        lo[qi] = (cnt >= 13) ? cand : lo[qi]; } }
#pragma unroll
                for (int qi = 0; qi < 8; ++qi) { const unsigned T = lo[qi];
                    const bool g0 = k0[qi] > T, g1 = k1[qi] > T, e0 = k0[qi] == T, e1 = k1[qi] == T;
                    const int need = 13 - (__popcll(__ballot(g0)) + __popcll(__ballot(g1)));
                    const unsigned long long be0 = __ballot(e0), be1 = __ballot(e1);
                    const int r0 = (int)__builtin_amdgcn_mbcnt_hi((unsigned)(be0 >> 32), __builtin_amdgcn_mbcnt_lo((unsigned)be0, 0u));
                    const int r1 = __popcll(be0) + (int)__builtin_amdgcn_mbcnt_hi((unsigned)(be1 >> 32), __builtin_amdgcn_mbcnt_lo((unsigned)be1, 0u));
                    s0[qi] = s0[qi] || g0 || (e0 && r0 < need); s1[qi] = s1[qi] || g1 || (e1 && r1 < need); }
            }
#pragma unroll
            for (int qi = 0; qi < 8; ++qi) { const int ql = L.wid * 8 + qi; const unsigned long long b0 = __ballot(s0[qi]), b1 = __ballot(s1[qi]);
                if (L.lane == 0) { uint4 mv; mv.x = (unsigned)b0; mv.y = (unsigned)(b0 >> 32); mv.z = (unsigned)b1; mv.w = (unsigned)(b1 >> 32); *(uint4*)(SELM + ((size_t)(tok0 + ql) * 4 + g) * 4) = mv; } }
        }
        __syncthreads();
        LAS char* const totb[4] = {lds + fa::OFF_TAB + F.tid * 32, lds + fa::OFF_TAB + 16384 + F.tid * 32, lds + fa::OFF_TAB + 64 * fa::TABLD * 4 + F.tid * 32, (LAS char*)(F.lds + DSA_SCR) + F.tid * 32};
#pragma unroll
        for (int d0 = 0; d0 < 4; ++d0) { v4u ta, tb; ta.x = tot[d0][0]; ta.y = tot[d0][1]; ta.z = tot[d0][2]; ta.w = tot[d0][3]; tb.x = tot[d0][4]; tb.y = tot[d0][5]; tb.z = tot[d0][6]; tb.w = tot[d0][7];
            *(LAS v4u*)(totb[d0]) = ta; *(LAS v4u*)(totb[d0] + 16) = tb; }
        {
            m_reg = -1e30f; l_reg = 0.f;
#pragma unroll
            for (int d = 0; d < 4; ++d)
#pragma unroll
                for (int r = 0; r < 16; ++r) o[d][r] = 0.f;
            asm volatile("s_waitcnt vmcnt(0)" ::: "memory");
            fa::stage_write(S, lds + fa::OFF_K, lds + fa::OFF_V, L.kws, L.vst0, L.vst1);
            __syncthreads();
#pragma unroll 1
            for (int tt = 0; tt < NTW; ++tt) {
                const int buf = tt & 1, t = t0 + tt;
                if (tt + 1 < NTW) fa::stage_load(S, Kw, Vw, P0LD, (t + 1) * 64, SEQ - 1, L.sr, L.sc);
                fa::f32x16 p0, p1;
                const bool farT = (qb * 64 + L.wid * 8) - (t * 64 + 63) >= 128;
                fa::qkt(p0, p1, lds + fa::OFF_K + buf * fa::SHM_K, L.r32, L.hi, qr, farT ? bias_far : 0.f);
                const int dq = trow - t * 64 - 4 * L.hi;
                if (!farT) fa::bias_near(p0, p1, dq, 1, lutcol);
                if (t == qb || t == t0) fa::mask_tile(p0, p1, dq, 512u);
                float alpha; fa::partialSM(p0, p1, m_reg, alpha);
                fa::rescale(o, alpha, al_l, L.r32, L.hi);
                bf16x8 a0, a1, a2, a3; const float ps = fa::finishSM(p0, p1, a0, a1, a2, a3); l_reg = l_reg * alpha + ps;
                fa::pv_tile(o, (int)(uintptr_t)(lds + fa::OFF_V + buf * fa::SHM_V) + L.vrd, a0, a1, a2, a3);
                if (tt + 1 < NTW) { asm volatile("s_waitcnt vmcnt(0)" ::: "memory"); fa::stage_write(S, lds + fa::OFF_K + (buf ^ 1) * fa::SHM_K, lds + fa::OFF_V + (buf ^ 1) * fa::SHM_V, L.kws, L.vst0, L.vst1); }
                __syncthreads();
            }
            float scl[16]; nsa_scales(scl, l_reg, li_l, GL, tok0, g, 2, L);
#pragma unroll
            for (int d0 = 0; d0 < 4; ++d0) { const v4u ta = *(const LAS v4u*)(totb[d0]), tb = *(const LAS v4u*)(totb[d0] + 16); const unsigned tt8[8] = {ta.x, ta.y, ta.z, ta.w, tb.x, tb.y, tb.z, tb.w};
#pragma unroll
                for (int r = 0; r < 16; ++r) { const int row = fa::crow(r, L.hi), tok = tok0 + L.wid * 8 + (row >> 2), h = g * 4 + (row & 3);
                    bf16* dst = OACC + (size_t)tok * DM + h * 128 + L.r32;
                    const float v = o[d0][r] * scl[r] + ((r & 1) ? bfhi(tt8[r >> 1]) : bflo(tt8[r >> 1]));
                    const float vn = dpp_xor1(v); if ((L.r32 & 1) == 0) *(unsigned*)(dst + d0 * 32) = fa::cvtpk(v, vn); } }
            asm volatile("s_waitcnt lgkmcnt(0)" ::: "memory");
        }
        __syncthreads();
    }
}
constexpr int N3_OFF_V = 0, N3_OFF_K = 3 * fa::SHM_V, N3_OFF_WS = 3 * fa::SHM_V + 3 * fa::SHM_K, N3_OFF_LUT = N3_OFF_WS + 8 * 256;
__device__ __forceinline__ void nsa_lut3(Frame& F, const Args& A) {
    LAS float* lut = (LAS float*)(F.lds + RING_OFF + N3_OFF_LUT);
    for (int i = F.tid; i < 144 * 16; i += 512) { const int n = i >> 4, h = i & 15; lut[h * 144 + n] = A.in[1][rel_bucket(n) * 16 + h]; }
    __syncthreads();
}
__device__ __forceinline__ void p3b_nsa_sel(Frame& F, const Args& A) {
    unsigned char* ws = A.ws; const NsaLane L = nsa_lane(F);
    const bf16* P0 = (const bf16*)(ws + WS_P0); const float* GL = (const float*)(ws + WS_GL); bf16* OACC = (bf16*)(ws + WS_Z + 64 * MiB); const unsigned* SELM = (const unsigned*)(ws + WS_SELM);
    nsa_lut3(F, A);
    LAS char* lds = (LAS char*)(F.lds + RING_OFF);
    LAS float* wsf = (LAS float*)(lds + N3_OFF_WS) + L.wid * 64; LAS float* li_l = wsf; LAS float* al_l = wsf + 32;
    const LAS float* lut = (const LAS float*)(lds + N3_OFF_LUT);
    const bool grpB = L.wid >= 4;
    for (int ui = 0; ui < 2 * ((512 - F.vcu + F.G - 1) / F.G); ++ui) {
        const int p = F.vcu + (ui >> 1) * F.G, bg = p >> 6, y = p & 63, qb = (ui & 1) ? 127 - y : y, b = bg >> 2, g = bg & 3;
        const int tok0 = b * SEQ + qb * 64;
        bf16x8 qr[8]; nsa_load_q(qr, P0, tok0, g, L);
        const int trow = qb * 64 + L.wid * 8 + L.ql;
        const int h = g * 4 + L.j; const LAS float* lutcol = lut + h * 144; const float bias_far = lutcol[128];
        const uint4 mv = *(const uint4*)(SELM + ((size_t)(tok0 + L.wid * 8 + L.ql) * 4 + g) * 4);
        const bf16* Kg = P0 + (size_t)b * SEQ * P0LD + COL_KS + g * 128; const bf16* Vg = P0 + (size_t)b * SEQ * P0LD + COL_VS + g * 128;
        const int NT = qb + 1;
        float m_reg = -1e30f, l_reg = 0.f; fa::f32x16 o[4];
#pragma unroll
        for (int d = 0; d < 4; ++d)
#pragma unroll
            for (int r = 0; r < 16; ++r) o[d][r] = 0.f;
        fa::Stage Sa;
        fa::stage_load(Sa, Kg, Vg, P0LD, 0, SEQ - 1, L.sr, L.sc); asm volatile("s_waitcnt vmcnt(0)" ::: "memory");
        asm volatile("" : "+v"(qr[0]), "+v"(qr[1]), "+v"(qr[2]), "+v"(qr[3]), "+v"(qr[4]), "+v"(qr[5]), "+v"(qr[6]), "+v"(qr[7]));
        unsigned mvx = mv.x, mvy = mv.y, mvz = mv.z, mvw = mv.w; asm volatile("" : "+v"(mvx), "+v"(mvy), "+v"(mvz), "+v"(mvw));
        fa::stage_write(Sa, lds + N3_OFF_K, lds + N3_OFF_V, L.kws, L.vst0, L.vst1);
        __syncthreads();
        bf16x8 a0 = {0, 0, 0, 0, 0, 0, 0, 0}, a1 = a0, a2 = a0, a3 = a0; bool actp = false;
        int bcur = 0, bprev = 2;
#define P3B_STEP(t, SNEXT2, SNEXT1) do { \
            const int bnext = (bcur == 2) ? 0 : bcur + 1; \
            if ((t) + 1 < NT) fa::stage_load(SNEXT1, Kg, Vg, P0LD, ((t) + 1) * 64, SEQ - 1, L.sr, L.sc); \
            FA_SBAR();     \
            const unsigned word = ((t) < 32) ? mvx : ((t) < 64) ? mvy : ((t) < 96) ? mvz : mvw; \
            const bool mine = ((word >> ((t) & 31)) & 1u) != 0u; \
            const bool act = __any(mine); \
            if (grpB && actp) fa::pv_tile(o, (int)(uintptr_t)(lds + N3_OFF_V + bprev * fa::SHM_V) + L.vrd, a0, a1, a2, a3); \
            if (act) { \
                fa::f32x16 p0, p1; \
                const bool farT = (qb * 64 + L.wid * 8) - ((t) * 64 + 63) >= 128; \
                fa::qkt(p0, p1, lds + N3_OFF_K + bcur * fa::SHM_K, L.r32, L.hi, qr, mine ? (farT ? bias_far : 0.f) : -__builtin_inff()); \
                const int dq = trow - (t) * 64 - 4 * L.hi; \
                if (!farT) fa::bias_near(p0, p1, dq, 1, lutcol); \
                if ((t) == qb) fa::mask_tile(p0, p1, dq, 0x40000000u); \
                float alpha; fa::partialSM(p0, p1, m_reg, alpha); \
                fa::rescale(o, alpha, al_l, L.r32, L.hi); \
                const float ps = fa::finishSM(p0, p1, a0, a1, a2, a3); l_reg = l_reg * alpha + ps; \
                if (!grpB) fa::pv_tile(o, (int)(uintptr_t)(lds + N3_OFF_V + bcur * fa::SHM_V) + L.vrd, a0, a1, a2, a3); \
            } \
            actp = act; \
            if ((t) + 1 < NT) { asm volatile("s_waitcnt vmcnt(0)" ::: "memory"); fa::stage_write(SNEXT1, lds + N3_OFF_K + bnext * fa::SHM_K, lds + N3_OFF_V + bnext * fa::SHM_V, L.kws, L.vst0, L.vst1); } \
            __syncthreads(); \
            bprev = bcur; bcur = bnext; } while (0)
#pragma unroll 1
        for (int t = 0; t < NT; t += 2) {
            P3B_STEP(t, Sa, Sa);
            if (t + 1 < NT) P3B_STEP(t + 1, Sa, Sa);
        }
#undef P3B_STEP
        if (grpB && actp) fa::pv_tile(o, (int)(uintptr_t)(lds + N3_OFF_V + bprev * fa::SHM_V) + L.vrd, a0, a1, a2, a3);
        int tokz = tok0; asm volatile("" : "+s"(tokz));
        nsa_store<2>(o, l_reg, li_l, GL, OACC, (bf16*)(ws + WS_OATT0), tokz, g, 1, L);
        __syncthreads();
    }
}
__device__ __forceinline__ void p3c_nsa_win(Frame& F, const Args& A) {
    unsigned char* ws = A.ws; const NsaLane L = nsa_lane(F);
    const bf16* P0 = (const bf16*)(ws + WS_P0); const float* GL = (const float*)(ws + WS_GL); bf16* OACC = (bf16*)(ws + WS_Z + 64 * MiB); bf16* OATT = (bf16*)(ws + WS_OATT0);
    nsa_lut(F, A);
    LAS char* lds = (LAS char*)(F.lds + RING_OFF);
    LAS float* wsf = (LAS float*)(lds + fa::OFF_WS) + L.wid * 64; LAS float* li_l = wsf; LAS float* al_l = wsf + 32;
    const LAS float* lut = (const LAS float*)(lds + fa::OFF_LUT);
    for (int ui = 0; ui < 2 * ((512 - F.vcu + F.G - 1) / F.G); ++ui) {
        const int p = F.vcu + (ui >> 1) * F.G, bg = p >> 6, y = p & 63, qb = (ui & 1) ? 127 - y : y, b = bg >> 2, g = bg & 3;
        const int tok0 = b * SEQ + qb * 64;
        bf16x8 qr[8]; nsa_load_q(qr, P0, tok0, g, L);
        const int trow = qb * 64 + L.wid * 8 + L.ql;
        const int h = g * 4 + L.j; const LAS float* lutcol = lut + h * 144; const float bias_far = lutcol[128];
        const bf16* Kg = P0 + (size_t)b * SEQ * P0LD + COL_KW + g * 128; const bf16* Vg = P0 + (size_t)b * SEQ * P0LD + COL_VW + g * 128;
        const int t0 = max(0, qb - 8), NT = qb - t0 + 1;
        float m_reg = -1e30f, l_reg = 0.f; fa::f32x16 o[4];
#pragma unroll
        for (int d = 0; d < 4; ++d)
#pragma unroll
            for (int r = 0; r < 16; ++r) o[d][r] = 0.f;
        fa::Stage S;
        fa::stage_load(S, Kg, Vg, P0LD, t0 * 64, SEQ - 1, L.sr, L.sc); asm volatile("s_waitcnt vmcnt(0)" ::: "memory");
        fa::stage_write(S, lds + fa::OFF_K, lds + fa::OFF_V, L.kws, L.vst0, L.vst1);
        __syncthreads();
#pragma unroll 1
        for (int tt = 0; tt < NT; ++tt) {
            const int buf = tt & 1, t = t0 + tt;
            if (tt + 1 < NT) fa::stage_load(S, Kg, Vg, P0LD, (t + 1) * 64, SEQ - 1, L.sr, L.sc);
            fa::f32x16 p0, p1;
            const bool farT = (qb * 64 + L.wid * 8) - (t * 64 + 63) >= 128;
            fa::qkt(p0, p1, lds + fa::OFF_K + buf * fa::SHM_K, L.r32, L.hi, qr, farT ? bias_far : 0.f);
            const int dq = trow - t * 64 - 4 * L.hi;
            if (!farT) fa::bias_near(p0, p1, dq, 1, lutcol);
            if (t == qb || t == t0) fa::mask_tile(p0, p1, dq, 512u);
            float alpha; fa::partialSM(p0, p1, m_reg, alpha);
            fa::rescale(o, alpha, al_l, L.r32, L.hi);
            bf16x8 a0, a1, a2, a3; const float ps = fa::finishSM(p0, p1, a0, a1, a2, a3); l_reg = l_reg * alpha + ps;
            fa::pv_tile(o, (int)(uintptr_t)(lds + fa::OFF_V + buf * fa::SHM_V) + L.vrd, a0, a1, a2, a3);
            if (tt + 1 < NT) { asm volatile("s_waitcnt vmcnt(0)" ::: "memory"); fa::stage_write(S, lds + fa::OFF_K + (buf ^ 1) * fa::SHM_K, lds + fa::OFF_V + (buf ^ 1) * fa::SHM_V, L.kws, L.vst0, L.vst1); }
            __syncthreads();
        }
        nsa_store<2>(o, l_reg, li_l, GL, OACC, OATT, tok0, g, 2, L);
        __syncthreads();
    }
}

template <bool ROUTE, bool F8 = false>
__device__ __forceinline__ void ln_phase(Frame& F, const Args& A, const bf16* Z, const float* gam, const float* bet, bf16* XH, unsigned char* X8) {
    const int gw = F.vcu * NWAVES + F.wave, NGW = F.G * NWAVES, lane = F.lane;
    LAS float* wrl = (LAS float*)(F.lds + RING_OFF);
    if (ROUTE) { for (int i = F.tid; i < DM * 8 / 4; i += 512) *(LAS f32x4*)(wrl + i * 4) = *(const f32x4*)(A.in[18] + i * 4); }
    LAS float* gml = (LAS float*)(F.lds + DSA_SCR); LAS float* btl = gml + DM;
    { const int i = F.tid; *(LAS f32x4*)(gml + i * 4) = *(const f32x4*)(gam + i * 4); *(LAS f32x4*)(btl + i * 4) = *(const f32x4*)(bet + i * 4); }
    __syncthreads();
    uint2 zn[8];
    if (gw < NTOK) { const uint2* zr = (const uint2*)(Z + (size_t)gw * DM) + lane;
#pragma unroll
        for (int j = 0; j < 8; ++j) zn[j] = zr[64 * j]; }
    for (int row = gw; row < NTOK; row += NGW) {
        f32x4 v[8]; float s = 0.f;
#pragma unroll
        for (int j = 0; j < 8; ++j) { const uint2 z2 = zn[j]; v[j] = (f32x4){bflo(z2.x), bfhi(z2.x), bflo(z2.y), bfhi(z2.y)}; s += (v[j][0] + v[j][1]) + (v[j][2] + v[j][3]); }
        if (row + NGW < NTOK) { const uint2* zr = (const uint2*)(Z + (size_t)(row + NGW) * DM) + lane;
#pragma unroll
            for (int j = 0; j < 8; ++j) zn[j] = zr[64 * j]; }
        __builtin_amdgcn_sched_barrier(0);
        const float mean = wave_sum(s) * (1.f / DM); float s2 = 0.f;
#pragma unroll
        for (int j = 0; j < 8; ++j) { v[j] = v[j] - mean; s2 += (v[j][0] * v[j][0] + v[j][1] * v[j][1]) + (v[j][2] * v[j][2] + v[j][3] * v[j][3]); }
        const float rstd = 1.f / sqrtf(wave_sum(s2) * (1.f / DM) + LN_EPS);
        float lg[8];
#pragma unroll
        for (int e = 0; e < 8; ++e) lg[e] = 0.f;
#pragma unroll
        for (int j = 0; j < 8; ++j) { const int c = 4 * lane + 256 * j; const f32x4 gg = *(const LAS f32x4*)(gml + c), bb = *(const LAS f32x4*)(btl + c);
            const f32x4 x = v[j] * rstd * gg + bb;
            { uint2 o; o.x = pk2(x[0], x[1]); o.y = pk2(x[2], x[3]); *(uint2*)(XH + (size_t)row * DM + c) = o; }
            if (F8) { int w = __builtin_amdgcn_cvt_pk_fp8_f32(x[0], x[1], 0, false); w = __builtin_amdgcn_cvt_pk_fp8_f32(x[2], x[3], w, true); *(int*)(X8 + (size_t)row * DM + c) = w; }
            asm volatile("" ::: "memory");
            if (ROUTE) { const LAS float* wr = wrl + c * 8;
#pragma unroll
                for (int q = 0; q < 4; ++q) { const f32x4 w0 = *(const LAS f32x4*)(wr + q * 8), w1 = *(const LAS f32x4*)(wr + q * 8 + 4);
                    lg[0] += x[q] * w0[0]; lg[1] += x[q] * w0[1]; lg[2] += x[q] * w0[2]; lg[3] += x[q] * w0[3]; lg[4] += x[q] * w1[0]; lg[5] += x[q] * w1[1]; lg[6] += x[q] * w1[2]; lg[7] += x[q] * w1[3]; }  asm volatile("" ::: "memory"); }
        }
        if (ROUTE) {
#pragma unroll
            for (int e = 0; e < 8; ++e) lg[e] = wave_sum(lg[e]) + A.in[19][e];
            int e0 = 0; float l0 = lg[0];
#pragma unroll
            for (int e = 1; e < 8; ++e) if (lg[e] > l0) { l0 = lg[e]; e0 = e; }
            int e1 = -1; float l1 = -3e38f;
#pragma unroll
            for (int e = 0; e < 8; ++e) if (e != e0 && lg[e] > l1) { l1 = lg[e]; e1 = e; }
            const float w0 = 1.0f / (1.0f + __expf(l1 - l0)), w1 = 1.0f - w0;
            if (lane == 0) {
                const unsigned p0 = __hip_atomic_fetch_add((unsigned*)(F.ctl + CW_MOECNT + 64 * e0), 1u, __ATOMIC_RELAXED, __HIP_MEMORY_SCOPE_AGENT);
                const unsigned p1 = __hip_atomic_fetch_add((unsigned*)(F.ctl + CW_MOECNT + 64 * e1), 1u, __ATOMIC_RELAXED, __HIP_MEMORY_SCOPE_AGENT);
                int* re = (int*)(A.ws + WS_ROUTE); int* rp = re + 2 * NTOK; float* rw = (float*)(rp + 2 * NTOK);
                re[2 * row] = e0; re[2 * row + 1] = e1; rp[2 * row] = (int)p0; rp[2 * row + 1] = (int)p1; rw[2 * row] = w0; rw[2 * row + 1] = w1;
            }
        }
    }
}

__device__ __forceinline__ void ln_route_phase(Frame& F, const Args& A, const bf16* Z, const float* gam, const float* bet, bf16* XH) {
    const int gw = F.vcu * NWAVES + F.wave, NGW = F.G * NWAVES, lane = F.lane;
    LAS float* wrl = (LAS float*)(F.lds + RING_OFF);
    LAS float* rowb = (LAS float*)(F.lds + RING_OFF + 65536 + F.wave * 8192);
    LAS float* gml = (LAS float*)(F.lds + DSA_SCR); LAS float* btl = gml + DM;
    for (int i = F.tid; i < DM * 8 / 4; i += 512) *(LAS f32x4*)(wrl + i * 4) = *(const f32x4*)(A.in[18] + i * 4);
    { const int i = F.tid; *(LAS f32x4*)(gml + i * 4) = *(const f32x4*)(gam + i * 4); *(LAS f32x4*)(btl + i * 4) = *(const f32x4*)(bet + i * 4); }
    __syncthreads();
    uint2 zn[8];
    if (gw < NTOK) {
#pragma unroll
        for (int j = 0; j < 8; ++j) zn[j] = *(const uint2*)(Z + (size_t)gw * DM + 4 * lane + 256 * j); }
    for (int row = gw; row < NTOK; row += NGW) {
        float s = 0.f, s2 = 0.f;
#pragma unroll
        for (int j = 0; j < 8; ++j) { const uint2 z2 = zn[j]; const f32x4 v = (f32x4){bflo(z2.x), bfhi(z2.x), bflo(z2.y), bfhi(z2.y)}; *(LAS f32x4*)(rowb + 4 * lane + 256 * j) = v;
            s += (v[0] + v[1]) + (v[2] + v[3]); }
        if (row + NGW < NTOK) {
#pragma unroll
            for (int j = 0; j < 8; ++j) zn[j] = *(const uint2*)(Z + (size_t)(row + NGW) * DM + 4 * lane + 256 * j); }
        __builtin_amdgcn_sched_barrier(0);
        const float mean = wave_sum(s) * (1.f / DM);
#pragma unroll 1
        for (int j = 0; j < 8; ++j) { const f32x4 v = *(const LAS f32x4*)(rowb + 4 * lane + 256 * j) - mean; s2 += (v[0] * v[0] + v[1] * v[1]) + (v[2] * v[2] + v[3] * v[3]); }
        const float rstd = 1.f / sqrtf(wave_sum(s2) * (1.f / DM) + LN_EPS);
        float lg[8];
#pragma unroll
        for (int e = 0; e < 8; ++e) lg[e] = 0.f;
#pragma unroll 1
        for (int j = 0; j < 8; ++j) { const int c = 4 * lane + 256 * j; const f32x4 gg = *(const LAS f32x4*)(gml + c), bb = *(const LAS f32x4*)(btl + c);
            const f32x4 x = (*(const LAS f32x4*)(rowb + c) - mean) * rstd * gg + bb;
            { uint2 o; o.x = pk2(x[0], x[1]); o.y = pk2(x[2], x[3]); *(uint2*)(XH + (size_t)row * DM + c) = o; }
            const LAS float* wr = wrl + c * 8;
#pragma unroll
            for (int q = 0; q < 4; ++q) { const f32x4 w0 = *(const LAS f32x4*)(wr + q * 8), w1 = *(const LAS f32x4*)(wr + q * 8 + 4);
                lg[0] += x[q] * w0[0]; lg[1] += x[q] * w0[1]; lg[2] += x[q] * w0[2]; lg[3] += x[q] * w0[3]; lg[4] += x[q] * w1[0]; lg[5] += x[q] * w1[1]; lg[6] += x[q] * w1[2]; lg[7] += x[q] * w1[3]; } }
#pragma unroll
        for (int e = 0; e < 8; ++e) lg[e] = wave_sum(lg[e]) + A.in[19][e];
        int e0 = 0; float l0 = lg[0];
#pragma unroll
        for (int e = 1; e < 8; ++e) if (lg[e] > l0) { l0 = lg[e]; e0 = e; }
        int e1 = -1; float l1 = -3e38f;
#pragma unroll
        for (int e = 0; e < 8; ++e) if (e != e0 && lg[e] > l1) { l1 = lg[e]; e1 = e; }
        const float w0 = 1.0f / (1.0f + __expf(l1 - l0)), w1 = 1.0f - w0;
        if (lane == 0) {
            const unsigned p0 = __hip_atomic_fetch_add((unsigned*)(F.ctl + CW_MOECNT + 64 * e0), 1u, __ATOMIC_RELAXED, __HIP_MEMORY_SCOPE_AGENT);
            const unsigned p1 = __hip_atomic_fetch_add((unsigned*)(F.ctl + CW_MOECNT + 64 * e1), 1u, __ATOMIC_RELAXED, __HIP_MEMORY_SCOPE_AGENT);
            int* re = (int*)(A.ws + WS_ROUTE); int* rp = re + 2 * NTOK; float* rw = (float*)(rp + 2 * NTOK);
            re[2 * row] = e0; re[2 * row + 1] = e1; rp[2 * row] = (int)p0; rp[2 * row + 1] = (int)p1; rw[2 * row] = w0; rw[2 * row + 1] = w1;
        }
        WSYNC();
    }
    __syncthreads();
}

__device__ __forceinline__ void p10_dsa_prep(Frame& F, const Args& A) {
    unsigned char* ws = A.ws; const int lane = F.lane;
    const int gw = F.vcu * NWAVES + F.wave, NGW = F.G * NWAVES;
    { const float* CR = (const float*)(ws + WS_CRAW); bf16* CN = (bf16*)(ws + WS_CN); const f32x4 gg = *(const f32x4*)(A.in[11] + 4 * lane);
      f32x4 vn = (f32x4){0.f, 0.f, 0.f, 0.f}, kn = vn;
      if (gw < NTOK) { vn = *(const f32x4*)(CR + (size_t)gw * KVR + 4 * lane); if (lane < 16) kn = *(const f32x4*)((const float*)(ws + WS_KIWI) + (size_t)gw * 128 + 4 * lane); }
      for (int row = gw; row < NTOK; row += NGW) { const f32x4 v = vn, kv = kn;
          if (row + NGW < NTOK) { vn = *(const f32x4*)(CR + (size_t)(row + NGW) * KVR + 4 * lane); if (lane < 16) kn = *(const f32x4*)((const float*)(ws + WS_KIWI) + (size_t)(row + NGW) * 128 + 4 * lane); }
          const float ss = wave_sum(v[0] * v[0] + v[1] * v[1] + v[2] * v[2] + v[3] * v[3]); const float r = 1.f / sqrtf(ss * (1.f / KVR) + RMS_EPS);
          uint2 o; o.x = pk2(v[0] * r * gg[0], v[1] * r * gg[1]); o.y = pk2(v[2] * r * gg[2], v[3] * r * gg[3]); *(uint2*)(CN + (size_t)row * KVR + 4 * lane) = o;
          if (lane < 16) { uint2 k2; k2.x = pk2(kv[0], kv[1]); k2.y = pk2(kv[2], kv[3]); *(uint2*)((bf16*)(ws + WS_KIB) + (size_t)(row >> 5) * 2048 + (lane >> 2) * 512 + ((((lane >> 1) & 1) * 32 + (row & 31)) * 8) + (lane & 1) * 4) = k2; } } }
    { pg8::Gemm g{(const bf16*)(ws + WS_Q), (const bf16*)(ws + WS_W_UK), NTOK, 4096, 256, 2, 0x7f7f7f7f, DM};
      pg8::PairOrder S; S.init(NTOK, 4096, F.G, (int)blockIdx.x); S.pn_shift = 1; S.kslice = 256;
      pg8::EpiBf16Scale E{(bf16*)(ws + WS_QLAT), 4096, 0.08838834764831845f};
      pg8::gemm_phase<pg8::EpiBf16Scale, pg8::PairOrder, true, true>(F.lds + RING_OFF, g, S, E); }
}
__device__ __forceinline__ void p12_dsa_uv(Frame& F, const Args& A) {
    unsigned char* ws = A.ws;
    pg8::Gemm g{(const bf16*)(ws + WS_OLAT), (const bf16*)(ws + WS_W_UV), NTOK, DM, 512, 2, 0x7f7f7f7f, 4096};
    pg8::PairOrder S; S.init(NTOK, DM, F.G, (int)blockIdx.x); S.pn_shift = 0; S.kslice = 512;
    pg8::EpiBf16Scale E{(bf16*)(ws + WS_OATT1), DM, 1.0f};
    pg8::gemm_phase<pg8::EpiBf16Scale, pg8::PairOrder, true, true>(F.lds + RING_OFF, g, S, E);
}
__device__ __forceinline__ unsigned f2key(float f) { const unsigned u = __float_as_uint(f); return (u & 0x80000000u) ? ~u : (u | 0x80000000u); }

__device__ __forceinline__ unsigned dsa_off_b(unsigned row, unsigned ch) { return 256u * row + 16u * (ch ^ (((row & 3) << 2) | ((row >> 2) & 3))); }

__device__ __forceinline__ float relu1(float x) { return __builtin_amdgcn_fmed3f(x, 0.f, 3.0e38f); }
__device__ __forceinline__ float max1(float a, float b) { float r; asm("v_max_f32 %0, %1, %2" : "=v"(r) : "v"(a), "v"(b)); return r; }
__device__ __forceinline__ float min1(float a, float b) { float r; asm("v_min_f32 %0, %1, %2" : "=v"(r) : "v"(a), "v"(b)); return r; }
__device__ __forceinline__ float key2f(unsigned k) { return __uint_as_float((k & 0x80000000u) ? (k & 0x7fffffffu) : ~k); }
__device__ __forceinline__ void p13a_dsa_index(Frame& F, const Args& A) {
    unsigned char* ws = A.ws; const int lane = F.lane, wid = F.wave, r32 = lane & 31, hi = lane >> 5;
    const bf16* QI = (const bf16*)(ws + WS_QI); const bf16* KIB = (const bf16*)(ws + WS_KIB); const float* KIWI = (const float*)(ws + WS_KIWI); int* IDX = (int*)(ws + WS_IDX);
    LAS float* sc = (LAS float*)(F.lds + RING_OFF);
    LAS unsigned* hist = (LAS unsigned*)(F.lds + DSA_SCR);
    LAS unsigned* qm = hist + 4096;
    LAS float* mmx = (LAS float*)(qm + 64);
    LAS unsigned* dmy = (LAS unsigned*)(mmx + 64);
    LAS unsigned* candk = dmy + 128;
    LAS unsigned* candi = candk + 1024;
    LAS unsigned* outl = candi + 1024;
    LAS unsigned* cntG = outl;
    LAS unsigned* cntE = cntG + 512;
    constexpr int CAP = 256;
    const int q = wid >> 1, sub = wid & 1, th = sub * 64 + lane;
    bf16x8 qa[4]; float wv[16];
#define P13A_TOK0(slot_) ((((slot_) >> 8) * 256 + ((((slot_) >> 8) & 1) ? 255 - ((slot_) & 255) : ((slot_) & 255))) * 4)
#define P13A_LOADQ(tk_) do { _Pragma("unroll") for (int s = 0; s < 4; ++s) qa[s] = *(const bf16x8*)(QI + (size_t)((tk_) + (r32 >> 3)) * 512 + (r32 & 7) * 64 + 16 * s + 8 * hi); \
        _Pragma("unroll") for (int r = 0; r < 16; ++r) wv[r] = KIWI[(size_t)((tk_) + (r >> 2)) * 128 + 64 + (r & 3) + 4 * hi] * 0.35355339059327373f; } while (0)
    if (F.vcu < NTOK / 4) P13A_LOADQ(P13A_TOK0(F.vcu));
    for (int slot = F.vcu; slot < NTOK / 4; slot += F.G) {
        const int tok0 = P13A_TOK0(slot), b = tok0 >> 13, t0 = tok0 & (SEQ - 1), tmax = t0 + 3;
        const int ntiles = (tmax >> 5) + 1;
#pragma unroll
        for (int z = 0; z < 8; ++z) hist[q * 1024 + z * 128 + th] = 0u;
        if (th == 0) { qm[q * 16 + 2] = 0u; qm[q * 16 + 4] = 0u; }
        float mn0 = 3e38f, mx0 = -3e38f, mn1 = 3e38f, mx1 = -3e38f;
        {
            bf16x8 ka[4], kc[4]; int tile = wid;
#define P13A_LDK(dst_, tl_) do { const bf16* kp_ = KIB + (size_t)(b * (SEQ / 32) + min((tl_), ntiles - 1)) * 2048 + (hi * 32 + r32) * 8; \
                asm volatile("global_load_dwordx4 %0, %4, off\n\tglobal_load_dwordx4 %1, %4, off offset:1024\n\tglobal_load_dwordx4 %2, %4, off offset:2048\n\tglobal_load_dwordx4 %3, %4, off offset:3072" \
                             : "=&v"(dst_[0]), "=&v"(dst_[1]), "=&v"(dst_[2]), "=&v"(dst_[3]) : "v"(kp_) : "memory"); } while (0)
#define P13A_WAIT(dst_, n_) asm volatile("s_waitcnt vmcnt(" #n_ ")" : "+v"(dst_[0]), "+v"(dst_[1]), "+v"(dst_[2]), "+v"(dst_[3]) :: "memory")
#define P13A_TILE(kk_, tl_) do { const int key_ = (tl_) * 32 + r32; fa::f32x16 acc_; \
                _Pragma("unroll") for (int r = 0; r < 16; ++r) acc_[r] = 0.f; \
                _Pragma("unroll") for (int s = 0; s < 4; ++s) acc_ = __builtin_amdgcn_mfma_f32_32x32x16_bf16(qa[s], kk_[s], acc_, 0, 0, 0); \
                float tot_[4]; \
                _Pragma("unroll") for (int qq = 0; qq < 4; ++qq) { float part = wv[4 * qq] * relu1(acc_[4 * qq]); _Pragma("unroll") for (int r3 = 1; r3 < 4; ++r3) part = fmaf(wv[4 * qq + r3], relu1(acc_[4 * qq + r3]), part); tot_[qq] = sum_xor32(part) + 0.0f; } \
                const float ta_ = hi ? tot_[2] : tot_[0], tb_ = hi ? tot_[3] : tot_[1]; \
                sc[(2 * hi) * 8192 + key_] = ta_; sc[(2 * hi + 1) * 8192 + key_] = tb_; \
                mn0 = min1(mn0, ta_); mx0 = max1(mx0, ta_); mn1 = min1(mn1, tb_); mx1 = max1(mx1, tb_);     \
                } while (0)
            asm volatile("s_waitcnt vmcnt(0)" ::: "memory");
            P13A_LDK(ka, tile);
            while (tile < ntiles) {
                P13A_LDK(kc, tile + 8); P13A_WAIT(ka, 4);
                P13A_TILE(ka, tile);
                tile += 8; if (tile >= ntiles) break;
                P13A_LDK(ka, tile + 8); P13A_WAIT(kc, 4);
                P13A_TILE(kc, tile);
                tile += 8;
            }
            asm volatile("s_waitcnt vmcnt(0)" : "+v"(ka[0]), "+v"(ka[1]), "+v"(ka[2]), "+v"(ka[3]), "+v"(kc[0]), "+v"(kc[1]), "+v"(kc[2]), "+v"(kc[3]) :: "memory");
#undef P13A_WAIT
#undef P13A_LDK
#undef P13A_TILE
        }
        if (slot + F.G < NTOK / 4) P13A_LOADQ(P13A_TOK0(slot + F.G));
        __builtin_amdgcn_sched_barrier(0);
        {
#define HM_(x, OP) do { x = OP(x, dpp_xor1(x)); x = OP(x, dpp_xor2(x)); x = OP(x, __int_as_float(__builtin_amdgcn_mov_dpp(__float_as_int(x), 0x141, 0xF, 0xF, true))); x = OP(x, __int_as_float(__builtin_amdgcn_mov_dpp(__float_as_int(x), 0x140, 0xF, 0xF, true))); \
            { auto r_ = __builtin_amdgcn_permlane16_swap(__float_as_uint(x), __float_as_uint(x), false, false); x = OP(__uint_as_float(r_[0]), __uint_as_float(r_[1])); } } while (0)
            HM_(mn0, fminf); HM_(mx0, fmaxf); HM_(mn1, fminf); HM_(mx1, fmaxf);
#undef HM_
        }
        if (r32 == 0) { mmx[(wid * 4 + 2 * hi) * 2] = mn0; mmx[(wid * 4 + 2 * hi) * 2 + 1] = mx0; mmx[(wid * 4 + 2 * hi + 1) * 2] = mn1; mmx[(wid * 4 + 2 * hi + 1) * 2 + 1] = mx1; }
        __syncthreads();
        const int tok = tok0 + q, n = t0 + q + 1; bool ovf = false;
        if (tmax + 1 <= TOPK) {
            for (int i = th; i < TOPK; i += 128) IDX[(size_t)tok * TOPK + i] = (i < n) ? i : 0;
        } else {
            const LAS float* scq = sc + q * 8192; const int nsl = (n + 127) >> 7;
            float fmn = 3e38f, fmx = -3e38f;
#pragma unroll
            for (int w = 0; w < 8; ++w) { fmn = fminf(fmn, mmx[(w * 4 + q) * 2]); fmx = fmaxf(fmx, mmx[(w * 4 + q) * 2 + 1]); }
            const float bsc = (fmx > fmn) ? 255.99f / (fmx - fmn) : 0.f;
            for (int s0 = 0; s0 < nsl; s0 += 8) { float v[8];
#pragma unroll
                for (int j = 0; j < 8; ++j) { const int i = (s0 + j) * 128 + th; v[j] = scq[min(i, n - 1)]; }
#pragma unroll
                for (int j = 0; j < 8; ++j) { const int i = (s0 + j) * 128 + th; const int bin = min(max((int)((v[j] - fmn) * bsc), 0), 255);
                    LAS unsigned* tgt = (i < n) ? &hist[q * 1024 + (lane & 3) * 256 + bin] : &dmy[th];
                    __hip_atomic_fetch_add(tgt, 1u, __ATOMIC_RELAXED, __HIP_MEMORY_SCOPE_WORKGROUP); } }
            __syncthreads();
            if (sub == 0) {
                const v4u c4 = *(const LAS v4u*)(hist + q * 1024 + 4 * lane) + *(const LAS v4u*)(hist + q * 1024 + 256 + 4 * lane) + *(const LAS v4u*)(hist + q * 1024 + 512 + 4 * lane) + *(const LAS v4u*)(hist + q * 1024 + 768 + 4 * lane); const unsigned s4 = c4.x + c4.y + c4.z + c4.w; unsigned S = s4;
#pragma unroll
                for (int o = 1; o < 64; o <<= 1) { const unsigned v = __shfl_down(S, o); if (lane + o < 64) S += v; }
                const unsigned above = S - s4;
                if (above < (unsigned)TOPK && (unsigned)TOPK <= S) { unsigned cum = above; int bin;
                    if (cum + c4.w >= (unsigned)TOPK) bin = 3; else { cum += c4.w; if (cum + c4.z >= (unsigned)TOPK) bin = 2; else { cum += c4.z; if (cum + c4.y >= (unsigned)TOPK) bin = 1; else { cum += c4.y; bin = 0; } } }
                    qm[q * 16 + 0] = (unsigned)(4 * lane + bin); qm[q * 16 + 1] = (unsigned)TOPK - cum; }
            }
            __syncthreads();
            const int bstar = (int)qm[q * 16 + 0]; const unsigned need1 = qm[q * 16 + 1];
            { unsigned run = 0u;
              for (int s0 = 0; s0 < nsl; s0 += 8) { float v[8];
#pragma unroll
                for (int j = 0; j < 8; ++j) { const int i = (s0 + j) * 128 + th; v[j] = scq[min(i, n - 1)]; }
#pragma unroll
                for (int j = 0; j < 8; ++j) { const int i = (s0 + j) * 128 + th; const bool ok = i < n; const int bin = min(max((int)((v[j] - fmn) * bsc), 0), 255);
                    const bool def = ok && bin > bstar; const unsigned long long bd = __ballot(def);
                    const unsigned pos = run + __builtin_amdgcn_mbcnt_hi((unsigned)(bd >> 32), __builtin_amdgcn_mbcnt_lo((unsigned)bd, 0u));
                    if (def && pos < (unsigned)TOPK) outl[q * 256 + (sub ? 255u - pos : pos)] = (unsigned)i;
                    run += (unsigned)__popcll(bd);
                    if (ok && bin == bstar) { const unsigned pc = __hip_atomic_fetch_add(&qm[q * 16 + 4], 1u, __ATOMIC_RELAXED, __HIP_MEMORY_SCOPE_WORKGROUP); if (pc < (unsigned)CAP) { candk[q * CAP + pc] = f2key(v[j]); candi[q * CAP + pc] = (unsigned)i; } } } }
              if (lane == 0) qm[q * 16 + 10 + sub] = run; }
            __syncthreads();
            if (sub == 0) {
                const unsigned mc = qm[q * 16 + 4];
                if (mc <= (unsigned)CAP) {
                    const unsigned D0 = qm[q * 16 + 10];
                    unsigned kc[4], ic[4], rk[4];
#pragma unroll
                    for (int c = 0; c < 4; ++c) { const bool vl = lane + 64 * c < (int)mc; kc[c] = vl ? candk[q * CAP + lane + 64 * c] : 0u; ic[c] = vl ? candi[q * CAP + lane + 64 * c] : 0xffffffffu; rk[c] = 0u; }
#pragma unroll 4
                    for (unsigned j = 0; j < mc; ++j) { const unsigned kj = candk[q * CAP + j], ij = candi[q * CAP + j];
#pragma unroll
                        for (int c = 0; c < 4; ++c) rk[c] += (kj > kc[c] || (kj == kc[c] && ij < ic[c])) ? 1u : 0u; }
#pragma unroll
                    for (int c = 0; c < 4; ++c) if (lane + 64 * c < (int)mc && rk[c] < need1) outl[q * 256 + D0 + rk[c]] = ic[c];
                    if (lane == 0) qm[q * 16 + 5] = 0u;
                } else if (lane == 0) qm[q * 16 + 5] = 1u;
            }
            __syncthreads();
            ovf = (qm[5] | qm[16 + 5] | qm[32 + 5] | qm[48 + 5]) != 0u;
            if (ovf) {
            for (int s0 = 0; s0 < nsl; s0 += 8) { float v[8];
#pragma unroll
                for (int j = 0; j < 8; ++j) { const int i = (s0 + j) * 128 + th; v[j] = scq[min(i, n - 1)]; }
#pragma unroll
                for (int j = 0; j < 8; ++j) { const int i = (s0 + j) * 128 + th; const int bin = min(max((int)((v[j] - fmn) * bsc), 0), 255);
                    if (i < n && bin == bstar) { const unsigned pc = __hip_atomic_fetch_add(&qm[q * 16 + 2], 1u, __ATOMIC_RELAXED, __HIP_MEMORY_SCOPE_WORKGROUP); if (pc < (unsigned)CAP) candk[q * CAP + pc] = f2key(v[j]); } } }
            __syncthreads();
            if (sub == 0) {
                const unsigned mc = qm[q * 16 + 2]; unsigned T = 0u, nt = 0u; bool found = false;
                if (mc <= (unsigned)CAP) {
                    unsigned kc[4], gt[4], ge[4];
#pragma unroll
                    for (int c = 0; c < 4; ++c) { kc[c] = (lane + 64 * c < (int)mc) ? candk[q * CAP + lane + 64 * c] : 0u; gt[c] = 0u; ge[c] = 0u; }
                    for (unsigned j = 0; j < mc; ++j) { const unsigned kj = candk[q * CAP + j];
#pragma unroll
                        for (int c = 0; c < 4; ++c) { gt[c] += (kj > kc[c]) ? 1u : 0u; ge[c] += (kj >= kc[c]) ? 1u : 0u; } }
#pragma unroll
                    for (int c = 0; c < 4; ++c) if (lane + 64 * c < (int)mc && gt[c] < need1 && need1 <= ge[c]) { T = kc[c]; nt = need1 - gt[c]; found = true; }
                } else {
                    unsigned lo = 0u;
                    for (int bit = 31; bit >= 0; --bit) { const unsigned cand = lo | (1u << bit); unsigned c = 0u;
                        for (int i = lane; i < n; i += 64) c += (f2key(scq[i]) >= cand) ? 1u : 0u;
#pragma unroll
                        for (int o = 1; o < 64; o <<= 1) c += __shfl_xor(c, o);
                        if (c >= (unsigned)TOPK) lo = cand; }
                    unsigned cg = 0u;
                    for (int i = lane; i < n; i += 64) cg += (f2key(scq[i]) > lo) ? 1u : 0u;
#pragma unroll
                    for (int o = 1; o < 64; o <<= 1) cg += __shfl_xor(cg, o);
                    T = lo; nt = (unsigned)TOPK - cg; found = (lane == 0);
                }
                if (found) { qm[q * 16 + 0] = T; qm[q * 16 + 1] = nt; }
            }
            __syncthreads();
            const unsigned T = qm[q * 16 + 0], need = qm[q * 16 + 1];
            unsigned Gs = 0u, Es = 0u;
            for (int s0 = 0; s0 < nsl; s0 += 8) { float v[8];
#pragma unroll
                for (int j = 0; j < 8; ++j) { const int i = (s0 + j) * 128 + th; v[j] = scq[min(i, n - 1)]; }
#pragma unroll
                for (int j = 0; j < 8; ++j) { const int i = (s0 + j) * 128 + th; const bool ok = i < n; const unsigned k = f2key(v[j]);
                    Gs += (unsigned)__popcll(__ballot(ok && k > T)); Es += (unsigned)__popcll(__ballot(ok && k == T)); } }
            if (lane == 0) { qm[q * 16 + 10 + sub * 2] = Gs; qm[q * 16 + 11 + sub * 2] = Es; }
            __syncthreads();
            const unsigned G0 = qm[q * 16 + 10], E0 = qm[q * 16 + 11], E1 = qm[q * 16 + 13];
            bool slow = false;
#pragma unroll
            for (int qx = 0; qx < 4; ++qx) slow = slow || (qm[qx * 16 + 11] + qm[qx * 16 + 13] != qm[qx * 16 + 1]);
            (void)E1;
            if (!slow) {
                unsigned run = sub ? (G0 + E0) : 0u;
                for (int s0 = 0; s0 < nsl; s0 += 8) { float v[8];
#pragma unroll
                    for (int j = 0; j < 8; ++j) { const int i = (s0 + j) * 128 + th; v[j] = scq[min(i, n - 1)]; }
#pragma unroll
                    for (int j = 0; j < 8; ++j) { const int i = (s0 + j) * 128 + th; const bool sel = (i < n) && f2key(v[j]) >= T; const unsigned long long bs = __ballot(sel);
                        const unsigned pos = run + __builtin_amdgcn_mbcnt_hi((unsigned)(bs >> 32), __builtin_amdgcn_mbcnt_lo((unsigned)bs, 0u));
                        if (sel && pos < (unsigned)TOPK) candk[q * CAP + pos] = (unsigned)i; run += (unsigned)__popcll(bs); } }
            } else {
            unsigned myG = 0u, myE = 0u;
            for (int s0 = 0; s0 < nsl; s0 += 8) { float v[8];
#pragma unroll
                for (int j = 0; j < 8; ++j) { const int i = (s0 + j) * 128 + th; v[j] = scq[min(i, n - 1)]; }
#pragma unroll
                for (int j = 0; j < 8; ++j) { const int s2 = s0 + j, i = s2 * 128 + th; const bool ok = i < n; const unsigned k = f2key(v[j]); const unsigned long long bg = __ballot(ok && k > T), be = __ballot(ok && k == T);
                    const unsigned cg = (unsigned)__popcll(bg), ce = (unsigned)__popcll(be); myG = (lane == s2) ? cg : myG; myE = (lane == s2) ? ce : myE; } }
            cntG[(q * 2 + sub) * 64 + lane] = myG; cntE[(q * 2 + sub) * 64 + lane] = myE;
            __syncthreads();
            unsigned tbase, pbase;
            { const unsigned e0 = cntE[(q * 2) * 64 + lane], e1 = cntE[(q * 2 + 1) * 64 + lane], g0 = cntG[(q * 2) * 64 + lane], g1 = cntG[(q * 2 + 1) * 64 + lane];
              unsigned inc = e0 + e1;
#pragma unroll
              for (int o = 1; o < 64; o <<= 1) { const unsigned v = __shfl_up(inc, o); if (lane >= o) inc += v; }
              const unsigned tb0 = inc - (e0 + e1), tb1 = tb0 + e0;
              const unsigned se0 = (need > tb0) ? min(need - tb0, e0) : 0u, se1 = (need > tb1) ? min(need - tb1, e1) : 0u;
              const unsigned c0 = g0 + se0, c1 = g1 + se1; unsigned inc2 = c0 + c1;
#pragma unroll
              for (int o = 1; o < 64; o <<= 1) { const unsigned v = __shfl_up(inc2, o); if (lane >= o) inc2 += v; }
              const unsigned pb0 = inc2 - (c0 + c1);
              tbase = sub ? tb1 : tb0; pbase = sub ? pb0 + c0 : pb0; }
            for (int s0 = 0; s0 < nsl; s0 += 8) { float v[8];
#pragma unroll
                for (int j = 0; j < 8; ++j) { const int i = (s0 + j) * 128 + th; v[j] = scq[min(i, n - 1)]; }
#pragma unroll
                for (int j = 0; j < 8; ++j) { const int s2 = s0 + j; if (s2 < nsl) { const int i = s2 * 128 + th; const bool ok = i < n; const unsigned k = f2key(v[j]); const bool g = ok && k > T, e = ok && k == T;
                    const unsigned long long be = __ballot(e);
                    const unsigned trank = (unsigned)__builtin_amdgcn_readlane((int)tbase, s2) + __builtin_amdgcn_mbcnt_hi((unsigned)(be >> 32), __builtin_amdgcn_mbcnt_lo((unsigned)be, 0u));
                    const bool sel = g || (e && trank < need);
                    const unsigned long long bs = __ballot(sel);
                    const unsigned pos = (unsigned)__builtin_amdgcn_readlane((int)pbase, s2) + __builtin_amdgcn_mbcnt_hi((unsigned)(bs >> 32), __builtin_amdgcn_mbcnt_lo((unsigned)bs, 0u));
                    if (sel && pos < (unsigned)TOPK) candk[q * CAP + pos] = (unsigned)i; } } }
            }
            }
        }
        __syncthreads();
        if (tmax + 1 > TOPK) { const LAS unsigned* src = ovf ? candk + q * CAP : outl + q * 256; for (int i = th; i < TOPK; i += 128) IDX[(size_t)tok * TOPK + i] = (int)src[i]; }
    }
}

__device__ __forceinline__ void p13b_dsa_attn(Frame& F, const Args& A) {
    unsigned char* ws = A.ws; const int lane = F.lane, wid = F.wave, c16 = lane & 15, g4 = lane >> 4;
    const bf16* CN = (const bf16*)(ws + WS_CN); const bf16* QL = (const bf16*)(ws + WS_QLAT); const int* IDX = (const int*)(ws + WS_IDX); bf16* OL = (bf16*)(ws + WS_OLAT);
    LAS float* lut = (LAS float*)(F.lds + DSA_SCR + 8192);
    for (int i = F.tid; i < 144 * 16; i += 512) { const int n = i >> 4, h = i & 15; lut[i] = A.in[1][rel_bucket(n) * 16 + h]; }
    __syncthreads();
    LAS char* img = (LAS char*)(F.lds + RING_OFF + wid * 16384);
    LAS int* idxw = (LAS int*)(F.lds + DSA_SCR + wid * 1024);
    const unsigned imgb = (unsigned)(uintptr_t)img;
    const int gw = F.vcu * NWAVES + wid, NGW = F.G * NWAVES;
    const unsigned prow0 = 8u * ((lane >> 2) & 3) + (lane & 3);
    unsigned ta0[8], ta1[8];
    { const unsigned qq = (lane & 15) >> 2, pp = lane & 3;
#pragma unroll
      for (int c = 0; c < 8; ++c) { ta0[c] = imgb + dsa_off_b(8 * g4 + qq, 2 * c + (pp >> 1)) + 8 * (pp & 1); ta1[c] = imgb + dsa_off_b(8 * g4 + 4 + qq, 2 * c + (pp >> 1)) + 8 * (pp & 1); } }
    (void)gw; (void)NGW;
    for (int j = wid; ; j += NWAVES) {
        const int slot = F.vcu + (j >> 2) * F.G; if (slot >= NTOK / 4) break;
        const int tok = P13A_TOK0(slot) + (j & 3);
        const int b = tok >> 13, t = tok & (SEQ - 1), cnt = min(TOPK, t + 1), ntile = (cnt + 31) >> 5;
        bf16x8 qb[8];
#pragma unroll
        for (int ks = 0; ks < 8; ++ks) qb[ks] = *(const bf16x8*)(QL + (size_t)tok * 4096 + c16 * 256 + ks * 32 + g4 * 8);
#pragma unroll
        for (int i = 0; i < 4; ++i) idxw[lane + 64 * i] = IDX[(size_t)tok * TOPK + lane + 64 * i];
        WSYNC();
        f32x4 o[16];
#pragma unroll
        for (int ct = 0; ct < 16; ++ct) o[ct] = (f32x4){0.f, 0.f, 0.f, 0.f};
        float m_run = -1e30f, l_run = 0.f;
        const LAS float* lutcol = lut + c16;
#pragma unroll 1
        for (int tile = 0; tile < ntile; ++tile) {
            { v4u st[16];
#pragma unroll
              for (int i = 0; i < 16; ++i) { const int nn = lane + 64 * i, row = nn >> 5, chg = nn & 31; const int key = idxw[tile * 32 + row];
                  st[i] = *(const v4u*)(CN + (size_t)(b * SEQ + key) * KVR + chg * 8); }
#pragma unroll
              for (int i = 0; i < 16; ++i) { const int nn = lane + 64 * i, row = nn >> 5, chg = nn & 31;
                  *(LAS v4u*)(img + (chg >> 4) * 8192 + dsa_off_b(row, chg & 15)) = st[i]; } }
            WSYNC();
            f32x4 sacc[2];
#pragma unroll
            for (int T = 0; T < 2; ++T) { sacc[T] = (f32x4){0.f, 0.f, 0.f, 0.f};
#pragma unroll
                for (int ks = 0; ks < 8; ++ks) { const bf16x8 a = *(const LAS bf16x8*)(img + (ks >> 2) * 8192 + dsa_off_b(prow0 + 4 * T, 4 * (ks & 3) + g4));
                    sacc[T] = __builtin_amdgcn_mfma_f32_16x16x32_bf16(a, qb[ks], sacc[T], 0, 0, 0); } }
            float pmax = -__builtin_inff();
#pragma unroll
            for (int T = 0; T < 2; ++T) { const int i0 = tile * 32 + 8 * g4 + 4 * T; const v4u kk = *(const LAS v4u*)(idxw + i0);
                const int kidx[4] = {(int)kk.x, (int)kk.y, (int)kk.z, (int)kk.w};
#pragma unroll
                for (int e = 0; e < 4; ++e) { const int dist = min(max(t - kidx[e], 0), 128); float s = sacc[T][e] + lutcol[dist * 16];
                    s = (i0 + e < cnt) ? s : -__builtin_inff(); sacc[T][e] = s; pmax = fmaxf(pmax, s); } }
            pmax = max_xor16(pmax); pmax = max_xor32(pmax);
            const float mn = fmaxf(m_run, pmax), alpha = __builtin_amdgcn_exp2f((m_run - mn) * fa::C2); m_run = mn;
            float ps = 0.f;
#pragma unroll
            for (int T = 0; T < 2; ++T)
#pragma unroll
                for (int e = 0; e < 4; ++e) { const float pv = __builtin_amdgcn_exp2f((sacc[T][e] - mn) * fa::C2); sacc[T][e] = pv; ps += pv; }
            ps = sum_xor16(ps); ps = sum_xor32(ps);
            l_run = l_run * alpha + ps;
            if (__any(alpha < 1.f)) {
                float al[4];
#pragma unroll
                for (int e = 0; e < 4; ++e) al[e] = __shfl(alpha, 4 * g4 + e);
#pragma unroll
                for (int ct = 0; ct < 16; ++ct)
#pragma unroll
                    for (int e = 0; e < 4; ++e) o[ct][e] *= al[e];
            }
            fa::u32x4v pw; pw.x = fa::cvtpk(sacc[0][0], sacc[0][1]); pw.y = fa::cvtpk(sacc[0][2], sacc[0][3]); pw.z = fa::cvtpk(sacc[1][0], sacc[1][1]); pw.w = fa::cvtpk(sacc[1][2], sacc[1][3]);
            const bf16x8 pa = *reinterpret_cast<bf16x8*>(&pw);
#pragma unroll
            for (int cg = 0; cg < 4; ++cg) { fa::s16x4 b0[4], b1[4];
                asm volatile("ds_read_b64_tr_b16 %0, %8 offset:%c16\n\tds_read_b64_tr_b16 %1, %9 offset:%c16\n\tds_read_b64_tr_b16 %2, %10 offset:%c16\n\tds_read_b64_tr_b16 %3, %11 offset:%c16\n\t"
                             "ds_read_b64_tr_b16 %4, %12 offset:%c16\n\tds_read_b64_tr_b16 %5, %13 offset:%c16\n\tds_read_b64_tr_b16 %6, %14 offset:%c16\n\tds_read_b64_tr_b16 %7, %15 offset:%c16\n\ts_waitcnt lgkmcnt(0)"
                             : "=&v"(b0[0]), "=&v"(b1[0]), "=&v"(b0[1]), "=&v"(b1[1]), "=&v"(b0[2]), "=&v"(b1[2]), "=&v"(b0[3]), "=&v"(b1[3])
                             : "v"(ta0[(cg & 1) * 4 + 0]), "v"(ta1[(cg & 1) * 4 + 0]), "v"(ta0[(cg & 1) * 4 + 1]), "v"(ta1[(cg & 1) * 4 + 1]), "v"(ta0[(cg & 1) * 4 + 2]), "v"(ta1[(cg & 1) * 4 + 2]), "v"(ta0[(cg & 1) * 4 + 3]), "v"(ta1[(cg & 1) * 4 + 3]), "i"((cg >> 1) * 8192) : "memory");
                FA_SBAR();
#pragma unroll
                for (int k = 0; k < 4; ++k) o[cg * 4 + k] = __builtin_amdgcn_mfma_f32_16x16x32_bf16(pa, (bf16x8){b0[k][0], b0[k][1], b0[k][2], b0[k][3], b1[k][0], b1[k][1], b1[k][2], b1[k][3]}, o[cg * 4 + k], 0, 0, 0); }
            WSYNC();
        }
        { const float il = (l_run > 0.f) ? 1.0f / l_run : 0.f; float ile[4];
#pragma unroll
          for (int e = 0; e < 4; ++e) ile[e] = __shfl(il, 4 * g4 + e);
#pragma unroll
          for (int ct = 0; ct < 16; ++ct)
#pragma unroll
              for (int e = 0; e < 4; ++e) { const float v = o[ct][e] * ile[e]; const float vn = dpp_xor1(v);
                  if ((lane & 1) == 0) *(unsigned*)(OL + (size_t)tok * 4096 + (4 * g4 + e) * 256 + ct * 16 + c16) = fa::cvtpk(v, vn); } }
        WSYNC();
    }
    __syncthreads();
}

struct MoeTiles { int tend[8]; int pstart[8]; int MT; };
__device__ __forceinline__ void moe_tiles(Frame& F, MoeTiles& T) {
    int acc = 0;
#pragma unroll
    for (int e = 0; e < 8; ++e) { const int c = (int)__builtin_amdgcn_readfirstlane(__hip_atomic_load((unsigned*)(F.ctl + CW_MOECNT + 64 * e), __ATOMIC_RELAXED, __HIP_MEMORY_SCOPE_AGENT));
        T.pstart[e] = acc * 256; acc += (c + 255) >> 8; T.tend[e] = acc; }
    T.MT = acc;
}
__device__ __forceinline__ void p15_gather(Frame& F, const Args& A) {
    MoeTiles T; moe_tiles(F, T);
    const int gw = F.vcu * NWAVES + F.wave, NGW = F.G * NWAVES, lane = F.lane;
    const bf16* XH = (const bf16*)(A.ws + WS_XF); unsigned char* XG = (unsigned char*)(A.ws + WS_XG);
    const int* re = (const int*)(A.ws + WS_ROUTE); const int* rp = re + 2 * NTOK;
    v4u xn[4];
    if (gw < NTOK) {
#pragma unroll
        for (int k = 0; k < 4; ++k) xn[k] = *(const v4u*)(XH + (size_t)gw * DM + 8 * lane + 512 * k); }
    for (int tok = gw; tok < NTOK; tok += NGW) {
        uint2 o[4];
#pragma unroll
        for (int k = 0; k < 4; ++k) { int w0 = __builtin_amdgcn_cvt_pk_fp8_f32(bflo(xn[k].x), bfhi(xn[k].x), 0, false); w0 = __builtin_amdgcn_cvt_pk_fp8_f32(bflo(xn[k].y), bfhi(xn[k].y), w0, true);
            int w1 = __builtin_amdgcn_cvt_pk_fp8_f32(bflo(xn[k].z), bfhi(xn[k].z), 0, false); w1 = __builtin_amdgcn_cvt_pk_fp8_f32(bflo(xn[k].w), bfhi(xn[k].w), w1, true); o[k].x = (unsigned)w0; o[k].y = (unsigned)w1; }
        const int e0 = re[2 * tok], e1 = re[2 * tok + 1], p0 = rp[2 * tok], p1 = rp[2 * tok + 1];
        if (tok + NGW < NTOK) {
#pragma unroll
            for (int k = 0; k < 4; ++k) xn[k] = *(const v4u*)(XH + (size_t)(tok + NGW) * DM + 8 * lane + 512 * k); }
        __builtin_amdgcn_sched_barrier(0);
#pragma unroll
        for (int s = 0; s < 2; ++s) { const int e = s ? e1 : e0, pp = s ? p1 : p0; int ps = 0;
#pragma unroll
            for (int q = 0; q < 8; ++q) ps = (q == e) ? T.pstart[q] : ps;
            unsigned char* dst = XG + (size_t)(ps + pp) * DM + 8 * lane;
#pragma unroll
            for (int k = 0; k < 4; ++k) *(uint2*)(dst + 512 * k) = o[k]; }
    }
}
__device__ __forceinline__ void p18_final(Frame& F, const Args& A) {
    MoeTiles T; moe_tiles(F, T);
    const int gw = F.vcu * NWAVES + F.wave, NGW = F.G * NWAVES, lane = F.lane;
    const bf16* XH = (const bf16*)(A.ws + WS_XF); const bf16* Y = (const bf16*)(A.ws + WS_Y);
    const int* re = (const int*)(A.ws + WS_ROUTE); const int* rp = re + 2 * NTOK; const float* rw = (const float*)(rp + 2 * NTOK);
    const float* gam = A.in[25] + DM; const float* bet = A.in[26] + DM;
    LAS float* gml = (LAS float*)(F.lds + DSA_SCR); LAS float* btl = gml + DM;
    { const int i = F.tid; *(LAS f32x4*)(gml + i * 4) = *(const f32x4*)(gam + i * 4); *(LAS f32x4*)(btl + i * 4) = *(const f32x4*)(bet + i * 4); }
    __syncthreads();
    int en[2] = {0, 0}, pn[2] = {0, 0}; float wn[2] = {0.f, 0.f};
    if (gw < NTOK) { en[0] = re[2 * gw]; en[1] = re[2 * gw + 1]; pn[0] = rp[2 * gw]; pn[1] = rp[2 * gw + 1]; wn[0] = rw[2 * gw]; wn[1] = rw[2 * gw + 1]; }
    for (int tok = gw; tok < NTOK; tok += NGW) {
        int rows[2]; float w[2];
#pragma unroll
        for (int s = 0; s < 2; ++s) { const int e = en[s]; int ps = 0;
#pragma unroll
            for (int q = 0; q < 8; ++q) ps = (q == e) ? T.pstart[q] : ps;
            rows[s] = ps + pn[s]; w[s] = wn[s]; }
        if (tok + NGW < NTOK) { const int t2 = tok + NGW; en[0] = re[2 * t2]; en[1] = re[2 * t2 + 1]; pn[0] = rp[2 * t2]; pn[1] = rp[2 * t2 + 1]; wn[0] = rw[2 * t2]; wn[1] = rw[2 * t2 + 1]; }
        const uint2* xr = (const uint2*)(XH + (size_t)tok * DM) + lane; const uint2* y0 = (const uint2*)(Y + (size_t)rows[0] * DM) + lane; const uint2* y1 = (const uint2*)(Y + (size_t)rows[1] * DM) + lane;
        f32x4 v[8]; float s = 0.f;
#pragma unroll
        for (int j = 0; j < 8; ++j) { const uint2 a = y0[64 * j], bq = y1[64 * j]; const f32x4 ya = (f32x4){bflo(a.x), bfhi(a.x), bflo(a.y), bfhi(a.y)}, yb = (f32x4){bflo(bq.x), bfhi(bq.x), bflo(bq.y), bfhi(bq.y)};
            const uint2 xq = xr[64 * j]; const f32x4 xv = (f32x4){bflo(xq.x), bfhi(xq.x), bflo(xq.y), bfhi(xq.y)};
            v[j] = xv * ALPHA + ya * w[0] + yb * w[1]; s += (v[j][0] + v[j][1]) + (v[j][2] + v[j][3]); }
        const float mean = wave_sum(s) * (1.f / DM); float s2 = 0.f;
#pragma unroll
        for (int j = 0; j < 8; ++j) { v[j] = v[j] - mean; s2 += (v[j][0] * v[j][0] + v[j][1] * v[j][1]) + (v[j][2] * v[j][2] + v[j][3] * v[j][3]); }
        const float rstd = 1.f / sqrtf(wave_sum(s2) * (1.f / DM) + LN_EPS);
#pragma unroll
        for (int j = 0; j < 8; ++j) { const int c = 4 * lane + 256 * j; const f32x4 gg = *(const LAS f32x4*)(gml + c), bb = *(const LAS f32x4*)(btl + c);
            *(f32x4*)(A.out + (size_t)tok * DM + c) = v[j] * rstd * gg + bb; }
    }
}

__global__ void __launch_bounds__(NWAVES * 64, 2) mega_fwd(Args args) {
    extern __shared__ __attribute__((aligned(16))) unsigned char lds[];
    Frame F;
    F.lds = (LAS unsigned char*)lds;
    F.MISC = (volatile LAS unsigned*)(F.lds + MISC_OFF);
    F.tid = threadIdx.x; F.lane = F.tid & 63; F.wave = __builtin_amdgcn_readfirstlane(F.tid >> 6);
    F.G = gridDim.x; { const int bx = blockIdx.x; F.vcu = (F.G % 8 == 0) ? (bx % 8) * (F.G / 8) + bx / 8 : bx; }
    unsigned char* ws = args.ws;
    F.ctl = (gu32*)(ws + WS_CTL);
    for (int u = F.tid; u < (LDS_BYTES - LDSCTL_OFF) / 4; u += NWAVES * 64) ((LAS unsigned*)(F.lds + LDSCTL_OFF))[u] = 0u;
    __syncthreads();
    XcdBarrier bar; bar.bar = (unsigned*)(F.ctl + CW_BAR); bar.x = 0; bar.st = nullptr;
#if !MK_PER_PHASE
    bar = xcd_barrier_post((unsigned*)(F.ctl + CW_BAR), F.MISC + 8);
#define GRID_BAR() xcd_barrier(bar)
#else
#define GRID_BAR() do { } while (0)
#endif
    const int lo = args.ph_lo, hi = args.ph_hi;
#ifndef PH_MASK
#define PH_MASK 0x3fffff
#endif
#define IN(k) (((PH_MASK >> (k)) & 1) && lo <= (k) && (k) < hi)
#define BOTH(k) (IN(k) && IN((k) + 1))
    bf16* XB = (bf16*)(ws + WS_XB); bf16* XH = (bf16*)(ws + WS_XF); bf16* Z = (bf16*)(ws + WS_Z);

#ifndef PROBE_MASK
#define PROBE_MASK 0
#endif
#define REPS(k) ((((PROBE_MASK) >> (k)) & 1) ? 2 : 1)
    if (IN(0)) for (int rep_ = 0; rep_ < REPS(0); ++rep_) { relaunder(F); p0_prologue(F, args); if (BOTH(0) || rep_ + 1 < REPS(0)) GRID_BAR(); }
    if (IN(1)) for (int rep_ = 0; rep_ < REPS(1); ++rep_) { relaunder(F);
        pg8::Gemm g{XB, (const bf16*)(ws + WS_W_NSA_IN), NTOK, 5120, DM}; pg8::StaticOrder S; S.init(NTOK, 5120, F.G, (int)blockIdx.x);
        pg8::EpiNsaIn E{(bf16*)(ws + WS_P0), (float*)(ws + WS_GL), 0.08838834764831845f};
        pg8::gemm_phase<pg8::EpiNsaIn, pg8::StaticOrder, true, true>(F.lds + RING_OFF, g, S, E);
        if (BOTH(1) || rep_ + 1 < REPS(1)) GRID_BAR();
    }
    if (IN(2)) for (int rep_ = 0; rep_ < REPS(2); ++rep_) { relaunder(F); p2_compress(F, args); if (BOTH(2) || rep_ + 1 < REPS(2)) GRID_BAR(); }
#ifndef PROBE_NSA2
#define PROBE_NSA2 0
#endif
    for (int repn_ = 0; repn_ < (PROBE_NSA2 ? 2 : 1); ++repn_) {
    if (IN(3)) for (int rep_ = 0; rep_ < REPS(3); ++rep_) { relaunder(F); p3a_nsa_cmp(F, args); __syncthreads(); }
    if (IN(4)) for (int rep_ = 0; rep_ < REPS(4); ++rep_) { relaunder(F); p3b_nsa_sel(F, args); if (BOTH(4) || rep_ + 1 < REPS(4) || repn_ + 1 < (PROBE_NSA2 ? 2 : 1)) GRID_BAR(); }
    }
    if (IN(6)) for (int rep_ = 0; rep_ < REPS(6); ++rep_) { relaunder(F);
        pg8::Gemm g{(const bf16*)(ws + WS_OATT0), (const bf16*)(ws + WS_W_NSA_OUT), NTOK, DM, DM}; pg8::StaticOrder S; S.init(NTOK, DM, F.G, (int)blockIdx.x);
        pg8::EpiResF32 E{args.in[0], Z, ALPHA, DM};
        pg8::gemm_phase<pg8::EpiResF32, pg8::StaticOrder, true, true>(F.lds + RING_OFF, g, S, E);
        if (BOTH(6) || rep_ + 1 < REPS(6)) GRID_BAR();
    }
    if (IN(7)) for (int rep_ = 0; rep_ < REPS(7); ++rep_) { relaunder(F); ln_phase<false, FFN_F8 != 0>(F, args, Z, args.in[23], args.in[24], XH, (unsigned char*)XB); if (BOTH(7) || rep_ + 1 < REPS(7)) GRID_BAR(); }
    if (IN(8)) for (int rep_ = 0; rep_ < REPS(8); ++rep_) { relaunder(F);
        pg8::StaticOrder S; S.init(NTOK, 2 * DFF, F.G, (int)blockIdx.x);
#if FFN_F8
        pg8::Gemm g{XB, (const bf16*)(ws + WS_W_FFN_GU), NTOK, 2 * DFF, DM, 1, 0x79797979};
        pg8::EpiSwiGLU8 E{(unsigned char*)(ws + WS_HFF), DFF};
        pg8::gemm_phase<pg8::EpiSwiGLU8, pg8::StaticOrder, true, true, true>(F.lds + RING_OFF, g, S, E);
#else
        pg8::Gemm g{XB, (const bf16*)(ws + WS_W_FFN_GU), NTOK, 2 * DFF, DM};
        pg8::EpiSwiGLU E{(bf16*)(ws + WS_HFF), DFF};
        pg8::gemm_phase<pg8::EpiSwiGLU, pg8::StaticOrder, true, true>(F.lds + RING_OFF, g, S, E);
#endif
        if (BOTH(8) || rep_ + 1 < REPS(8)) GRID_BAR();
    }
    if (IN(9)) for (int rep_ = 0; rep_ < REPS(9); ++rep_) { relaunder(F);
        pg8::StaticOrder S; S.init(NTOK, DM, F.G, (int)blockIdx.x);
        pg8::EpiResH E{XH, Z, ALPHA, DM};
#if FFN_F8
        pg8::Gemm g{(const bf16*)(ws + WS_HFF), (const bf16*)(ws + WS_W_FFN_DN), NTOK, DM, DFF, 1, 0x77777777};
        pg8::gemm_phase<pg8::EpiResH, pg8::StaticOrder, true, true, true>(F.lds + RING_OFF, g, S, E);
#else
        pg8::Gemm g{(const bf16*)(ws + WS_HFF), (const bf16*)(ws + WS_W_FFN_DN), NTOK, DM, DFF};
        pg8::gemm_phase<pg8::EpiResH, pg8::StaticOrder, true, true>(F.lds + RING_OFF, g, S, E);
#endif
        if (BOTH(9) || rep_ + 1 < REPS(9)) GRID_BAR();
    }
    if (IN(10)) for (int rep_ = 0; rep_ < REPS(10); ++rep_) { relaunder(F); ln_phase<false>(F, args, Z, args.in[25], args.in[26], XH, nullptr); if (BOTH(10) || rep_ + 1 < REPS(10)) GRID_BAR(); }
    if (IN(11)) for (int rep_ = 0; rep_ < REPS(11); ++rep_) { relaunder(F);
        pg8::Gemm g{XH, (const bf16*)(ws + WS_W_DSA_IN), NTOK, DSA_NPAD, DM}; pg8::StaticOrder S; S.init(NTOK, DSA_NPAD, F.G, (int)blockIdx.x);
        pg8::EpiDsaIn E{(bf16*)(ws + WS_Q), (float*)(ws + WS_CRAW), (bf16*)(ws + WS_QI), (float*)(ws + WS_KIWI), 0.125f};
        pg8::gemm_phase<pg8::EpiDsaIn, pg8::StaticOrder, true, true>(F.lds + RING_OFF, g, S, E);
        if (BOTH(11) || rep_ + 1 < REPS(11)) GRID_BAR();
    }
    if (IN(12)) for (int rep_ = 0; rep_ < REPS(12); ++rep_) { relaunder(F); p10_dsa_prep(F, args); if (BOTH(12) || rep_ + 1 < REPS(12)) GRID_BAR(); }
    if (IN(13)) for (int rep_ = 0; rep_ < REPS(13); ++rep_) { relaunder(F); p13a_dsa_index(F, args); __syncthreads(); }
    if (IN(14)) for (int rep_ = 0; rep_ < REPS(14); ++rep_) { relaunder(F); p13b_dsa_attn(F, args); if (BOTH(14) || rep_ + 1 < REPS(14)) GRID_BAR(); }
    if (IN(15)) for (int rep_ = 0; rep_ < REPS(15); ++rep_) { relaunder(F); p12_dsa_uv(F, args); if (BOTH(15) || rep_ + 1 < REPS(15)) GRID_BAR(); }
    if (IN(16)) for (int rep_ = 0; rep_ < REPS(16); ++rep_) { relaunder(F);
        pg8::Gemm g{(const bf16*)(ws + WS_OATT1), (const bf16*)(ws + WS_W_DSA_OUT), NTOK, DM, DM}; pg8::StaticOrder S; S.init(NTOK, DM, F.G, (int)blockIdx.x);
        pg8::EpiResH E{XH, Z, ALPHA, DM};
        pg8::gemm_phase<pg8::EpiResH, pg8::StaticOrder, true, true>(F.lds + RING_OFF, g, S, E);
        if (BOTH(16) || rep_ + 1 < REPS(16)) GRID_BAR();
    }
    if (IN(17)) for (int rep_ = 0; rep_ < REPS(17); ++rep_) { relaunder(F); ln_route_phase(F, args, Z, args.in[23] + DM, args.in[24] + DM, XH); if (BOTH(17) || rep_ + 1 < REPS(17)) GRID_BAR(); }
    if (IN(18)) for (int rep_ = 0; rep_ < REPS(18); ++rep_) { relaunder(F); p15_gather(F, args); if (BOTH(18) || rep_ + 1 < REPS(18)) GRID_BAR(); }
    if (IN(19)) for (int rep_ = 0; rep_ < REPS(19); ++rep_) { relaunder(F);
        MoeTiles T; moe_tiles(F, T);
        pg8::Gemm g{(const bf16*)(ws + WS_XG), (const bf16*)(ws + WS_W_MOE_GU), T.MT * 256, 2 * DFFE, DM, 1, 0x79797979}; pg8::MoeOrder S; S.init(T.MT * 256, 2 * DFFE, F.G, (int)blockIdx.x); S.nexp_rows = 2 * DFFE;
#pragma unroll
        for (int e = 0; e < 8; ++e) S.tend[e] = T.tend[e];
        pg8::EpiSwiGLU8 E{(unsigned char*)(ws + WS_HM), DFFE};
        pg8::gemm_phase<pg8::EpiSwiGLU8, pg8::MoeOrder, true, true, true>(F.lds + RING_OFF, g, S, E);
        if (BOTH(19) || rep_ + 1 < REPS(19)) GRID_BAR();
    }
    if (IN(20)) for (int rep_ = 0; rep_ < REPS(20); ++rep_) { relaunder(F);
        MoeTiles T; moe_tiles(F, T);
        pg8::Gemm g{(const bf16*)(ws + WS_HM), (const bf16*)(ws + WS_W_MOE_DN), T.MT * 256, DM, DFFE, 1, 0x77777777}; pg8::MoeOrder S; S.init(T.MT * 256, DM, F.G, (int)blockIdx.x); S.nexp_rows = DM;
#pragma unroll
        for (int e = 0; e < 8; ++e) S.tend[e] = T.tend[e];
        pg8::EpiBf16Plain E{(bf16*)(ws + WS_Y), DM};
        pg8::gemm_phase<pg8::EpiBf16Plain, pg8::MoeOrder, true, true, true>(F.lds + RING_OFF, g, S, E);
        if (BOTH(20) || rep_ + 1 < REPS(20)) GRID_BAR();
    }
    if (IN(21)) for (int rep_ = 0; rep_ < REPS(21); ++rep_) { relaunder(F); p18_final(F, args); }
#undef IN
#undef BOTH
}

extern "C" void kernel_launch(void* const* d_in, const int* in_sizes, int n_in, void* d_out, int out_size, void* d_ws, size_t ws_size, hipStream_t stream) {
    static int grid = 0;
    if (grid == 0) {
        if (n_in != 27 || out_size != NTOK * DM || ws_size < WS_END) { fprintf(stderr, "kernel_launch: unexpected shapes (n_in %d, out %d, ws %zu); nothing launched\n", n_in, out_size, ws_size); grid = -1; return; }
        int dev = 0, cus = 0, per_cu = 0;
        if (hipGetDevice(&dev) != hipSuccess || hipDeviceGetAttribute(&cus, hipDeviceAttributeMultiprocessorCount, dev) != hipSuccess) { grid = -1; return; }
        if (hipFuncSetAttribute((const void*)mega_fwd, hipFuncAttributeMaxDynamicSharedMemorySize, LDS_BYTES) != hipSuccess) { fprintf(stderr, "kernel_launch: hipFuncSetAttribute failed\n"); grid = -1; return; }
        if (hipOccupancyMaxActiveBlocksPerMultiprocessor(&per_cu, (const void*)mega_fwd, NWAVES * 64, LDS_BYTES) != hipSuccess || per_cu < 1) { fprintf(stderr, "kernel_launch: occupancy query says %d\n", per_cu); }
        (void)hipGetLastError();
        grid = cus;
    }
    if (grid < 0) return;
    if (hipMemsetAsync((char*)d_ws + WS_CTL, 0, CTL_ZERO_BYTES, stream) != hipSuccess) return;
    Args a{};
    for (int i = 0; i < 27; ++i) a.in[i] = (const float*)d_in[i];
    a.out = (float*)d_out; a.ws = (unsigned char*)d_ws;
#if MK_PER_PHASE
    for (int p = 0; p < NPHASE; ++p) { a.ph_lo = p; a.ph_hi = p + 1; hipLaunchKernelGGL(mega_fwd, dim3(grid), dim3(NWAVES * 64), LDS_BYTES, stream, a); }
#else
    a.ph_lo = 0; a.ph_hi = NPHASE;
    hipLaunchKernelGGL(mega_fwd, dim3(grid), dim3(NWAVES * 64), LDS_BYTES, stream, a);
#endif
}
```

```cpp
#include <hip/hip_runtime.h>
#include <cstdio>
#include <cstdint>
namespace pg8 {
#define PG8_LAS __attribute__((address_space(3)))
typedef unsigned short bf16_t;
typedef short bf16x8 __attribute__((ext_vector_type(8)));
typedef float f32x4 __attribute__((ext_vector_type(4)));
typedef unsigned u32x4 __attribute__((ext_vector_type(4)));
constexpr int BM = 256, BK = 64, HALF = 128, HTB = HALF * BK * 2  , STAGE_BYTES = 8 * HTB, NXCD = 8, WGM = 8;

__host__ __device__ __forceinline__ int lds_byte(int r, int c) { const int st = (r >> 4) * 2 + (c >> 5), rr = r & 15, cc = c & 31, ob = rr * 64 + cc * 2; return st * 1024 + (ob ^ (((ob >> 9) & 1) << 5)); }
__host__ __device__ __forceinline__ void stage_rc(int b, int& R, int& C) { const int st = b / 1024, sb = b % 1024, swz = sb ^ (((sb >> 9) & 1) << 5); R = (st >> 1) * 16 + swz / 64; C = (st & 1) * 32 + (swz % 64) / 2; }
__host__ __device__ __forceinline__ int perm32(int rho) { const int n = rho >> 4, i = rho & 15; return 8 * (i >> 2) + 4 * n + (i & 3); }

struct Unit { int pm, pn; };
struct Gemm { const bf16_t* A; const bf16_t* Bt; int M, N, K; int esz = 2; int scale = 0x7f7f7f7f; int lda = 0; };

struct StaticOrder {
    int nM, nN, nwg, G, c;
    __host__ __device__ void init(int M, int N, int G_, int c_) { nM = M / BM; nN = N / BM; nwg = nM * nN; G = G_; c = c_; }
    __host__ __device__ bool next(int i, Unit& u) const {
        const long L = (long)i * G + c; if (L >= nwg) return false;
        int wgid = (int)L; { const int q = nwg / NXCD, r = nwg % NXCD, xcd = wgid % NXCD, off = wgid / NXCD; wgid = (xcd < r ? xcd * (q + 1) : r * (q + 1) + (xcd - r) * q) + off; }
        const int nig = WGM * nN, gid = wgid / nig, fm = gid * WGM, gsz = (nM - fm) < WGM ? (nM - fm) : WGM;
        u.pm = fm + ((wgid % nig) % gsz); u.pn = (wgid % nig) / gsz; return true;
    }
    __device__ __forceinline__ void a_ready(const Unit&) const {}
    __device__ __forceinline__ void done(const Unit&) const {}
    __device__ __forceinline__ const char* a_ptr(const Gemm& g, const Unit& u) const { return (const char*)g.A + (size_t)u.pm * ((size_t)BM * (g.lda ? g.lda : g.K) * g.esz); }
    __device__ __forceinline__ const char* b_ptr(const Gemm& g, const Unit& u) const { return (const char*)g.Bt + (size_t)u.pn * ((size_t)BM * g.K * g.esz); }
};


__device__ __forceinline__ unsigned cvt_pk_bf16(float lo, float hi) { unsigned r; asm volatile("v_cvt_pk_bf16_f32 %0, %1, %2" : "=v"(r) : "v"(lo), "v"(hi)); return r; }
__device__ __forceinline__ u32x4 pack8(const f32x4 v0, const f32x4 v1) { u32x4 w; w.x = cvt_pk_bf16(v0[0], v0[1]); w.y = cvt_pk_bf16(v0[2], v0[3]); w.z = cvt_pk_bf16(v1[0], v1[1]); w.w = cvt_pk_bf16(v1[2], v1[3]); return w; }

struct EpiNsaIn {
    static constexpr bool PERM = true, AFTER_DRAIN = false;
    bf16_t* P0; float* GL; float qscale;
    __device__ __forceinline__ void operator()(const f32x4 (&acc)[2][2][4][2], const Unit& u, int wr, int wc, int fr, int fq) const {
        const int row0 = u.pm * BM + wr * 64 + fr;
        if (u.pn < 20) {
            const float s = u.pn < 8 ? qscale : 1.0f;
            const int col0 = u.pn * BM + wc * 32 + 8 * fq;
#pragma unroll
            for (int ai = 0; ai < 2; ++ai)
#pragma unroll
                for (int m = 0; m < 4; ++m) { bf16_t* rowp = P0 + (size_t)(row0 + ai * HALF + m * 16) * 5120 + col0;
#pragma unroll
                    for (int bj = 0; bj < 2; ++bj) *(u32x4*)(rowp + bj * HALF) = pack8(acc[ai][bj][m][0] * s, acc[ai][bj][m][1] * s); }
        } else {
            const int c = wc * 32 + 8 * fq;
            if (c < 48) {
#pragma unroll
                for (int ai = 0; ai < 2; ++ai)
#pragma unroll
                    for (int m = 0; m < 4; ++m) { float* gp = GL + (size_t)(row0 + ai * HALF + m * 16) * 48 + c;
                        *(f32x4*)gp = acc[ai][0][m][0]; *(f32x4*)(gp + 4) = acc[ai][0][m][1]; }
            }
        }
    }
};
struct EpiDsaIn {
    static constexpr bool PERM = true, AFTER_DRAIN = false;
    bf16_t* Q; float* CRAW; bf16_t* QI; float* KIWI; float qiscale;
    __device__ __forceinline__ void operator()(const f32x4 (&acc)[2][2][4][2], const Unit& u, int wr, int wc, int fr, int fq) const {
        const int row0 = u.pm * BM + wr * 64 + fr; const int c = wc * 32 + 8 * fq;
        if (u.pn < 8) {
#pragma unroll
            for (int ai = 0; ai < 2; ++ai)
#pragma unroll
                for (int m = 0; m < 4; ++m) { bf16_t* rowp = Q + (size_t)(row0 + ai * HALF + m * 16) * 2048 + u.pn * BM + c;
#pragma unroll
                    for (int bj = 0; bj < 2; ++bj) *(u32x4*)(rowp + bj * HALF) = pack8(acc[ai][bj][m][0], acc[ai][bj][m][1]); }
        } else if (u.pn == 8) {
#pragma unroll
            for (int ai = 0; ai < 2; ++ai)
#pragma unroll
                for (int m = 0; m < 4; ++m) { float* rowp = CRAW + (size_t)(row0 + ai * HALF + m * 16) * 256 + c;
#pragma unroll
                    for (int bj = 0; bj < 2; ++bj) { *(f32x4*)(rowp + bj * HALF) = acc[ai][bj][m][0]; *(f32x4*)(rowp + bj * HALF + 4) = acc[ai][bj][m][1]; } }
        } else if (u.pn < 11) {
#pragma unroll
            for (int ai = 0; ai < 2; ++ai)
#pragma unroll
                for (int m = 0; m < 4; ++m) { bf16_t* rowp = QI + (size_t)(row0 + ai * HALF + m * 16) * 512 + (u.pn - 9) * BM + c;
#pragma unroll
                    for (int bj = 0; bj < 2; ++bj) *(u32x4*)(rowp + bj * HALF) = pack8(acc[ai][bj][m][0] * qiscale, acc[ai][bj][m][1] * qiscale); }
        } else {
#pragma unroll
            for (int ai = 0; ai < 2; ++ai)
#pragma unroll
                for (int m = 0; m < 4; ++m) { float* rowp = KIWI + (size_t)(row0 + ai * HALF + m * 16) * 128 + c;
                    *(f32x4*)rowp = acc[ai][0][m][0]; *(f32x4*)(rowp + 4) = acc[ai][0][m][1]; }
        }
    }
};
struct EpiResF32 {
    static constexpr bool PERM = true, AFTER_DRAIN = false;
    const float* R; bf16_t* Z; float alpha; int ldc;
    __device__ __forceinline__ void operator()(const f32x4 (&acc)[2][2][4][2], const Unit& u, int wr, int wc, int fr, int fq) const {
        const int row0 = u.pm * BM + wr * 64 + fr, col0 = u.pn * BM + wc * 32 + 8 * fq;
#pragma unroll
        for (int ai = 0; ai < 2; ++ai)
#pragma unroll
            for (int m = 0; m < 4; ++m) { const size_t off = (size_t)(row0 + ai * HALF + m * 16) * ldc + col0;
#pragma unroll
                for (int bj = 0; bj < 2; ++bj) { const f32x4 r0 = *(const f32x4*)(R + off + bj * HALF), r1 = *(const f32x4*)(R + off + bj * HALF + 4);
                    *(u32x4*)(Z + off + bj * HALF) = pack8(r0 * alpha + acc[ai][bj][m][0], r1 * alpha + acc[ai][bj][m][1]); } }
    }
};
struct EpiResH {
    static constexpr bool PERM = true, AFTER_DRAIN = false;
    const bf16_t* R; bf16_t* Z; float alpha; int ldc;
    __device__ __forceinline__ void operator()(const f32x4 (&acc)[2][2][4][2], const Unit& u, int wr, int wc, int fr, int fq) const {
        const int row0 = u.pm * BM + wr * 64 + fr, col0 = u.pn * BM + wc * 32 + 8 * fq;
#pragma unroll
        for (int ai = 0; ai < 2; ++ai)
#pragma unroll
            for (int m = 0; m < 4; ++m) { const size_t off = (size_t)(row0 + ai * HALF + m * 16) * ldc + col0;
#pragma unroll
                for (int bj = 0; bj < 2; ++bj) { const u32x4 rr = *(const u32x4*)(R + off + bj * HALF);
                    const f32x4 r0 = (f32x4){__uint_as_float(rr.x << 16), __uint_as_float(rr.x & 0xffff0000u), __uint_as_float(rr.y << 16), __uint_as_float(rr.y & 0xffff0000u)};
                    const f32x4 r1 = (f32x4){__uint_as_float(rr.z << 16), __uint_as_float(rr.z & 0xffff0000u), __uint_as_float(rr.w << 16), __uint_as_float(rr.w & 0xffff0000u)};
                    *(u32x4*)(Z + off + bj * HALF) = pack8(r0 * alpha + acc[ai][bj][m][0], r1 * alpha + acc[ai][bj][m][1]); } }
    }
};
struct EpiF32 {
    static constexpr bool PERM = false, AFTER_DRAIN = false;
    float* C; int ldc;
    __device__ __forceinline__ void operator()(const f32x4 (&acc)[2][2][4][2], const Unit& u, int wr, int wc, int fr, int fq) const {
        const int row0 = u.pm * BM + wr * 64 + fr, col0 = u.pn * BM + wc * 32 + 4 * fq;
#pragma unroll
        for (int ai = 0; ai < 2; ++ai)
#pragma unroll
            for (int m = 0; m < 4; ++m) { float* rowp = C + (size_t)(row0 + ai * HALF + m * 16) * ldc + col0;
#pragma unroll
                for (int bj = 0; bj < 2; ++bj)
#pragma unroll
                    for (int n = 0; n < 2; ++n) *(f32x4*)(rowp + bj * HALF + n * 16) = acc[ai][bj][m][n]; }
    }
};
struct EpiBf16Plain {
    static constexpr bool PERM = true, AFTER_DRAIN = false;
    bf16_t* C; int ldc;
    __device__ __forceinline__ void operator()(const f32x4 (&acc)[2][2][4][2], const Unit& u, int wr, int wc, int fr, int fq) const {
        const int row0 = u.pm * BM + wr * 64 + fr, col0 = u.pn * BM + wc * 32 + 8 * fq;
#pragma unroll
        for (int ai = 0; ai < 2; ++ai)
#pragma unroll
            for (int m = 0; m < 4; ++m) { bf16_t* rowp = C + (size_t)(row0 + ai * HALF + m * 16) * ldc + col0;
#pragma unroll
                for (int bj = 0; bj < 2; ++bj) *(u32x4*)(rowp + bj * HALF) = pack8(acc[ai][bj][m][0], acc[ai][bj][m][1]); }
    }
};
__device__ __forceinline__ float silu_mul(float g, float u) { return g * __builtin_amdgcn_rcpf(1.0f + __expf(-g)) * u; }
struct EpiSwiGLU {
    static constexpr bool PERM = true, AFTER_DRAIN = false;
    bf16_t* H; int ldh;
    __device__ __forceinline__ void operator()(const f32x4 (&acc)[2][2][4][2], const Unit& u, int wr, int wc, int fr, int fq) const {
        const int row0 = u.pm * BM + wr * 64 + fr, col0 = u.pn * HALF + wc * 32 + 8 * fq;
#pragma unroll
        for (int ai = 0; ai < 2; ++ai)
#pragma unroll
            for (int m = 0; m < 4; ++m) { bf16_t* rowp = H + (size_t)(row0 + ai * HALF + m * 16) * ldh + col0;
                f32x4 v0, v1;
#pragma unroll
                for (int j = 0; j < 4; ++j) { v0[j] = silu_mul(acc[ai][0][m][0][j], acc[ai][1][m][0][j]); v1[j] = silu_mul(acc[ai][0][m][1][j], acc[ai][1][m][1][j]); }
                *(u32x4*)rowp = pack8(v0, v1); }
    }
};
struct EpiSwiGLU8 {
    static constexpr bool PERM = true, AFTER_DRAIN = false;
    unsigned char* H; int ldh;
    __device__ __forceinline__ void operator()(const f32x4 (&acc)[2][2][4][2], const Unit& u, int wr, int wc, int fr, int fq) const {
        const int row0 = u.pm * BM + wr * 64 + fr, col0 = u.pn * HALF + wc * 32 + 8 * fq;
#pragma unroll
        for (int ai = 0; ai < 2; ++ai)
#pragma unroll
            for (int m = 0; m < 4; ++m) { unsigned char* rowp = H + (size_t)(row0 + ai * HALF + m * 16) * ldh + col0;
                float v[8];
#pragma unroll
                for (int j = 0; j < 4; ++j) { v[j] = silu_mul(acc[ai][0][m][0][j], acc[ai][1][m][0][j]); v[4 + j] = silu_mul(acc[ai][0][m][1][j], acc[ai][1][m][1][j]); }
                int w0 = __builtin_amdgcn_cvt_pk_fp8_f32(v[0], v[1], 0, false); w0 = __builtin_amdgcn_cvt_pk_fp8_f32(v[2], v[3], w0, true);
                int w1 = __builtin_amdgcn_cvt_pk_fp8_f32(v[4], v[5], 0, false); w1 = __builtin_amdgcn_cvt_pk_fp8_f32(v[6], v[7], w1, true);
                uint2 o; o.x = (unsigned)w0; o.y = (unsigned)w1; *(uint2*)rowp = o; }
    }
};
struct PairOrder : StaticOrder {
    int pn_shift, kslice;
    __device__ __forceinline__ const char* a_ptr(const Gemm& g, const Unit& u) const { return (const char*)g.A + ((size_t)u.pm * BM * g.lda + (size_t)(u.pn >> pn_shift) * kslice) * 2; }
};
struct EpiBf16Scale {
    static constexpr bool PERM = true, AFTER_DRAIN = false;
    bf16_t* C; int ldc; float scale;
    __device__ __forceinline__ void operator()(const f32x4 (&acc)[2][2][4][2], const Unit& u, int wr, int wc, int fr, int fq) const {
        const int row0 = u.pm * BM + wr * 64 + fr, col0 = u.pn * BM + wc * 32 + 8 * fq;
#pragma unroll
        for (int ai = 0; ai < 2; ++ai)
#pragma unroll
            for (int m = 0; m < 4; ++m) { bf16_t* rowp = C + (size_t)(row0 + ai * HALF + m * 16) * ldc + col0;
#pragma unroll
                for (int bj = 0; bj < 2; ++bj) *(u32x4*)(rowp + bj * HALF) = pack8(acc[ai][bj][m][0] * scale, acc[ai][bj][m][1] * scale); }
    }
};
struct MoeOrder : StaticOrder {
    int tend[8]; int nexp_rows;
    __device__ __forceinline__ int expert(int pm) const { int e = 0;
#pragma unroll
        for (int i = 0; i < 7; ++i) e += (pm >= tend[i]) ? 1 : 0; return e; }
    __device__ __forceinline__ const char* b_ptr(const Gemm& g, const Unit& u) const { return (const char*)g.Bt + ((size_t)expert(u.pm) * nexp_rows + (size_t)u.pn * BM) * ((size_t)g.K * g.esz); }
};
typedef int i32x8 __attribute__((ext_vector_type(8)));
typedef int i32x4 __attribute__((ext_vector_type(4)));
__device__ __forceinline__ i32x8 cat8(bf16x8 lo, bf16x8 hi) { const i32x4 a = *reinterpret_cast<const i32x4*>(&lo), b = *reinterpret_cast<const i32x4*>(&hi); return __builtin_shufflevector(a, b, 0, 1, 2, 3, 4, 5, 6, 7); }
template <class Epi, class Sched, bool ALIGN_EPI = false, bool SP2 = false, bool FP8 = false>
__device__ __forceinline__ void gemm_phase(PG8_LAS unsigned char* lds, const Gemm g, const Sched& S, const Epi& E) {
    int tid = threadIdx.x; asm volatile("" : "+v"(tid));
    const int wid = __builtin_amdgcn_readfirstlane(tid >> 6), lane = tid & 63, wr = wid >> 2, wc = wid & 3, fr = lane & 15, fq = lane >> 4;
    const int K = g.K, nt = K / (FP8 ? 2 * BK : BK), LDA = g.lda ? g.lda : g.K;
    unsigned voffA[2], voffB[2];
#pragma unroll
    for (int i = 0; i < 2; ++i) { int R, C; stage_rc(tid * 16 + i * 8192, R, C); const int Rb = Epi::PERM ? ((R & ~31) + perm32(R & 31)) : R;
        voffA[i] = FP8 ? (unsigned)(R * LDA + C * 2) : (unsigned)(R * LDA + C) * 2u; voffB[i] = FP8 ? (unsigned)(Rb * K + C * 2) : (unsigned)(Rb * K + C) * 2u; }
    const size_t kstep = (size_t)(BK * 2);
    const size_t hstep = (size_t)HALF * K * (FP8 ? 1 : 2), hstepA = (size_t)HALF * LDA * (FP8 ? 1 : 2);
    const size_t tstep = 2 * hstep;
    const unsigned ldsw = (unsigned)wid * 1024u;
    const int aoff = lds_byte(wr * 64 + fr, fq * 8), boff = lds_byte(wc * 32 + fr, fq * 8);
#define PG8_SA(b, h) (((b) * 2 + (h)) * HTB)
#define PG8_SB(b, h) ((4 + (b) * 2 + (h)) * HTB)
#define PG8_STAGE(bufoff, gbase, voff) do { _Pragma("unroll") for (int _i = 0; _i < 2; ++_i) \
        __builtin_amdgcn_global_load_lds((const unsigned*)((const char*)(gbase) + (voff)[_i]), (PG8_LAS unsigned*)(lds + (bufoff) + ldsw + _i * 8192), 16, 0, 0); } while (0)
#define PG8_LDA(dst, b, h) do { _Pragma("unroll") for (int m = 0; m < 4; ++m) { if constexpr (FP8) { const i32x4 lo_ = *(const PG8_LAS i32x4*)(lds + PG8_SA(b, h) + aoff + m * 2048), hi_ = *(const PG8_LAS i32x4*)(lds + PG8_SA(b, h) + aoff + m * 2048 + 1024); dst##8[m] = __builtin_shufflevector(lo_, hi_, 0, 1, 2, 3, 4, 5, 6, 7); } else { _Pragma("unroll") for (int k = 0; k < 2; ++k) dst[m][k] = *(const PG8_LAS bf16x8*)(lds + PG8_SA(b, h) + aoff + m * 2048 + k * 1024); } } } while (0)
#define PG8_LDB(dst, b, h) do { _Pragma("unroll") for (int n = 0; n < 2; ++n) { if constexpr (FP8) { const i32x4 lo_ = *(const PG8_LAS i32x4*)(lds + PG8_SB(b, h) + boff + n * 2048), hi_ = *(const PG8_LAS i32x4*)(lds + PG8_SB(b, h) + boff + n * 2048 + 1024); dst##8[n] = __builtin_shufflevector(lo_, hi_, 0, 1, 2, 3, 4, 5, 6, 7); } else { _Pragma("unroll") for (int k = 0; k < 2; ++k) dst[n][k] = *(const PG8_LAS bf16x8*)(lds + PG8_SB(b, h) + boff + n * 2048 + k * 1024); } } } while (0)
#define PG8_MMA(ai, bj, At, Bt) do { __builtin_amdgcn_s_setprio(1); _Pragma("unroll") for (int m = 0; m < 4; ++m) _Pragma("unroll") for (int n = 0; n < 2; ++n) { \
        if constexpr (FP8) { asm volatile("v_mfma_scale_f32_16x16x128_f8f6f4 %0, %1, %2, %0, %3, %4 op_sel_hi:[0,0,0]" : "+v"(acc[ai][bj][m][n]) : "v"(Bt##8[n]), "v"(At##8[m]), "v"(sclA), "v"(sclB)); } \
        else { _Pragma("unroll") for (int k = 0; k < 2; ++k) acc[ai][bj][m][n] = __builtin_amdgcn_mfma_f32_16x16x32_bf16(Bt[n][k], At[m][k], acc[ai][bj][m][n], 0, 0, 0); } } __builtin_amdgcn_s_setprio(0); } while (0)
#define PG8_WAIT_V(n) asm volatile("s_waitcnt vmcnt(" #n ")" ::: "memory")
#define PG8_WAIT_L(n) asm volatile("s_waitcnt lgkmcnt(" #n ")" ::: "memory")
#define PG8_BAR __builtin_amdgcn_s_barrier()
#define PG8_SCHED __builtin_amdgcn_sched_barrier(0)
    Unit cur, nxt; int ui = 0;
    if (!S.next(0, cur)) return;
    f32x4 acc[2][2][4][2];
#pragma unroll
    for (int a = 0; a < 2; ++a)
#pragma unroll
        for (int b = 0; b < 2; ++b)
#pragma unroll
            for (int m = 0; m < 4; ++m)
#pragma unroll
                for (int n = 0; n < 2; ++n) acc[a][b][m][n] = (f32x4){0.f, 0.f, 0.f, 0.f};
    bf16x8 At[4][2], B0[2][2], B1[2][2]; i32x8 At8[4], B08[2], B18[2]; const int sclA = g.scale, sclB = 0x7f7f7f7f;
    const char* cA = S.a_ptr(g, cur); const char* cB = S.b_ptr(g, cur);
    S.a_ready(cur);
    if constexpr (SP2) {
        PG8_STAGE(PG8_SB(0, 0), cB, voffB); PG8_STAGE(PG8_SB(0, 1), cB + hstep, voffB); PG8_STAGE(PG8_SA(0, 0), cA, voffA); PG8_STAGE(PG8_SA(0, 1), cA + hstepA, voffA);
        if (wr == 1) PG8_BAR;
        PG8_WAIT_V(2); PG8_BAR;
        PG8_STAGE(PG8_SB(1, 0), cB + kstep, voffB); PG8_STAGE(PG8_SA(1, 0), cA + kstep, voffA); PG8_STAGE(PG8_SB(1, 1), cB + hstep + kstep, voffB);
        PG8_WAIT_V(6); PG8_BAR;
    } else {
        PG8_STAGE(PG8_SB(0, 0), cB, voffB); PG8_STAGE(PG8_SA(0, 0), cA, voffA); PG8_STAGE(PG8_SB(0, 1), cB + hstep, voffB); PG8_STAGE(PG8_SA(0, 1), cA + hstepA, voffA);
        if (wr == 1) PG8_BAR;
        PG8_WAIT_V(4); PG8_BAR;
        PG8_STAGE(PG8_SB(1, 0), cB + kstep, voffB); PG8_STAGE(PG8_SA(1, 0), cA + kstep, voffA); PG8_STAGE(PG8_SB(1, 1), cB + hstep + kstep, voffB);
        PG8_WAIT_V(6); PG8_BAR;
    }
    for (;;) {
        const bool has_next = S.next(ui + 1, nxt);
        const char* nA = has_next ? S.a_ptr(g, nxt) : cA; const char* nB = has_next ? S.b_ptr(g, nxt) : cB;
        for (int t = 0; t < nt; t += 2) {
            const bool last = (t == nt - 2);
            const char* a1 = cA + (size_t)(t + 1) * kstep;
            const char* a2 = last ? nA : cA + (size_t)(t + 2) * kstep; const char* b2 = last ? nB : cB + (size_t)(t + 2) * kstep;
            const char* a3 = a2 + kstep; const char* b3 = b2 + kstep;
            if (last && has_next) S.a_ready(nxt);
            if constexpr (SP2) {
            PG8_LDB(B0, 0, 0); PG8_LDB(B1, 0, 1); PG8_SCHED; PG8_LDA(At, 0, 0); PG8_STAGE(PG8_SA(1, 1), a1 + hstepA, voffA);
            PG8_WAIT_V(8); PG8_WAIT_L(0); PG8_BAR; PG8_MMA(0, 0, At, B0); PG8_MMA(0, 1, At, B1); PG8_BAR; PG8_SCHED;
            PG8_LDA(At, 0, 1); PG8_STAGE(PG8_SB(0, 0), b2, voffB); PG8_STAGE(PG8_SB(0, 1), b2 + hstep, voffB); PG8_STAGE(PG8_SA(0, 0), a2, voffA);
            PG8_WAIT_V(8); PG8_WAIT_L(0); PG8_BAR; PG8_MMA(1, 0, At, B0); PG8_MMA(1, 1, At, B1); PG8_BAR; PG8_SCHED;
            PG8_LDB(B0, 1, 0); PG8_LDB(B1, 1, 1); PG8_SCHED; PG8_LDA(At, 1, 0); PG8_STAGE(PG8_SA(0, 1), a2 + hstepA, voffA);
            PG8_WAIT_V(8); PG8_WAIT_L(0); PG8_BAR; PG8_MMA(0, 0, At, B0); PG8_MMA(0, 1, At, B1); PG8_BAR; PG8_SCHED;
            PG8_LDA(At, 1, 1); PG8_STAGE(PG8_SB(1, 0), b3, voffB); PG8_STAGE(PG8_SB(1, 1), b3 + hstep, voffB); PG8_STAGE(PG8_SA(1, 0), a3, voffA);
            PG8_WAIT_V(8); PG8_WAIT_L(0); PG8_BAR; PG8_MMA(1, 0, At, B0); PG8_MMA(1, 1, At, B1); PG8_BAR; PG8_SCHED;
            } else {
            PG8_LDB(B0, 0, 0); PG8_SCHED; PG8_LDA(At, 0, 0); PG8_STAGE(PG8_SA(1, 1), a1 + hstepA, voffA);
            PG8_WAIT_L(8); PG8_BAR; PG8_WAIT_L(0); PG8_MMA(0, 0, At, B0); PG8_BAR; PG8_SCHED;
            PG8_LDB(B1, 0, 1); PG8_STAGE(PG8_SB(0, 0), b2, voffB);
            PG8_BAR; PG8_WAIT_L(0); PG8_MMA(0, 1, At, B1); PG8_BAR;
            PG8_LDA(At, 0, 1); PG8_STAGE(PG8_SA(0, 0), a2, voffA);
            PG8_BAR; PG8_WAIT_L(0); PG8_MMA(1, 0, At, B0); PG8_BAR; PG8_SCHED;
            PG8_STAGE(PG8_SB(0, 1), b2 + hstep, voffB);
            PG8_WAIT_V(6); PG8_BAR; PG8_MMA(1, 1, At, B1); PG8_BAR;
            PG8_LDB(B0, 1, 0); PG8_SCHED; PG8_LDA(At, 1, 0); PG8_STAGE(PG8_SA(0, 1), a2 + hstepA, voffA);
            PG8_WAIT_L(8); PG8_BAR; PG8_WAIT_L(0); PG8_MMA(0, 0, At, B0); PG8_BAR; PG8_SCHED;
            PG8_LDB(B1, 1, 1); PG8_STAGE(PG8_SB(1, 0), b3, voffB);
            PG8_BAR; PG8_WAIT_L(0); PG8_MMA(0, 1, At, B1); PG8_BAR;
            PG8_LDA(At, 1, 1); PG8_STAGE(PG8_SA(1, 0), a3, voffA);
            PG8_BAR; PG8_WAIT_L(0); PG8_MMA(1, 0, At, B0); PG8_BAR; PG8_SCHED;
            PG8_STAGE(PG8_SB(1, 1), b3 + hstep, voffB);
            PG8_WAIT_V(6); PG8_BAR; PG8_MMA(1, 1, At, B1); PG8_BAR;
            }
        }
        if constexpr (FP8) asm volatile("s_nop 15\n\ts_nop 15" ::: "memory");
        if constexpr (ALIGN_EPI) { if (wr == 0) PG8_BAR; }
        if constexpr (!Epi::AFTER_DRAIN) { E(acc, cur, wr, wc, fr, fq); S.done(cur); }
        if (!has_next) break;
#pragma unroll
        for (int a = 0; a < 2; ++a)
#pragma unroll
            for (int b = 0; b < 2; ++b)
#pragma unroll
                for (int m = 0; m < 4; ++m)
#pragma unroll
                    for (int n = 0; n < 2; ++n) acc[a][b][m][n] = (f32x4){0.f, 0.f, 0.f, 0.f};
        cur = nxt; cA = nA; cB = nB; ++ui;
        if constexpr (ALIGN_EPI) { if (wr == 1) PG8_BAR; }
    }
    PG8_WAIT_V(0);
    if constexpr (!ALIGN_EPI) { if (wr == 0) PG8_BAR; }
    PG8_BAR;
    if constexpr (Epi::AFTER_DRAIN) { E.fused(acc, cur, wr, wc, fr, fq, lds, wid, lane); S.done(cur); }
#undef PG8_SA
#undef PG8_SB
#undef PG8_STAGE
#undef PG8_LDA
#undef PG8_LDB
#undef PG8_MMA
#undef PG8_WAIT_V
#undef PG8_WAIT_L
#undef PG8_BAR
#undef PG8_SCHED
}
}
#define GAS __attribute__((address_space(1)))
#define LAS __attribute__((address_space(3)))
typedef unsigned short bf16;
typedef unsigned v4u __attribute__((ext_vector_type(4)));
typedef float f32x4 __attribute__((ext_vector_type(4)));
typedef short bf16x8 __attribute__((ext_vector_type(8)));
typedef GAS unsigned gu32;
typedef GAS unsigned long long gu64;
#define RLX_AGENT __ATOMIC_RELAXED, __HIP_MEMORY_SCOPE_AGENT
#define LDS_WAIT() asm volatile("s_waitcnt lgkmcnt(0)" ::: "memory")
#define VM_WAIT() asm volatile("s_waitcnt vmcnt(0)" ::: "memory")
__device__ __forceinline__ unsigned long long rt() { return __builtin_amdgcn_s_memrealtime(); }
__device__ __forceinline__ unsigned f2bf(float f) { unsigned u = __builtin_bit_cast(unsigned, f); return (u + 0x7fffu + ((u >> 16) & 1u)) >> 16; }
__device__ __forceinline__ unsigned pk2(float lo, float hi) { return f2bf(lo) | (f2bf(hi) << 16); }

#define XB_TMO      128
#define XB_XCNT(j)  (256  + 64 * (j))
#define XB_XSUB(j)  (1280 + 64 * (j))
#define XB_XGEN(j)  (2304 + 64 * (j))
#define XB_TOP      3328
#define XB_TOPGEN   3392
#define XCD_BAR_WORDS 3456
#define XB_SPIN_CAP (1u << 18)

__device__ __forceinline__ unsigned xb_ld(unsigned* p)              { return __hip_atomic_load(p, __ATOMIC_RELAXED, __HIP_MEMORY_SCOPE_AGENT); }
__device__ __forceinline__ unsigned xb_add(unsigned* p, unsigned v) { return __hip_atomic_fetch_add(p, v, __ATOMIC_RELAXED, __HIP_MEMORY_SCOPE_AGENT); }
__device__ __forceinline__ unsigned xb_xcc_id() { return (unsigned)__builtin_amdgcn_s_getreg((3 << 11) | 20) & 0xFu; }
#define XB_SPIN(cond, bar) do { unsigned _sp = 0; while (cond) { __builtin_amdgcn_s_sleep(1); \
    if ((++_sp & 255u) == 0u) { if (xb_ld(&(bar)[XB_TMO])) break; if (_sp > XB_SPIN_CAP) { atomicAdd(&(bar)[XB_TMO], 1u); break; } } } } while (0)

struct XcdBarrier {
    unsigned* bar; unsigned x;
    volatile LAS unsigned* st;
};

__device__ __forceinline__ XcdBarrier xcd_barrier_post(unsigned* bar, volatile LAS unsigned* st) {
    XcdBarrier b; b.bar = bar; b.x = xb_xcc_id(); b.st = st;
    if (threadIdx.x == 0) (void)xb_add(&bar[XB_XCNT(b.x)], 1u);
    return b;
}
__device__ __forceinline__ void xcd_barrier_complete(unsigned* bar, unsigned x, unsigned& nloc, unsigned& nx) {
    const unsigned G = gridDim.x * gridDim.y * gridDim.z;
    unsigned sum, cnt, mine, sp = 0u;
    for (;;) {
        sum = 0u; cnt = 0u; mine = 0u;
#pragma unroll
        for (unsigned j = 0; j < 16; ++j) { const unsigned c = xb_ld(&bar[XB_XCNT(j)]); sum += c; cnt += (c > 0u) ? 1u : 0u; mine = (j == x) ? c : mine; }
        if (sum == G) break;
        __builtin_amdgcn_s_sleep(1);
        if ((++sp & 255u) == 0u) { if (xb_ld(&bar[XB_TMO])) break; if (sp > XB_SPIN_CAP) { atomicAdd(&bar[XB_TMO], 1u); break; } }
    }
    nloc = mine > 0u ? mine : 1u; nx = cnt > 0u ? cnt : 1u;
}

__device__ __forceinline__ void xcd_barrier(const XcdBarrier& b) {
    asm volatile("s_waitcnt vmcnt(0)" ::: "memory");
    __syncthreads();
    if (threadIdx.x == 0) {
        unsigned* bar = b.bar;
        __builtin_amdgcn_s_waitcnt(0);
        unsigned nloc = b.st[0], nx = b.st[1];
        if (nloc == 0u) { xcd_barrier_complete(bar, b.x, nloc, nx); b.st[0] = nloc; b.st[1] = nx; }
        const unsigned old = xb_add(&bar[XB_XSUB(b.x)], 1u);
        const unsigned gen = old / nloc;
        if (old + 1u == (gen + 1u) * nloc) {
            __builtin_amdgcn_fence(__ATOMIC_RELEASE, "agent");
            asm volatile("s_waitcnt vmcnt(0)" ::: "memory");
            const unsigned og = xb_add(&bar[XB_TOP], 1u);
            const unsigned tg = og / nx;
            if (og + 1u == (tg + 1u) * nx) xb_add(&bar[XB_TOPGEN], 1u);
            else XB_SPIN(xb_ld(&bar[XB_TOPGEN]) == tg, bar);
            __builtin_amdgcn_fence(__ATOMIC_ACQUIRE, "agent");
            xb_add(&bar[XB_XGEN(b.x)], 1u);
            asm volatile("s_waitcnt vmcnt(0)" ::: "memory");
        } else {
            XB_SPIN(xb_ld(&bar[XB_XGEN(b.x)]) == gen, bar);
            __builtin_amdgcn_fence(__ATOMIC_ACQUIRE, "agent");
            asm volatile("s_waitcnt vmcnt(0)" ::: "memory");
        }
    }
    __syncthreads();
}

constexpr int NWAVES = 8;
#ifndef MK_PER_PHASE
#define MK_PER_PHASE 0
#endif
constexpr int NPHASE = 22;

constexpr int BATCH = 2, SEQ = 8192, DM = 2048, NTOK = BATCH * SEQ, NH = 16, DH = 128;
constexpr int NSA_N = 5168, NSA_NPAD = 5376, P0LD = 5120;
constexpr int NCMP = 511, NSELB = 128;
constexpr int COL_KC = 2048, COL_VC = 2560, COL_KS = 3072, COL_VS = 3584, COL_KW = 4096, COL_VW = 4608;
constexpr int DSA_N = 2888, DSA_NPAD = 3072, KVR = 256, TOPK = 256;
constexpr int DFF = 5632, NEXP = 8, DFFE = 7168, MOE_ROWS = 34816;
constexpr float ALPHA = 1.41421356237309515f, LN_EPS = 1e-5f, RMS_EPS = 1e-6f;

constexpr size_t MiB = (size_t)1 << 20;
constexpr size_t WS_CTL = 0, CTL_ZERO_BYTES = 128 * 1024;
constexpr size_t WS_W_NSA_IN = 2 * MiB, WS_W_NSA_OUT = 23 * MiB, WS_W_FFN_GU = 31 * MiB, WS_W_FFN_DN = 75 * MiB, WS_W_DSA_IN = 97 * MiB, WS_W_DSA_OUT = 109 * MiB;
constexpr size_t WS_W_CMPK = 117 * MiB, WS_W_CMPV = 118 * MiB, WS_W_UK = 181 * MiB, WS_W_UV = 183 * MiB, WS_CBIAS = 121 * MiB;
constexpr size_t WS_KCMP = 122 * MiB, WS_VCMP = 124 * MiB, WS_GL = 126 * MiB, WS_ROUTE = 129 * MiB;
constexpr size_t WS_KIB = 179 * MiB;
constexpr size_t WS_SELM = 178 * MiB;
constexpr size_t WS_CRAW = 130 * MiB, WS_KIWI = 146 * MiB, WS_IDX = 154 * MiB, WS_CN = 170 * MiB;
constexpr size_t WS_W_MOE_GU = 192 * MiB, WS_W_MOE_DN = 640 * MiB;
constexpr size_t WS_XB = 864 * MiB, WS_XF = 928 * MiB, WS_Z = 1056 * MiB;
constexpr size_t WS_P0 = 1184 * MiB, WS_OATT0 = 1344 * MiB, WS_HFF = 1408 * MiB;
constexpr size_t WS_Q = 1184 * MiB, WS_QI = 1248 * MiB, WS_QLAT = 1264 * MiB, WS_OLAT = 1392 * MiB, WS_OATT1 = 1520 * MiB;
constexpr size_t WS_XG = 1056 * MiB, WS_HM = 1192 * MiB, WS_Y = 192 * MiB;
constexpr size_t WS_END = 1668 * MiB;
static_assert(WS_HM + (size_t)MOE_ROWS * DFFE * 2 <= WS_END, "hm fits");
static_assert(WS_XG + (size_t)MOE_ROWS * DM * 2 <= WS_HM, "xg fits");
static_assert(WS_Y + (size_t)MOE_ROWS * DM * 4 <= WS_W_MOE_DN, "y overlays the dead gate/up weights only");
static_assert(WS_HFF + (size_t)NTOK * DFF * 2 <= WS_END, "hff fits");
constexpr int CW_TMO = 0, CW_CODE = 1;
constexpr int CW_BAR = 4096;
constexpr int CW_MOECNT = 16384;

constexpr int RING_OFF = 0, RING_BYTES = 131072;
constexpr int LDSCTL_OFF = RING_BYTES, MISC_OFF = LDSCTL_OFF + 320;
constexpr int LDS_BYTES = 163840;
constexpr int DSA_SCR = 133120;

struct Frame {
    LAS unsigned char* lds;
    volatile LAS unsigned* MISC;
    gu32* ctl;
    int tid, lane, wave, vcu, G;
};

__device__ __forceinline__ void relaunder(Frame& F) { int t = F.tid; asm volatile("" : "+v"(t)); F.tid = t; F.lane = t & 63; }
__device__ __forceinline__ float bf2f(unsigned short h) { return __uint_as_float(((unsigned)h) << 16); }
__device__ __forceinline__ float bflo(unsigned w) { return __uint_as_float(w << 16); }
__device__ __forceinline__ float bfhi(unsigned w) { return __uint_as_float(w & 0xffff0000u); }
__device__ __forceinline__ float dpp_xor1(float v) { return __int_as_float(__builtin_amdgcn_mov_dpp(__float_as_int(v), 0xB1, 0xF, 0xF, true)); }
__device__ __forceinline__ float dpp_xor2(float v) { return __int_as_float(__builtin_amdgcn_mov_dpp(__float_as_int(v), 0x4E, 0xF, 0xF, true)); }
__device__ __forceinline__ float sum_xor32(float v) { auto r = __builtin_amdgcn_permlane32_swap(__float_as_uint(v), __float_as_uint(v), false, false); return __uint_as_float(r[0]) + __uint_as_float(r[1]); }
__device__ __forceinline__ float max_xor32(float v) { auto r = __builtin_amdgcn_permlane32_swap(__float_as_uint(v), __float_as_uint(v), false, false); return fmaxf(__uint_as_float(r[0]), __uint_as_float(r[1])); }
__device__ __forceinline__ float sum_xor16(float v) { auto r = __builtin_amdgcn_permlane16_swap(__float_as_uint(v), __float_as_uint(v), false, false); return __uint_as_float(r[0]) + __uint_as_float(r[1]); }
__device__ __forceinline__ float max_xor16(float v) { auto r = __builtin_amdgcn_permlane16_swap(__float_as_uint(v), __float_as_uint(v), false, false); return fmaxf(__uint_as_float(r[0]), __uint_as_float(r[1])); }
__device__ __forceinline__ float wave_sum(float v) {
    v += dpp_xor1(v); v += dpp_xor2(v);
    v += __int_as_float(__builtin_amdgcn_mov_dpp(__float_as_int(v), 0x141, 0xF, 0xF, true));
    v += __int_as_float(__builtin_amdgcn_mov_dpp(__float_as_int(v), 0x140, 0xF, 0xF, true));
    return sum_xor32(sum_xor16(v));
}
__device__ __forceinline__ float wave_max(float v) {
    v = fmaxf(v, dpp_xor1(v)); v = fmaxf(v, dpp_xor2(v));
    v = fmaxf(v, __int_as_float(__builtin_amdgcn_mov_dpp(__float_as_int(v), 0x141, 0xF, 0xF, true)));
    v = fmaxf(v, __int_as_float(__builtin_amdgcn_mov_dpp(__float_as_int(v), 0x140, 0xF, 0xF, true)));
    return max_xor32(max_xor16(v));
}
#define WSYNC() do { __builtin_amdgcn_wave_barrier(); asm volatile("s_waitcnt lgkmcnt(0)" ::: "memory"); __builtin_amdgcn_wave_barrier(); } while (0)

__device__ __forceinline__ int rel_bucket(int n) {
    if (n < 16) return n;
    if (n >= 113) return 31;
    int b = 16;
    b += (n >= 19); b += (n >= 21); b += (n >= 24); b += (n >= 27); b += (n >= 31); b += (n >= 35); b += (n >= 40); b += (n >= 46);
    b += (n >= 52); b += (n >= 59); b += (n >= 67); b += (n >= 77); b += (n >= 87); b += (n >= 99);
    return b;
}

struct Args { const float* in[27]; float* out; unsigned char* ws; int ph_lo, ph_hi; };
#ifndef FFN_F8
#define FFN_F8 1
#endif
struct TrItem { const float* W; bf16* WT; int N, K, k0, n0, drow, kdoff; float f8scale; };
__device__ __forceinline__ void tr_set(TrItem& T, const float* W, int K, int N, int Npad, bf16* WT, int mode, int item, float f8scale = 0.f, int Kdst = 0, int kdoff = 0, int drow_off = 0) {
    T.f8scale = f8scale; T.kdoff = kdoff;
    const int nblk = Npad / 32, kb = item / nblk, nb = item - kb * nblk, n0 = 32 * nb;
    T.W = W; T.WT = WT; T.N = N; T.K = Kdst ? Kdst : K; T.k0 = 64 * kb; T.n0 = n0; T.drow = drow_off + ((mode == 0) ? n0 : ((n0 >> 7) * 256 + (mode - 1) * 128 + (n0 & 127)));
}
constexpr int TR_I_NSA_IN = (DM / 64) * (NSA_NPAD / 32), TR_I_SQ = (DM / 64) * (DM / 32), TR_I_FFN = (DM / 64) * (DFF / 32), TR_I_FFD = (DFF / 64) * (DM / 32), TR_I_DSA_IN = (DM / 64) * (DSA_NPAD / 32);
constexpr int TR_I_CMP = (4096 / 64) * (128 / 32), TR_I_UK1 = (128 / 64) * (256 / 32), TR_I_UV1 = (256 / 64) * (128 / 32);
constexpr int TR_I_MG1 = (DM / 64) * (DFFE / 32), TR_I_MD1 = (DFFE / 64) * (DM / 32);
constexpr int TR_NITEMS = TR_I_NSA_IN + 2 * TR_I_SQ + 2 * TR_I_FFN + TR_I_FFD + TR_I_DSA_IN + 2 * TR_I_CMP + 16 * TR_I_UK1 + 16 * TR_I_UV1 + 16 * TR_I_MG1 + 8 * TR_I_MD1;
__device__ __forceinline__ void tr_decode(const Args& A, unsigned char* ws, int it, TrItem& T) {
    int r = it;
    if (r < TR_I_NSA_IN) { tr_set(T, A.in[2], DM, NSA_N, NSA_NPAD, (bf16*)(ws + WS_W_NSA_IN), 0, r); return; } r -= TR_I_NSA_IN;
    if (r < TR_I_SQ) { tr_set(T, A.in[9], DM, DM, DM, (bf16*)(ws + WS_W_NSA_OUT), 0, r); return; } r -= TR_I_SQ;
    if (r < TR_I_SQ) { tr_set(T, A.in[14], DM, DM, DM, (bf16*)(ws + WS_W_DSA_OUT), 0, r); return; } r -= TR_I_SQ;
    if (r < TR_I_FFN) { tr_set(T, A.in[15], DM, DFF, DFF, (bf16*)(ws + WS_W_FFN_GU), 1, r, FFN_F8 ? 64.f : 0.f); return; } r -= TR_I_FFN;
    if (r < TR_I_FFN) { tr_set(T, A.in[16], DM, DFF, DFF, (bf16*)(ws + WS_W_FFN_GU), 2, r, FFN_F8 ? 64.f : 0.f); return; } r -= TR_I_FFN;
    if (r < TR_I_FFD) { tr_set(T, A.in[17], DFF, DM, DM, (bf16*)(ws + WS_W_FFN_DN), 0, r, FFN_F8 ? 256.f : 0.f); return; } r -= TR_I_FFD;
    if (r < TR_I_DSA_IN) { tr_set(T, A.in[10], DM, DSA_N, DSA_NPAD, (bf16*)(ws + WS_W_DSA_IN), 0, r); return; } r -= TR_I_DSA_IN;
    if (r < TR_I_CMP) { tr_set(T, A.in[4], 4096, 128, 128, (bf16*)(ws + WS_W_CMPK), 0, r); return; } r -= TR_I_CMP;
    if (r < TR_I_CMP) { tr_set(T, A.in[7], 4096, 128, 128, (bf16*)(ws + WS_W_CMPV), 0, r); return; } r -= TR_I_CMP;
    if (r < 16 * TR_I_UK1) { const int h = r / TR_I_UK1; tr_set(T, A.in[12] + (size_t)h * 128 * 256, 128, 256, 256, (bf16*)(ws + WS_W_UK), 0, r - h * TR_I_UK1, 0.f, 256, (h & 1) * 128, h * 256); return; } r -= 16 * TR_I_UK1;
    if (r < 16 * TR_I_UV1) { const int h = r / TR_I_UV1; tr_set(T, A.in[13] + (size_t)h * 256 * 128, 256, 128, 128, (bf16*)(ws + WS_W_UV), 0, r - h * TR_I_UV1, 0.f, 512, (h & 1) * 256, h * 128); return; } r -= 16 * TR_I_UV1;
    if (r < 8 * TR_I_MG1) { const int e = r / TR_I_MG1; tr_set(T, A.in[20] + (size_t)e * DM * DFFE, DM, DFFE, DFFE, (bf16*)(ws + WS_W_MOE_GU + (size_t)e * 2 * DFFE * DM), 1, r - e * TR_I_MG1, 64.f); return; } r -= 8 * TR_I_MG1;
    if (r < 8 * TR_I_MG1) { const int e = r / TR_I_MG1; tr_set(T, A.in[21] + (size_t)e * DM * DFFE, DM, DFFE, DFFE, (bf16*)(ws + WS_W_MOE_GU + (size_t)e * 2 * DFFE * DM), 2, r - e * TR_I_MG1, 64.f); return; } r -= 8 * TR_I_MG1;
    { const int e = r / TR_I_MD1; tr_set(T, A.in[22] + (size_t)e * DFFE * DM, DFFE, DM, DM, (bf16*)(ws + WS_W_MOE_DN + (size_t)e * DM * DFFE), 0, r - e * TR_I_MD1, 256.f); }
}
__device__ __forceinline__ void tr_load(const TrItem& T, f32x4 (&v)[8], int lane) {
    const int kr = lane >> 3, c4 = lane & 7, n = T.n0 + 4 * c4;
#pragma unroll
    for (int i = 0; i < 8; ++i) v[i] = (n < T.N) ? __builtin_nontemporal_load((const f32x4*)(T.W + (size_t)(T.k0 + 8 * i + kr) * T.N + n)) : (f32x4){0.f, 0.f, 0.f, 0.f};
}
__device__ __forceinline__ void tr_store(const TrItem& T, const f32x4 (&v)[8], LAS float* scr, int lane) {
    { const int kr = lane >> 3, c4 = lane & 7;
#pragma unroll
      for (int i = 0; i < 8; ++i) { LAS float* d = scr + (8 * i + kr) * 33 + 4 * c4; d[0] = v[i][0]; d[1] = v[i][1]; d[2] = v[i][2]; d[3] = v[i][3]; } }
    LDS_WAIT(); asm volatile("" ::: "memory");
    const int c = lane & 7;
#pragma unroll
    for (int j = 0; j < 4; ++j) { const int n = (lane >> 3) + 8 * j; const LAS float* s = scr + (8 * c) * 33 + n;
        v4u o; o.x = pg8::cvt_pk_bf16(s[0 * 33], s[1 * 33]); o.y = pg8::cvt_pk_bf16(s[2 * 33], s[3 * 33]); o.z = pg8::cvt_pk_bf16(s[4 * 33], s[5 * 33]); o.w = pg8::cvt_pk_bf16(s[6 * 33], s[7 * 33]);
        *(v4u*)(T.WT + (size_t)(T.drow + n) * T.K + T.kdoff + T.k0 + 8 * c) = o; }
    LDS_WAIT(); asm volatile("" ::: "memory");
}

__device__ __forceinline__ void tr_store8(const TrItem& T, const f32x4 (&v)[8], LAS float* scr, int lane) {
    { const int kr = lane >> 3, c4 = lane & 7;
#pragma unroll
      for (int i = 0; i < 8; ++i) { LAS float* d = scr + (8 * i + kr) * 33 + 4 * c4; d[0] = v[i][0]; d[1] = v[i][1]; d[2] = v[i][2]; d[3] = v[i][3]; } }
    LDS_WAIT(); asm volatile("" ::: "memory");
    const int c = lane & 3, nr = lane >> 2; const float sc = T.f8scale;
#pragma unroll
    for (int j = 0; j < 2; ++j) { const int n = nr + 16 * j; const LAS float* s = scr + (16 * c) * 33 + n; int w[4];
#pragma unroll
        for (int q = 0; q < 4; ++q) { w[q] = __builtin_amdgcn_cvt_pk_fp8_f32(s[(4 * q) * 33] * sc, s[(4 * q + 1) * 33] * sc, 0, false); w[q] = __builtin_amdgcn_cvt_pk_fp8_f32(s[(4 * q + 2) * 33] * sc, s[(4 * q + 3) * 33] * sc, w[q], true); }
        v4u o; o.x = (unsigned)w[0]; o.y = (unsigned)w[1]; o.z = (unsigned)w[2]; o.w = (unsigned)w[3];
        __builtin_nontemporal_store(o, (v4u*)((unsigned char*)T.WT + (size_t)(T.drow + n) * T.K + T.kdoff + T.k0 + 16 * c)); }
    LDS_WAIT(); asm volatile("" ::: "memory");
}
__device__ __forceinline__ void p0_prologue(Frame& F, const Args& A) {
    LAS float* scr = (LAS float*)(F.lds + RING_OFF + F.wave * 16384);
    unsigned char* ws = A.ws;
    const int gw = F.vcu * NWAVES + F.wave, NGW = F.G * NWAVES, lane = F.lane;
    {
        TrItem T0, T1, T2, T3; f32x4 v0[8], v1[8], v2[8], v3[8]; int it = gw;
#define TR_ISSUE(T, v, idx) do { if ((idx) < TR_NITEMS) { tr_decode(A, ws, (idx), T); tr_load(T, v, lane); } } while (0)
#define TR_RETIRE(T, v, idx) do { if ((idx) < TR_NITEMS) { if (T.f8scale != 0.f) tr_store8(T, v, scr, lane); else tr_store(T, v, scr, lane); } } while (0)
        TR_ISSUE(T0, v0, it); TR_ISSUE(T1, v1, it + NGW); TR_ISSUE(T2, v2, it + 2 * NGW);
        while (it < TR_NITEMS) {
            TR_ISSUE(T3, v3, it + 3 * NGW); TR_RETIRE(T0, v0, it);
            TR_ISSUE(T0, v0, it + 4 * NGW); TR_RETIRE(T1, v1, it + NGW);
            TR_ISSUE(T1, v1, it + 5 * NGW); TR_RETIRE(T2, v2, it + 2 * NGW);
            TR_ISSUE(T2, v2, it + 6 * NGW); TR_RETIRE(T3, v3, it + 3 * NGW);
            it += 4 * NGW;
        }
#undef TR_ISSUE
#undef TR_RETIRE
    }
    { const v4u z = {0u, 0u, 0u, 0u};
      for (int i = F.vcu * 512 + F.tid; i < 4096 * 16; i += F.G * 512) { const int n = i >> 4, ch = i & 15, h = n >> 8; *(v4u*)((bf16*)(ws + WS_W_UK) + (size_t)n * 256 + (1 - (h & 1)) * 128 + ch * 8) = z; }
      for (int i = F.vcu * 512 + F.tid; i < 2048 * 32; i += F.G * 512) { const int n = i >> 5, ch = i & 31, h = n >> 7; *(v4u*)((bf16*)(ws + WS_W_UV) + (size_t)n * 512 + (1 - (h & 1)) * 256 + ch * 8) = z; } }
    { const float* x = A.in[0]; bf16* xb = (bf16*)(ws + WS_XB); const size_t n8 = (size_t)NTOK * DM / 8;
      const size_t st = (size_t)F.G * 512;
      size_t i = (size_t)F.vcu * 512 + F.tid;
      for (; i + 3 * st < n8; i += 4 * st) { f32x4 a[4], b[4];
#pragma unroll
          for (int u = 0; u < 4; ++u) { a[u] = __builtin_nontemporal_load((const f32x4*)(x + (i + u * st) * 8)); b[u] = __builtin_nontemporal_load((const f32x4*)(x + (i + u * st) * 8 + 4)); }
#pragma unroll
          for (int u = 0; u < 4; ++u) { v4u o; o.x = pk2(a[u][0], a[u][1]); o.y = pk2(a[u][2], a[u][3]); o.z = pk2(b[u][0], b[u][1]); o.w = pk2(b[u][2], b[u][3]); *(v4u*)(xb + (i + u * st) * 8) = o; } }
      for (; i < n8; i += st) { const f32x4 a = *(const f32x4*)(x + i * 8), b = *(const f32x4*)(x + i * 8 + 4);
          v4u o; o.x = pk2(a[0], a[1]); o.y = pk2(a[2], a[3]); o.z = pk2(b[0], b[1]); o.w = pk2(b[2], b[3]); *(v4u*)(xb + i * 8) = o; } }
    for (int it = gw; it < 64; it += NGW) { const int kv = it >> 5, ch = it & 31; const float* pe = A.in[kv ? 6 : 3]; const float* w1 = A.in[kv ? 7 : 4];
        float s0 = 0.f, s1 = 0.f;
#pragma unroll 1
        for (int k0 = ch * 128; k0 < ch * 128 + 128; k0 += 32) { float pv[32], wa[32], wb[32];
#pragma unroll
            for (int j = 0; j < 32; ++j) { pv[j] = pe[k0 + j]; wa[j] = w1[(size_t)(k0 + j) * 128 + lane]; wb[j] = w1[(size_t)(k0 + j) * 128 + 64 + lane]; }
#pragma unroll
            for (int j = 0; j < 32; ++j) { s0 += pv[j] * wa[j]; s1 += pv[j] * wb[j]; } }
        float* cb = (float*)(ws + WS_CBIAS) + (size_t)(kv * 32 + ch) * 128; cb[lane] = s0; cb[64 + lane] = s1; }
}

typedef short s8v __attribute__((ext_vector_type(8)));
__device__ __forceinline__ s8v ld_frag(const bf16* p) { return *(const s8v*)p; }

__device__ __forceinline__ float gelu_tanh(float x) { const float u = 0.7978845608028654f * (x + 0.044715f * x * x * x); return 0.5f * x * (1.0f + tanhf(u)); }
__device__ __forceinline__ void p2_compress(Frame& F, const Args& A) {
    unsigned char* ws = A.ws; const int lane = F.lane, wid = F.wave, tid = F.tid;
    const bf16* P0 = (const bf16*)(ws + WS_P0);
    LAS float* part = (LAS float*)(F.lds + RING_OFF);
    LAS float* hid = (LAS float*)(F.lds + DSA_SCR);
    LAS float* cbl = hid + 4096;
    if (tid < 256) { const float* cbp = (const float*)(ws + WS_CBIAS) + (size_t)(tid >> 7) * 32 * 128 + (tid & 127); float cb = 0.f; for (int ch = 0; ch < 32; ++ch) cb += cbp[ch * 128]; cbl[tid] = cb; }
    if (F.vcu < 16 && wid == 0) { bf16* zp = (bf16*)(ws + ((F.vcu & 1) ? WS_VCMP : WS_KCMP)) + ((size_t)(F.vcu >> 1) * 512 + 511) * 128; zp[lane] = 0; zp[64 + lane] = 0; }
    __syncthreads();
    const int r16 = lane & 15, kq = lane >> 4;
    for (int it = F.vcu; it < 256; it += F.G) {
        const int kv = it >> 7, tile = it & 127;
        const bf16* W1T = (const bf16*)(ws + (kv ? WS_W_CMPV : WS_W_CMPK));
        const float* w2 = A.in[kv ? 8 : 5];
        bf16* outp = (bf16*)(ws + (kv ? WS_VCMP : WS_KCMP));
        const int colbase = kv ? COL_VC : COL_KC;
        f32x4 acc[2][8];
#pragma unroll
        for (int m = 0; m < 2; ++m)
#pragma unroll
            for (int n = 0; n < 8; ++n) acc[m][n] = (f32x4){0.f, 0.f, 0.f, 0.f};
        const bf16* arow[2];
#pragma unroll
        for (int m = 0; m < 2; ++m) { int R = tile * 32 + m * 16 + r16; if (R > 4087) R = 4087; const int g = R & 3, bn = R >> 2, b = bn / NCMP, n = bn - b * NCMP;
            arow[m] = P0 + (size_t)(b * SEQ + 16 * n) * P0LD + colbase + g * 128 + kq * 8; }
#pragma unroll 2
        for (int kk = 0; kk < 16; ++kk) {
            const int ks = wid * 16 + kk, l = ks >> 2, d0 = (ks & 3) * 32;
            s8v af[2], bfr[8];
#pragma unroll
            for (int m = 0; m < 2; ++m) af[m] = ld_frag(arow[m] + (size_t)l * P0LD + d0);
#pragma unroll
            for (int n = 0; n < 8; ++n) bfr[n] = ld_frag(W1T + (size_t)(n * 16 + r16) * 4096 + ks * 32 + kq * 8);
#pragma unroll
            for (int m = 0; m < 2; ++m)
#pragma unroll
                for (int n = 0; n < 8; ++n) acc[m][n] = __builtin_amdgcn_mfma_f32_16x16x32_bf16(af[m], bfr[n], acc[m][n], 0, 0, 0);
        }
#pragma unroll
        for (int m = 0; m < 2; ++m)
#pragma unroll
            for (int n = 0; n < 8; ++n)
#pragma unroll
                for (int j = 0; j < 4; ++j) part[wid * 4096 + (m * 16 + kq * 4 + j) * 128 + n * 16 + r16] = acc[m][n][j];
        __syncthreads();
        { const int row = tid >> 4, e0 = (tid & 15) * 8; f32x4 s0 = (f32x4){0.f, 0.f, 0.f, 0.f}, s1 = s0;
#pragma unroll
          for (int w = 0; w < 8; ++w) { s0 += *(const LAS f32x4*)(part + w * 4096 + row * 128 + e0); s1 += *(const LAS f32x4*)(part + w * 4096 + row * 128 + e0 + 4); }
#pragma unroll
          for (int j = 0; j < 4; ++j) { hid[row * 128 + e0 + j] = gelu_tanh(s0[j] + cbl[kv * 128 + e0 + j]); hid[row * 128 + e0 + 4 + j] = gelu_tanh(s1[j] + cbl[kv * 128 + e0 + 4 + j]); } }
        __syncthreads();
        { const int rr = tid >> 4, f0 = (tid & 15) * 8, R = tile * 32 + rr; f32x4 o0 = (f32x4){0.f, 0.f, 0.f, 0.f}, o1 = o0;
#pragma unroll 16
          for (int e = 0; e < 128; ++e) { const float hv = hid[rr * 128 + e]; o0 += *(const f32x4*)(w2 + e * 128 + f0) * hv; o1 += *(const f32x4*)(w2 + e * 128 + f0 + 4) * hv; }
          if (R <= 4087) { const int g = R & 3, bn = R >> 2, b = bn / NCMP, n = bn - b * NCMP;
              v4u o; o.x = pk2(o0[0], o0[1]); o.y = pk2(o0[2], o0[3]); o.z = pk2(o1[0], o1[1]); o.w = pk2(o1[2], o1[3]);
              *(v4u*)(outp + ((size_t)(b * 4 + g) * 512 + n) * 128 + f0) = o; } }
        __syncthreads();
    }
    for (int tb = F.vcu; tb < NTOK / 64; tb += F.G) {
        const bf16* XBp = (const bf16*)(ws + WS_XB); const bf16* WG = (const bf16*)(ws + WS_W_NSA_IN) + (size_t)5120 * DM; float* GL = (float*)(ws + WS_GL);
        const int rt = wid & 3, kh = wid >> 2, tokr = tb * 64 + rt * 16;
        f32x4 ga[3];
#pragma unroll
        for (int n = 0; n < 3; ++n) ga[n] = (f32x4){0.f, 0.f, 0.f, 0.f};
        const bf16* ap = XBp + (size_t)(tokr + r16) * DM + kh * 1024 + kq * 8; const bf16* bp = WG + (size_t)r16 * DM + kh * 1024 + kq * 8;
#pragma unroll 8
        for (int ks = 0; ks < 32; ++ks) { const s8v af = ld_frag(ap + ks * 32);
#pragma unroll
            for (int n = 0; n < 3; ++n) ga[n] = __builtin_amdgcn_mfma_f32_16x16x32_bf16(af, ld_frag(bp + (size_t)n * 16 * DM + ks * 32), ga[n], 0, 0, 0); }
        if (kh == 1) {
#pragma unroll
            for (int n = 0; n < 3; ++n) *(LAS f32x4*)(part + (rt * 3 + n) * 256 + lane * 4) = ga[n]; }
        __syncthreads();
        if (kh == 0) {
#pragma unroll
            for (int n = 0; n < 3; ++n) { const f32x4 o = ga[n] + *(const LAS f32x4*)(part + (rt * 3 + n) * 256 + lane * 4);
#pragma unroll
                for (int j = 0; j < 4; ++j) GL[(size_t)(tokr + kq * 4 + j) * 48 + n * 16 + r16] = o[j]; } }
        __syncthreads();
    }
}

namespace fa {
typedef float f32x16 __attribute__((ext_vector_type(16)));
typedef short s16x4 __attribute__((ext_vector_type(4)));
typedef unsigned u32x4v __attribute__((ext_vector_type(4)));
constexpr int SHM_K = 16384, SHM_V = 16384;
constexpr int OFF_V = 0, OFF_K = 2 * SHM_V, OFF_WS = 2 * SHM_V + 2 * SHM_K, OFF_LUT = OFF_WS + 8 * 256, OFF_MASK = OFF_LUT + 144 * 16 * 4, OFF_TAB = OFF_MASK + 1024;
constexpr int TABLD = 130;
constexpr float C2 = 1.4426950408889634f, THR = 8.f;
#define FA_KSWZ(row, colB) ((row) * 256 + ((colB) ^ (((row) & 7) << 4)))
#define FA_SBAR() __builtin_amdgcn_sched_barrier(0)
__device__ __forceinline__ int v_st(int k, int c) { const int kk = (k & ~0xC) | ((k & 4) << 1) | ((k & 8) >> 1); return ((kk >> 3) * 4 + (c >> 5)) * 512 + ((kk & 7) * 32 + (c & 31)) * 2; }
__device__ __forceinline__ int v_rd_base(int lane) { return ((lane & 3) << 3) | (((lane >> 2) & 3) << 6) | (((lane >> 4) & 1) << 5) | (((lane >> 5) & 1) << 8); }
constexpr int v_rd_off(int d0, int ks, int half) { return d0 * 512 + ks * 4096 + half * 2048; }
__device__ __forceinline__ int crow(int r, int hi) { return (r & 3) + 8 * (r >> 2) + 4 * hi; }
__device__ __forceinline__ unsigned cvtpk(float lo, float hi) { unsigned r; asm volatile("v_cvt_pk_bf16_f32 %0, %1, %2" : "=v"(r) : "v"(lo), "v"(hi)); return r; }

__device__ __forceinline__ void qkt(f32x16& p0, f32x16& p1, const LAS char* Kb, int r32, int hi, const bf16x8 (&qr)[8], float init) {
#pragma unroll
    for (int r = 0; r < 16; ++r) { p0[r] = init; p1[r] = init; }
    int kb[4];
#pragma unroll
    for (int dd = 0; dd < 4; ++dd) kb[dd] = (int)(uintptr_t)(Kb + FA_KSWZ(r32, (dd * 16 + hi * 8) * 2));
    bf16x8 fa_[4], fb_[4];
#define FA_QRD(dst, addr, off) asm volatile("ds_read_b128 %0, %1 offset:%2" : "=&v"(dst) : "v"(addr), "i"(off) : "memory")
#define FA_QRD4(F_, ka_, kb_, off_) do { FA_QRD(F_[0], ka_, off_); FA_QRD(F_[1], ka_, (off_) + 8192); FA_QRD(F_[2], kb_, off_); FA_QRD(F_[3], kb_, (off_) + 8192); } while (0)
#define FA_QWAIT(F_, n_) asm volatile("s_waitcnt lgkmcnt(" #n_ ")" : "+v"(F_[0]), "+v"(F_[1]), "+v"(F_[2]), "+v"(F_[3]) :: "memory")
#define FA_QMMA(F_, d_) do { p0 = __builtin_amdgcn_mfma_f32_32x32x16_bf16(F_[0], qr[d_], p0, 0, 0, 0); p1 = __builtin_amdgcn_mfma_f32_32x32x16_bf16(F_[1], qr[d_], p1, 0, 0, 0); \
        p0 = __builtin_amdgcn_mfma_f32_32x32x16_bf16(F_[2], qr[(d_) + 1], p0, 0, 0, 0); p1 = __builtin_amdgcn_mfma_f32_32x32x16_bf16(F_[3], qr[(d_) + 1], p1, 0, 0, 0); } while (0)
    FA_QRD4(fa_, kb[0], kb[1], 0);
    FA_QRD4(fb_, kb[2], kb[3], 0);   FA_QWAIT(fa_, 4); FA_QMMA(fa_, 0);
    FA_QRD4(fa_, kb[0], kb[1], 128); FA_QWAIT(fb_, 4); FA_QMMA(fb_, 2);
    FA_QRD4(fb_, kb[2], kb[3], 128); FA_QWAIT(fa_, 4); FA_QMMA(fa_, 4);
    FA_QWAIT(fb_, 0); FA_QMMA(fb_, 6);
#undef FA_QRD
#undef FA_QRD4
#undef FA_QWAIT
#undef FA_QMMA
}
__device__ __forceinline__ void pv_tile(f32x16 (&o)[4], int vb0, bf16x8 pa0, bf16x8 pa1, bf16x8 pa2, bf16x8 pa3) {
#define FA_TRRD(dst, off) asm volatile("ds_read_b64_tr_b16 %0, %1 offset:%2" : "=&v"(dst) : "v"(vb0), "i"(off) : "memory")
#define FA_PV_D0(d0) do { s16x4 l0, l1, l2, l3, h0, h1, h2, h3; constexpr int b_ = v_rd_off(d0, 0, 0); \
        FA_TRRD(l0, b_); FA_TRRD(h0, b_ + 2048); FA_TRRD(l1, b_ + 4096); FA_TRRD(h1, b_ + 6144); FA_TRRD(l2, b_ + 8192); FA_TRRD(h2, b_ + 10240); FA_TRRD(l3, b_ + 12288); FA_TRRD(h3, b_ + 14336); \
        asm volatile("s_waitcnt lgkmcnt(0)" ::: "memory"); FA_SBAR(); \
        o[d0] = __builtin_amdgcn_mfma_f32_32x32x16_bf16(pa0, (bf16x8){l0[0], l0[1], l0[2], l0[3], h0[0], h0[1], h0[2], h0[3]}, o[d0], 0, 0, 0); \
        o[d0] = __builtin_amdgcn_mfma_f32_32x32x16_bf16(pa1, (bf16x8){l1[0], l1[1], l1[2], l1[3], h1[0], h1[1], h1[2], h1[3]}, o[d0], 0, 0, 0); \
        o[d0] = __builtin_amdgcn_mfma_f32_32x32x16_bf16(pa2, (bf16x8){l2[0], l2[1], l2[2], l2[3], h2[0], h2[1], h2[2], h2[3]}, o[d0], 0, 0, 0); \
        o[d0] = __builtin_amdgcn_mfma_f32_32x32x16_bf16(pa3, (bf16x8){l3[0], l3[1], l3[2], l3[3], h3[0], h3[1], h3[2], h3[3]}, o[d0], 0, 0, 0); } while (0)
    FA_PV_D0(0); FA_PV_D0(1); FA_PV_D0(2); FA_PV_D0(3);
#undef FA_PV_D0
#undef FA_TRRD
}
__device__ __forceinline__ void partialSM(f32x16& p0, f32x16& p1, float& m_reg, float& alpha) {
    float pmax = p0[0];
#pragma unroll
    for (int r = 1; r < 16; ++r) pmax = fmaxf(pmax, p0[r]);
#pragma unroll
    for (int r = 0; r < 16; ++r) pmax = fmaxf(pmax, p1[r]);
    { auto rr = __builtin_amdgcn_permlane32_swap(__float_as_uint(pmax), __float_as_uint(pmax), false, false); pmax = fmaxf(__uint_as_float(rr[0]), __uint_as_float(rr[1])); }
    float mn;
    if (__all(pmax - m_reg <= THR)) { mn = m_reg; alpha = 1.f; }
    else { mn = fmaxf(m_reg, pmax); alpha = __builtin_amdgcn_exp2f((m_reg - mn) * C2); m_reg = mn; }
    const float mnL = -mn * C2;
#pragma unroll
    for (int r = 0; r < 16; ++r) { p0[r] = __builtin_amdgcn_exp2f(fmaf(p0[r], C2, mnL)); p1[r] = __builtin_amdgcn_exp2f(fmaf(p1[r], C2, mnL)); }
}
__device__ __forceinline__ float finishSM(const f32x16& p0, const f32x16& p1, bf16x8& pa0, bf16x8& pa1, bf16x8& pa2, bf16x8& pa3) {
    float ps = 0.f;
#pragma unroll
    for (int r = 0; r < 16; ++r) ps += p0[r];
#pragma unroll
    for (int r = 0; r < 16; ++r) ps += p1[r];
    { auto rr = __builtin_amdgcn_permlane32_swap(__float_as_uint(ps), __float_as_uint(ps), false, false); ps = __uint_as_float(rr[0]) + __uint_as_float(rr[1]); }
#define FA_PK4(P, B_, OUT) do { unsigned a0 = cvtpk(P[B_ + 0], P[B_ + 1]), a1 = cvtpk(P[B_ + 2], P[B_ + 3]); unsigned b0 = cvtpk(P[B_ + 4], P[B_ + 5]), b1 = cvtpk(P[B_ + 6], P[B_ + 7]); \
        auto r0 = __builtin_amdgcn_permlane32_swap(a0, b0, false, false); auto r1 = __builtin_amdgcn_permlane32_swap(a1, b1, false, false); \
        u32x4v w = {r0[0], r1[0], r0[1], r1[1]}; OUT = *reinterpret_cast<bf16x8*>(&w); } while (0)
    FA_PK4(p0, 0, pa0); FA_PK4(p0, 8, pa1); FA_PK4(p1, 0, pa2); FA_PK4(p1, 8, pa3);
#undef FA_PK4
    return ps;
}
__device__ __forceinline__ void rescale(f32x16 (&o)[4], float alpha, LAS float* al_l, int r32, int hi) {
    if (__any(alpha < 1.f)) { if (hi == 0) al_l[r32] = alpha; asm volatile("s_waitcnt lgkmcnt(0)" ::: "memory");
#pragma unroll
        for (int r = 0; r < 16; ++r) { const float a = al_l[crow(r, hi)];
#pragma unroll
            for (int d = 0; d < 4; ++d) o[d][r] *= a; }
        asm volatile("s_waitcnt lgkmcnt(0)" ::: "memory"); }
}
__device__ __forceinline__ void mask_tile(f32x16& p0, f32x16& p1, int dq, unsigned W) {
    const float NEG = -__builtin_inff();
#pragma unroll
    for (int r = 0; r < 16; ++r) { const int c = (r & 3) + 8 * (r >> 2);
        if ((unsigned)(dq - c) >= W) p0[r] = NEG;
        if ((unsigned)(dq - c - 32) >= W) p1[r] = NEG; }
}
__device__ __forceinline__ void mask_all(f32x16& p0, f32x16& p1, bool keep) {
    const float NEG = -__builtin_inff();
#pragma unroll
    for (int r = 0; r < 16; ++r) { p0[r] = keep ? p0[r] : NEG; p1[r] = keep ? p1[r] : NEG; }
}
__device__ __forceinline__ void bias_near(f32x16& p0, f32x16& p1, int dq, int step, const LAS float* lutcol) {
#pragma unroll
    for (int r = 0; r < 16; ++r) { const int c = (r & 3) + 8 * (r >> 2);
        const int d0 = min(max((dq - c) * step, 0), 128), d1 = min(max((dq - c - 32) * step, 0), 128);
        p0[r] += lutcol[d0]; p1[r] += lutcol[d1]; }
}
struct Stage { bf16x8 k0, k1, v0, v1; };
__device__ __forceinline__ void stage_load(Stage& S, const bf16* Kp, const bf16* Vp, size_t ld, int row0, int maxrow, int sr, int sc) {
    const int ra = min(row0 + sr, maxrow), rb = min(row0 + 32 + sr, maxrow);
    S.k0 = *(const bf16x8*)(Kp + (size_t)ra * ld + sc); S.k1 = *(const bf16x8*)(Kp + (size_t)rb * ld + sc);
    S.v0 = *(const bf16x8*)(Vp + (size_t)ra * ld + sc); S.v1 = *(const bf16x8*)(Vp + (size_t)rb * ld + sc);
}
__device__ __forceinline__ void stage_write(const Stage& S, LAS char* Kb, LAS char* Vb, int kws, int vst0, int vst1) {
    *(LAS bf16x8*)(Kb + kws) = S.k0; *(LAS bf16x8*)(Kb + kws + 32 * 256) = S.k1;
    *(LAS bf16x8*)(Vb + vst0) = S.v0; *(LAS bf16x8*)(Vb + vst1) = S.v1;
}
}

struct NsaLane { int wid, lane, r32, hi, ql, j, sr, sc, kws, vst0, vst1, vrd; };
__device__ __forceinline__ NsaLane nsa_lane(const Frame& F) {
    NsaLane L; L.wid = F.wave; L.lane = F.lane; L.r32 = F.lane & 31; L.hi = F.lane >> 5; L.ql = L.r32 >> 2; L.j = L.r32 & 3;
    L.sr = F.tid >> 4; L.sc = (F.tid & 15) * 8; L.kws = FA_KSWZ(L.sr, L.sc * 2); L.vst0 = fa::v_st(L.sr, L.sc); L.vst1 = fa::v_st(32 + L.sr, L.sc); L.vrd = fa::v_rd_base(F.lane);
    return L;
}
__device__ __forceinline__ void nsa_load_q(bf16x8 (&qr)[8], const bf16* P0, int tok0, int g, const NsaLane& L) {
    const bf16* qp = P0 + (size_t)(tok0 + L.wid * 8 + L.ql) * P0LD + (g * 4 + L.j) * 128 + L.hi * 8;
#pragma unroll
    for (int d0 = 0; d0 < 8; ++d0) qr[d0] = *(const bf16x8*)(qp + d0 * 16);
}
__device__ __forceinline__ void nsa_lut(Frame& F, const Args& A) {
    LAS float* lut = (LAS float*)(F.lds + RING_OFF + fa::OFF_LUT);
    for (int i = F.tid; i < 144 * 16; i += 512) { const int n = i >> 4, h = i & 15; lut[h * 144 + n] = A.in[1][rel_bucket(n) * 16 + h]; }
    __syncthreads();
}
template <int MODE>
__device__ __forceinline__ void nsa_store(const fa::f32x16 (&o)[4], float l_reg, LAS float* li_l, const float* GL, bf16* OACC, bf16* OATT, int tok0, int g, int br, const NsaLane& L) {
    if (L.hi == 0) li_l[L.r32] = l_reg;
    asm volatile("s_waitcnt lgkmcnt(0)" ::: "memory");
    float sc[16];
#pragma unroll
    for (int r = 0; r < 16; ++r) { const int row = fa::crow(r, L.hi), tok = tok0 + L.wid * 8 + (row >> 2), h = g * 4 + (row & 3); sc[r] = GL[(size_t)tok * 48 + h * 3 + br]; }
    unsigned prev[4][16];
    if (MODE != 0) {
#pragma unroll
        for (int r = 0; r < 16; ++r) { const int row = fa::crow(r, L.hi), tok = tok0 + L.wid * 8 + (row >> 2), h = g * 4 + (row & 3); const bf16* ap = OACC + (size_t)tok * DM + h * 128 + (L.r32 & ~1);
#pragma unroll
            for (int d0 = 0; d0 < 4; ++d0) prev[d0][r] = *(const unsigned*)(ap + d0 * 32); } }
#pragma unroll
    for (int r = 0; r < 16; ++r) { const int row = fa::crow(r, L.hi), tok = tok0 + L.wid * 8 + (row >> 2), h = g * 4 + (row & 3);
        const float l = li_l[row]; const float gl = sc[r];
        const float scl = (l > 0.f) ? __builtin_amdgcn_rcpf(l) / (1.0f + __expf(-gl)) : 0.f;
        bf16* dst = ((MODE == 2) ? OATT : OACC) + (size_t)tok * DM + h * 128 + L.r32;
#pragma unroll
        for (int d0 = 0; d0 < 4; ++d0) { float v = o[d0][r] * scl;
            if (MODE != 0) v += (L.r32 & 1) ? bfhi(prev[d0][r]) : bflo(prev[d0][r]);
            const float vn = dpp_xor1(v); if ((L.r32 & 1) == 0) *(unsigned*)(dst + d0 * 32) = fa::cvtpk(v, vn); } }
    asm volatile("s_waitcnt lgkmcnt(0)" ::: "memory");
}

__device__ __forceinline__ void nsa_scales(float (&scl)[16], float l_reg, LAS float* li_l, const float* GL, int tok0, int g, int br, const NsaLane& L) {
    if (L.hi == 0) li_l[L.r32] = l_reg;
    asm volatile("s_waitcnt lgkmcnt(0)" ::: "memory");
    float sc[16];
#pragma unroll
    for (int r = 0; r < 16; ++r) { const int row = fa::crow(r, L.hi), tok = tok0 + L.wid * 8 + (row >> 2), h = g * 4 + (row & 3); sc[r] = GL[(size_t)tok * 48 + h * 3 + br]; }
#pragma unroll
    for (int r = 0; r < 16; ++r) { const float l = li_l[fa::crow(r, L.hi)]; scl[r] = (l > 0.f) ? __builtin_amdgcn_rcpf(l) / (1.0f + __expf(-sc[r])) : 0.f; }
    asm volatile("s_waitcnt lgkmcnt(0)" ::: "memory");
}
__device__ __forceinline__ void p3a_nsa_cmp(Frame& F, const Args& A) {
    unsigned char* ws = A.ws; const NsaLane L = nsa_lane(F);
    const bf16* P0 = (const bf16*)(ws + WS_P0); const bf16* KCB = (const bf16*)(ws + WS_KCMP); const bf16* VCB = (const bf16*)(ws + WS_VCMP);
    const float* GL = (const float*)(ws + WS_GL); bf16* OACC = (bf16*)(ws + WS_Z + 64 * MiB); unsigned* SELM = (unsigned*)(ws + WS_SELM);
    nsa_lut(F, A);
    LAS char* lds = (LAS char*)(F.lds + RING_OFF);
    LAS float* wsf = (LAS float*)(lds + fa::OFF_WS) + L.wid * 64; LAS float* li_l = wsf; LAS float* al_l = wsf + 32;
    const LAS float* lut = (const LAS float*)(lds + fa::OFF_LUT);
    LAS float* tab = (LAS float*)(lds + fa::OFF_TAB);
    for (int ui = 0; ui < 2 * ((512 - F.vcu + F.G - 1) / F.G); ++ui) {
        const int p = F.vcu + (ui >> 1) * F.G, bg = p >> 6, y = p & 63, qb = (ui & 1) ? 127 - y : y, b = bg >> 2, g = bg & 3;
        const int tok0 = b * SEQ + qb * 64;
        bf16x8 qr[8]; nsa_load_q(qr, P0, tok0, g, L);
        const int trow = qb * 64 + L.wid * 8 + L.ql;
        const int h = g * 4 + L.j; const LAS float* lutcol = lut + h * 144; const float bias_far = lutcol[128];
        const int nmaxrow = (trow >= 31) ? (trow - 31) >> 4 : -1;
        const int NT = (4 * qb + 3 + 63) >> 6;
        const bf16* Kg = KCB + (size_t)(b * 4 + g) * 512 * 128; const bf16* Vg = VCB + (size_t)(b * 4 + g) * 512 * 128;
        for (int i = F.tid; i < 64 * fa::TABLD; i += 512) tab[i] = 0.f;
        float m_reg = -1e30f, l_reg = 0.f;
        fa::Stage S;
        const int rem16 = (trow >= 31) ? ((trow - 31) & 15) : 0;
        fa::stage_load(S, Kg, Vg, 128, 0, 511, L.sr, L.sc); asm volatile("s_waitcnt vmcnt(0)" ::: "memory");
        fa::stage_write(S, lds + fa::OFF_K, lds + fa::OFF_V, L.kws, L.vst0, L.vst1);
        __syncthreads();
#pragma unroll 1
        for (int t = 0; t < NT; ++t) {
            const int buf = t & 1;
            fa::stage_load(S, Kg, Vg, 128, (t + 1 < NT) ? (t + 1) * 64 : 0, 511, L.sr, L.sc);
            fa::f32x16 p0, p1;
            const bool farT = (qb * 64 + L.wid * 8) - 31 - 16 * (t * 64 + 63) >= 128;
            fa::qkt(p0, p1, lds + fa::OFF_K + buf * fa::SHM_K, L.r32, L.hi, qr, farT ? bias_far : 0.f);
            const int dq = nmaxrow - t * 64 - 4 * L.hi;
            if (!farT) fa::bias_near(p0, p1, dq, 16, lutcol + rem16);
            fa::mask_tile(p0, p1, dq, 0x40000000u);
            float alpha; fa::partialSM(p0, p1, m_reg, alpha);
            float ps = 0.f;
#pragma unroll
            for (int r = 0; r < 16; ++r) ps += p0[r] + p1[r];
            { auto rr = __builtin_amdgcn_permlane32_swap(__float_as_uint(ps), __float_as_uint(ps), false, false); ps = __uint_as_float(rr[0]) + __uint_as_float(rr[1]); }
            l_reg = l_reg * alpha + ps;
            if (t + 1 < NT) { asm volatile("s_waitcnt vmcnt(0)" ::: "memory"); fa::stage_write(S, lds + fa::OFF_K + (buf ^ 1) * fa::SHM_K, lds + fa::OFF_V + (buf ^ 1) * fa::SHM_V, L.kws, L.vst0, L.vst1); }
            __syncthreads();
        }
        fa::f32x16 o[4];
#pragma unroll
        for (int d = 0; d < 4; ++d)
#pragma unroll
            for (int r = 0; r < 16; ++r) o[d][r] = 0.f;
        asm volatile("s_waitcnt vmcnt(0)" ::: "memory");
        fa::stage_write(S, lds + fa::OFF_K, lds + fa::OFF_V, L.kws, L.vst0, L.vst1);
        __syncthreads();
        const float inv_l = (l_reg > 0.f) ? 1.0f / l_reg : 0.f; const float mnL = -m_reg * fa::C2;
#pragma unroll 1
        for (int t = 0; t < NT; ++t) {
            const int buf = t & 1;
            if (t + 1 < NT) fa::stage_load(S, Kg, Vg, 128, (t + 1) * 64, 511, L.sr, L.sc);
            fa::f32x16 p0, p1;
            const bool farT = (qb * 64 + L.wid * 8) - 31 - 16 * (t * 64 + 63) >= 128;
            fa::qkt(p0, p1, lds + fa::OFF_K + buf * fa::SHM_K, L.r32, L.hi, qr, farT ? bias_far : 0.f);
            const int dq = nmaxrow - t * 64 - 4 * L.hi;
            if (!farT) fa::bias_near(p0, p1, dq, 16, lutcol + rem16);
            fa::mask_tile(p0, p1, dq, 0x40000000u);
#pragma unroll
            for (int r = 0; r < 16; ++r) { p0[r] = __builtin_amdgcn_exp2f(fmaf(p0[r], fa::C2, mnL)) * inv_l; p1[r] = __builtin_amdgcn_exp2f(fmaf(p1[r], fa::C2, mnL)) * inv_l; }
            LAS float* tb = tab + (L.wid * 8 + L.ql) * fa::TABLD + t * 16 + L.hi;
#pragma unroll
            for (int half = 0; half < 2; ++half)
#pragma unroll
                for (int gq = 0; gq < 4; ++gq) { const fa::f32x16& pp = half ? p1 : p0;
                    float s4 = pp[4 * gq] + pp[4 * gq + 1] + pp[4 * gq + 2] + 0.5f * pp[4 * gq + 3], cr = 0.5f * pp[4 * gq + 3];
                    s4 += dpp_xor1(s4); s4 += dpp_xor2(s4); cr += dpp_xor1(cr); cr += dpp_xor2(cr);
                    if (L.j == 0) { __hip_atomic_fetch_add(tb + half * 8 + 2 * gq, s4, __ATOMIC_RELAXED, __HIP_MEMORY_SCOPE_WORKGROUP); __hip_atomic_fetch_add(tb + half * 8 + 2 * gq + 1, cr, __ATOMIC_RELAXED, __HIP_MEMORY_SCOPE_WORKGROUP); } }
            bf16x8 a0, a1, a2, a3; (void)fa::finishSM(p0, p1, a0, a1, a2, a3);
            fa::pv_tile(o, (int)(uintptr_t)(lds + fa::OFF_V + buf * fa::SHM_V) + L.vrd, a0, a1, a2, a3);
            if (t + 1 < NT) { asm volatile("s_waitcnt vmcnt(0)" ::: "memory"); fa::stage_write(S, lds + fa::OFF_K + (buf ^ 1) * fa::SHM_K, lds + fa::OFF_V + (buf ^ 1) * fa::SHM_V, L.kws, L.vst0, L.vst1); }
            __syncthreads();
        }
        const bf16* Kw = P0 + (size_t)b * SEQ * P0LD + COL_KW + g * 128; const bf16* Vw = P0 + (size_t)b * SEQ * P0LD + COL_VW + g * 128;
        const int t0 = max(0, qb - 8), NTW = qb - t0 + 1;
        fa::stage_load(S, Kw, Vw, P0LD, t0 * 64, SEQ - 1, L.sr, L.sc);
        unsigned tot[4][8];
        { float scl[16]; nsa_scales(scl, (l_reg > 0.f) ? 1.0f : 0.f, li_l, GL, tok0, g, 0, L);
#pragma unroll
          for (int d0 = 0; d0 < 4; ++d0)
#pragma unroll
              for (int r2 = 0; r2 < 8; ++r2) tot[d0][r2] = fa::cvtpk(o[d0][2 * r2] * scl[2 * r2], o[d0][2 * r2 + 1] * scl[2 * r2 + 1]); }
        __syncthreads();
        {
            bool s0[8], s1[8];
            if (qb < 16) {
#pragma unroll
                for (int qi = 0; qi < 8; ++qi) { s0[qi] = (L.lane <= qb); s1[qi] = false; }
            } else {
                unsigned k0[8], k1[8], lo[8];
#pragma unroll
                for (int qi = 0; qi < 8; ++qi) { const int ql = L.wid * 8 + qi;
                    const bool c0 = (L.lane >= 1 && L.lane <= qb - 2), c1 = (L.lane + 64 <= qb - 2);
                    k0[qi] = c0 ? __float_as_uint(tab[ql * fa::TABLD + L.lane]) + 1u : 0u; k1[qi] = c1 ? __float_as_uint(tab[ql * fa::TABLD + L.lane + 64]) + 1u : 0u;
                    s0[qi] = (L.lane == 0) || (L.lane == qb) || (L.lane == qb - 1); s1[qi] = (L.lane + 64 == qb) || (L.lane + 64 == qb - 1); lo[qi] = 0u; }
#pragma unroll 1
                for (int bit = 30; bit >= 0; --bit) {
#pragma unroll
                    for (int qi = 0; qi < 8; ++qi) { const unsigned cand = lo[qi] | (1u << bit);
                        const int cnt = __popcll(__ballot(k0[qi] >= cand)) + __popcll(__ballot(k1[qi] >= cand));
                        lo[qi] = (cnt >= 13) ? cand : lo[qi]; } }
#pragma unroll
                for (int qi = 0; qi < 8; ++qi) { const unsigned T = lo[qi];
                    const bool g0 = k0[qi] > T, g1 = k1[qi] > T, e0 = k0[qi] == T, e1 = k1[qi] == T;
                    const int need = 13 - (__popcll(__ballot(g0)) + __popcll(__ballot(g1)));
                    const unsigned long long be0 = __ballot(e0), be1 = __ballot(e1);
                    const int r0 = (int)__builtin_amdgcn_mbcnt_hi((unsigned)(be0 >> 32), __builtin_amdgcn_mbcnt_lo((unsigned)be0, 0u));
                    const int r1 = __popcll(be0) + (int)__builtin_amdgcn_mbcnt_hi((unsigned)(be1 >> 32), __builtin_amdgcn_mbcnt_lo((unsigned)be1, 0u));
                    s0[qi] = s0[qi] || g0 || (e0 && r0 < need); s1[qi] = s1[qi] || g1 || (e1 && r1 < need); }
            }
#pragma unroll
            for (int qi = 0; qi < 8; ++qi) { const int ql = L.wid * 8 + qi; const unsigned long long b0 = __ballot(s0[qi]), b1 = __ballot(s1[qi]);
                if (L.lane == 0) { uint4 mv; mv.x = (unsigned)b0; mv.y = (unsigned)(b0 >> 32); mv.z = (unsigned)b1; mv.w = (unsigned)(b1 >> 32); *(uint4*)(SELM + ((size_t)(tok0 + ql) * 4 + g) * 4) = mv; } }
        }
        __syncthreads();
        LAS char* const totb[4] = {lds + fa::OFF_TAB + F.tid * 32, lds + fa::OFF_TAB + 16384 + F.tid * 32, lds + fa::OFF_TAB + 64 * fa::TABLD * 4 + F.tid * 32, (LAS char*)(F.lds + DSA_SCR) + F.tid * 32};
#pragma unroll
        for (int d0 = 0; d0 < 4; ++d0) { v4u ta, tb; ta.x = tot[d0][0]; ta.y = tot[d0][1]; ta.z = tot[d0][2]; ta.w = tot[d0][3]; tb.x = tot[d0][4]; tb.y = tot[d0][5]; tb.z = tot[d0][6]; tb.w = tot[d0][7];
            *(LAS v4u*)(totb[d0]) = ta; *(LAS v4u*)(totb[d0] + 16) = tb; }
        {
            m_reg = -1e30f; l_reg = 0.f;
#pragma unroll
            for (int d = 0; d < 4; ++d)
#pragma unroll
                for (int r = 0; r < 16; ++r) o[d][r] = 0.f;
            asm volatile("s_waitcnt vmcnt(0)" ::: "memory");
            fa::stage_write(S, lds + fa::OFF_K, lds + fa::OFF_V, L.kws, L.vst0, L.vst1);
            __syncthreads();
#pragma unroll 1
            for (int tt = 0; tt < NTW; ++tt) {
                const int buf = tt & 1, t = t0 + tt;
                if (tt + 1 < NTW) fa::stage_load(S, Kw, Vw, P0LD, (t + 1) * 64, SEQ - 1, L.sr, L.sc);
                fa::f32x16 p0, p1;
                const bool farT = (qb * 64 + L.wid * 8) - (t * 64 + 63) >= 128;
                fa::qkt(p0, p1, lds + fa::OFF_K + buf * fa::SHM_K, L.r32, L.hi, qr, farT ? bias_far : 0.f);
                const int dq = trow - t * 64 - 4 * L.hi;
                if (!farT) fa::bias_near(p0, p1, dq, 1, lutcol);
                if (t == qb || t == t0) fa::mask_tile(p0, p1, dq, 512u);
                float alpha; fa::partialSM(p0, p1, m_reg, alpha);
                fa::rescale(o, alpha, al_l, L.r32, L.hi);
                bf16x8 a0, a1, a2, a3; const float ps = fa::finishSM(p0, p1, a0, a1, a2, a3); l_reg = l_reg * alpha + ps;
                fa::pv_tile(o, (int)(uintptr_t)(lds + fa::OFF_V + buf * fa::SHM_V) + L.vrd, a0, a1, a2, a3);
                if (tt + 1 < NTW) { asm volatile("s_waitcnt vmcnt(0)" ::: "memory"); fa::stage_write(S, lds + fa::OFF_K + (buf ^ 1) * fa::SHM_K, lds + fa::OFF_V + (buf ^ 1) * fa::SHM_V, L.kws, L.vst0, L.vst1); }
                __syncthreads();
            }
            float scl[16]; nsa_scales(scl, l_reg, li_l, GL, tok0, g, 2, L);
#pragma unroll
            for (int d0 = 0; d0 < 4; ++d0) { const v4u ta = *(const LAS v4u*)(totb[d0]), tb = *(const LAS v4u*)(totb[d0] + 16); const unsigned tt8[8] = {ta.x, ta.y, ta.z, ta.w, tb.x, tb.y, tb.z, tb.w};
#pragma unroll
                for (int r = 0; r < 16; ++r) { const int row = fa::crow(r, L.hi), tok = tok0 + L.wid * 8 + (row >> 2), h = g * 4 + (row & 3);
                    bf16* dst = OACC + (size_t)tok * DM + h * 128 + L.r32;
                    const float v = o[d0][r] * scl[r] + ((r & 1) ? bfhi(tt8[r >> 1]) : bflo(tt8[r >> 1]));
                    const float vn = dpp_xor1(v); if ((L.r32 & 1) == 0) *(unsigned*)(dst + d0 * 32) = fa::cvtpk(v, vn); } }
            asm volatile("s_waitcnt lgkmcnt(0)" ::: "memory");
        }
        __syncthreads();
    }
}
constexpr int N3_OFF_V = 0, N3_OFF_K = 3 * fa::SHM_V, N3_OFF_WS = 3 * fa::SHM_V + 3 * fa::SHM_K, N3_OFF_LUT = N3_OFF_WS + 8 * 256;
__device__ __forceinline__ void nsa_lut3(Frame& F, const Args& A) {
    LAS float* lut = (LAS float*)(F.lds + RING_OFF + N3_OFF_LUT);
    for (int i = F.tid; i < 144 * 16; i += 512) { const int n = i >> 4, h = i & 15; lut[h * 144 + n] = A.in[1][rel_bucket(n) * 16 + h]; }
    __syncthreads();
}
__device__ __forceinline__ void p3b_nsa_sel(Frame& F, const Args& A) {
    unsigned char* ws = A.ws; const NsaLane L = nsa_lane(F);
    const bf16* P0 = (const bf16*)(ws + WS_P0); const float* GL = (const float*)(ws + WS_GL); bf16* OACC = (bf16*)(ws + WS_Z + 64 * MiB); const unsigned* SELM = (const unsigned*)(ws + WS_SELM);
    nsa_lut3(F, A);
    LAS char* lds = (LAS char*)(F.lds + RING_OFF);
    LAS float* wsf = (LAS float*)(lds + N3_OFF_WS) + L.wid * 64; LAS float* li_l = wsf; LAS float* al_l = wsf + 32;
    const LAS float* lut = (const LAS float*)(lds + N3_OFF_LUT);
    const bool grpB = L.wid >= 4;
    for (int ui = 0; ui < 2 * ((512 - F.vcu + F.G - 1) / F.G); ++ui) {
        const int p = F.vcu + (ui >> 1) * F.G, bg = p >> 6, y = p & 63, qb = (ui & 1) ? 127 - y : y, b = bg >> 2, g = bg & 3;
        const int tok0 = b * SEQ + qb * 64;
        bf16x8 qr[8]; nsa_load_q(qr, P0, tok0, g, L);
        const int trow = qb * 64 + L.wid * 8 + L.ql;
        const int h = g * 4 + L.j; const LAS float* lutcol = lut + h * 144; const float bias_far = lutcol[128];
        const uint4 mv = *(const uint4*)(SELM + ((size_t)(tok0 + L.wid * 8 + L.ql) * 4 + g) * 4);
        const bf16* Kg = P0 + (size_t)b * SEQ * P0LD + COL_KS + g * 128; const bf16* Vg = P0 + (size_t)b * SEQ * P0LD + COL_VS + g * 128;
        const int NT = qb + 1;
        float m_reg = -1e30f, l_reg = 0.f; fa::f32x16 o[4];
#pragma unroll
        for (int d = 0; d < 4; ++d)
#pragma unroll
            for (int r = 0; r < 16; ++r) o[d][r] = 0.f;
        fa::Stage Sa;
        fa::stage_load(Sa, Kg, Vg, P0LD, 0, SEQ - 1, L.sr, L.sc); asm volatile("s_waitcnt vmcnt(0)" ::: "memory");
        asm volatile("" : "+v"(qr[0]), "+v"(qr[1]), "+v"(qr[2]), "+v"(qr[3]), "+v"(qr[4]), "+v"(qr[5]), "+v"(qr[6]), "+v"(qr[7]));
        unsigned mvx = mv.x, mvy = mv.y, mvz = mv.z, mvw = mv.w; asm volatile("" : "+v"(mvx), "+v"(mvy), "+v"(mvz), "+v"(mvw));
        fa::stage_write(Sa, lds + N3_OFF_K, lds + N3_OFF_V, L.kws, L.vst0, L.vst1);
        __syncthreads();
        bf16x8 a0 = {0, 0, 0, 0, 0, 0, 0, 0}, a1 = a0, a2 = a0, a3 = a0; bool actp = false;
        int bcur = 0, bprev = 2;
#define P3B_STEP(t, SNEXT2, SNEXT1) do { \
            const int bnext = (bcur == 2) ? 0 : bcur + 1; \
            if ((t) + 1 < NT) fa::stage_load(SNEXT1, Kg, Vg, P0LD, ((t) + 1) * 64, SEQ - 1, L.sr, L.sc); \
            FA_SBAR();     \
            const unsigned word = ((t) < 32) ? mvx : ((t) < 64) ? mvy : ((t) < 96) ? mvz : mvw; \
            const bool mine = ((word >> ((t) & 31)) & 1u) != 0u; \
            const bool act = __any(mine); \
            if (grpB && actp) fa::pv_tile(o, (int)(uintptr_t)(lds + N3_OFF_V + bprev * fa::SHM_V) + L.vrd, a0, a1, a2, a3); \
            if (act) { \
                fa::f32x16 p0, p1; \
                const bool farT = (qb * 64 + L.wid * 8) - ((t) * 64 + 63) >= 128; \
                fa::qkt(p0, p1, lds + N3_OFF_K + bcur * fa::SHM_K, L.r32, L.hi, qr, mine ? (farT ? bias_far : 0.f) : -__builtin_inff()); \
                const int dq = trow - (t) * 64 - 4 * L.hi; \
                if (!farT) fa::bias_near(p0, p1, dq, 1, lutcol); \
                if ((t) == qb) fa::mask_tile(p0, p1, dq, 0x40000000u); \
                float alpha; fa::partialSM(p0, p1, m_reg, alpha); \
                fa::rescale(o, alpha, al_l, L.r32, L.hi); \
                const float ps = fa::finishSM(p0, p1, a0, a1, a2, a3); l_reg = l_reg * alpha + ps; \
                if (!grpB) fa::pv_tile(o, (int)(uintptr_t)(lds + N3_OFF_V + bcur * fa::SHM_V) + L.vrd, a0, a1, a2, a3); \
            } \
            actp = act; \
            if ((t) + 1 < NT) { asm volatile("s_waitcnt vmcnt(0)" ::: "memory"); fa::stage_write(SNEXT1, lds + N3_OFF_K + bnext * fa::SHM_K, lds + N3_OFF_V + bnext * fa::SHM_V, L.kws, L.vst0, L.vst1); } \
            __syncthreads(); \
            bprev = bcur; bcur = bnext; } while (0)
#pragma unroll 1
        for (int t = 0; t < NT; t += 2) {
            P3B_STEP(t, Sa, Sa);
            if (t + 1 < NT) P3B_STEP(t + 1, Sa, Sa);
        }
#undef P3B_STEP
        if (grpB && actp) fa::pv_tile(o, (int)(uintptr_t)(lds + N3_OFF_V + bprev * fa::SHM_V) + L.vrd, a0, a1, a2, a3);
        int tokz = tok0; asm volatile("" : "+s"(tokz));
        nsa_store<2>(o, l_reg, li_l, GL, OACC, (bf16*)(ws + WS_OATT0), tokz, g, 1, L);
        __syncthreads();
    }
}
__device__ __forceinline__ void p3c_nsa_win(Frame& F, const Args& A) {
    unsigned char* ws = A.ws; const NsaLane L = nsa_lane(F);
    const bf16* P0 = (const bf16*)(ws + WS_P0); const float* GL = (const float*)(ws + WS_GL); bf16* OACC = (bf16*)(ws + WS_Z + 64 * MiB); bf16* OATT = (bf16*)(ws + WS_OATT0);
    nsa_lut(F, A);
    LAS char* lds = (LAS char*)(F.lds + RING_OFF);
    LAS float* wsf = (LAS float*)(lds + fa::OFF_WS) + L.wid * 64; LAS float* li_l = wsf; LAS float* al_l = wsf + 32;
    const LAS float* lut = (const LAS float*)(lds + fa::OFF_LUT);
    for (int ui = 0; ui < 2 * ((512 - F.vcu + F.G - 1) / F.G); ++ui) {
        const int p = F.vcu + (ui >> 1) * F.G, bg = p >> 6, y = p & 63, qb = (ui & 1) ? 127 - y : y, b = bg >> 2, g = bg & 3;
        const int tok0 = b * SEQ + qb * 64;
        bf16x8 qr[8]; nsa_load_q(qr, P0, tok0, g, L);
        const int trow = qb * 64 + L.wid * 8 + L.ql;
        const int h = g * 4 + L.j; const LAS float* lutcol = lut + h * 144; const float bias_far = lutcol[128];
        const bf16* Kg = P0 + (size_t)b * SEQ * P0LD + COL_KW + g * 128; const bf16* Vg = P0 + (size_t)b * SEQ * P0LD + COL_VW + g * 128;
        const int t0 = max(0, qb - 8), NT = qb - t0 + 1;
        float m_reg = -1e30f, l_reg = 0.f; fa::f32x16 o[4];
#pragma unroll
        for (int d = 0; d < 4; ++d)
#pragma unroll
            for (int r = 0; r < 16; ++r) o[d][r] = 0.f;
        fa::Stage S;
        fa::stage_load(S, Kg, Vg, P0LD, t0 * 64, SEQ - 1, L.sr, L.sc); asm volatile("s_waitcnt vmcnt(0)" ::: "memory");
        fa::stage_write(S, lds + fa::OFF_K, lds + fa::OFF_V, L.kws, L.vst0, L.vst1);
        __syncthreads();
#pragma unroll 1
        for (int tt = 0; tt < NT; ++tt) {
            const int buf = tt & 1, t = t0 + tt;
            if (tt + 1 < NT) fa::stage_load(S, Kg, Vg, P0LD, (t + 1) * 64, SEQ - 1, L.sr, L.sc);
            fa::f32x16 p0, p1;
            const bool farT = (qb * 64 + L.wid * 8) - (t * 64 + 63) >= 128;
            fa::qkt(p0, p1, lds + fa::OFF_K + buf * fa::SHM_K, L.r32, L.hi, qr, farT ? bias_far : 0.f);
            const int dq = trow - t * 64 - 4 * L.hi;
            if (!farT) fa::bias_near(p0, p1, dq, 1, lutcol);
            if (t == qb || t == t0) fa::mask_tile(p0, p1, dq, 512u);
            float alpha; fa::partialSM(p0, p1, m_reg, alpha);
            fa::rescale(o, alpha, al_l, L.r32, L.hi);
            bf16x8 a0, a1, a2, a3; const float ps = fa::finishSM(p0, p1, a0, a1, a2, a3); l_reg = l_reg * alpha + ps;
            fa::pv_tile(o, (int)(uintptr_t)(lds + fa::OFF_V + buf * fa::SHM_V) + L.vrd, a0, a1, a2, a3);
            if (tt + 1 < NT) { asm volatile("s_waitcnt vmcnt(0)" ::: "memory"); fa::stage_write(S, lds + fa::OFF_K + (buf ^ 1) * fa::SHM_K, lds + fa::OFF_V + (buf ^ 1) * fa::SHM_V, L.kws, L.vst0, L.vst1); }
            __syncthreads();
        }
        nsa_store<2>(o, l_reg, li_l, GL, OACC, OATT, tok0, g, 2, L);
        __syncthreads();
    }
}

template <bool ROUTE, bool F8 = false>
__device__ __forceinline__ void ln_phase(Frame& F, const Args& A, const bf16* Z, const float* gam, const float* bet, bf16* XH, unsigned char* X8) {
    const int gw = F.vcu * NWAVES + F.wave, NGW = F.G * NWAVES, lane = F.lane;
    LAS float* wrl = (LAS float*)(F.lds + RING_OFF);
    if (ROUTE) { for (int i = F.tid; i < DM * 8 / 4; i += 512) *(LAS f32x4*)(wrl + i * 4) = *(const f32x4*)(A.in[18] + i * 4); }
    LAS float* gml = (LAS float*)(F.lds + DSA_SCR); LAS float* btl = gml + DM;
    { const int i = F.tid; *(LAS f32x4*)(gml + i * 4) = *(const f32x4*)(gam + i * 4); *(LAS f32x4*)(btl + i * 4) = *(const f32x4*)(bet + i * 4); }
    __syncthreads();
    uint2 zn[8];
    if (gw < NTOK) { const uint2* zr = (const uint2*)(Z + (size_t)gw * DM) + lane;
#pragma unroll
        for (int j = 0; j < 8; ++j) zn[j] = zr[64 * j]; }
    for (int row = gw; row < NTOK; row += NGW) {
        f32x4 v[8]; float s = 0.f;
#pragma unroll
        for (int j = 0; j < 8; ++j) { const uint2 z2 = zn[j]; v[j] = (f32x4){bflo(z2.x), bfhi(z2.x), bflo(z2.y), bfhi(z2.y)}; s += (v[j][0] + v[j][1]) + (v[j][2] + v[j][3]); }
        if (row + NGW < NTOK) { const uint2* zr = (const uint2*)(Z + (size_t)(row + NGW) * DM) + lane;
#pragma unroll
            for (int j = 0; j < 8; ++j) zn[j] = zr[64 * j]; }
        __builtin_amdgcn_sched_barrier(0);
        const float mean = wave_sum(s) * (1.f / DM); float s2 = 0.f;
#pragma unroll
        for (int j = 0; j < 8; ++j) { v[j] = v[j] - mean; s2 += (v[j][0] * v[j][0] + v[j][1] * v[j][1]) + (v[j][2] * v[j][2] + v[j][3] * v[j][3]); }
        const float rstd = 1.f / sqrtf(wave_sum(s2) * (1.f / DM) + LN_EPS);
        float lg[8];
#pragma unroll
        for (int e = 0; e < 8; ++e) lg[e] = 0.f;
#pragma unroll
        for (int j = 0; j < 8; ++j) { const int c = 4 * lane + 256 * j; const f32x4 gg = *(const LAS f32x4*)(gml + c), bb = *(const LAS f32x4*)(btl + c);
            const f32x4 x = v[j] * rstd * gg + bb;
            { uint2 o; o.x = pk2(x[0], x[1]); o.y = pk2(x[2], x[3]); *(uint2*)(XH + (size_t)row * DM + c) = o; }
            if (F8) { int w = __builtin_amdgcn_cvt_pk_fp8_f32(x[0], x[1], 0, false); w = __builtin_amdgcn_cvt_pk_fp8_f32(x[2], x[3], w, true); *(int*)(X8 + (size_t)row * DM + c) = w; }
            asm volatile("" ::: "memory");
            if (ROUTE) { const LAS float* wr = wrl + c * 8;
#pragma unroll
                for (int q = 0; q < 4; ++q) { const f32x4 w0 = *(const LAS f32x4*)(wr + q * 8), w1 = *(const LAS f32x4*)(wr + q * 8 + 4);
                    lg[0] += x[q] * w0[0]; lg[1] += x[q] * w0[1]; lg[2] += x[q] * w0[2]; lg[3] += x[q] * w0[3]; lg[4] += x[q] * w1[0]; lg[5] += x[q] * w1[1]; lg[6] += x[q] * w1[2]; lg[7] += x[q] * w1[3]; }  asm volatile("" ::: "memory"); }
        }
        if (ROUTE) {
#pragma unroll
            for (int e = 0; e < 8; ++e) lg[e] = wave_sum(lg[e]) + A.in[19][e];
            int e0 = 0; float l0 = lg[0];
#pragma unroll
            for (int e = 1; e < 8; ++e) if (lg[e] > l0) { l0 = lg[e]; e0 = e; }
            int e1 = -1; float l1 = -3e38f;
#pragma unroll
            for (int e = 0; e < 8; ++e) if (e != e0 && lg[e] > l1) { l1 = lg[e]; e1 = e; }
            const float w0 = 1.0f / (1.0f + __expf(l1 - l0)), w1 = 1.0f - w0;
            if (lane == 0) {
                const unsigned p0 = __hip_atomic_fetch_add((unsigned*)(F.ctl + CW_MOECNT + 64 * e0), 1u, __ATOMIC_RELAXED, __HIP_MEMORY_SCOPE_AGENT);
                const unsigned p1 = __hip_atomic_fetch_add((unsigned*)(F.ctl + CW_MOECNT + 64 * e1), 1u, __ATOMIC_RELAXED, __HIP_MEMORY_SCOPE_AGENT);
                int* re = (int*)(A.ws + WS_ROUTE); int* rp = re + 2 * NTOK; float* rw = (float*)(rp + 2 * NTOK);
                re[2 * row] = e0; re[2 * row + 1] = e1; rp[2 * row] = (int)p0; rp[2 * row + 1] = (int)p1; rw[2 * row] = w0; rw[2 * row + 1] = w1;
            }
        }
    }
}

__device__ __forceinline__ void ln_route_phase(Frame& F, const Args& A, const bf16* Z, const float* gam, const float* bet, bf16* XH) {
    const int gw = F.vcu * NWAVES + F.wave, NGW = F.G * NWAVES, lane = F.lane;
    LAS float* wrl = (LAS float*)(F.lds + RING_OFF);
    LAS float* rowb = (LAS float*)(F.lds + RING_OFF + 65536 + F.wave * 8192);
    LAS float* gml = (LAS float*)(F.lds + DSA_SCR); LAS float* btl = gml + DM;
    for (int i = F.tid; i < DM * 8 / 4; i += 512) *(LAS f32x4*)(wrl + i * 4) = *(const f32x4*)(A.in[18] + i * 4);
    { const int i = F.tid; *(LAS f32x4*)(gml + i * 4) = *(const f32x4*)(gam + i * 4); *(LAS f32x4*)(btl + i * 4) = *(const f32x4*)(bet + i * 4); }
    __syncthreads();
    uint2 zn[8];
    if (gw < NTOK) {
#pragma unroll
        for (int j = 0; j < 8; ++j) zn[j] = *(const uint2*)(Z + (size_t)gw * DM + 4 * lane + 256 * j); }
    for (int row = gw; row < NTOK; row += NGW) {
        float s = 0.f, s2 = 0.f;
#pragma unroll
        for (int j = 0; j < 8; ++j) { const uint2 z2 = zn[j]; const f32x4 v = (f32x4){bflo(z2.x), bfhi(z2.x), bflo(z2.y), bfhi(z2.y)}; *(LAS f32x4*)(rowb + 4 * lane + 256 * j) = v;
            s += (v[0] + v[1]) + (v[2] + v[3]); }
        if (row + NGW < NTOK) {
#pragma unroll
            for (int j = 0; j < 8; ++j) zn[j] = *(const uint2*)(Z + (size_t)(row + NGW) * DM + 4 * lane + 256 * j); }
        __builtin_amdgcn_sched_barrier(0);
        const float mean = wave_sum(s) * (1.f / DM);
#pragma unroll 1
        for (int j = 0; j < 8; ++j) { const f32x4 v = *(const LAS f32x4*)(rowb + 4 * lane + 256 * j) - mean; s2 += (v[0] * v[0] + v[1] * v[1]) + (v[2] * v[2] + v[3] * v[3]); }
        const float rstd = 1.f / sqrtf(wave_sum(s2) * (1.f / DM) + LN_EPS);
        float lg[8];
#pragma unroll
        for (int e = 0; e < 8; ++e) lg[e] = 0.f;
#pragma unroll 1
        for (int j = 0; j < 8; ++j) { const int c = 4 * lane + 256 * j; const f32x4 gg = *(const LAS f32x4*)(gml + c), bb = *(const LAS f32x4*)(btl + c);
            const f32x4 x = (*(const LAS f32x4*)(rowb + c) - mean) * rstd * gg + bb;
            { uint2 o; o.x = pk2(x[0], x[1]); o.y = pk2(x[2], x[3]); *(uint2*)(XH + (size_t)row * DM + c) = o; }
            const LAS float* wr = wrl + c * 8;
#pragma unroll
            for (int q = 0; q < 4; ++q) { const f32x4 w0 = *(const LAS f32x4*)(wr + q * 8), w1 = *(const LAS f32x4*)(wr + q * 8 + 4);
                lg[0] += x[q] * w0[0]; lg[1] += x[q] * w0[1]; lg[2] += x[q] * w0[2]; lg[3] += x[q] * w0[3]; lg[4] += x[q] * w1[0]; lg[5] += x[q] * w1[1]; lg[6] += x[q] * w1[2]; lg[7] += x[q] * w1[3]; } }
#pragma unroll
        for (int e = 0; e < 8; ++e) lg[e] = wave_sum(lg[e]) + A.in[19][e];
        int e0 = 0; float l0 = lg[0];
#pragma unroll
        for (int e = 1; e < 8; ++e) if (lg[e] > l0) { l0 = lg[e]; e0 = e; }
        int e1 = -1; float l1 = -3e38f;
#pragma unroll
        for (int e = 0; e < 8; ++e) if (e != e0 && lg[e] > l1) { l1 = lg[e]; e1 = e; }
        const float w0 = 1.0f / (1.0f + __expf(l1 - l0)), w1 = 1.0f - w0;
        if (lane == 0) {
            const unsigned p0 = __hip_atomic_fetch_add((unsigned*)(F.ctl + CW_MOECNT + 64 * e0), 1u, __ATOMIC_RELAXED, __HIP_MEMORY_SCOPE_AGENT);
            const unsigned p1 = __hip_atomic_fetch_add((unsigned*)(F.ctl + CW_MOECNT + 64 * e1), 1u, __ATOMIC_RELAXED, __HIP_MEMORY_SCOPE_AGENT);
            int* re = (int*)(A.ws + WS_ROUTE); int* rp = re + 2 * NTOK; float* rw = (float*)(rp + 2 * NTOK);
            re[2 * row] = e0; re[2 * row + 1] = e1; rp[2 * row] = (int)p0; rp[2 * row + 1] = (int)p1; rw[2 * row] = w0; rw[2 * row + 1] = w1;
        }
        WSYNC();
    }
    __syncthreads();
}

__device__ __forceinline__ void p10_dsa_prep(Frame& F, const Args& A) {
    unsigned char* ws = A.ws; const int lane = F.lane;
    const int gw = F.vcu * NWAVES + F.wave, NGW = F.G * NWAVES;
    { const float* CR = (const float*)(ws + WS_CRAW); bf16* CN = (bf16*)(ws + WS_CN); const f32x4 gg = *(const f32x4*)(A.in[11] + 4 * lane);
      f32x4 vn = (f32x4){0.f, 0.f, 0.f, 0.f}, kn = vn;
      if (gw < NTOK) { vn = *(const f32x4*)(CR + (size_t)gw * KVR + 4 * lane); if (lane < 16) kn = *(const f32x4*)((const float*)(ws + WS_KIWI) + (size_t)gw * 128 + 4 * lane); }
      for (int row = gw; row < NTOK; row += NGW) { const f32x4 v = vn, kv = kn;
          if (row + NGW < NTOK) { vn = *(const f32x4*)(CR + (size_t)(row + NGW) * KVR + 4 * lane); if (lane < 16) kn = *(const f32x4*)((const float*)(ws + WS_KIWI) + (size_t)(row + NGW) * 128 + 4 * lane); }
          const float ss = wave_sum(v[0] * v[0] + v[1] * v[1] + v[2] * v[2] + v[3] * v[3]); const float r = 1.f / sqrtf(ss * (1.f / KVR) + RMS_EPS);
          uint2 o; o.x = pk2(v[0] * r * gg[0], v[1] * r * gg[1]); o.y = pk2(v[2] * r * gg[2], v[3] * r * gg[3]); *(uint2*)(CN + (size_t)row * KVR + 4 * lane) = o;
          if (lane < 16) { uint2 k2; k2.x = pk2(kv[0], kv[1]); k2.y = pk2(kv[2], kv[3]); *(uint2*)((bf16*)(ws + WS_KIB) + (size_t)(row >> 5) * 2048 + (lane >> 2) * 512 + ((((lane >> 1) & 1) * 32 + (row & 31)) * 8) + (lane & 1) * 4) = k2; } } }
    { pg8::Gemm g{(const bf16*)(ws + WS_Q), (const bf16*)(ws + WS_W_UK), NTOK, 4096, 256, 2, 0x7f7f7f7f, DM};
      pg8::PairOrder S; S.init(NTOK, 4096, F.G, (int)blockIdx.x); S.pn_shift = 1; S.kslice = 256;
      pg8::EpiBf16Scale E{(bf16*)(ws + WS_QLAT), 4096, 0.08838834764831845f};
      pg8::gemm_phase<pg8::EpiBf16Scale, pg8::PairOrder, true, true>(F.lds + RING_OFF, g, S, E); }
}
__device__ __forceinline__ void p12_dsa_uv(Frame& F, const Args& A) {
    unsigned char* ws = A.ws;
    pg8::Gemm g{(const bf16*)(ws + WS_OLAT), (const bf16*)(ws + WS_W_UV), NTOK, DM, 512, 2, 0x7f7f7f7f, 4096};
    pg8::PairOrder S; S.init(NTOK, DM, F.G, (int)blockIdx.x); S.pn_shift = 0; S.kslice = 512;
    pg8::EpiBf16Scale E{(bf16*)(ws + WS_OATT1), DM, 1.0f};
    pg8::gemm_phase<pg8::EpiBf16Scale, pg8::PairOrder, true, true>(F.lds + RING_OFF, g, S, E);
}
__device__ __forceinline__ unsigned f2key(float f) { const unsigned u = __float_as_uint(f); return (u & 0x80000000u) ? ~u : (u | 0x80000000u); }

__device__ __forceinline__ unsigned dsa_off_b(unsigned row, unsigned ch) { return 256u * row + 16u * (ch ^ (((row & 3) << 2) | ((row >> 2) & 3))); }

__device__ __forceinline__ float relu1(float x) { return __builtin_amdgcn_fmed3f(x, 0.f, 3.0e38f); }
__device__ __forceinline__ float max1(float a, float b) { float r; asm("v_max_f32 %0, %1, %2" : "=v"(r) : "v"(a), "v"(b)); return r; }
__device__ __forceinline__ float min1(float a, float b) { float r; asm("v_min_f32 %0, %1, %2" : "=v"(r) : "v"(a), "v"(b)); return r; }
__device__ __forceinline__ float key2f(unsigned k) { return __uint_as_float((k & 0x80000000u) ? (k & 0x7fffffffu) : ~k); }
__device__ __forceinline__ void p13a_dsa_index(Frame& F, const Args& A) {
    unsigned char* ws = A.ws; const int lane = F.lane, wid = F.wave, r32 = lane & 31, hi = lane >> 5;
    const bf16* QI = (const bf16*)(ws + WS_QI); const bf16* KIB = (const bf16*)(ws + WS_KIB); const float* KIWI = (const float*)(ws + WS_KIWI); int* IDX = (int*)(ws + WS_IDX);
    LAS float* sc = (LAS float*)(F.lds + RING_OFF);
    LAS unsigned* hist = (LAS unsigned*)(F.lds + DSA_SCR);
    LAS unsigned* qm = hist + 4096;
    LAS float* mmx = (LAS float*)(qm + 64);
    LAS unsigned* dmy = (LAS unsigned*)(mmx + 64);
    LAS unsigned* candk = dmy + 128;
    LAS unsigned* candi = candk + 1024;
    LAS unsigned* outl = candi + 1024;
    LAS unsigned* cntG = outl;
    LAS unsigned* cntE = cntG + 512;
    constexpr int CAP = 256;
    const int q = wid >> 1, sub = wid & 1, th = sub * 64 + lane;
    bf16x8 qa[4]; float wv[16];
#define P13A_TOK0(slot_) ((((slot_) >> 8) * 256 + ((((slot_) >> 8) & 1) ? 255 - ((slot_) & 255) : ((slot_) & 255))) * 4)
#define P13A_LOADQ(tk_) do { _Pragma("unroll") for (int s = 0; s < 4; ++s) qa[s] = *(const bf16x8*)(QI + (size_t)((tk_) + (r32 >> 3)) * 512 + (r32 & 7) * 64 + 16 * s + 8 * hi); \
        _Pragma("unroll") for (int r = 0; r < 16; ++r) wv[r] = KIWI[(size_t)((tk_) + (r >> 2)) * 128 + 64 + (r & 3) + 4 * hi] * 0.35355339059327373f; } while (0)
    if (F.vcu < NTOK / 4) P13A_LOADQ(P13A_TOK0(F.vcu));
    for (int slot = F.vcu; slot < NTOK / 4; slot += F.G) {
        const int tok0 = P13A_TOK0(slot), b = tok0 >> 13, t0 = tok0 & (SEQ - 1), tmax = t0 + 3;
        const int ntiles = (tmax >> 5) + 1;
#pragma unroll
        for (int z = 0; z < 8; ++z) hist[q * 1024 + z * 128 + th] = 0u;
        if (th == 0) { qm[q * 16 + 2] = 0u; qm[q * 16 + 4] = 0u; }
        float mn0 = 3e38f, mx0 = -3e38f, mn1 = 3e38f, mx1 = -3e38f;
        {
            bf16x8 ka[4], kc[4]; int tile = wid;
#define P13A_LDK(dst_, tl_) do { const bf16* kp_ = KIB + (size_t)(b * (SEQ / 32) + min((tl_), ntiles - 1)) * 2048 + (hi * 32 + r32) * 8; \
                asm volatile("global_load_dwordx4 %0, %4, off\n\tglobal_load_dwordx4 %1, %4, off offset:1024\n\tglobal_load_dwordx4 %2, %4, off offset:2048\n\tglobal_load_dwordx4 %3, %4, off offset:3072" \
                             : "=&v"(dst_[0]), "=&v"(dst_[1]), "=&v"(dst_[2]), "=&v"(dst_[3]) : "v"(kp_) : "memory"); } while (0)
#define P13A_WAIT(dst_, n_) asm volatile("s_waitcnt vmcnt(" #n_ ")" : "+v"(dst_[0]), "+v"(dst_[1]), "+v"(dst_[2]), "+v"(dst_[3]) :: "memory")
#define P13A_TILE(kk_, tl_) do { const int key_ = (tl_) * 32 + r32; fa::f32x16 acc_; \
                _Pragma("unroll") for (int r = 0; r < 16; ++r) acc_[r] = 0.f; \
                _Pragma("unroll") for (int s = 0; s < 4; ++s) acc_ = __builtin_amdgcn_mfma_f32_32x32x16_bf16(qa[s], kk_[s], acc_, 0, 0, 0); \
                float tot_[4]; \
                _Pragma("unroll") for (int qq = 0; qq < 4; ++qq) { float part = wv[4 * qq] * relu1(acc_[4 * qq]); _Pragma("unroll") for (int r3 = 1; r3 < 4; ++r3) part = fmaf(wv[4 * qq + r3], relu1(acc_[4 * qq + r3]), part); tot_[qq] = sum_xor32(part) + 0.0f; } \
                const float ta_ = hi ? tot_[2] : tot_[0], tb_ = hi ? tot_[3] : tot_[1]; \
                sc[(2 * hi) * 8192 + key_] = ta_; sc[(2 * hi + 1) * 8192 + key_] = tb_; \
                mn0 = min1(mn0, ta_); mx0 = max1(mx0, ta_); mn1 = min1(mn1, tb_); mx1 = max1(mx1, tb_);     \
                } while (0)
            asm volatile("s_waitcnt vmcnt(0)" ::: "memory");
            P13A_LDK(ka, tile);
            while (tile < ntiles) {
                P13A_LDK(kc, tile + 8); P13A_WAIT(ka, 4);
                P13A_TILE(ka, tile);
                tile += 8; if (tile >= ntiles) break;
                P13A_LDK(ka, tile + 8); P13A_WAIT(kc, 4);
                P13A_TILE(kc, tile);
                tile += 8;
            }
            asm volatile("s_waitcnt vmcnt(0)" : "+v"(ka[0]), "+v"(ka[1]), "+v"(ka[2]), "+v"(ka[3]), "+v"(kc[0]), "+v"(kc[1]), "+v"(kc[2]), "+v"(kc[3]) :: "memory");
#undef P13A_WAIT
#undef P13A_LDK
#undef P13A_TILE
        }
        if (slot + F.G < NTOK / 4) P13A_LOADQ(P13A_TOK0(slot + F.G));
        __builtin_amdgcn_sched_barrier(0);
        {
#define HM_(x, OP) do { x = OP(x, dpp_xor1(x)); x = OP(x, dpp_xor2(x)); x = OP(x, __int_as_float(__builtin_amdgcn_mov_dpp(__float_as_int(x), 0x141, 0xF, 0xF, true))); x = OP(x, __int_as_float(__builtin_amdgcn_mov_dpp(__float_as_int(x), 0x140, 0xF, 0xF, true))); \
            { auto r_ = __builtin_amdgcn_permlane16_swap(__float_as_uint(x), __float_as_uint(x), false, false); x = OP(__uint_as_float(r_[0]), __uint_as_float(r_[1])); } } while (0)
            HM_(mn0, fminf); HM_(mx0, fmaxf); HM_(mn1, fminf); HM_(mx1, fmaxf);
#undef HM_
        }
        if (r32 == 0) { mmx[(wid * 4 + 2 * hi) * 2] = mn0; mmx[(wid * 4 + 2 * hi) * 2 + 1] = mx0; mmx[(wid * 4 + 2 * hi + 1) * 2] = mn1; mmx[(wid * 4 + 2 * hi + 1) * 2 + 1] = mx1; }
        __syncthreads();
        const int tok = tok0 + q, n = t0 + q + 1; bool ovf = false;
        if (tmax + 1 <= TOPK) {
            for (int i = th; i < TOPK; i += 128) IDX[(size_t)tok * TOPK + i] = (i < n) ? i : 0;
        } else {
            const LAS float* scq = sc + q * 8192; const int nsl = (n + 127) >> 7;
            float fmn = 3e38f, fmx = -3e38f;
#pragma unroll
            for (int w = 0; w < 8; ++w) { fmn = fminf(fmn, mmx[(w * 4 + q) * 2]); fmx = fmaxf(fmx, mmx[(w * 4 + q) * 2 + 1]); }
            const float bsc = (fmx > fmn) ? 255.99f / (fmx - fmn) : 0.f;
            for (int s0 = 0; s0 < nsl; s0 += 8) { float v[8];
#pragma unroll
                for (int j = 0; j < 8; ++j) { const int i = (s0 + j) * 128 + th; v[j] = scq[min(i, n - 1)]; }
#pragma unroll
                for (int j = 0; j < 8; ++j) { const int i = (s0 + j) * 128 + th; const int bin = min(max((int)((v[j] - fmn) * bsc), 0), 255);
                    LAS unsigned* tgt = (i < n) ? &hist[q * 1024 + (lane & 3) * 256 + bin] : &dmy[th];
                    __hip_atomic_fetch_add(tgt, 1u, __ATOMIC_RELAXED, __HIP_MEMORY_SCOPE_WORKGROUP); } }
            __syncthreads();
            if (sub == 0) {
                const v4u c4 = *(const LAS v4u*)(hist + q * 1024 + 4 * lane) + *(const LAS v4u*)(hist + q * 1024 + 256 + 4 * lane) + *(const LAS v4u*)(hist + q * 1024 + 512 + 4 * lane) + *(const LAS v4u*)(hist + q * 1024 + 768 + 4 * lane); const unsigned s4 = c4.x + c4.y + c4.z + c4.w; unsigned S = s4;
#pragma unroll
                for (int o = 1; o < 64; o <<= 1) { const unsigned v = __shfl_down(S, o); if (lane + o < 64) S += v; }
                const unsigned above = S - s4;
                if (above < (unsigned)TOPK && (unsigned)TOPK <= S) { unsigned cum = above; int bin;
                    if (cum + c4.w >= (unsigned)TOPK) bin = 3; else { cum += c4.w; if (cum + c4.z >= (unsigned)TOPK) bin = 2; else { cum += c4.z; if (cum + c4.y >= (unsigned)TOPK) bin = 1; else { cum += c4.y; bin = 0; } } }
                    qm[q * 16 + 0] = (unsigned)(4 * lane + bin); qm[q * 16 + 1] = (unsigned)TOPK - cum; }
            }
            __syncthreads();
            const int bstar = (int)qm[q * 16 + 0]; const unsigned need1 = qm[q * 16 + 1];
            { unsigned run = 0u;
              for (int s0 = 0; s0 < nsl; s0 += 8) { float v[8];
#pragma unroll
                for (int j = 0; j < 8; ++j) { const int i = (s0 + j) * 128 + th; v[j] = scq[min(i, n - 1)]; }
#pragma unroll
                for (int j = 0; j < 8; ++j) { const int i = (s0 + j) * 128 + th; const bool ok = i < n; const int bin = min(max((int)((v[j] - fmn) * bsc), 0), 255);
                    const bool def = ok && bin > bstar; const unsigned long long bd = __ballot(def);
                    const unsigned pos = run + __builtin_amdgcn_mbcnt_hi((unsigned)(bd >> 32), __builtin_amdgcn_mbcnt_lo((unsigned)bd, 0u));
                    if (def && pos < (unsigned)TOPK) outl[q * 256 + (sub ? 255u - pos : pos)] = (unsigned)i;
                    run += (unsigned)__popcll(bd);
                    if (ok && bin == bstar) { const unsigned pc = __hip_atomic_fetch_add(&qm[q * 16 + 4], 1u, __ATOMIC_RELAXED, __HIP_MEMORY_SCOPE_WORKGROUP); if (pc < (unsigned)CAP) { candk[q * CAP + pc] = f2key(v[j]); candi[q * CAP + pc] = (unsigned)i; } } } }
              if (lane == 0) qm[q * 16 + 10 + sub] = run; }
            __syncthreads();
            if (sub == 0) {
                const unsigned mc = qm[q * 16 + 4];
                if (mc <= (unsigned)CAP) {
                    const unsigned D0 = qm[q * 16 + 10];
                    unsigned kc[4], ic[4], rk[4];
#pragma unroll
                    for (int c = 0; c < 4; ++c) { const bool vl = lane + 64 * c < (int)mc; kc[c] = vl ? candk[q * CAP + lane + 64 * c] : 0u; ic[c] = vl ? candi[q * CAP + lane + 64 * c] : 0xffffffffu; rk[c] = 0u; }
#pragma unroll 4
                    for (unsigned j = 0; j < mc; ++j) { const unsigned kj = candk[q * CAP + j], ij = candi[q * CAP + j];
#pragma unroll
                        for (int c = 0; c < 4; ++c) rk[c] += (kj > kc[c] || (kj == kc[c] && ij < ic[c])) ? 1u : 0u; }
#pragma unroll
                    for (int c = 0; c < 4; ++c) if (lane + 64 * c < (int)mc && rk[c] < need1) outl[q * 256 + D0 + rk[c]] = ic[c];
                    if (lane == 0) qm[q * 16 + 5] = 0u;
                } else if (lane == 0) qm[q * 16 + 5] = 1u;
            }
            __syncthreads();
            ovf = (qm[5] | qm[16 + 5] | qm[32 + 5] | qm[48 + 5]) != 0u;
            if (ovf) {
            for (int s0 = 0; s0 < nsl; s0 += 8) { float v[8];
#pragma unroll
                for (int j = 0; j < 8; ++j) { const int i = (s0 + j) * 128 + th; v[j] = scq[min(i, n - 1)]; }
#pragma unroll
                for (int j = 0; j < 8; ++j) { const int i = (s0 + j) * 128 + th; const int bin = min(max((int)((v[j] - fmn) * bsc), 0), 255);
                    if (i < n && bin == bstar) { const unsigned pc = __hip_atomic_fetch_add(&qm[q * 16 + 2], 1u, __ATOMIC_RELAXED, __HIP_MEMORY_SCOPE_WORKGROUP); if (pc < (unsigned)CAP) candk[q * CAP + pc] = f2key(v[j]); } } }
            __syncthreads();
            if (sub == 0) {
                const unsigned mc = qm[q * 16 + 2]; unsigned T = 0u, nt = 0u; bool found = false;
                if (mc <= (unsigned)CAP) {
                    unsigned kc[4], gt[4], ge[4];
#pragma unroll
                    for (int c = 0; c < 4; ++c) { kc[c] = (lane + 64 * c < (int)mc) ? candk[q * CAP + lane + 64 * c] : 0u; gt[c] = 0u; ge[c] = 0u; }
                    for (unsigned j = 0; j < mc; ++j) { const unsigned kj = candk[q * CAP + j];
#pragma unroll
                        for (int c = 0; c < 4; ++c) { gt[c] += (kj > kc[c]) ? 1u : 0u; ge[c] += (kj >= kc[c]) ? 1u : 0u; } }
#pragma unroll
                    for (int c = 0; c < 4; ++c) if (lane + 64 * c < (int)mc && gt[c] < need1 && need1 <= ge[c]) { T = kc[c]; nt = need1 - gt[c]; found = true; }
                } else {
                    unsigned lo = 0u;
                    for (int bit = 31; bit >= 0; --bit) { const unsigned cand = lo | (1u << bit); unsigned c = 0u;
                        for (int i = lane; i < n; i += 64) c += (f2key(scq[i]) >= cand) ? 1u : 0u;
#pragma unroll
                        for (int o = 1; o < 64; o <<= 1) c += __shfl_xor(c, o);
                        if (c >= (unsigned)TOPK) lo = cand; }
                    unsigned cg = 0u;
                    for (int i = lane; i < n; i += 64) cg += (f2key(scq[i]) > lo) ? 1u : 0u;
#pragma unroll
                    for (int o = 1; o < 64; o <<= 1) cg += __shfl_xor(cg, o);
                    T = lo; nt = (unsigned)TOPK - cg; found = (lane == 0);
                }
                if (found) { qm[q * 16 + 0] = T; qm[q * 16 + 1] = nt; }
            }
            __syncthreads();
            const unsigned T = qm[q * 16 + 0], need = qm[q * 16 + 1];
            unsigned Gs = 0u, Es = 0u;
            for (int s0 = 0; s0 < nsl; s0 += 8) { float v[8];
#pragma unroll
                for (int j = 0; j < 8; ++j) { const int i = (s0 + j) * 128 + th; v[j] = scq[min(i, n - 1)]; }
#pragma unroll
                for (int j = 0; j < 8; ++j) { const int i = (s0 + j) * 128 + th; const bool ok = i < n; const unsigned k = f2key(v[j]);
                    Gs += (unsigned)__popcll(__ballot(ok && k > T)); Es += (unsigned)__popcll(__ballot(ok && k == T)); } }
            if (lane == 0) { qm[q * 16 + 10 + sub * 2] = Gs; qm[q * 16 + 11 + sub * 2] = Es; }
            __syncthreads();
            const unsigned G0 = qm[q * 16 + 10], E0 = qm[q * 16 + 11], E1 = qm[q * 16 + 13];
            bool slow = false;
#pragma unroll
            for (int qx = 0; qx < 4; ++qx) slow = slow || (qm[qx * 16 + 11] + qm[qx * 16 + 13] != qm[qx * 16 + 1]);
            (void)E1;
            if (!slow) {
                unsigned run = sub ? (G0 + E0) : 0u;
                for (int s0 = 0; s0 < nsl; s0 += 8) { float v[8];
#pragma unroll
                    for (int j = 0; j < 8; ++j) { const int i = (s0 + j) * 128 + th; v[j] = scq[min(i, n - 1)]; }
#pragma unroll
                    for (int j = 0; j < 8; ++j) { const int i = (s0 + j) * 128 + th; const bool sel = (i < n) && f2key(v[j]) >= T; const unsigned long long bs = __ballot(sel);
                        const unsigned pos = run + __builtin_amdgcn_mbcnt_hi((unsigned)(bs >> 32), __builtin_amdgcn_mbcnt_lo((unsigned)bs, 0u));
                        if (sel && pos < (unsigned)TOPK) candk[q * CAP + pos] = (unsigned)i; run += (unsigned)__popcll(bs); } }
            } else {
            unsigned myG = 0u, myE = 0u;
            for (int s0 = 0; s0 < nsl; s0 += 8) { float v[8];
#pragma unroll
                for (int j = 0; j < 8; ++j) { const int i = (s0 + j) * 128 + th; v[j] = scq[min(i, n - 1)]; }
#pragma unroll
                for (int j = 0; j < 8; ++j) { const int s2 = s0 + j, i = s2 * 128 + th; const bool ok = i < n; const unsigned k = f2key(v[j]); const unsigned long long bg = __ballot(ok && k > T), be = __ballot(ok && k == T);
                    const unsigned cg = (unsigned)__popcll(bg), ce = (unsigned)__popcll(be); myG = (lane == s2) ? cg : myG; myE = (lane == s2) ? ce : myE; } }
            cntG[(q * 2 + sub) * 64 + lane] = myG; cntE[(q * 2 + sub) * 64 + lane] = myE;
            __syncthreads();
            unsigned tbase, pbase;
            { const unsigned e0 = cntE[(q * 2) * 64 + lane], e1 = cntE[(q * 2 + 1) * 64 + lane], g0 = cntG[(q * 2) * 64 + lane], g1 = cntG[(q * 2 + 1) * 64 + lane];
              unsigned inc = e0 + e1;
#pragma unroll
              for (int o = 1; o < 64; o <<= 1) { const unsigned v = __shfl_up(inc, o); if (lane >= o) inc += v; }
              const unsigned tb0 = inc - (e0 + e1), tb1 = tb0 + e0;
              const unsigned se0 = (need > tb0) ? min(need - tb0, e0) : 0u, se1 = (need > tb1) ? min(need - tb1, e1) : 0u;
              const unsigned c0 = g0 + se0, c1 = g1 + se1; unsigned inc2 = c0 + c1;
#pragma unroll
              for (int o = 1; o < 64; o <<= 1) { const unsigned v = __shfl_up(inc2, o); if (lane >= o) inc2 += v; }
              const unsigned pb0 = inc2 - (c0 + c1);
              tbase = sub ? tb1 : tb0; pbase = sub ? pb0 + c0 : pb0; }
            for (int s0 = 0; s0 < nsl; s0 += 8) { float v[8];
#pragma unroll
                for (int j = 0; j < 8; ++j) { const int i = (s0 + j) * 128 + th; v[j] = scq[min(i, n - 1)]; }
#pragma unroll
                for (int j = 0; j < 8; ++j) { const int s2 = s0 + j; if (s2 < nsl) { const int i = s2 * 128 + th; const bool ok = i < n; const unsigned k = f2key(v[j]); const bool g = ok && k > T, e = ok && k == T;
                    const unsigned long long be = __ballot(e);
                    const unsigned trank = (unsigned)__builtin_amdgcn_readlane((int)tbase, s2) + __builtin_amdgcn_mbcnt_hi((unsigned)(be >> 32), __builtin_amdgcn_mbcnt_lo((unsigned)be, 0u));
                    const bool sel = g || (e && trank < need);
                    const unsigned long long bs = __ballot(sel);
                    const unsigned pos = (unsigned)__builtin_amdgcn_readlane((int)pbase, s2) + __builtin_amdgcn_mbcnt_hi((unsigned)(bs >> 32), __builtin_amdgcn_mbcnt_lo((unsigned)bs, 0u));
                    if (sel && pos < (unsigned)TOPK) candk[q * CAP + pos] = (unsigned)i; } } }
            }
            }
        }
        __syncthreads();
        if (tmax + 1 > TOPK) { const LAS unsigned* src = ovf ? candk + q * CAP : outl + q * 256; for (int i = th; i < TOPK; i += 128) IDX[(size_t)tok * TOPK + i] = (int)src[i]; }
    }
}

__device__ __forceinline__ void p13b_dsa_attn(Frame& F, const Args& A) {
    unsigned char* ws = A.ws; const int lane = F.lane, wid = F.wave, c16 = lane & 15, g4 = lane >> 4;
    const bf16* CN = (const bf16*)(ws + WS_CN); const bf16* QL = (const bf16*)(ws + WS_QLAT); const int* IDX = (const int*)(ws + WS_IDX); bf16* OL = (bf16*)(ws + WS_OLAT);
    LAS float* lut = (LAS float*)(F.lds + DSA_SCR + 8192);
    for (int i = F.tid; i < 144 * 16; i += 512) { const int n = i >> 4, h = i & 15; lut[i] = A.in[1][rel_bucket(n) * 16 + h]; }
    __syncthreads();
    LAS char* img = (LAS char*)(F.lds + RING_OFF + wid * 16384);
    LAS int* idxw = (LAS int*)(F.lds + DSA_SCR + wid * 1024);
    const unsigned imgb = (unsigned)(uintptr_t)img;
    const int gw = F.vcu * NWAVES + wid, NGW = F.G * NWAVES;
    const unsigned prow0 = 8u * ((lane >> 2) & 3) + (lane & 3);
    unsigned ta0[8], ta1[8];
    { const unsigned qq = (lane & 15) >> 2, pp = lane & 3;
#pragma unroll
      for (int c = 0; c < 8; ++c) { ta0[c] = imgb + dsa_off_b(8 * g4 + qq, 2 * c + (pp >> 1)) + 8 * (pp & 1); ta1[c] = imgb + dsa_off_b(8 * g4 + 4 + qq, 2 * c + (pp >> 1)) + 8 * (pp & 1); } }
    (void)gw; (void)NGW;
    for (int j = wid; ; j += NWAVES) {
        const int slot = F.vcu + (j >> 2) * F.G; if (slot >= NTOK / 4) break;
        const int tok = P13A_TOK0(slot) + (j & 3);
        const int b = tok >> 13, t = tok & (SEQ - 1), cnt = min(TOPK, t + 1), ntile = (cnt + 31) >> 5;
        bf16x8 qb[8];
#pragma unroll
        for (int ks = 0; ks < 8; ++ks) qb[ks] = *(const bf16x8*)(QL + (size_t)tok * 4096 + c16 * 256 + ks * 32 + g4 * 8);
#pragma unroll
        for (int i = 0; i < 4; ++i) idxw[lane + 64 * i] = IDX[(size_t)tok * TOPK + lane + 64 * i];
        WSYNC();
        f32x4 o[16];
#pragma unroll
        for (int ct = 0; ct < 16; ++ct) o[ct] = (f32x4){0.f, 0.f, 0.f, 0.f};
        float m_run = -1e30f, l_run = 0.f;
        const LAS float* lutcol = lut + c16;
#pragma unroll 1
        for (int tile = 0; tile < ntile; ++tile) {
            { v4u st[16];
#pragma unroll
              for (int i = 0; i < 16; ++i) { const int nn = lane + 64 * i, row = nn >> 5, chg = nn & 31; const int key = idxw[tile * 32 + row];
                  st[i] = *(const v4u*)(CN + (size_t)(b * SEQ + key) * KVR + chg * 8); }
#pragma unroll
              for (int i = 0; i < 16; ++i) { const int nn = lane + 64 * i, row = nn >> 5, chg = nn & 31;
                  *(LAS v4u*)(img + (chg >> 4) * 8192 + dsa_off_b(row, chg & 15)) = st[i]; } }
            WSYNC();
            f32x4 sacc[2];
#pragma unroll
            for (int T = 0; T < 2; ++T) { sacc[T] = (f32x4){0.f, 0.f, 0.f, 0.f};
#pragma unroll
                for (int ks = 0; ks < 8; ++ks) { const bf16x8 a = *(const LAS bf16x8*)(img + (ks >> 2) * 8192 + dsa_off_b(prow0 + 4 * T, 4 * (ks & 3) + g4));
                    sacc[T] = __builtin_amdgcn_mfma_f32_16x16x32_bf16(a, qb[ks], sacc[T], 0, 0, 0); } }
            float pmax = -__builtin_inff();
#pragma unroll
            for (int T = 0; T < 2; ++T) { const int i0 = tile * 32 + 8 * g4 + 4 * T; const v4u kk = *(const LAS v4u*)(idxw + i0);
                const int kidx[4] = {(int)kk.x, (int)kk.y, (int)kk.z, (int)kk.w};
#pragma unroll
                for (int e = 0; e < 4; ++e) { const int dist = min(max(t - kidx[e], 0), 128); float s = sacc[T][e] + lutcol[dist * 16];
                    s = (i0 + e < cnt) ? s : -__builtin_inff(); sacc[T][e] = s; pmax = fmaxf(pmax, s); } }
            pmax = max_xor16(pmax); pmax = max_xor32(pmax);
            const float mn = fmaxf(m_run, pmax), alpha = __builtin_amdgcn_exp2f((m_run - mn) * fa::C2); m_run = mn;
            float ps = 0.f;
#pragma unroll
            for (int T = 0; T < 2; ++T)
#pragma unroll
                for (int e = 0; e < 4; ++e) { const float pv = __builtin_amdgcn_exp2f((sacc[T][e] - mn) * fa::C2); sacc[T][e] = pv; ps += pv; }
            ps = sum_xor16(ps); ps = sum_xor32(ps);
            l_run = l_run * alpha + ps;
            if (__any(alpha < 1.f)) {
                float al[4];
#pragma unroll
                for (int e = 0; e < 4; ++e) al[e] = __shfl(alpha, 4 * g4 + e);
#pragma unroll
                for (int ct = 0; ct < 16; ++ct)
#pragma unroll
                    for (int e = 0; e < 4; ++e) o[ct][e] *= al[e];
            }
            fa::u32x4v pw; pw.x = fa::cvtpk(sacc[0][0], sacc[0][1]); pw.y = fa::cvtpk(sacc[0][2], sacc[0][3]); pw.z = fa::cvtpk(sacc[1][0], sacc[1][1]); pw.w = fa::cvtpk(sacc[1][2], sacc[1][3]);
            const bf16x8 pa = *reinterpret_cast<bf16x8*>(&pw);
#pragma unroll
            for (int cg = 0; cg < 4; ++cg) { fa::s16x4 b0[4], b1[4];
                asm volatile("ds_read_b64_tr_b16 %0, %8 offset:%c16\n\tds_read_b64_tr_b16 %1, %9 offset:%c16\n\tds_read_b64_tr_b16 %2, %10 offset:%c16\n\tds_read_b64_tr_b16 %3, %11 offset:%c16\n\t"
                             "ds_read_b64_tr_b16 %4, %12 offset:%c16\n\tds_read_b64_tr_b16 %5, %13 offset:%c16\n\tds_read_b64_tr_b16 %6, %14 offset:%c16\n\tds_read_b64_tr_b16 %7, %15 offset:%c16\n\ts_waitcnt lgkmcnt(0)"
                             : "=&v"(b0[0]), "=&v"(b1[0]), "=&v"(b0[1]), "=&v"(b1[1]), "=&v"(b0[2]), "=&v"(b1[2]), "=&v"(b0[3]), "=&v"(b1[3])
                             : "v"(ta0[(cg & 1) * 4 + 0]), "v"(ta1[(cg & 1) * 4 + 0]), "v"(ta0[(cg & 1) * 4 + 1]), "v"(ta1[(cg & 1) * 4 + 1]), "v"(ta0[(cg & 1) * 4 + 2]), "v"(ta1[(cg & 1) * 4 + 2]), "v"(ta0[(cg & 1) * 4 + 3]), "v"(ta1[(cg & 1) * 4 + 3]), "i"((cg >> 1) * 8192) : "memory");
                FA_SBAR();
#pragma unroll
                for (int k = 0; k < 4; ++k) o[cg * 4 + k] = __builtin_amdgcn_mfma_f32_16x16x32_bf16(pa, (bf16x8){b0[k][0], b0[k][1], b0[k][2], b0[k][3], b1[k][0], b1[k][1], b1[k][2], b1[k][3]}, o[cg * 4 + k], 0, 0, 0); }
            WSYNC();
        }
        { const float il = (l_run > 0.f) ? 1.0f / l_run : 0.f; float ile[4];
#pragma unroll
          for (int e = 0; e < 4; ++e) ile[e] = __shfl(il, 4 * g4 + e);
#pragma unroll
          for (int ct = 0; ct < 16; ++ct)
#pragma unroll
              for (int e = 0; e < 4; ++e) { const float v = o[ct][e] * ile[e]; const float vn = dpp_xor1(v);
                  if ((lane & 1) == 0) *(unsigned*)(OL + (size_t)tok * 4096 + (4 * g4 + e) * 256 + ct * 16 + c16) = fa::cvtpk(v, vn); } }
        WSYNC();
    }
    __syncthreads();
}

struct MoeTiles { int tend[8]; int pstart[8]; int MT; };
__device__ __forceinline__ void moe_tiles(Frame& F, MoeTiles& T) {
    int acc = 0;
#pragma unroll
    for (int e = 0; e < 8; ++e) { const int c = (int)__builtin_amdgcn_readfirstlane(__hip_atomic_load((unsigned*)(F.ctl + CW_MOECNT + 64 * e), __ATOMIC_RELAXED, __HIP_MEMORY_SCOPE_AGENT));
        T.pstart[e] = acc * 256; acc += (c + 255) >> 8; T.tend[e] = acc; }
    T.MT = acc;
}
__device__ __forceinline__ void p15_gather(Frame& F, const Args& A) {
    MoeTiles T; moe_tiles(F, T);
    const int gw = F.vcu * NWAVES + F.wave, NGW = F.G * NWAVES, lane = F.lane;
    const bf16* XH = (const bf16*)(A.ws + WS_XF); unsigned char* XG = (unsigned char*)(A.ws + WS_XG);
    const int* re = (const int*)(A.ws + WS_ROUTE); const int* rp = re + 2 * NTOK;
    v4u xn[4];
    if (gw < NTOK) {
#pragma unroll
        for (int k = 0; k < 4; ++k) xn[k] = *(const v4u*)(XH + (size_t)gw * DM + 8 * lane + 512 * k); }
    for (int tok = gw; tok < NTOK; tok += NGW) {
        uint2 o[4];
#pragma unroll
        for (int k = 0; k < 4; ++k) { int w0 = __builtin_amdgcn_cvt_pk_fp8_f32(bflo(xn[k].x), bfhi(xn[k].x), 0, false); w0 = __builtin_amdgcn_cvt_pk_fp8_f32(bflo(xn[k].y), bfhi(xn[k].y), w0, true);
            int w1 = __builtin_amdgcn_cvt_pk_fp8_f32(bflo(xn[k].z), bfhi(xn[k].z), 0, false); w1 = __builtin_amdgcn_cvt_pk_fp8_f32(bflo(xn[k].w), bfhi(xn[k].w), w1, true); o[k].x = (unsigned)w0; o[k].y = (unsigned)w1; }
        const int e0 = re[2 * tok], e1 = re[2 * tok + 1], p0 = rp[2 * tok], p1 = rp[2 * tok + 1];
        if (tok + NGW < NTOK) {
#pragma unroll
            for (int k = 0; k < 4; ++k) xn[k] = *(const v4u*)(XH + (size_t)(tok + NGW) * DM + 8 * lane + 512 * k); }
        __builtin_amdgcn_sched_barrier(0);
#pragma unroll
        for (int s = 0; s < 2; ++s) { const int e = s ? e1 : e0, pp = s ? p1 : p0; int ps = 0;
#pragma unroll
            for (int q = 0; q < 8; ++q) ps = (q == e) ? T.pstart[q] : ps;
            unsigned char* dst = XG + (size_t)(ps + pp) * DM + 8 * lane;
#pragma unroll
            for (int k = 0; k < 4; ++k) *(uint2*)(dst + 512 * k) = o[k]; }
    }
}
__device__ __forceinline__ void p18_final(Frame& F, const Args& A) {
    MoeTiles T; moe_tiles(F, T);
    const int gw = F.vcu * NWAVES + F.wave, NGW = F.G * NWAVES, lane = F.lane;
    const bf16* XH = (const bf16*)(A.ws + WS_XF); const bf16* Y = (const bf16*)(A.ws + WS_Y);
    const int* re = (const int*)(A.ws + WS_ROUTE); const int* rp = re + 2 * NTOK; const float* rw = (const float*)(rp + 2 * NTOK);
    const float* gam = A.in[25] + DM; const float* bet = A.in[26] + DM;
    LAS float* gml = (LAS float*)(F.lds + DSA_SCR); LAS float* btl = gml + DM;
    { const int i = F.tid; *(LAS f32x4*)(gml + i * 4) = *(const f32x4*)(gam + i * 4); *(LAS f32x4*)(btl + i * 4) = *(const f32x4*)(bet + i * 4); }
    __syncthreads();
    int en[2][2], pn[2][2]; float wn[2][2];
#pragma unroll
    for (int u = 0; u < 2; ++u) { const int t = min(gw + u * NGW, NTOK - 1); en[u][0] = re[2 * t]; en[u][1] = re[2 * t + 1]; pn[u][0] = rp[2 * t]; pn[u][1] = rp[2 * t + 1]; wn[u][0] = rw[2 * t]; wn[u][1] = rw[2 * t + 1]; }
    for (int tok = gw; tok < NTOK; tok += 2 * NGW) {
        int rows[2][2]; float w[2][2]; int tk[2];
#pragma unroll
        for (int u = 0; u < 2; ++u) { tk[u] = min(tok + u * NGW, NTOK - 1);
#pragma unroll
            for (int s = 0; s < 2; ++s) { const int e = en[u][s]; int ps = 0;
#pragma unroll
                for (int q = 0; q < 8; ++q) ps = (q == e) ? T.pstart[q] : ps;
                rows[u][s] = ps + pn[u][s]; w[u][s] = wn[u][s]; } }
#pragma unroll
        for (int u = 0; u < 2; ++u) { const int t = min(tok + (2 + u) * NGW, NTOK - 1); en[u][0] = re[2 * t]; en[u][1] = re[2 * t + 1]; pn[u][0] = rp[2 * t]; pn[u][1] = rp[2 * t + 1]; wn[u][0] = rw[2 * t]; wn[u][1] = rw[2 * t + 1]; }
        v4u xa[2][4], ya[2][4], yb[2][4];
#pragma unroll
        for (int u = 0; u < 2; ++u) { const v4u* xr = (const v4u*)(XH + (size_t)tk[u] * DM) + lane; const v4u* y0 = (const v4u*)(Y + (size_t)rows[u][0] * DM) + lane; const v4u* y1 = (const v4u*)(Y + (size_t)rows[u][1] * DM) + lane;
#pragma unroll
            for (int j = 0; j < 4; ++j) { xa[u][j] = xr[64 * j]; ya[u][j] = y0[64 * j]; yb[u][j] = y1[64 * j]; } }
#pragma unroll
        for (int u = 0; u < 2; ++u) {
            f32x4 v[8]; float s = 0.f;
#pragma unroll
            for (int j = 0; j < 4; ++j) { const v4u x4 = xa[u][j], a4 = ya[u][j], b4 = yb[u][j];
                v[2 * j] = (f32x4){bflo(x4.x), bfhi(x4.x), bflo(x4.y), bfhi(x4.y)} * ALPHA + (f32x4){bflo(a4.x), bfhi(a4.x), bflo(a4.y), bfhi(a4.y)} * w[u][0] + (f32x4){bflo(b4.x), bfhi(b4.x), bflo(b4.y), bfhi(b4.y)} * w[u][1];
                v[2 * j + 1] = (f32x4){bflo(x4.z), bfhi(x4.z), bflo(x4.w), bfhi(x4.w)} * ALPHA + (f32x4){bflo(a4.z), bfhi(a4.z), bflo(a4.w), bfhi(a4.w)} * w[u][0] + (f32x4){bflo(b4.z), bfhi(b4.z), bflo(b4.w), bfhi(b4.w)} * w[u][1];
                s += ((v[2 * j][0] + v[2 * j][1]) + (v[2 * j][2] + v[2 * j][3])) + ((v[2 * j + 1][0] + v[2 * j + 1][1]) + (v[2 * j + 1][2] + v[2 * j + 1][3])); }
            const float mean = wave_sum(s) * (1.f / DM); float s2 = 0.f;
#pragma unroll
            for (int j = 0; j < 8; ++j) { v[j] = v[j] - mean; s2 += (v[j][0] * v[j][0] + v[j][1] * v[j][1]) + (v[j][2] * v[j][2] + v[j][3] * v[j][3]); }
            const float rstd = 1.f / sqrtf(wave_sum(s2) * (1.f / DM) + LN_EPS);
            if (tok + u * NGW < NTOK) {
#pragma unroll
                for (int j = 0; j < 4; ++j) { const int c = 8 * lane + 512 * j;
                    *(f32x4*)(A.out + (size_t)tk[u] * DM + c) = v[2 * j] * rstd * *(const LAS f32x4*)(gml + c) + *(const LAS f32x4*)(btl + c);
                    *(f32x4*)(A.out + (size_t)tk[u] * DM + c + 4) = v[2 * j + 1] * rstd * *(const LAS f32x4*)(gml + c + 4) + *(const LAS f32x4*)(btl + c + 4); } }
        }
    }
}

__global__ void __launch_bounds__(NWAVES * 64, 2) mega_fwd(Args args) {
    extern __shared__ __attribute__((aligned(16))) unsigned char lds[];
    Frame F;
    F.lds = (LAS unsigned char*)lds;
    F.MISC = (volatile LAS unsigned*)(F.lds + MISC_OFF);
    F.tid = threadIdx.x; F.lane = F.tid & 63; F.wave = __builtin_amdgcn_readfirstlane(F.tid >> 6);
    F.G = gridDim.x; { const int bx = blockIdx.x; F.vcu = (F.G % 8 == 0) ? (bx % 8) * (F.G / 8) + bx / 8 : bx; }
    unsigned char* ws = args.ws;
    F.ctl = (gu32*)(ws + WS_CTL);
    for (int u = F.tid; u < (LDS_BYTES - LDSCTL_OFF) / 4; u += NWAVES * 64) ((LAS unsigned*)(F.lds + LDSCTL_OFF))[u] = 0u;
    __syncthreads();
    XcdBarrier bar; bar.bar = (unsigned*)(F.ctl + CW_BAR); bar.x = 0; bar.st = nullptr;
#if !MK_PER_PHASE
    bar = xcd_barrier_post((unsigned*)(F.ctl + CW_BAR), F.MISC + 8);
#define GRID_BAR() xcd_barrier(bar)
#else
#define GRID_BAR() do { } while (0)
#endif
    const int lo = args.ph_lo, hi = args.ph_hi;
#ifndef PH_MASK
#define PH_MASK 0x3fffff
#endif
#define IN(k) (((PH_MASK >> (k)) & 1) && lo <= (k) && (k) < hi)
#define BOTH(k) (IN(k) && IN((k) + 1))
    bf16* XB = (bf16*)(ws + WS_XB); bf16* XH = (bf16*)(ws + WS_XF); bf16* Z = (bf16*)(ws + WS_Z);

#ifndef PROBE_MASK
#define PROBE_MASK 0
#endif
#define REPS(k) ((((PROBE_MASK) >> (k)) & 1) ? 2 : 1)
    if (IN(0)) for (int rep_ = 0; rep_ < REPS(0); ++rep_) { relaunder(F); p0_prologue(F, args); if (BOTH(0) || rep_ + 1 < REPS(0)) GRID_BAR(); }
    if (IN(1)) for (int rep_ = 0; rep_ < REPS(1); ++rep_) { relaunder(F);
        pg8::Gemm g{XB, (const bf16*)(ws + WS_W_NSA_IN), NTOK, 5120, DM}; pg8::StaticOrder S; S.init(NTOK, 5120, F.G, (int)blockIdx.x);
        pg8::EpiNsaIn E{(bf16*)(ws + WS_P0), (float*)(ws + WS_GL), 0.08838834764831845f};
        pg8::gemm_phase<pg8::EpiNsaIn, pg8::StaticOrder, true, true>(F.lds + RING_OFF, g, S, E);
        if (BOTH(1) || rep_ + 1 < REPS(1)) GRID_BAR();
    }
    if (IN(2)) for (int rep_ = 0; rep_ < REPS(2); ++rep_) { relaunder(F); p2_compress(F, args); if (BOTH(2) || rep_ + 1 < REPS(2)) GRID_BAR(); }
#ifndef PROBE_NSA2
#define PROBE_NSA2 0
#endif
    for (int repn_ = 0; repn_ < (PROBE_NSA2 ? 2 : 1); ++repn_) {
    if (IN(3)) for (int rep_ = 0; rep_ < REPS(3); ++rep_) { relaunder(F); p3a_nsa_cmp(F, args); __syncthreads(); }
    if (IN(4)) for (int rep_ = 0; rep_ < REPS(4); ++rep_) { relaunder(F); p3b_nsa_sel(F, args); if (BOTH(4) || rep_ + 1 < REPS(4) || repn_ + 1 < (PROBE_NSA2 ? 2 : 1)) GRID_BAR(); }
    }
    if (IN(6)) for (int rep_ = 0; rep_ < REPS(6); ++rep_) { relaunder(F);
        pg8::Gemm g{(const bf16*)(ws + WS_OATT0), (const bf16*)(ws + WS_W_NSA_OUT), NTOK, DM, DM}; pg8::StaticOrder S; S.init(NTOK, DM, F.G, (int)blockIdx.x);
        pg8::EpiResF32 E{args.in[0], Z, ALPHA, DM};
        pg8::gemm_phase<pg8::EpiResF32, pg8::StaticOrder, true, true>(F.lds + RING_OFF, g, S, E);
        if (BOTH(6) || rep_ + 1 < REPS(6)) GRID_BAR();
    }
    if (IN(7)) for (int rep_ = 0; rep_ < REPS(7); ++rep_) { relaunder(F); ln_phase<false, FFN_F8 != 0>(F, args, Z, args.in[23], args.in[24], XH, (unsigned char*)XB); if (BOTH(7) || rep_ + 1 < REPS(7)) GRID_BAR(); }
    if (IN(8)) for (int rep_ = 0; rep_ < REPS(8); ++rep_) { relaunder(F);
        pg8::StaticOrder S; S.init(NTOK, 2 * DFF, F.G, (int)blockIdx.x);
#if FFN_F8
        pg8::Gemm g{XB, (const bf16*)(ws + WS_W_FFN_GU), NTOK, 2 * DFF, DM, 1, 0x79797979};
        pg8::EpiSwiGLU8 E{(unsigned char*)(ws + WS_HFF), DFF};
        pg8::gemm_phase<pg8::EpiSwiGLU8, pg8::StaticOrder, true, true, true>(F.lds + RING_OFF, g, S, E);
#else
        pg8::Gemm g{XB, (const bf16*)(ws + WS_W_FFN_GU), NTOK, 2 * DFF, DM};
        pg8::EpiSwiGLU E{(bf16*)(ws + WS_HFF), DFF};
        pg8::gemm_phase<pg8::EpiSwiGLU, pg8::StaticOrder, true, true>(F.lds + RING_OFF, g, S, E);
#endif
        if (BOTH(8) || rep_ + 1 < REPS(8)) GRID_BAR();
    }
    if (IN(9)) for (int rep_ = 0; rep_ < REPS(9); ++rep_) { relaunder(F);
        pg8::StaticOrder S; S.init(NTOK, DM, F.G, (int)blockIdx.x);
        pg8::EpiResH E{XH, Z, ALPHA, DM};
#if FFN_F8
        pg8::Gemm g{(const bf16*)(ws + WS_HFF), (const bf16*)(ws + WS_W_FFN_DN), NTOK, DM, DFF, 1, 0x77777777};
        pg8::gemm_phase<pg8::EpiResH, pg8::StaticOrder, true, true, true>(F.lds + RING_OFF, g, S, E);
#else
        pg8::Gemm g{(const bf16*)(ws + WS_HFF), (const bf16*)(ws + WS_W_FFN_DN), NTOK, DM, DFF};
        pg8::gemm_phase<pg8::EpiResH, pg8::StaticOrder, true, true>(F.lds + RING_OFF, g, S, E);
#endif
        if (BOTH(9) || rep_ + 1 < REPS(9)) GRID_BAR();
    }
    if (IN(10)) for (int rep_ = 0; rep_ < REPS(10); ++rep_) { relaunder(F); ln_phase<false>(F, args, Z, args.in[25], args.in[26], XH, nullptr); if (BOTH(10) || rep_ + 1 < REPS(10)) GRID_BAR(); }
    if (IN(11)) for (int rep_ = 0; rep_ < REPS(11); ++rep_) { relaunder(F);
        pg8::Gemm g{XH, (const bf16*)(ws + WS_W_DSA_IN), NTOK, DSA_NPAD, DM}; pg8::StaticOrder S; S.init(NTOK, DSA_NPAD, F.G, (int)blockIdx.x);
        pg8::EpiDsaIn E{(bf16*)(ws + WS_Q), (float*)(ws + WS_CRAW), (bf16*)(ws + WS_QI), (float*)(ws + WS_KIWI), 0.125f};
        pg8::gemm_phase<pg8::EpiDsaIn, pg8::StaticOrder, true, true>(F.lds + RING_OFF, g, S, E);
        if (BOTH(11) || rep_ + 1 < REPS(11)) GRID_BAR();
    }
    if (IN(12)) for (int rep_ = 0; rep_ < REPS(12); ++rep_) { relaunder(F); p10_dsa_prep(F, args); if (BOTH(12) || rep_ + 1 < REPS(12)) GRID_BAR(); }
    if (IN(13)) for (int rep_ = 0; rep_ < REPS(13); ++rep_) { relaunder(F); p13a_dsa_index(F, args); __syncthreads(); }
    if (IN(14)) for (int rep_ = 0; rep_ < REPS(14); ++rep_) { relaunder(F); p13b_dsa_attn(F, args); if (BOTH(14) || rep_ + 1 < REPS(14)) GRID_BAR(); }
    if (IN(15)) for (int rep_ = 0; rep_ < REPS(15); ++rep_) { relaunder(F); p12_dsa_uv(F, args); if (BOTH(15) || rep_ + 1 < REPS(15)) GRID_BAR(); }
    if (IN(16)) for (int rep_ = 0; rep_ < REPS(16); ++rep_) { relaunder(F);
        pg8::Gemm g{(const bf16*)(ws + WS_OATT1), (const bf16*)(ws + WS_W_DSA_OUT), NTOK, DM, DM}; pg8::StaticOrder S; S.init(NTOK, DM, F.G, (int)blockIdx.x);
        pg8::EpiResH E{XH, Z, ALPHA, DM};
        pg8::gemm_phase<pg8::EpiResH, pg8::StaticOrder, true, true>(F.lds + RING_OFF, g, S, E);
        if (BOTH(16) || rep_ + 1 < REPS(16)) GRID_BAR();
    }
    if (IN(17)) for (int rep_ = 0; rep_ < REPS(17); ++rep_) { relaunder(F); ln_route_phase(F, args, Z, args.in[23] + DM, args.in[24] + DM, XH); if (BOTH(17) || rep_ + 1 < REPS(17)) GRID_BAR(); }
    if (IN(18)) for (int rep_ = 0; rep_ < REPS(18); ++rep_) { relaunder(F); p15_gather(F, args); if (BOTH(18) || rep_ + 1 < REPS(18)) GRID_BAR(); }
    if (IN(19)) for (int rep_ = 0; rep_ < REPS(19); ++rep_) { relaunder(F);
        MoeTiles T; moe_tiles(F, T);
        pg8::Gemm g{(const bf16*)(ws + WS_XG), (const bf16*)(ws + WS_W_MOE_GU), T.MT * 256, 2 * DFFE, DM, 1, 0x79797979}; pg8::MoeOrder S; S.init(T.MT * 256, 2 * DFFE, F.G, (int)blockIdx.x); S.nexp_rows = 2 * DFFE;
#pragma unroll
        for (int e = 0; e < 8; ++e) S.tend[e] = T.tend[e];
        pg8::EpiSwiGLU8 E{(unsigned char*)(ws + WS_HM), DFFE};
        pg8::gemm_phase<pg8::EpiSwiGLU8, pg8::MoeOrder, true, true, true>(F.lds + RING_OFF, g, S, E);
        if (BOTH(19) || rep_ + 1 < REPS(19)) GRID_BAR();
    }
    if (IN(20)) for (int rep_ = 0; rep_ < REPS(20); ++rep_) { relaunder(F);
        MoeTiles T; moe_tiles(F, T);
        pg8::Gemm g{(const bf16*)(ws + WS_HM), (const bf16*)(ws + WS_W_MOE_DN), T.MT * 256, DM, DFFE, 1, 0x77777777}; pg8::MoeOrder S; S.init(T.MT * 256, DM, F.G, (int)blockIdx.x); S.nexp_rows = DM;
#pragma unroll
        for (int e = 0; e < 8; ++e) S.tend[e] = T.tend[e];
        pg8::EpiBf16Plain E{(bf16*)(ws + WS_Y), DM};
        pg8::gemm_phase<pg8::EpiBf16Plain, pg8::MoeOrder, true, true, true>(F.lds + RING_OFF, g, S, E);
        if (BOTH(20) || rep_ + 1 < REPS(20)) GRID_BAR();
    }
    if (IN(21)) for (int rep_ = 0; rep_ < REPS(21); ++rep_) { relaunder(F); p18_final(F, args); }
#undef IN
#undef BOTH
}

extern "C" void kernel_launch(void* const* d_in, const int* in_sizes, int n_in, void* d_out, int out_size, void* d_ws, size_t ws_size, hipStream_t stream) {
    static int grid = 0;
    if (grid == 0) {
        if (n_in != 27 || out_size != NTOK * DM || ws_size < WS_END) { fprintf(stderr, "kernel_launch: unexpected shapes (n_in %d, out %d, ws %zu); nothing launched\n", n_in, out_size, ws_size); grid = -1; return; }
        int dev = 0, cus = 0, per_cu = 0;
        if (hipGetDevice(&dev) != hipSuccess || hipDeviceGetAttribute(&cus, hipDeviceAttributeMultiprocessorCount, dev) != hipSuccess) { grid = -1; return; }
        if (hipFuncSetAttribute((const void*)mega_fwd, hipFuncAttributeMaxDynamicSharedMemorySize, LDS_BYTES) != hipSuccess) { fprintf(stderr, "kernel_launch: hipFuncSetAttribute failed\n"); grid = -1; return; }
        if (hipOccupancyMaxActiveBlocksPerMultiprocessor(&per_cu, (const void*)mega_fwd, NWAVES * 64, LDS_BYTES) != hipSuccess || per_cu < 1) { fprintf(stderr, "kernel_launch: occupancy query says %d\n", per_cu); }
        (void)hipGetLastError();
        grid = cus;
    }
    if (grid < 0) return;
    if (hipMemsetAsync((char*)d_ws + WS_CTL, 0, CTL_ZERO_BYTES, stream) != hipSuccess) return;
    Args a{};
    for (int i = 0; i < 27; ++i) a.in[i] = (const float*)d_in[i];
    a.out = (float*)d_out; a.ws = (unsigned char*)d_ws;
#if MK_PER_PHASE
    for (int p = 0; p < NPHASE; ++p) { a.ph_lo = p; a.ph_hi = p + 1; hipLaunchKernelGGL(mega_fwd, dim3(grid), dim3(NWAVES * 64), LDS_BYTES, stream, a); }
#else
    a.ph_lo = 0; a.ph_hi = NPHASE;
    hipLaunchKernelGGL(mega_fwd, dim3(grid), dim3(NWAVES * 64), LDS_BYTES, stream, a);
#endif
}
```

```cpp
#include <hip/hip_runtime.h>
#include <cstdio>
#include <cstdint>
namespace pg8 {
#define PG8_LAS __attribute__((address_space(3)))
typedef unsigned short bf16_t;
typedef short bf16x8 __attribute__((ext_vector_type(8)));
typedef float f32x4 __attribute__((ext_vector_type(4)));
typedef unsigned u32x4 __attribute__((ext_vector_type(4)));
constexpr int BM = 256, BK = 64, HALF = 128, HTB = HALF * BK * 2  , STAGE_BYTES = 8 * HTB, NXCD = 8, WGM = 8;

__host__ __device__ __forceinline__ int lds_byte(int r, int c) { const int st = (r >> 4) * 2 + (c >> 5), rr = r & 15, cc = c & 31, ob = rr * 64 + cc * 2; return st * 1024 + (ob ^ (((ob >> 9) & 1) << 5)); }
__host__ __device__ __forceinline__ void stage_rc(int b, int& R, int& C) { const int st = b / 1024, sb = b % 1024, swz = sb ^ (((sb >> 9) & 1) << 5); R = (st >> 1) * 16 + swz / 64; C = (st & 1) * 32 + (swz % 64) / 2; }
__host__ __device__ __forceinline__ int perm32(int rho) { const int n = rho >> 4, i = rho & 15; return 8 * (i >> 2) + 4 * n + (i & 3); }

struct Unit { int pm, pn; };
struct Gemm { const bf16_t* A; const bf16_t* Bt; int M, N, K; int esz = 2; int scale = 0x7f7f7f7f; int lda = 0; };

struct StaticOrder {
    int nM, nN, nwg, G, c;
    __host__ __device__ void init(int M, int N, int G_, int c_) { nM = M / BM; nN = N / BM; nwg = nM * nN; G = G_; c = c_; }
    __host__ __device__ bool next(int i, Unit& u) const {
        const long L = (long)i * G + c; if (L >= nwg) return false;
        int wgid = (int)L; { const int q = nwg / NXCD, r = nwg % NXCD, xcd = wgid % NXCD, off = wgid / NXCD; wgid = (xcd < r ? xcd * (q + 1) : r * (q + 1) + (xcd - r) * q) + off; }
        const int nig = WGM * nN, gid = wgid / nig, fm = gid * WGM, gsz = (nM - fm) < WGM ? (nM - fm) : WGM;
        u.pm = fm + ((wgid % nig) % gsz); u.pn = (wgid % nig) / gsz; return true;
    }
    __device__ __forceinline__ void a_ready(const Unit&) const {}
    __device__ __forceinline__ void done(const Unit&) const {}
    __device__ __forceinline__ const char* a_ptr(const Gemm& g, const Unit& u) const { return (const char*)g.A + (size_t)u.pm * ((size_t)BM * (g.lda ? g.lda : g.K) * g.esz); }
    __device__ __forceinline__ const char* b_ptr(const Gemm& g, const Unit& u) const { return (const char*)g.Bt + (size_t)u.pn * ((size_t)BM * g.K * g.esz); }
};


__device__ __forceinline__ unsigned cvt_pk_bf16(float lo, float hi) { unsigned r; asm volatile("v_cvt_pk_bf16_f32 %0, %1, %2" : "=v"(r) : "v"(lo), "v"(hi)); return r; }
__device__ __forceinline__ u32x4 pack8(const f32x4 v0, const f32x4 v1) { u32x4 w; w.x = cvt_pk_bf16(v0[0], v0[1]); w.y = cvt_pk_bf16(v0[2], v0[3]); w.z = cvt_pk_bf16(v1[0], v1[1]); w.w = cvt_pk_bf16(v1[2], v1[3]); return w; }

struct EpiNsaIn {
    static constexpr bool PERM = true, AFTER_DRAIN = false;
    bf16_t* P0; float* GL; float qscale;
    __device__ __forceinline__ void operator()(const f32x4 (&acc)[2][2][4][2], const Unit& u, int wr, int wc, int fr, int fq) const {
        const int row0 = u.pm * BM + wr * 64 + fr;
        if (u.pn < 20) {
            const float s = u.pn < 8 ? qscale : 1.0f;
            const int col0 = u.pn * BM + wc * 32 + 8 * fq;
#pragma unroll
            for (int ai = 0; ai < 2; ++ai)
#pragma unroll
                for (int m = 0; m < 4; ++m) { bf16_t* rowp = P0 + (size_t)(row0 + ai * HALF + m * 16) * 5120 + col0;
#pragma unroll
                    for (int bj = 0; bj < 2; ++bj) *(u32x4*)(rowp + bj * HALF) = pack8(acc[ai][bj][m][0] * s, acc[ai][bj][m][1] * s); }
        } else {
            const int c = wc * 32 + 8 * fq;
            if (c < 48) {
#pragma unroll
                for (int ai = 0; ai < 2; ++ai)
#pragma unroll
                    for (int m = 0; m < 4; ++m) { float* gp = GL + (size_t)(row0 + ai * HALF + m * 16) * 48 + c;
                        *(f32x4*)gp = acc[ai][0][m][0]; *(f32x4*)(gp + 4) = acc[ai][0][m][1]; }
            }
        }
    }
};
struct EpiDsaIn {
    static constexpr bool PERM = true, AFTER_DRAIN = false;
    bf16_t* Q; float* CRAW; bf16_t* QI; float* KIWI; float qiscale;
    __device__ __forceinline__ void operator()(const f32x4 (&acc)[2][2][4][2], const Unit& u, int wr, int wc, int fr, int fq) const {
        const int row0 = u.pm * BM + wr * 64 + fr; const int c = wc * 32 + 8 * fq;
        if (u.pn < 8) {
#pragma unroll
            for (int ai = 0; ai < 2; ++ai)
#pragma unroll
                for (int m = 0; m < 4; ++m) { bf16_t* rowp = Q + (size_t)(row0 + ai * HALF + m * 16) * 2048 + u.pn * BM + c;
#pragma unroll
                    for (int bj = 0; bj < 2; ++bj) *(u32x4*)(rowp + bj * HALF) = pack8(acc[ai][bj][m][0], acc[ai][bj][m][1]); }
        } else if (u.pn == 8) {
#pragma unroll
            for (int ai = 0; ai < 2; ++ai)
#pragma unroll
                for (int m = 0; m < 4; ++m) { float* rowp = CRAW + (size_t)(row0 + ai * HALF + m * 16) * 256 + c;
#pragma unroll
                    for (int bj = 0; bj < 2; ++bj) { *(f32x4*)(rowp + bj * HALF) = acc[ai][bj][m][0]; *(f32x4*)(rowp + bj * HALF + 4) = acc[ai][bj][m][1]; } }
        } else if (u.pn < 11) {
#pragma unroll
            for (int ai = 0; ai < 2; ++ai)
#pragma unroll
                for (int m = 0; m < 4; ++m) { bf16_t* rowp = QI + (size_t)(row0 + ai * HALF + m * 16) * 512 + (u.pn - 9) * BM + c;
#pragma unroll
                    for (int bj = 0; bj < 2; ++bj) *(u32x4*)(rowp + bj * HALF) = pack8(acc[ai][bj][m][0] * qiscale, acc[ai][bj][m][1] * qiscale); }
        } else {
#pragma unroll
            for (int ai = 0; ai < 2; ++ai)
#pragma unroll
                for (int m = 0; m < 4; ++m) { float* rowp = KIWI + (size_t)(row0 + ai * HALF + m * 16) * 128 + c;
                    *(f32x4*)rowp = acc[ai][0][m][0]; *(f32x4*)(rowp + 4) = acc[ai][0][m][1]; }
        }
    }
};
struct EpiResF32 {
    static constexpr bool PERM = true, AFTER_DRAIN = false;
    const float* R; bf16_t* Z; float alpha; int ldc;
    __device__ __forceinline__ void operator()(const f32x4 (&acc)[2][2][4][2], const Unit& u, int wr, int wc, int fr, int fq) const {
        const int row0 = u.pm * BM + wr * 64 + fr, col0 = u.pn * BM + wc * 32 + 8 * fq;
#pragma unroll
        for (int ai = 0; ai < 2; ++ai)
#pragma unroll
            for (int m = 0; m < 4; ++m) { const size_t off = (size_t)(row0 + ai * HALF + m * 16) * ldc + col0;
#pragma unroll
                for (int bj = 0; bj < 2; ++bj) { const f32x4 r0 = *(const f32x4*)(R + off + bj * HALF), r1 = *(const f32x4*)(R + off + bj * HALF + 4);
                    *(u32x4*)(Z + off + bj * HALF) = pack8(r0 * alpha + acc[ai][bj][m][0], r1 * alpha + acc[ai][bj][m][1]); } }
    }
};
struct EpiResH {
    static constexpr bool PERM = true, AFTER_DRAIN = false;
    const bf16_t* R; bf16_t* Z; float alpha; int ldc;
    __device__ __forceinline__ void operator()(const f32x4 (&acc)[2][2][4][2], const Unit& u, int wr, int wc, int fr, int fq) const {
        const int row0 = u.pm * BM + wr * 64 + fr, col0 = u.pn * BM + wc * 32 + 8 * fq;
#pragma unroll
        for (int ai = 0; ai < 2; ++ai)
#pragma unroll
            for (int m = 0; m < 4; ++m) { const size_t off = (size_t)(row0 + ai * HALF + m * 16) * ldc + col0;
#pragma unroll
                for (int bj = 0; bj < 2; ++bj) { const u32x4 rr = *(const u32x4*)(R + off + bj * HALF);
                    const f32x4 r0 = (f32x4){__uint_as_float(rr.x << 16), __uint_as_float(rr.x & 0xffff0000u), __uint_as_float(rr.y << 16), __uint_as_float(rr.y & 0xffff0000u)};
                    const f32x4 r1 = (f32x4){__uint_as_float(rr.z << 16), __uint_as_float(rr.z & 0xffff0000u), __uint_as_float(rr.w << 16), __uint_as_float(rr.w & 0xffff0000u)};
                    *(u32x4*)(Z + off + bj * HALF) = pack8(r0 * alpha + acc[ai][bj][m][0], r1 * alpha + acc[ai][bj][m][1]); } }
    }
};
struct EpiF32 {
    static constexpr bool PERM = false, AFTER_DRAIN = false;
    float* C; int ldc;
    __device__ __forceinline__ void operator()(const f32x4 (&acc)[2][2][4][2], const Unit& u, int wr, int wc, int fr, int fq) const {
        const int row0 = u.pm * BM + wr * 64 + fr, col0 = u.pn * BM + wc * 32 + 4 * fq;
#pragma unroll
        for (int ai = 0; ai < 2; ++ai)
#pragma unroll
            for (int m = 0; m < 4; ++m) { float* rowp = C + (size_t)(row0 + ai * HALF + m * 16) * ldc + col0;
#pragma unroll
                for (int bj = 0; bj < 2; ++bj)
#pragma unroll
                    for (int n = 0; n < 2; ++n) *(f32x4*)(rowp + bj * HALF + n * 16) = acc[ai][bj][m][n]; }
    }
};
struct EpiBf16Plain {
    static constexpr bool PERM = true, AFTER_DRAIN = false;
    bf16_t* C; int ldc;
    __device__ __forceinline__ void operator()(const f32x4 (&acc)[2][2][4][2], const Unit& u, int wr, int wc, int fr, int fq) const {
        const int row0 = u.pm * BM + wr * 64 + fr, col0 = u.pn * BM + wc * 32 + 8 * fq;
#pragma unroll
        for (int ai = 0; ai < 2; ++ai)
#pragma unroll
            for (int m = 0; m < 4; ++m) { bf16_t* rowp = C + (size_t)(row0 + ai * HALF + m * 16) * ldc + col0;
#pragma unroll
                for (int bj = 0; bj < 2; ++bj) *(u32x4*)(rowp + bj * HALF) = pack8(acc[ai][bj][m][0], acc[ai][bj][m][1]); }
    }
};
__device__ __forceinline__ float silu_mul(float g, float u) { return g * __builtin_amdgcn_rcpf(1.0f + __expf(-g)) * u; }
struct EpiSwiGLU {
    static constexpr bool PERM = true, AFTER_DRAIN = false;
    bf16_t* H; int ldh;
    __device__ __forceinline__ void operator()(const f32x4 (&acc)[2][2][4][2], const Unit& u, int wr, int wc, int fr, int fq) const {
        const int row0 = u.pm * BM + wr * 64 + fr, col0 = u.pn * HALF + wc * 32 + 8 * fq;
#pragma unroll
        for (int ai = 0; ai < 2; ++ai)
#pragma unroll
            for (int m = 0; m < 4; ++m) { bf16_t* rowp = H + (size_t)(row0 + ai * HALF + m * 16) * ldh + col0;
                f32x4 v0, v1;
#pragma unroll
                for (int j = 0; j < 4; ++j) { v0[j] = silu_mul(acc[ai][0][m][0][j], acc[ai][1][m][0][j]); v1[j] = silu_mul(acc[ai][0][m][1][j], acc[ai][1][m][1][j]); }
                *(u32x4*)rowp = pack8(v0, v1); }
    }
};
struct EpiSwiGLU8 {
    static constexpr bool PERM = true, AFTER_DRAIN = false;
    unsigned char* H; int ldh;
    __device__ __forceinline__ void operator()(const f32x4 (&acc)[2][2][4][2], const Unit& u, int wr, int wc, int fr, int fq) const {
        const int row0 = u.pm * BM + wr * 64 + fr, col0 = u.pn * HALF + wc * 32 + 8 * fq;
#pragma unroll
        for (int ai = 0; ai < 2; ++ai)
#pragma unroll
            for (int m = 0; m < 4; ++m) { unsigned char* rowp = H + (size_t)(row0 + ai * HALF + m * 16) * ldh + col0;
                float v[8];
#pragma unroll
                for (int j = 0; j < 4; ++j) { v[j] = silu_mul(acc[ai][0][m][0][j], acc[ai][1][m][0][j]); v[4 + j] = silu_mul(acc[ai][0][m][1][j], acc[ai][1][m][1][j]); }
                int w0 = __builtin_amdgcn_cvt_pk_fp8_f32(v[0], v[1], 0, false); w0 = __builtin_amdgcn_cvt_pk_fp8_f32(v[2], v[3], w0, true);
                int w1 = __builtin_amdgcn_cvt_pk_fp8_f32(v[4], v[5], 0, false); w1 = __builtin_amdgcn_cvt_pk_fp8_f32(v[6], v[7], w1, true);
                uint2 o; o.x = (unsigned)w0; o.y = (unsigned)w1; *(uint2*)rowp = o; }
    }
};
struct PairOrder : StaticOrder {
    int pn_shift, kslice;
    __device__ __forceinline__ const char* a_ptr(const Gemm& g, const Unit& u) const { return (const char*)g.A + ((size_t)u.pm * BM * g.lda + (size_t)(u.pn >> pn_shift) * kslice) * 2; }
};
struct EpiBf16Scale {
    static constexpr bool PERM = true, AFTER_DRAIN = false;
    bf16_t* C; int ldc; float scale;
    __device__ __forceinline__ void operator()(const f32x4 (&acc)[2][2][4][2], const Unit& u, int wr, int wc, int fr, int fq) const {
        const int row0 = u.pm * BM + wr * 64 + fr, col0 = u.pn * BM + wc * 32 + 8 * fq;
#pragma unroll
        for (int ai = 0; ai < 2; ++ai)
#pragma unroll
            for (int m = 0; m < 4; ++m) { bf16_t* rowp = C + (size_t)(row0 + ai * HALF + m * 16) * ldc + col0;
#pragma unroll
                for (int bj = 0; bj < 2; ++bj) *(u32x4*)(rowp + bj * HALF) = pack8(acc[ai][bj][m][0] * scale, acc[ai][bj][m][1] * scale); }
    }
};
struct MoeOrder : StaticOrder {
    int tend[8]; int nexp_rows;
    __device__ __forceinline__ int expert(int pm) const { int e = 0;
#pragma unroll
        for (int i = 0; i < 7; ++i) e += (pm >= tend[i]) ? 1 : 0; return e; }
    __device__ __forceinline__ const char* b_ptr(const Gemm& g, const Unit& u) const { return (const char*)g.Bt + ((size_t)expert(u.pm) * nexp_rows + (size_t)u.pn * BM) * ((size_t)g.K * g.esz); }
};
typedef int i32x8 __attribute__((ext_vector_type(8)));
typedef int i32x4 __attribute__((ext_vector_type(4)));
__device__ __forceinline__ i32x8 cat8(bf16x8 lo, bf16x8 hi) { const i32x4 a = *reinterpret_cast<const i32x4*>(&lo), b = *reinterpret_cast<const i32x4*>(&hi); return __builtin_shufflevector(a, b, 0, 1, 2, 3, 4, 5, 6, 7); }
template <class Epi, class Sched, bool ALIGN_EPI = false, bool SP2 = false, bool FP8 = false>
__device__ __forceinline__ void gemm_phase(PG8_LAS unsigned char* lds, const Gemm g, const Sched& S, const Epi& E) {
    int tid = threadIdx.x; asm volatile("" : "+v"(tid));
    const int wid = __builtin_amdgcn_readfirstlane(tid >> 6), lane = tid & 63, wr = wid >> 2, wc = wid & 3, fr = lane & 15, fq = lane >> 4;
    const int K = g.K, nt = K / (FP8 ? 2 * BK : BK), LDA = g.lda ? g.lda : g.K;
    unsigned voffA[2], voffB[2];
#pragma unroll
    for (int i = 0; i < 2; ++i) { int R, C; stage_rc(tid * 16 + i * 8192, R, C); const int Rb = Epi::PERM ? ((R & ~31) + perm32(R & 31)) : R;
        voffA[i] = FP8 ? (unsigned)(R * LDA + C * 2) : (unsigned)(R * LDA + C) * 2u; voffB[i] = FP8 ? (unsigned)(Rb * K + C * 2) : (unsigned)(Rb * K + C) * 2u; }
    const size_t kstep = (size_t)(BK * 2);
    const size_t hstep = (size_t)HALF * K * (FP8 ? 1 : 2), hstepA = (size_t)HALF * LDA * (FP8 ? 1 : 2);
    const size_t tstep = 2 * hstep;
    const unsigned ldsw = (unsigned)wid * 1024u;
    const int aoff = lds_byte(wr * 64 + fr, fq * 8), boff = lds_byte(wc * 32 + fr, fq * 8);
#define PG8_SA(b, h) (((b) * 2 + (h)) * HTB)
#define PG8_SB(b, h) ((4 + (b) * 2 + (h)) * HTB)
#define PG8_STAGE(bufoff, gbase, voff) do { _Pragma("unroll") for (int _i = 0; _i < 2; ++_i) \
        __builtin_amdgcn_global_load_lds((const unsigned*)((const char*)(gbase) + (voff)[_i]), (PG8_LAS unsigned*)(lds + (bufoff) + ldsw + _i * 8192), 16, 0, 0); } while (0)
#define PG8_LDA(dst, b, h) do { _Pragma("unroll") for (int m = 0; m < 4; ++m) { if constexpr (FP8) { const i32x4 lo_ = *(const PG8_LAS i32x4*)(lds + PG8_SA(b, h) + aoff + m * 2048), hi_ = *(const PG8_LAS i32x4*)(lds + PG8_SA(b, h) + aoff + m * 2048 + 1024); dst##8[m] = __builtin_shufflevector(lo_, hi_, 0, 1, 2, 3, 4, 5, 6, 7); } else { _Pragma("unroll") for (int k = 0; k < 2; ++k) dst[m][k] = *(const PG8_LAS bf16x8*)(lds + PG8_SA(b, h) + aoff + m * 2048 + k * 1024); } } } while (0)
#define PG8_LDB(dst, b, h) do { _Pragma("unroll") for (int n = 0; n < 2; ++n) { if constexpr (FP8) { const i32x4 lo_ = *(const PG8_LAS i32x4*)(lds + PG8_SB(b, h) + boff + n * 2048), hi_ = *(const PG8_LAS i32x4*)(lds + PG8_SB(b, h) + boff + n * 2048 + 1024); dst##8[n] = __builtin_shufflevector(lo_, hi_, 0, 1, 2, 3, 4, 5, 6, 7); } else { _Pragma("unroll") for (int k = 0; k < 2; ++k) dst[n][k] = *(const PG8_LAS bf16x8*)(lds + PG8_SB(b, h) + boff + n * 2048 + k * 1024); } } } while (0)
#define PG8_MMA(ai, bj, At, Bt) do { __builtin_amdgcn_s_setprio(1); _Pragma("unroll") for (int m = 0; m < 4; ++m) _Pragma("unroll") for (int n = 0; n < 2; ++n) { \
        if constexpr (FP8) { asm volatile("v_mfma_scale_f32_16x16x128_f8f6f4 %0, %1, %2, %0, %3, %4 op_sel_hi:[0,0,0]" : "+v"(acc[ai][bj][m][n]) : "v"(Bt##8[n]), "v"(At##8[m]), "v"(sclA), "v"(sclB)); } \
        else { _Pragma("unroll") for (int k = 0; k < 2; ++k) acc[ai][bj][m][n] = __builtin_amdgcn_mfma_f32_16x16x32_bf16(Bt[n][k], At[m][k], acc[ai][bj][m][n], 0, 0, 0); } } __builtin_amdgcn_s_setprio(0); } while (0)
#define PG8_WAIT_V(n) asm volatile("s_waitcnt vmcnt(" #n ")" ::: "memory")
#define PG8_WAIT_L(n) asm volatile("s_waitcnt lgkmcnt(" #n ")" ::: "memory")
#define PG8_BAR __builtin_amdgcn_s_barrier()
#define PG8_SCHED __builtin_amdgcn_sched_barrier(0)
    Unit cur, nxt; int ui = 0;
    if (!S.next(0, cur)) return;
    f32x4 acc[2][2][4][2];
#pragma unroll
    for (int a = 0; a < 2; ++a)
#pragma unroll
        for (int b = 0; b < 2; ++b)
#pragma unroll
            for (int m = 0; m < 4; ++m)
#pragma unroll
                for (int n = 0; n < 2; ++n) acc[a][b][m][n] = (f32x4){0.f, 0.f, 0.f, 0.f};
    bf16x8 At[4][2], B0[2][2], B1[2][2]; i32x8 At8[4], B08[2], B18[2]; const int sclA = g.scale, sclB = 0x7f7f7f7f;
    const char* cA = S.a_ptr(g, cur); const char* cB = S.b_ptr(g, cur);
    S.a_ready(cur);
    if constexpr (SP2) {
        PG8_STAGE(PG8_SB(0, 0), cB, voffB); PG8_STAGE(PG8_SB(0, 1), cB + hstep, voffB); PG8_STAGE(PG8_SA(0, 0), cA, voffA); PG8_STAGE(PG8_SA(0, 1), cA + hstepA, voffA);
        if (wr == 1) PG8_BAR;
        PG8_WAIT_V(2); PG8_BAR;
        PG8_STAGE(PG8_SB(1, 0), cB + kstep, voffB); PG8_STAGE(PG8_SA(1, 0), cA + kstep, voffA); PG8_STAGE(PG8_SB(1, 1), cB + hstep + kstep, voffB);
        PG8_WAIT_V(6); PG8_BAR;
    } else {
        PG8_STAGE(PG8_SB(0, 0), cB, voffB); PG8_STAGE(PG8_SA(0, 0), cA, voffA); PG8_STAGE(PG8_SB(0, 1), cB + hstep, voffB); PG8_STAGE(PG8_SA(0, 1), cA + hstepA, voffA);
        if (wr == 1) PG8_BAR;
        PG8_WAIT_V(4); PG8_BAR;
        PG8_STAGE(PG8_SB(1, 0), cB + kstep, voffB); PG8_STAGE(PG8_SA(1, 0), cA + kstep, voffA); PG8_STAGE(PG8_SB(1, 1), cB + hstep + kstep, voffB);
        PG8_WAIT_V(6); PG8_BAR;
    }
    for (;;) {
        const bool has_next = S.next(ui + 1, nxt);
        const char* nA = has_next ? S.a_ptr(g, nxt) : cA; const char* nB = has_next ? S.b_ptr(g, nxt) : cB;
        for (int t = 0; t < nt; t += 2) {
            const bool last = (t == nt - 2);
            const char* a1 = cA + (size_t)(t + 1) * kstep;
            const char* a2 = last ? nA : cA + (size_t)(t + 2) * kstep; const char* b2 = last ? nB : cB + (size_t)(t + 2) * kstep;
            const char* a3 = a2 + kstep; const char* b3 = b2 + kstep;
            if (last && has_next) S.a_ready(nxt);
            if constexpr (SP2) {
            PG8_LDB(B0, 0, 0); PG8_LDB(B1, 0, 1); PG8_SCHED; PG8_LDA(At, 0, 0); PG8_STAGE(PG8_SA(1, 1), a1 + hstepA, voffA);
            PG8_WAIT_V(8); PG8_WAIT_L(0); PG8_BAR; PG8_MMA(0, 0, At, B0); PG8_MMA(0, 1, At, B1); PG8_BAR; PG8_SCHED;
            PG8_LDA(At, 0, 1); PG8_STAGE(PG8_SB(0, 0), b2, voffB); PG8_STAGE(PG8_SB(0, 1), b2 + hstep, voffB); PG8_STAGE(PG8_SA(0, 0), a2, voffA);
            PG8_WAIT_V(8); PG8_WAIT_L(0); PG8_BAR; PG8_MMA(1, 0, At, B0); PG8_MMA(1, 1, At, B1); PG8_BAR; PG8_SCHED;
            PG8_LDB(B0, 1, 0); PG8_LDB(B1, 1, 1); PG8_SCHED; PG8_LDA(At, 1, 0); PG8_STAGE(PG8_SA(0, 1), a2 + hstepA, voffA);
            PG8_WAIT_V(8); PG8_WAIT_L(0); PG8_BAR; PG8_MMA(0, 0, At, B0); PG8_MMA(0, 1, At, B1); PG8_BAR; PG8_SCHED;
            PG8_LDA(At, 1, 1); PG8_STAGE(PG8_SB(1, 0), b3, voffB); PG8_STAGE(PG8_SB(1, 1), b3 + hstep, voffB); PG8_STAGE(PG8_SA(1, 0), a3, voffA);
            PG8_WAIT_V(8); PG8_WAIT_L(0); PG8_BAR; PG8_MMA(1, 0, At, B0); PG8_MMA(1, 1, At, B1); PG8_BAR; PG8_SCHED;
            } else {
            PG8_LDB(B0, 0, 0); PG8_SCHED; PG8_LDA(At, 0, 0); PG8_STAGE(PG8_SA(1, 1), a1 + hstepA, voffA);
            PG8_WAIT_L(8); PG8_BAR; PG8_WAIT_L(0); PG8_MMA(0, 0, At, B0); PG8_BAR; PG8_SCHED;
            PG8_LDB(B1, 0, 1); PG8_STAGE(PG8_SB(0, 0), b2, voffB);
            PG8_BAR; PG8_WAIT_L(0); PG8_MMA(0, 1, At, B1); PG8_BAR;
            PG8_LDA(At, 0, 1); PG8_STAGE(PG8_SA(0, 0), a2, voffA);
            PG8_BAR; PG8_WAIT_L(0); PG8_MMA(1, 0, At, B0); PG8_BAR; PG8_SCHED;
            PG8_STAGE(PG8_SB(0, 1), b2 + hstep, voffB);
            PG8_WAIT_V(6); PG8_BAR; PG8_MMA(1, 1, At, B1); PG8_BAR;
            PG8_LDB(B0, 1, 0); PG8_SCHED; PG8_LDA(At, 1, 0); PG8_STAGE(PG8_SA(0, 1), a2 + hstepA, voffA);
            PG8_WAIT_L(8); PG8_BAR; PG8_WAIT_L(0); PG8_MMA(0, 0, At, B0); PG8_BAR; PG8_SCHED;
            PG8_LDB(B1, 1, 1); PG8_STAGE(PG8_SB(1, 0), b3, voffB);
            PG8_BAR; PG8_WAIT_L(0); PG8_MMA(0, 1, At, B1); PG8_BAR;
            PG8_LDA(At, 1, 1); PG8_STAGE(PG8_SA(1, 0), a3, voffA);
            PG8_BAR; PG8_WAIT_L(0); PG8_MMA(1, 0, At, B0); PG8_BAR; PG8_SCHED;
            PG8_STAGE(PG8_SB(1, 1), b3 + hstep, voffB);
            PG8_WAIT_V(6); PG8_BAR; PG8_MMA(1, 1, At, B1); PG8_BAR;
            }
        }
        if constexpr (FP8) asm volatile("s_nop 15\n\ts_nop 15" ::: "memory");
        if constexpr (ALIGN_EPI) { if (wr == 0) PG8_BAR; }
        if constexpr (!Epi::AFTER_DRAIN) { E(acc, cur, wr, wc, fr, fq); S.done(cur); }
        if (!has_next) break;
#pragma unroll
        for (int a = 0; a < 2; ++a)
#pragma unroll
            for (int b = 0; b < 2; ++b)
#pragma unroll
                for (int m = 0; m < 4; ++m)
#pragma unroll
                    for (int n = 0; n < 2; ++n) acc[a][b][m][n] = (f32x4){0.f, 0.f, 0.f, 0.f};
        cur = nxt; cA = nA; cB = nB; ++ui;
        if constexpr (ALIGN_EPI) { if (wr == 1) PG8_BAR; }
    }
    PG8_WAIT_V(0);
    if constexpr (!ALIGN_EPI) { if (wr == 0) PG8_BAR; }
    PG8_BAR;
    if constexpr (Epi::AFTER_DRAIN) { E.fused(acc, cur, wr, wc, fr, fq, lds, wid, lane); S.done(cur); }
#undef PG8_SA
#undef PG8_SB
#undef PG8_STAGE
#undef PG8_LDA
#undef PG8_LDB
#undef PG8_MMA
#undef PG8_WAIT_V
#undef PG8_WAIT_L
#undef PG8_BAR
#undef PG8_SCHED
}
}
#define GAS __attribute__((address_space(1)))
#define LAS __attribute__((address_space(3)))
typedef unsigned short bf16;
typedef unsigned v4u __attribute__((ext_vector_type(4)));
typedef float f32x4 __attribute__((ext_vector_type(4)));
typedef short bf16x8 __attribute__((ext_vector_type(8)));
typedef GAS unsigned gu32;
typedef GAS unsigned long long gu64;
#define RLX_AGENT __ATOMIC_RELAXED, __HIP_MEMORY_SCOPE_AGENT
#define LDS_WAIT() asm volatile("s_waitcnt lgkmcnt(0)" ::: "memory")
#define VM_WAIT() asm volatile("s_waitcnt vmcnt(0)" ::: "memory")
__device__ __forceinline__ unsigned long long rt() { return __builtin_amdgcn_s_memrealtime(); }
__device__ __forceinline__ unsigned f2bf(float f) { unsigned u = __builtin_bit_cast(unsigned, f); return (u + 0x7fffu + ((u >> 16) & 1u)) >> 16; }
__device__ __forceinline__ unsigned pk2(float lo, float hi) { return f2bf(lo) | (f2bf(hi) << 16); }

#define XB_TMO      128
#define XB_XCNT(j)  (256  + 64 * (j))
#define XB_XSUB(j)  (1280 + 64 * (j))
#define XB_XGEN(j)  (2304 + 64 * (j))
#define XB_TOP      3328
#define XB_TOPGEN   3392
#define XCD_BAR_WORDS 3456
#define XB_SPIN_CAP (1u << 18)

__device__ __forceinline__ unsigned xb_ld(unsigned* p)              { return __hip_atomic_load(p, __ATOMIC_RELAXED, __HIP_MEMORY_SCOPE_AGENT); }
__device__ __forceinline__ unsigned xb_add(unsigned* p, unsigned v) { return __hip_atomic_fetch_add(p, v, __ATOMIC_RELAXED, __HIP_MEMORY_SCOPE_AGENT); }
__device__ __forceinline__ unsigned xb_xcc_id() { return (unsigned)__builtin_amdgcn_s_getreg((3 << 11) | 20) & 0xFu; }
#define XB_SPIN(cond, bar) do { unsigned _sp = 0; while (cond) { __builtin_amdgcn_s_sleep(1); \
    if ((++_sp & 255u) == 0u) { if (xb_ld(&(bar)[XB_TMO])) break; if (_sp > XB_SPIN_CAP) { atomicAdd(&(bar)[XB_TMO], 1u); break; } } } } while (0)

struct XcdBarrier {
    unsigned* bar; unsigned x;
    volatile LAS unsigned* st;
};

__device__ __forceinline__ XcdBarrier xcd_barrier_post(unsigned* bar, volatile LAS unsigned* st) {
    XcdBarrier b; b.bar = bar; b.x = xb_xcc_id(); b.st = st;
    if (threadIdx.x == 0) (void)xb_add(&bar[XB_XCNT(b.x)], 1u);
    return b;
}
__device__ __forceinline__ void xcd_barrier_complete(unsigned* bar, unsigned x, unsigned& nloc, unsigned& nx) {
    const unsigned G = gridDim.x * gridDim.y * gridDim.z;
    unsigned sum, cnt, mine, sp = 0u;
    for (;;) {
        sum = 0u; cnt = 0u; mine = 0u;
#pragma unroll
        for (unsigned j = 0; j < 16; ++j) { const unsigned c = xb_ld(&bar[XB_XCNT(j)]); sum += c; cnt += (c > 0u) ? 1u : 0u; mine = (j == x) ? c : mine; }
        if (sum == G) break;
        __builtin_amdgcn_s_sleep(1);
        if ((++sp & 255u) == 0u) { if (xb_ld(&bar[XB_TMO])) break; if (sp > XB_SPIN_CAP) { atomicAdd(&bar[XB_TMO], 1u); break; } }
    }
    nloc = mine > 0u ? mine : 1u; nx = cnt > 0u ? cnt : 1u;
}

__device__ __forceinline__ void xcd_barrier(const XcdBarrier& b) {
    asm volatile("s_waitcnt vmcnt(0)" ::: "memory");
    __syncthreads();
    if (threadIdx.x == 0) {
        unsigned* bar = b.bar;
        __builtin_amdgcn_s_waitcnt(0);
        unsigned nloc = b.st[0], nx = b.st[1];
        if (nloc == 0u) { xcd_barrier_complete(bar, b.x, nloc, nx); b.st[0] = nloc; b.st[1] = nx; }
        const unsigned old = xb_add(&bar[XB_XSUB(b.x)], 1u);
        const unsigned gen = old / nloc;
        if (old + 1u == (gen + 1u) * nloc) {
            __builtin_amdgcn_fence(__ATOMIC_RELEASE, "agent");
            asm volatile("s_waitcnt vmcnt(0)" ::: "memory");
            const unsigned og = xb_add(&bar[XB_TOP], 1u);
            const unsigned tg = og / nx;
            if (og + 1u == (tg + 1u) * nx) xb_add(&bar[XB_TOPGEN], 1u);
            else XB_SPIN(xb_ld(&bar[XB_TOPGEN]) == tg, bar);
            __builtin_amdgcn_fence(__ATOMIC_ACQUIRE, "agent");
            xb_add(&bar[XB_XGEN(b.x)], 1u);
            asm volatile("s_waitcnt vmcnt(0)" ::: "memory");
        } else {
            XB_SPIN(xb_ld(&bar[XB_XGEN(b.x)]) == gen, bar);
            __builtin_amdgcn_fence(__ATOMIC_ACQUIRE, "agent");
            asm volatile("s_waitcnt vmcnt(0)" ::: "memory");
        }
    }
    __syncthreads();
}

constexpr int NWAVES = 8;
#ifndef MK_PER_PHASE
#define MK_PER_PHASE 0
#endif
constexpr int NPHASE = 22;

constexpr int BATCH = 2, SEQ = 8192, DM = 2048, NTOK = BATCH * SEQ, NH = 16, DH = 128;
constexpr int NSA_N = 5168, NSA_NPAD = 5376, P0LD = 5120;
constexpr int NCMP = 511, NSELB = 128;
constexpr int COL_KC = 2048, COL_VC = 2560, COL_KS = 3072, COL_VS = 3584, COL_KW = 4096, COL_VW = 4608;
constexpr int DSA_N = 2888, DSA_NPAD = 3072, KVR = 256, TOPK = 256;
constexpr int DFF = 5632, NEXP = 8, DFFE = 7168, MOE_ROWS = 34816;
constexpr float ALPHA = 1.41421356237309515f, LN_EPS = 1e-5f, RMS_EPS = 1e-6f;

constexpr size_t MiB = (size_t)1 << 20;
constexpr size_t WS_CTL = 0, CTL_ZERO_BYTES = 128 * 1024;
constexpr size_t WS_W_NSA_IN = 2 * MiB, WS_W_NSA_OUT = 23 * MiB, WS_W_FFN_GU = 31 * MiB, WS_W_FFN_DN = 75 * MiB, WS_W_DSA_IN = 97 * MiB, WS_W_DSA_OUT = 109 * MiB;
constexpr size_t WS_W_CMPK = 117 * MiB, WS_W_CMPV = 118 * MiB, WS_W_UK = 181 * MiB, WS_W_UV = 183 * MiB, WS_CBIAS = 121 * MiB;
constexpr size_t WS_KCMP = 122 * MiB, WS_VCMP = 124 * MiB, WS_GL = 126 * MiB, WS_ROUTE = 129 * MiB;
constexpr size_t WS_KIB = 179 * MiB;
constexpr size_t WS_SELM = 178 * MiB;
constexpr size_t WS_CRAW = 130 * MiB, WS_KIWI = 146 * MiB, WS_IDX = 154 * MiB, WS_CN = 170 * MiB;
constexpr size_t WS_W_MOE_GU = 192 * MiB, WS_W_MOE_DN = 640 * MiB;
constexpr size_t WS_XB = 864 * MiB, WS_XF = 928 * MiB, WS_Z = 1056 * MiB;
constexpr size_t WS_P0 = 1184 * MiB, WS_OATT0 = 1344 * MiB, WS_HFF = 1408 * MiB;
constexpr size_t WS_Q = 1184 * MiB, WS_QI = 1248 * MiB, WS_QLAT = 1264 * MiB, WS_OLAT = 1392 * MiB, WS_OATT1 = 1520 * MiB;
constexpr size_t WS_XG = 1056 * MiB, WS_HM = 1192 * MiB, WS_Y = 192 * MiB;
constexpr size_t WS_END = 1668 * MiB;
static_assert(WS_HM + (size_t)MOE_ROWS * DFFE * 2 <= WS_END, "hm fits");
static_assert(WS_XG + (size_t)MOE_ROWS * DM * 2 <= WS_HM, "xg fits");
static_assert(WS_Y + (size_t)MOE_ROWS * DM * 4 <= WS_W_MOE_DN, "y overlays the dead gate/up weights only");
static_assert(WS_HFF + (size_t)NTOK * DFF * 2 <= WS_END, "hff fits");
constexpr int CW_TMO = 0, CW_CODE = 1;
constexpr int CW_BAR = 4096;
constexpr int CW_MOECNT = 16384;

constexpr int RING_OFF = 0, RING_BYTES = 131072;
constexpr int LDSCTL_OFF = RING_BYTES, MISC_OFF = LDSCTL_OFF + 320;
constexpr int LDS_BYTES = 163840;
constexpr int DSA_SCR = 133120;

struct Frame {
    LAS unsigned char* lds;
    volatile LAS unsigned* MISC;
    gu32* ctl;
    int tid, lane, wave, vcu, G;
};

__device__ __forceinline__ void relaunder(Frame& F) { int t = F.tid; asm volatile("" : "+v"(t)); F.tid = t; F.lane = t & 63; }
__device__ __forceinline__ float bf2f(unsigned short h) { return __uint_as_float(((unsigned)h) << 16); }
__device__ __forceinline__ float bflo(unsigned w) { return __uint_as_float(w << 16); }
__device__ __forceinline__ float bfhi(unsigned w) { return __uint_as_float(w & 0xffff0000u); }
__device__ __forceinline__ float dpp_xor1(float v) { return __int_as_float(__builtin_amdgcn_mov_dpp(__float_as_int(v), 0xB1, 0xF, 0xF, true)); }
__device__ __forceinline__ float dpp_xor2(float v) { return __int_as_float(__builtin_amdgcn_mov_dpp(__float_as_int(v), 0x4E, 0xF, 0xF, true)); }
__device__ __forceinline__ float sum_xor32(float v) { auto r = __builtin_amdgcn_permlane32_swap(__float_as_uint(v), __float_as_uint(v), false, false); return __uint_as_float(r[0]) + __uint_as_float(r[1]); }
__device__ __forceinline__ float max_xor32(float v) { auto r = __builtin_amdgcn_permlane32_swap(__float_as_uint(v), __float_as_uint(v), false, false); return fmaxf(__uint_as_float(r[0]), __uint_as_float(r[1])); }
__device__ __forceinline__ float sum_xor16(float v) { auto r = __builtin_amdgcn_permlane16_swap(__float_as_uint(v), __float_as_uint(v), false, false); return __uint_as_float(r[0]) + __uint_as_float(r[1]); }
__device__ __forceinline__ float max_xor16(float v) { auto r = __builtin_amdgcn_permlane16_swap(__float_as_uint(v), __float_as_uint(v), false, false); return fmaxf(__uint_as_float(r[0]), __uint_as_float(r[1])); }
__device__ __forceinline__ float wave_sum(float v) {
    v += dpp_xor1(v); v += dpp_xor2(v);
    v += __int_as_float(__builtin_amdgcn_mov_dpp(__float_as_int(v), 0x141, 0xF, 0xF, true));
    v += __int_as_float(__builtin_amdgcn_mov_dpp(__float_as_int(v), 0x140, 0xF, 0xF, true));
    return sum_xor32(sum_xor16(v));
}
__device__ __forceinline__ float wave_max(float v) {
    v = fmaxf(v, dpp_xor1(v)); v = fmaxf(v, dpp_xor2(v));
    v = fmaxf(v, __int_as_float(__builtin_amdgcn_mov_dpp(__float_as_int(v), 0x141, 0xF, 0xF, true)));
    v = fmaxf(v, __int_as_float(__builtin_amdgcn_mov_dpp(__float_as_int(v), 0x140, 0xF, 0xF, true)));
    return max_xor32(max_xor16(v));
}
#define WSYNC() do { __builtin_amdgcn_wave_barrier(); asm volatile("s_waitcnt lgkmcnt(0)" ::: "memory"); __builtin_amdgcn_wave_barrier(); } while (0)

__device__ __forceinline__ int rel_bucket(int n) {
    if (n < 16) return n;
    if (n >= 113) return 31;
    int b = 16;
    b += (n >= 19); b += (n >= 21); b += (n >= 24); b += (n >= 27); b += (n >= 31); b += (n >= 35); b += (n >= 40); b += (n >= 46);
    b += (n >= 52); b += (n >= 59); b += (n >= 67); b += (n >= 77); b += (n >= 87); b += (n >= 99);
    return b;
}

struct Args { const float* in[27]; float* out; unsigned char* ws; int ph_lo, ph_hi; };
#ifndef FFN_F8
#define FFN_F8 1
#endif
struct TrItem { const float* W; bf16* WT; int N, K, k0, n0, drow, kdoff; float f8scale; };
__device__ __forceinline__ void tr_set(TrItem& T, const float* W, int K, int N, int Npad, bf16* WT, int mode, int item, float f8scale = 0.f, int Kdst = 0, int kdoff = 0, int drow_off = 0) {
    T.f8scale = f8scale; T.kdoff = kdoff;
    const int nblk = Npad / 32, kb = item / nblk, nb = item - kb * nblk, n0 = 32 * nb;
    T.W = W; T.WT = WT; T.N = N; T.K = Kdst ? Kdst : K; T.k0 = 64 * kb; T.n0 = n0; T.drow = drow_off + ((mode == 0) ? n0 : ((n0 >> 7) * 256 + (mode - 1) * 128 + (n0 & 127)));
}
constexpr int TR_I_NSA_IN = (DM / 64) * (NSA_NPAD / 32), TR_I_SQ = (DM / 64) * (DM / 32), TR_I_FFN = (DM / 64) * (DFF / 32), TR_I_FFD = (DFF / 64) * (DM / 32), TR_I_DSA_IN = (DM / 64) * (DSA_NPAD / 32);
constexpr int TR_I_CMP = (4096 / 64) * (128 / 32), TR_I_UK1 = (128 / 64) * (256 / 32), TR_I_UV1 = (256 / 64) * (128 / 32);
constexpr int TR_I_MG1 = (DM / 64) * (DFFE / 32), TR_I_MD1 = (DFFE / 64) * (DM / 32);
constexpr int TR_NITEMS = TR_I_NSA_IN + 2 * TR_I_SQ + 2 * TR_I_FFN + TR_I_FFD + TR_I_DSA_IN + 2 * TR_I_CMP + 16 * TR_I_UK1 + 16 * TR_I_UV1 + 16 * TR_I_MG1 + 8 * TR_I_MD1;
__device__ __forceinline__ void tr_decode(const Args& A, unsigned char* ws, int it, TrItem& T) {
    int r = it;
    if (r < TR_I_NSA_IN) { tr_set(T, A.in[2], DM, NSA_N, NSA_NPAD, (bf16*)(ws + WS_W_NSA_IN), 0, r); return; } r -= TR_I_NSA_IN;
    if (r < TR_I_SQ) { tr_set(T, A.in[9], DM, DM, DM, (bf16*)(ws + WS_W_NSA_OUT), 0, r); return; } r -= TR_I_SQ;
    if (r < TR_I_SQ) { tr_set(T, A.in[14], DM, DM, DM, (bf16*)(ws + WS_W_DSA_OUT), 0, r); return; } r -= TR_I_SQ;
    if (r < TR_I_FFN) { tr_set(T, A.in[15], DM, DFF, DFF, (bf16*)(ws + WS_W_FFN_GU), 1, r, FFN_F8 ? 64.f : 0.f); return; } r -= TR_I_FFN;
    if (r < TR_I_FFN) { tr_set(T, A.in[16], DM, DFF, DFF, (bf16*)(ws + WS_W_FFN_GU), 2, r, FFN_F8 ? 64.f : 0.f); return; } r -= TR_I_FFN;
    if (r < TR_I_FFD) { tr_set(T, A.in[17], DFF, DM, DM, (bf16*)(ws + WS_W_FFN_DN), 0, r, FFN_F8 ? 256.f : 0.f); return; } r -= TR_I_FFD;
    if (r < TR_I_DSA_IN) { tr_set(T, A.in[10], DM, DSA_N, DSA_NPAD, (bf16*)(ws + WS_W_DSA_IN), 0, r); return; } r -= TR_I_DSA_IN;
    if (r < TR_I_CMP) { tr_set(T, A.in[4], 4096, 128, 128, (bf16*)(ws + WS_W_CMPK), 0, r); return; } r -= TR_I_CMP;
    if (r < TR_I_CMP) { tr_set(T, A.in[7], 4096, 128, 128, (bf16*)(ws + WS_W_CMPV), 0, r); return; } r -= TR_I_CMP;
    if (r < 16 * TR_I_UK1) { const int h = r / TR_I_UK1; tr_set(T, A.in[12] + (size_t)h * 128 * 256, 128, 256, 256, (bf16*)(ws + WS_W_UK), 0, r - h * TR_I_UK1, 0.f, 256, (h & 1) * 128, h * 256); return; } r -= 16 * TR_I_UK1;
    if (r < 16 * TR_I_UV1) { const int h = r / TR_I_UV1; tr_set(T, A.in[13] + (size_t)h * 256 * 128, 256, 128, 128, (bf16*)(ws + WS_W_UV), 0, r - h * TR_I_UV1, 0.f, 512, (h & 1) * 256, h * 128); return; } r -= 16 * TR_I_UV1;
    if (r < 8 * TR_I_MG1) { const int e = r / TR_I_MG1; tr_set(T, A.in[20] + (size_t)e * DM * DFFE, DM, DFFE, DFFE, (bf16*)(ws + WS_W_MOE_GU + (size_t)e * 2 * DFFE * DM), 1, r - e * TR_I_MG1, 64.f); return; } r -= 8 * TR_I_MG1;
    if (r < 8 * TR_I_MG1) { const int e = r / TR_I_MG1; tr_set(T, A.in[21] + (size_t)e * DM * DFFE, DM, DFFE, DFFE, (bf16*)(ws + WS_W_MOE_GU + (size_t)e * 2 * DFFE * DM), 2, r - e * TR_I_MG1, 64.f); return; } r -= 8 * TR_I_MG1;
    { const int e = r / TR_I_MD1; tr_set(T, A.in[22] + (size_t)e * DFFE * DM, DFFE, DM, DM, (bf16*)(ws + WS_W_MOE_DN + (size_t)e * DM * DFFE), 0, r - e * TR_I_MD1, 256.f); }
}
__device__ __forceinline__ void tr_load(const TrItem& T, f32x4 (&v)[8], int lane) {
    const int kr = lane >> 3, c4 = lane & 7, n = T.n0 + 4 * c4;
#pragma unroll
    for (int i = 0; i < 8; ++i) v[i] = (n < T.N) ? __builtin_nontemporal_load((const f32x4*)(T.W + (size_t)(T.k0 + 8 * i + kr) * T.N + n)) : (f32x4){0.f, 0.f, 0.f, 0.f};
}
__device__ __forceinline__ void tr_store(const TrItem& T, const f32x4 (&v)[8], LAS float* scr, int lane) {
    { const int kr = lane >> 3, c4 = lane & 7;
#pragma unroll
      for (int i = 0; i < 8; ++i) { LAS float* d = scr + (8 * i + kr) * 33 + 4 * c4; d[0] = v[i][0]; d[1] = v[i][1]; d[2] = v[i][2]; d[3] = v[i][3]; } }
    LDS_WAIT(); asm volatile("" ::: "memory");
    const int c = lane & 7;
#pragma unroll
    for (int j = 0; j < 4; ++j) { const int n = (lane >> 3) + 8 * j; const LAS float* s = scr + (8 * c) * 33 + n;
        v4u o; o.x = pg8::cvt_pk_bf16(s[0 * 33], s[1 * 33]); o.y = pg8::cvt_pk_bf16(s[2 * 33], s[3 * 33]); o.z = pg8::cvt_pk_bf16(s[4 * 33], s[5 * 33]); o.w = pg8::cvt_pk_bf16(s[6 * 33], s[7 * 33]);
        *(v4u*)(T.WT + (size_t)(T.drow + n) * T.K + T.kdoff + T.k0 + 8 * c) = o; }
    LDS_WAIT(); asm volatile("" ::: "memory");
}

__device__ __forceinline__ void tr_store8(const TrItem& T, const f32x4 (&v)[8], LAS float* scr, int lane) {
    { const int kr = lane >> 3, c4 = lane & 7;
#pragma unroll
      for (int i = 0; i < 8; ++i) { LAS float* d = scr + (8 * i + kr) * 33 + 4 * c4; d[0] = v[i][0]; d[1] = v[i][1]; d[2] = v[i][2]; d[3] = v[i][3]; } }
    LDS_WAIT(); asm volatile("" ::: "memory");
    const int c = lane & 3, nr = lane >> 2; const float sc = T.f8scale;
#pragma unroll
    for (int j = 0; j < 2; ++j) { const int n = nr + 16 * j; const LAS float* s = scr + (16 * c) * 33 + n; int w[4];
#pragma unroll
        for (int q = 0; q < 4; ++q) { w[q] = __builtin_amdgcn_cvt_pk_fp8_f32(s[(4 * q) * 33] * sc, s[(4 * q + 1) * 33] * sc, 0, false); w[q] = __builtin_amdgcn_cvt_pk_fp8_f32(s[(4 * q + 2) * 33] * sc, s[(4 * q + 3) * 33] * sc, w[q], true); }
        v4u o; o.x = (unsigned)w[0]; o.y = (unsigned)w[1]; o.z = (unsigned)w[2]; o.w = (unsigned)w[3];
        __builtin_nontemporal_store(o, (v4u*)((unsigned char*)T.WT + (size_t)(T.drow + n) * T.K + T.kdoff + T.k0 + 16 * c)); }
    LDS_WAIT(); asm volatile("" ::: "memory");
}
__device__ __forceinline__ void p0_prologue(Frame& F, const Args& A) {
    LAS float* scr = (LAS float*)(F.lds + RING_OFF + F.wave * 16384);
    unsigned char* ws = A.ws;
    const int gw = F.vcu * NWAVES + F.wave, NGW = F.G * NWAVES, lane = F.lane;
    {
        TrItem T0, T1, T2, T3; f32x4 v0[8], v1[8], v2[8], v3[8]; int it = gw;
#define TR_ISSUE(T, v, idx) do { if ((idx) < TR_NITEMS) { tr_decode(A, ws, (idx), T); tr_load(T, v, lane); } } while (0)
#define TR_RETIRE(T, v, idx) do { if ((idx) < TR_NITEMS) { if (T.f8scale != 0.f) tr_store8(T, v, scr, lane); else tr_store(T, v, scr, lane); } } while (0)
        TR_ISSUE(T0, v0, it); TR_ISSUE(T1, v1, it + NGW); TR_ISSUE(T2, v2, it + 2 * NGW);
        while (it < TR_NITEMS) {
            TR_ISSUE(T3, v3, it + 3 * NGW); TR_RETIRE(T0, v0, it);
            TR_ISSUE(T0, v0, it + 4 * NGW); TR_RETIRE(T1, v1, it + NGW);
            TR_ISSUE(T1, v1, it + 5 * NGW); TR_RETIRE(T2, v2, it + 2 * NGW);
            TR_ISSUE(T2, v2, it + 6 * NGW); TR_RETIRE(T3, v3, it + 3 * NGW);
            it += 4 * NGW;
        }
#undef TR_ISSUE
#undef TR_RETIRE
    }
    { const v4u z = {0u, 0u, 0u, 0u};
      for (int i = F.vcu * 512 + F.tid; i < 4096 * 16; i += F.G * 512) { const int n = i >> 4, ch = i & 15, h = n >> 8; *(v4u*)((bf16*)(ws + WS_W_UK) + (size_t)n * 256 + (1 - (h & 1)) * 128 + ch * 8) = z; }
      for (int i = F.vcu * 512 + F.tid; i < 2048 * 32; i += F.G * 512) { const int n = i >> 5, ch = i & 31, h = n >> 7; *(v4u*)((bf16*)(ws + WS_W_UV) + (size_t)n * 512 + (1 - (h & 1)) * 256 + ch * 8) = z; } }
    { const float* x = A.in[0]; bf16* xb = (bf16*)(ws + WS_XB); const size_t n8 = (size_t)NTOK * DM / 8;
      const size_t st = (size_t)F.G * 512;
      size_t i = (size_t)F.vcu * 512 + F.tid;
      for (; i + 3 * st < n8; i += 4 * st) { f32x4 a[4], b[4];
#pragma unroll
          for (int u = 0; u < 4; ++u) { a[u] = __builtin_nontemporal_load((const f32x4*)(x + (i + u * st) * 8)); b[u] = __builtin_nontemporal_load((const f32x4*)(x + (i + u * st) * 8 + 4)); }
#pragma unroll
          for (int u = 0; u < 4; ++u) { v4u o; o.x = pk2(a[u][0], a[u][1]); o.y = pk2(a[u][2], a[u][3]); o.z = pk2(b[u][0], b[u][1]); o.w = pk2(b[u][2], b[u][3]); *(v4u*)(xb + (i + u * st) * 8) = o; } }
      for (; i < n8; i += st) { const f32x4 a = *(const f32x4*)(x + i * 8), b = *(const f32x4*)(x + i * 8 + 4);
          v4u o; o.x = pk2(a[0], a[1]); o.y = pk2(a[2], a[3]); o.z = pk2(b[0], b[1]); o.w = pk2(b[2], b[3]); *(v4u*)(xb + i * 8) = o; } }
    for (int it = gw; it < 64; it += NGW) { const int kv = it >> 5, ch = it & 31; const float* pe = A.in[kv ? 6 : 3]; const float* w1 = A.in[kv ? 7 : 4];
        float s0 = 0.f, s1 = 0.f;
#pragma unroll 1
        for (int k0 = ch * 128; k0 < ch * 128 + 128; k0 += 32) { float pv[32], wa[32], wb[32];
#pragma unroll
            for (int j = 0; j < 32; ++j) { pv[j] = pe[k0 + j]; wa[j] = w1[(size_t)(k0 + j) * 128 + lane]; wb[j] = w1[(size_t)(k0 + j) * 128 + 64 + lane]; }
#pragma unroll
            for (int j = 0; j < 32; ++j) { s0 += pv[j] * wa[j]; s1 += pv[j] * wb[j]; } }
        float* cb = (float*)(ws + WS_CBIAS) + (size_t)(kv * 32 + ch) * 128; cb[lane] = s0; cb[64 + lane] = s1; }
}

typedef short s8v __attribute__((ext_vector_type(8)));
__device__ __forceinline__ s8v ld_frag(const bf16* p) { return *(const s8v*)p; }

__device__ __forceinline__ float gelu_tanh(float x) { const float u = 0.7978845608028654f * (x + 0.044715f * x * x * x); return 0.5f * x * (1.0f + tanhf(u)); }
__device__ __forceinline__ void p2_compress(Frame& F, const Args& A) {
    unsigned char* ws = A.ws; const int lane = F.lane, wid = F.wave, tid = F.tid;
    const bf16* P0 = (const bf16*)(ws + WS_P0);
    LAS float* part = (LAS float*)(F.lds + RING_OFF);
    LAS float* hid = (LAS float*)(F.lds + DSA_SCR);
    LAS float* cbl = hid + 4096;
    if (tid < 256) { const float* cbp = (const float*)(ws + WS_CBIAS) + (size_t)(tid >> 7) * 32 * 128 + (tid & 127); float cb = 0.f; for (int ch = 0; ch < 32; ++ch) cb += cbp[ch * 128]; cbl[tid] = cb; }
    if (F.vcu < 16 && wid == 0) { bf16* zp = (bf16*)(ws + ((F.vcu & 1) ? WS_VCMP : WS_KCMP)) + ((size_t)(F.vcu >> 1) * 512 + 511) * 128; zp[lane] = 0; zp[64 + lane] = 0; }
    __syncthreads();
    const int r16 = lane & 15, kq = lane >> 4;
    for (int it = F.vcu; it < 256; it += F.G) {
        const int kv = it >> 7, tile = it & 127;
        const bf16* W1T = (const bf16*)(ws + (kv ? WS_W_CMPV : WS_W_CMPK));
        const float* w2 = A.in[kv ? 8 : 5];
        bf16* outp = (bf16*)(ws + (kv ? WS_VCMP : WS_KCMP));
        const int colbase = kv ? COL_VC : COL_KC;
        f32x4 acc[2][8];
#pragma unroll
        for (int m = 0; m < 2; ++m)
#pragma unroll
            for (int n = 0; n < 8; ++n) acc[m][n] = (f32x4){0.f, 0.f, 0.f, 0.f};
        const bf16* arow[2];
#pragma unroll
        for (int m = 0; m < 2; ++m) { int R = tile * 32 + m * 16 + r16; if (R > 4087) R = 4087; const int g = R & 3, bn = R >> 2, b = bn / NCMP, n = bn - b * NCMP;
            arow[m] = P0 + (size_t)(b * SEQ + 16 * n) * P0LD + colbase + g * 128 + kq * 8; }
#pragma unroll 2
        for (int kk = 0; kk < 16; ++kk) {
            const int ks = wid * 16 + kk, l = ks >> 2, d0 = (ks & 3) * 32;
            s8v af[2], bfr[8];
#pragma unroll
            for (int m = 0; m < 2; ++m) af[m] = ld_frag(arow[m] + (size_t)l * P0LD + d0);
#pragma unroll
            for (int n = 0; n < 8; ++n) bfr[n] = ld_frag(W1T + (size_t)(n * 16 + r16) * 4096 + ks * 32 + kq * 8);
#pragma unroll
            for (int m = 0; m < 2; ++m)
#pragma unroll
                for (int n = 0; n < 8; ++n) acc[m][n] = __builtin_amdgcn_mfma_f32_16x16x32_bf16(af[m], bfr[n], acc[m][n], 0, 0, 0);
        }
#pragma unroll
        for (int m = 0; m < 2; ++m)
#pragma unroll
            for (int n = 0; n < 8; ++n)
#pragma unroll
                for (int j = 0; j < 4; ++j) part[wid * 4096 + (m * 16 + kq * 4 + j) * 128 + n * 16 + r16] = acc[m][n][j];
        __syncthreads();
        { const int row = tid >> 4, e0 = (tid & 15) * 8; f32x4 s0 = (f32x4){0.f, 0.f, 0.f, 0.f}, s1 = s0;
#pragma unroll
          for (int w = 0; w < 8; ++w) { s0 += *(const LAS f32x4*)(part + w * 4096 + row * 128 + e0); s1 += *(const LAS f32x4*)(part + w * 4096 + row * 128 + e0 + 4); }
#pragma unroll
          for (int j = 0; j < 4; ++j) { hid[row * 128 + e0 + j] = gelu_tanh(s0[j] + cbl[kv * 128 + e0 + j]); hid[row * 128 + e0 + 4 + j] = gelu_tanh(s1[j] + cbl[kv * 128 + e0 + 4 + j]); } }
        __syncthreads();
        { const int rr = tid >> 4, f0 = (tid & 15) * 8, R = tile * 32 + rr; f32x4 o0 = (f32x4){0.f, 0.f, 0.f, 0.f}, o1 = o0;
#pragma unroll 16
          for (int e = 0; e < 128; ++e) { const float hv = hid[rr * 128 + e]; o0 += *(const f32x4*)(w2 + e * 128 + f0) * hv; o1 += *(const f32x4*)(w2 + e * 128 + f0 + 4) * hv; }
          if (R <= 4087) { const int g = R & 3, bn = R >> 2, b = bn / NCMP, n = bn - b * NCMP;
              v4u o; o.x = pk2(o0[0], o0[1]); o.y = pk2(o0[2], o0[3]); o.z = pk2(o1[0], o1[1]); o.w = pk2(o1[2], o1[3]);
              *(v4u*)(outp + ((size_t)(b * 4 + g) * 512 + n) * 128 + f0) = o; } }
        __syncthreads();
    }
    for (int tb = F.vcu; tb < NTOK / 64; tb += F.G) {
        const bf16* XBp = (const bf16*)(ws + WS_XB); const bf16* WG = (const bf16*)(ws + WS_W_NSA_IN) + (size_t)5120 * DM; float* GL = (float*)(ws + WS_GL);
        const int rt = wid & 3, kh = wid >> 2, tokr = tb * 64 + rt * 16;
        f32x4 ga[3];
#pragma unroll
        for (int n = 0; n < 3; ++n) ga[n] = (f32x4){0.f, 0.f, 0.f, 0.f};
        const bf16* ap = XBp + (size_t)(tokr + r16) * DM + kh * 1024 + kq * 8; const bf16* bp = WG + (size_t)r16 * DM + kh * 1024 + kq * 8;
#pragma unroll 1
        for (int kb8 = 0; kb8 < 4; ++kb8) {
            s8v af[8], bf0[8], bf1[8], bf2[8];
#pragma unroll
            for (int k2 = 0; k2 < 8; ++k2) { const int ks = kb8 * 8 + k2; af[k2] = ld_frag(ap + ks * 32); bf0[k2] = ld_frag(bp + ks * 32); bf1[k2] = ld_frag(bp + (size_t)16 * DM + ks * 32); bf2[k2] = ld_frag(bp + (size_t)32 * DM + ks * 32); }
            __builtin_amdgcn_sched_barrier(0);
#pragma unroll
            for (int k2 = 0; k2 < 8; ++k2) { ga[0] = __builtin_amdgcn_mfma_f32_16x16x32_bf16(af[k2], bf0[k2], ga[0], 0, 0, 0); ga[1] = __builtin_amdgcn_mfma_f32_16x16x32_bf16(af[k2], bf1[k2], ga[1], 0, 0, 0); ga[2] = __builtin_amdgcn_mfma_f32_16x16x32_bf16(af[k2], bf2[k2], ga[2], 0, 0, 0); }
            __builtin_amdgcn_sched_barrier(0);
        }
        if (kh == 1) {
#pragma unroll
            for (int n = 0; n < 3; ++n) *(LAS f32x4*)(part + (rt * 3 + n) * 256 + lane * 4) = ga[n]; }
        __syncthreads();
        if (kh == 0) {
#pragma unroll
            for (int n = 0; n < 3; ++n) { const f32x4 o = ga[n] + *(const LAS f32x4*)(part + (rt * 3 + n) * 256 + lane * 4);
#pragma unroll
                for (int j = 0; j < 4; ++j) GL[(size_t)(tokr + kq * 4 + j) * 48 + n * 16 + r16] = o[j]; } }
        __syncthreads();
    }
}

namespace fa {
typedef float f32x16 __attribute__((ext_vector_type(16)));
typedef short s16x4 __attribute__((ext_vector_type(4)));
typedef unsigned u32x4v __attribute__((ext_vector_type(4)));
constexpr int SHM_K = 16384, SHM_V = 16384;
constexpr int OFF_V = 0, OFF_K = 2 * SHM_V, OFF_WS = 2 * SHM_V + 2 * SHM_K, OFF_LUT = OFF_WS + 8 * 256, OFF_MASK = OFF_LUT + 144 * 16 * 4, OFF_TAB = OFF_MASK + 1024;
constexpr int TABLD = 130;
constexpr float C2 = 1.4426950408889634f, THR = 8.f;
#define FA_KSWZ(row, colB) ((row) * 256 + ((colB) ^ (((row) & 7) << 4)))
#define FA_SBAR() __builtin_amdgcn_sched_barrier(0)
__device__ __forceinline__ int v_st(int k, int c) { const int kk = (k & ~0xC) | ((k & 4) << 1) | ((k & 8) >> 1); return ((kk >> 3) * 4 + (c >> 5)) * 512 + ((kk & 7) * 32 + (c & 31)) * 2; }
__device__ __forceinline__ int v_rd_base(int lane) { return ((lane & 3) << 3) | (((lane >> 2) & 3) << 6) | (((lane >> 4) & 1) << 5) | (((lane >> 5) & 1) << 8); }
constexpr int v_rd_off(int d0, int ks, int half) { return d0 * 512 + ks * 4096 + half * 2048; }
__device__ __forceinline__ int crow(int r, int hi) { return (r & 3) + 8 * (r >> 2) + 4 * hi; }
__device__ __forceinline__ unsigned cvtpk(float lo, float hi) { unsigned r; asm volatile("v_cvt_pk_bf16_f32 %0, %1, %2" : "=v"(r) : "v"(lo), "v"(hi)); return r; }

__device__ __forceinline__ void qkt(f32x16& p0, f32x16& p1, const LAS char* Kb, int r32, int hi, const bf16x8 (&qr)[8], float init) {
#pragma unroll
    for (int r = 0; r < 16; ++r) { p0[r] = init; p1[r] = init; }
    int kb[4];
#pragma unroll
    for (int dd = 0; dd < 4; ++dd) kb[dd] = (int)(uintptr_t)(Kb + FA_KSWZ(r32, (dd * 16 + hi * 8) * 2));
    bf16x8 fa_[4], fb_[4];
#define FA_QRD(dst, addr, off) asm volatile("ds_read_b128 %0, %1 offset:%2" : "=&v"(dst) : "v"(addr), "i"(off) : "memory")
#define FA_QRD4(F_, ka_, kb_, off_) do { FA_QRD(F_[0], ka_, off_); FA_QRD(F_[1], ka_, (off_) + 8192); FA_QRD(F_[2], kb_, off_); FA_QRD(F_[3], kb_, (off_) + 8192); } while (0)
#define FA_QWAIT(F_, n_) asm volatile("s_waitcnt lgkmcnt(" #n_ ")" : "+v"(F_[0]), "+v"(F_[1]), "+v"(F_[2]), "+v"(F_[3]) :: "memory")
#define FA_QMMA(F_, d_) do { p0 = __builtin_amdgcn_mfma_f32_32x32x16_bf16(F_[0], qr[d_], p0, 0, 0, 0); p1 = __builtin_amdgcn_mfma_f32_32x32x16_bf16(F_[1], qr[d_], p1, 0, 0, 0); \
        p0 = __builtin_amdgcn_mfma_f32_32x32x16_bf16(F_[2], qr[(d_) + 1], p0, 0, 0, 0); p1 = __builtin_amdgcn_mfma_f32_32x32x16_bf16(F_[3], qr[(d_) + 1], p1, 0, 0, 0); } while (0)
    FA_QRD4(fa_, kb[0], kb[1], 0);
    FA_QRD4(fb_, kb[2], kb[3], 0);   FA_QWAIT(fa_, 4); FA_QMMA(fa_, 0);
    FA_QRD4(fa_, kb[0], kb[1], 128); FA_QWAIT(fb_, 4); FA_QMMA(fb_, 2);
    FA_QRD4(fb_, kb[2], kb[3], 128); FA_QWAIT(fa_, 4); FA_QMMA(fa_, 4);
    FA_QWAIT(fb_, 0); FA_QMMA(fb_, 6);
#undef FA_QRD
#undef FA_QRD4
#undef FA_QWAIT
#undef FA_QMMA
}
__device__ __forceinline__ void pv_tile(f32x16 (&o)[4], int vb0, bf16x8 pa0, bf16x8 pa1, bf16x8 pa2, bf16x8 pa3) {
#define FA_TRRD(dst, off) asm volatile("ds_read_b64_tr_b16 %0, %1 offset:%2" : "=&v"(dst) : "v"(vb0), "i"(off) : "memory")
#define FA_PV_D0(d0) do { s16x4 l0, l1, l2, l3, h0, h1, h2, h3; constexpr int b_ = v_rd_off(d0, 0, 0); \
        FA_TRRD(l0, b_); FA_TRRD(h0, b_ + 2048); FA_TRRD(l1, b_ + 4096); FA_TRRD(h1, b_ + 6144); FA_TRRD(l2, b_ + 8192); FA_TRRD(h2, b_ + 10240); FA_TRRD(l3, b_ + 12288); FA_TRRD(h3, b_ + 14336); \
        asm volatile("s_waitcnt lgkmcnt(0)" ::: "memory"); FA_SBAR(); \
        o[d0] = __builtin_amdgcn_mfma_f32_32x32x16_bf16(pa0, (bf16x8){l0[0], l0[1], l0[2], l0[3], h0[0], h0[1], h0[2], h0[3]}, o[d0], 0, 0, 0); \
        o[d0] = __builtin_amdgcn_mfma_f32_32x32x16_bf16(pa1, (bf16x8){l1[0], l1[1], l1[2], l1[3], h1[0], h1[1], h1[2], h1[3]}, o[d0], 0, 0, 0); \
        o[d0] = __builtin_amdgcn_mfma_f32_32x32x16_bf16(pa2, (bf16x8){l2[0], l2[1], l2[2], l2[3], h2[0], h2[1], h2[2], h2[3]}, o[d0], 0, 0, 0); \
        o[d0] = __builtin_amdgcn_mfma_f32_32x32x16_bf16(pa3, (bf16x8){l3[0], l3[1], l3[2], l3[3], h3[0], h3[1], h3[2], h3[3]}, o[d0], 0, 0, 0); } while (0)
    FA_PV_D0(0); FA_PV_D0(1); FA_PV_D0(2); FA_PV_D0(3);
#undef FA_PV_D0
#undef FA_TRRD
}
__device__ __forceinline__ void partialSM(f32x16& p0, f32x16& p1, float& m_reg, float& alpha) {
    float pmax = p0[0];
#pragma unroll
    for (int r = 1; r < 16; ++r) pmax = fmaxf(pmax, p0[r]);
#pragma unroll
    for (int r = 0; r < 16; ++r) pmax = fmaxf(pmax, p1[r]);
    { auto rr = __builtin_amdgcn_permlane32_swap(__float_as_uint(pmax), __float_as_uint(pmax), false, false); pmax = fmaxf(__uint_as_float(rr[0]), __uint_as_float(rr[1])); }
    float mn;
    if (__all(pmax - m_reg <= THR)) { mn = m_reg; alpha = 1.f; }
    else { mn = fmaxf(m_reg, pmax); alpha = __builtin_amdgcn_exp2f((m_reg - mn) * C2); m_reg = mn; }
    const float mnL = -mn * C2;
#pragma unroll
    for (int r = 0; r < 16; ++r) { p0[r] = __builtin_amdgcn_exp2f(fmaf(p0[r], C2, mnL)); p1[r] = __builtin_amdgcn_exp2f(fmaf(p1[r], C2, mnL)); }
}
__device__ __forceinline__ float finishSM(const f32x16& p0, const f32x16& p1, bf16x8& pa0, bf16x8& pa1, bf16x8& pa2, bf16x8& pa3) {
    float ps = 0.f;
#pragma unroll
    for (int r = 0; r < 16; ++r) ps += p0[r];
#pragma unroll
    for (int r = 0; r < 16; ++r) ps += p1[r];
    { auto rr = __builtin_amdgcn_permlane32_swap(__float_as_uint(ps), __float_as_uint(ps), false, false); ps = __uint_as_float(rr[0]) + __uint_as_float(rr[1]); }
#define FA_PK4(P, B_, OUT) do { unsigned a0 = cvtpk(P[B_ + 0], P[B_ + 1]), a1 = cvtpk(P[B_ + 2], P[B_ + 3]); unsigned b0 = cvtpk(P[B_ + 4], P[B_ + 5]), b1 = cvtpk(P[B_ + 6], P[B_ + 7]); \
        auto r0 = __builtin_amdgcn_permlane32_swap(a0, b0, false, false); auto r1 = __builtin_amdgcn_permlane32_swap(a1, b1, false, false); \
        u32x4v w = {r0[0], r1[0], r0[1], r1[1]}; OUT = *reinterpret_cast<bf16x8*>(&w); } while (0)
    FA_PK4(p0, 0, pa0); FA_PK4(p0, 8, pa1); FA_PK4(p1, 0, pa2); FA_PK4(p1, 8, pa3);
#undef FA_PK4
    return ps;
}
__device__ __forceinline__ void rescale(f32x16 (&o)[4], float alpha, LAS float* al_l, int r32, int hi) {
    if (__any(alpha < 1.f)) { if (hi == 0) al_l[r32] = alpha; asm volatile("s_waitcnt lgkmcnt(0)" ::: "memory");
#pragma unroll
        for (int r = 0; r < 16; ++r) { const float a = al_l[crow(r, hi)];
#pragma unroll
            for (int d = 0; d < 4; ++d) o[d][r] *= a; }
        asm volatile("s_waitcnt lgkmcnt(0)" ::: "memory"); }
}
__device__ __forceinline__ void mask_tile(f32x16& p0, f32x16& p1, int dq, unsigned W) {
    const float NEG = -__builtin_inff();
#pragma unroll
    for (int r = 0; r < 16; ++r) { const int c = (r & 3) + 8 * (r >> 2);
        if ((unsigned)(dq - c) >= W) p0[r] = NEG;
        if ((unsigned)(dq - c - 32) >= W) p1[r] = NEG; }
}
__device__ __forceinline__ void mask_all(f32x16& p0, f32x16& p1, bool keep) {
    const float NEG = -__builtin_inff();
#pragma unroll
    for (int r = 0; r < 16; ++r) { p0[r] = keep ? p0[r] : NEG; p1[r] = keep ? p1[r] : NEG; }
}
__device__ __forceinline__ void bias_near(f32x16& p0, f32x16& p1, int dq, int step, const LAS float* lutcol) {
#pragma unroll
    for (int r = 0; r < 16; ++r) { const int c = (r & 3) + 8 * (r >> 2);
        const int d0 = min(max((dq - c) * step, 0), 128), d1 = min(max((dq - c - 32) * step, 0), 128);
        p0[r] += lutcol[d0]; p1[r] += lutcol[d1]; }
}
struct Stage { bf16x8 k0, k1, v0, v1; };
__device__ __forceinline__ void stage_load(Stage& S, const bf16* Kp, const bf16* Vp, size_t ld, int row0, int maxrow, int sr, int sc) {
    const int ra = min(row0 + sr, maxrow), rb = min(row0 + 32 + sr, maxrow);
    S.k0 = *(const bf16x8*)(Kp + (size_t)ra * ld + sc); S.k1 = *(const bf16x8*)(Kp + (size_t)rb * ld + sc);
    S.v0 = *(const bf16x8*)(Vp + (size_t)ra * ld + sc); S.v1 = *(const bf16x8*)(Vp + (size_t)rb * ld + sc);
}
__device__ __forceinline__ void stage_write(const Stage& S, LAS char* Kb, LAS char* Vb, int kws, int vst0, int vst1) {
    *(LAS bf16x8*)(Kb + kws) = S.k0; *(LAS bf16x8*)(Kb + kws + 32 * 256) = S.k1;
    *(LAS bf16x8*)(Vb + vst0) = S.v0; *(LAS bf16x8*)(Vb + vst1) = S.v1;
}
}

struct NsaLane { int wid, lane, r32, hi, ql, j, sr, sc, kws, vst0, vst1, vrd; };
__device__ __forceinline__ NsaLane nsa_lane(const Frame& F) {
    NsaLane L; L.wid = F.wave; L.lane = F.lane; L.r32 = F.lane & 31; L.hi = F.lane >> 5; L.ql = L.r32 >> 2; L.j = L.r32 & 3;
    L.sr = F.tid >> 4; L.sc = (F.tid & 15) * 8; L.kws = FA_KSWZ(L.sr, L.sc * 2); L.vst0 = fa::v_st(L.sr, L.sc); L.vst1 = fa::v_st(32 + L.sr, L.sc); L.vrd = fa::v_rd_base(F.lane);
    return L;
}
__device__ __forceinline__ void nsa_load_q(bf16x8 (&qr)[8], const bf16* P0, int tok0, int g, const NsaLane& L) {
    const bf16* qp = P0 + (size_t)(tok0 + L.wid * 8 + L.ql) * P0LD + (g * 4 + L.j) * 128 + L.hi * 8;
#pragma unroll
    for (int d0 = 0; d0 < 8; ++d0) qr[d0] = *(const bf16x8*)(qp + d0 * 16);
}
__device__ __forceinline__ void nsa_lut(Frame& F, const Args& A) {
    LAS float* lut = (LAS float*)(F.lds + RING_OFF + fa::OFF_LUT);
    for (int i = F.tid; i < 144 * 16; i += 512) { const int n = i >> 4, h = i & 15; lut[h * 144 + n] = A.in[1][rel_bucket(n) * 16 + h]; }
    __syncthreads();
}
template <int MODE>
__device__ __forceinline__ void nsa_store(const fa::f32x16 (&o)[4], float l_reg, LAS float* li_l, const float* GL, bf16* OACC, bf16* OATT, int tok0, int g, int br, const NsaLane& L) {
    if (L.hi == 0) li_l[L.r32] = l_reg;
    asm volatile("s_waitcnt lgkmcnt(0)" ::: "memory");
    float sc[16];
#pragma unroll
    for (int r = 0; r < 16; ++r) { const int row = fa::crow(r, L.hi), tok = tok0 + L.wid * 8 + (row >> 2), h = g * 4 + (row & 3); sc[r] = GL[(size_t)tok * 48 + h * 3 + br]; }
    unsigned prev[4][16];
    if (MODE != 0) {
#pragma unroll
        for (int r = 0; r < 16; ++r) { const int row = fa::crow(r, L.hi), tok = tok0 + L.wid * 8 + (row >> 2), h = g * 4 + (row & 3); const bf16* ap = OACC + (size_t)tok * DM + h * 128 + (L.r32 & ~1);
#pragma unroll
            for (int d0 = 0; d0 < 4; ++d0) prev[d0][r] = *(const unsigned*)(ap + d0 * 32); } }
#pragma unroll
    for (int r = 0; r < 16; ++r) { const int row = fa::crow(r, L.hi), tok = tok0 + L.wid * 8 + (row >> 2), h = g * 4 + (row & 3);
        const float l = li_l[row]; const float gl = sc[r];
        const float scl = (l > 0.f) ? __builtin_amdgcn_rcpf(l) / (1.0f + __expf(-gl)) : 0.f;
        bf16* dst = ((MODE == 2) ? OATT : OACC) + (size_t)tok * DM + h * 128 + L.r32;
#pragma unroll
        for (int d0 = 0; d0 < 4; ++d0) { float v = o[d0][r] * scl;
            if (MODE != 0) v += (L.r32 & 1) ? bfhi(prev[d0][r]) : bflo(prev[d0][r]);
            const float vn = dpp_xor1(v); if ((L.r32 & 1) == 0) *(unsigned*)(dst + d0 * 32) = fa::cvtpk(v, vn); } }
    asm volatile("s_waitcnt lgkmcnt(0)" ::: "memory");
}

__device__ __forceinline__ void nsa_scales(float (&scl)[16], float l_reg, LAS float* li_l, const float* GL, int tok0, int g, int br, const NsaLane& L) {
    if (L.hi == 0) li_l[L.r32] = l_reg;
    asm volatile("s_waitcnt lgkmcnt(0)" ::: "memory");
    float sc[16];
#pragma unroll
    for (int r = 0; r < 16; ++r) { const int row = fa::crow(r, L.hi), tok = tok0 + L.wid * 8 + (row >> 2), h = g * 4 + (row & 3); sc[r] = GL[(size_t)tok * 48 + h * 3 + br]; }
#pragma unroll
    for (int r = 0; r < 16; ++r) { const float l = li_l[fa::crow(r, L.hi)]; scl[r] = (l > 0.f) ? __builtin_amdgcn_rcpf(l) / (1.0f + __expf(-sc[r])) : 0.f; }
    asm volatile("s_waitcnt lgkmcnt(0)" ::: "memory");
}
__device__ __forceinline__ void p3a_nsa_cmp(Frame& F, const Args& A) {
    unsigned char* ws = A.ws; const NsaLane L = nsa_lane(F);
    const bf16* P0 = (const bf16*)(ws + WS_P0); const bf16* KCB = (const bf16*)(ws + WS_KCMP); const bf16* VCB = (const bf16*)(ws + WS_VCMP);
    const float* GL = (const float*)(ws + WS_GL); bf16* OACC = (bf16*)(ws + WS_Z + 64 * MiB); unsigned* SELM = (unsigned*)(ws + WS_SELM);
    nsa_lut(F, A);
    LAS char* lds = (LAS char*)(F.lds + RING_OFF);
    LAS float* wsf = (LAS float*)(lds + fa::OFF_WS) + L.wid * 64; LAS float* li_l = wsf; LAS float* al_l = wsf + 32;
    const LAS float* lut = (const LAS float*)(lds + fa::OFF_LUT);
    LAS float* tab = (LAS float*)(lds + fa::OFF_TAB);
    for (int ui = 0; ui < 2 * ((512 - F.vcu + F.G - 1) / F.G); ++ui) {
        const int p = F.vcu + (ui >> 1) * F.G, bg = p >> 6, y = p & 63, qb = (ui & 1) ? 127 - y : y, b = bg >> 2, g = bg & 3;
        const int tok0 = b * SEQ + qb * 64;
        bf16x8 qr[8]; nsa_load_q(qr, P0, tok0, g, L);
        const int trow = qb * 64 + L.wid * 8 + L.ql;
        const int h = g * 4 + L.j; const LAS float* lutcol = lut + h * 144; const float bias_far = lutcol[128];
        const int nmaxrow = (trow >= 31) ? (trow - 31) >> 4 : -1;
        const int NT = (4 * qb + 3 + 63) >> 6;
        const bf16* Kg = KCB + (size_t)(b * 4 + g) * 512 * 128; const bf16* Vg = VCB + (size_t)(b * 4 + g) * 512 * 128;
        for (int i = F.tid; i < 64 * fa::TABLD; i += 512) tab[i] = 0.f;
        float m_reg = -1e30f, l_reg = 0.f;
        fa::Stage S;
        const int rem16 = (trow >= 31) ? ((trow - 31) & 15) : 0;
        fa::stage_load(S, Kg, Vg, 128, 0, 511, L.sr, L.sc); asm volatile("s_waitcnt vmcnt(0)" ::: "memory");
        fa::stage_write(S, lds + fa::OFF_K, lds + fa::OFF_V, L.kws, L.vst0, L.vst1);
        __syncthreads();
#pragma unroll 1
        for (int t = 0; t < NT; ++t) {
            const int buf = t & 1;
            fa::stage_load(S, Kg, Vg, 128, (t + 1 < NT) ? (t + 1) * 64 : 0, 511, L.sr, L.sc);
            fa::f32x16 p0, p1;
            const bool farT = (qb * 64 + L.wid * 8) - 31 - 16 * (t * 64 + 63) >= 128;
            fa::qkt(p0, p1, lds + fa::OFF_K + buf * fa::SHM_K, L.r32, L.hi, qr, farT ? bias_far : 0.f);
            const int dq = nmaxrow - t * 64 - 4 * L.hi;
            if (!farT) fa::bias_near(p0, p1, dq, 16, lutcol + rem16);
            fa::mask_tile(p0, p1, dq, 0x40000000u);
            float alpha; fa::partialSM(p0, p1, m_reg, alpha);
            float ps = 0.f;
#pragma unroll
            for (int r = 0; r < 16; ++r) ps += p0[r] + p1[r];
            { auto rr = __builtin_amdgcn_permlane32_swap(__float_as_uint(ps), __float_as_uint(ps), false, false); ps = __uint_as_float(rr[0]) + __uint_as_float(rr[1]); }
            l_reg = l_reg * alpha + ps;
            if (t + 1 < NT) { asm volatile("s_waitcnt vmcnt(0)" ::: "memory"); fa::stage_write(S, lds + fa::OFF_K + (buf ^ 1) * fa::SHM_K, lds + fa::OFF_V + (buf ^ 1) * fa::SHM_V, L.kws, L.vst0, L.vst1); }
            __syncthreads();
        }
        fa::f32x16 o[4];
#pragma unroll
        for (int d = 0; d < 4; ++d)
#pragma unroll
            for (int r = 0; r < 16; ++r) o[d][r] = 0.f;
        asm volatile("s_waitcnt vmcnt(0)" ::: "memory");
        fa::stage_write(S, lds + fa::OFF_K, lds + fa::OFF_V, L.kws, L.vst0, L.vst1);
        __syncthreads();
        const float inv_l = (l_reg > 0.f) ? 1.0f / l_reg : 0.f; const float mnL = -m_reg * fa::C2;
#pragma unroll 1
        for (int t = 0; t < NT; ++t) {
            const int buf = t & 1;
            if (t + 1 < NT) fa::stage_load(S, Kg, Vg, 128, (t + 1) * 64, 511, L.sr, L.sc);
            fa::f32x16 p0, p1;
            const bool farT = (qb * 64 + L.wid * 8) - 31 - 16 * (t * 64 + 63) >= 128;
            fa::qkt(p0, p1, lds + fa::OFF_K + buf * fa::SHM_K, L.r32, L.hi, qr, farT ? bias_far : 0.f);
            const int dq = nmaxrow - t * 64 - 4 * L.hi;
            if (!farT) fa::bias_near(p0, p1, dq, 16, lutcol + rem16);
            fa::mask_tile(p0, p1, dq, 0x40000000u);
#pragma unroll
            for (int r = 0; r < 16; ++r) { p0[r] = __builtin_amdgcn_exp2f(fmaf(p0[r], fa::C2, mnL)) * inv_l; p1[r] = __builtin_amdgcn_exp2f(fmaf(p1[r], fa::C2, mnL)) * inv_l; }
            LAS float* tb = tab + (L.wid * 8 + L.ql) * fa::TABLD + t * 16 + L.hi;
#pragma unroll
            for (int half = 0; half < 2; ++half)
#pragma unroll
                for (int gq = 0; gq < 4; ++gq) { const fa::f32x16& pp = half ? p1 : p0;
                    float s4 = pp[4 * gq] + pp[4 * gq + 1] + pp[4 * gq + 2] + 0.5f * pp[4 * gq + 3], cr = 0.5f * pp[4 * gq + 3];
                    s4 += dpp_xor1(s4); s4 += dpp_xor2(s4); cr += dpp_xor1(cr); cr += dpp_xor2(cr);
                    if (L.j == 0) { __hip_atomic_fetch_add(tb + half * 8 + 2 * gq, s4, __ATOMIC_RELAXED, __HIP_MEMORY_SCOPE_WORKGROUP); __hip_atomic_fetch_add(tb + half * 8 + 2 * gq + 1, cr, __ATOMIC_RELAXED, __HIP_MEMORY_SCOPE_WORKGROUP); } }
            bf16x8 a0, a1, a2, a3; (void)fa::finishSM(p0, p1, a0, a1, a2, a3);
            fa::pv_tile(o, (int)(uintptr_t)(lds + fa::OFF_V + buf * fa::SHM_V) + L.vrd, a0, a1, a2, a3);
            if (t + 1 < NT) { asm volatile("s_waitcnt vmcnt(0)" ::: "memory"); fa::stage_write(S, lds + fa::OFF_K + (buf ^ 1) * fa::SHM_K, lds + fa::OFF_V + (buf ^ 1) * fa::SHM_V, L.kws, L.vst0, L.vst1); }
            __syncthreads();
        }
        const bf16* Kw = P0 + (size_t)b * SEQ * P0LD + COL_KW + g * 128; const bf16* Vw = P0 + (size_t)b * SEQ * P0LD + COL_VW + g * 128;
        const int t0 = max(0, qb - 8), NTW = qb - t0 + 1;
        fa::stage_load(S, Kw, Vw, P0LD, t0 * 64, SEQ - 1, L.sr, L.sc);
        unsigned tot[4][8];
        { float scl[16]; nsa_scales(scl, (l_reg > 0.f) ? 1.0f : 0.f, li_l, GL, tok0, g, 0, L);
#pragma unroll
          for (int d0 = 0; d0 < 4; ++d0)
#pragma unroll
              for (int r2 = 0; r2 < 8; ++r2) tot[d0][r2] = fa::cvtpk(o[d0][2 * r2] * scl[2 * r2], o[d0][2 * r2 + 1] * scl[2 * r2 + 1]); }
        __syncthreads();
        {
            bool s0[8], s1[8];
            if (qb < 16) {
#pragma unroll
                for (int qi = 0; qi < 8; ++qi) { s0[qi] = (L.lane <= qb); s1[qi] = false; }
            } else {
                unsigned k0[8], k1[8], lo[8];
#pragma unroll
                for (int qi = 0; qi < 8; ++qi) { const int ql = L.wid * 8 + qi;
                    const bool c0 = (L.lane >= 1 && L.lane <= qb - 2), c1 = (L.lane + 64 <= qb - 2);
                    k0[qi] = c0 ? __float_as_uint(tab[ql * fa::TABLD + L.lane]) + 1u : 0u; k1[qi] = c1 ? __float_as_uint(tab[ql * fa::TABLD + L.lane + 64]) + 1u : 0u;
                    s0[qi] = (L.lane == 0) || (L.lane == qb) || (L.lane == qb - 1); s1[qi] = (L.lane + 64 == qb) || (L.lane + 64 == qb - 1); lo[qi] = 0u; }
#pragma unroll 1
                for (int bit = 30; bit >= 0; --bit) {
#pragma unroll
                    for (int qi = 0; qi < 8; ++qi) { const unsigned cand = lo[qi] | (1u << bit);
                        const int cnt = __popcll(__ballot(k0[qi] >= cand)) + __popcll(__ballot(k1[qi] >= cand));
                        lo[qi] = (cnt >= 13) ? cand : lo[qi]; } }
#pragma unroll
                for (int qi = 0; qi < 8; ++qi) { const unsigned T = lo[qi];
                    const bool g0 = k0[qi] > T, g1 = k1[qi] > T, e0 = k0[qi] == T, e1 = k1[qi] == T;
                    const int need = 13 - (__popcll(__ballot(g0)) + __popcll(__ballot(g1)));
                    const unsigned long long be0 = __ballot(e0), be1 = __ballot(e1);
                    const int r0 = (int)__builtin_amdgcn_mbcnt_hi((unsigned)(be0 >> 32), __builtin_amdgcn_mbcnt_lo((unsigned)be0, 0u));
                    const int r1 = __popcll(be0) + (int)__builtin_amdgcn_mbcnt_hi((unsigned)(be1 >> 32), __builtin_amdgcn_mbcnt_lo((unsigned)be1, 0u));
                    s0[qi] = s0[qi] || g0 || (e0 && r0 < need); s1[qi] = s1[qi] || g1 || (e1 && r1 < need); }
            }
#pragma unroll
            for (int qi = 0; qi < 8; ++qi) { const int ql = L.wid * 8 + qi; const unsigned long long b0 = __ballot(s0[qi]), b1 = __ballot(s1[qi]);
                if (L.lane == 0) { uint4 mv; mv.x = (unsigned)b0; mv.y = (unsigned)(b0 >> 32); mv.z = (unsigned)b1; mv.w = (unsigned)(b1 >> 32); *(uint4*)(SELM + ((size_t)(tok0 + ql) * 4 + g) * 4) = mv; } }
        }
        __syncthreads();
        LAS char* const totb[4] = {lds + fa::OFF_TAB + F.tid * 32, lds + fa::OFF_TAB + 16384 + F.tid * 32, lds + fa::OFF_TAB + 64 * fa::TABLD * 4 + F.tid * 32, (LAS char*)(F.lds + DSA_SCR) + F.tid * 32};
#pragma unroll
        for (int d0 = 0; d0 < 4; ++d0) { v4u ta, tb; ta.x = tot[d0][0]; ta.y = tot[d0][1]; ta.z = tot[d0][2]; ta.w = tot[d0][3]; tb.x = tot[d0][4]; tb.y = tot[d0][5]; tb.z = tot[d0][6]; tb.w = tot[d0][7];
            *(LAS v4u*)(totb[d0]) = ta; *(LAS v4u*)(totb[d0] + 16) = tb; }
        {
            m_reg = -1e30f; l_reg = 0.f;
#pragma unroll
            for (int d = 0; d < 4; ++d)
#pragma unroll
                for (int r = 0; r < 16; ++r) o[d][r] = 0.f;
            asm volatile("s_waitcnt vmcnt(0)" ::: "memory");
            fa::stage_write(S, lds + fa::OFF_K, lds + fa::OFF_V, L.kws, L.vst0, L.vst1);
            __syncthreads();
#pragma unroll 1
            for (int tt = 0; tt < NTW; ++tt) {
                const int buf = tt & 1, t = t0 + tt;
                if (tt + 1 < NTW) fa::stage_load(S, Kw, Vw, P0LD, (t + 1) * 64, SEQ - 1, L.sr, L.sc);
                fa::f32x16 p0, p1;
                const bool farT = (qb * 64 + L.wid * 8) - (t * 64 + 63) >= 128;
                fa::qkt(p0, p1, lds + fa::OFF_K + buf * fa::SHM_K, L.r32, L.hi, qr, farT ? bias_far : 0.f);
                const int dq = trow - t * 64 - 4 * L.hi;
                if (!farT) fa::bias_near(p0, p1, dq, 1, lutcol);
                if (t == qb || t == t0) fa::mask_tile(p0, p1, dq, 512u);
                float alpha; fa::partialSM(p0, p1, m_reg, alpha);
                fa::rescale(o, alpha, al_l, L.r32, L.hi);
                bf16x8 a0, a1, a2, a3; const float ps = fa::finishSM(p0, p1, a0, a1, a2, a3); l_reg = l_reg * alpha + ps;
                fa::pv_tile(o, (int)(uintptr_t)(lds + fa::OFF_V + buf * fa::SHM_V) + L.vrd, a0, a1, a2, a3);
                if (tt + 1 < NTW) { asm volatile("s_waitcnt vmcnt(0)" ::: "memory"); fa::stage_write(S, lds + fa::OFF_K + (buf ^ 1) * fa::SHM_K, lds + fa::OFF_V + (buf ^ 1) * fa::SHM_V, L.kws, L.vst0, L.vst1); }
                __syncthreads();
            }
            float scl[16]; nsa_scales(scl, l_reg, li_l, GL, tok0, g, 2, L);
#pragma unroll
            for (int d0 = 0; d0 < 4; ++d0) { const v4u ta = *(const LAS v4u*)(totb[d0]), tb = *(const LAS v4u*)(totb[d0] + 16); const unsigned tt8[8] = {ta.x, ta.y, ta.z, ta.w, tb.x, tb.y, tb.z, tb.w};
#pragma unroll
                for (int r = 0; r < 16; ++r) { const int row = fa::crow(r, L.hi), tok = tok0 + L.wid * 8 + (row >> 2), h = g * 4 + (row & 3);
                    bf16* dst = OACC + (size_t)tok * DM + h * 128 + L.r32;
                    const float v = o[d0][r] * scl[r] + ((r & 1) ? bfhi(tt8[r >> 1]) : bflo(tt8[r >> 1]));
                    const float vn = dpp_xor1(v); if ((L.r32 & 1) == 0) *(unsigned*)(dst + d0 * 32) = fa::cvtpk(v, vn); } }
            asm volatile("s_waitcnt lgkmcnt(0)" ::: "memory");
        }
        __syncthreads();
    }
}
constexpr int N3_OFF_V = 0, N3_OFF_K = 3 * fa::SHM_V, N3_OFF_WS = 3 * fa::SHM_V + 3 * fa::SHM_K, N3_OFF_LUT = N3_OFF_WS + 8 * 256;
__device__ __forceinline__ void nsa_lut3(Frame& F, const Args& A) {
    LAS float* lut = (LAS float*)(F.lds + RING_OFF + N3_OFF_LUT);
    for (int i = F.tid; i < 144 * 16; i += 512) { const int n = i >> 4, h = i & 15; lut[h * 144 + n] = A.in[1][rel_bucket(n) * 16 + h]; }
    __syncthreads();
}
__device__ __forceinline__ void p3b_nsa_sel(Frame& F, const Args& A) {
    unsigned char* ws = A.ws; const NsaLane L = nsa_lane(F);
    const bf16* P0 = (const bf16*)(ws + WS_P0); const float* GL = (const float*)(ws + WS_GL); bf16* OACC = (bf16*)(ws + WS_Z + 64 * MiB); const unsigned* SELM = (const unsigned*)(ws + WS_SELM);
    nsa_lut3(F, A);
    LAS char* lds = (LAS char*)(F.lds + RING_OFF);
    LAS float* wsf = (LAS float*)(lds + N3_OFF_WS) + L.wid * 64; LAS float* li_l = wsf; LAS float* al_l = wsf + 32;
    const LAS float* lut = (const LAS float*)(lds + N3_OFF_LUT);
    const bool grpB = L.wid >= 4;
    for (int ui = 0; ui < 2 * ((512 - F.vcu + F.G - 1) / F.G); ++ui) {
        const int p = F.vcu + (ui >> 1) * F.G, bg = p >> 6, y = p & 63, qb = (ui & 1) ? 127 - y : y, b = bg >> 2, g = bg & 3;
        const int tok0 = b * SEQ + qb * 64;
        bf16x8 qr[8]; nsa_load_q(qr, P0, tok0, g, L);
        const int trow = qb * 64 + L.wid * 8 + L.ql;
        const int h = g * 4 + L.j; const LAS float* lutcol = lut + h * 144; const float bias_far = lutcol[128];
        const uint4 mv = *(const uint4*)(SELM + ((size_t)(tok0 + L.wid * 8 + L.ql) * 4 + g) * 4);
        const bf16* Kg = P0 + (size_t)b * SEQ * P0LD + COL_KS + g * 128; const bf16* Vg = P0 + (size_t)b * SEQ * P0LD + COL_VS + g * 128;
        const int NT = qb + 1;
        float m_reg = -1e30f, l_reg = 0.f; fa::f32x16 o[4];
#pragma unroll
        for (int d = 0; d < 4; ++d)
#pragma unroll
            for (int r = 0; r < 16; ++r) o[d][r] = 0.f;
        fa::Stage Sa;
        fa::stage_load(Sa, Kg, Vg, P0LD, 0, SEQ - 1, L.sr, L.sc); asm volatile("s_waitcnt vmcnt(0)" ::: "memory");
        asm volatile("" : "+v"(qr[0]), "+v"(qr[1]), "+v"(qr[2]), "+v"(qr[3]), "+v"(qr[4]), "+v"(qr[5]), "+v"(qr[6]), "+v"(qr[7]));
        unsigned mvx = mv.x, mvy = mv.y, mvz = mv.z, mvw = mv.w; asm volatile("" : "+v"(mvx), "+v"(mvy), "+v"(mvz), "+v"(mvw));
        fa::stage_write(Sa, lds + N3_OFF_K, lds + N3_OFF_V, L.kws, L.vst0, L.vst1);
        __syncthreads();
        bf16x8 a0 = {0, 0, 0, 0, 0, 0, 0, 0}, a1 = a0, a2 = a0, a3 = a0; bool actp = false;
        int bcur = 0, bprev = 2;
#define P3B_STEP(t, SNEXT2, SNEXT1) do { \
            const int bnext = (bcur == 2) ? 0 : bcur + 1; \
            if ((t) + 1 < NT) fa::stage_load(SNEXT1, Kg, Vg, P0LD, ((t) + 1) * 64, SEQ - 1, L.sr, L.sc); \
            FA_SBAR();     \
            const unsigned word = ((t) < 32) ? mvx : ((t) < 64) ? mvy : ((t) < 96) ? mvz : mvw; \
            const bool mine = ((word >> ((t) & 31)) & 1u) != 0u; \
            const bool act = __any(mine); \
            if (grpB && actp) fa::pv_tile(o, (int)(uintptr_t)(lds + N3_OFF_V + bprev * fa::SHM_V) + L.vrd, a0, a1, a2, a3); \
            if (act) { \
                fa::f32x16 p0, p1; \
                const bool farT = (qb * 64 + L.wid * 8) - ((t) * 64 + 63) >= 128; \
                fa::qkt(p0, p1, lds + N3_OFF_K + bcur * fa::SHM_K, L.r32, L.hi, qr, mine ? (farT ? bias_far : 0.f) : -__builtin_inff()); \
                const int dq = trow - (t) * 64 - 4 * L.hi; \
                if (!farT) fa::bias_near(p0, p1, dq, 1, lutcol); \
                if ((t) == qb) fa::mask_tile(p0, p1, dq, 0x40000000u); \
                float alpha; fa::partialSM(p0, p1, m_reg, alpha); \
                fa::rescale(o, alpha, al_l, L.r32, L.hi); \
                const float ps = fa::finishSM(p0, p1, a0, a1, a2, a3); l_reg = l_reg * alpha + ps; \
                if (!grpB) fa::pv_tile(o, (int)(uintptr_t)(lds + N3_OFF_V + bcur * fa::SHM_V) + L.vrd, a0, a1, a2, a3); \
            } \
            actp = act; \
            if ((t) + 1 < NT) { asm volatile("s_waitcnt vmcnt(0)" ::: "memory"); fa::stage_write(SNEXT1, lds + N3_OFF_K + bnext * fa::SHM_K, lds + N3_OFF_V + bnext * fa::SHM_V, L.kws, L.vst0, L.vst1); } \
            __syncthreads(); \
            bprev = bcur; bcur = bnext; } while (0)
#pragma unroll 1
        for (int t = 0; t < NT; t += 2) {
            P3B_STEP(t, Sa, Sa);
            if (t + 1 < NT) P3B_STEP(t + 1, Sa, Sa);
        }
#undef P3B_STEP
        if (grpB && actp) fa::pv_tile(o, (int)(uintptr_t)(lds + N3_OFF_V + bprev * fa::SHM_V) + L.vrd, a0, a1, a2, a3);
        int tokz = tok0; asm volatile("" : "+s"(tokz));
        nsa_store<2>(o, l_reg, li_l, GL, OACC, (bf16*)(ws + WS_OATT0), tokz, g, 1, L);
        __syncthreads();
    }
}
__device__ __forceinline__ void p3c_nsa_win(Frame& F, const Args& A) {
    unsigned char* ws = A.ws; const NsaLane L = nsa_lane(F);
    const bf16* P0 = (const bf16*)(ws + WS_P0); const float* GL = (const float*)(ws + WS_GL); bf16* OACC = (bf16*)(ws + WS_Z + 64 * MiB); bf16* OATT = (bf16*)(ws + WS_OATT0);
    nsa_lut(F, A);
    LAS char* lds = (LAS char*)(F.lds + RING_OFF);
    LAS float* wsf = (LAS float*)(lds + fa::OFF_WS) + L.wid * 64; LAS float* li_l = wsf; LAS float* al_l = wsf + 32;
    const LAS float* lut = (const LAS float*)(lds + fa::OFF_LUT);
    for (int ui = 0; ui < 2 * ((512 - F.vcu + F.G - 1) / F.G); ++ui) {
        const int p = F.vcu + (ui >> 1) * F.G, bg = p >> 6, y = p & 63, qb = (ui & 1) ? 127 - y : y, b = bg >> 2, g = bg & 3;
        const int tok0 = b * SEQ + qb * 64;
        bf16x8 qr[8]; nsa_load_q(qr, P0, tok0, g, L);
        const int trow = qb * 64 + L.wid * 8 + L.ql;
        const int h = g * 4 + L.j; const LAS float* lutcol = lut + h * 144; const float bias_far = lutcol[128];
        const bf16* Kg = P0 + (size_t)b * SEQ * P0LD + COL_KW + g * 128; const bf16* Vg = P0 + (size_t)b * SEQ * P0LD + COL_VW + g * 128;
        const int t0 = max(0, qb - 8), NT = qb - t0 + 1;
        float m_reg = -1e30f, l_reg = 0.f; fa::f32x16 o[4];
#pragma unroll
        for (int d = 0; d < 4; ++d)
#pragma unroll
            for (int r = 0; r < 16; ++r) o[d][r] = 0.f;
        fa::Stage S;
        fa::stage_load(S, Kg, Vg, P0LD, t0 * 64, SEQ - 1, L.sr, L.sc); asm volatile("s_waitcnt vmcnt(0)" ::: "memory");
        fa::stage_write(S, lds + fa::OFF_K, lds + fa::OFF_V, L.kws, L.vst0, L.vst1);
        __syncthreads();
#pragma unroll 1
        for (int tt = 0; tt < NT; ++tt) {
            const int buf = tt & 1, t = t0 + tt;
            if (tt + 1 < NT) fa::stage_load(S, Kg, Vg, P0LD, (t + 1) * 64, SEQ - 1, L.sr, L.sc);
            fa::f32x16 p0, p1;
            const bool farT = (qb * 64 + L.wid * 8) - (t * 64 + 63) >= 128;
            fa::qkt(p0, p1, lds + fa::OFF_K + buf * fa::SHM_K, L.r32, L.hi, qr, farT ? bias_far : 0.f);
            const int dq = trow - t * 64 - 4 * L.hi;
            if (!farT) fa::bias_near(p0, p1, dq, 1, lutcol);
            if (t == qb || t == t0) fa::mask_tile(p0, p1, dq, 512u);
            float alpha; fa::partialSM(p0, p1, m_reg, alpha);
            fa::rescale(o, alpha, al_l, L.r32, L.hi);
            bf16x8 a0, a1, a2, a3; const float ps = fa::finishSM(p0, p1, a0, a1, a2, a3); l_reg = l_reg * alpha + ps;
            fa::pv_tile(o, (int)(uintptr_t)(lds + fa::OFF_V + buf * fa::SHM_V) + L.vrd, a0, a1, a2, a3);
            if (tt + 1 < NT) { asm volatile("s_waitcnt vmcnt(0)" ::: "memory"); fa::stage_write(S, lds + fa::OFF_K + (buf ^ 1) * fa::SHM_K, lds + fa::OFF_V + (buf ^ 1) * fa::SHM_V, L.kws, L.vst0, L.vst1); }
            __syncthreads();
        }
        nsa_store<2>(o, l_reg, li_l, GL, OACC, OATT, tok0, g, 2, L);
        __syncthreads();
    }
}

template <bool ROUTE, bool F8 = false>
__device__ __forceinline__ void ln_phase(Frame& F, const Args& A, const bf16* Z, const float* gam, const float* bet, bf16* XH, unsigned char* X8) {
    const int gw = F.vcu * NWAVES + F.wave, NGW = F.G * NWAVES, lane = F.lane;
    LAS float* wrl = (LAS float*)(F.lds + RING_OFF);
    if (ROUTE) { for (int i = F.tid; i < DM * 8 / 4; i += 512) *(LAS f32x4*)(wrl + i * 4) = *(const f32x4*)(A.in[18] + i * 4); }
    LAS float* gml = (LAS float*)(F.lds + DSA_SCR); LAS float* btl = gml + DM;
    { const int i = F.tid; *(LAS f32x4*)(gml + i * 4) = *(const f32x4*)(gam + i * 4); *(LAS f32x4*)(btl + i * 4) = *(const f32x4*)(bet + i * 4); }
    __syncthreads();
    uint2 zn[8];
    if (gw < NTOK) { const uint2* zr = (const uint2*)(Z + (size_t)gw * DM) + lane;
#pragma unroll
        for (int j = 0; j < 8; ++j) zn[j] = zr[64 * j]; }
    for (int row = gw; row < NTOK; row += NGW) {
        f32x4 v[8]; float s = 0.f;
#pragma unroll
        for (int j = 0; j < 8; ++j) { const uint2 z2 = zn[j]; v[j] = (f32x4){bflo(z2.x), bfhi(z2.x), bflo(z2.y), bfhi(z2.y)}; s += (v[j][0] + v[j][1]) + (v[j][2] + v[j][3]); }
        if (row + NGW < NTOK) { const uint2* zr = (const uint2*)(Z + (size_t)(row + NGW) * DM) + lane;
#pragma unroll
            for (int j = 0; j < 8; ++j) zn[j] = zr[64 * j]; }
        __builtin_amdgcn_sched_barrier(0);
        const float mean = wave_sum(s) * (1.f / DM); float s2 = 0.f;
#pragma unroll
        for (int j = 0; j < 8; ++j) { v[j] = v[j] - mean; s2 += (v[j][0] * v[j][0] + v[j][1] * v[j][1]) + (v[j][2] * v[j][2] + v[j][3] * v[j][3]); }
        const float rstd = 1.f / sqrtf(wave_sum(s2) * (1.f / DM) + LN_EPS);
        float lg[8];
#pragma unroll
        for (int e = 0; e < 8; ++e) lg[e] = 0.f;
#pragma unroll
        for (int j = 0; j < 8; ++j) { const int c = 4 * lane + 256 * j; const f32x4 gg = *(const LAS f32x4*)(gml + c), bb = *(const LAS f32x4*)(btl + c);
            const f32x4 x = v[j] * rstd * gg + bb;
            { uint2 o; o.x = pk2(x[0], x[1]); o.y = pk2(x[2], x[3]); *(uint2*)(XH + (size_t)row * DM + c) = o; }
            if (F8) { int w = __builtin_amdgcn_cvt_pk_fp8_f32(x[0], x[1], 0, false); w = __builtin_amdgcn_cvt_pk_fp8_f32(x[2], x[3], w, true); *(int*)(X8 + (size_t)row * DM + c) = w; }
            asm volatile("" ::: "memory");
            if (ROUTE) { const LAS float* wr = wrl + c * 8;
#pragma unroll
                for (int q = 0; q < 4; ++q) { const f32x4 w0 = *(const LAS f32x4*)(wr + q * 8), w1 = *(const LAS f32x4*)(wr + q * 8 + 4);
                    lg[0] += x[q] * w0[0]; lg[1] += x[q] * w0[1]; lg[2] += x[q] * w0[2]; lg[3] += x[q] * w0[3]; lg[4] += x[q] * w1[0]; lg[5] += x[q] * w1[1]; lg[6] += x[q] * w1[2]; lg[7] += x[q] * w1[3]; }  asm volatile("" ::: "memory"); }
        }
        if (ROUTE) {
#pragma unroll
            for (int e = 0; e < 8; ++e) lg[e] = wave_sum(lg[e]) + A.in[19][e];
            int e0 = 0; float l0 = lg[0];
#pragma unroll
            for (int e = 1; e < 8; ++e) if (lg[e] > l0) { l0 = lg[e]; e0 = e; }
            int e1 = -1; float l1 = -3e38f;
#pragma unroll
            for (int e = 0; e < 8; ++e) if (e != e0 && lg[e] > l1) { l1 = lg[e]; e1 = e; }
            const float w0 = 1.0f / (1.0f + __expf(l1 - l0)), w1 = 1.0f - w0;
            if (lane == 0) {
                const unsigned p0 = __hip_atomic_fetch_add((unsigned*)(F.ctl + CW_MOECNT + 64 * e0), 1u, __ATOMIC_RELAXED, __HIP_MEMORY_SCOPE_AGENT);
                const unsigned p1 = __hip_atomic_fetch_add((unsigned*)(F.ctl + CW_MOECNT + 64 * e1), 1u, __ATOMIC_RELAXED, __HIP_MEMORY_SCOPE_AGENT);
                int* re = (int*)(A.ws + WS_ROUTE); int* rp = re + 2 * NTOK; float* rw = (float*)(rp + 2 * NTOK);
                re[2 * row] = e0; re[2 * row + 1] = e1; rp[2 * row] = (int)p0; rp[2 * row + 1] = (int)p1; rw[2 * row] = w0; rw[2 * row + 1] = w1;
            }
        }
    }
}

__device__ __forceinline__ void ln_route_phase(Frame& F, const Args& A, const bf16* Z, const float* gam, const float* bet, bf16* XH) {
    const int gw = F.vcu * NWAVES + F.wave, NGW = F.G * NWAVES, lane = F.lane;
    LAS float* wrl = (LAS float*)(F.lds + RING_OFF);
    LAS float* rowb = (LAS float*)(F.lds + RING_OFF + 65536 + F.wave * 8192);
    LAS float* gml = (LAS float*)(F.lds + DSA_SCR); LAS float* btl = gml + DM;
    for (int i = F.tid; i < DM * 8 / 4; i += 512) *(LAS f32x4*)(wrl + i * 4) = *(const f32x4*)(A.in[18] + i * 4);
    { const int i = F.tid; *(LAS f32x4*)(gml + i * 4) = *(const f32x4*)(gam + i * 4); *(LAS f32x4*)(btl + i * 4) = *(const f32x4*)(bet + i * 4); }
    __syncthreads();
    uint2 zn[8];
    if (gw < NTOK) {
#pragma unroll
        for (int j = 0; j < 8; ++j) zn[j] = *(const uint2*)(Z + (size_t)gw * DM + 4 * lane + 256 * j); }
    for (int row = gw; row < NTOK; row += NGW) {
        float s = 0.f, s2 = 0.f;
#pragma unroll
        for (int j = 0; j < 8; ++j) { const uint2 z2 = zn[j]; const f32x4 v = (f32x4){bflo(z2.x), bfhi(z2.x), bflo(z2.y), bfhi(z2.y)}; *(LAS f32x4*)(rowb + 4 * lane + 256 * j) = v;
            s += (v[0] + v[1]) + (v[2] + v[3]); }
        if (row + NGW < NTOK) {
#pragma unroll
            for (int j = 0; j < 8; ++j) zn[j] = *(const uint2*)(Z + (size_t)(row + NGW) * DM + 4 * lane + 256 * j); }
        __builtin_amdgcn_sched_barrier(0);
        const float mean = wave_sum(s) * (1.f / DM);
#pragma unroll 1
        for (int j = 0; j < 8; ++j) { const f32x4 v = *(const LAS f32x4*)(rowb + 4 * lane + 256 * j) - mean; s2 += (v[0] * v[0] + v[1] * v[1]) + (v[2] * v[2] + v[3] * v[3]); }
        const float rstd = 1.f / sqrtf(wave_sum(s2) * (1.f / DM) + LN_EPS);
        float lg[8];
#pragma unroll
        for (int e = 0; e < 8; ++e) lg[e] = 0.f;
#pragma unroll 1
        for (int j = 0; j < 8; ++j) { const int c = 4 * lane + 256 * j; const f32x4 gg = *(const LAS f32x4*)(gml + c), bb = *(const LAS f32x4*)(btl + c);
            const f32x4 x = (*(const LAS f32x4*)(rowb + c) - mean) * rstd * gg + bb;
            { uint2 o; o.x = pk2(x[0], x[1]); o.y = pk2(x[2], x[3]); *(uint2*)(XH + (size_t)row * DM + c) = o; }
            const LAS float* wr = wrl + c * 8;
#pragma unroll
            for (int q = 0; q < 4; ++q) { const f32x4 w0 = *(const LAS f32x4*)(wr + q * 8), w1 = *(const LAS f32x4*)(wr + q * 8 + 4);
                lg[0] += x[q] * w0[0]; lg[1] += x[q] * w0[1]; lg[2] += x[q] * w0[2]; lg[3] += x[q] * w0[3]; lg[4] += x[q] * w1[0]; lg[5] += x[q] * w1[1]; lg[6] += x[q] * w1[2]; lg[7] += x[q] * w1[3]; } }
#pragma unroll
        for (int e = 0; e < 8; ++e) lg[e] = wave_sum(lg[e]) + A.in[19][e];
        int e0 = 0; float l0 = lg[0];
#pragma unroll
        for (int e = 1; e < 8; ++e) if (lg[e] > l0) { l0 = lg[e]; e0 = e; }
        int e1 = -1; float l1 = -3e38f;
#pragma unroll
        for (int e = 0; e < 8; ++e) if (e != e0 && lg[e] > l1) { l1 = lg[e]; e1 = e; }
        const float w0 = 1.0f / (1.0f + __expf(l1 - l0)), w1 = 1.0f - w0;
        if (lane == 0) {
            const unsigned p0 = __hip_atomic_fetch_add((unsigned*)(F.ctl + CW_MOECNT + 64 * e0), 1u, __ATOMIC_RELAXED, __HIP_MEMORY_SCOPE_AGENT);
            const unsigned p1 = __hip_atomic_fetch_add((unsigned*)(F.ctl + CW_MOECNT + 64 * e1), 1u, __ATOMIC_RELAXED, __HIP_MEMORY_SCOPE_AGENT);
            int* re = (int*)(A.ws + WS_ROUTE); int* rp = re + 2 * NTOK; float* rw = (float*)(rp + 2 * NTOK);
            re[2 * row] = e0; re[2 * row + 1] = e1; rp[2 * row] = (int)p0; rp[2 * row + 1] = (int)p1; rw[2 * row] = w0; rw[2 * row + 1] = w1;
        }
        WSYNC();
    }
    __syncthreads();
}

__device__ __forceinline__ void p10_dsa_prep(Frame& F, const Args& A) {
    unsigned char* ws = A.ws; const int lane = F.lane;
    const int gw = F.vcu * NWAVES + F.wave, NGW = F.G * NWAVES;
    { const float* CR = (const float*)(ws + WS_CRAW); bf16* CN = (bf16*)(ws + WS_CN); const f32x4 gg = *(const f32x4*)(A.in[11] + 4 * lane);
      f32x4 vn = (f32x4){0.f, 0.f, 0.f, 0.f}, kn = vn;
      if (gw < NTOK) { vn = *(const f32x4*)(CR + (size_t)gw * KVR + 4 * lane); if (lane < 16) kn = *(const f32x4*)((const float*)(ws + WS_KIWI) + (size_t)gw * 128 + 4 * lane); }
      for (int row = gw; row < NTOK; row += NGW) { const f32x4 v = vn, kv = kn;
          if (row + NGW < NTOK) { vn = *(const f32x4*)(CR + (size_t)(row + NGW) * KVR + 4 * lane); if (lane < 16) kn = *(const f32x4*)((const float*)(ws + WS_KIWI) + (size_t)(row + NGW) * 128 + 4 * lane); }
          const float ss = wave_sum(v[0] * v[0] + v[1] * v[1] + v[2] * v[2] + v[3] * v[3]); const float r = 1.f / sqrtf(ss * (1.f / KVR) + RMS_EPS);
          uint2 o; o.x = pk2(v[0] * r * gg[0], v[1] * r * gg[1]); o.y = pk2(v[2] * r * gg[2], v[3] * r * gg[3]); *(uint2*)(CN + (size_t)row * KVR + 4 * lane) = o;
          if (lane < 16) { uint2 k2; k2.x = pk2(kv[0], kv[1]); k2.y = pk2(kv[2], kv[3]); *(uint2*)((bf16*)(ws + WS_KIB) + (size_t)(row >> 5) * 2048 + (lane >> 2) * 512 + ((((lane >> 1) & 1) * 32 + (row & 31)) * 8) + (lane & 1) * 4) = k2; } } }
    { pg8::Gemm g{(const bf16*)(ws + WS_Q), (const bf16*)(ws + WS_W_UK), NTOK, 4096, 256, 2, 0x7f7f7f7f, DM};
      pg8::PairOrder S; S.init(NTOK, 4096, F.G, (int)blockIdx.x); S.pn_shift = 1; S.kslice = 256;
      pg8::EpiBf16Scale E{(bf16*)(ws + WS_QLAT), 4096, 0.08838834764831845f};
      pg8::gemm_phase<pg8::EpiBf16Scale, pg8::PairOrder, true, true>(F.lds + RING_OFF, g, S, E); }
}
__device__ __forceinline__ void p12_dsa_uv(Frame& F, const Args& A) {
    unsigned char* ws = A.ws;
    pg8::Gemm g{(const bf16*)(ws + WS_OLAT), (const bf16*)(ws + WS_W_UV), NTOK, DM, 512, 2, 0x7f7f7f7f, 4096};
    pg8::PairOrder S; S.init(NTOK, DM, F.G, (int)blockIdx.x); S.pn_shift = 0; S.kslice = 512;
    pg8::EpiBf16Scale E{(bf16*)(ws + WS_OATT1), DM, 1.0f};
    pg8::gemm_phase<pg8::EpiBf16Scale, pg8::PairOrder, true, true>(F.lds + RING_OFF, g, S, E);
}
__device__ __forceinline__ unsigned f2key(float f) { const unsigned u = __float_as_uint(f); return (u & 0x80000000u) ? ~u : (u | 0x80000000u); }

__device__ __forceinline__ unsigned dsa_off_b(unsigned row, unsigned ch) { return 256u * row + 16u * (ch ^ (((row & 3) << 2) | ((row >> 2) & 3))); }

__device__ __forceinline__ float relu1(float x) { return __builtin_amdgcn_fmed3f(x, 0.f, 3.0e38f); }
__device__ __forceinline__ float max1(float a, float b) { float r; asm("v_max_f32 %0, %1, %2" : "=v"(r) : "v"(a), "v"(b)); return r; }
__device__ __forceinline__ float min1(float a, float b) { float r; asm("v_min_f32 %0, %1, %2" : "=v"(r) : "v"(a), "v"(b)); return r; }
__device__ __forceinline__ float key2f(unsigned k) { return __uint_as_float((k & 0x80000000u) ? (k & 0x7fffffffu) : ~k); }
__device__ __forceinline__ void p13a_dsa_index(Frame& F, const Args& A) {
    unsigned char* ws = A.ws; const int lane = F.lane, wid = F.wave, r32 = lane & 31, hi = lane >> 5;
    const bf16* QI = (const bf16*)(ws + WS_QI); const bf16* KIB = (const bf16*)(ws + WS_KIB); const float* KIWI = (const float*)(ws + WS_KIWI); int* IDX = (int*)(ws + WS_IDX);
    LAS float* sc = (LAS float*)(F.lds + RING_OFF);
    LAS unsigned* hist = (LAS unsigned*)(F.lds + DSA_SCR);
    LAS unsigned* qm = hist + 4096;
    LAS float* mmx = (LAS float*)(qm + 64);
    LAS unsigned* dmy = (LAS unsigned*)(mmx + 64);
    LAS unsigned* candk = dmy + 128;
    LAS unsigned* candi = candk + 1024;
    LAS unsigned* outl = candi + 1024;
    LAS unsigned* cntG = outl;
    LAS unsigned* cntE = cntG + 512;
    constexpr int CAP = 256;
    const int q = wid >> 1, sub = wid & 1, th = sub * 64 + lane;
    bf16x8 qa[4]; float wv[16];
#define P13A_TOK0(slot_) ((((slot_) >> 8) * 256 + ((((slot_) >> 8) & 1) ? 255 - ((slot_) & 255) : ((slot_) & 255))) * 4)
#define P13A_LOADQ(tk_) do { _Pragma("unroll") for (int s = 0; s < 4; ++s) qa[s] = *(const bf16x8*)(QI + (size_t)((tk_) + (r32 >> 3)) * 512 + (r32 & 7) * 64 + 16 * s + 8 * hi); \
        _Pragma("unroll") for (int r = 0; r < 16; ++r) wv[r] = KIWI[(size_t)((tk_) + (r >> 2)) * 128 + 64 + (r & 3) + 4 * hi] * 0.35355339059327373f; } while (0)
    if (F.vcu < NTOK / 4) P13A_LOADQ(P13A_TOK0(F.vcu));
    for (int slot = F.vcu; slot < NTOK / 4; slot += F.G) {
        const int tok0 = P13A_TOK0(slot), b = tok0 >> 13, t0 = tok0 & (SEQ - 1), tmax = t0 + 3;
        const int ntiles = (tmax >> 5) + 1;
#pragma unroll
        for (int z = 0; z < 8; ++z) hist[q * 1024 + z * 128 + th] = 0u;
        if (th == 0) { qm[q * 16 + 2] = 0u; qm[q * 16 + 4] = 0u; }
        float mn0 = 3e38f, mx0 = -3e38f, mn1 = 3e38f, mx1 = -3e38f;
        {
            bf16x8 ka[4], kc[4]; int tile = wid;
#define P13A_LDK(dst_, tl_) do { const bf16* kp_ = KIB + (size_t)(b * (SEQ / 32) + min((tl_), ntiles - 1)) * 2048 + (hi * 32 + r32) * 8; \
                asm volatile("global_load_dwordx4 %0, %4, off\n\tglobal_load_dwordx4 %1, %4, off offset:1024\n\tglobal_load_dwordx4 %2, %4, off offset:2048\n\tglobal_load_dwordx4 %3, %4, off offset:3072" \
                             : "=&v"(dst_[0]), "=&v"(dst_[1]), "=&v"(dst_[2]), "=&v"(dst_[3]) : "v"(kp_) : "memory"); } while (0)
#define P13A_WAIT(dst_, n_) asm volatile("s_waitcnt vmcnt(" #n_ ")" : "+v"(dst_[0]), "+v"(dst_[1]), "+v"(dst_[2]), "+v"(dst_[3]) :: "memory")
#define P13A_TILE(kk_, tl_) do { const int key_ = (tl_) * 32 + r32; fa::f32x16 acc_; \
                _Pragma("unroll") for (int r = 0; r < 16; ++r) acc_[r] = 0.f; \
                _Pragma("unroll") for (int s = 0; s < 4; ++s) acc_ = __builtin_amdgcn_mfma_f32_32x32x16_bf16(qa[s], kk_[s], acc_, 0, 0, 0); \
                float tot_[4]; \
                _Pragma("unroll") for (int qq = 0; qq < 4; ++qq) { float part = wv[4 * qq] * relu1(acc_[4 * qq]); _Pragma("unroll") for (int r3 = 1; r3 < 4; ++r3) part = fmaf(wv[4 * qq + r3], relu1(acc_[4 * qq + r3]), part); tot_[qq] = sum_xor32(part) + 0.0f; } \
                const float ta_ = hi ? tot_[2] : tot_[0], tb_ = hi ? tot_[3] : tot_[1]; \
                sc[(2 * hi) * 8192 + key_] = ta_; sc[(2 * hi + 1) * 8192 + key_] = tb_; \
                mn0 = min1(mn0, ta_); mx0 = max1(mx0, ta_); mn1 = min1(mn1, tb_); mx1 = max1(mx1, tb_);     \
                } while (0)
            asm volatile("s_waitcnt vmcnt(0)" ::: "memory");
            P13A_LDK(ka, tile);
            while (tile < ntiles) {
                P13A_LDK(kc, tile + 8); P13A_WAIT(ka, 4);
                P13A_TILE(ka, tile);
                tile += 8; if (tile >= ntiles) break;
                P13A_LDK(ka, tile + 8); P13A_WAIT(kc, 4);
                P13A_TILE(kc, tile);
                tile += 8;
            }
            asm volatile("s_waitcnt vmcnt(0)" : "+v"(ka[0]), "+v"(ka[1]), "+v"(ka[2]), "+v"(ka[3]), "+v"(kc[0]), "+v"(kc[1]), "+v"(kc[2]), "+v"(kc[3]) :: "memory");
#undef P13A_WAIT
#undef P13A_LDK
#undef P13A_TILE
        }
        if (slot + F.G < NTOK / 4) P13A_LOADQ(P13A_TOK0(slot + F.G));
        __builtin_amdgcn_sched_barrier(0);
        {
#define HM_(x, OP) do { x = OP(x, dpp_xor1(x)); x = OP(x, dpp_xor2(x)); x = OP(x, __int_as_float(__builtin_amdgcn_mov_dpp(__float_as_int(x), 0x141, 0xF, 0xF, true))); x = OP(x, __int_as_float(__builtin_amdgcn_mov_dpp(__float_as_int(x), 0x140, 0xF, 0xF, true))); \
            { auto r_ = __builtin_amdgcn_permlane16_swap(__float_as_uint(x), __float_as_uint(x), false, false); x = OP(__uint_as_float(r_[0]), __uint_as_float(r_[1])); } } while (0)
            HM_(mn0, fminf); HM_(mx0, fmaxf); HM_(mn1, fminf); HM_(mx1, fmaxf);
#undef HM_
        }
        if (r32 == 0) { mmx[(wid * 4 + 2 * hi) * 2] = mn0; mmx[(wid * 4 + 2 * hi) * 2 + 1] = mx0; mmx[(wid * 4 + 2 * hi + 1) * 2] = mn1; mmx[(wid * 4 + 2 * hi + 1) * 2 + 1] = mx1; }
        __syncthreads();
        const int tok = tok0 + q, n = t0 + q + 1; bool ovf = false;
        if (tmax + 1 <= TOPK) {
            for (int i = th; i < TOPK; i += 128) IDX[(size_t)tok * TOPK + i] = (i < n) ? i : 0;
        } else {
            const LAS float* scq = sc + q * 8192; const int nsl = (n + 127) >> 7;
            float fmn = 3e38f, fmx = -3e38f;
#pragma unroll
            for (int w = 0; w < 8; ++w) { fmn = fminf(fmn, mmx[(w * 4 + q) * 2]); fmx = fmaxf(fmx, mmx[(w * 4 + q) * 2 + 1]); }
            const float bsc = (fmx > fmn) ? 255.99f / (fmx - fmn) : 0.f;
            for (int s0 = 0; s0 < nsl; s0 += 8) { float v[8];
#pragma unroll
                for (int j = 0; j < 8; ++j) { const int i = (s0 + j) * 128 + th; v[j] = scq[min(i, n - 1)]; }
#pragma unroll
                for (int j = 0; j < 8; ++j) { const int i = (s0 + j) * 128 + th; const int bin = min(max((int)((v[j] - fmn) * bsc), 0), 255);
                    LAS unsigned* tgt = (i < n) ? &hist[q * 1024 + (lane & 3) * 256 + bin] : &dmy[th];
                    __hip_atomic_fetch_add(tgt, 1u, __ATOMIC_RELAXED, __HIP_MEMORY_SCOPE_WORKGROUP); } }
            __syncthreads();
            if (sub == 0) {
                const v4u c4 = *(const LAS v4u*)(hist + q * 1024 + 4 * lane) + *(const LAS v4u*)(hist + q * 1024 + 256 + 4 * lane) + *(const LAS v4u*)(hist + q * 1024 + 512 + 4 * lane) + *(const LAS v4u*)(hist + q * 1024 + 768 + 4 * lane); const unsigned s4 = c4.x + c4.y + c4.z + c4.w; unsigned S = s4;
#pragma unroll
                for (int o = 1; o < 64; o <<= 1) { const unsigned v = __shfl_down(S, o); if (lane + o < 64) S += v; }
                const unsigned above = S - s4;
                if (above < (unsigned)TOPK && (unsigned)TOPK <= S) { unsigned cum = above; int bin;
                    if (cum + c4.w >= (unsigned)TOPK) bin = 3; else { cum += c4.w; if (cum + c4.z >= (unsigned)TOPK) bin = 2; else { cum += c4.z; if (cum + c4.y >= (unsigned)TOPK) bin = 1; else { cum += c4.y; bin = 0; } } }
                    qm[q * 16 + 0] = (unsigned)(4 * lane + bin); qm[q * 16 + 1] = (unsigned)TOPK - cum; }
            }
            __syncthreads();
            const int bstar = (int)qm[q * 16 + 0]; const unsigned need1 = qm[q * 16 + 1];
            { unsigned run = 0u;
              for (int s0 = 0; s0 < nsl; s0 += 8) { float v[8];
#pragma unroll
                for (int j = 0; j < 8; ++j) { const int i = (s0 + j) * 128 + th; v[j] = scq[min(i, n - 1)]; }
#pragma unroll
                for (int j = 0; j < 8; ++j) { const int i = (s0 + j) * 128 + th; const bool ok = i < n; const int bin = min(max((int)((v[j] - fmn) * bsc), 0), 255);
                    const bool def = ok && bin > bstar; const unsigned long long bd = __ballot(def);
                    const unsigned pos = run + __builtin_amdgcn_mbcnt_hi((unsigned)(bd >> 32), __builtin_amdgcn_mbcnt_lo((unsigned)bd, 0u));
                    if (def && pos < (unsigned)TOPK) outl[q * 256 + (sub ? 255u - pos : pos)] = (unsigned)i;
                    run += (unsigned)__popcll(bd);
                    if (ok && bin == bstar) { const unsigned pc = __hip_atomic_fetch_add(&qm[q * 16 + 4], 1u, __ATOMIC_RELAXED, __HIP_MEMORY_SCOPE_WORKGROUP); if (pc < (unsigned)CAP) { candk[q * CAP + pc] = f2key(v[j]); candi[q * CAP + pc] = (unsigned)i; } } } }
              if (lane == 0) qm[q * 16 + 10 + sub] = run; }
            __syncthreads();
            if (sub == 0) {
                const unsigned mc = qm[q * 16 + 4];
                if (mc <= (unsigned)CAP) {
                    const unsigned D0 = qm[q * 16 + 10];
                    unsigned kc[4], ic[4], rk[4];
#pragma unroll
                    for (int c = 0; c < 4; ++c) { const bool vl = lane + 64 * c < (int)mc; kc[c] = vl ? candk[q * CAP + lane + 64 * c] : 0u; ic[c] = vl ? candi[q * CAP + lane + 64 * c] : 0xffffffffu; rk[c] = 0u; }
#pragma unroll 4
                    for (unsigned j = 0; j < mc; ++j) { const unsigned kj = candk[q * CAP + j], ij = candi[q * CAP + j];
#pragma unroll
                        for (int c = 0; c < 4; ++c) rk[c] += (kj > kc[c] || (kj == kc[c] && ij < ic[c])) ? 1u : 0u; }
#pragma unroll
                    for (int c = 0; c < 4; ++c) if (lane + 64 * c < (int)mc && rk[c] < need1) outl[q * 256 + D0 + rk[c]] = ic[c];
                    if (lane == 0) qm[q * 16 + 5] = 0u;
                } else if (lane == 0) qm[q * 16 + 5] = 1u;
            }
            __syncthreads();
            ovf = (qm[5] | qm[16 + 5] | qm[32 + 5] | qm[48 + 5]) != 0u;
            if (ovf) {
            for (int s0 = 0; s0 < nsl; s0 += 8) { float v[8];
#pragma unroll
                for (int j = 0; j < 8; ++j) { const int i = (s0 + j) * 128 + th; v[j] = scq[min(i, n - 1)]; }
#pragma unroll
                for (int j = 0; j < 8; ++j) { const int i = (s0 + j) * 128 + th; const int bin = min(max((int)((v[j] - fmn) * bsc), 0), 255);
                    if (i < n && bin == bstar) { const unsigned pc = __hip_atomic_fetch_add(&qm[q * 16 + 2], 1u, __ATOMIC_RELAXED, __HIP_MEMORY_SCOPE_WORKGROUP); if (pc < (unsigned)CAP) candk[q * CAP + pc] = f2key(v[j]); } } }
            __syncthreads();
            if (sub == 0) {
                const unsigned mc = qm[q * 16 + 2]; unsigned T = 0u, nt = 0u; bool found = false;
                if (mc <= (unsigned)CAP) {
                    unsigned kc[4], gt[4], ge[4];
#pragma unroll
                    for (int c = 0; c < 4; ++c) { kc[c] = (lane + 64 * c < (int)mc) ? candk[q * CAP + lane + 64 * c] : 0u; gt[c] = 0u; ge[c] = 0u; }
                    for (unsigned j = 0; j < mc; ++j) { const unsigned kj = candk[q * CAP + j];
#pragma unroll
                        for (int c = 0; c < 4; ++c) { gt[c] += (kj > kc[c]) ? 1u : 0u; ge[c] += (kj >= kc[c]) ? 1u : 0u; } }
#pragma unroll
                    for (int c = 0; c < 4; ++c) if (lane + 64 * c < (int)mc && gt[c] < need1 && need1 <= ge[c]) { T = kc[c]; nt = need1 - gt[c]; found = true; }
                } else {
                    unsigned lo = 0u;
                    for (int bit = 31; bit >= 0; --bit) { const unsigned cand = lo | (1u << bit); unsigned c = 0u;
                        for (int i = lane; i < n; i += 64) c += (f2key(scq[i]) >= cand) ? 1u : 0u;
#pragma unroll
                        for (int o = 1; o < 64; o <<= 1) c += __shfl_xor(c, o);
                        if (c >= (unsigned)TOPK) lo = cand; }
                    unsigned cg = 0u;
                    for (int i = lane; i < n; i += 64) cg += (f2key(scq[i]) > lo) ? 1u : 0u;
#pragma unroll
                    for (int o = 1; o < 64; o <<= 1) cg += __shfl_xor(cg, o);
                    T = lo; nt = (unsigned)TOPK - cg; found = (lane == 0);
                }
                if (found) { qm[q * 16 + 0] = T; qm[q * 16 + 1] = nt; }
            }
            __syncthreads();
            const unsigned T = qm[q * 16 + 0], need = qm[q * 16 + 1];
            unsigned Gs = 0u, Es = 0u;
            for (int s0 = 0; s0 < nsl; s0 += 8) { float v[8];
#pragma unroll
                for (int j = 0; j < 8; ++j) { const int i = (s0 + j) * 128 + th; v[j] = scq[min(i, n - 1)]; }
#pragma unroll
                for (int j = 0; j < 8; ++j) { const int i = (s0 + j) * 128 + th; const bool ok = i < n; const unsigned k = f2key(v[j]);
                    Gs += (unsigned)__popcll(__ballot(ok && k > T)); Es += (unsigned)__popcll(__ballot(ok && k == T)); } }
            if (lane == 0) { qm[q * 16 + 10 + sub * 2] = Gs; qm[q * 16 + 11 + sub * 2] = Es; }
            __syncthreads();
            const unsigned G0 = qm[q * 16 + 10], E0 = qm[q * 16 + 11], E1 = qm[q * 16 + 13];
            bool slow = false;
#pragma unroll
            for (int qx = 0; qx < 4; ++qx) slow = slow || (qm[qx * 16 + 11] + qm[qx * 16 + 13] != qm[qx * 16 + 1]);
            (void)E1;
            if (!slow) {
                unsigned run = sub ? (G0 + E0) : 0u;
                for (int s0 = 0; s0 < nsl; s0 += 8) { float v[8];
#pragma unroll
                    for (int j = 0; j < 8; ++j) { const int i = (s0 + j) * 128 + th; v[j] = scq[min(i, n - 1)]; }
#pragma unroll
                    for (int j = 0; j < 8; ++j) { const int i = (s0 + j) * 128 + th; const bool sel = (i < n) && f2key(v[j]) >= T; const unsigned long long bs = __ballot(sel);
                        const unsigned pos = run + __builtin_amdgcn_mbcnt_hi((unsigned)(bs >> 32), __builtin_amdgcn_mbcnt_lo((unsigned)bs, 0u));
                        if (sel && pos < (unsigned)TOPK) candk[q * CAP + pos] = (unsigned)i; run += (unsigned)__popcll(bs); } }
            } else {
            unsigned myG = 0u, myE = 0u;
            for (int s0 = 0; s0 < nsl; s0 += 8) { float v[8];
#pragma unroll
                for (int j = 0; j < 8; ++j) { const int i = (s0 + j) * 128 + th; v[j] = scq[min(i, n - 1)]; }
#pragma unroll
                for (int j = 0; j < 8; ++j) { const int s2 = s0 + j, i = s2 * 128 + th; const bool ok = i < n; const unsigned k = f2key(v[j]); const unsigned long long bg = __ballot(ok && k > T), be = __ballot(ok && k == T);
                    const unsigned cg = (unsigned)__popcll(bg), ce = (unsigned)__popcll(be); myG = (lane == s2) ? cg : myG; myE = (lane == s2) ? ce : myE; } }
            cntG[(q * 2 + sub) * 64 + lane] = myG; cntE[(q * 2 + sub) * 64 + lane] = myE;
            __syncthreads();
            unsigned tbase, pbase;
            { const unsigned e0 = cntE[(q * 2) * 64 + lane], e1 = cntE[(q * 2 + 1) * 64 + lane], g0 = cntG[(q * 2) * 64 + lane], g1 = cntG[(q * 2 + 1) * 64 + lane];
              unsigned inc = e0 + e1;
#pragma unroll
              for (int o = 1; o < 64; o <<= 1) { const unsigned v = __shfl_up(inc, o); if (lane >= o) inc += v; }
              const unsigned tb0 = inc - (e0 + e1), tb1 = tb0 + e0;
              const unsigned se0 = (need > tb0) ? min(need - tb0, e0) : 0u, se1 = (need > tb1) ? min(need - tb1, e1) : 0u;
              const unsigned c0 = g0 + se0, c1 = g1 + se1; unsigned inc2 = c0 + c1;
#pragma unroll
              for (int o = 1; o < 64; o <<= 1) { const unsigned v = __shfl_up(inc2, o); if (lane >= o) inc2 += v; }
              const unsigned pb0 = inc2 - (c0 + c1);
              tbase = sub ? tb1 : tb0; pbase = sub ? pb0 + c0 : pb0; }
            for (int s0 = 0; s0 < nsl; s0 += 8) { float v[8];
#pragma unroll
                for (int j = 0; j < 8; ++j) { const int i = (s0 + j) * 128 + th; v[j] = scq[min(i, n - 1)]; }
#pragma unroll
                for (int j = 0; j < 8; ++j) { const int s2 = s0 + j; if (s2 < nsl) { const int i = s2 * 128 + th; const bool ok = i < n; const unsigned k = f2key(v[j]); const bool g = ok && k > T, e = ok && k == T;
                    const unsigned long long be = __ballot(e);
                    const unsigned trank = (unsigned)__builtin_amdgcn_readlane((int)tbase, s2) + __builtin_amdgcn_mbcnt_hi((unsigned)(be >> 32), __builtin_amdgcn_mbcnt_lo((unsigned)be, 0u));
                    const bool sel = g || (e && trank < need);
                    const unsigned long long bs = __ballot(sel);
                    const unsigned pos = (unsigned)__builtin_amdgcn_readlane((int)pbase, s2) + __builtin_amdgcn_mbcnt_hi((unsigned)(bs >> 32), __builtin_amdgcn_mbcnt_lo((unsigned)bs, 0u));
                    if (sel && pos < (unsigned)TOPK) candk[q * CAP + pos] = (unsigned)i; } } }
            }
            }
        }
        __syncthreads();
        if (tmax + 1 > TOPK) { const LAS unsigned* src = ovf ? candk + q * CAP : outl + q * 256; for (int i = th; i < TOPK; i += 128) IDX[(size_t)tok * TOPK + i] = (int)src[i]; }
    }
}

__device__ __forceinline__ void p13b_dsa_attn(Frame& F, const Args& A) {
    unsigned char* ws = A.ws; const int lane = F.lane, wid = F.wave, c16 = lane & 15, g4 = lane >> 4;
    const bf16* CN = (const bf16*)(ws + WS_CN); const bf16* QL = (const bf16*)(ws + WS_QLAT); const int* IDX = (const int*)(ws + WS_IDX); bf16* OL = (bf16*)(ws + WS_OLAT);
    LAS float* lut = (LAS float*)(F.lds + DSA_SCR + 8192);
    for (int i = F.tid; i < 144 * 16; i += 512) { const int n = i >> 4, h = i & 15; lut[i] = A.in[1][rel_bucket(n) * 16 + h]; }
    __syncthreads();
    LAS char* img = (LAS char*)(F.lds + RING_OFF + wid * 16384);
    LAS int* idxw = (LAS int*)(F.lds + DSA_SCR + wid * 1024);
    const unsigned imgb = (unsigned)(uintptr_t)img;
    const int gw = F.vcu * NWAVES + wid, NGW = F.G * NWAVES;
    const unsigned prow0 = 8u * ((lane >> 2) & 3) + (lane & 3);
    unsigned ta0[8], ta1[8];
    { const unsigned qq = (lane & 15) >> 2, pp = lane & 3;
#pragma unroll
      for (int c = 0; c < 8; ++c) { ta0[c] = imgb + dsa_off_b(8 * g4 + qq, 2 * c + (pp >> 1)) + 8 * (pp & 1); ta1[c] = imgb + dsa_off_b(8 * g4 + 4 + qq, 2 * c + (pp >> 1)) + 8 * (pp & 1); } }
    (void)gw; (void)NGW;
    for (int j = wid; ; j += NWAVES) {
        const int slot = F.vcu + (j >> 2) * F.G; if (slot >= NTOK / 4) break;
        const int tok = P13A_TOK0(slot) + (j & 3);
        const int b = tok >> 13, t = tok & (SEQ - 1), cnt = min(TOPK, t + 1), ntile = (cnt + 31) >> 5;
        bf16x8 qb[8];
#pragma unroll
        for (int ks = 0; ks < 8; ++ks) qb[ks] = *(const bf16x8*)(QL + (size_t)tok * 4096 + c16 * 256 + ks * 32 + g4 * 8);
#pragma unroll
        for (int i = 0; i < 4; ++i) idxw[lane + 64 * i] = IDX[(size_t)tok * TOPK + lane + 64 * i];
        WSYNC();
        f32x4 o[16];
#pragma unroll
        for (int ct = 0; ct < 16; ++ct) o[ct] = (f32x4){0.f, 0.f, 0.f, 0.f};
        float m_run = -1e30f, l_run = 0.f;
        const LAS float* lutcol = lut + c16;
#pragma unroll 1
        for (int tile = 0; tile < ntile; ++tile) {
            { v4u st[16];
#pragma unroll
              for (int i = 0; i < 16; ++i) { const int nn = lane + 64 * i, row = nn >> 5, chg = nn & 31; const int key = idxw[tile * 32 + row];
                  st[i] = *(const v4u*)(CN + (size_t)(b * SEQ + key) * KVR + chg * 8); }
#pragma unroll
              for (int i = 0; i < 16; ++i) { const int nn = lane + 64 * i, row = nn >> 5, chg = nn & 31;
                  *(LAS v4u*)(img + (chg >> 4) * 8192 + dsa_off_b(row, chg & 15)) = st[i]; } }
            WSYNC();
            f32x4 sacc[2];
#pragma unroll
            for (int T = 0; T < 2; ++T) { sacc[T] = (f32x4){0.f, 0.f, 0.f, 0.f};
#pragma unroll
                for (int ks = 0; ks < 8; ++ks) { const bf16x8 a = *(const LAS bf16x8*)(img + (ks >> 2) * 8192 + dsa_off_b(prow0 + 4 * T, 4 * (ks & 3) + g4));
                    sacc[T] = __builtin_amdgcn_mfma_f32_16x16x32_bf16(a, qb[ks], sacc[T], 0, 0, 0); } }
            float pmax = -__builtin_inff();
#pragma unroll
            for (int T = 0; T < 2; ++T) { const int i0 = tile * 32 + 8 * g4 + 4 * T; const v4u kk = *(const LAS v4u*)(idxw + i0);
                const int kidx[4] = {(int)kk.x, (int)kk.y, (int)kk.z, (int)kk.w};
#pragma unroll
                for (int e = 0; e < 4; ++e) { const int dist = min(max(t - kidx[e], 0), 128); float s = sacc[T][e] + lutcol[dist * 16];
                    s = (i0 + e < cnt) ? s : -__builtin_inff(); sacc[T][e] = s; pmax = fmaxf(pmax, s); } }
            pmax = max_xor16(pmax); pmax = max_xor32(pmax);
            const float mn = fmaxf(m_run, pmax), alpha = __builtin_amdgcn_exp2f((m_run - mn) * fa::C2); m_run = mn;
            float ps = 0.f;
#pragma unroll
            for (int T = 0; T < 2; ++T)
#pragma unroll
                for (int e = 0; e < 4; ++e) { const float pv = __builtin_amdgcn_exp2f((sacc[T][e] - mn) * fa::C2); sacc[T][e] = pv; ps += pv; }
            ps = sum_xor16(ps); ps = sum_xor32(ps);
            l_run = l_run * alpha + ps;
            if (__any(alpha < 1.f)) {
                float al[4];
#pragma unroll
                for (int e = 0; e < 4; ++e) al[e] = __shfl(alpha, 4 * g4 + e);
#pragma unroll
                for (int ct = 0; ct < 16; ++ct)
#pragma unroll
                    for (int e = 0; e < 4; ++e) o[ct][e] *= al[e];
            }
            fa::u32x4v pw; pw.x = fa::cvtpk(sacc[0][0], sacc[0][1]); pw.y = fa::cvtpk(sacc[0][2], sacc[0][3]); pw.z = fa::cvtpk(sacc[1][0], sacc[1][1]); pw.w = fa::cvtpk(sacc[1][2], sacc[1][3]);
            const bf16x8 pa = *reinterpret_cast<bf16x8*>(&pw);
#pragma unroll
            for (int cg = 0; cg < 4; ++cg) { fa::s16x4 b0[4], b1[4];
                asm volatile("ds_read_b64_tr_b16 %0, %8 offset:%c16\n\tds_read_b64_tr_b16 %1, %9 offset:%c16\n\tds_read_b64_tr_b16 %2, %10 offset:%c16\n\tds_read_b64_tr_b16 %3, %11 offset:%c16\n\t"
                             "ds_read_b64_tr_b16 %4, %12 offset:%c16\n\tds_read_b64_tr_b16 %5, %13 offset:%c16\n\tds_read_b64_tr_b16 %6, %14 offset:%c16\n\tds_read_b64_tr_b16 %7, %15 offset:%c16\n\ts_waitcnt lgkmcnt(0)"
                             : "=&v"(b0[0]), "=&v"(b1[0]), "=&v"(b0[1]), "=&v"(b1[1]), "=&v"(b0[2]), "=&v"(b1[2]), "=&v"(b0[3]), "=&v"(b1[3])
                             : "v"(ta0[(cg & 1) * 4 + 0]), "v"(ta1[(cg & 1) * 4 + 0]), "v"(ta0[(cg & 1) * 4 + 1]), "v"(ta1[(cg & 1) * 4 + 1]), "v"(ta0[(cg & 1) * 4 + 2]), "v"(ta1[(cg & 1) * 4 + 2]), "v"(ta0[(cg & 1) * 4 + 3]), "v"(ta1[(cg & 1) * 4 + 3]), "i"((cg >> 1) * 8192) : "memory");
                FA_SBAR();
#pragma unroll
                for (int k = 0; k < 4; ++k) o[cg * 4 + k] = __builtin_amdgcn_mfma_f32_16x16x32_bf16(pa, (bf16x8){b0[k][0], b0[k][1], b0[k][2], b0[k][3], b1[k][0], b1[k][1], b1[k][2], b1[k][3]}, o[cg * 4 + k], 0, 0, 0); }
            WSYNC();
        }
        { const float il = (l_run > 0.f) ? 1.0f / l_run : 0.f; float ile[4];
#pragma unroll
          for (int e = 0; e < 4; ++e) ile[e] = __shfl(il, 4 * g4 + e);
#pragma unroll
          for (int ct = 0; ct < 16; ++ct)
#pragma unroll
              for (int e = 0; e < 4; ++e) { const float v = o[ct][e] * ile[e]; const float vn = dpp_xor1(v);
                  if ((lane & 1) == 0) *(unsigned*)(OL + (size_t)tok * 4096 + (4 * g4 + e) * 256 + ct * 16 + c16) = fa::cvtpk(v, vn); } }
        WSYNC();
    }
    __syncthreads();
}

struct MoeTiles { int tend[8]; int pstart[8]; int MT; };
__device__ __forceinline__ void moe_tiles(Frame& F, MoeTiles& T) {
    int acc = 0;
#pragma unroll
    for (int e = 0; e < 8; ++e) { const int c = (int)__builtin_amdgcn_readfirstlane(__hip_atomic_load((unsigned*)(F.ctl + CW_MOECNT + 64 * e), __ATOMIC_RELAXED, __HIP_MEMORY_SCOPE_AGENT));
        T.pstart[e] = acc * 256; acc += (c + 255) >> 8; T.tend[e] = acc; }
    T.MT = acc;
}
__device__ __forceinline__ void p15_gather(Frame& F, const Args& A) {
    MoeTiles T; moe_tiles(F, T);
    const int gw = F.vcu * NWAVES + F.wave, NGW = F.G * NWAVES, lane = F.lane;
    const bf16* XH = (const bf16*)(A.ws + WS_XF); unsigned char* XG = (unsigned char*)(A.ws + WS_XG);
    const int* re = (const int*)(A.ws + WS_ROUTE); const int* rp = re + 2 * NTOK;
    v4u xn[4];
    if (gw < NTOK) {
#pragma unroll
        for (int k = 0; k < 4; ++k) xn[k] = *(const v4u*)(XH + (size_t)gw * DM + 8 * lane + 512 * k); }
    for (int tok = gw; tok < NTOK; tok += NGW) {
        uint2 o[4];
#pragma unroll
        for (int k = 0; k < 4; ++k) { int w0 = __builtin_amdgcn_cvt_pk_fp8_f32(bflo(xn[k].x), bfhi(xn[k].x), 0, false); w0 = __builtin_amdgcn_cvt_pk_fp8_f32(bflo(xn[k].y), bfhi(xn[k].y), w0, true);
            int w1 = __builtin_amdgcn_cvt_pk_fp8_f32(bflo(xn[k].z), bfhi(xn[k].z), 0, false); w1 = __builtin_amdgcn_cvt_pk_fp8_f32(bflo(xn[k].w), bfhi(xn[k].w), w1, true); o[k].x = (unsigned)w0; o[k].y = (unsigned)w1; }
        const int e0 = re[2 * tok], e1 = re[2 * tok + 1], p0 = rp[2 * tok], p1 = rp[2 * tok + 1];
        if (tok + NGW < NTOK) {
#pragma unroll
            for (int k = 0; k < 4; ++k) xn[k] = *(const v4u*)(XH + (size_t)(tok + NGW) * DM + 8 * lane + 512 * k); }
        __builtin_amdgcn_sched_barrier(0);
#pragma unroll
        for (int s = 0; s < 2; ++s) { const int e = s ? e1 : e0, pp = s ? p1 : p0; int ps = 0;
#pragma unroll
            for (int q = 0; q < 8; ++q) ps = (q == e) ? T.pstart[q] : ps;
            unsigned char* dst = XG + (size_t)(ps + pp) * DM + 8 * lane;
#pragma unroll
            for (int k = 0; k < 4; ++k) *(uint2*)(dst + 512 * k) = o[k]; }
    }
}
__device__ __forceinline__ void p18_final(Frame& F, const Args& A) {
    MoeTiles T; moe_tiles(F, T);
    const int gw = F.vcu * NWAVES + F.wave, NGW = F.G * NWAVES, lane = F.lane;
    const bf16* XH = (const bf16*)(A.ws + WS_XF); const bf16* Y = (const bf16*)(A.ws + WS_Y);
    const int* re = (const int*)(A.ws + WS_ROUTE); const int* rp = re + 2 * NTOK; const float* rw = (const float*)(rp + 2 * NTOK);
    const float* gam = A.in[25] + DM; const float* bet = A.in[26] + DM;
    LAS float* gml = (LAS float*)(F.lds + DSA_SCR); LAS float* btl = gml + DM;
    { const int i = F.tid; *(LAS f32x4*)(gml + i * 4) = *(const f32x4*)(gam + i * 4); *(LAS f32x4*)(btl + i * 4) = *(const f32x4*)(bet + i * 4); }
    __syncthreads();
    int en[2][2], pn[2][2]; float wn[2][2];
#pragma unroll
    for (int u = 0; u < 2; ++u) { const int t = min(gw + u * NGW, NTOK - 1); en[u][0] = re[2 * t]; en[u][1] = re[2 * t + 1]; pn[u][0] = rp[2 * t]; pn[u][1] = rp[2 * t + 1]; wn[u][0] = rw[2 * t]; wn[u][1] = rw[2 * t + 1]; }
    for (int tok = gw; tok < NTOK; tok += 2 * NGW) {
        int rows[2][2]; float w[2][2]; int tk[2];
#pragma unroll
        for (int u = 0; u < 2; ++u) { tk[u] = min(tok + u * NGW, NTOK - 1);
#pragma unroll
            for (int s = 0; s < 2; ++s) { const int e = en[u][s]; int ps = 0;
#pragma unroll
                for (int q = 0; q < 8; ++q) ps = (q == e) ? T.pstart[q] : ps;
                rows[u][s] = ps + pn[u][s]; w[u][s] = wn[u][s]; } }
#pragma unroll
        for (int u = 0; u < 2; ++u) { const int t = min(tok + (2 + u) * NGW, NTOK - 1); en[u][0] = re[2 * t]; en[u][1] = re[2 * t + 1]; pn[u][0] = rp[2 * t]; pn[u][1] = rp[2 * t + 1]; wn[u][0] = rw[2 * t]; wn[u][1] = rw[2 * t + 1]; }
        v4u xa[2][4], ya[2][4], yb[2][4];
#pragma unroll
        for (int u = 0; u < 2; ++u) { const v4u* xr = (const v4u*)(XH + (size_t)tk[u] * DM) + lane; const v4u* y0 = (const v4u*)(Y + (size_t)rows[u][0] * DM) + lane; const v4u* y1 = (const v4u*)(Y + (size_t)rows[u][1] * DM) + lane;
#pragma unroll
            for (int j = 0; j < 4; ++j) { xa[u][j] = xr[64 * j]; ya[u][j] = y0[64 * j]; yb[u][j] = y1[64 * j]; } }
#pragma unroll
        for (int u = 0; u < 2; ++u) {
            f32x4 v[8]; float s = 0.f;
#pragma unroll
            for (int j = 0; j < 4; ++j) { const v4u x4 = xa[u][j], a4 = ya[u][j], b4 = yb[u][j];
                v[2 * j] = (f32x4){bflo(x4.x), bfhi(x4.x), bflo(x4.y), bfhi(x4.y)} * ALPHA + (f32x4){bflo(a4.x), bfhi(a4.x), bflo(a4.y), bfhi(a4.y)} * w[u][0] + (f32x4){bflo(b4.x), bfhi(b4.x), bflo(b4.y), bfhi(b4.y)} * w[u][1];
                v[2 * j + 1] = (f32x4){bflo(x4.z), bfhi(x4.z), bflo(x4.w), bfhi(x4.w)} * ALPHA + (f32x4){bflo(a4.z), bfhi(a4.z), bflo(a4.w), bfhi(a4.w)} * w[u][0] + (f32x4){bflo(b4.z), bfhi(b4.z), bflo(b4.w), bfhi(b4.w)} * w[u][1];
                s += ((v[2 * j][0] + v[2 * j][1]) + (v[2 * j][2] + v[2 * j][3])) + ((v[2 * j + 1][0] + v[2 * j + 1][1]) + (v[2 * j + 1][2] + v[2 * j + 1][3])); }
            const float mean = wave_sum(s) * (1.f / DM); float s2 = 0.f;
#pragma unroll
            for (int j = 0; j < 8; ++j) { v[j] = v[j] - mean; s2 += (v[j][0] * v[j][0] + v[j][1] * v[j][1]) + (v[j][2] * v[j][2] + v[j][3] * v[j][3]); }
            const float rstd = 1.f / sqrtf(wave_sum(s2) * (1.f / DM) + LN_EPS);
            if (tok + u * NGW < NTOK) {
#pragma unroll
                for (int j = 0; j < 4; ++j) { const int c = 8 * lane + 512 * j;
                    *(f32x4*)(A.out + (size_t)tk[u] * DM + c) = v[2 * j] * rstd * *(const LAS f32x4*)(gml + c) + *(const LAS f32x4*)(btl + c);
                    *(f32x4*)(A.out + (size_t)tk[u] * DM + c + 4) = v[2 * j + 1] * rstd * *(const LAS f32x4*)(gml + c + 4) + *(const LAS f32x4*)(btl + c + 4); } }
        }
    }
}

__global__ void __launch_bounds__(NWAVES * 64, 2) mega_fwd(Args args) {
    extern __shared__ __attribute__((aligned(16))) unsigned char lds[];
    Frame F;
    F.lds = (LAS unsigned char*)lds;
    F.MISC = (volatile LAS unsigned*)(F.lds + MISC_OFF);
    F.tid = threadIdx.x; F.lane = F.tid & 63; F.wave = __builtin_amdgcn_readfirstlane(F.tid >> 6);
    F.G = gridDim.x; { const int bx = blockIdx.x; F.vcu = (F.G % 8 == 0) ? (bx % 8) * (F.G / 8) + bx / 8 : bx; }
    unsigned char* ws = args.ws;
    F.ctl = (gu32*)(ws + WS_CTL);
    for (int u = F.tid; u < (LDS_BYTES - LDSCTL_OFF) / 4; u += NWAVES * 64) ((LAS unsigned*)(F.lds + LDSCTL_OFF))[u] = 0u;
    __syncthreads();
    XcdBarrier bar; bar.bar = (unsigned*)(F.ctl + CW_BAR); bar.x = 0; bar.st = nullptr;
#if !MK_PER_PHASE
    bar = xcd_barrier_post((unsigned*)(F.ctl + CW_BAR), F.MISC + 8);
#define GRID_BAR() xcd_barrier(bar)
#else
#define GRID_BAR() do { } while (0)
#endif
    const int lo = args.ph_lo, hi = args.ph_hi;
#ifndef PH_MASK
#define PH_MASK 0x3fffff
#endif
#define IN(k) (((PH_MASK >> (k)) & 1) && lo <= (k) && (k) < hi)
#define BOTH(k) (IN(k) && IN((k) + 1))
    bf16* XB = (bf16*)(ws + WS_XB); bf16* XH = (bf16*)(ws + WS_XF); bf16* Z = (bf16*)(ws + WS_Z);

#ifndef PROBE_MASK
#define PROBE_MASK 0
#endif
#define REPS(k) ((((PROBE_MASK) >> (k)) & 1) ? 2 : 1)
    if (IN(0)) for (int rep_ = 0; rep_ < REPS(0); ++rep_) { relaunder(F); p0_prologue(F, args); if (BOTH(0) || rep_ + 1 < REPS(0)) GRID_BAR(); }
    if (IN(1)) for (int rep_ = 0; rep_ < REPS(1); ++rep_) { relaunder(F);
        pg8::Gemm g{XB, (const bf16*)(ws + WS_W_NSA_IN), NTOK, 5120, DM}; pg8::StaticOrder S; S.init(NTOK, 5120, F.G, (int)blockIdx.x);
        pg8::EpiNsaIn E{(bf16*)(ws + WS_P0), (float*)(ws + WS_GL), 0.08838834764831845f};
        pg8::gemm_phase<pg8::EpiNsaIn, pg8::StaticOrder, true, true>(F.lds + RING_OFF, g, S, E);
        if (BOTH(1) || rep_ + 1 < REPS(1)) GRID_BAR();
    }
    if (IN(2)) for (int rep_ = 0; rep_ < REPS(2); ++rep_) { relaunder(F); p2_compress(F, args); if (BOTH(2) || rep_ + 1 < REPS(2)) GRID_BAR(); }
#ifndef PROBE_NSA2
#define PROBE_NSA2 0
#endif
    for (int repn_ = 0; repn_ < (PROBE_NSA2 ? 2 : 1); ++repn_) {
    if (IN(3)) for (int rep_ = 0; rep_ < REPS(3); ++rep_) { relaunder(F); p3a_nsa_cmp(F, args); __syncthreads(); }
    if (IN(4)) for (int rep_ = 0; rep_ < REPS(4); ++rep_) { relaunder(F); p3b_nsa_sel(F, args); if (BOTH(4) || rep_ + 1 < REPS(4) || repn_ + 1 < (PROBE_NSA2 ? 2 : 1)) GRID_BAR(); }
    }
    if (IN(6)) for (int rep_ = 0; rep_ < REPS(6); ++rep_) { relaunder(F);
        pg8::Gemm g{(const bf16*)(ws + WS_OATT0), (const bf16*)(ws + WS_W_NSA_OUT), NTOK, DM, DM}; pg8::StaticOrder S; S.init(NTOK, DM, F.G, (int)blockIdx.x);
        pg8::EpiResF32 E{args.in[0], Z, ALPHA, DM};
        pg8::gemm_phase<pg8::EpiResF32, pg8::StaticOrder, true, true>(F.lds + RING_OFF, g, S, E);
        if (BOTH(6) || rep_ + 1 < REPS(6)) GRID_BAR();
    }
    if (IN(7)) for (int rep_ = 0; rep_ < REPS(7); ++rep_) { relaunder(F); ln_phase<false, FFN_F8 != 0>(F, args, Z, args.in[23], args.in[24], XH, (unsigned char*)XB); if (BOTH(7) || rep_ + 1 < REPS(7)) GRID_BAR(); }
    if (IN(8)) for (int rep_ = 0; rep_ < REPS(8); ++rep_) { relaunder(F);
        pg8::StaticOrder S; S.init(NTOK, 2 * DFF, F.G, (int)blockIdx.x);
#if FFN_F8
        pg8::Gemm g{XB, (const bf16*)(ws + WS_W_FFN_GU), NTOK, 2 * DFF, DM, 1, 0x79797979};
        pg8::EpiSwiGLU8 E{(unsigned char*)(ws + WS_HFF), DFF};
        pg8::gemm_phase<pg8::EpiSwiGLU8, pg8::StaticOrder, true, true, true>(F.lds + RING_OFF, g, S, E);
#else
        pg8::Gemm g{XB, (const bf16*)(ws + WS_W_FFN_GU), NTOK, 2 * DFF, DM};
        pg8::EpiSwiGLU E{(bf16*)(ws + WS_HFF), DFF};
        pg8::gemm_phase<pg8::EpiSwiGLU, pg8::StaticOrder, true, true>(F.lds + RING_OFF, g, S, E);
#endif
        if (BOTH(8) || rep_ + 1 < REPS(8)) GRID_BAR();
    }
    if (IN(9)) for (int rep_ = 0; rep_ < REPS(9); ++rep_) { relaunder(F);
        pg8::StaticOrder S; S.init(NTOK, DM, F.G, (int)blockIdx.x);
        pg8::EpiResH E{XH, Z, ALPHA, DM};
#if FFN_F8
        pg8::Gemm g{(const bf16*)(ws + WS_HFF), (const bf16*)(ws + WS_W_FFN_DN), NTOK, DM, DFF, 1, 0x77777777};
        pg8::gemm_phase<pg8::EpiResH, pg8::StaticOrder, true, true, true>(F.lds + RING_OFF, g, S, E);
#else
        pg8::Gemm g{(const bf16*)(ws + WS_HFF), (const bf16*)(ws + WS_W_FFN_DN), NTOK, DM, DFF};
        pg8::gemm_phase<pg8::EpiResH, pg8::StaticOrder, true, true>(F.lds + RING_OFF, g, S, E);
#endif
        if (BOTH(9) || rep_ + 1 < REPS(9)) GRID_BAR();
    }
    if (IN(10)) for (int rep_ = 0; rep_ < REPS(10); ++rep_) { relaunder(F); ln_phase<false>(F, args, Z, args.in[25], args.in[26], XH, nullptr); if (BOTH(10) || rep_ + 1 < REPS(10)) GRID_BAR(); }
    if (IN(11)) for (int rep_ = 0; rep_ < REPS(11); ++rep_) { relaunder(F);
        pg8::Gemm g{XH, (const bf16*)(ws + WS_W_DSA_IN), NTOK, DSA_NPAD, DM}; pg8::StaticOrder S; S.init(NTOK, DSA_NPAD, F.G, (int)blockIdx.x);
        pg8::EpiDsaIn E{(bf16*)(ws + WS_Q), (float*)(ws + WS_CRAW), (bf16*)(ws + WS_QI), (float*)(ws + WS_KIWI), 0.125f};
        pg8::gemm_phase<pg8::EpiDsaIn, pg8::StaticOrder, true, true>(F.lds + RING_OFF, g, S, E);
        if (BOTH(11) || rep_ + 1 < REPS(11)) GRID_BAR();
    }
    if (IN(12)) for (int rep_ = 0; rep_ < REPS(12); ++rep_) { relaunder(F); p10_dsa_prep(F, args); if (BOTH(12) || rep_ + 1 < REPS(12)) GRID_BAR(); }
    if (IN(13)) for (int rep_ = 0; rep_ < REPS(13); ++rep_) { relaunder(F); p13a_dsa_index(F, args); __syncthreads(); }
    if (IN(14)) for (int rep_ = 0; rep_ < REPS(14); ++rep_) { relaunder(F); p13b_dsa_attn(F, args); if (BOTH(14) || rep_ + 1 < REPS(14)) GRID_BAR(); }
    if (IN(15)) for (int rep_ = 0; rep_ < REPS(15); ++rep_) { relaunder(F); p12_dsa_uv(F, args); if (BOTH(15) || rep_ + 1 < REPS(15)) GRID_BAR(); }
    if (IN(16)) for (int rep_ = 0; rep_ < REPS(16); ++rep_) { relaunder(F);
        pg8::Gemm g{(const bf16*)(ws + WS_OATT1), (const bf16*)(ws + WS_W_DSA_OUT), NTOK, DM, DM}; pg8::StaticOrder S; S.init(NTOK, DM, F.G, (int)blockIdx.x);
        pg8::EpiResH E{XH, Z, ALPHA, DM};
        pg8::gemm_phase<pg8::EpiResH, pg8::StaticOrder, true, true>(F.lds + RING_OFF, g, S, E);
        if (BOTH(16) || rep_ + 1 < REPS(16)) GRID_BAR();
    }
    if (IN(17)) for (int rep_ = 0; rep_ < REPS(17); ++rep_) { relaunder(F); ln_route_phase(F, args, Z, args.in[23] + DM, args.in[24] + DM, XH); if (BOTH(17) || rep_ + 1 < REPS(17)) GRID_BAR(); }
    if (IN(18)) for (int rep_ = 0; rep_ < REPS(18); ++rep_) { relaunder(F); p15_gather(F, args); if (BOTH(18) || rep_ + 1 < REPS(18)) GRID_BAR(); }
    if (IN(19)) for (int rep_ = 0; rep_ < REPS(19); ++rep_) { relaunder(F);
        MoeTiles T; moe_tiles(F, T);
        pg8::Gemm g{(const bf16*)(ws + WS_XG), (const bf16*)(ws + WS_W_MOE_GU), T.MT * 256, 2 * DFFE, DM, 1, 0x79797979}; pg8::MoeOrder S; S.init(T.MT * 256, 2 * DFFE, F.G, (int)blockIdx.x); S.nexp_rows = 2 * DFFE;
#pragma unroll
        for (int e = 0; e < 8; ++e) S.tend[e] = T.tend[e];
        pg8::EpiSwiGLU8 E{(unsigned char*)(ws + WS_HM), DFFE};
        pg8::gemm_phase<pg8::EpiSwiGLU8, pg8::MoeOrder, true, true, true>(F.lds + RING_OFF, g, S, E);
        if (BOTH(19) || rep_ + 1 < REPS(19)) GRID_BAR();
    }
    if (IN(20)) for (int rep_ = 0; rep_ < REPS(20); ++rep_) { relaunder(F);
        MoeTiles T; moe_tiles(F, T);
        pg8::Gemm g{(const bf16*)(ws + WS_HM), (const bf16*)(ws + WS_W_MOE_DN), T.MT * 256, DM, DFFE, 1, 0x77777777}; pg8::MoeOrder S; S.init(T.MT * 256, DM, F.G, (int)blockIdx.x); S.nexp_rows = DM;
#pragma unroll
        for (int e = 0; e < 8; ++e) S.tend[e] = T.tend[e];
        pg8::EpiBf16Plain E{(bf16*)(ws + WS_Y), DM};
        pg8::gemm_phase<pg8::EpiBf16Plain, pg8::MoeOrder, true, true, true>(F.lds + RING_OFF, g, S, E);
        if (BOTH(20) || rep_ + 1 < REPS(20)) GRID_BAR();
    }
    if (IN(21)) for (int rep_ = 0; rep_ < REPS(21); ++rep_) { relaunder(F); p18_final(F, args); }
#undef IN
#undef BOTH
}

extern "C" void kernel_launch(void* const* d_in, const int* in_sizes, int n_in, void* d_out, int out_size, void* d_ws, size_t ws_size, hipStream_t stream) {
    static int grid = 0;
    if (grid == 0) {
        if (n_in != 27 || out_size != NTOK * DM || ws_size < WS_END) { fprintf(stderr, "kernel_launch: unexpected shapes (n_in %d, out %d, ws %zu); nothing launched\n", n_in, out_size, ws_size); grid = -1; return; }
        int dev = 0, cus = 0, per_cu = 0;
        if (hipGetDevice(&dev) != hipSuccess || hipDeviceGetAttribute(&cus, hipDeviceAttributeMultiprocessorCount, dev) != hipSuccess) { grid = -1; return; }
        if (hipFuncSetAttribute((const void*)mega_fwd, hipFuncAttributeMaxDynamicSharedMemorySize, LDS_BYTES) != hipSuccess) { fprintf(stderr, "kernel_launch: hipFuncSetAttribute failed\n"); grid = -1; return; }
        if (hipOccupancyMaxActiveBlocksPerMultiprocessor(&per_cu, (const void*)mega_fwd, NWAVES * 64, LDS_BYTES) != hipSuccess || per_cu < 1) { fprintf(stderr, "kernel_launch: occupancy query says %d\n", per_cu); }
        (void)hipGetLastError();
        grid = cus;
    }
    if (grid < 0) return;
    if (hipMemsetAsync((char*)d_ws + WS_CTL, 0, CTL_ZERO_BYTES, stream) != hipSuccess) return;
    Args a{};
    for (int i = 0; i < 27; ++i) a.in[i] = (const float*)d_in[i];
    a.out = (float*)d_out; a.ws = (unsigned char*)d_ws;
#if MK_PER_PHASE
    for (int p = 0; p < NPHASE; ++p) { a.ph_lo = p; a.ph_hi = p + 1; hipLaunchKernelGGL(mega_fwd, dim3(grid), dim3(NWAVES * 64), LDS_BYTES, stream, a); }
#else
    a.ph_lo = 0; a.ph_hi = NPHASE;
    hipLaunchKernelGGL(mega_fwd, dim3(grid), dim3(NWAVES * 64), LDS_BYTES, stream, a);
#endif
}
```
